# Optimizing an MI355X kernel written in HIP

```python
import math
import jax
import jax.numpy as jnp
from jax import lax
import numpy as np

D_MODEL = 1024
BATCH = 8
SEQ = 2048
DEPTH = 2

N_BRANCHES = 3
BRANCH_WIDTH = 512
HGRN_HEADS = 4
HGRN_DK = 128
HGRN_DV = 128
DSA_HEADS = 4
DSA_HEAD_DIM = 128
IDX_HEADS = 4
IDX_DIM = 64
DSA_MAX_TOPK = 256
QBLOCK = 128
GLA_HEADS = 4
GLA_DK = 64
GLA_DV = 128
GLA_GATE_RANK = 16
GLA_TAU = 16.0
CHUNK = 64
PEER_HEADS = 8
PEER_DQ = 256
N_KEYS = 128
N_EXPERTS = N_KEYS * N_KEYS
PEER_TOPK = 16
PEER_BLOCK = 128
EPS = 1e-6

IN_SPLITS = (
    HGRN_HEADS * HGRN_DK,
    HGRN_HEADS * HGRN_DK,
    HGRN_HEADS * HGRN_DV,
    HGRN_HEADS * HGRN_DV,
    DSA_HEADS * DSA_HEAD_DIM,
    DSA_HEADS * DSA_HEAD_DIM,
    DSA_HEADS * DSA_HEAD_DIM,
    IDX_HEADS * IDX_DIM,
    IDX_DIM,
    IDX_HEADS,
    GLA_HEADS * GLA_DK,
    GLA_HEADS * GLA_DK,
    GLA_HEADS * GLA_DV,
    GLA_GATE_RANK,
    GLA_HEADS * GLA_DV,
    N_BRANCHES * D_MODEL,
)
IN_COLS = sum(IN_SPLITS)

kernel_name = "hybrid_hgrn2_dsa_gla_peer_adaln"


def rms_norm(x, gain):
    xf = x.astype(jnp.float32)
    y = xf * lax.rsqrt(jnp.mean(xf * xf, axis=-1, keepdims=True) + EPS)
    return (y * gain.astype(jnp.float32)).astype(x.dtype)


def modulate(x, gain, shift, scale):
    return rms_norm(x, gain) * (1.0 + scale[:, None, :]) + shift[:, None, :]


def split_heads(t, n_heads):
    return t.reshape(*t.shape[:-1], n_heads, t.shape[-1] // n_heads)


def chunk_gated_scan(q, k, v, log_decay, scale):
    B, S, H, dk = q.shape
    dv = v.shape[-1]
    n_chunks = S // CHUNK

    def to_chunks(t):
        t = t.astype(jnp.float32).reshape(B, n_chunks, CHUNK, H, t.shape[-1])
        return jnp.transpose(t, (1, 0, 3, 2, 4))

    qc, kc, vc, gc = to_chunks(q * scale), to_chunks(k), to_chunks(v), to_chunks(log_decay)
    tri = jnp.tril(jnp.ones((CHUNK, CHUNK), dtype=bool))

    def step(state, inp):
        qb, kb, vb, gb = inp
        b = jnp.cumsum(gb, axis=2)
        diff = b[:, :, :, None, :] - b[:, :, None, :, :]
        decay = jnp.exp(jnp.where(tri[:, :, None], diff, -jnp.inf))
        scores = jnp.einsum('bhtk,bhsk,bhtsk->bhts', qb, kb, decay)
        o = jnp.einsum('bhts,bhsv->bhtv', scores, vb)
        o = o + jnp.einsum('bhtk,bhkv->bhtv', qb * jnp.exp(b), state)
        b_last = b[:, :, -1:, :]
        new_state = jnp.exp(b_last[:, :, 0, :])[..., None] * state + jnp.einsum(
            'bhsk,bhsv->bhkv', kb * jnp.exp(b_last - b), vb)
        return new_state, o

    state0 = jnp.zeros((B, H, dk, dv), jnp.float32)
    _, out = lax.scan(step, state0, (qc, kc, vc, gc))
    out = jnp.transpose(out, (1, 0, 3, 2, 4)).reshape(B, S, H, dv)
    return out.astype(v.dtype)


def hgrn2_mixer(q, f_logits, i, g, lower_bound, out_gain):
    B, S, _ = q.shape
    f = lower_bound + (1.0 - lower_bound) * jax.nn.sigmoid(f_logits.astype(jnp.float32))
    log_f = jnp.log(f)
    key = 1.0 - f
    o = chunk_gated_scan(split_heads(q, HGRN_HEADS), split_heads(key, HGRN_HEADS),
                         split_heads(i, HGRN_HEADS), split_heads(log_f, HGRN_HEADS), HGRN_DK ** -0.5)
    o = rms_norm(o, out_gain) * jax.nn.silu(split_heads(g, HGRN_HEADS))
    return o.reshape(B, S, HGRN_HEADS * HGRN_DV)


def gla_mixer(q, k, v, gate_code, g, gate_up, gate_bias, out_gain):
    B, S, _ = q.shape
    log_alpha = jax.nn.log_sigmoid((gate_code @ gate_up + gate_bias).astype(jnp.float32)) / GLA_TAU
    o = chunk_gated_scan(split_heads(q, GLA_HEADS), split_heads(k, GLA_HEADS),
                         split_heads(v, GLA_HEADS), split_heads(log_alpha, GLA_HEADS), GLA_DK ** -0.5)
    o = rms_norm(o, out_gain) * jax.nn.silu(split_heads(g, GLA_HEADS))
    return o.reshape(B, S, GLA_HEADS * GLA_DV)


def dsa_mixer(q, k, v, q_idx, k_idx, w_idx, q_gain, k_gain):
    B, S, _ = q.shape
    topk = min(DSA_MAX_TOPK, S // 4)
    n_blocks = S // QBLOCK
    q = rms_norm(split_heads(q, DSA_HEADS), q_gain)
    k = rms_norm(split_heads(k, DSA_HEADS), k_gain)
    v = split_heads(v, DSA_HEADS)
    q_idx = split_heads(q_idx, IDX_HEADS)
    w_idx = w_idx * (IDX_HEADS ** -0.5)
    key_pos = jnp.arange(S)
    batch_ix = jnp.arange(B)[:, None, None]
    attn_scale = DSA_HEAD_DIM ** -0.5

    def to_blocks(t):
        return jnp.moveaxis(t.reshape(B, n_blocks, QBLOCK, *t.shape[2:]), 1, 0)

    def block(args):
        blk, qb, qib, wb = args
        q_pos = blk * QBLOCK + jnp.arange(QBLOCK)
        causal = key_pos[None, :] <= q_pos[:, None]
        idx_logits = jnp.einsum('bqhd,bsd->bqhs', qib, k_idx).astype(jnp.float32) * (IDX_DIM ** -0.5)
        index_score = jnp.einsum('bqh,bqhs->bqs', wb.astype(jnp.float32), jax.nn.relu(idx_logits))
        index_score = jnp.where(causal[None], index_score, -jnp.inf)
        _, sel = lax.top_k(index_score, topk)
        valid = sel <= q_pos[None, :, None]
        k_sel = k[batch_ix, sel]
        v_sel = v[batch_ix, sel]
        s = jnp.einsum('bqhd,bqkhd->bhqk', qb, k_sel).astype(jnp.float32) * attn_scale
        s = jnp.where(valid[:, None], s, -jnp.inf)
        p = jax.nn.softmax(s, axis=-1).astype(v.dtype)
        return jnp.einsum('bhqk,bqkhd->bqhd', p, v_sel)

    out = lax.map(block, (jnp.arange(n_blocks), to_blocks(q), to_blocks(q_idx), to_blocks(w_idx)))
    return jnp.moveaxis(out, 0, 1).reshape(B, S, DSA_HEADS * DSA_HEAD_DIM)


def peer_ffn(h, w_query, sub_keys, expert_u, expert_v):
    B, S, D = h.shape
    tokens = h.reshape(-1, PEER_BLOCK, D)

    def block(hb):
        q = (hb @ w_query).reshape(PEER_BLOCK, PEER_HEADS, 2, PEER_DQ // 2)
        s = jnp.einsum('thpd,hpnd->thpn', q, sub_keys).astype(jnp.float32)
        s_top, i_top = lax.top_k(s, PEER_TOPK)
        cand = (s_top[:, :, 0, :, None] + s_top[:, :, 1, None, :]).reshape(PEER_BLOCK, PEER_HEADS, PEER_TOPK * PEER_TOPK)
        cand_idx = (i_top[:, :, 0, :, None] * N_KEYS + i_top[:, :, 1, None, :]).reshape(PEER_BLOCK, PEER_HEADS, PEER_TOPK * PEER_TOPK)
        best, pos = lax.top_k(cand, PEER_TOPK)
        expert_idx = jnp.take_along_axis(cand_idx, pos, axis=-1)
        gate = jax.nn.softmax(best, axis=-1).astype(hb.dtype)
        act = jax.nn.gelu(jnp.einsum('td,thkd->thk', hb, expert_u[expert_idx]), approximate=False)
        return jnp.einsum('thk,thkd->td', gate * act, expert_v[expert_idx])

    return lax.map(block, tokens).reshape(B, S, D)


def setup_inputs(seed: int = 0) -> dict:
    key = jax.random.key(seed)
    ks = jax.random.split(key, 20)

    def nrm(k, shape, scale):
        return jax.random.normal(k, shape, jnp.float32) * scale

    D = D_MODEL
    return {
        'x': nrm(ks[0], (BATCH, SEQ, D), 1.0),
        'c': nrm(ks[1], (BATCH, D), 1.0),
        'w_ada': nrm(ks[2], (DEPTH, D, 6 * D), D ** -0.5),
        'b_ada': nrm(ks[3], (DEPTH, 6 * D), 0.02),
        'norm_mix': 1.0 + nrm(ks[4], (DEPTH, D), 0.05),
        'norm_ffn': 1.0 + nrm(ks[5], (DEPTH, D), 0.05),
        'w_in': nrm(ks[6], (DEPTH, D, IN_COLS), D ** -0.5),
        'hgrn_lb_logits': nrm(ks[7], (DEPTH, HGRN_HEADS * HGRN_DK), 0.5),
        'hgrn_out_norm': 1.0 + nrm(ks[8], (DEPTH, HGRN_DV), 0.05),
        'dsa_q_norm': 1.0 + nrm(ks[9], (DEPTH, DSA_HEAD_DIM), 0.05),
        'dsa_k_norm': 1.0 + nrm(ks[10], (DEPTH, DSA_HEAD_DIM), 0.05),
        'gla_gate_up': nrm(ks[11], (DEPTH, GLA_GATE_RANK, GLA_HEADS * GLA_DK), GLA_GATE_RANK ** -0.5),
        'gla_gate_bias': nrm(ks[12], (DEPTH, GLA_HEADS * GLA_DK), 0.1),
        'gla_out_norm': 1.0 + nrm(ks[13], (DEPTH, GLA_DV), 0.05),
        'w_branch': nrm(ks[14], (DEPTH, N_BRANCHES, BRANCH_WIDTH, D), BRANCH_WIDTH ** -0.5),
        'w_out': nrm(ks[15], (DEPTH, D, D), D ** -0.5),
        'peer_w_query': nrm(ks[16], (DEPTH, D, PEER_HEADS * PEER_DQ), D ** -0.5),
        'peer_sub_keys': nrm(ks[17], (DEPTH, PEER_HEADS, 2, N_KEYS, PEER_DQ // 2), (PEER_DQ // 2) ** -0.5),
        'peer_u': nrm(ks[18], (DEPTH, N_EXPERTS, D), D ** -0.5),
        'peer_v': nrm(ks[19], (DEPTH, N_EXPERTS, D), PEER_HEADS ** -0.5),
    }


def reference(x, c, w_ada, b_ada, norm_mix, norm_ffn, w_in, hgrn_lb_logits, hgrn_out_norm,
              dsa_q_norm, dsa_k_norm, gla_gate_up, gla_gate_bias, gla_out_norm, w_branch, w_out,
              peer_w_query, peer_sub_keys, peer_u, peer_v):
    B, S, D = x.shape
    lb_p = jax.nn.softmax(hgrn_lb_logits.astype(jnp.float32), axis=0)
    lb_cum = jnp.cumsum(lb_p, axis=0)
    lower_bounds = lb_cum - lb_cum[0:1]
    split_points = np.cumsum(IN_SPLITS)[:-1].tolist()
    silu_c = jax.nn.silu(c)

    for l in range(DEPTH):
        mod = silu_c @ w_ada[l] + b_ada[l]
        shift_m, scale_m, gate_m, shift_f, scale_f, gate_f = jnp.split(mod, 6, axis=-1)

        h = modulate(x, norm_mix[l], shift_m, scale_m)
        z = h @ w_in[l]
        (a_q, a_f, a_i, a_g,
         b_q, b_k, b_v, b_qi, b_ki, b_wi,
         c_q, c_k, c_v, c_code, c_g,
         merge_logits) = jnp.split(z, split_points, axis=-1)

        y_a = hgrn2_mixer(a_q, a_f, a_i, a_g, lower_bounds[l], hgrn_out_norm[l])
        y_b = dsa_mixer(b_q, b_k, b_v, b_qi, b_ki, b_wi, dsa_q_norm[l], dsa_k_norm[l])
        y_c = gla_mixer(c_q, c_k, c_v, c_code, c_g, gla_gate_up[l], gla_gate_bias[l], gla_out_norm[l])

        branches = jnp.stack([y_a, y_b, y_c], axis=2)
        up = jnp.einsum('bsgk,gkd->bsgd', branches, w_branch[l])
        gates = jax.nn.sigmoid(merge_logits.reshape(B, S, N_BRANCHES, D))
        mixed = jnp.sum(gates * up, axis=2) @ w_out[l]
        x = x + gate_m[:, None, :] * mixed

        h2 = modulate(x, norm_ffn[l], shift_f, scale_f)
        x = x + gate_f[:, None, :] * peer_ffn(h2, peer_w_query[l], peer_sub_keys[l], peer_u[l], peer_v[l])

    return x
```

```cpp
#include <hip/hip_runtime.h>
#include <stdint.h>
#include <stdio.h>

#ifndef MEGA
#define MEGA 0
#endif

typedef unsigned short bf16_t;
typedef short bf16x8 __attribute__((ext_vector_type(8)));
typedef float f32x4 __attribute__((ext_vector_type(4)));
typedef unsigned u32x4 __attribute__((ext_vector_type(4)));

#define NT 512
constexpr int T_TOK = 16384, DM = 1024, SEQ = 2048;
constexpr int LDZ = 8576;
constexpr int ZA_Q = 0, ZA_F = 512, ZA_I = 1024, ZA_G = 1536, ZB_Q = 2048, ZB_K = 2560, ZB_V = 3072, ZC_V = 3584, ZC_G = 4096,
              ZB_QI = 4608, ZC_Q = 4864, ZC_K = 5120, ZB_KI = 5376, ZB_WI = 5440, ZC_CODE = 5444, ZM = 5504;
constexpr int IN_COLS = 8532;

constexpr size_t al256(size_t x) { return (x + 255) & ~(size_t)255; }
constexpr size_t WS_CTL = 0;
constexpr size_t WS_MOD = 65536;
constexpr size_t WS_WIN = al256(WS_MOD + (size_t)2 * 8 * 6144 * 4);
constexpr size_t WS_WBR = al256(WS_WIN + (size_t)LDZ * 1024 * 2);
constexpr size_t WS_WOUT = al256(WS_WBR + (size_t)3 * 1024 * 512 * 2);
constexpr size_t WS_WQ = al256(WS_WOUT + (size_t)1024 * 1024 * 2);
constexpr size_t WS_SK = al256(WS_WQ + (size_t)2048 * 1024 * 2);
constexpr size_t WS_PU = al256(WS_SK + (size_t)16 * 128 * 128 * 2);
constexpr size_t WS_PV = al256(WS_PU + (size_t)16384 * 1024 * 2);
constexpr size_t WS_H = al256(WS_PV + (size_t)16384 * 1024 * 2);
constexpr size_t WS_OA = al256(WS_H + (size_t)T_TOK * 1024 * 2);
constexpr size_t WS_OC = al256(WS_OA + (size_t)T_TOK * 512 * 2);
constexpr size_t WS_Y = al256(WS_OC + (size_t)T_TOK * 512 * 2);
constexpr size_t WS_Z = al256(WS_Y + (size_t)T_TOK * 1536 * 2);
constexpr size_t WS_END = al256(WS_Z + (size_t)T_TOK * LDZ * 2);
constexpr size_t WS_QP = WS_Z;
constexpr size_t WS_SC = al256(WS_QP + (size_t)T_TOK * 2048 * 2);
constexpr size_t WS_RI = al256(WS_SC + (size_t)T_TOK * 2048 * 4);
constexpr size_t WS_RG = al256(WS_RI + (size_t)T_TOK * 128 * 4);
static_assert(WS_RG + (size_t)T_TOK * 128 * 4 <= WS_END, "peer alias overflow");

struct Params {
    const float* x; const float* c; const float* w_ada; const float* b_ada; const float* norm_mix; const float* norm_ffn;
    const float* w_in; const float* hgrn_lb; const float* hgrn_on; const float* dsa_qn; const float* dsa_kn;
    const float* gla_up; const float* gla_bias; const float* gla_on; const float* w_branch; const float* w_out;
    const float* peer_wq; const float* peer_keys; const float* peer_u; const float* peer_v;
    float* out; unsigned char* ws;
};

__device__ __forceinline__ float bf2f(bf16_t h) { return __uint_as_float(((unsigned)h) << 16); }
__device__ __forceinline__ float bflo(unsigned u) { return __uint_as_float(u << 16); }
__device__ __forceinline__ float bfhi(unsigned u) { return __uint_as_float(u & 0xffff0000u); }
__device__ __forceinline__ bf16_t f2bf(float f) { unsigned u = __float_as_uint(f); u += 0x7fffu + ((u >> 16) & 1u); return (bf16_t)(u >> 16); }
__device__ __forceinline__ unsigned pack2(float a, float b) { return (unsigned)f2bf(a) | ((unsigned)f2bf(b) << 16); }
__device__ __forceinline__ float wave_sum(float v) { for (int o = 32; o > 0; o >>= 1) v += __shfl_xor(v, o); return v; }
__device__ __forceinline__ float wave_max(float v) { for (int o = 32; o > 0; o >>= 1) v = fmaxf(v, __shfl_xor(v, o)); return v; }
__device__ __forceinline__ int wave_sum_i(int v) { for (int o = 32; o > 0; o >>= 1) v += __shfl_xor(v, o); return v; }
__device__ __forceinline__ float sigm(float x) { return 1.f / (1.f + expf(-x)); }

__device__ __forceinline__ int src_col(int j) {
    if (j < 3584) return j;
    if (j < 4096) return j - 3584 + 4420;
    if (j < 4608) return j - 4096 + 4948;
    if (j < 4864) return j - 4608 + 3584;
    if (j < 5120) return j - 4864 + 3908;
    if (j < 5376) return j - 5120 + 4164;
    if (j < 5440) return j - 5376 + 3840;
    if (j < 5444) return j - 5440 + 3904;
    if (j < 5460) return j - 5444 + 4932;
    if (j < 5504) return -1;
    return j - 5504 + 5460;
}

__device__ void ph_mod(const Params& p, int vb0, int nvb, char* smem_) {
    float* sc = (float*)smem_;
    float* mod = (float*)(p.ws + WS_MOD);
    for (int i = threadIdx.x; i < 8 * 1024; i += NT) { float c = p.c[i]; sc[i] = c / (1.f + expf(-c)); }
    __syncthreads();
    for (int vb = vb0; vb < 24; vb += nvb) {
        int col = vb * 512 + threadIdx.x;
        int l = col / 6144, n = col % 6144;
        const float* w = p.w_ada + (size_t)l * 1024 * 6144 + n;
        float acc[8];
#pragma unroll
        for (int b = 0; b < 8; ++b) acc[b] = 0.f;
#pragma unroll 8
        for (int k = 0; k < 1024; ++k) {
            float wv = w[(size_t)k * 6144];
#pragma unroll
            for (int b = 0; b < 8; ++b) acc[b] += sc[b * 1024 + k] * wv;
        }
        float bias = p.b_ada[l * 6144 + n];
#pragma unroll
        for (int b = 0; b < 8; ++b) mod[(size_t)(l * 8 + b) * 6144 + n] = acc[b] + bias;
    }
    __syncthreads();
}

template <bool MAP>
__device__ void tr_tile(const float* __restrict__ src, int lds_, bf16_t* __restrict__ out, int ldo, int k0, int n0, float* tile) {
    const int tid = threadIdx.x;
#pragma unroll
    for (int i = 0; i < 8; ++i) {
        int kk = (tid >> 6) + 8 * i, nn = tid & 63;
        int scol = MAP ? src_col(n0 + nn) : (n0 + nn);
        float v = (scol >= 0) ? src[(size_t)(k0 + kk) * lds_ + scol] : 0.f;
        tile[kk * 65 + nn] = v;
    }
    __syncthreads();
#pragma unroll
    for (int i = 0; i < 4; ++i) {
        int nn = (tid >> 5) + 16 * i, kk = (tid & 31) * 2;
        unsigned v = pack2(tile[kk * 65 + nn], tile[(kk + 1) * 65 + nn]);
        *(unsigned*)(out + (size_t)(n0 + nn) * ldo + k0 + kk) = v;
    }
    __syncthreads();
}
__device__ void conv_chunk(const float* __restrict__ src, bf16_t* __restrict__ dst, size_t base) {
#pragma unroll
    for (int i = 0; i < 4; ++i) {
        size_t e = base + (size_t)(i * NT + threadIdx.x) * 8;
        float4 a = *(const float4*)(src + e), b = *(const float4*)(src + e + 4);
        uint4 o; o.x = pack2(a.x, a.y); o.y = pack2(a.z, a.w); o.z = pack2(b.x, b.y); o.w = pack2(b.z, b.w);
        *(uint4*)(dst + e) = o;
    }
}
__device__ void ph_wprep(const Params& p, int l, int vb0, int nvb, char* smem_) {
    float* tile = (float*)smem_;
    bf16_t* WIN = (bf16_t*)(p.ws + WS_WIN); bf16_t* WBR = (bf16_t*)(p.ws + WS_WBR); bf16_t* WOUT = (bf16_t*)(p.ws + WS_WOUT);
    bf16_t* WQ = (bf16_t*)(p.ws + WS_WQ); bf16_t* SK = (bf16_t*)(p.ws + WS_SK); bf16_t* PU = (bf16_t*)(p.ws + WS_PU); bf16_t* PV = (bf16_t*)(p.ws + WS_PV);
    constexpr int N_WIN = 134 * 16, N_WBR = 3 * 16 * 8, N_WOUT = 16 * 16, N_WQ = 32 * 16, N_SK = 16, N_PU = 1024, N_PV = 1024;
    constexpr int TOTAL = N_WIN + N_WBR + N_WOUT + N_WQ + N_SK + N_PU + N_PV;
    for (int task = vb0; task < TOTAL; task += nvb) {
        int r = task;
        if (r < N_WIN) { int nt = r / 16, kt = r % 16; tr_tile<true>(p.w_in + (size_t)l * 1024 * IN_COLS, IN_COLS, WIN, 1024, kt * 64, nt * 64, tile); continue; }
        r -= N_WIN;
        if (r < N_WBR) { int g = r / 128, rr = r % 128, nt = rr / 8, kt = rr % 8;
            tr_tile<false>(p.w_branch + (size_t)(l * 3 + g) * 512 * 1024, 1024, WBR + (size_t)g * 1024 * 512, 512, kt * 64, nt * 64, tile); continue; }
        r -= N_WBR;
        if (r < N_WOUT) { int nt = r / 16, kt = r % 16; tr_tile<false>(p.w_out + (size_t)l * 1024 * 1024, 1024, WOUT, 1024, kt * 64, nt * 64, tile); continue; }
        r -= N_WOUT;
        if (r < N_WQ) { int nt = r / 16, kt = r % 16; tr_tile<false>(p.peer_wq + (size_t)l * 1024 * 2048, 2048, WQ, 1024, kt * 64, nt * 64, tile); continue; }
        r -= N_WQ;
        if (r < N_SK) { conv_chunk(p.peer_keys + (size_t)l * 16 * 128 * 128, SK, (size_t)r * 16384); continue; }
        r -= N_SK;
        if (r < N_PU) { conv_chunk(p.peer_u + (size_t)l * 16384 * 1024, PU, (size_t)r * 16384); continue; }
        r -= N_PU;
        conv_chunk(p.peer_v + (size_t)l * 16384 * 1024, PV, (size_t)r * 16384);
    }
}

__device__ void ph_norm(const Params& p, int l, int which, const float* xin, int vb0, int nvb) {
    const int wave = threadIdx.x >> 6, lane = threadIdx.x & 63;
    const float* gain = (which ? p.norm_ffn : p.norm_mix) + l * 1024;
    const float* modb = (const float*)(p.ws + WS_MOD);
    bf16_t* H = (bf16_t*)(p.ws + WS_H);
    for (int t = vb0 * 8 + wave; t < T_TOK; t += nvb * 8) {
        int b = t >> 11;
        const float* mod = modb + (size_t)(l * 8 + b) * 6144 + (which ? 3072 : 0);
        const float4* xr = (const float4*)(xin + (size_t)t * 1024);
        float4 v[4]; float ss = 0.f;
#pragma unroll
        for (int i = 0; i < 4; ++i) { v[i] = xr[lane + 64 * i]; ss += v[i].x * v[i].x + v[i].y * v[i].y + v[i].z * v[i].z + v[i].w * v[i].w; }
        ss = wave_sum(ss);
        float rstd = rsqrtf(ss * (1.f / 1024.f) + 1e-6f);
#pragma unroll
        for (int i = 0; i < 4; ++i) {
            int idx = (lane + 64 * i) * 4;
            float4 g = *(const float4*)(gain + idx), sc = *(const float4*)(mod + 1024 + idx), sh = *(const float4*)(mod + idx);
            float h0 = v[i].x * rstd * g.x * (1.f + sc.x) + sh.x, h1 = v[i].y * rstd * g.y * (1.f + sc.y) + sh.y;
            float h2 = v[i].z * rstd * g.z * (1.f + sc.z) + sh.z, h3 = v[i].w * rstd * g.w * (1.f + sc.w) + sh.w;
            uint2 o; o.x = pack2(h0, h1); o.y = pack2(h2, h3);
            *(uint2*)(H + (size_t)t * 1024 + idx) = o;
        }
    }
}

constexpr int GBM = 256, GBN = 128, GBK = 64, GLS = 72;
__device__ __forceinline__ void gemm_tile(const bf16_t* __restrict__ A, int lda, const bf16_t* __restrict__ Bt, int ldb, int K,
                                          int m0, int n0, bf16_t* sA, bf16_t* sB, f32x4 (&acc)[4][4]) {
    const int tid = threadIdx.x, lane = tid & 63, wave = tid >> 6;
    const int wm = wave >> 1, wn = wave & 1, fr = lane & 15, fq = lane >> 4;
    u32x4 ra[4], rb[2];
    const int crow = tid >> 3, ckc = (tid & 7) * 8;
    const bf16_t* Ag = A + (size_t)(m0 + crow) * lda + ckc;
    const bf16_t* Bg = Bt + (size_t)(n0 + crow) * ldb + ckc;
#pragma unroll
    for (int i = 0; i < 4; ++i) ra[i] = *(const u32x4*)(Ag + (size_t)(64 * i) * lda);
#pragma unroll
    for (int i = 0; i < 2; ++i) rb[i] = *(const u32x4*)(Bg + (size_t)(64 * i) * ldb);
    for (int k0 = 0; k0 < K; k0 += GBK) {
        __syncthreads();
#pragma unroll
        for (int i = 0; i < 4; ++i) *(u32x4*)(sA + (crow + 64 * i) * GLS + ckc) = ra[i];
#pragma unroll
        for (int i = 0; i < 2; ++i) *(u32x4*)(sB + (crow + 64 * i) * GLS + ckc) = rb[i];
        __syncthreads();
        {
            const int kn = (k0 + GBK < K) ? (k0 + GBK) : k0;
#pragma unroll
            for (int i = 0; i < 4; ++i) ra[i] = *(const u32x4*)(Ag + (size_t)(64 * i) * lda + kn);
#pragma unroll
            for (int i = 0; i < 2; ++i) rb[i] = *(const u32x4*)(Bg + (size_t)(64 * i) * ldb + kn);
        }
#pragma unroll
        for (int ks = 0; ks < 2; ++ks) {
            bf16x8 af[4], wf[4];
#pragma unroll
            for (int mf = 0; mf < 4; ++mf) af[mf] = *(const bf16x8*)(sA + (wm * 64 + mf * 16 + fr) * GLS + ks * 32 + fq * 8);
#pragma unroll
            for (int nf = 0; nf < 4; ++nf) wf[nf] = *(const bf16x8*)(sB + (wn * 64 + nf * 16 + fr) * GLS + ks * 32 + fq * 8);
#pragma unroll
            for (int nf = 0; nf < 4; ++nf)
#pragma unroll
                for (int mf = 0; mf < 4; ++mf)
                    acc[nf][mf] = __builtin_amdgcn_mfma_f32_16x16x32_bf16(wf[nf], af[mf], acc[nf][mf], 0, 0, 0);
        }
    }
}

struct EpiZ {
    bf16_t* Z; int ld;
    __device__ __forceinline__ void operator()(int m, int n, const f32x4& v) const {
        uint2 o; o.x = pack2(v[0], v[1]); o.y = pack2(v[2], v[3]);
        *(uint2*)(Z + (size_t)m * ld + n) = o;
    }
};
struct EpiF32 {
    float* C; int ld;
    __device__ __forceinline__ void operator()(int m, int n, const f32x4& v) const {
        *(float4*)(C + (size_t)m * ld + n) = make_float4(v[0], v[1], v[2], v[3]);
    }
};
struct EpiOut {
    const float* xin; float* out; const float* mod;
    __device__ __forceinline__ void operator()(int m, int n, const f32x4& v) const {
        int b = m >> 11;
        float4 g = *(const float4*)(mod + (size_t)b * 6144 + 2048 + n);
        float4 xi = *(const float4*)(xin + (size_t)m * 1024 + n);
        *(float4*)(out + (size_t)m * 1024 + n) = make_float4(xi.x + g.x * v[0], xi.y + g.y * v[1], xi.z + g.z * v[2], xi.w + g.w * v[3]);
    }
};

template <class Epi>
__device__ void gemm_phase(const bf16_t* A, int lda, const bf16_t* Bt, int ldb, int M, int N, int K, bool batched, Epi epi,
                           int vb0, int nvb, char* smem_) {
    bf16_t* sA = (bf16_t*)smem_; bf16_t* sB = sA + GBM * GLS;
    const int lane = threadIdx.x & 63, wave = threadIdx.x >> 6, wm = wave >> 1, wn = wave & 1, fr = lane & 15, fq = lane >> 4;
    const int MT = M / GBM, NTL = N / GBN;
    for (int tile = vb0; tile < MT * NTL; tile += nvb) {
        int mt = tile % MT, nt = tile / MT;
        f32x4 acc[4][4];
#pragma unroll
        for (int a = 0; a < 4; ++a)
#pragma unroll
            for (int b = 0; b < 4; ++b) acc[a][b] = f32x4{0.f, 0.f, 0.f, 0.f};
        gemm_tile(batched ? A + nt * 128 : A, lda, Bt, ldb, K, mt * GBM, nt * GBN, sA, sB, acc);
#pragma unroll
        for (int nf = 0; nf < 4; ++nf)
#pragma unroll
            for (int mf = 0; mf < 4; ++mf)
                epi(mt * GBM + wm * 64 + mf * 16 + fr, nt * GBN + wn * 64 + nf * 16 + fq * 4, acc[nf][mf]);
    }
}

__device__ void ph_merge(const Params& p, int vb0, int nvb, char* smem_) {
    bf16_t* sA = (bf16_t*)smem_; bf16_t* sB = sA + GBM * GLS;
    const bf16_t* Y = (const bf16_t*)(p.ws + WS_Y); const bf16_t* WBR = (const bf16_t*)(p.ws + WS_WBR);
    const bf16_t* Z = (const bf16_t*)(p.ws + WS_Z); bf16_t* H = (bf16_t*)(p.ws + WS_H);
    const int lane = threadIdx.x & 63, wave = threadIdx.x >> 6, wm = wave >> 1, wn = wave & 1, fr = lane & 15, fq = lane >> 4;
    for (int tile = vb0; tile < 64 * 8; tile += nvb) {
        int mt = tile % 64, nt = tile / 64;
        f32x4 tot[4][4];
#pragma unroll
        for (int a = 0; a < 4; ++a)
#pragma unroll
            for (int b = 0; b < 4; ++b) tot[a][b] = f32x4{0.f, 0.f, 0.f, 0.f};
        for (int g = 0; g < 3; ++g) {
            f32x4 acc[4][4];
#pragma unroll
            for (int a = 0; a < 4; ++a)
#pragma unroll
                for (int b = 0; b < 4; ++b) acc[a][b] = f32x4{0.f, 0.f, 0.f, 0.f};
            gemm_tile(Y + g * 512, 1536, WBR + (size_t)g * 1024 * 512, 512, 512, mt * GBM, nt * GBN, sA, sB, acc);
#pragma unroll
            for (int nf = 0; nf < 4; ++nf)
#pragma unroll
                for (int mf = 0; mf < 4; ++mf) {
                    int m = mt * GBM + wm * 64 + mf * 16 + fr, n = nt * GBN + wn * 64 + nf * 16 + fq * 4;
                    uint2 gz = *(const uint2*)(Z + (size_t)m * LDZ + ZM + g * 1024 + n);
                    tot[nf][mf][0] += sigm(bflo(gz.x)) * acc[nf][mf][0];
                    tot[nf][mf][1] += sigm(bfhi(gz.x)) * acc[nf][mf][1];
                    tot[nf][mf][2] += sigm(bflo(gz.y)) * acc[nf][mf][2];
                    tot[nf][mf][3] += sigm(bfhi(gz.y)) * acc[nf][mf][3];
                }
        }
#pragma unroll
        for (int nf = 0; nf < 4; ++nf)
#pragma unroll
            for (int mf = 0; mf < 4; ++mf) {
                int m = mt * GBM + wm * 64 + mf * 16 + fr, n = nt * GBN + wn * 64 + nf * 16 + fq * 4;
                uint2 o; o.x = pack2(tot[nf][mf][0], tot[nf][mf][1]); o.y = pack2(tot[nf][mf][2], tot[nf][mf][3]);
                *(uint2*)(H + (size_t)m * 1024 + n) = o;
            }
    }
}

template <int DK, bool GLA>
__device__ void scan_item(const Params& p, int l, int item, char* smem_) {
    constexpr int TB = 16, KPT = DK / 32, SSTR = NT / DK;
    const int b = item >> 5, h = (item >> 3) & 3, vs = item & 7;
    const int tid = threadIdx.x, lane = tid & 63, wave = tid >> 6;
    const int kg = tid >> 4, v = tid & 15;
    float* qs = (float*)smem_; float* fs = qs + TB * DK; float* ks = fs + TB * DK; float* vsm = ks + TB * DK; float* wp = vsm + TB * 16;
    const int kl = tid % DK, step0 = tid / DK;
    float lbv = 0.f, gbias = 0.f; float gu[16];
#pragma unroll
    for (int r = 0; r < 16; ++r) gu[r] = 0.f;
    if (GLA) {
#pragma unroll
        for (int r = 0; r < 16; ++r) gu[r] = p.gla_up[(size_t)(l * 16 + r) * 256 + h * 64 + kl];
        gbias = p.gla_bias[l * 256 + h * 64 + kl];
    } else if (l == 1) {
        float x0 = p.hgrn_lb[h * 128 + kl], x1 = p.hgrn_lb[512 + h * 128 + kl];
        lbv = 1.f / (1.f + expf(x0 - x1));
    }
    const float scale = GLA ? 0.125f : 0.08838834764831845f;
    float s[KPT];
#pragma unroll
    for (int i = 0; i < KPT; ++i) s[i] = 0.f;
    const bf16_t* Zb = (const bf16_t*)(p.ws + WS_Z) + (size_t)(b * 2048) * LDZ;
    bf16_t* OX = (bf16_t*)(p.ws + (GLA ? WS_OC : WS_OA));
    for (int t0 = 0; t0 < 2048; t0 += TB) {
        for (int st = step0; st < TB; st += SSTR) {
            const bf16_t* zr = Zb + (size_t)(t0 + st) * LDZ;
            float q, f, kk;
            if (GLA) {
                float x = gbias;
#pragma unroll
                for (int r = 0; r < 16; ++r) x += bf2f(zr[ZC_CODE + r]) * gu[r];
                float ls = fminf(x, 0.f) - log1pf(expf(-fabsf(x)));
                f = expf(ls * (1.f / 16.f));
                q = bf2f(zr[ZC_Q + h * 64 + kl]) * scale; kk = bf2f(zr[ZC_K + h * 64 + kl]);
            } else {
                float lg = bf2f(zr[ZA_F + h * 128 + kl]);
                f = lbv + (1.f - lbv) * sigm(lg); kk = 1.f - f;
                q = bf2f(zr[ZA_Q + h * 128 + kl]) * scale;
            }
            qs[st * DK + kl] = q; fs[st * DK + kl] = f; ks[st * DK + kl] = kk;
        }
        if (tid < TB * 16) {
            int st = tid >> 4, vv = tid & 15;
            vsm[st * 16 + vv] = bf2f(Zb[(size_t)(t0 + st) * LDZ + (GLA ? ZC_V : ZA_I) + h * 128 + vs * 16 + vv]);
        }
        __syncthreads();
        float po[TB];
#pragma unroll
        for (int st = 0; st < TB; ++st) {
            float vv = vsm[st * 16 + v], a = 0.f;
#pragma unroll
            for (int i = 0; i < KPT; ++i) {
                int k = kg * KPT + i;
                s[i] = fs[st * DK + k] * s[i] + ks[st * DK + k] * vv;
                a += qs[st * DK + k] * s[i];
            }
            a += __shfl_xor(a, 16); a += __shfl_xor(a, 32);
            po[st] = a;
        }
        if (lane < 16) {
#pragma unroll
            for (int st = 0; st < TB; ++st) wp[(wave * TB + st) * 16 + lane] = po[st];
        }
        __syncthreads();
        if (tid < TB * 16) {
            int st = tid >> 4, vv = tid & 15; float o = 0.f;
#pragma unroll
            for (int w = 0; w < 8; ++w) o += wp[(w * TB + st) * 16 + vv];
            OX[(size_t)(b * 2048 + t0 + st) * 512 + h * 128 + vs * 16 + vv] = f2bf(o);
        }
        __syncthreads();
    }
}
__device__ void ph_scan(const Params& p, int l, int vb0, int nvb, char* smem_) {
    for (int item = vb0; item < 512; item += nvb) {
        if (item < 256) scan_item<128, false>(p, l, item, smem_);
        else scan_item<64, true>(p, l, item - 256, smem_);
    }
}

__device__ void ph_dsaprep(const Params& p, int l, int vb0, int nvb) {
    const int wave = threadIdx.x >> 6, lane = threadIdx.x & 63;
    bf16_t* Z = (bf16_t*)(p.ws + WS_Z);
    for (int t = vb0 * 8 + wave; t < T_TOK; t += nvb * 8) {
#pragma unroll
        for (int grp = 0; grp < 8; ++grp) {
            bf16_t* ptr = Z + (size_t)t * LDZ + (grp < 4 ? ZB_Q : ZB_K) + (grp & 3) * 128 + lane * 2;
            unsigned u = *(unsigned*)ptr;
            float a = bflo(u), b = bfhi(u);
            float ss = wave_sum(a * a + b * b);
            float r = rsqrtf(ss * (1.f / 128.f) + 1e-6f);
            const float* gn = (grp < 4 ? p.dsa_qn : p.dsa_kn) + l * 128 + lane * 2;
            float sc = (grp < 4) ? 0.08838834764831845f : 1.f;
            *(unsigned*)ptr = pack2(a * r * gn[0] * sc, b * r * gn[1] * sc);
        }
    }
}

__device__ void ph_post(const Params& p, int l, int vb0, int nvb) {
    const int wave = threadIdx.x >> 6, lane = threadIdx.x & 63;
    const bf16_t* Z = (const bf16_t*)(p.ws + WS_Z);
    const bf16_t* OA = (const bf16_t*)(p.ws + WS_OA); const bf16_t* OC = (const bf16_t*)(p.ws + WS_OC);
    bf16_t* Y = (bf16_t*)(p.ws + WS_Y);
    for (int t = vb0 * 8 + wave; t < T_TOK; t += nvb * 8) {
#pragma unroll
        for (int grp = 0; grp < 8; ++grp) {
            const int hh = grp & 3;
            unsigned u = *(const unsigned*)((grp < 4 ? OA : OC) + (size_t)t * 512 + hh * 128 + lane * 2);
            float a = bflo(u), b = bfhi(u);
            float ss = wave_sum(a * a + b * b);
            float r = rsqrtf(ss * (1.f / 128.f) + 1e-6f);
            const float* gn = (grp < 4 ? p.hgrn_on : p.gla_on) + l * 128 + lane * 2;
            unsigned gz = *(const unsigned*)(Z + (size_t)t * LDZ + (grp < 4 ? ZA_G : ZC_G) + hh * 128 + lane * 2);
            float g0 = bflo(gz), g1 = bfhi(gz);
            float y0 = a * r * gn[0] * (g0 * sigm(g0)), y1 = b * r * gn[1] * (g1 * sigm(g1));
            *(unsigned*)(Y + (size_t)t * 1536 + (grp < 4 ? 0 : 1024) + hh * 128 + lane * 2) = pack2(y0, y1);
        }
    }
}

__device__ void ph_dsa(const Params& p, int l, int vb0, int nvb, char* smem_) {
    float* qi = (float*)smem_;
    float* qn = qi + 256;
    float* wv = qn + 512;
    int* sel = (int*)(wv + 16);
    float* pr = (float*)(sel + 256);
    int* red = (int*)(pr + 1024);
    int* cnt = red + 16;
    const int tid = threadIdx.x, lane = tid & 63, wave = tid >> 6;
    const bf16_t* Z = (const bf16_t*)(p.ws + WS_Z);
    bf16_t* Y = (bf16_t*)(p.ws + WS_Y);
    const unsigned long long lt_mask = (lane == 0) ? 0ull : (~0ull >> (64 - lane));
    for (int t = vb0; t < T_TOK; t += nvb) {
        const int b = t >> 11, tl = t & 2047, n = tl + 1;
        const bf16_t* zr = Z + (size_t)t * LDZ;
        if (tid < 256) qi[tid] = bf2f(zr[ZB_QI + tid]);
        qn[tid] = bf2f(zr[ZB_Q + tid]);
        if (tid < 4) wv[tid] = bf2f(zr[ZB_WI + tid]) * 0.5f;
        __syncthreads();
        const bf16_t* Zb = Z + (size_t)(b * 2048) * LDZ;
        unsigned mk[4];
#pragma unroll
        for (int i = 0; i < 4; ++i) {
            int s = tid + i * 512; unsigned key = 0u;
            if (s < n) {
                const uint4* kp = (const uint4*)(Zb + (size_t)s * LDZ + ZB_KI);
                float d0 = 0.f, d1 = 0.f, d2 = 0.f, d3 = 0.f;
#pragma unroll
                for (int c = 0; c < 8; ++c) {
                    uint4 u = kp[c];
                    float x[8] = {bflo(u.x), bfhi(u.x), bflo(u.y), bfhi(u.y), bflo(u.z), bfhi(u.z), bflo(u.w), bfhi(u.w)};
#pragma unroll
                    for (int j = 0; j < 8; ++j) {
                        d0 += x[j] * qi[c * 8 + j]; d1 += x[j] * qi[64 + c * 8 + j];
                        d2 += x[j] * qi[128 + c * 8 + j]; d3 += x[j] * qi[192 + c * 8 + j];
                    }
                }
                float sc = wv[0] * fmaxf(d0 * 0.125f, 0.f) + wv[1] * fmaxf(d1 * 0.125f, 0.f) + wv[2] * fmaxf(d2 * 0.125f, 0.f) + wv[3] * fmaxf(d3 * 0.125f, 0.f);
                if (sc == 0.f) sc = 0.f;
                unsigned u = __float_as_uint(sc);
                key = (u & 0x80000000u) ? ~u : (u | 0x80000000u);
            }
            mk[i] = key;
        }
        if (n > 256) {
            unsigned T = 0u;
            for (int bit = 31; bit >= 0; --bit) {
                unsigned cand = T | (1u << bit);
                int c = (mk[0] >= cand) + (mk[1] >= cand) + (mk[2] >= cand) + (mk[3] >= cand);
                c = wave_sum_i(c);
                if (lane == 0) red[(bit & 1) * 8 + wave] = c;
                __syncthreads();
                int tot = 0;
#pragma unroll
                for (int w = 0; w < 8; ++w) tot += red[(bit & 1) * 8 + w];
                if (tot >= 256) T = cand;
            }
            unsigned long long beq[4], bgt[4];
#pragma unroll
            for (int i = 0; i < 4; ++i) { beq[i] = __ballot(mk[i] == T); bgt[i] = __ballot(mk[i] > T); }
            __syncthreads();
            if (lane == 0) {
#pragma unroll
                for (int i = 0; i < 4; ++i) { cnt[i * 8 + wave] = __popcll(beq[i]); cnt[32 + i * 8 + wave] = __popcll(bgt[i]); }
            }
            __syncthreads();
            int cgt = 0;
#pragma unroll
            for (int j = 0; j < 32; ++j) cgt += cnt[32 + j];
            const int need = 256 - cgt;
            int eqbase = 0;
            unsigned long long bsel[4];
#pragma unroll
            for (int i = 0; i < 4; ++i) {
                int before = eqbase;
#pragma unroll
                for (int w = 0; w < 8; ++w) { int cw = cnt[i * 8 + w]; if (w < wave) before += cw; eqbase += cw; }
                int rank = before + __popcll(beq[i] & lt_mask);
                bool s_ = (mk[i] > T) || ((mk[i] == T) && rank < need);
                bsel[i] = __ballot(s_);
            }
            __syncthreads();
            if (lane == 0) {
#pragma unroll
                for (int i = 0; i < 4; ++i) cnt[i * 8 + wave] = __popcll(bsel[i]);
            }
            __syncthreads();
            int sbase = 0;
#pragma unroll
            for (int i = 0; i < 4; ++i) {
                int before = sbase;
#pragma unroll
                for (int w = 0; w < 8; ++w) { int cw = cnt[i * 8 + w]; if (w < wave) before += cw; sbase += cw; }
                if ((bsel[i] >> lane) & 1ull) { int pos = before + __popcll(bsel[i] & lt_mask); if (pos < 256) sel[pos] = tid + i * 512; }
            }
        } else {
            if (tid < n) sel[tid] = tid;
        }
        const int m = n < 256 ? n : 256;
        __syncthreads();
        {
            int j = tid >> 1, hh = tid & 1;
            if (j < m) {
                const uint4* kr = (const uint4*)(Zb + (size_t)sel[j] * LDZ + ZB_K + hh * 256);
                float d0 = 0.f, d1 = 0.f;
#pragma unroll
                for (int c = 0; c < 16; ++c) {
                    uint4 u = kr[c]; const float* q = qn + hh * 256 + c * 8;
                    d0 += bflo(u.x) * q[0] + bfhi(u.x) * q[1] + bflo(u.y) * q[2] + bfhi(u.y) * q[3] + bflo(u.z) * q[4] + bfhi(u.z) * q[5] + bflo(u.w) * q[6] + bfhi(u.w) * q[7];
                }
#pragma unroll
                for (int c = 16; c < 32; ++c) {
                    uint4 u = kr[c]; const float* q = qn + hh * 256 + c * 8;
                    d1 += bflo(u.x) * q[0] + bfhi(u.x) * q[1] + bflo(u.y) * q[2] + bfhi(u.y) * q[3] + bflo(u.z) * q[4] + bfhi(u.z) * q[5] + bflo(u.w) * q[6] + bfhi(u.w) * q[7];
                }
                pr[(2 * hh) * 256 + j] = d0; pr[(2 * hh + 1) * 256 + j] = d1;
            }
        }
        __syncthreads();
        if (wave < 4) {
            float xv[4]; float mx = -INFINITY;
#pragma unroll
            for (int i = 0; i < 4; ++i) { int j = lane + 64 * i; xv[i] = (j < m) ? pr[wave * 256 + j] : -INFINITY; mx = fmaxf(mx, xv[i]); }
            mx = wave_max(mx);
            float sm = 0.f;
#pragma unroll
            for (int i = 0; i < 4; ++i) { xv[i] = expf(xv[i] - mx); sm += xv[i]; }
            sm = wave_sum(sm);
            float inv = 1.f / sm;
#pragma unroll
            for (int i = 0; i < 4; ++i) { int j = lane + 64 * i; pr[wave * 256 + j] = xv[i] * inv; }
        }
        __syncthreads();
        {
            const int d = tid, hd = d >> 7;
            float o = 0.f;
            const bf16_t* vb = Zb + ZB_V + d;
#pragma unroll 8
            for (int j = 0; j < m; ++j) o += pr[hd * 256 + j] * bf2f(vb[(size_t)sel[j] * LDZ]);
            Y[(size_t)t * 1536 + 512 + d] = f2bf(o);
        }
        __syncthreads();
    }
}

__device__ __forceinline__ int f2sort(float f) { int i = __float_as_int(f); return i ^ ((i >> 31) & 0x7fffffff); }
__device__ __forceinline__ float sort2f(int i) { return __int_as_float(i ^ ((i >> 31) & 0x7fffffff)); }
#define INSK(K, xv) do { int _x = (xv); \
    _Pragma("unroll") for (int _j = 0; _j < 16; ++_j) { int _hi = max(K[_j], _x); _x = min(K[_j], _x); K[_j] = _hi; } } while (0)
#define INS64(K, xv) do { unsigned long long _x = (xv); \
    _Pragma("unroll") for (int _j = 0; _j < 16; ++_j) { bool _c = _x > K[_j]; unsigned long long _o = K[_j]; K[_j] = _c ? _x : _o; _x = _c ? _o : _x; } } while (0)

__device__ void ph_route(const Params& p, int vb0, int nvb) {
    const float* SC = (const float*)(p.ws + WS_SC);
    int* RI = (int*)(p.ws + WS_RI); float* RG = (float*)(p.ws + WS_RG);
    for (int item = vb0 * NT + threadIdx.x; item < T_TOK * 8; item += nvb * NT) {
        const int t = item >> 3, h = item & 7;
        const float* s0 = SC + (size_t)t * 2048 + h * 256;
        int k0[16], k1[16];
#pragma unroll
        for (int j = 0; j < 16; ++j) { k0[j] = (int)0x80000000; k1[j] = (int)0x80000000; }
#pragma unroll 1
        for (int i = 0; i < 128; i += 4) {
            float4 a = *(const float4*)(s0 + i), b = *(const float4*)(s0 + 128 + i);
            INSK(k0, (f2sort(a.x) & ~127) | (127 - i)); INSK(k0, (f2sort(a.y) & ~127) | (126 - i));
            INSK(k0, (f2sort(a.z) & ~127) | (125 - i)); INSK(k0, (f2sort(a.w) & ~127) | (124 - i));
            INSK(k1, (f2sort(b.x) & ~127) | (127 - i)); INSK(k1, (f2sort(b.y) & ~127) | (126 - i));
            INSK(k1, (f2sort(b.z) & ~127) | (125 - i)); INSK(k1, (f2sort(b.w) & ~127) | (124 - i));
        }
        float v0[16], v1[16];
#pragma unroll
        for (int j = 0; j < 16; ++j) { k0[j] = 127 - (k0[j] & 127); k1[j] = 127 - (k1[j] & 127); v0[j] = s0[k0[j]]; v1[j] = s0[128 + k1[j]]; }
        unsigned long long ck[16];
#pragma unroll
        for (int j = 0; j < 16; ++j) ck[j] = 0ull;
#pragma unroll
        for (int a = 0; a < 16; ++a)
#pragma unroll
            for (int b = 0; b < 16; ++b)
                if ((a + 1) * (b + 1) <= 16) {
                    unsigned hi = (unsigned)f2sort(v0[a] + v1[b]) ^ 0x80000000u;
                    unsigned lo = ((unsigned)(255 - (a * 16 + b)) << 16) | (unsigned)(k0[a] * 128 + k1[b]);
                    INS64(ck, ((unsigned long long)hi << 32) | lo);
                }
        float e[16]; float sm = 0.f;
        const float mx = sort2f((int)((unsigned)(ck[0] >> 32) ^ 0x80000000u));
#pragma unroll
        for (int j = 0; j < 16; ++j) { e[j] = expf(sort2f((int)((unsigned)(ck[j] >> 32) ^ 0x80000000u)) - mx); sm += e[j]; }
        const float inv = 1.f / sm;
#pragma unroll
        for (int j = 0; j < 16; j += 4) {
            *(int4*)(RI + (size_t)t * 128 + h * 16 + j) = make_int4((int)(ck[j] & 0xffffu), (int)(ck[j + 1] & 0xffffu), (int)(ck[j + 2] & 0xffffu), (int)(ck[j + 3] & 0xffffu));
            *(float4*)(RG + (size_t)t * 128 + h * 16 + j) = make_float4(e[j] * inv, e[j + 1] * inv, e[j + 2] * inv, e[j + 3] * inv);
        }
    }
}

__device__ void ph_gather(const Params& p, int l, int vb0, int nvb) {
    const int wave = threadIdx.x >> 6, lane = threadIdx.x & 63;
    const bf16_t* H = (const bf16_t*)(p.ws + WS_H); const bf16_t* PU = (const bf16_t*)(p.ws + WS_PU); const bf16_t* PV = (const bf16_t*)(p.ws + WS_PV);
    const int* RI = (const int*)(p.ws + WS_RI); const float* RG = (const float*)(p.ws + WS_RG);
    const float* modb = (const float*)(p.ws + WS_MOD);
    for (int t = vb0 * 8 + wave; t < T_TOK; t += nvb * 8) {
        const int b = t >> 11;
        float hv[16], y[16];
        {
            const uint4* hp = (const uint4*)(H + (size_t)t * 1024 + lane * 16);
            uint4 a = hp[0], c = hp[1];
            hv[0] = bflo(a.x); hv[1] = bfhi(a.x); hv[2] = bflo(a.y); hv[3] = bfhi(a.y); hv[4] = bflo(a.z); hv[5] = bfhi(a.z); hv[6] = bflo(a.w); hv[7] = bfhi(a.w);
            hv[8] = bflo(c.x); hv[9] = bfhi(c.x); hv[10] = bflo(c.y); hv[11] = bfhi(c.y); hv[12] = bflo(c.z); hv[13] = bfhi(c.z); hv[14] = bflo(c.w); hv[15] = bfhi(c.w);
        }
#pragma unroll
        for (int j = 0; j < 16; ++j) y[j] = 0.f;
        const int e_lo = RI[(size_t)t * 128 + lane], e_hi = RI[(size_t)t * 128 + 64 + lane];
        const float g_lo = RG[(size_t)t * 128 + lane], g_hi = RG[(size_t)t * 128 + 64 + lane];
#pragma unroll 4
        for (int k = 0; k < 128; ++k) {
            const int e = __shfl(k < 64 ? e_lo : e_hi, k & 63);
            const float g = __shfl(k < 64 ? g_lo : g_hi, k & 63);
            const uint4* up = (const uint4*)(PU + (size_t)e * 1024 + lane * 16);
            const uint4* vp = (const uint4*)(PV + (size_t)e * 1024 + lane * 16);
            uint4 a = up[0], c = up[1], va = vp[0], vc = vp[1];
            float d = hv[0] * bflo(a.x) + hv[1] * bfhi(a.x) + hv[2] * bflo(a.y) + hv[3] * bfhi(a.y) + hv[4] * bflo(a.z) + hv[5] * bfhi(a.z) + hv[6] * bflo(a.w) + hv[7] * bfhi(a.w)
                    + hv[8] * bflo(c.x) + hv[9] * bfhi(c.x) + hv[10] * bflo(c.y) + hv[11] * bfhi(c.y) + hv[12] * bflo(c.z) + hv[13] * bfhi(c.z) + hv[14] * bflo(c.w) + hv[15] * bfhi(c.w);
            d = wave_sum(d);
            const float coef = g * 0.5f * d * (1.f + erff(d * 0.7071067811865476f));
            y[0] += coef * bflo(va.x); y[1] += coef * bfhi(va.x); y[2] += coef * bflo(va.y); y[3] += coef * bfhi(va.y);
            y[4] += coef * bflo(va.z); y[5] += coef * bfhi(va.z); y[6] += coef * bflo(va.w); y[7] += coef * bfhi(va.w);
            y[8] += coef * bflo(vc.x); y[9] += coef * bfhi(vc.x); y[10] += coef * bflo(vc.y); y[11] += coef * bfhi(vc.y);
            y[12] += coef * bflo(vc.z); y[13] += coef * bfhi(vc.z); y[14] += coef * bflo(vc.w); y[15] += coef * bfhi(vc.w);
        }
        const float* gf = modb + (size_t)(l * 8 + b) * 6144 + 5120 + lane * 16;
        float* op = p.out + (size_t)t * 1024 + lane * 16;
#pragma unroll
        for (int j = 0; j < 16; j += 4) {
            float4 xi = *(const float4*)(op + j), g4 = *(const float4*)(gf + j);
            *(float4*)(op + j) = make_float4(xi.x + g4.x * y[j], xi.y + g4.y * y[j + 1], xi.z + g4.z * y[j + 2], xi.w + g4.w * y[j + 3]);
        }
    }
}

enum { PH_MOD = 0, PH_WPREP, PH_NORM1, PH_GEMM_IN, PH_SCAN, PH_DSAPREP, PH_DSA, PH_POST, PH_MERGE, PH_OUT, PH_NORM2, PH_GEMM_Q, PH_GEMM_SC, PH_ROUTE, PH_GATHER };

template <int PH>
__device__ __forceinline__ void run_phase(const Params& p, int l, int vb0, int nvb, char* smem) {
    const float* xin = (l == 0) ? p.x : p.out;
    if (PH == PH_MOD) ph_mod(p, vb0, nvb, smem);
    else if (PH == PH_WPREP) ph_wprep(p, l, vb0, nvb, smem);
    else if (PH == PH_NORM1) ph_norm(p, l, 0, xin, vb0, nvb);
    else if (PH == PH_GEMM_IN) gemm_phase((const bf16_t*)(p.ws + WS_H), 1024, (const bf16_t*)(p.ws + WS_WIN), 1024, T_TOK, LDZ, 1024, false,
                                          EpiZ{(bf16_t*)(p.ws + WS_Z), LDZ}, vb0, nvb, smem);
    else if (PH == PH_SCAN) ph_scan(p, l, vb0, nvb, smem);
    else if (PH == PH_DSAPREP) ph_dsaprep(p, l, vb0, nvb);
    else if (PH == PH_DSA) ph_dsa(p, l, vb0, nvb, smem);
    else if (PH == PH_POST) ph_post(p, l, vb0, nvb);
    else if (PH == PH_MERGE) ph_merge(p, vb0, nvb, smem);
    else if (PH == PH_OUT) gemm_phase((const bf16_t*)(p.ws + WS_H), 1024, (const bf16_t*)(p.ws + WS_WOUT), 1024, T_TOK, 1024, 1024, false,
                                      EpiOut{xin, p.out, (const float*)(p.ws + WS_MOD) + (size_t)l * 8 * 6144}, vb0, nvb, smem);
    else if (PH == PH_NORM2) ph_norm(p, l, 1, p.out, vb0, nvb);
    else if (PH == PH_GEMM_Q) gemm_phase((const bf16_t*)(p.ws + WS_H), 1024, (const bf16_t*)(p.ws + WS_WQ), 1024, T_TOK, 2048, 1024, false,
                                         EpiZ{(bf16_t*)(p.ws + WS_QP), 2048}, vb0, nvb, smem);
    else if (PH == PH_GEMM_SC) gemm_phase((const bf16_t*)(p.ws + WS_QP), 2048, (const bf16_t*)(p.ws + WS_SK), 128, T_TOK, 2048, 128, true,
                                          EpiF32{(float*)(p.ws + WS_SC), 2048}, vb0, nvb, smem);
    else if (PH == PH_ROUTE) ph_route(p, vb0, nvb);
    else if (PH == PH_GATHER) ph_gather(p, l, vb0, nvb);
}

template <int PH>
__global__ void __launch_bounds__(NT) k_phase(Params p, int l) {
    extern __shared__ __attribute__((aligned(16))) char smem[];
    run_phase<PH>(p, l, (int)blockIdx.x, (int)gridDim.x, smem);
}

constexpr int LDS_BYTES = 65536;

extern "C" void kernel_launch(void* const* d_in, const int* in_sizes, int n_in, void* d_out, int out_size, void* d_ws, size_t ws_size,
                              hipStream_t stream) {
    if (n_in != 20 || ws_size < WS_END) { fprintf(stderr, "kernel_launch: bad inputs (n_in %d ws %zu need %zu)\n", n_in, ws_size, (size_t)WS_END); return; }
    Params p{};
    p.x = (const float*)d_in[0]; p.c = (const float*)d_in[1]; p.w_ada = (const float*)d_in[2]; p.b_ada = (const float*)d_in[3];
    p.norm_mix = (const float*)d_in[4]; p.norm_ffn = (const float*)d_in[5]; p.w_in = (const float*)d_in[6]; p.hgrn_lb = (const float*)d_in[7];
    p.hgrn_on = (const float*)d_in[8]; p.dsa_qn = (const float*)d_in[9]; p.dsa_kn = (const float*)d_in[10]; p.gla_up = (const float*)d_in[11];
    p.gla_bias = (const float*)d_in[12]; p.gla_on = (const float*)d_in[13]; p.w_branch = (const float*)d_in[14]; p.w_out = (const float*)d_in[15];
    p.peer_wq = (const float*)d_in[16]; p.peer_keys = (const float*)d_in[17]; p.peer_u = (const float*)d_in[18]; p.peer_v = (const float*)d_in[19];
    p.out = (float*)d_out; p.ws = (unsigned char*)d_ws;
    const int G = 256;
#define LAUNCH(PH, l) hipLaunchKernelGGL(k_phase<PH>, dim3(G), dim3(NT), LDS_BYTES, stream, p, l)
    LAUNCH(PH_MOD, 0);
    for (int l = 0; l < 2; ++l) {
        LAUNCH(PH_WPREP, l);
        LAUNCH(PH_NORM1, l);
        LAUNCH(PH_GEMM_IN, l);
        LAUNCH(PH_SCAN, l);
        LAUNCH(PH_DSAPREP, l);
        LAUNCH(PH_DSA, l);
        LAUNCH(PH_POST, l);
        LAUNCH(PH_MERGE, l);
        LAUNCH(PH_OUT, l);
        LAUNCH(PH_NORM2, l);
        LAUNCH(PH_GEMM_Q, l);
        LAUNCH(PH_GEMM_SC, l);
        LAUNCH(PH_ROUTE, l);
        LAUNCH(PH_GATHER, l);
    }
}
```

```cpp
#include <hip/hip_runtime.h>
#include <stdint.h>
#include <stdio.h>

#ifndef MEGA
#define MEGA 1
#endif

typedef unsigned short bf16_t;
typedef short bf16x8 __attribute__((ext_vector_type(8)));
typedef float f32x4 __attribute__((ext_vector_type(4)));
typedef unsigned u32x4 __attribute__((ext_vector_type(4)));

#define NT 512
constexpr int T_TOK = 16384, DM = 1024, SEQ = 2048;
constexpr int LDZ = 8576;
constexpr int ZA_Q = 0, ZA_F = 512, ZA_I = 1024, ZA_G = 1536, ZB_Q = 2048, ZB_K = 2560, ZB_V = 3072, ZC_V = 3584, ZC_G = 4096,
              ZB_QI = 4608, ZC_Q = 4864, ZC_K = 5120, ZB_KI = 5376, ZB_WI = 5440, ZC_CODE = 5444, ZM = 5504;
constexpr int IN_COLS = 8532;

constexpr size_t al256(size_t x) { return (x + 255) & ~(size_t)255; }
constexpr size_t WS_CTL = 0;
constexpr size_t WS_MOD = 65536;
constexpr size_t WS_WIN = al256(WS_MOD + (size_t)2 * 8 * 6144 * 4);
constexpr size_t WS_WBR = al256(WS_WIN + (size_t)LDZ * 1024 * 2);
constexpr size_t WS_WOUT = al256(WS_WBR + (size_t)3 * 1024 * 512 * 2);
constexpr size_t WS_WQ = al256(WS_WOUT + (size_t)1024 * 1024 * 2);
constexpr size_t WS_SK = al256(WS_WQ + (size_t)2048 * 1024 * 2);
constexpr size_t WS_PU = al256(WS_SK + (size_t)16 * 128 * 128 * 2);
constexpr size_t WS_PV = al256(WS_PU + (size_t)16384 * 1024 * 2);
constexpr size_t WS_H = al256(WS_PV + (size_t)16384 * 1024 * 2);
constexpr size_t WS_OA = al256(WS_H + (size_t)T_TOK * 1024 * 2);
constexpr size_t WS_OC = al256(WS_OA + (size_t)T_TOK * 512 * 2);
constexpr size_t WS_Y = al256(WS_OC + (size_t)T_TOK * 512 * 2);
constexpr size_t WS_Z = al256(WS_Y + (size_t)T_TOK * 1536 * 2);
constexpr size_t WS_END = al256(WS_Z + (size_t)T_TOK * LDZ * 2);
constexpr size_t WS_QP = WS_Z;
constexpr size_t WS_SC = al256(WS_QP + (size_t)T_TOK * 2048 * 2);
constexpr size_t WS_RI = al256(WS_SC + (size_t)T_TOK * 2048 * 4);
constexpr size_t WS_RG = al256(WS_RI + (size_t)T_TOK * 128 * 4);
static_assert(WS_RG + (size_t)T_TOK * 128 * 4 <= WS_END, "peer alias overflow");

struct Params {
    const float* x; const float* c; const float* w_ada; const float* b_ada; const float* norm_mix; const float* norm_ffn;
    const float* w_in; const float* hgrn_lb; const float* hgrn_on; const float* dsa_qn; const float* dsa_kn;
    const float* gla_up; const float* gla_bias; const float* gla_on; const float* w_branch; const float* w_out;
    const float* peer_wq; const float* peer_keys; const float* peer_u; const float* peer_v;
    float* out; unsigned char* ws;
};

__device__ __forceinline__ float bf2f(bf16_t h) { return __uint_as_float(((unsigned)h) << 16); }
__device__ __forceinline__ float bflo(unsigned u) { return __uint_as_float(u << 16); }
__device__ __forceinline__ float bfhi(unsigned u) { return __uint_as_float(u & 0xffff0000u); }
__device__ __forceinline__ bf16_t f2bf(float f) { unsigned u = __float_as_uint(f); u += 0x7fffu + ((u >> 16) & 1u); return (bf16_t)(u >> 16); }
__device__ __forceinline__ unsigned pack2(float a, float b) { return (unsigned)f2bf(a) | ((unsigned)f2bf(b) << 16); }
__device__ __forceinline__ float wave_sum(float v) { for (int o = 32; o > 0; o >>= 1) v += __shfl_xor(v, o); return v; }
__device__ __forceinline__ float wave_max(float v) { for (int o = 32; o > 0; o >>= 1) v = fmaxf(v, __shfl_xor(v, o)); return v; }
__device__ __forceinline__ int wave_sum_i(int v) { for (int o = 32; o > 0; o >>= 1) v += __shfl_xor(v, o); return v; }
__device__ __forceinline__ float sigm(float x) { return 1.f / (1.f + expf(-x)); }

__device__ __forceinline__ int TIDX() { int t = (int)threadIdx.x; asm volatile("" : "+v"(t)); return t; }

__device__ __forceinline__ int src_col(int j) {
    if (j < 3584) return j;
    if (j < 4096) return j - 3584 + 4420;
    if (j < 4608) return j - 4096 + 4948;
    if (j < 4864) return j - 4608 + 3584;
    if (j < 5120) return j - 4864 + 3908;
    if (j < 5376) return j - 5120 + 4164;
    if (j < 5440) return j - 5376 + 3840;
    if (j < 5444) return j - 5440 + 3904;
    if (j < 5460) return j - 5444 + 4932;
    if (j < 5504) return -1;
    return j - 5504 + 5460;
}

__device__ void ph_mod(const Params& p, int vb0, int nvb, char* smem_) {
    float* sc = (float*)smem_;
    float* mod = (float*)(p.ws + WS_MOD);
    for (int i = TIDX(); i < 8 * 1024; i += NT) { float c = p.c[i]; sc[i] = c / (1.f + expf(-c)); }
    __syncthreads();
    for (int vb = vb0; vb < 24; vb += nvb) {
        int col = vb * 512 + TIDX();
        int l = col / 6144, n = col % 6144;
        const float* w = p.w_ada + (size_t)l * 1024 * 6144 + n;
        float acc[8];
#pragma unroll
        for (int b = 0; b < 8; ++b) acc[b] = 0.f;
#pragma unroll 8
        for (int k = 0; k < 1024; ++k) {
            float wv = w[(size_t)k * 6144];
#pragma unroll
            for (int b = 0; b < 8; ++b) acc[b] += sc[b * 1024 + k] * wv;
        }
        float bias = p.b_ada[l * 6144 + n];
#pragma unroll
        for (int b = 0; b < 8; ++b) mod[(size_t)(l * 8 + b) * 6144 + n] = acc[b] + bias;
    }
    __syncthreads();
}

template <bool MAP>
__device__ void tr_tile(const float* __restrict__ src, int lds_, bf16_t* __restrict__ out, int ldo, int k0, int n0, float* tile) {
    const int tid = TIDX();
#pragma unroll
    for (int i = 0; i < 8; ++i) {
        int kk = (tid >> 6) + 8 * i, nn = tid & 63;
        int scol = MAP ? src_col(n0 + nn) : (n0 + nn);
        float v = (scol >= 0) ? src[(size_t)(k0 + kk) * lds_ + scol] : 0.f;
        tile[kk * 65 + nn] = v;
    }
    __syncthreads();
#pragma unroll
    for (int i = 0; i < 4; ++i) {
        int nn = (tid >> 5) + 16 * i, kk = (tid & 31) * 2;
        unsigned v = pack2(tile[kk * 65 + nn], tile[(kk + 1) * 65 + nn]);
        *(unsigned*)(out + (size_t)(n0 + nn) * ldo + k0 + kk) = v;
    }
    __syncthreads();
}
__device__ void conv_chunk(const float* __restrict__ src, bf16_t* __restrict__ dst, size_t base) {
#pragma unroll
    for (int i = 0; i < 4; ++i) {
        size_t e = base + (size_t)(i * NT + TIDX()) * 8;
        float4 a = *(const float4*)(src + e), b = *(const float4*)(src + e + 4);
        uint4 o; o.x = pack2(a.x, a.y); o.y = pack2(a.z, a.w); o.z = pack2(b.x, b.y); o.w = pack2(b.z, b.w);
        *(uint4*)(dst + e) = o;
    }
}
__device__ void ph_wprep(const Params& p, int l, int vb0, int nvb, char* smem_) {
    float* tile = (float*)smem_;
    bf16_t* WIN = (bf16_t*)(p.ws + WS_WIN); bf16_t* WBR = (bf16_t*)(p.ws + WS_WBR); bf16_t* WOUT = (bf16_t*)(p.ws + WS_WOUT);
    bf16_t* WQ = (bf16_t*)(p.ws + WS_WQ); bf16_t* SK = (bf16_t*)(p.ws + WS_SK); bf16_t* PU = (bf16_t*)(p.ws + WS_PU); bf16_t* PV = (bf16_t*)(p.ws + WS_PV);
    constexpr int N_WIN = 134 * 16, N_WBR = 3 * 16 * 8, N_WOUT = 16 * 16, N_WQ = 32 * 16, N_SK = 16, N_PU = 1024, N_PV = 1024;
    constexpr int TOTAL = N_WIN + N_WBR + N_WOUT + N_WQ + N_SK + N_PU + N_PV;
    for (int task = vb0; task < TOTAL; task += nvb) {
        int r = task;
        if (r < N_WIN) { int nt = r / 16, kt = r % 16; tr_tile<true>(p.w_in + (size_t)l * 1024 * IN_COLS, IN_COLS, WIN, 1024, kt * 64, nt * 64, tile); continue; }
        r -= N_WIN;
        if (r < N_WBR) { int g = r / 128, rr = r % 128, nt = rr / 8, kt = rr % 8;
            tr_tile<false>(p.w_branch + (size_t)(l * 3 + g) * 512 * 1024, 1024, WBR + (size_t)g * 1024 * 512, 512, kt * 64, nt * 64, tile); continue; }
        r -= N_WBR;
        if (r < N_WOUT) { int nt = r / 16, kt = r % 16; tr_tile<false>(p.w_out + (size_t)l * 1024 * 1024, 1024, WOUT, 1024, kt * 64, nt * 64, tile); continue; }
        r -= N_WOUT;
        if (r < N_WQ) { int nt = r / 16, kt = r % 16; tr_tile<false>(p.peer_wq + (size_t)l * 1024 * 2048, 2048, WQ, 1024, kt * 64, nt * 64, tile); continue; }
        r -= N_WQ;
        if (r < N_SK) { conv_chunk(p.peer_keys + (size_t)l * 16 * 128 * 128, SK, (size_t)r * 16384); continue; }
        r -= N_SK;
        if (r < N_PU) { conv_chunk(p.peer_u + (size_t)l * 16384 * 1024, PU, (size_t)r * 16384); continue; }
        r -= N_PU;
        conv_chunk(p.peer_v + (size_t)l * 16384 * 1024, PV, (size_t)r * 16384);
    }
}

__device__ void ph_norm(const Params& p, int l, int which, const float* xin, int vb0, int nvb) {
    const int wave = TIDX() >> 6, lane = TIDX() & 63;
    const float* gain = (which ? p.norm_ffn : p.norm_mix) + l * 1024;
    const float* modb = (const float*)(p.ws + WS_MOD);
    bf16_t* H = (bf16_t*)(p.ws + WS_H);
    for (int t = vb0 * 8 + wave; t < T_TOK; t += nvb * 8) {
        int b = t >> 11;
        const float* mod = modb + (size_t)(l * 8 + b) * 6144 + (which ? 3072 : 0);
        const float4* xr = (const float4*)(xin + (size_t)t * 1024);
        float4 v[4]; float ss = 0.f;
#pragma unroll
        for (int i = 0; i < 4; ++i) { v[i] = xr[lane + 64 * i]; ss += v[i].x * v[i].x + v[i].y * v[i].y + v[i].z * v[i].z + v[i].w * v[i].w; }
        ss = wave_sum(ss);
        float rstd = rsqrtf(ss * (1.f / 1024.f) + 1e-6f);
#pragma unroll
        for (int i = 0; i < 4; ++i) {
            int idx = (lane + 64 * i) * 4;
            float4 g = *(const float4*)(gain + idx), sc = *(const float4*)(mod + 1024 + idx), sh = *(const float4*)(mod + idx);
            float h0 = v[i].x * rstd * g.x * (1.f + sc.x) + sh.x, h1 = v[i].y * rstd * g.y * (1.f + sc.y) + sh.y;
            float h2 = v[i].z * rstd * g.z * (1.f + sc.z) + sh.z, h3 = v[i].w * rstd * g.w * (1.f + sc.w) + sh.w;
            uint2 o; o.x = pack2(h0, h1); o.y = pack2(h2, h3);
            *(uint2*)(H + (size_t)t * 1024 + idx) = o;
        }
    }
}

constexpr int GBM = 256, GBN = 128, GBK = 64, GLS = 72;
__device__ __forceinline__ void gemm_tile(const bf16_t* __restrict__ A, int lda, const bf16_t* __restrict__ Bt, int ldb, int K,
                                          int m0, int n0, bf16_t* sA, bf16_t* sB, f32x4 (&acc)[4][4]) {
    const int tid = TIDX(), lane = tid & 63, wave = tid >> 6;
    const int wm = wave >> 1, wn = wave & 1, fr = lane & 15, fq = lane >> 4;
    u32x4 ra[4], rb[2];
    const int crow = tid >> 3, ckc = (tid & 7) * 8;
    const bf16_t* Ag = A + (size_t)(m0 + crow) * lda + ckc;
    const bf16_t* Bg = Bt + (size_t)(n0 + crow) * ldb + ckc;
#pragma unroll
    for (int i = 0; i < 4; ++i) ra[i] = *(const u32x4*)(Ag + (size_t)(64 * i) * lda);
#pragma unroll
    for (int i = 0; i < 2; ++i) rb[i] = *(const u32x4*)(Bg + (size_t)(64 * i) * ldb);
    for (int k0 = 0; k0 < K; k0 += GBK) {
        __syncthreads();
#pragma unroll
        for (int i = 0; i < 4; ++i) *(u32x4*)(sA + (crow + 64 * i) * GLS + ckc) = ra[i];
#pragma unroll
        for (int i = 0; i < 2; ++i) *(u32x4*)(sB + (crow + 64 * i) * GLS + ckc) = rb[i];
        __syncthreads();
        {
            const int kn = (k0 + GBK < K) ? (k0 + GBK) : k0;
#pragma unroll
            for (int i = 0; i < 4; ++i) ra[i] = *(const u32x4*)(Ag + (size_t)(64 * i) * lda + kn);
#pragma unroll
            for (int i = 0; i < 2; ++i) rb[i] = *(const u32x4*)(Bg + (size_t)(64 * i) * ldb + kn);
        }
#pragma unroll
        for (int ks = 0; ks < 2; ++ks) {
            bf16x8 af[4], wf[4];
#pragma unroll
            for (int mf = 0; mf < 4; ++mf) af[mf] = *(const bf16x8*)(sA + (wm * 64 + mf * 16 + fr) * GLS + ks * 32 + fq * 8);
#pragma unroll
            for (int nf = 0; nf < 4; ++nf) wf[nf] = *(const bf16x8*)(sB + (wn * 64 + nf * 16 + fr) * GLS + ks * 32 + fq * 8);
#pragma unroll
            for (int nf = 0; nf < 4; ++nf)
#pragma unroll
                for (int mf = 0; mf < 4; ++mf)
                    acc[nf][mf] = __builtin_amdgcn_mfma_f32_16x16x32_bf16(wf[nf], af[mf], acc[nf][mf], 0, 0, 0);
        }
    }
}

struct EpiZ {
    bf16_t* Z; int ld;
    __device__ __forceinline__ void operator()(int m, int n, const f32x4& v) const {
        uint2 o; o.x = pack2(v[0], v[1]); o.y = pack2(v[2], v[3]);
        *(uint2*)(Z + (size_t)m * ld + n) = o;
    }
};
struct EpiF32 {
    float* C; int ld;
    __device__ __forceinline__ void operator()(int m, int n, const f32x4& v) const {
        *(float4*)(C + (size_t)m * ld + n) = make_float4(v[0], v[1], v[2], v[3]);
    }
};
struct EpiOut {
    const float* xin; float* out; const float* mod;
    __device__ __forceinline__ void operator()(int m, int n, const f32x4& v) const {
        int b = m >> 11;
        float4 g = *(const float4*)(mod + (size_t)b * 6144 + 2048 + n);
        float4 xi = *(const float4*)(xin + (size_t)m * 1024 + n);
        *(float4*)(out + (size_t)m * 1024 + n) = make_float4(xi.x + g.x * v[0], xi.y + g.y * v[1], xi.z + g.z * v[2], xi.w + g.w * v[3]);
    }
};

template <class Epi>
__device__ void gemm_phase(const bf16_t* A, int lda, const bf16_t* Bt, int ldb, int M, int N, int K, bool batched, Epi epi,
                           int vb0, int nvb, char* smem_) {
    bf16_t* sA = (bf16_t*)smem_; bf16_t* sB = sA + GBM * GLS;
    const int lane = TIDX() & 63, wave = TIDX() >> 6, wm = wave >> 1, wn = wave & 1, fr = lane & 15, fq = lane >> 4;
    const int MT = M / GBM, NTL = N / GBN;
    for (int tile = vb0; tile < MT * NTL; tile += nvb) {
        int mt = tile % MT, nt = tile / MT;
        f32x4 acc[4][4];
#pragma unroll
        for (int a = 0; a < 4; ++a)
#pragma unroll
            for (int b = 0; b < 4; ++b) acc[a][b] = f32x4{0.f, 0.f, 0.f, 0.f};
        gemm_tile(batched ? A + nt * 128 : A, lda, Bt, ldb, K, mt * GBM, nt * GBN, sA, sB, acc);
#pragma unroll
        for (int nf = 0; nf < 4; ++nf)
#pragma unroll
            for (int mf = 0; mf < 4; ++mf)
                epi(mt * GBM + wm * 64 + mf * 16 + fr, nt * GBN + wn * 64 + nf * 16 + fq * 4, acc[nf][mf]);
    }
}

__device__ void ph_merge(const Params& p, int vb0, int nvb, char* smem_) {
    bf16_t* sA = (bf16_t*)smem_; bf16_t* sB = sA + GBM * GLS;
    const bf16_t* Y = (const bf16_t*)(p.ws + WS_Y); const bf16_t* WBR = (const bf16_t*)(p.ws + WS_WBR);
    const bf16_t* Z = (const bf16_t*)(p.ws + WS_Z); bf16_t* H = (bf16_t*)(p.ws + WS_H);
    const int lane = TIDX() & 63, wave = TIDX() >> 6, wm = wave >> 1, wn = wave & 1, fr = lane & 15, fq = lane >> 4;
    for (int tile = vb0; tile < 64 * 8; tile += nvb) {
        int mt = tile % 64, nt = tile / 64;
        f32x4 tot[4][4];
#pragma unroll
        for (int a = 0; a < 4; ++a)
#pragma unroll
            for (int b = 0; b < 4; ++b) tot[a][b] = f32x4{0.f, 0.f, 0.f, 0.f};
        for (int g = 0; g < 3; ++g) {
            f32x4 acc[4][4];
#pragma unroll
            for (int a = 0; a < 4; ++a)
#pragma unroll
                for (int b = 0; b < 4; ++b) acc[a][b] = f32x4{0.f, 0.f, 0.f, 0.f};
            gemm_tile(Y + g * 512, 1536, WBR + (size_t)g * 1024 * 512, 512, 512, mt * GBM, nt * GBN, sA, sB, acc);
#pragma unroll
            for (int nf = 0; nf < 4; ++nf)
#pragma unroll
                for (int mf = 0; mf < 4; ++mf) {
                    int m = mt * GBM + wm * 64 + mf * 16 + fr, n = nt * GBN + wn * 64 + nf * 16 + fq * 4;
                    uint2 gz = *(const uint2*)(Z + (size_t)m * LDZ + ZM + g * 1024 + n);
                    tot[nf][mf][0] += sigm(bflo(gz.x)) * acc[nf][mf][0];
                    tot[nf][mf][1] += sigm(bfhi(gz.x)) * acc[nf][mf][1];
                    tot[nf][mf][2] += sigm(bflo(gz.y)) * acc[nf][mf][2];
                    tot[nf][mf][3] += sigm(bfhi(gz.y)) * acc[nf][mf][3];
                }
        }
#pragma unroll
        for (int nf = 0; nf < 4; ++nf)
#pragma unroll
            for (int mf = 0; mf < 4; ++mf) {
                int m = mt * GBM + wm * 64 + mf * 16 + fr, n = nt * GBN + wn * 64 + nf * 16 + fq * 4;
                uint2 o; o.x = pack2(tot[nf][mf][0], tot[nf][mf][1]); o.y = pack2(tot[nf][mf][2], tot[nf][mf][3]);
                *(uint2*)(H + (size_t)m * 1024 + n) = o;
            }
    }
}

template <int DK, bool GLA>
__device__ void scan_item(const Params& p, int l, int item, char* smem_) {
    constexpr int TB = 16, KPT = DK / 32, SSTR = NT / DK;
    const int b = item >> 5, h = (item >> 3) & 3, vs = item & 7;
    const int tid = TIDX(), lane = tid & 63, wave = tid >> 6;
    const int kg = tid >> 4, v = tid & 15;
    float* qs = (float*)smem_; float* fs = qs + TB * DK; float* ks = fs + TB * DK; float* vsm = ks + TB * DK; float* wp = vsm + TB * 16;
    const int kl = tid % DK, step0 = tid / DK;
    float lbv = 0.f, gbias = 0.f; float gu[16];
#pragma unroll
    for (int r = 0; r < 16; ++r) gu[r] = 0.f;
    if (GLA) {
#pragma unroll
        for (int r = 0; r < 16; ++r) gu[r] = p.gla_up[(size_t)(l * 16 + r) * 256 + h * 64 + kl];
        gbias = p.gla_bias[l * 256 + h * 64 + kl];
    } else if (l == 1) {
        float x0 = p.hgrn_lb[h * 128 + kl], x1 = p.hgrn_lb[512 + h * 128 + kl];
        lbv = 1.f / (1.f + expf(x0 - x1));
    }
    const float scale = GLA ? 0.125f : 0.08838834764831845f;
    float s[KPT];
#pragma unroll
    for (int i = 0; i < KPT; ++i) s[i] = 0.f;
    const bf16_t* Zb = (const bf16_t*)(p.ws + WS_Z) + (size_t)(b * 2048) * LDZ;
    bf16_t* OX = (bf16_t*)(p.ws + (GLA ? WS_OC : WS_OA));
    for (int t0 = 0; t0 < 2048; t0 += TB) {
        for (int st = step0; st < TB; st += SSTR) {
            const bf16_t* zr = Zb + (size_t)(t0 + st) * LDZ;
            float q, f, kk;
            if (GLA) {
                float x = gbias;
#pragma unroll
                for (int r = 0; r < 16; ++r) x += bf2f(zr[ZC_CODE + r]) * gu[r];
                float ls = fminf(x, 0.f) - log1pf(expf(-fabsf(x)));
                f = expf(ls * (1.f / 16.f));
                q = bf2f(zr[ZC_Q + h * 64 + kl]) * scale; kk = bf2f(zr[ZC_K + h * 64 + kl]);
            } else {
                float lg = bf2f(zr[ZA_F + h * 128 + kl]);
                f = lbv + (1.f - lbv) * sigm(lg); kk = 1.f - f;
                q = bf2f(zr[ZA_Q + h * 128 + kl]) * scale;
            }
            qs[st * DK + kl] = q; fs[st * DK + kl] = f; ks[st * DK + kl] = kk;
        }
        if (tid < TB * 16) {
            int st = tid >> 4, vv = tid & 15;
            vsm[st * 16 + vv] = bf2f(Zb[(size_t)(t0 + st) * LDZ + (GLA ? ZC_V : ZA_I) + h * 128 + vs * 16 + vv]);
        }
        __syncthreads();
        float po[TB];
#pragma unroll
        for (int st = 0; st < TB; ++st) {
            float vv = vsm[st * 16 + v], a = 0.f;
#pragma unroll
            for (int i = 0; i < KPT; ++i) {
                int k = kg * KPT + i;
                s[i] = fs[st * DK + k] * s[i] + ks[st * DK + k] * vv;
                a += qs[st * DK + k] * s[i];
            }
            a += __shfl_xor(a, 16); a += __shfl_xor(a, 32);
            po[st] = a;
        }
        if (lane < 16) {
#pragma unroll
            for (int st = 0; st < TB; ++st) wp[(wave * TB + st) * 16 + lane] = po[st];
        }
        __syncthreads();
        if (tid < TB * 16) {
            int st = tid >> 4, vv = tid & 15; float o = 0.f;
#pragma unroll
            for (int w = 0; w < 8; ++w) o += wp[(w * TB + st) * 16 + vv];
            OX[(size_t)(b * 2048 + t0 + st) * 512 + h * 128 + vs * 16 + vv] = f2bf(o);
        }
        __syncthreads();
    }
}
__device__ void ph_scan(const Params& p, int l, int vb0, int nvb, char* smem_) {
    for (int item = vb0; item < 512; item += nvb) {
        if (item < 256) scan_item<128, false>(p, l, item, smem_);
        else scan_item<64, true>(p, l, item - 256, smem_);
    }
}

__device__ void ph_dsaprep(const Params& p, int l, int vb0, int nvb) {
    const int wave = TIDX() >> 6, lane = TIDX() & 63;
    bf16_t* Z = (bf16_t*)(p.ws + WS_Z);
    for (int t = vb0 * 8 + wave; t < T_TOK; t += nvb * 8) {
#pragma unroll
        for (int grp = 0; grp < 8; ++grp) {
            bf16_t* ptr = Z + (size_t)t * LDZ + (grp < 4 ? ZB_Q : ZB_K) + (grp & 3) * 128 + lane * 2;
            unsigned u = *(unsigned*)ptr;
            float a = bflo(u), b = bfhi(u);
            float ss = wave_sum(a * a + b * b);
            float r = rsqrtf(ss * (1.f / 128.f) + 1e-6f);
            const float* gn = (grp < 4 ? p.dsa_qn : p.dsa_kn) + l * 128 + lane * 2;
            float sc = (grp < 4) ? 0.08838834764831845f : 1.f;
            *(unsigned*)ptr = pack2(a * r * gn[0] * sc, b * r * gn[1] * sc);
        }
    }
}

__device__ void ph_post(const Params& p, int l, int vb0, int nvb) {
    const int wave = TIDX() >> 6, lane = TIDX() & 63;
    const bf16_t* Z = (const bf16_t*)(p.ws + WS_Z);
    const bf16_t* OA = (const bf16_t*)(p.ws + WS_OA); const bf16_t* OC = (const bf16_t*)(p.ws + WS_OC);
    bf16_t* Y = (bf16_t*)(p.ws + WS_Y);
    for (int t = vb0 * 8 + wave; t < T_TOK; t += nvb * 8) {
#pragma unroll
        for (int grp = 0; grp < 8; ++grp) {
            const int hh = grp & 3;
            unsigned u = *(const unsigned*)((grp < 4 ? OA : OC) + (size_t)t * 512 + hh * 128 + lane * 2);
            float a = bflo(u), b = bfhi(u);
            float ss = wave_sum(a * a + b * b);
            float r = rsqrtf(ss * (1.f / 128.f) + 1e-6f);
            const float* gn = (grp < 4 ? p.hgrn_on : p.gla_on) + l * 128 + lane * 2;
            unsigned gz = *(const unsigned*)(Z + (size_t)t * LDZ + (grp < 4 ? ZA_G : ZC_G) + hh * 128 + lane * 2);
            float g0 = bflo(gz), g1 = bfhi(gz);
            float y0 = a * r * gn[0] * (g0 * sigm(g0)), y1 = b * r * gn[1] * (g1 * sigm(g1));
            *(unsigned*)(Y + (size_t)t * 1536 + (grp < 4 ? 0 : 1024) + hh * 128 + lane * 2) = pack2(y0, y1);
        }
    }
}

__device__ void ph_dsa(const Params& p, int l, int vb0, int nvb, char* smem_) {
    float* qi = (float*)smem_;
    float* qn = qi + 256;
    float* wv = qn + 512;
    int* sel = (int*)(wv + 16);
    float* pr = (float*)(sel + 256);
    int* red = (int*)(pr + 1024);
    int* cnt = red + 16;
    const int tid = TIDX(), lane = tid & 63, wave = tid >> 6;
    const bf16_t* Z = (const bf16_t*)(p.ws + WS_Z);
    bf16_t* Y = (bf16_t*)(p.ws + WS_Y);
    const unsigned long long lt_mask = (lane == 0) ? 0ull : (~0ull >> (64 - lane));
    for (int t = vb0; t < T_TOK; t += nvb) {
        const int b = t >> 11, tl = t & 2047, n = tl + 1;
        const bf16_t* zr = Z + (size_t)t * LDZ;
        if (tid < 256) qi[tid] = bf2f(zr[ZB_QI + tid]);
        qn[tid] = bf2f(zr[ZB_Q + tid]);
        if (tid < 4) wv[tid] = bf2f(zr[ZB_WI + tid]) * 0.5f;
        __syncthreads();
        const bf16_t* Zb = Z + (size_t)(b * 2048) * LDZ;
        unsigned mk[4];
#pragma unroll
        for (int i = 0; i < 4; ++i) {
            int s = tid + i * 512; unsigned key = 0u;
            if (s < n) {
                const uint4* kp = (const uint4*)(Zb + (size_t)s * LDZ + ZB_KI);
                float d0 = 0.f, d1 = 0.f, d2 = 0.f, d3 = 0.f;
#pragma unroll
                for (int c = 0; c < 8; ++c) {
                    uint4 u = kp[c];
                    float x[8] = {bflo(u.x), bfhi(u.x), bflo(u.y), bfhi(u.y), bflo(u.z), bfhi(u.z), bflo(u.w), bfhi(u.w)};
#pragma unroll
                    for (int j = 0; j < 8; ++j) {
                        d0 += x[j] * qi[c * 8 + j]; d1 += x[j] * qi[64 + c * 8 + j];
                        d2 += x[j] * qi[128 + c * 8 + j]; d3 += x[j] * qi[192 + c * 8 + j];
                    }
                }
                float sc = wv[0] * fmaxf(d0 * 0.125f, 0.f) + wv[1] * fmaxf(d1 * 0.125f, 0.f) + wv[2] * fmaxf(d2 * 0.125f, 0.f) + wv[3] * fmaxf(d3 * 0.125f, 0.f);
                if (sc == 0.f) sc = 0.f;
                unsigned u = __float_as_uint(sc);
                key = (u & 0x80000000u) ? ~u : (u | 0x80000000u);
            }
            mk[i] = key;
        }
        if (n > 256) {
            unsigned T = 0u;
            for (int bit = 31; bit >= 0; --bit) {
                unsigned cand = T | (1u << bit);
                int c = (mk[0] >= cand) + (mk[1] >= cand) + (mk[2] >= cand) + (mk[3] >= cand);
                c = wave_sum_i(c);
                if (lane == 0) red[(bit & 1) * 8 + wave] = c;
                __syncthreads();
                int tot = 0;
#pragma unroll
                for (int w = 0; w < 8; ++w) tot += red[(bit & 1) * 8 + w];
                if (tot >= 256) T = cand;
            }
            unsigned long long beq[4], bgt[4];
#pragma unroll
            for (int i = 0; i < 4; ++i) { beq[i] = __ballot(mk[i] == T); bgt[i] = __ballot(mk[i] > T); }
            __syncthreads();
            if (lane == 0) {
#pragma unroll
                for (int i = 0; i < 4; ++i) { cnt[i * 8 + wave] = __popcll(beq[i]); cnt[32 + i * 8 + wave] = __popcll(bgt[i]); }
            }
            __syncthreads();
            int cgt = 0;
#pragma unroll
            for (int j = 0; j < 32; ++j) cgt += cnt[32 + j];
            const int need = 256 - cgt;
            int eqbase = 0;
            unsigned long long bsel[4];
#pragma unroll
            for (int i = 0; i < 4; ++i) {
                int before = eqbase;
#pragma unroll
                for (int w = 0; w < 8; ++w) { int cw = cnt[i * 8 + w]; if (w < wave) before += cw; eqbase += cw; }
                int rank = before + __popcll(beq[i] & lt_mask);
                bool s_ = (mk[i] > T) || ((mk[i] == T) && rank < need);
                bsel[i] = __ballot(s_);
            }
            __syncthreads();
            if (lane == 0) {
#pragma unroll
                for (int i = 0; i < 4; ++i) cnt[i * 8 + wave] = __popcll(bsel[i]);
            }
            __syncthreads();
            int sbase = 0;
#pragma unroll
            for (int i = 0; i < 4; ++i) {
                int before = sbase;
#pragma unroll
                for (int w = 0; w < 8; ++w) { int cw = cnt[i * 8 + w]; if (w < wave) before += cw; sbase += cw; }
                if ((bsel[i] >> lane) & 1ull) { int pos = before + __popcll(bsel[i] & lt_mask); if (pos < 256) sel[pos] = tid + i * 512; }
            }
        } else {
            if (tid < n) sel[tid] = tid;
        }
        const int m = n < 256 ? n : 256;
        __syncthreads();
        {
            int j = tid >> 1, hh = tid & 1;
            if (j < m) {
                const uint4* kr = (const uint4*)(Zb + (size_t)sel[j] * LDZ + ZB_K + hh * 256);
                float d0 = 0.f, d1 = 0.f;
#pragma unroll
                for (int c = 0; c < 16; ++c) {
                    uint4 u = kr[c]; const float* q = qn + hh * 256 + c * 8;
                    d0 += bflo(u.x) * q[0] + bfhi(u.x) * q[1] + bflo(u.y) * q[2] + bfhi(u.y) * q[3] + bflo(u.z) * q[4] + bfhi(u.z) * q[5] + bflo(u.w) * q[6] + bfhi(u.w) * q[7];
                }
#pragma unroll
                for (int c = 16; c < 32; ++c) {
                    uint4 u = kr[c]; const float* q = qn + hh * 256 + c * 8;
                    d1 += bflo(u.x) * q[0] + bfhi(u.x) * q[1] + bflo(u.y) * q[2] + bfhi(u.y) * q[3] + bflo(u.z) * q[4] + bfhi(u.z) * q[5] + bflo(u.w) * q[6] + bfhi(u.w) * q[7];
                }
                pr[(2 * hh) * 256 + j] = d0; pr[(2 * hh + 1) * 256 + j] = d1;
            }
        }
        __syncthreads();
        if (wave < 4) {
            float xv[4]; float mx = -INFINITY;
#pragma unroll
            for (int i = 0; i < 4; ++i) { int j = lane + 64 * i; xv[i] = (j < m) ? pr[wave * 256 + j] : -INFINITY; mx = fmaxf(mx, xv[i]); }
            mx = wave_max(mx);
            float sm = 0.f;
#pragma unroll
            for (int i = 0; i < 4; ++i) { xv[i] = expf(xv[i] - mx); sm += xv[i]; }
            sm = wave_sum(sm);
            float inv = 1.f / sm;
#pragma unroll
            for (int i = 0; i < 4; ++i) { int j = lane + 64 * i; pr[wave * 256 + j] = xv[i] * inv; }
        }
        __syncthreads();
        {
            const int d = tid, hd = d >> 7;
            float o = 0.f;
            const bf16_t* vb = Zb + ZB_V + d;
#pragma unroll 8
            for (int j = 0; j < m; ++j) o += pr[hd * 256 + j] * bf2f(vb[(size_t)sel[j] * LDZ]);
            Y[(size_t)t * 1536 + 512 + d] = f2bf(o);
        }
        __syncthreads();
    }
}

__device__ __forceinline__ int f2sort(float f) { int i = __float_as_int(f); return i ^ ((i >> 31) & 0x7fffffff); }
__device__ __forceinline__ float sort2f(int i) { return __int_as_float(i ^ ((i >> 31) & 0x7fffffff)); }
#define INSK(K, xv) do { int _x = (xv); \
    _Pragma("unroll") for (int _j = 0; _j < 16; ++_j) { int _hi = max(K[_j], _x); _x = min(K[_j], _x); K[_j] = _hi; } } while (0)
#define INS64(K, xv) do { unsigned long long _x = (xv); \
    _Pragma("unroll") for (int _j = 0; _j < 16; ++_j) { bool _c = _x > K[_j]; unsigned long long _o = K[_j]; K[_j] = _c ? _x : _o; _x = _c ? _o : _x; } } while (0)

__device__ void ph_route(const Params& p, int vb0, int nvb) {
    const float* SC = (const float*)(p.ws + WS_SC);
    int* RI = (int*)(p.ws + WS_RI); float* RG = (float*)(p.ws + WS_RG);
    for (int item = vb0 * NT + TIDX(); item < T_TOK * 8; item += nvb * NT) {
        const int t = item >> 3, h = item & 7;
        const float* s0 = SC + (size_t)t * 2048 + h * 256;
        int k0[16], k1[16];
#pragma unroll
        for (int j = 0; j < 16; ++j) { k0[j] = (int)0x80000000; k1[j] = (int)0x80000000; }
#pragma unroll 1
        for (int i = 0; i < 128; i += 4) {
            float4 a = *(const float4*)(s0 + i), b = *(const float4*)(s0 + 128 + i);
            INSK(k0, (f2sort(a.x) & ~127) | (127 - i)); INSK(k0, (f2sort(a.y) & ~127) | (126 - i));
            INSK(k0, (f2sort(a.z) & ~127) | (125 - i)); INSK(k0, (f2sort(a.w) & ~127) | (124 - i));
            INSK(k1, (f2sort(b.x) & ~127) | (127 - i)); INSK(k1, (f2sort(b.y) & ~127) | (126 - i));
            INSK(k1, (f2sort(b.z) & ~127) | (125 - i)); INSK(k1, (f2sort(b.w) & ~127) | (124 - i));
        }
        float v0[16], v1[16];
#pragma unroll
        for (int j = 0; j < 16; ++j) { k0[j] = 127 - (k0[j] & 127); k1[j] = 127 - (k1[j] & 127); v0[j] = s0[k0[j]]; v1[j] = s0[128 + k1[j]]; }
        unsigned long long ck[16];
#pragma unroll
        for (int j = 0; j < 16; ++j) ck[j] = 0ull;
#pragma unroll
        for (int a = 0; a < 16; ++a)
#pragma unroll
            for (int b = 0; b < 16; ++b)
                if ((a + 1) * (b + 1) <= 16) {
                    unsigned hi = (unsigned)f2sort(v0[a] + v1[b]) ^ 0x80000000u;
                    unsigned lo = ((unsigned)(255 - (a * 16 + b)) << 16) | (unsigned)(k0[a] * 128 + k1[b]);
                    INS64(ck, ((unsigned long long)hi << 32) | lo);
                }
        float e[16]; float sm = 0.f;
        const float mx = sort2f((int)((unsigned)(ck[0] >> 32) ^ 0x80000000u));
#pragma unroll
        for (int j = 0; j < 16; ++j) { e[j] = expf(sort2f((int)((unsigned)(ck[j] >> 32) ^ 0x80000000u)) - mx); sm += e[j]; }
        const float inv = 1.f / sm;
#pragma unroll
        for (int j = 0; j < 16; j += 4) {
            *(int4*)(RI + (size_t)t * 128 + h * 16 + j) = make_int4((int)(ck[j] & 0xffffu), (int)(ck[j + 1] & 0xffffu), (int)(ck[j + 2] & 0xffffu), (int)(ck[j + 3] & 0xffffu));
            *(float4*)(RG + (size_t)t * 128 + h * 16 + j) = make_float4(e[j] * inv, e[j + 1] * inv, e[j + 2] * inv, e[j + 3] * inv);
        }
    }
}

__device__ void ph_gather(const Params& p, int l, int vb0, int nvb) {
    const int wave = TIDX() >> 6, lane = TIDX() & 63;
    const bf16_t* H = (const bf16_t*)(p.ws + WS_H); const bf16_t* PU = (const bf16_t*)(p.ws + WS_PU); const bf16_t* PV = (const bf16_t*)(p.ws + WS_PV);
    const int* RI = (const int*)(p.ws + WS_RI); const float* RG = (const float*)(p.ws + WS_RG);
    const float* modb = (const float*)(p.ws + WS_MOD);
    for (int t = vb0 * 8 + wave; t < T_TOK; t += nvb * 8) {
        const int b = t >> 11;
        float hv[16], y[16];
        {
            const uint4* hp = (const uint4*)(H + (size_t)t * 1024 + lane * 16);
            uint4 a = hp[0], c = hp[1];
            hv[0] = bflo(a.x); hv[1] = bfhi(a.x); hv[2] = bflo(a.y); hv[3] = bfhi(a.y); hv[4] = bflo(a.z); hv[5] = bfhi(a.z); hv[6] = bflo(a.w); hv[7] = bfhi(a.w);
            hv[8] = bflo(c.x); hv[9] = bfhi(c.x); hv[10] = bflo(c.y); hv[11] = bfhi(c.y); hv[12] = bflo(c.z); hv[13] = bfhi(c.z); hv[14] = bflo(c.w); hv[15] = bfhi(c.w);
        }
#pragma unroll
        for (int j = 0; j < 16; ++j) y[j] = 0.f;
        const int e_lo = RI[(size_t)t * 128 + lane], e_hi = RI[(size_t)t * 128 + 64 + lane];
        const float g_lo = RG[(size_t)t * 128 + lane], g_hi = RG[(size_t)t * 128 + 64 + lane];
#pragma unroll 4
        for (int k = 0; k < 128; ++k) {
            const int e = __shfl(k < 64 ? e_lo : e_hi, k & 63);
            const float g = __shfl(k < 64 ? g_lo : g_hi, k & 63);
            const uint4* up = (const uint4*)(PU + (size_t)e * 1024 + lane * 16);
            const uint4* vp = (const uint4*)(PV + (size_t)e * 1024 + lane * 16);
            uint4 a = up[0], c = up[1], va = vp[0], vc = vp[1];
            float d = hv[0] * bflo(a.x) + hv[1] * bfhi(a.x) + hv[2] * bflo(a.y) + hv[3] * bfhi(a.y) + hv[4] * bflo(a.z) + hv[5] * bfhi(a.z) + hv[6] * bflo(a.w) + hv[7] * bfhi(a.w)
                    + hv[8] * bflo(c.x) + hv[9] * bfhi(c.x) + hv[10] * bflo(c.y) + hv[11] * bfhi(c.y) + hv[12] * bflo(c.z) + hv[13] * bfhi(c.z) + hv[14] * bflo(c.w) + hv[15] * bfhi(c.w);
            d = wave_sum(d);
            const float coef = g * 0.5f * d * (1.f + erff(d * 0.7071067811865476f));
            y[0] += coef * bflo(va.x); y[1] += coef * bfhi(va.x); y[2] += coef * bflo(va.y); y[3] += coef * bfhi(va.y);
            y[4] += coef * bflo(va.z); y[5] += coef * bfhi(va.z); y[6] += coef * bflo(va.w); y[7] += coef * bfhi(va.w);
            y[8] += coef * bflo(vc.x); y[9] += coef * bfhi(vc.x); y[10] += coef * bflo(vc.y); y[11] += coef * bfhi(vc.y);
            y[12] += coef * bflo(vc.z); y[13] += coef * bfhi(vc.z); y[14] += coef * bflo(vc.w); y[15] += coef * bfhi(vc.w);
        }
        const float* gf = modb + (size_t)(l * 8 + b) * 6144 + 5120 + lane * 16;
        float* op = p.out + (size_t)t * 1024 + lane * 16;
#pragma unroll
        for (int j = 0; j < 16; j += 4) {
            float4 xi = *(const float4*)(op + j), g4 = *(const float4*)(gf + j);
            *(float4*)(op + j) = make_float4(xi.x + g4.x * y[j], xi.y + g4.y * y[j + 1], xi.z + g4.z * y[j + 2], xi.w + g4.w * y[j + 3]);
        }
    }
}

enum { PH_MOD = 0, PH_WPREP, PH_NORM1, PH_GEMM_IN, PH_SCAN, PH_DSAPREP, PH_DSA, PH_POST, PH_MERGE, PH_OUT, PH_NORM2, PH_GEMM_Q, PH_GEMM_SC, PH_ROUTE, PH_GATHER };

template <int PH>
__device__ __forceinline__ void run_phase(const Params& p, int l, int vb0, int nvb, char* smem) {
    const float* xin = (l == 0) ? p.x : p.out;
    if (PH == PH_MOD) ph_mod(p, vb0, nvb, smem);
    else if (PH == PH_WPREP) ph_wprep(p, l, vb0, nvb, smem);
    else if (PH == PH_NORM1) ph_norm(p, l, 0, xin, vb0, nvb);
    else if (PH == PH_GEMM_IN) gemm_phase((const bf16_t*)(p.ws + WS_H), 1024, (const bf16_t*)(p.ws + WS_WIN), 1024, T_TOK, LDZ, 1024, false,
                                          EpiZ{(bf16_t*)(p.ws + WS_Z), LDZ}, vb0, nvb, smem);
    else if (PH == PH_SCAN) ph_scan(p, l, vb0, nvb, smem);
    else if (PH == PH_DSAPREP) ph_dsaprep(p, l, vb0, nvb);
    else if (PH == PH_DSA) ph_dsa(p, l, vb0, nvb, smem);
    else if (PH == PH_POST) ph_post(p, l, vb0, nvb);
    else if (PH == PH_MERGE) ph_merge(p, vb0, nvb, smem);
    else if (PH == PH_OUT) gemm_phase((const bf16_t*)(p.ws + WS_H), 1024, (const bf16_t*)(p.ws + WS_WOUT), 1024, T_TOK, 1024, 1024, false,
                                      EpiOut{xin, p.out, (const float*)(p.ws + WS_MOD) + (size_t)l * 8 * 6144}, vb0, nvb, smem);
    else if (PH == PH_NORM2) ph_norm(p, l, 1, p.out, vb0, nvb);
    else if (PH == PH_GEMM_Q) gemm_phase((const bf16_t*)(p.ws + WS_H), 1024, (const bf16_t*)(p.ws + WS_WQ), 1024, T_TOK, 2048, 1024, false,
                                         EpiZ{(bf16_t*)(p.ws + WS_QP), 2048}, vb0, nvb, smem);
    else if (PH == PH_GEMM_SC) gemm_phase((const bf16_t*)(p.ws + WS_QP), 2048, (const bf16_t*)(p.ws + WS_SK), 128, T_TOK, 2048, 128, true,
                                          EpiF32{(float*)(p.ws + WS_SC), 2048}, vb0, nvb, smem);
    else if (PH == PH_ROUTE) ph_route(p, vb0, nvb);
    else if (PH == PH_GATHER) ph_gather(p, l, vb0, nvb);
}

template <int PH>
__global__ void __launch_bounds__(NT) k_phase(Params p, int l) {
    extern __shared__ __attribute__((aligned(16))) char smem[];
    run_phase<PH>(p, l, (int)blockIdx.x, (int)gridDim.x, smem);
}

constexpr int LDS_BYTES = 65536;

#define XB_TMO      128
#define XB_XCNT(j)  (256  + 64 * (j))
#define XB_XSUB(j)  (1280 + 64 * (j))
#define XB_XGEN(j)  (2304 + 64 * (j))
#define XB_TOP      3328
#define XB_TOPGEN   3392
#define XCD_BAR_WORDS 3456
#define XB_SPIN_CAP (1u << 18)
#define LAS __attribute__((address_space(3)))
__device__ __forceinline__ unsigned xb_ld(unsigned* p)              { return __hip_atomic_load(p, __ATOMIC_RELAXED, __HIP_MEMORY_SCOPE_AGENT); }
__device__ __forceinline__ unsigned xb_add(unsigned* p, unsigned v) { return __hip_atomic_fetch_add(p, v, __ATOMIC_RELAXED, __HIP_MEMORY_SCOPE_AGENT); }
__device__ __forceinline__ unsigned xb_xcc_id() { return (unsigned)__builtin_amdgcn_s_getreg((3 << 11) | 20) & 0xFu; }
#define XB_SPIN(cond, bar) do { unsigned _sp = 0; while (cond) { __builtin_amdgcn_s_sleep(1); \
    if ((++_sp & 255u) == 0u) { if (xb_ld(&(bar)[XB_TMO])) break; if (_sp > XB_SPIN_CAP) { atomicAdd(&(bar)[XB_TMO], 1u); break; } } } } while (0)
struct XcdBarrier { unsigned* bar; unsigned x; volatile LAS unsigned* st; };
__device__ __forceinline__ XcdBarrier xcd_barrier_post(unsigned* bar, volatile LAS unsigned* st) {
    XcdBarrier b; b.bar = bar; b.x = xb_xcc_id(); b.st = st;
    if (threadIdx.x == 0) (void)xb_add(&bar[XB_XCNT(b.x)], 1u);
    return b;
}
__device__ __forceinline__ void xcd_barrier_complete(unsigned* bar, unsigned x, unsigned& nloc, unsigned& nx) {
    const unsigned G = gridDim.x * gridDim.y * gridDim.z;
    unsigned sum, cnt, mine, sp = 0u;
    for (;;) {
        sum = 0u; cnt = 0u; mine = 0u;
#pragma unroll
        for (unsigned j = 0; j < 16; ++j) { const unsigned c = xb_ld(&bar[XB_XCNT(j)]); sum += c; cnt += (c > 0u) ? 1u : 0u; mine = (j == x) ? c : mine; }
        if (sum == G) break;
        __builtin_amdgcn_s_sleep(1);
        if ((++sp & 255u) == 0u) { if (xb_ld(&bar[XB_TMO])) break; if (sp > XB_SPIN_CAP) { atomicAdd(&bar[XB_TMO], 1u); break; } }
    }
    nloc = mine > 0u ? mine : 1u; nx = cnt > 0u ? cnt : 1u;
}
__device__ __forceinline__ void xcd_barrier(const XcdBarrier& b) {
    asm volatile("s_waitcnt vmcnt(0)" ::: "memory");
    __syncthreads();
    if (threadIdx.x == 0) {
        unsigned* bar = b.bar;
        __builtin_amdgcn_s_waitcnt(0);
        unsigned nloc = b.st[0], nx = b.st[1];
        if (nloc == 0u) { xcd_barrier_complete(bar, b.x, nloc, nx); b.st[0] = nloc; b.st[1] = nx; }
        const unsigned old = xb_add(&bar[XB_XSUB(b.x)], 1u);
        const unsigned gen = old / nloc;
        if (old + 1u == (gen + 1u) * nloc) {
            __builtin_amdgcn_fence(__ATOMIC_RELEASE, "agent");
            asm volatile("s_waitcnt vmcnt(0)" ::: "memory");
            const unsigned og = xb_add(&bar[XB_TOP], 1u);
            const unsigned tg = og / nx;
            if (og + 1u == (tg + 1u) * nx) xb_add(&bar[XB_TOPGEN], 1u);
            else XB_SPIN(xb_ld(&bar[XB_TOPGEN]) == tg, bar);
            __builtin_amdgcn_fence(__ATOMIC_ACQUIRE, "agent");
            xb_add(&bar[XB_XGEN(b.x)], 1u);
            asm volatile("s_waitcnt vmcnt(0)" ::: "memory");
        } else {
            XB_SPIN(xb_ld(&bar[XB_XGEN(b.x)]) == gen, bar);
            __builtin_amdgcn_fence(__ATOMIC_ACQUIRE, "agent");
            asm volatile("s_waitcnt vmcnt(0)" ::: "memory");
        }
    }
    __syncthreads();
}

__global__ void __launch_bounds__(NT) mega_kernel(Params p) {
    extern __shared__ __attribute__((aligned(16))) char smem[];
    volatile LAS unsigned* st = (volatile LAS unsigned*)(smem + LDS_BYTES - 16);
    if (threadIdx.x < 4) st[threadIdx.x] = 0u;
    __syncthreads();
    XcdBarrier bar = xcd_barrier_post((unsigned*)(p.ws + WS_CTL), st);
    const int vb = (int)blockIdx.x, nvb = (int)gridDim.x;
#define GB() xcd_barrier(bar)
#define RUN(PH, L) do { int _l = (L), _vb = vb, _nvb = nvb; asm volatile("" : "+s"(_l), "+s"(_vb), "+s"(_nvb)); run_phase<PH>(p, _l, _vb, _nvb, smem); } while (0)
    RUN(PH_MOD, 0);
#pragma unroll 1
    for (int l = 0; l < 2; ++l) {
        RUN(PH_WPREP, l); GB();
        RUN(PH_NORM1, l); GB();
        RUN(PH_GEMM_IN, l); GB();
        RUN(PH_SCAN, l);
        RUN(PH_DSAPREP, l); GB();
        RUN(PH_DSA, l);
        RUN(PH_POST, l); GB();
        RUN(PH_MERGE, l); GB();
        RUN(PH_OUT, l); GB();
        RUN(PH_NORM2, l); GB();
        RUN(PH_GEMM_Q, l); GB();
        RUN(PH_GEMM_SC, l); GB();
        RUN(PH_ROUTE, l); GB();
        RUN(PH_GATHER, l);
        if (l == 0) GB();
    }
#undef RUN
#undef GB
}

extern "C" void kernel_launch(void* const* d_in, const int* in_sizes, int n_in, void* d_out, int out_size, void* d_ws, size_t ws_size,
                              hipStream_t stream) {
    if (n_in != 20 || ws_size < WS_END) { fprintf(stderr, "kernel_launch: bad inputs (n_in %d ws %zu need %zu)\n", n_in, ws_size, (size_t)WS_END); return; }
    Params p{};
    p.x = (const float*)d_in[0]; p.c = (const float*)d_in[1]; p.w_ada = (const float*)d_in[2]; p.b_ada = (const float*)d_in[3];
    p.norm_mix = (const float*)d_in[4]; p.norm_ffn = (const float*)d_in[5]; p.w_in = (const float*)d_in[6]; p.hgrn_lb = (const float*)d_in[7];
    p.hgrn_on = (const float*)d_in[8]; p.dsa_qn = (const float*)d_in[9]; p.dsa_kn = (const float*)d_in[10]; p.gla_up = (const float*)d_in[11];
    p.gla_bias = (const float*)d_in[12]; p.gla_on = (const float*)d_in[13]; p.w_branch = (const float*)d_in[14]; p.w_out = (const float*)d_in[15];
    p.peer_wq = (const float*)d_in[16]; p.peer_keys = (const float*)d_in[17]; p.peer_u = (const float*)d_in[18]; p.peer_v = (const float*)d_in[19];
    p.out = (float*)d_out; p.ws = (unsigned char*)d_ws;
#if MEGA
    static int grid = 0;
    if (grid == 0) {
        int dev = 0, cus = 0, per_cu = 0;
        hipGetDevice(&dev);
        hipDeviceGetAttribute(&cus, hipDeviceAttributeMultiprocessorCount, dev);
        hipFuncSetAttribute((const void*)mega_kernel, hipFuncAttributeMaxDynamicSharedMemorySize, LDS_BYTES);
        hipOccupancyMaxActiveBlocksPerMultiprocessor(&per_cu, (const void*)mega_kernel, NT, LDS_BYTES);
        if (per_cu < 1) { fprintf(stderr, "kernel_launch: occupancy query says %d blocks per CU\n", per_cu); per_cu = 1; }
        (void)hipGetLastError();
        grid = cus;
    }
    hipMemsetAsync((char*)d_ws + WS_CTL, 0, 16384, stream);
    void* args[] = {&p};
    hipError_t e = hipLaunchCooperativeKernel((const void*)mega_kernel, dim3(grid), dim3(NT), args, LDS_BYTES, stream);
    if (e != hipSuccess) fprintf(stderr, "cooperative launch failed: %s (grid %d)\n", hipGetErrorString(e), grid);
#else
    const int G = 256;
#define LAUNCH(PH, l) hipLaunchKernelGGL(k_phase<PH>, dim3(G), dim3(NT), LDS_BYTES, stream, p, l)
    LAUNCH(PH_MOD, 0);
    for (int l = 0; l < 2; ++l) {
        LAUNCH(PH_WPREP, l);
        LAUNCH(PH_NORM1, l);
        LAUNCH(PH_GEMM_IN, l);
        LAUNCH(PH_SCAN, l);
        LAUNCH(PH_DSAPREP, l);
        LAUNCH(PH_DSA, l);
        LAUNCH(PH_POST, l);
        LAUNCH(PH_MERGE, l);
        LAUNCH(PH_OUT, l);
        LAUNCH(PH_NORM2, l);
        LAUNCH(PH_GEMM_Q, l);
        LAUNCH(PH_GEMM_SC, l);
        LAUNCH(PH_ROUTE, l);
        LAUNCH(PH_GATHER, l);
    }
#endif
}
```

```cpp
#include <hip/hip_runtime.h>
#include <stdint.h>
#include <stdio.h>

#ifndef MEGA
#define MEGA 1
#endif

typedef unsigned short bf16_t;
typedef short bf16x8 __attribute__((ext_vector_type(8)));
typedef float f32x4 __attribute__((ext_vector_type(4)));
typedef unsigned u32x4 __attribute__((ext_vector_type(4)));

#define NT 512
constexpr int T_TOK = 16384, DM = 1024, SEQ = 2048;
constexpr int LDZ = 8576;
constexpr int ZA_Q = 0, ZA_F = 512, ZA_I = 1024, ZA_G = 1536, ZB_Q = 2048, ZB_K = 2560, ZB_V = 3072, ZC_V = 3584, ZC_G = 4096,
              ZB_QI = 4608, ZC_Q = 4864, ZC_K = 5120, ZB_KI = 5376, ZB_WI = 5440, ZC_CODE = 5444, ZM = 5504;
constexpr int IN_COLS = 8532;

constexpr size_t al256(size_t x) { return (x + 255) & ~(size_t)255; }
constexpr size_t WS_CTL = 0;
constexpr size_t WS_MOD = 65536;
constexpr size_t WS_WIN = al256(WS_MOD + (size_t)2 * 8 * 6144 * 4);
constexpr size_t WS_WBR = al256(WS_WIN + (size_t)LDZ * 1024 * 2);
constexpr size_t WS_WOUT = al256(WS_WBR + (size_t)3 * 1024 * 512 * 2);
constexpr size_t WS_WQ = al256(WS_WOUT + (size_t)1024 * 1024 * 2);
constexpr size_t WS_SK = al256(WS_WQ + (size_t)2048 * 1024 * 2);
constexpr size_t WS_PU = al256(WS_SK + (size_t)16 * 128 * 128 * 2);
constexpr size_t WS_PV = al256(WS_PU + (size_t)16384 * 1024);
constexpr size_t WS_H = al256(WS_PV + (size_t)16384 * 1024);
constexpr float PU_SCALE = 32.f, PV_SCALE = 4.f;
constexpr size_t WS_OA = al256(WS_H + (size_t)T_TOK * 1024 * 2);
constexpr size_t WS_OC = al256(WS_OA + (size_t)T_TOK * 512 * 2);
constexpr size_t WS_Y = al256(WS_OC + (size_t)T_TOK * 512 * 2);
constexpr size_t WS_Z = al256(WS_Y + (size_t)T_TOK * 1536 * 2);
constexpr size_t WS_VT = al256(WS_Z + (size_t)T_TOK * LDZ * 2);
constexpr size_t WS_BM = al256(WS_VT + (size_t)T_TOK * 512 * 2);
constexpr size_t WS_END = al256(WS_BM + (size_t)T_TOK * 64 * 4);
constexpr size_t WS_QP = WS_Z;
constexpr size_t WS_SC = al256(WS_QP + (size_t)T_TOK * 2048 * 2);
constexpr size_t WS_RI = al256(WS_SC + (size_t)T_TOK * 2048 * 4);
constexpr size_t WS_RG = al256(WS_RI + (size_t)T_TOK * 128 * 4);
static_assert(WS_RG + (size_t)T_TOK * 128 * 4 <= WS_END, "peer alias overflow");

struct Params {
    const float* x; const float* c; const float* w_ada; const float* b_ada; const float* norm_mix; const float* norm_ffn;
    const float* w_in; const float* hgrn_lb; const float* hgrn_on; const float* dsa_qn; const float* dsa_kn;
    const float* gla_up; const float* gla_bias; const float* gla_on; const float* w_branch; const float* w_out;
    const float* peer_wq; const float* peer_keys; const float* peer_u; const float* peer_v;
    float* out; unsigned char* ws;
};

__device__ __forceinline__ float bf2f(bf16_t h) { return __uint_as_float(((unsigned)h) << 16); }
__device__ __forceinline__ float bflo(unsigned u) { return __uint_as_float(u << 16); }
__device__ __forceinline__ float bfhi(unsigned u) { return __uint_as_float(u & 0xffff0000u); }
__device__ __forceinline__ bf16_t f2bf(float f) { unsigned u = __float_as_uint(f); u += 0x7fffu + ((u >> 16) & 1u); return (bf16_t)(u >> 16); }
__device__ __forceinline__ unsigned pack2(float a, float b) { return (unsigned)f2bf(a) | ((unsigned)f2bf(b) << 16); }
__device__ __forceinline__ float wave_sum(float v) { for (int o = 32; o > 0; o >>= 1) v += __shfl_xor(v, o); return v; }
__device__ __forceinline__ float wave_max(float v) { for (int o = 32; o > 0; o >>= 1) v = fmaxf(v, __shfl_xor(v, o)); return v; }
__device__ __forceinline__ int wave_sum_i(int v) { for (int o = 32; o > 0; o >>= 1) v += __shfl_xor(v, o); return v; }
__device__ __forceinline__ float sigm(float x) { return 1.f / (1.f + expf(-x)); }

__device__ __forceinline__ int TIDX() { int t = (int)threadIdx.x; asm volatile("" : "+v"(t)); return t; }

__device__ __forceinline__ int src_col(int j) {
    if (j < 3584) return j;
    if (j < 4096) return j - 3584 + 4420;
    if (j < 4608) return j - 4096 + 4948;
    if (j < 4864) return j - 4608 + 3584;
    if (j < 5120) return j - 4864 + 3908;
    if (j < 5376) return j - 5120 + 4164;
    if (j < 5440) return j - 5376 + 3840;
    if (j < 5444) return j - 5440 + 3904;
    if (j < 5460) return j - 5444 + 4932;
    if (j < 5504) return -1;
    return j - 5504 + 5460;
}

__device__ void ph_mod(const Params& p, int vb0, int nvb, char* smem_) {
    float* sc = (float*)smem_;
    float* mod = (float*)(p.ws + WS_MOD);
    for (int i = TIDX(); i < 8 * 1024; i += NT) { float c = p.c[i]; sc[i] = c / (1.f + expf(-c)); }
    __syncthreads();
    for (int vb = vb0; vb < 24; vb += nvb) {
        int col = vb * 512 + TIDX();
        int l = col / 6144, n = col % 6144;
        const float* w = p.w_ada + (size_t)l * 1024 * 6144 + n;
        float acc[8];
#pragma unroll
        for (int b = 0; b < 8; ++b) acc[b] = 0.f;
#pragma unroll 8
        for (int k = 0; k < 1024; ++k) {
            float wv = w[(size_t)k * 6144];
#pragma unroll
            for (int b = 0; b < 8; ++b) acc[b] += sc[b * 1024 + k] * wv;
        }
        float bias = p.b_ada[l * 6144 + n];
#pragma unroll
        for (int b = 0; b < 8; ++b) mod[(size_t)(l * 8 + b) * 6144 + n] = acc[b] + bias;
    }
    __syncthreads();
}

template <bool MAP>
__device__ void tr_tile(const float* __restrict__ src, int lds_, bf16_t* __restrict__ out, int ldo, int k0, int n0, float* tile) {
    const int tid = TIDX();
#pragma unroll
    for (int i = 0; i < 8; ++i) {
        int kk = (tid >> 6) + 8 * i, nn = tid & 63;
        int scol = MAP ? src_col(n0 + nn) : (n0 + nn);
        float v = (scol >= 0) ? src[(size_t)(k0 + kk) * lds_ + scol] : 0.f;
        tile[kk * 65 + nn] = v;
    }
    __syncthreads();
#pragma unroll
    for (int i = 0; i < 4; ++i) {
        int nn = (tid >> 5) + 16 * i, kk = (tid & 31) * 2;
        unsigned v = pack2(tile[kk * 65 + nn], tile[(kk + 1) * 65 + nn]);
        *(unsigned*)(out + (size_t)(n0 + nn) * ldo + k0 + kk) = v;
    }
    __syncthreads();
}
__device__ void conv_chunk(const float* __restrict__ src, bf16_t* __restrict__ dst, size_t base) {
#pragma unroll
    for (int i = 0; i < 4; ++i) {
        size_t e = base + (size_t)(i * NT + TIDX()) * 8;
        float4 a = *(const float4*)(src + e), b = *(const float4*)(src + e + 4);
        uint4 o; o.x = pack2(a.x, a.y); o.y = pack2(a.z, a.w); o.z = pack2(b.x, b.y); o.w = pack2(b.z, b.w);
        *(uint4*)(dst + e) = o;
    }
}
__device__ void conv_chunk_fp8(const float* __restrict__ src, unsigned char* __restrict__ dst, size_t base, float scale) {
#pragma unroll
    for (int i = 0; i < 4; ++i) {
        size_t e = base + (size_t)(i * NT + TIDX()) * 8;
        float4 a = *(const float4*)(src + e), b = *(const float4*)(src + e + 4);
        int lo = __builtin_amdgcn_cvt_pk_fp8_f32(a.x * scale, a.y * scale, 0, false); lo = __builtin_amdgcn_cvt_pk_fp8_f32(a.z * scale, a.w * scale, lo, true);
        int hi = __builtin_amdgcn_cvt_pk_fp8_f32(b.x * scale, b.y * scale, 0, false); hi = __builtin_amdgcn_cvt_pk_fp8_f32(b.z * scale, b.w * scale, hi, true);
        *(uint2*)(dst + e) = make_uint2((unsigned)lo, (unsigned)hi);
    }
}
__device__ void ph_wprep(const Params& p, int l, int vb0, int nvb, char* smem_) {
    float* tile = (float*)smem_;
    bf16_t* WIN = (bf16_t*)(p.ws + WS_WIN); bf16_t* WBR = (bf16_t*)(p.ws + WS_WBR); bf16_t* WOUT = (bf16_t*)(p.ws + WS_WOUT);
    bf16_t* WQ = (bf16_t*)(p.ws + WS_WQ); bf16_t* SK = (bf16_t*)(p.ws + WS_SK); unsigned char* PU = p.ws + WS_PU; unsigned char* PV = p.ws + WS_PV;
    constexpr int N_WIN = 134 * 16, N_WBR = 3 * 16 * 8, N_WOUT = 16 * 16, N_WQ = 32 * 16, N_SK = 16, N_PU = 1024, N_PV = 1024;
    constexpr int TOTAL = N_WIN + N_WBR + N_WOUT + N_WQ + N_SK + N_PU + N_PV;
    for (int task = vb0; task < TOTAL; task += nvb) {
        int r = task;
        if (r < N_WIN) { int nt = r / 16, kt = r % 16; tr_tile<true>(p.w_in + (size_t)l * 1024 * IN_COLS, IN_COLS, WIN, 1024, kt * 64, nt * 64, tile); continue; }
        r -= N_WIN;
        if (r < N_WBR) { int g = r / 128, rr = r % 128, nt = rr / 8, kt = rr % 8;
            tr_tile<false>(p.w_branch + (size_t)(l * 3 + g) * 512 * 1024, 1024, WBR + (size_t)g * 1024 * 512, 512, kt * 64, nt * 64, tile); continue; }
        r -= N_WBR;
        if (r < N_WOUT) { int nt = r / 16, kt = r % 16; tr_tile<false>(p.w_out + (size_t)l * 1024 * 1024, 1024, WOUT, 1024, kt * 64, nt * 64, tile); continue; }
        r -= N_WOUT;
        if (r < N_WQ) { int nt = r / 16, kt = r % 16; tr_tile<false>(p.peer_wq + (size_t)l * 1024 * 2048, 2048, WQ, 1024, kt * 64, nt * 64, tile); continue; }
        r -= N_WQ;
        if (r < N_SK) { conv_chunk(p.peer_keys + (size_t)l * 16 * 128 * 128, SK, (size_t)r * 16384); continue; }
        r -= N_SK;
        if (r < N_PU) { conv_chunk_fp8(p.peer_u + (size_t)l * 16384 * 1024, PU, (size_t)r * 16384, PU_SCALE); continue; }
        r -= N_PU;
        conv_chunk_fp8(p.peer_v + (size_t)l * 16384 * 1024, PV, (size_t)r * 16384, PV_SCALE);
    }
}

__device__ void ph_norm(const Params& p, int l, int which, const float* xin, int vb0, int nvb) {
    const int wave = TIDX() >> 6, lane = TIDX() & 63;
    const float* gain = (which ? p.norm_ffn : p.norm_mix) + l * 1024;
    const float* modb = (const float*)(p.ws + WS_MOD);
    bf16_t* H = (bf16_t*)(p.ws + WS_H);
    for (int t = vb0 * 8 + wave; t < T_TOK; t += nvb * 8) {
        int b = t >> 11;
        const float* mod = modb + (size_t)(l * 8 + b) * 6144 + (which ? 3072 : 0);
        const float4* xr = (const float4*)(xin + (size_t)t * 1024);
        float4 v[4]; float ss = 0.f;
#pragma unroll
        for (int i = 0; i < 4; ++i) { v[i] = xr[lane + 64 * i]; ss += v[i].x * v[i].x + v[i].y * v[i].y + v[i].z * v[i].z + v[i].w * v[i].w; }
        ss = wave_sum(ss);
        float rstd = rsqrtf(ss * (1.f / 1024.f) + 1e-6f);
#pragma unroll
        for (int i = 0; i < 4; ++i) {
            int idx = (lane + 64 * i) * 4;
            float4 g = *(const float4*)(gain + idx), sc = *(const float4*)(mod + 1024 + idx), sh = *(const float4*)(mod + idx);
            float h0 = v[i].x * rstd * g.x * (1.f + sc.x) + sh.x, h1 = v[i].y * rstd * g.y * (1.f + sc.y) + sh.y;
            float h2 = v[i].z * rstd * g.z * (1.f + sc.z) + sh.z, h3 = v[i].w * rstd * g.w * (1.f + sc.w) + sh.w;
            uint2 o; o.x = pack2(h0, h1); o.y = pack2(h2, h3);
            *(uint2*)(H + (size_t)t * 1024 + idx) = o;
        }
    }
}

constexpr int GBM = 256, GBN = 128, GBK = 64, GLS = 72;
__device__ __forceinline__ void gemm_tile(const bf16_t* __restrict__ A, int lda, const bf16_t* __restrict__ Bt, int ldb, int K,
                                          int m0, int n0, bf16_t* sA, bf16_t* sB, f32x4 (&acc)[4][4]) {
    const int tid = TIDX(), lane = tid & 63, wave = tid >> 6;
    const int wm = wave >> 1, wn = wave & 1, fr = lane & 15, fq = lane >> 4;
    u32x4 ra[4], rb[2];
    const int crow = tid >> 3, ckc = (tid & 7) * 8;
    const bf16_t* Ag = A + (size_t)(m0 + crow) * lda + ckc;
    const bf16_t* Bg = Bt + (size_t)(n0 + crow) * ldb + ckc;
#pragma unroll
    for (int i = 0; i < 4; ++i) ra[i] = *(const u32x4*)(Ag + (size_t)(64 * i) * lda);
#pragma unroll
    for (int i = 0; i < 2; ++i) rb[i] = *(const u32x4*)(Bg + (size_t)(64 * i) * ldb);
    for (int k0 = 0; k0 < K; k0 += GBK) {
        __syncthreads();
#pragma unroll
        for (int i = 0; i < 4; ++i) *(u32x4*)(sA + (crow + 64 * i) * GLS + ckc) = ra[i];
#pragma unroll
        for (int i = 0; i < 2; ++i) *(u32x4*)(sB + (crow + 64 * i) * GLS + ckc) = rb[i];
        __syncthreads();
        {
            const int kn = (k0 + GBK < K) ? (k0 + GBK) : k0;
#pragma unroll
            for (int i = 0; i < 4; ++i) ra[i] = *(const u32x4*)(Ag + (size_t)(64 * i) * lda + kn);
#pragma unroll
            for (int i = 0; i < 2; ++i) rb[i] = *(const u32x4*)(Bg + (size_t)(64 * i) * ldb + kn);
        }
#pragma unroll
        for (int ks = 0; ks < 2; ++ks) {
            bf16x8 af[4], wf[4];
#pragma unroll
            for (int mf = 0; mf < 4; ++mf) af[mf] = *(const bf16x8*)(sA + (wm * 64 + mf * 16 + fr) * GLS + ks * 32 + fq * 8);
#pragma unroll
            for (int nf = 0; nf < 4; ++nf) wf[nf] = *(const bf16x8*)(sB + (wn * 64 + nf * 16 + fr) * GLS + ks * 32 + fq * 8);
#pragma unroll
            for (int nf = 0; nf < 4; ++nf)
#pragma unroll
                for (int mf = 0; mf < 4; ++mf)
                    acc[nf][mf] = __builtin_amdgcn_mfma_f32_16x16x32_bf16(wf[nf], af[mf], acc[nf][mf], 0, 0, 0);
        }
    }
}

struct EpiZ {
    bf16_t* Z; int ld;
    __device__ __forceinline__ void operator()(int m, int n, const f32x4& v) const {
        uint2 o; o.x = pack2(v[0], v[1]); o.y = pack2(v[2], v[3]);
        *(uint2*)(Z + (size_t)m * ld + n) = o;
    }
};
struct EpiF32 {
    float* C; int ld;
    __device__ __forceinline__ void operator()(int m, int n, const f32x4& v) const {
        *(float4*)(C + (size_t)m * ld + n) = make_float4(v[0], v[1], v[2], v[3]);
    }
};
struct EpiOut {
    const float* xin; float* out; const float* mod;
    __device__ __forceinline__ void operator()(int m, int n, const f32x4& v) const {
        int b = m >> 11;
        float4 g = *(const float4*)(mod + (size_t)b * 6144 + 2048 + n);
        float4 xi = *(const float4*)(xin + (size_t)m * 1024 + n);
        *(float4*)(out + (size_t)m * 1024 + n) = make_float4(xi.x + g.x * v[0], xi.y + g.y * v[1], xi.z + g.z * v[2], xi.w + g.w * v[3]);
    }
};

template <class Epi>
__device__ void gemm_phase(const bf16_t* A, int lda, const bf16_t* Bt, int ldb, int M, int N, int K, bool batched, Epi epi,
                           int vb0, int nvb, char* smem_) {
    bf16_t* sA = (bf16_t*)smem_; bf16_t* sB = sA + GBM * GLS;
    const int lane = TIDX() & 63, wave = TIDX() >> 6, wm = wave >> 1, wn = wave & 1, fr = lane & 15, fq = lane >> 4;
    const int MT = M / GBM, NTL = N / GBN;
    for (int tile = vb0; tile < MT * NTL; tile += nvb) {
        int mt = tile % MT, nt = tile / MT;
        f32x4 acc[4][4];
#pragma unroll
        for (int a = 0; a < 4; ++a)
#pragma unroll
            for (int b = 0; b < 4; ++b) acc[a][b] = f32x4{0.f, 0.f, 0.f, 0.f};
        gemm_tile(batched ? A + nt * 128 : A, lda, Bt, ldb, K, mt * GBM, nt * GBN, sA, sB, acc);
#pragma unroll
        for (int nf = 0; nf < 4; ++nf)
#pragma unroll
            for (int mf = 0; mf < 4; ++mf)
                epi(mt * GBM + wm * 64 + mf * 16 + fr, nt * GBN + wn * 64 + nf * 16 + fq * 4, acc[nf][mf]);
    }
}

__device__ void ph_merge(const Params& p, int vb0, int nvb, char* smem_) {
    bf16_t* sA = (bf16_t*)smem_; bf16_t* sB = sA + GBM * GLS;
    const bf16_t* Y = (const bf16_t*)(p.ws + WS_Y); const bf16_t* WBR = (const bf16_t*)(p.ws + WS_WBR);
    const bf16_t* Z = (const bf16_t*)(p.ws + WS_Z); bf16_t* H = (bf16_t*)(p.ws + WS_H);
    const int lane = TIDX() & 63, wave = TIDX() >> 6, wm = wave >> 1, wn = wave & 1, fr = lane & 15, fq = lane >> 4;
    for (int tile = vb0; tile < 64 * 8; tile += nvb) {
        int mt = tile % 64, nt = tile / 64;
        f32x4 tot[4][4];
#pragma unroll
        for (int a = 0; a < 4; ++a)
#pragma unroll
            for (int b = 0; b < 4; ++b) tot[a][b] = f32x4{0.f, 0.f, 0.f, 0.f};
        for (int g = 0; g < 3; ++g) {
            f32x4 acc[4][4];
#pragma unroll
            for (int a = 0; a < 4; ++a)
#pragma unroll
                for (int b = 0; b < 4; ++b) acc[a][b] = f32x4{0.f, 0.f, 0.f, 0.f};
            gemm_tile(Y + g * 512, 1536, WBR + (size_t)g * 1024 * 512, 512, 512, mt * GBM, nt * GBN, sA, sB, acc);
#pragma unroll
            for (int nf = 0; nf < 4; ++nf)
#pragma unroll
                for (int mf = 0; mf < 4; ++mf) {
                    int m = mt * GBM + wm * 64 + mf * 16 + fr, n = nt * GBN + wn * 64 + nf * 16 + fq * 4;
                    uint2 gz = *(const uint2*)(Z + (size_t)m * LDZ + ZM + g * 1024 + n);
                    tot[nf][mf][0] += sigm(bflo(gz.x)) * acc[nf][mf][0];
                    tot[nf][mf][1] += sigm(bfhi(gz.x)) * acc[nf][mf][1];
                    tot[nf][mf][2] += sigm(bflo(gz.y)) * acc[nf][mf][2];
                    tot[nf][mf][3] += sigm(bfhi(gz.y)) * acc[nf][mf][3];
                }
        }
#pragma unroll
        for (int nf = 0; nf < 4; ++nf)
#pragma unroll
            for (int mf = 0; mf < 4; ++mf) {
                int m = mt * GBM + wm * 64 + mf * 16 + fr, n = nt * GBN + wn * 64 + nf * 16 + fq * 4;
                uint2 o; o.x = pack2(tot[nf][mf][0], tot[nf][mf][1]); o.y = pack2(tot[nf][mf][2], tot[nf][mf][3]);
                *(uint2*)(H + (size_t)m * 1024 + n) = o;
            }
    }
}

template <int DK, bool GLA>
__device__ void scan_item(const Params& p, int l, int item, char* smem_) {
    constexpr int TB = 16, KPT = DK / 32, SSTR = NT / DK;
    const int b = item >> 5, h = (item >> 3) & 3, vs = item & 7;
    const int tid = TIDX(), lane = tid & 63, wave = tid >> 6;
    const int kg = tid >> 4, v = tid & 15;
    float* qs = (float*)smem_; float* fs = qs + TB * DK; float* ks = fs + TB * DK; float* vsm = ks + TB * DK; float* wp = vsm + TB * 16;
    const int kl = tid % DK, step0 = tid / DK;
    float lbv = 0.f, gbias = 0.f; float gu[16];
#pragma unroll
    for (int r = 0; r < 16; ++r) gu[r] = 0.f;
    if (GLA) {
#pragma unroll
        for (int r = 0; r < 16; ++r) gu[r] = p.gla_up[(size_t)(l * 16 + r) * 256 + h * 64 + kl];
        gbias = p.gla_bias[l * 256 + h * 64 + kl];
    } else if (l == 1) {
        float x0 = p.hgrn_lb[h * 128 + kl], x1 = p.hgrn_lb[512 + h * 128 + kl];
        lbv = 1.f / (1.f + expf(x0 - x1));
    }
    const float scale = GLA ? 0.125f : 0.08838834764831845f;
    float s[KPT];
#pragma unroll
    for (int i = 0; i < KPT; ++i) s[i] = 0.f;
    const bf16_t* Zb = (const bf16_t*)(p.ws + WS_Z) + (size_t)(b * 2048) * LDZ;
    bf16_t* OX = (bf16_t*)(p.ws + (GLA ? WS_OC : WS_OA));
    for (int t0 = 0; t0 < 2048; t0 += TB) {
        for (int st = step0; st < TB; st += SSTR) {
            const bf16_t* zr = Zb + (size_t)(t0 + st) * LDZ;
            float q, f, kk;
            if (GLA) {
                float x = gbias;
#pragma unroll
                for (int r = 0; r < 16; ++r) x += bf2f(zr[ZC_CODE + r]) * gu[r];
                float ls = fminf(x, 0.f) - log1pf(expf(-fabsf(x)));
                f = expf(ls * (1.f / 16.f));
                q = bf2f(zr[ZC_Q + h * 64 + kl]) * scale; kk = bf2f(zr[ZC_K + h * 64 + kl]);
            } else {
                float lg = bf2f(zr[ZA_F + h * 128 + kl]);
                f = lbv + (1.f - lbv) * sigm(lg); kk = 1.f - f;
                q = bf2f(zr[ZA_Q + h * 128 + kl]) * scale;
            }
            qs[st * DK + kl] = q; fs[st * DK + kl] = f; ks[st * DK + kl] = kk;
        }
        if (tid < TB * 16) {
            int st = tid >> 4, vv = tid & 15;
            vsm[st * 16 + vv] = bf2f(Zb[(size_t)(t0 + st) * LDZ + (GLA ? ZC_V : ZA_I) + h * 128 + vs * 16 + vv]);
        }
        __syncthreads();
        float po[TB];
#pragma unroll
        for (int st = 0; st < TB; ++st) {
            float vv = vsm[st * 16 + v], a = 0.f;
#pragma unroll
            for (int i = 0; i < KPT; ++i) {
                int k = kg * KPT + i;
                s[i] = fs[st * DK + k] * s[i] + ks[st * DK + k] * vv;
                a += qs[st * DK + k] * s[i];
            }
            a += __shfl_xor(a, 16); a += __shfl_xor(a, 32);
            po[st] = a;
        }
        if (lane < 16) {
#pragma unroll
            for (int st = 0; st < TB; ++st) wp[(wave * TB + st) * 16 + lane] = po[st];
        }
        __syncthreads();
        if (tid < TB * 16) {
            int st = tid >> 4, vv = tid & 15; float o = 0.f;
#pragma unroll
            for (int w = 0; w < 8; ++w) o += wp[(w * TB + st) * 16 + vv];
            OX[(size_t)(b * 2048 + t0 + st) * 512 + h * 128 + vs * 16 + vv] = f2bf(o);
        }
        __syncthreads();
    }
}
__device__ void ph_scan(const Params& p, int l, int vb0, int nvb, char* smem_) {
    for (int item = vb0; item < 512; item += nvb) {
        if (item < 256) scan_item<128, false>(p, l, item, smem_);
        else scan_item<64, true>(p, l, item - 256, smem_);
    }
}

__device__ void ph_dsaprep(const Params& p, int l, int vb0, int nvb) {
    const int wave = TIDX() >> 6, lane = TIDX() & 63;
    bf16_t* Z = (bf16_t*)(p.ws + WS_Z);
    for (int t = vb0 * 8 + wave; t < T_TOK; t += nvb * 8) {
#pragma unroll
        for (int grp = 0; grp < 8; ++grp) {
            bf16_t* ptr = Z + (size_t)t * LDZ + (grp < 4 ? ZB_Q : ZB_K) + (grp & 3) * 128 + lane * 2;
            unsigned u = *(unsigned*)ptr;
            float a = bflo(u), b = bfhi(u);
            float ss = wave_sum(a * a + b * b);
            float r = rsqrtf(ss * (1.f / 128.f) + 1e-6f);
            const float* gn = (grp < 4 ? p.dsa_qn : p.dsa_kn) + l * 128 + lane * 2;
            float sc = (grp < 4) ? 0.08838834764831845f : 1.f;
            *(unsigned*)ptr = pack2(a * r * gn[0] * sc, b * r * gn[1] * sc);
        }
    }
}

__device__ void ph_post(const Params& p, int l, int vb0, int nvb) {
    const int wave = TIDX() >> 6, lane = TIDX() & 63;
    const bf16_t* Z = (const bf16_t*)(p.ws + WS_Z);
    const bf16_t* OA = (const bf16_t*)(p.ws + WS_OA); const bf16_t* OC = (const bf16_t*)(p.ws + WS_OC);
    bf16_t* Y = (bf16_t*)(p.ws + WS_Y);
    for (int t = vb0 * 8 + wave; t < T_TOK; t += nvb * 8) {
#pragma unroll
        for (int grp = 0; grp < 8; ++grp) {
            const int hh = grp & 3;
            unsigned u = *(const unsigned*)((grp < 4 ? OA : OC) + (size_t)t * 512 + hh * 128 + lane * 2);
            float a = bflo(u), b = bfhi(u);
            float ss = wave_sum(a * a + b * b);
            float r = rsqrtf(ss * (1.f / 128.f) + 1e-6f);
            const float* gn = (grp < 4 ? p.hgrn_on : p.gla_on) + l * 128 + lane * 2;
            unsigned gz = *(const unsigned*)(Z + (size_t)t * LDZ + (grp < 4 ? ZA_G : ZC_G) + hh * 128 + lane * 2);
            float g0 = bflo(gz), g1 = bfhi(gz);
            float y0 = a * r * gn[0] * (g0 * sigm(g0)), y1 = b * r * gn[1] * (g1 * sigm(g1));
            *(unsigned*)(Y + (size_t)t * 1536 + (grp < 4 ? 0 : 1024) + hh * 128 + lane * 2) = pack2(y0, y1);
        }
    }
}

__device__ void ph_dsa(const Params& p, int l, int vb0, int nvb, char* smem_) {
    float* qi = (float*)smem_;
    float* qn = qi + 256;
    float* wv = qn + 512;
    int* sel = (int*)(wv + 16);
    float* pr = (float*)(sel + 256);
    int* red = (int*)(pr + 1024);
    int* cnt = red + 16;
    const int tid = TIDX(), lane = tid & 63, wave = tid >> 6;
    const bf16_t* Z = (const bf16_t*)(p.ws + WS_Z);
    bf16_t* Y = (bf16_t*)(p.ws + WS_Y);
    const unsigned long long lt_mask = (lane == 0) ? 0ull : (~0ull >> (64 - lane));
    for (int t = vb0; t < T_TOK; t += nvb) {
        const int b = t >> 11, tl = t & 2047, n = tl + 1;
        const bf16_t* zr = Z + (size_t)t * LDZ;
        if (tid < 256) qi[tid] = bf2f(zr[ZB_QI + tid]);
        qn[tid] = bf2f(zr[ZB_Q + tid]);
        if (tid < 4) wv[tid] = bf2f(zr[ZB_WI + tid]) * 0.5f;
        __syncthreads();
        const bf16_t* Zb = Z + (size_t)(b * 2048) * LDZ;
        unsigned mk[4];
#pragma unroll
        for (int i = 0; i < 4; ++i) {
            int s = tid + i * 512; unsigned key = 0u;
            if (s < n) {
                const uint4* kp = (const uint4*)(Zb + (size_t)s * LDZ + ZB_KI);
                float d0 = 0.f, d1 = 0.f, d2 = 0.f, d3 = 0.f;
#pragma unroll
                for (int c = 0; c < 8; ++c) {
                    uint4 u = kp[c];
                    float x[8] = {bflo(u.x), bfhi(u.x), bflo(u.y), bfhi(u.y), bflo(u.z), bfhi(u.z), bflo(u.w), bfhi(u.w)};
#pragma unroll
                    for (int j = 0; j < 8; ++j) {
                        d0 += x[j] * qi[c * 8 + j]; d1 += x[j] * qi[64 + c * 8 + j];
                        d2 += x[j] * qi[128 + c * 8 + j]; d3 += x[j] * qi[192 + c * 8 + j];
                    }
                }
                float sc = wv[0] * fmaxf(d0 * 0.125f, 0.f) + wv[1] * fmaxf(d1 * 0.125f, 0.f) + wv[2] * fmaxf(d2 * 0.125f, 0.f) + wv[3] * fmaxf(d3 * 0.125f, 0.f);
                if (sc == 0.f) sc = 0.f;
                unsigned u = __float_as_uint(sc);
                key = (u & 0x80000000u) ? ~u : (u | 0x80000000u);
            }
            mk[i] = key;
        }
        if (n > 256) {
            unsigned T = 0u;
            for (int bit = 31; bit >= 0; --bit) {
                unsigned cand = T | (1u << bit);
                int c = (mk[0] >= cand) + (mk[1] >= cand) + (mk[2] >= cand) + (mk[3] >= cand);
                c = wave_sum_i(c);
                if (lane == 0) red[(bit & 1) * 8 + wave] = c;
                __syncthreads();
                int tot = 0;
#pragma unroll
                for (int w = 0; w < 8; ++w) tot += red[(bit & 1) * 8 + w];
                if (tot >= 256) T = cand;
            }
            unsigned long long beq[4], bgt[4];
#pragma unroll
            for (int i = 0; i < 4; ++i) { beq[i] = __ballot(mk[i] == T); bgt[i] = __ballot(mk[i] > T); }
            __syncthreads();
            if (lane == 0) {
#pragma unroll
                for (int i = 0; i < 4; ++i) { cnt[i * 8 + wave] = __popcll(beq[i]); cnt[32 + i * 8 + wave] = __popcll(bgt[i]); }
            }
            __syncthreads();
            int cgt = 0;
#pragma unroll
            for (int j = 0; j < 32; ++j) cgt += cnt[32 + j];
            const int need = 256 - cgt;
            int eqbase = 0;
            unsigned long long bsel[4];
#pragma unroll
            for (int i = 0; i < 4; ++i) {
                int before = eqbase;
#pragma unroll
                for (int w = 0; w < 8; ++w) { int cw = cnt[i * 8 + w]; if (w < wave) before += cw; eqbase += cw; }
                int rank = before + __popcll(beq[i] & lt_mask);
                bool s_ = (mk[i] > T) || ((mk[i] == T) && rank < need);
                bsel[i] = __ballot(s_);
            }
            __syncthreads();
            if (lane == 0) {
#pragma unroll
                for (int i = 0; i < 4; ++i) cnt[i * 8 + wave] = __popcll(bsel[i]);
            }
            __syncthreads();
            int sbase = 0;
#pragma unroll
            for (int i = 0; i < 4; ++i) {
                int before = sbase;
#pragma unroll
                for (int w = 0; w < 8; ++w) { int cw = cnt[i * 8 + w]; if (w < wave) before += cw; sbase += cw; }
                if ((bsel[i] >> lane) & 1ull) { int pos = before + __popcll(bsel[i] & lt_mask); if (pos < 256) sel[pos] = tid + i * 512; }
            }
        } else {
            if (tid < n) sel[tid] = tid;
        }
        const int m = n < 256 ? n : 256;
        __syncthreads();
        {
            int j = tid >> 1, hh = tid & 1;
            if (j < m) {
                const uint4* kr = (const uint4*)(Zb + (size_t)sel[j] * LDZ + ZB_K + hh * 256);
                float d0 = 0.f, d1 = 0.f;
#pragma unroll
                for (int c = 0; c < 16; ++c) {
                    uint4 u = kr[c]; const float* q = qn + hh * 256 + c * 8;
                    d0 += bflo(u.x) * q[0] + bfhi(u.x) * q[1] + bflo(u.y) * q[2] + bfhi(u.y) * q[3] + bflo(u.z) * q[4] + bfhi(u.z) * q[5] + bflo(u.w) * q[6] + bfhi(u.w) * q[7];
                }
#pragma unroll
                for (int c = 16; c < 32; ++c) {
                    uint4 u = kr[c]; const float* q = qn + hh * 256 + c * 8;
                    d1 += bflo(u.x) * q[0] + bfhi(u.x) * q[1] + bflo(u.y) * q[2] + bfhi(u.y) * q[3] + bflo(u.z) * q[4] + bfhi(u.z) * q[5] + bflo(u.w) * q[6] + bfhi(u.w) * q[7];
                }
                pr[(2 * hh) * 256 + j] = d0; pr[(2 * hh + 1) * 256 + j] = d1;
            }
        }
        __syncthreads();
        if (wave < 4) {
            float xv[4]; float mx = -INFINITY;
#pragma unroll
            for (int i = 0; i < 4; ++i) { int j = lane + 64 * i; xv[i] = (j < m) ? pr[wave * 256 + j] : -INFINITY; mx = fmaxf(mx, xv[i]); }
            mx = wave_max(mx);
            float sm = 0.f;
#pragma unroll
            for (int i = 0; i < 4; ++i) { xv[i] = expf(xv[i] - mx); sm += xv[i]; }
            sm = wave_sum(sm);
            float inv = 1.f / sm;
#pragma unroll
            for (int i = 0; i < 4; ++i) { int j = lane + 64 * i; pr[wave * 256 + j] = xv[i] * inv; }
        }
        __syncthreads();
        {
            const int d = tid, hd = d >> 7;
            float o = 0.f;
            const bf16_t* vb = Zb + ZB_V + d;
#pragma unroll 8
            for (int j = 0; j < m; ++j) o += pr[hd * 256 + j] * bf2f(vb[(size_t)sel[j] * LDZ]);
            Y[(size_t)t * 1536 + 512 + d] = f2bf(o);
        }
        __syncthreads();
    }
}


__device__ void ph_dsaprep2(const Params& p, int l, int vb0, int nvb, char* smem_) {
    bf16_t* tile = (bf16_t*)smem_;
    const int tid = TIDX(), lane = tid & 63, wave = tid >> 6;
    bf16_t* Z = (bf16_t*)(p.ws + WS_Z); bf16_t* VT = (bf16_t*)(p.ws + WS_VT);
    for (int item = vb0; item < 512; item += nvb) {
        const int tb = item * 32;
        for (int tt = wave; tt < 32; tt += 8) {
            const int t = tb + tt;
#pragma unroll
            for (int grp = 0; grp < 8; ++grp) {
                bf16_t* ptr = Z + (size_t)t * LDZ + (grp < 4 ? ZB_Q : ZB_K) + (grp & 3) * 128 + lane * 2;
                unsigned u = *(unsigned*)ptr;
                float a = bflo(u), b = bfhi(u);
                float ss = wave_sum(a * a + b * b);
                float r = rsqrtf(ss * (1.f / 128.f) + 1e-6f);
                const float* gn = (grp < 4 ? p.dsa_qn : p.dsa_kn) + l * 128 + lane * 2;
                float sc = (grp < 4) ? 0.08838834764831845f : 1.f;
                *(unsigned*)ptr = pack2(a * r * gn[0] * sc, b * r * gn[1] * sc);
            }
        }
#pragma unroll
        for (int i = 0; i < 4; ++i) {
            int ch = tid + i * 512, t = ch >> 6, c8 = (ch & 63) * 8;
            uint4 u = *(const uint4*)(Z + (size_t)(tb + t) * LDZ + ZB_V + c8);
            unsigned* d = (unsigned*)(tile + t * 514 + c8);
            d[0] = u.x; d[1] = u.y; d[2] = u.z; d[3] = u.w;
        }
        __syncthreads();
        {
            const int c = tid, b = tb >> 11, s0 = tb & 2047;
            unsigned w[16];
#pragma unroll
            for (int j = 0; j < 16; ++j) w[j] = (unsigned)tile[(2 * j) * 514 + c] | ((unsigned)tile[(2 * j + 1) * 514 + c] << 16);
            uint4* dst = (uint4*)(VT + ((size_t)(b * 512 + c)) * 2048 + s0);
            dst[0] = make_uint4(w[0], w[1], w[2], w[3]); dst[1] = make_uint4(w[4], w[5], w[6], w[7]);
            dst[2] = make_uint4(w[8], w[9], w[10], w[11]); dst[3] = make_uint4(w[12], w[13], w[14], w[15]);
        }
        __syncthreads();
    }
}

__device__ void ph_dsa_select(const Params& p, int vb0, int nvb, char* smem_) {
    int* red = (int*)smem_;
    const int tid = TIDX(), lane = tid & 63, wave = __builtin_amdgcn_readfirstlane(tid >> 6), fr = lane & 15, fq = lane >> 4;
    const bf16_t* Z = (const bf16_t*)(p.ws + WS_Z);
    unsigned short* BMh = (unsigned short*)(p.ws + WS_BM);
    int it = 0;
    for (int q = vb0; q < 1024; q += nvb, ++it) {
        const int b = q >> 7; int tq = q & 127; if (it & 1) tq = 127 - tq;
        const int t0 = tq * 16, tl = t0 + fr;
        const size_t trow = (size_t)b * 2048 + tl;
        bf16x8 qf[4][2];
#pragma unroll
        for (int h = 0; h < 4; ++h)
#pragma unroll
            for (int ks = 0; ks < 2; ++ks) qf[h][ks] = *(const bf16x8*)(Z + trow * LDZ + ZB_QI + h * 64 + ks * 32 + fq * 8);
        float w[4];
#pragma unroll
        for (int h = 0; h < 4; ++h) w[h] = bf2f(Z[trow * LDZ + ZB_WI + h]) * 0.5f;
        unsigned key[64];
#pragma unroll
        for (int i = 0; i < 16; ++i) {
            const int kt = wave + 8 * i;
            if (kt <= tq) {
                const bf16_t* kr = Z + ((size_t)b * 2048 + kt * 16 + fr) * LDZ + ZB_KI + fq * 8;
                bf16x8 k0 = *(const bf16x8*)kr, k1 = *(const bf16x8*)(kr + 32);
                f32x4 acc[4];
#pragma unroll
                for (int h = 0; h < 4; ++h) {
                    acc[h] = __builtin_amdgcn_mfma_f32_16x16x32_bf16(k0, qf[h][0], f32x4{0.f, 0.f, 0.f, 0.f}, 0, 0, 0);
                    acc[h] = __builtin_amdgcn_mfma_f32_16x16x32_bf16(k1, qf[h][1], acc[h], 0, 0, 0);
                }
#pragma unroll
                for (int r = 0; r < 4; ++r) {
                    float sc = w[0] * fmaxf(acc[0][r] * 0.125f, 0.f) + w[1] * fmaxf(acc[1][r] * 0.125f, 0.f) + w[2] * fmaxf(acc[2][r] * 0.125f, 0.f) + w[3] * fmaxf(acc[3][r] * 0.125f, 0.f);
                    if (sc == 0.f) sc = 0.f;
                    unsigned u = __float_as_uint(sc);
                    unsigned k = (u & 0x80000000u) ? ~u : (u | 0x80000000u);
                    const int s = kt * 16 + 4 * fq + r;
                    key[i * 4 + r] = (s <= tl) ? k : 0u;
                }
            } else {
#pragma unroll
                for (int r = 0; r < 4; ++r) key[i * 4 + r] = 0u;
            }
        }
        unsigned T = 1u; int C = 2047;
        if (t0 >= 256) {
            int ph = 0;
            T = 0u;
            for (int bit = 31; bit >= 0; --bit, ++ph) {
                const unsigned cand = T | (1u << bit);
                int c = 0;
#pragma unroll
                for (int j = 0; j < 64; ++j) c += (key[j] >= cand) ? 1 : 0;
                c += __shfl_xor(c, 16); c += __shfl_xor(c, 32);
                if (fq == 0) red[((ph & 1) * 8 + wave) * 16 + fr] = c;
                __syncthreads();
                int tot = 0;
#pragma unroll
                for (int wv_ = 0; wv_ < 8; ++wv_) tot += red[((ph & 1) * 8 + wv_) * 16 + fr];
                if (tot >= 256) T = cand;
            }
            int need;
            {
                int c = 0;
#pragma unroll
                for (int j = 0; j < 64; ++j) c += (key[j] > T) ? 1 : 0;
                c += __shfl_xor(c, 16); c += __shfl_xor(c, 32);
                if (fq == 0) red[((ph & 1) * 8 + wave) * 16 + fr] = c;
                __syncthreads();
                int tot = 0;
#pragma unroll
                for (int wv_ = 0; wv_ < 8; ++wv_) tot += red[((ph & 1) * 8 + wv_) * 16 + fr];
                need = 256 - tot; ++ph;
            }
            C = 0;
            for (int bit = 10; bit >= 0; --bit, ++ph) {
                const int cand = C | (1 << bit);
                int c = 0;
#pragma unroll
                for (int j = 0; j < 64; ++j) { const int s = (wave + 8 * (j >> 2)) * 16 + 4 * fq + (j & 3); c += (key[j] == T && s < cand) ? 1 : 0; }
                c += __shfl_xor(c, 16); c += __shfl_xor(c, 32);
                if (fq == 0) red[((ph & 1) * 8 + wave) * 16 + fr] = c;
                __syncthreads();
                int tot = 0;
#pragma unroll
                for (int wv_ = 0; wv_ < 8; ++wv_) tot += red[((ph & 1) * 8 + wv_) * 16 + fr];
                if (tot < need) C = cand;
            }
        }
#pragma unroll
        for (int i = 0; i < 16; ++i) {
            unsigned nib = 0u;
#pragma unroll
            for (int r = 0; r < 4; ++r) {
                const unsigned k = key[i * 4 + r]; const int s = (wave + 8 * i) * 16 + 4 * fq + r;
                const bool sel = (k > T) || (k == T && s <= C);
                nib |= (sel ? 1u : 0u) << (4 * fq + r);
            }
            nib |= __shfl_xor(nib, 16); nib |= __shfl_xor(nib, 32);
            if (fq == 0) BMh[trow * 128 + wave + 8 * i] = (unsigned short)nib;
        }
        __syncthreads();
    }
}

__device__ void ph_dsa_attn(const Params& p, int vb0, int nvb) {
    const int tid = TIDX(), lane = tid & 63, wave = __builtin_amdgcn_readfirstlane(tid >> 6), fr = lane & 15, fq = lane >> 4;
    const bf16_t* Z = (const bf16_t*)(p.ws + WS_Z); const bf16_t* VT = (const bf16_t*)(p.ws + WS_VT);
    const unsigned* BM = (const unsigned*)(p.ws + WS_BM); bf16_t* Y = (bf16_t*)(p.ws + WS_Y);
    int it = 0;
    for (int item = vb0; item < 512; item += nvb, ++it) {
        const int b = item >> 6, h = (item >> 4) & 3; int qg = item & 15; if (it & 1) qg = 15 - qg;
        const int t0 = qg * 128 + wave * 16;
        const size_t trow = (size_t)b * 2048 + t0 + fr;
        bf16x8 qf[4];
#pragma unroll
        for (int ks = 0; ks < 4; ++ks) qf[ks] = *(const bf16x8*)(Z + trow * LDZ + ZB_Q + h * 128 + ks * 32 + fq * 8);
        f32x4 o[8];
#pragma unroll
        for (int i = 0; i < 8; ++i) o[i] = f32x4{0.f, 0.f, 0.f, 0.f};
        float m = -INFINITY, lsum = 0.f;
        const unsigned* bmrow = BM + trow * 64;
        const int nsteps = (t0 + 15) / 32 + 1;
        const bf16_t* kbase = Z + ((size_t)b * 2048 + fr) * LDZ + ZB_K + h * 128 + fq * 8;
        const bf16_t* vbase = VT + ((size_t)(b * 4 + h) * 128 + fr) * 2048 + 4 * fq;
        for (int st = 0; st < nsteps; ++st) {
            const int s0 = st * 32;
            f32x4 sa = f32x4{0.f, 0.f, 0.f, 0.f}, sb = f32x4{0.f, 0.f, 0.f, 0.f};
            const bf16_t* ka = kbase + (size_t)s0 * LDZ;
            const bf16_t* kb = ka + (size_t)16 * LDZ;
#pragma unroll
            for (int ks = 0; ks < 4; ++ks) {
                bf16x8 fa = *(const bf16x8*)(ka + ks * 32), fb = *(const bf16x8*)(kb + ks * 32);
                sa = __builtin_amdgcn_mfma_f32_16x16x32_bf16(fa, qf[ks], sa, 0, 0, 0);
                sb = __builtin_amdgcn_mfma_f32_16x16x32_bf16(fb, qf[ks], sb, 0, 0, 0);
            }
            const unsigned mw = bmrow[st] >> (4 * fq);
            float x[8];
#pragma unroll
            for (int r = 0; r < 4; ++r) { x[r] = ((mw >> r) & 1u) ? sa[r] : -INFINITY; x[4 + r] = ((mw >> (16 + r)) & 1u) ? sb[r] : -INFINITY; }
            float mx = fmaxf(fmaxf(fmaxf(x[0], x[1]), fmaxf(x[2], x[3])), fmaxf(fmaxf(x[4], x[5]), fmaxf(x[6], x[7])));
            mx = fmaxf(mx, __shfl_xor(mx, 16)); mx = fmaxf(mx, __shfl_xor(mx, 32));
            const float mnew = fmaxf(m, mx);
            const float msafe = (mnew == -INFINITY) ? 0.f : mnew;
            const float alpha = __expf(m - msafe);
            float pe[8]; float ps = 0.f;
#pragma unroll
            for (int j = 0; j < 8; ++j) { pe[j] = __expf(x[j] - msafe); ps += pe[j]; }
            lsum = lsum * alpha + ps;
            m = mnew;
#pragma unroll
            for (int i = 0; i < 8; ++i) { o[i][0] *= alpha; o[i][1] *= alpha; o[i][2] *= alpha; o[i][3] *= alpha; }
            union { bf16x8 v; unsigned u[4]; } pf;
            pf.u[0] = pack2(pe[0], pe[1]); pf.u[1] = pack2(pe[2], pe[3]); pf.u[2] = pack2(pe[4], pe[5]); pf.u[3] = pack2(pe[6], pe[7]);
            const bf16_t* vr = vbase + s0;
#pragma unroll
            for (int i = 0; i < 8; ++i) {
                union { bf16x8 v; uint2 u[2]; } vf;
                vf.u[0] = *(const uint2*)(vr + (size_t)(i * 16) * 2048);
                vf.u[1] = *(const uint2*)(vr + (size_t)(i * 16) * 2048 + 16);
                o[i] = __builtin_amdgcn_mfma_f32_16x16x32_bf16(vf.v, pf.v, o[i], 0, 0, 0);
            }
        }
        lsum += __shfl_xor(lsum, 16); lsum += __shfl_xor(lsum, 32);
        const float inv = 1.f / lsum;
#pragma unroll
        for (int i = 0; i < 8; ++i) {
            uint2 ov; ov.x = pack2(o[i][0] * inv, o[i][1] * inv); ov.y = pack2(o[i][2] * inv, o[i][3] * inv);
            *(uint2*)(Y + trow * 1536 + 512 + h * 128 + i * 16 + 4 * fq) = ov;
        }
    }
}

__device__ __forceinline__ int f2sort(float f) { int i = __float_as_int(f); return i ^ ((i >> 31) & 0x7fffffff); }
__device__ __forceinline__ float sort2f(int i) { return __int_as_float(i ^ ((i >> 31) & 0x7fffffff)); }
#define INSK(K, xv) do { int _x = (xv); \
    _Pragma("unroll") for (int _j = 0; _j < 16; ++_j) { int _hi = max(K[_j], _x); _x = min(K[_j], _x); K[_j] = _hi; } } while (0)
#define INS64(K, xv) do { unsigned long long _x = (xv); \
    _Pragma("unroll") for (int _j = 0; _j < 16; ++_j) { bool _c = _x > K[_j]; unsigned long long _o = K[_j]; K[_j] = _c ? _x : _o; _x = _c ? _o : _x; } } while (0)

__device__ void ph_route(const Params& p, int vb0, int nvb) {
    const float* SC = (const float*)(p.ws + WS_SC);
    int* RI = (int*)(p.ws + WS_RI); float* RG = (float*)(p.ws + WS_RG);
    for (int item = vb0 * NT + TIDX(); item < T_TOK * 8; item += nvb * NT) {
        const int t = item >> 3, h = item & 7;
        const float* s0 = SC + (size_t)t * 2048 + h * 256;
        int k0[16], k1[16];
#pragma unroll
        for (int j = 0; j < 16; ++j) { k0[j] = (int)0x80000000; k1[j] = (int)0x80000000; }
#pragma unroll 1
        for (int i = 0; i < 128; i += 4) {
            float4 a = *(const float4*)(s0 + i), b = *(const float4*)(s0 + 128 + i);
            INSK(k0, (f2sort(a.x) & ~127) | (127 - i)); INSK(k0, (f2sort(a.y) & ~127) | (126 - i));
            INSK(k0, (f2sort(a.z) & ~127) | (125 - i)); INSK(k0, (f2sort(a.w) & ~127) | (124 - i));
            INSK(k1, (f2sort(b.x) & ~127) | (127 - i)); INSK(k1, (f2sort(b.y) & ~127) | (126 - i));
            INSK(k1, (f2sort(b.z) & ~127) | (125 - i)); INSK(k1, (f2sort(b.w) & ~127) | (124 - i));
        }
        float v0[16], v1[16];
#pragma unroll
        for (int j = 0; j < 16; ++j) { k0[j] = 127 - (k0[j] & 127); k1[j] = 127 - (k1[j] & 127); v0[j] = s0[k0[j]]; v1[j] = s0[128 + k1[j]]; }
        unsigned long long ck[16];
#pragma unroll
        for (int j = 0; j < 16; ++j) ck[j] = 0ull;
#pragma unroll
        for (int a = 0; a < 16; ++a)
#pragma unroll
            for (int b = 0; b < 16; ++b)
                if ((a + 1) * (b + 1) <= 16) {
                    unsigned hi = (unsigned)f2sort(v0[a] + v1[b]) ^ 0x80000000u;
                    unsigned lo = ((unsigned)(255 - (a * 16 + b)) << 16) | (unsigned)(k0[a] * 128 + k1[b]);
                    INS64(ck, ((unsigned long long)hi << 32) | lo);
                }
        float e[16]; float sm = 0.f;
        const float mx = sort2f((int)((unsigned)(ck[0] >> 32) ^ 0x80000000u));
#pragma unroll
        for (int j = 0; j < 16; ++j) { e[j] = expf(sort2f((int)((unsigned)(ck[j] >> 32) ^ 0x80000000u)) - mx); sm += e[j]; }
        const float inv = 1.f / sm;
#pragma unroll
        for (int j = 0; j < 16; j += 4) {
            *(int4*)(RI + (size_t)t * 128 + h * 16 + j) = make_int4((int)(ck[j] & 0xffffu), (int)(ck[j + 1] & 0xffffu), (int)(ck[j + 2] & 0xffffu), (int)(ck[j + 3] & 0xffffu));
            *(float4*)(RG + (size_t)t * 128 + h * 16 + j) = make_float4(e[j] * inv, e[j + 1] * inv, e[j + 2] * inv, e[j + 3] * inv);
        }
    }
}

__device__ void ph_gather(const Params& p, int l, int vb0, int nvb, bool dummy = false) {
    const int wave = TIDX() >> 6, lane = TIDX() & 63;
    const bf16_t* H = (const bf16_t*)(p.ws + WS_H); const unsigned char* PU = p.ws + WS_PU; const unsigned char* PV = p.ws + WS_PV;
    const int* RI = (const int*)(p.ws + WS_RI); const float* RG = (const float*)(p.ws + WS_RG);
    const float* modb = (const float*)(p.ws + WS_MOD);
    for (int t = vb0 * 8 + wave; t < T_TOK; t += nvb * 8) {
        const int b = t >> 11;
        float hv[16], y[16];
        {
            const uint4* hp = (const uint4*)(H + (size_t)t * 1024 + lane * 16);
            uint4 a = hp[0], c = hp[1];
            hv[0] = bflo(a.x); hv[1] = bfhi(a.x); hv[2] = bflo(a.y); hv[3] = bfhi(a.y); hv[4] = bflo(a.z); hv[5] = bfhi(a.z); hv[6] = bflo(a.w); hv[7] = bfhi(a.w);
            hv[8] = bflo(c.x); hv[9] = bfhi(c.x); hv[10] = bflo(c.y); hv[11] = bfhi(c.y); hv[12] = bflo(c.z); hv[13] = bfhi(c.z); hv[14] = bflo(c.w); hv[15] = bfhi(c.w);
        }
#pragma unroll
        for (int j = 0; j < 16; ++j) y[j] = 0.f;
        const int e_lo = RI[(size_t)t * 128 + lane], e_hi = RI[(size_t)t * 128 + 64 + lane];
        const float g_lo = RG[(size_t)t * 128 + lane], g_hi = RG[(size_t)t * 128 + 64 + lane];
#pragma unroll 1
        for (int grp = 0; grp < 8; ++grp) {
            const int esrc = grp < 4 ? e_lo : e_hi; const float gsrc = grp < 4 ? g_lo : g_hi;
            uint4 uq[16], vq[16];
#pragma unroll
            for (int j = 0; j < 16; ++j) {
                const int e = __shfl(esrc, (grp * 16 + j) & 63);
                uq[j] = *(const uint4*)(PU + (size_t)e * 1024 + lane * 16);
                vq[j] = *(const uint4*)(PV + (size_t)e * 1024 + lane * 16);
            }
            float part[16];
#pragma unroll
            for (int j = 0; j < 16; ++j) {
                const unsigned uw[4] = {uq[j].x, uq[j].y, uq[j].z, uq[j].w};
                float d = 0.f;
#pragma unroll
                for (int c = 0; c < 4; ++c) {
                    auto f0 = __builtin_amdgcn_cvt_pk_f32_fp8((int)uw[c], false); auto f1 = __builtin_amdgcn_cvt_pk_f32_fp8((int)uw[c], true);
                    d += hv[4 * c] * f0[0] + hv[4 * c + 1] * f0[1] + hv[4 * c + 2] * f1[0] + hv[4 * c + 3] * f1[1];
                }
                part[j] = d;
            }
            float r8[8], r4[4], r2[2];
            const bool b5 = lane & 32, b4 = lane & 16, b3 = lane & 8, b2 = lane & 4;
#pragma unroll
            for (int j = 0; j < 8; ++j) { float snd = b5 ? part[j] : part[j + 8], kp = b5 ? part[j + 8] : part[j]; r8[j] = kp + __shfl_xor(snd, 32); }
#pragma unroll
            for (int j = 0; j < 4; ++j) { float snd = b4 ? r8[j] : r8[j + 4], kp = b4 ? r8[j + 4] : r8[j]; r4[j] = kp + __shfl_xor(snd, 16); }
#pragma unroll
            for (int j = 0; j < 2; ++j) { float snd = b3 ? r4[j] : r4[j + 2], kp = b3 ? r4[j + 2] : r4[j]; r2[j] = kp + __shfl_xor(snd, 8); }
            float d;
            { float snd = b2 ? r2[0] : r2[1], kp = b2 ? r2[1] : r2[0]; d = kp + __shfl_xor(snd, 4); }
            d += __shfl_xor(d, 2); d += __shfl_xor(d, 1);
            d *= (1.f / PU_SCALE);
            const int me = ((lane >> 5) & 1) * 8 + ((lane >> 4) & 1) * 4 + ((lane >> 3) & 1) * 2 + ((lane >> 2) & 1);
            const float gme = __shfl(gsrc, (grp * 16 + me) & 63);
            const float coef = gme * 0.5f * d * (1.f + erff(d * 0.7071067811865476f)) * (1.f / PV_SCALE);
#pragma unroll
            for (int j = 0; j < 16; ++j) {
                const float cj = __shfl(coef, (((j >> 3) & 1) << 5) | (((j >> 2) & 1) << 4) | (((j >> 1) & 1) << 3) | ((j & 1) << 2));
                const unsigned vw[4] = {vq[j].x, vq[j].y, vq[j].z, vq[j].w};
#pragma unroll
                for (int c = 0; c < 4; ++c) {
                    auto f0 = __builtin_amdgcn_cvt_pk_f32_fp8((int)vw[c], false); auto f1 = __builtin_amdgcn_cvt_pk_f32_fp8((int)vw[c], true);
                    y[4 * c] += cj * f0[0]; y[4 * c + 1] += cj * f0[1]; y[4 * c + 2] += cj * f1[0]; y[4 * c + 3] += cj * f1[1];
                }
            }
        }
        const float* gf = modb + (size_t)(l * 8 + b) * 6144 + 5120 + lane * 16;
        float* op = p.out + (size_t)t * 1024 + lane * 16;
        float* wp_ = dummy ? (float*)(p.ws + WS_OA) + (size_t)t * 1024 + lane * 16 : op;
#pragma unroll
        for (int j = 0; j < 16; j += 4) {
            float4 xi = *(const float4*)(op + j), g4 = *(const float4*)(gf + j);
            *(float4*)(wp_ + j) = make_float4(xi.x + g4.x * y[j], xi.y + g4.y * y[j + 1], xi.z + g4.z * y[j + 2], xi.w + g4.w * y[j + 3]);
        }
    }
}

enum { PH_MOD = 0, PH_WPREP, PH_NORM1, PH_GEMM_IN, PH_SCAN, PH_DSAPREP, PH_DSA, PH_POST, PH_MERGE, PH_OUT, PH_NORM2, PH_GEMM_Q, PH_GEMM_SC, PH_ROUTE, PH_GATHER, PH_GATHER_DUMMY, PH_DSASEL };

template <int PH>
__device__ __forceinline__ void run_phase(const Params& p, int l, int vb0, int nvb, char* smem) {
    const float* xin = (l == 0) ? p.x : p.out;
    if (PH == PH_MOD) ph_mod(p, vb0, nvb, smem);
    else if (PH == PH_WPREP) ph_wprep(p, l, vb0, nvb, smem);
    else if (PH == PH_NORM1) ph_norm(p, l, 0, xin, vb0, nvb);
    else if (PH == PH_GEMM_IN) gemm_phase((const bf16_t*)(p.ws + WS_H), 1024, (const bf16_t*)(p.ws + WS_WIN), 1024, T_TOK, LDZ, 1024, false,
                                          EpiZ{(bf16_t*)(p.ws + WS_Z), LDZ}, vb0, nvb, smem);
    else if (PH == PH_SCAN) ph_scan(p, l, vb0, nvb, smem);
    else if (PH == PH_DSAPREP) { ph_dsaprep2(p, l, vb0, nvb, smem); ph_dsa_select(p, vb0, nvb, smem); }
    else if (PH == PH_DSA) ph_dsa_attn(p, vb0, nvb);
    else if (PH == PH_POST) ph_post(p, l, vb0, nvb);
    else if (PH == PH_MERGE) ph_merge(p, vb0, nvb, smem);
    else if (PH == PH_OUT) gemm_phase((const bf16_t*)(p.ws + WS_H), 1024, (const bf16_t*)(p.ws + WS_WOUT), 1024, T_TOK, 1024, 1024, false,
                                      EpiOut{xin, p.out, (const float*)(p.ws + WS_MOD) + (size_t)l * 8 * 6144}, vb0, nvb, smem);
    else if (PH == PH_NORM2) ph_norm(p, l, 1, p.out, vb0, nvb);
    else if (PH == PH_GEMM_Q) gemm_phase((const bf16_t*)(p.ws + WS_H), 1024, (const bf16_t*)(p.ws + WS_WQ), 1024, T_TOK, 2048, 1024, false,
                                         EpiZ{(bf16_t*)(p.ws + WS_QP), 2048}, vb0, nvb, smem);
    else if (PH == PH_GEMM_SC) gemm_phase((const bf16_t*)(p.ws + WS_QP), 2048, (const bf16_t*)(p.ws + WS_SK), 128, T_TOK, 2048, 128, true,
                                          EpiF32{(float*)(p.ws + WS_SC), 2048}, vb0, nvb, smem);
    else if (PH == PH_ROUTE) ph_route(p, vb0, nvb);
    else if (PH == PH_GATHER) ph_gather(p, l, vb0, nvb);
    else if (PH == PH_GATHER_DUMMY) ph_gather(p, l, vb0, nvb, true);
    else if (PH == PH_DSASEL) ph_dsa_select(p, vb0, nvb, smem);
}

template <int PH>
__global__ void __launch_bounds__(NT) k_phase(Params p, int l) {
    extern __shared__ __attribute__((aligned(16))) char smem[];
    run_phase<PH>(p, l, (int)blockIdx.x, (int)gridDim.x, smem);
}

constexpr int LDS_BYTES = 65536;

#define XB_TMO      128
#define XB_XCNT(j)  (256  + 64 * (j))
#define XB_XSUB(j)  (1280 + 64 * (j))
#define XB_XGEN(j)  (2304 + 64 * (j))
#define XB_TOP      3328
#define XB_TOPGEN   3392
#define XCD_BAR_WORDS 3456
#define XB_SPIN_CAP (1u << 18)
#define LAS __attribute__((address_space(3)))
__device__ __forceinline__ unsigned xb_ld(unsigned* p)              { return __hip_atomic_load(p, __ATOMIC_RELAXED, __HIP_MEMORY_SCOPE_AGENT); }
__device__ __forceinline__ unsigned xb_add(unsigned* p, unsigned v) { return __hip_atomic_fetch_add(p, v, __ATOMIC_RELAXED, __HIP_MEMORY_SCOPE_AGENT); }
__device__ __forceinline__ unsigned xb_xcc_id() { return (unsigned)__builtin_amdgcn_s_getreg((3 << 11) | 20) & 0xFu; }
#define XB_SPIN(cond, bar) do { unsigned _sp = 0; while (cond) { __builtin_amdgcn_s_sleep(1); \
    if ((++_sp & 255u) == 0u) { if (xb_ld(&(bar)[XB_TMO])) break; if (_sp > XB_SPIN_CAP) { atomicAdd(&(bar)[XB_TMO], 1u); break; } } } } while (0)
struct XcdBarrier { unsigned* bar; unsigned x; volatile LAS unsigned* st; };
__device__ __forceinline__ XcdBarrier xcd_barrier_post(unsigned* bar, volatile LAS unsigned* st) {
    XcdBarrier b; b.bar = bar; b.x = xb_xcc_id(); b.st = st;
    if (threadIdx.x == 0) (void)xb_add(&bar[XB_XCNT(b.x)], 1u);
    return b;
}
__device__ __forceinline__ void xcd_barrier_complete(unsigned* bar, unsigned x, unsigned& nloc, unsigned& nx) {
    const unsigned G = gridDim.x * gridDim.y * gridDim.z;
    unsigned sum, cnt, mine, sp = 0u;
    for (;;) {
        sum = 0u; cnt = 0u; mine = 0u;
#pragma unroll
        for (unsigned j = 0; j < 16; ++j) { const unsigned c = xb_ld(&bar[XB_XCNT(j)]); sum += c; cnt += (c > 0u) ? 1u : 0u; mine = (j == x) ? c : mine; }
        if (sum == G) break;
        __builtin_amdgcn_s_sleep(1);
        if ((++sp & 255u) == 0u) { if (xb_ld(&bar[XB_TMO])) break; if (sp > XB_SPIN_CAP) { atomicAdd(&bar[XB_TMO], 1u); break; } }
    }
    nloc = mine > 0u ? mine : 1u; nx = cnt > 0u ? cnt : 1u;
}
__device__ __forceinline__ void xcd_barrier(const XcdBarrier& b) {
    asm volatile("s_waitcnt vmcnt(0)" ::: "memory");
    __syncthreads();
    if (threadIdx.x == 0) {
        unsigned* bar = b.bar;
        __builtin_amdgcn_s_waitcnt(0);
        unsigned nloc = b.st[0], nx = b.st[1];
        if (nloc == 0u) { xcd_barrier_complete(bar, b.x, nloc, nx); b.st[0] = nloc; b.st[1] = nx; }
        const unsigned old = xb_add(&bar[XB_XSUB(b.x)], 1u);
        const unsigned gen = old / nloc;
        if (old + 1u == (gen + 1u) * nloc) {
            __builtin_amdgcn_fence(__ATOMIC_RELEASE, "agent");
            asm volatile("s_waitcnt vmcnt(0)" ::: "memory");
            const unsigned og = xb_add(&bar[XB_TOP], 1u);
            const unsigned tg = og / nx;
            if (og + 1u == (tg + 1u) * nx) xb_add(&bar[XB_TOPGEN], 1u);
            else XB_SPIN(xb_ld(&bar[XB_TOPGEN]) == tg, bar);
            __builtin_amdgcn_fence(__ATOMIC_ACQUIRE, "agent");
            xb_add(&bar[XB_XGEN(b.x)], 1u);
            asm volatile("s_waitcnt vmcnt(0)" ::: "memory");
        } else {
            XB_SPIN(xb_ld(&bar[XB_XGEN(b.x)]) == gen, bar);
            __builtin_amdgcn_fence(__ATOMIC_ACQUIRE, "agent");
            asm volatile("s_waitcnt vmcnt(0)" ::: "memory");
        }
    }
    __syncthreads();
}

__global__ void __launch_bounds__(NT) mega_kernel(Params p) {
    extern __shared__ __attribute__((aligned(16))) char smem[];
    volatile LAS unsigned* st = (volatile LAS unsigned*)(smem + LDS_BYTES - 16);
    if (threadIdx.x < 4) st[threadIdx.x] = 0u;
    __syncthreads();
    XcdBarrier bar = xcd_barrier_post((unsigned*)(p.ws + WS_CTL), st);
    const int vb = (int)blockIdx.x, nvb = (int)gridDim.x;
#ifndef PROBE_PH
#define PROBE_PH -1
#endif
#define GB() xcd_barrier(bar)
#define RUN(PH, L) do { if ((PROBE_PH == PH && PH != PH_DSAPREP) || (PROBE_PH == PH_GATHER_DUMMY && PH == PH_GATHER)) { int _l = (L), _vb = vb, _nvb = nvb; asm volatile("" : "+s"(_l), "+s"(_vb), "+s"(_nvb)); run_phase<(PROBE_PH == PH_GATHER_DUMMY && PH == PH_GATHER) ? PH_GATHER_DUMMY : PH>(p, _l, _vb, _nvb, smem); __syncthreads(); } int _l = (L), _vb = vb, _nvb = nvb; asm volatile("" : "+s"(_l), "+s"(_vb), "+s"(_nvb)); run_phase<PH>(p, _l, _vb, _nvb, smem); } while (0)
    RUN(PH_MOD, 0);
#pragma unroll 1
    for (int l = 0; l < 2; ++l) {
        RUN(PH_WPREP, l); GB();
        RUN(PH_NORM1, l); GB();
        RUN(PH_GEMM_IN, l); GB();
        RUN(PH_SCAN, l);
        RUN(PH_DSAPREP, l);
        if (PROBE_PH == PH_DSASEL) { int _l = l, _vb = vb, _nvb = nvb; asm volatile("" : "+s"(_l), "+s"(_vb), "+s"(_nvb)); run_phase<PH_DSASEL>(p, _l, _vb, _nvb, smem); }
        GB();
        RUN(PH_DSA, l);
        RUN(PH_POST, l); GB();
        RUN(PH_MERGE, l); GB();
        RUN(PH_OUT, l); GB();
        RUN(PH_NORM2, l); GB();
        RUN(PH_GEMM_Q, l); GB();
        RUN(PH_GEMM_SC, l); GB();
        RUN(PH_ROUTE, l); GB();
        RUN(PH_GATHER, l);
        if (l == 0) GB();
    }
#undef RUN
#undef GB
}

extern "C" void kernel_launch(void* const* d_in, const int* in_sizes, int n_in, void* d_out, int out_size, void* d_ws, size_t ws_size,
                              hipStream_t stream) {
    if (n_in != 20 || ws_size < WS_END) { fprintf(stderr, "kernel_launch: bad inputs (n_in %d ws %zu need %zu)\n", n_in, ws_size, (size_t)WS_END); return; }
    Params p{};
    p.x = (const float*)d_in[0]; p.c = (const float*)d_in[1]; p.w_ada = (const float*)d_in[2]; p.b_ada = (const float*)d_in[3];
    p.norm_mix = (const float*)d_in[4]; p.norm_ffn = (const float*)d_in[5]; p.w_in = (const float*)d_in[6]; p.hgrn_lb = (const float*)d_in[7];
    p.hgrn_on = (const float*)d_in[8]; p.dsa_qn = (const float*)d_in[9]; p.dsa_kn = (const float*)d_in[10]; p.gla_up = (const float*)d_in[11];
    p.gla_bias = (const float*)d_in[12]; p.gla_on = (const float*)d_in[13]; p.w_branch = (const float*)d_in[14]; p.w_out = (const float*)d_in[15];
    p.peer_wq = (const float*)d_in[16]; p.peer_keys = (const float*)d_in[17]; p.peer_u = (const float*)d_in[18]; p.peer_v = (const float*)d_in[19];
    p.out = (float*)d_out; p.ws = (unsigned char*)d_ws;
#if MEGA
    static int grid = 0;
    if (grid == 0) {
        int dev = 0, cus = 0, per_cu = 0;
        hipGetDevice(&dev);
        hipDeviceGetAttribute(&cus, hipDeviceAttributeMultiprocessorCount, dev);
        hipFuncSetAttribute((const void*)mega_kernel, hipFuncAttributeMaxDynamicSharedMemorySize, LDS_BYTES);
        hipOccupancyMaxActiveBlocksPerMultiprocessor(&per_cu, (const void*)mega_kernel, NT, LDS_BYTES);
        if (per_cu < 1) { fprintf(stderr, "kernel_launch: occupancy query says %d blocks per CU\n", per_cu); per_cu = 1; }
        (void)hipGetLastError();
        grid = cus;
    }
    hipMemsetAsync((char*)d_ws + WS_CTL, 0, 16384, stream);
    void* args[] = {&p};
    hipError_t e = hipLaunchCooperativeKernel((const void*)mega_kernel, dim3(grid), dim3(NT), args, LDS_BYTES, stream);
    if (e != hipSuccess) fprintf(stderr, "cooperative launch failed: %s (grid %d)\n", hipGetErrorString(e), grid);
#else
    const int G = 256;
#define LAUNCH(PH, l) hipLaunchKernelGGL(k_phase<PH>, dim3(G), dim3(NT), LDS_BYTES, stream, p, l)
    LAUNCH(PH_MOD, 0);
    for (int l = 0; l < 2; ++l) {
        LAUNCH(PH_WPREP, l);
        LAUNCH(PH_NORM1, l);
        LAUNCH(PH_GEMM_IN, l);
        LAUNCH(PH_SCAN, l);
        LAUNCH(PH_DSAPREP, l);
        LAUNCH(PH_DSA, l);
        LAUNCH(PH_POST, l);
        LAUNCH(PH_MERGE, l);
        LAUNCH(PH_OUT, l);
        LAUNCH(PH_NORM2, l);
        LAUNCH(PH_GEMM_Q, l);
        LAUNCH(PH_GEMM_SC, l);
        LAUNCH(PH_ROUTE, l);
        LAUNCH(PH_GATHER, l);
    }
#endif
}
```

```cpp
#include <hip/hip_runtime.h>
#include <stdint.h>
#include <stdio.h>

#ifndef MEGA
#define MEGA 1
#endif

typedef unsigned short bf16_t;
typedef short bf16x8 __attribute__((ext_vector_type(8)));
typedef float f32x4 __attribute__((ext_vector_type(4)));
typedef unsigned u32x4 __attribute__((ext_vector_type(4)));

#define NT 512
constexpr int T_TOK = 16384, DM = 1024, SEQ = 2048;
constexpr int LDZ = 8704;
constexpr int ZA_Q = 0, ZA_F = 512, ZA_I = 1024, ZA_G = 1536, ZB_Q = 2048, ZB_K = 2560, ZB_V = 3072, ZC_V = 3584, ZC_G = 4096,
              ZB_QI = 4608, ZC_Q = 4864, ZC_K = 5120, ZB_KI = 5376, ZB_WI = 5440, ZC_CODE = 5444, ZM = 5632;
constexpr int IN_COLS = 8532;

constexpr size_t al256(size_t x) { return (x + 255) & ~(size_t)255; }
constexpr size_t WS_CTL = 0;
constexpr size_t WS_MOD = 65536;
constexpr size_t WS_WIN = al256(WS_MOD + (size_t)2 * 8 * 6144 * 4);
constexpr size_t WS_WBR = al256(WS_WIN + (size_t)LDZ * 1024 * 2);
constexpr size_t WS_WOUT = al256(WS_WBR + (size_t)3 * 1024 * 512 * 2);
constexpr size_t WS_WQ = al256(WS_WOUT + (size_t)1024 * 1024 * 2);
constexpr size_t WS_SK = al256(WS_WQ + (size_t)2048 * 1024 * 2);
constexpr size_t WS_PU = al256(WS_SK + (size_t)16 * 128 * 128 * 2);
constexpr size_t WS_PV = al256(WS_PU + (size_t)16384 * 1024);
constexpr size_t WS_H = al256(WS_PV + (size_t)16384 * 1024);
constexpr float PU_SCALE = 32.f, PV_SCALE = 4.f;
constexpr size_t WS_OA = al256(WS_H + (size_t)T_TOK * 1024 * 2);
constexpr size_t WS_OC = al256(WS_OA + (size_t)T_TOK * 512 * 2);
constexpr size_t WS_Y = al256(WS_OC + (size_t)T_TOK * 512 * 2);
constexpr size_t WS_Z = al256(WS_Y + (size_t)T_TOK * 1536 * 2);
constexpr size_t WS_VT = al256(WS_Z + (size_t)T_TOK * LDZ * 2);
constexpr size_t WS_BM = al256(WS_VT + (size_t)T_TOK * 512 * 2);
constexpr size_t WS_END = al256(WS_BM + (size_t)T_TOK * 64 * 4);
constexpr size_t WS_QP = WS_Z;
constexpr size_t WS_SC = al256(WS_QP + (size_t)T_TOK * 2048 * 2);
constexpr size_t WS_RI = al256(WS_SC + (size_t)T_TOK * 2048 * 4);
constexpr size_t WS_RG = al256(WS_RI + (size_t)T_TOK * 128 * 4);
static_assert(WS_RG + (size_t)T_TOK * 128 * 4 <= WS_END, "peer alias overflow");

struct Params {
    const float* x; const float* c; const float* w_ada; const float* b_ada; const float* norm_mix; const float* norm_ffn;
    const float* w_in; const float* hgrn_lb; const float* hgrn_on; const float* dsa_qn; const float* dsa_kn;
    const float* gla_up; const float* gla_bias; const float* gla_on; const float* w_branch; const float* w_out;
    const float* peer_wq; const float* peer_keys; const float* peer_u; const float* peer_v;
    float* out; unsigned char* ws;
};

__device__ __forceinline__ float bf2f(bf16_t h) { return __uint_as_float(((unsigned)h) << 16); }
__device__ __forceinline__ float bflo(unsigned u) { return __uint_as_float(u << 16); }
__device__ __forceinline__ float bfhi(unsigned u) { return __uint_as_float(u & 0xffff0000u); }
__device__ __forceinline__ bf16_t f2bf(float f) { unsigned u = __float_as_uint(f); u += 0x7fffu + ((u >> 16) & 1u); return (bf16_t)(u >> 16); }
__device__ __forceinline__ unsigned pack2(float a, float b) { return (unsigned)f2bf(a) | ((unsigned)f2bf(b) << 16); }
__device__ __forceinline__ float wave_sum(float v) { for (int o = 32; o > 0; o >>= 1) v += __shfl_xor(v, o); return v; }
__device__ __forceinline__ float wave_max(float v) { for (int o = 32; o > 0; o >>= 1) v = fmaxf(v, __shfl_xor(v, o)); return v; }
__device__ __forceinline__ int wave_sum_i(int v) { for (int o = 32; o > 0; o >>= 1) v += __shfl_xor(v, o); return v; }
__device__ __forceinline__ float sigm(float x) { return 1.f / (1.f + expf(-x)); }

__device__ __forceinline__ int TIDX() { int t = (int)threadIdx.x; asm volatile("" : "+v"(t)); return t; }

__device__ __forceinline__ int src_col(int j) {
    if (j < 3584) return j;
    if (j < 4096) return j - 3584 + 4420;
    if (j < 4608) return j - 4096 + 4948;
    if (j < 4864) return j - 4608 + 3584;
    if (j < 5120) return j - 4864 + 3908;
    if (j < 5376) return j - 5120 + 4164;
    if (j < 5440) return j - 5376 + 3840;
    if (j < 5444) return j - 5440 + 3904;
    if (j < 5460) return j - 5444 + 4932;
    if (j < 5632) return -1;
    return j - 5632 + 5460;
}

__device__ void ph_mod(const Params& p, int vb0, int nvb, char* smem_) {
    float* sc = (float*)smem_;
    float* mod = (float*)(p.ws + WS_MOD);
    for (int i = TIDX(); i < 8 * 1024; i += NT) { float c = p.c[i]; sc[i] = c / (1.f + expf(-c)); }
    __syncthreads();
    for (int vb = vb0; vb < 24; vb += nvb) {
        int col = vb * 512 + TIDX();
        int l = col / 6144, n = col % 6144;
        const float* w = p.w_ada + (size_t)l * 1024 * 6144 + n;
        float acc[8];
#pragma unroll
        for (int b = 0; b < 8; ++b) acc[b] = 0.f;
#pragma unroll 8
        for (int k = 0; k < 1024; ++k) {
            float wv = w[(size_t)k * 6144];
#pragma unroll
            for (int b = 0; b < 8; ++b) acc[b] += sc[b * 1024 + k] * wv;
        }
        float bias = p.b_ada[l * 6144 + n];
#pragma unroll
        for (int b = 0; b < 8; ++b) mod[(size_t)(l * 8 + b) * 6144 + n] = acc[b] + bias;
    }
    __syncthreads();
}

template <bool MAP>
__device__ void tr_tile(const float* __restrict__ src, int lds_, bf16_t* __restrict__ out, int ldo, int k0, int n0, float* tile) {
    const int tid = TIDX();
#pragma unroll
    for (int i = 0; i < 8; ++i) {
        int kk = (tid >> 6) + 8 * i, nn = tid & 63;
        int scol = MAP ? src_col(n0 + nn) : (n0 + nn);
        float v = (scol >= 0) ? src[(size_t)(k0 + kk) * lds_ + scol] : 0.f;
        tile[kk * 65 + nn] = v;
    }
    __syncthreads();
#pragma unroll
    for (int i = 0; i < 4; ++i) {
        int nn = (tid >> 5) + 16 * i, kk = (tid & 31) * 2;
        unsigned v = pack2(tile[kk * 65 + nn], tile[(kk + 1) * 65 + nn]);
        *(unsigned*)(out + (size_t)(n0 + nn) * ldo + k0 + kk) = v;
    }
    __syncthreads();
}
__device__ void conv_chunk(const float* __restrict__ src, bf16_t* __restrict__ dst, size_t base) {
#pragma unroll
    for (int i = 0; i < 4; ++i) {
        size_t e = base + (size_t)(i * NT + TIDX()) * 8;
        float4 a = *(const float4*)(src + e), b = *(const float4*)(src + e + 4);
        uint4 o; o.x = pack2(a.x, a.y); o.y = pack2(a.z, a.w); o.z = pack2(b.x, b.y); o.w = pack2(b.z, b.w);
        *(uint4*)(dst + e) = o;
    }
}
__device__ void conv_chunk_fp8(const float* __restrict__ src, unsigned char* __restrict__ dst, size_t base, float scale) {
#pragma unroll
    for (int i = 0; i < 4; ++i) {
        size_t e = base + (size_t)(i * NT + TIDX()) * 8;
        float4 a = *(const float4*)(src + e), b = *(const float4*)(src + e + 4);
        int lo = __builtin_amdgcn_cvt_pk_fp8_f32(a.x * scale, a.y * scale, 0, false); lo = __builtin_amdgcn_cvt_pk_fp8_f32(a.z * scale, a.w * scale, lo, true);
        int hi = __builtin_amdgcn_cvt_pk_fp8_f32(b.x * scale, b.y * scale, 0, false); hi = __builtin_amdgcn_cvt_pk_fp8_f32(b.z * scale, b.w * scale, hi, true);
        *(uint2*)(dst + e) = make_uint2((unsigned)lo, (unsigned)hi);
    }
}
__device__ void ph_wprep(const Params& p, int l, int vb0, int nvb, char* smem_) {
    float* tile = (float*)smem_;
    bf16_t* WIN = (bf16_t*)(p.ws + WS_WIN); bf16_t* WBR = (bf16_t*)(p.ws + WS_WBR); bf16_t* WOUT = (bf16_t*)(p.ws + WS_WOUT);
    bf16_t* WQ = (bf16_t*)(p.ws + WS_WQ); bf16_t* SK = (bf16_t*)(p.ws + WS_SK); unsigned char* PU = p.ws + WS_PU; unsigned char* PV = p.ws + WS_PV;
    constexpr int N_WIN = 136 * 16, N_WBR = 3 * 16 * 8, N_WOUT = 16 * 16, N_WQ = 32 * 16, N_SK = 16, N_PU = 1024, N_PV = 1024;
    constexpr int TOTAL = N_WIN + N_WBR + N_WOUT + N_WQ + N_SK + N_PU + N_PV;
    for (int task = vb0; task < TOTAL; task += nvb) {
        int r = task;
        if (r < N_WIN) { int nt = r / 16, kt = r % 16; tr_tile<true>(p.w_in + (size_t)l * 1024 * IN_COLS, IN_COLS, WIN, 1024, kt * 64, nt * 64, tile); continue; }
        r -= N_WIN;
        if (r < N_WBR) { int g = r / 128, rr = r % 128, nt = rr / 8, kt = rr % 8;
            tr_tile<false>(p.w_branch + (size_t)(l * 3 + g) * 512 * 1024, 1024, WBR + (size_t)g * 1024 * 512, 512, kt * 64, nt * 64, tile); continue; }
        r -= N_WBR;
        if (r < N_WOUT) { int nt = r / 16, kt = r % 16; tr_tile<false>(p.w_out + (size_t)l * 1024 * 1024, 1024, WOUT, 1024, kt * 64, nt * 64, tile); continue; }
        r -= N_WOUT;
        if (r < N_WQ) { int nt = r / 16, kt = r % 16; tr_tile<false>(p.peer_wq + (size_t)l * 1024 * 2048, 2048, WQ, 1024, kt * 64, nt * 64, tile); continue; }
        r -= N_WQ;
        if (r < N_SK) { conv_chunk(p.peer_keys + (size_t)l * 16 * 128 * 128, SK, (size_t)r * 16384); continue; }
        r -= N_SK;
        if (r < N_PU) { conv_chunk_fp8(p.peer_u + (size_t)l * 16384 * 1024, PU, (size_t)r * 16384, PU_SCALE); continue; }
        r -= N_PU;
        conv_chunk_fp8(p.peer_v + (size_t)l * 16384 * 1024, PV, (size_t)r * 16384, PV_SCALE);
    }
}

__device__ void ph_norm(const Params& p, int l, int which, const float* xin, int vb0, int nvb) {
    const int wave = TIDX() >> 6, lane = TIDX() & 63;
    const float* gain = (which ? p.norm_ffn : p.norm_mix) + l * 1024;
    const float* modb = (const float*)(p.ws + WS_MOD);
    bf16_t* H = (bf16_t*)(p.ws + WS_H);
    for (int t = vb0 * 8 + wave; t < T_TOK; t += nvb * 8) {
        int b = t >> 11;
        const float* mod = modb + (size_t)(l * 8 + b) * 6144 + (which ? 3072 : 0);
        const float4* xr = (const float4*)(xin + (size_t)t * 1024);
        float4 v[4]; float ss = 0.f;
#pragma unroll
        for (int i = 0; i < 4; ++i) { v[i] = xr[lane + 64 * i]; ss += v[i].x * v[i].x + v[i].y * v[i].y + v[i].z * v[i].z + v[i].w * v[i].w; }
        ss = wave_sum(ss);
        float rstd = rsqrtf(ss * (1.f / 1024.f) + 1e-6f);
#pragma unroll
        for (int i = 0; i < 4; ++i) {
            int idx = (lane + 64 * i) * 4;
            float4 g = *(const float4*)(gain + idx), sc = *(const float4*)(mod + 1024 + idx), sh = *(const float4*)(mod + idx);
            float h0 = v[i].x * rstd * g.x * (1.f + sc.x) + sh.x, h1 = v[i].y * rstd * g.y * (1.f + sc.y) + sh.y;
            float h2 = v[i].z * rstd * g.z * (1.f + sc.z) + sh.z, h3 = v[i].w * rstd * g.w * (1.f + sc.w) + sh.w;
            uint2 o; o.x = pack2(h0, h1); o.y = pack2(h2, h3);
            *(uint2*)(H + (size_t)t * 1024 + idx) = o;
        }
    }
}

constexpr int GBM = 256, GBN = 128, GBK = 64, GLS = 72;
__device__ __forceinline__ void gemm_tile(const bf16_t* __restrict__ A, int lda, const bf16_t* __restrict__ Bt, int ldb, int K,
                                          int m0, int n0, bf16_t* sA, bf16_t* sB, f32x4 (&acc)[4][4]) {
    const int tid = TIDX(), lane = tid & 63, wave = tid >> 6;
    const int wm = wave >> 1, wn = wave & 1, fr = lane & 15, fq = lane >> 4;
    u32x4 ra[4], rb[2];
    const int crow = tid >> 3, ckc = (tid & 7) * 8;
    const bf16_t* Ag = A + (size_t)(m0 + crow) * lda + ckc;
    const bf16_t* Bg = Bt + (size_t)(n0 + crow) * ldb + ckc;
#pragma unroll
    for (int i = 0; i < 4; ++i) ra[i] = *(const u32x4*)(Ag + (size_t)(64 * i) * lda);
#pragma unroll
    for (int i = 0; i < 2; ++i) rb[i] = *(const u32x4*)(Bg + (size_t)(64 * i) * ldb);
    for (int k0 = 0; k0 < K; k0 += GBK) {
        __syncthreads();
#pragma unroll
        for (int i = 0; i < 4; ++i) *(u32x4*)(sA + (crow + 64 * i) * GLS + ckc) = ra[i];
#pragma unroll
        for (int i = 0; i < 2; ++i) *(u32x4*)(sB + (crow + 64 * i) * GLS + ckc) = rb[i];
        __syncthreads();
        {
            const int kn = (k0 + GBK < K) ? (k0 + GBK) : k0;
#pragma unroll
            for (int i = 0; i < 4; ++i) ra[i] = *(const u32x4*)(Ag + (size_t)(64 * i) * lda + kn);
#pragma unroll
            for (int i = 0; i < 2; ++i) rb[i] = *(const u32x4*)(Bg + (size_t)(64 * i) * ldb + kn);
        }
#pragma unroll
        for (int ks = 0; ks < 2; ++ks) {
            bf16x8 af[4], wf[4];
#pragma unroll
            for (int mf = 0; mf < 4; ++mf) af[mf] = *(const bf16x8*)(sA + (wm * 64 + mf * 16 + fr) * GLS + ks * 32 + fq * 8);
#pragma unroll
            for (int nf = 0; nf < 4; ++nf) wf[nf] = *(const bf16x8*)(sB + (wn * 64 + nf * 16 + fr) * GLS + ks * 32 + fq * 8);
#pragma unroll
            for (int nf = 0; nf < 4; ++nf)
#pragma unroll
                for (int mf = 0; mf < 4; ++mf)
                    acc[nf][mf] = __builtin_amdgcn_mfma_f32_16x16x32_bf16(wf[nf], af[mf], acc[nf][mf], 0, 0, 0);
        }
    }
}


namespace pg8 {
#define PG8_LAS __attribute__((address_space(3)))
constexpr int BM = 256, BK = 64, HALF = 128, HTB = HALF * BK * 2, STAGE_BYTES = 8 * HTB, NXCD = 8, WGM = 8;
__device__ __forceinline__ int lds_byte(int r, int c) { const int st = (r >> 4) * 2 + (c >> 5), rr = r & 15, cc = c & 31, ob = rr * 64 + cc * 2; return st * 1024 + (ob ^ (((ob >> 9) & 1) << 5)); }
__device__ __forceinline__ void stage_rc(int b, int& R, int& C) { const int st = b / 1024, sb = b % 1024, swz = sb ^ (((sb >> 9) & 1) << 5); R = (st >> 1) * 16 + swz / 64; C = (st & 1) * 32 + (swz % 64) / 2; }
__device__ __forceinline__ int perm32(int rho) { const int n = rho >> 4, i = rho & 15; return 8 * (i >> 2) + 4 * n + (i & 3); }
struct Unit { int pm, pn, aux; size_t aoff, boff; };
struct Gemm { const bf16_t* A; const bf16_t* Bt; int lda, ldb, K; };

struct StaticOrder {
    int nM, nN, nwg, G, c, lda, ldb;
    __device__ void init(int M, int N, int G_, int c_, int lda_, int ldb_) { nM = M / BM; nN = N / BM; nwg = nM * nN; G = G_; c = c_; lda = lda_; ldb = ldb_; }
    __device__ bool next(int i, Unit& u) const {
        const long L = (long)i * G + c; if (L >= nwg) return false;
        int wgid = (int)L; { const int q = nwg / NXCD, r = nwg % NXCD, xcd = wgid % NXCD, off = wgid / NXCD; wgid = (xcd < r ? xcd * (q + 1) : r * (q + 1) + (xcd - r) * q) + off; }
        const int nig = WGM * nN, gid = wgid / nig, fm = gid * WGM, gsz = (nM - fm) < WGM ? (nM - fm) : WGM;
        u.pm = fm + ((wgid % nig) % gsz); u.pn = (wgid % nig) / gsz; u.aux = 0;
        u.aoff = (size_t)u.pm * BM * lda * 2; u.boff = (size_t)u.pn * BM * ldb * 2;
        return true;
    }
};
struct MergeOrder {
    int c, G;
    __device__ bool next(int i, Unit& u) const {
        const int tile = c + (i / 3) * G; if (tile >= 256) return false;
        u.pm = tile & 63; u.pn = tile >> 6; u.aux = i % 3;
        u.aoff = ((size_t)u.pm * BM * 1536 + (size_t)u.aux * 512) * 2; u.boff = ((size_t)u.aux * 1024 + (size_t)u.pn * BM) * 512 * 2;
        return true;
    }
};

template <class Epi, class Sched>
__device__ __forceinline__ void gemm_phase(PG8_LAS unsigned char* lds, const Gemm g, const Sched& S, const Epi& E) {
    const int tid = TIDX(), wid = __builtin_amdgcn_readfirstlane(tid >> 6), lane = tid & 63, wr = wid >> 2, wc = wid & 3, fr = lane & 15, fq = lane >> 4;
    const int K = g.K, nt = K / BK;
    unsigned voffA[2], voffB[2];
#pragma unroll
    for (int i = 0; i < 2; ++i) { int R, C; stage_rc(tid * 16 + i * 8192, R, C); const int Rb = Epi::PERM ? ((R & ~31) + perm32(R & 31)) : R;
        voffA[i] = (unsigned)(R * g.lda + C) * 2u; voffB[i] = (unsigned)(Rb * g.ldb + C) * 2u; }
    const size_t kstep = (size_t)(BK * 2);
    const size_t hstepA = (size_t)HALF * g.lda * 2, hstepB = (size_t)HALF * g.ldb * 2;
    const unsigned ldsw = (unsigned)wid * 1024u;
    const int aoff = lds_byte(wr * 64 + fr, fq * 8), boff = lds_byte(wc * 32 + fr, fq * 8);
#define PG8_SA(b, h) (((b) * 2 + (h)) * HTB)
#define PG8_SB(b, h) ((4 + (b) * 2 + (h)) * HTB)
#define PG8_STAGE(bufoff, gbase, voff) do { _Pragma("unroll") for (int _i = 0; _i < 2; ++_i) \
        __builtin_amdgcn_global_load_lds((const unsigned*)((const char*)(gbase) + (voff)[_i]), (PG8_LAS unsigned*)(lds + (bufoff) + ldsw + _i * 8192), 16, 0, 0); } while (0)
#define PG8_LDA(dst, b, h) do { _Pragma("unroll") for (int m = 0; m < 4; ++m) _Pragma("unroll") for (int k = 0; k < 2; ++k) dst[m][k] = *(const PG8_LAS bf16x8*)(lds + PG8_SA(b, h) + aoff + m * 2048 + k * 1024); } while (0)
#define PG8_LDB(dst, b, h) do { _Pragma("unroll") for (int n = 0; n < 2; ++n) _Pragma("unroll") for (int k = 0; k < 2; ++k) dst[n][k] = *(const PG8_LAS bf16x8*)(lds + PG8_SB(b, h) + boff + n * 2048 + k * 1024); } while (0)
#define PG8_MMA(ai, bj, At, Bt) do { __builtin_amdgcn_s_setprio(1); _Pragma("unroll") for (int m = 0; m < 4; ++m) _Pragma("unroll") for (int n = 0; n < 2; ++n) _Pragma("unroll") for (int k = 0; k < 2; ++k) \
        acc[ai][bj][m][n] = __builtin_amdgcn_mfma_f32_16x16x32_bf16(Bt[n][k], At[m][k], acc[ai][bj][m][n], 0, 0, 0); __builtin_amdgcn_s_setprio(0); } while (0)
#define PG8_WAIT_V(n) asm volatile("s_waitcnt vmcnt(" #n ")" ::: "memory")
#define PG8_WAIT_L(n) asm volatile("s_waitcnt lgkmcnt(" #n ")" ::: "memory")
#define PG8_BAR __builtin_amdgcn_s_barrier()
#define PG8_SCHED __builtin_amdgcn_sched_barrier(0)
    Unit cur, nxt; int ui = 0;
    if (!S.next(0, cur)) return;
    f32x4 acc[2][2][4][2];
#pragma unroll
    for (int a = 0; a < 2; ++a)
#pragma unroll
        for (int b = 0; b < 2; ++b)
#pragma unroll
            for (int m = 0; m < 4; ++m)
#pragma unroll
                for (int n = 0; n < 2; ++n) acc[a][b][m][n] = f32x4{0.f, 0.f, 0.f, 0.f};
    bf16x8 At[4][2], B0[2][2], B1[2][2];
    const char* cA = (const char*)g.A + cur.aoff; const char* cB = (const char*)g.Bt + cur.boff;
    PG8_STAGE(PG8_SB(0, 0), cB, voffB); PG8_STAGE(PG8_SA(0, 0), cA, voffA); PG8_STAGE(PG8_SB(0, 1), cB + hstepB, voffB); PG8_STAGE(PG8_SA(0, 1), cA + hstepA, voffA);
    if (wr == 1) PG8_BAR;
    PG8_WAIT_V(4); PG8_BAR;
    PG8_STAGE(PG8_SB(1, 0), cB + kstep, voffB); PG8_STAGE(PG8_SA(1, 0), cA + kstep, voffA); PG8_STAGE(PG8_SB(1, 1), cB + hstepB + kstep, voffB);
    PG8_WAIT_V(6); PG8_BAR;
    for (;;) {
        const bool has_next = S.next(ui + 1, nxt);
        const char* nA = has_next ? (const char*)g.A + nxt.aoff : cA; const char* nB = has_next ? (const char*)g.Bt + nxt.boff : cB;
        for (int t = 0; t < nt; t += 2) {
            const bool last = (t == nt - 2);
            const char* a1 = cA + (size_t)(t + 1) * kstep;
            const char* a2 = last ? nA : cA + (size_t)(t + 2) * kstep; const char* b2 = last ? nB : cB + (size_t)(t + 2) * kstep;
            const char* a3 = a2 + kstep; const char* b3 = b2 + kstep;
            PG8_LDB(B0, 0, 0); PG8_SCHED; PG8_LDA(At, 0, 0); PG8_STAGE(PG8_SA(1, 1), a1 + hstepA, voffA);
            PG8_WAIT_L(8); PG8_BAR; PG8_WAIT_L(0); PG8_MMA(0, 0, At, B0); PG8_BAR; PG8_SCHED;
            PG8_LDB(B1, 0, 1); PG8_STAGE(PG8_SB(0, 0), b2, voffB);
            PG8_BAR; PG8_WAIT_L(0); PG8_MMA(0, 1, At, B1); PG8_BAR;
            PG8_LDA(At, 0, 1); PG8_STAGE(PG8_SA(0, 0), a2, voffA);
            PG8_BAR; PG8_WAIT_L(0); PG8_MMA(1, 0, At, B0); PG8_BAR; PG8_SCHED;
            PG8_STAGE(PG8_SB(0, 1), b2 + hstepB, voffB);
            PG8_WAIT_V(6); PG8_BAR; PG8_MMA(1, 1, At, B1); PG8_BAR;
            PG8_LDB(B0, 1, 0); PG8_SCHED; PG8_LDA(At, 1, 0); PG8_STAGE(PG8_SA(0, 1), a2 + hstepA, voffA);
            PG8_WAIT_L(8); PG8_BAR; PG8_WAIT_L(0); PG8_MMA(0, 0, At, B0); PG8_BAR; PG8_SCHED;
            PG8_LDB(B1, 1, 1); PG8_STAGE(PG8_SB(1, 0), b3, voffB);
            PG8_BAR; PG8_WAIT_L(0); PG8_MMA(0, 1, At, B1); PG8_BAR;
            PG8_LDA(At, 1, 1); PG8_STAGE(PG8_SA(1, 0), a3, voffA);
            PG8_BAR; PG8_WAIT_L(0); PG8_MMA(1, 0, At, B0); PG8_BAR; PG8_SCHED;
            PG8_STAGE(PG8_SB(1, 1), b3 + hstepB, voffB);
            PG8_WAIT_V(6); PG8_BAR; PG8_MMA(1, 1, At, B1); PG8_BAR;
        }
        E(acc, cur, wr, wc, fr, fq);
        if (!has_next) break;
#pragma unroll
        for (int a = 0; a < 2; ++a)
#pragma unroll
            for (int b = 0; b < 2; ++b)
#pragma unroll
                for (int m = 0; m < 4; ++m)
#pragma unroll
                    for (int n = 0; n < 2; ++n) acc[a][b][m][n] = f32x4{0.f, 0.f, 0.f, 0.f};
        cur = nxt; cA = nA; cB = nB; ++ui;
    }
    PG8_WAIT_V(0);
    if (wr == 0) PG8_BAR;
    PG8_BAR;
#undef PG8_SA
#undef PG8_SB
#undef PG8_STAGE
#undef PG8_LDA
#undef PG8_LDB
#undef PG8_MMA
#undef PG8_WAIT_V
#undef PG8_WAIT_L
#undef PG8_BAR
#undef PG8_SCHED
}

struct EpiBf16 {
    static constexpr bool PERM = true;
    bf16_t* O; int ldc;
    __device__ __forceinline__ void operator()(const f32x4 (&acc)[2][2][4][2], const Unit& u, int wr, int wc, int fr, int fq) const {
        const int row0 = u.pm * BM + wr * 64 + fr, col0 = u.pn * BM + wc * 32 + 8 * fq;
#pragma unroll
        for (int ai = 0; ai < 2; ++ai)
#pragma unroll
            for (int m = 0; m < 4; ++m) { bf16_t* rowp = O + (size_t)(row0 + ai * HALF + m * 16) * ldc + col0;
#pragma unroll
                for (int bj = 0; bj < 2; ++bj) { const f32x4 v0 = acc[ai][bj][m][0], v1 = acc[ai][bj][m][1];
                    u32x4 w; w.x = pack2(v0[0], v0[1]); w.y = pack2(v0[2], v0[3]); w.z = pack2(v1[0], v1[1]); w.w = pack2(v1[2], v1[3]);
                    *(u32x4*)(rowp + bj * HALF) = w; } }
    }
};
struct EpiResid {
    static constexpr bool PERM = false;
    const float* xin; float* out; const float* mod;
    __device__ __forceinline__ void operator()(const f32x4 (&acc)[2][2][4][2], const Unit& u, int wr, int wc, int fr, int fq) const {
        const int row0 = u.pm * BM + wr * 64 + fr, col0 = u.pn * BM + wc * 32 + 4 * fq;
        const float* gm = mod + (size_t)(row0 >> 11) * 6144 + 2048 + col0;
#pragma unroll
        for (int ai = 0; ai < 2; ++ai)
#pragma unroll
            for (int m = 0; m < 4; ++m) { const size_t ro = (size_t)(row0 + ai * HALF + m * 16) * 1024 + col0;
#pragma unroll
                for (int bj = 0; bj < 2; ++bj)
#pragma unroll
                    for (int n = 0; n < 2; ++n) {
                        const f32x4 g4 = *(const f32x4*)(gm + bj * HALF + n * 16), xi = *(const f32x4*)(xin + ro + bj * HALF + n * 16);
                        *(f32x4*)(out + ro + bj * HALF + n * 16) = xi + g4 * acc[ai][bj][m][n]; } }
    }
};
struct EpiMerge {
    static constexpr bool PERM = true;
    bf16_t* Hm; const bf16_t* Z;
    __device__ __forceinline__ void operator()(const f32x4 (&acc)[2][2][4][2], const Unit& u, int wr, int wc, int fr, int fq) const {
        const int row0 = u.pm * BM + wr * 64 + fr, col0 = u.pn * BM + wc * 32 + 8 * fq, g = u.aux;
#pragma unroll
        for (int ai = 0; ai < 2; ++ai)
#pragma unroll
            for (int m = 0; m < 4; ++m) { const int row = row0 + ai * HALF + m * 16;
#pragma unroll
                for (int bj = 0; bj < 2; ++bj) {
                    const int col = col0 + bj * HALF;
                    const u32x4 gz = *(const u32x4*)(Z + (size_t)row * LDZ + ZM + g * 1024 + col);
                    u32x4 prev = u32x4{0u, 0u, 0u, 0u};
                    if (g > 0) prev = *(const u32x4*)(Hm + (size_t)row * 1024 + col);
                    const f32x4 v0 = acc[ai][bj][m][0], v1 = acc[ai][bj][m][1];
                    u32x4 w;
                    w.x = pack2(bflo(prev.x) + sigm(bflo(gz.x)) * v0[0], bfhi(prev.x) + sigm(bfhi(gz.x)) * v0[1]);
                    w.y = pack2(bflo(prev.y) + sigm(bflo(gz.y)) * v0[2], bfhi(prev.y) + sigm(bfhi(gz.y)) * v0[3]);
                    w.z = pack2(bflo(prev.z) + sigm(bflo(gz.z)) * v1[0], bfhi(prev.z) + sigm(bfhi(gz.z)) * v1[1]);
                    w.w = pack2(bflo(prev.w) + sigm(bflo(gz.w)) * v1[2], bfhi(prev.w) + sigm(bfhi(gz.w)) * v1[3]);
                    *(u32x4*)(Hm + (size_t)row * 1024 + col) = w; } }
    }
};
}

struct EpiZ {
    bf16_t* Z; int ld;
    __device__ __forceinline__ void operator()(int m, int n, const f32x4& v) const {
        uint2 o; o.x = pack2(v[0], v[1]); o.y = pack2(v[2], v[3]);
        *(uint2*)(Z + (size_t)m * ld + n) = o;
    }
};
struct EpiF32 {
    float* C; int ld;
    __device__ __forceinline__ void operator()(int m, int n, const f32x4& v) const {
        *(float4*)(C + (size_t)m * ld + n) = make_float4(v[0], v[1], v[2], v[3]);
    }
};
struct EpiOut {
    const float* xin; float* out; const float* mod;
    __device__ __forceinline__ void operator()(int m, int n, const f32x4& v) const {
        int b = m >> 11;
        float4 g = *(const float4*)(mod + (size_t)b * 6144 + 2048 + n);
        float4 xi = *(const float4*)(xin + (size_t)m * 1024 + n);
        *(float4*)(out + (size_t)m * 1024 + n) = make_float4(xi.x + g.x * v[0], xi.y + g.y * v[1], xi.z + g.z * v[2], xi.w + g.w * v[3]);
    }
};

template <class Epi>
__device__ void gemm_phase(const bf16_t* A, int lda, const bf16_t* Bt, int ldb, int M, int N, int K, bool batched, Epi epi,
                           int vb0, int nvb, char* smem_) {
    bf16_t* sA = (bf16_t*)smem_; bf16_t* sB = sA + GBM * GLS;
    const int lane = TIDX() & 63, wave = TIDX() >> 6, wm = wave >> 1, wn = wave & 1, fr = lane & 15, fq = lane >> 4;
    const int MT = M / GBM, NTL = N / GBN;
    for (int tile = vb0; tile < MT * NTL; tile += nvb) {
        int mt = tile % MT, nt = tile / MT;
        f32x4 acc[4][4];
#pragma unroll
        for (int a = 0; a < 4; ++a)
#pragma unroll
            for (int b = 0; b < 4; ++b) acc[a][b] = f32x4{0.f, 0.f, 0.f, 0.f};
        gemm_tile(batched ? A + nt * 128 : A, lda, Bt, ldb, K, mt * GBM, nt * GBN, sA, sB, acc);
#pragma unroll
        for (int nf = 0; nf < 4; ++nf)
#pragma unroll
            for (int mf = 0; mf < 4; ++mf)
                epi(mt * GBM + wm * 64 + mf * 16 + fr, nt * GBN + wn * 64 + nf * 16 + fq * 4, acc[nf][mf]);
    }
}

__device__ void ph_merge(const Params& p, int vb0, int nvb, char* smem_) {
    bf16_t* sA = (bf16_t*)smem_; bf16_t* sB = sA + GBM * GLS;
    const bf16_t* Y = (const bf16_t*)(p.ws + WS_Y); const bf16_t* WBR = (const bf16_t*)(p.ws + WS_WBR);
    const bf16_t* Z = (const bf16_t*)(p.ws + WS_Z); bf16_t* H = (bf16_t*)(p.ws + WS_H);
    const int lane = TIDX() & 63, wave = TIDX() >> 6, wm = wave >> 1, wn = wave & 1, fr = lane & 15, fq = lane >> 4;
    for (int tile = vb0; tile < 64 * 8; tile += nvb) {
        int mt = tile % 64, nt = tile / 64;
        f32x4 tot[4][4];
#pragma unroll
        for (int a = 0; a < 4; ++a)
#pragma unroll
            for (int b = 0; b < 4; ++b) tot[a][b] = f32x4{0.f, 0.f, 0.f, 0.f};
        for (int g = 0; g < 3; ++g) {
            f32x4 acc[4][4];
#pragma unroll
            for (int a = 0; a < 4; ++a)
#pragma unroll
                for (int b = 0; b < 4; ++b) acc[a][b] = f32x4{0.f, 0.f, 0.f, 0.f};
            gemm_tile(Y + g * 512, 1536, WBR + (size_t)g * 1024 * 512, 512, 512, mt * GBM, nt * GBN, sA, sB, acc);
#pragma unroll
            for (int nf = 0; nf < 4; ++nf)
#pragma unroll
                for (int mf = 0; mf < 4; ++mf) {
                    int m = mt * GBM + wm * 64 + mf * 16 + fr, n = nt * GBN + wn * 64 + nf * 16 + fq * 4;
                    uint2 gz = *(const uint2*)(Z + (size_t)m * LDZ + ZM + g * 1024 + n);
                    tot[nf][mf][0] += sigm(bflo(gz.x)) * acc[nf][mf][0];
                    tot[nf][mf][1] += sigm(bfhi(gz.x)) * acc[nf][mf][1];
                    tot[nf][mf][2] += sigm(bflo(gz.y)) * acc[nf][mf][2];
                    tot[nf][mf][3] += sigm(bfhi(gz.y)) * acc[nf][mf][3];
                }
        }
#pragma unroll
        for (int nf = 0; nf < 4; ++nf)
#pragma unroll
            for (int mf = 0; mf < 4; ++mf) {
                int m = mt * GBM + wm * 64 + mf * 16 + fr, n = nt * GBN + wn * 64 + nf * 16 + fq * 4;
                uint2 o; o.x = pack2(tot[nf][mf][0], tot[nf][mf][1]); o.y = pack2(tot[nf][mf][2], tot[nf][mf][3]);
                *(uint2*)(H + (size_t)m * 1024 + n) = o;
            }
    }
}

template <int DK, bool GLA>
__device__ void scan_item(const Params& p, int l, int item, char* smem_) {
    constexpr int TB = 16, KPT = DK / 32, SSTR = NT / DK;
    const int b = item >> 5, h = (item >> 3) & 3, vs = item & 7;
    const int tid = TIDX(), lane = tid & 63, wave = tid >> 6;
    const int kg = tid >> 4, v = tid & 15;
    float* qs = (float*)smem_; float* fs = qs + TB * DK; float* ks = fs + TB * DK; float* vsm = ks + TB * DK; float* wp = vsm + TB * 16;
    const int kl = tid % DK, step0 = tid / DK;
    float lbv = 0.f, gbias = 0.f; float gu[16];
#pragma unroll
    for (int r = 0; r < 16; ++r) gu[r] = 0.f;
    if (GLA) {
#pragma unroll
        for (int r = 0; r < 16; ++r) gu[r] = p.gla_up[(size_t)(l * 16 + r) * 256 + h * 64 + kl];
        gbias = p.gla_bias[l * 256 + h * 64 + kl];
    } else if (l == 1) {
        float x0 = p.hgrn_lb[h * 128 + kl], x1 = p.hgrn_lb[512 + h * 128 + kl];
        lbv = 1.f / (1.f + expf(x0 - x1));
    }
    const float scale = GLA ? 0.125f : 0.08838834764831845f;
    float s[KPT];
#pragma unroll
    for (int i = 0; i < KPT; ++i) s[i] = 0.f;
    const bf16_t* Zb = (const bf16_t*)(p.ws + WS_Z) + (size_t)(b * 2048) * LDZ;
    bf16_t* OX = (bf16_t*)(p.ws + (GLA ? WS_OC : WS_OA));
    for (int t0 = 0; t0 < 2048; t0 += TB) {
        for (int st = step0; st < TB; st += SSTR) {
            const bf16_t* zr = Zb + (size_t)(t0 + st) * LDZ;
            float q, f, kk;
            if (GLA) {
                float x = gbias;
#pragma unroll
                for (int r = 0; r < 16; ++r) x += bf2f(zr[ZC_CODE + r]) * gu[r];
                float ls = fminf(x, 0.f) - log1pf(expf(-fabsf(x)));
                f = expf(ls * (1.f / 16.f));
                q = bf2f(zr[ZC_Q + h * 64 + kl]) * scale; kk = bf2f(zr[ZC_K + h * 64 + kl]);
            } else {
                float lg = bf2f(zr[ZA_F + h * 128 + kl]);
                f = lbv + (1.f - lbv) * sigm(lg); kk = 1.f - f;
                q = bf2f(zr[ZA_Q + h * 128 + kl]) * scale;
            }
            qs[st * DK + kl] = q; fs[st * DK + kl] = f; ks[st * DK + kl] = kk;
        }
        if (tid < TB * 16) {
            int st = tid >> 4, vv = tid & 15;
            vsm[st * 16 + vv] = bf2f(Zb[(size_t)(t0 + st) * LDZ + (GLA ? ZC_V : ZA_I) + h * 128 + vs * 16 + vv]);
        }
        __syncthreads();
        float po[TB];
#pragma unroll
        for (int st = 0; st < TB; ++st) {
            float vv = vsm[st * 16 + v], a = 0.f;
#pragma unroll
            for (int i = 0; i < KPT; ++i) {
                int k = kg * KPT + i;
                s[i] = fs[st * DK + k] * s[i] + ks[st * DK + k] * vv;
                a += qs[st * DK + k] * s[i];
            }
            a += __shfl_xor(a, 16); a += __shfl_xor(a, 32);
            po[st] = a;
        }
        if (lane < 16) {
#pragma unroll
            for (int st = 0; st < TB; ++st) wp[(wave * TB + st) * 16 + lane] = po[st];
        }
        __syncthreads();
        if (tid < TB * 16) {
            int st = tid >> 4, vv = tid & 15; float o = 0.f;
#pragma unroll
            for (int w = 0; w < 8; ++w) o += wp[(w * TB + st) * 16 + vv];
            OX[(size_t)(b * 2048 + t0 + st) * 512 + h * 128 + vs * 16 + vv] = f2bf(o);
        }
        __syncthreads();
    }
}

template <int DK, bool GLA>
__device__ void scan2_item(const Params& p, int l, int b, int h, char* smem_) {
    constexpr int SEG = NT / DK, SLEN = 64 / SEG, KS = DK / 32, KT = DK / 16;
    constexpr int QS = DK + 8, BS = DK + 4, VS = 72;
    bf16_t* qs = (bf16_t*)smem_;
    bf16_t* ks = qs + 64 * QS;
    float* bs = (float*)(ks + 64 * QS);
    bf16_t* vt = (bf16_t*)(bs + 64 * BS);
    bf16_t* At = vt + 128 * VS;
    bf16_t* kht = At + 64 * VS;
    bf16_t* st = kht + DK * VS;
    float* segtot = (float*)(st + 128 * QS);
    float* blast = segtot + SEG * DK;
    const int tid = TIDX(), lane = tid & 63, wave = __builtin_amdgcn_readfirstlane(tid >> 6), fr = lane & 15, fq = lane >> 4;
    const int kl = tid % DK, seg = tid / DK;
    float lbv = 0.f, gbias = 0.f; float gu[16];
#pragma unroll
    for (int r = 0; r < 16; ++r) gu[r] = 0.f;
    if (GLA) {
#pragma unroll
        for (int r = 0; r < 16; ++r) gu[r] = p.gla_up[(size_t)(l * 16 + r) * 256 + h * 64 + kl];
        gbias = p.gla_bias[l * 256 + h * 64 + kl];
    } else if (l == 1) {
        float x0 = p.hgrn_lb[h * 128 + kl], x1 = p.hgrn_lb[512 + h * 128 + kl];
        lbv = 1.f / (1.f + expf(x0 - x1));
    }
    const float scale = GLA ? 0.125f : 0.08838834764831845f;
    const bf16_t* Zb = (const bf16_t*)(p.ws + WS_Z) + (size_t)(b * 2048) * LDZ;
    bf16_t* OX = (bf16_t*)(p.ws + (GLA ? WS_OC : WS_OA));
    const int QCOL = (GLA ? ZC_Q : ZA_Q) + h * DK, KCOL = (GLA ? ZC_K : ZA_F) + h * DK, VCOL = (GLA ? ZC_V : ZA_I) + h * 128;
    f32x4 sacc[KT];
#pragma unroll
    for (int i = 0; i < KT; ++i) sacc[i] = f32x4{0.f, 0.f, 0.f, 0.f};
    for (int i = tid; i < 128 * QS / 2; i += NT) ((unsigned*)st)[i] = 0u;
    __syncthreads();

    for (int c = 0; c < 32; ++c) {
        const bf16_t* Zc = Zb + (size_t)(c * 64) * LDZ;
        float loc[SLEN], kraw[SLEN];
        {
            bf16_t rq[SLEN], rk[SLEN], rv[16];
            u32x4 rc0[GLA ? SLEN : 1], rc1[GLA ? SLEN : 1];
#pragma unroll
            for (int i = 0; i < SLEN; ++i) {
                const bf16_t* zr = Zc + (size_t)(seg * SLEN + i) * LDZ;
                rq[i] = zr[QCOL + kl]; rk[i] = zr[KCOL + kl];
                if (GLA) { rc0[i] = *(const u32x4*)(zr + ZC_CODE); rc1[i] = *(const u32x4*)(zr + ZC_CODE + 8); }
            }
            {
                const int v = tid & 127, sb_ = tid >> 7;
#pragma unroll
                for (int i = 0; i < 16; ++i) rv[i] = Zc[(size_t)(sb_ + 4 * i) * LDZ + VCOL + v];
            }
            float run = 0.f;
#pragma unroll
            for (int i = 0; i < SLEN; ++i) {
                const int s_ = seg * SLEN + i;
                float g, kk;
                if (GLA) {
                    float x = gbias;
#pragma unroll
                    for (int r = 0; r < 4; ++r) {
                        x += bflo(rc0[i][r]) * gu[2 * r] + bfhi(rc0[i][r]) * gu[2 * r + 1];
                        x += bflo(rc1[i][r]) * gu[8 + 2 * r] + bfhi(rc1[i][r]) * gu[8 + 2 * r + 1];
                    }
                    g = (fminf(x, 0.f) - __logf(1.f + __expf(-fabsf(x)))) * (1.f / 16.f);
                    kk = bf2f(rk[i]);
                } else {
                    const float f = lbv + (1.f - lbv) * __frcp_rn(1.f + __expf(-bf2f(rk[i])));
                    g = __logf(f); kk = 1.f - f;
                }
                run += g; loc[i] = run; kraw[i] = kk;
                qs[s_ * QS + kl] = rq[i];
                ks[s_ * QS + kl] = f2bf(kk);
            }
            segtot[seg * DK + kl] = run;
            {
                const int v = tid & 127, sb_ = tid >> 7;
#pragma unroll
                for (int i = 0; i < 16; ++i) vt[v * VS + sb_ + 4 * i] = rv[i];
            }
        }
        __syncthreads();
        {
            float pre = 0.f, tot = 0.f;
#pragma unroll
            for (int g_ = 0; g_ < SEG; ++g_) { const float v_ = segtot[g_ * DK + kl]; if (g_ < seg) pre += v_; tot += v_; }
            if (seg == 0) blast[kl] = tot;
            unsigned pk[SLEN / 2];
#pragma unroll
            for (int i = 0; i < SLEN; ++i) {
                const float bv = loc[i] + pre;
                bs[(seg * SLEN + i) * BS + kl] = bv;
                const float kh = kraw[i] * __expf(tot - bv);
                if (i & 1) pk[i >> 1] |= ((unsigned)f2bf(kh)) << 16; else pk[i >> 1] = (unsigned)f2bf(kh);
            }
            unsigned* dst = (unsigned*)(kht + kl * VS + seg * SLEN);
#pragma unroll
            for (int i = 0; i < SLEN / 2; ++i) dst[i] = pk[i];
        }
        __syncthreads();
        for (int blk = wave; blk < 10; blk += 8) {
            int bi, bj;
            if (blk < 1) { bi = 0; bj = 0; } else if (blk < 3) { bi = 1; bj = blk - 1; } else if (blk < 6) { bi = 2; bj = blk - 3; } else { bi = 3; bj = blk - 6; }
            f32x4 acc = f32x4{0.f, 0.f, 0.f, 0.f};
            const int srow = bj * 16 + fr, trow = bi * 16 + fr;
#pragma unroll
            for (int kk = 0; kk < KS; ++kk) {
                const int k0 = kk * 32 + fq * 8;
                float br[8];
                if (bi == 0) {
#pragma unroll
                    for (int j = 0; j < 8; ++j) br[j] = 0.f;
                } else {
                    const float4 r0 = *(const float4*)(bs + (bi * 16 - 1) * BS + k0), r1 = *(const float4*)(bs + (bi * 16 - 1) * BS + k0 + 4);
                    br[0] = r0.x; br[1] = r0.y; br[2] = r0.z; br[3] = r0.w; br[4] = r1.x; br[5] = r1.y; br[6] = r1.z; br[7] = r1.w;
                }
                const uint4 kq = *(const uint4*)(ks + srow * QS + k0), qq = *(const uint4*)(qs + trow * QS + k0);
                const float4 s0 = *(const float4*)(bs + srow * BS + k0), s1 = *(const float4*)(bs + srow * BS + k0 + 4);
                const float4 t0_ = *(const float4*)(bs + trow * BS + k0), t1_ = *(const float4*)(bs + trow * BS + k0 + 4);
                const float bsv[8] = {s0.x, s0.y, s0.z, s0.w, s1.x, s1.y, s1.z, s1.w}, btv[8] = {t0_.x, t0_.y, t0_.z, t0_.w, t1_.x, t1_.y, t1_.z, t1_.w};
                const unsigned kw[4] = {kq.x, kq.y, kq.z, kq.w}, qw[4] = {qq.x, qq.y, qq.z, qq.w};
                union { bf16x8 v; unsigned u[4]; } ka, qb;
#pragma unroll
                for (int j = 0; j < 4; ++j) {
                    const float e0 = __expf(fminf(br[2 * j] - bsv[2 * j], 60.f)), e1 = __expf(fminf(br[2 * j + 1] - bsv[2 * j + 1], 60.f));
                    ka.u[j] = pack2(bflo(kw[j]) * e0, bfhi(kw[j]) * e1);
                    const float f0 = __expf(btv[2 * j] - br[2 * j]), f1 = __expf(btv[2 * j + 1] - br[2 * j + 1]);
                    qb.u[j] = pack2(bflo(qw[j]) * f0, bfhi(qw[j]) * f1);
                }
                acc = __builtin_amdgcn_mfma_f32_16x16x32_bf16(ka.v, qb.v, acc, 0, 0, 0);
            }
            if (bi == bj) {
#pragma unroll
                for (int r = 0; r < 4; ++r) if (4 * fq + r > fr) acc[r] = 0.f;
            }
            uint2 o; o.x = pack2(acc[0], acc[1]); o.y = pack2(acc[2], acc[3]);
            *(uint2*)(At + trow * VS + bj * 16 + 4 * fq) = o;
        }
        if (wave == 2) *(uint2*)(At + (0 * 16 + fr) * VS + 16 + 4 * fq) = make_uint2(0u, 0u);
        if (wave == 3) *(uint2*)(At + (2 * 16 + fr) * VS + 48 + 4 * fq) = make_uint2(0u, 0u);
        __syncthreads();
        {
            const int vrow = wave * 16 + fr;
            const bf16x8 vf0 = *(const bf16x8*)(vt + vrow * VS + fq * 8), vf1 = *(const bf16x8*)(vt + vrow * VS + 32 + fq * 8);
            bf16x8 sf[KS];
#pragma unroll
            for (int kk = 0; kk < KS; ++kk) sf[kk] = *(const bf16x8*)(st + vrow * QS + kk * 32 + fq * 8);
#pragma unroll
            for (int ti = 0; ti < 4; ++ti) {
                const int trow = ti * 16 + fr;
                f32x4 acc = f32x4{0.f, 0.f, 0.f, 0.f};
                acc = __builtin_amdgcn_mfma_f32_16x16x32_bf16(vf0, *(const bf16x8*)(At + trow * VS + fq * 8), acc, 0, 0, 0);
                if (ti >= 2) acc = __builtin_amdgcn_mfma_f32_16x16x32_bf16(vf1, *(const bf16x8*)(At + trow * VS + 32 + fq * 8), acc, 0, 0, 0);
#pragma unroll
                for (int kk = 0; kk < KS; ++kk) {
                    const int k0 = kk * 32 + fq * 8;
                    const uint4 qq = *(const uint4*)(qs + trow * QS + k0);
                    const float4 t0_ = *(const float4*)(bs + trow * BS + k0), t1_ = *(const float4*)(bs + trow * BS + k0 + 4);
                    union { bf16x8 v; unsigned u[4]; } qh;
                    qh.u[0] = pack2(bflo(qq.x) * __expf(t0_.x), bfhi(qq.x) * __expf(t0_.y));
                    qh.u[1] = pack2(bflo(qq.y) * __expf(t0_.z), bfhi(qq.y) * __expf(t0_.w));
                    qh.u[2] = pack2(bflo(qq.z) * __expf(t1_.x), bfhi(qq.z) * __expf(t1_.y));
                    qh.u[3] = pack2(bflo(qq.w) * __expf(t1_.z), bfhi(qq.w) * __expf(t1_.w));
                    acc = __builtin_amdgcn_mfma_f32_16x16x32_bf16(sf[kk], qh.v, acc, 0, 0, 0);
                }
                uint2 o; o.x = pack2(acc[0] * scale, acc[1] * scale); o.y = pack2(acc[2] * scale, acc[3] * scale);
                *(uint2*)(OX + (size_t)(b * 2048 + c * 64 + trow) * 512 + h * 128 + wave * 16 + 4 * fq) = o;
            }
#pragma unroll
            for (int kt = 0; kt < KT; ++kt) {
                const float dec = __expf(blast[kt * 16 + fr]);
                sacc[kt][0] *= dec; sacc[kt][1] *= dec; sacc[kt][2] *= dec; sacc[kt][3] *= dec;
                sacc[kt] = __builtin_amdgcn_mfma_f32_16x16x32_bf16(vf0, *(const bf16x8*)(kht + (kt * 16 + fr) * VS + fq * 8), sacc[kt], 0, 0, 0);
                sacc[kt] = __builtin_amdgcn_mfma_f32_16x16x32_bf16(vf1, *(const bf16x8*)(kht + (kt * 16 + fr) * VS + 32 + fq * 8), sacc[kt], 0, 0, 0);
            }
        }
        __syncthreads();
#pragma unroll
        for (int kt = 0; kt < KT; ++kt)
#pragma unroll
            for (int r = 0; r < 4; ++r) st[(wave * 16 + 4 * fq + r) * QS + kt * 16 + fr] = f2bf(sacc[kt][r]);
    }
    __syncthreads();
}

__device__ void ph_scan(const Params& p, int l, int vb0, int nvb, char* smem_) {
    for (int item = vb0; item < 512; item += nvb) {
        if (item < 256) scan_item<128, false>(p, l, item, smem_);
        else scan_item<64, true>(p, l, item - 256, smem_);
    }
}


__device__ void ph_dsaprep(const Params& p, int l, int vb0, int nvb) {
    const int wave = TIDX() >> 6, lane = TIDX() & 63;
    bf16_t* Z = (bf16_t*)(p.ws + WS_Z);
    for (int t = vb0 * 8 + wave; t < T_TOK; t += nvb * 8) {
#pragma unroll
        for (int grp = 0; grp < 8; ++grp) {
            bf16_t* ptr = Z + (size_t)t * LDZ + (grp < 4 ? ZB_Q : ZB_K) + (grp & 3) * 128 + lane * 2;
            unsigned u = *(unsigned*)ptr;
            float a = bflo(u), b = bfhi(u);
            float ss = wave_sum(a * a + b * b);
            float r = rsqrtf(ss * (1.f / 128.f) + 1e-6f);
            const float* gn = (grp < 4 ? p.dsa_qn : p.dsa_kn) + l * 128 + lane * 2;
            float sc = (grp < 4) ? 0.08838834764831845f : 1.f;
            *(unsigned*)ptr = pack2(a * r * gn[0] * sc, b * r * gn[1] * sc);
        }
    }
}

__device__ void ph_post(const Params& p, int l, int vb0, int nvb) {
    const int wave = TIDX() >> 6, lane = TIDX() & 63;
    const bf16_t* Z = (const bf16_t*)(p.ws + WS_Z);
    const bf16_t* OA = (const bf16_t*)(p.ws + WS_OA); const bf16_t* OC = (const bf16_t*)(p.ws + WS_OC);
    bf16_t* Y = (bf16_t*)(p.ws + WS_Y);
    for (int t = vb0 * 8 + wave; t < T_TOK; t += nvb * 8) {
#pragma unroll
        for (int grp = 0; grp < 8; ++grp) {
            const int hh = grp & 3;
            unsigned u = *(const unsigned*)((grp < 4 ? OA : OC) + (size_t)t * 512 + hh * 128 + lane * 2);
            float a = bflo(u), b = bfhi(u);
            float ss = wave_sum(a * a + b * b);
            float r = rsqrtf(ss * (1.f / 128.f) + 1e-6f);
            const float* gn = (grp < 4 ? p.hgrn_on : p.gla_on) + l * 128 + lane * 2;
            unsigned gz = *(const unsigned*)(Z + (size_t)t * LDZ + (grp < 4 ? ZA_G : ZC_G) + hh * 128 + lane * 2);
            float g0 = bflo(gz), g1 = bfhi(gz);
            float y0 = a * r * gn[0] * (g0 * sigm(g0)), y1 = b * r * gn[1] * (g1 * sigm(g1));
            *(unsigned*)(Y + (size_t)t * 1536 + (grp < 4 ? 0 : 1024) + hh * 128 + lane * 2) = pack2(y0, y1);
        }
    }
}

__device__ void ph_dsa(const Params& p, int l, int vb0, int nvb, char* smem_) {
    float* qi = (float*)smem_;
    float* qn = qi + 256;
    float* wv = qn + 512;
    int* sel = (int*)(wv + 16);
    float* pr = (float*)(sel + 256);
    int* red = (int*)(pr + 1024);
    int* cnt = red + 16;
    const int tid = TIDX(), lane = tid & 63, wave = tid >> 6;
    const bf16_t* Z = (const bf16_t*)(p.ws + WS_Z);
    bf16_t* Y = (bf16_t*)(p.ws + WS_Y);
    const unsigned long long lt_mask = (lane == 0) ? 0ull : (~0ull >> (64 - lane));
    for (int t = vb0; t < T_TOK; t += nvb) {
        const int b = t >> 11, tl = t & 2047, n = tl + 1;
        const bf16_t* zr = Z + (size_t)t * LDZ;
        if (tid < 256) qi[tid] = bf2f(zr[ZB_QI + tid]);
        qn[tid] = bf2f(zr[ZB_Q + tid]);
        if (tid < 4) wv[tid] = bf2f(zr[ZB_WI + tid]) * 0.5f;
        __syncthreads();
        const bf16_t* Zb = Z + (size_t)(b * 2048) * LDZ;
        unsigned mk[4];
#pragma unroll
        for (int i = 0; i < 4; ++i) {
            int s = tid + i * 512; unsigned key = 0u;
            if (s < n) {
                const uint4* kp = (const uint4*)(Zb + (size_t)s * LDZ + ZB_KI);
                float d0 = 0.f, d1 = 0.f, d2 = 0.f, d3 = 0.f;
#pragma unroll
                for (int c = 0; c < 8; ++c) {
                    uint4 u = kp[c];
                    float x[8] = {bflo(u.x), bfhi(u.x), bflo(u.y), bfhi(u.y), bflo(u.z), bfhi(u.z), bflo(u.w), bfhi(u.w)};
#pragma unroll
                    for (int j = 0; j < 8; ++j) {
                        d0 += x[j] * qi[c * 8 + j]; d1 += x[j] * qi[64 + c * 8 + j];
                        d2 += x[j] * qi[128 + c * 8 + j]; d3 += x[j] * qi[192 + c * 8 + j];
                    }
                }
                float sc = wv[0] * fmaxf(d0 * 0.125f, 0.f) + wv[1] * fmaxf(d1 * 0.125f, 0.f) + wv[2] * fmaxf(d2 * 0.125f, 0.f) + wv[3] * fmaxf(d3 * 0.125f, 0.f);
                if (sc == 0.f) sc = 0.f;
                unsigned u = __float_as_uint(sc);
                key = (u & 0x80000000u) ? ~u : (u | 0x80000000u);
            }
            mk[i] = key;
        }
        if (n > 256) {
            unsigned T = 0u;
            for (int bit = 31; bit >= 0; --bit) {
                unsigned cand = T | (1u << bit);
                int c = (mk[0] >= cand) + (mk[1] >= cand) + (mk[2] >= cand) + (mk[3] >= cand);
                c = wave_sum_i(c);
                if (lane == 0) red[(bit & 1) * 8 + wave] = c;
                __syncthreads();
                int tot = 0;
#pragma unroll
                for (int w = 0; w < 8; ++w) tot += red[(bit & 1) * 8 + w];
                if (tot >= 256) T = cand;
            }
            unsigned long long beq[4], bgt[4];
#pragma unroll
            for (int i = 0; i < 4; ++i) { beq[i] = __ballot(mk[i] == T); bgt[i] = __ballot(mk[i] > T); }
            __syncthreads();
            if (lane == 0) {
#pragma unroll
                for (int i = 0; i < 4; ++i) { cnt[i * 8 + wave] = __popcll(beq[i]); cnt[32 + i * 8 + wave] = __popcll(bgt[i]); }
            }
            __syncthreads();
            int cgt = 0;
#pragma unroll
            for (int j = 0; j < 32; ++j) cgt += cnt[32 + j];
            const int need = 256 - cgt;
            int eqbase = 0;
            unsigned long long bsel[4];
#pragma unroll
            for (int i = 0; i < 4; ++i) {
                int before = eqbase;
#pragma unroll
                for (int w = 0; w < 8; ++w) { int cw = cnt[i * 8 + w]; if (w < wave) before += cw; eqbase += cw; }
                int rank = before + __popcll(beq[i] & lt_mask);
                bool s_ = (mk[i] > T) || ((mk[i] == T) && rank < need);
                bsel[i] = __ballot(s_);
            }
            __syncthreads();
            if (lane == 0) {
#pragma unroll
                for (int i = 0; i < 4; ++i) cnt[i * 8 + wave] = __popcll(bsel[i]);
            }
            __syncthreads();
            int sbase = 0;
#pragma unroll
            for (int i = 0; i < 4; ++i) {
                int before = sbase;
#pragma unroll
                for (int w = 0; w < 8; ++w) { int cw = cnt[i * 8 + w]; if (w < wave) before += cw; sbase += cw; }
                if ((bsel[i] >> lane) & 1ull) { int pos = before + __popcll(bsel[i] & lt_mask); if (pos < 256) sel[pos] = tid + i * 512; }
            }
        } else {
            if (tid < n) sel[tid] = tid;
        }
        const int m = n < 256 ? n : 256;
        __syncthreads();
        {
            int j = tid >> 1, hh = tid & 1;
            if (j < m) {
                const uint4* kr = (const uint4*)(Zb + (size_t)sel[j] * LDZ + ZB_K + hh * 256);
                float d0 = 0.f, d1 = 0.f;
#pragma unroll
                for (int c = 0; c < 16; ++c) {
                    uint4 u = kr[c]; const float* q = qn + hh * 256 + c * 8;
                    d0 += bflo(u.x) * q[0] + bfhi(u.x) * q[1] + bflo(u.y) * q[2] + bfhi(u.y) * q[3] + bflo(u.z) * q[4] + bfhi(u.z) * q[5] + bflo(u.w) * q[6] + bfhi(u.w) * q[7];
                }
#pragma unroll
                for (int c = 16; c < 32; ++c) {
                    uint4 u = kr[c]; const float* q = qn + hh * 256 + c * 8;
                    d1 += bflo(u.x) * q[0] + bfhi(u.x) * q[1] + bflo(u.y) * q[2] + bfhi(u.y) * q[3] + bflo(u.z) * q[4] + bfhi(u.z) * q[5] + bflo(u.w) * q[6] + bfhi(u.w) * q[7];
                }
                pr[(2 * hh) * 256 + j] = d0; pr[(2 * hh + 1) * 256 + j] = d1;
            }
        }
        __syncthreads();
        if (wave < 4) {
            float xv[4]; float mx = -INFINITY;
#pragma unroll
            for (int i = 0; i < 4; ++i) { int j = lane + 64 * i; xv[i] = (j < m) ? pr[wave * 256 + j] : -INFINITY; mx = fmaxf(mx, xv[i]); }
            mx = wave_max(mx);
            float sm = 0.f;
#pragma unroll
            for (int i = 0; i < 4; ++i) { xv[i] = expf(xv[i] - mx); sm += xv[i]; }
            sm = wave_sum(sm);
            float inv = 1.f / sm;
#pragma unroll
            for (int i = 0; i < 4; ++i) { int j = lane + 64 * i; pr[wave * 256 + j] = xv[i] * inv; }
        }
        __syncthreads();
        {
            const int d = tid, hd = d >> 7;
            float o = 0.f;
            const bf16_t* vb = Zb + ZB_V + d;
#pragma unroll 8
            for (int j = 0; j < m; ++j) o += pr[hd * 256 + j] * bf2f(vb[(size_t)sel[j] * LDZ]);
            Y[(size_t)t * 1536 + 512 + d] = f2bf(o);
        }
        __syncthreads();
    }
}


__device__ void dsaprep2_item(const Params& p, int l, int item, char* smem_) {
    bf16_t* tile = (bf16_t*)smem_;
    const int tid = TIDX(), lane = tid & 63, wave = tid >> 6;
    bf16_t* Z = (bf16_t*)(p.ws + WS_Z); bf16_t* VT = (bf16_t*)(p.ws + WS_VT);
    {
        const int tb = item * 32;
        for (int tt = wave; tt < 32; tt += 8) {
            const int t = tb + tt;
#pragma unroll
            for (int grp = 0; grp < 8; ++grp) {
                bf16_t* ptr = Z + (size_t)t * LDZ + (grp < 4 ? ZB_Q : ZB_K) + (grp & 3) * 128 + lane * 2;
                unsigned u = *(unsigned*)ptr;
                float a = bflo(u), b = bfhi(u);
                float ss = wave_sum(a * a + b * b);
                float r = rsqrtf(ss * (1.f / 128.f) + 1e-6f);
                const float* gn = (grp < 4 ? p.dsa_qn : p.dsa_kn) + l * 128 + lane * 2;
                float sc = (grp < 4) ? 0.08838834764831845f : 1.f;
                *(unsigned*)ptr = pack2(a * r * gn[0] * sc, b * r * gn[1] * sc);
            }
        }
#pragma unroll
        for (int i = 0; i < 4; ++i) {
            int ch = tid + i * 512, t = ch >> 6, c8 = (ch & 63) * 8;
            uint4 u = *(const uint4*)(Z + (size_t)(tb + t) * LDZ + ZB_V + c8);
            unsigned* d = (unsigned*)(tile + t * 514 + c8);
            d[0] = u.x; d[1] = u.y; d[2] = u.z; d[3] = u.w;
        }
        __syncthreads();
        {
            const int c = tid, b = tb >> 11, s0 = tb & 2047;
            unsigned w[16];
#pragma unroll
            for (int j = 0; j < 16; ++j) w[j] = (unsigned)tile[(2 * j) * 514 + c] | ((unsigned)tile[(2 * j + 1) * 514 + c] << 16);
            uint4* dst = (uint4*)(VT + ((size_t)(b * 512 + c)) * 2048 + s0);
            dst[0] = make_uint4(w[0], w[1], w[2], w[3]); dst[1] = make_uint4(w[4], w[5], w[6], w[7]);
            dst[2] = make_uint4(w[8], w[9], w[10], w[11]); dst[3] = make_uint4(w[12], w[13], w[14], w[15]);
        }
        __syncthreads();
    }
}

__device__ void dsa_select_tile(const Params& p, int b, int tq, char* smem_) {
    int* red = (int*)smem_;
    const int tid = TIDX(), lane = tid & 63, wave = __builtin_amdgcn_readfirstlane(tid >> 6), fr = lane & 15, fq = lane >> 4;
    const bf16_t* Z = (const bf16_t*)(p.ws + WS_Z);
    unsigned short* BMh = (unsigned short*)(p.ws + WS_BM);
    {
        const int t0 = tq * 16, tl = t0 + fr;
        const size_t trow = (size_t)b * 2048 + tl;
        bf16x8 qf[4][2];
#pragma unroll
        for (int h = 0; h < 4; ++h)
#pragma unroll
            for (int ks = 0; ks < 2; ++ks) qf[h][ks] = *(const bf16x8*)(Z + trow * LDZ + ZB_QI + h * 64 + ks * 32 + fq * 8);
        float w[4];
#pragma unroll
        for (int h = 0; h < 4; ++h) w[h] = bf2f(Z[trow * LDZ + ZB_WI + h]) * 0.5f;
        unsigned key[64];
#pragma unroll
        for (int i = 0; i < 16; ++i) {
            const int kt = wave + 8 * i;
            if (kt <= tq) {
                const bf16_t* kr = Z + ((size_t)b * 2048 + kt * 16 + fr) * LDZ + ZB_KI + fq * 8;
                bf16x8 k0 = *(const bf16x8*)kr, k1 = *(const bf16x8*)(kr + 32);
                f32x4 acc[4];
#pragma unroll
                for (int h = 0; h < 4; ++h) {
                    acc[h] = __builtin_amdgcn_mfma_f32_16x16x32_bf16(k0, qf[h][0], f32x4{0.f, 0.f, 0.f, 0.f}, 0, 0, 0);
                    acc[h] = __builtin_amdgcn_mfma_f32_16x16x32_bf16(k1, qf[h][1], acc[h], 0, 0, 0);
                }
#pragma unroll
                for (int r = 0; r < 4; ++r) {
                    float sc = w[0] * fmaxf(acc[0][r] * 0.125f, 0.f) + w[1] * fmaxf(acc[1][r] * 0.125f, 0.f) + w[2] * fmaxf(acc[2][r] * 0.125f, 0.f) + w[3] * fmaxf(acc[3][r] * 0.125f, 0.f);
                    if (sc == 0.f) sc = 0.f;
                    unsigned u = __float_as_uint(sc);
                    unsigned k = (u & 0x80000000u) ? ~u : (u | 0x80000000u);
                    const int s = kt * 16 + 4 * fq + r;
                    key[i * 4 + r] = (s <= tl) ? k : 0u;
                }
            } else {
#pragma unroll
                for (int r = 0; r < 4; ++r) key[i * 4 + r] = 0u;
            }
        }
        unsigned T = 1u; int C = 2047;
        if (t0 >= 256) {
            int ph = 0;
            T = 0u;
            for (int bit = 31; bit >= 0; --bit, ++ph) {
                const unsigned cand = T | (1u << bit);
                int c = 0;
#pragma unroll
                for (int j = 0; j < 64; ++j) c += (key[j] >= cand) ? 1 : 0;
                c += __shfl_xor(c, 16); c += __shfl_xor(c, 32);
                if (fq == 0) red[((ph & 1) * 8 + wave) * 16 + fr] = c;
                __syncthreads();
                int tot = 0;
#pragma unroll
                for (int wv_ = 0; wv_ < 8; ++wv_) tot += red[((ph & 1) * 8 + wv_) * 16 + fr];
                if (tot >= 256) T = cand;
            }
            int need;
            {
                int c = 0;
#pragma unroll
                for (int j = 0; j < 64; ++j) c += (key[j] > T) ? 1 : 0;
                c += __shfl_xor(c, 16); c += __shfl_xor(c, 32);
                if (fq == 0) red[((ph & 1) * 8 + wave) * 16 + fr] = c;
                __syncthreads();
                int tot = 0;
#pragma unroll
                for (int wv_ = 0; wv_ < 8; ++wv_) tot += red[((ph & 1) * 8 + wv_) * 16 + fr];
                need = 256 - tot; ++ph;
            }
            C = 0;
            for (int bit = 10; bit >= 0; --bit, ++ph) {
                const int cand = C | (1 << bit);
                int c = 0;
#pragma unroll
                for (int j = 0; j < 64; ++j) { const int s = (wave + 8 * (j >> 2)) * 16 + 4 * fq + (j & 3); c += (key[j] == T && s < cand) ? 1 : 0; }
                c += __shfl_xor(c, 16); c += __shfl_xor(c, 32);
                if (fq == 0) red[((ph & 1) * 8 + wave) * 16 + fr] = c;
                __syncthreads();
                int tot = 0;
#pragma unroll
                for (int wv_ = 0; wv_ < 8; ++wv_) tot += red[((ph & 1) * 8 + wv_) * 16 + fr];
                if (tot < need) C = cand;
            }
        }
#pragma unroll
        for (int i = 0; i < 16; ++i) {
            unsigned nib = 0u;
#pragma unroll
            for (int r = 0; r < 4; ++r) {
                const unsigned k = key[i * 4 + r]; const int s = (wave + 8 * i) * 16 + 4 * fq + r;
                const bool sel = (k > T) || (k == T && s <= C);
                nib |= (sel ? 1u : 0u) << (4 * fq + r);
            }
            nib |= __shfl_xor(nib, 16); nib |= __shfl_xor(nib, 32);
            if (fq == 0) BMh[trow * 128 + wave + 8 * i] = (unsigned short)nib;
        }
        __syncthreads();
    }
}

__device__ void ph_dsa_attn(const Params& p, int vb0, int nvb) {
    const int tid = TIDX(), lane = tid & 63, wave = __builtin_amdgcn_readfirstlane(tid >> 6), fr = lane & 15, fq = lane >> 4;
    const bf16_t* Z = (const bf16_t*)(p.ws + WS_Z); const bf16_t* VT = (const bf16_t*)(p.ws + WS_VT);
    const unsigned* BM = (const unsigned*)(p.ws + WS_BM); bf16_t* Y = (bf16_t*)(p.ws + WS_Y);
    int it = 0;
    for (int item = vb0; item < 512; item += nvb, ++it) {
        const int b = item >> 6, h = (item >> 4) & 3; int qg = item & 15; if (it & 1) qg = 15 - qg;
        const int t0 = qg * 128 + wave * 16;
        const size_t trow = (size_t)b * 2048 + t0 + fr;
        bf16x8 qf[4];
#pragma unroll
        for (int ks = 0; ks < 4; ++ks) qf[ks] = *(const bf16x8*)(Z + trow * LDZ + ZB_Q + h * 128 + ks * 32 + fq * 8);
        f32x4 o[8];
#pragma unroll
        for (int i = 0; i < 8; ++i) o[i] = f32x4{0.f, 0.f, 0.f, 0.f};
        float m = -INFINITY, lsum = 0.f;
        const unsigned* bmrow = BM + trow * 64;
        const int nsteps = (t0 + 15) / 32 + 1;
        const bf16_t* kbase = Z + ((size_t)b * 2048 + fr) * LDZ + ZB_K + h * 128 + fq * 8;
        const bf16_t* vbase = VT + ((size_t)(b * 4 + h) * 128 + fr) * 2048 + 4 * fq;
        for (int st = 0; st < nsteps; ++st) {
            const int s0 = st * 32;
            f32x4 sa = f32x4{0.f, 0.f, 0.f, 0.f}, sb = f32x4{0.f, 0.f, 0.f, 0.f};
            const bf16_t* ka = kbase + (size_t)s0 * LDZ;
            const bf16_t* kb = ka + (size_t)16 * LDZ;
#pragma unroll
            for (int ks = 0; ks < 4; ++ks) {
                bf16x8 fa = *(const bf16x8*)(ka + ks * 32), fb = *(const bf16x8*)(kb + ks * 32);
                sa = __builtin_amdgcn_mfma_f32_16x16x32_bf16(fa, qf[ks], sa, 0, 0, 0);
                sb = __builtin_amdgcn_mfma_f32_16x16x32_bf16(fb, qf[ks], sb, 0, 0, 0);
            }
            const unsigned mw = bmrow[st] >> (4 * fq);
            float x[8];
#pragma unroll
            for (int r = 0; r < 4; ++r) { x[r] = ((mw >> r) & 1u) ? sa[r] : -INFINITY; x[4 + r] = ((mw >> (16 + r)) & 1u) ? sb[r] : -INFINITY; }
            float mx = fmaxf(fmaxf(fmaxf(x[0], x[1]), fmaxf(x[2], x[3])), fmaxf(fmaxf(x[4], x[5]), fmaxf(x[6], x[7])));
            mx = fmaxf(mx, __shfl_xor(mx, 16)); mx = fmaxf(mx, __shfl_xor(mx, 32));
            const float mnew = fmaxf(m, mx);
            const float msafe = (mnew == -INFINITY) ? 0.f : mnew;
            const float alpha = __expf(m - msafe);
            float pe[8]; float ps = 0.f;
#pragma unroll
            for (int j = 0; j < 8; ++j) { pe[j] = __expf(x[j] - msafe); ps += pe[j]; }
            lsum = lsum * alpha + ps;
            m = mnew;
#pragma unroll
            for (int i = 0; i < 8; ++i) { o[i][0] *= alpha; o[i][1] *= alpha; o[i][2] *= alpha; o[i][3] *= alpha; }
            union { bf16x8 v; unsigned u[4]; } pf;
            pf.u[0] = pack2(pe[0], pe[1]); pf.u[1] = pack2(pe[2], pe[3]); pf.u[2] = pack2(pe[4], pe[5]); pf.u[3] = pack2(pe[6], pe[7]);
            const bf16_t* vr = vbase + s0;
#pragma unroll
            for (int i = 0; i < 8; ++i) {
                union { bf16x8 v; uint2 u[2]; } vf;
                vf.u[0] = *(const uint2*)(vr + (size_t)(i * 16) * 2048);
                vf.u[1] = *(const uint2*)(vr + (size_t)(i * 16) * 2048 + 16);
                o[i] = __builtin_amdgcn_mfma_f32_16x16x32_bf16(vf.v, pf.v, o[i], 0, 0, 0);
            }
        }
        lsum += __shfl_xor(lsum, 16); lsum += __shfl_xor(lsum, 32);
        const float inv = 1.f / lsum;
#pragma unroll
        for (int i = 0; i < 8; ++i) {
            uint2 ov; ov.x = pack2(o[i][0] * inv, o[i][1] * inv); ov.y = pack2(o[i][2] * inv, o[i][3] * inv);
            *(uint2*)(Y + trow * 1536 + 512 + h * 128 + i * 16 + 4 * fq) = ov;
        }
    }
}


constexpr int LDS_BYTES = 155648;
__device__ void ph_mixA(const Params& p, int l, int vb0, int nvb, char* smem_) {
    for (int item = vb0; item < 64; item += nvb) {
        if (item < 32) scan2_item<128, false>(p, l, item >> 2, item & 3, smem_);
        else scan2_item<64, true>(p, l, (item - 32) >> 2, (item - 32) & 3, smem_);
    }
    unsigned* ctr = (unsigned*)(p.ws + WS_CTL) + 3584 + l * 64;
    volatile int* slot = (volatile int*)(smem_ + LDS_BYTES - 64);
    for (;;) {
        if (threadIdx.x == 0) *slot = (int)atomicAdd(ctr, 1u);
        __syncthreads();
        const int idx = *slot;
        __syncthreads();
        if (idx >= 1536) break;
        if (idx < 1024) dsa_select_tile(p, idx & 7, 127 - (idx >> 3), smem_);
        else dsaprep2_item(p, l, idx - 1024, smem_);
    }
}

__device__ __forceinline__ int f2sort(float f) { int i = __float_as_int(f); return i ^ ((i >> 31) & 0x7fffffff); }
__device__ __forceinline__ float sort2f(int i) { return __int_as_float(i ^ ((i >> 31) & 0x7fffffff)); }
#define INSK(K, xv) do { int _x = (xv); \
    _Pragma("unroll") for (int _j = 0; _j < 16; ++_j) { int _hi = max(K[_j], _x); _x = min(K[_j], _x); K[_j] = _hi; } } while (0)
#define INS64(K, xv) do { unsigned long long _x = (xv); \
    _Pragma("unroll") for (int _j = 0; _j < 16; ++_j) { bool _c = _x > K[_j]; unsigned long long _o = K[_j]; K[_j] = _c ? _x : _o; _x = _c ? _o : _x; } } while (0)

__device__ void ph_route(const Params& p, int vb0, int nvb) {
    const float* SC = (const float*)(p.ws + WS_SC);
    int* RI = (int*)(p.ws + WS_RI); float* RG = (float*)(p.ws + WS_RG);
    for (int item = vb0 * NT + TIDX(); item < T_TOK * 8; item += nvb * NT) {
        const int t = item >> 3, h = item & 7;
        const float* s0 = SC + (size_t)t * 2048 + h * 256;
        int k0[16], k1[16];
#pragma unroll
        for (int j = 0; j < 16; ++j) { k0[j] = (int)0x80000000; k1[j] = (int)0x80000000; }
#pragma unroll 1
        for (int i = 0; i < 128; i += 4) {
            float4 a = *(const float4*)(s0 + i), b = *(const float4*)(s0 + 128 + i);
            INSK(k0, (f2sort(a.x) & ~127) | (127 - i)); INSK(k0, (f2sort(a.y) & ~127) | (126 - i));
            INSK(k0, (f2sort(a.z) & ~127) | (125 - i)); INSK(k0, (f2sort(a.w) & ~127) | (124 - i));
            INSK(k1, (f2sort(b.x) & ~127) | (127 - i)); INSK(k1, (f2sort(b.y) & ~127) | (126 - i));
            INSK(k1, (f2sort(b.z) & ~127) | (125 - i)); INSK(k1, (f2sort(b.w) & ~127) | (124 - i));
        }
        float v0[16], v1[16];
#pragma unroll
        for (int j = 0; j < 16; ++j) { k0[j] = 127 - (k0[j] & 127); k1[j] = 127 - (k1[j] & 127); v0[j] = s0[k0[j]]; v1[j] = s0[128 + k1[j]]; }
        unsigned long long ck[16];
#pragma unroll
        for (int j = 0; j < 16; ++j) ck[j] = 0ull;
#pragma unroll
        for (int a = 0; a < 16; ++a)
#pragma unroll
            for (int b = 0; b < 16; ++b)
                if ((a + 1) * (b + 1) <= 16) {
                    unsigned hi = (unsigned)f2sort(v0[a] + v1[b]) ^ 0x80000000u;
                    unsigned lo = ((unsigned)(255 - (a * 16 + b)) << 16) | (unsigned)(k0[a] * 128 + k1[b]);
                    INS64(ck, ((unsigned long long)hi << 32) | lo);
                }
        float e[16]; float sm = 0.f;
        const float mx = sort2f((int)((unsigned)(ck[0] >> 32) ^ 0x80000000u));
#pragma unroll
        for (int j = 0; j < 16; ++j) { e[j] = expf(sort2f((int)((unsigned)(ck[j] >> 32) ^ 0x80000000u)) - mx); sm += e[j]; }
        const float inv = 1.f / sm;
#pragma unroll
        for (int j = 0; j < 16; j += 4) {
            *(int4*)(RI + (size_t)t * 128 + h * 16 + j) = make_int4((int)(ck[j] & 0xffffu), (int)(ck[j + 1] & 0xffffu), (int)(ck[j + 2] & 0xffffu), (int)(ck[j + 3] & 0xffffu));
            *(float4*)(RG + (size_t)t * 128 + h * 16 + j) = make_float4(e[j] * inv, e[j + 1] * inv, e[j + 2] * inv, e[j + 3] * inv);
        }
    }
}

__device__ void ph_gather(const Params& p, int l, int vb0, int nvb, bool dummy = false) {
    const int wave = TIDX() >> 6, lane = TIDX() & 63;
    const bf16_t* H = (const bf16_t*)(p.ws + WS_H); const unsigned char* PU = p.ws + WS_PU; const unsigned char* PV = p.ws + WS_PV;
    const int* RI = (const int*)(p.ws + WS_RI); const float* RG = (const float*)(p.ws + WS_RG);
    const float* modb = (const float*)(p.ws + WS_MOD);
    for (int t = vb0 * 8 + wave; t < T_TOK; t += nvb * 8) {
        const int b = t >> 11;
        float hv[16], y[16];
        {
            const uint4* hp = (const uint4*)(H + (size_t)t * 1024 + lane * 16);
            uint4 a = hp[0], c = hp[1];
            hv[0] = bflo(a.x); hv[1] = bfhi(a.x); hv[2] = bflo(a.y); hv[3] = bfhi(a.y); hv[4] = bflo(a.z); hv[5] = bfhi(a.z); hv[6] = bflo(a.w); hv[7] = bfhi(a.w);
            hv[8] = bflo(c.x); hv[9] = bfhi(c.x); hv[10] = bflo(c.y); hv[11] = bfhi(c.y); hv[12] = bflo(c.z); hv[13] = bfhi(c.z); hv[14] = bflo(c.w); hv[15] = bfhi(c.w);
        }
#pragma unroll
        for (int j = 0; j < 16; ++j) y[j] = 0.f;
        const int e_lo = RI[(size_t)t * 128 + lane], e_hi = RI[(size_t)t * 128 + 64 + lane];
        const float g_lo = RG[(size_t)t * 128 + lane], g_hi = RG[(size_t)t * 128 + 64 + lane];
#pragma unroll 1
        for (int grp = 0; grp < 8; ++grp) {
            const int esrc = grp < 4 ? e_lo : e_hi; const float gsrc = grp < 4 ? g_lo : g_hi;
            uint4 uq[16], vq[16];
#pragma unroll
            for (int j = 0; j < 16; ++j) {
                const int e = __shfl(esrc, (grp * 16 + j) & 63);
                uq[j] = *(const uint4*)(PU + (size_t)e * 1024 + lane * 16);
                vq[j] = *(const uint4*)(PV + (size_t)e * 1024 + lane * 16);
            }
            float part[16];
#pragma unroll
            for (int j = 0; j < 16; ++j) {
                const unsigned uw[4] = {uq[j].x, uq[j].y, uq[j].z, uq[j].w};
                float d = 0.f;
#pragma unroll
                for (int c = 0; c < 4; ++c) {
                    auto f0 = __builtin_amdgcn_cvt_pk_f32_fp8((int)uw[c], false); auto f1 = __builtin_amdgcn_cvt_pk_f32_fp8((int)uw[c], true);
                    d += hv[4 * c] * f0[0] + hv[4 * c + 1] * f0[1] + hv[4 * c + 2] * f1[0] + hv[4 * c + 3] * f1[1];
                }
                part[j] = d;
            }
            float r8[8], r4[4], r2[2];
            const bool b5 = lane & 32, b4 = lane & 16, b3 = lane & 8, b2 = lane & 4;
#pragma unroll
            for (int j = 0; j < 8; ++j) { float snd = b5 ? part[j] : part[j + 8], kp = b5 ? part[j + 8] : part[j]; r8[j] = kp + __shfl_xor(snd, 32); }
#pragma unroll
            for (int j = 0; j < 4; ++j) { float snd = b4 ? r8[j] : r8[j + 4], kp = b4 ? r8[j + 4] : r8[j]; r4[j] = kp + __shfl_xor(snd, 16); }
#pragma unroll
            for (int j = 0; j < 2; ++j) { float snd = b3 ? r4[j] : r4[j + 2], kp = b3 ? r4[j + 2] : r4[j]; r2[j] = kp + __shfl_xor(snd, 8); }
            float d;
            { float snd = b2 ? r2[0] : r2[1], kp = b2 ? r2[1] : r2[0]; d = kp + __shfl_xor(snd, 4); }
            d += __shfl_xor(d, 2); d += __shfl_xor(d, 1);
            d *= (1.f / PU_SCALE);
            const int me = ((lane >> 5) & 1) * 8 + ((lane >> 4) & 1) * 4 + ((lane >> 3) & 1) * 2 + ((lane >> 2) & 1);
            const float gme = __shfl(gsrc, (grp * 16 + me) & 63);
            const float coef = gme * 0.5f * d * (1.f + erff(d * 0.7071067811865476f)) * (1.f / PV_SCALE);
#pragma unroll
            for (int j = 0; j < 16; ++j) {
                const float cj = __shfl(coef, (((j >> 3) & 1) << 5) | (((j >> 2) & 1) << 4) | (((j >> 1) & 1) << 3) | ((j & 1) << 2));
                const unsigned vw[4] = {vq[j].x, vq[j].y, vq[j].z, vq[j].w};
#pragma unroll
                for (int c = 0; c < 4; ++c) {
                    auto f0 = __builtin_amdgcn_cvt_pk_f32_fp8((int)vw[c], false); auto f1 = __builtin_amdgcn_cvt_pk_f32_fp8((int)vw[c], true);
                    y[4 * c] += cj * f0[0]; y[4 * c + 1] += cj * f0[1]; y[4 * c + 2] += cj * f1[0]; y[4 * c + 3] += cj * f1[1];
                }
            }
        }
        const float* gf = modb + (size_t)(l * 8 + b) * 6144 + 5120 + lane * 16;
        float* op = p.out + (size_t)t * 1024 + lane * 16;
        float* wp_ = dummy ? (float*)(p.ws + WS_OA) + (size_t)t * 1024 + lane * 16 : op;
#pragma unroll
        for (int j = 0; j < 16; j += 4) {
            float4 xi = *(const float4*)(op + j), g4 = *(const float4*)(gf + j);
            *(float4*)(wp_ + j) = make_float4(xi.x + g4.x * y[j], xi.y + g4.y * y[j + 1], xi.z + g4.z * y[j + 2], xi.w + g4.w * y[j + 3]);
        }
    }
}

enum { PH_MOD = 0, PH_WPREP, PH_NORM1, PH_GEMM_IN, PH_SCAN, PH_DSAPREP, PH_DSA, PH_POST, PH_MERGE, PH_OUT, PH_NORM2, PH_GEMM_Q, PH_GEMM_SC, PH_ROUTE, PH_GATHER, PH_GATHER_DUMMY, PH_DSASEL };

template <int PH>
__device__ __forceinline__ void run_phase(const Params& p, int l, int vb0, int nvb, char* smem) {
    const float* xin = (l == 0) ? p.x : p.out;
    if (PH == PH_MOD) ph_mod(p, vb0, nvb, smem);
    else if (PH == PH_WPREP) ph_wprep(p, l, vb0, nvb, smem);
    else if (PH == PH_NORM1) ph_norm(p, l, 0, xin, vb0, nvb);
    else if (PH == PH_GEMM_IN) {
        pg8::Gemm g{(const bf16_t*)(p.ws + WS_H), (const bf16_t*)(p.ws + WS_WIN), 1024, 1024, 1024};
        pg8::StaticOrder S; S.init(T_TOK, LDZ, nvb, vb0, 1024, 1024);
        pg8::gemm_phase(( PG8_LAS unsigned char*)smem, g, S, pg8::EpiBf16{(bf16_t*)(p.ws + WS_Z), LDZ});
    }
    else if (PH == PH_SCAN) ph_mixA(p, l, vb0, nvb, smem);
    else if (PH == PH_DSAPREP) { }
    else if (PH == PH_DSA) ph_dsa_attn(p, vb0, nvb);
    else if (PH == PH_POST) ph_post(p, l, vb0, nvb);
    else if (PH == PH_MERGE) {
        pg8::Gemm g{(const bf16_t*)(p.ws + WS_Y), (const bf16_t*)(p.ws + WS_WBR), 1536, 512, 512};
        pg8::MergeOrder S{vb0, nvb};
        pg8::gemm_phase((PG8_LAS unsigned char*)smem, g, S, pg8::EpiMerge{(bf16_t*)(p.ws + WS_H), (const bf16_t*)(p.ws + WS_Z)});
    }
    else if (PH == PH_OUT) {
        pg8::Gemm g{(const bf16_t*)(p.ws + WS_H), (const bf16_t*)(p.ws + WS_WOUT), 1024, 1024, 1024};
        pg8::StaticOrder S; S.init(T_TOK, 1024, nvb, vb0, 1024, 1024);
        pg8::gemm_phase((PG8_LAS unsigned char*)smem, g, S, pg8::EpiResid{xin, p.out, (const float*)(p.ws + WS_MOD) + (size_t)l * 8 * 6144});
    }
    else if (PH == PH_NORM2) ph_norm(p, l, 1, p.out, vb0, nvb);
    else if (PH == PH_GEMM_Q) {
        pg8::Gemm g{(const bf16_t*)(p.ws + WS_H), (const bf16_t*)(p.ws + WS_WQ), 1024, 1024, 1024};
        pg8::StaticOrder S; S.init(T_TOK, 2048, nvb, vb0, 1024, 1024);
        pg8::gemm_phase((PG8_LAS unsigned char*)smem, g, S, pg8::EpiBf16{(bf16_t*)(p.ws + WS_QP), 2048});
    }
    else if (PH == PH_GEMM_SC) gemm_phase((const bf16_t*)(p.ws + WS_QP), 2048, (const bf16_t*)(p.ws + WS_SK), 128, T_TOK, 2048, 128, true,
                                          EpiF32{(float*)(p.ws + WS_SC), 2048}, vb0, nvb, smem);
    else if (PH == PH_ROUTE) ph_route(p, vb0, nvb);
    else if (PH == PH_GATHER) ph_gather(p, l, vb0, nvb);
    else if (PH == PH_GATHER_DUMMY) ph_gather(p, l, vb0, nvb, true);
    else if (PH == PH_DSASEL) { }
}

template <int PH>
__global__ void __launch_bounds__(NT) k_phase(Params p, int l) {
    extern __shared__ __attribute__((aligned(16))) char smem[];
    run_phase<PH>(p, l, (int)blockIdx.x, (int)gridDim.x, smem);
}


#define XB_TMO      128
#define XB_XCNT(j)  (256  + 64 * (j))
#define XB_XSUB(j)  (1280 + 64 * (j))
#define XB_XGEN(j)  (2304 + 64 * (j))
#define XB_TOP      3328
#define XB_TOPGEN   3392
#define XCD_BAR_WORDS 3456
#define XB_SPIN_CAP (1u << 18)
#define LAS __attribute__((address_space(3)))
__device__ __forceinline__ unsigned xb_ld(unsigned* p)              { return __hip_atomic_load(p, __ATOMIC_RELAXED, __HIP_MEMORY_SCOPE_AGENT); }
__device__ __forceinline__ unsigned xb_add(unsigned* p, unsigned v) { return __hip_atomic_fetch_add(p, v, __ATOMIC_RELAXED, __HIP_MEMORY_SCOPE_AGENT); }
__device__ __forceinline__ unsigned xb_xcc_id() { return (unsigned)__builtin_amdgcn_s_getreg((3 << 11) | 20) & 0xFu; }
#define XB_SPIN(cond, bar) do { unsigned _sp = 0; while (cond) { __builtin_amdgcn_s_sleep(1); \
    if ((++_sp & 255u) == 0u) { if (xb_ld(&(bar)[XB_TMO])) break; if (_sp > XB_SPIN_CAP) { atomicAdd(&(bar)[XB_TMO], 1u); break; } } } } while (0)
struct XcdBarrier { unsigned* bar; unsigned x; volatile LAS unsigned* st; };
__device__ __forceinline__ XcdBarrier xcd_barrier_post(unsigned* bar, volatile LAS unsigned* st) {
    XcdBarrier b; b.bar = bar; b.x = xb_xcc_id(); b.st = st;
    if (threadIdx.x == 0) (void)xb_add(&bar[XB_XCNT(b.x)], 1u);
    return b;
}
__device__ __forceinline__ void xcd_barrier_complete(unsigned* bar, unsigned x, unsigned& nloc, unsigned& nx) {
    const unsigned G = gridDim.x * gridDim.y * gridDim.z;
    unsigned sum, cnt, mine, sp = 0u;
    for (;;) {
        sum = 0u; cnt = 0u; mine = 0u;
#pragma unroll
        for (unsigned j = 0; j < 16; ++j) { const unsigned c = xb_ld(&bar[XB_XCNT(j)]); sum += c; cnt += (c > 0u) ? 1u : 0u; mine = (j == x) ? c : mine; }
        if (sum == G) break;
        __builtin_amdgcn_s_sleep(1);
        if ((++sp & 255u) == 0u) { if (xb_ld(&bar[XB_TMO])) break; if (sp > XB_SPIN_CAP) { atomicAdd(&bar[XB_TMO], 1u); break; } }
    }
    nloc = mine > 0u ? mine : 1u; nx = cnt > 0u ? cnt : 1u;
}
__device__ __forceinline__ void xcd_barrier(const XcdBarrier& b) {
    asm volatile("s_waitcnt vmcnt(0)" ::: "memory");
    __syncthreads();
    if (threadIdx.x == 0) {
        unsigned* bar = b.bar;
        __builtin_amdgcn_s_waitcnt(0);
        unsigned nloc = b.st[0], nx = b.st[1];
        if (nloc == 0u) { xcd_barrier_complete(bar, b.x, nloc, nx); b.st[0] = nloc; b.st[1] = nx; }
        const unsigned old = xb_add(&bar[XB_XSUB(b.x)], 1u);
        const unsigned gen = old / nloc;
        if (old + 1u == (gen + 1u) * nloc) {
            __builtin_amdgcn_fence(__ATOMIC_RELEASE, "agent");
            asm volatile("s_waitcnt vmcnt(0)" ::: "memory");
            const unsigned og = xb_add(&bar[XB_TOP], 1u);
            const unsigned tg = og / nx;
            if (og + 1u == (tg + 1u) * nx) xb_add(&bar[XB_TOPGEN], 1u);
            else XB_SPIN(xb_ld(&bar[XB_TOPGEN]) == tg, bar);
            __builtin_amdgcn_fence(__ATOMIC_ACQUIRE, "agent");
            xb_add(&bar[XB_XGEN(b.x)], 1u);
            asm volatile("s_waitcnt vmcnt(0)" ::: "memory");
        } else {
            XB_SPIN(xb_ld(&bar[XB_XGEN(b.x)]) == gen, bar);
            __builtin_amdgcn_fence(__ATOMIC_ACQUIRE, "agent");
            asm volatile("s_waitcnt vmcnt(0)" ::: "memory");
        }
    }
    __syncthreads();
}

__global__ void __launch_bounds__(NT) mega_kernel(Params p) {
    extern __shared__ __attribute__((aligned(16))) char smem[];
    volatile LAS unsigned* st = (volatile LAS unsigned*)(smem + LDS_BYTES - 16);
    if (threadIdx.x < 4) st[threadIdx.x] = 0u;
    __syncthreads();
    XcdBarrier bar = xcd_barrier_post((unsigned*)(p.ws + WS_CTL), st);
    const int vb = (int)blockIdx.x, nvb = (int)gridDim.x;
#ifndef PROBE_PH
#define PROBE_PH -1
#endif
#define GB() xcd_barrier(bar)
#define RUN(PH, L) do { if ((PROBE_PH == PH && PH != PH_DSAPREP) || (PROBE_PH == PH_GATHER_DUMMY && PH == PH_GATHER)) { int _l = (L), _vb = vb, _nvb = nvb; asm volatile("" : "+s"(_l), "+s"(_vb), "+s"(_nvb)); run_phase<(PROBE_PH == PH_GATHER_DUMMY && PH == PH_GATHER) ? PH_GATHER_DUMMY : PH>(p, _l, _vb, _nvb, smem); __syncthreads(); } int _l = (L), _vb = vb, _nvb = nvb; asm volatile("" : "+s"(_l), "+s"(_vb), "+s"(_nvb)); run_phase<PH>(p, _l, _vb, _nvb, smem); } while (0)
    RUN(PH_MOD, 0);
#pragma unroll 1
    for (int l = 0; l < 2; ++l) {
        RUN(PH_WPREP, l); GB();
        RUN(PH_NORM1, l); GB();
        RUN(PH_GEMM_IN, l); GB();
        RUN(PH_SCAN, l);
        RUN(PH_DSAPREP, l);
        if (PROBE_PH == PH_DSASEL) { int _l = l, _vb = vb, _nvb = nvb; asm volatile("" : "+s"(_l), "+s"(_vb), "+s"(_nvb)); run_phase<PH_DSASEL>(p, _l, _vb, _nvb, smem); }
        GB();
        RUN(PH_DSA, l);
        RUN(PH_POST, l); GB();
        RUN(PH_MERGE, l); GB();
        RUN(PH_OUT, l); GB();
        RUN(PH_NORM2, l); GB();
        RUN(PH_GEMM_Q, l); GB();
        RUN(PH_GEMM_SC, l); GB();
        RUN(PH_ROUTE, l); GB();
        RUN(PH_GATHER, l);
        if (l == 0) GB();
    }
#undef RUN
#undef GB
}

extern "C" void kernel_launch(void* const* d_in, const int* in_sizes, int n_in, void* d_out, int out_size, void* d_ws, size_t ws_size,
                              hipStream_t stream) {
    if (n_in != 20 || ws_size < WS_END) { fprintf(stderr, "kernel_launch: bad inputs (n_in %d ws %zu need %zu)\n", n_in, ws_size, (size_t)WS_END); return; }
    Params p{};
    p.x = (const float*)d_in[0]; p.c = (const float*)d_in[1]; p.w_ada = (const float*)d_in[2]; p.b_ada = (const float*)d_in[3];
    p.norm_mix = (const float*)d_in[4]; p.norm_ffn = (const float*)d_in[5]; p.w_in = (const float*)d_in[6]; p.hgrn_lb = (const float*)d_in[7];
    p.hgrn_on = (const float*)d_in[8]; p.dsa_qn = (const float*)d_in[9]; p.dsa_kn = (const float*)d_in[10]; p.gla_up = (const float*)d_in[11];
    p.gla_bias = (const float*)d_in[12]; p.gla_on = (const float*)d_in[13]; p.w_branch = (const float*)d_in[14]; p.w_out = (const float*)d_in[15];
    p.peer_wq = (const float*)d_in[16]; p.peer_keys = (const float*)d_in[17]; p.peer_u = (const float*)d_in[18]; p.peer_v = (const float*)d_in[19];
    p.out = (float*)d_out; p.ws = (unsigned char*)d_ws;
#if MEGA
    static int grid = 0;
    if (grid == 0) {
        int dev = 0, cus = 0, per_cu = 0;
        hipGetDevice(&dev);
        hipDeviceGetAttribute(&cus, hipDeviceAttributeMultiprocessorCount, dev);
        hipFuncSetAttribute((const void*)mega_kernel, hipFuncAttributeMaxDynamicSharedMemorySize, LDS_BYTES);
        hipOccupancyMaxActiveBlocksPerMultiprocessor(&per_cu, (const void*)mega_kernel, NT, LDS_BYTES);
        if (per_cu < 1) { fprintf(stderr, "kernel_launch: occupancy query says %d blocks per CU\n", per_cu); per_cu = 1; }
        (void)hipGetLastError();
        grid = cus;
    }
    hipMemsetAsync((char*)d_ws + WS_CTL, 0, 16384, stream);
    void* args[] = {&p};
    hipError_t e = hipLaunchCooperativeKernel((const void*)mega_kernel, dim3(grid), dim3(NT), args, LDS_BYTES, stream);
    if (e != hipSuccess) fprintf(stderr, "cooperative launch failed: %s (grid %d)\n", hipGetErrorString(e), grid);
#else
    const int G = 256;
#define LAUNCH(PH, l) hipLaunchKernelGGL(k_phase<PH>, dim3(G), dim3(NT), LDS_BYTES, stream, p, l)
    LAUNCH(PH_MOD, 0);
    for (int l = 0; l < 2; ++l) {
        LAUNCH(PH_WPREP, l);
        LAUNCH(PH_NORM1, l);
        LAUNCH(PH_GEMM_IN, l);
        LAUNCH(PH_SCAN, l);
        LAUNCH(PH_DSAPREP, l);
        LAUNCH(PH_DSA, l);
        LAUNCH(PH_POST, l);
        LAUNCH(PH_MERGE, l);
        LAUNCH(PH_OUT, l);
        LAUNCH(PH_NORM2, l);
        LAUNCH(PH_GEMM_Q, l);
        LAUNCH(PH_GEMM_SC, l);
        LAUNCH(PH_ROUTE, l);
        LAUNCH(PH_GATHER, l);
    }
#endif
}
```

```cpp
#include <hip/hip_runtime.h>
#include <stdint.h>
#include <stdio.h>

#ifndef MEGA
#define MEGA 1
#endif

typedef unsigned short bf16_t;
typedef short bf16x8 __attribute__((ext_vector_type(8)));
typedef float f32x4 __attribute__((ext_vector_type(4)));
typedef unsigned u32x4 __attribute__((ext_vector_type(4)));

#define NT 512
constexpr int T_TOK = 16384, DM = 1024, SEQ = 2048;
constexpr int LDZ = 8704;
constexpr int ZA_Q = 0, ZA_F = 512, ZA_I = 1024, ZA_G = 1536, ZB_Q = 2048, ZB_K = 2560, ZB_V = 3072, ZC_V = 3584, ZC_G = 4096,
              ZB_QI = 4608, ZC_Q = 4864, ZC_K = 5120, ZB_KI = 5376, ZB_WI = 5440, ZC_CODE = 5444, ZM = 5632;
constexpr int IN_COLS = 8532;

constexpr size_t al256(size_t x) { return (x + 255) & ~(size_t)255; }
constexpr size_t WS_CTL = 0;
constexpr size_t WS_MOD = 65536;
constexpr size_t WS_WIN = al256(WS_MOD + (size_t)2 * 8 * 6144 * 4);
constexpr size_t WS_WBR = al256(WS_WIN + (size_t)LDZ * 1024 * 2);
constexpr size_t WS_WOUT = al256(WS_WBR + (size_t)3 * 1024 * 512 * 2);
constexpr size_t WS_WQ = al256(WS_WOUT + (size_t)1024 * 1024 * 2);
constexpr size_t WS_SK = al256(WS_WQ + (size_t)2048 * 1024 * 2);
constexpr size_t WS_PU = al256(WS_SK + (size_t)16 * 128 * 128 * 2);
constexpr size_t WS_PV = al256(WS_PU + (size_t)16384 * 1024);
constexpr size_t WS_H = al256(WS_PV + (size_t)16384 * 1024);
constexpr float PU_SCALE = 32.f, PV_SCALE = 4.f;
constexpr size_t WS_OA = al256(WS_H + (size_t)T_TOK * 1024 * 2);
constexpr size_t WS_OC = al256(WS_OA + (size_t)T_TOK * 512 * 2);
constexpr size_t WS_Y = al256(WS_OC + (size_t)T_TOK * 512 * 2);
constexpr size_t WS_Z = al256(WS_Y + (size_t)T_TOK * 1536 * 2);
constexpr size_t WS_VT = al256(WS_Z + (size_t)T_TOK * LDZ * 2);
constexpr size_t WS_BM = al256(WS_VT + (size_t)T_TOK * 512 * 2);
constexpr size_t WS_END = al256(WS_BM + (size_t)T_TOK * 64 * 4);
constexpr size_t WS_QP = WS_Z;
constexpr size_t WS_SC = al256(WS_QP + (size_t)T_TOK * 2048 * 2);
constexpr size_t WS_RI = al256(WS_SC + (size_t)T_TOK * 2048 * 4);
constexpr size_t WS_RG = al256(WS_RI + (size_t)T_TOK * 128 * 4);
constexpr size_t WS_PP = al256(WS_RG + (size_t)T_TOK * 128 * 4);
static_assert(WS_PP + (size_t)8 * T_TOK * 128 * 4 <= WS_VT, "peer partials overflow the Z region");
static_assert(WS_RG + (size_t)T_TOK * 128 * 4 <= WS_END, "peer alias overflow");

struct Params {
    const float* x; const float* c; const float* w_ada; const float* b_ada; const float* norm_mix; const float* norm_ffn;
    const float* w_in; const float* hgrn_lb; const float* hgrn_on; const float* dsa_qn; const float* dsa_kn;
    const float* gla_up; const float* gla_bias; const float* gla_on; const float* w_branch; const float* w_out;
    const float* peer_wq; const float* peer_keys; const float* peer_u; const float* peer_v;
    float* out; unsigned char* ws;
    int wv, pad;
};

__device__ __forceinline__ float bf2f(bf16_t h) { return __uint_as_float(((unsigned)h) << 16); }
__device__ __forceinline__ float bflo(unsigned u) { return __uint_as_float(u << 16); }
__device__ __forceinline__ float bfhi(unsigned u) { return __uint_as_float(u & 0xffff0000u); }
__device__ __forceinline__ bf16_t f2bf(float f) { unsigned r; asm volatile("v_cvt_pk_bf16_f32 %0, %1, %1" : "=v"(r) : "v"(f)); return (bf16_t)(r & 0xffffu); }
__device__ __forceinline__ unsigned pack2(float a, float b) { unsigned r; asm volatile("v_cvt_pk_bf16_f32 %0, %1, %2" : "=v"(r) : "v"(a), "v"(b)); return r; }
__device__ __forceinline__ int lane_id_opaque() { int l; asm volatile("v_mbcnt_lo_u32_b32 %0, -1, 0\n\tv_mbcnt_hi_u32_b32 %0, -1, %0" : "=v"(l)); return l; }
template <int M> __device__ __forceinline__ int shx_i(int v) {
    if (M < 32) return __builtin_amdgcn_ds_swizzle(v, (M << 10) | 0x1f);
    return __builtin_amdgcn_ds_bpermute((lane_id_opaque() ^ 32) << 2, v);
}
template <int M> __device__ __forceinline__ float shx(float v) { return __int_as_float(shx_i<M>(__float_as_int(v))); }
template <int M> __device__ __forceinline__ int shx(int v) { return shx_i<M>(v); }
template <int M> __device__ __forceinline__ unsigned shx(unsigned v) { return (unsigned)shx_i<M>((int)v); }
__device__ __forceinline__ int bperm(int v, int src) { return __builtin_amdgcn_ds_bpermute(src << 2, v); }
__device__ __forceinline__ float bperm(float v, int src) { return __int_as_float(__builtin_amdgcn_ds_bpermute(src << 2, __float_as_int(v))); }
__device__ __forceinline__ float wave_sum(float v) { v += shx<32>(v); v += shx<16>(v); v += shx<8>(v); v += shx<4>(v); v += shx<2>(v); v += shx<1>(v); return v; }
__device__ __forceinline__ float wave_max(float v) { v = fmaxf(v, shx<32>(v)); v = fmaxf(v, shx<16>(v)); v = fmaxf(v, shx<8>(v)); v = fmaxf(v, shx<4>(v)); v = fmaxf(v, shx<2>(v)); v = fmaxf(v, shx<1>(v)); return v; }
__device__ __forceinline__ int wave_sum_i(int v) { v += shx<32>(v); v += shx<16>(v); v += shx<8>(v); v += shx<4>(v); v += shx<2>(v); v += shx<1>(v); return v; }
__device__ __forceinline__ float sigm(float x) { return __frcp_rn(1.f + __expf(-x)); }

__device__ __forceinline__ unsigned xb_xcc_id() { return (unsigned)__builtin_amdgcn_s_getreg((3 << 11) | 20) & 0xFu; }
__device__ __forceinline__ int TIDXW(int wv) { int t; asm volatile("v_mbcnt_lo_u32_b32 %0, -1, 0\n\tv_mbcnt_hi_u32_b32 %0, -1, %0\n\tv_lshl_or_b32 %0, %1, 6, %0" : "=v"(t) : "s"(wv)); return t; }
#define TIDX() TIDXW(p.wv)

__device__ __forceinline__ int src_col(int j) {
    if (j < 3584) return j;
    if (j < 4096) return j - 3584 + 4420;
    if (j < 4608) return j - 4096 + 4948;
    if (j < 4864) return j - 4608 + 3584;
    if (j < 5120) return j - 4864 + 3908;
    if (j < 5376) return j - 5120 + 4164;
    if (j < 5440) return j - 5376 + 3840;
    if (j < 5444) return j - 5440 + 3904;
    if (j < 5460) return j - 5444 + 4932;
    if (j < 5632) return -1;
    return j - 5632 + 5460;
}

__device__ void ph_mod(const Params& p, int vb0, int nvb, char* smem_) {
    float* sc = (float*)smem_;
    float* part = sc + 8 * 1024;
    float* mod = (float*)(p.ws + WS_MOD);
    const int tid = TIDX(), lane = tid & 63, wave = tid >> 6;
    if (vb0 >= 192) return;
    for (int i = tid; i < 8 * 1024; i += NT) { float c = p.c[i]; sc[i] = c / (1.f + __expf(-c)); }
    __syncthreads();
    for (int task = vb0; task < 192; task += nvb) {
        const int l = task / 96, n0 = (task % 96) * 64;
        const float* w = p.w_ada + (size_t)l * 1024 * 6144 + (size_t)(wave * 128) * 6144 + n0 + lane;
        float acc[8];
#pragma unroll
        for (int b = 0; b < 8; ++b) acc[b] = 0.f;
#pragma unroll 1
        for (int k0 = 0; k0 < 128; k0 += 16) {
            float wv[16];
#pragma unroll
            for (int j = 0; j < 16; ++j) wv[j] = w[(size_t)(k0 + j) * 6144];
#pragma unroll
            for (int j = 0; j < 16; ++j)
#pragma unroll
                for (int b = 0; b < 8; ++b) acc[b] += sc[b * 1024 + wave * 128 + k0 + j] * wv[j];
        }
#pragma unroll
        for (int b = 0; b < 8; ++b) part[(wave * 8 + b) * 64 + lane] = acc[b];
        __syncthreads();
        {
            const int b = tid >> 6, col = tid & 63;
            float v = p.b_ada[l * 6144 + n0 + col];
#pragma unroll
            for (int w_ = 0; w_ < 8; ++w_) v += part[(w_ * 8 + b) * 64 + col];
            mod[(size_t)(l * 8 + b) * 6144 + n0 + col] = v;
        }
        __syncthreads();
    }
}

template <bool MAP>
__device__ void tr_tile(const float* __restrict__ src, int lds_, bf16_t* __restrict__ out, int ldo, int k0, int n0, float* tile, const int tid) {
#pragma unroll
    for (int i = 0; i < 8; ++i) {
        int kk = (tid >> 6) + 8 * i, nn = tid & 63;
        int scol = MAP ? src_col(n0 + nn) : (n0 + nn);
        float v = (scol >= 0) ? src[(size_t)(k0 + kk) * lds_ + scol] : 0.f;
        tile[kk * 65 + nn] = v;
    }
    __syncthreads();
#pragma unroll
    for (int i = 0; i < 4; ++i) {
        int nn = (tid >> 5) + 16 * i, kk = (tid & 31) * 2;
        unsigned v = pack2(tile[kk * 65 + nn], tile[(kk + 1) * 65 + nn]);
        *(unsigned*)(out + (size_t)(n0 + nn) * ldo + k0 + kk) = v;
    }
    __syncthreads();
}
__device__ void conv_chunk(const float* __restrict__ src, bf16_t* __restrict__ dst, size_t base, const int tid) {
#pragma unroll
    for (int i = 0; i < 4; ++i) {
        size_t e = base + (size_t)(i * NT + tid) * 8;
        float4 a = *(const float4*)(src + e), b = *(const float4*)(src + e + 4);
        uint4 o; o.x = pack2(a.x, a.y); o.y = pack2(a.z, a.w); o.z = pack2(b.x, b.y); o.w = pack2(b.z, b.w);
        *(uint4*)(dst + e) = o;
    }
}
__device__ void conv_chunk_fp8(const float* __restrict__ src, unsigned char* __restrict__ dst, size_t base, float scale, const int tid) {
#pragma unroll
    for (int i = 0; i < 4; ++i) {
        size_t e = base + (size_t)(i * NT + tid) * 8;
        float4 a = *(const float4*)(src + e), b = *(const float4*)(src + e + 4);
        int lo = __builtin_amdgcn_cvt_pk_fp8_f32(a.x * scale, a.y * scale, 0, false); lo = __builtin_amdgcn_cvt_pk_fp8_f32(a.z * scale, a.w * scale, lo, true);
        int hi = __builtin_amdgcn_cvt_pk_fp8_f32(b.x * scale, b.y * scale, 0, false); hi = __builtin_amdgcn_cvt_pk_fp8_f32(b.z * scale, b.w * scale, hi, true);
        const size_t row = e >> 10, col = e & 1023;
        *(uint2*)(dst + ((col >> 7) * 16384 + row) * 128 + (col & 127)) = make_uint2((unsigned)lo, (unsigned)hi);
    }
}
__device__ void ph_wprep(const Params& p, int l, int vb0, int nvb, char* smem_) {
    float* tile = (float*)smem_;
    const int tid = TIDX();
    bf16_t* WIN = (bf16_t*)(p.ws + WS_WIN); bf16_t* WBR = (bf16_t*)(p.ws + WS_WBR); bf16_t* WOUT = (bf16_t*)(p.ws + WS_WOUT);
    bf16_t* WQ = (bf16_t*)(p.ws + WS_WQ); bf16_t* SK = (bf16_t*)(p.ws + WS_SK); unsigned char* PU = p.ws + WS_PU; unsigned char* PV = p.ws + WS_PV;
    constexpr int N_WIN = 136 * 16, N_WBR = 3 * 16 * 8, N_WOUT = 16 * 16, N_WQ = 32 * 16, N_SK = 16, N_PU = 1024, N_PV = 1024;
    constexpr int TOTAL = N_WIN + N_WBR + N_WOUT + N_WQ + N_SK + N_PU + N_PV;
    for (int task = vb0; task < TOTAL; task += nvb) {
        int r = task;
        if (r < N_WIN) { int nt = r / 16, kt = r % 16; tr_tile<true>(p.w_in + (size_t)l * 1024 * IN_COLS, IN_COLS, WIN, 1024, kt * 64, nt * 64, tile, tid); continue; }
        r -= N_WIN;
        if (r < N_WBR) { int g = r / 128, rr = r % 128, nt = rr / 8, kt = rr % 8;
            tr_tile<false>(p.w_branch + (size_t)(l * 3 + g) * 512 * 1024, 1024, WBR + (size_t)g * 1024 * 512, 512, kt * 64, nt * 64, tile, tid); continue; }
        r -= N_WBR;
        if (r < N_WOUT) { int nt = r / 16, kt = r % 16; tr_tile<false>(p.w_out + (size_t)l * 1024 * 1024, 1024, WOUT, 1024, kt * 64, nt * 64, tile, tid); continue; }
        r -= N_WOUT;
        if (r < N_WQ) { int nt = r / 16, kt = r % 16; tr_tile<false>(p.peer_wq + (size_t)l * 1024 * 2048, 2048, WQ, 1024, kt * 64, nt * 64, tile, tid); continue; }
        r -= N_WQ;
        if (r < N_SK) { conv_chunk(p.peer_keys + (size_t)l * 16 * 128 * 128, SK, (size_t)r * 16384, tid); continue; }
        r -= N_SK;
        if (r < N_PU) { conv_chunk_fp8(p.peer_u + (size_t)l * 16384 * 1024, PU, (size_t)r * 16384, PU_SCALE, tid); continue; }
        r -= N_PU;
        conv_chunk_fp8(p.peer_v + (size_t)l * 16384 * 1024, PV, (size_t)r * 16384, PV_SCALE, tid);
    }
}

__device__ void ph_norm(const Params& p, int l, int which, const float* xin, int vb0, int nvb) {
    const int wave = TIDX() >> 6, lane = TIDX() & 63;
    const float* gain = (which ? p.norm_ffn : p.norm_mix) + l * 1024;
    const float* modb = (const float*)(p.ws + WS_MOD);
    bf16_t* H = (bf16_t*)(p.ws + WS_H);
    for (int t = vb0 * 8 + wave; t < T_TOK; t += nvb * 8) {
        int b = t >> 11;
        const float* mod = modb + (size_t)(l * 8 + b) * 6144 + (which ? 3072 : 0);
        const float4* xr = (const float4*)(xin + (size_t)t * 1024);
        float4 v[4]; float ss = 0.f;
#pragma unroll
        for (int i = 0; i < 4; ++i) { v[i] = xr[lane + 64 * i]; ss += v[i].x * v[i].x + v[i].y * v[i].y + v[i].z * v[i].z + v[i].w * v[i].w; }
        ss = wave_sum(ss);
        float rstd = rsqrtf(ss * (1.f / 1024.f) + 1e-6f);
#pragma unroll
        for (int i = 0; i < 4; ++i) {
            int idx = (lane + 64 * i) * 4;
            float4 g = *(const float4*)(gain + idx), sc = *(const float4*)(mod + 1024 + idx), sh = *(const float4*)(mod + idx);
            float h0 = v[i].x * rstd * g.x * (1.f + sc.x) + sh.x, h1 = v[i].y * rstd * g.y * (1.f + sc.y) + sh.y;
            float h2 = v[i].z * rstd * g.z * (1.f + sc.z) + sh.z, h3 = v[i].w * rstd * g.w * (1.f + sc.w) + sh.w;
            uint2 o; o.x = pack2(h0, h1); o.y = pack2(h2, h3);
            *(uint2*)(H + (size_t)t * 1024 + idx) = o;
        }
    }
}

constexpr int GBM = 256, GBN = 128, GBK = 64, GLS = 72;
__device__ __forceinline__ void gemm_tile(const bf16_t* __restrict__ A, int lda, const bf16_t* __restrict__ Bt, int ldb, int K,
                                          int m0, int n0, bf16_t* sA, bf16_t* sB, f32x4 (&acc)[4][4], const int tid) {
    const int lane = tid & 63, wave = tid >> 6;
    const int wm = wave >> 1, wn = wave & 1, fr = lane & 15, fq = lane >> 4;
    u32x4 ra[4], rb[2];
    const int crow = tid >> 3, ckc = (tid & 7) * 8;
    const bf16_t* Ag = A + (size_t)(m0 + crow) * lda + ckc;
    const bf16_t* Bg = Bt + (size_t)(n0 + crow) * ldb + ckc;
#pragma unroll
    for (int i = 0; i < 4; ++i) ra[i] = *(const u32x4*)(Ag + (size_t)(64 * i) * lda);
#pragma unroll
    for (int i = 0; i < 2; ++i) rb[i] = *(const u32x4*)(Bg + (size_t)(64 * i) * ldb);
    for (int k0 = 0; k0 < K; k0 += GBK) {
        __syncthreads();
#pragma unroll
        for (int i = 0; i < 4; ++i) *(u32x4*)(sA + (crow + 64 * i) * GLS + ckc) = ra[i];
#pragma unroll
        for (int i = 0; i < 2; ++i) *(u32x4*)(sB + (crow + 64 * i) * GLS + ckc) = rb[i];
        __syncthreads();
        {
            const int kn = (k0 + GBK < K) ? (k0 + GBK) : k0;
#pragma unroll
            for (int i = 0; i < 4; ++i) ra[i] = *(const u32x4*)(Ag + (size_t)(64 * i) * lda + kn);
#pragma unroll
            for (int i = 0; i < 2; ++i) rb[i] = *(const u32x4*)(Bg + (size_t)(64 * i) * ldb + kn);
        }
#pragma unroll
        for (int ks = 0; ks < 2; ++ks) {
            bf16x8 af[4], wf[4];
#pragma unroll
            for (int mf = 0; mf < 4; ++mf) af[mf] = *(const bf16x8*)(sA + (wm * 64 + mf * 16 + fr) * GLS + ks * 32 + fq * 8);
#pragma unroll
            for (int nf = 0; nf < 4; ++nf) wf[nf] = *(const bf16x8*)(sB + (wn * 64 + nf * 16 + fr) * GLS + ks * 32 + fq * 8);
#pragma unroll
            for (int nf = 0; nf < 4; ++nf)
#pragma unroll
                for (int mf = 0; mf < 4; ++mf)
                    acc[nf][mf] = __builtin_amdgcn_mfma_f32_16x16x32_bf16(wf[nf], af[mf], acc[nf][mf], 0, 0, 0);
        }
    }
}


namespace pg8 {
#define PG8_LAS __attribute__((address_space(3)))
constexpr int BM = 256, BK = 64, HALF = 128, HTB = HALF * BK * 2, STAGE_BYTES = 8 * HTB, NXCD = 8, WGM = 8;
__device__ __forceinline__ int lds_byte(int r, int c) { const int st = (r >> 4) * 2 + (c >> 5), rr = r & 15, cc = c & 31, ob = rr * 64 + cc * 2; return st * 1024 + (ob ^ (((ob >> 9) & 1) << 5)); }
__device__ __forceinline__ void stage_rc(int b, int& R, int& C) { const int st = b / 1024, sb = b % 1024, swz = sb ^ (((sb >> 9) & 1) << 5); R = (st >> 1) * 16 + swz / 64; C = (st & 1) * 32 + (swz % 64) / 2; }
__device__ __forceinline__ int perm32(int rho) { const int n = rho >> 4, i = rho & 15; return 8 * (i >> 2) + 4 * n + (i & 3); }
struct Unit { int pm, pn, aux; size_t aoff, boff; };
struct Gemm { const bf16_t* A; const bf16_t* Bt; int lda, ldb, K; };

struct StaticOrder {
    int nM, nN, nwg, G, c, lda, ldb;
    __device__ void init(int M, int N, int G_, int c_, int lda_, int ldb_) { nM = M / BM; nN = N / BM; nwg = nM * nN; G = G_; c = c_; lda = lda_; ldb = ldb_; }
    __device__ bool next(int i, Unit& u) const {
        const long L = (long)i * G + c; if (L >= nwg) return false;
        int wgid = (int)L; { const int q = nwg / NXCD, r = nwg % NXCD, xcd = wgid % NXCD, off = wgid / NXCD; wgid = (xcd < r ? xcd * (q + 1) : r * (q + 1) + (xcd - r) * q) + off; }
        const int nig = WGM * nN, gid = wgid / nig, fm = gid * WGM, gsz = (nM - fm) < WGM ? (nM - fm) : WGM;
        u.pm = fm + ((wgid % nig) % gsz); u.pn = (wgid % nig) / gsz; u.aux = 0;
        u.aoff = (size_t)u.pm * BM * lda * 2; u.boff = (size_t)u.pn * BM * ldb * 2;
        return true;
    }
};
struct MergeOrder {
    int c, G;
    __device__ bool next(int i, Unit& u) const {
        const int tile = c + (i / 3) * G; if (tile >= 256) return false;
        u.pm = tile & 63; u.pn = tile >> 6; u.aux = i % 3;
        u.aoff = ((size_t)u.pm * BM * 1536 + (size_t)u.aux * 512) * 2; u.boff = ((size_t)u.aux * 1024 + (size_t)u.pn * BM) * 512 * 2;
        return true;
    }
};

template <class Epi, class Sched>
__device__ __forceinline__ void gemm_phase(PG8_LAS unsigned char* lds, const Gemm g, const Sched& S, const Epi& E, const int tid) {
    const int wid = __builtin_amdgcn_readfirstlane(tid >> 6), lane = tid & 63, wr = wid >> 2, wc = wid & 3, fr = lane & 15, fq = lane >> 4;
    const int K = g.K, nt = K / BK;
    unsigned voffA[2], voffB[2];
#pragma unroll
    for (int i = 0; i < 2; ++i) { int R, C; stage_rc(tid * 16 + i * 8192, R, C); const int Rb = Epi::PERM ? ((R & ~31) + perm32(R & 31)) : R;
        voffA[i] = (unsigned)(R * g.lda + C) * 2u; voffB[i] = (unsigned)(Rb * g.ldb + C) * 2u; }
    const size_t kstep = (size_t)(BK * 2);
    const size_t hstepA = (size_t)HALF * g.lda * 2, hstepB = (size_t)HALF * g.ldb * 2;
    const unsigned ldsw = (unsigned)wid * 1024u;
    const int aoff = lds_byte(wr * 64 + fr, fq * 8), boff = lds_byte(wc * 32 + fr, fq * 8);
#define PG8_SA(b, h) (((b) * 2 + (h)) * HTB)
#define PG8_SB(b, h) ((4 + (b) * 2 + (h)) * HTB)
#define PG8_STAGE(bufoff, gbase, voff) do { _Pragma("unroll") for (int _i = 0; _i < 2; ++_i) \
        __builtin_amdgcn_global_load_lds((const unsigned*)((const char*)(gbase) + (voff)[_i]), (PG8_LAS unsigned*)(lds + (bufoff) + ldsw + _i * 8192), 16, 0, 0); } while (0)
#define PG8_LDA(dst, b, h) do { _Pragma("unroll") for (int m = 0; m < 4; ++m) _Pragma("unroll") for (int k = 0; k < 2; ++k) dst[m][k] = *(const PG8_LAS bf16x8*)(lds + PG8_SA(b, h) + aoff + m * 2048 + k * 1024); } while (0)
#define PG8_LDB(dst, b, h) do { _Pragma("unroll") for (int n = 0; n < 2; ++n) _Pragma("unroll") for (int k = 0; k < 2; ++k) dst[n][k] = *(const PG8_LAS bf16x8*)(lds + PG8_SB(b, h) + boff + n * 2048 + k * 1024); } while (0)
#define PG8_MMA(ai, bj, At, Bt) do { __builtin_amdgcn_s_setprio(1); _Pragma("unroll") for (int m = 0; m < 4; ++m) _Pragma("unroll") for (int n = 0; n < 2; ++n) _Pragma("unroll") for (int k = 0; k < 2; ++k) \
        acc[ai][bj][m][n] = __builtin_amdgcn_mfma_f32_16x16x32_bf16(Bt[n][k], At[m][k], acc[ai][bj][m][n], 0, 0, 0); __builtin_amdgcn_s_setprio(0); } while (0)
#define PG8_WAIT_V(n) asm volatile("s_waitcnt vmcnt(" #n ")" ::: "memory")
#define PG8_WAIT_L(n) asm volatile("s_waitcnt lgkmcnt(" #n ")" ::: "memory")
#define PG8_BAR __builtin_amdgcn_s_barrier()
#define PG8_SCHED __builtin_amdgcn_sched_barrier(0)
    Unit cur, nxt; int ui = 0;
    if (!S.next(0, cur)) return;
    f32x4 acc[2][2][4][2];
#pragma unroll
    for (int a = 0; a < 2; ++a)
#pragma unroll
        for (int b = 0; b < 2; ++b)
#pragma unroll
            for (int m = 0; m < 4; ++m)
#pragma unroll
                for (int n = 0; n < 2; ++n) acc[a][b][m][n] = f32x4{0.f, 0.f, 0.f, 0.f};
    bf16x8 At[4][2], B0[2][2], B1[2][2];
    const char* cA = (const char*)g.A + cur.aoff; const char* cB = (const char*)g.Bt + cur.boff;
    PG8_STAGE(PG8_SB(0, 0), cB, voffB); PG8_STAGE(PG8_SA(0, 0), cA, voffA); PG8_STAGE(PG8_SB(0, 1), cB + hstepB, voffB); PG8_STAGE(PG8_SA(0, 1), cA + hstepA, voffA);
    if (wr == 1) PG8_BAR;
    PG8_WAIT_V(4); PG8_BAR;
    PG8_STAGE(PG8_SB(1, 0), cB + kstep, voffB); PG8_STAGE(PG8_SA(1, 0), cA + kstep, voffA); PG8_STAGE(PG8_SB(1, 1), cB + hstepB + kstep, voffB);
    PG8_WAIT_V(6); PG8_BAR;
    for (;;) {
        const bool has_next = S.next(ui + 1, nxt);
        const char* nA = has_next ? (const char*)g.A + nxt.aoff : cA; const char* nB = has_next ? (const char*)g.Bt + nxt.boff : cB;
        for (int t = 0; t < nt; t += 2) {
            const bool last = (t == nt - 2);
            const char* a1 = cA + (size_t)(t + 1) * kstep;
            const char* a2 = last ? nA : cA + (size_t)(t + 2) * kstep; const char* b2 = last ? nB : cB + (size_t)(t + 2) * kstep;
            const char* a3 = a2 + kstep; const char* b3 = b2 + kstep;
            PG8_LDB(B0, 0, 0); PG8_SCHED; PG8_LDA(At, 0, 0); PG8_STAGE(PG8_SA(1, 1), a1 + hstepA, voffA);
            PG8_WAIT_L(8); PG8_BAR; PG8_WAIT_L(0); PG8_MMA(0, 0, At, B0); PG8_BAR; PG8_SCHED;
            PG8_LDB(B1, 0, 1); PG8_STAGE(PG8_SB(0, 0), b2, voffB);
            PG8_BAR; PG8_WAIT_L(0); PG8_MMA(0, 1, At, B1); PG8_BAR;
            PG8_LDA(At, 0, 1); PG8_STAGE(PG8_SA(0, 0), a2, voffA);
            PG8_BAR; PG8_WAIT_L(0); PG8_MMA(1, 0, At, B0); PG8_BAR; PG8_SCHED;
            PG8_STAGE(PG8_SB(0, 1), b2 + hstepB, voffB);
            PG8_WAIT_V(6); PG8_BAR; PG8_MMA(1, 1, At, B1); PG8_BAR;
            PG8_LDB(B0, 1, 0); PG8_SCHED; PG8_LDA(At, 1, 0); PG8_STAGE(PG8_SA(0, 1), a2 + hstepA, voffA);
            PG8_WAIT_L(8); PG8_BAR; PG8_WAIT_L(0); PG8_MMA(0, 0, At, B0); PG8_BAR; PG8_SCHED;
            PG8_LDB(B1, 1, 1); PG8_STAGE(PG8_SB(1, 0), b3, voffB);
            PG8_BAR; PG8_WAIT_L(0); PG8_MMA(0, 1, At, B1); PG8_BAR;
            PG8_LDA(At, 1, 1); PG8_STAGE(PG8_SA(1, 0), a3, voffA);
            PG8_BAR; PG8_WAIT_L(0); PG8_MMA(1, 0, At, B0); PG8_BAR; PG8_SCHED;
            PG8_STAGE(PG8_SB(1, 1), b3 + hstepB, voffB);
            PG8_WAIT_V(6); PG8_BAR; PG8_MMA(1, 1, At, B1); PG8_BAR;
        }
        E(acc, cur, wr, wc, fr, fq);
        if (!has_next) break;
#pragma unroll
        for (int a = 0; a < 2; ++a)
#pragma unroll
            for (int b = 0; b < 2; ++b)
#pragma unroll
                for (int m = 0; m < 4; ++m)
#pragma unroll
                    for (int n = 0; n < 2; ++n) acc[a][b][m][n] = f32x4{0.f, 0.f, 0.f, 0.f};
        cur = nxt; cA = nA; cB = nB; ++ui;
    }
    PG8_WAIT_V(0);
    if (wr == 0) PG8_BAR;
    PG8_BAR;
#undef PG8_SA
#undef PG8_SB
#undef PG8_STAGE
#undef PG8_LDA
#undef PG8_LDB
#undef PG8_MMA
#undef PG8_WAIT_V
#undef PG8_WAIT_L
#undef PG8_BAR
#undef PG8_SCHED
}

struct EpiBf16 {
    static constexpr bool PERM = true;
    bf16_t* O; int ldc;
    __device__ __forceinline__ void operator()(const f32x4 (&acc)[2][2][4][2], const Unit& u, int wr, int wc, int fr, int fq) const {
        const int row0 = u.pm * BM + wr * 64 + fr, col0 = u.pn * BM + wc * 32 + 8 * fq;
#pragma unroll
        for (int ai = 0; ai < 2; ++ai)
#pragma unroll
            for (int m = 0; m < 4; ++m) { bf16_t* rowp = O + (size_t)(row0 + ai * HALF + m * 16) * ldc + col0;
#pragma unroll
                for (int bj = 0; bj < 2; ++bj) { const f32x4 v0 = acc[ai][bj][m][0], v1 = acc[ai][bj][m][1];
                    u32x4 w; w.x = pack2(v0[0], v0[1]); w.y = pack2(v0[2], v0[3]); w.z = pack2(v1[0], v1[1]); w.w = pack2(v1[2], v1[3]);
                    *(u32x4*)(rowp + bj * HALF) = w; } }
    }
};
struct EpiResid {
    static constexpr bool PERM = false;
    const float* xin; float* out; const float* mod;
    __device__ __forceinline__ void operator()(const f32x4 (&acc)[2][2][4][2], const Unit& u, int wr, int wc, int fr, int fq) const {
        const int row0 = u.pm * BM + wr * 64 + fr, col0 = u.pn * BM + wc * 32 + 4 * fq;
        const float* gm = mod + (size_t)(row0 >> 11) * 6144 + 2048 + col0;
#pragma unroll
        for (int ai = 0; ai < 2; ++ai)
#pragma unroll
            for (int m = 0; m < 4; ++m) { const size_t ro = (size_t)(row0 + ai * HALF + m * 16) * 1024 + col0;
#pragma unroll
                for (int bj = 0; bj < 2; ++bj)
#pragma unroll
                    for (int n = 0; n < 2; ++n) {
                        const f32x4 g4 = *(const f32x4*)(gm + bj * HALF + n * 16), xi = *(const f32x4*)(xin + ro + bj * HALF + n * 16);
                        *(f32x4*)(out + ro + bj * HALF + n * 16) = xi + g4 * acc[ai][bj][m][n]; } }
    }
};
struct EpiMerge {
    static constexpr bool PERM = true;
    bf16_t* Hm; const bf16_t* Z;
    __device__ __forceinline__ void operator()(const f32x4 (&acc)[2][2][4][2], const Unit& u, int wr, int wc, int fr, int fq) const {
        const int row0 = u.pm * BM + wr * 64 + fr, col0 = u.pn * BM + wc * 32 + 8 * fq, g = u.aux;
#pragma unroll
        for (int ai = 0; ai < 2; ++ai)
#pragma unroll
            for (int m = 0; m < 4; ++m) { const int row = row0 + ai * HALF + m * 16;
#pragma unroll
                for (int bj = 0; bj < 2; ++bj) {
                    const int col = col0 + bj * HALF;
                    const u32x4 gz = *(const u32x4*)(Z + (size_t)row * LDZ + ZM + g * 1024 + col);
                    u32x4 prev = u32x4{0u, 0u, 0u, 0u};
                    if (g > 0) prev = *(const u32x4*)(Hm + (size_t)row * 1024 + col);
                    const f32x4 v0 = acc[ai][bj][m][0], v1 = acc[ai][bj][m][1];
                    u32x4 w;
                    w.x = pack2(bflo(prev.x) + sigm(bflo(gz.x)) * v0[0], bfhi(prev.x) + sigm(bfhi(gz.x)) * v0[1]);
                    w.y = pack2(bflo(prev.y) + sigm(bflo(gz.y)) * v0[2], bfhi(prev.y) + sigm(bfhi(gz.y)) * v0[3]);
                    w.z = pack2(bflo(prev.z) + sigm(bflo(gz.z)) * v1[0], bfhi(prev.z) + sigm(bfhi(gz.z)) * v1[1]);
                    w.w = pack2(bflo(prev.w) + sigm(bflo(gz.w)) * v1[2], bfhi(prev.w) + sigm(bfhi(gz.w)) * v1[3]);
                    *(u32x4*)(Hm + (size_t)row * 1024 + col) = w; } }
    }
};
}

struct EpiZ {
    bf16_t* Z; int ld;
    __device__ __forceinline__ void operator()(int m, int n, const f32x4& v) const {
        uint2 o; o.x = pack2(v[0], v[1]); o.y = pack2(v[2], v[3]);
        *(uint2*)(Z + (size_t)m * ld + n) = o;
    }
};
struct EpiF32 {
    float* C; int ld;
    __device__ __forceinline__ void operator()(int m, int n, const f32x4& v) const {
        *(float4*)(C + (size_t)m * ld + n) = make_float4(v[0], v[1], v[2], v[3]);
    }
};
struct EpiOut {
    const float* xin; float* out; const float* mod;
    __device__ __forceinline__ void operator()(int m, int n, const f32x4& v) const {
        int b = m >> 11;
        float4 g = *(const float4*)(mod + (size_t)b * 6144 + 2048 + n);
        float4 xi = *(const float4*)(xin + (size_t)m * 1024 + n);
        *(float4*)(out + (size_t)m * 1024 + n) = make_float4(xi.x + g.x * v[0], xi.y + g.y * v[1], xi.z + g.z * v[2], xi.w + g.w * v[3]);
    }
};

template <class Epi>
__device__ void gemm_phase(const bf16_t* A, int lda, const bf16_t* Bt, int ldb, int M, int N, int K, bool batched, Epi epi,
                           int vb0, int nvb, char* smem_, const int tid) {
    bf16_t* sA = (bf16_t*)smem_; bf16_t* sB = sA + GBM * GLS;
    const int lane = tid & 63, wave = tid >> 6, wm = wave >> 1, wn = wave & 1, fr = lane & 15, fq = lane >> 4;
    const int MT = M / GBM, NTL = N / GBN;
    for (int tile = vb0; tile < MT * NTL; tile += nvb) {
        int mt = tile % MT, nt = tile / MT;
        f32x4 acc[4][4];
#pragma unroll
        for (int a = 0; a < 4; ++a)
#pragma unroll
            for (int b = 0; b < 4; ++b) acc[a][b] = f32x4{0.f, 0.f, 0.f, 0.f};
        gemm_tile(batched ? A + nt * 128 : A, lda, Bt, ldb, K, mt * GBM, nt * GBN, sA, sB, acc, tid);
#pragma unroll
        for (int nf = 0; nf < 4; ++nf)
#pragma unroll
            for (int mf = 0; mf < 4; ++mf)
                epi(mt * GBM + wm * 64 + mf * 16 + fr, nt * GBN + wn * 64 + nf * 16 + fq * 4, acc[nf][mf]);
    }
}

template <int DK, bool GLA>
__device__ void scan_item(const Params& p, int l, int item, char* smem_) {
    constexpr int TB = 16, KPT = DK / 32, SSTR = NT / DK;
    const int b = item >> 5, h = (item >> 3) & 3, vs = item & 7;
    const int tid = TIDX(), lane = tid & 63, wave = tid >> 6;
    const int kg = tid >> 4, v = tid & 15;
    float* qs = (float*)smem_; float* fs = qs + TB * DK; float* ks = fs + TB * DK; float* vsm = ks + TB * DK; float* wp = vsm + TB * 16;
    const int kl = tid % DK, step0 = tid / DK;
    float lbv = 0.f, gbias = 0.f; float gu[16];
#pragma unroll
    for (int r = 0; r < 16; ++r) gu[r] = 0.f;
    if (GLA) {
#pragma unroll
        for (int r = 0; r < 16; ++r) gu[r] = p.gla_up[(size_t)(l * 16 + r) * 256 + h * 64 + kl];
        gbias = p.gla_bias[l * 256 + h * 64 + kl];
    } else if (l == 1) {
        float x0 = p.hgrn_lb[h * 128 + kl], x1 = p.hgrn_lb[512 + h * 128 + kl];
        lbv = 1.f / (1.f + expf(x0 - x1));
    }
    const float scale = GLA ? 0.125f : 0.08838834764831845f;
    float s[KPT];
#pragma unroll
    for (int i = 0; i < KPT; ++i) s[i] = 0.f;
    const bf16_t* Zb = (const bf16_t*)(p.ws + WS_Z) + (size_t)(b * 2048) * LDZ;
    bf16_t* OX = (bf16_t*)(p.ws + (GLA ? WS_OC : WS_OA));
    for (int t0 = 0; t0 < 2048; t0 += TB) {
        for (int st = step0; st < TB; st += SSTR) {
            const bf16_t* zr = Zb + (size_t)(t0 + st) * LDZ;
            float q, f, kk;
            if (GLA) {
                float x = gbias;
#pragma unroll
                for (int r = 0; r < 16; ++r) x += bf2f(zr[ZC_CODE + r]) * gu[r];
                float ls = fminf(x, 0.f) - log1pf(expf(-fabsf(x)));
                f = expf(ls * (1.f / 16.f));
                q = bf2f(zr[ZC_Q + h * 64 + kl]) * scale; kk = bf2f(zr[ZC_K + h * 64 + kl]);
            } else {
                float lg = bf2f(zr[ZA_F + h * 128 + kl]);
                f = lbv + (1.f - lbv) * sigm(lg); kk = 1.f - f;
                q = bf2f(zr[ZA_Q + h * 128 + kl]) * scale;
            }
            qs[st * DK + kl] = q; fs[st * DK + kl] = f; ks[st * DK + kl] = kk;
        }
        if (tid < TB * 16) {
            int st = tid >> 4, vv = tid & 15;
            vsm[st * 16 + vv] = bf2f(Zb[(size_t)(t0 + st) * LDZ + (GLA ? ZC_V : ZA_I) + h * 128 + vs * 16 + vv]);
        }
        __syncthreads();
        float po[TB];
#pragma unroll
        for (int st = 0; st < TB; ++st) {
            float vv = vsm[st * 16 + v], a = 0.f;
#pragma unroll
            for (int i = 0; i < KPT; ++i) {
                int k = kg * KPT + i;
                s[i] = fs[st * DK + k] * s[i] + ks[st * DK + k] * vv;
                a += qs[st * DK + k] * s[i];
            }
            a += shx<16>(a); a += shx<32>(a);
            po[st] = a;
        }
        if (lane < 16) {
#pragma unroll
            for (int st = 0; st < TB; ++st) wp[(wave * TB + st) * 16 + lane] = po[st];
        }
        __syncthreads();
        if (tid < TB * 16) {
            int st = tid >> 4, vv = tid & 15; float o = 0.f;
#pragma unroll
            for (int w = 0; w < 8; ++w) o += wp[(w * TB + st) * 16 + vv];
            OX[(size_t)(b * 2048 + t0 + st) * 512 + h * 128 + vs * 16 + vv] = f2bf(o);
        }
        __syncthreads();
    }
}

template <int DK, bool GLA>
__device__ void scan2_item(const Params& p, int l, int b, int h, char* smem_) {
    constexpr int SEG = NT / DK, SLEN = 64 / SEG, KS = DK / 32, KT = DK / 16;
    constexpr int QS = DK + 8, BS = DK + 4, VS = 72;
    bf16_t* qs = (bf16_t*)smem_;
    bf16_t* ks = qs + 64 * QS;
    float* bs = (float*)(ks + 64 * QS);
    bf16_t* vt = (bf16_t*)(bs + 64 * BS);
    bf16_t* At = vt + 128 * VS;
    bf16_t* kht = At + 64 * VS;
    bf16_t* st = kht + DK * VS;
    float* segtot = (float*)(st + 128 * QS);
    float* blast = segtot + SEG * DK;
    const int tid = TIDX(), lane = tid & 63, wave = __builtin_amdgcn_readfirstlane(tid >> 6), fr = lane & 15, fq = lane >> 4;
    const int kl = tid % DK, seg = __builtin_amdgcn_readfirstlane(tid / DK);
    float lbv = 0.f, gbias = 0.f; float gu[16];
#pragma unroll
    for (int r = 0; r < 16; ++r) gu[r] = 0.f;
    if (GLA) {
#pragma unroll
        for (int r = 0; r < 16; ++r) gu[r] = p.gla_up[(size_t)(l * 16 + r) * 256 + h * 64 + kl];
        gbias = p.gla_bias[l * 256 + h * 64 + kl];
    } else if (l == 1) {
        float x0 = p.hgrn_lb[h * 128 + kl], x1 = p.hgrn_lb[512 + h * 128 + kl];
        lbv = 1.f / (1.f + expf(x0 - x1));
    }
    const float scale = GLA ? 0.125f : 0.08838834764831845f;
    const bf16_t* Zb = (const bf16_t*)(p.ws + WS_Z) + (size_t)(b * 2048) * LDZ;
    bf16_t* OX = (bf16_t*)(p.ws + (GLA ? WS_OC : WS_OA));
    const int QCOL = (GLA ? ZC_Q : ZA_Q) + h * DK, KCOL = (GLA ? ZC_K : ZA_F) + h * DK, VCOL = (GLA ? ZC_V : ZA_I) + h * 128;
    f32x4 sacc[KT];
#pragma unroll
    for (int i = 0; i < KT; ++i) sacc[i] = f32x4{0.f, 0.f, 0.f, 0.f};
    for (int i = tid; i < 128 * QS / 2; i += NT) ((unsigned*)st)[i] = 0u;
    __syncthreads();

    for (int c = 0; c < 32; ++c) {
        const bf16_t* Zc = Zb + (size_t)(c * 64) * LDZ;
        {
            bf16_t rq[SLEN], rk[SLEN];
            u32x4 rc0[GLA ? SLEN : 1], rc1[GLA ? SLEN : 1];
            {
                bf16_t rv[16];
                const int v = tid & 127, sb_ = __builtin_amdgcn_readfirstlane(tid >> 7);
#pragma unroll
                for (int i = 0; i < 16; ++i) rv[i] = Zc[(size_t)(sb_ + 4 * i) * LDZ + VCOL + v];
#pragma unroll
                for (int i = 0; i < SLEN; ++i) {
                    const bf16_t* zr = Zc + (size_t)(seg * SLEN + i) * LDZ;
                    rq[i] = zr[QCOL + kl]; rk[i] = zr[KCOL + kl];
                    if (GLA) { rc0[i] = *(const u32x4*)(zr + ZC_CODE); rc1[i] = *(const u32x4*)(zr + ZC_CODE + 8); }
                }
#pragma unroll
                for (int i = 0; i < 16; ++i) vt[v * VS + sb_ + 4 * i] = rv[i];
            }
            float run = 0.f;
#pragma unroll
            for (int i = 0; i < SLEN; ++i) {
                const int s_ = seg * SLEN + i;
                float g, kk;
                if (GLA) {
                    float x = gbias;
#pragma unroll
                    for (int r = 0; r < 4; ++r) {
                        x += bflo(rc0[i][r]) * gu[2 * r] + bfhi(rc0[i][r]) * gu[2 * r + 1];
                        x += bflo(rc1[i][r]) * gu[8 + 2 * r] + bfhi(rc1[i][r]) * gu[8 + 2 * r + 1];
                    }
                    g = (fminf(x, 0.f) - __logf(1.f + __expf(-fabsf(x)))) * (1.f / 16.f);
                    kk = bf2f(rk[i]);
                } else {
                    const float f = lbv + (1.f - lbv) * __frcp_rn(1.f + __expf(-bf2f(rk[i])));
                    g = __logf(f); kk = 1.f - f;
                }
                run += g;
                bs[s_ * BS + kl] = run;
                qs[s_ * QS + kl] = rq[i];
                ks[s_ * QS + kl] = f2bf(kk);
            }
            segtot[seg * DK + kl] = run;
        }
        __syncthreads();
        {
            float pre = 0.f, tot = 0.f;
#pragma unroll
            for (int g_ = 0; g_ < SEG; ++g_) { const float v_ = segtot[g_ * DK + kl]; if (g_ < seg) pre += v_; tot += v_; }
            if (seg == 0) blast[kl] = tot;
            unsigned pk[SLEN / 2];
#pragma unroll
            for (int i = 0; i < SLEN; ++i) {
                const float bv = bs[(seg * SLEN + i) * BS + kl] + pre;
                bs[(seg * SLEN + i) * BS + kl] = bv;
                const float kh = bf2f(ks[(seg * SLEN + i) * QS + kl]) * __expf(tot - bv);
                if (i & 1) pk[i >> 1] |= ((unsigned)f2bf(kh)) << 16; else pk[i >> 1] = (unsigned)f2bf(kh);
            }
            unsigned* dst = (unsigned*)(kht + kl * VS + seg * SLEN);
#pragma unroll
            for (int i = 0; i < SLEN / 2; ++i) dst[i] = pk[i];
        }
        __syncthreads();
        for (int blk = wave; blk < 10; blk += 8) {
            int bi, bj;
            if (blk < 1) { bi = 0; bj = 0; } else if (blk < 3) { bi = 1; bj = blk - 1; } else if (blk < 6) { bi = 2; bj = blk - 3; } else { bi = 3; bj = blk - 6; }
            f32x4 acc = f32x4{0.f, 0.f, 0.f, 0.f};
            const int srow = bj * 16 + fr, trow = bi * 16 + fr;
#pragma unroll
            for (int kk = 0; kk < KS; ++kk) {
                const int k0 = kk * 32 + fq * 8;
                float br[8];
                if (bi == 0) {
#pragma unroll
                    for (int j = 0; j < 8; ++j) br[j] = 0.f;
                } else {
                    const float4 r0 = *(const float4*)(bs + (bi * 16 - 1) * BS + k0), r1 = *(const float4*)(bs + (bi * 16 - 1) * BS + k0 + 4);
                    br[0] = r0.x; br[1] = r0.y; br[2] = r0.z; br[3] = r0.w; br[4] = r1.x; br[5] = r1.y; br[6] = r1.z; br[7] = r1.w;
                }
                const uint4 kq = *(const uint4*)(ks + srow * QS + k0), qq = *(const uint4*)(qs + trow * QS + k0);
                const float4 s0 = *(const float4*)(bs + srow * BS + k0), s1 = *(const float4*)(bs + srow * BS + k0 + 4);
                const float4 t0_ = *(const float4*)(bs + trow * BS + k0), t1_ = *(const float4*)(bs + trow * BS + k0 + 4);
                const float bsv[8] = {s0.x, s0.y, s0.z, s0.w, s1.x, s1.y, s1.z, s1.w}, btv[8] = {t0_.x, t0_.y, t0_.z, t0_.w, t1_.x, t1_.y, t1_.z, t1_.w};
                const unsigned kw[4] = {kq.x, kq.y, kq.z, kq.w}, qw[4] = {qq.x, qq.y, qq.z, qq.w};
                union { bf16x8 v; unsigned u[4]; } ka, qb;
#pragma unroll
                for (int j = 0; j < 4; ++j) {
                    const float e0 = __expf(fminf(br[2 * j] - bsv[2 * j], 60.f)), e1 = __expf(fminf(br[2 * j + 1] - bsv[2 * j + 1], 60.f));
                    ka.u[j] = pack2(bflo(kw[j]) * e0, bfhi(kw[j]) * e1);
                    const float f0 = __expf(btv[2 * j] - br[2 * j]), f1 = __expf(btv[2 * j + 1] - br[2 * j + 1]);
                    qb.u[j] = pack2(bflo(qw[j]) * f0, bfhi(qw[j]) * f1);
                }
                acc = __builtin_amdgcn_mfma_f32_16x16x32_bf16(ka.v, qb.v, acc, 0, 0, 0);
            }
            if (bi == bj) {
#pragma unroll
                for (int r = 0; r < 4; ++r) if (4 * fq + r > fr) acc[r] = 0.f;
            }
            uint2 o; o.x = pack2(acc[0], acc[1]); o.y = pack2(acc[2], acc[3]);
            *(uint2*)(At + trow * VS + bj * 16 + 4 * fq) = o;
        }
        {
            unsigned z_ = 0u; asm volatile("" : "+v"(z_));
            if (wave == 2) *(uint2*)(At + (0 * 16 + fr) * VS + 16 + 4 * fq) = make_uint2(z_, z_);
            if (wave == 3) *(uint2*)(At + (2 * 16 + fr) * VS + 48 + 4 * fq) = make_uint2(z_, z_);
        }
        __syncthreads();
        {
            const int ti = wave & 3, vh = wave >> 2, trow = ti * 16 + fr;
            bf16x8 qh[KS];
#pragma unroll
            for (int kk = 0; kk < KS; ++kk) {
                const int k0 = kk * 32 + fq * 8;
                const uint4 qq = *(const uint4*)(qs + trow * QS + k0);
                const float4 t0_ = *(const float4*)(bs + trow * BS + k0), t1_ = *(const float4*)(bs + trow * BS + k0 + 4);
                union { bf16x8 v; unsigned u[4]; } q_;
                q_.u[0] = pack2(bflo(qq.x) * __expf(t0_.x), bfhi(qq.x) * __expf(t0_.y));
                q_.u[1] = pack2(bflo(qq.y) * __expf(t0_.z), bfhi(qq.y) * __expf(t0_.w));
                q_.u[2] = pack2(bflo(qq.z) * __expf(t1_.x), bfhi(qq.z) * __expf(t1_.y));
                q_.u[3] = pack2(bflo(qq.w) * __expf(t1_.z), bfhi(qq.w) * __expf(t1_.w));
                qh[kk] = q_.v;
            }
            const bf16x8 af0 = *(const bf16x8*)(At + trow * VS + fq * 8), af1 = *(const bf16x8*)(At + trow * VS + 32 + fq * 8);
#pragma unroll
            for (int vi = 0; vi < 4; ++vi) {
                const int vrow = vh * 64 + vi * 16 + fr;
                f32x4 acc = f32x4{0.f, 0.f, 0.f, 0.f};
                acc = __builtin_amdgcn_mfma_f32_16x16x32_bf16(*(const bf16x8*)(vt + vrow * VS + fq * 8), af0, acc, 0, 0, 0);
                if (ti >= 2) acc = __builtin_amdgcn_mfma_f32_16x16x32_bf16(*(const bf16x8*)(vt + vrow * VS + 32 + fq * 8), af1, acc, 0, 0, 0);
#pragma unroll
                for (int kk = 0; kk < KS; ++kk)
                    acc = __builtin_amdgcn_mfma_f32_16x16x32_bf16(*(const bf16x8*)(st + vrow * QS + kk * 32 + fq * 8), qh[kk], acc, 0, 0, 0);
                uint2 o; o.x = pack2(acc[0] * scale, acc[1] * scale); o.y = pack2(acc[2] * scale, acc[3] * scale);
                *(uint2*)(OX + (size_t)(b * 2048 + c * 64 + trow) * 512 + h * 128 + vh * 64 + vi * 16 + 4 * fq) = o;
            }
        }
        {
            const int vrow = wave * 16 + fr;
            const bf16x8 vf0 = *(const bf16x8*)(vt + vrow * VS + fq * 8), vf1 = *(const bf16x8*)(vt + vrow * VS + 32 + fq * 8);
#pragma unroll
            for (int kt = 0; kt < KT; ++kt) {
                const float dec = __expf(blast[kt * 16 + fr]);
                sacc[kt][0] *= dec; sacc[kt][1] *= dec; sacc[kt][2] *= dec; sacc[kt][3] *= dec;
                sacc[kt] = __builtin_amdgcn_mfma_f32_16x16x32_bf16(vf0, *(const bf16x8*)(kht + (kt * 16 + fr) * VS + fq * 8), sacc[kt], 0, 0, 0);
                sacc[kt] = __builtin_amdgcn_mfma_f32_16x16x32_bf16(vf1, *(const bf16x8*)(kht + (kt * 16 + fr) * VS + 32 + fq * 8), sacc[kt], 0, 0, 0);
            }
        }
        __syncthreads();
#pragma unroll
        for (int kt = 0; kt < KT; ++kt)
#pragma unroll
            for (int r = 0; r < 4; ++r) st[(wave * 16 + 4 * fq + r) * QS + kt * 16 + fr] = f2bf(sacc[kt][r]);
    }
    __syncthreads();
}

__device__ void ph_scan(const Params& p, int l, int vb0, int nvb, char* smem_) {
    for (int item = vb0; item < 512; item += nvb) {
        if (item < 256) scan_item<128, false>(p, l, item, smem_);
        else scan_item<64, true>(p, l, item - 256, smem_);
    }
}


__device__ void ph_dsaprep(const Params& p, int l, int vb0, int nvb) {
    const int wave = TIDX() >> 6, lane = TIDX() & 63;
    bf16_t* Z = (bf16_t*)(p.ws + WS_Z);
    for (int t = vb0 * 8 + wave; t < T_TOK; t += nvb * 8) {
#pragma unroll
        for (int grp = 0; grp < 8; ++grp) {
            bf16_t* ptr = Z + (size_t)t * LDZ + (grp < 4 ? ZB_Q : ZB_K) + (grp & 3) * 128 + lane * 2;
            unsigned u = *(unsigned*)ptr;
            float a = bflo(u), b = bfhi(u);
            float ss = wave_sum(a * a + b * b);
            float r = rsqrtf(ss * (1.f / 128.f) + 1e-6f);
            const float* gn = (grp < 4 ? p.dsa_qn : p.dsa_kn) + l * 128 + lane * 2;
            float sc = (grp < 4) ? 0.08838834764831845f : 1.f;
            *(unsigned*)ptr = pack2(a * r * gn[0] * sc, b * r * gn[1] * sc);
        }
    }
}

__device__ void ph_post(const Params& p, int l, int vb0, int nvb) {
    const int wave = TIDX() >> 6, lane = TIDX() & 63;
    const bf16_t* Z = (const bf16_t*)(p.ws + WS_Z);
    const bf16_t* OA = (const bf16_t*)(p.ws + WS_OA); const bf16_t* OC = (const bf16_t*)(p.ws + WS_OC);
    bf16_t* Y = (bf16_t*)(p.ws + WS_Y);
    for (int t = vb0 * 8 + wave; t < T_TOK; t += nvb * 8) {
#pragma unroll
        for (int grp = 0; grp < 8; ++grp) {
            const int hh = grp & 3;
            unsigned u = *(const unsigned*)((grp < 4 ? OA : OC) + (size_t)t * 512 + hh * 128 + lane * 2);
            float a = bflo(u), b = bfhi(u);
            float ss = wave_sum(a * a + b * b);
            float r = rsqrtf(ss * (1.f / 128.f) + 1e-6f);
            const float* gn = (grp < 4 ? p.hgrn_on : p.gla_on) + l * 128 + lane * 2;
            unsigned gz = *(const unsigned*)(Z + (size_t)t * LDZ + (grp < 4 ? ZA_G : ZC_G) + hh * 128 + lane * 2);
            float g0 = bflo(gz), g1 = bfhi(gz);
            float y0 = a * r * gn[0] * (g0 * sigm(g0)), y1 = b * r * gn[1] * (g1 * sigm(g1));
            *(unsigned*)(Y + (size_t)t * 1536 + (grp < 4 ? 0 : 1024) + hh * 128 + lane * 2) = pack2(y0, y1);
        }
    }
}

__device__ void ph_dsa(const Params& p, int l, int vb0, int nvb, char* smem_) {
    float* qi = (float*)smem_;
    float* qn = qi + 256;
    float* wv = qn + 512;
    int* sel = (int*)(wv + 16);
    float* pr = (float*)(sel + 256);
    int* red = (int*)(pr + 1024);
    int* cnt = red + 16;
    const int tid = TIDX(), lane = tid & 63, wave = tid >> 6;
    const bf16_t* Z = (const bf16_t*)(p.ws + WS_Z);
    bf16_t* Y = (bf16_t*)(p.ws + WS_Y);
    const unsigned long long lt_mask = (lane == 0) ? 0ull : (~0ull >> (64 - lane));
    for (int t = vb0; t < T_TOK; t += nvb) {
        const int b = t >> 11, tl = t & 2047, n = tl + 1;
        const bf16_t* zr = Z + (size_t)t * LDZ;
        if (tid < 256) qi[tid] = bf2f(zr[ZB_QI + tid]);
        qn[tid] = bf2f(zr[ZB_Q + tid]);
        if (tid < 4) wv[tid] = bf2f(zr[ZB_WI + tid]) * 0.5f;
        __syncthreads();
        const bf16_t* Zb = Z + (size_t)(b * 2048) * LDZ;
        unsigned mk[4];
#pragma unroll
        for (int i = 0; i < 4; ++i) {
            int s = tid + i * 512; unsigned key = 0u;
            if (s < n) {
                const uint4* kp = (const uint4*)(Zb + (size_t)s * LDZ + ZB_KI);
                float d0 = 0.f, d1 = 0.f, d2 = 0.f, d3 = 0.f;
#pragma unroll
                for (int c = 0; c < 8; ++c) {
                    uint4 u = kp[c];
                    float x[8] = {bflo(u.x), bfhi(u.x), bflo(u.y), bfhi(u.y), bflo(u.z), bfhi(u.z), bflo(u.w), bfhi(u.w)};
#pragma unroll
                    for (int j = 0; j < 8; ++j) {
                        d0 += x[j] * qi[c * 8 + j]; d1 += x[j] * qi[64 + c * 8 + j];
                        d2 += x[j] * qi[128 + c * 8 + j]; d3 += x[j] * qi[192 + c * 8 + j];
                    }
                }
                float sc = wv[0] * fmaxf(d0 * 0.125f, 0.f) + wv[1] * fmaxf(d1 * 0.125f, 0.f) + wv[2] * fmaxf(d2 * 0.125f, 0.f) + wv[3] * fmaxf(d3 * 0.125f, 0.f);
                if (sc == 0.f) sc = 0.f;
                unsigned u = __float_as_uint(sc);
                key = (u & 0x80000000u) ? ~u : (u | 0x80000000u);
            }
            mk[i] = key;
        }
        if (n > 256) {
            unsigned T = 0u;
            for (int bit = 31; bit >= 0; --bit) {
                unsigned cand = T | (1u << bit);
                int c = (mk[0] >= cand) + (mk[1] >= cand) + (mk[2] >= cand) + (mk[3] >= cand);
                c = wave_sum_i(c);
                if (lane == 0) red[(bit & 1) * 8 + wave] = c;
                __syncthreads();
                int tot = 0;
#pragma unroll
                for (int w = 0; w < 8; ++w) tot += red[(bit & 1) * 8 + w];
                if (tot >= 256) T = cand;
            }
            unsigned long long beq[4], bgt[4];
#pragma unroll
            for (int i = 0; i < 4; ++i) { beq[i] = __ballot(mk[i] == T); bgt[i] = __ballot(mk[i] > T); }
            __syncthreads();
            if (lane == 0) {
#pragma unroll
                for (int i = 0; i < 4; ++i) { cnt[i * 8 + wave] = __popcll(beq[i]); cnt[32 + i * 8 + wave] = __popcll(bgt[i]); }
            }
            __syncthreads();
            int cgt = 0;
#pragma unroll
            for (int j = 0; j < 32; ++j) cgt += cnt[32 + j];
            const int need = 256 - cgt;
            int eqbase = 0;
            unsigned long long bsel[4];
#pragma unroll
            for (int i = 0; i < 4; ++i) {
                int before = eqbase;
#pragma unroll
                for (int w = 0; w < 8; ++w) { int cw = cnt[i * 8 + w]; if (w < wave) before += cw; eqbase += cw; }
                int rank = before + __popcll(beq[i] & lt_mask);
                bool s_ = (mk[i] > T) || ((mk[i] == T) && rank < need);
                bsel[i] = __ballot(s_);
            }
            __syncthreads();
            if (lane == 0) {
#pragma unroll
                for (int i = 0; i < 4; ++i) cnt[i * 8 + wave] = __popcll(bsel[i]);
            }
            __syncthreads();
            int sbase = 0;
#pragma unroll
            for (int i = 0; i < 4; ++i) {
                int before = sbase;
#pragma unroll
                for (int w = 0; w < 8; ++w) { int cw = cnt[i * 8 + w]; if (w < wave) before += cw; sbase += cw; }
                if ((bsel[i] >> lane) & 1ull) { int pos = before + __popcll(bsel[i] & lt_mask); if (pos < 256) sel[pos] = tid + i * 512; }
            }
        } else {
            if (tid < n) sel[tid] = tid;
        }
        const int m = n < 256 ? n : 256;
        __syncthreads();
        {
            int j = tid >> 1, hh = tid & 1;
            if (j < m) {
                const uint4* kr = (const uint4*)(Zb + (size_t)sel[j] * LDZ + ZB_K + hh * 256);
                float d0 = 0.f, d1 = 0.f;
#pragma unroll
                for (int c = 0; c < 16; ++c) {
                    uint4 u = kr[c]; const float* q = qn + hh * 256 + c * 8;
                    d0 += bflo(u.x) * q[0] + bfhi(u.x) * q[1] + bflo(u.y) * q[2] + bfhi(u.y) * q[3] + bflo(u.z) * q[4] + bfhi(u.z) * q[5] + bflo(u.w) * q[6] + bfhi(u.w) * q[7];
                }
#pragma unroll
                for (int c = 16; c < 32; ++c) {
                    uint4 u = kr[c]; const float* q = qn + hh * 256 + c * 8;
                    d1 += bflo(u.x) * q[0] + bfhi(u.x) * q[1] + bflo(u.y) * q[2] + bfhi(u.y) * q[3] + bflo(u.z) * q[4] + bfhi(u.z) * q[5] + bflo(u.w) * q[6] + bfhi(u.w) * q[7];
                }
                pr[(2 * hh) * 256 + j] = d0; pr[(2 * hh + 1) * 256 + j] = d1;
            }
        }
        __syncthreads();
        if (wave < 4) {
            float xv[4]; float mx = -INFINITY;
#pragma unroll
            for (int i = 0; i < 4; ++i) { int j = lane + 64 * i; xv[i] = (j < m) ? pr[wave * 256 + j] : -INFINITY; mx = fmaxf(mx, xv[i]); }
            mx = wave_max(mx);
            float sm = 0.f;
#pragma unroll
            for (int i = 0; i < 4; ++i) { xv[i] = expf(xv[i] - mx); sm += xv[i]; }
            sm = wave_sum(sm);
            float inv = 1.f / sm;
#pragma unroll
            for (int i = 0; i < 4; ++i) { int j = lane + 64 * i; pr[wave * 256 + j] = xv[i] * inv; }
        }
        __syncthreads();
        {
            const int d = tid, hd = d >> 7;
            float o = 0.f;
            const bf16_t* vb = Zb + ZB_V + d;
#pragma unroll 8
            for (int j = 0; j < m; ++j) o += pr[hd * 256 + j] * bf2f(vb[(size_t)sel[j] * LDZ]);
            Y[(size_t)t * 1536 + 512 + d] = f2bf(o);
        }
        __syncthreads();
    }
}


__device__ void dsaprep2_item(const Params& p, int l, int item, char* smem_) {
    bf16_t* tile = (bf16_t*)smem_;
    const int tid = TIDX(), lane = tid & 63, wave = tid >> 6;
    bf16_t* Z = (bf16_t*)(p.ws + WS_Z); bf16_t* VT = (bf16_t*)(p.ws + WS_VT);
    {
        const int tb = item * 32;
        for (int tt = wave; tt < 32; tt += 8) {
            const int t = tb + tt;
#pragma unroll
            for (int grp = 0; grp < 8; ++grp) {
                bf16_t* ptr = Z + (size_t)t * LDZ + (grp < 4 ? ZB_Q : ZB_K) + (grp & 3) * 128 + lane * 2;
                unsigned u = *(unsigned*)ptr;
                float a = bflo(u), b = bfhi(u);
                float ss = wave_sum(a * a + b * b);
                float r = rsqrtf(ss * (1.f / 128.f) + 1e-6f);
                const float* gn = (grp < 4 ? p.dsa_qn : p.dsa_kn) + l * 128 + lane * 2;
                float sc = (grp < 4) ? 0.08838834764831845f : 1.f;
                *(unsigned*)ptr = pack2(a * r * gn[0] * sc, b * r * gn[1] * sc);
            }
        }
#pragma unroll
        for (int i = 0; i < 4; ++i) {
            int ch = tid + i * 512, t = ch >> 6, c8 = (ch & 63) * 8;
            uint4 u = *(const uint4*)(Z + (size_t)(tb + t) * LDZ + ZB_V + c8);
            unsigned* d = (unsigned*)(tile + t * 514 + c8);
            d[0] = u.x; d[1] = u.y; d[2] = u.z; d[3] = u.w;
        }
        __syncthreads();
        {
            const int c = tid, b = tb >> 11, s0 = tb & 2047;
            unsigned w[16];
#pragma unroll
            for (int j = 0; j < 16; ++j) w[j] = (unsigned)tile[(2 * j) * 514 + c] | ((unsigned)tile[(2 * j + 1) * 514 + c] << 16);
            uint4* dst = (uint4*)(VT + ((size_t)(b * 512 + c)) * 2048 + s0);
            dst[0] = make_uint4(w[0], w[1], w[2], w[3]); dst[1] = make_uint4(w[4], w[5], w[6], w[7]);
            dst[2] = make_uint4(w[8], w[9], w[10], w[11]); dst[3] = make_uint4(w[12], w[13], w[14], w[15]);
        }
        __syncthreads();
    }
}

__device__ void dsa_select_tile(const Params& p, int b, int tq, char* smem_) {
    int* red = (int*)smem_;
    const int tid = TIDX(), lane = tid & 63, wave = __builtin_amdgcn_readfirstlane(tid >> 6), fr = lane & 15, fq = lane >> 4;
    const bf16_t* Z = (const bf16_t*)(p.ws + WS_Z);
    unsigned short* BMh = (unsigned short*)(p.ws + WS_BM);
    {
        const int t0 = tq * 16, tl = t0 + fr;
        const size_t trow = (size_t)b * 2048 + tl;
        bf16x8 qf[4][2];
#pragma unroll
        for (int h = 0; h < 4; ++h)
#pragma unroll
            for (int ks = 0; ks < 2; ++ks) qf[h][ks] = *(const bf16x8*)(Z + trow * LDZ + ZB_QI + h * 64 + ks * 32 + fq * 8);
        float w[4];
#pragma unroll
        for (int h = 0; h < 4; ++h) w[h] = bf2f(Z[trow * LDZ + ZB_WI + h]) * 0.5f;
        unsigned key[64];
#pragma unroll
        for (int i = 0; i < 16; ++i) {
            const int kt = wave + 8 * i;
            if (kt <= tq) {
                const bf16_t* kr = Z + ((size_t)b * 2048 + kt * 16 + fr) * LDZ + ZB_KI + fq * 8;
                bf16x8 k0 = *(const bf16x8*)kr, k1 = *(const bf16x8*)(kr + 32);
                f32x4 acc[4];
#pragma unroll
                for (int h = 0; h < 4; ++h) {
                    acc[h] = __builtin_amdgcn_mfma_f32_16x16x32_bf16(k0, qf[h][0], f32x4{0.f, 0.f, 0.f, 0.f}, 0, 0, 0);
                    acc[h] = __builtin_amdgcn_mfma_f32_16x16x32_bf16(k1, qf[h][1], acc[h], 0, 0, 0);
                }
#pragma unroll
                for (int r = 0; r < 4; ++r) {
                    float sc = w[0] * fmaxf(acc[0][r] * 0.125f, 0.f) + w[1] * fmaxf(acc[1][r] * 0.125f, 0.f) + w[2] * fmaxf(acc[2][r] * 0.125f, 0.f) + w[3] * fmaxf(acc[3][r] * 0.125f, 0.f);
                    if (sc == 0.f) sc = 0.f;
                    unsigned u = __float_as_uint(sc);
                    unsigned k = (u & 0x80000000u) ? ~u : (u | 0x80000000u);
                    const int s = kt * 16 + 4 * fq + r;
                    key[i * 4 + r] = (s <= tl) ? k : 0u;
                }
            } else {
#pragma unroll
                for (int r = 0; r < 4; ++r) key[i * 4 + r] = 0u;
            }
        }
        const int imax = (tq >= wave) ? ((tq - wave) >> 3) : -1;
        unsigned T = 1u; int C = 2047;
        if (t0 >= 256) {
            int ph = 0;
            T = 0u;
            for (int bit = 31; bit >= 0; --bit, ++ph) {
                const unsigned cand = T | (1u << bit);
                int c = 0;
#pragma unroll
                for (int i = 0; i < 16; ++i)
                    if (i <= imax) {
#pragma unroll
                        for (int r = 0; r < 4; ++r) c += (key[i * 4 + r] >= cand) ? 1 : 0;
                    }
                c += shx<16>(c); c += shx<32>(c);
                if (fq == 0) red[((ph & 1) * 8 + wave) * 16 + fr] = c;
                __syncthreads();
                int tot = 0;
#pragma unroll
                for (int wv_ = 0; wv_ < 8; ++wv_) tot += red[((ph & 1) * 8 + wv_) * 16 + fr];
                if (tot >= 256) T = cand;
            }
            int need;
            {
                int c = 0;
#pragma unroll
                for (int i = 0; i < 16; ++i)
                    if (i <= imax) {
#pragma unroll
                        for (int r = 0; r < 4; ++r) c += (key[i * 4 + r] > T) ? 1 : 0;
                    }
                c += shx<16>(c); c += shx<32>(c);
                if (fq == 0) red[((ph & 1) * 8 + wave) * 16 + fr] = c;
                __syncthreads();
                int tot = 0;
#pragma unroll
                for (int wv_ = 0; wv_ < 8; ++wv_) tot += red[((ph & 1) * 8 + wv_) * 16 + fr];
                need = 256 - tot; ++ph;
            }
            C = 0;
            for (int bit = 10; bit >= 0; --bit, ++ph) {
                const int cand = C | (1 << bit);
                int c = 0;
#pragma unroll
                for (int i = 0; i < 16; ++i)
                    if (i <= imax) {
#pragma unroll
                        for (int r = 0; r < 4; ++r) { const int s = (wave + 8 * i) * 16 + 4 * fq + r; c += (key[i * 4 + r] == T && s < cand) ? 1 : 0; }
                    }
                c += shx<16>(c); c += shx<32>(c);
                if (fq == 0) red[((ph & 1) * 8 + wave) * 16 + fr] = c;
                __syncthreads();
                int tot = 0;
#pragma unroll
                for (int wv_ = 0; wv_ < 8; ++wv_) tot += red[((ph & 1) * 8 + wv_) * 16 + fr];
                if (tot < need) C = cand;
            }
        }
#pragma unroll
        for (int i = 0; i < 16; ++i) {
            unsigned nib = 0u;
#pragma unroll
            for (int r = 0; r < 4; ++r) {
                const unsigned k = key[i * 4 + r]; const int s = (wave + 8 * i) * 16 + 4 * fq + r;
                const bool sel = (k > T) || (k == T && s <= C);
                nib |= (sel ? 1u : 0u) << (4 * fq + r);
            }
            nib |= shx<16>(nib); nib |= shx<32>(nib);
            if (fq == 0) BMh[trow * 128 + wave + 8 * i] = (unsigned short)nib;
        }
        __syncthreads();
    }
}

__device__ void ph_dsa_attn(const Params& p, int vb0, int nvb, char* smem_) {
    constexpr int KSTR = 136, VSTR = 40;
    bf16_t* Kl = (bf16_t*)smem_;
    bf16_t* Vl = Kl + 2 * 32 * KSTR;
    const int tid = TIDX(), lane = tid & 63, wave = __builtin_amdgcn_readfirstlane(tid >> 6), fr = lane & 15, fq = lane >> 4;
    const bf16_t* Z = (const bf16_t*)(p.ws + WS_Z); const bf16_t* VT = (const bf16_t*)(p.ws + WS_VT);
    const unsigned* BM = (const unsigned*)(p.ws + WS_BM); bf16_t* Y = (bf16_t*)(p.ws + WS_Y);
    const int kr = tid >> 4, kc = tid & 15, vd = tid >> 2, vc = tid & 3;
    const int ka_row = 8 * (fr >> 2) + (fr & 3);
    int it = 0;
    for (int item = vb0; item < 512; item += nvb, ++it) {
        const int b = item >> 6, h = (item >> 4) & 3; int qg = item & 15; if (it & 1) qg = 15 - qg;
        const int t0 = qg * 128 + wave * 16;
        const size_t trow = (size_t)b * 2048 + t0 + fr;
        bf16x8 qf[4];
#pragma unroll
        for (int ks = 0; ks < 4; ++ks) qf[ks] = *(const bf16x8*)(Z + trow * LDZ + ZB_Q + h * 128 + ks * 32 + fq * 8);
        f32x4 o[8];
#pragma unroll
        for (int i = 0; i < 8; ++i) o[i] = f32x4{0.f, 0.f, 0.f, 0.f};
        float m = -INFINITY, lsum = 0.f;
        const unsigned* bmrow = BM + trow * 64;
        const int nsteps_blk = qg * 4 + 4, nsteps_w = (t0 + 15) / 32 + 1;
        const bf16_t* kg = Z + ((size_t)b * 2048 + kr) * LDZ + ZB_K + h * 128 + kc * 8;
        const bf16_t* vg = VT + ((size_t)(b * 4 + h) * 128 + vd) * 2048 + vc * 8;
        u32x4 rk = *(const u32x4*)kg, rv = *(const u32x4*)vg;
        *(u32x4*)(Kl + kr * KSTR + kc * 8) = rk; *(u32x4*)(Vl + vd * VSTR + vc * 8) = rv;
        __syncthreads();
        for (int st = 0; st < nsteps_blk; ++st) {
            const bool more = (st + 1 < nsteps_blk);
            if (more) { rk = *(const u32x4*)(kg + (size_t)(st + 1) * 32 * LDZ); rv = *(const u32x4*)(vg + (st + 1) * 32); }
            if (st < nsteps_w) {
                const bf16_t* Kb = Kl + (st & 1) * 32 * KSTR; const bf16_t* Vb = Vl + (st & 1) * 128 * VSTR;
                f32x4 sa = f32x4{0.f, 0.f, 0.f, 0.f}, sb = f32x4{0.f, 0.f, 0.f, 0.f};
#pragma unroll
                for (int ks = 0; ks < 4; ++ks) {
                    const bf16x8 fa = *(const bf16x8*)(Kb + ka_row * KSTR + ks * 32 + fq * 8), fb = *(const bf16x8*)(Kb + (ka_row + 4) * KSTR + ks * 32 + fq * 8);
                    sa = __builtin_amdgcn_mfma_f32_16x16x32_bf16(fa, qf[ks], sa, 0, 0, 0);
                    sb = __builtin_amdgcn_mfma_f32_16x16x32_bf16(fb, qf[ks], sb, 0, 0, 0);
                }
                const unsigned mw = bmrow[st] >> (8 * fq);
                float x[8];
#pragma unroll
                for (int r = 0; r < 4; ++r) { x[r] = ((mw >> r) & 1u) ? sa[r] : -INFINITY; x[4 + r] = ((mw >> (4 + r)) & 1u) ? sb[r] : -INFINITY; }
                float mx = fmaxf(fmaxf(fmaxf(x[0], x[1]), fmaxf(x[2], x[3])), fmaxf(fmaxf(x[4], x[5]), fmaxf(x[6], x[7])));
                mx = fmaxf(mx, shx<16>(mx)); mx = fmaxf(mx, shx<32>(mx));
                const float mnew = fmaxf(m, mx);
                const float msafe = (mnew == -INFINITY) ? 0.f : mnew;
                const float alpha = __expf(m - msafe);
                float pe[8]; float ps = 0.f;
#pragma unroll
                for (int j = 0; j < 8; ++j) { pe[j] = __expf(x[j] - msafe); ps += pe[j]; }
                lsum = lsum * alpha + ps;
                m = mnew;
#pragma unroll
                for (int i = 0; i < 8; ++i) { o[i][0] *= alpha; o[i][1] *= alpha; o[i][2] *= alpha; o[i][3] *= alpha; }
                union { bf16x8 v; unsigned u[4]; } pf;
                pf.u[0] = pack2(pe[0], pe[1]); pf.u[1] = pack2(pe[2], pe[3]); pf.u[2] = pack2(pe[4], pe[5]); pf.u[3] = pack2(pe[6], pe[7]);
#pragma unroll
                for (int i = 0; i < 8; ++i) {
                    const bf16x8 vf = *(const bf16x8*)(Vb + (i * 16 + fr) * VSTR + fq * 8);
                    o[i] = __builtin_amdgcn_mfma_f32_16x16x32_bf16(vf, pf.v, o[i], 0, 0, 0);
                }
            }
            if (more) { *(u32x4*)(Kl + ((st + 1) & 1) * 32 * KSTR + kr * KSTR + kc * 8) = rk; *(u32x4*)(Vl + ((st + 1) & 1) * 128 * VSTR + vd * VSTR + vc * 8) = rv; }
            __syncthreads();
        }
        lsum += shx<16>(lsum); lsum += shx<32>(lsum);
        const float inv = 1.f / lsum;
#pragma unroll
        for (int i = 0; i < 8; ++i) {
            uint2 ov; ov.x = pack2(o[i][0] * inv, o[i][1] * inv); ov.y = pack2(o[i][2] * inv, o[i][3] * inv);
            *(uint2*)(Y + trow * 1536 + 512 + h * 128 + i * 16 + 4 * fq) = ov;
        }
    }
}

constexpr int LDS_BYTES = 155648;
__device__ void ph_mixA(const Params& p, int l, int vb0, int nvb, char* smem_) {
    for (int item = vb0; item < 64; item += nvb) {
        if (item < 32) scan2_item<128, false>(p, l, item >> 2, item & 3, smem_);
        else scan2_item<64, true>(p, l, (item - 32) >> 2, (item - 32) & 3, smem_);
    }
    unsigned* ctr = (unsigned*)(p.ws + WS_CTL) + 3584 + l * 64;
    volatile int* slot = (volatile int*)(smem_ + LDS_BYTES - 64);
    for (;;) {
        if (TIDX() == 0) *slot = (int)atomicAdd(ctr, 1u);
        __syncthreads();
        const int idx = *slot;
        __syncthreads();
        if (idx >= 1536) break;
        if (idx < 1024) dsa_select_tile(p, idx & 7, 127 - (idx >> 3), smem_);
        else dsaprep2_item(p, l, idx - 1024, smem_);
    }
}

__device__ __forceinline__ int f2sort(float f) { int i = __float_as_int(f); return i ^ ((i >> 31) & 0x7fffffff); }
__device__ __forceinline__ float sort2f(int i) { return __int_as_float(i ^ ((i >> 31) & 0x7fffffff)); }
#define INSK(K, xv) do { int _x = (xv); \
    _Pragma("unroll") for (int _j = 0; _j < 16; ++_j) { int _hi = max(K[_j], _x); _x = min(K[_j], _x); K[_j] = _hi; } } while (0)
#define INS64(K, xv) do { unsigned long long _x = (xv); \
    _Pragma("unroll") for (int _j = 0; _j < 16; ++_j) { bool _c = _x > K[_j]; unsigned long long _o = K[_j]; K[_j] = _c ? _x : _o; _x = _c ? _o : _x; } } while (0)

__device__ void ph_route(const Params& p, int vb0, int nvb, char* smem_) {
    const float* SC = (const float*)(p.ws + WS_SC);
    int* RI = (int*)(p.ws + WS_RI); float* RG = (float*)(p.ws + WS_RG);
    const int tid = TIDX(), lane = tid & 63, wave = tid >> 6;
    float* tile = (float*)smem_ + wave * (64 * 68);
    for (int item0 = (vb0 * 8 + wave) * 64; item0 < T_TOK * 8; item0 += nvb * 8 * 64) {
        const int item = item0 + lane;
        const int t = item >> 3, h = item & 7;
        const float* s0 = SC + (size_t)t * 2048 + h * 256;
        const float* wbase = SC + (size_t)item0 * 256;
        int k0[16], k1[16];
#pragma unroll
        for (int j = 0; j < 16; ++j) { k0[j] = (int)0x80000000; k1[j] = (int)0x80000000; }
#pragma unroll 1
        for (int slab = 0; slab < 4; ++slab) {
            f32x4 ld[16];
#pragma unroll
            for (int j = 0; j < 8; ++j) {
                const float* src = wbase + (size_t)(8 * j + (lane >> 3)) * 256 + slab * 32 + (lane & 7) * 4;
                ld[j] = *(const f32x4*)src; ld[8 + j] = *(const f32x4*)(src + 128);
            }
            __builtin_amdgcn_wave_barrier();
#pragma unroll
            for (int j = 0; j < 8; ++j) {
                float* dst = tile + (8 * j + (lane >> 3)) * 68 + (lane & 7) * 4;
                *(f32x4*)dst = ld[j]; *(f32x4*)(dst + 32) = ld[8 + j];
            }
            __builtin_amdgcn_fence(__ATOMIC_RELEASE, "wavefront");
            __builtin_amdgcn_wave_barrier();
            __builtin_amdgcn_fence(__ATOMIC_ACQUIRE, "wavefront");
#pragma unroll 2
            for (int ii = 0; ii < 32; ii += 4) {
                const int i = slab * 32 + ii;
                const f32x4 a = *(const f32x4*)(tile + lane * 68 + ii), b = *(const f32x4*)(tile + lane * 68 + 32 + ii);
                INSK(k0, (f2sort(a[0]) & ~127) | (127 - i)); INSK(k0, (f2sort(a[1]) & ~127) | (126 - i));
                INSK(k0, (f2sort(a[2]) & ~127) | (125 - i)); INSK(k0, (f2sort(a[3]) & ~127) | (124 - i));
                INSK(k1, (f2sort(b[0]) & ~127) | (127 - i)); INSK(k1, (f2sort(b[1]) & ~127) | (126 - i));
                INSK(k1, (f2sort(b[2]) & ~127) | (125 - i)); INSK(k1, (f2sort(b[3]) & ~127) | (124 - i));
            }
            __builtin_amdgcn_wave_barrier();
        }
        float v0[16], v1[16];
#pragma unroll
        for (int j = 0; j < 16; ++j) { k0[j] = 127 - (k0[j] & 127); k1[j] = 127 - (k1[j] & 127); v0[j] = s0[k0[j]]; v1[j] = s0[128 + k1[j]]; }
        unsigned long long ck[16];
#pragma unroll
        for (int j = 0; j < 16; ++j) ck[j] = 0ull;
#pragma unroll
        for (int a = 0; a < 16; ++a)
#pragma unroll
            for (int b = 0; b < 16; ++b)
                if ((a + 1) * (b + 1) <= 16) {
                    unsigned hi = (unsigned)f2sort(v0[a] + v1[b]) ^ 0x80000000u;
                    unsigned lo = ((unsigned)(255 - (a * 16 + b)) << 16) | (unsigned)(k0[a] * 128 + k1[b]);
                    INS64(ck, ((unsigned long long)hi << 32) | lo);
                }
        float e[16]; float sm = 0.f;
        const float mx = sort2f((int)((unsigned)(ck[0] >> 32) ^ 0x80000000u));
#pragma unroll
        for (int j = 0; j < 16; ++j) { e[j] = expf(sort2f((int)((unsigned)(ck[j] >> 32) ^ 0x80000000u)) - mx); sm += e[j]; }
        const float inv = 1.f / sm;
#pragma unroll
        for (int j = 0; j < 16; j += 4) {
            *(int4*)(RI + (size_t)t * 128 + h * 16 + j) = make_int4((int)(ck[j] & 0xffffu), (int)(ck[j + 1] & 0xffffu), (int)(ck[j + 2] & 0xffffu), (int)(ck[j + 3] & 0xffffu));
            *(float4*)(RG + (size_t)t * 128 + h * 16 + j) = make_float4(e[j] * inv, e[j + 1] * inv, e[j + 2] * inv, e[j + 3] * inv);
        }
    }
}

__device__ void ph_gather(const Params& p, int l, int vb0, int nvb, bool dummy = false) {
    const int wave = TIDX() >> 6, lane = TIDX() & 63;
    const bf16_t* H = (const bf16_t*)(p.ws + WS_H); const unsigned char* PU = p.ws + WS_PU; const unsigned char* PV = p.ws + WS_PV;
    const int* RI = (const int*)(p.ws + WS_RI); const float* RG = (const float*)(p.ws + WS_RG);
    const float* modb = (const float*)(p.ws + WS_MOD);
    for (int t = vb0 * 8 + wave; t < T_TOK; t += nvb * 8) {
        const int b = t >> 11;
        float hv[16], y[16];
        {
            const uint4* hp = (const uint4*)(H + (size_t)t * 1024 + lane * 16);
            uint4 a = hp[0], c = hp[1];
            hv[0] = bflo(a.x); hv[1] = bfhi(a.x); hv[2] = bflo(a.y); hv[3] = bfhi(a.y); hv[4] = bflo(a.z); hv[5] = bfhi(a.z); hv[6] = bflo(a.w); hv[7] = bfhi(a.w);
            hv[8] = bflo(c.x); hv[9] = bfhi(c.x); hv[10] = bflo(c.y); hv[11] = bfhi(c.y); hv[12] = bflo(c.z); hv[13] = bfhi(c.z); hv[14] = bflo(c.w); hv[15] = bfhi(c.w);
        }
#pragma unroll
        for (int j = 0; j < 16; ++j) y[j] = 0.f;
        const int e_lo = RI[(size_t)t * 128 + lane], e_hi = RI[(size_t)t * 128 + 64 + lane];
        const float g_lo = RG[(size_t)t * 128 + lane], g_hi = RG[(size_t)t * 128 + 64 + lane];
#pragma unroll 1
        for (int grp = 0; grp < 8; ++grp) {
            const int esrc = grp < 4 ? e_lo : e_hi; const float gsrc = grp < 4 ? g_lo : g_hi;
            uint4 uq[16], vq[16];
#pragma unroll
            for (int j = 0; j < 16; ++j) {
                const int e = bperm(esrc, (grp * 16 + j) & 63);
                uq[j] = *(const uint4*)(PU + (size_t)e * 1024 + lane * 16);
                vq[j] = *(const uint4*)(PV + (size_t)e * 1024 + lane * 16);
            }
            float part[16];
#pragma unroll
            for (int j = 0; j < 16; ++j) {
                const unsigned uw[4] = {uq[j].x, uq[j].y, uq[j].z, uq[j].w};
                float d = 0.f;
#pragma unroll
                for (int c = 0; c < 4; ++c) {
                    auto f0 = __builtin_amdgcn_cvt_pk_f32_fp8((int)uw[c], false); auto f1 = __builtin_amdgcn_cvt_pk_f32_fp8((int)uw[c], true);
                    d += hv[4 * c] * f0[0] + hv[4 * c + 1] * f0[1] + hv[4 * c + 2] * f1[0] + hv[4 * c + 3] * f1[1];
                }
                part[j] = d;
            }
            float r8[8], r4[4], r2[2];
            const bool b5 = lane & 32, b4 = lane & 16, b3 = lane & 8, b2 = lane & 4;
#pragma unroll
            for (int j = 0; j < 8; ++j) { float snd = b5 ? part[j] : part[j + 8], kp = b5 ? part[j + 8] : part[j]; r8[j] = kp + shx<32>(snd); }
#pragma unroll
            for (int j = 0; j < 4; ++j) { float snd = b4 ? r8[j] : r8[j + 4], kp = b4 ? r8[j + 4] : r8[j]; r4[j] = kp + shx<16>(snd); }
#pragma unroll
            for (int j = 0; j < 2; ++j) { float snd = b3 ? r4[j] : r4[j + 2], kp = b3 ? r4[j + 2] : r4[j]; r2[j] = kp + shx<8>(snd); }
            float d;
            { float snd = b2 ? r2[0] : r2[1], kp = b2 ? r2[1] : r2[0]; d = kp + shx<4>(snd); }
            d += shx<2>(d); d += shx<1>(d);
            d *= (1.f / PU_SCALE);
            const int me = ((lane >> 5) & 1) * 8 + ((lane >> 4) & 1) * 4 + ((lane >> 3) & 1) * 2 + ((lane >> 2) & 1);
            const float gme = bperm(gsrc, (grp * 16 + me) & 63);
            const float coef = gme * 0.5f * d * (1.f + erff(d * 0.7071067811865476f)) * (1.f / PV_SCALE);
#pragma unroll
            for (int j = 0; j < 16; ++j) {
                const float cj = bperm(coef, (((j >> 3) & 1) << 5) | (((j >> 2) & 1) << 4) | (((j >> 1) & 1) << 3) | ((j & 1) << 2));
                const unsigned vw[4] = {vq[j].x, vq[j].y, vq[j].z, vq[j].w};
#pragma unroll
                for (int c = 0; c < 4; ++c) {
                    auto f0 = __builtin_amdgcn_cvt_pk_f32_fp8((int)vw[c], false); auto f1 = __builtin_amdgcn_cvt_pk_f32_fp8((int)vw[c], true);
                    y[4 * c] += cj * f0[0]; y[4 * c + 1] += cj * f0[1]; y[4 * c + 2] += cj * f1[0]; y[4 * c + 3] += cj * f1[1];
                }
            }
        }
        const float* gf = modb + (size_t)(l * 8 + b) * 6144 + 5120 + lane * 16;
        float* op = p.out + (size_t)t * 1024 + lane * 16;
        float* wp_ = dummy ? (float*)(p.ws + WS_OA) + (size_t)t * 1024 + lane * 16 : op;
#pragma unroll
        for (int j = 0; j < 16; j += 4) {
            float4 xi = *(const float4*)(op + j), g4 = *(const float4*)(gf + j);
            *(float4*)(wp_ + j) = make_float4(xi.x + g4.x * y[j], xi.y + g4.y * y[j + 1], xi.z + g4.z * y[j + 2], xi.w + g4.w * y[j + 3]);
        }
    }
}


__device__ __forceinline__ void fp8x16_to_f32(const uint4 q, float (&f)[16]) {
    const unsigned w[4] = {q.x, q.y, q.z, q.w};
#pragma unroll
    for (int c = 0; c < 4; ++c) {
        auto f0 = __builtin_amdgcn_cvt_pk_f32_fp8((int)w[c], false); auto f1 = __builtin_amdgcn_cvt_pk_f32_fp8((int)w[c], true);
        f[4 * c] = f0[0]; f[4 * c + 1] = f0[1]; f[4 * c + 2] = f1[0]; f[4 * c + 3] = f1[1];
    }
}
template <int WHICH>
#ifndef PEER_REP
#define PEER_REP 1
#endif
__device__ void ph_peer_sliced(const Params& p, int l, char* smem_) {
    const int tid = TIDX(), wave = tid >> 6;
    const bf16_t* H = (const bf16_t*)(p.ws + WS_H); const unsigned char* PU = p.ws + WS_PU; const unsigned char* PV = p.ws + WS_PV;
    const int* RI = (const int*)(p.ws + WS_RI); float* RG = (float*)(p.ws + WS_RG); float* PP = (float*)(p.ws + WS_PP);
    const float* modb = (const float*)(p.ws + WS_MOD);
    for (int rep = 0; rep < PEER_REP; ++rep) {
    unsigned* ctr = (unsigned*)(p.ws + WS_CTL) + 3712 + (l * 2 + WHICH) * 128 + rep * 1024;
    volatile int* slot = (volatile int*)(smem_ + LDS_BYTES - 64);
    const int xcc = (int)(xb_xcc_id() & 7u);
    for (int so = 0; so < 8; ++so) {
        const int x = (xcc + so) & 7;
        for (;;) {
            if (tid == 0) *slot = (int)atomicAdd(ctr + x * 16, 1u);
            __syncthreads();
            const int chunk = *slot;
            __syncthreads();
            if (chunk >= 256) break;
            {
                const int lane = lane_id_opaque(), eg = lane >> 3, ll = lane & 7;
                const int tb = chunk * 64 + wave * 8;
                int* lri = (int*)smem_ + wave * 2048; float* lrg = (float*)(lri + 1024);
                {
                    int ra[16]; float rg_[16];
#pragma unroll
                    for (int i = 0; i < 8; ++i) {
                        ra[2 * i] = RI[(size_t)(tb + i) * 128 + lane]; ra[2 * i + 1] = RI[(size_t)(tb + i) * 128 + 64 + lane];
                        if (WHICH == 1) { rg_[2 * i] = RG[(size_t)(tb + i) * 128 + lane]; rg_[2 * i + 1] = RG[(size_t)(tb + i) * 128 + 64 + lane]; }
                    }
#pragma unroll
                    for (int i = 0; i < 8; ++i) {
                        lri[i * 128 + lane] = ra[2 * i]; lri[i * 128 + 64 + lane] = ra[2 * i + 1];
                        if (WHICH == 1) { lrg[i * 128 + lane] = rg_[2 * i]; lrg[i * 128 + 64 + lane] = rg_[2 * i + 1]; }
                    }
                }
                __builtin_amdgcn_fence(__ATOMIC_RELEASE, "wavefront");
                __builtin_amdgcn_wave_barrier();
                __builtin_amdgcn_fence(__ATOMIC_ACQUIRE, "wavefront");
                uint4 hq0 = make_uint4(0u, 0u, 0u, 0u), hq1 = hq0;
                if (WHICH == 0) { const uint4* hp = (const uint4*)(H + (size_t)tb * 1024 + x * 128 + ll * 16); hq0 = hp[0]; hq1 = hp[1]; }
#pragma unroll 1
                for (int i = 0; i < 8; ++i) {
                    const int t = tb + i;
                    if (WHICH == 0) {
                        float hv[16];
                        hv[0] = bflo(hq0.x); hv[1] = bfhi(hq0.x); hv[2] = bflo(hq0.y); hv[3] = bfhi(hq0.y); hv[4] = bflo(hq0.z); hv[5] = bfhi(hq0.z); hv[6] = bflo(hq0.w); hv[7] = bfhi(hq0.w);
                        hv[8] = bflo(hq1.x); hv[9] = bfhi(hq1.x); hv[10] = bflo(hq1.y); hv[11] = bfhi(hq1.y); hv[12] = bflo(hq1.z); hv[13] = bfhi(hq1.z); hv[14] = bflo(hq1.w); hv[15] = bfhi(hq1.w);
                        if (i < 7) { const uint4* hp = (const uint4*)(H + (size_t)(t + 1) * 1024 + x * 128 + ll * 16); hq0 = hp[0]; hq1 = hp[1]; }
                        uint4 uq[16];
#pragma unroll
                        for (int it = 0; it < 16; ++it) {
                            const int e = lri[i * 128 + it * 8 + eg];
                            uq[it] = *(const uint4*)(PU + ((size_t)x * 16384 + e) * 128 + ll * 16);
                        }
#pragma unroll
                        for (int b2 = 0; b2 < 2; ++b2) {
                            float part[8];
#pragma unroll
                            for (int it = 0; it < 8; ++it) {
                                float f[16]; fp8x16_to_f32(uq[b2 * 8 + it], f);
                                float d = 0.f;
#pragma unroll
                                for (int j = 0; j < 16; ++j) d += hv[j] * f[j];
                                part[it] = d;
                            }
                            float r4[4], r2[2];
                            const bool b2_ = lane & 4, b1_ = lane & 2, b0_ = lane & 1;
#pragma unroll
                            for (int j = 0; j < 4; ++j) { const float snd = b2_ ? part[j] : part[j + 4], kp = b2_ ? part[j + 4] : part[j]; r4[j] = kp + shx<4>(snd); }
#pragma unroll
                            for (int j = 0; j < 2; ++j) { const float snd = b1_ ? r4[j] : r4[j + 2], kp = b1_ ? r4[j + 2] : r4[j]; r2[j] = kp + shx<2>(snd); }
                            const float snd = b0_ ? r2[0] : r2[1], kp = b0_ ? r2[1] : r2[0];
                            const float d = kp + shx<1>(snd);
                            PP[((size_t)x * T_TOK + t) * 128 + b2 * 64 + ll * 8 + eg] = d;
                        }
                    } else {
                        float y[16];
#pragma unroll
                        for (int j = 0; j < 16; ++j) y[j] = 0.f;
#pragma unroll
                        for (int b2 = 0; b2 < 2; ++b2) {
                            uint4 vq[8];
#pragma unroll
                            for (int it = 0; it < 8; ++it) {
                                const int e = lri[i * 128 + b2 * 64 + it * 8 + eg];
                                vq[it] = *(const uint4*)(PV + ((size_t)x * 16384 + e) * 128 + ll * 16);
                            }
#pragma unroll
                            for (int it = 0; it < 8; ++it) {
                                const float ck = lrg[i * 128 + b2 * 64 + it * 8 + eg];
                                float f[16]; fp8x16_to_f32(vq[it], f);
#pragma unroll
                                for (int j = 0; j < 16; ++j) y[j] += ck * f[j];
                            }
                        }
                        float r8[8], r4[4], r2[2];
                        const bool b5 = lane & 32, b4 = lane & 16, b3 = lane & 8;
#pragma unroll
                        for (int j = 0; j < 8; ++j) { const float snd = b5 ? y[j] : y[j + 8], kp = b5 ? y[j + 8] : y[j]; r8[j] = kp + shx<32>(snd); }
#pragma unroll
                        for (int j = 0; j < 4; ++j) { const float snd = b4 ? r8[j] : r8[j + 4], kp = b4 ? r8[j + 4] : r8[j]; r4[j] = kp + shx<16>(snd); }
#pragma unroll
                        for (int j = 0; j < 2; ++j) { const float snd = b3 ? r4[j] : r4[j + 2], kp = b3 ? r4[j + 2] : r4[j]; r2[j] = kp + shx<8>(snd); }
                        const int col = x * 128 + ll * 16 + ((lane >> 5) & 1) * 8 + ((lane >> 4) & 1) * 4 + ((lane >> 3) & 1) * 2;
                        const float2 gf = *(const float2*)(modb + (size_t)(l * 8 + (t >> 11)) * 6144 + 5120 + col);
                        float2* op = (float2*)(p.out + (size_t)t * 1024 + col);
                        const float2 xi = *op;
                        if (rep > 0) op = (float2*)((float*)(p.ws + WS_OA) + (size_t)t * 1024 + col);
                        *op = make_float2(xi.x + gf.x * r2[0], xi.y + gf.y * r2[1]);
                    }
                }
            }
        }
    }
    __syncthreads();
    }
}
__device__ void ph_peer_coef(const Params& p, int vb0, int nvb) {
    const int wave = TIDX() >> 6, lane = TIDX() & 63;
    float* RG = (float*)(p.ws + WS_RG); const float* PP = (const float*)(p.ws + WS_PP);
    for (int t = vb0 * 8 + wave; t < T_TOK; t += nvb * 8) {
#pragma unroll
        for (int half = 0; half < 2; ++half) {
            const int k = half * 64 + lane;
            float d = 0.f;
#pragma unroll
            for (int x = 0; x < 8; ++x) d += PP[((size_t)x * T_TOK + t) * 128 + k];
            d *= (1.f / PU_SCALE);
            const float g = RG[(size_t)t * 128 + k];
            RG[(size_t)t * 128 + k] = g * 0.5f * d * (1.f + erff(d * 0.7071067811865476f)) * (1.f / PV_SCALE);
        }
    }
}

enum { PH_MOD = 0, PH_WPREP, PH_NORM1, PH_GEMM_IN, PH_SCAN, PH_DSAPREP, PH_DSA, PH_POST, PH_MERGE, PH_OUT, PH_NORM2, PH_GEMM_Q, PH_GEMM_SC, PH_ROUTE, PH_GATHER, PH_GATHER_DUMMY, PH_DSASEL, PH_G1, PH_G15, PH_G2, PH_G1R, PH_G2R };

template <int PH>
__device__ __forceinline__ void run_phase(const Params& p, int l, int vb0, int nvb, char* smem) {
    const float* xin = (l == 0) ? p.x : p.out;
    if (PH == PH_MOD) ph_mod(p, vb0, nvb, smem);
    else if (PH == PH_WPREP) ph_wprep(p, l, vb0, nvb, smem);
    else if (PH == PH_NORM1) ph_norm(p, l, 0, xin, vb0, nvb);
    else if (PH == PH_GEMM_IN) {
        pg8::Gemm g{(const bf16_t*)(p.ws + WS_H), (const bf16_t*)(p.ws + WS_WIN), 1024, 1024, 1024};
        pg8::StaticOrder S; S.init(T_TOK, LDZ, nvb, vb0, 1024, 1024);
        pg8::gemm_phase(( PG8_LAS unsigned char*)smem, g, S, pg8::EpiBf16{(bf16_t*)(p.ws + WS_Z), LDZ}, TIDX());
    }
    else if (PH == PH_SCAN) ph_mixA(p, l, vb0, nvb, smem);
    else if (PH == PH_DSAPREP) { }
    else if (PH == PH_DSA) ph_dsa_attn(p, vb0, nvb, smem);
    else if (PH == PH_POST) ph_post(p, l, vb0, nvb);
    else if (PH == PH_MERGE) {
        pg8::Gemm g{(const bf16_t*)(p.ws + WS_Y), (const bf16_t*)(p.ws + WS_WBR), 1536, 512, 512};
        pg8::MergeOrder S{vb0, nvb};
        pg8::gemm_phase((PG8_LAS unsigned char*)smem, g, S, pg8::EpiMerge{(bf16_t*)(p.ws + WS_H), (const bf16_t*)(p.ws + WS_Z)}, TIDX());
    }
    else if (PH == PH_OUT) {
        pg8::Gemm g{(const bf16_t*)(p.ws + WS_H), (const bf16_t*)(p.ws + WS_WOUT), 1024, 1024, 1024};
        pg8::StaticOrder S; S.init(T_TOK, 1024, nvb, vb0, 1024, 1024);
        pg8::gemm_phase((PG8_LAS unsigned char*)smem, g, S, pg8::EpiResid{xin, p.out, (const float*)(p.ws + WS_MOD) + (size_t)l * 8 * 6144}, TIDX());
    }
    else if (PH == PH_NORM2) ph_norm(p, l, 1, p.out, vb0, nvb);
    else if (PH == PH_GEMM_Q) {
        pg8::Gemm g{(const bf16_t*)(p.ws + WS_H), (const bf16_t*)(p.ws + WS_WQ), 1024, 1024, 1024};
        pg8::StaticOrder S; S.init(T_TOK, 2048, nvb, vb0, 1024, 1024);
        pg8::gemm_phase((PG8_LAS unsigned char*)smem, g, S, pg8::EpiBf16{(bf16_t*)(p.ws + WS_QP), 2048}, TIDX());
    }
    else if (PH == PH_GEMM_SC) gemm_phase((const bf16_t*)(p.ws + WS_QP), 2048, (const bf16_t*)(p.ws + WS_SK), 128, T_TOK, 2048, 128, true,
                                          EpiF32{(float*)(p.ws + WS_SC), 2048}, vb0, nvb, smem, TIDX());
    else if (PH == PH_ROUTE) ph_route(p, vb0, nvb, smem);
    else if (PH == PH_GATHER) ph_gather(p, l, vb0, nvb);
    else if (PH == PH_GATHER_DUMMY) ph_gather(p, l, vb0, nvb, true);
    else if (PH == PH_DSASEL) { }
    else if (PH == PH_G1) ph_peer_sliced<0>(p, l, smem);
    else if (PH == PH_G15) ph_peer_coef(p, vb0, nvb);
    else if (PH == PH_G2) ph_peer_sliced<1>(p, l, smem);

}

template <int PH>
__global__ void __launch_bounds__(NT) k_phase(Params p, int l) {
    extern __shared__ __attribute__((aligned(16))) char smem[];
    p.wv = __builtin_amdgcn_readfirstlane((int)threadIdx.x >> 6);
    run_phase<PH>(p, l, (int)blockIdx.x, (int)gridDim.x, smem);
}


#define XB_TMO      128
#define XB_XCNT(j)  (256  + 64 * (j))
#define XB_XSUB(j)  (1280 + 64 * (j))
#define XB_XGEN(j)  (2304 + 64 * (j))
#define XB_TOP      3328
#define XB_TOPGEN   3392
#define XCD_BAR_WORDS 3456
#define XB_SPIN_CAP (1u << 18)
#define LAS __attribute__((address_space(3)))
__device__ __forceinline__ unsigned xb_ld(unsigned* p)              { return __hip_atomic_load(p, __ATOMIC_RELAXED, __HIP_MEMORY_SCOPE_AGENT); }
__device__ __forceinline__ unsigned xb_add(unsigned* p, unsigned v) { return __hip_atomic_fetch_add(p, v, __ATOMIC_RELAXED, __HIP_MEMORY_SCOPE_AGENT); }
#define XB_SPIN(cond, bar) do { unsigned _sp = 0; while (cond) { __builtin_amdgcn_s_sleep(1); \
    if ((++_sp & 255u) == 0u) { if (xb_ld(&(bar)[XB_TMO])) break; if (_sp > XB_SPIN_CAP) { atomicAdd(&(bar)[XB_TMO], 1u); break; } } } } while (0)
struct XcdBarrier { unsigned* bar; unsigned x; volatile LAS unsigned* st; int wv; };
__device__ __forceinline__ XcdBarrier xcd_barrier_post(unsigned* bar, volatile LAS unsigned* st, int wv) {
    XcdBarrier b; b.bar = bar; b.x = xb_xcc_id(); b.st = st; b.wv = wv;
    if (TIDXW(wv) == 0) (void)xb_add(&bar[XB_XCNT(b.x)], 1u);
    return b;
}
__device__ __forceinline__ void xcd_barrier_complete(unsigned* bar, unsigned x, unsigned& nloc, unsigned& nx) {
    const unsigned G = gridDim.x * gridDim.y * gridDim.z;
    unsigned sum, cnt, mine, sp = 0u;
    for (;;) {
        sum = 0u; cnt = 0u; mine = 0u;
#pragma unroll
        for (unsigned j = 0; j < 16; ++j) { const unsigned c = xb_ld(&bar[XB_XCNT(j)]); sum += c; cnt += (c > 0u) ? 1u : 0u; mine = (j == x) ? c : mine; }
        if (sum == G) break;
        __builtin_amdgcn_s_sleep(1);
        if ((++sp & 255u) == 0u) { if (xb_ld(&bar[XB_TMO])) break; if (sp > XB_SPIN_CAP) { atomicAdd(&bar[XB_TMO], 1u); break; } }
    }
    nloc = mine > 0u ? mine : 1u; nx = cnt > 0u ? cnt : 1u;
}
__device__ __forceinline__ void xcd_barrier(const XcdBarrier& b) {
    asm volatile("s_waitcnt vmcnt(0)" ::: "memory");
    __syncthreads();
    if (TIDXW(b.wv) == 0) {
        unsigned* bar = b.bar;
        __builtin_amdgcn_s_waitcnt(0);
        unsigned nloc = b.st[0], nx = b.st[1];
        if (nloc == 0u) { xcd_barrier_complete(bar, b.x, nloc, nx); b.st[0] = nloc; b.st[1] = nx; }
        const unsigned old = xb_add(&bar[XB_XSUB(b.x)], 1u);
        const unsigned gen = old / nloc;
        if (old + 1u == (gen + 1u) * nloc) {
            __builtin_amdgcn_fence(__ATOMIC_RELEASE, "agent");
            asm volatile("s_waitcnt vmcnt(0)" ::: "memory");
            const unsigned og = xb_add(&bar[XB_TOP], 1u);
            const unsigned tg = og / nx;
            if (og + 1u == (tg + 1u) * nx) xb_add(&bar[XB_TOPGEN], 1u);
            else XB_SPIN(xb_ld(&bar[XB_TOPGEN]) == tg, bar);
            __builtin_amdgcn_fence(__ATOMIC_ACQUIRE, "agent");
            xb_add(&bar[XB_XGEN(b.x)], 1u);
            asm volatile("s_waitcnt vmcnt(0)" ::: "memory");
        } else {
            XB_SPIN(xb_ld(&bar[XB_XGEN(b.x)]) == gen, bar);
            __builtin_amdgcn_fence(__ATOMIC_ACQUIRE, "agent");
            asm volatile("s_waitcnt vmcnt(0)" ::: "memory");
        }
    }
    __syncthreads();
}

__global__ void __launch_bounds__(NT) mega_kernel(Params p_in) {
#if defined(__HIP_DEVICE_COMPILE__)
    extern __shared__ __attribute__((aligned(16))) char smem[];
    volatile LAS unsigned* st = (volatile LAS unsigned*)(smem + LDS_BYTES - 16);
    int wv_ = __builtin_amdgcn_readfirstlane((int)threadIdx.x >> 6); asm volatile("" : "+s"(wv_));
    { const int t_ = TIDXW(wv_); if (t_ < 4) st[t_] = 0u; }
    __syncthreads();
    XcdBarrier bar = xcd_barrier_post((unsigned*)(p_in.ws + WS_CTL), st, wv_);
    const int vb = (int)blockIdx.x, nvb = (int)gridDim.x;
#ifndef PROBE_PH
#define PROBE_PH -1
#endif
#define GB() xcd_barrier(bar)
#define RUN(PH, L) do { for (int _r = 0; _r < ((PROBE_PH == PH && PH != PH_DSAPREP) ? 2 : 1); ++_r) { \
        const __attribute__((address_space(4))) Params* _kp = (const __attribute__((address_space(4))) Params*)__builtin_amdgcn_kernarg_segment_ptr(); asm volatile("" : "+s"(_kp)); Params _p = *_kp; _p.wv = wv_; \
        int _l = (L), _vb = vb, _nvb = nvb; asm volatile("" : "+s"(_l), "+s"(_vb), "+s"(_nvb)); \
        run_phase<(PROBE_PH == PH_GATHER_DUMMY && PH == PH_GATHER && 0) ? PH_GATHER_DUMMY : PH>(_p, _l, _vb, _nvb, smem); if (PROBE_PH == PH) __syncthreads(); } } while (0)
    RUN(PH_MOD, 0);
#pragma unroll 1
    for (int l = 0; l < 2; ++l) {
        RUN(PH_WPREP, l); GB();
        RUN(PH_NORM1, l); GB();
        RUN(PH_GEMM_IN, l); GB();
        RUN(PH_SCAN, l);
        RUN(PH_DSAPREP, l);
        GB();
        RUN(PH_DSA, l);
        RUN(PH_POST, l); GB();
        RUN(PH_MERGE, l); GB();
        RUN(PH_OUT, l); GB();
        RUN(PH_NORM2, l); GB();
        RUN(PH_GEMM_Q, l); GB();
        RUN(PH_GEMM_SC, l); GB();
        RUN(PH_ROUTE, l); GB();
        RUN(PH_G1, l); GB();
        RUN(PH_G15, l); GB();
        RUN(PH_G2, l);
        if (l == 0) GB();
    }
#undef RUN
#undef GB
#endif
}

extern "C" void kernel_launch(void* const* d_in, const int* in_sizes, int n_in, void* d_out, int out_size, void* d_ws, size_t ws_size,
                              hipStream_t stream) {
    if (n_in != 20 || ws_size < WS_END) { fprintf(stderr, "kernel_launch: bad inputs (n_in %d ws %zu need %zu)\n", n_in, ws_size, (size_t)WS_END); return; }
    Params p{};
    p.x = (const float*)d_in[0]; p.c = (const float*)d_in[1]; p.w_ada = (const float*)d_in[2]; p.b_ada = (const float*)d_in[3];
    p.norm_mix = (const float*)d_in[4]; p.norm_ffn = (const float*)d_in[5]; p.w_in = (const float*)d_in[6]; p.hgrn_lb = (const float*)d_in[7];
    p.hgrn_on = (const float*)d_in[8]; p.dsa_qn = (const float*)d_in[9]; p.dsa_kn = (const float*)d_in[10]; p.gla_up = (const float*)d_in[11];
    p.gla_bias = (const float*)d_in[12]; p.gla_on = (const float*)d_in[13]; p.w_branch = (const float*)d_in[14]; p.w_out = (const float*)d_in[15];
    p.peer_wq = (const float*)d_in[16]; p.peer_keys = (const float*)d_in[17]; p.peer_u = (const float*)d_in[18]; p.peer_v = (const float*)d_in[19];
    p.out = (float*)d_out; p.ws = (unsigned char*)d_ws;
#if MEGA
    static int grid = 0;
    if (grid == 0) {
        int dev = 0, cus = 0, per_cu = 0;
        hipGetDevice(&dev);
        hipDeviceGetAttribute(&cus, hipDeviceAttributeMultiprocessorCount, dev);
        hipFuncSetAttribute((const void*)mega_kernel, hipFuncAttributeMaxDynamicSharedMemorySize, LDS_BYTES);
        hipOccupancyMaxActiveBlocksPerMultiprocessor(&per_cu, (const void*)mega_kernel, NT, LDS_BYTES);
        if (per_cu < 1) { fprintf(stderr, "kernel_launch: occupancy query says %d blocks per CU\n", per_cu); per_cu = 1; }
        (void)hipGetLastError();
        grid = cus;
    }
    hipMemsetAsync((char*)d_ws + WS_CTL, 0, 32768, stream);
    void* args[] = {&p};
    hipError_t e = hipLaunchCooperativeKernel((const void*)mega_kernel, dim3(grid), dim3(NT), args, LDS_BYTES, stream);
    if (e != hipSuccess) fprintf(stderr, "cooperative launch failed: %s (grid %d)\n", hipGetErrorString(e), grid);
#else
    const int G = 256;
#define LAUNCH(PH, l) hipLaunchKernelGGL(k_phase<PH>, dim3(G), dim3(NT), LDS_BYTES, stream, p, l)
    LAUNCH(PH_MOD, 0);
    for (int l = 0; l < 2; ++l) {
        LAUNCH(PH_WPREP, l);
        LAUNCH(PH_NORM1, l);
        LAUNCH(PH_GEMM_IN, l);
        LAUNCH(PH_SCAN, l);
        LAUNCH(PH_DSAPREP, l);
        LAUNCH(PH_DSA, l);
        LAUNCH(PH_POST, l);
        LAUNCH(PH_MERGE, l);
        LAUNCH(PH_OUT, l);
        LAUNCH(PH_NORM2, l);
        LAUNCH(PH_GEMM_Q, l);
        LAUNCH(PH_GEMM_SC, l);
        LAUNCH(PH_ROUTE, l);
        LAUNCH(PH_GATHER, l);
    }
#endif
}
```

```cpp
#include <hip/hip_runtime.h>
#include <stdint.h>
#include <stdio.h>

#ifndef MEGA
#define MEGA 1
#endif

typedef unsigned short bf16_t;
typedef short bf16x8 __attribute__((ext_vector_type(8)));
typedef float f32x4 __attribute__((ext_vector_type(4)));
typedef unsigned u32x4 __attribute__((ext_vector_type(4)));

#define NT 512
constexpr int T_TOK = 16384, DM = 1024, SEQ = 2048;
constexpr int LDZ = 8704;
constexpr int ZA_Q = 0, ZA_F = 512, ZA_I = 1024, ZA_G = 1536, ZB_Q = 2048, ZB_K = 2560, ZB_V = 3072, ZC_V = 3584, ZC_G = 4096,
              ZB_QI = 4608, ZC_Q = 4864, ZC_K = 5120, ZB_KI = 5376, ZB_WI = 5440, ZC_CODE = 5444, ZM = 5632;
constexpr int IN_COLS = 8532;

constexpr size_t al256(size_t x) { return (x + 255) & ~(size_t)255; }
constexpr size_t WS_CTL = 0;
constexpr size_t WS_MOD = 65536;
constexpr size_t WS_WIN = al256(WS_MOD + (size_t)2 * 8 * 6144 * 4);
constexpr size_t WS_WBR = al256(WS_WIN + (size_t)LDZ * 1024 * 2);
constexpr size_t WS_WOUT = al256(WS_WBR + (size_t)3 * 1024 * 512 * 2);
constexpr size_t WS_WQ = al256(WS_WOUT + (size_t)1024 * 1024 * 2);
constexpr size_t WS_SK = al256(WS_WQ + (size_t)2048 * 1024 * 2);
constexpr size_t WS_PU = al256(WS_SK + (size_t)16 * 128 * 128 * 2);
constexpr size_t WS_PV = al256(WS_PU + (size_t)16384 * 1024);
constexpr size_t WS_H = al256(WS_PV + (size_t)16384 * 1024);
constexpr float PU_SCALE = 32.f, PV_SCALE = 4.f;
constexpr size_t WS_OA = al256(WS_H + (size_t)T_TOK * 1024 * 2);
constexpr size_t WS_OC = al256(WS_OA + (size_t)T_TOK * 512 * 2);
constexpr size_t WS_Y = al256(WS_OC + (size_t)T_TOK * 512 * 2);
constexpr size_t WS_Z = al256(WS_Y + (size_t)T_TOK * 1536 * 2);
constexpr size_t WS_VT = al256(WS_Z + (size_t)T_TOK * LDZ * 2);
constexpr size_t WS_BM = al256(WS_VT + (size_t)T_TOK * 512 * 2);
constexpr size_t WS_END = al256(WS_BM + (size_t)T_TOK * 64 * 4);
constexpr size_t WS_QP = WS_Z;
constexpr size_t WS_SC = al256(WS_QP + (size_t)T_TOK * 2048 * 2);
constexpr size_t WS_RI = al256(WS_SC + (size_t)T_TOK * 2048 * 4);
constexpr size_t WS_RG = al256(WS_RI + (size_t)T_TOK * 128 * 4);
constexpr size_t WS_PP = al256(WS_RG + (size_t)T_TOK * 128 * 4);
static_assert(WS_PP + (size_t)8 * T_TOK * 128 * 4 <= WS_VT, "peer partials overflow the Z region");
static_assert(WS_RG + (size_t)T_TOK * 128 * 4 <= WS_END, "peer alias overflow");

struct Params {
    const float* x; const float* c; const float* w_ada; const float* b_ada; const float* norm_mix; const float* norm_ffn;
    const float* w_in; const float* hgrn_lb; const float* hgrn_on; const float* dsa_qn; const float* dsa_kn;
    const float* gla_up; const float* gla_bias; const float* gla_on; const float* w_branch; const float* w_out;
    const float* peer_wq; const float* peer_keys; const float* peer_u; const float* peer_v;
    float* out; unsigned char* ws;
    int wv, pad;
};

__device__ __forceinline__ float bf2f(bf16_t h) { return __uint_as_float(((unsigned)h) << 16); }
__device__ __forceinline__ float bflo(unsigned u) { return __uint_as_float(u << 16); }
__device__ __forceinline__ float bfhi(unsigned u) { return __uint_as_float(u & 0xffff0000u); }
__device__ __forceinline__ bf16_t f2bf(float f) { unsigned r; asm volatile("v_cvt_pk_bf16_f32 %0, %1, %1" : "=v"(r) : "v"(f)); return (bf16_t)(r & 0xffffu); }
__device__ __forceinline__ unsigned pack2(float a, float b) { unsigned r; asm volatile("v_cvt_pk_bf16_f32 %0, %1, %2" : "=v"(r) : "v"(a), "v"(b)); return r; }
__device__ __forceinline__ int lane_id_opaque() { int l; asm volatile("v_mbcnt_lo_u32_b32 %0, -1, 0\n\tv_mbcnt_hi_u32_b32 %0, -1, %0" : "=v"(l)); return l; }
template <int M> __device__ __forceinline__ int shx_i(int v) {
    if (M < 32) return __builtin_amdgcn_ds_swizzle(v, (M << 10) | 0x1f);
    return __builtin_amdgcn_ds_bpermute((lane_id_opaque() ^ 32) << 2, v);
}
template <int M> __device__ __forceinline__ float shx(float v) { return __int_as_float(shx_i<M>(__float_as_int(v))); }
template <int M> __device__ __forceinline__ int shx(int v) { return shx_i<M>(v); }
template <int M> __device__ __forceinline__ unsigned shx(unsigned v) { return (unsigned)shx_i<M>((int)v); }
__device__ __forceinline__ int bperm(int v, int src) { return __builtin_amdgcn_ds_bpermute(src << 2, v); }
__device__ __forceinline__ float bperm(float v, int src) { return __int_as_float(__builtin_amdgcn_ds_bpermute(src << 2, __float_as_int(v))); }
__device__ __forceinline__ float wave_sum(float v) { v += shx<32>(v); v += shx<16>(v); v += shx<8>(v); v += shx<4>(v); v += shx<2>(v); v += shx<1>(v); return v; }
__device__ __forceinline__ float wave_max(float v) { v = fmaxf(v, shx<32>(v)); v = fmaxf(v, shx<16>(v)); v = fmaxf(v, shx<8>(v)); v = fmaxf(v, shx<4>(v)); v = fmaxf(v, shx<2>(v)); v = fmaxf(v, shx<1>(v)); return v; }
__device__ __forceinline__ int wave_sum_i(int v) { v += shx<32>(v); v += shx<16>(v); v += shx<8>(v); v += shx<4>(v); v += shx<2>(v); v += shx<1>(v); return v; }
__device__ __forceinline__ float sigm(float x) { return __frcp_rn(1.f + __expf(-x)); }

__device__ __forceinline__ unsigned xb_xcc_id() { return (unsigned)__builtin_amdgcn_s_getreg((3 << 11) | 20) & 0xFu; }
__device__ __forceinline__ int TIDXW(int wv) { int t; asm volatile("v_mbcnt_lo_u32_b32 %0, -1, 0\n\tv_mbcnt_hi_u32_b32 %0, -1, %0\n\tv_lshl_or_b32 %0, %1, 6, %0" : "=v"(t) : "s"(wv)); return t; }
#define TIDX() TIDXW(p.wv)

__device__ __forceinline__ int src_col(int j) {
    if (j < 3584) return j;
    if (j < 4096) return j - 3584 + 4420;
    if (j < 4608) return j - 4096 + 4948;
    if (j < 4864) return j - 4608 + 3584;
    if (j < 5120) return j - 4864 + 3908;
    if (j < 5376) return j - 5120 + 4164;
    if (j < 5440) return j - 5376 + 3840;
    if (j < 5444) return j - 5440 + 3904;
    if (j < 5460) return j - 5444 + 4932;
    if (j < 5632) return -1;
    return j - 5632 + 5460;
}

__device__ void ph_mod(const Params& p, int vb0, int nvb, char* smem_) {
    float* sc = (float*)smem_;
    float* part = sc + 8 * 1024;
    float* mod = (float*)(p.ws + WS_MOD);
    const int tid = TIDX(), lane = tid & 63, wave = tid >> 6;
    if (vb0 >= 192) return;
    for (int i = tid; i < 8 * 1024; i += NT) { float c = p.c[i]; sc[i] = c / (1.f + __expf(-c)); }
    __syncthreads();
    for (int task = vb0; task < 192; task += nvb) {
        const int l = task / 96, n0 = (task % 96) * 64;
        const float* w = p.w_ada + (size_t)l * 1024 * 6144 + (size_t)(wave * 128) * 6144 + n0 + lane;
        float acc[8];
#pragma unroll
        for (int b = 0; b < 8; ++b) acc[b] = 0.f;
#pragma unroll 1
        for (int k0 = 0; k0 < 128; k0 += 16) {
            float wv[16];
#pragma unroll
            for (int j = 0; j < 16; ++j) wv[j] = w[(size_t)(k0 + j) * 6144];
#pragma unroll
            for (int j = 0; j < 16; ++j)
#pragma unroll
                for (int b = 0; b < 8; ++b) acc[b] += sc[b * 1024 + wave * 128 + k0 + j] * wv[j];
        }
#pragma unroll
        for (int b = 0; b < 8; ++b) part[(wave * 8 + b) * 64 + lane] = acc[b];
        __syncthreads();
        {
            const int b = tid >> 6, col = tid & 63;
            float v = p.b_ada[l * 6144 + n0 + col];
#pragma unroll
            for (int w_ = 0; w_ < 8; ++w_) v += part[(w_ * 8 + b) * 64 + col];
            mod[(size_t)(l * 8 + b) * 6144 + n0 + col] = v;
        }
        __syncthreads();
    }
}

template <bool MAP>
__device__ void tr_tile(const float* __restrict__ src, int lds_, bf16_t* __restrict__ out, int ldo, int k0, int n0, float* tile, const int tid) {
#pragma unroll
    for (int i = 0; i < 8; ++i) {
        int kk = (tid >> 6) + 8 * i, nn = tid & 63;
        int scol = MAP ? src_col(n0 + nn) : (n0 + nn);
        float v = (scol >= 0) ? src[(size_t)(k0 + kk) * lds_ + scol] : 0.f;
        tile[kk * 65 + nn] = v;
    }
    __syncthreads();
#pragma unroll
    for (int i = 0; i < 4; ++i) {
        int nn = (tid >> 5) + 16 * i, kk = (tid & 31) * 2;
        unsigned v = pack2(tile[kk * 65 + nn], tile[(kk + 1) * 65 + nn]);
        *(unsigned*)(out + (size_t)(n0 + nn) * ldo + k0 + kk) = v;
    }
    __syncthreads();
}
__device__ void conv_chunk(const float* __restrict__ src, bf16_t* __restrict__ dst, size_t base, const int tid) {
#pragma unroll
    for (int i = 0; i < 4; ++i) {
        size_t e = base + (size_t)(i * NT + tid) * 8;
        float4 a = *(const float4*)(src + e), b = *(const float4*)(src + e + 4);
        uint4 o; o.x = pack2(a.x, a.y); o.y = pack2(a.z, a.w); o.z = pack2(b.x, b.y); o.w = pack2(b.z, b.w);
        *(uint4*)(dst + e) = o;
    }
}
__device__ void conv_chunk_fp8(const float* __restrict__ src, unsigned char* __restrict__ dst, size_t base, float scale, const int tid) {
#pragma unroll
    for (int i = 0; i < 4; ++i) {
        size_t e = base + (size_t)(i * NT + tid) * 8;
        float4 a = *(const float4*)(src + e), b = *(const float4*)(src + e + 4);
        int lo = __builtin_amdgcn_cvt_pk_fp8_f32(a.x * scale, a.y * scale, 0, false); lo = __builtin_amdgcn_cvt_pk_fp8_f32(a.z * scale, a.w * scale, lo, true);
        int hi = __builtin_amdgcn_cvt_pk_fp8_f32(b.x * scale, b.y * scale, 0, false); hi = __builtin_amdgcn_cvt_pk_fp8_f32(b.z * scale, b.w * scale, hi, true);
        const size_t row = e >> 10, col = e & 1023;
        *(uint2*)(dst + ((col >> 7) * 16384 + row) * 128 + (col & 127)) = make_uint2((unsigned)lo, (unsigned)hi);
    }
}
__device__ void ph_wprep(const Params& p, int l, int vb0, int nvb, char* smem_) {
    float* tile = (float*)smem_;
    const int tid = TIDX();
    bf16_t* WIN = (bf16_t*)(p.ws + WS_WIN); bf16_t* WBR = (bf16_t*)(p.ws + WS_WBR); bf16_t* WOUT = (bf16_t*)(p.ws + WS_WOUT);
    bf16_t* WQ = (bf16_t*)(p.ws + WS_WQ); bf16_t* SK = (bf16_t*)(p.ws + WS_SK); unsigned char* PU = p.ws + WS_PU; unsigned char* PV = p.ws + WS_PV;
    constexpr int N_WIN = 136 * 16, N_WBR = 3 * 16 * 8, N_WOUT = 16 * 16, N_WQ = 32 * 16, N_SK = 16, N_PU = 1024, N_PV = 1024;
    constexpr int TOTAL = N_WIN + N_WBR + N_WOUT + N_WQ + N_SK + N_PU + N_PV;
    for (int task = vb0; task < TOTAL; task += nvb) {
        int r = task;
        if (r < N_WIN) { int nt = r / 16, kt = r % 16; tr_tile<true>(p.w_in + (size_t)l * 1024 * IN_COLS, IN_COLS, WIN, 1024, kt * 64, nt * 64, tile, tid); continue; }
        r -= N_WIN;
        if (r < N_WBR) { int g = r / 128, rr = r % 128, nt = rr / 8, kt = rr % 8;
            tr_tile<false>(p.w_branch + (size_t)(l * 3 + g) * 512 * 1024, 1024, WBR + (size_t)g * 1024 * 512, 512, kt * 64, nt * 64, tile, tid); continue; }
        r -= N_WBR;
        if (r < N_WOUT) { int nt = r / 16, kt = r % 16; tr_tile<false>(p.w_out + (size_t)l * 1024 * 1024, 1024, WOUT, 1024, kt * 64, nt * 64, tile, tid); continue; }
        r -= N_WOUT;
        if (r < N_WQ) { int nt = r / 16, kt = r % 16; tr_tile<false>(p.peer_wq + (size_t)l * 1024 * 2048, 2048, WQ, 1024, kt * 64, nt * 64, tile, tid); continue; }
        r -= N_WQ;
        if (r < N_SK) { conv_chunk(p.peer_keys + (size_t)l * 16 * 128 * 128, SK, (size_t)r * 16384, tid); continue; }
        r -= N_SK;
        if (r < N_PU) { conv_chunk_fp8(p.peer_u + (size_t)l * 16384 * 1024, PU, (size_t)r * 16384, PU_SCALE, tid); continue; }
        r -= N_PU;
        conv_chunk_fp8(p.peer_v + (size_t)l * 16384 * 1024, PV, (size_t)r * 16384, PV_SCALE, tid);
    }
}

__device__ void ph_norm(const Params& p, int l, int which, const float* xin, int vb0, int nvb) {
    const int wave = TIDX() >> 6, lane = TIDX() & 63;
    const float* gain = (which ? p.norm_ffn : p.norm_mix) + l * 1024;
    const float* modb = (const float*)(p.ws + WS_MOD);
    bf16_t* H = (bf16_t*)(p.ws + WS_H);
    for (int t = vb0 * 8 + wave; t < T_TOK; t += nvb * 8) {
        int b = t >> 11;
        const float* mod = modb + (size_t)(l * 8 + b) * 6144 + (which ? 3072 : 0);
        const float4* xr = (const float4*)(xin + (size_t)t * 1024);
        float4 v[4]; float ss = 0.f;
#pragma unroll
        for (int i = 0; i < 4; ++i) { v[i] = xr[lane + 64 * i]; ss += v[i].x * v[i].x + v[i].y * v[i].y + v[i].z * v[i].z + v[i].w * v[i].w; }
        ss = wave_sum(ss);
        float rstd = rsqrtf(ss * (1.f / 1024.f) + 1e-6f);
#pragma unroll
        for (int i = 0; i < 4; ++i) {
            int idx = (lane + 64 * i) * 4;
            float4 g = *(const float4*)(gain + idx), sc = *(const float4*)(mod + 1024 + idx), sh = *(const float4*)(mod + idx);
            float h0 = v[i].x * rstd * g.x * (1.f + sc.x) + sh.x, h1 = v[i].y * rstd * g.y * (1.f + sc.y) + sh.y;
            float h2 = v[i].z * rstd * g.z * (1.f + sc.z) + sh.z, h3 = v[i].w * rstd * g.w * (1.f + sc.w) + sh.w;
            uint2 o; o.x = pack2(h0, h1); o.y = pack2(h2, h3);
            *(uint2*)(H + (size_t)t * 1024 + idx) = o;
        }
    }
}

constexpr int GBM = 256, GBN = 128, GBK = 64, GLS = 72;
__device__ __forceinline__ void gemm_tile(const bf16_t* __restrict__ A, int lda, const bf16_t* __restrict__ Bt, int ldb, int K,
                                          int m0, int n0, bf16_t* sA, bf16_t* sB, f32x4 (&acc)[4][4], const int tid) {
    const int lane = tid & 63, wave = tid >> 6;
    const int wm = wave >> 1, wn = wave & 1, fr = lane & 15, fq = lane >> 4;
    u32x4 ra[4], rb[2];
    const int crow = tid >> 3, ckc = (tid & 7) * 8;
    const bf16_t* Ag = A + (size_t)(m0 + crow) * lda + ckc;
    const bf16_t* Bg = Bt + (size_t)(n0 + crow) * ldb + ckc;
#pragma unroll
    for (int i = 0; i < 4; ++i) ra[i] = *(const u32x4*)(Ag + (size_t)(64 * i) * lda);
#pragma unroll
    for (int i = 0; i < 2; ++i) rb[i] = *(const u32x4*)(Bg + (size_t)(64 * i) * ldb);
    for (int k0 = 0; k0 < K; k0 += GBK) {
        __syncthreads();
#pragma unroll
        for (int i = 0; i < 4; ++i) *(u32x4*)(sA + (crow + 64 * i) * GLS + ckc) = ra[i];
#pragma unroll
        for (int i = 0; i < 2; ++i) *(u32x4*)(sB + (crow + 64 * i) * GLS + ckc) = rb[i];
        __syncthreads();
        {
            const int kn = (k0 + GBK < K) ? (k0 + GBK) : k0;
#pragma unroll
            for (int i = 0; i < 4; ++i) ra[i] = *(const u32x4*)(Ag + (size_t)(64 * i) * lda + kn);
#pragma unroll
            for (int i = 0; i < 2; ++i) rb[i] = *(const u32x4*)(Bg + (size_t)(64 * i) * ldb + kn);
        }
#pragma unroll
        for (int ks = 0; ks < 2; ++ks) {
            bf16x8 af[4], wf[4];
#pragma unroll
            for (int mf = 0; mf < 4; ++mf) af[mf] = *(const bf16x8*)(sA + (wm * 64 + mf * 16 + fr) * GLS + ks * 32 + fq * 8);
#pragma unroll
            for (int nf = 0; nf < 4; ++nf) wf[nf] = *(const bf16x8*)(sB + (wn * 64 + nf * 16 + fr) * GLS + ks * 32 + fq * 8);
#pragma unroll
            for (int nf = 0; nf < 4; ++nf)
#pragma unroll
                for (int mf = 0; mf < 4; ++mf)
                    acc[nf][mf] = __builtin_amdgcn_mfma_f32_16x16x32_bf16(wf[nf], af[mf], acc[nf][mf], 0, 0, 0);
        }
    }
}


namespace pg8 {
#define PG8_LAS __attribute__((address_space(3)))
constexpr int BM = 256, BK = 64, HALF = 128, HTB = HALF * BK * 2, STAGE_BYTES = 8 * HTB, NXCD = 8, WGM = 8;
__device__ __forceinline__ int lds_byte(int r, int c) { const int st = (r >> 4) * 2 + (c >> 5), rr = r & 15, cc = c & 31, ob = rr * 64 + cc * 2; return st * 1024 + (ob ^ (((ob >> 9) & 1) << 5)); }
__device__ __forceinline__ void stage_rc(int b, int& R, int& C) { const int st = b / 1024, sb = b % 1024, swz = sb ^ (((sb >> 9) & 1) << 5); R = (st >> 1) * 16 + swz / 64; C = (st & 1) * 32 + (swz % 64) / 2; }
__device__ __forceinline__ int perm32(int rho) { const int n = rho >> 4, i = rho & 15; return 8 * (i >> 2) + 4 * n + (i & 3); }
struct Unit { int pm, pn, aux; size_t aoff, boff; };
struct Gemm { const bf16_t* A; const bf16_t* Bt; int lda, ldb, K; };

struct StaticOrder {
    int nM, nN, nwg, G, c, lda, ldb;
    __device__ void init(int M, int N, int G_, int c_, int lda_, int ldb_) { nM = M / BM; nN = N / BM; nwg = nM * nN; G = G_; c = c_; lda = lda_; ldb = ldb_; }
    __device__ bool next(int i, Unit& u) const {
        const long L = (long)i * G + c; if (L >= nwg) return false;
        int wgid = (int)L; { const int q = nwg / NXCD, r = nwg % NXCD, xcd = wgid % NXCD, off = wgid / NXCD; wgid = (xcd < r ? xcd * (q + 1) : r * (q + 1) + (xcd - r) * q) + off; }
        const int nig = WGM * nN, gid = wgid / nig, fm = gid * WGM, gsz = (nM - fm) < WGM ? (nM - fm) : WGM;
        u.pm = fm + ((wgid % nig) % gsz); u.pn = (wgid % nig) / gsz; u.aux = 0;
        u.aoff = (size_t)u.pm * BM * lda * 2; u.boff = (size_t)u.pn * BM * ldb * 2;
        return true;
    }
};
struct MergeOrder {
    int c, G;
    __device__ bool next(int i, Unit& u) const {
        const int tile = c + (i / 3) * G; if (tile >= 256) return false;
        u.pm = tile & 63; u.pn = tile >> 6; u.aux = i % 3;
        u.aoff = ((size_t)u.pm * BM * 1536 + (size_t)u.aux * 512) * 2; u.boff = ((size_t)u.aux * 1024 + (size_t)u.pn * BM) * 512 * 2;
        return true;
    }
};

template <class Epi, class Sched>
__device__ __forceinline__ void gemm_phase(PG8_LAS unsigned char* lds, const Gemm g, const Sched& S, const Epi& E, const int tid) {
    const int wid = __builtin_amdgcn_readfirstlane(tid >> 6), lane = tid & 63, wr = wid >> 2, wc = wid & 3, fr = lane & 15, fq = lane >> 4;
    const int K = g.K, nt = K / BK;
    unsigned voffA[2], voffB[2];
#pragma unroll
    for (int i = 0; i < 2; ++i) { int R, C; stage_rc(tid * 16 + i * 8192, R, C); const int Rb = Epi::PERM ? ((R & ~31) + perm32(R & 31)) : R;
        voffA[i] = (unsigned)(R * g.lda + C) * 2u; voffB[i] = (unsigned)(Rb * g.ldb + C) * 2u; }
    const size_t kstep = (size_t)(BK * 2);
    const size_t hstepA = (size_t)HALF * g.lda * 2, hstepB = (size_t)HALF * g.ldb * 2;
    const unsigned ldsw = (unsigned)wid * 1024u;
    const int aoff = lds_byte(wr * 64 + fr, fq * 8), boff = lds_byte(wc * 32 + fr, fq * 8);
#define PG8_SA(b, h) (((b) * 2 + (h)) * HTB)
#define PG8_SB(b, h) ((4 + (b) * 2 + (h)) * HTB)
#define PG8_STAGE(bufoff, gbase, voff) do { _Pragma("unroll") for (int _i = 0; _i < 2; ++_i) \
        __builtin_amdgcn_global_load_lds((const unsigned*)((const char*)(gbase) + (voff)[_i]), (PG8_LAS unsigned*)(lds + (bufoff) + ldsw + _i * 8192), 16, 0, 0); } while (0)
#define PG8_LDA(dst, b, h) do { _Pragma("unroll") for (int m = 0; m < 4; ++m) _Pragma("unroll") for (int k = 0; k < 2; ++k) dst[m][k] = *(const PG8_LAS bf16x8*)(lds + PG8_SA(b, h) + aoff + m * 2048 + k * 1024); } while (0)
#define PG8_LDB(dst, b, h) do { _Pragma("unroll") for (int n = 0; n < 2; ++n) _Pragma("unroll") for (int k = 0; k < 2; ++k) dst[n][k] = *(const PG8_LAS bf16x8*)(lds + PG8_SB(b, h) + boff + n * 2048 + k * 1024); } while (0)
#define PG8_MMA(ai, bj, At, Bt) do { __builtin_amdgcn_s_setprio(1); _Pragma("unroll") for (int m = 0; m < 4; ++m) _Pragma("unroll") for (int n = 0; n < 2; ++n) _Pragma("unroll") for (int k = 0; k < 2; ++k) \
        acc[ai][bj][m][n] = __builtin_amdgcn_mfma_f32_16x16x32_bf16(Bt[n][k], At[m][k], acc[ai][bj][m][n], 0, 0, 0); __builtin_amdgcn_s_setprio(0); } while (0)
#define PG8_WAIT_V(n) asm volatile("s_waitcnt vmcnt(" #n ")" ::: "memory")
#define PG8_WAIT_L(n) asm volatile("s_waitcnt lgkmcnt(" #n ")" ::: "memory")
#define PG8_BAR __builtin_amdgcn_s_barrier()
#define PG8_SCHED __builtin_amdgcn_sched_barrier(0)
    Unit cur, nxt; int ui = 0;
    if (!S.next(0, cur)) return;
    f32x4 acc[2][2][4][2];
#pragma unroll
    for (int a = 0; a < 2; ++a)
#pragma unroll
        for (int b = 0; b < 2; ++b)
#pragma unroll
            for (int m = 0; m < 4; ++m)
#pragma unroll
                for (int n = 0; n < 2; ++n) acc[a][b][m][n] = f32x4{0.f, 0.f, 0.f, 0.f};
    bf16x8 At[4][2], B0[2][2], B1[2][2];
    const char* cA = (const char*)g.A + cur.aoff; const char* cB = (const char*)g.Bt + cur.boff;
    PG8_STAGE(PG8_SB(0, 0), cB, voffB); PG8_STAGE(PG8_SA(0, 0), cA, voffA); PG8_STAGE(PG8_SB(0, 1), cB + hstepB, voffB); PG8_STAGE(PG8_SA(0, 1), cA + hstepA, voffA);
    if (wr == 1) PG8_BAR;
    PG8_WAIT_V(4); PG8_BAR;
    PG8_STAGE(PG8_SB(1, 0), cB + kstep, voffB); PG8_STAGE(PG8_SA(1, 0), cA + kstep, voffA); PG8_STAGE(PG8_SB(1, 1), cB + hstepB + kstep, voffB);
    PG8_WAIT_V(6); PG8_BAR;
    for (;;) {
        const bool has_next = S.next(ui + 1, nxt);
        const char* nA = has_next ? (const char*)g.A + nxt.aoff : cA; const char* nB = has_next ? (const char*)g.Bt + nxt.boff : cB;
        for (int t = 0; t < nt; t += 2) {
            const bool last = (t == nt - 2);
            const char* a1 = cA + (size_t)(t + 1) * kstep;
            const char* a2 = last ? nA : cA + (size_t)(t + 2) * kstep; const char* b2 = last ? nB : cB + (size_t)(t + 2) * kstep;
            const char* a3 = a2 + kstep; const char* b3 = b2 + kstep;
            PG8_LDB(B0, 0, 0); PG8_SCHED; PG8_LDA(At, 0, 0); PG8_STAGE(PG8_SA(1, 1), a1 + hstepA, voffA);
            PG8_WAIT_L(8); PG8_BAR; PG8_WAIT_L(0); PG8_MMA(0, 0, At, B0); PG8_BAR; PG8_SCHED;
            PG8_LDB(B1, 0, 1); PG8_STAGE(PG8_SB(0, 0), b2, voffB);
            PG8_BAR; PG8_WAIT_L(0); PG8_MMA(0, 1, At, B1); PG8_BAR;
            PG8_LDA(At, 0, 1); PG8_STAGE(PG8_SA(0, 0), a2, voffA);
            PG8_BAR; PG8_WAIT_L(0); PG8_MMA(1, 0, At, B0); PG8_BAR; PG8_SCHED;
            PG8_STAGE(PG8_SB(0, 1), b2 + hstepB, voffB);
            PG8_WAIT_V(6); PG8_BAR; PG8_MMA(1, 1, At, B1); PG8_BAR;
            PG8_LDB(B0, 1, 0); PG8_SCHED; PG8_LDA(At, 1, 0); PG8_STAGE(PG8_SA(0, 1), a2 + hstepA, voffA);
            PG8_WAIT_L(8); PG8_BAR; PG8_WAIT_L(0); PG8_MMA(0, 0, At, B0); PG8_BAR; PG8_SCHED;
            PG8_LDB(B1, 1, 1); PG8_STAGE(PG8_SB(1, 0), b3, voffB);
            PG8_BAR; PG8_WAIT_L(0); PG8_MMA(0, 1, At, B1); PG8_BAR;
            PG8_LDA(At, 1, 1); PG8_STAGE(PG8_SA(1, 0), a3, voffA);
            PG8_BAR; PG8_WAIT_L(0); PG8_MMA(1, 0, At, B0); PG8_BAR; PG8_SCHED;
            PG8_STAGE(PG8_SB(1, 1), b3 + hstepB, voffB);
            PG8_WAIT_V(6); PG8_BAR; PG8_MMA(1, 1, At, B1); PG8_BAR;
        }
        E(acc, cur, wr, wc, fr, fq);
        if (!has_next) break;
#pragma unroll
        for (int a = 0; a < 2; ++a)
#pragma unroll
            for (int b = 0; b < 2; ++b)
#pragma unroll
                for (int m = 0; m < 4; ++m)
#pragma unroll
                    for (int n = 0; n < 2; ++n) acc[a][b][m][n] = f32x4{0.f, 0.f, 0.f, 0.f};
        cur = nxt; cA = nA; cB = nB; ++ui;
    }
    PG8_WAIT_V(0);
    if (wr == 0) PG8_BAR;
    PG8_BAR;
#undef PG8_SA
#undef PG8_SB
#undef PG8_STAGE
#undef PG8_LDA
#undef PG8_LDB
#undef PG8_MMA
#undef PG8_WAIT_V
#undef PG8_WAIT_L
#undef PG8_BAR
#undef PG8_SCHED
}

struct EpiBf16 {
    static constexpr bool PERM = true;
    bf16_t* O; int ldc;
    __device__ __forceinline__ void operator()(const f32x4 (&acc)[2][2][4][2], const Unit& u, int wr, int wc, int fr, int fq) const {
        const int row0 = u.pm * BM + wr * 64 + fr, col0 = u.pn * BM + wc * 32 + 8 * fq;
#pragma unroll
        for (int ai = 0; ai < 2; ++ai)
#pragma unroll
            for (int m = 0; m < 4; ++m) { bf16_t* rowp = O + (size_t)(row0 + ai * HALF + m * 16) * ldc + col0;
#pragma unroll
                for (int bj = 0; bj < 2; ++bj) { const f32x4 v0 = acc[ai][bj][m][0], v1 = acc[ai][bj][m][1];
                    u32x4 w; w.x = pack2(v0[0], v0[1]); w.y = pack2(v0[2], v0[3]); w.z = pack2(v1[0], v1[1]); w.w = pack2(v1[2], v1[3]);
                    *(u32x4*)(rowp + bj * HALF) = w; } }
    }
};
struct EpiResid {
    static constexpr bool PERM = false;
    const float* xin; float* out; const float* mod;
    __device__ __forceinline__ void operator()(const f32x4 (&acc)[2][2][4][2], const Unit& u, int wr, int wc, int fr, int fq) const {
        const int row0 = u.pm * BM + wr * 64 + fr, col0 = u.pn * BM + wc * 32 + 4 * fq;
        const float* gm = mod + (size_t)(row0 >> 11) * 6144 + 2048 + col0;
#pragma unroll
        for (int ai = 0; ai < 2; ++ai)
#pragma unroll
            for (int m = 0; m < 4; ++m) { const size_t ro = (size_t)(row0 + ai * HALF + m * 16) * 1024 + col0;
#pragma unroll
                for (int bj = 0; bj < 2; ++bj)
#pragma unroll
                    for (int n = 0; n < 2; ++n) {
                        const f32x4 g4 = *(const f32x4*)(gm + bj * HALF + n * 16), xi = *(const f32x4*)(xin + ro + bj * HALF + n * 16);
                        *(f32x4*)(out + ro + bj * HALF + n * 16) = xi + g4 * acc[ai][bj][m][n]; } }
    }
};
struct EpiMerge {
    static constexpr bool PERM = true;
    bf16_t* Hm; const bf16_t* Z;
    __device__ __forceinline__ void operator()(const f32x4 (&acc)[2][2][4][2], const Unit& u, int wr, int wc, int fr, int fq) const {
        const int row0 = u.pm * BM + wr * 64 + fr, col0 = u.pn * BM + wc * 32 + 8 * fq, g = u.aux;
#pragma unroll
        for (int ai = 0; ai < 2; ++ai)
#pragma unroll
            for (int m = 0; m < 4; ++m) { const int row = row0 + ai * HALF + m * 16;
#pragma unroll
                for (int bj = 0; bj < 2; ++bj) {
                    const int col = col0 + bj * HALF;
                    const u32x4 gz = *(const u32x4*)(Z + (size_t)row * LDZ + ZM + g * 1024 + col);
                    u32x4 prev = u32x4{0u, 0u, 0u, 0u};
                    if (g > 0) prev = *(const u32x4*)(Hm + (size_t)row * 1024 + col);
                    const f32x4 v0 = acc[ai][bj][m][0], v1 = acc[ai][bj][m][1];
                    u32x4 w;
                    w.x = pack2(bflo(prev.x) + sigm(bflo(gz.x)) * v0[0], bfhi(prev.x) + sigm(bfhi(gz.x)) * v0[1]);
                    w.y = pack2(bflo(prev.y) + sigm(bflo(gz.y)) * v0[2], bfhi(prev.y) + sigm(bfhi(gz.y)) * v0[3]);
                    w.z = pack2(bflo(prev.z) + sigm(bflo(gz.z)) * v1[0], bfhi(prev.z) + sigm(bfhi(gz.z)) * v1[1]);
                    w.w = pack2(bflo(prev.w) + sigm(bflo(gz.w)) * v1[2], bfhi(prev.w) + sigm(bfhi(gz.w)) * v1[3]);
                    *(u32x4*)(Hm + (size_t)row * 1024 + col) = w; } }
    }
};
}

struct EpiZ {
    bf16_t* Z; int ld;
    __device__ __forceinline__ void operator()(int m, int n, const f32x4& v) const {
        uint2 o; o.x = pack2(v[0], v[1]); o.y = pack2(v[2], v[3]);
        *(uint2*)(Z + (size_t)m * ld + n) = o;
    }
};
struct EpiF32 {
    float* C; int ld;
    __device__ __forceinline__ void operator()(int m, int n, const f32x4& v) const {
        *(float4*)(C + (size_t)m * ld + n) = make_float4(v[0], v[1], v[2], v[3]);
    }
};
struct EpiOut {
    const float* xin; float* out; const float* mod;
    __device__ __forceinline__ void operator()(int m, int n, const f32x4& v) const {
        int b = m >> 11;
        float4 g = *(const float4*)(mod + (size_t)b * 6144 + 2048 + n);
        float4 xi = *(const float4*)(xin + (size_t)m * 1024 + n);
        *(float4*)(out + (size_t)m * 1024 + n) = make_float4(xi.x + g.x * v[0], xi.y + g.y * v[1], xi.z + g.z * v[2], xi.w + g.w * v[3]);
    }
};

template <class Epi>
__device__ void gemm_phase(const bf16_t* A, int lda, const bf16_t* Bt, int ldb, int M, int N, int K, bool batched, Epi epi,
                           int vb0, int nvb, char* smem_, const int tid) {
    bf16_t* sA = (bf16_t*)smem_; bf16_t* sB = sA + GBM * GLS;
    const int lane = tid & 63, wave = tid >> 6, wm = wave >> 1, wn = wave & 1, fr = lane & 15, fq = lane >> 4;
    const int MT = M / GBM, NTL = N / GBN;
    for (int tile = vb0; tile < MT * NTL; tile += nvb) {
        int mt = tile % MT, nt = tile / MT;
        f32x4 acc[4][4];
#pragma unroll
        for (int a = 0; a < 4; ++a)
#pragma unroll
            for (int b = 0; b < 4; ++b) acc[a][b] = f32x4{0.f, 0.f, 0.f, 0.f};
        gemm_tile(batched ? A + nt * 128 : A, lda, Bt, ldb, K, mt * GBM, nt * GBN, sA, sB, acc, tid);
#pragma unroll
        for (int nf = 0; nf < 4; ++nf)
#pragma unroll
            for (int mf = 0; mf < 4; ++mf)
                epi(mt * GBM + wm * 64 + mf * 16 + fr, nt * GBN + wn * 64 + nf * 16 + fq * 4, acc[nf][mf]);
    }
}


template <int DK, bool GLA>
__device__ void scan2_item(const Params& p, int l, int b, int h, char* smem_) {
    constexpr int SEG = NT / DK, SLEN = 64 / SEG, KS = DK / 32, KT = DK / 16;
    constexpr int QS = DK + 8, BS = DK + 4, VS = 72;
    bf16_t* qs = (bf16_t*)smem_;
    bf16_t* ks = qs + 64 * QS;
    float* bs = (float*)(ks + 64 * QS);
    bf16_t* vt = (bf16_t*)(bs + 64 * BS);
    bf16_t* At = vt + 128 * VS;
    bf16_t* kht = At + 64 * VS;
    bf16_t* st = kht + DK * VS;
    float* segtot = (float*)(st + 128 * QS);
    float* blast = segtot + SEG * DK;
    const int tid = TIDX(), lane = tid & 63, wave = __builtin_amdgcn_readfirstlane(tid >> 6), fr = lane & 15, fq = lane >> 4;
    const int kl = tid % DK, seg = __builtin_amdgcn_readfirstlane(tid / DK);
    float lbv = 0.f, gbias = 0.f; float gu[16];
#pragma unroll
    for (int r = 0; r < 16; ++r) gu[r] = 0.f;
    if (GLA) {
#pragma unroll
        for (int r = 0; r < 16; ++r) gu[r] = p.gla_up[(size_t)(l * 16 + r) * 256 + h * 64 + kl];
        gbias = p.gla_bias[l * 256 + h * 64 + kl];
    } else if (l == 1) {
        float x0 = p.hgrn_lb[h * 128 + kl], x1 = p.hgrn_lb[512 + h * 128 + kl];
        lbv = 1.f / (1.f + expf(x0 - x1));
    }
    const float scale = GLA ? 0.125f : 0.08838834764831845f;
    const bf16_t* Zb = (const bf16_t*)(p.ws + WS_Z) + (size_t)(b * 2048) * LDZ;
    float* ssq = (float*)(smem_ + 152576);
    const int QCOL = (GLA ? ZC_Q : ZA_Q) + h * DK, KCOL = (GLA ? ZC_K : ZA_F) + h * DK, VCOL = (GLA ? ZC_V : ZA_I) + h * 128, GCOL = (GLA ? ZC_G : ZA_G) + h * 128;
    f32x4 sacc[KT];
#pragma unroll
    for (int i = 0; i < KT; ++i) sacc[i] = f32x4{0.f, 0.f, 0.f, 0.f};
    for (int i = tid; i < 128 * QS / 2; i += NT) ((unsigned*)st)[i] = 0u;
    __syncthreads();

    for (int c = 0; c < 32; ++c) {
        const bf16_t* Zc = Zb + (size_t)(c * 64) * LDZ;
        {
            bf16_t rq[SLEN], rk[SLEN];
            u32x4 rc0[GLA ? SLEN : 1], rc1[GLA ? SLEN : 1];
            {
                bf16_t rv[16];
                const int v = tid & 127, sb_ = __builtin_amdgcn_readfirstlane(tid >> 7);
#pragma unroll
                for (int i = 0; i < 16; ++i) rv[i] = Zc[(size_t)(sb_ + 4 * i) * LDZ + VCOL + v];
#pragma unroll
                for (int i = 0; i < SLEN; ++i) {
                    const bf16_t* zr = Zc + (size_t)(seg * SLEN + i) * LDZ;
                    rq[i] = zr[QCOL + kl]; rk[i] = zr[KCOL + kl];
                    if (GLA) { rc0[i] = *(const u32x4*)(zr + ZC_CODE); rc1[i] = *(const u32x4*)(zr + ZC_CODE + 8); }
                }
#pragma unroll
                for (int i = 0; i < 16; ++i) vt[v * VS + sb_ + 4 * i] = rv[i];
            }
            float run = 0.f;
#pragma unroll
            for (int i = 0; i < SLEN; ++i) {
                const int s_ = seg * SLEN + i;
                float g, kk;
                if (GLA) {
                    float x = gbias;
#pragma unroll
                    for (int r = 0; r < 4; ++r) {
                        x += bflo(rc0[i][r]) * gu[2 * r] + bfhi(rc0[i][r]) * gu[2 * r + 1];
                        x += bflo(rc1[i][r]) * gu[8 + 2 * r] + bfhi(rc1[i][r]) * gu[8 + 2 * r + 1];
                    }
                    g = (fminf(x, 0.f) - __logf(1.f + __expf(-fabsf(x)))) * (1.f / 16.f);
                    kk = bf2f(rk[i]);
                } else {
                    const float f = lbv + (1.f - lbv) * __frcp_rn(1.f + __expf(-bf2f(rk[i])));
                    g = __logf(f); kk = 1.f - f;
                }
                run += g;
                bs[s_ * BS + kl] = run;
                qs[s_ * QS + kl] = rq[i];
                ks[s_ * QS + kl] = f2bf(kk);
            }
            segtot[seg * DK + kl] = run;
        }
        __syncthreads();
        {
            float pre = 0.f, tot = 0.f;
#pragma unroll
            for (int g_ = 0; g_ < SEG; ++g_) { const float v_ = segtot[g_ * DK + kl]; if (g_ < seg) pre += v_; tot += v_; }
            if (seg == 0) blast[kl] = tot;
            unsigned pk[SLEN / 2];
#pragma unroll
            for (int i = 0; i < SLEN; ++i) {
                const float bv = bs[(seg * SLEN + i) * BS + kl] + pre;
                bs[(seg * SLEN + i) * BS + kl] = bv;
                const float kh = bf2f(ks[(seg * SLEN + i) * QS + kl]) * __expf(tot - bv);
                if (i & 1) pk[i >> 1] |= ((unsigned)f2bf(kh)) << 16; else pk[i >> 1] = (unsigned)f2bf(kh);
            }
            unsigned* dst = (unsigned*)(kht + kl * VS + seg * SLEN);
#pragma unroll
            for (int i = 0; i < SLEN / 2; ++i) dst[i] = pk[i];
        }
        __syncthreads();
        for (int blk = wave; blk < 10; blk += 8) {
            int bi, bj;
            if (blk < 1) { bi = 0; bj = 0; } else if (blk < 3) { bi = 1; bj = blk - 1; } else if (blk < 6) { bi = 2; bj = blk - 3; } else { bi = 3; bj = blk - 6; }
            f32x4 acc = f32x4{0.f, 0.f, 0.f, 0.f};
            const int srow = bj * 16 + fr, trow = bi * 16 + fr;
#pragma unroll
            for (int kk = 0; kk < KS; ++kk) {
                const int k0 = kk * 32 + fq * 8;
                float br[8];
                if (bi == 0) {
#pragma unroll
                    for (int j = 0; j < 8; ++j) br[j] = 0.f;
                } else {
                    const float4 r0 = *(const float4*)(bs + (bi * 16 - 1) * BS + k0), r1 = *(const float4*)(bs + (bi * 16 - 1) * BS + k0 + 4);
                    br[0] = r0.x; br[1] = r0.y; br[2] = r0.z; br[3] = r0.w; br[4] = r1.x; br[5] = r1.y; br[6] = r1.z; br[7] = r1.w;
                }
                const uint4 kq = *(const uint4*)(ks + srow * QS + k0), qq = *(const uint4*)(qs + trow * QS + k0);
                const float4 s0 = *(const float4*)(bs + srow * BS + k0), s1 = *(const float4*)(bs + srow * BS + k0 + 4);
                const float4 t0_ = *(const float4*)(bs + trow * BS + k0), t1_ = *(const float4*)(bs + trow * BS + k0 + 4);
                const float bsv[8] = {s0.x, s0.y, s0.z, s0.w, s1.x, s1.y, s1.z, s1.w}, btv[8] = {t0_.x, t0_.y, t0_.z, t0_.w, t1_.x, t1_.y, t1_.z, t1_.w};
                const unsigned kw[4] = {kq.x, kq.y, kq.z, kq.w}, qw[4] = {qq.x, qq.y, qq.z, qq.w};
                union { bf16x8 v; unsigned u[4]; } ka, qb;
#pragma unroll
                for (int j = 0; j < 4; ++j) {
                    const float e0 = __expf(fminf(br[2 * j] - bsv[2 * j], 60.f)), e1 = __expf(fminf(br[2 * j + 1] - bsv[2 * j + 1], 60.f));
                    ka.u[j] = pack2(bflo(kw[j]) * e0, bfhi(kw[j]) * e1);
                    const float f0 = __expf(btv[2 * j] - br[2 * j]), f1 = __expf(btv[2 * j + 1] - br[2 * j + 1]);
                    qb.u[j] = pack2(bflo(qw[j]) * f0, bfhi(qw[j]) * f1);
                }
                acc = __builtin_amdgcn_mfma_f32_16x16x32_bf16(ka.v, qb.v, acc, 0, 0, 0);
            }
            if (bi == bj) {
#pragma unroll
                for (int r = 0; r < 4; ++r) if (4 * fq + r > fr) acc[r] = 0.f;
            }
            uint2 o; o.x = pack2(acc[0], acc[1]); o.y = pack2(acc[2], acc[3]);
            *(uint2*)(At + trow * VS + bj * 16 + 4 * fq) = o;
        }
        {
            unsigned z_ = 0u; asm volatile("" : "+v"(z_));
            if (wave == 2) *(uint2*)(At + (0 * 16 + fr) * VS + 16 + 4 * fq) = make_uint2(z_, z_);
            if (wave == 3) *(uint2*)(At + (2 * 16 + fr) * VS + 48 + 4 * fq) = make_uint2(z_, z_);
        }
        __syncthreads();
        f32x4 oacc[4]; uint2 gz[4];
        {
            const int ti = wave & 3, vh = wave >> 2, trow = ti * 16 + fr;
            bf16x8 qh[KS];
#pragma unroll
            for (int kk = 0; kk < KS; ++kk) {
                const int k0 = kk * 32 + fq * 8;
                const uint4 qq = *(const uint4*)(qs + trow * QS + k0);
                const float4 t0_ = *(const float4*)(bs + trow * BS + k0), t1_ = *(const float4*)(bs + trow * BS + k0 + 4);
                union { bf16x8 v; unsigned u[4]; } q_;
                q_.u[0] = pack2(bflo(qq.x) * __expf(t0_.x), bfhi(qq.x) * __expf(t0_.y));
                q_.u[1] = pack2(bflo(qq.y) * __expf(t0_.z), bfhi(qq.y) * __expf(t0_.w));
                q_.u[2] = pack2(bflo(qq.z) * __expf(t1_.x), bfhi(qq.z) * __expf(t1_.y));
                q_.u[3] = pack2(bflo(qq.w) * __expf(t1_.z), bfhi(qq.w) * __expf(t1_.w));
                qh[kk] = q_.v;
            }
            const bf16x8 af0 = *(const bf16x8*)(At + trow * VS + fq * 8), af1 = *(const bf16x8*)(At + trow * VS + 32 + fq * 8);
            float sq = 0.f;
#pragma unroll
            for (int vi = 0; vi < 4; ++vi) {
                const int vrow = vh * 64 + vi * 16 + fr;
                gz[vi] = *(const uint2*)(Zc + (size_t)trow * LDZ + GCOL + vh * 64 + vi * 16 + 4 * fq);
                f32x4 acc = f32x4{0.f, 0.f, 0.f, 0.f};
                acc = __builtin_amdgcn_mfma_f32_16x16x32_bf16(*(const bf16x8*)(vt + vrow * VS + fq * 8), af0, acc, 0, 0, 0);
                if (ti >= 2) acc = __builtin_amdgcn_mfma_f32_16x16x32_bf16(*(const bf16x8*)(vt + vrow * VS + 32 + fq * 8), af1, acc, 0, 0, 0);
#pragma unroll
                for (int kk = 0; kk < KS; ++kk)
                    acc = __builtin_amdgcn_mfma_f32_16x16x32_bf16(*(const bf16x8*)(st + vrow * QS + kk * 32 + fq * 8), qh[kk], acc, 0, 0, 0);
                oacc[vi] = acc * scale;
                sq += oacc[vi][0] * oacc[vi][0] + oacc[vi][1] * oacc[vi][1] + oacc[vi][2] * oacc[vi][2] + oacc[vi][3] * oacc[vi][3];
            }
            sq += shx<16>(sq); sq += shx<32>(sq);
            if (fq == 0) ssq[vh * 64 + trow] = sq;
        }
        {
            const int vrow = wave * 16 + fr;
            const bf16x8 vf0 = *(const bf16x8*)(vt + vrow * VS + fq * 8), vf1 = *(const bf16x8*)(vt + vrow * VS + 32 + fq * 8);
#pragma unroll
            for (int kt = 0; kt < KT; ++kt) {
                const float dec = __expf(blast[kt * 16 + fr]);
                sacc[kt][0] *= dec; sacc[kt][1] *= dec; sacc[kt][2] *= dec; sacc[kt][3] *= dec;
                sacc[kt] = __builtin_amdgcn_mfma_f32_16x16x32_bf16(vf0, *(const bf16x8*)(kht + (kt * 16 + fr) * VS + fq * 8), sacc[kt], 0, 0, 0);
                sacc[kt] = __builtin_amdgcn_mfma_f32_16x16x32_bf16(vf1, *(const bf16x8*)(kht + (kt * 16 + fr) * VS + 32 + fq * 8), sacc[kt], 0, 0, 0);
            }
        }
        __syncthreads();
#pragma unroll
        for (int kt = 0; kt < KT; ++kt)
#pragma unroll
            for (int r = 0; r < 4; ++r) st[(wave * 16 + 4 * fq + r) * QS + kt * 16 + fr] = f2bf(sacc[kt][r]);
        {
            const int ti = wave & 3, vh = wave >> 2, trow = ti * 16 + fr;
            const float rstd = rsqrtf((ssq[trow] + ssq[64 + trow]) * (1.f / 128.f) + 1e-6f);
            bf16_t* yrow = (bf16_t*)(p.ws + WS_Y) + (size_t)(b * 2048 + c * 64 + trow) * 1536 + (GLA ? 1024 : 0) + h * 128 + vh * 64 + 4 * fq;
            const float* gn = (GLA ? p.gla_on : p.hgrn_on) + l * 128 + vh * 64 + 4 * fq;
#pragma unroll
            for (int vi = 0; vi < 4; ++vi) {
                const float4 g4 = *(const float4*)(gn + vi * 16);
                const float z0 = bflo(gz[vi].x), z1 = bfhi(gz[vi].x), z2 = bflo(gz[vi].y), z3 = bfhi(gz[vi].y);
                uint2 o;
                o.x = pack2(oacc[vi][0] * rstd * g4.x * (z0 * sigm(z0)), oacc[vi][1] * rstd * g4.y * (z1 * sigm(z1)));
                o.y = pack2(oacc[vi][2] * rstd * g4.z * (z2 * sigm(z2)), oacc[vi][3] * rstd * g4.w * (z3 * sigm(z3)));
                *(uint2*)(yrow + vi * 16) = o;
            }
        }
    }
    __syncthreads();
}

__device__ void dsaprep2_item(const Params& p, int l, int item, char* smem_) {
    bf16_t* tile = (bf16_t*)smem_;
    const int tid = TIDX(), lane = tid & 63, wave = tid >> 6;
    bf16_t* Z = (bf16_t*)(p.ws + WS_Z); bf16_t* VT = (bf16_t*)(p.ws + WS_VT);
    {
        const int tb = item * 32;
        for (int tt = wave; tt < 32; tt += 8) {
            const int t = tb + tt;
#pragma unroll
            for (int grp = 0; grp < 8; ++grp) {
                bf16_t* ptr = Z + (size_t)t * LDZ + (grp < 4 ? ZB_Q : ZB_K) + (grp & 3) * 128 + lane * 2;
                unsigned u = *(unsigned*)ptr;
                float a = bflo(u), b = bfhi(u);
                float ss = wave_sum(a * a + b * b);
                float r = rsqrtf(ss * (1.f / 128.f) + 1e-6f);
                const float* gn = (grp < 4 ? p.dsa_qn : p.dsa_kn) + l * 128 + lane * 2;
                float sc = (grp < 4) ? 0.08838834764831845f : 1.f;
                *(unsigned*)ptr = pack2(a * r * gn[0] * sc, b * r * gn[1] * sc);
            }
        }
#pragma unroll
        for (int i = 0; i < 4; ++i) {
            int ch = tid + i * 512, t = ch >> 6, c8 = (ch & 63) * 8;
            uint4 u = *(const uint4*)(Z + (size_t)(tb + t) * LDZ + ZB_V + c8);
            unsigned* d = (unsigned*)(tile + t * 514 + c8);
            d[0] = u.x; d[1] = u.y; d[2] = u.z; d[3] = u.w;
        }
        __syncthreads();
        {
            const int c = tid, b = tb >> 11, s0 = tb & 2047;
            unsigned w[16];
#pragma unroll
            for (int j = 0; j < 16; ++j) w[j] = (unsigned)tile[(2 * j) * 514 + c] | ((unsigned)tile[(2 * j + 1) * 514 + c] << 16);
            uint4* dst = (uint4*)(VT + ((size_t)(b * 512 + c)) * 2048 + s0);
            dst[0] = make_uint4(w[0], w[1], w[2], w[3]); dst[1] = make_uint4(w[4], w[5], w[6], w[7]);
            dst[2] = make_uint4(w[8], w[9], w[10], w[11]); dst[3] = make_uint4(w[12], w[13], w[14], w[15]);
        }
        __syncthreads();
    }
}

__device__ void dsa_select_tile(const Params& p, int b, int tq, char* smem_) {
    constexpr int KS_ = 2052;
    unsigned* keyL = (unsigned*)smem_;
    const int tid = TIDX(), lane = tid & 63, wave = __builtin_amdgcn_readfirstlane(tid >> 6), fr = lane & 15, fq = lane >> 4;
    const bf16_t* Z = (const bf16_t*)(p.ws + WS_Z);
    unsigned long long* BM64 = (unsigned long long*)(p.ws + WS_BM);
    const int t0 = tq * 16;
    {
        const int tl = t0 + fr;
        const size_t trow = (size_t)b * 2048 + tl;
        bf16x8 qf[4][2];
#pragma unroll
        for (int h = 0; h < 4; ++h)
#pragma unroll
            for (int ks = 0; ks < 2; ++ks) qf[h][ks] = *(const bf16x8*)(Z + trow * LDZ + ZB_QI + h * 64 + ks * 32 + fq * 8);
        float w[4];
#pragma unroll
        for (int h = 0; h < 4; ++h) w[h] = bf2f(Z[trow * LDZ + ZB_WI + h]) * 0.5f;
#pragma unroll 2
        for (int kt = wave; kt <= tq; kt += 8) {
            const bf16_t* kr = Z + ((size_t)b * 2048 + kt * 16 + fr) * LDZ + ZB_KI + fq * 8;
            const bf16x8 k0 = *(const bf16x8*)kr, k1 = *(const bf16x8*)(kr + 32);
            f32x4 acc[4];
#pragma unroll
            for (int h = 0; h < 4; ++h) {
                acc[h] = __builtin_amdgcn_mfma_f32_16x16x32_bf16(k0, qf[h][0], f32x4{0.f, 0.f, 0.f, 0.f}, 0, 0, 0);
                acc[h] = __builtin_amdgcn_mfma_f32_16x16x32_bf16(k1, qf[h][1], acc[h], 0, 0, 0);
            }
            u32x4 kk;
#pragma unroll
            for (int r = 0; r < 4; ++r) {
                float sc = w[0] * fmaxf(acc[0][r] * 0.125f, 0.f) + w[1] * fmaxf(acc[1][r] * 0.125f, 0.f) + w[2] * fmaxf(acc[2][r] * 0.125f, 0.f) + w[3] * fmaxf(acc[3][r] * 0.125f, 0.f);
                if (sc == 0.f) sc = 0.f;
                const unsigned u = __float_as_uint(sc);
                const unsigned k = (u & 0x80000000u) ? ~u : (u | 0x80000000u);
                kk[r] = (kt * 16 + 4 * fq + r <= tl) ? k : 0u;
            }
            *(u32x4*)(keyL + fr * KS_ + kt * 16 + 4 * fq) = kk;
        }
    }
    __syncthreads();
    {
        const int nk = (tq + 1) * 16, jmax = (nk + 63) >> 6;
        const int qa = 2 * wave, qb = qa + 1;
        unsigned ka[32], kb[32];
#pragma unroll
        for (int j = 0; j < 32; ++j) {
            const int s = lane + 64 * j;
            ka[j] = (s < nk) ? keyL[qa * KS_ + s] : 0u;
            kb[j] = (s < nk) ? keyL[qb * KS_ + s] : 0u;
        }
        unsigned Ta = 1u, Tb = 1u; int Ca = 2047, Cb = 2047;
        if (t0 >= 256) {
            Ta = 0u; Tb = 0u;
            for (int bit = 31; bit >= 0; --bit) {
                const unsigned ca_ = Ta | (1u << bit), cb_ = Tb | (1u << bit);
                int c = 0;
#pragma unroll
                for (int j = 0; j < 32; ++j)
                    if (j < jmax) c += ((ka[j] >= ca_) ? 1 : 0) + ((kb[j] >= cb_) ? 65536 : 0);
                c = wave_sum_i(c);
                if ((c & 0xffff) >= 256) Ta = ca_;
                if ((c >> 16) >= 256) Tb = cb_;
            }
            int needa, needb;
            {
                int c = 0;
#pragma unroll
                for (int j = 0; j < 32; ++j)
                    if (j < jmax) c += ((ka[j] > Ta) ? 1 : 0) + ((kb[j] > Tb) ? 65536 : 0);
                c = wave_sum_i(c);
                needa = 256 - (c & 0xffff); needb = 256 - (c >> 16);
            }
            Ca = 0; Cb = 0;
            for (int bit = 10; bit >= 0; --bit) {
                const int ca_ = Ca | (1 << bit), cb_ = Cb | (1 << bit);
                int c = 0;
#pragma unroll
                for (int j = 0; j < 32; ++j)
                    if (j < jmax) { const int s = lane + 64 * j; c += ((ka[j] == Ta && s < ca_) ? 1 : 0) + ((kb[j] == Tb && s < cb_) ? 65536 : 0); }
                c = wave_sum_i(c);
                if ((c & 0xffff) < needa) Ca = ca_;
                if ((c >> 16) < needb) Cb = cb_;
            }
        }
        const size_t rowa = (size_t)b * 2048 + t0 + qa;
#pragma unroll
        for (int j = 0; j < 32; ++j) {
            const int s = lane + 64 * j;
            const unsigned long long ma = __ballot((ka[j] > Ta) || (ka[j] == Ta && s <= Ca));
            const unsigned long long mb = __ballot((kb[j] > Tb) || (kb[j] == Tb && s <= Cb));
            if (lane == 0) { BM64[rowa * 32 + j] = ma; BM64[(rowa + 1) * 32 + j] = mb; }
        }
    }
    __syncthreads();
}

__device__ void ph_dsa_attn(const Params& p, int vb0, int nvb, char* smem_) {
    constexpr int KSTR = 136, VSTR = 40;
    bf16_t* Kl = (bf16_t*)smem_;
    bf16_t* Vl = Kl + 2 * 32 * KSTR;
    const int tid = TIDX(), lane = tid & 63, wave = __builtin_amdgcn_readfirstlane(tid >> 6), fr = lane & 15, fq = lane >> 4;
    const bf16_t* Z = (const bf16_t*)(p.ws + WS_Z); const bf16_t* VT = (const bf16_t*)(p.ws + WS_VT);
    const unsigned* BM = (const unsigned*)(p.ws + WS_BM); bf16_t* Y = (bf16_t*)(p.ws + WS_Y);
    const int kr = tid >> 4, kc = tid & 15, vd = tid >> 2, vc = tid & 3;
    const int ka_row = 8 * (fr >> 2) + (fr & 3);
    int it = 0;
    for (int item = vb0; item < 512; item += nvb, ++it) {
        const int b = item >> 6, h = (item >> 4) & 3; int qg = item & 15; if (it & 1) qg = 15 - qg;
        const int t0 = qg * 128 + wave * 16;
        const size_t trow = (size_t)b * 2048 + t0 + fr;
        bf16x8 qf[4];
#pragma unroll
        for (int ks = 0; ks < 4; ++ks) qf[ks] = *(const bf16x8*)(Z + trow * LDZ + ZB_Q + h * 128 + ks * 32 + fq * 8);
        f32x4 o[8];
#pragma unroll
        for (int i = 0; i < 8; ++i) o[i] = f32x4{0.f, 0.f, 0.f, 0.f};
        float m = -INFINITY, lsum = 0.f;
        const unsigned* bmrow = BM + trow * 64;
        const int nsteps_blk = qg * 4 + 4, nsteps_w = (t0 + 15) / 32 + 1;
        const bf16_t* kg = Z + ((size_t)b * 2048 + kr) * LDZ + ZB_K + h * 128 + kc * 8;
        const bf16_t* vg = VT + ((size_t)(b * 4 + h) * 128 + vd) * 2048 + vc * 8;
        u32x4 rk = *(const u32x4*)kg, rv = *(const u32x4*)vg;
        *(u32x4*)(Kl + kr * KSTR + kc * 8) = rk; *(u32x4*)(Vl + vd * VSTR + vc * 8) = rv;
        __syncthreads();
        for (int st = 0; st < nsteps_blk; ++st) {
            const bool more = (st + 1 < nsteps_blk);
            if (more) { rk = *(const u32x4*)(kg + (size_t)(st + 1) * 32 * LDZ); rv = *(const u32x4*)(vg + (st + 1) * 32); }
            if (st < nsteps_w) {
                const bf16_t* Kb = Kl + (st & 1) * 32 * KSTR; const bf16_t* Vb = Vl + (st & 1) * 128 * VSTR;
                f32x4 sa = f32x4{0.f, 0.f, 0.f, 0.f}, sb = f32x4{0.f, 0.f, 0.f, 0.f};
#pragma unroll
                for (int ks = 0; ks < 4; ++ks) {
                    const bf16x8 fa = *(const bf16x8*)(Kb + ka_row * KSTR + ks * 32 + fq * 8), fb = *(const bf16x8*)(Kb + (ka_row + 4) * KSTR + ks * 32 + fq * 8);
                    sa = __builtin_amdgcn_mfma_f32_16x16x32_bf16(fa, qf[ks], sa, 0, 0, 0);
                    sb = __builtin_amdgcn_mfma_f32_16x16x32_bf16(fb, qf[ks], sb, 0, 0, 0);
                }
                const unsigned mw = bmrow[st] >> (8 * fq);
                float x[8];
#pragma unroll
                for (int r = 0; r < 4; ++r) { x[r] = ((mw >> r) & 1u) ? sa[r] : -INFINITY; x[4 + r] = ((mw >> (4 + r)) & 1u) ? sb[r] : -INFINITY; }
                float mx = fmaxf(fmaxf(fmaxf(x[0], x[1]), fmaxf(x[2], x[3])), fmaxf(fmaxf(x[4], x[5]), fmaxf(x[6], x[7])));
                mx = fmaxf(mx, shx<16>(mx)); mx = fmaxf(mx, shx<32>(mx));
                const float mnew = fmaxf(m, mx);
                const float msafe = (mnew == -INFINITY) ? 0.f : mnew;
                const float alpha = __expf(m - msafe);
                float pe[8]; float ps = 0.f;
#pragma unroll
                for (int j = 0; j < 8; ++j) { pe[j] = __expf(x[j] - msafe); ps += pe[j]; }
                lsum = lsum * alpha + ps;
                m = mnew;
#pragma unroll
                for (int i = 0; i < 8; ++i) { o[i][0] *= alpha; o[i][1] *= alpha; o[i][2] *= alpha; o[i][3] *= alpha; }
                union { bf16x8 v; unsigned u[4]; } pf;
                pf.u[0] = pack2(pe[0], pe[1]); pf.u[1] = pack2(pe[2], pe[3]); pf.u[2] = pack2(pe[4], pe[5]); pf.u[3] = pack2(pe[6], pe[7]);
#pragma unroll
                for (int i = 0; i < 8; ++i) {
                    const bf16x8 vf = *(const bf16x8*)(Vb + (i * 16 + fr) * VSTR + fq * 8);
                    o[i] = __builtin_amdgcn_mfma_f32_16x16x32_bf16(vf, pf.v, o[i], 0, 0, 0);
                }
            }
            if (more) { *(u32x4*)(Kl + ((st + 1) & 1) * 32 * KSTR + kr * KSTR + kc * 8) = rk; *(u32x4*)(Vl + ((st + 1) & 1) * 128 * VSTR + vd * VSTR + vc * 8) = rv; }
            __syncthreads();
        }
        lsum += shx<16>(lsum); lsum += shx<32>(lsum);
        const float inv = 1.f / lsum;
#pragma unroll
        for (int i = 0; i < 8; ++i) {
            uint2 ov; ov.x = pack2(o[i][0] * inv, o[i][1] * inv); ov.y = pack2(o[i][2] * inv, o[i][3] * inv);
            *(uint2*)(Y + trow * 1536 + 512 + h * 128 + i * 16 + 4 * fq) = ov;
        }
    }
}

constexpr int LDS_BYTES = 155648;
__device__ void ph_mixA(const Params& p, int l, int vb0, int nvb, char* smem_) {
    for (int item = vb0; item < 64; item += nvb) {
        if (item < 32) scan2_item<128, false>(p, l, item >> 2, item & 3, smem_);
        else scan2_item<64, true>(p, l, (item - 32) >> 2, (item - 32) & 3, smem_);
    }
    unsigned* ctr = (unsigned*)(p.ws + WS_CTL) + 3584 + l * 64;
    volatile int* slot = (volatile int*)(smem_ + LDS_BYTES - 64);
    for (;;) {
        if (TIDX() == 0) *slot = (int)atomicAdd(ctr, 1u);
        __syncthreads();
        const int idx = *slot;
        __syncthreads();
        if (idx >= 1536) break;
        if (idx < 1024) dsa_select_tile(p, idx & 7, 127 - (idx >> 3), smem_);
        else dsaprep2_item(p, l, idx - 1024, smem_);
    }
}

__device__ __forceinline__ int f2sort(float f) { int i = __float_as_int(f); return i ^ ((i >> 31) & 0x7fffffff); }
__device__ __forceinline__ float sort2f(int i) { return __int_as_float(i ^ ((i >> 31) & 0x7fffffff)); }
#define INSK(K, xv) do { int _x = (xv); \
    _Pragma("unroll") for (int _j = 0; _j < 16; ++_j) { int _hi = max(K[_j], _x); _x = min(K[_j], _x); K[_j] = _hi; } } while (0)
#define INS64(K, xv) do { unsigned long long _x = (xv); \
    _Pragma("unroll") for (int _j = 0; _j < 16; ++_j) { bool _c = _x > K[_j]; unsigned long long _o = K[_j]; K[_j] = _c ? _x : _o; _x = _c ? _o : _x; } } while (0)

__device__ void ph_route(const Params& p, int vb0, int nvb, char* smem_) {
    const float* SC = (const float*)(p.ws + WS_SC);
    int* RI = (int*)(p.ws + WS_RI); float* RG = (float*)(p.ws + WS_RG);
    const int tid = TIDX(), lane = tid & 63, wave = tid >> 6;
    float* tile = (float*)smem_ + wave * (64 * 68);
    for (int item0 = (vb0 * 8 + wave) * 64; item0 < T_TOK * 8; item0 += nvb * 8 * 64) {
        const int item = item0 + lane;
        const int t = item >> 3, h = item & 7;
        const float* s0 = SC + (size_t)t * 2048 + h * 256;
        const float* wbase = SC + (size_t)item0 * 256;
        int k0[16], k1[16];
#pragma unroll
        for (int j = 0; j < 16; ++j) { k0[j] = (int)0x80000000; k1[j] = (int)0x80000000; }
#pragma unroll 1
        for (int slab = 0; slab < 4; ++slab) {
            f32x4 ld[16];
#pragma unroll
            for (int j = 0; j < 8; ++j) {
                const float* src = wbase + (size_t)(8 * j + (lane >> 3)) * 256 + slab * 32 + (lane & 7) * 4;
                ld[j] = *(const f32x4*)src; ld[8 + j] = *(const f32x4*)(src + 128);
            }
            __builtin_amdgcn_wave_barrier();
#pragma unroll
            for (int j = 0; j < 8; ++j) {
                float* dst = tile + (8 * j + (lane >> 3)) * 68 + (lane & 7) * 4;
                *(f32x4*)dst = ld[j]; *(f32x4*)(dst + 32) = ld[8 + j];
            }
            __builtin_amdgcn_fence(__ATOMIC_RELEASE, "wavefront");
            __builtin_amdgcn_wave_barrier();
            __builtin_amdgcn_fence(__ATOMIC_ACQUIRE, "wavefront");
#pragma unroll 2
            for (int ii = 0; ii < 32; ii += 4) {
                const int i = slab * 32 + ii;
                const f32x4 a = *(const f32x4*)(tile + lane * 68 + ii), b = *(const f32x4*)(tile + lane * 68 + 32 + ii);
                INSK(k0, (f2sort(a[0]) & ~127) | (127 - i)); INSK(k0, (f2sort(a[1]) & ~127) | (126 - i));
                INSK(k0, (f2sort(a[2]) & ~127) | (125 - i)); INSK(k0, (f2sort(a[3]) & ~127) | (124 - i));
                INSK(k1, (f2sort(b[0]) & ~127) | (127 - i)); INSK(k1, (f2sort(b[1]) & ~127) | (126 - i));
                INSK(k1, (f2sort(b[2]) & ~127) | (125 - i)); INSK(k1, (f2sort(b[3]) & ~127) | (124 - i));
            }
            __builtin_amdgcn_wave_barrier();
        }
        float v0[16], v1[16];
#pragma unroll
        for (int j = 0; j < 16; ++j) { k0[j] = 127 - (k0[j] & 127); k1[j] = 127 - (k1[j] & 127); v0[j] = s0[k0[j]]; v1[j] = s0[128 + k1[j]]; }
        unsigned long long ck[16];
#pragma unroll
        for (int j = 0; j < 16; ++j) ck[j] = 0ull;
#pragma unroll
        for (int a = 0; a < 16; ++a)
#pragma unroll
            for (int b = 0; b < 16; ++b)
                if ((a + 1) * (b + 1) <= 16) {
                    unsigned hi = (unsigned)f2sort(v0[a] + v1[b]) ^ 0x80000000u;
                    unsigned lo = ((unsigned)(255 - (a * 16 + b)) << 16) | (unsigned)(k0[a] * 128 + k1[b]);
                    INS64(ck, ((unsigned long long)hi << 32) | lo);
                }
        float e[16]; float sm = 0.f;
        const float mx = sort2f((int)((unsigned)(ck[0] >> 32) ^ 0x80000000u));
#pragma unroll
        for (int j = 0; j < 16; ++j) { e[j] = expf(sort2f((int)((unsigned)(ck[j] >> 32) ^ 0x80000000u)) - mx); sm += e[j]; }
        const float inv = 1.f / sm;
#pragma unroll
        for (int j = 0; j < 16; j += 4) {
            *(int4*)(RI + (size_t)t * 128 + h * 16 + j) = make_int4((int)(ck[j] & 0xffffu), (int)(ck[j + 1] & 0xffffu), (int)(ck[j + 2] & 0xffffu), (int)(ck[j + 3] & 0xffffu));
            *(float4*)(RG + (size_t)t * 128 + h * 16 + j) = make_float4(e[j] * inv, e[j + 1] * inv, e[j + 2] * inv, e[j + 3] * inv);
        }
    }
}

__device__ __forceinline__ void fp8x16_to_f32(const uint4 q, float (&f)[16]) {
    const unsigned w[4] = {q.x, q.y, q.z, q.w};
#pragma unroll
    for (int c = 0; c < 4; ++c) {
        auto f0 = __builtin_amdgcn_cvt_pk_f32_fp8((int)w[c], false); auto f1 = __builtin_amdgcn_cvt_pk_f32_fp8((int)w[c], true);
        f[4 * c] = f0[0]; f[4 * c + 1] = f0[1]; f[4 * c + 2] = f1[0]; f[4 * c + 3] = f1[1];
    }
}
template <int WHICH>
#ifndef PEER_REP
#define PEER_REP 1
#endif
__device__ void ph_peer_sliced(const Params& p, int l, char* smem_) {
    const int tid = TIDX(), wave = tid >> 6;
    const bf16_t* H = (const bf16_t*)(p.ws + WS_H); const unsigned char* PU = p.ws + WS_PU; const unsigned char* PV = p.ws + WS_PV;
    const int* RI = (const int*)(p.ws + WS_RI); float* RG = (float*)(p.ws + WS_RG); float* PP = (float*)(p.ws + WS_PP);
    const float* modb = (const float*)(p.ws + WS_MOD);
    for (int rep = 0; rep < PEER_REP; ++rep) {
    unsigned* ctr = (unsigned*)(p.ws + WS_CTL) + 3712 + (l * 2 + WHICH) * 128 + rep * 1024;
    volatile int* slot = (volatile int*)(smem_ + LDS_BYTES - 64);
    const int xcc = (int)(xb_xcc_id() & 7u);
    for (int so = 0; so < 8; ++so) {
        const int x = (xcc + so) & 7;
        for (;;) {
            if (tid == 0) *slot = (int)atomicAdd(ctr + x * 16, 1u);
            __syncthreads();
            const int chunk = *slot;
            __syncthreads();
            if (chunk >= 256) break;
            {
                const int lane = lane_id_opaque(), eg = lane >> 3, ll = lane & 7;
                const int tb = chunk * 64 + wave * 8;
                int* lri = (int*)smem_ + wave * 2048; float* lrg = (float*)(lri + 1024);
                {
                    int ra[16]; float rg_[16];
#pragma unroll
                    for (int i = 0; i < 8; ++i) {
                        ra[2 * i] = RI[(size_t)(tb + i) * 128 + lane]; ra[2 * i + 1] = RI[(size_t)(tb + i) * 128 + 64 + lane];
                        if (WHICH == 1) { rg_[2 * i] = RG[(size_t)(tb + i) * 128 + lane]; rg_[2 * i + 1] = RG[(size_t)(tb + i) * 128 + 64 + lane]; }
                    }
#pragma unroll
                    for (int i = 0; i < 8; ++i) {
                        lri[i * 128 + lane] = ra[2 * i]; lri[i * 128 + 64 + lane] = ra[2 * i + 1];
                        if (WHICH == 1) { lrg[i * 128 + lane] = rg_[2 * i]; lrg[i * 128 + 64 + lane] = rg_[2 * i + 1]; }
                    }
                }
                __builtin_amdgcn_fence(__ATOMIC_RELEASE, "wavefront");
                __builtin_amdgcn_wave_barrier();
                __builtin_amdgcn_fence(__ATOMIC_ACQUIRE, "wavefront");
                uint4 hq0 = make_uint4(0u, 0u, 0u, 0u), hq1 = hq0;
                if (WHICH == 0) { const uint4* hp = (const uint4*)(H + (size_t)tb * 1024 + x * 128 + ll * 16); hq0 = hp[0]; hq1 = hp[1]; }
#pragma unroll 1
                for (int i = 0; i < 8; ++i) {
                    const int t = tb + i;
                    if (WHICH == 0) {
                        float hv[16];
                        hv[0] = bflo(hq0.x); hv[1] = bfhi(hq0.x); hv[2] = bflo(hq0.y); hv[3] = bfhi(hq0.y); hv[4] = bflo(hq0.z); hv[5] = bfhi(hq0.z); hv[6] = bflo(hq0.w); hv[7] = bfhi(hq0.w);
                        hv[8] = bflo(hq1.x); hv[9] = bfhi(hq1.x); hv[10] = bflo(hq1.y); hv[11] = bfhi(hq1.y); hv[12] = bflo(hq1.z); hv[13] = bfhi(hq1.z); hv[14] = bflo(hq1.w); hv[15] = bfhi(hq1.w);
                        if (i < 7) { const uint4* hp = (const uint4*)(H + (size_t)(t + 1) * 1024 + x * 128 + ll * 16); hq0 = hp[0]; hq1 = hp[1]; }
                        uint4 uq[16];
#pragma unroll
                        for (int it = 0; it < 16; ++it) {
                            const int e = lri[i * 128 + it * 8 + eg];
                            uq[it] = *(const uint4*)(PU + ((size_t)x * 16384 + e) * 128 + ll * 16);
                        }
#pragma unroll
                        for (int b2 = 0; b2 < 2; ++b2) {
                            float part[8];
#pragma unroll
                            for (int it = 0; it < 8; ++it) {
                                float f[16]; fp8x16_to_f32(uq[b2 * 8 + it], f);
                                float d = 0.f;
#pragma unroll
                                for (int j = 0; j < 16; ++j) d += hv[j] * f[j];
                                part[it] = d;
                            }
                            float r4[4], r2[2];
                            const bool b2_ = lane & 4, b1_ = lane & 2, b0_ = lane & 1;
#pragma unroll
                            for (int j = 0; j < 4; ++j) { const float snd = b2_ ? part[j] : part[j + 4], kp = b2_ ? part[j + 4] : part[j]; r4[j] = kp + shx<4>(snd); }
#pragma unroll
                            for (int j = 0; j < 2; ++j) { const float snd = b1_ ? r4[j] : r4[j + 2], kp = b1_ ? r4[j + 2] : r4[j]; r2[j] = kp + shx<2>(snd); }
                            const float snd = b0_ ? r2[0] : r2[1], kp = b0_ ? r2[1] : r2[0];
                            const float d = kp + shx<1>(snd);
                            PP[((size_t)x * T_TOK + t) * 128 + b2 * 64 + ll * 8 + eg] = d;
                        }
                    } else {
                        float y[16];
#pragma unroll
                        for (int j = 0; j < 16; ++j) y[j] = 0.f;
#pragma unroll
                        for (int b2 = 0; b2 < 2; ++b2) {
                            uint4 vq[8];
#pragma unroll
                            for (int it = 0; it < 8; ++it) {
                                const int e = lri[i * 128 + b2 * 64 + it * 8 + eg];
                                vq[it] = *(const uint4*)(PV + ((size_t)x * 16384 + e) * 128 + ll * 16);
                            }
#pragma unroll
                            for (int it = 0; it < 8; ++it) {
                                const float ck = lrg[i * 128 + b2 * 64 + it * 8 + eg];
                                float f[16]; fp8x16_to_f32(vq[it], f);
#pragma unroll
                                for (int j = 0; j < 16; ++j) y[j] += ck * f[j];
                            }
                        }
                        float r8[8], r4[4], r2[2];
                        const bool b5 = lane & 32, b4 = lane & 16, b3 = lane & 8;
#pragma unroll
                        for (int j = 0; j < 8; ++j) { const float snd = b5 ? y[j] : y[j + 8], kp = b5 ? y[j + 8] : y[j]; r8[j] = kp + shx<32>(snd); }
#pragma unroll
                        for (int j = 0; j < 4; ++j) { const float snd = b4 ? r8[j] : r8[j + 4], kp = b4 ? r8[j + 4] : r8[j]; r4[j] = kp + shx<16>(snd); }
#pragma unroll
                        for (int j = 0; j < 2; ++j) { const float snd = b3 ? r4[j] : r4[j + 2], kp = b3 ? r4[j + 2] : r4[j]; r2[j] = kp + shx<8>(snd); }
                        const int col = x * 128 + ll * 16 + ((lane >> 5) & 1) * 8 + ((lane >> 4) & 1) * 4 + ((lane >> 3) & 1) * 2;
                        const float2 gf = *(const float2*)(modb + (size_t)(l * 8 + (t >> 11)) * 6144 + 5120 + col);
                        float2* op = (float2*)(p.out + (size_t)t * 1024 + col);
                        const float2 xi = *op;
                        if (rep > 0) op = (float2*)((float*)(p.ws + WS_OA) + (size_t)t * 1024 + col);
                        *op = make_float2(xi.x + gf.x * r2[0], xi.y + gf.y * r2[1]);
                    }
                }
            }
        }
    }
    __syncthreads();
    }
}
__device__ void ph_peer_coef(const Params& p, int vb0, int nvb) {
    const int wave = TIDX() >> 6, lane = TIDX() & 63;
    float* RG = (float*)(p.ws + WS_RG); const float* PP = (const float*)(p.ws + WS_PP);
    for (int t = vb0 * 8 + wave; t < T_TOK; t += nvb * 8) {
#pragma unroll
        for (int half = 0; half < 2; ++half) {
            const int k = half * 64 + lane;
            float d = 0.f;
#pragma unroll
            for (int x = 0; x < 8; ++x) d += PP[((size_t)x * T_TOK + t) * 128 + k];
            d *= (1.f / PU_SCALE);
            const float g = RG[(size_t)t * 128 + k];
            RG[(size_t)t * 128 + k] = g * 0.5f * d * (1.f + erff(d * 0.7071067811865476f)) * (1.f / PV_SCALE);
        }
    }
}

enum { PH_MOD = 0, PH_WPREP, PH_NORM1, PH_GEMM_IN, PH_SCAN, PH_DSAPREP, PH_DSA, PH_POST, PH_MERGE, PH_OUT, PH_NORM2, PH_GEMM_Q, PH_GEMM_SC, PH_ROUTE, PH_GATHER, PH_GATHER_DUMMY, PH_DSASEL, PH_G1, PH_G15, PH_G2, PH_G1R, PH_G2R };

template <int PH>
__device__ __forceinline__ void run_phase(const Params& p, int l, int vb0, int nvb, char* smem) {
    const float* xin = (l == 0) ? p.x : p.out;
    if (PH == PH_MOD) ph_mod(p, vb0, nvb, smem);
    else if (PH == PH_WPREP) ph_wprep(p, l, vb0, nvb, smem);
    else if (PH == PH_NORM1) ph_norm(p, l, 0, xin, vb0, nvb);
    else if (PH == PH_GEMM_IN) {
        pg8::Gemm g{(const bf16_t*)(p.ws + WS_H), (const bf16_t*)(p.ws + WS_WIN), 1024, 1024, 1024};
        pg8::StaticOrder S; S.init(T_TOK, LDZ, nvb, vb0, 1024, 1024);
        pg8::gemm_phase(( PG8_LAS unsigned char*)smem, g, S, pg8::EpiBf16{(bf16_t*)(p.ws + WS_Z), LDZ}, TIDX());
    }
    else if (PH == PH_SCAN) ph_mixA(p, l, vb0, nvb, smem);
    else if (PH == PH_DSAPREP) { }
    else if (PH == PH_DSA) ph_dsa_attn(p, vb0, nvb, smem);
    else if (PH == PH_POST) { }
    else if (PH == PH_MERGE) {
        pg8::Gemm g{(const bf16_t*)(p.ws + WS_Y), (const bf16_t*)(p.ws + WS_WBR), 1536, 512, 512};
        pg8::MergeOrder S{vb0, nvb};
        pg8::gemm_phase((PG8_LAS unsigned char*)smem, g, S, pg8::EpiMerge{(bf16_t*)(p.ws + WS_H), (const bf16_t*)(p.ws + WS_Z)}, TIDX());
    }
    else if (PH == PH_OUT) {
        pg8::Gemm g{(const bf16_t*)(p.ws + WS_H), (const bf16_t*)(p.ws + WS_WOUT), 1024, 1024, 1024};
        pg8::StaticOrder S; S.init(T_TOK, 1024, nvb, vb0, 1024, 1024);
        pg8::gemm_phase((PG8_LAS unsigned char*)smem, g, S, pg8::EpiResid{xin, p.out, (const float*)(p.ws + WS_MOD) + (size_t)l * 8 * 6144}, TIDX());
    }
    else if (PH == PH_NORM2) ph_norm(p, l, 1, p.out, vb0, nvb);
    else if (PH == PH_GEMM_Q) {
        pg8::Gemm g{(const bf16_t*)(p.ws + WS_H), (const bf16_t*)(p.ws + WS_WQ), 1024, 1024, 1024};
        pg8::StaticOrder S; S.init(T_TOK, 2048, nvb, vb0, 1024, 1024);
        pg8::gemm_phase((PG8_LAS unsigned char*)smem, g, S, pg8::EpiBf16{(bf16_t*)(p.ws + WS_QP), 2048}, TIDX());
    }
    else if (PH == PH_GEMM_SC) gemm_phase((const bf16_t*)(p.ws + WS_QP), 2048, (const bf16_t*)(p.ws + WS_SK), 128, T_TOK, 2048, 128, true,
                                          EpiF32{(float*)(p.ws + WS_SC), 2048}, vb0, nvb, smem, TIDX());
    else if (PH == PH_ROUTE) ph_route(p, vb0, nvb, smem);
    else if (PH == PH_GATHER || PH == PH_GATHER_DUMMY) { }
    else if (PH == PH_DSASEL) { }
    else if (PH == PH_G1) ph_peer_sliced<0>(p, l, smem);
    else if (PH == PH_G15) ph_peer_coef(p, vb0, nvb);
    else if (PH == PH_G2) ph_peer_sliced<1>(p, l, smem);

}

template <int PH>
__global__ void __launch_bounds__(NT) k_phase(Params p, int l) {
    extern __shared__ __attribute__((aligned(16))) char smem[];
    p.wv = __builtin_amdgcn_readfirstlane((int)threadIdx.x >> 6);
    run_phase<PH>(p, l, (int)blockIdx.x, (int)gridDim.x, smem);
}


#define XB_TMO      128
#define XB_XCNT(j)  (256  + 64 * (j))
#define XB_XSUB(j)  (1280 + 64 * (j))
#define XB_XGEN(j)  (2304 + 64 * (j))
#define XB_TOP      3328
#define XB_TOPGEN   3392
#define XCD_BAR_WORDS 3456
#define XB_SPIN_CAP (1u << 18)
#define LAS __attribute__((address_space(3)))
__device__ __forceinline__ unsigned xb_ld(unsigned* p)              { return __hip_atomic_load(p, __ATOMIC_RELAXED, __HIP_MEMORY_SCOPE_AGENT); }
__device__ __forceinline__ unsigned xb_add(unsigned* p, unsigned v) { return __hip_atomic_fetch_add(p, v, __ATOMIC_RELAXED, __HIP_MEMORY_SCOPE_AGENT); }
#define XB_SPIN(cond, bar) do { unsigned _sp = 0; while (cond) { __builtin_amdgcn_s_sleep(1); \
    if ((++_sp & 255u) == 0u) { if (xb_ld(&(bar)[XB_TMO])) break; if (_sp > XB_SPIN_CAP) { atomicAdd(&(bar)[XB_TMO], 1u); break; } } } } while (0)
struct XcdBarrier { unsigned* bar; unsigned x; volatile LAS unsigned* st; int wv; };
__device__ __forceinline__ XcdBarrier xcd_barrier_post(unsigned* bar, volatile LAS unsigned* st, int wv) {
    XcdBarrier b; b.bar = bar; b.x = xb_xcc_id(); b.st = st; b.wv = wv;
    if (TIDXW(wv) == 0) (void)xb_add(&bar[XB_XCNT(b.x)], 1u);
    return b;
}
__device__ __forceinline__ void xcd_barrier_complete(unsigned* bar, unsigned x, unsigned& nloc, unsigned& nx) {
    const unsigned G = gridDim.x * gridDim.y * gridDim.z;
    unsigned sum, cnt, mine, sp = 0u;
    for (;;) {
        sum = 0u; cnt = 0u; mine = 0u;
#pragma unroll
        for (unsigned j = 0; j < 16; ++j) { const unsigned c = xb_ld(&bar[XB_XCNT(j)]); sum += c; cnt += (c > 0u) ? 1u : 0u; mine = (j == x) ? c : mine; }
        if (sum == G) break;
        __builtin_amdgcn_s_sleep(1);
        if ((++sp & 255u) == 0u) { if (xb_ld(&bar[XB_TMO])) break; if (sp > XB_SPIN_CAP) { atomicAdd(&bar[XB_TMO], 1u); break; } }
    }
    nloc = mine > 0u ? mine : 1u; nx = cnt > 0u ? cnt : 1u;
}
__device__ __forceinline__ void xcd_barrier(const XcdBarrier& b) {
    asm volatile("s_waitcnt vmcnt(0)" ::: "memory");
    __syncthreads();
    if (TIDXW(b.wv) == 0) {
        unsigned* bar = b.bar;
        __builtin_amdgcn_s_waitcnt(0);
        unsigned nloc = b.st[0], nx = b.st[1];
        if (nloc == 0u) { xcd_barrier_complete(bar, b.x, nloc, nx); b.st[0] = nloc; b.st[1] = nx; }
        const unsigned old = xb_add(&bar[XB_XSUB(b.x)], 1u);
        const unsigned gen = old / nloc;
        if (old + 1u == (gen + 1u) * nloc) {
            __builtin_amdgcn_fence(__ATOMIC_RELEASE, "agent");
            asm volatile("s_waitcnt vmcnt(0)" ::: "memory");
            const unsigned og = xb_add(&bar[XB_TOP], 1u);
            const unsigned tg = og / nx;
            if (og + 1u == (tg + 1u) * nx) xb_add(&bar[XB_TOPGEN], 1u);
            else XB_SPIN(xb_ld(&bar[XB_TOPGEN]) == tg, bar);
            __builtin_amdgcn_fence(__ATOMIC_ACQUIRE, "agent");
            xb_add(&bar[XB_XGEN(b.x)], 1u);
            asm volatile("s_waitcnt vmcnt(0)" ::: "memory");
        } else {
            XB_SPIN(xb_ld(&bar[XB_XGEN(b.x)]) == gen, bar);
            __builtin_amdgcn_fence(__ATOMIC_ACQUIRE, "agent");
            asm volatile("s_waitcnt vmcnt(0)" ::: "memory");
        }
    }
    __syncthreads();
}

__global__ void __launch_bounds__(NT) mega_kernel(Params p_in) {
#if defined(__HIP_DEVICE_COMPILE__)
    extern __shared__ __attribute__((aligned(16))) char smem[];
    volatile LAS unsigned* st = (volatile LAS unsigned*)(smem + LDS_BYTES - 16);
    int wv_ = __builtin_amdgcn_readfirstlane((int)threadIdx.x >> 6); asm volatile("" : "+s"(wv_));
    { const int t_ = TIDXW(wv_); if (t_ < 4) st[t_] = 0u; }
    __syncthreads();
    XcdBarrier bar = xcd_barrier_post((unsigned*)(p_in.ws + WS_CTL), st, wv_);
    const int vb = (int)blockIdx.x, nvb = (int)gridDim.x;
#ifndef PROBE_PH
#define PROBE_PH -1
#endif
#define GB() xcd_barrier(bar)
#define RUN(PH, L) do { for (int _r = 0; _r < ((PROBE_PH == PH && PH != PH_DSAPREP) ? 2 : 1); ++_r) { \
        const __attribute__((address_space(4))) Params* _kp = (const __attribute__((address_space(4))) Params*)__builtin_amdgcn_kernarg_segment_ptr(); asm volatile("" : "+s"(_kp)); Params _p = *_kp; _p.wv = wv_; \
        int _l = (L), _vb = vb, _nvb = nvb; asm volatile("" : "+s"(_l), "+s"(_vb), "+s"(_nvb)); \
        run_phase<(PROBE_PH == PH_GATHER_DUMMY && PH == PH_GATHER && 0) ? PH_GATHER_DUMMY : PH>(_p, _l, _vb, _nvb, smem); if (PROBE_PH == PH) __syncthreads(); } } while (0)
    RUN(PH_MOD, 0);
#pragma unroll 1
    for (int l = 0; l < 2; ++l) {
        RUN(PH_WPREP, l); GB();
        RUN(PH_NORM1, l); GB();
        RUN(PH_GEMM_IN, l); GB();
        RUN(PH_SCAN, l);
        RUN(PH_DSAPREP, l);
        GB();
        RUN(PH_DSA, l);
        GB();
        RUN(PH_MERGE, l); GB();
        RUN(PH_OUT, l); GB();
        RUN(PH_NORM2, l); GB();
        RUN(PH_GEMM_Q, l); GB();
        RUN(PH_GEMM_SC, l); GB();
        RUN(PH_ROUTE, l); GB();
        RUN(PH_G1, l); GB();
        RUN(PH_G15, l); GB();
        RUN(PH_G2, l);
        if (l == 0) GB();
    }
#undef RUN
#undef GB
#endif
}

extern "C" void kernel_launch(void* const* d_in, const int* in_sizes, int n_in, void* d_out, int out_size, void* d_ws, size_t ws_size,
                              hipStream_t stream) {
    if (n_in != 20 || ws_size < WS_END) { fprintf(stderr, "kernel_launch: bad inputs (n_in %d ws %zu need %zu)\n", n_in, ws_size, (size_t)WS_END); return; }
    Params p{};
    p.x = (const float*)d_in[0]; p.c = (const float*)d_in[1]; p.w_ada = (const float*)d_in[2]; p.b_ada = (const float*)d_in[3];
    p.norm_mix = (const float*)d_in[4]; p.norm_ffn = (const float*)d_in[5]; p.w_in = (const float*)d_in[6]; p.hgrn_lb = (const float*)d_in[7];
    p.hgrn_on = (const float*)d_in[8]; p.dsa_qn = (const float*)d_in[9]; p.dsa_kn = (const float*)d_in[10]; p.gla_up = (const float*)d_in[11];
    p.gla_bias = (const float*)d_in[12]; p.gla_on = (const float*)d_in[13]; p.w_branch = (const float*)d_in[14]; p.w_out = (const float*)d_in[15];
    p.peer_wq = (const float*)d_in[16]; p.peer_keys = (const float*)d_in[17]; p.peer_u = (const float*)d_in[18]; p.peer_v = (const float*)d_in[19];
    p.out = (float*)d_out; p.ws = (unsigned char*)d_ws;
#if MEGA
    static int grid = 0;
    if (grid == 0) {
        int dev = 0, cus = 0, per_cu = 0;
        hipGetDevice(&dev);
        hipDeviceGetAttribute(&cus, hipDeviceAttributeMultiprocessorCount, dev);
        hipFuncSetAttribute((const void*)mega_kernel, hipFuncAttributeMaxDynamicSharedMemorySize, LDS_BYTES);
        hipOccupancyMaxActiveBlocksPerMultiprocessor(&per_cu, (const void*)mega_kernel, NT, LDS_BYTES);
        if (per_cu < 1) { fprintf(stderr, "kernel_launch: occupancy query says %d blocks per CU\n", per_cu); per_cu = 1; }
        (void)hipGetLastError();
        grid = cus;
    }
    hipMemsetAsync((char*)d_ws + WS_CTL, 0, 32768, stream);
    void* args[] = {&p};
    hipError_t e = hipLaunchCooperativeKernel((const void*)mega_kernel, dim3(grid), dim3(NT), args, LDS_BYTES, stream);
    if (e != hipSuccess) fprintf(stderr, "cooperative launch failed: %s (grid %d)\n", hipGetErrorString(e), grid);
#else
    const int G = 256;
#define LAUNCH(PH, l) hipLaunchKernelGGL(k_phase<PH>, dim3(G), dim3(NT), LDS_BYTES, stream, p, l)
    LAUNCH(PH_MOD, 0);
    for (int l = 0; l < 2; ++l) {
        LAUNCH(PH_WPREP, l);
        LAUNCH(PH_NORM1, l);
        LAUNCH(PH_GEMM_IN, l);
        LAUNCH(PH_SCAN, l);
        LAUNCH(PH_DSAPREP, l);
        LAUNCH(PH_DSA, l);
        LAUNCH(PH_POST, l);
        LAUNCH(PH_MERGE, l);
        LAUNCH(PH_OUT, l);
        LAUNCH(PH_NORM2, l);
        LAUNCH(PH_GEMM_Q, l);
        LAUNCH(PH_GEMM_SC, l);
        LAUNCH(PH_ROUTE, l);
        LAUNCH(PH_GATHER, l);
    }
#endif
}
```

```cpp
#include <hip/hip_runtime.h>
#include <stdint.h>
#include <stdio.h>

#ifndef MEGA
#define MEGA 1
#endif

typedef unsigned short bf16_t;
typedef short bf16x8 __attribute__((ext_vector_type(8)));
typedef float f32x4 __attribute__((ext_vector_type(4)));
typedef unsigned u32x4 __attribute__((ext_vector_type(4)));

#define NT 512
constexpr int T_TOK = 16384, DM = 1024, SEQ = 2048;
constexpr int LDZ = 8704;
constexpr int ZA_Q = 0, ZA_F = 512, ZA_I = 1024, ZA_G = 1536, ZB_Q = 2048, ZB_K = 2560, ZB_V = 3072, ZC_V = 3584, ZC_G = 4096,
              ZB_QI = 4608, ZC_Q = 4864, ZC_K = 5120, ZB_KI = 5376, ZB_WI = 5440, ZC_CODE = 5444, ZM = 5632;
constexpr int IN_COLS = 8532;

constexpr size_t al256(size_t x) { return (x + 255) & ~(size_t)255; }
constexpr size_t WS_CTL = 0;
constexpr size_t WS_MOD = 65536;
constexpr size_t WS_WIN = al256(WS_MOD + (size_t)2 * 8 * 6144 * 4);
constexpr size_t WS_WBR = al256(WS_WIN + (size_t)LDZ * 1024 * 2);
constexpr size_t WS_WOUT = al256(WS_WBR + (size_t)3 * 1024 * 512 * 2);
constexpr size_t WS_WQ = al256(WS_WOUT + (size_t)1024 * 1024 * 2);
constexpr size_t WS_SK = al256(WS_WQ + (size_t)2048 * 1024 * 2);
constexpr size_t WS_PU = al256(WS_SK + (size_t)16 * 128 * 128 * 2);
constexpr size_t WS_PV = al256(WS_PU + (size_t)16384 * 1024);
constexpr size_t WS_H = al256(WS_PV + (size_t)16384 * 1024);
constexpr float PU_SCALE = 32.f, PV_SCALE = 4.f;
constexpr size_t WS_OA = al256(WS_H + (size_t)T_TOK * 1024 * 2);
constexpr size_t WS_OC = al256(WS_OA + (size_t)T_TOK * 512 * 2);
constexpr size_t WS_Y = al256(WS_OC + (size_t)T_TOK * 512 * 2);
constexpr size_t WS_Z = al256(WS_Y + (size_t)T_TOK * 1536 * 2);
constexpr size_t WS_VT = al256(WS_Z + (size_t)T_TOK * LDZ * 2);
constexpr size_t WS_BM = al256(WS_VT + (size_t)T_TOK * 512 * 2);
constexpr size_t WS_END = al256(WS_BM + (size_t)T_TOK * 64 * 4);
constexpr size_t WS_QP = WS_Z;
constexpr size_t WS_SC = al256(WS_QP + (size_t)T_TOK * 2048 * 2);
constexpr size_t WS_RI = al256(WS_SC + (size_t)T_TOK * 2048 * 4);
constexpr size_t WS_RG = al256(WS_RI + (size_t)T_TOK * 128 * 4);
constexpr size_t WS_PP = al256(WS_RG + (size_t)T_TOK * 128 * 4);
static_assert(WS_PP + (size_t)8 * T_TOK * 128 * 4 <= WS_VT, "peer partials overflow the Z region");
static_assert(WS_RG + (size_t)T_TOK * 128 * 4 <= WS_END, "peer alias overflow");

struct Params {
    const float* x; const float* c; const float* w_ada; const float* b_ada; const float* norm_mix; const float* norm_ffn;
    const float* w_in; const float* hgrn_lb; const float* hgrn_on; const float* dsa_qn; const float* dsa_kn;
    const float* gla_up; const float* gla_bias; const float* gla_on; const float* w_branch; const float* w_out;
    const float* peer_wq; const float* peer_keys; const float* peer_u; const float* peer_v;
    float* out; unsigned char* ws;
    int wv, pad;
};

__device__ __forceinline__ float bf2f(bf16_t h) { return __uint_as_float(((unsigned)h) << 16); }
__device__ __forceinline__ float bflo(unsigned u) { return __uint_as_float(u << 16); }
__device__ __forceinline__ float bfhi(unsigned u) { return __uint_as_float(u & 0xffff0000u); }
__device__ __forceinline__ bf16_t f2bf(float f) { unsigned r; asm volatile("v_cvt_pk_bf16_f32 %0, %1, %1" : "=v"(r) : "v"(f)); return (bf16_t)(r & 0xffffu); }
__device__ __forceinline__ unsigned pack2(float a, float b) { unsigned r; asm volatile("v_cvt_pk_bf16_f32 %0, %1, %2" : "=v"(r) : "v"(a), "v"(b)); return r; }
__device__ __forceinline__ int lane_id_opaque() { int l; asm volatile("v_mbcnt_lo_u32_b32 %0, -1, 0\n\tv_mbcnt_hi_u32_b32 %0, -1, %0" : "=v"(l)); return l; }
template <int M> __device__ __forceinline__ int shx_i(int v) {
    if (M < 32) return __builtin_amdgcn_ds_swizzle(v, (M << 10) | 0x1f);
    return __builtin_amdgcn_ds_bpermute((lane_id_opaque() ^ 32) << 2, v);
}
template <int M> __device__ __forceinline__ float shx(float v) { return __int_as_float(shx_i<M>(__float_as_int(v))); }
template <int M> __device__ __forceinline__ int shx(int v) { return shx_i<M>(v); }
template <int M> __device__ __forceinline__ unsigned shx(unsigned v) { return (unsigned)shx_i<M>((int)v); }
__device__ __forceinline__ int bperm(int v, int src) { return __builtin_amdgcn_ds_bpermute(src << 2, v); }
__device__ __forceinline__ float bperm(float v, int src) { return __int_as_float(__builtin_amdgcn_ds_bpermute(src << 2, __float_as_int(v))); }
__device__ __forceinline__ float wave_sum(float v) { v += shx<32>(v); v += shx<16>(v); v += shx<8>(v); v += shx<4>(v); v += shx<2>(v); v += shx<1>(v); return v; }
__device__ __forceinline__ float wave_max(float v) { v = fmaxf(v, shx<32>(v)); v = fmaxf(v, shx<16>(v)); v = fmaxf(v, shx<8>(v)); v = fmaxf(v, shx<4>(v)); v = fmaxf(v, shx<2>(v)); v = fmaxf(v, shx<1>(v)); return v; }
__device__ __forceinline__ int wave_sum_i(int v) { v += shx<32>(v); v += shx<16>(v); v += shx<8>(v); v += shx<4>(v); v += shx<2>(v); v += shx<1>(v); return v; }
__device__ __forceinline__ int wave_total_i(int v) {
    v += __builtin_amdgcn_update_dpp(0, v, 0x111, 0xf, 0xf, true);
    v += __builtin_amdgcn_update_dpp(0, v, 0x112, 0xf, 0xf, true);
    v += __builtin_amdgcn_update_dpp(0, v, 0x114, 0xf, 0xf, true);
    v += __builtin_amdgcn_update_dpp(0, v, 0x118, 0xf, 0xf, true);
    v += __builtin_amdgcn_update_dpp(0, v, 0x142, 0xa, 0xf, true);
    v += __builtin_amdgcn_update_dpp(0, v, 0x143, 0xc, 0xf, true);
    return __builtin_amdgcn_readlane(v, 63);
}
__device__ __forceinline__ float sigm(float x) { return __frcp_rn(1.f + __expf(-x)); }

__device__ __forceinline__ unsigned xb_xcc_id() { return (unsigned)__builtin_amdgcn_s_getreg((3 << 11) | 20) & 0xFu; }
__device__ __forceinline__ int TIDXW(int wv) { int t; asm volatile("v_mbcnt_lo_u32_b32 %0, -1, 0\n\tv_mbcnt_hi_u32_b32 %0, -1, %0\n\tv_lshl_or_b32 %0, %1, 6, %0" : "=v"(t) : "s"(wv)); return t; }
#define TIDX() TIDXW(p.wv)

__device__ __forceinline__ int src_col(int j) {
    if (j < 3584) return j;
    if (j < 4096) return j - 3584 + 4420;
    if (j < 4608) return j - 4096 + 4948;
    if (j < 4864) return j - 4608 + 3584;
    if (j < 5120) return j - 4864 + 3908;
    if (j < 5376) return j - 5120 + 4164;
    if (j < 5440) return j - 5376 + 3840;
    if (j < 5444) return j - 5440 + 3904;
    if (j < 5460) return j - 5444 + 4932;
    if (j < 5632) return -1;
    return j - 5632 + 5460;
}

__device__ void ph_mod(const Params& p, int vb0, int nvb, char* smem_) {
    float* sc = (float*)smem_;
    float* part = sc + 8 * 1024;
    float* mod = (float*)(p.ws + WS_MOD);
    const int tid = TIDX(), lane = tid & 63, wave = tid >> 6;
    if (vb0 >= 192) return;
    for (int i = tid; i < 8 * 1024; i += NT) { float c = p.c[i]; sc[i] = c / (1.f + __expf(-c)); }
    __syncthreads();
    for (int task = vb0; task < 192; task += nvb) {
        const int l = task / 96, n0 = (task % 96) * 64;
        const float* w = p.w_ada + (size_t)l * 1024 * 6144 + (size_t)(wave * 128) * 6144 + n0 + lane;
        float acc[8];
#pragma unroll
        for (int b = 0; b < 8; ++b) acc[b] = 0.f;
#pragma unroll 1
        for (int k0 = 0; k0 < 128; k0 += 16) {
            float wv[16];
#pragma unroll
            for (int j = 0; j < 16; ++j) wv[j] = w[(size_t)(k0 + j) * 6144];
#pragma unroll
            for (int j = 0; j < 16; ++j)
#pragma unroll
                for (int b = 0; b < 8; ++b) acc[b] += sc[b * 1024 + wave * 128 + k0 + j] * wv[j];
        }
#pragma unroll
        for (int b = 0; b < 8; ++b) part[(wave * 8 + b) * 64 + lane] = acc[b];
        __syncthreads();
        {
            const int b = tid >> 6, col = tid & 63;
            float v = p.b_ada[l * 6144 + n0 + col];
#pragma unroll
            for (int w_ = 0; w_ < 8; ++w_) v += part[(w_ * 8 + b) * 64 + col];
            mod[(size_t)(l * 8 + b) * 6144 + n0 + col] = v;
        }
        __syncthreads();
    }
}

template <bool MAP>
__device__ void tr_tile(const float* __restrict__ src, int lds_, bf16_t* __restrict__ out, int ldo, int k0, int n0, float* tile, const int tid) {
#pragma unroll
    for (int i = 0; i < 8; ++i) {
        int kk = (tid >> 6) + 8 * i, nn = tid & 63;
        int scol = MAP ? src_col(n0 + nn) : (n0 + nn);
        float v = (scol >= 0) ? src[(size_t)(k0 + kk) * lds_ + scol] : 0.f;
        tile[kk * 65 + nn] = v;
    }
    __syncthreads();
#pragma unroll
    for (int i = 0; i < 4; ++i) {
        int nn = (tid >> 5) + 16 * i, kk = (tid & 31) * 2;
        unsigned v = pack2(tile[kk * 65 + nn], tile[(kk + 1) * 65 + nn]);
        *(unsigned*)(out + (size_t)(n0 + nn) * ldo + k0 + kk) = v;
    }
    __syncthreads();
}
__device__ void conv_chunk(const float* __restrict__ src, bf16_t* __restrict__ dst, size_t base, const int tid) {
#pragma unroll
    for (int i = 0; i < 4; ++i) {
        size_t e = base + (size_t)(i * NT + tid) * 8;
        float4 a = *(const float4*)(src + e), b = *(const float4*)(src + e + 4);
        uint4 o; o.x = pack2(a.x, a.y); o.y = pack2(a.z, a.w); o.z = pack2(b.x, b.y); o.w = pack2(b.z, b.w);
        *(uint4*)(dst + e) = o;
    }
}
__device__ void conv_chunk_fp8(const float* __restrict__ src, unsigned char* __restrict__ dst, size_t base, float scale, const int tid) {
#pragma unroll
    for (int i = 0; i < 4; ++i) {
        size_t e = base + (size_t)(i * NT + tid) * 8;
        float4 a = *(const float4*)(src + e), b = *(const float4*)(src + e + 4);
        int lo = __builtin_amdgcn_cvt_pk_fp8_f32(a.x * scale, a.y * scale, 0, false); lo = __builtin_amdgcn_cvt_pk_fp8_f32(a.z * scale, a.w * scale, lo, true);
        int hi = __builtin_amdgcn_cvt_pk_fp8_f32(b.x * scale, b.y * scale, 0, false); hi = __builtin_amdgcn_cvt_pk_fp8_f32(b.z * scale, b.w * scale, hi, true);
        const size_t row = e >> 10, col = e & 1023;
        *(uint2*)(dst + ((col >> 7) * 16384 + row) * 128 + (col & 127)) = make_uint2((unsigned)lo, (unsigned)hi);
    }
}
__device__ void ph_wprep(const Params& p, int l, int vb0, int nvb, char* smem_) {
    float* tile = (float*)smem_;
    const int tid = TIDX();
    bf16_t* WIN = (bf16_t*)(p.ws + WS_WIN); bf16_t* WBR = (bf16_t*)(p.ws + WS_WBR); bf16_t* WOUT = (bf16_t*)(p.ws + WS_WOUT);
    bf16_t* WQ = (bf16_t*)(p.ws + WS_WQ); bf16_t* SK = (bf16_t*)(p.ws + WS_SK); unsigned char* PU = p.ws + WS_PU; unsigned char* PV = p.ws + WS_PV;
    constexpr int N_WIN = 136 * 16, N_WBR = 3 * 16 * 8, N_WOUT = 16 * 16, N_WQ = 32 * 16, N_SK = 16, N_PU = 1024, N_PV = 1024;
    constexpr int TOTAL = N_WIN + N_WBR + N_WOUT + N_WQ + N_SK + N_PU + N_PV;
    for (int task = vb0; task < TOTAL; task += nvb) {
        int r = task;
        if (r < N_WIN) { int nt = r / 16, kt = r % 16; tr_tile<true>(p.w_in + (size_t)l * 1024 * IN_COLS, IN_COLS, WIN, 1024, kt * 64, nt * 64, tile, tid); continue; }
        r -= N_WIN;
        if (r < N_WBR) { int g = r / 128, rr = r % 128, nt = rr / 8, kt = rr % 8;
            tr_tile<false>(p.w_branch + (size_t)(l * 3 + g) * 512 * 1024, 1024, WBR + (size_t)g * 1024 * 512, 512, kt * 64, nt * 64, tile, tid); continue; }
        r -= N_WBR;
        if (r < N_WOUT) { int nt = r / 16, kt = r % 16; tr_tile<false>(p.w_out + (size_t)l * 1024 * 1024, 1024, WOUT, 1024, kt * 64, nt * 64, tile, tid); continue; }
        r -= N_WOUT;
        if (r < N_WQ) { int nt = r / 16, kt = r % 16; tr_tile<false>(p.peer_wq + (size_t)l * 1024 * 2048, 2048, WQ, 1024, kt * 64, nt * 64, tile, tid); continue; }
        r -= N_WQ;
        if (r < N_SK) { conv_chunk(p.peer_keys + (size_t)l * 16 * 128 * 128, SK, (size_t)r * 16384, tid); continue; }
        r -= N_SK;
        if (r < N_PU) { conv_chunk_fp8(p.peer_u + (size_t)l * 16384 * 1024, PU, (size_t)r * 16384, PU_SCALE, tid); continue; }
        r -= N_PU;
        conv_chunk_fp8(p.peer_v + (size_t)l * 16384 * 1024, PV, (size_t)r * 16384, PV_SCALE, tid);
    }
}

__device__ void ph_norm(const Params& p, int l, int which, const float* xin, int vb0, int nvb) {
    const int wave = TIDX() >> 6, lane = TIDX() & 63;
    const float* gain = (which ? p.norm_ffn : p.norm_mix) + l * 1024;
    const float* modb = (const float*)(p.ws + WS_MOD);
    bf16_t* H = (bf16_t*)(p.ws + WS_H);
    for (int t = vb0 * 8 + wave; t < T_TOK; t += nvb * 8) {
        int b = t >> 11;
        const float* mod = modb + (size_t)(l * 8 + b) * 6144 + (which ? 3072 : 0);
        const float4* xr = (const float4*)(xin + (size_t)t * 1024);
        float4 v[4]; float ss = 0.f;
#pragma unroll
        for (int i = 0; i < 4; ++i) { v[i] = xr[lane + 64 * i]; ss += v[i].x * v[i].x + v[i].y * v[i].y + v[i].z * v[i].z + v[i].w * v[i].w; }
        ss = wave_sum(ss);
        float rstd = rsqrtf(ss * (1.f / 1024.f) + 1e-6f);
#pragma unroll
        for (int i = 0; i < 4; ++i) {
            int idx = (lane + 64 * i) * 4;
            float4 g = *(const float4*)(gain + idx), sc = *(const float4*)(mod + 1024 + idx), sh = *(const float4*)(mod + idx);
            float h0 = v[i].x * rstd * g.x * (1.f + sc.x) + sh.x, h1 = v[i].y * rstd * g.y * (1.f + sc.y) + sh.y;
            float h2 = v[i].z * rstd * g.z * (1.f + sc.z) + sh.z, h3 = v[i].w * rstd * g.w * (1.f + sc.w) + sh.w;
            uint2 o; o.x = pack2(h0, h1); o.y = pack2(h2, h3);
            *(uint2*)(H + (size_t)t * 1024 + idx) = o;
        }
    }
}

constexpr int GBM = 256, GBN = 128, GBK = 64, GLS = 72;
__device__ __forceinline__ void gemm_tile(const bf16_t* __restrict__ A, int lda, const bf16_t* __restrict__ Bt, int ldb, int K,
                                          int m0, int n0, bf16_t* sA, bf16_t* sB, f32x4 (&acc)[4][4], const int tid) {
    const int lane = tid & 63, wave = tid >> 6;
    const int wm = wave >> 1, wn = wave & 1, fr = lane & 15, fq = lane >> 4;
    u32x4 ra[4], rb[2];
    const int crow = tid >> 3, ckc = (tid & 7) * 8;
    const bf16_t* Ag = A + (size_t)(m0 + crow) * lda + ckc;
    const bf16_t* Bg = Bt + (size_t)(n0 + crow) * ldb + ckc;
#pragma unroll
    for (int i = 0; i < 4; ++i) ra[i] = *(const u32x4*)(Ag + (size_t)(64 * i) * lda);
#pragma unroll
    for (int i = 0; i < 2; ++i) rb[i] = *(const u32x4*)(Bg + (size_t)(64 * i) * ldb);
    for (int k0 = 0; k0 < K; k0 += GBK) {
        __syncthreads();
#pragma unroll
        for (int i = 0; i < 4; ++i) *(u32x4*)(sA + (crow + 64 * i) * GLS + ckc) = ra[i];
#pragma unroll
        for (int i = 0; i < 2; ++i) *(u32x4*)(sB + (crow + 64 * i) * GLS + ckc) = rb[i];
        __syncthreads();
        {
            const int kn = (k0 + GBK < K) ? (k0 + GBK) : k0;
#pragma unroll
            for (int i = 0; i < 4; ++i) ra[i] = *(const u32x4*)(Ag + (size_t)(64 * i) * lda + kn);
#pragma unroll
            for (int i = 0; i < 2; ++i) rb[i] = *(const u32x4*)(Bg + (size_t)(64 * i) * ldb + kn);
        }
#pragma unroll
        for (int ks = 0; ks < 2; ++ks) {
            bf16x8 af[4], wf[4];
#pragma unroll
            for (int mf = 0; mf < 4; ++mf) af[mf] = *(const bf16x8*)(sA + (wm * 64 + mf * 16 + fr) * GLS + ks * 32 + fq * 8);
#pragma unroll
            for (int nf = 0; nf < 4; ++nf) wf[nf] = *(const bf16x8*)(sB + (wn * 64 + nf * 16 + fr) * GLS + ks * 32 + fq * 8);
#pragma unroll
            for (int nf = 0; nf < 4; ++nf)
#pragma unroll
                for (int mf = 0; mf < 4; ++mf)
                    acc[nf][mf] = __builtin_amdgcn_mfma_f32_16x16x32_bf16(wf[nf], af[mf], acc[nf][mf], 0, 0, 0);
        }
    }
}


namespace pg8 {
#define PG8_LAS __attribute__((address_space(3)))
constexpr int BM = 256, BK = 64, HALF = 128, HTB = HALF * BK * 2, STAGE_BYTES = 8 * HTB, NXCD = 8, WGM = 8;
__device__ __forceinline__ int lds_byte(int r, int c) { const int st = (r >> 4) * 2 + (c >> 5), rr = r & 15, cc = c & 31, ob = rr * 64 + cc * 2; return st * 1024 + (ob ^ (((ob >> 9) & 1) << 5)); }
__device__ __forceinline__ void stage_rc(int b, int& R, int& C) { const int st = b / 1024, sb = b % 1024, swz = sb ^ (((sb >> 9) & 1) << 5); R = (st >> 1) * 16 + swz / 64; C = (st & 1) * 32 + (swz % 64) / 2; }
__device__ __forceinline__ int perm32(int rho) { const int n = rho >> 4, i = rho & 15; return 8 * (i >> 2) + 4 * n + (i & 3); }
struct Unit { int pm, pn, aux; size_t aoff, boff; };
struct Gemm { const bf16_t* A; const bf16_t* Bt; int lda, ldb, K; };

struct StaticOrder {
    int nM, nN, nwg, G, c, lda, ldb;
    __device__ void init(int M, int N, int G_, int c_, int lda_, int ldb_) { nM = M / BM; nN = N / BM; nwg = nM * nN; G = G_; c = c_; lda = lda_; ldb = ldb_; }
    __device__ bool next(int i, Unit& u) const {
        const long L = (long)i * G + c; if (L >= nwg) return false;
        int wgid = (int)L; { const int q = nwg / NXCD, r = nwg % NXCD, xcd = wgid % NXCD, off = wgid / NXCD; wgid = (xcd < r ? xcd * (q + 1) : r * (q + 1) + (xcd - r) * q) + off; }
        const int nig = WGM * nN, gid = wgid / nig, fm = gid * WGM, gsz = (nM - fm) < WGM ? (nM - fm) : WGM;
        u.pm = fm + ((wgid % nig) % gsz); u.pn = (wgid % nig) / gsz; u.aux = 0;
        u.aoff = (size_t)u.pm * BM * lda * 2; u.boff = (size_t)u.pn * BM * ldb * 2;
        return true;
    }
};
struct MergeOrder {
    int c, G;
    __device__ bool next(int i, Unit& u) const {
        const int tile = c + (i / 3) * G; if (tile >= 256) return false;
        u.pm = tile & 63; u.pn = tile >> 6; u.aux = i % 3;
        u.aoff = ((size_t)u.pm * BM * 1536 + (size_t)u.aux * 512) * 2; u.boff = ((size_t)u.aux * 1024 + (size_t)u.pn * BM) * 512 * 2;
        return true;
    }
};

template <class Epi, class Sched>
__device__ __forceinline__ void gemm_phase(PG8_LAS unsigned char* lds, const Gemm g, const Sched& S, const Epi& E, const int tid) {
    const int wid = __builtin_amdgcn_readfirstlane(tid >> 6), lane = tid & 63, wr = wid >> 2, wc = wid & 3, fr = lane & 15, fq = lane >> 4;
    const int K = g.K, nt = K / BK;
    unsigned voffA[2], voffB[2];
#pragma unroll
    for (int i = 0; i < 2; ++i) { int R, C; stage_rc(tid * 16 + i * 8192, R, C); const int Rb = Epi::PERM ? ((R & ~31) + perm32(R & 31)) : R;
        voffA[i] = (unsigned)(R * g.lda + C) * 2u; voffB[i] = (unsigned)(Rb * g.ldb + C) * 2u; }
    const size_t kstep = (size_t)(BK * 2);
    const size_t hstepA = (size_t)HALF * g.lda * 2, hstepB = (size_t)HALF * g.ldb * 2;
    const unsigned ldsw = (unsigned)wid * 1024u;
    const int aoff = lds_byte(wr * 64 + fr, fq * 8), boff = lds_byte(wc * 32 + fr, fq * 8);
#define PG8_SA(b, h) (((b) * 2 + (h)) * HTB)
#define PG8_SB(b, h) ((4 + (b) * 2 + (h)) * HTB)
#define PG8_STAGE(bufoff, gbase, voff) do { _Pragma("unroll") for (int _i = 0; _i < 2; ++_i) \
        __builtin_amdgcn_global_load_lds((const unsigned*)((const char*)(gbase) + (voff)[_i]), (PG8_LAS unsigned*)(lds + (bufoff) + ldsw + _i * 8192), 16, 0, 0); } while (0)
#define PG8_LDA(dst, b, h) do { _Pragma("unroll") for (int m = 0; m < 4; ++m) _Pragma("unroll") for (int k = 0; k < 2; ++k) dst[m][k] = *(const PG8_LAS bf16x8*)(lds + PG8_SA(b, h) + aoff + m * 2048 + k * 1024); } while (0)
#define PG8_LDB(dst, b, h) do { _Pragma("unroll") for (int n = 0; n < 2; ++n) _Pragma("unroll") for (int k = 0; k < 2; ++k) dst[n][k] = *(const PG8_LAS bf16x8*)(lds + PG8_SB(b, h) + boff + n * 2048 + k * 1024); } while (0)
#define PG8_MMA(ai, bj, At, Bt) do { __builtin_amdgcn_s_setprio(1); _Pragma("unroll") for (int m = 0; m < 4; ++m) _Pragma("unroll") for (int n = 0; n < 2; ++n) _Pragma("unroll") for (int k = 0; k < 2; ++k) \
        acc[ai][bj][m][n] = __builtin_amdgcn_mfma_f32_16x16x32_bf16(Bt[n][k], At[m][k], acc[ai][bj][m][n], 0, 0, 0); __builtin_amdgcn_s_setprio(0); } while (0)
#define PG8_WAIT_V(n) asm volatile("s_waitcnt vmcnt(" #n ")" ::: "memory")
#define PG8_WAIT_L(n) asm volatile("s_waitcnt lgkmcnt(" #n ")" ::: "memory")
#define PG8_BAR __builtin_amdgcn_s_barrier()
#define PG8_SCHED __builtin_amdgcn_sched_barrier(0)
    Unit cur, nxt; int ui = 0;
    if (!S.next(0, cur)) return;
    f32x4 acc[2][2][4][2];
#pragma unroll
    for (int a = 0; a < 2; ++a)
#pragma unroll
        for (int b = 0; b < 2; ++b)
#pragma unroll
            for (int m = 0; m < 4; ++m)
#pragma unroll
                for (int n = 0; n < 2; ++n) acc[a][b][m][n] = f32x4{0.f, 0.f, 0.f, 0.f};
    bf16x8 At[4][2], B0[2][2], B1[2][2];
    const char* cA = (const char*)g.A + cur.aoff; const char* cB = (const char*)g.Bt + cur.boff;
    PG8_STAGE(PG8_SB(0, 0), cB, voffB); PG8_STAGE(PG8_SA(0, 0), cA, voffA); PG8_STAGE(PG8_SB(0, 1), cB + hstepB, voffB); PG8_STAGE(PG8_SA(0, 1), cA + hstepA, voffA);
    if (wr == 1) PG8_BAR;
    PG8_WAIT_V(4); PG8_BAR;
    PG8_STAGE(PG8_SB(1, 0), cB + kstep, voffB); PG8_STAGE(PG8_SA(1, 0), cA + kstep, voffA); PG8_STAGE(PG8_SB(1, 1), cB + hstepB + kstep, voffB);
    PG8_WAIT_V(6); PG8_BAR;
    for (;;) {
        const bool has_next = S.next(ui + 1, nxt);
        const char* nA = has_next ? (const char*)g.A + nxt.aoff : cA; const char* nB = has_next ? (const char*)g.Bt + nxt.boff : cB;
        for (int t = 0; t < nt; t += 2) {
            const bool last = (t == nt - 2);
            const char* a1 = cA + (size_t)(t + 1) * kstep;
            const char* a2 = last ? nA : cA + (size_t)(t + 2) * kstep; const char* b2 = last ? nB : cB + (size_t)(t + 2) * kstep;
            const char* a3 = a2 + kstep; const char* b3 = b2 + kstep;
            PG8_LDB(B0, 0, 0); PG8_SCHED; PG8_LDA(At, 0, 0); PG8_STAGE(PG8_SA(1, 1), a1 + hstepA, voffA);
            PG8_WAIT_L(8); PG8_BAR; PG8_WAIT_L(0); PG8_MMA(0, 0, At, B0); PG8_BAR; PG8_SCHED;
            PG8_LDB(B1, 0, 1); PG8_STAGE(PG8_SB(0, 0), b2, voffB);
            PG8_BAR; PG8_WAIT_L(0); PG8_MMA(0, 1, At, B1); PG8_BAR;
            PG8_LDA(At, 0, 1); PG8_STAGE(PG8_SA(0, 0), a2, voffA);
            PG8_BAR; PG8_WAIT_L(0); PG8_MMA(1, 0, At, B0); PG8_BAR; PG8_SCHED;
            PG8_STAGE(PG8_SB(0, 1), b2 + hstepB, voffB);
            PG8_WAIT_V(6); PG8_BAR; PG8_MMA(1, 1, At, B1); PG8_BAR;
            PG8_LDB(B0, 1, 0); PG8_SCHED; PG8_LDA(At, 1, 0); PG8_STAGE(PG8_SA(0, 1), a2 + hstepA, voffA);
            PG8_WAIT_L(8); PG8_BAR; PG8_WAIT_L(0); PG8_MMA(0, 0, At, B0); PG8_BAR; PG8_SCHED;
            PG8_LDB(B1, 1, 1); PG8_STAGE(PG8_SB(1, 0), b3, voffB);
            PG8_BAR; PG8_WAIT_L(0); PG8_MMA(0, 1, At, B1); PG8_BAR;
            PG8_LDA(At, 1, 1); PG8_STAGE(PG8_SA(1, 0), a3, voffA);
            PG8_BAR; PG8_WAIT_L(0); PG8_MMA(1, 0, At, B0); PG8_BAR; PG8_SCHED;
            PG8_STAGE(PG8_SB(1, 1), b3 + hstepB, voffB);
            PG8_WAIT_V(6); PG8_BAR; PG8_MMA(1, 1, At, B1); PG8_BAR;
        }
        E(acc, cur, wr, wc, fr, fq);
        if (!has_next) break;
#pragma unroll
        for (int a = 0; a < 2; ++a)
#pragma unroll
            for (int b = 0; b < 2; ++b)
#pragma unroll
                for (int m = 0; m < 4; ++m)
#pragma unroll
                    for (int n = 0; n < 2; ++n) acc[a][b][m][n] = f32x4{0.f, 0.f, 0.f, 0.f};
        cur = nxt; cA = nA; cB = nB; ++ui;
    }
    PG8_WAIT_V(0);
    if (wr == 0) PG8_BAR;
    PG8_BAR;
#undef PG8_SA
#undef PG8_SB
#undef PG8_STAGE
#undef PG8_LDA
#undef PG8_LDB
#undef PG8_MMA
#undef PG8_WAIT_V
#undef PG8_WAIT_L
#undef PG8_BAR
#undef PG8_SCHED
}

struct EpiBf16 {
    static constexpr bool PERM = true;
    bf16_t* O; int ldc;
    __device__ __forceinline__ void operator()(const f32x4 (&acc)[2][2][4][2], const Unit& u, int wr, int wc, int fr, int fq) const {
        const int row0 = u.pm * BM + wr * 64 + fr, col0 = u.pn * BM + wc * 32 + 8 * fq;
#pragma unroll
        for (int ai = 0; ai < 2; ++ai)
#pragma unroll
            for (int m = 0; m < 4; ++m) { bf16_t* rowp = O + (size_t)(row0 + ai * HALF + m * 16) * ldc + col0;
#pragma unroll
                for (int bj = 0; bj < 2; ++bj) { const f32x4 v0 = acc[ai][bj][m][0], v1 = acc[ai][bj][m][1];
                    u32x4 w; w.x = pack2(v0[0], v0[1]); w.y = pack2(v0[2], v0[3]); w.z = pack2(v1[0], v1[1]); w.w = pack2(v1[2], v1[3]);
                    *(u32x4*)(rowp + bj * HALF) = w; } }
    }
};
struct EpiResid {
    static constexpr bool PERM = false;
    const float* xin; float* out; const float* mod;
    __device__ __forceinline__ void operator()(const f32x4 (&acc)[2][2][4][2], const Unit& u, int wr, int wc, int fr, int fq) const {
        const int row0 = u.pm * BM + wr * 64 + fr, col0 = u.pn * BM + wc * 32 + 4 * fq;
        const float* gm = mod + (size_t)(row0 >> 11) * 6144 + 2048 + col0;
#pragma unroll
        for (int ai = 0; ai < 2; ++ai)
#pragma unroll
            for (int m = 0; m < 4; ++m) { const size_t ro = (size_t)(row0 + ai * HALF + m * 16) * 1024 + col0;
#pragma unroll
                for (int bj = 0; bj < 2; ++bj)
#pragma unroll
                    for (int n = 0; n < 2; ++n) {
                        const f32x4 g4 = *(const f32x4*)(gm + bj * HALF + n * 16), xi = *(const f32x4*)(xin + ro + bj * HALF + n * 16);
                        *(f32x4*)(out + ro + bj * HALF + n * 16) = xi + g4 * acc[ai][bj][m][n]; } }
    }
};
struct EpiMerge {
    static constexpr bool PERM = true;
    bf16_t* Hm; const bf16_t* Z;
    __device__ __forceinline__ void operator()(const f32x4 (&acc)[2][2][4][2], const Unit& u, int wr, int wc, int fr, int fq) const {
        const int row0 = u.pm * BM + wr * 64 + fr, col0 = u.pn * BM + wc * 32 + 8 * fq, g = u.aux;
#pragma unroll
        for (int ai = 0; ai < 2; ++ai)
#pragma unroll
            for (int m = 0; m < 4; ++m) { const int row = row0 + ai * HALF + m * 16;
#pragma unroll
                for (int bj = 0; bj < 2; ++bj) {
                    const int col = col0 + bj * HALF;
                    const u32x4 gz = *(const u32x4*)(Z + (size_t)row * LDZ + ZM + g * 1024 + col);
                    u32x4 prev = u32x4{0u, 0u, 0u, 0u};
                    if (g > 0) prev = *(const u32x4*)(Hm + (size_t)row * 1024 + col);
                    const f32x4 v0 = acc[ai][bj][m][0], v1 = acc[ai][bj][m][1];
                    u32x4 w;
                    w.x = pack2(bflo(prev.x) + sigm(bflo(gz.x)) * v0[0], bfhi(prev.x) + sigm(bfhi(gz.x)) * v0[1]);
                    w.y = pack2(bflo(prev.y) + sigm(bflo(gz.y)) * v0[2], bfhi(prev.y) + sigm(bfhi(gz.y)) * v0[3]);
                    w.z = pack2(bflo(prev.z) + sigm(bflo(gz.z)) * v1[0], bfhi(prev.z) + sigm(bfhi(gz.z)) * v1[1]);
                    w.w = pack2(bflo(prev.w) + sigm(bflo(gz.w)) * v1[2], bfhi(prev.w) + sigm(bfhi(gz.w)) * v1[3]);
                    *(u32x4*)(Hm + (size_t)row * 1024 + col) = w; } }
    }
};
}

struct EpiZ {
    bf16_t* Z; int ld;
    __device__ __forceinline__ void operator()(int m, int n, const f32x4& v) const {
        uint2 o; o.x = pack2(v[0], v[1]); o.y = pack2(v[2], v[3]);
        *(uint2*)(Z + (size_t)m * ld + n) = o;
    }
};
struct EpiF32 {
    float* C; int ld;
    __device__ __forceinline__ void operator()(int m, int n, const f32x4& v) const {
        *(float4*)(C + (size_t)m * ld + n) = make_float4(v[0], v[1], v[2], v[3]);
    }
};
struct EpiOut {
    const float* xin; float* out; const float* mod;
    __device__ __forceinline__ void operator()(int m, int n, const f32x4& v) const {
        int b = m >> 11;
        float4 g = *(const float4*)(mod + (size_t)b * 6144 + 2048 + n);
        float4 xi = *(const float4*)(xin + (size_t)m * 1024 + n);
        *(float4*)(out + (size_t)m * 1024 + n) = make_float4(xi.x + g.x * v[0], xi.y + g.y * v[1], xi.z + g.z * v[2], xi.w + g.w * v[3]);
    }
};

template <class Epi>
__device__ void gemm_phase(const bf16_t* A, int lda, const bf16_t* Bt, int ldb, int M, int N, int K, bool batched, Epi epi,
                           int vb0, int nvb, char* smem_, const int tid) {
    bf16_t* sA = (bf16_t*)smem_; bf16_t* sB = sA + GBM * GLS;
    const int lane = tid & 63, wave = tid >> 6, wm = wave >> 1, wn = wave & 1, fr = lane & 15, fq = lane >> 4;
    const int MT = M / GBM, NTL = N / GBN;
    for (int tile = vb0; tile < MT * NTL; tile += nvb) {
        int mt = tile % MT, nt = tile / MT;
        f32x4 acc[4][4];
#pragma unroll
        for (int a = 0; a < 4; ++a)
#pragma unroll
            for (int b = 0; b < 4; ++b) acc[a][b] = f32x4{0.f, 0.f, 0.f, 0.f};
        gemm_tile(batched ? A + nt * 128 : A, lda, Bt, ldb, K, mt * GBM, nt * GBN, sA, sB, acc, tid);
#pragma unroll
        for (int nf = 0; nf < 4; ++nf)
#pragma unroll
            for (int mf = 0; mf < 4; ++mf)
                epi(mt * GBM + wm * 64 + mf * 16 + fr, nt * GBN + wn * 64 + nf * 16 + fq * 4, acc[nf][mf]);
    }
}


template <int DK, bool GLA>
__device__ void scan2_item(const Params& p, int l, int b, int h, char* smem_) {
    constexpr int SEG = NT / DK, SLEN = 64 / SEG, KS = DK / 32, KT = DK / 16;
    constexpr int QS = DK + 8, BS = DK + 4, VS = 72;
    bf16_t* qs = (bf16_t*)smem_;
    bf16_t* ks = qs + 64 * QS;
    float* bs = (float*)(ks + 64 * QS);
    bf16_t* vt = (bf16_t*)(bs + 64 * BS);
    bf16_t* At = vt + 128 * VS;
    bf16_t* kht = At + 64 * VS;
    bf16_t* st = kht + DK * VS;
    float* segtot = (float*)(st + 128 * QS);
    float* blast = segtot + SEG * DK;
    const int tid = TIDX(), lane = tid & 63, wave = __builtin_amdgcn_readfirstlane(tid >> 6), fr = lane & 15, fq = lane >> 4;
    const int kl = tid % DK, seg = __builtin_amdgcn_readfirstlane(tid / DK);
    float lbv = 0.f, gbias = 0.f; float gu[16];
#pragma unroll
    for (int r = 0; r < 16; ++r) gu[r] = 0.f;
    if (GLA) {
#pragma unroll
        for (int r = 0; r < 16; ++r) gu[r] = p.gla_up[(size_t)(l * 16 + r) * 256 + h * 64 + kl];
        gbias = p.gla_bias[l * 256 + h * 64 + kl];
    } else if (l == 1) {
        float x0 = p.hgrn_lb[h * 128 + kl], x1 = p.hgrn_lb[512 + h * 128 + kl];
        lbv = 1.f / (1.f + expf(x0 - x1));
    }
    const float scale = GLA ? 0.125f : 0.08838834764831845f;
    const bf16_t* Zb = (const bf16_t*)(p.ws + WS_Z) + (size_t)(b * 2048) * LDZ;
    float* ssq = (float*)(smem_ + 152576);
    const int QCOL = (GLA ? ZC_Q : ZA_Q) + h * DK, KCOL = (GLA ? ZC_K : ZA_F) + h * DK, VCOL = (GLA ? ZC_V : ZA_I) + h * 128, GCOL = (GLA ? ZC_G : ZA_G) + h * 128;
    f32x4 sacc[KT];
#pragma unroll
    for (int i = 0; i < KT; ++i) sacc[i] = f32x4{0.f, 0.f, 0.f, 0.f};
    for (int i = tid; i < 128 * QS / 2; i += NT) ((unsigned*)st)[i] = 0u;
    __syncthreads();

    for (int c = 0; c < 32; ++c) {
        const bf16_t* Zc = Zb + (size_t)(c * 64) * LDZ;
        {
            bf16_t rq[SLEN], rk[SLEN];
            u32x4 rc0[GLA ? SLEN : 1], rc1[GLA ? SLEN : 1];
            {
                bf16_t rv[16];
                const int v = tid & 127, sb_ = __builtin_amdgcn_readfirstlane(tid >> 7);
#pragma unroll
                for (int i = 0; i < 16; ++i) rv[i] = Zc[(size_t)(sb_ + 4 * i) * LDZ + VCOL + v];
#pragma unroll
                for (int i = 0; i < SLEN; ++i) {
                    const bf16_t* zr = Zc + (size_t)(seg * SLEN + i) * LDZ;
                    rq[i] = zr[QCOL + kl]; rk[i] = zr[KCOL + kl];
                    if (GLA) { rc0[i] = *(const u32x4*)(zr + ZC_CODE); rc1[i] = *(const u32x4*)(zr + ZC_CODE + 8); }
                }
#pragma unroll
                for (int i = 0; i < 16; ++i) vt[v * VS + sb_ + 4 * i] = rv[i];
            }
            float run = 0.f;
#pragma unroll
            for (int i = 0; i < SLEN; ++i) {
                const int s_ = seg * SLEN + i;
                float g, kk;
                if (GLA) {
                    float x = gbias;
#pragma unroll
                    for (int r = 0; r < 4; ++r) {
                        x += bflo(rc0[i][r]) * gu[2 * r] + bfhi(rc0[i][r]) * gu[2 * r + 1];
                        x += bflo(rc1[i][r]) * gu[8 + 2 * r] + bfhi(rc1[i][r]) * gu[8 + 2 * r + 1];
                    }
                    g = (fminf(x, 0.f) - __logf(1.f + __expf(-fabsf(x)))) * (1.f / 16.f);
                    kk = bf2f(rk[i]);
                } else {
                    const float f = lbv + (1.f - lbv) * __frcp_rn(1.f + __expf(-bf2f(rk[i])));
                    g = __logf(f); kk = 1.f - f;
                }
                run += g;
                bs[s_ * BS + kl] = run;
                qs[s_ * QS + kl] = rq[i];
                ks[s_ * QS + kl] = f2bf(kk);
            }
            segtot[seg * DK + kl] = run;
        }
        __syncthreads();
        {
            float pre = 0.f, tot = 0.f;
#pragma unroll
            for (int g_ = 0; g_ < SEG; ++g_) { const float v_ = segtot[g_ * DK + kl]; if (g_ < seg) pre += v_; tot += v_; }
            if (seg == 0) blast[kl] = tot;
            unsigned pk[SLEN / 2];
#pragma unroll
            for (int i = 0; i < SLEN; ++i) {
                const float bv = bs[(seg * SLEN + i) * BS + kl] + pre;
                bs[(seg * SLEN + i) * BS + kl] = bv;
                const float kh = bf2f(ks[(seg * SLEN + i) * QS + kl]) * __expf(tot - bv);
                if (i & 1) pk[i >> 1] |= ((unsigned)f2bf(kh)) << 16; else pk[i >> 1] = (unsigned)f2bf(kh);
            }
            unsigned* dst = (unsigned*)(kht + kl * VS + seg * SLEN);
#pragma unroll
            for (int i = 0; i < SLEN / 2; ++i) dst[i] = pk[i];
        }
        __syncthreads();
        for (int blk = wave; blk < 10; blk += 8) {
            int bi, bj;
            if (blk < 1) { bi = 0; bj = 0; } else if (blk < 3) { bi = 1; bj = blk - 1; } else if (blk < 6) { bi = 2; bj = blk - 3; } else { bi = 3; bj = blk - 6; }
            f32x4 acc = f32x4{0.f, 0.f, 0.f, 0.f};
            const int srow = bj * 16 + fr, trow = bi * 16 + fr;
#pragma unroll
            for (int kk = 0; kk < KS; ++kk) {
                const int k0 = kk * 32 + fq * 8;
                float br[8];
                if (bi == 0) {
#pragma unroll
                    for (int j = 0; j < 8; ++j) br[j] = 0.f;
                } else {
                    const float4 r0 = *(const float4*)(bs + (bi * 16 - 1) * BS + k0), r1 = *(const float4*)(bs + (bi * 16 - 1) * BS + k0 + 4);
                    br[0] = r0.x; br[1] = r0.y; br[2] = r0.z; br[3] = r0.w; br[4] = r1.x; br[5] = r1.y; br[6] = r1.z; br[7] = r1.w;
                }
                const uint4 kq = *(const uint4*)(ks + srow * QS + k0), qq = *(const uint4*)(qs + trow * QS + k0);
                const float4 s0 = *(const float4*)(bs + srow * BS + k0), s1 = *(const float4*)(bs + srow * BS + k0 + 4);
                const float4 t0_ = *(const float4*)(bs + trow * BS + k0), t1_ = *(const float4*)(bs + trow * BS + k0 + 4);
                const float bsv[8] = {s0.x, s0.y, s0.z, s0.w, s1.x, s1.y, s1.z, s1.w}, btv[8] = {t0_.x, t0_.y, t0_.z, t0_.w, t1_.x, t1_.y, t1_.z, t1_.w};
                const unsigned kw[4] = {kq.x, kq.y, kq.z, kq.w}, qw[4] = {qq.x, qq.y, qq.z, qq.w};
                union { bf16x8 v; unsigned u[4]; } ka, qb;
#pragma unroll
                for (int j = 0; j < 4; ++j) {
                    const float e0 = __expf(fminf(br[2 * j] - bsv[2 * j], 60.f)), e1 = __expf(fminf(br[2 * j + 1] - bsv[2 * j + 1], 60.f));
                    ka.u[j] = pack2(bflo(kw[j]) * e0, bfhi(kw[j]) * e1);
                    const float f0 = __expf(btv[2 * j] - br[2 * j]), f1 = __expf(btv[2 * j + 1] - br[2 * j + 1]);
                    qb.u[j] = pack2(bflo(qw[j]) * f0, bfhi(qw[j]) * f1);
                }
                acc = __builtin_amdgcn_mfma_f32_16x16x32_bf16(ka.v, qb.v, acc, 0, 0, 0);
            }
            if (bi == bj) {
#pragma unroll
                for (int r = 0; r < 4; ++r) if (4 * fq + r > fr) acc[r] = 0.f;
            }
            uint2 o; o.x = pack2(acc[0], acc[1]); o.y = pack2(acc[2], acc[3]);
            *(uint2*)(At + trow * VS + bj * 16 + 4 * fq) = o;
        }
        {
            unsigned z_ = 0u; asm volatile("" : "+v"(z_));
            if (wave == 2) *(uint2*)(At + (0 * 16 + fr) * VS + 16 + 4 * fq) = make_uint2(z_, z_);
            if (wave == 3) *(uint2*)(At + (2 * 16 + fr) * VS + 48 + 4 * fq) = make_uint2(z_, z_);
        }
        __syncthreads();
        f32x4 oacc[4]; uint2 gz[4];
        {
            const int ti = wave & 3, vh = wave >> 2, trow = ti * 16 + fr;
            bf16x8 qh[KS];
#pragma unroll
            for (int kk = 0; kk < KS; ++kk) {
                const int k0 = kk * 32 + fq * 8;
                const uint4 qq = *(const uint4*)(qs + trow * QS + k0);
                const float4 t0_ = *(const float4*)(bs + trow * BS + k0), t1_ = *(const float4*)(bs + trow * BS + k0 + 4);
                union { bf16x8 v; unsigned u[4]; } q_;
                q_.u[0] = pack2(bflo(qq.x) * __expf(t0_.x), bfhi(qq.x) * __expf(t0_.y));
                q_.u[1] = pack2(bflo(qq.y) * __expf(t0_.z), bfhi(qq.y) * __expf(t0_.w));
                q_.u[2] = pack2(bflo(qq.z) * __expf(t1_.x), bfhi(qq.z) * __expf(t1_.y));
                q_.u[3] = pack2(bflo(qq.w) * __expf(t1_.z), bfhi(qq.w) * __expf(t1_.w));
                qh[kk] = q_.v;
            }
            const bf16x8 af0 = *(const bf16x8*)(At + trow * VS + fq * 8), af1 = *(const bf16x8*)(At + trow * VS + 32 + fq * 8);
            float sq = 0.f;
#pragma unroll
            for (int vi = 0; vi < 4; ++vi) {
                const int vrow = vh * 64 + vi * 16 + fr;
                gz[vi] = *(const uint2*)(Zc + (size_t)trow * LDZ + GCOL + vh * 64 + vi * 16 + 4 * fq);
                f32x4 acc = f32x4{0.f, 0.f, 0.f, 0.f};
                acc = __builtin_amdgcn_mfma_f32_16x16x32_bf16(*(const bf16x8*)(vt + vrow * VS + fq * 8), af0, acc, 0, 0, 0);
                if (ti >= 2) acc = __builtin_amdgcn_mfma_f32_16x16x32_bf16(*(const bf16x8*)(vt + vrow * VS + 32 + fq * 8), af1, acc, 0, 0, 0);
#pragma unroll
                for (int kk = 0; kk < KS; ++kk)
                    acc = __builtin_amdgcn_mfma_f32_16x16x32_bf16(*(const bf16x8*)(st + vrow * QS + kk * 32 + fq * 8), qh[kk], acc, 0, 0, 0);
                oacc[vi] = acc * scale;
                sq += oacc[vi][0] * oacc[vi][0] + oacc[vi][1] * oacc[vi][1] + oacc[vi][2] * oacc[vi][2] + oacc[vi][3] * oacc[vi][3];
            }
            sq += shx<16>(sq); sq += shx<32>(sq);
            if (fq == 0) ssq[vh * 64 + trow] = sq;
        }
        {
            const int vrow = wave * 16 + fr;
            const bf16x8 vf0 = *(const bf16x8*)(vt + vrow * VS + fq * 8), vf1 = *(const bf16x8*)(vt + vrow * VS + 32 + fq * 8);
#pragma unroll
            for (int kt = 0; kt < KT; ++kt) {
                const float dec = __expf(blast[kt * 16 + fr]);
                sacc[kt][0] *= dec; sacc[kt][1] *= dec; sacc[kt][2] *= dec; sacc[kt][3] *= dec;
                sacc[kt] = __builtin_amdgcn_mfma_f32_16x16x32_bf16(vf0, *(const bf16x8*)(kht + (kt * 16 + fr) * VS + fq * 8), sacc[kt], 0, 0, 0);
                sacc[kt] = __builtin_amdgcn_mfma_f32_16x16x32_bf16(vf1, *(const bf16x8*)(kht + (kt * 16 + fr) * VS + 32 + fq * 8), sacc[kt], 0, 0, 0);
            }
        }
        __syncthreads();
#pragma unroll
        for (int kt = 0; kt < KT; ++kt)
#pragma unroll
            for (int r = 0; r < 4; ++r) st[(wave * 16 + 4 * fq + r) * QS + kt * 16 + fr] = f2bf(sacc[kt][r]);
        {
            const int ti = wave & 3, vh = wave >> 2, trow = ti * 16 + fr;
            const float rstd = rsqrtf((ssq[trow] + ssq[64 + trow]) * (1.f / 128.f) + 1e-6f);
            bf16_t* yrow = (bf16_t*)(p.ws + WS_Y) + (size_t)(b * 2048 + c * 64 + trow) * 1536 + (GLA ? 1024 : 0) + h * 128 + vh * 64 + 4 * fq;
            const float* gn = (GLA ? p.gla_on : p.hgrn_on) + l * 128 + vh * 64 + 4 * fq;
#pragma unroll
            for (int vi = 0; vi < 4; ++vi) {
                const float4 g4 = *(const float4*)(gn + vi * 16);
                const float z0 = bflo(gz[vi].x), z1 = bfhi(gz[vi].x), z2 = bflo(gz[vi].y), z3 = bfhi(gz[vi].y);
                uint2 o;
                o.x = pack2(oacc[vi][0] * rstd * g4.x * (z0 * sigm(z0)), oacc[vi][1] * rstd * g4.y * (z1 * sigm(z1)));
                o.y = pack2(oacc[vi][2] * rstd * g4.z * (z2 * sigm(z2)), oacc[vi][3] * rstd * g4.w * (z3 * sigm(z3)));
                *(uint2*)(yrow + vi * 16) = o;
            }
        }
    }
    __syncthreads();
}

__device__ void dsaprep2_item(const Params& p, int l, int item, char* smem_) {
    bf16_t* tile = (bf16_t*)smem_;
    const int tid = TIDX(), lane = tid & 63, wave = tid >> 6;
    bf16_t* Z = (bf16_t*)(p.ws + WS_Z); bf16_t* VT = (bf16_t*)(p.ws + WS_VT);
    {
        const int tb = item * 32;
        for (int tt = wave; tt < 32; tt += 8) {
            const int t = tb + tt;
#pragma unroll
            for (int grp = 0; grp < 8; ++grp) {
                bf16_t* ptr = Z + (size_t)t * LDZ + (grp < 4 ? ZB_Q : ZB_K) + (grp & 3) * 128 + lane * 2;
                unsigned u = *(unsigned*)ptr;
                float a = bflo(u), b = bfhi(u);
                float ss = wave_sum(a * a + b * b);
                float r = rsqrtf(ss * (1.f / 128.f) + 1e-6f);
                const float* gn = (grp < 4 ? p.dsa_qn : p.dsa_kn) + l * 128 + lane * 2;
                float sc = (grp < 4) ? 0.08838834764831845f : 1.f;
                __hip_atomic_store((unsigned*)ptr, pack2(a * r * gn[0] * sc, b * r * gn[1] * sc), __ATOMIC_RELAXED, __HIP_MEMORY_SCOPE_AGENT);
            }
        }
#pragma unroll
        for (int i = 0; i < 4; ++i) {
            int ch = tid + i * 512, t = ch >> 6, c8 = (ch & 63) * 8;
            uint4 u = *(const uint4*)(Z + (size_t)(tb + t) * LDZ + ZB_V + c8);
            unsigned* d = (unsigned*)(tile + t * 514 + c8);
            d[0] = u.x; d[1] = u.y; d[2] = u.z; d[3] = u.w;
        }
        __syncthreads();
        {
            const int c = tid, b = tb >> 11, s0 = tb & 2047;
            unsigned w[16];
#pragma unroll
            for (int j = 0; j < 16; ++j) w[j] = (unsigned)tile[(2 * j) * 514 + c] | ((unsigned)tile[(2 * j + 1) * 514 + c] << 16);
            unsigned long long* dst = (unsigned long long*)(VT + ((size_t)(b * 512 + c)) * 2048 + s0);
#pragma unroll
            for (int j = 0; j < 8; ++j) __hip_atomic_store(dst + j, ((unsigned long long)w[2 * j + 1] << 32) | w[2 * j], __ATOMIC_RELAXED, __HIP_MEMORY_SCOPE_AGENT);
        }
        __syncthreads();
    }
}

__device__ void dsa_select_tile(const Params& p, int b, int tq, char* smem_) {
    constexpr int KS_ = 2052;
    unsigned* keyL = (unsigned*)smem_;
    const int tid = TIDX(), lane = tid & 63, wave = __builtin_amdgcn_readfirstlane(tid >> 6), fr = lane & 15, fq = lane >> 4;
    const bf16_t* Z = (const bf16_t*)(p.ws + WS_Z);
    unsigned long long* BM64 = (unsigned long long*)(p.ws + WS_BM);
    const int t0 = tq * 16;
    {
        const int tl = t0 + fr;
        const size_t trow = (size_t)b * 2048 + tl;
        bf16x8 qf[4][2];
#pragma unroll
        for (int h = 0; h < 4; ++h)
#pragma unroll
            for (int ks = 0; ks < 2; ++ks) qf[h][ks] = *(const bf16x8*)(Z + trow * LDZ + ZB_QI + h * 64 + ks * 32 + fq * 8);
        float w[4];
#pragma unroll
        for (int h = 0; h < 4; ++h) w[h] = bf2f(Z[trow * LDZ + ZB_WI + h]) * 0.5f;
#pragma unroll 2
        for (int kt = wave; kt <= tq; kt += 8) {
            const bf16_t* kr = Z + ((size_t)b * 2048 + kt * 16 + fr) * LDZ + ZB_KI + fq * 8;
            const bf16x8 k0 = *(const bf16x8*)kr, k1 = *(const bf16x8*)(kr + 32);
            f32x4 acc[4];
#pragma unroll
            for (int h = 0; h < 4; ++h) {
                acc[h] = __builtin_amdgcn_mfma_f32_16x16x32_bf16(k0, qf[h][0], f32x4{0.f, 0.f, 0.f, 0.f}, 0, 0, 0);
                acc[h] = __builtin_amdgcn_mfma_f32_16x16x32_bf16(k1, qf[h][1], acc[h], 0, 0, 0);
            }
            u32x4 kk;
#pragma unroll
            for (int r = 0; r < 4; ++r) {
                float sc = w[0] * fmaxf(acc[0][r] * 0.125f, 0.f) + w[1] * fmaxf(acc[1][r] * 0.125f, 0.f) + w[2] * fmaxf(acc[2][r] * 0.125f, 0.f) + w[3] * fmaxf(acc[3][r] * 0.125f, 0.f);
                if (sc == 0.f) sc = 0.f;
                const unsigned u = __float_as_uint(sc);
                const unsigned k = (u & 0x80000000u) ? ~u : (u | 0x80000000u);
                kk[r] = (kt * 16 + 4 * fq + r <= tl) ? k : 0u;
            }
            *(u32x4*)(keyL + fr * KS_ + kt * 16 + 4 * fq) = kk;
        }
    }
    __syncthreads();
    {
        const int nk = (tq + 1) * 16, jmax = (nk + 63) >> 6;
        const int qa = 2 * wave, qb = qa + 1;
        unsigned ka[32], kb[32];
#pragma unroll
        for (int j = 0; j < 32; ++j) {
            const int s = lane + 64 * j;
            ka[j] = (s < nk) ? keyL[qa * KS_ + s] : 0u;
            kb[j] = (s < nk) ? keyL[qb * KS_ + s] : 0u;
        }
        unsigned Ta = 1u, Tb = 1u; int Ca = 2047, Cb = 2047;
        if (t0 >= 256) {
            int na, nb;
            bool da, db;
            {
                int c0 = 0, c1 = 0, c2 = 0, c3 = 0;
#pragma unroll
                for (int j = 0; j < 32; ++j)
                    if (j < jmax) { c0 += (ka[j] >= 0x80000000u); c1 += (ka[j] > 0x80000000u); c2 += (kb[j] >= 0x80000000u); c3 += (kb[j] > 0x80000000u); }
                c0 = wave_total_i(c0); c1 = wave_total_i(c1); c2 = wave_total_i(c2); c3 = wave_total_i(c3);
                da = (c1 < 256 && c0 >= 256); db = (c3 < 256 && c2 >= 256);
                Ta = da ? 0x80000000u : ((c0 >= 256) ? 0x80000000u : 0u); na = da ? c0 : ((c0 >= 256) ? c0 : 0x7fffffff);
                Tb = db ? 0x80000000u : ((c2 >= 256) ? 0x80000000u : 0u); nb = db ? c2 : ((c2 >= 256) ? c2 : 0x7fffffff);
            }
            for (int bit = 30; bit >= 0; --bit) {
                if (da && db) break;
                const unsigned ca_ = Ta | (1u << bit), cb_ = Tb | (1u << bit);
                int c0 = 0, c1 = 0;
#pragma unroll
                for (int j = 0; j < 32; ++j)
                    if (j < jmax) { c0 += (ka[j] >= ca_); c1 += (kb[j] >= cb_); }
                c0 = wave_total_i(c0); c1 = wave_total_i(c1);
                if (!da && c0 >= 256) { Ta = ca_; na = c0; }
                if (!db && c1 >= 256) { Tb = cb_; nb = c1; }
                da = da || (na == 256); db = db || (nb == 256);
            }
            if (na != 256 || nb != 256) {
                int needa, needb;
                {
                    int c0 = 0, c1 = 0;
#pragma unroll
                    for (int j = 0; j < 32; ++j)
                        if (j < jmax) { c0 += (ka[j] > Ta); c1 += (kb[j] > Tb); }
                    needa = 256 - wave_total_i(c0); needb = 256 - wave_total_i(c1);
                }
                Ca = 0; Cb = 0;
                for (int bit = 10; bit >= 0; --bit) {
                    const int ca_ = Ca | (1 << bit), cb_ = Cb | (1 << bit);
                    int c0 = 0, c1 = 0;
#pragma unroll
                    for (int j = 0; j < 32; ++j)
                        if (j < jmax) { const int s = lane + 64 * j; c0 += (ka[j] == Ta && s < ca_); c1 += (kb[j] == Tb && s < cb_); }
                    c0 = wave_total_i(c0); c1 = wave_total_i(c1);
                    if (c0 < needa) Ca = ca_;
                    if (c1 < needb) Cb = cb_;
                }
            }
        }
        const size_t rowa = (size_t)b * 2048 + t0 + qa;
#pragma unroll
        for (int j = 0; j < 32; ++j) {
            const int s = lane + 64 * j;
            const unsigned long long ma = __ballot((ka[j] > Ta) || (ka[j] == Ta && s <= Ca));
            const unsigned long long mb = __ballot((kb[j] > Tb) || (kb[j] == Tb && s <= Cb));
            if (lane == 0) {
                __hip_atomic_store(&BM64[rowa * 32 + j], ma, __ATOMIC_RELAXED, __HIP_MEMORY_SCOPE_AGENT);
                __hip_atomic_store(&BM64[(rowa + 1) * 32 + j], mb, __ATOMIC_RELAXED, __HIP_MEMORY_SCOPE_AGENT);
            }
        }
    }
    __syncthreads();
}

__device__ void dsa_attn_item(const Params& p, int b, int h, int qg, char* smem_) {
    constexpr int KSTR = 136, VSTR = 40;
    bf16_t* Kl = (bf16_t*)smem_;
    bf16_t* Vl = Kl + 2 * 32 * KSTR;
    const int tid = TIDX(), lane = tid & 63, wave = __builtin_amdgcn_readfirstlane(tid >> 6), fr = lane & 15, fq = lane >> 4;
    const bf16_t* Z = (const bf16_t*)(p.ws + WS_Z); const bf16_t* VT = (const bf16_t*)(p.ws + WS_VT);
    const unsigned* BM = (const unsigned*)(p.ws + WS_BM); bf16_t* Y = (bf16_t*)(p.ws + WS_Y);
    const int kr = tid >> 4, kc = tid & 15, vd = tid >> 2, vc = tid & 3;
    const int ka_row = 8 * (fr >> 2) + (fr & 3);
    {
        const int t0 = qg * 128 + wave * 16;
        const size_t trow = (size_t)b * 2048 + t0 + fr;
        bf16x8 qf[4];
#pragma unroll
        for (int ks = 0; ks < 4; ++ks) qf[ks] = *(const bf16x8*)(Z + trow * LDZ + ZB_Q + h * 128 + ks * 32 + fq * 8);
        f32x4 o[8];
#pragma unroll
        for (int i = 0; i < 8; ++i) o[i] = f32x4{0.f, 0.f, 0.f, 0.f};
        float m = -INFINITY, lsum = 0.f;
        const unsigned* bmrow = BM + trow * 64;
        const int nsteps_blk = qg * 4 + 4, nsteps_w = (t0 + 15) / 32 + 1;
        const bf16_t* kg = Z + ((size_t)b * 2048 + kr) * LDZ + ZB_K + h * 128 + kc * 8;
        const bf16_t* vg = VT + ((size_t)(b * 4 + h) * 128 + vd) * 2048 + vc * 8;
        u32x4 rk = *(const u32x4*)kg, rv = *(const u32x4*)vg;
        *(u32x4*)(Kl + kr * KSTR + kc * 8) = rk; *(u32x4*)(Vl + vd * VSTR + vc * 8) = rv;
        __syncthreads();
        for (int st = 0; st < nsteps_blk; ++st) {
            const bool more = (st + 1 < nsteps_blk);
            if (more) { rk = *(const u32x4*)(kg + (size_t)(st + 1) * 32 * LDZ); rv = *(const u32x4*)(vg + (st + 1) * 32); }
            if (st < nsteps_w) {
                const bf16_t* Kb = Kl + (st & 1) * 32 * KSTR; const bf16_t* Vb = Vl + (st & 1) * 128 * VSTR;
                f32x4 sa = f32x4{0.f, 0.f, 0.f, 0.f}, sb = f32x4{0.f, 0.f, 0.f, 0.f};
#pragma unroll
                for (int ks = 0; ks < 4; ++ks) {
                    const bf16x8 fa = *(const bf16x8*)(Kb + ka_row * KSTR + ks * 32 + fq * 8), fb = *(const bf16x8*)(Kb + (ka_row + 4) * KSTR + ks * 32 + fq * 8);
                    sa = __builtin_amdgcn_mfma_f32_16x16x32_bf16(fa, qf[ks], sa, 0, 0, 0);
                    sb = __builtin_amdgcn_mfma_f32_16x16x32_bf16(fb, qf[ks], sb, 0, 0, 0);
                }
                const unsigned mw = bmrow[st] >> (8 * fq);
                float x[8];
#pragma unroll
                for (int r = 0; r < 4; ++r) { x[r] = ((mw >> r) & 1u) ? sa[r] : -INFINITY; x[4 + r] = ((mw >> (4 + r)) & 1u) ? sb[r] : -INFINITY; }
                float mx = fmaxf(fmaxf(fmaxf(x[0], x[1]), fmaxf(x[2], x[3])), fmaxf(fmaxf(x[4], x[5]), fmaxf(x[6], x[7])));
                mx = fmaxf(mx, shx<16>(mx)); mx = fmaxf(mx, shx<32>(mx));
                const float mnew = fmaxf(m, mx);
                const float msafe = (mnew == -INFINITY) ? 0.f : mnew;
                const float alpha = __expf(m - msafe);
                float pe[8]; float ps = 0.f;
#pragma unroll
                for (int j = 0; j < 8; ++j) { pe[j] = __expf(x[j] - msafe); ps += pe[j]; }
                lsum = lsum * alpha + ps;
                m = mnew;
#pragma unroll
                for (int i = 0; i < 8; ++i) { o[i][0] *= alpha; o[i][1] *= alpha; o[i][2] *= alpha; o[i][3] *= alpha; }
                union { bf16x8 v; unsigned u[4]; } pf;
                pf.u[0] = pack2(pe[0], pe[1]); pf.u[1] = pack2(pe[2], pe[3]); pf.u[2] = pack2(pe[4], pe[5]); pf.u[3] = pack2(pe[6], pe[7]);
#pragma unroll
                for (int i = 0; i < 8; ++i) {
                    const bf16x8 vf = *(const bf16x8*)(Vb + (i * 16 + fr) * VSTR + fq * 8);
                    o[i] = __builtin_amdgcn_mfma_f32_16x16x32_bf16(vf, pf.v, o[i], 0, 0, 0);
                }
            }
            if (more) { *(u32x4*)(Kl + ((st + 1) & 1) * 32 * KSTR + kr * KSTR + kc * 8) = rk; *(u32x4*)(Vl + ((st + 1) & 1) * 128 * VSTR + vd * VSTR + vc * 8) = rv; }
            __syncthreads();
        }
        lsum += shx<16>(lsum); lsum += shx<32>(lsum);
        const float inv = 1.f / lsum;
#pragma unroll
        for (int i = 0; i < 8; ++i) {
            uint2 ov; ov.x = pack2(o[i][0] * inv, o[i][1] * inv); ov.y = pack2(o[i][2] * inv, o[i][3] * inv);
            *(uint2*)(Y + trow * 1536 + 512 + h * 128 + i * 16 + 4 * fq) = ov;
        }
    }
}

constexpr int LDS_BYTES = 155648;
__device__ void ph_mixA(const Params& p, int l, int vb0, int nvb, char* smem_) {
    for (int item = vb0; item < 64; item += nvb) {
        if (item < 32) scan2_item<128, false>(p, l, item >> 2, item & 3, smem_);
        else scan2_item<64, true>(p, l, (item - 32) >> 2, (item - 32) & 3, smem_);
    }
    unsigned* ctr = (unsigned*)(p.ws + WS_CTL) + 3584 + l * 64;
    unsigned* done = (unsigned*)(p.ws + WS_CTL) + 5300 + l * 8 * 16;
    volatile int* slot = (volatile int*)(smem_ + LDS_BYTES - 64);
    for (;;) {
        if (TIDX() == 0) *slot = (int)atomicAdd(ctr, 1u);
        __syncthreads();
        const int idx = __builtin_amdgcn_readfirstlane(*slot);
        __syncthreads();
        if (idx >= 2048) break;
        if (idx < 1536) {
            const int b = idx / 192, r = idx % 192;
            if (r < 128) dsa_select_tile(p, b, 127 - r, smem_);
            else dsaprep2_item(p, l, b * 64 + (r - 128), smem_);
            asm volatile("s_waitcnt vmcnt(0)" ::: "memory");
            __syncthreads();
            if (TIDX() == 0) __hip_atomic_fetch_add(done + b * 16, 1u, __ATOMIC_RELAXED, __HIP_MEMORY_SCOPE_AGENT);
        } else {
            const int a = idx - 1536, b = a >> 6, h = (a >> 4) & 3, qg = 15 - (a & 15);
            if (TIDX() == 0) {
                unsigned spins = 0;
                while (__hip_atomic_load(done + b * 16, __ATOMIC_RELAXED, __HIP_MEMORY_SCOPE_AGENT) < 192u) { __builtin_amdgcn_s_sleep(2); if (++spins > (1u << 18)) break; }
                __builtin_amdgcn_fence(__ATOMIC_ACQUIRE, "agent");
                asm volatile("s_waitcnt vmcnt(0)" ::: "memory");
            }
            __syncthreads();
            dsa_attn_item(p, b, h, qg, smem_);
        }
    }
}

__device__ __forceinline__ int f2sort(float f) { int i = __float_as_int(f); return i ^ ((i >> 31) & 0x7fffffff); }
__device__ __forceinline__ float sort2f(int i) { return __int_as_float(i ^ ((i >> 31) & 0x7fffffff)); }
#define INSK(K, xv) do { int _x = (xv); \
    _Pragma("unroll") for (int _j = 0; _j < 16; ++_j) { int _hi = max(K[_j], _x); _x = min(K[_j], _x); K[_j] = _hi; } } while (0)
#define INS64(K, xv) do { unsigned long long _x = (xv); \
    _Pragma("unroll") for (int _j = 0; _j < 16; ++_j) { bool _c = _x > K[_j]; unsigned long long _o = K[_j]; K[_j] = _c ? _x : _o; _x = _c ? _o : _x; } } while (0)

__device__ void ph_route(const Params& p, int vb0, int nvb, char* smem_) {
    const float* SC = (const float*)(p.ws + WS_SC);
    int* RI = (int*)(p.ws + WS_RI); float* RG = (float*)(p.ws + WS_RG);
    const int tid = TIDX(), lane = tid & 63, wave = tid >> 6;
    float* tile = (float*)smem_ + wave * (64 * 68);
    for (int item0 = (vb0 * 8 + wave) * 64; item0 < T_TOK * 8; item0 += nvb * 8 * 64) {
        const int item = item0 + lane;
        const int t = item >> 3, h = item & 7;
        const float* s0 = SC + (size_t)t * 2048 + h * 256;
        const float* wbase = SC + (size_t)item0 * 256;
        int k0[16], k1[16];
#pragma unroll
        for (int j = 0; j < 16; ++j) { k0[j] = (int)0x80000000; k1[j] = (int)0x80000000; }
#pragma unroll 1
        for (int slab = 0; slab < 4; ++slab) {
            f32x4 ld[16];
#pragma unroll
            for (int j = 0; j < 8; ++j) {
                const float* src = wbase + (size_t)(8 * j + (lane >> 3)) * 256 + slab * 32 + (lane & 7) * 4;
                ld[j] = *(const f32x4*)src; ld[8 + j] = *(const f32x4*)(src + 128);
            }
            __builtin_amdgcn_wave_barrier();
#pragma unroll
            for (int j = 0; j < 8; ++j) {
                float* dst = tile + (8 * j + (lane >> 3)) * 68 + (lane & 7) * 4;
                *(f32x4*)dst = ld[j]; *(f32x4*)(dst + 32) = ld[8 + j];
            }
            __builtin_amdgcn_fence(__ATOMIC_RELEASE, "wavefront");
            __builtin_amdgcn_wave_barrier();
            __builtin_amdgcn_fence(__ATOMIC_ACQUIRE, "wavefront");
#pragma unroll 2
            for (int ii = 0; ii < 32; ii += 4) {
                const int i = slab * 32 + ii;
                const f32x4 a = *(const f32x4*)(tile + lane * 68 + ii), b = *(const f32x4*)(tile + lane * 68 + 32 + ii);
                INSK(k0, (f2sort(a[0]) & ~127) | (127 - i)); INSK(k0, (f2sort(a[1]) & ~127) | (126 - i));
                INSK(k0, (f2sort(a[2]) & ~127) | (125 - i)); INSK(k0, (f2sort(a[3]) & ~127) | (124 - i));
                INSK(k1, (f2sort(b[0]) & ~127) | (127 - i)); INSK(k1, (f2sort(b[1]) & ~127) | (126 - i));
                INSK(k1, (f2sort(b[2]) & ~127) | (125 - i)); INSK(k1, (f2sort(b[3]) & ~127) | (124 - i));
            }
            __builtin_amdgcn_wave_barrier();
        }
        float v0[16], v1[16];
#pragma unroll
        for (int j = 0; j < 16; ++j) { k0[j] = 127 - (k0[j] & 127); k1[j] = 127 - (k1[j] & 127); v0[j] = s0[k0[j]]; v1[j] = s0[128 + k1[j]]; }
        unsigned long long ck[16];
#pragma unroll
        for (int j = 0; j < 16; ++j) ck[j] = 0ull;
#pragma unroll
        for (int a = 0; a < 16; ++a)
#pragma unroll
            for (int b = 0; b < 16; ++b)
                if ((a + 1) * (b + 1) <= 16) {
                    unsigned hi = (unsigned)f2sort(v0[a] + v1[b]) ^ 0x80000000u;
                    unsigned lo = ((unsigned)(255 - (a * 16 + b)) << 16) | (unsigned)(k0[a] * 128 + k1[b]);
                    INS64(ck, ((unsigned long long)hi << 32) | lo);
                }
        float e[16]; float sm = 0.f;
        const float mx = sort2f((int)((unsigned)(ck[0] >> 32) ^ 0x80000000u));
#pragma unroll
        for (int j = 0; j < 16; ++j) { e[j] = expf(sort2f((int)((unsigned)(ck[j] >> 32) ^ 0x80000000u)) - mx); sm += e[j]; }
        const float inv = 1.f / sm;
#pragma unroll
        for (int j = 0; j < 16; j += 4) {
            *(int4*)(RI + (size_t)t * 128 + h * 16 + j) = make_int4((int)(ck[j] & 0xffffu), (int)(ck[j + 1] & 0xffffu), (int)(ck[j + 2] & 0xffffu), (int)(ck[j + 3] & 0xffffu));
            *(float4*)(RG + (size_t)t * 128 + h * 16 + j) = make_float4(e[j] * inv, e[j + 1] * inv, e[j + 2] * inv, e[j + 3] * inv);
        }
    }
}

__device__ __forceinline__ void fp8x16_to_f32(const uint4 q, float (&f)[16]) {
    const unsigned w[4] = {q.x, q.y, q.z, q.w};
#pragma unroll
    for (int c = 0; c < 4; ++c) {
        auto f0 = __builtin_amdgcn_cvt_pk_f32_fp8((int)w[c], false); auto f1 = __builtin_amdgcn_cvt_pk_f32_fp8((int)w[c], true);
        f[4 * c] = f0[0]; f[4 * c + 1] = f0[1]; f[4 * c + 2] = f1[0]; f[4 * c + 3] = f1[1];
    }
}
template <int WHICH>
#ifndef PEER_REP
#define PEER_REP 1
#endif
__device__ void ph_peer_sliced(const Params& p, int l, char* smem_) {
    const int tid = TIDX(), wave = tid >> 6;
    const bf16_t* H = (const bf16_t*)(p.ws + WS_H); const unsigned char* PU = p.ws + WS_PU; const unsigned char* PV = p.ws + WS_PV;
    const int* RI = (const int*)(p.ws + WS_RI); float* RG = (float*)(p.ws + WS_RG); float* PP = (float*)(p.ws + WS_PP);
    const float* modb = (const float*)(p.ws + WS_MOD);
    for (int rep = 0; rep < PEER_REP; ++rep) {
    unsigned* ctr = (unsigned*)(p.ws + WS_CTL) + 3712 + (l * 2 + WHICH) * 128 + rep * 1024;
    volatile int* slot = (volatile int*)(smem_ + LDS_BYTES - 64);
    const int xcc = (int)(xb_xcc_id() & 7u);
    for (int so = 0; so < 8; ++so) {
        const int x = (xcc + so) & 7;
        for (;;) {
            if (tid == 0) *slot = (int)atomicAdd(ctr + x * 16, 1u);
            __syncthreads();
            const int chunk = __builtin_amdgcn_readfirstlane(*slot);
            __syncthreads();
            if (chunk >= 256) break;
            {
                const int lane = lane_id_opaque(), eg = lane >> 3, ll = lane & 7;
                const int tb = chunk * 64 + wave * 8;
                int* lri = (int*)smem_ + wave * 2048; float* lrg = (float*)(lri + 1024);
                {
                    int ra[16]; float rg_[16];
#pragma unroll
                    for (int i = 0; i < 8; ++i) {
                        ra[2 * i] = RI[(size_t)(tb + i) * 128 + lane]; ra[2 * i + 1] = RI[(size_t)(tb + i) * 128 + 64 + lane];
                        if (WHICH == 1) { rg_[2 * i] = RG[(size_t)(tb + i) * 128 + lane]; rg_[2 * i + 1] = RG[(size_t)(tb + i) * 128 + 64 + lane]; }
                    }
#pragma unroll
                    for (int i = 0; i < 8; ++i) {
                        lri[i * 128 + lane] = ra[2 * i]; lri[i * 128 + 64 + lane] = ra[2 * i + 1];
                        if (WHICH == 1) { lrg[i * 128 + lane] = rg_[2 * i]; lrg[i * 128 + 64 + lane] = rg_[2 * i + 1]; }
                    }
                }
                __builtin_amdgcn_fence(__ATOMIC_RELEASE, "wavefront");
                __builtin_amdgcn_wave_barrier();
                __builtin_amdgcn_fence(__ATOMIC_ACQUIRE, "wavefront");
                uint4 hq0 = make_uint4(0u, 0u, 0u, 0u), hq1 = hq0;
                if (WHICH == 0) { const uint4* hp = (const uint4*)(H + (size_t)tb * 1024 + x * 128 + ll * 16); hq0 = hp[0]; hq1 = hp[1]; }
#pragma unroll 1
                for (int i = 0; i < 8; ++i) {
                    const int t = tb + i;
                    if (WHICH == 0) {
                        float hv[16];
                        hv[0] = bflo(hq0.x); hv[1] = bfhi(hq0.x); hv[2] = bflo(hq0.y); hv[3] = bfhi(hq0.y); hv[4] = bflo(hq0.z); hv[5] = bfhi(hq0.z); hv[6] = bflo(hq0.w); hv[7] = bfhi(hq0.w);
                        hv[8] = bflo(hq1.x); hv[9] = bfhi(hq1.x); hv[10] = bflo(hq1.y); hv[11] = bfhi(hq1.y); hv[12] = bflo(hq1.z); hv[13] = bfhi(hq1.z); hv[14] = bflo(hq1.w); hv[15] = bfhi(hq1.w);
                        if (i < 7) { const uint4* hp = (const uint4*)(H + (size_t)(t + 1) * 1024 + x * 128 + ll * 16); hq0 = hp[0]; hq1 = hp[1]; }
                        uint4 uq[16];
#pragma unroll
                        for (int it = 0; it < 16; ++it) {
                            const int e = lri[i * 128 + it * 8 + eg];
                            uq[it] = *(const uint4*)(PU + ((size_t)x * 16384 + e) * 128 + ll * 16);
                        }
#pragma unroll
                        for (int b2 = 0; b2 < 2; ++b2) {
                            float part[8];
#pragma unroll
                            for (int it = 0; it < 8; ++it) {
                                float f[16]; fp8x16_to_f32(uq[b2 * 8 + it], f);
                                float d = 0.f;
#pragma unroll
                                for (int j = 0; j < 16; ++j) d += hv[j] * f[j];
                                part[it] = d;
                            }
                            float r4[4], r2[2];
                            const bool b2_ = lane & 4, b1_ = lane & 2, b0_ = lane & 1;
#pragma unroll
                            for (int j = 0; j < 4; ++j) { const float snd = b2_ ? part[j] : part[j + 4], kp = b2_ ? part[j + 4] : part[j]; r4[j] = kp + shx<4>(snd); }
#pragma unroll
                            for (int j = 0; j < 2; ++j) { const float snd = b1_ ? r4[j] : r4[j + 2], kp = b1_ ? r4[j + 2] : r4[j]; r2[j] = kp + shx<2>(snd); }
                            const float snd = b0_ ? r2[0] : r2[1], kp = b0_ ? r2[1] : r2[0];
                            const float d = kp + shx<1>(snd);
                            PP[((size_t)x * T_TOK + t) * 128 + b2 * 64 + ll * 8 + eg] = d;
                        }
                    } else {
                        float y[16];
#pragma unroll
                        for (int j = 0; j < 16; ++j) y[j] = 0.f;
#pragma unroll
                        for (int b2 = 0; b2 < 2; ++b2) {
                            uint4 vq[8];
#pragma unroll
                            for (int it = 0; it < 8; ++it) {
                                const int e = lri[i * 128 + b2 * 64 + it * 8 + eg];
                                vq[it] = *(const uint4*)(PV + ((size_t)x * 16384 + e) * 128 + ll * 16);
                            }
#pragma unroll
                            for (int it = 0; it < 8; ++it) {
                                const float ck = lrg[i * 128 + b2 * 64 + it * 8 + eg];
                                float f[16]; fp8x16_to_f32(vq[it], f);
#pragma unroll
                                for (int j = 0; j < 16; ++j) y[j] += ck * f[j];
                            }
                        }
                        float r8[8], r4[4], r2[2];
                        const bool b5 = lane & 32, b4 = lane & 16, b3 = lane & 8;
#pragma unroll
                        for (int j = 0; j < 8; ++j) { const float snd = b5 ? y[j] : y[j + 8], kp = b5 ? y[j + 8] : y[j]; r8[j] = kp + shx<32>(snd); }
#pragma unroll
                        for (int j = 0; j < 4; ++j) { const float snd = b4 ? r8[j] : r8[j + 4], kp = b4 ? r8[j + 4] : r8[j]; r4[j] = kp + shx<16>(snd); }
#pragma unroll
                        for (int j = 0; j < 2; ++j) { const float snd = b3 ? r4[j] : r4[j + 2], kp = b3 ? r4[j + 2] : r4[j]; r2[j] = kp + shx<8>(snd); }
                        const int col = x * 128 + ll * 16 + ((lane >> 5) & 1) * 8 + ((lane >> 4) & 1) * 4 + ((lane >> 3) & 1) * 2;
                        const float2 gf = *(const float2*)(modb + (size_t)(l * 8 + (t >> 11)) * 6144 + 5120 + col);
                        float2* op = (float2*)(p.out + (size_t)t * 1024 + col);
                        const float2 xi = *op;
                        if (rep > 0) op = (float2*)((float*)(p.ws + WS_OA) + (size_t)t * 1024 + col);
                        *op = make_float2(xi.x + gf.x * r2[0], xi.y + gf.y * r2[1]);
                    }
                }
            }
        }
    }
    __syncthreads();
    }
}
__device__ void ph_peer_coef(const Params& p, int vb0, int nvb) {
    const int wave = TIDX() >> 6, lane = TIDX() & 63;
    float* RG = (float*)(p.ws + WS_RG); const float* PP = (const float*)(p.ws + WS_PP);
    for (int t = vb0 * 8 + wave; t < T_TOK; t += nvb * 8) {
#pragma unroll
        for (int half = 0; half < 2; ++half) {
            const int k = half * 64 + lane;
            float d = 0.f;
#pragma unroll
            for (int x = 0; x < 8; ++x) d += PP[((size_t)x * T_TOK + t) * 128 + k];
            d *= (1.f / PU_SCALE);
            const float g = RG[(size_t)t * 128 + k];
            RG[(size_t)t * 128 + k] = g * 0.5f * d * (1.f + erff(d * 0.7071067811865476f)) * (1.f / PV_SCALE);
        }
    }
}

enum { PH_MOD = 0, PH_WPREP, PH_NORM1, PH_GEMM_IN, PH_SCAN, PH_DSAPREP, PH_DSA, PH_POST, PH_MERGE, PH_OUT, PH_NORM2, PH_GEMM_Q, PH_GEMM_SC, PH_ROUTE, PH_GATHER, PH_GATHER_DUMMY, PH_DSASEL, PH_G1, PH_G15, PH_G2, PH_G1R, PH_G2R };

template <int PH>
__device__ __forceinline__ void run_phase(const Params& p, int l, int vb0, int nvb, char* smem) {
    const float* xin = (l == 0) ? p.x : p.out;
    if (PH == PH_MOD) ph_mod(p, vb0, nvb, smem);
    else if (PH == PH_WPREP) ph_wprep(p, l, vb0, nvb, smem);
    else if (PH == PH_NORM1) ph_norm(p, l, 0, xin, vb0, nvb);
    else if (PH == PH_GEMM_IN) {
        pg8::Gemm g{(const bf16_t*)(p.ws + WS_H), (const bf16_t*)(p.ws + WS_WIN), 1024, 1024, 1024};
        pg8::StaticOrder S; S.init(T_TOK, LDZ, nvb, vb0, 1024, 1024);
        pg8::gemm_phase(( PG8_LAS unsigned char*)smem, g, S, pg8::EpiBf16{(bf16_t*)(p.ws + WS_Z), LDZ}, TIDX());
    }
    else if (PH == PH_SCAN) ph_mixA(p, l, vb0, nvb, smem);
    else if (PH == PH_DSAPREP) { }
    else if (PH == PH_DSA) { }
    else if (PH == PH_POST) { }
    else if (PH == PH_MERGE) {
        pg8::Gemm g{(const bf16_t*)(p.ws + WS_Y), (const bf16_t*)(p.ws + WS_WBR), 1536, 512, 512};
        pg8::MergeOrder S{vb0, nvb};
        pg8::gemm_phase((PG8_LAS unsigned char*)smem, g, S, pg8::EpiMerge{(bf16_t*)(p.ws + WS_H), (const bf16_t*)(p.ws + WS_Z)}, TIDX());
    }
    else if (PH == PH_OUT) {
        pg8::Gemm g{(const bf16_t*)(p.ws + WS_H), (const bf16_t*)(p.ws + WS_WOUT), 1024, 1024, 1024};
        pg8::StaticOrder S; S.init(T_TOK, 1024, nvb, vb0, 1024, 1024);
        pg8::gemm_phase((PG8_LAS unsigned char*)smem, g, S, pg8::EpiResid{xin, p.out, (const float*)(p.ws + WS_MOD) + (size_t)l * 8 * 6144}, TIDX());
    }
    else if (PH == PH_NORM2) ph_norm(p, l, 1, p.out, vb0, nvb);
    else if (PH == PH_GEMM_Q) {
        pg8::Gemm g{(const bf16_t*)(p.ws + WS_H), (const bf16_t*)(p.ws + WS_WQ), 1024, 1024, 1024};
        pg8::StaticOrder S; S.init(T_TOK, 2048, nvb, vb0, 1024, 1024);
        pg8::gemm_phase((PG8_LAS unsigned char*)smem, g, S, pg8::EpiBf16{(bf16_t*)(p.ws + WS_QP), 2048}, TIDX());
    }
    else if (PH == PH_GEMM_SC) gemm_phase((const bf16_t*)(p.ws + WS_QP), 2048, (const bf16_t*)(p.ws + WS_SK), 128, T_TOK, 2048, 128, true,
                                          EpiF32{(float*)(p.ws + WS_SC), 2048}, vb0, nvb, smem, TIDX());
    else if (PH == PH_ROUTE) ph_route(p, vb0, nvb, smem);
    else if (PH == PH_GATHER || PH == PH_GATHER_DUMMY) { }
    else if (PH == PH_DSASEL) { }
    else if (PH == PH_G1) ph_peer_sliced<0>(p, l, smem);
    else if (PH == PH_G15) ph_peer_coef(p, vb0, nvb);
    else if (PH == PH_G2) ph_peer_sliced<1>(p, l, smem);

}

template <int PH>
__global__ void __launch_bounds__(NT) k_phase(Params p, int l) {
    extern __shared__ __attribute__((aligned(16))) char smem[];
    p.wv = __builtin_amdgcn_readfirstlane((int)threadIdx.x >> 6);
    run_phase<PH>(p, l, (int)blockIdx.x, (int)gridDim.x, smem);
}


#define XB_TMO      128
#define XB_XCNT(j)  (256  + 64 * (j))
#define XB_XSUB(j)  (1280 + 64 * (j))
#define XB_XGEN(j)  (2304 + 64 * (j))
#define XB_TOP      3328
#define XB_TOPGEN   3392
#define XCD_BAR_WORDS 3456
#define XB_SPIN_CAP (1u << 18)
#define LAS __attribute__((address_space(3)))
__device__ __forceinline__ unsigned xb_ld(unsigned* p)              { return __hip_atomic_load(p, __ATOMIC_RELAXED, __HIP_MEMORY_SCOPE_AGENT); }
__device__ __forceinline__ unsigned xb_add(unsigned* p, unsigned v) { return __hip_atomic_fetch_add(p, v, __ATOMIC_RELAXED, __HIP_MEMORY_SCOPE_AGENT); }
#define XB_SPIN(cond, bar) do { unsigned _sp = 0; while (cond) { __builtin_amdgcn_s_sleep(1); \
    if ((++_sp & 255u) == 0u) { if (xb_ld(&(bar)[XB_TMO])) break; if (_sp > XB_SPIN_CAP) { atomicAdd(&(bar)[XB_TMO], 1u); break; } } } } while (0)
struct XcdBarrier { unsigned* bar; unsigned x; volatile LAS unsigned* st; int wv; };
__device__ __forceinline__ XcdBarrier xcd_barrier_post(unsigned* bar, volatile LAS unsigned* st, int wv) {
    XcdBarrier b; b.bar = bar; b.x = xb_xcc_id(); b.st = st; b.wv = wv;
    if (TIDXW(wv) == 0) (void)xb_add(&bar[XB_XCNT(b.x)], 1u);
    return b;
}
__device__ __forceinline__ void xcd_barrier_complete(unsigned* bar, unsigned x, unsigned& nloc, unsigned& nx) {
    const unsigned G = gridDim.x * gridDim.y * gridDim.z;
    unsigned sum, cnt, mine, sp = 0u;
    for (;;) {
        sum = 0u; cnt = 0u; mine = 0u;
#pragma unroll
        for (unsigned j = 0; j < 16; ++j) { const unsigned c = xb_ld(&bar[XB_XCNT(j)]); sum += c; cnt += (c > 0u) ? 1u : 0u; mine = (j == x) ? c : mine; }
        if (sum == G) break;
        __builtin_amdgcn_s_sleep(1);
        if ((++sp & 255u) == 0u) { if (xb_ld(&bar[XB_TMO])) break; if (sp > XB_SPIN_CAP) { atomicAdd(&bar[XB_TMO], 1u); break; } }
    }
    nloc = mine > 0u ? mine : 1u; nx = cnt > 0u ? cnt : 1u;
}
__device__ __forceinline__ void xcd_barrier(const XcdBarrier& b) {
    asm volatile("s_waitcnt vmcnt(0)" ::: "memory");
    __syncthreads();
    if (TIDXW(b.wv) == 0) {
        unsigned* bar = b.bar;
        __builtin_amdgcn_s_waitcnt(0);
        unsigned nloc = b.st[0], nx = b.st[1];
        if (nloc == 0u) { xcd_barrier_complete(bar, b.x, nloc, nx); b.st[0] = nloc; b.st[1] = nx; }
        const unsigned old = xb_add(&bar[XB_XSUB(b.x)], 1u);
        const unsigned gen = old / nloc;
        if (old + 1u == (gen + 1u) * nloc) {
            __builtin_amdgcn_fence(__ATOMIC_RELEASE, "agent");
            asm volatile("s_waitcnt vmcnt(0)" ::: "memory");
            const unsigned og = xb_add(&bar[XB_TOP], 1u);
            const unsigned tg = og / nx;
            if (og + 1u == (tg + 1u) * nx) xb_add(&bar[XB_TOPGEN], 1u);
            else XB_SPIN(xb_ld(&bar[XB_TOPGEN]) == tg, bar);
            __builtin_amdgcn_fence(__ATOMIC_ACQUIRE, "agent");
            xb_add(&bar[XB_XGEN(b.x)], 1u);
            asm volatile("s_waitcnt vmcnt(0)" ::: "memory");
        } else {
            XB_SPIN(xb_ld(&bar[XB_XGEN(b.x)]) == gen, bar);
            __builtin_amdgcn_fence(__ATOMIC_ACQUIRE, "agent");
            asm volatile("s_waitcnt vmcnt(0)" ::: "memory");
        }
    }
    __syncthreads();
}

__global__ void __launch_bounds__(NT) mega_kernel(Params p_in) {
#if defined(__HIP_DEVICE_COMPILE__)
    extern __shared__ __attribute__((aligned(16))) char smem[];
    volatile LAS unsigned* st = (volatile LAS unsigned*)(smem + LDS_BYTES - 16);
    int wv_ = __builtin_amdgcn_readfirstlane((int)threadIdx.x >> 6); asm volatile("" : "+s"(wv_));
    { const int t_ = TIDXW(wv_); if (t_ < 4) st[t_] = 0u; }
    __syncthreads();
    XcdBarrier bar = xcd_barrier_post((unsigned*)(p_in.ws + WS_CTL), st, wv_);
    const int vb = (int)blockIdx.x, nvb = (int)gridDim.x;
#ifndef PROBE_PH
#define PROBE_PH -1
#endif
#define GB() xcd_barrier(bar)
#define RUN(PH, L) do { for (int _r = 0; _r < ((PROBE_PH == PH && PH != PH_DSAPREP) ? 2 : 1); ++_r) { \
        const __attribute__((address_space(4))) Params* _kp = (const __attribute__((address_space(4))) Params*)__builtin_amdgcn_kernarg_segment_ptr(); asm volatile("" : "+s"(_kp)); Params _p = *_kp; _p.wv = wv_; \
        int _l = (L), _vb = vb, _nvb = nvb; asm volatile("" : "+s"(_l), "+s"(_vb), "+s"(_nvb)); \
        run_phase<(PROBE_PH == PH_GATHER_DUMMY && PH == PH_GATHER && 0) ? PH_GATHER_DUMMY : PH>(_p, _l, _vb, _nvb, smem); if (PROBE_PH == PH) __syncthreads(); } } while (0)
    RUN(PH_MOD, 0);
#pragma unroll 1
    for (int l = 0; l < 2; ++l) {
        RUN(PH_WPREP, l); GB();
        RUN(PH_NORM1, l); GB();
        RUN(PH_GEMM_IN, l); GB();
        RUN(PH_SCAN, l);
        RUN(PH_DSAPREP, l);
        GB();
        RUN(PH_MERGE, l); GB();
        RUN(PH_OUT, l); GB();
        RUN(PH_NORM2, l); GB();
        RUN(PH_GEMM_Q, l); GB();
        RUN(PH_GEMM_SC, l); GB();
        RUN(PH_ROUTE, l); GB();
        RUN(PH_G1, l); GB();
        RUN(PH_G15, l); GB();
        RUN(PH_G2, l);
        if (l == 0) GB();
    }
#undef RUN
#undef GB
#endif
}

extern "C" void kernel_launch(void* const* d_in, const int* in_sizes, int n_in, void* d_out, int out_size, void* d_ws, size_t ws_size,
                              hipStream_t stream) {
    if (n_in != 20 || ws_size < WS_END) { fprintf(stderr, "kernel_launch: bad inputs (n_in %d ws %zu need %zu)\n", n_in, ws_size, (size_t)WS_END); return; }
    Params p{};
    p.x = (const float*)d_in[0]; p.c = (const float*)d_in[1]; p.w_ada = (const float*)d_in[2]; p.b_ada = (const float*)d_in[3];
    p.norm_mix = (const float*)d_in[4]; p.norm_ffn = (const float*)d_in[5]; p.w_in = (const float*)d_in[6]; p.hgrn_lb = (const float*)d_in[7];
    p.hgrn_on = (const float*)d_in[8]; p.dsa_qn = (const float*)d_in[9]; p.dsa_kn = (const float*)d_in[10]; p.gla_up = (const float*)d_in[11];
    p.gla_bias = (const float*)d_in[12]; p.gla_on = (const float*)d_in[13]; p.w_branch = (const float*)d_in[14]; p.w_out = (const float*)d_in[15];
    p.peer_wq = (const float*)d_in[16]; p.peer_keys = (const float*)d_in[17]; p.peer_u = (const float*)d_in[18]; p.peer_v = (const float*)d_in[19];
    p.out = (float*)d_out; p.ws = (unsigned char*)d_ws;
#if MEGA
    static int grid = 0;
    if (grid == 0) {
        int dev = 0, cus = 0, per_cu = 0;
        hipGetDevice(&dev);
        hipDeviceGetAttribute(&cus, hipDeviceAttributeMultiprocessorCount, dev);
        hipFuncSetAttribute((const void*)mega_kernel, hipFuncAttributeMaxDynamicSharedMemorySize, LDS_BYTES);
        hipOccupancyMaxActiveBlocksPerMultiprocessor(&per_cu, (const void*)mega_kernel, NT, LDS_BYTES);
        if (per_cu < 1) { fprintf(stderr, "kernel_launch: occupancy query says %d blocks per CU\n", per_cu); per_cu = 1; }
        (void)hipGetLastError();
        grid = cus;
    }
    hipMemsetAsync((char*)d_ws + WS_CTL, 0, 32768, stream);
    void* args[] = {&p};
    hipError_t e = hipLaunchCooperativeKernel((const void*)mega_kernel, dim3(grid), dim3(NT), args, LDS_BYTES, stream);
    if (e != hipSuccess) fprintf(stderr, "cooperative launch failed: %s (grid %d)\n", hipGetErrorString(e), grid);
#else
    const int G = 256;
#define LAUNCH(PH, l) hipLaunchKernelGGL(k_phase<PH>, dim3(G), dim3(NT), LDS_BYTES, stream, p, l)
    LAUNCH(PH_MOD, 0);
    for (int l = 0; l < 2; ++l) {
        LAUNCH(PH_WPREP, l);
        LAUNCH(PH_NORM1, l);
        LAUNCH(PH_GEMM_IN, l);
        LAUNCH(PH_SCAN, l);
        LAUNCH(PH_DSAPREP, l);
        LAUNCH(PH_DSA, l);
        LAUNCH(PH_POST, l);
        LAUNCH(PH_MERGE, l);
        LAUNCH(PH_OUT, l);
        LAUNCH(PH_NORM2, l);
        LAUNCH(PH_GEMM_Q, l);
        LAUNCH(PH_GEMM_SC, l);
        LAUNCH(PH_ROUTE, l);
        LAUNCH(PH_GATHER, l);
    }
#endif
}
```

```cpp
#include <hip/hip_runtime.h>
#include <stdint.h>
#include <stdio.h>

#ifndef MEGA
#define MEGA 1
#endif

typedef unsigned short bf16_t;
typedef short bf16x8 __attribute__((ext_vector_type(8)));
typedef float f32x4 __attribute__((ext_vector_type(4)));
typedef unsigned u32x4 __attribute__((ext_vector_type(4)));

#define NT 512
constexpr int T_TOK = 16384, DM = 1024, SEQ = 2048;
constexpr int LDZ = 8704;
constexpr int ZA_Q = 0, ZA_F = 512, ZA_I = 1024, ZA_G = 1536, ZB_Q = 2048, ZB_K = 2560, ZB_V = 3072, ZC_V = 3584, ZC_G = 4096,
              ZB_QI = 4608, ZC_Q = 4864, ZC_K = 5120, ZB_KI = 5376, ZB_WI = 5440, ZC_CODE = 5444, ZM = 5632;
constexpr int IN_COLS = 8532;

constexpr size_t al256(size_t x) { return (x + 255) & ~(size_t)255; }
constexpr size_t WS_CTL = 0;
constexpr size_t WS_MOD = 65536;
constexpr size_t WS_WIN = al256(WS_MOD + (size_t)2 * 8 * 6144 * 4);
constexpr size_t WS_WBR = al256(WS_WIN + (size_t)LDZ * 1024 * 2);
constexpr size_t WS_WOUT = al256(WS_WBR + (size_t)3 * 1024 * 512 * 2);
constexpr size_t WS_WQ = al256(WS_WOUT + (size_t)1024 * 1024 * 2);
constexpr size_t WS_SK = al256(WS_WQ + (size_t)2048 * 1024 * 2);
constexpr size_t WS_PU = al256(WS_SK + (size_t)16 * 128 * 128 * 2);
constexpr size_t WS_PV = al256(WS_PU + (size_t)16384 * 1024);
constexpr size_t WS_H = al256(WS_PV + (size_t)16384 * 1024);
constexpr float PU_SCALE = 32.f, PV_SCALE = 4.f;
constexpr size_t WS_OA = al256(WS_H + (size_t)T_TOK * 1024 * 2);
constexpr size_t WS_OC = al256(WS_OA + (size_t)T_TOK * 512 * 2);
constexpr size_t WS_Y = al256(WS_OC + (size_t)T_TOK * 512 * 2);
constexpr size_t WS_Z = al256(WS_Y + (size_t)T_TOK * 1536 * 2);
constexpr size_t WS_VT = al256(WS_Z + (size_t)T_TOK * LDZ * 2);
constexpr size_t WS_BM = al256(WS_VT + (size_t)T_TOK * 512 * 2);
constexpr size_t WS_END = al256(WS_BM + (size_t)T_TOK * 64 * 4);
constexpr size_t WS_QP = WS_Z;
constexpr size_t WS_SC = al256(WS_QP + (size_t)T_TOK * 2048 * 2);
constexpr size_t WS_RI = al256(WS_SC + (size_t)T_TOK * 2048 * 4);
constexpr size_t WS_RG = al256(WS_RI + (size_t)T_TOK * 128 * 4);
constexpr size_t WS_PP = al256(WS_RG + (size_t)T_TOK * 128 * 4);
static_assert(WS_PP + (size_t)8 * T_TOK * 128 * 4 <= WS_VT, "peer partials overflow the Z region");
static_assert(WS_RG + (size_t)T_TOK * 128 * 4 <= WS_END, "peer alias overflow");

struct Params {
    const float* x; const float* c; const float* w_ada; const float* b_ada; const float* norm_mix; const float* norm_ffn;
    const float* w_in; const float* hgrn_lb; const float* hgrn_on; const float* dsa_qn; const float* dsa_kn;
    const float* gla_up; const float* gla_bias; const float* gla_on; const float* w_branch; const float* w_out;
    const float* peer_wq; const float* peer_keys; const float* peer_u; const float* peer_v;
    float* out; unsigned char* ws;
    int wv, pad;
};

__device__ __forceinline__ float bf2f(bf16_t h) { return __uint_as_float(((unsigned)h) << 16); }
__device__ __forceinline__ float bflo(unsigned u) { return __uint_as_float(u << 16); }
__device__ __forceinline__ float bfhi(unsigned u) { return __uint_as_float(u & 0xffff0000u); }
__device__ __forceinline__ bf16_t f2bf(float f) { unsigned r; asm volatile("v_cvt_pk_bf16_f32 %0, %1, %1" : "=v"(r) : "v"(f)); return (bf16_t)(r & 0xffffu); }
__device__ __forceinline__ unsigned pack2(float a, float b) { unsigned r; asm volatile("v_cvt_pk_bf16_f32 %0, %1, %2" : "=v"(r) : "v"(a), "v"(b)); return r; }
__device__ __forceinline__ int lane_id_opaque() { int l; asm volatile("v_mbcnt_lo_u32_b32 %0, -1, 0\n\tv_mbcnt_hi_u32_b32 %0, -1, %0" : "=v"(l)); return l; }
template <int M> __device__ __forceinline__ int shx_i(int v) {
    if (M < 32) return __builtin_amdgcn_ds_swizzle(v, (M << 10) | 0x1f);
    return __builtin_amdgcn_ds_bpermute((lane_id_opaque() ^ 32) << 2, v);
}
template <int M> __device__ __forceinline__ float shx(float v) { return __int_as_float(shx_i<M>(__float_as_int(v))); }
template <int M> __device__ __forceinline__ int shx(int v) { return shx_i<M>(v); }
template <int M> __device__ __forceinline__ unsigned shx(unsigned v) { return (unsigned)shx_i<M>((int)v); }
__device__ __forceinline__ int bperm(int v, int src) { return __builtin_amdgcn_ds_bpermute(src << 2, v); }
__device__ __forceinline__ float bperm(float v, int src) { return __int_as_float(__builtin_amdgcn_ds_bpermute(src << 2, __float_as_int(v))); }
__device__ __forceinline__ float wave_sum(float v) { v += shx<32>(v); v += shx<16>(v); v += shx<8>(v); v += shx<4>(v); v += shx<2>(v); v += shx<1>(v); return v; }
__device__ __forceinline__ float wave_max(float v) { v = fmaxf(v, shx<32>(v)); v = fmaxf(v, shx<16>(v)); v = fmaxf(v, shx<8>(v)); v = fmaxf(v, shx<4>(v)); v = fmaxf(v, shx<2>(v)); v = fmaxf(v, shx<1>(v)); return v; }
__device__ __forceinline__ int wave_sum_i(int v) { v += shx<32>(v); v += shx<16>(v); v += shx<8>(v); v += shx<4>(v); v += shx<2>(v); v += shx<1>(v); return v; }
__device__ __forceinline__ int wave_total_i(int v) {
    v += __builtin_amdgcn_update_dpp(0, v, 0x111, 0xf, 0xf, true);
    v += __builtin_amdgcn_update_dpp(0, v, 0x112, 0xf, 0xf, true);
    v += __builtin_amdgcn_update_dpp(0, v, 0x114, 0xf, 0xf, true);
    v += __builtin_amdgcn_update_dpp(0, v, 0x118, 0xf, 0xf, true);
    v += __builtin_amdgcn_update_dpp(0, v, 0x142, 0xa, 0xf, true);
    v += __builtin_amdgcn_update_dpp(0, v, 0x143, 0xc, 0xf, true);
    return __builtin_amdgcn_readlane(v, 63);
}
__device__ __forceinline__ float sigm(float x) { return __frcp_rn(1.f + __expf(-x)); }

__device__ __forceinline__ unsigned xb_xcc_id() { return (unsigned)__builtin_amdgcn_s_getreg((3 << 11) | 20) & 0xFu; }
__device__ __forceinline__ int TIDXW(int wv) { int t; asm volatile("v_mbcnt_lo_u32_b32 %0, -1, 0\n\tv_mbcnt_hi_u32_b32 %0, -1, %0\n\tv_lshl_or_b32 %0, %1, 6, %0" : "=v"(t) : "s"(wv)); return t; }
#define TIDX() TIDXW(p.wv)

__device__ __forceinline__ int src_col(int j) {
    if (j < 3584) return j;
    if (j < 4096) return j - 3584 + 4420;
    if (j < 4608) return j - 4096 + 4948;
    if (j < 4864) return j - 4608 + 3584;
    if (j < 5120) return j - 4864 + 3908;
    if (j < 5376) return j - 5120 + 4164;
    if (j < 5440) return j - 5376 + 3840;
    if (j < 5444) return j - 5440 + 3904;
    if (j < 5460) return j - 5444 + 4932;
    if (j < 5632) return -1;
    return j - 5632 + 5460;
}

__device__ void ph_mod(const Params& p, int vb0, int nvb, char* smem_) {
    float* sc = (float*)smem_;
    float* part = sc + 8 * 1024;
    float* mod = (float*)(p.ws + WS_MOD);
    const int tid = TIDX(), lane = tid & 63, wave = tid >> 6;
    if (vb0 >= 192) return;
    for (int i = tid; i < 8 * 1024; i += NT) { float c = p.c[i]; sc[i] = c / (1.f + __expf(-c)); }
    __syncthreads();
    for (int task = vb0; task < 192; task += nvb) {
        const int l = task / 96, n0 = (task % 96) * 64;
        const float* w = p.w_ada + (size_t)l * 1024 * 6144 + (size_t)(wave * 128) * 6144 + n0 + lane;
        float acc[8];
#pragma unroll
        for (int b = 0; b < 8; ++b) acc[b] = 0.f;
#pragma unroll 1
        for (int k0 = 0; k0 < 128; k0 += 16) {
            float wv[16];
#pragma unroll
            for (int j = 0; j < 16; ++j) wv[j] = w[(size_t)(k0 + j) * 6144];
#pragma unroll
            for (int j = 0; j < 16; ++j)
#pragma unroll
                for (int b = 0; b < 8; ++b) acc[b] += sc[b * 1024 + wave * 128 + k0 + j] * wv[j];
        }
#pragma unroll
        for (int b = 0; b < 8; ++b) part[(wave * 8 + b) * 64 + lane] = acc[b];
        __syncthreads();
        {
            const int b = tid >> 6, col = tid & 63;
            float v = p.b_ada[l * 6144 + n0 + col];
#pragma unroll
            for (int w_ = 0; w_ < 8; ++w_) v += part[(w_ * 8 + b) * 64 + col];
            mod[(size_t)(l * 8 + b) * 6144 + n0 + col] = v;
        }
        __syncthreads();
    }
}

template <bool MAP>
__device__ void tr_tile(const float* __restrict__ src, int lds_, bf16_t* __restrict__ out, int ldo, int k0, int n0, float* tile, const int tid) {
#pragma unroll
    for (int i = 0; i < 8; ++i) {
        int kk = (tid >> 6) + 8 * i, nn = tid & 63;
        int scol = MAP ? src_col(n0 + nn) : (n0 + nn);
        float v = (scol >= 0) ? src[(size_t)(k0 + kk) * lds_ + scol] : 0.f;
        tile[kk * 65 + nn] = v;
    }
    __syncthreads();
#pragma unroll
    for (int i = 0; i < 4; ++i) {
        int nn = (tid >> 5) + 16 * i, kk = (tid & 31) * 2;
        unsigned v = pack2(tile[kk * 65 + nn], tile[(kk + 1) * 65 + nn]);
        *(unsigned*)(out + (size_t)(n0 + nn) * ldo + k0 + kk) = v;
    }
    __syncthreads();
}
__device__ void conv_chunk(const float* __restrict__ src, bf16_t* __restrict__ dst, size_t base, const int tid) {
#pragma unroll
    for (int i = 0; i < 4; ++i) {
        size_t e = base + (size_t)(i * NT + tid) * 8;
        float4 a = *(const float4*)(src + e), b = *(const float4*)(src + e + 4);
        uint4 o; o.x = pack2(a.x, a.y); o.y = pack2(a.z, a.w); o.z = pack2(b.x, b.y); o.w = pack2(b.z, b.w);
        *(uint4*)(dst + e) = o;
    }
}
__device__ void conv_chunk_fp8(const float* __restrict__ src, unsigned char* __restrict__ dst, size_t base, float scale, const int tid) {
#pragma unroll
    for (int i = 0; i < 4; ++i) {
        size_t e = base + (size_t)(i * NT + tid) * 8;
        float4 a = *(const float4*)(src + e), b = *(const float4*)(src + e + 4);
        int lo = __builtin_amdgcn_cvt_pk_fp8_f32(a.x * scale, a.y * scale, 0, false); lo = __builtin_amdgcn_cvt_pk_fp8_f32(a.z * scale, a.w * scale, lo, true);
        int hi = __builtin_amdgcn_cvt_pk_fp8_f32(b.x * scale, b.y * scale, 0, false); hi = __builtin_amdgcn_cvt_pk_fp8_f32(b.z * scale, b.w * scale, hi, true);
        const size_t row = e >> 10, col = e & 1023;
        *(uint2*)(dst + ((col >> 7) * 16384 + row) * 128 + (col & 127)) = make_uint2((unsigned)lo, (unsigned)hi);
    }
}
__device__ void ph_wprep(const Params& p, int l, int vb0, int nvb, char* smem_) {
    float* tile = (float*)smem_;
    const int tid = TIDX();
    bf16_t* WIN = (bf16_t*)(p.ws + WS_WIN); bf16_t* WBR = (bf16_t*)(p.ws + WS_WBR); bf16_t* WOUT = (bf16_t*)(p.ws + WS_WOUT);
    bf16_t* WQ = (bf16_t*)(p.ws + WS_WQ); bf16_t* SK = (bf16_t*)(p.ws + WS_SK); unsigned char* PU = p.ws + WS_PU; unsigned char* PV = p.ws + WS_PV;
    constexpr int N_WIN = 136 * 16, N_WBR = 3 * 16 * 8, N_WOUT = 16 * 16, N_WQ = 32 * 16, N_SK = 16, N_PU = 1024, N_PV = 1024;
    constexpr int TOTAL = N_WIN + N_WBR + N_WOUT + N_WQ + N_SK + N_PU + N_PV;
    for (int task = vb0; task < TOTAL; task += nvb) {
        int r = task;
        if (r < N_WIN) { int nt = r / 16, kt = r % 16; tr_tile<true>(p.w_in + (size_t)l * 1024 * IN_COLS, IN_COLS, WIN, 1024, kt * 64, nt * 64, tile, tid); continue; }
        r -= N_WIN;
        if (r < N_WBR) { int g = r / 128, rr = r % 128, nt = rr / 8, kt = rr % 8;
            tr_tile<false>(p.w_branch + (size_t)(l * 3 + g) * 512 * 1024, 1024, WBR + (size_t)g * 1024 * 512, 512, kt * 64, nt * 64, tile, tid); continue; }
        r -= N_WBR;
        if (r < N_WOUT) { int nt = r / 16, kt = r % 16; tr_tile<false>(p.w_out + (size_t)l * 1024 * 1024, 1024, WOUT, 1024, kt * 64, nt * 64, tile, tid); continue; }
        r -= N_WOUT;
        if (r < N_WQ) { int nt = r / 16, kt = r % 16; tr_tile<false>(p.peer_wq + (size_t)l * 1024 * 2048, 2048, WQ, 1024, kt * 64, nt * 64, tile, tid); continue; }
        r -= N_WQ;
        if (r < N_SK) { conv_chunk(p.peer_keys + (size_t)l * 16 * 128 * 128, SK, (size_t)r * 16384, tid); continue; }
        r -= N_SK;
        if (r < N_PU) { conv_chunk_fp8(p.peer_u + (size_t)l * 16384 * 1024, PU, (size_t)r * 16384, PU_SCALE, tid); continue; }
        r -= N_PU;
        conv_chunk_fp8(p.peer_v + (size_t)l * 16384 * 1024, PV, (size_t)r * 16384, PV_SCALE, tid);
    }
}

__device__ void ph_norm(const Params& p, int l, int which, const float* xin, int vb0, int nvb) {
    const int wave = TIDX() >> 6, lane = TIDX() & 63;
    const float* gain = (which ? p.norm_ffn : p.norm_mix) + l * 1024;
    const float* modb = (const float*)(p.ws + WS_MOD);
    bf16_t* H = (bf16_t*)(p.ws + WS_H);
    for (int t = vb0 * 8 + wave; t < T_TOK; t += nvb * 8) {
        int b = t >> 11;
        const float* mod = modb + (size_t)(l * 8 + b) * 6144 + (which ? 3072 : 0);
        const float4* xr = (const float4*)(xin + (size_t)t * 1024);
        float4 v[4]; float ss = 0.f;
#pragma unroll
        for (int i = 0; i < 4; ++i) { v[i] = xr[lane + 64 * i]; ss += v[i].x * v[i].x + v[i].y * v[i].y + v[i].z * v[i].z + v[i].w * v[i].w; }
        ss = wave_sum(ss);
        float rstd = rsqrtf(ss * (1.f / 1024.f) + 1e-6f);
#pragma unroll
        for (int i = 0; i < 4; ++i) {
            int idx = (lane + 64 * i) * 4;
            float4 g = *(const float4*)(gain + idx), sc = *(const float4*)(mod + 1024 + idx), sh = *(const float4*)(mod + idx);
            float h0 = v[i].x * rstd * g.x * (1.f + sc.x) + sh.x, h1 = v[i].y * rstd * g.y * (1.f + sc.y) + sh.y;
            float h2 = v[i].z * rstd * g.z * (1.f + sc.z) + sh.z, h3 = v[i].w * rstd * g.w * (1.f + sc.w) + sh.w;
            uint2 o; o.x = pack2(h0, h1); o.y = pack2(h2, h3);
            *(uint2*)(H + (size_t)t * 1024 + idx) = o;
        }
    }
}

constexpr int GBM = 256, GBN = 128, GBK = 64, GLS = 72;
__device__ __forceinline__ void gemm_tile(const bf16_t* __restrict__ A, int lda, const bf16_t* __restrict__ Bt, int ldb, int K,
                                          int m0, int n0, bf16_t* sA, bf16_t* sB, f32x4 (&acc)[4][4], const int tid) {
    const int lane = tid & 63, wave = tid >> 6;
    const int wm = wave >> 1, wn = wave & 1, fr = lane & 15, fq = lane >> 4;
    u32x4 ra[4], rb[2];
    const int crow = tid >> 3, ckc = (tid & 7) * 8;
    const bf16_t* Ag = A + (size_t)(m0 + crow) * lda + ckc;
    const bf16_t* Bg = Bt + (size_t)(n0 + crow) * ldb + ckc;
#pragma unroll
    for (int i = 0; i < 4; ++i) ra[i] = *(const u32x4*)(Ag + (size_t)(64 * i) * lda);
#pragma unroll
    for (int i = 0; i < 2; ++i) rb[i] = *(const u32x4*)(Bg + (size_t)(64 * i) * ldb);
    for (int k0 = 0; k0 < K; k0 += GBK) {
        __syncthreads();
#pragma unroll
        for (int i = 0; i < 4; ++i) *(u32x4*)(sA + (crow + 64 * i) * GLS + ckc) = ra[i];
#pragma unroll
        for (int i = 0; i < 2; ++i) *(u32x4*)(sB + (crow + 64 * i) * GLS + ckc) = rb[i];
        __syncthreads();
        {
            const int kn = (k0 + GBK < K) ? (k0 + GBK) : k0;
#pragma unroll
            for (int i = 0; i < 4; ++i) ra[i] = *(const u32x4*)(Ag + (size_t)(64 * i) * lda + kn);
#pragma unroll
            for (int i = 0; i < 2; ++i) rb[i] = *(const u32x4*)(Bg + (size_t)(64 * i) * ldb + kn);
        }
#pragma unroll
        for (int ks = 0; ks < 2; ++ks) {
            bf16x8 af[4], wf[4];
#pragma unroll
            for (int mf = 0; mf < 4; ++mf) af[mf] = *(const bf16x8*)(sA + (wm * 64 + mf * 16 + fr) * GLS + ks * 32 + fq * 8);
#pragma unroll
            for (int nf = 0; nf < 4; ++nf) wf[nf] = *(const bf16x8*)(sB + (wn * 64 + nf * 16 + fr) * GLS + ks * 32 + fq * 8);
#pragma unroll
            for (int nf = 0; nf < 4; ++nf)
#pragma unroll
                for (int mf = 0; mf < 4; ++mf)
                    acc[nf][mf] = __builtin_amdgcn_mfma_f32_16x16x32_bf16(wf[nf], af[mf], acc[nf][mf], 0, 0, 0);
        }
    }
}


namespace pg8 {
#define PG8_LAS __attribute__((address_space(3)))
constexpr int BM = 256, BK = 64, HALF = 128, HTB = HALF * BK * 2, STAGE_BYTES = 8 * HTB, NXCD = 8, WGM = 8;
__device__ __forceinline__ int lds_byte(int r, int c) { const int st = (r >> 4) * 2 + (c >> 5), rr = r & 15, cc = c & 31, ob = rr * 64 + cc * 2; return st * 1024 + (ob ^ (((ob >> 9) & 1) << 5)); }
__device__ __forceinline__ void stage_rc(int b, int& R, int& C) { const int st = b / 1024, sb = b % 1024, swz = sb ^ (((sb >> 9) & 1) << 5); R = (st >> 1) * 16 + swz / 64; C = (st & 1) * 32 + (swz % 64) / 2; }
__device__ __forceinline__ int perm32(int rho) { const int n = rho >> 4, i = rho & 15; return 8 * (i >> 2) + 4 * n + (i & 3); }
struct Unit { int pm, pn, aux; size_t aoff, boff; };
struct Gemm { const bf16_t* A; const bf16_t* Bt; int lda, ldb, K; };

struct StaticOrder {
    int nM, nN, nwg, G, c, lda, ldb;
    __device__ void init(int M, int N, int G_, int c_, int lda_, int ldb_) { nM = M / BM; nN = N / BM; nwg = nM * nN; G = G_; c = c_; lda = lda_; ldb = ldb_; }
    __device__ bool next(int i, Unit& u) const {
        const long L = (long)i * G + c; if (L >= nwg) return false;
        int wgid = (int)L; { const int q = nwg / NXCD, r = nwg % NXCD, xcd = wgid % NXCD, off = wgid / NXCD; wgid = (xcd < r ? xcd * (q + 1) : r * (q + 1) + (xcd - r) * q) + off; }
        const int nig = WGM * nN, gid = wgid / nig, fm = gid * WGM, gsz = (nM - fm) < WGM ? (nM - fm) : WGM;
        u.pm = fm + ((wgid % nig) % gsz); u.pn = (wgid % nig) / gsz; u.aux = 0;
        u.aoff = (size_t)u.pm * BM * lda * 2; u.boff = (size_t)u.pn * BM * ldb * 2;
        return true;
    }
};
struct MergeOrder {
    int c, G;
    __device__ bool next(int i, Unit& u) const {
        const int tile = c + (i / 3) * G; if (tile >= 256) return false;
        u.pm = tile & 63; u.pn = tile >> 6; u.aux = i % 3;
        u.aoff = ((size_t)u.pm * BM * 1536 + (size_t)u.aux * 512) * 2; u.boff = ((size_t)u.aux * 1024 + (size_t)u.pn * BM) * 512 * 2;
        return true;
    }
};

template <class Epi, class Sched>
__device__ __forceinline__ void gemm_phase(PG8_LAS unsigned char* lds, const Gemm g, const Sched& S, const Epi& E, const int tid) {
    const int wid = __builtin_amdgcn_readfirstlane(tid >> 6), lane = tid & 63, wr = wid >> 2, wc = wid & 3, fr = lane & 15, fq = lane >> 4;
    const int K = g.K, nt = K / BK;
    unsigned voffA[2], voffB[2];
#pragma unroll
    for (int i = 0; i < 2; ++i) { int R, C; stage_rc(tid * 16 + i * 8192, R, C); const int Rb = Epi::PERM ? ((R & ~31) + perm32(R & 31)) : R;
        voffA[i] = (unsigned)(R * g.lda + C) * 2u; voffB[i] = (unsigned)(Rb * g.ldb + C) * 2u; }
    const size_t kstep = (size_t)(BK * 2);
    const size_t hstepA = (size_t)HALF * g.lda * 2, hstepB = (size_t)HALF * g.ldb * 2;
    const unsigned ldsw = (unsigned)wid * 1024u;
    const int aoff = lds_byte(wr * 64 + fr, fq * 8), boff = lds_byte(wc * 32 + fr, fq * 8);
#define PG8_SA(b, h) (((b) * 2 + (h)) * HTB)
#define PG8_SB(b, h) ((4 + (b) * 2 + (h)) * HTB)
#define PG8_STAGE(bufoff, gbase, voff) do { _Pragma("unroll") for (int _i = 0; _i < 2; ++_i) \
        __builtin_amdgcn_global_load_lds((const unsigned*)((const char*)(gbase) + (voff)[_i]), (PG8_LAS unsigned*)(lds + (bufoff) + ldsw + _i * 8192), 16, 0, 0); } while (0)
#define PG8_LDA(dst, b, h) do { _Pragma("unroll") for (int m = 0; m < 4; ++m) _Pragma("unroll") for (int k = 0; k < 2; ++k) dst[m][k] = *(const PG8_LAS bf16x8*)(lds + PG8_SA(b, h) + aoff + m * 2048 + k * 1024); } while (0)
#define PG8_LDB(dst, b, h) do { _Pragma("unroll") for (int n = 0; n < 2; ++n) _Pragma("unroll") for (int k = 0; k < 2; ++k) dst[n][k] = *(const PG8_LAS bf16x8*)(lds + PG8_SB(b, h) + boff + n * 2048 + k * 1024); } while (0)
#define PG8_MMA(ai, bj, At, Bt) do { __builtin_amdgcn_s_setprio(1); _Pragma("unroll") for (int m = 0; m < 4; ++m) _Pragma("unroll") for (int n = 0; n < 2; ++n) _Pragma("unroll") for (int k = 0; k < 2; ++k) \
        acc[ai][bj][m][n] = __builtin_amdgcn_mfma_f32_16x16x32_bf16(Bt[n][k], At[m][k], acc[ai][bj][m][n], 0, 0, 0); __builtin_amdgcn_s_setprio(0); } while (0)
#define PG8_WAIT_V(n) asm volatile("s_waitcnt vmcnt(" #n ")" ::: "memory")
#define PG8_WAIT_L(n) asm volatile("s_waitcnt lgkmcnt(" #n ")" ::: "memory")
#define PG8_BAR __builtin_amdgcn_s_barrier()
#define PG8_SCHED __builtin_amdgcn_sched_barrier(0)
    Unit cur, nxt; int ui = 0;
    if (!S.next(0, cur)) return;
    f32x4 acc[2][2][4][2];
#pragma unroll
    for (int a = 0; a < 2; ++a)
#pragma unroll
        for (int b = 0; b < 2; ++b)
#pragma unroll
            for (int m = 0; m < 4; ++m)
#pragma unroll
                for (int n = 0; n < 2; ++n) acc[a][b][m][n] = f32x4{0.f, 0.f, 0.f, 0.f};
    bf16x8 At[4][2], B0[2][2], B1[2][2];
    const char* cA = (const char*)g.A + cur.aoff; const char* cB = (const char*)g.Bt + cur.boff;
    PG8_STAGE(PG8_SB(0, 0), cB, voffB); PG8_STAGE(PG8_SA(0, 0), cA, voffA); PG8_STAGE(PG8_SB(0, 1), cB + hstepB, voffB); PG8_STAGE(PG8_SA(0, 1), cA + hstepA, voffA);
    if (wr == 1) PG8_BAR;
    PG8_WAIT_V(4); PG8_BAR;
    PG8_STAGE(PG8_SB(1, 0), cB + kstep, voffB); PG8_STAGE(PG8_SA(1, 0), cA + kstep, voffA); PG8_STAGE(PG8_SB(1, 1), cB + hstepB + kstep, voffB);
    PG8_WAIT_V(6); PG8_BAR;
    for (;;) {
        const bool has_next = S.next(ui + 1, nxt);
        const char* nA = has_next ? (const char*)g.A + nxt.aoff : cA; const char* nB = has_next ? (const char*)g.Bt + nxt.boff : cB;
        for (int t = 0; t < nt; t += 2) {
            const bool last = (t == nt - 2);
            const char* a1 = cA + (size_t)(t + 1) * kstep;
            const char* a2 = last ? nA : cA + (size_t)(t + 2) * kstep; const char* b2 = last ? nB : cB + (size_t)(t + 2) * kstep;
            const char* a3 = a2 + kstep; const char* b3 = b2 + kstep;
            PG8_LDB(B0, 0, 0); PG8_SCHED; PG8_LDA(At, 0, 0); PG8_STAGE(PG8_SA(1, 1), a1 + hstepA, voffA);
            PG8_WAIT_L(8); PG8_BAR; PG8_WAIT_L(0); PG8_MMA(0, 0, At, B0); PG8_BAR; PG8_SCHED;
            PG8_LDB(B1, 0, 1); PG8_STAGE(PG8_SB(0, 0), b2, voffB);
            PG8_BAR; PG8_WAIT_L(0); PG8_MMA(0, 1, At, B1); PG8_BAR;
            PG8_LDA(At, 0, 1); PG8_STAGE(PG8_SA(0, 0), a2, voffA);
            PG8_BAR; PG8_WAIT_L(0); PG8_MMA(1, 0, At, B0); PG8_BAR; PG8_SCHED;
            PG8_STAGE(PG8_SB(0, 1), b2 + hstepB, voffB);
            PG8_WAIT_V(6); PG8_BAR; PG8_MMA(1, 1, At, B1); PG8_BAR;
            PG8_LDB(B0, 1, 0); PG8_SCHED; PG8_LDA(At, 1, 0); PG8_STAGE(PG8_SA(0, 1), a2 + hstepA, voffA);
            PG8_WAIT_L(8); PG8_BAR; PG8_WAIT_L(0); PG8_MMA(0, 0, At, B0); PG8_BAR; PG8_SCHED;
            PG8_LDB(B1, 1, 1); PG8_STAGE(PG8_SB(1, 0), b3, voffB);
            PG8_BAR; PG8_WAIT_L(0); PG8_MMA(0, 1, At, B1); PG8_BAR;
            PG8_LDA(At, 1, 1); PG8_STAGE(PG8_SA(1, 0), a3, voffA);
            PG8_BAR; PG8_WAIT_L(0); PG8_MMA(1, 0, At, B0); PG8_BAR; PG8_SCHED;
            PG8_STAGE(PG8_SB(1, 1), b3 + hstepB, voffB);
            PG8_WAIT_V(6); PG8_BAR; PG8_MMA(1, 1, At, B1); PG8_BAR;
        }
        E(acc, cur, wr, wc, fr, fq);
        if (!has_next) break;
#pragma unroll
        for (int a = 0; a < 2; ++a)
#pragma unroll
            for (int b = 0; b < 2; ++b)
#pragma unroll
                for (int m = 0; m < 4; ++m)
#pragma unroll
                    for (int n = 0; n < 2; ++n) acc[a][b][m][n] = f32x4{0.f, 0.f, 0.f, 0.f};
        cur = nxt; cA = nA; cB = nB; ++ui;
    }
    PG8_WAIT_V(0);
    if (wr == 0) PG8_BAR;
    PG8_BAR;
#undef PG8_SA
#undef PG8_SB
#undef PG8_STAGE
#undef PG8_LDA
#undef PG8_LDB
#undef PG8_MMA
#undef PG8_WAIT_V
#undef PG8_WAIT_L
#undef PG8_BAR
#undef PG8_SCHED
}

struct EpiBf16 {
    static constexpr bool PERM = true;
    bf16_t* O; int ldc;
    __device__ __forceinline__ void operator()(const f32x4 (&acc)[2][2][4][2], const Unit& u, int wr, int wc, int fr, int fq) const {
        const int row0 = u.pm * BM + wr * 64 + fr, col0 = u.pn * BM + wc * 32 + 8 * fq;
#pragma unroll
        for (int ai = 0; ai < 2; ++ai)
#pragma unroll
            for (int m = 0; m < 4; ++m) { bf16_t* rowp = O + (size_t)(row0 + ai * HALF + m * 16) * ldc + col0;
#pragma unroll
                for (int bj = 0; bj < 2; ++bj) { const f32x4 v0 = acc[ai][bj][m][0], v1 = acc[ai][bj][m][1];
                    u32x4 w; w.x = pack2(v0[0], v0[1]); w.y = pack2(v0[2], v0[3]); w.z = pack2(v1[0], v1[1]); w.w = pack2(v1[2], v1[3]);
                    *(u32x4*)(rowp + bj * HALF) = w; } }
    }
};
struct EpiResid {
    static constexpr bool PERM = false;
    const float* xin; float* out; const float* mod;
    __device__ __forceinline__ void operator()(const f32x4 (&acc)[2][2][4][2], const Unit& u, int wr, int wc, int fr, int fq) const {
        const int row0 = u.pm * BM + wr * 64 + fr, col0 = u.pn * BM + wc * 32 + 4 * fq;
        const float* gm = mod + (size_t)(row0 >> 11) * 6144 + 2048 + col0;
#pragma unroll
        for (int ai = 0; ai < 2; ++ai)
#pragma unroll
            for (int m = 0; m < 4; ++m) { const size_t ro = (size_t)(row0 + ai * HALF + m * 16) * 1024 + col0;
#pragma unroll
                for (int bj = 0; bj < 2; ++bj)
#pragma unroll
                    for (int n = 0; n < 2; ++n) {
                        const f32x4 g4 = *(const f32x4*)(gm + bj * HALF + n * 16), xi = *(const f32x4*)(xin + ro + bj * HALF + n * 16);
                        *(f32x4*)(out + ro + bj * HALF + n * 16) = xi + g4 * acc[ai][bj][m][n]; } }
    }
};
struct EpiMerge {
    static constexpr bool PERM = true;
    bf16_t* Hm; const bf16_t* Z;
    __device__ __forceinline__ void operator()(const f32x4 (&acc)[2][2][4][2], const Unit& u, int wr, int wc, int fr, int fq) const {
        const int row0 = u.pm * BM + wr * 64 + fr, col0 = u.pn * BM + wc * 32 + 8 * fq, g = u.aux;
#pragma unroll
        for (int ai = 0; ai < 2; ++ai)
#pragma unroll
            for (int m = 0; m < 4; ++m) { const int row = row0 + ai * HALF + m * 16;
#pragma unroll
                for (int bj = 0; bj < 2; ++bj) {
                    const int col = col0 + bj * HALF;
                    const u32x4 gz = *(const u32x4*)(Z + (size_t)row * LDZ + ZM + g * 1024 + col);
                    u32x4 prev = u32x4{0u, 0u, 0u, 0u};
                    if (g > 0) prev = *(const u32x4*)(Hm + (size_t)row * 1024 + col);
                    const f32x4 v0 = acc[ai][bj][m][0], v1 = acc[ai][bj][m][1];
                    u32x4 w;
                    w.x = pack2(bflo(prev.x) + sigm(bflo(gz.x)) * v0[0], bfhi(prev.x) + sigm(bfhi(gz.x)) * v0[1]);
                    w.y = pack2(bflo(prev.y) + sigm(bflo(gz.y)) * v0[2], bfhi(prev.y) + sigm(bfhi(gz.y)) * v0[3]);
                    w.z = pack2(bflo(prev.z) + sigm(bflo(gz.z)) * v1[0], bfhi(prev.z) + sigm(bfhi(gz.z)) * v1[1]);
                    w.w = pack2(bflo(prev.w) + sigm(bflo(gz.w)) * v1[2], bfhi(prev.w) + sigm(bfhi(gz.w)) * v1[3]);
                    *(u32x4*)(Hm + (size_t)row * 1024 + col) = w; } }
    }
};
}

struct EpiZ {
    bf16_t* Z; int ld;
    __device__ __forceinline__ void operator()(int m, int n, const f32x4& v) const {
        uint2 o; o.x = pack2(v[0], v[1]); o.y = pack2(v[2], v[3]);
        *(uint2*)(Z + (size_t)m * ld + n) = o;
    }
};
struct EpiF16 {
    _Float16* C; int ld;
    __device__ __forceinline__ void operator()(int m, int n, const f32x4& v) const {
        typedef _Float16 h4 __attribute__((ext_vector_type(4)));
        h4 o = {(_Float16)v[0], (_Float16)v[1], (_Float16)v[2], (_Float16)v[3]};
        *(h4*)(C + (size_t)m * ld + n) = o;
    }
};
struct EpiOut {
    const float* xin; float* out; const float* mod;
    __device__ __forceinline__ void operator()(int m, int n, const f32x4& v) const {
        int b = m >> 11;
        float4 g = *(const float4*)(mod + (size_t)b * 6144 + 2048 + n);
        float4 xi = *(const float4*)(xin + (size_t)m * 1024 + n);
        *(float4*)(out + (size_t)m * 1024 + n) = make_float4(xi.x + g.x * v[0], xi.y + g.y * v[1], xi.z + g.z * v[2], xi.w + g.w * v[3]);
    }
};

template <class Epi>
__device__ void gemm_phase(const bf16_t* A, int lda, const bf16_t* Bt, int ldb, int M, int N, int K, bool batched, Epi epi,
                           int vb0, int nvb, char* smem_, const int tid) {
    bf16_t* sA = (bf16_t*)smem_; bf16_t* sB = sA + GBM * GLS;
    const int lane = tid & 63, wave = tid >> 6, wm = wave >> 1, wn = wave & 1, fr = lane & 15, fq = lane >> 4;
    const int MT = M / GBM, NTL = N / GBN;
    for (int tile = vb0; tile < MT * NTL; tile += nvb) {
        int mt = tile % MT, nt = tile / MT;
        f32x4 acc[4][4];
#pragma unroll
        for (int a = 0; a < 4; ++a)
#pragma unroll
            for (int b = 0; b < 4; ++b) acc[a][b] = f32x4{0.f, 0.f, 0.f, 0.f};
        gemm_tile(batched ? A + nt * 128 : A, lda, Bt, ldb, K, mt * GBM, nt * GBN, sA, sB, acc, tid);
#pragma unroll
        for (int nf = 0; nf < 4; ++nf)
#pragma unroll
            for (int mf = 0; mf < 4; ++mf)
                epi(mt * GBM + wm * 64 + mf * 16 + fr, nt * GBN + wn * 64 + nf * 16 + fq * 4, acc[nf][mf]);
    }
}


template <int DK, bool GLA>
__device__ void scan2_item(const Params& p, int l, int b, int h, char* smem_) {
    constexpr int SEG = NT / DK, SLEN = 64 / SEG, KS = DK / 32, KT = DK / 16;
    constexpr int QS = DK + 8, BS = DK + 4, VS = 72;
    bf16_t* qs = (bf16_t*)smem_;
    bf16_t* ks = qs + 64 * QS;
    float* bs = (float*)(ks + 64 * QS);
    bf16_t* vt = (bf16_t*)(bs + 64 * BS);
    bf16_t* At = vt + 128 * VS;
    bf16_t* kht = At + 64 * VS;
    bf16_t* st = kht + DK * VS;
    float* segtot = (float*)(st + 128 * QS);
    float* blast = segtot + SEG * DK;
    const int tid = TIDX(), lane = tid & 63, wave = __builtin_amdgcn_readfirstlane(tid >> 6), fr = lane & 15, fq = lane >> 4;
    const int kl = tid % DK, seg = __builtin_amdgcn_readfirstlane(tid / DK);
    float lbv = 0.f, gbias = 0.f; float gu[16];
#pragma unroll
    for (int r = 0; r < 16; ++r) gu[r] = 0.f;
    if (GLA) {
#pragma unroll
        for (int r = 0; r < 16; ++r) gu[r] = p.gla_up[(size_t)(l * 16 + r) * 256 + h * 64 + kl];
        gbias = p.gla_bias[l * 256 + h * 64 + kl];
    } else if (l == 1) {
        float x0 = p.hgrn_lb[h * 128 + kl], x1 = p.hgrn_lb[512 + h * 128 + kl];
        lbv = 1.f / (1.f + expf(x0 - x1));
    }
    const float scale = GLA ? 0.125f : 0.08838834764831845f;
    const bf16_t* Zb = (const bf16_t*)(p.ws + WS_Z) + (size_t)(b * 2048) * LDZ;
    float* ssq = (float*)(smem_ + 152576);
    const int QCOL = (GLA ? ZC_Q : ZA_Q) + h * DK, KCOL = (GLA ? ZC_K : ZA_F) + h * DK, VCOL = (GLA ? ZC_V : ZA_I) + h * 128, GCOL = (GLA ? ZC_G : ZA_G) + h * 128;
    f32x4 sacc[KT];
#pragma unroll
    for (int i = 0; i < KT; ++i) sacc[i] = f32x4{0.f, 0.f, 0.f, 0.f};
    for (int i = tid; i < 128 * QS / 2; i += NT) ((unsigned*)st)[i] = 0u;
    __syncthreads();

    for (int c = 0; c < 32; ++c) {
        const bf16_t* Zc = Zb + (size_t)(c * 64) * LDZ;
        {
            bf16_t rq[SLEN], rk[SLEN];
            u32x4 rc0[GLA ? SLEN : 1], rc1[GLA ? SLEN : 1];
            {
                bf16_t rv[16];
                const int v = tid & 127, sb_ = __builtin_amdgcn_readfirstlane(tid >> 7);
#pragma unroll
                for (int i = 0; i < 16; ++i) rv[i] = Zc[(size_t)(sb_ + 4 * i) * LDZ + VCOL + v];
#pragma unroll
                for (int i = 0; i < SLEN; ++i) {
                    const bf16_t* zr = Zc + (size_t)(seg * SLEN + i) * LDZ;
                    rq[i] = zr[QCOL + kl]; rk[i] = zr[KCOL + kl];
                    if (GLA) { rc0[i] = *(const u32x4*)(zr + ZC_CODE); rc1[i] = *(const u32x4*)(zr + ZC_CODE + 8); }
                }
#pragma unroll
                for (int i = 0; i < 16; ++i) vt[v * VS + sb_ + 4 * i] = rv[i];
            }
            float run = 0.f;
#pragma unroll
            for (int i = 0; i < SLEN; ++i) {
                const int s_ = seg * SLEN + i;
                float g, kk;
                if (GLA) {
                    float x = gbias;
#pragma unroll
                    for (int r = 0; r < 4; ++r) {
                        x += bflo(rc0[i][r]) * gu[2 * r] + bfhi(rc0[i][r]) * gu[2 * r + 1];
                        x += bflo(rc1[i][r]) * gu[8 + 2 * r] + bfhi(rc1[i][r]) * gu[8 + 2 * r + 1];
                    }
                    g = (fminf(x, 0.f) - __logf(1.f + __expf(-fabsf(x)))) * (1.f / 16.f);
                    kk = bf2f(rk[i]);
                } else {
                    const float f = lbv + (1.f - lbv) * __frcp_rn(1.f + __expf(-bf2f(rk[i])));
                    g = __logf(f); kk = 1.f - f;
                }
                run += g;
                bs[s_ * BS + kl] = run;
                qs[s_ * QS + kl] = rq[i];
                ks[s_ * QS + kl] = f2bf(kk);
            }
            segtot[seg * DK + kl] = run;
        }
        __syncthreads();
        {
            float pre = 0.f, tot = 0.f;
#pragma unroll
            for (int g_ = 0; g_ < SEG; ++g_) { const float v_ = segtot[g_ * DK + kl]; if (g_ < seg) pre += v_; tot += v_; }
            if (seg == 0) blast[kl] = tot;
            unsigned pk[SLEN / 2];
#pragma unroll
            for (int i = 0; i < SLEN; ++i) {
                const float bv = bs[(seg * SLEN + i) * BS + kl] + pre;
                bs[(seg * SLEN + i) * BS + kl] = bv;
                const float kh = bf2f(ks[(seg * SLEN + i) * QS + kl]) * __expf(tot - bv);
                if (i & 1) pk[i >> 1] |= ((unsigned)f2bf(kh)) << 16; else pk[i >> 1] = (unsigned)f2bf(kh);
            }
            unsigned* dst = (unsigned*)(kht + kl * VS + seg * SLEN);
#pragma unroll
            for (int i = 0; i < SLEN / 2; ++i) dst[i] = pk[i];
        }
        __syncthreads();
        for (int blk = wave; blk < 10; blk += 8) {
            int bi, bj;
            if (blk < 1) { bi = 0; bj = 0; } else if (blk < 3) { bi = 1; bj = blk - 1; } else if (blk < 6) { bi = 2; bj = blk - 3; } else { bi = 3; bj = blk - 6; }
            f32x4 acc = f32x4{0.f, 0.f, 0.f, 0.f};
            const int srow = bj * 16 + fr, trow = bi * 16 + fr;
#pragma unroll
            for (int kk = 0; kk < KS; ++kk) {
                const int k0 = kk * 32 + fq * 8;
                float br[8];
                if (bi == 0) {
#pragma unroll
                    for (int j = 0; j < 8; ++j) br[j] = 0.f;
                } else {
                    const float4 r0 = *(const float4*)(bs + (bi * 16 - 1) * BS + k0), r1 = *(const float4*)(bs + (bi * 16 - 1) * BS + k0 + 4);
                    br[0] = r0.x; br[1] = r0.y; br[2] = r0.z; br[3] = r0.w; br[4] = r1.x; br[5] = r1.y; br[6] = r1.z; br[7] = r1.w;
                }
                const uint4 kq = *(const uint4*)(ks + srow * QS + k0), qq = *(const uint4*)(qs + trow * QS + k0);
                const float4 s0 = *(const float4*)(bs + srow * BS + k0), s1 = *(const float4*)(bs + srow * BS + k0 + 4);
                const float4 t0_ = *(const float4*)(bs + trow * BS + k0), t1_ = *(const float4*)(bs + trow * BS + k0 + 4);
                const float bsv[8] = {s0.x, s0.y, s0.z, s0.w, s1.x, s1.y, s1.z, s1.w}, btv[8] = {t0_.x, t0_.y, t0_.z, t0_.w, t1_.x, t1_.y, t1_.z, t1_.w};
                const unsigned kw[4] = {kq.x, kq.y, kq.z, kq.w}, qw[4] = {qq.x, qq.y, qq.z, qq.w};
                union { bf16x8 v; unsigned u[4]; } ka, qb;
#pragma unroll
                for (int j = 0; j < 4; ++j) {
                    const float e0 = __expf(fminf(br[2 * j] - bsv[2 * j], 60.f)), e1 = __expf(fminf(br[2 * j + 1] - bsv[2 * j + 1], 60.f));
                    ka.u[j] = pack2(bflo(kw[j]) * e0, bfhi(kw[j]) * e1);
                    const float f0 = __expf(btv[2 * j] - br[2 * j]), f1 = __expf(btv[2 * j + 1] - br[2 * j + 1]);
                    qb.u[j] = pack2(bflo(qw[j]) * f0, bfhi(qw[j]) * f1);
                }
                acc = __builtin_amdgcn_mfma_f32_16x16x32_bf16(ka.v, qb.v, acc, 0, 0, 0);
            }
            if (bi == bj) {
#pragma unroll
                for (int r = 0; r < 4; ++r) if (4 * fq + r > fr) acc[r] = 0.f;
            }
            uint2 o; o.x = pack2(acc[0], acc[1]); o.y = pack2(acc[2], acc[3]);
            *(uint2*)(At + trow * VS + bj * 16 + 4 * fq) = o;
        }
        {
            unsigned z_ = 0u; asm volatile("" : "+v"(z_));
            if (wave == 2) *(uint2*)(At + (0 * 16 + fr) * VS + 16 + 4 * fq) = make_uint2(z_, z_);
            if (wave == 3) *(uint2*)(At + (2 * 16 + fr) * VS + 48 + 4 * fq) = make_uint2(z_, z_);
        }
        __syncthreads();
        f32x4 oacc[4]; uint2 gz[4];
        {
            const int ti = wave & 3, vh = wave >> 2, trow = ti * 16 + fr;
            bf16x8 qh[KS];
#pragma unroll
            for (int kk = 0; kk < KS; ++kk) {
                const int k0 = kk * 32 + fq * 8;
                const uint4 qq = *(const uint4*)(qs + trow * QS + k0);
                const float4 t0_ = *(const float4*)(bs + trow * BS + k0), t1_ = *(const float4*)(bs + trow * BS + k0 + 4);
                union { bf16x8 v; unsigned u[4]; } q_;
                q_.u[0] = pack2(bflo(qq.x) * __expf(t0_.x), bfhi(qq.x) * __expf(t0_.y));
                q_.u[1] = pack2(bflo(qq.y) * __expf(t0_.z), bfhi(qq.y) * __expf(t0_.w));
                q_.u[2] = pack2(bflo(qq.z) * __expf(t1_.x), bfhi(qq.z) * __expf(t1_.y));
                q_.u[3] = pack2(bflo(qq.w) * __expf(t1_.z), bfhi(qq.w) * __expf(t1_.w));
                qh[kk] = q_.v;
            }
            const bf16x8 af0 = *(const bf16x8*)(At + trow * VS + fq * 8), af1 = *(const bf16x8*)(At + trow * VS + 32 + fq * 8);
            float sq = 0.f;
#pragma unroll
            for (int vi = 0; vi < 4; ++vi) {
                const int vrow = vh * 64 + vi * 16 + fr;
                gz[vi] = *(const uint2*)(Zc + (size_t)trow * LDZ + GCOL + vh * 64 + vi * 16 + 4 * fq);
                f32x4 acc = f32x4{0.f, 0.f, 0.f, 0.f};
                acc = __builtin_amdgcn_mfma_f32_16x16x32_bf16(*(const bf16x8*)(vt + vrow * VS + fq * 8), af0, acc, 0, 0, 0);
                if (ti >= 2) acc = __builtin_amdgcn_mfma_f32_16x16x32_bf16(*(const bf16x8*)(vt + vrow * VS + 32 + fq * 8), af1, acc, 0, 0, 0);
#pragma unroll
                for (int kk = 0; kk < KS; ++kk)
                    acc = __builtin_amdgcn_mfma_f32_16x16x32_bf16(*(const bf16x8*)(st + vrow * QS + kk * 32 + fq * 8), qh[kk], acc, 0, 0, 0);
                oacc[vi] = acc * scale;
                sq += oacc[vi][0] * oacc[vi][0] + oacc[vi][1] * oacc[vi][1] + oacc[vi][2] * oacc[vi][2] + oacc[vi][3] * oacc[vi][3];
            }
            sq += shx<16>(sq); sq += shx<32>(sq);
            if (fq == 0) ssq[vh * 64 + trow] = sq;
        }
        {
            const int vrow = wave * 16 + fr;
            const bf16x8 vf0 = *(const bf16x8*)(vt + vrow * VS + fq * 8), vf1 = *(const bf16x8*)(vt + vrow * VS + 32 + fq * 8);
#pragma unroll
            for (int kt = 0; kt < KT; ++kt) {
                const float dec = __expf(blast[kt * 16 + fr]);
                sacc[kt][0] *= dec; sacc[kt][1] *= dec; sacc[kt][2] *= dec; sacc[kt][3] *= dec;
                sacc[kt] = __builtin_amdgcn_mfma_f32_16x16x32_bf16(vf0, *(const bf16x8*)(kht + (kt * 16 + fr) * VS + fq * 8), sacc[kt], 0, 0, 0);
                sacc[kt] = __builtin_amdgcn_mfma_f32_16x16x32_bf16(vf1, *(const bf16x8*)(kht + (kt * 16 + fr) * VS + 32 + fq * 8), sacc[kt], 0, 0, 0);
            }
        }
        __syncthreads();
#pragma unroll
        for (int kt = 0; kt < KT; ++kt)
#pragma unroll
            for (int r = 0; r < 4; ++r) st[(wave * 16 + 4 * fq + r) * QS + kt * 16 + fr] = f2bf(sacc[kt][r]);
        {
            const int ti = wave & 3, vh = wave >> 2, trow = ti * 16 + fr;
            const float rstd = rsqrtf((ssq[trow] + ssq[64 + trow]) * (1.f / 128.f) + 1e-6f);
            bf16_t* yrow = (bf16_t*)(p.ws + WS_Y) + (size_t)(b * 2048 + c * 64 + trow) * 1536 + (GLA ? 1024 : 0) + h * 128 + vh * 64 + 4 * fq;
            const float* gn = (GLA ? p.gla_on : p.hgrn_on) + l * 128 + vh * 64 + 4 * fq;
#pragma unroll
            for (int vi = 0; vi < 4; ++vi) {
                const float4 g4 = *(const float4*)(gn + vi * 16);
                const float z0 = bflo(gz[vi].x), z1 = bfhi(gz[vi].x), z2 = bflo(gz[vi].y), z3 = bfhi(gz[vi].y);
                uint2 o;
                o.x = pack2(oacc[vi][0] * rstd * g4.x * (z0 * sigm(z0)), oacc[vi][1] * rstd * g4.y * (z1 * sigm(z1)));
                o.y = pack2(oacc[vi][2] * rstd * g4.z * (z2 * sigm(z2)), oacc[vi][3] * rstd * g4.w * (z3 * sigm(z3)));
                *(uint2*)(yrow + vi * 16) = o;
            }
        }
    }
    __syncthreads();
}

__device__ void dsaprep2_item(const Params& p, int l, int item, char* smem_) {
    bf16_t* tile = (bf16_t*)smem_;
    const int tid = TIDX(), lane = tid & 63, wave = tid >> 6;
    bf16_t* Z = (bf16_t*)(p.ws + WS_Z); bf16_t* VT = (bf16_t*)(p.ws + WS_VT);
    {
        const int tb = item * 32;
        for (int tt = wave; tt < 32; tt += 8) {
            const int t = tb + tt;
#pragma unroll
            for (int grp = 0; grp < 8; ++grp) {
                bf16_t* ptr = Z + (size_t)t * LDZ + (grp < 4 ? ZB_Q : ZB_K) + (grp & 3) * 128 + lane * 2;
                unsigned u = *(unsigned*)ptr;
                float a = bflo(u), b = bfhi(u);
                float ss = wave_sum(a * a + b * b);
                float r = rsqrtf(ss * (1.f / 128.f) + 1e-6f);
                const float* gn = (grp < 4 ? p.dsa_qn : p.dsa_kn) + l * 128 + lane * 2;
                float sc = (grp < 4) ? 0.08838834764831845f : 1.f;
                __hip_atomic_store((unsigned*)ptr, pack2(a * r * gn[0] * sc, b * r * gn[1] * sc), __ATOMIC_RELAXED, __HIP_MEMORY_SCOPE_AGENT);
            }
        }
#pragma unroll
        for (int i = 0; i < 4; ++i) {
            int ch = tid + i * 512, t = ch >> 6, c8 = (ch & 63) * 8;
            uint4 u = *(const uint4*)(Z + (size_t)(tb + t) * LDZ + ZB_V + c8);
            unsigned* d = (unsigned*)(tile + t * 514 + c8);
            d[0] = u.x; d[1] = u.y; d[2] = u.z; d[3] = u.w;
        }
        __syncthreads();
        {
            const int c = tid, b = tb >> 11, s0 = tb & 2047;
            unsigned w[16];
#pragma unroll
            for (int j = 0; j < 16; ++j) w[j] = (unsigned)tile[(2 * j) * 514 + c] | ((unsigned)tile[(2 * j + 1) * 514 + c] << 16);
            unsigned long long* dst = (unsigned long long*)(VT + ((size_t)(b * 512 + c)) * 2048 + s0);
#pragma unroll
            for (int j = 0; j < 8; ++j) __hip_atomic_store(dst + j, ((unsigned long long)w[2 * j + 1] << 32) | w[2 * j], __ATOMIC_RELAXED, __HIP_MEMORY_SCOPE_AGENT);
        }
        __syncthreads();
    }
}

__device__ void dsa_select_tile(const Params& p, int b, int tq, char* smem_) {
    constexpr int KS_ = 2052;
    unsigned* keyL = (unsigned*)smem_;
    const int tid = TIDX(), lane = tid & 63, wave = __builtin_amdgcn_readfirstlane(tid >> 6), fr = lane & 15, fq = lane >> 4;
    const bf16_t* Z = (const bf16_t*)(p.ws + WS_Z);
    unsigned long long* BM64 = (unsigned long long*)(p.ws + WS_BM);
    const int t0 = tq * 16;
    {
        const int tl = t0 + fr;
        const size_t trow = (size_t)b * 2048 + tl;
        bf16x8 qf[4][2];
#pragma unroll
        for (int h = 0; h < 4; ++h)
#pragma unroll
            for (int ks = 0; ks < 2; ++ks) qf[h][ks] = *(const bf16x8*)(Z + trow * LDZ + ZB_QI + h * 64 + ks * 32 + fq * 8);
        float w[4];
#pragma unroll
        for (int h = 0; h < 4; ++h) w[h] = bf2f(Z[trow * LDZ + ZB_WI + h]) * 0.5f;
#pragma unroll 4
        for (int kt = wave; kt <= tq; kt += 8) {
            const bf16_t* kr = Z + ((size_t)b * 2048 + kt * 16 + fr) * LDZ + ZB_KI + fq * 8;
            const bf16x8 k0 = *(const bf16x8*)kr, k1 = *(const bf16x8*)(kr + 32);
            f32x4 acc[4];
#pragma unroll
            for (int h = 0; h < 4; ++h) {
                acc[h] = __builtin_amdgcn_mfma_f32_16x16x32_bf16(k0, qf[h][0], f32x4{0.f, 0.f, 0.f, 0.f}, 0, 0, 0);
                acc[h] = __builtin_amdgcn_mfma_f32_16x16x32_bf16(k1, qf[h][1], acc[h], 0, 0, 0);
            }
            u32x4 kk;
#pragma unroll
            for (int r = 0; r < 4; ++r) {
                float sc = w[0] * fmaxf(acc[0][r] * 0.125f, 0.f) + w[1] * fmaxf(acc[1][r] * 0.125f, 0.f) + w[2] * fmaxf(acc[2][r] * 0.125f, 0.f) + w[3] * fmaxf(acc[3][r] * 0.125f, 0.f);
                if (sc == 0.f) sc = 0.f;
                const unsigned u = __float_as_uint(sc);
                const unsigned k = (u & 0x80000000u) ? ~u : (u | 0x80000000u);
                kk[r] = (kt * 16 + 4 * fq + r <= tl) ? k : 0u;
            }
            *(u32x4*)(keyL + fr * KS_ + kt * 16 + 4 * fq) = kk;
        }
    }
    __syncthreads();
    {
        const int nk = (tq + 1) * 16, jmax = (nk + 63) >> 6;
        const int qa = 2 * wave, qb = qa + 1;
        unsigned ka[32], kb[32];
#pragma unroll
        for (int j = 0; j < 32; ++j) {
            const int s = lane + 64 * j;
            ka[j] = (s < nk) ? keyL[qa * KS_ + s] : 0u;
            kb[j] = (s < nk) ? keyL[qb * KS_ + s] : 0u;
        }
        unsigned Ta = 1u, Tb = 1u; int Ca = 2047, Cb = 2047;
        if (t0 >= 256) {
            int na, nb;
            bool da, db;
            {
                int c0 = 0, c1 = 0, c2 = 0, c3 = 0;
#pragma unroll
                for (int j = 0; j < 32; ++j)
                    if (j < jmax) { c0 += (ka[j] >= 0x80000000u); c1 += (ka[j] > 0x80000000u); c2 += (kb[j] >= 0x80000000u); c3 += (kb[j] > 0x80000000u); }
                c0 = wave_total_i(c0); c1 = wave_total_i(c1); c2 = wave_total_i(c2); c3 = wave_total_i(c3);
                da = (c1 < 256 && c0 >= 256); db = (c3 < 256 && c2 >= 256);
                Ta = da ? 0x80000000u : ((c0 >= 256) ? 0x80000000u : 0u); na = da ? c0 : ((c0 >= 256) ? c0 : 0x7fffffff);
                Tb = db ? 0x80000000u : ((c2 >= 256) ? 0x80000000u : 0u); nb = db ? c2 : ((c2 >= 256) ? c2 : 0x7fffffff);
            }
            for (int bit = 30; bit >= 0; --bit) {
                if (da && db) break;
                const unsigned ca_ = Ta | (1u << bit), cb_ = Tb | (1u << bit);
                int c0 = 0, c1 = 0;
#pragma unroll
                for (int j = 0; j < 32; ++j)
                    if (j < jmax) { c0 += (ka[j] >= ca_); c1 += (kb[j] >= cb_); }
                c0 = wave_total_i(c0); c1 = wave_total_i(c1);
                if (!da && c0 >= 256) { Ta = ca_; na = c0; }
                if (!db && c1 >= 256) { Tb = cb_; nb = c1; }
                da = da || (na == 256); db = db || (nb == 256);
            }
            if (na != 256 || nb != 256) {
                int needa, needb;
                {
                    int c0 = 0, c1 = 0;
#pragma unroll
                    for (int j = 0; j < 32; ++j)
                        if (j < jmax) { c0 += (ka[j] > Ta); c1 += (kb[j] > Tb); }
                    needa = 256 - wave_total_i(c0); needb = 256 - wave_total_i(c1);
                }
                Ca = 0; Cb = 0;
                for (int bit = 10; bit >= 0; --bit) {
                    const int ca_ = Ca | (1 << bit), cb_ = Cb | (1 << bit);
                    int c0 = 0, c1 = 0;
#pragma unroll
                    for (int j = 0; j < 32; ++j)
                        if (j < jmax) { const int s = lane + 64 * j; c0 += (ka[j] == Ta && s < ca_); c1 += (kb[j] == Tb && s < cb_); }
                    c0 = wave_total_i(c0); c1 = wave_total_i(c1);
                    if (c0 < needa) Ca = ca_;
                    if (c1 < needb) Cb = cb_;
                }
            }
        }
        const size_t rowa = (size_t)b * 2048 + t0 + qa;
#pragma unroll
        for (int j = 0; j < 32; ++j) {
            const int s = lane + 64 * j;
            const unsigned long long ma = __ballot((ka[j] > Ta) || (ka[j] == Ta && s <= Ca));
            const unsigned long long mb = __ballot((kb[j] > Tb) || (kb[j] == Tb && s <= Cb));
            if (lane == 0) {
                __hip_atomic_store(&BM64[rowa * 32 + j], ma, __ATOMIC_RELAXED, __HIP_MEMORY_SCOPE_AGENT);
                __hip_atomic_store(&BM64[(rowa + 1) * 32 + j], mb, __ATOMIC_RELAXED, __HIP_MEMORY_SCOPE_AGENT);
            }
        }
    }
    __syncthreads();
}

__device__ void dsa_attn_item(const Params& p, int b, int h, int qg, char* smem_) {
    constexpr int KSTR = 136, VSTR = 40;
    bf16_t* Kl = (bf16_t*)smem_;
    bf16_t* Vl = Kl + 2 * 32 * KSTR;
    const int tid = TIDX(), lane = tid & 63, wave = __builtin_amdgcn_readfirstlane(tid >> 6), fr = lane & 15, fq = lane >> 4;
    const bf16_t* Z = (const bf16_t*)(p.ws + WS_Z); const bf16_t* VT = (const bf16_t*)(p.ws + WS_VT);
    const unsigned* BM = (const unsigned*)(p.ws + WS_BM); bf16_t* Y = (bf16_t*)(p.ws + WS_Y);
    const int kr = tid >> 4, kc = tid & 15, vd = tid >> 2, vc = tid & 3;
    const int ka_row = 8 * (fr >> 2) + (fr & 3);
    {
        const int t0 = qg * 128 + wave * 16;
        const size_t trow = (size_t)b * 2048 + t0 + fr;
        bf16x8 qf[4];
#pragma unroll
        for (int ks = 0; ks < 4; ++ks) qf[ks] = *(const bf16x8*)(Z + trow * LDZ + ZB_Q + h * 128 + ks * 32 + fq * 8);
        f32x4 o[8];
#pragma unroll
        for (int i = 0; i < 8; ++i) o[i] = f32x4{0.f, 0.f, 0.f, 0.f};
        float m = -INFINITY, lsum = 0.f;
        const unsigned* bmrow = BM + trow * 64;
        const int nsteps_blk = qg * 4 + 4, nsteps_w = (t0 + 15) / 32 + 1;
        const bf16_t* kg = Z + ((size_t)b * 2048 + kr) * LDZ + ZB_K + h * 128 + kc * 8;
        const bf16_t* vg = VT + ((size_t)(b * 4 + h) * 128 + vd) * 2048 + vc * 8;
        u32x4 rk = *(const u32x4*)kg, rv = *(const u32x4*)vg;
        *(u32x4*)(Kl + kr * KSTR + kc * 8) = rk; *(u32x4*)(Vl + vd * VSTR + vc * 8) = rv;
        __syncthreads();
        for (int st = 0; st < nsteps_blk; ++st) {
            const bool more = (st + 1 < nsteps_blk);
            if (more) { rk = *(const u32x4*)(kg + (size_t)(st + 1) * 32 * LDZ); rv = *(const u32x4*)(vg + (st + 1) * 32); }
            if (st < nsteps_w) {
                const bf16_t* Kb = Kl + (st & 1) * 32 * KSTR; const bf16_t* Vb = Vl + (st & 1) * 128 * VSTR;
                f32x4 sa = f32x4{0.f, 0.f, 0.f, 0.f}, sb = f32x4{0.f, 0.f, 0.f, 0.f};
#pragma unroll
                for (int ks = 0; ks < 4; ++ks) {
                    const bf16x8 fa = *(const bf16x8*)(Kb + ka_row * KSTR + ks * 32 + fq * 8), fb = *(const bf16x8*)(Kb + (ka_row + 4) * KSTR + ks * 32 + fq * 8);
                    sa = __builtin_amdgcn_mfma_f32_16x16x32_bf16(fa, qf[ks], sa, 0, 0, 0);
                    sb = __builtin_amdgcn_mfma_f32_16x16x32_bf16(fb, qf[ks], sb, 0, 0, 0);
                }
                const unsigned mw = bmrow[st] >> (8 * fq);
                float x[8];
#pragma unroll
                for (int r = 0; r < 4; ++r) { x[r] = ((mw >> r) & 1u) ? sa[r] : -INFINITY; x[4 + r] = ((mw >> (4 + r)) & 1u) ? sb[r] : -INFINITY; }
                float mx = fmaxf(fmaxf(fmaxf(x[0], x[1]), fmaxf(x[2], x[3])), fmaxf(fmaxf(x[4], x[5]), fmaxf(x[6], x[7])));
                mx = fmaxf(mx, shx<16>(mx)); mx = fmaxf(mx, shx<32>(mx));
                const float mnew = fmaxf(m, mx);
                const float msafe = (mnew == -INFINITY) ? 0.f : mnew;
                const float alpha = __expf(m - msafe);
                float pe[8]; float ps = 0.f;
#pragma unroll
                for (int j = 0; j < 8; ++j) { pe[j] = __expf(x[j] - msafe); ps += pe[j]; }
                lsum = lsum * alpha + ps;
                m = mnew;
#pragma unroll
                for (int i = 0; i < 8; ++i) { o[i][0] *= alpha; o[i][1] *= alpha; o[i][2] *= alpha; o[i][3] *= alpha; }
                union { bf16x8 v; unsigned u[4]; } pf;
                pf.u[0] = pack2(pe[0], pe[1]); pf.u[1] = pack2(pe[2], pe[3]); pf.u[2] = pack2(pe[4], pe[5]); pf.u[3] = pack2(pe[6], pe[7]);
#pragma unroll
                for (int i = 0; i < 8; ++i) {
                    const bf16x8 vf = *(const bf16x8*)(Vb + (i * 16 + fr) * VSTR + fq * 8);
                    o[i] = __builtin_amdgcn_mfma_f32_16x16x32_bf16(vf, pf.v, o[i], 0, 0, 0);
                }
            }
            if (more) { *(u32x4*)(Kl + ((st + 1) & 1) * 32 * KSTR + kr * KSTR + kc * 8) = rk; *(u32x4*)(Vl + ((st + 1) & 1) * 128 * VSTR + vd * VSTR + vc * 8) = rv; }
            __syncthreads();
        }
        lsum += shx<16>(lsum); lsum += shx<32>(lsum);
        const float inv = 1.f / lsum;
#pragma unroll
        for (int i = 0; i < 8; ++i) {
            uint2 ov; ov.x = pack2(o[i][0] * inv, o[i][1] * inv); ov.y = pack2(o[i][2] * inv, o[i][3] * inv);
            *(uint2*)(Y + trow * 1536 + 512 + h * 128 + i * 16 + 4 * fq) = ov;
        }
    }
}

constexpr int LDS_BYTES = 155648;
__device__ void ph_mixA(const Params& p, int l, int vb0, int nvb, char* smem_) {
    for (int item = vb0; item < 64; item += nvb) {
        if (item < 32) scan2_item<128, false>(p, l, item >> 2, item & 3, smem_);
        else scan2_item<64, true>(p, l, (item - 32) >> 2, (item - 32) & 3, smem_);
    }
    unsigned* ctr = (unsigned*)(p.ws + WS_CTL) + 3584 + l * 64;
    unsigned* done = (unsigned*)(p.ws + WS_CTL) + 5300 + l * 8 * 16;
    volatile int* slot = (volatile int*)(smem_ + LDS_BYTES - 64);
    for (;;) {
        if (TIDX() == 0) *slot = (int)atomicAdd(ctr, 1u);
        __syncthreads();
        const int idx = __builtin_amdgcn_readfirstlane(*slot);
        __syncthreads();
        if (idx >= 2048) break;
        if (idx < 1536) {
            const int b = idx / 192, r = idx % 192;
            if (r < 128) dsa_select_tile(p, b, 127 - r, smem_);
            else dsaprep2_item(p, l, b * 64 + (r - 128), smem_);
            asm volatile("s_waitcnt vmcnt(0)" ::: "memory");
            __syncthreads();
            if (TIDX() == 0) __hip_atomic_fetch_add(done + b * 16, 1u, __ATOMIC_RELAXED, __HIP_MEMORY_SCOPE_AGENT);
        } else {
            const int a = idx - 1536, b = a >> 6, h = (a >> 4) & 3, qg = 15 - (a & 15);
            if (TIDX() == 0) {
                unsigned spins = 0;
                while (__hip_atomic_load(done + b * 16, __ATOMIC_RELAXED, __HIP_MEMORY_SCOPE_AGENT) < 192u) { __builtin_amdgcn_s_sleep(2); if (++spins > (1u << 18)) break; }
                __builtin_amdgcn_fence(__ATOMIC_ACQUIRE, "agent");
                asm volatile("s_waitcnt vmcnt(0)" ::: "memory");
            }
            __syncthreads();
            dsa_attn_item(p, b, h, qg, smem_);
        }
    }
}

__device__ __forceinline__ int f2sort(float f) { int i = __float_as_int(f); return i ^ ((i >> 31) & 0x7fffffff); }
__device__ __forceinline__ float sort2f(int i) { return __int_as_float(i ^ ((i >> 31) & 0x7fffffff)); }
#define INSK(K, xv) do { int _x = (xv); \
    _Pragma("unroll") for (int _j = 0; _j < 16; ++_j) { int _hi = max(K[_j], _x); _x = min(K[_j], _x); K[_j] = _hi; } } while (0)
#define INS64(K, xv) do { unsigned long long _x = (xv); \
    _Pragma("unroll") for (int _j = 0; _j < 16; ++_j) { bool _c = _x > K[_j]; unsigned long long _o = K[_j]; K[_j] = _c ? _x : _o; _x = _c ? _o : _x; } } while (0)

__device__ void ph_route(const Params& p, int vb0, int nvb, char* smem_) {
    typedef _Float16 h8 __attribute__((ext_vector_type(8)));
    const _Float16* SC = (const _Float16*)(p.ws + WS_SC);
    int* RI = (int*)(p.ws + WS_RI); float* RG = (float*)(p.ws + WS_RG);
    const int tid = TIDX(), lane = tid & 63, wave = tid >> 6;
    _Float16* tile = (_Float16*)smem_ + wave * (64 * 72);
    for (int item0 = (vb0 * 8 + wave) * 64; item0 < T_TOK * 8; item0 += nvb * 8 * 64) {
        const int item = item0 + lane;
        const int t = item >> 3, h = item & 7;
        const _Float16* s0 = SC + (size_t)t * 2048 + h * 256;
        const _Float16* wbase = SC + (size_t)item0 * 256;
        int k0[16], k1[16];
#pragma unroll
        for (int j = 0; j < 16; ++j) { k0[j] = (int)0x80000000; k1[j] = (int)0x80000000; }
#pragma unroll 1
        for (int slab = 0; slab < 4; ++slab) {
            h8 ld[8];
#pragma unroll
            for (int j = 0; j < 4; ++j) {
                const _Float16* src = wbase + (size_t)(16 * j + (lane >> 2)) * 256 + slab * 32 + (lane & 3) * 8;
                ld[j] = *(const h8*)src; ld[4 + j] = *(const h8*)(src + 128);
            }
            __builtin_amdgcn_wave_barrier();
#pragma unroll
            for (int j = 0; j < 4; ++j) {
                _Float16* dst = tile + (16 * j + (lane >> 2)) * 72 + (lane & 3) * 8;
                *(h8*)dst = ld[j]; *(h8*)(dst + 32) = ld[4 + j];
            }
            __builtin_amdgcn_fence(__ATOMIC_RELEASE, "wavefront");
            __builtin_amdgcn_wave_barrier();
            __builtin_amdgcn_fence(__ATOMIC_ACQUIRE, "wavefront");
#pragma unroll 2
            for (int ii = 0; ii < 32; ii += 8) {
                const int i = slab * 32 + ii;
                const h8 a = *(const h8*)(tile + lane * 72 + ii), b = *(const h8*)(tile + lane * 72 + 32 + ii);
#pragma unroll
                for (int e_ = 0; e_ < 8; ++e_) {
                    INSK(k0, (f2sort((float)a[e_]) & ~127) | (127 - i - e_));
                    INSK(k1, (f2sort((float)b[e_]) & ~127) | (127 - i - e_));
                }
            }
            __builtin_amdgcn_wave_barrier();
        }
        float v0[16], v1[16];
#pragma unroll
        for (int j = 0; j < 16; ++j) { k0[j] = 127 - (k0[j] & 127); k1[j] = 127 - (k1[j] & 127); v0[j] = (float)s0[k0[j]]; v1[j] = (float)s0[128 + k1[j]]; }
        unsigned long long ck[16];
#pragma unroll
        for (int j = 0; j < 16; ++j) ck[j] = 0ull;
#pragma unroll
        for (int a = 0; a < 16; ++a)
#pragma unroll
            for (int b = 0; b < 16; ++b)
                if ((a + 1) * (b + 1) <= 16) {
                    unsigned hi = (unsigned)f2sort(v0[a] + v1[b]) ^ 0x80000000u;
                    unsigned lo = ((unsigned)(255 - (a * 16 + b)) << 16) | (unsigned)(k0[a] * 128 + k1[b]);
                    INS64(ck, ((unsigned long long)hi << 32) | lo);
                }
        float e[16]; float sm = 0.f;
        const float mx = sort2f((int)((unsigned)(ck[0] >> 32) ^ 0x80000000u));
#pragma unroll
        for (int j = 0; j < 16; ++j) { e[j] = expf(sort2f((int)((unsigned)(ck[j] >> 32) ^ 0x80000000u)) - mx); sm += e[j]; }
        const float inv = 1.f / sm;
#pragma unroll
        for (int j = 0; j < 16; j += 4) {
            *(int4*)(RI + (size_t)t * 128 + h * 16 + j) = make_int4((int)(ck[j] & 0xffffu), (int)(ck[j + 1] & 0xffffu), (int)(ck[j + 2] & 0xffffu), (int)(ck[j + 3] & 0xffffu));
            *(float4*)(RG + (size_t)t * 128 + h * 16 + j) = make_float4(e[j] * inv, e[j + 1] * inv, e[j + 2] * inv, e[j + 3] * inv);
        }
    }
}

__device__ __forceinline__ void fp8x16_to_f32(const uint4 q, float (&f)[16]) {
    const unsigned w[4] = {q.x, q.y, q.z, q.w};
#pragma unroll
    for (int c = 0; c < 4; ++c) {
        auto f0 = __builtin_amdgcn_cvt_pk_f32_fp8((int)w[c], false); auto f1 = __builtin_amdgcn_cvt_pk_f32_fp8((int)w[c], true);
        f[4 * c] = f0[0]; f[4 * c + 1] = f0[1]; f[4 * c + 2] = f1[0]; f[4 * c + 3] = f1[1];
    }
}
template <int WHICH>
#ifndef PEER_REP
#define PEER_REP 1
#endif
__device__ void ph_peer_sliced(const Params& p, int l, char* smem_) {
    const int tid = TIDX(), wave = tid >> 6;
    const bf16_t* H = (const bf16_t*)(p.ws + WS_H); const unsigned char* PU = p.ws + WS_PU; const unsigned char* PV = p.ws + WS_PV;
    const int* RI = (const int*)(p.ws + WS_RI); float* RG = (float*)(p.ws + WS_RG); float* PP = (float*)(p.ws + WS_PP);
    const float* modb = (const float*)(p.ws + WS_MOD);
    for (int rep = 0; rep < PEER_REP; ++rep) {
    unsigned* ctr = (unsigned*)(p.ws + WS_CTL) + 3712 + (l * 2 + WHICH) * 128 + rep * 1024;
    volatile int* slot = (volatile int*)(smem_ + LDS_BYTES - 64);
    const int xcc = (int)(xb_xcc_id() & 7u);
    for (int so = 0; so < 8; ++so) {
        const int x = (xcc + so) & 7;
        for (;;) {
            if (tid == 0) *slot = (int)atomicAdd(ctr + x * 16, 1u);
            __syncthreads();
            const int chunk = __builtin_amdgcn_readfirstlane(*slot);
            __syncthreads();
            if (chunk >= 256) break;
            {
                const int lane = lane_id_opaque(), eg = lane >> 3, ll = lane & 7;
                const int tb = chunk * 64 + wave * 8;
                int* lri = (int*)smem_ + wave * 2048; float* lrg = (float*)(lri + 1024);
                {
                    int ra[16]; float rg_[16];
#pragma unroll
                    for (int i = 0; i < 8; ++i) {
                        ra[2 * i] = RI[(size_t)(tb + i) * 128 + lane]; ra[2 * i + 1] = RI[(size_t)(tb + i) * 128 + 64 + lane];
                        if (WHICH == 1) { rg_[2 * i] = RG[(size_t)(tb + i) * 128 + lane]; rg_[2 * i + 1] = RG[(size_t)(tb + i) * 128 + 64 + lane]; }
                    }
#pragma unroll
                    for (int i = 0; i < 8; ++i) {
                        lri[i * 128 + lane] = ra[2 * i]; lri[i * 128 + 64 + lane] = ra[2 * i + 1];
                        if (WHICH == 1) { lrg[i * 128 + lane] = rg_[2 * i]; lrg[i * 128 + 64 + lane] = rg_[2 * i + 1]; }
                    }
                }
                __builtin_amdgcn_fence(__ATOMIC_RELEASE, "wavefront");
                __builtin_amdgcn_wave_barrier();
                __builtin_amdgcn_fence(__ATOMIC_ACQUIRE, "wavefront");
                uint4 hq0 = make_uint4(0u, 0u, 0u, 0u), hq1 = hq0;
                if (WHICH == 0) { const uint4* hp = (const uint4*)(H + (size_t)tb * 1024 + x * 128 + ll * 16); hq0 = hp[0]; hq1 = hp[1]; }
#pragma unroll 1
                for (int i = 0; i < 8; ++i) {
                    const int t = tb + i;
                    if (WHICH == 0) {
                        float hv[16];
                        hv[0] = bflo(hq0.x); hv[1] = bfhi(hq0.x); hv[2] = bflo(hq0.y); hv[3] = bfhi(hq0.y); hv[4] = bflo(hq0.z); hv[5] = bfhi(hq0.z); hv[6] = bflo(hq0.w); hv[7] = bfhi(hq0.w);
                        hv[8] = bflo(hq1.x); hv[9] = bfhi(hq1.x); hv[10] = bflo(hq1.y); hv[11] = bfhi(hq1.y); hv[12] = bflo(hq1.z); hv[13] = bfhi(hq1.z); hv[14] = bflo(hq1.w); hv[15] = bfhi(hq1.w);
                        if (i < 7) { const uint4* hp = (const uint4*)(H + (size_t)(t + 1) * 1024 + x * 128 + ll * 16); hq0 = hp[0]; hq1 = hp[1]; }
                        uint4 uq[16];
#pragma unroll
                        for (int it = 0; it < 16; ++it) {
                            const int e = lri[i * 128 + it * 8 + eg];
                            uq[it] = *(const uint4*)(PU + ((size_t)x * 16384 + e) * 128 + ll * 16);
                        }
#pragma unroll
                        for (int b2 = 0; b2 < 2; ++b2) {
                            float part[8];
#pragma unroll
                            for (int it = 0; it < 8; ++it) {
                                float f[16]; fp8x16_to_f32(uq[b2 * 8 + it], f);
                                float d = 0.f;
#pragma unroll
                                for (int j = 0; j < 16; ++j) d += hv[j] * f[j];
                                part[it] = d;
                            }
                            float r4[4], r2[2];
                            const bool b2_ = lane & 4, b1_ = lane & 2, b0_ = lane & 1;
#pragma unroll
                            for (int j = 0; j < 4; ++j) { const float snd = b2_ ? part[j] : part[j + 4], kp = b2_ ? part[j + 4] : part[j]; r4[j] = kp + shx<4>(snd); }
#pragma unroll
                            for (int j = 0; j < 2; ++j) { const float snd = b1_ ? r4[j] : r4[j + 2], kp = b1_ ? r4[j + 2] : r4[j]; r2[j] = kp + shx<2>(snd); }
                            const float snd = b0_ ? r2[0] : r2[1], kp = b0_ ? r2[1] : r2[0];
                            const float d = kp + shx<1>(snd);
                            PP[((size_t)x * T_TOK + t) * 128 + b2 * 64 + ll * 8 + eg] = d;
                        }
                    } else {
                        float y[16];
#pragma unroll
                        for (int j = 0; j < 16; ++j) y[j] = 0.f;
#pragma unroll
                        for (int b2 = 0; b2 < 2; ++b2) {
                            uint4 vq[8];
#pragma unroll
                            for (int it = 0; it < 8; ++it) {
                                const int e = lri[i * 128 + b2 * 64 + it * 8 + eg];
                                vq[it] = *(const uint4*)(PV + ((size_t)x * 16384 + e) * 128 + ll * 16);
                            }
#pragma unroll
                            for (int it = 0; it < 8; ++it) {
                                const float ck = lrg[i * 128 + b2 * 64 + it * 8 + eg];
                                float f[16]; fp8x16_to_f32(vq[it], f);
#pragma unroll
                                for (int j = 0; j < 16; ++j) y[j] += ck * f[j];
                            }
                        }
                        float r8[8], r4[4], r2[2];
                        const bool b5 = lane & 32, b4 = lane & 16, b3 = lane & 8;
#pragma unroll
                        for (int j = 0; j < 8; ++j) { const float snd = b5 ? y[j] : y[j + 8], kp = b5 ? y[j + 8] : y[j]; r8[j] = kp + shx<32>(snd); }
#pragma unroll
                        for (int j = 0; j < 4; ++j) { const float snd = b4 ? r8[j] : r8[j + 4], kp = b4 ? r8[j + 4] : r8[j]; r4[j] = kp + shx<16>(snd); }
#pragma unroll
                        for (int j = 0; j < 2; ++j) { const float snd = b3 ? r4[j] : r4[j + 2], kp = b3 ? r4[j + 2] : r4[j]; r2[j] = kp + shx<8>(snd); }
                        const int col = x * 128 + ll * 16 + ((lane >> 5) & 1) * 8 + ((lane >> 4) & 1) * 4 + ((lane >> 3) & 1) * 2;
                        const float2 gf = *(const float2*)(modb + (size_t)(l * 8 + (t >> 11)) * 6144 + 5120 + col);
                        float2* op = (float2*)(p.out + (size_t)t * 1024 + col);
                        const float2 xi = *op;
                        if (rep > 0) op = (float2*)((float*)(p.ws + WS_OA) + (size_t)t * 1024 + col);
                        *op = make_float2(xi.x + gf.x * r2[0], xi.y + gf.y * r2[1]);
                    }
                }
            }
        }
    }
    __syncthreads();
    }
}
__device__ void ph_peer_coef(const Params& p, int vb0, int nvb) {
    const int wave = TIDX() >> 6, lane = TIDX() & 63;
    float* RG = (float*)(p.ws + WS_RG); const float* PP = (const float*)(p.ws + WS_PP);
    for (int t = vb0 * 8 + wave; t < T_TOK; t += nvb * 8) {
#pragma unroll
        for (int half = 0; half < 2; ++half) {
            const int k = half * 64 + lane;
            float d = 0.f;
#pragma unroll
            for (int x = 0; x < 8; ++x) d += PP[((size_t)x * T_TOK + t) * 128 + k];
            d *= (1.f / PU_SCALE);
            const float g = RG[(size_t)t * 128 + k];
            RG[(size_t)t * 128 + k] = g * 0.5f * d * (1.f + erff(d * 0.7071067811865476f)) * (1.f / PV_SCALE);
        }
    }
}

enum { PH_MOD = 0, PH_WPREP, PH_NORM1, PH_GEMM_IN, PH_SCAN, PH_DSAPREP, PH_DSA, PH_POST, PH_MERGE, PH_OUT, PH_NORM2, PH_GEMM_Q, PH_GEMM_SC, PH_ROUTE, PH_GATHER, PH_GATHER_DUMMY, PH_DSASEL, PH_G1, PH_G15, PH_G2, PH_G1R, PH_G2R };

template <int PH>
__device__ __forceinline__ void run_phase(const Params& p, int l, int vb0, int nvb, char* smem) {
    const float* xin = (l == 0) ? p.x : p.out;
    if (PH == PH_MOD) ph_mod(p, vb0, nvb, smem);
    else if (PH == PH_WPREP) ph_wprep(p, l, vb0, nvb, smem);
    else if (PH == PH_NORM1) ph_norm(p, l, 0, xin, vb0, nvb);
    else if (PH == PH_GEMM_IN) {
        pg8::Gemm g{(const bf16_t*)(p.ws + WS_H), (const bf16_t*)(p.ws + WS_WIN), 1024, 1024, 1024};
        pg8::StaticOrder S; S.init(T_TOK, LDZ, nvb, vb0, 1024, 1024);
        pg8::gemm_phase(( PG8_LAS unsigned char*)smem, g, S, pg8::EpiBf16{(bf16_t*)(p.ws + WS_Z), LDZ}, TIDX());
    }
    else if (PH == PH_SCAN) ph_mixA(p, l, vb0, nvb, smem);
    else if (PH == PH_DSAPREP) { }
    else if (PH == PH_DSA) { }
    else if (PH == PH_POST) { }
    else if (PH == PH_MERGE) {
        pg8::Gemm g{(const bf16_t*)(p.ws + WS_Y), (const bf16_t*)(p.ws + WS_WBR), 1536, 512, 512};
        pg8::MergeOrder S{vb0, nvb};
        pg8::gemm_phase((PG8_LAS unsigned char*)smem, g, S, pg8::EpiMerge{(bf16_t*)(p.ws + WS_H), (const bf16_t*)(p.ws + WS_Z)}, TIDX());
    }
    else if (PH == PH_OUT) {
        pg8::Gemm g{(const bf16_t*)(p.ws + WS_H), (const bf16_t*)(p.ws + WS_WOUT), 1024, 1024, 1024};
        pg8::StaticOrder S; S.init(T_TOK, 1024, nvb, vb0, 1024, 1024);
        pg8::gemm_phase((PG8_LAS unsigned char*)smem, g, S, pg8::EpiResid{xin, p.out, (const float*)(p.ws + WS_MOD) + (size_t)l * 8 * 6144}, TIDX());
    }
    else if (PH == PH_NORM2) ph_norm(p, l, 1, p.out, vb0, nvb);
    else if (PH == PH_GEMM_Q) {
        pg8::Gemm g{(const bf16_t*)(p.ws + WS_H), (const bf16_t*)(p.ws + WS_WQ), 1024, 1024, 1024};
        pg8::StaticOrder S; S.init(T_TOK, 2048, nvb, vb0, 1024, 1024);
        pg8::gemm_phase((PG8_LAS unsigned char*)smem, g, S, pg8::EpiBf16{(bf16_t*)(p.ws + WS_QP), 2048}, TIDX());
    }
    else if (PH == PH_GEMM_SC) gemm_phase((const bf16_t*)(p.ws + WS_QP), 2048, (const bf16_t*)(p.ws + WS_SK), 128, T_TOK, 2048, 128, true,
                                          EpiF16{(_Float16*)(p.ws + WS_SC), 2048}, vb0, nvb, smem, TIDX());
    else if (PH == PH_ROUTE) ph_route(p, vb0, nvb, smem);
    else if (PH == PH_GATHER || PH == PH_GATHER_DUMMY) { }
    else if (PH == PH_DSASEL) { }
    else if (PH == PH_G1) ph_peer_sliced<0>(p, l, smem);
    else if (PH == PH_G15) ph_peer_coef(p, vb0, nvb);
    else if (PH == PH_G2) ph_peer_sliced<1>(p, l, smem);

}

template <int PH>
__global__ void __launch_bounds__(NT) k_phase(Params p, int l) {
    extern __shared__ __attribute__((aligned(16))) char smem[];
    p.wv = __builtin_amdgcn_readfirstlane((int)threadIdx.x >> 6);
    run_phase<PH>(p, l, (int)blockIdx.x, (int)gridDim.x, smem);
}


#define XB_TMO      128
#define XB_XCNT(j)  (256  + 64 * (j))
#define XB_XSUB(j)  (1280 + 64 * (j))
#define XB_XGEN(j)  (2304 + 64 * (j))
#define XB_TOP      3328
#define XB_TOPGEN   3392
#define XCD_BAR_WORDS 3456
#define XB_SPIN_CAP (1u << 18)
#define LAS __attribute__((address_space(3)))
__device__ __forceinline__ unsigned xb_ld(unsigned* p)              { return __hip_atomic_load(p, __ATOMIC_RELAXED, __HIP_MEMORY_SCOPE_AGENT); }
__device__ __forceinline__ unsigned xb_add(unsigned* p, unsigned v) { return __hip_atomic_fetch_add(p, v, __ATOMIC_RELAXED, __HIP_MEMORY_SCOPE_AGENT); }
#define XB_SPIN(cond, bar) do { unsigned _sp = 0; while (cond) { __builtin_amdgcn_s_sleep(1); \
    if ((++_sp & 255u) == 0u) { if (xb_ld(&(bar)[XB_TMO])) break; if (_sp > XB_SPIN_CAP) { atomicAdd(&(bar)[XB_TMO], 1u); break; } } } } while (0)
struct XcdBarrier { unsigned* bar; unsigned x; volatile LAS unsigned* st; int wv; };
__device__ __forceinline__ XcdBarrier xcd_barrier_post(unsigned* bar, volatile LAS unsigned* st, int wv) {
    XcdBarrier b; b.bar = bar; b.x = xb_xcc_id(); b.st = st; b.wv = wv;
    if (TIDXW(wv) == 0) (void)xb_add(&bar[XB_XCNT(b.x)], 1u);
    return b;
}
__device__ __forceinline__ void xcd_barrier_complete(unsigned* bar, unsigned x, unsigned& nloc, unsigned& nx) {
    const unsigned G = gridDim.x * gridDim.y * gridDim.z;
    unsigned sum, cnt, mine, sp = 0u;
    for (;;) {
        sum = 0u; cnt = 0u; mine = 0u;
#pragma unroll
        for (unsigned j = 0; j < 16; ++j) { const unsigned c = xb_ld(&bar[XB_XCNT(j)]); sum += c; cnt += (c > 0u) ? 1u : 0u; mine = (j == x) ? c : mine; }
        if (sum == G) break;
        __builtin_amdgcn_s_sleep(1);
        if ((++sp & 255u) == 0u) { if (xb_ld(&bar[XB_TMO])) break; if (sp > XB_SPIN_CAP) { atomicAdd(&bar[XB_TMO], 1u); break; } }
    }
    nloc = mine > 0u ? mine : 1u; nx = cnt > 0u ? cnt : 1u;
}
__device__ __forceinline__ void xcd_barrier(const XcdBarrier& b) {
    asm volatile("s_waitcnt vmcnt(0)" ::: "memory");
    __syncthreads();
    if (TIDXW(b.wv) == 0) {
        unsigned* bar = b.bar;
        __builtin_amdgcn_s_waitcnt(0);
        unsigned nloc = b.st[0], nx = b.st[1];
        if (nloc == 0u) { xcd_barrier_complete(bar, b.x, nloc, nx); b.st[0] = nloc; b.st[1] = nx; }
        const unsigned old = xb_add(&bar[XB_XSUB(b.x)], 1u);
        const unsigned gen = old / nloc;
        if (old + 1u == (gen + 1u) * nloc) {
            __builtin_amdgcn_fence(__ATOMIC_RELEASE, "agent");
            asm volatile("s_waitcnt vmcnt(0)" ::: "memory");
            const unsigned og = xb_add(&bar[XB_TOP], 1u);
            const unsigned tg = og / nx;
            if (og + 1u == (tg + 1u) * nx) xb_add(&bar[XB_TOPGEN], 1u);
            else XB_SPIN(xb_ld(&bar[XB_TOPGEN]) == tg, bar);
            __builtin_amdgcn_fence(__ATOMIC_ACQUIRE, "agent");
            xb_add(&bar[XB_XGEN(b.x)], 1u);
            asm volatile("s_waitcnt vmcnt(0)" ::: "memory");
        } else {
            XB_SPIN(xb_ld(&bar[XB_XGEN(b.x)]) == gen, bar);
            __builtin_amdgcn_fence(__ATOMIC_ACQUIRE, "agent");
            asm volatile("s_waitcnt vmcnt(0)" ::: "memory");
        }
    }
    __syncthreads();
}

__global__ void __launch_bounds__(NT) mega_kernel(Params p_in) {
#if defined(__HIP_DEVICE_COMPILE__)
    extern __shared__ __attribute__((aligned(16))) char smem[];
    volatile LAS unsigned* st = (volatile LAS unsigned*)(smem + LDS_BYTES - 16);
    int wv_ = __builtin_amdgcn_readfirstlane((int)threadIdx.x >> 6); asm volatile("" : "+s"(wv_));
    { const int t_ = TIDXW(wv_); if (t_ < 4) st[t_] = 0u; }
    __syncthreads();
    XcdBarrier bar = xcd_barrier_post((unsigned*)(p_in.ws + WS_CTL), st, wv_);
    const int vb = (int)blockIdx.x, nvb = (int)gridDim.x;
#ifndef PROBE_PH
#define PROBE_PH -1
#endif
#define GB() xcd_barrier(bar)
#define RUN(PH, L) do { for (int _r = 0; _r < ((PROBE_PH == PH && PH != PH_DSAPREP) ? 2 : 1); ++_r) { \
        const __attribute__((address_space(4))) Params* _kp = (const __attribute__((address_space(4))) Params*)__builtin_amdgcn_kernarg_segment_ptr(); asm volatile("" : "+s"(_kp)); Params _p = *_kp; _p.wv = wv_; \
        int _l = (L), _vb = vb, _nvb = nvb; asm volatile("" : "+s"(_l), "+s"(_vb), "+s"(_nvb)); \
        run_phase<(PROBE_PH == PH_GATHER_DUMMY && PH == PH_GATHER && 0) ? PH_GATHER_DUMMY : PH>(_p, _l, _vb, _nvb, smem); if (PROBE_PH == PH) __syncthreads(); } } while (0)
    RUN(PH_MOD, 0);
#pragma unroll 1
    for (int l = 0; l < 2; ++l) {
        RUN(PH_WPREP, l); if (l == 0) GB();
        RUN(PH_NORM1, l); GB();
        RUN(PH_GEMM_IN, l); GB();
        RUN(PH_SCAN, l);
        RUN(PH_DSAPREP, l);
        GB();
        RUN(PH_MERGE, l); GB();
        RUN(PH_OUT, l); GB();
        RUN(PH_NORM2, l); GB();
        RUN(PH_GEMM_Q, l); GB();
        RUN(PH_GEMM_SC, l); GB();
        RUN(PH_ROUTE, l); GB();
        RUN(PH_G1, l); GB();
        RUN(PH_G15, l); GB();
        RUN(PH_G2, l);
        if (l == 0) GB();
    }
#undef RUN
#undef GB
#endif
}

extern "C" void kernel_launch(void* const* d_in, const int* in_sizes, int n_in, void* d_out, int out_size, void* d_ws, size_t ws_size,
                              hipStream_t stream) {
    if (n_in != 20 || ws_size < WS_END) { fprintf(stderr, "kernel_launch: bad inputs (n_in %d ws %zu need %zu)\n", n_in, ws_size, (size_t)WS_END); return; }
    Params p{};
    p.x = (const float*)d_in[0]; p.c = (const float*)d_in[1]; p.w_ada = (const float*)d_in[2]; p.b_ada = (const float*)d_in[3];
    p.norm_mix = (const float*)d_in[4]; p.norm_ffn = (const float*)d_in[5]; p.w_in = (const float*)d_in[6]; p.hgrn_lb = (const float*)d_in[7];
    p.hgrn_on = (const float*)d_in[8]; p.dsa_qn = (const float*)d_in[9]; p.dsa_kn = (const float*)d_in[10]; p.gla_up = (const float*)d_in[11];
    p.gla_bias = (const float*)d_in[12]; p.gla_on = (const float*)d_in[13]; p.w_branch = (const float*)d_in[14]; p.w_out = (const float*)d_in[15];
    p.peer_wq = (const float*)d_in[16]; p.peer_keys = (const float*)d_in[17]; p.peer_u = (const float*)d_in[18]; p.peer_v = (const float*)d_in[19];
    p.out = (float*)d_out; p.ws = (unsigned char*)d_ws;
#if MEGA
    static int grid = 0;
    if (grid == 0) {
        int dev = 0, cus = 0, per_cu = 0;
        hipGetDevice(&dev);
        hipDeviceGetAttribute(&cus, hipDeviceAttributeMultiprocessorCount, dev);
        hipFuncSetAttribute((const void*)mega_kernel, hipFuncAttributeMaxDynamicSharedMemorySize, LDS_BYTES);
        hipOccupancyMaxActiveBlocksPerMultiprocessor(&per_cu, (const void*)mega_kernel, NT, LDS_BYTES);
        if (per_cu < 1) { fprintf(stderr, "kernel_launch: occupancy query says %d blocks per CU\n", per_cu); per_cu = 1; }
        (void)hipGetLastError();
        grid = cus;
    }
    hipMemsetAsync((char*)d_ws + WS_CTL, 0, 32768, stream);
    void* args[] = {&p};
    hipError_t e = hipLaunchCooperativeKernel((const void*)mega_kernel, dim3(grid), dim3(NT), args, LDS_BYTES, stream);
    if (e != hipSuccess) fprintf(stderr, "cooperative launch failed: %s (grid %d)\n", hipGetErrorString(e), grid);
#else
    const int G = 256;
#define LAUNCH(PH, l) hipLaunchKernelGGL(k_phase<PH>, dim3(G), dim3(NT), LDS_BYTES, stream, p, l)
    LAUNCH(PH_MOD, 0);
    for (int l = 0; l < 2; ++l) {
        LAUNCH(PH_WPREP, l);
        LAUNCH(PH_NORM1, l);
        LAUNCH(PH_GEMM_IN, l);
        LAUNCH(PH_SCAN, l);
        LAUNCH(PH_DSAPREP, l);
        LAUNCH(PH_DSA, l);
        LAUNCH(PH_POST, l);
        LAUNCH(PH_MERGE, l);
        LAUNCH(PH_OUT, l);
        LAUNCH(PH_NORM2, l);
        LAUNCH(PH_GEMM_Q, l);
        LAUNCH(PH_GEMM_SC, l);
        LAUNCH(PH_ROUTE, l);
        LAUNCH(PH_GATHER, l);
    }
#endif
}
```

```cpp
#include <hip/hip_runtime.h>
#include <stdint.h>
#include <stdio.h>

typedef unsigned short bf16_t;
typedef short bf16x8 __attribute__((ext_vector_type(8)));
typedef float f32x4 __attribute__((ext_vector_type(4)));
typedef unsigned u32x4 __attribute__((ext_vector_type(4)));

#define NT 512
constexpr int T_TOK = 16384, DM = 1024, SEQ = 2048;
constexpr int LDZ = 8704;
constexpr int ZA_Q = 0, ZA_F = 512, ZA_I = 1024, ZA_G = 1536, ZB_Q = 2048, ZB_K = 2560, ZB_V = 3072, ZC_V = 3584, ZC_G = 4096,
              ZB_QI = 4608, ZC_Q = 4864, ZC_K = 5120, ZB_KI = 5376, ZB_WI = 5440, ZC_CODE = 5444, ZM = 5632;
constexpr int IN_COLS = 8532;

constexpr size_t al256(size_t x) { return (x + 255) & ~(size_t)255; }
constexpr size_t WS_CTL = 0;
constexpr size_t WS_MOD = 65536;
constexpr size_t WS_WIN = al256(WS_MOD + (size_t)2 * 8 * 6144 * 4);
constexpr size_t WS_WBR = al256(WS_WIN + (size_t)LDZ * 1024 * 2);
constexpr size_t WS_WOUT = al256(WS_WBR + (size_t)3 * 1024 * 512 * 2);
constexpr size_t WS_WQ = al256(WS_WOUT + (size_t)1024 * 1024 * 2);
constexpr size_t WS_SK = al256(WS_WQ + (size_t)2048 * 1024 * 2);
constexpr size_t WS_PU = al256(WS_SK + (size_t)16 * 128 * 128 * 2);
constexpr size_t WS_PV = al256(WS_PU + (size_t)16384 * 1024);
constexpr size_t WS_H = al256(WS_PV + (size_t)16384 * 1024);
constexpr float PU_SCALE = 32.f, PV_SCALE = 4.f;
constexpr size_t WS_OA = al256(WS_H + (size_t)T_TOK * 1024 * 2);
constexpr size_t WS_OC = al256(WS_OA + (size_t)T_TOK * 512 * 2);
constexpr size_t WS_Y = al256(WS_OC + (size_t)T_TOK * 512 * 2);
constexpr size_t WS_Z = al256(WS_Y + (size_t)T_TOK * 1536 * 2);
constexpr size_t WS_VT = al256(WS_Z + (size_t)T_TOK * LDZ * 2);
constexpr size_t WS_BM = al256(WS_VT + (size_t)T_TOK * 512 * 2);
constexpr size_t WS_END = al256(WS_BM + (size_t)T_TOK * 64 * 4);
constexpr size_t WS_QP = WS_Z;
constexpr size_t WS_SC = al256(WS_QP + (size_t)T_TOK * 2048 * 2);
constexpr size_t WS_RI = al256(WS_SC + (size_t)T_TOK * 2048 * 4);
constexpr size_t WS_RG = al256(WS_RI + (size_t)T_TOK * 128 * 4);
constexpr size_t WS_PP = al256(WS_RG + (size_t)T_TOK * 128 * 4);
static_assert(WS_PP + (size_t)8 * T_TOK * 128 * 4 <= WS_VT, "peer partials overflow the Z region");
static_assert(WS_RG + (size_t)T_TOK * 128 * 4 <= WS_END, "peer alias overflow");

struct Params {
    const float* x; const float* c; const float* w_ada; const float* b_ada; const float* norm_mix; const float* norm_ffn;
    const float* w_in; const float* hgrn_lb; const float* hgrn_on; const float* dsa_qn; const float* dsa_kn;
    const float* gla_up; const float* gla_bias; const float* gla_on; const float* w_branch; const float* w_out;
    const float* peer_wq; const float* peer_keys; const float* peer_u; const float* peer_v;
    float* out; unsigned char* ws;
    int wv, pad;
};

__device__ __forceinline__ float bf2f(bf16_t h) { return __uint_as_float(((unsigned)h) << 16); }
__device__ __forceinline__ float bflo(unsigned u) { return __uint_as_float(u << 16); }
__device__ __forceinline__ float bfhi(unsigned u) { return __uint_as_float(u & 0xffff0000u); }
__device__ __forceinline__ bf16_t f2bf(float f) { unsigned r; asm volatile("v_cvt_pk_bf16_f32 %0, %1, %1" : "=v"(r) : "v"(f)); return (bf16_t)(r & 0xffffu); }
__device__ __forceinline__ unsigned pack2(float a, float b) { unsigned r; asm volatile("v_cvt_pk_bf16_f32 %0, %1, %2" : "=v"(r) : "v"(a), "v"(b)); return r; }
__device__ __forceinline__ int lane_id_opaque() { int l; asm volatile("v_mbcnt_lo_u32_b32 %0, -1, 0\n\tv_mbcnt_hi_u32_b32 %0, -1, %0" : "=v"(l)); return l; }
template <int M> __device__ __forceinline__ int shx_i(int v) {
    if (M < 32) return __builtin_amdgcn_ds_swizzle(v, (M << 10) | 0x1f);
    return __builtin_amdgcn_ds_bpermute((lane_id_opaque() ^ 32) << 2, v);
}
template <int M> __device__ __forceinline__ float shx(float v) { return __int_as_float(shx_i<M>(__float_as_int(v))); }
template <int M> __device__ __forceinline__ int shx(int v) { return shx_i<M>(v); }
template <int M> __device__ __forceinline__ unsigned shx(unsigned v) { return (unsigned)shx_i<M>((int)v); }
__device__ __forceinline__ int bperm(int v, int src) { return __builtin_amdgcn_ds_bpermute(src << 2, v); }
__device__ __forceinline__ float bperm(float v, int src) { return __int_as_float(__builtin_amdgcn_ds_bpermute(src << 2, __float_as_int(v))); }
__device__ __forceinline__ float wave_sum(float v) { v += shx<32>(v); v += shx<16>(v); v += shx<8>(v); v += shx<4>(v); v += shx<2>(v); v += shx<1>(v); return v; }
__device__ __forceinline__ float wave_max(float v) { v = fmaxf(v, shx<32>(v)); v = fmaxf(v, shx<16>(v)); v = fmaxf(v, shx<8>(v)); v = fmaxf(v, shx<4>(v)); v = fmaxf(v, shx<2>(v)); v = fmaxf(v, shx<1>(v)); return v; }
__device__ __forceinline__ int wave_sum_i(int v) { v += shx<32>(v); v += shx<16>(v); v += shx<8>(v); v += shx<4>(v); v += shx<2>(v); v += shx<1>(v); return v; }
__device__ __forceinline__ int wave_total_i(int v) {
    v += __builtin_amdgcn_update_dpp(0, v, 0x111, 0xf, 0xf, true);
    v += __builtin_amdgcn_update_dpp(0, v, 0x112, 0xf, 0xf, true);
    v += __builtin_amdgcn_update_dpp(0, v, 0x114, 0xf, 0xf, true);
    v += __builtin_amdgcn_update_dpp(0, v, 0x118, 0xf, 0xf, true);
    v += __builtin_amdgcn_update_dpp(0, v, 0x142, 0xa, 0xf, true);
    v += __builtin_amdgcn_update_dpp(0, v, 0x143, 0xc, 0xf, true);
    return __builtin_amdgcn_readlane(v, 63);
}
__device__ __forceinline__ float sigm(float x) { return __frcp_rn(1.f + __expf(-x)); }

__device__ __forceinline__ unsigned xb_xcc_id() { return (unsigned)__builtin_amdgcn_s_getreg((3 << 11) | 20) & 0xFu; }
__device__ __forceinline__ int TIDXW(int wv) { int t; asm volatile("v_mbcnt_lo_u32_b32 %0, -1, 0\n\tv_mbcnt_hi_u32_b32 %0, -1, %0\n\tv_lshl_or_b32 %0, %1, 6, %0" : "=v"(t) : "s"(wv)); return t; }
#define TIDX() TIDXW(p.wv)

__device__ __forceinline__ int src_col(int j) {
    if (j < 3584) return j;
    if (j < 4096) return j - 3584 + 4420;
    if (j < 4608) return j - 4096 + 4948;
    if (j < 4864) return j - 4608 + 3584;
    if (j < 5120) return j - 4864 + 3908;
    if (j < 5376) return j - 5120 + 4164;
    if (j < 5440) return j - 5376 + 3840;
    if (j < 5444) return j - 5440 + 3904;
    if (j < 5460) return j - 5444 + 4932;
    if (j < 5632) return -1;
    return j - 5632 + 5460;
}

__device__ void ph_mod(const Params& p, int vb0, int nvb, char* smem_) {
    float* sc = (float*)smem_;
    float* part = sc + 8 * 1024;
    float* mod = (float*)(p.ws + WS_MOD);
    const int tid = TIDX(), lane = tid & 63, wave = tid >> 6;
    if (vb0 >= 192) return;
    for (int i = tid; i < 8 * 1024; i += NT) { float c = p.c[i]; sc[i] = c / (1.f + __expf(-c)); }
    __syncthreads();
    for (int task = vb0; task < 192; task += nvb) {
        const int l = task / 96, n0 = (task % 96) * 64;
        const float* w = p.w_ada + (size_t)l * 1024 * 6144 + (size_t)(wave * 128) * 6144 + n0 + lane;
        float acc[8];
#pragma unroll
        for (int b = 0; b < 8; ++b) acc[b] = 0.f;
#pragma unroll 1
        for (int k0 = 0; k0 < 128; k0 += 16) {
            float wv[16];
#pragma unroll
            for (int j = 0; j < 16; ++j) wv[j] = w[(size_t)(k0 + j) * 6144];
#pragma unroll
            for (int j = 0; j < 16; ++j)
#pragma unroll
                for (int b = 0; b < 8; ++b) acc[b] += sc[b * 1024 + wave * 128 + k0 + j] * wv[j];
        }
#pragma unroll
        for (int b = 0; b < 8; ++b) part[(wave * 8 + b) * 64 + lane] = acc[b];
        __syncthreads();
        {
            const int b = tid >> 6, col = tid & 63;
            float v = p.b_ada[l * 6144 + n0 + col];
#pragma unroll
            for (int w_ = 0; w_ < 8; ++w_) v += part[(w_ * 8 + b) * 64 + col];
            mod[(size_t)(l * 8 + b) * 6144 + n0 + col] = v;
        }
        __syncthreads();
    }
}

template <bool MAP>
__device__ void tr_tile(const float* __restrict__ src, int lds_, bf16_t* __restrict__ out, int ldo, int k0, int n0, float* tile, const int tid) {
#pragma unroll
    for (int i = 0; i < 8; ++i) {
        int kk = (tid >> 6) + 8 * i, nn = tid & 63;
        int scol = MAP ? src_col(n0 + nn) : (n0 + nn);
        float v = (scol >= 0) ? src[(size_t)(k0 + kk) * lds_ + scol] : 0.f;
        tile[kk * 65 + nn] = v;
    }
    __syncthreads();
#pragma unroll
    for (int i = 0; i < 4; ++i) {
        int nn = (tid >> 5) + 16 * i, kk = (tid & 31) * 2;
        unsigned v = pack2(tile[kk * 65 + nn], tile[(kk + 1) * 65 + nn]);
        *(unsigned*)(out + (size_t)(n0 + nn) * ldo + k0 + kk) = v;
    }
    __syncthreads();
}
__device__ void conv_chunk(const float* __restrict__ src, bf16_t* __restrict__ dst, size_t base, const int tid) {
#pragma unroll
    for (int i = 0; i < 4; ++i) {
        size_t e = base + (size_t)(i * NT + tid) * 8;
        float4 a = *(const float4*)(src + e), b = *(const float4*)(src + e + 4);
        uint4 o; o.x = pack2(a.x, a.y); o.y = pack2(a.z, a.w); o.z = pack2(b.x, b.y); o.w = pack2(b.z, b.w);
        *(uint4*)(dst + e) = o;
    }
}
__device__ void conv_chunk_fp8(const float* __restrict__ src, unsigned char* __restrict__ dst, size_t base, float scale, const int tid) {
#pragma unroll
    for (int i = 0; i < 4; ++i) {
        size_t e = base + (size_t)(i * NT + tid) * 8;
        float4 a = *(const float4*)(src + e), b = *(const float4*)(src + e + 4);
        int lo = __builtin_amdgcn_cvt_pk_fp8_f32(a.x * scale, a.y * scale, 0, false); lo = __builtin_amdgcn_cvt_pk_fp8_f32(a.z * scale, a.w * scale, lo, true);
        int hi = __builtin_amdgcn_cvt_pk_fp8_f32(b.x * scale, b.y * scale, 0, false); hi = __builtin_amdgcn_cvt_pk_fp8_f32(b.z * scale, b.w * scale, hi, true);
        const size_t row = e >> 10, col = e & 1023;
        *(uint2*)(dst + ((col >> 7) * 16384 + row) * 128 + (col & 127)) = make_uint2((unsigned)lo, (unsigned)hi);
    }
}
__device__ void ph_wprep(const Params& p, int l, int vb0, int nvb, char* smem_) {
    float* tile = (float*)smem_;
    const int tid = TIDX();
    bf16_t* WIN = (bf16_t*)(p.ws + WS_WIN); bf16_t* WBR = (bf16_t*)(p.ws + WS_WBR); bf16_t* WOUT = (bf16_t*)(p.ws + WS_WOUT);
    bf16_t* WQ = (bf16_t*)(p.ws + WS_WQ); bf16_t* SK = (bf16_t*)(p.ws + WS_SK); unsigned char* PU = p.ws + WS_PU; unsigned char* PV = p.ws + WS_PV;
    constexpr int N_WIN = 136 * 16, N_WBR = 3 * 16 * 8, N_WOUT = 16 * 16, N_WQ = 32 * 16, N_SK = 16, N_PU = 1024, N_PV = 1024;
    constexpr int TOTAL = N_WIN + N_WBR + N_WOUT + N_WQ + N_SK + N_PU + N_PV;
    for (int task = vb0; task < TOTAL; task += nvb) {
        int r = task;
        if (r < N_WIN) { int nt = r / 16, kt = r % 16; tr_tile<true>(p.w_in + (size_t)l * 1024 * IN_COLS, IN_COLS, WIN, 1024, kt * 64, nt * 64, tile, tid); continue; }
        r -= N_WIN;
        if (r < N_WBR) { int g = r / 128, rr = r % 128, nt = rr / 8, kt = rr % 8;
            tr_tile<false>(p.w_branch + (size_t)(l * 3 + g) * 512 * 1024, 1024, WBR + (size_t)g * 1024 * 512, 512, kt * 64, nt * 64, tile, tid); continue; }
        r -= N_WBR;
        if (r < N_WOUT) { int nt = r / 16, kt = r % 16; tr_tile<false>(p.w_out + (size_t)l * 1024 * 1024, 1024, WOUT, 1024, kt * 64, nt * 64, tile, tid); continue; }
        r -= N_WOUT;
        if (r < N_WQ) { int nt = r / 16, kt = r % 16; tr_tile<false>(p.peer_wq + (size_t)l * 1024 * 2048, 2048, WQ, 1024, kt * 64, nt * 64, tile, tid); continue; }
        r -= N_WQ;
        if (r < N_SK) { conv_chunk(p.peer_keys + (size_t)l * 16 * 128 * 128, SK, (size_t)r * 16384, tid); continue; }
        r -= N_SK;
        if (r < N_PU) { conv_chunk_fp8(p.peer_u + (size_t)l * 16384 * 1024, PU, (size_t)r * 16384, PU_SCALE, tid); continue; }
        r -= N_PU;
        conv_chunk_fp8(p.peer_v + (size_t)l * 16384 * 1024, PV, (size_t)r * 16384, PV_SCALE, tid);
    }
}

__device__ void ph_norm(const Params& p, int l, int which, const float* xin, int vb0, int nvb) {
    const int wave = TIDX() >> 6, lane = TIDX() & 63;
    const float* gain = (which ? p.norm_ffn : p.norm_mix) + l * 1024;
    const float* modb = (const float*)(p.ws + WS_MOD);
    bf16_t* H = (bf16_t*)(p.ws + WS_H);
    for (int t = vb0 * 8 + wave; t < T_TOK; t += nvb * 8) {
        int b = t >> 11;
        const float* mod = modb + (size_t)(l * 8 + b) * 6144 + (which ? 3072 : 0);
        const float4* xr = (const float4*)(xin + (size_t)t * 1024);
        float4 v[4]; float ss = 0.f;
#pragma unroll
        for (int i = 0; i < 4; ++i) { v[i] = xr[lane + 64 * i]; ss += v[i].x * v[i].x + v[i].y * v[i].y + v[i].z * v[i].z + v[i].w * v[i].w; }
        ss = wave_sum(ss);
        float rstd = rsqrtf(ss * (1.f / 1024.f) + 1e-6f);
#pragma unroll
        for (int i = 0; i < 4; ++i) {
            int idx = (lane + 64 * i) * 4;
            float4 g = *(const float4*)(gain + idx), sc = *(const float4*)(mod + 1024 + idx), sh = *(const float4*)(mod + idx);
            float h0 = v[i].x * rstd * g.x * (1.f + sc.x) + sh.x, h1 = v[i].y * rstd * g.y * (1.f + sc.y) + sh.y;
            float h2 = v[i].z * rstd * g.z * (1.f + sc.z) + sh.z, h3 = v[i].w * rstd * g.w * (1.f + sc.w) + sh.w;
            uint2 o; o.x = pack2(h0, h1); o.y = pack2(h2, h3);
            *(uint2*)(H + (size_t)t * 1024 + idx) = o;
        }
    }
}

constexpr int GBM = 256, GBN = 128, GBK = 64, GLS = 72;
__device__ __forceinline__ void gemm_tile(const bf16_t* __restrict__ A, int lda, const bf16_t* __restrict__ Bt, int ldb, int K,
                                          int m0, int n0, bf16_t* sA, bf16_t* sB, f32x4 (&acc)[4][4], const int tid) {
    const int lane = tid & 63, wave = tid >> 6;
    const int wm = wave >> 1, wn = wave & 1, fr = lane & 15, fq = lane >> 4;
    u32x4 ra[4], rb[2];
    const int crow = tid >> 3, ckc = (tid & 7) * 8;
    const bf16_t* Ag = A + (size_t)(m0 + crow) * lda + ckc;
    const bf16_t* Bg = Bt + (size_t)(n0 + crow) * ldb + ckc;
#pragma unroll
    for (int i = 0; i < 4; ++i) ra[i] = *(const u32x4*)(Ag + (size_t)(64 * i) * lda);
#pragma unroll
    for (int i = 0; i < 2; ++i) rb[i] = *(const u32x4*)(Bg + (size_t)(64 * i) * ldb);
    for (int k0 = 0; k0 < K; k0 += GBK) {
        __syncthreads();
#pragma unroll
        for (int i = 0; i < 4; ++i) *(u32x4*)(sA + (crow + 64 * i) * GLS + ckc) = ra[i];
#pragma unroll
        for (int i = 0; i < 2; ++i) *(u32x4*)(sB + (crow + 64 * i) * GLS + ckc) = rb[i];
        __syncthreads();
        {
            const int kn = (k0 + GBK < K) ? (k0 + GBK) : k0;
#pragma unroll
            for (int i = 0; i < 4; ++i) ra[i] = *(const u32x4*)(Ag + (size_t)(64 * i) * lda + kn);
#pragma unroll
            for (int i = 0; i < 2; ++i) rb[i] = *(const u32x4*)(Bg + (size_t)(64 * i) * ldb + kn);
        }
#pragma unroll
        for (int ks = 0; ks < 2; ++ks) {
            bf16x8 af[4], wf[4];
#pragma unroll
            for (int mf = 0; mf < 4; ++mf) af[mf] = *(const bf16x8*)(sA + (wm * 64 + mf * 16 + fr) * GLS + ks * 32 + fq * 8);
#pragma unroll
            for (int nf = 0; nf < 4; ++nf) wf[nf] = *(const bf16x8*)(sB + (wn * 64 + nf * 16 + fr) * GLS + ks * 32 + fq * 8);
#pragma unroll
            for (int nf = 0; nf < 4; ++nf)
#pragma unroll
                for (int mf = 0; mf < 4; ++mf)
                    acc[nf][mf] = __builtin_amdgcn_mfma_f32_16x16x32_bf16(wf[nf], af[mf], acc[nf][mf], 0, 0, 0);
        }
    }
}


namespace pg8 {
#define PG8_LAS __attribute__((address_space(3)))
constexpr int BM = 256, BK = 64, HALF = 128, HTB = HALF * BK * 2, STAGE_BYTES = 8 * HTB, NXCD = 8, WGM = 8;
__device__ __forceinline__ int lds_byte(int r, int c) { const int st = (r >> 4) * 2 + (c >> 5), rr = r & 15, cc = c & 31, ob = rr * 64 + cc * 2; return st * 1024 + (ob ^ (((ob >> 9) & 1) << 5)); }
__device__ __forceinline__ void stage_rc(int b, int& R, int& C) { const int st = b / 1024, sb = b % 1024, swz = sb ^ (((sb >> 9) & 1) << 5); R = (st >> 1) * 16 + swz / 64; C = (st & 1) * 32 + (swz % 64) / 2; }
__device__ __forceinline__ int perm32(int rho) { const int n = rho >> 4, i = rho & 15; return 8 * (i >> 2) + 4 * n + (i & 3); }
struct Unit { int pm, pn, aux; size_t aoff, boff; };
struct Gemm { const bf16_t* A; const bf16_t* Bt; int lda, ldb, K; };

struct StaticOrder {
    int nM, nN, nwg, G, c, lda, ldb;
    __device__ void init(int M, int N, int G_, int c_, int lda_, int ldb_) { nM = M / BM; nN = N / BM; nwg = nM * nN; G = G_; c = c_; lda = lda_; ldb = ldb_; }
    __device__ bool next(int i, Unit& u) const {
        const long L = (long)i * G + c; if (L >= nwg) return false;
        int wgid = (int)L; { const int q = nwg / NXCD, r = nwg % NXCD, xcd = wgid % NXCD, off = wgid / NXCD; wgid = (xcd < r ? xcd * (q + 1) : r * (q + 1) + (xcd - r) * q) + off; }
        const int nig = WGM * nN, gid = wgid / nig, fm = gid * WGM, gsz = (nM - fm) < WGM ? (nM - fm) : WGM;
        u.pm = fm + ((wgid % nig) % gsz); u.pn = (wgid % nig) / gsz; u.aux = 0;
        u.aoff = (size_t)u.pm * BM * lda * 2; u.boff = (size_t)u.pn * BM * ldb * 2;
        return true;
    }
};
struct MergeOrder {
    int c, G;
    __device__ bool next(int i, Unit& u) const {
        const int tile = c + (i / 3) * G; if (tile >= 256) return false;
        u.pm = tile & 63; u.pn = tile >> 6; u.aux = i % 3;
        u.aoff = ((size_t)u.pm * BM * 1536 + (size_t)u.aux * 512) * 2; u.boff = ((size_t)u.aux * 1024 + (size_t)u.pn * BM) * 512 * 2;
        return true;
    }
};

template <class Epi, class Sched>
__device__ __forceinline__ void gemm_phase(PG8_LAS unsigned char* lds, const Gemm g, const Sched& S, const Epi& E, const int tid) {
    const int wid = __builtin_amdgcn_readfirstlane(tid >> 6), lane = tid & 63, wr = wid >> 2, wc = wid & 3, fr = lane & 15, fq = lane >> 4;
    const int K = g.K, nt = K / BK;
    unsigned voffA[2], voffB[2];
#pragma unroll
    for (int i = 0; i < 2; ++i) { int R, C; stage_rc(tid * 16 + i * 8192, R, C); const int Rb = Epi::PERM ? ((R & ~31) + perm32(R & 31)) : R;
        voffA[i] = (unsigned)(R * g.lda + C) * 2u; voffB[i] = (unsigned)(Rb * g.ldb + C) * 2u; }
    const size_t kstep = (size_t)(BK * 2);
    const size_t hstepA = (size_t)HALF * g.lda * 2, hstepB = (size_t)HALF * g.ldb * 2;
    const unsigned ldsw = (unsigned)wid * 1024u;
    const int aoff = lds_byte(wr * 64 + fr, fq * 8), boff = lds_byte(wc * 32 + fr, fq * 8);
#define PG8_SA(b, h) (((b) * 2 + (h)) * HTB)
#define PG8_SB(b, h) ((4 + (b) * 2 + (h)) * HTB)
#define PG8_STAGE(bufoff, gbase, voff) do { _Pragma("unroll") for (int _i = 0; _i < 2; ++_i) \
        __builtin_amdgcn_global_load_lds((const unsigned*)((const char*)(gbase) + (voff)[_i]), (PG8_LAS unsigned*)(lds + (bufoff) + ldsw + _i * 8192), 16, 0, 0); } while (0)
#define PG8_LDA(dst, b, h) do { _Pragma("unroll") for (int m = 0; m < 4; ++m) _Pragma("unroll") for (int k = 0; k < 2; ++k) dst[m][k] = *(const PG8_LAS bf16x8*)(lds + PG8_SA(b, h) + aoff + m * 2048 + k * 1024); } while (0)
#define PG8_LDB(dst, b, h) do { _Pragma("unroll") for (int n = 0; n < 2; ++n) _Pragma("unroll") for (int k = 0; k < 2; ++k) dst[n][k] = *(const PG8_LAS bf16x8*)(lds + PG8_SB(b, h) + boff + n * 2048 + k * 1024); } while (0)
#define PG8_MMA(ai, bj, At, Bt) do { __builtin_amdgcn_s_setprio(1); _Pragma("unroll") for (int m = 0; m < 4; ++m) _Pragma("unroll") for (int n = 0; n < 2; ++n) _Pragma("unroll") for (int k = 0; k < 2; ++k) \
        acc[ai][bj][m][n] = __builtin_amdgcn_mfma_f32_16x16x32_bf16(Bt[n][k], At[m][k], acc[ai][bj][m][n], 0, 0, 0); __builtin_amdgcn_s_setprio(0); } while (0)
#define PG8_WAIT_V(n) asm volatile("s_waitcnt vmcnt(" #n ")" ::: "memory")
#define PG8_WAIT_L(n) asm volatile("s_waitcnt lgkmcnt(" #n ")" ::: "memory")
#define PG8_BAR __builtin_amdgcn_s_barrier()
#define PG8_SCHED __builtin_amdgcn_sched_barrier(0)
    Unit cur, nxt; int ui = 0;
    if (!S.next(0, cur)) return;
    f32x4 acc[2][2][4][2];
#pragma unroll
    for (int a = 0; a < 2; ++a)
#pragma unroll
        for (int b = 0; b < 2; ++b)
#pragma unroll
            for (int m = 0; m < 4; ++m)
#pragma unroll
                for (int n = 0; n < 2; ++n) acc[a][b][m][n] = f32x4{0.f, 0.f, 0.f, 0.f};
    bf16x8 At[4][2], B0[2][2], B1[2][2];
    const char* cA = (const char*)g.A + cur.aoff; const char* cB = (const char*)g.Bt + cur.boff;
    PG8_STAGE(PG8_SB(0, 0), cB, voffB); PG8_STAGE(PG8_SA(0, 0), cA, voffA); PG8_STAGE(PG8_SB(0, 1), cB + hstepB, voffB); PG8_STAGE(PG8_SA(0, 1), cA + hstepA, voffA);
    if (wr == 1) PG8_BAR;
    PG8_WAIT_V(4); PG8_BAR;
    PG8_STAGE(PG8_SB(1, 0), cB + kstep, voffB); PG8_STAGE(PG8_SA(1, 0), cA + kstep, voffA); PG8_STAGE(PG8_SB(1, 1), cB + hstepB + kstep, voffB);
    PG8_WAIT_V(6); PG8_BAR;
    for (;;) {
        const bool has_next = S.next(ui + 1, nxt);
        const char* nA = has_next ? (const char*)g.A + nxt.aoff : cA; const char* nB = has_next ? (const char*)g.Bt + nxt.boff : cB;
        for (int t = 0; t < nt; t += 2) {
            const bool last = (t == nt - 2);
            const char* a1 = cA + (size_t)(t + 1) * kstep;
            const char* a2 = last ? nA : cA + (size_t)(t + 2) * kstep; const char* b2 = last ? nB : cB + (size_t)(t + 2) * kstep;
            const char* a3 = a2 + kstep; const char* b3 = b2 + kstep;
            PG8_LDB(B0, 0, 0); PG8_SCHED; PG8_LDA(At, 0, 0); PG8_STAGE(PG8_SA(1, 1), a1 + hstepA, voffA);
            PG8_WAIT_L(8); PG8_BAR; PG8_WAIT_L(0); PG8_MMA(0, 0, At, B0); PG8_BAR; PG8_SCHED;
            PG8_LDB(B1, 0, 1); PG8_STAGE(PG8_SB(0, 0), b2, voffB);
            PG8_BAR; PG8_WAIT_L(0); PG8_MMA(0, 1, At, B1); PG8_BAR;
            PG8_LDA(At, 0, 1); PG8_STAGE(PG8_SA(0, 0), a2, voffA);
            PG8_BAR; PG8_WAIT_L(0); PG8_MMA(1, 0, At, B0); PG8_BAR; PG8_SCHED;
            PG8_STAGE(PG8_SB(0, 1), b2 + hstepB, voffB);
            PG8_WAIT_V(6); PG8_BAR; PG8_MMA(1, 1, At, B1); PG8_BAR;
            PG8_LDB(B0, 1, 0); PG8_SCHED; PG8_LDA(At, 1, 0); PG8_STAGE(PG8_SA(0, 1), a2 + hstepA, voffA);
            PG8_WAIT_L(8); PG8_BAR; PG8_WAIT_L(0); PG8_MMA(0, 0, At, B0); PG8_BAR; PG8_SCHED;
            PG8_LDB(B1, 1, 1); PG8_STAGE(PG8_SB(1, 0), b3, voffB);
            PG8_BAR; PG8_WAIT_L(0); PG8_MMA(0, 1, At, B1); PG8_BAR;
            PG8_LDA(At, 1, 1); PG8_STAGE(PG8_SA(1, 0), a3, voffA);
            PG8_BAR; PG8_WAIT_L(0); PG8_MMA(1, 0, At, B0); PG8_BAR; PG8_SCHED;
            PG8_STAGE(PG8_SB(1, 1), b3 + hstepB, voffB);
            PG8_WAIT_V(6); PG8_BAR; PG8_MMA(1, 1, At, B1); PG8_BAR;
        }
        E(acc, cur, wr, wc, fr, fq);
        if (!has_next) break;
#pragma unroll
        for (int a = 0; a < 2; ++a)
#pragma unroll
            for (int b = 0; b < 2; ++b)
#pragma unroll
                for (int m = 0; m < 4; ++m)
#pragma unroll
                    for (int n = 0; n < 2; ++n) acc[a][b][m][n] = f32x4{0.f, 0.f, 0.f, 0.f};
        cur = nxt; cA = nA; cB = nB; ++ui;
    }
    PG8_WAIT_V(0);
    if (wr == 0) PG8_BAR;
    PG8_BAR;
#undef PG8_SA
#undef PG8_SB
#undef PG8_STAGE
#undef PG8_LDA
#undef PG8_LDB
#undef PG8_MMA
#undef PG8_WAIT_V
#undef PG8_WAIT_L
#undef PG8_BAR
#undef PG8_SCHED
}

struct EpiBf16 {
    static constexpr bool PERM = true;
    bf16_t* O; int ldc;
    __device__ __forceinline__ void operator()(const f32x4 (&acc)[2][2][4][2], const Unit& u, int wr, int wc, int fr, int fq) const {
        const int row0 = u.pm * BM + wr * 64 + fr, col0 = u.pn * BM + wc * 32 + 8 * fq;
#pragma unroll
        for (int ai = 0; ai < 2; ++ai)
#pragma unroll
            for (int m = 0; m < 4; ++m) { bf16_t* rowp = O + (size_t)(row0 + ai * HALF + m * 16) * ldc + col0;
#pragma unroll
                for (int bj = 0; bj < 2; ++bj) { const f32x4 v0 = acc[ai][bj][m][0], v1 = acc[ai][bj][m][1];
                    u32x4 w; w.x = pack2(v0[0], v0[1]); w.y = pack2(v0[2], v0[3]); w.z = pack2(v1[0], v1[1]); w.w = pack2(v1[2], v1[3]);
                    *(u32x4*)(rowp + bj * HALF) = w; } }
    }
};
struct EpiResid {
    static constexpr bool PERM = false;
    const float* xin; float* out; const float* mod;
    __device__ __forceinline__ void operator()(const f32x4 (&acc)[2][2][4][2], const Unit& u, int wr, int wc, int fr, int fq) const {
        const int row0 = u.pm * BM + wr * 64 + fr, col0 = u.pn * BM + wc * 32 + 4 * fq;
        const float* gm = mod + (size_t)(row0 >> 11) * 6144 + 2048 + col0;
#pragma unroll
        for (int ai = 0; ai < 2; ++ai)
#pragma unroll
            for (int m = 0; m < 4; ++m) { const size_t ro = (size_t)(row0 + ai * HALF + m * 16) * 1024 + col0;
#pragma unroll
                for (int bj = 0; bj < 2; ++bj)
#pragma unroll
                    for (int n = 0; n < 2; ++n) {
                        const f32x4 g4 = *(const f32x4*)(gm + bj * HALF + n * 16), xi = *(const f32x4*)(xin + ro + bj * HALF + n * 16);
                        *(f32x4*)(out + ro + bj * HALF + n * 16) = xi + g4 * acc[ai][bj][m][n]; } }
    }
};
struct EpiMerge {
    static constexpr bool PERM = true;
    bf16_t* Hm; const bf16_t* Z;
    __device__ __forceinline__ void operator()(const f32x4 (&acc)[2][2][4][2], const Unit& u, int wr, int wc, int fr, int fq) const {
        const int row0 = u.pm * BM + wr * 64 + fr, col0 = u.pn * BM + wc * 32 + 8 * fq, g = u.aux;
#pragma unroll
        for (int ai = 0; ai < 2; ++ai)
#pragma unroll
            for (int m = 0; m < 4; ++m) { const int row = row0 + ai * HALF + m * 16;
#pragma unroll
                for (int bj = 0; bj < 2; ++bj) {
                    const int col = col0 + bj * HALF;
                    const u32x4 gz = *(const u32x4*)(Z + (size_t)row * LDZ + ZM + g * 1024 + col);
                    u32x4 prev = u32x4{0u, 0u, 0u, 0u};
                    if (g > 0) prev = *(const u32x4*)(Hm + (size_t)row * 1024 + col);
                    const f32x4 v0 = acc[ai][bj][m][0], v1 = acc[ai][bj][m][1];
                    u32x4 w;
                    w.x = pack2(bflo(prev.x) + sigm(bflo(gz.x)) * v0[0], bfhi(prev.x) + sigm(bfhi(gz.x)) * v0[1]);
                    w.y = pack2(bflo(prev.y) + sigm(bflo(gz.y)) * v0[2], bfhi(prev.y) + sigm(bfhi(gz.y)) * v0[3]);
                    w.z = pack2(bflo(prev.z) + sigm(bflo(gz.z)) * v1[0], bfhi(prev.z) + sigm(bfhi(gz.z)) * v1[1]);
                    w.w = pack2(bflo(prev.w) + sigm(bflo(gz.w)) * v1[2], bfhi(prev.w) + sigm(bfhi(gz.w)) * v1[3]);
                    *(u32x4*)(Hm + (size_t)row * 1024 + col) = w; } }
    }
};
}

struct EpiZ {
    bf16_t* Z; int ld;
    __device__ __forceinline__ void operator()(int m, int n, const f32x4& v) const {
        uint2 o; o.x = pack2(v[0], v[1]); o.y = pack2(v[2], v[3]);
        *(uint2*)(Z + (size_t)m * ld + n) = o;
    }
};
struct EpiF16 {
    _Float16* C; int ld;
    __device__ __forceinline__ void operator()(int m, int n, const f32x4& v) const {
        typedef _Float16 h4 __attribute__((ext_vector_type(4)));
        h4 o = {(_Float16)v[0], (_Float16)v[1], (_Float16)v[2], (_Float16)v[3]};
        *(h4*)(C + (size_t)m * ld + n) = o;
    }
};
struct EpiOut {
    const float* xin; float* out; const float* mod;
    __device__ __forceinline__ void operator()(int m, int n, const f32x4& v) const {
        int b = m >> 11;
        float4 g = *(const float4*)(mod + (size_t)b * 6144 + 2048 + n);
        float4 xi = *(const float4*)(xin + (size_t)m * 1024 + n);
        *(float4*)(out + (size_t)m * 1024 + n) = make_float4(xi.x + g.x * v[0], xi.y + g.y * v[1], xi.z + g.z * v[2], xi.w + g.w * v[3]);
    }
};

template <class Epi>
__device__ void gemm_phase(const bf16_t* A, int lda, const bf16_t* Bt, int ldb, int M, int N, int K, bool batched, Epi epi,
                           int vb0, int nvb, char* smem_, const int tid) {
    bf16_t* sA = (bf16_t*)smem_; bf16_t* sB = sA + GBM * GLS;
    const int lane = tid & 63, wave = tid >> 6, wm = wave >> 1, wn = wave & 1, fr = lane & 15, fq = lane >> 4;
    const int MT = M / GBM, NTL = N / GBN;
    for (int tile = vb0; tile < MT * NTL; tile += nvb) {
        int mt = tile % MT, nt = tile / MT;
        f32x4 acc[4][4];
#pragma unroll
        for (int a = 0; a < 4; ++a)
#pragma unroll
            for (int b = 0; b < 4; ++b) acc[a][b] = f32x4{0.f, 0.f, 0.f, 0.f};
        gemm_tile(batched ? A + nt * 128 : A, lda, Bt, ldb, K, mt * GBM, nt * GBN, sA, sB, acc, tid);
#pragma unroll
        for (int nf = 0; nf < 4; ++nf)
#pragma unroll
            for (int mf = 0; mf < 4; ++mf)
                epi(mt * GBM + wm * 64 + mf * 16 + fr, nt * GBN + wn * 64 + nf * 16 + fq * 4, acc[nf][mf]);
    }
}


template <int DK, bool GLA>
__device__ void scan2_item(const Params& p, int l, int b, int h, char* smem_) {
    constexpr int SEG = NT / DK, SLEN = 64 / SEG, KS = DK / 32, KT = DK / 16;
    constexpr int QS = DK + 8, BS = DK + 4, VS = 72;
    bf16_t* qs = (bf16_t*)smem_;
    bf16_t* ks = qs + 64 * QS;
    float* bs = (float*)(ks + 64 * QS);
    bf16_t* vt = (bf16_t*)(bs + 64 * BS);
    bf16_t* At = vt + 128 * VS;
    bf16_t* kht = At + 64 * VS;
    bf16_t* st = kht + DK * VS;
    float* segtot = (float*)(st + 128 * QS);
    float* blast = segtot + SEG * DK;
    const int tid = TIDX(), lane = tid & 63, wave = __builtin_amdgcn_readfirstlane(tid >> 6), fr = lane & 15, fq = lane >> 4;
    const int kl = tid % DK, seg = __builtin_amdgcn_readfirstlane(tid / DK);
    float lbv = 0.f, gbias = 0.f; float gu[16];
#pragma unroll
    for (int r = 0; r < 16; ++r) gu[r] = 0.f;
    if (GLA) {
#pragma unroll
        for (int r = 0; r < 16; ++r) gu[r] = p.gla_up[(size_t)(l * 16 + r) * 256 + h * 64 + kl];
        gbias = p.gla_bias[l * 256 + h * 64 + kl];
    } else if (l == 1) {
        float x0 = p.hgrn_lb[h * 128 + kl], x1 = p.hgrn_lb[512 + h * 128 + kl];
        lbv = 1.f / (1.f + expf(x0 - x1));
    }
    const float scale = GLA ? 0.125f : 0.08838834764831845f;
    const bf16_t* Zb = (const bf16_t*)(p.ws + WS_Z) + (size_t)(b * 2048) * LDZ;
    float* ssq = (float*)(smem_ + 152576);
    const int QCOL = (GLA ? ZC_Q : ZA_Q) + h * DK, KCOL = (GLA ? ZC_K : ZA_F) + h * DK, VCOL = (GLA ? ZC_V : ZA_I) + h * 128, GCOL = (GLA ? ZC_G : ZA_G) + h * 128;
    f32x4 sacc[KT];
#pragma unroll
    for (int i = 0; i < KT; ++i) sacc[i] = f32x4{0.f, 0.f, 0.f, 0.f};
    for (int i = tid; i < 128 * QS / 2; i += NT) ((unsigned*)st)[i] = 0u;
    __syncthreads();

    for (int c = 0; c < 32; ++c) {
        const bf16_t* Zc = Zb + (size_t)(c * 64) * LDZ;
        {
            bf16_t rq[SLEN], rk[SLEN];
            u32x4 rc0[GLA ? SLEN : 1], rc1[GLA ? SLEN : 1];
            {
                bf16_t rv[16];
                const int v = tid & 127, sb_ = __builtin_amdgcn_readfirstlane(tid >> 7);
#pragma unroll
                for (int i = 0; i < 16; ++i) rv[i] = Zc[(size_t)(sb_ + 4 * i) * LDZ + VCOL + v];
#pragma unroll
                for (int i = 0; i < SLEN; ++i) {
                    const bf16_t* zr = Zc + (size_t)(seg * SLEN + i) * LDZ;
                    rq[i] = zr[QCOL + kl]; rk[i] = zr[KCOL + kl];
                    if (GLA) { rc0[i] = *(const u32x4*)(zr + ZC_CODE); rc1[i] = *(const u32x4*)(zr + ZC_CODE + 8); }
                }
#pragma unroll
                for (int i = 0; i < 16; ++i) vt[v * VS + sb_ + 4 * i] = rv[i];
            }
            float run = 0.f;
#pragma unroll
            for (int i = 0; i < SLEN; ++i) {
                const int s_ = seg * SLEN + i;
                float g, kk;
                if (GLA) {
                    float x = gbias;
#pragma unroll
                    for (int r = 0; r < 4; ++r) {
                        x += bflo(rc0[i][r]) * gu[2 * r] + bfhi(rc0[i][r]) * gu[2 * r + 1];
                        x += bflo(rc1[i][r]) * gu[8 + 2 * r] + bfhi(rc1[i][r]) * gu[8 + 2 * r + 1];
                    }
                    g = (fminf(x, 0.f) - __logf(1.f + __expf(-fabsf(x)))) * (1.f / 16.f);
                    kk = bf2f(rk[i]);
                } else {
                    const float f = lbv + (1.f - lbv) * __frcp_rn(1.f + __expf(-bf2f(rk[i])));
                    g = __logf(f); kk = 1.f - f;
                }
                run += g;
                bs[s_ * BS + kl] = run;
                qs[s_ * QS + kl] = rq[i];
                ks[s_ * QS + kl] = f2bf(kk);
            }
            segtot[seg * DK + kl] = run;
        }
        __syncthreads();
        {
            float pre = 0.f, tot = 0.f;
#pragma unroll
            for (int g_ = 0; g_ < SEG; ++g_) { const float v_ = segtot[g_ * DK + kl]; if (g_ < seg) pre += v_; tot += v_; }
            if (seg == 0) blast[kl] = tot;
            unsigned pk[SLEN / 2];
#pragma unroll
            for (int i = 0; i < SLEN; ++i) {
                const float bv = bs[(seg * SLEN + i) * BS + kl] + pre;
                bs[(seg * SLEN + i) * BS + kl] = bv;
                const float kh = bf2f(ks[(seg * SLEN + i) * QS + kl]) * __expf(tot - bv);
                if (i & 1) pk[i >> 1] |= ((unsigned)f2bf(kh)) << 16; else pk[i >> 1] = (unsigned)f2bf(kh);
            }
            unsigned* dst = (unsigned*)(kht + kl * VS + seg * SLEN);
#pragma unroll
            for (int i = 0; i < SLEN / 2; ++i) dst[i] = pk[i];
        }
        __syncthreads();
        for (int blk = wave; blk < 10; blk += 8) {
            int bi, bj;
            if (blk < 1) { bi = 0; bj = 0; } else if (blk < 3) { bi = 1; bj = blk - 1; } else if (blk < 6) { bi = 2; bj = blk - 3; } else { bi = 3; bj = blk - 6; }
            f32x4 acc = f32x4{0.f, 0.f, 0.f, 0.f};
            const int srow = bj * 16 + fr, trow = bi * 16 + fr;
#pragma unroll
            for (int kk = 0; kk < KS; ++kk) {
                const int k0 = kk * 32 + fq * 8;
                float br[8];
                if (bi == 0) {
#pragma unroll
                    for (int j = 0; j < 8; ++j) br[j] = 0.f;
                } else {
                    const float4 r0 = *(const float4*)(bs + (bi * 16 - 1) * BS + k0), r1 = *(const float4*)(bs + (bi * 16 - 1) * BS + k0 + 4);
                    br[0] = r0.x; br[1] = r0.y; br[2] = r0.z; br[3] = r0.w; br[4] = r1.x; br[5] = r1.y; br[6] = r1.z; br[7] = r1.w;
                }
                const uint4 kq = *(const uint4*)(ks + srow * QS + k0), qq = *(const uint4*)(qs + trow * QS + k0);
                const float4 s0 = *(const float4*)(bs + srow * BS + k0), s1 = *(const float4*)(bs + srow * BS + k0 + 4);
                const float4 t0_ = *(const float4*)(bs + trow * BS + k0), t1_ = *(const float4*)(bs + trow * BS + k0 + 4);
                const float bsv[8] = {s0.x, s0.y, s0.z, s0.w, s1.x, s1.y, s1.z, s1.w}, btv[8] = {t0_.x, t0_.y, t0_.z, t0_.w, t1_.x, t1_.y, t1_.z, t1_.w};
                const unsigned kw[4] = {kq.x, kq.y, kq.z, kq.w}, qw[4] = {qq.x, qq.y, qq.z, qq.w};
                union { bf16x8 v; unsigned u[4]; } ka, qb;
#pragma unroll
                for (int j = 0; j < 4; ++j) {
                    const float e0 = __expf(fminf(br[2 * j] - bsv[2 * j], 60.f)), e1 = __expf(fminf(br[2 * j + 1] - bsv[2 * j + 1], 60.f));
                    ka.u[j] = pack2(bflo(kw[j]) * e0, bfhi(kw[j]) * e1);
                    const float f0 = __expf(btv[2 * j] - br[2 * j]), f1 = __expf(btv[2 * j + 1] - br[2 * j + 1]);
                    qb.u[j] = pack2(bflo(qw[j]) * f0, bfhi(qw[j]) * f1);
                }
                acc = __builtin_amdgcn_mfma_f32_16x16x32_bf16(ka.v, qb.v, acc, 0, 0, 0);
            }
            if (bi == bj) {
#pragma unroll
                for (int r = 0; r < 4; ++r) if (4 * fq + r > fr) acc[r] = 0.f;
            }
            uint2 o; o.x = pack2(acc[0], acc[1]); o.y = pack2(acc[2], acc[3]);
            *(uint2*)(At + trow * VS + bj * 16 + 4 * fq) = o;
        }
        {
            unsigned z_ = 0u; asm volatile("" : "+v"(z_));
            if (wave == 2) *(uint2*)(At + (0 * 16 + fr) * VS + 16 + 4 * fq) = make_uint2(z_, z_);
            if (wave == 3) *(uint2*)(At + (2 * 16 + fr) * VS + 48 + 4 * fq) = make_uint2(z_, z_);
        }
        __syncthreads();
        f32x4 oacc[4]; uint2 gz[4];
        {
            const int ti = wave & 3, vh = wave >> 2, trow = ti * 16 + fr;
            bf16x8 qh[KS];
#pragma unroll
            for (int kk = 0; kk < KS; ++kk) {
                const int k0 = kk * 32 + fq * 8;
                const uint4 qq = *(const uint4*)(qs + trow * QS + k0);
                const float4 t0_ = *(const float4*)(bs + trow * BS + k0), t1_ = *(const float4*)(bs + trow * BS + k0 + 4);
                union { bf16x8 v; unsigned u[4]; } q_;
                q_.u[0] = pack2(bflo(qq.x) * __expf(t0_.x), bfhi(qq.x) * __expf(t0_.y));
                q_.u[1] = pack2(bflo(qq.y) * __expf(t0_.z), bfhi(qq.y) * __expf(t0_.w));
                q_.u[2] = pack2(bflo(qq.z) * __expf(t1_.x), bfhi(qq.z) * __expf(t1_.y));
                q_.u[3] = pack2(bflo(qq.w) * __expf(t1_.z), bfhi(qq.w) * __expf(t1_.w));
                qh[kk] = q_.v;
            }
            const bf16x8 af0 = *(const bf16x8*)(At + trow * VS + fq * 8), af1 = *(const bf16x8*)(At + trow * VS + 32 + fq * 8);
            float sq = 0.f;
#pragma unroll
            for (int vi = 0; vi < 4; ++vi) {
                const int vrow = vh * 64 + vi * 16 + fr;
                gz[vi] = *(const uint2*)(Zc + (size_t)trow * LDZ + GCOL + vh * 64 + vi * 16 + 4 * fq);
                f32x4 acc = f32x4{0.f, 0.f, 0.f, 0.f};
                acc = __builtin_amdgcn_mfma_f32_16x16x32_bf16(*(const bf16x8*)(vt + vrow * VS + fq * 8), af0, acc, 0, 0, 0);
                if (ti >= 2) acc = __builtin_amdgcn_mfma_f32_16x16x32_bf16(*(const bf16x8*)(vt + vrow * VS + 32 + fq * 8), af1, acc, 0, 0, 0);
#pragma unroll
                for (int kk = 0; kk < KS; ++kk)
                    acc = __builtin_amdgcn_mfma_f32_16x16x32_bf16(*(const bf16x8*)(st + vrow * QS + kk * 32 + fq * 8), qh[kk], acc, 0, 0, 0);
                oacc[vi] = acc * scale;
                sq += oacc[vi][0] * oacc[vi][0] + oacc[vi][1] * oacc[vi][1] + oacc[vi][2] * oacc[vi][2] + oacc[vi][3] * oacc[vi][3];
            }
            sq += shx<16>(sq); sq += shx<32>(sq);
            if (fq == 0) ssq[vh * 64 + trow] = sq;
        }
        {
            const int vrow = wave * 16 + fr;
            const bf16x8 vf0 = *(const bf16x8*)(vt + vrow * VS + fq * 8), vf1 = *(const bf16x8*)(vt + vrow * VS + 32 + fq * 8);
#pragma unroll
            for (int kt = 0; kt < KT; ++kt) {
                const float dec = __expf(blast[kt * 16 + fr]);
                sacc[kt][0] *= dec; sacc[kt][1] *= dec; sacc[kt][2] *= dec; sacc[kt][3] *= dec;
                sacc[kt] = __builtin_amdgcn_mfma_f32_16x16x32_bf16(vf0, *(const bf16x8*)(kht + (kt * 16 + fr) * VS + fq * 8), sacc[kt], 0, 0, 0);
                sacc[kt] = __builtin_amdgcn_mfma_f32_16x16x32_bf16(vf1, *(const bf16x8*)(kht + (kt * 16 + fr) * VS + 32 + fq * 8), sacc[kt], 0, 0, 0);
            }
        }
        __syncthreads();
#pragma unroll
        for (int kt = 0; kt < KT; ++kt)
#pragma unroll
            for (int r = 0; r < 4; ++r) st[(wave * 16 + 4 * fq + r) * QS + kt * 16 + fr] = f2bf(sacc[kt][r]);
        {
            const int ti = wave & 3, vh = wave >> 2, trow = ti * 16 + fr;
            const float rstd = rsqrtf((ssq[trow] + ssq[64 + trow]) * (1.f / 128.f) + 1e-6f);
            bf16_t* yrow = (bf16_t*)(p.ws + WS_Y) + (size_t)(b * 2048 + c * 64 + trow) * 1536 + (GLA ? 1024 : 0) + h * 128 + vh * 64 + 4 * fq;
            const float* gn = (GLA ? p.gla_on : p.hgrn_on) + l * 128 + vh * 64 + 4 * fq;
#pragma unroll
            for (int vi = 0; vi < 4; ++vi) {
                const float4 g4 = *(const float4*)(gn + vi * 16);
                const float z0 = bflo(gz[vi].x), z1 = bfhi(gz[vi].x), z2 = bflo(gz[vi].y), z3 = bfhi(gz[vi].y);
                uint2 o;
                o.x = pack2(oacc[vi][0] * rstd * g4.x * (z0 * sigm(z0)), oacc[vi][1] * rstd * g4.y * (z1 * sigm(z1)));
                o.y = pack2(oacc[vi][2] * rstd * g4.z * (z2 * sigm(z2)), oacc[vi][3] * rstd * g4.w * (z3 * sigm(z3)));
                *(uint2*)(yrow + vi * 16) = o;
            }
        }
    }
    __syncthreads();
}

__device__ void dsaprep2_item(const Params& p, int l, int item, char* smem_) {
    bf16_t* tile = (bf16_t*)smem_;
    const int tid = TIDX(), lane = tid & 63, wave = tid >> 6;
    bf16_t* Z = (bf16_t*)(p.ws + WS_Z); bf16_t* VT = (bf16_t*)(p.ws + WS_VT);
    {
        const int tb = item * 32;
        for (int tt = wave; tt < 32; tt += 8) {
            const int t = tb + tt;
#pragma unroll
            for (int grp = 0; grp < 8; ++grp) {
                bf16_t* ptr = Z + (size_t)t * LDZ + (grp < 4 ? ZB_Q : ZB_K) + (grp & 3) * 128 + lane * 2;
                unsigned u = *(unsigned*)ptr;
                float a = bflo(u), b = bfhi(u);
                float ss = wave_sum(a * a + b * b);
                float r = rsqrtf(ss * (1.f / 128.f) + 1e-6f);
                const float* gn = (grp < 4 ? p.dsa_qn : p.dsa_kn) + l * 128 + lane * 2;
                float sc = (grp < 4) ? 0.08838834764831845f : 1.f;
                __hip_atomic_store((unsigned*)ptr, pack2(a * r * gn[0] * sc, b * r * gn[1] * sc), __ATOMIC_RELAXED, __HIP_MEMORY_SCOPE_AGENT);
            }
        }
#pragma unroll
        for (int i = 0; i < 4; ++i) {
            int ch = tid + i * 512, t = ch >> 6, c8 = (ch & 63) * 8;
            uint4 u = *(const uint4*)(Z + (size_t)(tb + t) * LDZ + ZB_V + c8);
            unsigned* d = (unsigned*)(tile + t * 514 + c8);
            d[0] = u.x; d[1] = u.y; d[2] = u.z; d[3] = u.w;
        }
        __syncthreads();
        {
            const int c = tid, b = tb >> 11, s0 = tb & 2047;
            unsigned w[16];
#pragma unroll
            for (int j = 0; j < 16; ++j) w[j] = (unsigned)tile[(2 * j) * 514 + c] | ((unsigned)tile[(2 * j + 1) * 514 + c] << 16);
            unsigned long long* dst = (unsigned long long*)(VT + ((size_t)(b * 512 + c)) * 2048 + s0);
#pragma unroll
            for (int j = 0; j < 8; ++j) __hip_atomic_store(dst + j, ((unsigned long long)w[2 * j + 1] << 32) | w[2 * j], __ATOMIC_RELAXED, __HIP_MEMORY_SCOPE_AGENT);
        }
        __syncthreads();
    }
}

__device__ void dsa_select_tile(const Params& p, int b, int tq, char* smem_) {
    constexpr int KS_ = 2052;
    unsigned* keyL = (unsigned*)smem_;
    const int tid = TIDX(), lane = tid & 63, wave = __builtin_amdgcn_readfirstlane(tid >> 6), fr = lane & 15, fq = lane >> 4;
    const bf16_t* Z = (const bf16_t*)(p.ws + WS_Z);
    unsigned long long* BM64 = (unsigned long long*)(p.ws + WS_BM);
    const int t0 = tq * 16;
    {
        const int tl = t0 + fr;
        const size_t trow = (size_t)b * 2048 + tl;
        bf16x8 qf[4][2];
#pragma unroll
        for (int h = 0; h < 4; ++h)
#pragma unroll
            for (int ks = 0; ks < 2; ++ks) qf[h][ks] = *(const bf16x8*)(Z + trow * LDZ + ZB_QI + h * 64 + ks * 32 + fq * 8);
        float w[4];
#pragma unroll
        for (int h = 0; h < 4; ++h) w[h] = bf2f(Z[trow * LDZ + ZB_WI + h]) * 0.5f;
#pragma unroll 4
        for (int kt = wave; kt <= tq; kt += 8) {
            const bf16_t* kr = Z + ((size_t)b * 2048 + kt * 16 + fr) * LDZ + ZB_KI + fq * 8;
            const bf16x8 k0 = *(const bf16x8*)kr, k1 = *(const bf16x8*)(kr + 32);
            f32x4 acc[4];
#pragma unroll
            for (int h = 0; h < 4; ++h) {
                acc[h] = __builtin_amdgcn_mfma_f32_16x16x32_bf16(k0, qf[h][0], f32x4{0.f, 0.f, 0.f, 0.f}, 0, 0, 0);
                acc[h] = __builtin_amdgcn_mfma_f32_16x16x32_bf16(k1, qf[h][1], acc[h], 0, 0, 0);
            }
            u32x4 kk;
#pragma unroll
            for (int r = 0; r < 4; ++r) {
                float sc = w[0] * fmaxf(acc[0][r] * 0.125f, 0.f) + w[1] * fmaxf(acc[1][r] * 0.125f, 0.f) + w[2] * fmaxf(acc[2][r] * 0.125f, 0.f) + w[3] * fmaxf(acc[3][r] * 0.125f, 0.f);
                if (sc == 0.f) sc = 0.f;
                const unsigned u = __float_as_uint(sc);
                const unsigned k = (u & 0x80000000u) ? ~u : (u | 0x80000000u);
                kk[r] = (kt * 16 + 4 * fq + r <= tl) ? k : 0u;
            }
            *(u32x4*)(keyL + fr * KS_ + kt * 16 + 4 * fq) = kk;
        }
    }
    __syncthreads();
    {
        const int nk = (tq + 1) * 16, jmax = (nk + 63) >> 6;
        const int qa = 2 * wave, qb = qa + 1;
        unsigned ka[32], kb[32];
#pragma unroll
        for (int j = 0; j < 32; ++j) {
            const int s = lane + 64 * j;
            ka[j] = (s < nk) ? keyL[qa * KS_ + s] : 0u;
            kb[j] = (s < nk) ? keyL[qb * KS_ + s] : 0u;
        }
        unsigned Ta = 1u, Tb = 1u; int Ca = 2047, Cb = 2047;
        if (t0 >= 256) {
            int na, nb;
            bool da, db;
            {
                int c0 = 0, c1 = 0, c2 = 0, c3 = 0;
#pragma unroll
                for (int j = 0; j < 32; ++j)
                    if (j < jmax) { c0 += (ka[j] >= 0x80000000u); c1 += (ka[j] > 0x80000000u); c2 += (kb[j] >= 0x80000000u); c3 += (kb[j] > 0x80000000u); }
                c0 = wave_total_i(c0); c1 = wave_total_i(c1); c2 = wave_total_i(c2); c3 = wave_total_i(c3);
                da = (c1 < 256 && c0 >= 256); db = (c3 < 256 && c2 >= 256);
                Ta = da ? 0x80000000u : ((c0 >= 256) ? 0x80000000u : 0u); na = da ? c0 : ((c0 >= 256) ? c0 : 0x7fffffff);
                Tb = db ? 0x80000000u : ((c2 >= 256) ? 0x80000000u : 0u); nb = db ? c2 : ((c2 >= 256) ? c2 : 0x7fffffff);
            }
            for (int bit = 30; bit >= 0; --bit) {
                if (da && db) break;
                const unsigned ca_ = Ta | (1u << bit), cb_ = Tb | (1u << bit);
                int c0 = 0, c1 = 0;
#pragma unroll
                for (int j = 0; j < 32; ++j)
                    if (j < jmax) { c0 += (ka[j] >= ca_); c1 += (kb[j] >= cb_); }
                c0 = wave_total_i(c0); c1 = wave_total_i(c1);
                if (!da && c0 >= 256) { Ta = ca_; na = c0; }
                if (!db && c1 >= 256) { Tb = cb_; nb = c1; }
                da = da || (na == 256); db = db || (nb == 256);
            }
            if (na != 256 || nb != 256) {
                int needa, needb;
                {
                    int c0 = 0, c1 = 0;
#pragma unroll
                    for (int j = 0; j < 32; ++j)
                        if (j < jmax) { c0 += (ka[j] > Ta); c1 += (kb[j] > Tb); }
                    needa = 256 - wave_total_i(c0); needb = 256 - wave_total_i(c1);
                }
                Ca = 0; Cb = 0;
                for (int bit = 10; bit >= 0; --bit) {
                    const int ca_ = Ca | (1 << bit), cb_ = Cb | (1 << bit);
                    int c0 = 0, c1 = 0;
#pragma unroll
                    for (int j = 0; j < 32; ++j)
                        if (j < jmax) { const int s = lane + 64 * j; c0 += (ka[j] == Ta && s < ca_); c1 += (kb[j] == Tb && s < cb_); }
                    c0 = wave_total_i(c0); c1 = wave_total_i(c1);
                    if (c0 < needa) Ca = ca_;
                    if (c1 < needb) Cb = cb_;
                }
            }
        }
        const size_t rowa = (size_t)b * 2048 + t0 + qa;
#pragma unroll
        for (int j = 0; j < 32; ++j) {
            const int s = lane + 64 * j;
            const unsigned long long ma = __ballot((ka[j] > Ta) || (ka[j] == Ta && s <= Ca));
            const unsigned long long mb = __ballot((kb[j] > Tb) || (kb[j] == Tb && s <= Cb));
            if (lane == 0) {
                __hip_atomic_store(&BM64[rowa * 32 + j], ma, __ATOMIC_RELAXED, __HIP_MEMORY_SCOPE_AGENT);
                __hip_atomic_store(&BM64[(rowa + 1) * 32 + j], mb, __ATOMIC_RELAXED, __HIP_MEMORY_SCOPE_AGENT);
            }
        }
    }
    __syncthreads();
}

__device__ void dsa_attn_item(const Params& p, int b, int h, int qg, char* smem_) {
    constexpr int KSTR = 136, VSTR = 40;
    bf16_t* Kl = (bf16_t*)smem_;
    bf16_t* Vl = Kl + 2 * 32 * KSTR;
    const int tid = TIDX(), lane = tid & 63, wave = __builtin_amdgcn_readfirstlane(tid >> 6), fr = lane & 15, fq = lane >> 4;
    const bf16_t* Z = (const bf16_t*)(p.ws + WS_Z); const bf16_t* VT = (const bf16_t*)(p.ws + WS_VT);
    const unsigned* BM = (const unsigned*)(p.ws + WS_BM); bf16_t* Y = (bf16_t*)(p.ws + WS_Y);
    const int kr = tid >> 4, kc = tid & 15, vd = tid >> 2, vc = tid & 3;
    const int ka_row = 8 * (fr >> 2) + (fr & 3);
    {
        const int t0 = qg * 128 + wave * 16;
        const size_t trow = (size_t)b * 2048 + t0 + fr;
        bf16x8 qf[4];
#pragma unroll
        for (int ks = 0; ks < 4; ++ks) qf[ks] = *(const bf16x8*)(Z + trow * LDZ + ZB_Q + h * 128 + ks * 32 + fq * 8);
        f32x4 o[8];
#pragma unroll
        for (int i = 0; i < 8; ++i) o[i] = f32x4{0.f, 0.f, 0.f, 0.f};
        float m = -INFINITY, lsum = 0.f;
        const unsigned* bmrow = BM + trow * 64;
        const int nsteps_blk = qg * 4 + 4, nsteps_w = (t0 + 15) / 32 + 1;
        const bf16_t* kg = Z + ((size_t)b * 2048 + kr) * LDZ + ZB_K + h * 128 + kc * 8;
        const bf16_t* vg = VT + ((size_t)(b * 4 + h) * 128 + vd) * 2048 + vc * 8;
        u32x4 rk = *(const u32x4*)kg, rv = *(const u32x4*)vg;
        *(u32x4*)(Kl + kr * KSTR + kc * 8) = rk; *(u32x4*)(Vl + vd * VSTR + vc * 8) = rv;
        __syncthreads();
        for (int st = 0; st < nsteps_blk; ++st) {
            const bool more = (st + 1 < nsteps_blk);
            if (more) { rk = *(const u32x4*)(kg + (size_t)(st + 1) * 32 * LDZ); rv = *(const u32x4*)(vg + (st + 1) * 32); }
            if (st < nsteps_w) {
                const bf16_t* Kb = Kl + (st & 1) * 32 * KSTR; const bf16_t* Vb = Vl + (st & 1) * 128 * VSTR;
                f32x4 sa = f32x4{0.f, 0.f, 0.f, 0.f}, sb = f32x4{0.f, 0.f, 0.f, 0.f};
#pragma unroll
                for (int ks = 0; ks < 4; ++ks) {
                    const bf16x8 fa = *(const bf16x8*)(Kb + ka_row * KSTR + ks * 32 + fq * 8), fb = *(const bf16x8*)(Kb + (ka_row + 4) * KSTR + ks * 32 + fq * 8);
                    sa = __builtin_amdgcn_mfma_f32_16x16x32_bf16(fa, qf[ks], sa, 0, 0, 0);
                    sb = __builtin_amdgcn_mfma_f32_16x16x32_bf16(fb, qf[ks], sb, 0, 0, 0);
                }
                const unsigned mw = bmrow[st] >> (8 * fq);
                float x[8];
#pragma unroll
                for (int r = 0; r < 4; ++r) { x[r] = ((mw >> r) & 1u) ? sa[r] : -INFINITY; x[4 + r] = ((mw >> (4 + r)) & 1u) ? sb[r] : -INFINITY; }
                float mx = fmaxf(fmaxf(fmaxf(x[0], x[1]), fmaxf(x[2], x[3])), fmaxf(fmaxf(x[4], x[5]), fmaxf(x[6], x[7])));
                mx = fmaxf(mx, shx<16>(mx)); mx = fmaxf(mx, shx<32>(mx));
                const float mnew = fmaxf(m, mx);
                const float msafe = (mnew == -INFINITY) ? 0.f : mnew;
                const float alpha = __expf(m - msafe);
                float pe[8]; float ps = 0.f;
#pragma unroll
                for (int j = 0; j < 8; ++j) { pe[j] = __expf(x[j] - msafe); ps += pe[j]; }
                lsum = lsum * alpha + ps;
                m = mnew;
#pragma unroll
                for (int i = 0; i < 8; ++i) { o[i][0] *= alpha; o[i][1] *= alpha; o[i][2] *= alpha; o[i][3] *= alpha; }
                union { bf16x8 v; unsigned u[4]; } pf;
                pf.u[0] = pack2(pe[0], pe[1]); pf.u[1] = pack2(pe[2], pe[3]); pf.u[2] = pack2(pe[4], pe[5]); pf.u[3] = pack2(pe[6], pe[7]);
#pragma unroll
                for (int i = 0; i < 8; ++i) {
                    const bf16x8 vf = *(const bf16x8*)(Vb + (i * 16 + fr) * VSTR + fq * 8);
                    o[i] = __builtin_amdgcn_mfma_f32_16x16x32_bf16(vf, pf.v, o[i], 0, 0, 0);
                }
            }
            if (more) { *(u32x4*)(Kl + ((st + 1) & 1) * 32 * KSTR + kr * KSTR + kc * 8) = rk; *(u32x4*)(Vl + ((st + 1) & 1) * 128 * VSTR + vd * VSTR + vc * 8) = rv; }
            __syncthreads();
        }
        lsum += shx<16>(lsum); lsum += shx<32>(lsum);
        const float inv = 1.f / lsum;
#pragma unroll
        for (int i = 0; i < 8; ++i) {
            uint2 ov; ov.x = pack2(o[i][0] * inv, o[i][1] * inv); ov.y = pack2(o[i][2] * inv, o[i][3] * inv);
            *(uint2*)(Y + trow * 1536 + 512 + h * 128 + i * 16 + 4 * fq) = ov;
        }
    }
}

constexpr int LDS_BYTES = 155648;
__device__ void ph_mixA(const Params& p, int l, int vb0, int nvb, char* smem_) {
    for (int item = vb0; item < 64; item += nvb) {
        if (item < 32) scan2_item<128, false>(p, l, item >> 2, item & 3, smem_);
        else scan2_item<64, true>(p, l, (item - 32) >> 2, (item - 32) & 3, smem_);
    }
    unsigned* ctr = (unsigned*)(p.ws + WS_CTL) + 3584 + l * 64;
    unsigned* done = (unsigned*)(p.ws + WS_CTL) + 5300 + l * 8 * 16;
    volatile int* slot = (volatile int*)(smem_ + LDS_BYTES - 64);
    for (;;) {
        if (TIDX() == 0) *slot = (int)atomicAdd(ctr, 1u);
        __syncthreads();
        const int idx = __builtin_amdgcn_readfirstlane(*slot);
        __syncthreads();
        if (idx >= 2048) break;
        if (idx < 1536) {
            const int b = idx / 192, r = idx % 192;
            if (r < 128) dsa_select_tile(p, b, 127 - r, smem_);
            else dsaprep2_item(p, l, b * 64 + (r - 128), smem_);
            asm volatile("s_waitcnt vmcnt(0)" ::: "memory");
            __syncthreads();
            if (TIDX() == 0) __hip_atomic_fetch_add(done + b * 16, 1u, __ATOMIC_RELAXED, __HIP_MEMORY_SCOPE_AGENT);
        } else {
            const int a = idx - 1536, b = a >> 6, h = (a >> 4) & 3, qg = 15 - (a & 15);
            if (TIDX() == 0) {
                unsigned spins = 0;
                while (__hip_atomic_load(done + b * 16, __ATOMIC_RELAXED, __HIP_MEMORY_SCOPE_AGENT) < 192u) { __builtin_amdgcn_s_sleep(2); if (++spins > (1u << 18)) break; }
                __builtin_amdgcn_fence(__ATOMIC_ACQUIRE, "agent");
                asm volatile("s_waitcnt vmcnt(0)" ::: "memory");
            }
            __syncthreads();
            dsa_attn_item(p, b, h, qg, smem_);
        }
    }
}

__device__ __forceinline__ int f2sort(float f) { int i = __float_as_int(f); return i ^ ((i >> 31) & 0x7fffffff); }
__device__ __forceinline__ float sort2f(int i) { return __int_as_float(i ^ ((i >> 31) & 0x7fffffff)); }
#define INSK(K, xv) do { int _x = (xv); \
    _Pragma("unroll") for (int _j = 0; _j < 16; ++_j) { int _hi = max(K[_j], _x); _x = min(K[_j], _x); K[_j] = _hi; } } while (0)
#define INS64(K, xv) do { unsigned long long _x = (xv); \
    _Pragma("unroll") for (int _j = 0; _j < 16; ++_j) { bool _c = _x > K[_j]; unsigned long long _o = K[_j]; K[_j] = _c ? _x : _o; _x = _c ? _o : _x; } } while (0)

__device__ void ph_route(const Params& p, int vb0, int nvb, char* smem_) {
    typedef _Float16 h8 __attribute__((ext_vector_type(8)));
    const _Float16* SC = (const _Float16*)(p.ws + WS_SC);
    int* RI = (int*)(p.ws + WS_RI); float* RG = (float*)(p.ws + WS_RG);
    const int tid = TIDX(), lane = tid & 63, wave = tid >> 6;
    _Float16* tile = (_Float16*)smem_ + wave * (64 * 72);
    for (int item0 = (vb0 * 8 + wave) * 64; item0 < T_TOK * 8; item0 += nvb * 8 * 64) {
        const int item = item0 + lane;
        const int t = item >> 3, h = item & 7;
        const _Float16* s0 = SC + (size_t)t * 2048 + h * 256;
        const _Float16* wbase = SC + (size_t)item0 * 256;
        int k0[16], k1[16];
#pragma unroll
        for (int j = 0; j < 16; ++j) { k0[j] = (int)0x80000000; k1[j] = (int)0x80000000; }
#pragma unroll 1
        for (int slab = 0; slab < 4; ++slab) {
            h8 ld[8];
#pragma unroll
            for (int j = 0; j < 4; ++j) {
                const _Float16* src = wbase + (size_t)(16 * j + (lane >> 2)) * 256 + slab * 32 + (lane & 3) * 8;
                ld[j] = *(const h8*)src; ld[4 + j] = *(const h8*)(src + 128);
            }
            __builtin_amdgcn_wave_barrier();
#pragma unroll
            for (int j = 0; j < 4; ++j) {
                _Float16* dst = tile + (16 * j + (lane >> 2)) * 72 + (lane & 3) * 8;
                *(h8*)dst = ld[j]; *(h8*)(dst + 32) = ld[4 + j];
            }
            __builtin_amdgcn_fence(__ATOMIC_RELEASE, "wavefront");
            __builtin_amdgcn_wave_barrier();
            __builtin_amdgcn_fence(__ATOMIC_ACQUIRE, "wavefront");
#pragma unroll 2
            for (int ii = 0; ii < 32; ii += 8) {
                const int i = slab * 32 + ii;
                const h8 a = *(const h8*)(tile + lane * 72 + ii), b = *(const h8*)(tile + lane * 72 + 32 + ii);
#pragma unroll
                for (int e_ = 0; e_ < 8; ++e_) {
                    INSK(k0, (f2sort((float)a[e_]) & ~127) | (127 - i - e_));
                    INSK(k1, (f2sort((float)b[e_]) & ~127) | (127 - i - e_));
                }
            }
            __builtin_amdgcn_wave_barrier();
        }
        float v0[16], v1[16];
#pragma unroll
        for (int j = 0; j < 16; ++j) { k0[j] = 127 - (k0[j] & 127); k1[j] = 127 - (k1[j] & 127); v0[j] = (float)s0[k0[j]]; v1[j] = (float)s0[128 + k1[j]]; }
        unsigned long long ck[16];
#pragma unroll
        for (int j = 0; j < 16; ++j) ck[j] = 0ull;
#pragma unroll
        for (int a = 0; a < 16; ++a)
#pragma unroll
            for (int b = 0; b < 16; ++b)
                if ((a + 1) * (b + 1) <= 16) {
                    unsigned hi = (unsigned)f2sort(v0[a] + v1[b]) ^ 0x80000000u;
                    unsigned lo = ((unsigned)(255 - (a * 16 + b)) << 16) | (unsigned)(k0[a] * 128 + k1[b]);
                    INS64(ck, ((unsigned long long)hi << 32) | lo);
                }
        float e[16]; float sm = 0.f;
        const float mx = sort2f((int)((unsigned)(ck[0] >> 32) ^ 0x80000000u));
#pragma unroll
        for (int j = 0; j < 16; ++j) { e[j] = expf(sort2f((int)((unsigned)(ck[j] >> 32) ^ 0x80000000u)) - mx); sm += e[j]; }
        const float inv = 1.f / sm;
#pragma unroll
        for (int j = 0; j < 16; j += 4) {
            *(int4*)(RI + (size_t)t * 128 + h * 16 + j) = make_int4((int)(ck[j] & 0xffffu), (int)(ck[j + 1] & 0xffffu), (int)(ck[j + 2] & 0xffffu), (int)(ck[j + 3] & 0xffffu));
            *(float4*)(RG + (size_t)t * 128 + h * 16 + j) = make_float4(e[j] * inv, e[j + 1] * inv, e[j + 2] * inv, e[j + 3] * inv);
        }
    }
}

__device__ __forceinline__ void fp8x16_to_f32(const uint4 q, float (&f)[16]) {
    const unsigned w[4] = {q.x, q.y, q.z, q.w};
#pragma unroll
    for (int c = 0; c < 4; ++c) {
        auto f0 = __builtin_amdgcn_cvt_pk_f32_fp8((int)w[c], false); auto f1 = __builtin_amdgcn_cvt_pk_f32_fp8((int)w[c], true);
        f[4 * c] = f0[0]; f[4 * c + 1] = f0[1]; f[4 * c + 2] = f1[0]; f[4 * c + 3] = f1[1];
    }
}
template <int WHICH>
__device__ void ph_peer_sliced(const Params& p, int l, char* smem_) {
    const int tid = TIDX(), wave = tid >> 6;
    const bf16_t* H = (const bf16_t*)(p.ws + WS_H); const unsigned char* PU = p.ws + WS_PU; const unsigned char* PV = p.ws + WS_PV;
    const int* RI = (const int*)(p.ws + WS_RI); float* RG = (float*)(p.ws + WS_RG); float* PP = (float*)(p.ws + WS_PP);
    const float* modb = (const float*)(p.ws + WS_MOD);
    {
    unsigned* ctr = (unsigned*)(p.ws + WS_CTL) + 3712 + (l * 2 + WHICH) * 128;
    volatile int* slot = (volatile int*)(smem_ + LDS_BYTES - 64);
    const int xcc = (int)(xb_xcc_id() & 7u);
    for (int so = 0; so < 8; ++so) {
        const int x = (xcc + so) & 7;
        for (;;) {
            if (tid == 0) *slot = (int)atomicAdd(ctr + x * 16, 1u);
            __syncthreads();
            const int chunk = __builtin_amdgcn_readfirstlane(*slot);
            __syncthreads();
            if (chunk >= 256) break;
            {
                const int lane = lane_id_opaque(), eg = lane >> 3, ll = lane & 7;
                const int tb = chunk * 64 + wave * 8;
                int* lri = (int*)smem_ + wave * 2048; float* lrg = (float*)(lri + 1024);
                {
                    int ra[16]; float rg_[16];
#pragma unroll
                    for (int i = 0; i < 8; ++i) {
                        ra[2 * i] = RI[(size_t)(tb + i) * 128 + lane]; ra[2 * i + 1] = RI[(size_t)(tb + i) * 128 + 64 + lane];
                        if (WHICH == 1) { rg_[2 * i] = RG[(size_t)(tb + i) * 128 + lane]; rg_[2 * i + 1] = RG[(size_t)(tb + i) * 128 + 64 + lane]; }
                    }
#pragma unroll
                    for (int i = 0; i < 8; ++i) {
                        lri[i * 128 + lane] = ra[2 * i]; lri[i * 128 + 64 + lane] = ra[2 * i + 1];
                        if (WHICH == 1) { lrg[i * 128 + lane] = rg_[2 * i]; lrg[i * 128 + 64 + lane] = rg_[2 * i + 1]; }
                    }
                }
                __builtin_amdgcn_fence(__ATOMIC_RELEASE, "wavefront");
                __builtin_amdgcn_wave_barrier();
                __builtin_amdgcn_fence(__ATOMIC_ACQUIRE, "wavefront");
                uint4 hq0 = make_uint4(0u, 0u, 0u, 0u), hq1 = hq0;
                if (WHICH == 0) { const uint4* hp = (const uint4*)(H + (size_t)tb * 1024 + x * 128 + ll * 16); hq0 = hp[0]; hq1 = hp[1]; }
#pragma unroll 1
                for (int i = 0; i < 8; ++i) {
                    const int t = tb + i;
                    if (WHICH == 0) {
                        float hv[16];
                        hv[0] = bflo(hq0.x); hv[1] = bfhi(hq0.x); hv[2] = bflo(hq0.y); hv[3] = bfhi(hq0.y); hv[4] = bflo(hq0.z); hv[5] = bfhi(hq0.z); hv[6] = bflo(hq0.w); hv[7] = bfhi(hq0.w);
                        hv[8] = bflo(hq1.x); hv[9] = bfhi(hq1.x); hv[10] = bflo(hq1.y); hv[11] = bfhi(hq1.y); hv[12] = bflo(hq1.z); hv[13] = bfhi(hq1.z); hv[14] = bflo(hq1.w); hv[15] = bfhi(hq1.w);
                        if (i < 7) { const uint4* hp = (const uint4*)(H + (size_t)(t + 1) * 1024 + x * 128 + ll * 16); hq0 = hp[0]; hq1 = hp[1]; }
                        uint4 uq[16];
#pragma unroll
                        for (int it = 0; it < 16; ++it) {
                            const int e = lri[i * 128 + it * 8 + eg];
                            uq[it] = *(const uint4*)(PU + ((size_t)x * 16384 + e) * 128 + ll * 16);
                        }
#pragma unroll
                        for (int b2 = 0; b2 < 2; ++b2) {
                            float part[8];
#pragma unroll
                            for (int it = 0; it < 8; ++it) {
                                typedef float f32x2 __attribute__((ext_vector_type(2)));
                                const unsigned uw_[4] = {uq[b2 * 8 + it].x, uq[b2 * 8 + it].y, uq[b2 * 8 + it].z, uq[b2 * 8 + it].w};
                                f32x2 d2 = {0.f, 0.f};
#pragma unroll
                                for (int c_ = 0; c_ < 4; ++c_) {
                                    const f32x2 f0 = __builtin_amdgcn_cvt_pk_f32_fp8((int)uw_[c_], false), f1 = __builtin_amdgcn_cvt_pk_f32_fp8((int)uw_[c_], true);
                                    d2 = __builtin_elementwise_fma(f32x2{hv[4 * c_], hv[4 * c_ + 1]}, f0, d2);
                                    d2 = __builtin_elementwise_fma(f32x2{hv[4 * c_ + 2], hv[4 * c_ + 3]}, f1, d2);
                                }
                                part[it] = d2[0] + d2[1];
                            }
                            float r4[4], r2[2];
                            const bool b2_ = lane & 4, b1_ = lane & 2, b0_ = lane & 1;
#pragma unroll
                            for (int j = 0; j < 4; ++j) { const float snd = b2_ ? part[j] : part[j + 4], kp = b2_ ? part[j + 4] : part[j]; r4[j] = kp + shx<4>(snd); }
#pragma unroll
                            for (int j = 0; j < 2; ++j) { const float snd = b1_ ? r4[j] : r4[j + 2], kp = b1_ ? r4[j + 2] : r4[j]; r2[j] = kp + shx<2>(snd); }
                            const float snd = b0_ ? r2[0] : r2[1], kp = b0_ ? r2[1] : r2[0];
                            const float d = kp + shx<1>(snd);
                            PP[((size_t)x * T_TOK + t) * 128 + b2 * 64 + ll * 8 + eg] = d;
                        }
                    } else {
                        float y[16];
#pragma unroll
                        for (int j = 0; j < 16; ++j) y[j] = 0.f;
#pragma unroll
                        for (int b2 = 0; b2 < 2; ++b2) {
                            uint4 vq[8];
#pragma unroll
                            for (int it = 0; it < 8; ++it) {
                                const int e = lri[i * 128 + b2 * 64 + it * 8 + eg];
                                vq[it] = *(const uint4*)(PV + ((size_t)x * 16384 + e) * 128 + ll * 16);
                            }
#pragma unroll
                            for (int it = 0; it < 8; ++it) {
                                const float ck = lrg[i * 128 + b2 * 64 + it * 8 + eg];
                                float f[16]; fp8x16_to_f32(vq[it], f);
#pragma unroll
                                for (int j = 0; j < 16; ++j) y[j] += ck * f[j];
                            }
                        }
                        float r8[8], r4[4], r2[2];
                        const bool b5 = lane & 32, b4 = lane & 16, b3 = lane & 8;
#pragma unroll
                        for (int j = 0; j < 8; ++j) { const float snd = b5 ? y[j] : y[j + 8], kp = b5 ? y[j + 8] : y[j]; r8[j] = kp + shx<32>(snd); }
#pragma unroll
                        for (int j = 0; j < 4; ++j) { const float snd = b4 ? r8[j] : r8[j + 4], kp = b4 ? r8[j + 4] : r8[j]; r4[j] = kp + shx<16>(snd); }
#pragma unroll
                        for (int j = 0; j < 2; ++j) { const float snd = b3 ? r4[j] : r4[j + 2], kp = b3 ? r4[j + 2] : r4[j]; r2[j] = kp + shx<8>(snd); }
                        const int col = x * 128 + ll * 16 + ((lane >> 5) & 1) * 8 + ((lane >> 4) & 1) * 4 + ((lane >> 3) & 1) * 2;
                        const float2 gf = *(const float2*)(modb + (size_t)(l * 8 + (t >> 11)) * 6144 + 5120 + col);
                        float2* op = (float2*)(p.out + (size_t)t * 1024 + col);
                        const float2 xi = *op;
                        *op = make_float2(xi.x + gf.x * r2[0], xi.y + gf.y * r2[1]);
                    }
                }
            }
        }
    }
    __syncthreads();
    }
}
__device__ void ph_peer_coef(const Params& p, int vb0, int nvb) {
    const int wave = TIDX() >> 6, lane = TIDX() & 63;
    float* RG = (float*)(p.ws + WS_RG); const float* PP = (const float*)(p.ws + WS_PP);
    for (int t = vb0 * 8 + wave; t < T_TOK; t += nvb * 8) {
#pragma unroll
        for (int half = 0; half < 2; ++half) {
            const int k = half * 64 + lane;
            float d = 0.f;
#pragma unroll
            for (int x = 0; x < 8; ++x) d += PP[((size_t)x * T_TOK + t) * 128 + k];
            d *= (1.f / PU_SCALE);
            const float g = RG[(size_t)t * 128 + k];
            RG[(size_t)t * 128 + k] = g * 0.5f * d * (1.f + erff(d * 0.7071067811865476f)) * (1.f / PV_SCALE);
        }
    }
}

enum { PH_MOD = 0, PH_WPREP, PH_NORM1, PH_GEMM_IN, PH_SCAN, PH_MERGE, PH_OUT, PH_NORM2, PH_GEMM_Q, PH_GEMM_SC, PH_ROUTE, PH_G1, PH_G15, PH_G2 };

template <int PH>
__device__ __forceinline__ void run_phase(const Params& p, int l, int vb0, int nvb, char* smem) {
    const float* xin = (l == 0) ? p.x : p.out;
    if (PH == PH_MOD) ph_mod(p, vb0, nvb, smem);
    else if (PH == PH_WPREP) ph_wprep(p, l, vb0, nvb, smem);
    else if (PH == PH_NORM1) ph_norm(p, l, 0, xin, vb0, nvb);
    else if (PH == PH_GEMM_IN) {
        pg8::Gemm g{(const bf16_t*)(p.ws + WS_H), (const bf16_t*)(p.ws + WS_WIN), 1024, 1024, 1024};
        pg8::StaticOrder S; S.init(T_TOK, LDZ, nvb, vb0, 1024, 1024);
        pg8::gemm_phase(( PG8_LAS unsigned char*)smem, g, S, pg8::EpiBf16{(bf16_t*)(p.ws + WS_Z), LDZ}, TIDX());
    }
    else if (PH == PH_SCAN) ph_mixA(p, l, vb0, nvb, smem);
    else if (PH == PH_MERGE) {
        pg8::Gemm g{(const bf16_t*)(p.ws + WS_Y), (const bf16_t*)(p.ws + WS_WBR), 1536, 512, 512};
        pg8::MergeOrder S{vb0, nvb};
        pg8::gemm_phase((PG8_LAS unsigned char*)smem, g, S, pg8::EpiMerge{(bf16_t*)(p.ws + WS_H), (const bf16_t*)(p.ws + WS_Z)}, TIDX());
    }
    else if (PH == PH_OUT) {
        pg8::Gemm g{(const bf16_t*)(p.ws + WS_H), (const bf16_t*)(p.ws + WS_WOUT), 1024, 1024, 1024};
        pg8::StaticOrder S; S.init(T_TOK, 1024, nvb, vb0, 1024, 1024);
        pg8::gemm_phase((PG8_LAS unsigned char*)smem, g, S, pg8::EpiResid{xin, p.out, (const float*)(p.ws + WS_MOD) + (size_t)l * 8 * 6144}, TIDX());
    }
    else if (PH == PH_NORM2) ph_norm(p, l, 1, p.out, vb0, nvb);
    else if (PH == PH_GEMM_Q) {
        pg8::Gemm g{(const bf16_t*)(p.ws + WS_H), (const bf16_t*)(p.ws + WS_WQ), 1024, 1024, 1024};
        pg8::StaticOrder S; S.init(T_TOK, 2048, nvb, vb0, 1024, 1024);
        pg8::gemm_phase((PG8_LAS unsigned char*)smem, g, S, pg8::EpiBf16{(bf16_t*)(p.ws + WS_QP), 2048}, TIDX());
    }
    else if (PH == PH_GEMM_SC) gemm_phase((const bf16_t*)(p.ws + WS_QP), 2048, (const bf16_t*)(p.ws + WS_SK), 128, T_TOK, 2048, 128, true,
                                          EpiF16{(_Float16*)(p.ws + WS_SC), 2048}, vb0, nvb, smem, TIDX());
    else if (PH == PH_ROUTE) ph_route(p, vb0, nvb, smem);
    else if (PH == PH_G1) ph_peer_sliced<0>(p, l, smem);
    else if (PH == PH_G15) ph_peer_coef(p, vb0, nvb);
    else if (PH == PH_G2) ph_peer_sliced<1>(p, l, smem);

}

#define XB_TMO      128
#define XB_XCNT(j)  (256  + 64 * (j))
#define XB_XSUB(j)  (1280 + 64 * (j))
#define XB_XGEN(j)  (2304 + 64 * (j))
#define XB_TOP      3328
#define XB_TOPGEN   3392
#define XCD_BAR_WORDS 3456
#define XB_SPIN_CAP (1u << 18)
#define LAS __attribute__((address_space(3)))
__device__ __forceinline__ unsigned xb_ld(unsigned* p)              { return __hip_atomic_load(p, __ATOMIC_RELAXED, __HIP_MEMORY_SCOPE_AGENT); }
__device__ __forceinline__ unsigned xb_add(unsigned* p, unsigned v) { return __hip_atomic_fetch_add(p, v, __ATOMIC_RELAXED, __HIP_MEMORY_SCOPE_AGENT); }
#define XB_SPIN(cond, bar) do { unsigned _sp = 0; while (cond) { __builtin_amdgcn_s_sleep(1); \
    if ((++_sp & 255u) == 0u) { if (xb_ld(&(bar)[XB_TMO])) break; if (_sp > XB_SPIN_CAP) { atomicAdd(&(bar)[XB_TMO], 1u); break; } } } } while (0)
struct XcdBarrier { unsigned* bar; unsigned x; volatile LAS unsigned* st; int wv; };
__device__ __forceinline__ XcdBarrier xcd_barrier_post(unsigned* bar, volatile LAS unsigned* st, int wv) {
    XcdBarrier b; b.bar = bar; b.x = xb_xcc_id(); b.st = st; b.wv = wv;
    if (TIDXW(wv) == 0) (void)xb_add(&bar[XB_XCNT(b.x)], 1u);
    return b;
}
__device__ __forceinline__ void xcd_barrier_complete(unsigned* bar, unsigned x, unsigned& nloc, unsigned& nx) {
    const unsigned G = gridDim.x * gridDim.y * gridDim.z;
    unsigned sum, cnt, mine, sp = 0u;
    for (;;) {
        sum = 0u; cnt = 0u; mine = 0u;
#pragma unroll
        for (unsigned j = 0; j < 16; ++j) { const unsigned c = xb_ld(&bar[XB_XCNT(j)]); sum += c; cnt += (c > 0u) ? 1u : 0u; mine = (j == x) ? c : mine; }
        if (sum == G) break;
        __builtin_amdgcn_s_sleep(1);
        if ((++sp & 255u) == 0u) { if (xb_ld(&bar[XB_TMO])) break; if (sp > XB_SPIN_CAP) { atomicAdd(&bar[XB_TMO], 1u); break; } }
    }
    nloc = mine > 0u ? mine : 1u; nx = cnt > 0u ? cnt : 1u;
}
__device__ __forceinline__ void xcd_barrier(const XcdBarrier& b) {
    asm volatile("s_waitcnt vmcnt(0)" ::: "memory");
    __syncthreads();
    if (TIDXW(b.wv) == 0) {
        unsigned* bar = b.bar;
        __builtin_amdgcn_s_waitcnt(0);
        unsigned nloc = b.st[0], nx = b.st[1];
        if (nloc == 0u) { xcd_barrier_complete(bar, b.x, nloc, nx); b.st[0] = nloc; b.st[1] = nx; }
        const unsigned old = xb_add(&bar[XB_XSUB(b.x)], 1u);
        const unsigned gen = old / nloc;
        if (old + 1u == (gen + 1u) * nloc) {
            __builtin_amdgcn_fence(__ATOMIC_RELEASE, "agent");
            asm volatile("s_waitcnt vmcnt(0)" ::: "memory");
            const unsigned og = xb_add(&bar[XB_TOP], 1u);
            const unsigned tg = og / nx;
            if (og + 1u == (tg + 1u) * nx) xb_add(&bar[XB_TOPGEN], 1u);
            else XB_SPIN(xb_ld(&bar[XB_TOPGEN]) == tg, bar);
            __builtin_amdgcn_fence(__ATOMIC_ACQUIRE, "agent");
            xb_add(&bar[XB_XGEN(b.x)], 1u);
            asm volatile("s_waitcnt vmcnt(0)" ::: "memory");
        } else {
            XB_SPIN(xb_ld(&bar[XB_XGEN(b.x)]) == gen, bar);
            __builtin_amdgcn_fence(__ATOMIC_ACQUIRE, "agent");
            asm volatile("s_waitcnt vmcnt(0)" ::: "memory");
        }
    }
    __syncthreads();
}

__global__ void __launch_bounds__(NT) mega_kernel(Params p_in) {
#if defined(__HIP_DEVICE_COMPILE__)
    extern __shared__ __attribute__((aligned(16))) char smem[];
    volatile LAS unsigned* st = (volatile LAS unsigned*)(smem + LDS_BYTES - 16);
    int wv_ = __builtin_amdgcn_readfirstlane((int)threadIdx.x >> 6); asm volatile("" : "+s"(wv_));
    { const int t_ = TIDXW(wv_); if (t_ < 4) st[t_] = 0u; }
    __syncthreads();
    XcdBarrier bar = xcd_barrier_post((unsigned*)(p_in.ws + WS_CTL), st, wv_);
    const int vb = (int)blockIdx.x, nvb = (int)gridDim.x;
#define GB() xcd_barrier(bar)
#define RUN(PH, L) do { \
        const __attribute__((address_space(4))) Params* _kp = (const __attribute__((address_space(4))) Params*)__builtin_amdgcn_kernarg_segment_ptr(); asm volatile("" : "+s"(_kp)); Params _p = *_kp; _p.wv = wv_; \
        int _l = (L), _vb = vb, _nvb = nvb; asm volatile("" : "+s"(_l), "+s"(_vb), "+s"(_nvb)); \
        run_phase<PH>(_p, _l, _vb, _nvb, smem); } while (0)
    RUN(PH_MOD, 0);
#pragma unroll 1
    for (int l = 0; l < 2; ++l) {
        RUN(PH_WPREP, l); if (l == 0) GB();
        RUN(PH_NORM1, l); GB();
        RUN(PH_GEMM_IN, l); GB();
        RUN(PH_SCAN, l); GB();
        RUN(PH_MERGE, l); GB();
        RUN(PH_OUT, l); GB();
        RUN(PH_NORM2, l); GB();
        RUN(PH_GEMM_Q, l); GB();
        RUN(PH_GEMM_SC, l); GB();
        RUN(PH_ROUTE, l); GB();
        RUN(PH_G1, l); GB();
        RUN(PH_G15, l); GB();
        RUN(PH_G2, l);
        if (l == 0) GB();
    }
#undef RUN
#undef GB
#endif
}

extern "C" void kernel_launch(void* const* d_in, const int* in_sizes, int n_in, void* d_out, int out_size, void* d_ws, size_t ws_size,
                              hipStream_t stream) {
    if (n_in != 20 || ws_size < WS_END) { fprintf(stderr, "kernel_launch: bad inputs (n_in %d ws %zu need %zu)\n", n_in, ws_size, (size_t)WS_END); return; }
    Params p{};
    p.x = (const float*)d_in[0]; p.c = (const float*)d_in[1]; p.w_ada = (const float*)d_in[2]; p.b_ada = (const float*)d_in[3];
    p.norm_mix = (const float*)d_in[4]; p.norm_ffn = (const float*)d_in[5]; p.w_in = (const float*)d_in[6]; p.hgrn_lb = (const float*)d_in[7];
    p.hgrn_on = (const float*)d_in[8]; p.dsa_qn = (const float*)d_in[9]; p.dsa_kn = (const float*)d_in[10]; p.gla_up = (const float*)d_in[11];
    p.gla_bias = (const float*)d_in[12]; p.gla_on = (const float*)d_in[13]; p.w_branch = (const float*)d_in[14]; p.w_out = (const float*)d_in[15];
    p.peer_wq = (const float*)d_in[16]; p.peer_keys = (const float*)d_in[17]; p.peer_u = (const float*)d_in[18]; p.peer_v = (const float*)d_in[19];
    p.out = (float*)d_out; p.ws = (unsigned char*)d_ws;
    static int grid = 0;
    if (grid == 0) {
        int dev = 0, cus = 0, per_cu = 0;
        hipGetDevice(&dev);
        hipDeviceGetAttribute(&cus, hipDeviceAttributeMultiprocessorCount, dev);
        hipFuncSetAttribute((const void*)mega_kernel, hipFuncAttributeMaxDynamicSharedMemorySize, LDS_BYTES);
        hipOccupancyMaxActiveBlocksPerMultiprocessor(&per_cu, (const void*)mega_kernel, NT, LDS_BYTES);
        if (per_cu < 1) { fprintf(stderr, "kernel_launch: occupancy query says %d blocks per CU\n", per_cu); per_cu = 1; }
        (void)hipGetLastError();
        grid = cus;
    }
    hipMemsetAsync((char*)d_ws + WS_CTL, 0, 32768, stream);
    void* args[] = {&p};
    hipError_t e = hipLaunchCooperativeKernel((const void*)mega_kernel, dim3(grid), dim3(NT), args, LDS_BYTES, stream);
    if (e != hipSuccess) fprintf(stderr, "cooperative launch failed: %s (grid %d)\n", hipGetErrorString(e), grid);
}
```

```cpp
#include <hip/hip_runtime.h>
#include <stdint.h>
#include <stdio.h>

typedef unsigned short bf16_t;
typedef short bf16x8 __attribute__((ext_vector_type(8)));
typedef float f32x4 __attribute__((ext_vector_type(4)));
typedef unsigned u32x4 __attribute__((ext_vector_type(4)));

#define NT 512
constexpr int T_TOK = 16384, DM = 1024, SEQ = 2048;
constexpr int LDZ = 8704;
constexpr int ZA_Q = 0, ZA_F = 512, ZA_I = 1024, ZA_G = 1536, ZB_Q = 2048, ZB_K = 2560, ZB_V = 3072, ZC_V = 3584, ZC_G = 4096,
              ZB_QI = 4608, ZC_Q = 4864, ZC_K = 5120, ZB_KI = 5376, ZB_WI = 5440, ZC_CODE = 5444, ZM = 5632;
constexpr int IN_COLS = 8532;

constexpr size_t al256(size_t x) { return (x + 255) & ~(size_t)255; }
constexpr size_t WS_CTL = 0;
constexpr size_t WS_MOD = 65536;
constexpr size_t WS_WIN = al256(WS_MOD + (size_t)2 * 8 * 6144 * 4);
constexpr size_t WS_WBR = al256(WS_WIN + (size_t)LDZ * 1024 * 2);
constexpr size_t WS_WOUT = al256(WS_WBR + (size_t)3 * 1024 * 512 * 2);
constexpr size_t WS_WQ = al256(WS_WOUT + (size_t)1024 * 1024 * 2);
constexpr size_t WS_SK = al256(WS_WQ + (size_t)2048 * 1024 * 2);
constexpr size_t WS_PU = al256(WS_SK + (size_t)16 * 128 * 128 * 2);
constexpr size_t WS_PV = al256(WS_PU + (size_t)16384 * 1024);
constexpr size_t WS_H = al256(WS_PV + (size_t)16384 * 1024);
constexpr float PU_SCALE = 32.f, PV_SCALE = 4.f;
constexpr size_t WS_OA = al256(WS_H + (size_t)T_TOK * 1024 * 2);
constexpr size_t WS_OC = al256(WS_OA + (size_t)T_TOK * 512 * 2);
constexpr size_t WS_Y = al256(WS_OC + (size_t)T_TOK * 512 * 2);
constexpr size_t WS_Z = al256(WS_Y + (size_t)T_TOK * 1536 * 2);
constexpr size_t WS_VT = al256(WS_Z + (size_t)T_TOK * LDZ * 2);
constexpr size_t WS_BM = al256(WS_VT + (size_t)T_TOK * 512 * 2);
constexpr size_t WS_END = al256(WS_BM + (size_t)T_TOK * 64 * 4);
constexpr size_t WS_QP = WS_Z;
constexpr size_t WS_SC = al256(WS_QP + (size_t)T_TOK * 2048 * 2);
constexpr size_t WS_RI = al256(WS_SC + (size_t)T_TOK * 2048 * 4);
constexpr size_t WS_RG = al256(WS_RI + (size_t)T_TOK * 128 * 4);
constexpr size_t WS_PP = al256(WS_RG + (size_t)T_TOK * 128 * 4);
static_assert(WS_PP + (size_t)8 * T_TOK * 128 * 4 <= WS_VT, "peer partials overflow the Z region");
static_assert(WS_RG + (size_t)T_TOK * 128 * 4 <= WS_END, "peer alias overflow");

struct Params {
    const float* x; const float* c; const float* w_ada; const float* b_ada; const float* norm_mix; const float* norm_ffn;
    const float* w_in; const float* hgrn_lb; const float* hgrn_on; const float* dsa_qn; const float* dsa_kn;
    const float* gla_up; const float* gla_bias; const float* gla_on; const float* w_branch; const float* w_out;
    const float* peer_wq; const float* peer_keys; const float* peer_u; const float* peer_v;
    float* out; unsigned char* ws;
    int wv, pad;
};

__device__ __forceinline__ float bf2f(bf16_t h) { return __uint_as_float(((unsigned)h) << 16); }
__device__ __forceinline__ float bflo(unsigned u) { return __uint_as_float(u << 16); }
__device__ __forceinline__ float bfhi(unsigned u) { return __uint_as_float(u & 0xffff0000u); }
__device__ __forceinline__ bf16_t f2bf(float f) { unsigned r; asm volatile("v_cvt_pk_bf16_f32 %0, %1, %1" : "=v"(r) : "v"(f)); return (bf16_t)(r & 0xffffu); }
__device__ __forceinline__ unsigned pack2(float a, float b) { unsigned r; asm volatile("v_cvt_pk_bf16_f32 %0, %1, %2" : "=v"(r) : "v"(a), "v"(b)); return r; }
__device__ __forceinline__ int lane_id_opaque() { int l; asm volatile("v_mbcnt_lo_u32_b32 %0, -1, 0\n\tv_mbcnt_hi_u32_b32 %0, -1, %0" : "=v"(l)); return l; }
template <int M> __device__ __forceinline__ int shx_i(int v) {
    if (M < 32) return __builtin_amdgcn_ds_swizzle(v, (M << 10) | 0x1f);
    return __builtin_amdgcn_ds_bpermute((lane_id_opaque() ^ 32) << 2, v);
}
template <int M> __device__ __forceinline__ float shx(float v) { return __int_as_float(shx_i<M>(__float_as_int(v))); }
template <int M> __device__ __forceinline__ int shx(int v) { return shx_i<M>(v); }
template <int M> __device__ __forceinline__ unsigned shx(unsigned v) { return (unsigned)shx_i<M>((int)v); }
__device__ __forceinline__ int bperm(int v, int src) { return __builtin_amdgcn_ds_bpermute(src << 2, v); }
__device__ __forceinline__ float bperm(float v, int src) { return __int_as_float(__builtin_amdgcn_ds_bpermute(src << 2, __float_as_int(v))); }
__device__ __forceinline__ float wave_sum(float v) { v += shx<32>(v); v += shx<16>(v); v += shx<8>(v); v += shx<4>(v); v += shx<2>(v); v += shx<1>(v); return v; }
__device__ __forceinline__ float wave_max(float v) { v = fmaxf(v, shx<32>(v)); v = fmaxf(v, shx<16>(v)); v = fmaxf(v, shx<8>(v)); v = fmaxf(v, shx<4>(v)); v = fmaxf(v, shx<2>(v)); v = fmaxf(v, shx<1>(v)); return v; }
__device__ __forceinline__ int wave_sum_i(int v) { v += shx<32>(v); v += shx<16>(v); v += shx<8>(v); v += shx<4>(v); v += shx<2>(v); v += shx<1>(v); return v; }
__device__ __forceinline__ int wave_total_i(int v) {
    v += __builtin_amdgcn_update_dpp(0, v, 0x111, 0xf, 0xf, true);
    v += __builtin_amdgcn_update_dpp(0, v, 0x112, 0xf, 0xf, true);
    v += __builtin_amdgcn_update_dpp(0, v, 0x114, 0xf, 0xf, true);
    v += __builtin_amdgcn_update_dpp(0, v, 0x118, 0xf, 0xf, true);
    v += __builtin_amdgcn_update_dpp(0, v, 0x142, 0xa, 0xf, true);
    v += __builtin_amdgcn_update_dpp(0, v, 0x143, 0xc, 0xf, true);
    return __builtin_amdgcn_readlane(v, 63);
}
__device__ __forceinline__ float sigm(float x) { return __frcp_rn(1.f + __expf(-x)); }

__device__ __forceinline__ unsigned xb_xcc_id() { return (unsigned)__builtin_amdgcn_s_getreg((3 << 11) | 20) & 0xFu; }
__device__ __forceinline__ int TIDXW(int wv) { int t; asm volatile("v_mbcnt_lo_u32_b32 %0, -1, 0\n\tv_mbcnt_hi_u32_b32 %0, -1, %0\n\tv_lshl_or_b32 %0, %1, 6, %0" : "=v"(t) : "s"(wv)); return t; }
#define TIDX() TIDXW(p.wv)

__device__ __forceinline__ int src_col(int j) {
    if (j < 3584) return j;
    if (j < 4096) return j - 3584 + 4420;
    if (j < 4608) return j - 4096 + 4948;
    if (j < 4864) return j - 4608 + 3584;
    if (j < 5120) return j - 4864 + 3908;
    if (j < 5376) return j - 5120 + 4164;
    if (j < 5440) return j - 5376 + 3840;
    if (j < 5444) return j - 5440 + 3904;
    if (j < 5460) return j - 5444 + 4932;
    if (j < 5632) return -1;
    return j - 5632 + 5460;
}

__device__ void ph_mod(const Params& p, int vb0, int nvb, char* smem_) {
    float* sc = (float*)smem_;
    float* part = sc + 8 * 1024;
    float* mod = (float*)(p.ws + WS_MOD);
    const int tid = TIDX(), lane = tid & 63, wave = tid >> 6;
    if (vb0 >= 192) return;
    for (int i = tid; i < 8 * 1024; i += NT) { float c = p.c[i]; sc[i] = c / (1.f + __expf(-c)); }
    __syncthreads();
    for (int task = vb0; task < 192; task += nvb) {
        const int l = task / 96, n0 = (task % 96) * 64;
        const float* w = p.w_ada + (size_t)l * 1024 * 6144 + (size_t)(wave * 128) * 6144 + n0 + lane;
        float acc[8];
#pragma unroll
        for (int b = 0; b < 8; ++b) acc[b] = 0.f;
#pragma unroll 1
        for (int k0 = 0; k0 < 128; k0 += 16) {
            float wv[16];
#pragma unroll
            for (int j = 0; j < 16; ++j) wv[j] = w[(size_t)(k0 + j) * 6144];
#pragma unroll
            for (int j = 0; j < 16; ++j)
#pragma unroll
                for (int b = 0; b < 8; ++b) acc[b] += sc[b * 1024 + wave * 128 + k0 + j] * wv[j];
        }
#pragma unroll
        for (int b = 0; b < 8; ++b) part[(wave * 8 + b) * 64 + lane] = acc[b];
        __syncthreads();
        {
            const int b = tid >> 6, col = tid & 63;
            float v = p.b_ada[l * 6144 + n0 + col];
#pragma unroll
            for (int w_ = 0; w_ < 8; ++w_) v += part[(w_ * 8 + b) * 64 + col];
            mod[(size_t)(l * 8 + b) * 6144 + n0 + col] = v;
        }
        __syncthreads();
    }
}

template <bool MAP>
__device__ void tr_tile(const float* __restrict__ src, int lds_, bf16_t* __restrict__ out, int ldo, int k0, int n0, float* tile, const int tid) {
#pragma unroll
    for (int i = 0; i < 8; ++i) {
        int kk = (tid >> 6) + 8 * i, nn = tid & 63;
        int scol = MAP ? src_col(n0 + nn) : (n0 + nn);
        float v = (scol >= 0) ? src[(size_t)(k0 + kk) * lds_ + scol] : 0.f;
        tile[kk * 65 + nn] = v;
    }
    __syncthreads();
#pragma unroll
    for (int i = 0; i < 4; ++i) {
        int nn = (tid >> 5) + 16 * i, kk = (tid & 31) * 2;
        unsigned v = pack2(tile[kk * 65 + nn], tile[(kk + 1) * 65 + nn]);
        *(unsigned*)(out + (size_t)(n0 + nn) * ldo + k0 + kk) = v;
    }
    __syncthreads();
}
__device__ void conv_chunk(const float* __restrict__ src, bf16_t* __restrict__ dst, size_t base, const int tid) {
#pragma unroll
    for (int i = 0; i < 4; ++i) {
        size_t e = base + (size_t)(i * NT + tid) * 8;
        float4 a = *(const float4*)(src + e), b = *(const float4*)(src + e + 4);
        uint4 o; o.x = pack2(a.x, a.y); o.y = pack2(a.z, a.w); o.z = pack2(b.x, b.y); o.w = pack2(b.z, b.w);
        *(uint4*)(dst + e) = o;
    }
}
__device__ void conv_chunk_fp8(const float* __restrict__ src, unsigned char* __restrict__ dst, size_t base, float scale, const int tid) {
#pragma unroll
    for (int i = 0; i < 4; ++i) {
        size_t e = base + (size_t)(i * NT + tid) * 8;
        float4 a = *(const float4*)(src + e), b = *(const float4*)(src + e + 4);
        int lo = __builtin_amdgcn_cvt_pk_fp8_f32(a.x * scale, a.y * scale, 0, false); lo = __builtin_amdgcn_cvt_pk_fp8_f32(a.z * scale, a.w * scale, lo, true);
        int hi = __builtin_amdgcn_cvt_pk_fp8_f32(b.x * scale, b.y * scale, 0, false); hi = __builtin_amdgcn_cvt_pk_fp8_f32(b.z * scale, b.w * scale, hi, true);
        const size_t row = e >> 10, col = e & 1023;
        *(uint2*)(dst + ((col >> 7) * 16384 + row) * 128 + (col & 127)) = make_uint2((unsigned)lo, (unsigned)hi);
    }
}
__device__ void ph_wprep(const Params& p, int l, int vb0, int nvb, char* smem_) {
    float* tile = (float*)smem_;
    const int tid = TIDX();
    bf16_t* WIN = (bf16_t*)(p.ws + WS_WIN); bf16_t* WBR = (bf16_t*)(p.ws + WS_WBR); bf16_t* WOUT = (bf16_t*)(p.ws + WS_WOUT);
    bf16_t* WQ = (bf16_t*)(p.ws + WS_WQ); bf16_t* SK = (bf16_t*)(p.ws + WS_SK); unsigned char* PU = p.ws + WS_PU; unsigned char* PV = p.ws + WS_PV;
    constexpr int N_WIN = 136 * 16, N_WBR = 3 * 16 * 8, N_WOUT = 16 * 16, N_WQ = 32 * 16, N_SK = 16, N_PU = 1024, N_PV = 1024;
    constexpr int TOTAL = N_WIN + N_WBR + N_WOUT + N_WQ + N_SK + N_PU + N_PV;
    for (int task = vb0; task < TOTAL; task += nvb) {
        int r = task;
        if (r < N_WIN) { int nt = r / 16, kt = r % 16; tr_tile<true>(p.w_in + (size_t)l * 1024 * IN_COLS, IN_COLS, WIN, 1024, kt * 64, nt * 64, tile, tid); continue; }
        r -= N_WIN;
        if (r < N_WBR) { int g = r / 128, rr = r % 128, nt = rr / 8, kt = rr % 8;
            tr_tile<false>(p.w_branch + (size_t)(l * 3 + g) * 512 * 1024, 1024, WBR + (size_t)g * 1024 * 512, 512, kt * 64, nt * 64, tile, tid); continue; }
        r -= N_WBR;
        if (r < N_WOUT) { int nt = r / 16, kt = r % 16; tr_tile<false>(p.w_out + (size_t)l * 1024 * 1024, 1024, WOUT, 1024, kt * 64, nt * 64, tile, tid); continue; }
        r -= N_WOUT;
        if (r < N_WQ) { int nt = r / 16, kt = r % 16; tr_tile<false>(p.peer_wq + (size_t)l * 1024 * 2048, 2048, WQ, 1024, kt * 64, nt * 64, tile, tid); continue; }
        r -= N_WQ;
        if (r < N_SK) { conv_chunk(p.peer_keys + (size_t)l * 16 * 128 * 128, SK, (size_t)r * 16384, tid); continue; }
        r -= N_SK;
        if (r < N_PU) { conv_chunk_fp8(p.peer_u + (size_t)l * 16384 * 1024, PU, (size_t)r * 16384, PU_SCALE, tid); continue; }
        r -= N_PU;
        conv_chunk_fp8(p.peer_v + (size_t)l * 16384 * 1024, PV, (size_t)r * 16384, PV_SCALE, tid);
    }
}

__device__ void ph_norm(const Params& p, int l, int which, const float* xin, int vb0, int nvb) {
    const int wave = TIDX() >> 6, lane = TIDX() & 63;
    const float* gain = (which ? p.norm_ffn : p.norm_mix) + l * 1024;
    const float* modb = (const float*)(p.ws + WS_MOD);
    bf16_t* H = (bf16_t*)(p.ws + WS_H);
    for (int t = vb0 * 8 + wave; t < T_TOK; t += nvb * 8) {
        int b = t >> 11;
        const float* mod = modb + (size_t)(l * 8 + b) * 6144 + (which ? 3072 : 0);
        const float4* xr = (const float4*)(xin + (size_t)t * 1024);
        float4 v[4]; float ss = 0.f;
#pragma unroll
        for (int i = 0; i < 4; ++i) { v[i] = xr[lane + 64 * i]; ss += v[i].x * v[i].x + v[i].y * v[i].y + v[i].z * v[i].z + v[i].w * v[i].w; }
        ss = wave_sum(ss);
        float rstd = rsqrtf(ss * (1.f / 1024.f) + 1e-6f);
#pragma unroll
        for (int i = 0; i < 4; ++i) {
            int idx = (lane + 64 * i) * 4;
            float4 g = *(const float4*)(gain + idx), sc = *(const float4*)(mod + 1024 + idx), sh = *(const float4*)(mod + idx);
            float h0 = v[i].x * rstd * g.x * (1.f + sc.x) + sh.x, h1 = v[i].y * rstd * g.y * (1.f + sc.y) + sh.y;
            float h2 = v[i].z * rstd * g.z * (1.f + sc.z) + sh.z, h3 = v[i].w * rstd * g.w * (1.f + sc.w) + sh.w;
            uint2 o; o.x = pack2(h0, h1); o.y = pack2(h2, h3);
            *(uint2*)(H + (size_t)t * 1024 + idx) = o;
        }
    }
}

constexpr int GBM = 256, GBN = 128, GBK = 64, GLS = 72;
__device__ __forceinline__ void gemm_tile(const bf16_t* __restrict__ A, int lda, const bf16_t* __restrict__ Bt, int ldb, int K,
                                          int m0, int n0, bf16_t* sA, bf16_t* sB, f32x4 (&acc)[4][4], const int tid) {
    const int lane = tid & 63, wave = tid >> 6;
    const int wm = wave >> 1, wn = wave & 1, fr = lane & 15, fq = lane >> 4;
    u32x4 ra[4], rb[2];
    const int crow = tid >> 3, ckc = (tid & 7) * 8;
    const bf16_t* Ag = A + (size_t)(m0 + crow) * lda + ckc;
    const bf16_t* Bg = Bt + (size_t)(n0 + crow) * ldb + ckc;
#pragma unroll
    for (int i = 0; i < 4; ++i) ra[i] = *(const u32x4*)(Ag + (size_t)(64 * i) * lda);
#pragma unroll
    for (int i = 0; i < 2; ++i) rb[i] = *(const u32x4*)(Bg + (size_t)(64 * i) * ldb);
    for (int k0 = 0; k0 < K; k0 += GBK) {
        __syncthreads();
#pragma unroll
        for (int i = 0; i < 4; ++i) *(u32x4*)(sA + (crow + 64 * i) * GLS + ckc) = ra[i];
#pragma unroll
        for (int i = 0; i < 2; ++i) *(u32x4*)(sB + (crow + 64 * i) * GLS + ckc) = rb[i];
        __syncthreads();
        {
            const int kn = (k0 + GBK < K) ? (k0 + GBK) : k0;
#pragma unroll
            for (int i = 0; i < 4; ++i) ra[i] = *(const u32x4*)(Ag + (size_t)(64 * i) * lda + kn);
#pragma unroll
            for (int i = 0; i < 2; ++i) rb[i] = *(const u32x4*)(Bg + (size_t)(64 * i) * ldb + kn);
        }
#pragma unroll
        for (int ks = 0; ks < 2; ++ks) {
            bf16x8 af[4], wf[4];
#pragma unroll
            for (int mf = 0; mf < 4; ++mf) af[mf] = *(const bf16x8*)(sA + (wm * 64 + mf * 16 + fr) * GLS + ks * 32 + fq * 8);
#pragma unroll
            for (int nf = 0; nf < 4; ++nf) wf[nf] = *(const bf16x8*)(sB + (wn * 64 + nf * 16 + fr) * GLS + ks * 32 + fq * 8);
#pragma unroll
            for (int nf = 0; nf < 4; ++nf)
#pragma unroll
                for (int mf = 0; mf < 4; ++mf)
                    acc[nf][mf] = __builtin_amdgcn_mfma_f32_16x16x32_bf16(wf[nf], af[mf], acc[nf][mf], 0, 0, 0);
        }
    }
}


namespace pg8 {
#define PG8_LAS __attribute__((address_space(3)))
constexpr int BM = 256, BK = 64, HALF = 128, HTB = HALF * BK * 2, STAGE_BYTES = 8 * HTB, NXCD = 8, WGM = 8;
__device__ __forceinline__ int lds_byte(int r, int c) { const int st = (r >> 4) * 2 + (c >> 5), rr = r & 15, cc = c & 31, ob = rr * 64 + cc * 2; return st * 1024 + (ob ^ (((ob >> 9) & 1) << 5)); }
__device__ __forceinline__ void stage_rc(int b, int& R, int& C) { const int st = b / 1024, sb = b % 1024, swz = sb ^ (((sb >> 9) & 1) << 5); R = (st >> 1) * 16 + swz / 64; C = (st & 1) * 32 + (swz % 64) / 2; }
__device__ __forceinline__ int perm32(int rho) { const int n = rho >> 4, i = rho & 15; return 8 * (i >> 2) + 4 * n + (i & 3); }
struct Unit { int pm, pn, aux; size_t aoff, boff; };
struct Gemm { const bf16_t* A; const bf16_t* Bt; int lda, ldb, K; };

struct StaticOrder {
    int nM, nN, nwg, G, c, lda, ldb;
    __device__ void init(int M, int N, int G_, int c_, int lda_, int ldb_) { nM = M / BM; nN = N / BM; nwg = nM * nN; G = G_; c = c_; lda = lda_; ldb = ldb_; }
    __device__ bool next(int i, Unit& u) const {
        const long L = (long)i * G + c; if (L >= nwg) return false;
        int wgid = (int)L; { const int q = nwg / NXCD, r = nwg % NXCD, xcd = wgid % NXCD, off = wgid / NXCD; wgid = (xcd < r ? xcd * (q + 1) : r * (q + 1) + (xcd - r) * q) + off; }
        const int nig = WGM * nN, gid = wgid / nig, fm = gid * WGM, gsz = (nM - fm) < WGM ? (nM - fm) : WGM;
        u.pm = fm + ((wgid % nig) % gsz); u.pn = (wgid % nig) / gsz; u.aux = 0;
        u.aoff = (size_t)u.pm * BM * lda * 2; u.boff = (size_t)u.pn * BM * ldb * 2;
        return true;
    }
};
struct MergeOrder {
    int c, G;
    __device__ bool next(int i, Unit& u) const {
        const int tile = c + (i / 3) * G; if (tile >= 256) return false;
        u.pm = tile & 63; u.pn = tile >> 6; u.aux = i % 3;
        u.aoff = ((size_t)u.pm * BM * 1536 + (size_t)u.aux * 512) * 2; u.boff = ((size_t)u.aux * 1024 + (size_t)u.pn * BM) * 512 * 2;
        return true;
    }
};

template <class Epi, class Sched>
__device__ __forceinline__ void gemm_phase(PG8_LAS unsigned char* lds, const Gemm g, const Sched& S, const Epi& E, const int tid) {
    const int wid = __builtin_amdgcn_readfirstlane(tid >> 6), lane = tid & 63, wr = wid >> 2, wc = wid & 3, fr = lane & 15, fq = lane >> 4;
    const int K = g.K, nt = K / BK;
    unsigned voffA[2], voffB[2];
#pragma unroll
    for (int i = 0; i < 2; ++i) { int R, C; stage_rc(tid * 16 + i * 8192, R, C); const int Rb = Epi::PERM ? ((R & ~31) + perm32(R & 31)) : R;
        voffA[i] = (unsigned)(R * g.lda + C) * 2u; voffB[i] = (unsigned)(Rb * g.ldb + C) * 2u; }
    const size_t kstep = (size_t)(BK * 2);
    const size_t hstepA = (size_t)HALF * g.lda * 2, hstepB = (size_t)HALF * g.ldb * 2;
    const unsigned ldsw = (unsigned)wid * 1024u;
    const int aoff = lds_byte(wr * 64 + fr, fq * 8), boff = lds_byte(wc * 32 + fr, fq * 8);
#define PG8_SA(b, h) (((b) * 2 + (h)) * HTB)
#define PG8_SB(b, h) ((4 + (b) * 2 + (h)) * HTB)
#define PG8_STAGE(bufoff, gbase, voff) do { _Pragma("unroll") for (int _i = 0; _i < 2; ++_i) \
        __builtin_amdgcn_global_load_lds((const unsigned*)((const char*)(gbase) + (voff)[_i]), (PG8_LAS unsigned*)(lds + (bufoff) + ldsw + _i * 8192), 16, 0, 0); } while (0)
#define PG8_LDA(dst, b, h) do { _Pragma("unroll") for (int m = 0; m < 4; ++m) _Pragma("unroll") for (int k = 0; k < 2; ++k) dst[m][k] = *(const PG8_LAS bf16x8*)(lds + PG8_SA(b, h) + aoff + m * 2048 + k * 1024); } while (0)
#define PG8_LDB(dst, b, h) do { _Pragma("unroll") for (int n = 0; n < 2; ++n) _Pragma("unroll") for (int k = 0; k < 2; ++k) dst[n][k] = *(const PG8_LAS bf16x8*)(lds + PG8_SB(b, h) + boff + n * 2048 + k * 1024); } while (0)
#define PG8_MMA(ai, bj, At, Bt) do { __builtin_amdgcn_s_setprio(1); _Pragma("unroll") for (int m = 0; m < 4; ++m) _Pragma("unroll") for (int n = 0; n < 2; ++n) _Pragma("unroll") for (int k = 0; k < 2; ++k) \
        acc[ai][bj][m][n] = __builtin_amdgcn_mfma_f32_16x16x32_bf16(Bt[n][k], At[m][k], acc[ai][bj][m][n], 0, 0, 0); __builtin_amdgcn_s_setprio(0); } while (0)
#define PG8_WAIT_V(n) asm volatile("s_waitcnt vmcnt(" #n ")" ::: "memory")
#define PG8_WAIT_L(n) asm volatile("s_waitcnt lgkmcnt(" #n ")" ::: "memory")
#define PG8_BAR __builtin_amdgcn_s_barrier()
#define PG8_SCHED __builtin_amdgcn_sched_barrier(0)
    Unit cur, nxt; int ui = 0;
    if (!S.next(0, cur)) return;
    f32x4 acc[2][2][4][2];
#pragma unroll
    for (int a = 0; a < 2; ++a)
#pragma unroll
        for (int b = 0; b < 2; ++b)
#pragma unroll
            for (int m = 0; m < 4; ++m)
#pragma unroll
                for (int n = 0; n < 2; ++n) acc[a][b][m][n] = f32x4{0.f, 0.f, 0.f, 0.f};
    bf16x8 At[4][2], B0[2][2], B1[2][2];
    const char* cA = (const char*)g.A + cur.aoff; const char* cB = (const char*)g.Bt + cur.boff;
    PG8_STAGE(PG8_SB(0, 0), cB, voffB); PG8_STAGE(PG8_SA(0, 0), cA, voffA); PG8_STAGE(PG8_SB(0, 1), cB + hstepB, voffB); PG8_STAGE(PG8_SA(0, 1), cA + hstepA, voffA);
    if (wr == 1) PG8_BAR;
    PG8_WAIT_V(4); PG8_BAR;
    PG8_STAGE(PG8_SB(1, 0), cB + kstep, voffB); PG8_STAGE(PG8_SA(1, 0), cA + kstep, voffA); PG8_STAGE(PG8_SB(1, 1), cB + hstepB + kstep, voffB);
    PG8_WAIT_V(6); PG8_BAR;
    for (;;) {
        const bool has_next = S.next(ui + 1, nxt);
        const char* nA = has_next ? (const char*)g.A + nxt.aoff : cA; const char* nB = has_next ? (const char*)g.Bt + nxt.boff : cB;
        for (int t = 0; t < nt; t += 2) {
            const bool last = (t == nt - 2);
            const char* a1 = cA + (size_t)(t + 1) * kstep;
            const char* a2 = last ? nA : cA + (size_t)(t + 2) * kstep; const char* b2 = last ? nB : cB + (size_t)(t + 2) * kstep;
            const char* a3 = a2 + kstep; const char* b3 = b2 + kstep;
            PG8_LDB(B0, 0, 0); PG8_SCHED; PG8_LDA(At, 0, 0); PG8_STAGE(PG8_SA(1, 1), a1 + hstepA, voffA);
            PG8_WAIT_L(8); PG8_BAR; PG8_WAIT_L(0); PG8_MMA(0, 0, At, B0); PG8_BAR; PG8_SCHED;
            PG8_LDB(B1, 0, 1); PG8_STAGE(PG8_SB(0, 0), b2, voffB);
            PG8_BAR; PG8_WAIT_L(0); PG8_MMA(0, 1, At, B1); PG8_BAR;
            PG8_LDA(At, 0, 1); PG8_STAGE(PG8_SA(0, 0), a2, voffA);
            PG8_BAR; PG8_WAIT_L(0); PG8_MMA(1, 0, At, B0); PG8_BAR; PG8_SCHED;
            PG8_STAGE(PG8_SB(0, 1), b2 + hstepB, voffB);
            PG8_WAIT_V(6); PG8_BAR; PG8_MMA(1, 1, At, B1); PG8_BAR;
            PG8_LDB(B0, 1, 0); PG8_SCHED; PG8_LDA(At, 1, 0); PG8_STAGE(PG8_SA(0, 1), a2 + hstepA, voffA);
            PG8_WAIT_L(8); PG8_BAR; PG8_WAIT_L(0); PG8_MMA(0, 0, At, B0); PG8_BAR; PG8_SCHED;
            PG8_LDB(B1, 1, 1); PG8_STAGE(PG8_SB(1, 0), b3, voffB);
            PG8_BAR; PG8_WAIT_L(0); PG8_MMA(0, 1, At, B1); PG8_BAR;
            PG8_LDA(At, 1, 1); PG8_STAGE(PG8_SA(1, 0), a3, voffA);
            PG8_BAR; PG8_WAIT_L(0); PG8_MMA(1, 0, At, B0); PG8_BAR; PG8_SCHED;
            PG8_STAGE(PG8_SB(1, 1), b3 + hstepB, voffB);
            PG8_WAIT_V(6); PG8_BAR; PG8_MMA(1, 1, At, B1); PG8_BAR;
        }
        E(acc, cur, wr, wc, fr, fq);
        if (!has_next) break;
#pragma unroll
        for (int a = 0; a < 2; ++a)
#pragma unroll
            for (int b = 0; b < 2; ++b)
#pragma unroll
                for (int m = 0; m < 4; ++m)
#pragma unroll
                    for (int n = 0; n < 2; ++n) acc[a][b][m][n] = f32x4{0.f, 0.f, 0.f, 0.f};
        cur = nxt; cA = nA; cB = nB; ++ui;
    }
    PG8_WAIT_V(0);
    if (wr == 0) PG8_BAR;
    PG8_BAR;
#undef PG8_SA
#undef PG8_SB
#undef PG8_STAGE
#undef PG8_LDA
#undef PG8_LDB
#undef PG8_MMA
#undef PG8_WAIT_V
#undef PG8_WAIT_L
#undef PG8_BAR
#undef PG8_SCHED
}

struct EpiBf16 {
    static constexpr bool PERM = true;
    bf16_t* O; int ldc;
    __device__ __forceinline__ void operator()(const f32x4 (&acc)[2][2][4][2], const Unit& u, int wr, int wc, int fr, int fq) const {
        const int row0 = u.pm * BM + wr * 64 + fr, col0 = u.pn * BM + wc * 32 + 8 * fq;
#pragma unroll
        for (int ai = 0; ai < 2; ++ai)
#pragma unroll
            for (int m = 0; m < 4; ++m) { bf16_t* rowp = O + (size_t)(row0 + ai * HALF + m * 16) * ldc + col0;
#pragma unroll
                for (int bj = 0; bj < 2; ++bj) { const f32x4 v0 = acc[ai][bj][m][0], v1 = acc[ai][bj][m][1];
                    u32x4 w; w.x = pack2(v0[0], v0[1]); w.y = pack2(v0[2], v0[3]); w.z = pack2(v1[0], v1[1]); w.w = pack2(v1[2], v1[3]);
                    *(u32x4*)(rowp + bj * HALF) = w; } }
    }
};
struct EpiResid {
    static constexpr bool PERM = false;
    const float* xin; float* out; const float* mod;
    __device__ __forceinline__ void operator()(const f32x4 (&acc)[2][2][4][2], const Unit& u, int wr, int wc, int fr, int fq) const {
        const int row0 = u.pm * BM + wr * 64 + fr, col0 = u.pn * BM + wc * 32 + 4 * fq;
        const float* gm = mod + (size_t)(row0 >> 11) * 6144 + 2048 + col0;
        f32x4 g4[2][2];
#pragma unroll
        for (int bj = 0; bj < 2; ++bj)
#pragma unroll
            for (int n = 0; n < 2; ++n) g4[bj][n] = *(const f32x4*)(gm + bj * HALF + n * 16);
#pragma unroll
        for (int ai = 0; ai < 2; ++ai) {
            f32x4 xi[4][2][2];
#pragma unroll
            for (int m = 0; m < 4; ++m)
#pragma unroll
                for (int bj = 0; bj < 2; ++bj)
#pragma unroll
                    for (int n = 0; n < 2; ++n) xi[m][bj][n] = *(const f32x4*)(xin + (size_t)(row0 + ai * HALF + m * 16) * 1024 + col0 + bj * HALF + n * 16);
            asm volatile("" ::: "memory");
#pragma unroll
            for (int m = 0; m < 4; ++m)
#pragma unroll
                for (int bj = 0; bj < 2; ++bj)
#pragma unroll
                    for (int n = 0; n < 2; ++n)
                        *(f32x4*)(out + (size_t)(row0 + ai * HALF + m * 16) * 1024 + col0 + bj * HALF + n * 16) = xi[m][bj][n] + g4[bj][n] * acc[ai][bj][m][n];
            asm volatile("" ::: "memory");
        }
    }
};
struct EpiMerge {
    static constexpr bool PERM = true;
    bf16_t* Hm; const bf16_t* Z;
    __device__ __forceinline__ void operator()(const f32x4 (&acc)[2][2][4][2], const Unit& u, int wr, int wc, int fr, int fq) const {
        const int row0 = u.pm * BM + wr * 64 + fr, col0 = u.pn * BM + wc * 32 + 8 * fq, g = u.aux;
#pragma unroll
        for (int ai = 0; ai < 2; ++ai) {
            u32x4 gz[4][2], prev[4][2];
#pragma unroll
            for (int m = 0; m < 4; ++m)
#pragma unroll
                for (int bj = 0; bj < 2; ++bj) {
                    const int row = row0 + ai * HALF + m * 16, col = col0 + bj * HALF;
                    gz[m][bj] = *(const u32x4*)(Z + (size_t)row * LDZ + ZM + g * 1024 + col);
                    prev[m][bj] = u32x4{0u, 0u, 0u, 0u};
                    if (g > 0) prev[m][bj] = *(const u32x4*)(Hm + (size_t)row * 1024 + col);
                }
            asm volatile("" ::: "memory");
#pragma unroll
            for (int m = 0; m < 4; ++m)
#pragma unroll
                for (int bj = 0; bj < 2; ++bj) {
                    const int row = row0 + ai * HALF + m * 16, col = col0 + bj * HALF;
                    const f32x4 v0 = acc[ai][bj][m][0], v1 = acc[ai][bj][m][1];
                    const u32x4 z_ = gz[m][bj], p_ = prev[m][bj];
                    u32x4 w;
                    w.x = pack2(bflo(p_.x) + sigm(bflo(z_.x)) * v0[0], bfhi(p_.x) + sigm(bfhi(z_.x)) * v0[1]);
                    w.y = pack2(bflo(p_.y) + sigm(bflo(z_.y)) * v0[2], bfhi(p_.y) + sigm(bfhi(z_.y)) * v0[3]);
                    w.z = pack2(bflo(p_.z) + sigm(bflo(z_.z)) * v1[0], bfhi(p_.z) + sigm(bfhi(z_.z)) * v1[1]);
                    w.w = pack2(bflo(p_.w) + sigm(bflo(z_.w)) * v1[2], bfhi(p_.w) + sigm(bfhi(z_.w)) * v1[3]);
                    *(u32x4*)(Hm + (size_t)row * 1024 + col) = w;
                }
            asm volatile("" ::: "memory");
        }
    }
};
}

struct EpiZ {
    bf16_t* Z; int ld;
    __device__ __forceinline__ void operator()(int m, int n, const f32x4& v) const {
        uint2 o; o.x = pack2(v[0], v[1]); o.y = pack2(v[2], v[3]);
        *(uint2*)(Z + (size_t)m * ld + n) = o;
    }
};
struct EpiF16 {
    _Float16* C; int ld;
    __device__ __forceinline__ void operator()(int m, int n, const f32x4& v) const {
        typedef _Float16 h4 __attribute__((ext_vector_type(4)));
        h4 o = {(_Float16)v[0], (_Float16)v[1], (_Float16)v[2], (_Float16)v[3]};
        *(h4*)(C + (size_t)m * ld + n) = o;
    }
};
struct EpiOut {
    const float* xin; float* out; const float* mod;
    __device__ __forceinline__ void operator()(int m, int n, const f32x4& v) const {
        int b = m >> 11;
        float4 g = *(const float4*)(mod + (size_t)b * 6144 + 2048 + n);
        float4 xi = *(const float4*)(xin + (size_t)m * 1024 + n);
        *(float4*)(out + (size_t)m * 1024 + n) = make_float4(xi.x + g.x * v[0], xi.y + g.y * v[1], xi.z + g.z * v[2], xi.w + g.w * v[3]);
    }
};

template <class Epi>
__device__ void gemm_phase(const bf16_t* A, int lda, const bf16_t* Bt, int ldb, int M, int N, int K, bool batched, Epi epi,
                           int vb0, int nvb, char* smem_, const int tid) {
    bf16_t* sA = (bf16_t*)smem_; bf16_t* sB = sA + GBM * GLS;
    const int lane = tid & 63, wave = tid >> 6, wm = wave >> 1, wn = wave & 1, fr = lane & 15, fq = lane >> 4;
    const int MT = M / GBM, NTL = N / GBN;
    for (int tile = vb0; tile < MT * NTL; tile += nvb) {
        int mt = tile % MT, nt = tile / MT;
        f32x4 acc[4][4];
#pragma unroll
        for (int a = 0; a < 4; ++a)
#pragma unroll
            for (int b = 0; b < 4; ++b) acc[a][b] = f32x4{0.f, 0.f, 0.f, 0.f};
        gemm_tile(batched ? A + nt * 128 : A, lda, Bt, ldb, K, mt * GBM, nt * GBN, sA, sB, acc, tid);
#pragma unroll
        for (int nf = 0; nf < 4; ++nf)
#pragma unroll
            for (int mf = 0; mf < 4; ++mf)
                epi(mt * GBM + wm * 64 + mf * 16 + fr, nt * GBN + wn * 64 + nf * 16 + fq * 4, acc[nf][mf]);
    }
}


template <int DK, bool GLA>
__device__ void scan2_item(const Params& p, int l, int b, int h, char* smem_) {
    constexpr int SEG = NT / DK, SLEN = 64 / SEG, KS = DK / 32, KT = DK / 16;
    constexpr int QS = DK + 8, BS = DK + 4, VS = 72;
    bf16_t* qs = (bf16_t*)smem_;
    bf16_t* ks = qs + 64 * QS;
    float* bs = (float*)(ks + 64 * QS);
    bf16_t* vt = (bf16_t*)(bs + 64 * BS);
    bf16_t* At = vt + 128 * VS;
    bf16_t* kht = At + 64 * VS;
    bf16_t* st = kht + DK * VS;
    float* segtot = (float*)(st + 128 * QS);
    float* blast = segtot + SEG * DK;
    const int tid = TIDX(), lane = tid & 63, wave = __builtin_amdgcn_readfirstlane(tid >> 6), fr = lane & 15, fq = lane >> 4;
    const int kl = tid % DK, seg = __builtin_amdgcn_readfirstlane(tid / DK);
    float lbv = 0.f, gbias = 0.f; float gu[16];
#pragma unroll
    for (int r = 0; r < 16; ++r) gu[r] = 0.f;
    if (GLA) {
#pragma unroll
        for (int r = 0; r < 16; ++r) gu[r] = p.gla_up[(size_t)(l * 16 + r) * 256 + h * 64 + kl];
        gbias = p.gla_bias[l * 256 + h * 64 + kl];
    } else if (l == 1) {
        float x0 = p.hgrn_lb[h * 128 + kl], x1 = p.hgrn_lb[512 + h * 128 + kl];
        lbv = 1.f / (1.f + expf(x0 - x1));
    }
    const float scale = GLA ? 0.125f : 0.08838834764831845f;
    const bf16_t* Zb = (const bf16_t*)(p.ws + WS_Z) + (size_t)(b * 2048) * LDZ;
    float* ssq = (float*)(smem_ + 152576);
    const int QCOL = (GLA ? ZC_Q : ZA_Q) + h * DK, KCOL = (GLA ? ZC_K : ZA_F) + h * DK, VCOL = (GLA ? ZC_V : ZA_I) + h * 128, GCOL = (GLA ? ZC_G : ZA_G) + h * 128;
    f32x4 sacc[KT];
#pragma unroll
    for (int i = 0; i < KT; ++i) sacc[i] = f32x4{0.f, 0.f, 0.f, 0.f};
    for (int i = tid; i < 128 * QS / 2; i += NT) ((unsigned*)st)[i] = 0u;
    __syncthreads();

    for (int c = 0; c < 32; ++c) {
        const bf16_t* Zc = Zb + (size_t)(c * 64) * LDZ;
        {
            bf16_t rq[SLEN], rk[SLEN];
            u32x4 rc0[GLA ? SLEN : 1], rc1[GLA ? SLEN : 1];
            {
                bf16_t rv[16];
                const int v = tid & 127, sb_ = __builtin_amdgcn_readfirstlane(tid >> 7);
#pragma unroll
                for (int i = 0; i < 16; ++i) rv[i] = Zc[(size_t)(sb_ + 4 * i) * LDZ + VCOL + v];
#pragma unroll
                for (int i = 0; i < SLEN; ++i) {
                    const bf16_t* zr = Zc + (size_t)(seg * SLEN + i) * LDZ;
                    rq[i] = zr[QCOL + kl]; rk[i] = zr[KCOL + kl];
                    if (GLA) { rc0[i] = *(const u32x4*)(zr + ZC_CODE); rc1[i] = *(const u32x4*)(zr + ZC_CODE + 8); }
                }
#pragma unroll
                for (int i = 0; i < 16; ++i) vt[v * VS + sb_ + 4 * i] = rv[i];
            }
            float run = 0.f;
#pragma unroll
            for (int i = 0; i < SLEN; ++i) {
                const int s_ = seg * SLEN + i;
                float g, kk;
                if (GLA) {
                    float x = gbias;
#pragma unroll
                    for (int r = 0; r < 4; ++r) {
                        x += bflo(rc0[i][r]) * gu[2 * r] + bfhi(rc0[i][r]) * gu[2 * r + 1];
                        x += bflo(rc1[i][r]) * gu[8 + 2 * r] + bfhi(rc1[i][r]) * gu[8 + 2 * r + 1];
                    }
                    g = (fminf(x, 0.f) - __logf(1.f + __expf(-fabsf(x)))) * (1.f / 16.f);
                    kk = bf2f(rk[i]);
                } else {
                    const float f = lbv + (1.f - lbv) * __frcp_rn(1.f + __expf(-bf2f(rk[i])));
                    g = __logf(f); kk = 1.f - f;
                }
                run += g;
                bs[s_ * BS + kl] = run;
                qs[s_ * QS + kl] = rq[i];
                ks[s_ * QS + kl] = f2bf(kk);
            }
            segtot[seg * DK + kl] = run;
        }
        __syncthreads();
        {
            float pre = 0.f, tot = 0.f;
#pragma unroll
            for (int g_ = 0; g_ < SEG; ++g_) { const float v_ = segtot[g_ * DK + kl]; if (g_ < seg) pre += v_; tot += v_; }
            if (seg == 0) blast[kl] = tot;
            unsigned pk[SLEN / 2];
#pragma unroll
            for (int i = 0; i < SLEN; ++i) {
                const float bv = bs[(seg * SLEN + i) * BS + kl] + pre;
                bs[(seg * SLEN + i) * BS + kl] = bv;
                const float kh = bf2f(ks[(seg * SLEN + i) * QS + kl]) * __expf(tot - bv);
                if (i & 1) pk[i >> 1] |= ((unsigned)f2bf(kh)) << 16; else pk[i >> 1] = (unsigned)f2bf(kh);
            }
            unsigned* dst = (unsigned*)(kht + kl * VS + seg * SLEN);
#pragma unroll
            for (int i = 0; i < SLEN / 2; ++i) dst[i] = pk[i];
        }
        __syncthreads();
        for (int blk = wave; blk < 10; blk += 8) {
            int bi, bj;
            if (blk < 1) { bi = 0; bj = 0; } else if (blk < 3) { bi = 1; bj = blk - 1; } else if (blk < 6) { bi = 2; bj = blk - 3; } else { bi = 3; bj = blk - 6; }
            f32x4 acc = f32x4{0.f, 0.f, 0.f, 0.f};
            const int srow = bj * 16 + fr, trow = bi * 16 + fr;
#pragma unroll
            for (int kk = 0; kk < KS; ++kk) {
                const int k0 = kk * 32 + fq * 8;
                float br[8];
                if (bi == 0) {
#pragma unroll
                    for (int j = 0; j < 8; ++j) br[j] = 0.f;
                } else {
                    const float4 r0 = *(const float4*)(bs + (bi * 16 - 1) * BS + k0), r1 = *(const float4*)(bs + (bi * 16 - 1) * BS + k0 + 4);
                    br[0] = r0.x; br[1] = r0.y; br[2] = r0.z; br[3] = r0.w; br[4] = r1.x; br[5] = r1.y; br[6] = r1.z; br[7] = r1.w;
                }
                const uint4 kq = *(const uint4*)(ks + srow * QS + k0), qq = *(const uint4*)(qs + trow * QS + k0);
                const float4 s0 = *(const float4*)(bs + srow * BS + k0), s1 = *(const float4*)(bs + srow * BS + k0 + 4);
                const float4 t0_ = *(const float4*)(bs + trow * BS + k0), t1_ = *(const float4*)(bs + trow * BS + k0 + 4);
                const float bsv[8] = {s0.x, s0.y, s0.z, s0.w, s1.x, s1.y, s1.z, s1.w}, btv[8] = {t0_.x, t0_.y, t0_.z, t0_.w, t1_.x, t1_.y, t1_.z, t1_.w};
                const unsigned kw[4] = {kq.x, kq.y, kq.z, kq.w}, qw[4] = {qq.x, qq.y, qq.z, qq.w};
                union { bf16x8 v; unsigned u[4]; } ka, qb;
#pragma unroll
                for (int j = 0; j < 4; ++j) {
                    const float e0 = __expf(fminf(br[2 * j] - bsv[2 * j], 60.f)), e1 = __expf(fminf(br[2 * j + 1] - bsv[2 * j + 1], 60.f));
                    ka.u[j] = pack2(bflo(kw[j]) * e0, bfhi(kw[j]) * e1);
                    const float f0 = __expf(btv[2 * j] - br[2 * j]), f1 = __expf(btv[2 * j + 1] - br[2 * j + 1]);
                    qb.u[j] = pack2(bflo(qw[j]) * f0, bfhi(qw[j]) * f1);
                }
                acc = __builtin_amdgcn_mfma_f32_16x16x32_bf16(ka.v, qb.v, acc, 0, 0, 0);
            }
            if (bi == bj) {
#pragma unroll
                for (int r = 0; r < 4; ++r) if (4 * fq + r > fr) acc[r] = 0.f;
            }
            uint2 o; o.x = pack2(acc[0], acc[1]); o.y = pack2(acc[2], acc[3]);
            *(uint2*)(At + trow * VS + bj * 16 + 4 * fq) = o;
        }
        {
            unsigned z_ = 0u; asm volatile("" : "+v"(z_));
            if (wave == 2) *(uint2*)(At + (0 * 16 + fr) * VS + 16 + 4 * fq) = make_uint2(z_, z_);
            if (wave == 3) *(uint2*)(At + (2 * 16 + fr) * VS + 48 + 4 * fq) = make_uint2(z_, z_);
        }
        __syncthreads();
        f32x4 oacc[4]; uint2 gz[4];
        {
            const int ti = wave & 3, vh = wave >> 2, trow = ti * 16 + fr;
            bf16x8 qh[KS];
#pragma unroll
            for (int kk = 0; kk < KS; ++kk) {
                const int k0 = kk * 32 + fq * 8;
                const uint4 qq = *(const uint4*)(qs + trow * QS + k0);
                const float4 t0_ = *(const float4*)(bs + trow * BS + k0), t1_ = *(const float4*)(bs + trow * BS + k0 + 4);
                union { bf16x8 v; unsigned u[4]; } q_;
                q_.u[0] = pack2(bflo(qq.x) * __expf(t0_.x), bfhi(qq.x) * __expf(t0_.y));
                q_.u[1] = pack2(bflo(qq.y) * __expf(t0_.z), bfhi(qq.y) * __expf(t0_.w));
                q_.u[2] = pack2(bflo(qq.z) * __expf(t1_.x), bfhi(qq.z) * __expf(t1_.y));
                q_.u[3] = pack2(bflo(qq.w) * __expf(t1_.z), bfhi(qq.w) * __expf(t1_.w));
                qh[kk] = q_.v;
            }
            const bf16x8 af0 = *(const bf16x8*)(At + trow * VS + fq * 8), af1 = *(const bf16x8*)(At + trow * VS + 32 + fq * 8);
            float sq = 0.f;
#pragma unroll
            for (int vi = 0; vi < 4; ++vi) {
                const int vrow = vh * 64 + vi * 16 + fr;
                gz[vi] = *(const uint2*)(Zc + (size_t)trow * LDZ + GCOL + vh * 64 + vi * 16 + 4 * fq);
                f32x4 acc = f32x4{0.f, 0.f, 0.f, 0.f};
                acc = __builtin_amdgcn_mfma_f32_16x16x32_bf16(*(const bf16x8*)(vt + vrow * VS + fq * 8), af0, acc, 0, 0, 0);
                if (ti >= 2) acc = __builtin_amdgcn_mfma_f32_16x16x32_bf16(*(const bf16x8*)(vt + vrow * VS + 32 + fq * 8), af1, acc, 0, 0, 0);
#pragma unroll
                for (int kk = 0; kk < KS; ++kk)
                    acc = __builtin_amdgcn_mfma_f32_16x16x32_bf16(*(const bf16x8*)(st + vrow * QS + kk * 32 + fq * 8), qh[kk], acc, 0, 0, 0);
                oacc[vi] = acc * scale;
                sq += oacc[vi][0] * oacc[vi][0] + oacc[vi][1] * oacc[vi][1] + oacc[vi][2] * oacc[vi][2] + oacc[vi][3] * oacc[vi][3];
            }
            sq += shx<16>(sq); sq += shx<32>(sq);
            if (fq == 0) ssq[vh * 64 + trow] = sq;
        }
        {
            const int vrow = wave * 16 + fr;
            const bf16x8 vf0 = *(const bf16x8*)(vt + vrow * VS + fq * 8), vf1 = *(const bf16x8*)(vt + vrow * VS + 32 + fq * 8);
#pragma unroll
            for (int kt = 0; kt < KT; ++kt) {
                const float dec = __expf(blast[kt * 16 + fr]);
                sacc[kt][0] *= dec; sacc[kt][1] *= dec; sacc[kt][2] *= dec; sacc[kt][3] *= dec;
                sacc[kt] = __builtin_amdgcn_mfma_f32_16x16x32_bf16(vf0, *(const bf16x8*)(kht + (kt * 16 + fr) * VS + fq * 8), sacc[kt], 0, 0, 0);
                sacc[kt] = __builtin_amdgcn_mfma_f32_16x16x32_bf16(vf1, *(const bf16x8*)(kht + (kt * 16 + fr) * VS + 32 + fq * 8), sacc[kt], 0, 0, 0);
            }
        }
        __syncthreads();
#pragma unroll
        for (int kt = 0; kt < KT; ++kt)
#pragma unroll
            for (int r = 0; r < 4; ++r) st[(wave * 16 + 4 * fq + r) * QS + kt * 16 + fr] = f2bf(sacc[kt][r]);
        {
            const int ti = wave & 3, vh = wave >> 2, trow = ti * 16 + fr;
            const float rstd = rsqrtf((ssq[trow] + ssq[64 + trow]) * (1.f / 128.f) + 1e-6f);
            bf16_t* yrow = (bf16_t*)(p.ws + WS_Y) + (size_t)(b * 2048 + c * 64 + trow) * 1536 + (GLA ? 1024 : 0) + h * 128 + vh * 64 + 4 * fq;
            const float* gn = (GLA ? p.gla_on : p.hgrn_on) + l * 128 + vh * 64 + 4 * fq;
#pragma unroll
            for (int vi = 0; vi < 4; ++vi) {
                const float4 g4 = *(const float4*)(gn + vi * 16);
                const float z0 = bflo(gz[vi].x), z1 = bfhi(gz[vi].x), z2 = bflo(gz[vi].y), z3 = bfhi(gz[vi].y);
                uint2 o;
                o.x = pack2(oacc[vi][0] * rstd * g4.x * (z0 * sigm(z0)), oacc[vi][1] * rstd * g4.y * (z1 * sigm(z1)));
                o.y = pack2(oacc[vi][2] * rstd * g4.z * (z2 * sigm(z2)), oacc[vi][3] * rstd * g4.w * (z3 * sigm(z3)));
                *(uint2*)(yrow + vi * 16) = o;
            }
        }
    }
    __syncthreads();
}

__device__ void dsaprep2_item(const Params& p, int l, int item, char* smem_) {
    bf16_t* tile = (bf16_t*)smem_;
    const int tid = TIDX(), lane = tid & 63, wave = tid >> 6;
    bf16_t* Z = (bf16_t*)(p.ws + WS_Z); bf16_t* VT = (bf16_t*)(p.ws + WS_VT);
    {
        const int tb = item * 32;
        {
            const float2 gq = *(const float2*)(p.dsa_qn + l * 128 + lane * 2), gk = *(const float2*)(p.dsa_kn + l * 128 + lane * 2);
            unsigned uu[4][8];
#pragma unroll
            for (int j = 0; j < 4; ++j)
#pragma unroll
                for (int grp = 0; grp < 8; ++grp)
                    uu[j][grp] = *(const unsigned*)(Z + (size_t)(tb + wave + 8 * j) * LDZ + (grp < 4 ? ZB_Q : ZB_K) + (grp & 3) * 128 + lane * 2);
#pragma unroll
            for (int j = 0; j < 4; ++j)
#pragma unroll
                for (int grp = 0; grp < 8; ++grp) {
                    bf16_t* ptr = Z + (size_t)(tb + wave + 8 * j) * LDZ + (grp < 4 ? ZB_Q : ZB_K) + (grp & 3) * 128 + lane * 2;
                    const float a = bflo(uu[j][grp]), b = bfhi(uu[j][grp]);
                    const float ss = wave_sum(a * a + b * b);
                    const float r = rsqrtf(ss * (1.f / 128.f) + 1e-6f) * ((grp < 4) ? 0.08838834764831845f : 1.f);
                    const float2 g = (grp < 4) ? gq : gk;
                    __hip_atomic_store((unsigned*)ptr, pack2(a * r * g.x, b * r * g.y), __ATOMIC_RELAXED, __HIP_MEMORY_SCOPE_AGENT);
                }
        }
        u32x4 uv[4];
#pragma unroll
        for (int i = 0; i < 4; ++i) { const int ch = tid + i * 512; uv[i] = *(const u32x4*)(Z + (size_t)(tb + (ch >> 6)) * LDZ + ZB_V + (ch & 63) * 8); }
#pragma unroll
        for (int i = 0; i < 4; ++i) {
            const int ch = tid + i * 512, t = ch >> 6, c8 = (ch & 63) * 8;
            unsigned* d = (unsigned*)(tile + t * 514 + c8);
            d[0] = uv[i][0]; d[1] = uv[i][1]; d[2] = uv[i][2]; d[3] = uv[i][3];
        }
        __syncthreads();
        {
            const int c = tid, b = tb >> 11, s0 = tb & 2047;
            unsigned w[16];
#pragma unroll
            for (int j = 0; j < 16; ++j) w[j] = (unsigned)tile[(2 * j) * 514 + c] | ((unsigned)tile[(2 * j + 1) * 514 + c] << 16);
            unsigned long long* dst = (unsigned long long*)(VT + ((size_t)(b * 512 + c)) * 2048 + s0);
#pragma unroll
            for (int j = 0; j < 8; ++j) __hip_atomic_store(dst + j, ((unsigned long long)w[2 * j + 1] << 32) | w[2 * j], __ATOMIC_RELAXED, __HIP_MEMORY_SCOPE_AGENT);
        }
        __syncthreads();
    }
}

__device__ void dsa_select_tile(const Params& p, int b, int tq, char* smem_) {
    constexpr int KS_ = 2052;
    unsigned* keyL = (unsigned*)smem_;
    const int tid = TIDX(), lane = tid & 63, wave = __builtin_amdgcn_readfirstlane(tid >> 6), fr = lane & 15, fq = lane >> 4;
    const bf16_t* Z = (const bf16_t*)(p.ws + WS_Z);
    unsigned long long* BM64 = (unsigned long long*)(p.ws + WS_BM);
    const int t0 = tq * 16;
    {
        const int tl = t0 + fr;
        const size_t trow = (size_t)b * 2048 + tl;
        bf16x8 qf[4][2];
#pragma unroll
        for (int h = 0; h < 4; ++h)
#pragma unroll
            for (int ks = 0; ks < 2; ++ks) qf[h][ks] = *(const bf16x8*)(Z + trow * LDZ + ZB_QI + h * 64 + ks * 32 + fq * 8);
        float w[4];
#pragma unroll
        for (int h = 0; h < 4; ++h) w[h] = bf2f(Z[trow * LDZ + ZB_WI + h]) * 0.5f;
#pragma unroll 4
        for (int kt = wave; kt <= tq; kt += 8) {
            const bf16_t* kr = Z + ((size_t)b * 2048 + kt * 16 + fr) * LDZ + ZB_KI + fq * 8;
            const bf16x8 k0 = *(const bf16x8*)kr, k1 = *(const bf16x8*)(kr + 32);
            f32x4 acc[4];
#pragma unroll
            for (int h = 0; h < 4; ++h) {
                acc[h] = __builtin_amdgcn_mfma_f32_16x16x32_bf16(k0, qf[h][0], f32x4{0.f, 0.f, 0.f, 0.f}, 0, 0, 0);
                acc[h] = __builtin_amdgcn_mfma_f32_16x16x32_bf16(k1, qf[h][1], acc[h], 0, 0, 0);
            }
            u32x4 kk;
#pragma unroll
            for (int r = 0; r < 4; ++r) {
                float sc = w[0] * fmaxf(acc[0][r] * 0.125f, 0.f) + w[1] * fmaxf(acc[1][r] * 0.125f, 0.f) + w[2] * fmaxf(acc[2][r] * 0.125f, 0.f) + w[3] * fmaxf(acc[3][r] * 0.125f, 0.f);
                if (sc == 0.f) sc = 0.f;
                const unsigned u = __float_as_uint(sc);
                const unsigned k = (u & 0x80000000u) ? ~u : (u | 0x80000000u);
                kk[r] = (kt * 16 + 4 * fq + r <= tl) ? k : 0u;
            }
            *(u32x4*)(keyL + fr * KS_ + kt * 16 + 4 * fq) = kk;
        }
    }
    __syncthreads();
    {
        const int nk = (tq + 1) * 16, jmax = (nk + 63) >> 6;
        const int qa = 2 * wave, qb = qa + 1;
        unsigned ka[32], kb[32];
#pragma unroll
        for (int j = 0; j < 32; ++j) {
            const int s = lane + 64 * j;
            ka[j] = (s < nk) ? keyL[qa * KS_ + s] : 0u;
            kb[j] = (s < nk) ? keyL[qb * KS_ + s] : 0u;
        }
        unsigned Ta = 1u, Tb = 1u; int Ca = 2047, Cb = 2047;
        if (t0 >= 256) {
            int na, nb;
            bool da, db;
            {
                int c0 = 0, c1 = 0, c2 = 0, c3 = 0;
#pragma unroll
                for (int j = 0; j < 32; ++j)
                    if (j < jmax) { c0 += (ka[j] >= 0x80000000u); c1 += (ka[j] > 0x80000000u); c2 += (kb[j] >= 0x80000000u); c3 += (kb[j] > 0x80000000u); }
                c0 = wave_total_i(c0); c1 = wave_total_i(c1); c2 = wave_total_i(c2); c3 = wave_total_i(c3);
                da = (c1 < 256 && c0 >= 256); db = (c3 < 256 && c2 >= 256);
                Ta = da ? 0x80000000u : ((c0 >= 256) ? 0x80000000u : 0u); na = da ? c0 : ((c0 >= 256) ? c0 : 0x7fffffff);
                Tb = db ? 0x80000000u : ((c2 >= 256) ? 0x80000000u : 0u); nb = db ? c2 : ((c2 >= 256) ? c2 : 0x7fffffff);
            }
            for (int bit = 30; bit >= 0; --bit) {
                if (da && db) break;
                const unsigned ca_ = Ta | (1u << bit), cb_ = Tb | (1u << bit);
                int c0 = 0, c1 = 0;
#pragma unroll
                for (int j = 0; j < 32; ++j)
                    if (j < jmax) { c0 += (ka[j] >= ca_); c1 += (kb[j] >= cb_); }
                c0 = wave_total_i(c0); c1 = wave_total_i(c1);
                if (!da && c0 >= 256) { Ta = ca_; na = c0; }
                if (!db && c1 >= 256) { Tb = cb_; nb = c1; }
                da = da || (na == 256); db = db || (nb == 256);
            }
            if (na != 256 || nb != 256) {
                int needa, needb;
                {
                    int c0 = 0, c1 = 0;
#pragma unroll
                    for (int j = 0; j < 32; ++j)
                        if (j < jmax) { c0 += (ka[j] > Ta); c1 += (kb[j] > Tb); }
                    needa = 256 - wave_total_i(c0); needb = 256 - wave_total_i(c1);
                }
                Ca = 0; Cb = 0;
                for (int bit = 10; bit >= 0; --bit) {
                    const int ca_ = Ca | (1 << bit), cb_ = Cb | (1 << bit);
                    int c0 = 0, c1 = 0;
#pragma unroll
                    for (int j = 0; j < 32; ++j)
                        if (j < jmax) { const int s = lane + 64 * j; c0 += (ka[j] == Ta && s < ca_); c1 += (kb[j] == Tb && s < cb_); }
                    c0 = wave_total_i(c0); c1 = wave_total_i(c1);
                    if (c0 < needa) Ca = ca_;
                    if (c1 < needb) Cb = cb_;
                }
            }
        }
        const size_t rowa = (size_t)b * 2048 + t0 + qa;
#pragma unroll
        for (int j = 0; j < 32; ++j) {
            const int s = lane + 64 * j;
            const unsigned long long ma = __ballot((ka[j] > Ta) || (ka[j] == Ta && s <= Ca));
            const unsigned long long mb = __ballot((kb[j] > Tb) || (kb[j] == Tb && s <= Cb));
            if (lane == 0) {
                __hip_atomic_store(&BM64[rowa * 32 + j], ma, __ATOMIC_RELAXED, __HIP_MEMORY_SCOPE_AGENT);
                __hip_atomic_store(&BM64[(rowa + 1) * 32 + j], mb, __ATOMIC_RELAXED, __HIP_MEMORY_SCOPE_AGENT);
            }
        }
    }
    __syncthreads();
}

__device__ void dsa_attn_item(const Params& p, int b, int h, int qg, char* smem_) {
    constexpr int KSTR = 136, VSTR = 40;
    bf16_t* Kl = (bf16_t*)smem_;
    bf16_t* Vl = Kl + 2 * 32 * KSTR;
    const int tid = TIDX(), lane = tid & 63, wave = __builtin_amdgcn_readfirstlane(tid >> 6), fr = lane & 15, fq = lane >> 4;
    const bf16_t* Z = (const bf16_t*)(p.ws + WS_Z); const bf16_t* VT = (const bf16_t*)(p.ws + WS_VT);
    const unsigned* BM = (const unsigned*)(p.ws + WS_BM); bf16_t* Y = (bf16_t*)(p.ws + WS_Y);
    const int kr = tid >> 4, kc = tid & 15, vd = tid >> 2, vc = tid & 3;
    const int ka_row = 8 * (fr >> 2) + (fr & 3);
    {
        const int t0 = qg * 128 + wave * 16;
        const size_t trow = (size_t)b * 2048 + t0 + fr;
        bf16x8 qf[4];
#pragma unroll
        for (int ks = 0; ks < 4; ++ks) qf[ks] = *(const bf16x8*)(Z + trow * LDZ + ZB_Q + h * 128 + ks * 32 + fq * 8);
        f32x4 o[8];
#pragma unroll
        for (int i = 0; i < 8; ++i) o[i] = f32x4{0.f, 0.f, 0.f, 0.f};
        float m = -INFINITY, lsum = 0.f;
        const unsigned* bmrow = BM + trow * 64;
        const int nsteps_blk = qg * 4 + 4, nsteps_w = (t0 + 15) / 32 + 1;
        const bf16_t* kg = Z + ((size_t)b * 2048 + kr) * LDZ + ZB_K + h * 128 + kc * 8;
        const bf16_t* vg = VT + ((size_t)(b * 4 + h) * 128 + vd) * 2048 + vc * 8;
        u32x4 rk = *(const u32x4*)kg, rv = *(const u32x4*)vg;
        *(u32x4*)(Kl + kr * KSTR + kc * 8) = rk; *(u32x4*)(Vl + vd * VSTR + vc * 8) = rv;
        __syncthreads();
        unsigned mwn = bmrow[0];
        for (int st = 0; st < nsteps_blk; ++st) {
            const bool more = (st + 1 < nsteps_blk);
            const unsigned mwc = mwn;
            mwn = bmrow[(st + 1 < nsteps_w) ? st + 1 : st];
            if (more) { rk = *(const u32x4*)(kg + (size_t)(st + 1) * 32 * LDZ); rv = *(const u32x4*)(vg + (st + 1) * 32); }
            if (st < nsteps_w) {
                const bf16_t* Kb = Kl + (st & 1) * 32 * KSTR; const bf16_t* Vb = Vl + (st & 1) * 128 * VSTR;
                f32x4 sa = f32x4{0.f, 0.f, 0.f, 0.f}, sb = f32x4{0.f, 0.f, 0.f, 0.f};
#pragma unroll
                for (int ks = 0; ks < 4; ++ks) {
                    const bf16x8 fa = *(const bf16x8*)(Kb + ka_row * KSTR + ks * 32 + fq * 8), fb = *(const bf16x8*)(Kb + (ka_row + 4) * KSTR + ks * 32 + fq * 8);
                    sa = __builtin_amdgcn_mfma_f32_16x16x32_bf16(fa, qf[ks], sa, 0, 0, 0);
                    sb = __builtin_amdgcn_mfma_f32_16x16x32_bf16(fb, qf[ks], sb, 0, 0, 0);
                }
                const unsigned mw = mwc >> (8 * fq);
                float x[8];
#pragma unroll
                for (int r = 0; r < 4; ++r) { x[r] = ((mw >> r) & 1u) ? sa[r] : -INFINITY; x[4 + r] = ((mw >> (4 + r)) & 1u) ? sb[r] : -INFINITY; }
                float mx = fmaxf(fmaxf(fmaxf(x[0], x[1]), fmaxf(x[2], x[3])), fmaxf(fmaxf(x[4], x[5]), fmaxf(x[6], x[7])));
                mx = fmaxf(mx, shx<16>(mx)); mx = fmaxf(mx, shx<32>(mx));
                const float mnew = fmaxf(m, mx);
                const float msafe = (mnew == -INFINITY) ? 0.f : mnew;
                const float alpha = __expf(m - msafe);
                float pe[8]; float ps = 0.f;
#pragma unroll
                for (int j = 0; j < 8; ++j) { pe[j] = __expf(x[j] - msafe); ps += pe[j]; }
                lsum = lsum * alpha + ps;
                m = mnew;
#pragma unroll
                for (int i = 0; i < 8; ++i) { o[i][0] *= alpha; o[i][1] *= alpha; o[i][2] *= alpha; o[i][3] *= alpha; }
                union { bf16x8 v; unsigned u[4]; } pf;
                pf.u[0] = pack2(pe[0], pe[1]); pf.u[1] = pack2(pe[2], pe[3]); pf.u[2] = pack2(pe[4], pe[5]); pf.u[3] = pack2(pe[6], pe[7]);
#pragma unroll
                for (int i = 0; i < 8; ++i) {
                    const bf16x8 vf = *(const bf16x8*)(Vb + (i * 16 + fr) * VSTR + fq * 8);
                    o[i] = __builtin_amdgcn_mfma_f32_16x16x32_bf16(vf, pf.v, o[i], 0, 0, 0);
                }
            }
            if (more) { *(u32x4*)(Kl + ((st + 1) & 1) * 32 * KSTR + kr * KSTR + kc * 8) = rk; *(u32x4*)(Vl + ((st + 1) & 1) * 128 * VSTR + vd * VSTR + vc * 8) = rv; }
            __syncthreads();
        }
        lsum += shx<16>(lsum); lsum += shx<32>(lsum);
        const float inv = 1.f / lsum;
#pragma unroll
        for (int i = 0; i < 8; ++i) {
            uint2 ov; ov.x = pack2(o[i][0] * inv, o[i][1] * inv); ov.y = pack2(o[i][2] * inv, o[i][3] * inv);
            *(uint2*)(Y + trow * 1536 + 512 + h * 128 + i * 16 + 4 * fq) = ov;
        }
    }
}

constexpr int LDS_BYTES = 155648;
__device__ void ph_mixA(const Params& p, int l, int vb0, int nvb, char* smem_) {
    for (int item = vb0; item < 64; item += nvb) {
        if (item < 32) scan2_item<128, false>(p, l, item >> 2, item & 3, smem_);
        else scan2_item<64, true>(p, l, (item - 32) >> 2, (item - 32) & 3, smem_);
    }
    unsigned* ctr = (unsigned*)(p.ws + WS_CTL) + 3584 + l * 64;
    unsigned* done = (unsigned*)(p.ws + WS_CTL) + 5300 + l * 8 * 16;
    volatile int* slot = (volatile int*)(smem_ + LDS_BYTES - 64);
    for (;;) {
        if (TIDX() == 0) *slot = (int)atomicAdd(ctr, 1u);
        __syncthreads();
        const int idx = __builtin_amdgcn_readfirstlane(*slot);
        __syncthreads();
        if (idx >= 2048) break;
        if (idx < 1536) {
            const int b = idx / 192, r = idx % 192;
            if (r < 128) dsa_select_tile(p, b, 127 - r, smem_);
            else dsaprep2_item(p, l, b * 64 + (r - 128), smem_);
            asm volatile("s_waitcnt vmcnt(0)" ::: "memory");
            __syncthreads();
            if (TIDX() == 0) __hip_atomic_fetch_add(done + b * 16, 1u, __ATOMIC_RELAXED, __HIP_MEMORY_SCOPE_AGENT);
        } else {
            const int a = idx - 1536, b = a >> 6, h = (a >> 4) & 3, qg = 15 - (a & 15);
            if (TIDX() == 0) {
                unsigned spins = 0;
                while (__hip_atomic_load(done + b * 16, __ATOMIC_RELAXED, __HIP_MEMORY_SCOPE_AGENT) < 192u) { __builtin_amdgcn_s_sleep(2); if (++spins > (1u << 18)) break; }
                __builtin_amdgcn_fence(__ATOMIC_ACQUIRE, "agent");
                asm volatile("s_waitcnt vmcnt(0)" ::: "memory");
            }
            __syncthreads();
            dsa_attn_item(p, b, h, qg, smem_);
        }
    }
}

__device__ __forceinline__ int f2sort(float f) { int i = __float_as_int(f); return i ^ ((i >> 31) & 0x7fffffff); }
__device__ __forceinline__ float sort2f(int i) { return __int_as_float(i ^ ((i >> 31) & 0x7fffffff)); }
#define INSK(K, xv) do { int _x = (xv); \
    _Pragma("unroll") for (int _j = 0; _j < 16; ++_j) { int _hi = max(K[_j], _x); _x = min(K[_j], _x); K[_j] = _hi; } } while (0)
#define INS64(K, xv) do { unsigned long long _x = (xv); \
    _Pragma("unroll") for (int _j = 0; _j < 16; ++_j) { bool _c = _x > K[_j]; unsigned long long _o = K[_j]; K[_j] = _c ? _x : _o; _x = _c ? _o : _x; } } while (0)

__device__ void ph_route(const Params& p, int vb0, int nvb, char* smem_) {
    typedef _Float16 h8 __attribute__((ext_vector_type(8)));
    const _Float16* SC = (const _Float16*)(p.ws + WS_SC);
    int* RI = (int*)(p.ws + WS_RI); float* RG = (float*)(p.ws + WS_RG);
    const int tid = TIDX(), lane = tid & 63, wave = tid >> 6;
    _Float16* tile = (_Float16*)smem_ + wave * (64 * 72);
    for (int item0 = (vb0 * 8 + wave) * 64; item0 < T_TOK * 8; item0 += nvb * 8 * 64) {
        const int item = item0 + lane;
        const int t = item >> 3, h = item & 7;
        const _Float16* s0 = SC + (size_t)t * 2048 + h * 256;
        const _Float16* wbase = SC + (size_t)item0 * 256;
        int k0[16], k1[16];
#pragma unroll
        for (int j = 0; j < 16; ++j) { k0[j] = (int)0x80000000; k1[j] = (int)0x80000000; }
#pragma unroll 1
        for (int slab = 0; slab < 4; ++slab) {
            h8 ld[8];
#pragma unroll
            for (int j = 0; j < 4; ++j) {
                const _Float16* src = wbase + (size_t)(16 * j + (lane >> 2)) * 256 + slab * 32 + (lane & 3) * 8;
                ld[j] = *(const h8*)src; ld[4 + j] = *(const h8*)(src + 128);
            }
            __builtin_amdgcn_wave_barrier();
#pragma unroll
            for (int j = 0; j < 4; ++j) {
                _Float16* dst = tile + (16 * j + (lane >> 2)) * 72 + (lane & 3) * 8;
                *(h8*)dst = ld[j]; *(h8*)(dst + 32) = ld[4 + j];
            }
            __builtin_amdgcn_fence(__ATOMIC_RELEASE, "wavefront");
            __builtin_amdgcn_wave_barrier();
            __builtin_amdgcn_fence(__ATOMIC_ACQUIRE, "wavefront");
#pragma unroll 2
            for (int ii = 0; ii < 32; ii += 8) {
                const int i = slab * 32 + ii;
                const h8 a = *(const h8*)(tile + lane * 72 + ii), b = *(const h8*)(tile + lane * 72 + 32 + ii);
#pragma unroll
                for (int e_ = 0; e_ < 8; ++e_) {
                    INSK(k0, (f2sort((float)a[e_]) & ~127) | (127 - i - e_));
                    INSK(k1, (f2sort((float)b[e_]) & ~127) | (127 - i - e_));
                }
            }
            __builtin_amdgcn_wave_barrier();
        }
        float v0[16], v1[16];
#pragma unroll
        for (int j = 0; j < 16; ++j) { k0[j] = 127 - (k0[j] & 127); k1[j] = 127 - (k1[j] & 127); v0[j] = (float)s0[k0[j]]; v1[j] = (float)s0[128 + k1[j]]; }
        unsigned long long ck[16];
#pragma unroll
        for (int j = 0; j < 16; ++j) ck[j] = 0ull;
#pragma unroll
        for (int a = 0; a < 16; ++a)
#pragma unroll
            for (int b = 0; b < 16; ++b)
                if ((a + 1) * (b + 1) <= 16) {
                    unsigned hi = (unsigned)f2sort(v0[a] + v1[b]) ^ 0x80000000u;
                    unsigned lo = ((unsigned)(255 - (a * 16 + b)) << 16) | (unsigned)(k0[a] * 128 + k1[b]);
                    INS64(ck, ((unsigned long long)hi << 32) | lo);
                }
        float e[16]; float sm = 0.f;
        const float mx = sort2f((int)((unsigned)(ck[0] >> 32) ^ 0x80000000u));
#pragma unroll
        for (int j = 0; j < 16; ++j) { e[j] = expf(sort2f((int)((unsigned)(ck[j] >> 32) ^ 0x80000000u)) - mx); sm += e[j]; }
        const float inv = 1.f / sm;
#pragma unroll
        for (int j = 0; j < 16; j += 4) {
            *(int4*)(RI + (size_t)t * 128 + h * 16 + j) = make_int4((int)(ck[j] & 0xffffu), (int)(ck[j + 1] & 0xffffu), (int)(ck[j + 2] & 0xffffu), (int)(ck[j + 3] & 0xffffu));
            *(float4*)(RG + (size_t)t * 128 + h * 16 + j) = make_float4(e[j] * inv, e[j + 1] * inv, e[j + 2] * inv, e[j + 3] * inv);
        }
    }
}

__device__ __forceinline__ void fp8x16_to_f32(const uint4 q, float (&f)[16]) {
    const unsigned w[4] = {q.x, q.y, q.z, q.w};
#pragma unroll
    for (int c = 0; c < 4; ++c) {
        auto f0 = __builtin_amdgcn_cvt_pk_f32_fp8((int)w[c], false); auto f1 = __builtin_amdgcn_cvt_pk_f32_fp8((int)w[c], true);
        f[4 * c] = f0[0]; f[4 * c + 1] = f0[1]; f[4 * c + 2] = f1[0]; f[4 * c + 3] = f1[1];
    }
}
template <int WHICH>
__device__ void ph_peer_sliced(const Params& p, int l, char* smem_) {
    const int tid = TIDX(), wave = tid >> 6;
    const bf16_t* H = (const bf16_t*)(p.ws + WS_H); const unsigned char* PU = p.ws + WS_PU; const unsigned char* PV = p.ws + WS_PV;
    const int* RI = (const int*)(p.ws + WS_RI); float* RG = (float*)(p.ws + WS_RG); float* PP = (float*)(p.ws + WS_PP);
    const float* modb = (const float*)(p.ws + WS_MOD);
    {
    unsigned* ctr = (unsigned*)(p.ws + WS_CTL) + 3712 + (l * 2 + WHICH) * 128;
    volatile int* slot = (volatile int*)(smem_ + LDS_BYTES - 64);
    const int xcc = (int)(xb_xcc_id() & 7u);
    for (int so = 0; so < 8; ++so) {
        const int x = (xcc + so) & 7;
        for (;;) {
            if (tid == 0) *slot = (int)atomicAdd(ctr + x * 16, 1u);
            __syncthreads();
            const int chunk = __builtin_amdgcn_readfirstlane(*slot);
            __syncthreads();
            if (chunk >= 256) break;
            {
                const int lane = lane_id_opaque(), eg = lane >> 3, ll = lane & 7;
                const int tb = chunk * 64 + wave * 8;
                int* lri = (int*)smem_ + wave * 2048; float* lrg = (float*)(lri + 1024);
                {
                    int ra[16]; float rg_[16];
#pragma unroll
                    for (int i = 0; i < 8; ++i) {
                        ra[2 * i] = RI[(size_t)(tb + i) * 128 + lane]; ra[2 * i + 1] = RI[(size_t)(tb + i) * 128 + 64 + lane];
                        if (WHICH == 1) { rg_[2 * i] = RG[(size_t)(tb + i) * 128 + lane]; rg_[2 * i + 1] = RG[(size_t)(tb + i) * 128 + 64 + lane]; }
                    }
#pragma unroll
                    for (int i = 0; i < 8; ++i) {
                        lri[i * 128 + lane] = ra[2 * i]; lri[i * 128 + 64 + lane] = ra[2 * i + 1];
                        if (WHICH == 1) { lrg[i * 128 + lane] = rg_[2 * i]; lrg[i * 128 + 64 + lane] = rg_[2 * i + 1]; }
                    }
                }
                __builtin_amdgcn_fence(__ATOMIC_RELEASE, "wavefront");
                __builtin_amdgcn_wave_barrier();
                __builtin_amdgcn_fence(__ATOMIC_ACQUIRE, "wavefront");
                uint4 hq0 = make_uint4(0u, 0u, 0u, 0u), hq1 = hq0;
                if (WHICH == 0) { const uint4* hp = (const uint4*)(H + (size_t)tb * 1024 + x * 128 + ll * 16); hq0 = hp[0]; hq1 = hp[1]; }
#pragma unroll 1
                for (int i = 0; i < 8; ++i) {
                    const int t = tb + i;
                    if (WHICH == 0) {
                        float hv[16];
                        hv[0] = bflo(hq0.x); hv[1] = bfhi(hq0.x); hv[2] = bflo(hq0.y); hv[3] = bfhi(hq0.y); hv[4] = bflo(hq0.z); hv[5] = bfhi(hq0.z); hv[6] = bflo(hq0.w); hv[7] = bfhi(hq0.w);
                        hv[8] = bflo(hq1.x); hv[9] = bfhi(hq1.x); hv[10] = bflo(hq1.y); hv[11] = bfhi(hq1.y); hv[12] = bflo(hq1.z); hv[13] = bfhi(hq1.z); hv[14] = bflo(hq1.w); hv[15] = bfhi(hq1.w);
                        if (i < 7) { const uint4* hp = (const uint4*)(H + (size_t)(t + 1) * 1024 + x * 128 + ll * 16); hq0 = hp[0]; hq1 = hp[1]; }
                        uint4 uq[16];
#pragma unroll
                        for (int it = 0; it < 16; ++it) {
                            const int e = lri[i * 128 + it * 8 + eg];
                            uq[it] = *(const uint4*)(PU + ((size_t)x * 16384 + e) * 128 + ll * 16);
                        }
#pragma unroll
                        for (int b2 = 0; b2 < 2; ++b2) {
                            float part[8];
#pragma unroll
                            for (int it = 0; it < 8; ++it) {
                                typedef float f32x2 __attribute__((ext_vector_type(2)));
                                const unsigned uw_[4] = {uq[b2 * 8 + it].x, uq[b2 * 8 + it].y, uq[b2 * 8 + it].z, uq[b2 * 8 + it].w};
                                f32x2 d2 = {0.f, 0.f};
#pragma unroll
                                for (int c_ = 0; c_ < 4; ++c_) {
                                    const f32x2 f0 = __builtin_amdgcn_cvt_pk_f32_fp8((int)uw_[c_], false), f1 = __builtin_amdgcn_cvt_pk_f32_fp8((int)uw_[c_], true);
                                    d2 = __builtin_elementwise_fma(f32x2{hv[4 * c_], hv[4 * c_ + 1]}, f0, d2);
                                    d2 = __builtin_elementwise_fma(f32x2{hv[4 * c_ + 2], hv[4 * c_ + 3]}, f1, d2);
                                }
                                part[it] = d2[0] + d2[1];
                            }
                            float r4[4], r2[2];
                            const bool b2_ = lane & 4, b1_ = lane & 2, b0_ = lane & 1;
#pragma unroll
                            for (int j = 0; j < 4; ++j) { const float snd = b2_ ? part[j] : part[j + 4], kp = b2_ ? part[j + 4] : part[j]; r4[j] = kp + shx<4>(snd); }
#pragma unroll
                            for (int j = 0; j < 2; ++j) { const float snd = b1_ ? r4[j] : r4[j + 2], kp = b1_ ? r4[j + 2] : r4[j]; r2[j] = kp + shx<2>(snd); }
                            const float snd = b0_ ? r2[0] : r2[1], kp = b0_ ? r2[1] : r2[0];
                            const float d = kp + shx<1>(snd);
                            PP[((size_t)x * T_TOK + t) * 128 + b2 * 64 + ll * 8 + eg] = d;
                        }
                    } else {
                        const int col = x * 128 + ll * 16 + ((lane >> 5) & 1) * 8 + ((lane >> 4) & 1) * 4 + ((lane >> 3) & 1) * 2;
                        float2* op = (float2*)(p.out + (size_t)t * 1024 + col);
                        const float2 gf = *(const float2*)(modb + (size_t)(l * 8 + (t >> 11)) * 6144 + 5120 + col), xi = *op;
                        float y[16];
#pragma unroll
                        for (int j = 0; j < 16; ++j) y[j] = 0.f;
#pragma unroll
                        for (int b2 = 0; b2 < 2; ++b2) {
                            uint4 vq[8];
#pragma unroll
                            for (int it = 0; it < 8; ++it) {
                                const int e = lri[i * 128 + b2 * 64 + it * 8 + eg];
                                vq[it] = *(const uint4*)(PV + ((size_t)x * 16384 + e) * 128 + ll * 16);
                            }
#pragma unroll
                            for (int it = 0; it < 8; ++it) {
                                const float ck = lrg[i * 128 + b2 * 64 + it * 8 + eg];
                                float f[16]; fp8x16_to_f32(vq[it], f);
#pragma unroll
                                for (int j = 0; j < 16; ++j) y[j] += ck * f[j];
                            }
                        }
                        float r8[8], r4[4], r2[2];
                        const bool b5 = lane & 32, b4 = lane & 16, b3 = lane & 8;
#pragma unroll
                        for (int j = 0; j < 8; ++j) { const float snd = b5 ? y[j] : y[j + 8], kp = b5 ? y[j + 8] : y[j]; r8[j] = kp + shx<32>(snd); }
#pragma unroll
                        for (int j = 0; j < 4; ++j) { const float snd = b4 ? r8[j] : r8[j + 4], kp = b4 ? r8[j + 4] : r8[j]; r4[j] = kp + shx<16>(snd); }
#pragma unroll
                        for (int j = 0; j < 2; ++j) { const float snd = b3 ? r4[j] : r4[j + 2], kp = b3 ? r4[j + 2] : r4[j]; r2[j] = kp + shx<8>(snd); }
                        *op = make_float2(xi.x + gf.x * r2[0], xi.y + gf.y * r2[1]);
                    }
                }
            }
        }
    }
    __syncthreads();
    }
}
__device__ void ph_peer_coef(const Params& p, int vb0, int nvb) {
    const int wave = TIDX() >> 6, lane = TIDX() & 63;
    float* RG = (float*)(p.ws + WS_RG); const float* PP = (const float*)(p.ws + WS_PP);
    for (int t0 = (vb0 * 8 + wave) * 2; t0 < T_TOK; t0 += nvb * 8 * 2) {
        float pp[2][2][8], g[2][2];
#pragma unroll
        for (int u = 0; u < 2; ++u)
#pragma unroll
            for (int half = 0; half < 2; ++half) {
                const int k = half * 64 + lane;
#pragma unroll
                for (int x = 0; x < 8; ++x) pp[u][half][x] = PP[((size_t)x * T_TOK + t0 + u) * 128 + k];
                g[u][half] = RG[(size_t)(t0 + u) * 128 + k];
            }
        asm volatile("" ::: "memory");
#pragma unroll
        for (int u = 0; u < 2; ++u)
#pragma unroll
            for (int half = 0; half < 2; ++half) {
                float d = 0.f;
#pragma unroll
                for (int x = 0; x < 8; ++x) d += pp[u][half][x];
                d *= (1.f / PU_SCALE);
                RG[(size_t)(t0 + u) * 128 + half * 64 + lane] = g[u][half] * 0.5f * d * (1.f + erff(d * 0.7071067811865476f)) * (1.f / PV_SCALE);
            }
    }
}

enum { PH_MOD = 0, PH_WPREP, PH_NORM1, PH_GEMM_IN, PH_SCAN, PH_MERGE, PH_OUT, PH_NORM2, PH_GEMM_Q, PH_GEMM_SC, PH_ROUTE, PH_G1, PH_G15, PH_G2 };

template <int PH>
__device__ __forceinline__ void run_phase(const Params& p, int l, int vb0, int nvb, char* smem) {
    const float* xin = (l == 0) ? p.x : p.out;
    if (PH == PH_MOD) ph_mod(p, vb0, nvb, smem);
    else if (PH == PH_WPREP) ph_wprep(p, l, vb0, nvb, smem);
    else if (PH == PH_NORM1) ph_norm(p, l, 0, xin, vb0, nvb);
    else if (PH == PH_GEMM_IN) {
        pg8::Gemm g{(const bf16_t*)(p.ws + WS_H), (const bf16_t*)(p.ws + WS_WIN), 1024, 1024, 1024};
        pg8::StaticOrder S; S.init(T_TOK, LDZ, nvb, vb0, 1024, 1024);
        pg8::gemm_phase(( PG8_LAS unsigned char*)smem, g, S, pg8::EpiBf16{(bf16_t*)(p.ws + WS_Z), LDZ}, TIDX());
    }
    else if (PH == PH_SCAN) ph_mixA(p, l, vb0, nvb, smem);
    else if (PH == PH_MERGE) {
        pg8::Gemm g{(const bf16_t*)(p.ws + WS_Y), (const bf16_t*)(p.ws + WS_WBR), 1536, 512, 512};
        pg8::MergeOrder S{vb0, nvb};
        pg8::gemm_phase((PG8_LAS unsigned char*)smem, g, S, pg8::EpiMerge{(bf16_t*)(p.ws + WS_H), (const bf16_t*)(p.ws + WS_Z)}, TIDX());
    }
    else if (PH == PH_OUT) {
        pg8::Gemm g{(const bf16_t*)(p.ws + WS_H), (const bf16_t*)(p.ws + WS_WOUT), 1024, 1024, 1024};
        pg8::StaticOrder S; S.init(T_TOK, 1024, nvb, vb0, 1024, 1024);
        pg8::gemm_phase((PG8_LAS unsigned char*)smem, g, S, pg8::EpiResid{xin, p.out, (const float*)(p.ws + WS_MOD) + (size_t)l * 8 * 6144}, TIDX());
    }
    else if (PH == PH_NORM2) ph_norm(p, l, 1, p.out, vb0, nvb);
    else if (PH == PH_GEMM_Q) {
        pg8::Gemm g{(const bf16_t*)(p.ws + WS_H), (const bf16_t*)(p.ws + WS_WQ), 1024, 1024, 1024};
        pg8::StaticOrder S; S.init(T_TOK, 2048, nvb, vb0, 1024, 1024);
        pg8::gemm_phase((PG8_LAS unsigned char*)smem, g, S, pg8::EpiBf16{(bf16_t*)(p.ws + WS_QP), 2048}, TIDX());
    }
    else if (PH == PH_GEMM_SC) gemm_phase((const bf16_t*)(p.ws + WS_QP), 2048, (const bf16_t*)(p.ws + WS_SK), 128, T_TOK, 2048, 128, true,
                                          EpiF16{(_Float16*)(p.ws + WS_SC), 2048}, vb0, nvb, smem, TIDX());
    else if (PH == PH_ROUTE) ph_route(p, vb0, nvb, smem);
    else if (PH == PH_G1) ph_peer_sliced<0>(p, l, smem);
    else if (PH == PH_G15) ph_peer_coef(p, vb0, nvb);
    else if (PH == PH_G2) ph_peer_sliced<1>(p, l, smem);

}

#define XB_TMO      128
#define XB_XCNT(j)  (256  + 64 * (j))
#define XB_XSUB(j)  (1280 + 64 * (j))
#define XB_XGEN(j)  (2304 + 64 * (j))
#define XB_TOP      3328
#define XB_TOPGEN   3392
#define XCD_BAR_WORDS 3456
#define XB_SPIN_CAP (1u << 18)
#define LAS __attribute__((address_space(3)))
__device__ __forceinline__ unsigned xb_ld(unsigned* p)              { return __hip_atomic_load(p, __ATOMIC_RELAXED, __HIP_MEMORY_SCOPE_AGENT); }
__device__ __forceinline__ unsigned xb_add(unsigned* p, unsigned v) { return __hip_atomic_fetch_add(p, v, __ATOMIC_RELAXED, __HIP_MEMORY_SCOPE_AGENT); }
#define XB_SPIN(cond, bar) do { unsigned _sp = 0; while (cond) { __builtin_amdgcn_s_sleep(1); \
    if ((++_sp & 255u) == 0u) { if (xb_ld(&(bar)[XB_TMO])) break; if (_sp > XB_SPIN_CAP) { atomicAdd(&(bar)[XB_TMO], 1u); break; } } } } while (0)
struct XcdBarrier { unsigned* bar; unsigned x; volatile LAS unsigned* st; int wv; };
__device__ __forceinline__ XcdBarrier xcd_barrier_post(unsigned* bar, volatile LAS unsigned* st, int wv) {
    XcdBarrier b; b.bar = bar; b.x = xb_xcc_id(); b.st = st; b.wv = wv;
    if (TIDXW(wv) == 0) (void)xb_add(&bar[XB_XCNT(b.x)], 1u);
    return b;
}
__device__ __forceinline__ void xcd_barrier_complete(unsigned* bar, unsigned x, unsigned& nloc, unsigned& nx) {
    const unsigned G = gridDim.x * gridDim.y * gridDim.z;
    unsigned sum, cnt, mine, sp = 0u;
    for (;;) {
        sum = 0u; cnt = 0u; mine = 0u;
#pragma unroll
        for (unsigned j = 0; j < 16; ++j) { const unsigned c = xb_ld(&bar[XB_XCNT(j)]); sum += c; cnt += (c > 0u) ? 1u : 0u; mine = (j == x) ? c : mine; }
        if (sum == G) break;
        __builtin_amdgcn_s_sleep(1);
        if ((++sp & 255u) == 0u) { if (xb_ld(&bar[XB_TMO])) break; if (sp > XB_SPIN_CAP) { atomicAdd(&bar[XB_TMO], 1u); break; } }
    }
    nloc = mine > 0u ? mine : 1u; nx = cnt > 0u ? cnt : 1u;
}
__device__ __forceinline__ void xcd_barrier(const XcdBarrier& b) {
    asm volatile("s_waitcnt vmcnt(0)" ::: "memory");
    __syncthreads();
    if (TIDXW(b.wv) == 0) {
        unsigned* bar = b.bar;
        __builtin_amdgcn_s_waitcnt(0);
        unsigned nloc = b.st[0], nx = b.st[1];
        if (nloc == 0u) { xcd_barrier_complete(bar, b.x, nloc, nx); b.st[0] = nloc; b.st[1] = nx; }
        const unsigned old = xb_add(&bar[XB_XSUB(b.x)], 1u);
        const unsigned gen = old / nloc;
        if (old + 1u == (gen + 1u) * nloc) {
            __builtin_amdgcn_fence(__ATOMIC_RELEASE, "agent");
            asm volatile("s_waitcnt vmcnt(0)" ::: "memory");
            const unsigned og = xb_add(&bar[XB_TOP], 1u);
            const unsigned tg = og / nx;
            if (og + 1u == (tg + 1u) * nx) xb_add(&bar[XB_TOPGEN], 1u);
            else XB_SPIN(xb_ld(&bar[XB_TOPGEN]) == tg, bar);
            __builtin_amdgcn_fence(__ATOMIC_ACQUIRE, "agent");
            xb_add(&bar[XB_XGEN(b.x)], 1u);
            asm volatile("s_waitcnt vmcnt(0)" ::: "memory");
        } else {
            XB_SPIN(xb_ld(&bar[XB_XGEN(b.x)]) == gen, bar);
            __builtin_amdgcn_fence(__ATOMIC_ACQUIRE, "agent");
            asm volatile("s_waitcnt vmcnt(0)" ::: "memory");
        }
    }
    __syncthreads();
}

__global__ void __launch_bounds__(NT) mega_kernel(Params p_in) {
#if defined(__HIP_DEVICE_COMPILE__)
    extern __shared__ __attribute__((aligned(16))) char smem[];
    volatile LAS unsigned* st = (volatile LAS unsigned*)(smem + LDS_BYTES - 16);
    int wv_ = __builtin_amdgcn_readfirstlane((int)threadIdx.x >> 6); asm volatile("" : "+s"(wv_));
    { const int t_ = TIDXW(wv_); if (t_ < 4) st[t_] = 0u; }
    __syncthreads();
    XcdBarrier bar = xcd_barrier_post((unsigned*)(p_in.ws + WS_CTL), st, wv_);
    const int vb = (int)blockIdx.x, nvb = (int)gridDim.x;
#define GB() xcd_barrier(bar)
#define RUN(PH, L) do { \
        const __attribute__((address_space(4))) Params* _kp = (const __attribute__((address_space(4))) Params*)__builtin_amdgcn_kernarg_segment_ptr(); asm volatile("" : "+s"(_kp)); Params _p = *_kp; _p.wv = wv_; \
        int _l = (L), _vb = vb, _nvb = nvb; asm volatile("" : "+s"(_l), "+s"(_vb), "+s"(_nvb)); \
        run_phase<PH>(_p, _l, _vb, _nvb, smem); } while (0)
    RUN(PH_MOD, 0);
#pragma unroll 1
    for (int l = 0; l < 2; ++l) {
        RUN(PH_WPREP, l); if (l == 0) GB();
        RUN(PH_NORM1, l); GB();
        RUN(PH_GEMM_IN, l); GB();
        RUN(PH_SCAN, l); GB();
        RUN(PH_MERGE, l); GB();
        RUN(PH_OUT, l); GB();
        RUN(PH_NORM2, l); GB();
        RUN(PH_GEMM_Q, l); GB();
        RUN(PH_GEMM_SC, l); GB();
        RUN(PH_ROUTE, l); GB();
        RUN(PH_G1, l); GB();
        RUN(PH_G15, l); GB();
        RUN(PH_G2, l);
        if (l == 0) GB();
    }
#undef RUN
#undef GB
#endif
}

extern "C" void kernel_launch(void* const* d_in, const int* in_sizes, int n_in, void* d_out, int out_size, void* d_ws, size_t ws_size,
                              hipStream_t stream) {
    if (n_in != 20 || ws_size < WS_END) { fprintf(stderr, "kernel_launch: bad inputs (n_in %d ws %zu need %zu)\n", n_in, ws_size, (size_t)WS_END); return; }
    Params p{};
    p.x = (const float*)d_in[0]; p.c = (const float*)d_in[1]; p.w_ada = (const float*)d_in[2]; p.b_ada = (const float*)d_in[3];
    p.norm_mix = (const float*)d_in[4]; p.norm_ffn = (const float*)d_in[5]; p.w_in = (const float*)d_in[6]; p.hgrn_lb = (const float*)d_in[7];
    p.hgrn_on = (const float*)d_in[8]; p.dsa_qn = (const float*)d_in[9]; p.dsa_kn = (const float*)d_in[10]; p.gla_up = (const float*)d_in[11];
    p.gla_bias = (const float*)d_in[12]; p.gla_on = (const float*)d_in[13]; p.w_branch = (const float*)d_in[14]; p.w_out = (const float*)d_in[15];
    p.peer_wq = (const float*)d_in[16]; p.peer_keys = (const float*)d_in[17]; p.peer_u = (const float*)d_in[18]; p.peer_v = (const float*)d_in[19];
    p.out = (float*)d_out; p.ws = (unsigned char*)d_ws;
    static int grid = 0;
    if (grid == 0) {
        int dev = 0, cus = 0, per_cu = 0;
        hipGetDevice(&dev);
        hipDeviceGetAttribute(&cus, hipDeviceAttributeMultiprocessorCount, dev);
        hipFuncSetAttribute((const void*)mega_kernel, hipFuncAttributeMaxDynamicSharedMemorySize, LDS_BYTES);
        hipOccupancyMaxActiveBlocksPerMultiprocessor(&per_cu, (const void*)mega_kernel, NT, LDS_BYTES);
        if (per_cu < 1) { fprintf(stderr, "kernel_launch: occupancy query says %d blocks per CU\n", per_cu); per_cu = 1; }
        (void)hipGetLastError();
        grid = cus;
    }
    hipMemsetAsync((char*)d_ws + WS_CTL, 0, 32768, stream);
    void* args[] = {&p};
    hipError_t e = hipLaunchCooperativeKernel((const void*)mega_kernel, dim3(grid), dim3(NT), args, LDS_BYTES, stream);
    if (e != hipSuccess) fprintf(stderr, "cooperative launch failed: %s (grid %d)\n", hipGetErrorString(e), grid);
}
```

```cpp
#include <hip/hip_runtime.h>
#include <stdint.h>
#include <stdio.h>

typedef unsigned short bf16_t;
typedef short bf16x8 __attribute__((ext_vector_type(8)));
typedef float f32x4 __attribute__((ext_vector_type(4)));
typedef unsigned u32x4 __attribute__((ext_vector_type(4)));

#define NT 512
constexpr int T_TOK = 16384, DM = 1024, SEQ = 2048;
constexpr int LDZ = 8704;
constexpr int ZA_Q = 0, ZA_F = 512, ZA_I = 1024, ZA_G = 1536, ZB_Q = 2048, ZB_K = 2560, ZB_V = 3072, ZC_V = 3584, ZC_G = 4096,
              ZB_QI = 4608, ZC_Q = 4864, ZC_K = 5120, ZB_KI = 5376, ZB_WI = 5440, ZC_CODE = 5444, ZM = 5632;
constexpr int IN_COLS = 8532;

constexpr size_t al256(size_t x) { return (x + 255) & ~(size_t)255; }
constexpr size_t WS_CTL = 0;
constexpr size_t WS_MOD = 65536;
constexpr size_t WS_WIN = al256(WS_MOD + (size_t)2 * 8 * 6144 * 4);
constexpr size_t WS_WBR = al256(WS_WIN + (size_t)LDZ * 1024 * 2);
constexpr size_t WS_WOUT = al256(WS_WBR + (size_t)3 * 1024 * 512 * 2);
constexpr size_t WS_WQ = al256(WS_WOUT + (size_t)1024 * 1024 * 2);
constexpr size_t WS_SK = al256(WS_WQ + (size_t)2048 * 1024 * 2);
constexpr size_t WS_PU = al256(WS_SK + (size_t)16 * 128 * 128 * 2);
constexpr size_t WS_PV = al256(WS_PU + (size_t)16384 * 1024);
constexpr size_t WS_H = al256(WS_PV + (size_t)16384 * 1024);
constexpr float PU_SCALE = 32.f, PV_SCALE = 4.f;
constexpr size_t WS_OA = al256(WS_H + (size_t)T_TOK * 1024 * 2);
constexpr size_t WS_OC = al256(WS_OA + (size_t)T_TOK * 512 * 2);
constexpr size_t WS_Y = al256(WS_OC + (size_t)T_TOK * 512 * 2);
constexpr size_t WS_Z = al256(WS_Y + (size_t)T_TOK * 1536 * 2);
constexpr size_t WS_VT = al256(WS_Z + (size_t)T_TOK * LDZ * 2);
constexpr size_t WS_BM = al256(WS_VT + (size_t)T_TOK * 512 * 2);
constexpr size_t WS_END = al256(WS_BM + (size_t)T_TOK * 64 * 4);
constexpr size_t WS_QP = WS_Z;
constexpr size_t WS_SC = al256(WS_QP + (size_t)T_TOK * 2048 * 2);
constexpr size_t WS_RI = al256(WS_SC + (size_t)T_TOK * 2048 * 4);
constexpr size_t WS_RG = al256(WS_RI + (size_t)T_TOK * 128 * 4);
constexpr size_t WS_PP = al256(WS_RG + (size_t)T_TOK * 128 * 4);
static_assert(WS_PP + (size_t)8 * T_TOK * 128 * 4 <= WS_VT, "peer partials overflow the Z region");
static_assert(WS_RG + (size_t)T_TOK * 128 * 4 <= WS_END, "peer alias overflow");

struct Params {
    const float* x; const float* c; const float* w_ada; const float* b_ada; const float* norm_mix; const float* norm_ffn;
    const float* w_in; const float* hgrn_lb; const float* hgrn_on; const float* dsa_qn; const float* dsa_kn;
    const float* gla_up; const float* gla_bias; const float* gla_on; const float* w_branch; const float* w_out;
    const float* peer_wq; const float* peer_keys; const float* peer_u; const float* peer_v;
    float* out; unsigned char* ws;
    int wv, pad;
};

__device__ __forceinline__ float bf2f(bf16_t h) { return __uint_as_float(((unsigned)h) << 16); }
__device__ __forceinline__ float bflo(unsigned u) { return __uint_as_float(u << 16); }
__device__ __forceinline__ float bfhi(unsigned u) { return __uint_as_float(u & 0xffff0000u); }
__device__ __forceinline__ bf16_t f2bf(float f) { unsigned r; asm volatile("v_cvt_pk_bf16_f32 %0, %1, %1" : "=v"(r) : "v"(f)); return (bf16_t)(r & 0xffffu); }
__device__ __forceinline__ unsigned pack2(float a, float b) { unsigned r; asm volatile("v_cvt_pk_bf16_f32 %0, %1, %2" : "=v"(r) : "v"(a), "v"(b)); return r; }
__device__ __forceinline__ int lane_id_opaque() { int l; asm volatile("v_mbcnt_lo_u32_b32 %0, -1, 0\n\tv_mbcnt_hi_u32_b32 %0, -1, %0" : "=v"(l)); return l; }
template <int M> __device__ __forceinline__ int shx_i(int v) {
    if (M < 32) return __builtin_amdgcn_ds_swizzle(v, (M << 10) | 0x1f);
    return __builtin_amdgcn_ds_bpermute((lane_id_opaque() ^ 32) << 2, v);
}
template <int M> __device__ __forceinline__ float shx(float v) { return __int_as_float(shx_i<M>(__float_as_int(v))); }
template <int M> __device__ __forceinline__ int shx(int v) { return shx_i<M>(v); }
template <int M> __device__ __forceinline__ unsigned shx(unsigned v) { return (unsigned)shx_i<M>((int)v); }
__device__ __forceinline__ int bperm(int v, int src) { return __builtin_amdgcn_ds_bpermute(src << 2, v); }
__device__ __forceinline__ float bperm(float v, int src) { return __int_as_float(__builtin_amdgcn_ds_bpermute(src << 2, __float_as_int(v))); }
__device__ __forceinline__ float wave_sum(float v) { v += shx<32>(v); v += shx<16>(v); v += shx<8>(v); v += shx<4>(v); v += shx<2>(v); v += shx<1>(v); return v; }
__device__ __forceinline__ float wave_max(float v) { v = fmaxf(v, shx<32>(v)); v = fmaxf(v, shx<16>(v)); v = fmaxf(v, shx<8>(v)); v = fmaxf(v, shx<4>(v)); v = fmaxf(v, shx<2>(v)); v = fmaxf(v, shx<1>(v)); return v; }
__device__ __forceinline__ int wave_sum_i(int v) { v += shx<32>(v); v += shx<16>(v); v += shx<8>(v); v += shx<4>(v); v += shx<2>(v); v += shx<1>(v); return v; }
__device__ __forceinline__ int wave_total_i(int v) {
    v += __builtin_amdgcn_update_dpp(0, v, 0x111, 0xf, 0xf, true);
    v += __builtin_amdgcn_update_dpp(0, v, 0x112, 0xf, 0xf, true);
    v += __builtin_amdgcn_update_dpp(0, v, 0x114, 0xf, 0xf, true);
    v += __builtin_amdgcn_update_dpp(0, v, 0x118, 0xf, 0xf, true);
    v += __builtin_amdgcn_update_dpp(0, v, 0x142, 0xa, 0xf, true);
    v += __builtin_amdgcn_update_dpp(0, v, 0x143, 0xc, 0xf, true);
    return __builtin_amdgcn_readlane(v, 63);
}
__device__ __forceinline__ float sigm(float x) { return __frcp_rn(1.f + __expf(-x)); }

__device__ __forceinline__ unsigned xb_xcc_id() { return (unsigned)__builtin_amdgcn_s_getreg((3 << 11) | 20) & 0xFu; }
__device__ __forceinline__ int TIDXW(int wv) { int t; asm volatile("v_mbcnt_lo_u32_b32 %0, -1, 0\n\tv_mbcnt_hi_u32_b32 %0, -1, %0\n\tv_lshl_or_b32 %0, %1, 6, %0" : "=v"(t) : "s"(wv)); return t; }
#define TIDX() TIDXW(p.wv)

__device__ __forceinline__ int src_col(int j) {
    if (j < 3584) return j;
    if (j < 4096) return j - 3584 + 4420;
    if (j < 4608) return j - 4096 + 4948;
    if (j < 4864) return j - 4608 + 3584;
    if (j < 5120) return j - 4864 + 3908;
    if (j < 5376) return j - 5120 + 4164;
    if (j < 5440) return j - 5376 + 3840;
    if (j < 5444) return j - 5440 + 3904;
    if (j < 5460) return j - 5444 + 4932;
    if (j < 5632) return -1;
    return j - 5632 + 5460;
}

__device__ void ph_mod(const Params& p, int vb0, int nvb, char* smem_) {
    float* sc = (float*)smem_;
    float* part = sc + 8 * 1024;
    float* mod = (float*)(p.ws + WS_MOD);
    const int tid = TIDX(), lane = tid & 63, wave = tid >> 6;
    if (vb0 >= 192) return;
    for (int i = tid; i < 8 * 1024; i += NT) { float c = p.c[i]; sc[i] = c / (1.f + __expf(-c)); }
    __syncthreads();
    for (int task = vb0; task < 192; task += nvb) {
        const int l = task / 96, n0 = (task % 96) * 64;
        const float* w = p.w_ada + (size_t)l * 1024 * 6144 + (size_t)(wave * 128) * 6144 + n0 + lane;
        float acc[8];
#pragma unroll
        for (int b = 0; b < 8; ++b) acc[b] = 0.f;
#pragma unroll 1
        for (int k0 = 0; k0 < 128; k0 += 16) {
            float wv[16];
#pragma unroll
            for (int j = 0; j < 16; ++j) wv[j] = w[(size_t)(k0 + j) * 6144];
#pragma unroll
            for (int j = 0; j < 16; ++j)
#pragma unroll
                for (int b = 0; b < 8; ++b) acc[b] += sc[b * 1024 + wave * 128 + k0 + j] * wv[j];
        }
#pragma unroll
        for (int b = 0; b < 8; ++b) part[(wave * 8 + b) * 64 + lane] = acc[b];
        __syncthreads();
        {
            const int b = tid >> 6, col = tid & 63;
            float v = p.b_ada[l * 6144 + n0 + col];
#pragma unroll
            for (int w_ = 0; w_ < 8; ++w_) v += part[(w_ * 8 + b) * 64 + col];
            mod[(size_t)(l * 8 + b) * 6144 + n0 + col] = v;
        }
        __syncthreads();
    }
}

template <bool MAP>
__device__ void tr_tile(const float* __restrict__ src, int lds_, bf16_t* __restrict__ out, int ldo, int k0, int n0, float* tile, const int tid) {
    float lv[8];
    {
        const int nn = tid & 63, scol = MAP ? src_col(n0 + nn) : (n0 + nn);
#pragma unroll
        for (int i = 0; i < 8; ++i) { const int kk = (tid >> 6) + 8 * i; lv[i] = (scol >= 0) ? src[(size_t)(k0 + kk) * lds_ + scol] : 0.f; }
#pragma unroll
        for (int i = 0; i < 8; ++i) { const int kk = (tid >> 6) + 8 * i; tile[kk * 65 + nn] = lv[i]; }
    }
    __syncthreads();
#pragma unroll
    for (int i = 0; i < 4; ++i) {
        int nn = (tid >> 5) + 16 * i, kk = (tid & 31) * 2;
        unsigned v = pack2(tile[kk * 65 + nn], tile[(kk + 1) * 65 + nn]);
        *(unsigned*)(out + (size_t)(n0 + nn) * ldo + k0 + kk) = v;
    }
    __syncthreads();
}
__device__ void conv_chunk(const float* __restrict__ src, bf16_t* __restrict__ dst, size_t base, const int tid) {
    f32x4 la[4], lb[4];
#pragma unroll
    for (int i = 0; i < 4; ++i) { const size_t e = base + (size_t)(i * NT + tid) * 8; la[i] = *(const f32x4*)(src + e); lb[i] = *(const f32x4*)(src + e + 4); }
#pragma unroll
    for (int i = 0; i < 4; ++i) {
        size_t e = base + (size_t)(i * NT + tid) * 8;
        const float4 a = make_float4(la[i][0], la[i][1], la[i][2], la[i][3]), b = make_float4(lb[i][0], lb[i][1], lb[i][2], lb[i][3]);
        uint4 o; o.x = pack2(a.x, a.y); o.y = pack2(a.z, a.w); o.z = pack2(b.x, b.y); o.w = pack2(b.z, b.w);
        *(uint4*)(dst + e) = o;
    }
}
__device__ void conv_chunk_fp8(const float* __restrict__ src, unsigned char* __restrict__ dst, size_t base, float scale, const int tid) {
    f32x4 la[4], lb[4];
#pragma unroll
    for (int i = 0; i < 4; ++i) { const size_t e = base + (size_t)(i * NT + tid) * 8; la[i] = *(const f32x4*)(src + e); lb[i] = *(const f32x4*)(src + e + 4); }
#pragma unroll
    for (int i = 0; i < 4; ++i) {
        size_t e = base + (size_t)(i * NT + tid) * 8;
        const float4 a = make_float4(la[i][0], la[i][1], la[i][2], la[i][3]), b = make_float4(lb[i][0], lb[i][1], lb[i][2], lb[i][3]);
        int lo = __builtin_amdgcn_cvt_pk_fp8_f32(a.x * scale, a.y * scale, 0, false); lo = __builtin_amdgcn_cvt_pk_fp8_f32(a.z * scale, a.w * scale, lo, true);
        int hi = __builtin_amdgcn_cvt_pk_fp8_f32(b.x * scale, b.y * scale, 0, false); hi = __builtin_amdgcn_cvt_pk_fp8_f32(b.z * scale, b.w * scale, hi, true);
        const size_t row = e >> 10, col = e & 1023;
        *(uint2*)(dst + ((col >> 7) * 16384 + row) * 128 + (col & 127)) = make_uint2((unsigned)lo, (unsigned)hi);
    }
}
__device__ void ph_wprep(const Params& p, int l, int vb0, int nvb, char* smem_) {
    float* tile = (float*)smem_;
    const int tid = TIDX();
    bf16_t* WIN = (bf16_t*)(p.ws + WS_WIN); bf16_t* WBR = (bf16_t*)(p.ws + WS_WBR); bf16_t* WOUT = (bf16_t*)(p.ws + WS_WOUT);
    bf16_t* WQ = (bf16_t*)(p.ws + WS_WQ); bf16_t* SK = (bf16_t*)(p.ws + WS_SK); unsigned char* PU = p.ws + WS_PU; unsigned char* PV = p.ws + WS_PV;
    constexpr int N_WIN = 136 * 16, N_WBR = 3 * 16 * 8, N_WOUT = 16 * 16, N_WQ = 32 * 16, N_SK = 16, N_PU = 1024, N_PV = 1024;
    constexpr int TOTAL = N_WIN + N_WBR + N_WOUT + N_WQ + N_SK + N_PU + N_PV;
    for (int task = vb0; task < TOTAL; task += nvb) {
        int r = task;
        if (r < N_WIN) { int nt = r / 16, kt = r % 16; tr_tile<true>(p.w_in + (size_t)l * 1024 * IN_COLS, IN_COLS, WIN, 1024, kt * 64, nt * 64, tile, tid); continue; }
        r -= N_WIN;
        if (r < N_WBR) { int g = r / 128, rr = r % 128, nt = rr / 8, kt = rr % 8;
            tr_tile<false>(p.w_branch + (size_t)(l * 3 + g) * 512 * 1024, 1024, WBR + (size_t)g * 1024 * 512, 512, kt * 64, nt * 64, tile, tid); continue; }
        r -= N_WBR;
        if (r < N_WOUT) { int nt = r / 16, kt = r % 16; tr_tile<false>(p.w_out + (size_t)l * 1024 * 1024, 1024, WOUT, 1024, kt * 64, nt * 64, tile, tid); continue; }
        r -= N_WOUT;
        if (r < N_WQ) { int nt = r / 16, kt = r % 16; tr_tile<false>(p.peer_wq + (size_t)l * 1024 * 2048, 2048, WQ, 1024, kt * 64, nt * 64, tile, tid); continue; }
        r -= N_WQ;
        if (r < N_SK) { conv_chunk(p.peer_keys + (size_t)l * 16 * 128 * 128, SK, (size_t)r * 16384, tid); continue; }
        r -= N_SK;
        if (r < N_PU) { conv_chunk_fp8(p.peer_u + (size_t)l * 16384 * 1024, PU, (size_t)r * 16384, PU_SCALE, tid); continue; }
        r -= N_PU;
        conv_chunk_fp8(p.peer_v + (size_t)l * 16384 * 1024, PV, (size_t)r * 16384, PV_SCALE, tid);
    }
}

__device__ void ph_norm(const Params& p, int l, int which, const float* xin, int vb0, int nvb) {
    const int wave = TIDX() >> 6, lane = TIDX() & 63;
    const float* gain = (which ? p.norm_ffn : p.norm_mix) + l * 1024;
    const float* modb = (const float*)(p.ws + WS_MOD);
    bf16_t* H = (bf16_t*)(p.ws + WS_H);
    f32x4 g[4];
#pragma unroll
    for (int i = 0; i < 4; ++i) g[i] = *(const f32x4*)(gain + (lane + 64 * i) * 4);
    for (int t = vb0 * 8 + wave; t < T_TOK; t += nvb * 8) {
        const int b = t >> 11;
        const float* mod = modb + (size_t)(l * 8 + b) * 6144 + (which ? 3072 : 0);
        const f32x4* xr = (const f32x4*)(xin + (size_t)t * 1024);
        f32x4 v[4], sc[4], sh[4]; float ss = 0.f;
#pragma unroll
        for (int i = 0; i < 4; ++i) { v[i] = xr[lane + 64 * i]; sc[i] = *(const f32x4*)(mod + 1024 + (lane + 64 * i) * 4); sh[i] = *(const f32x4*)(mod + (lane + 64 * i) * 4); }
#pragma unroll
        for (int i = 0; i < 4; ++i) ss += v[i][0] * v[i][0] + v[i][1] * v[i][1] + v[i][2] * v[i][2] + v[i][3] * v[i][3];
        ss = wave_sum(ss);
        const float rstd = rsqrtf(ss * (1.f / 1024.f) + 1e-6f);
#pragma unroll
        for (int i = 0; i < 4; ++i) {
            const int idx = (lane + 64 * i) * 4;
            const f32x4 h = v[i] * rstd * g[i] * (1.f + sc[i]) + sh[i];
            uint2 o; o.x = pack2(h[0], h[1]); o.y = pack2(h[2], h[3]);
            *(uint2*)(H + (size_t)t * 1024 + idx) = o;
        }
    }
}

constexpr int GBM = 256, GBN = 128, GBK = 64, GLS = 72;
__device__ __forceinline__ void gemm_tile(const bf16_t* __restrict__ A, int lda, const bf16_t* __restrict__ Bt, int ldb, int K,
                                          int m0, int n0, bf16_t* sA, bf16_t* sB, f32x4 (&acc)[4][4], const int tid) {
    const int lane = tid & 63, wave = tid >> 6;
    const int wm = wave >> 1, wn = wave & 1, fr = lane & 15, fq = lane >> 4;
    u32x4 ra[4], rb[2];
    const int crow = tid >> 3, ckc = (tid & 7) * 8;
    const bf16_t* Ag = A + (size_t)(m0 + crow) * lda + ckc;
    const bf16_t* Bg = Bt + (size_t)(n0 + crow) * ldb + ckc;
#pragma unroll
    for (int i = 0; i < 4; ++i) ra[i] = *(const u32x4*)(Ag + (size_t)(64 * i) * lda);
#pragma unroll
    for (int i = 0; i < 2; ++i) rb[i] = *(const u32x4*)(Bg + (size_t)(64 * i) * ldb);
    for (int k0 = 0; k0 < K; k0 += GBK) {
        __syncthreads();
#pragma unroll
        for (int i = 0; i < 4; ++i) *(u32x4*)(sA + (crow + 64 * i) * GLS + ckc) = ra[i];
#pragma unroll
        for (int i = 0; i < 2; ++i) *(u32x4*)(sB + (crow + 64 * i) * GLS + ckc) = rb[i];
        __syncthreads();
        {
            const int kn = (k0 + GBK < K) ? (k0 + GBK) : k0;
#pragma unroll
            for (int i = 0; i < 4; ++i) ra[i] = *(const u32x4*)(Ag + (size_t)(64 * i) * lda + kn);
#pragma unroll
            for (int i = 0; i < 2; ++i) rb[i] = *(const u32x4*)(Bg + (size_t)(64 * i) * ldb + kn);
        }
#pragma unroll
        for (int ks = 0; ks < 2; ++ks) {
            bf16x8 af[4], wf[4];
#pragma unroll
            for (int mf = 0; mf < 4; ++mf) af[mf] = *(const bf16x8*)(sA + (wm * 64 + mf * 16 + fr) * GLS + ks * 32 + fq * 8);
#pragma unroll
            for (int nf = 0; nf < 4; ++nf) wf[nf] = *(const bf16x8*)(sB + (wn * 64 + nf * 16 + fr) * GLS + ks * 32 + fq * 8);
#pragma unroll
            for (int nf = 0; nf < 4; ++nf)
#pragma unroll
                for (int mf = 0; mf < 4; ++mf)
                    acc[nf][mf] = __builtin_amdgcn_mfma_f32_16x16x32_bf16(wf[nf], af[mf], acc[nf][mf], 0, 0, 0);
        }
    }
}


namespace pg8 {
#define PG8_LAS __attribute__((address_space(3)))
constexpr int BM = 256, BK = 64, HALF = 128, HTB = HALF * BK * 2, STAGE_BYTES = 8 * HTB, NXCD = 8, WGM = 8;
__device__ __forceinline__ int lds_byte(int r, int c) { const int st = (r >> 4) * 2 + (c >> 5), rr = r & 15, cc = c & 31, ob = rr * 64 + cc * 2; return st * 1024 + (ob ^ (((ob >> 9) & 1) << 5)); }
__device__ __forceinline__ void stage_rc(int b, int& R, int& C) { const int st = b / 1024, sb = b % 1024, swz = sb ^ (((sb >> 9) & 1) << 5); R = (st >> 1) * 16 + swz / 64; C = (st & 1) * 32 + (swz % 64) / 2; }
__device__ __forceinline__ int perm32(int rho) { const int n = rho >> 4, i = rho & 15; return 8 * (i >> 2) + 4 * n + (i & 3); }
struct Unit { int pm, pn, aux; size_t aoff, boff; };
struct Gemm { const bf16_t* A; const bf16_t* Bt; int lda, ldb, K; };

struct StaticOrder {
    int nM, nN, nwg, G, c, lda, ldb;
    __device__ void init(int M, int N, int G_, int c_, int lda_, int ldb_) { nM = M / BM; nN = N / BM; nwg = nM * nN; G = G_; c = c_; lda = lda_; ldb = ldb_; }
    __device__ bool next(int i, Unit& u) const {
        const long L = (long)i * G + c; if (L >= nwg) return false;
        int wgid = (int)L; { const int q = nwg / NXCD, r = nwg % NXCD, xcd = wgid % NXCD, off = wgid / NXCD; wgid = (xcd < r ? xcd * (q + 1) : r * (q + 1) + (xcd - r) * q) + off; }
        const int nig = WGM * nN, gid = wgid / nig, fm = gid * WGM, gsz = (nM - fm) < WGM ? (nM - fm) : WGM;
        u.pm = fm + ((wgid % nig) % gsz); u.pn = (wgid % nig) / gsz; u.aux = 0;
        u.aoff = (size_t)u.pm * BM * lda * 2; u.boff = (size_t)u.pn * BM * ldb * 2;
        return true;
    }
};
struct MergeOrder {
    int c, G;
    __device__ bool next(int i, Unit& u) const {
        const int tile = c + (i / 3) * G; if (tile >= 256) return false;
        u.pm = tile & 63; u.pn = tile >> 6; u.aux = i % 3;
        u.aoff = ((size_t)u.pm * BM * 1536 + (size_t)u.aux * 512) * 2; u.boff = ((size_t)u.aux * 1024 + (size_t)u.pn * BM) * 512 * 2;
        return true;
    }
};

template <class Epi, class Sched>
__device__ __forceinline__ void gemm_phase(PG8_LAS unsigned char* lds, const Gemm g, const Sched& S, const Epi& E, const int tid) {
    const int wid = __builtin_amdgcn_readfirstlane(tid >> 6), lane = tid & 63, wr = wid >> 2, wc = wid & 3, fr = lane & 15, fq = lane >> 4;
    const int K = g.K, nt = K / BK;
    unsigned voffA[2], voffB[2];
#pragma unroll
    for (int i = 0; i < 2; ++i) { int R, C; stage_rc(tid * 16 + i * 8192, R, C); const int Rb = Epi::PERM ? ((R & ~31) + perm32(R & 31)) : R;
        voffA[i] = (unsigned)(R * g.lda + C) * 2u; voffB[i] = (unsigned)(Rb * g.ldb + C) * 2u; }
    const size_t kstep = (size_t)(BK * 2);
    const size_t hstepA = (size_t)HALF * g.lda * 2, hstepB = (size_t)HALF * g.ldb * 2;
    const unsigned ldsw = (unsigned)wid * 1024u;
    const int aoff = lds_byte(wr * 64 + fr, fq * 8), boff = lds_byte(wc * 32 + fr, fq * 8);
#define PG8_SA(b, h) (((b) * 2 + (h)) * HTB)
#define PG8_SB(b, h) ((4 + (b) * 2 + (h)) * HTB)
#define PG8_STAGE(bufoff, gbase, voff) do { _Pragma("unroll") for (int _i = 0; _i < 2; ++_i) \
        __builtin_amdgcn_global_load_lds((const unsigned*)((const char*)(gbase) + (voff)[_i]), (PG8_LAS unsigned*)(lds + (bufoff) + ldsw + _i * 8192), 16, 0, 0); } while (0)
#define PG8_LDA(dst, b, h) do { _Pragma("unroll") for (int m = 0; m < 4; ++m) _Pragma("unroll") for (int k = 0; k < 2; ++k) dst[m][k] = *(const PG8_LAS bf16x8*)(lds + PG8_SA(b, h) + aoff + m * 2048 + k * 1024); } while (0)
#define PG8_LDB(dst, b, h) do { _Pragma("unroll") for (int n = 0; n < 2; ++n) _Pragma("unroll") for (int k = 0; k < 2; ++k) dst[n][k] = *(const PG8_LAS bf16x8*)(lds + PG8_SB(b, h) + boff + n * 2048 + k * 1024); } while (0)
#define PG8_MMA(ai, bj, At, Bt) do { __builtin_amdgcn_s_setprio(1); _Pragma("unroll") for (int m = 0; m < 4; ++m) _Pragma("unroll") for (int n = 0; n < 2; ++n) _Pragma("unroll") for (int k = 0; k < 2; ++k) \
        acc[ai][bj][m][n] = __builtin_amdgcn_mfma_f32_16x16x32_bf16(Bt[n][k], At[m][k], acc[ai][bj][m][n], 0, 0, 0); __builtin_amdgcn_s_setprio(0); } while (0)
#define PG8_WAIT_V(n) asm volatile("s_waitcnt vmcnt(" #n ")" ::: "memory")
#define PG8_WAIT_L(n) asm volatile("s_waitcnt lgkmcnt(" #n ")" ::: "memory")
#define PG8_BAR __builtin_amdgcn_s_barrier()
#define PG8_SCHED __builtin_amdgcn_sched_barrier(0)
    Unit cur, nxt; int ui = 0;
    if (!S.next(0, cur)) return;
    f32x4 acc[2][2][4][2];
#pragma unroll
    for (int a = 0; a < 2; ++a)
#pragma unroll
        for (int b = 0; b < 2; ++b)
#pragma unroll
            for (int m = 0; m < 4; ++m)
#pragma unroll
                for (int n = 0; n < 2; ++n) acc[a][b][m][n] = f32x4{0.f, 0.f, 0.f, 0.f};
    bf16x8 At[4][2], B0[2][2], B1[2][2];
    const char* cA = (const char*)g.A + cur.aoff; const char* cB = (const char*)g.Bt + cur.boff;
    PG8_STAGE(PG8_SB(0, 0), cB, voffB); PG8_STAGE(PG8_SA(0, 0), cA, voffA); PG8_STAGE(PG8_SB(0, 1), cB + hstepB, voffB); PG8_STAGE(PG8_SA(0, 1), cA + hstepA, voffA);
    if (wr == 1) PG8_BAR;
    PG8_WAIT_V(4); PG8_BAR;
    PG8_STAGE(PG8_SB(1, 0), cB + kstep, voffB); PG8_STAGE(PG8_SA(1, 0), cA + kstep, voffA); PG8_STAGE(PG8_SB(1, 1), cB + hstepB + kstep, voffB);
    PG8_WAIT_V(6); PG8_BAR;
    for (;;) {
        const bool has_next = S.next(ui + 1, nxt);
        const char* nA = has_next ? (const char*)g.A + nxt.aoff : cA; const char* nB = has_next ? (const char*)g.Bt + nxt.boff : cB;
        for (int t = 0; t < nt; t += 2) {
            const bool last = (t == nt - 2);
            const char* a1 = cA + (size_t)(t + 1) * kstep;
            const char* a2 = last ? nA : cA + (size_t)(t + 2) * kstep; const char* b2 = last ? nB : cB + (size_t)(t + 2) * kstep;
            const char* a3 = a2 + kstep; const char* b3 = b2 + kstep;
            PG8_LDB(B0, 0, 0); PG8_SCHED; PG8_LDA(At, 0, 0); PG8_STAGE(PG8_SA(1, 1), a1 + hstepA, voffA);
            PG8_WAIT_L(8); PG8_BAR; PG8_WAIT_L(0); PG8_MMA(0, 0, At, B0); PG8_BAR; PG8_SCHED;
            PG8_LDB(B1, 0, 1); PG8_STAGE(PG8_SB(0, 0), b2, voffB);
            PG8_BAR; PG8_WAIT_L(0); PG8_MMA(0, 1, At, B1); PG8_BAR;
            PG8_LDA(At, 0, 1); PG8_STAGE(PG8_SA(0, 0), a2, voffA);
            PG8_BAR; PG8_WAIT_L(0); PG8_MMA(1, 0, At, B0); PG8_BAR; PG8_SCHED;
            PG8_STAGE(PG8_SB(0, 1), b2 + hstepB, voffB);
            PG8_WAIT_V(6); PG8_BAR; PG8_MMA(1, 1, At, B1); PG8_BAR;
            PG8_LDB(B0, 1, 0); PG8_SCHED; PG8_LDA(At, 1, 0); PG8_STAGE(PG8_SA(0, 1), a2 + hstepA, voffA);
            PG8_WAIT_L(8); PG8_BAR; PG8_WAIT_L(0); PG8_MMA(0, 0, At, B0); PG8_BAR; PG8_SCHED;
            PG8_LDB(B1, 1, 1); PG8_STAGE(PG8_SB(1, 0), b3, voffB);
            PG8_BAR; PG8_WAIT_L(0); PG8_MMA(0, 1, At, B1); PG8_BAR;
            PG8_LDA(At, 1, 1); PG8_STAGE(PG8_SA(1, 0), a3, voffA);
            PG8_BAR; PG8_WAIT_L(0); PG8_MMA(1, 0, At, B0); PG8_BAR; PG8_SCHED;
            PG8_STAGE(PG8_SB(1, 1), b3 + hstepB, voffB);
            PG8_WAIT_V(6); PG8_BAR; PG8_MMA(1, 1, At, B1); PG8_BAR;
        }
        E(acc, cur, wr, wc, fr, fq);
        if (!has_next) break;
#pragma unroll
        for (int a = 0; a < 2; ++a)
#pragma unroll
            for (int b = 0; b < 2; ++b)
#pragma unroll
                for (int m = 0; m < 4; ++m)
#pragma unroll
                    for (int n = 0; n < 2; ++n) acc[a][b][m][n] = f32x4{0.f, 0.f, 0.f, 0.f};
        cur = nxt; cA = nA; cB = nB; ++ui;
    }
    PG8_WAIT_V(0);
    if (wr == 0) PG8_BAR;
    PG8_BAR;
#undef PG8_SA
#undef PG8_SB
#undef PG8_STAGE
#undef PG8_LDA
#undef PG8_LDB
#undef PG8_MMA
#undef PG8_WAIT_V
#undef PG8_WAIT_L
#undef PG8_BAR
#undef PG8_SCHED
}

struct EpiBf16 {
    static constexpr bool PERM = true;
    bf16_t* O; int ldc;
    __device__ __forceinline__ void operator()(const f32x4 (&acc)[2][2][4][2], const Unit& u, int wr, int wc, int fr, int fq) const {
        const int row0 = u.pm * BM + wr * 64 + fr, col0 = u.pn * BM + wc * 32 + 8 * fq;
#pragma unroll
        for (int ai = 0; ai < 2; ++ai)
#pragma unroll
            for (int m = 0; m < 4; ++m) { bf16_t* rowp = O + (size_t)(row0 + ai * HALF + m * 16) * ldc + col0;
#pragma unroll
                for (int bj = 0; bj < 2; ++bj) { const f32x4 v0 = acc[ai][bj][m][0], v1 = acc[ai][bj][m][1];
                    u32x4 w; w.x = pack2(v0[0], v0[1]); w.y = pack2(v0[2], v0[3]); w.z = pack2(v1[0], v1[1]); w.w = pack2(v1[2], v1[3]);
                    *(u32x4*)(rowp + bj * HALF) = w; } }
    }
};
struct EpiResid {
    static constexpr bool PERM = false;
    const float* xin; float* out; const float* mod;
    __device__ __forceinline__ void operator()(const f32x4 (&acc)[2][2][4][2], const Unit& u, int wr, int wc, int fr, int fq) const {
        const int row0 = u.pm * BM + wr * 64 + fr, col0 = u.pn * BM + wc * 32 + 4 * fq;
        const float* gm = mod + (size_t)(row0 >> 11) * 6144 + 2048 + col0;
        f32x4 g4[2][2];
#pragma unroll
        for (int bj = 0; bj < 2; ++bj)
#pragma unroll
            for (int n = 0; n < 2; ++n) g4[bj][n] = *(const f32x4*)(gm + bj * HALF + n * 16);
#pragma unroll
        for (int ai = 0; ai < 2; ++ai) {
            f32x4 xi[4][2][2];
#pragma unroll
            for (int m = 0; m < 4; ++m)
#pragma unroll
                for (int bj = 0; bj < 2; ++bj)
#pragma unroll
                    for (int n = 0; n < 2; ++n) xi[m][bj][n] = *(const f32x4*)(xin + (size_t)(row0 + ai * HALF + m * 16) * 1024 + col0 + bj * HALF + n * 16);
            asm volatile("" ::: "memory");
#pragma unroll
            for (int m = 0; m < 4; ++m)
#pragma unroll
                for (int bj = 0; bj < 2; ++bj)
#pragma unroll
                    for (int n = 0; n < 2; ++n)
                        *(f32x4*)(out + (size_t)(row0 + ai * HALF + m * 16) * 1024 + col0 + bj * HALF + n * 16) = xi[m][bj][n] + g4[bj][n] * acc[ai][bj][m][n];
            asm volatile("" ::: "memory");
        }
    }
};
struct EpiMerge {
    static constexpr bool PERM = true;
    bf16_t* Hm; const bf16_t* Z;
    __device__ __forceinline__ void operator()(const f32x4 (&acc)[2][2][4][2], const Unit& u, int wr, int wc, int fr, int fq) const {
        const int row0 = u.pm * BM + wr * 64 + fr, col0 = u.pn * BM + wc * 32 + 8 * fq, g = u.aux;
#pragma unroll
        for (int ai = 0; ai < 2; ++ai) {
            u32x4 gz[4][2], prev[4][2];
#pragma unroll
            for (int m = 0; m < 4; ++m)
#pragma unroll
                for (int bj = 0; bj < 2; ++bj) {
                    const int row = row0 + ai * HALF + m * 16, col = col0 + bj * HALF;
                    gz[m][bj] = *(const u32x4*)(Z + (size_t)row * LDZ + ZM + g * 1024 + col);
                    prev[m][bj] = u32x4{0u, 0u, 0u, 0u};
                    if (g > 0) prev[m][bj] = *(const u32x4*)(Hm + (size_t)row * 1024 + col);
                }
            asm volatile("" ::: "memory");
#pragma unroll
            for (int m = 0; m < 4; ++m)
#pragma unroll
                for (int bj = 0; bj < 2; ++bj) {
                    const int row = row0 + ai * HALF + m * 16, col = col0 + bj * HALF;
                    const f32x4 v0 = acc[ai][bj][m][0], v1 = acc[ai][bj][m][1];
                    const u32x4 z_ = gz[m][bj], p_ = prev[m][bj];
                    u32x4 w;
                    w.x = pack2(bflo(p_.x) + sigm(bflo(z_.x)) * v0[0], bfhi(p_.x) + sigm(bfhi(z_.x)) * v0[1]);
                    w.y = pack2(bflo(p_.y) + sigm(bflo(z_.y)) * v0[2], bfhi(p_.y) + sigm(bfhi(z_.y)) * v0[3]);
                    w.z = pack2(bflo(p_.z) + sigm(bflo(z_.z)) * v1[0], bfhi(p_.z) + sigm(bfhi(z_.z)) * v1[1]);
                    w.w = pack2(bflo(p_.w) + sigm(bflo(z_.w)) * v1[2], bfhi(p_.w) + sigm(bfhi(z_.w)) * v1[3]);
                    *(u32x4*)(Hm + (size_t)row * 1024 + col) = w;
                }
            asm volatile("" ::: "memory");
        }
    }
};
}

struct EpiZ {
    bf16_t* Z; int ld;
    __device__ __forceinline__ void operator()(int m, int n, const f32x4& v) const {
        uint2 o; o.x = pack2(v[0], v[1]); o.y = pack2(v[2], v[3]);
        *(uint2*)(Z + (size_t)m * ld + n) = o;
    }
};
struct EpiF16 {
    _Float16* C; int ld;
    __device__ __forceinline__ void operator()(int m, int n, const f32x4& v) const {
        typedef _Float16 h4 __attribute__((ext_vector_type(4)));
        h4 o = {(_Float16)v[0], (_Float16)v[1], (_Float16)v[2], (_Float16)v[3]};
        *(h4*)(C + (size_t)m * ld + n) = o;
    }
};
struct EpiOut {
    const float* xin; float* out; const float* mod;
    __device__ __forceinline__ void operator()(int m, int n, const f32x4& v) const {
        int b = m >> 11;
        float4 g = *(const float4*)(mod + (size_t)b * 6144 + 2048 + n);
        float4 xi = *(const float4*)(xin + (size_t)m * 1024 + n);
        *(float4*)(out + (size_t)m * 1024 + n) = make_float4(xi.x + g.x * v[0], xi.y + g.y * v[1], xi.z + g.z * v[2], xi.w + g.w * v[3]);
    }
};

template <class Epi>
__device__ void gemm_phase(const bf16_t* A, int lda, const bf16_t* Bt, int ldb, int M, int N, int K, bool batched, Epi epi,
                           int vb0, int nvb, char* smem_, const int tid) {
    bf16_t* sA = (bf16_t*)smem_; bf16_t* sB = sA + GBM * GLS;
    const int lane = tid & 63, wave = tid >> 6, wm = wave >> 1, wn = wave & 1, fr = lane & 15, fq = lane >> 4;
    const int MT = M / GBM, NTL = N / GBN;
    for (int tile = vb0; tile < MT * NTL; tile += nvb) {
        int mt = tile % MT, nt = tile / MT;
        f32x4 acc[4][4];
#pragma unroll
        for (int a = 0; a < 4; ++a)
#pragma unroll
            for (int b = 0; b < 4; ++b) acc[a][b] = f32x4{0.f, 0.f, 0.f, 0.f};
        gemm_tile(batched ? A + nt * 128 : A, lda, Bt, ldb, K, mt * GBM, nt * GBN, sA, sB, acc, tid);
#pragma unroll
        for (int nf = 0; nf < 4; ++nf)
#pragma unroll
            for (int mf = 0; mf < 4; ++mf)
                epi(mt * GBM + wm * 64 + mf * 16 + fr, nt * GBN + wn * 64 + nf * 16 + fq * 4, acc[nf][mf]);
    }
}


#define SCAN_SYNC() do { asm volatile("s_waitcnt lgkmcnt(0)" ::: "memory"); __builtin_amdgcn_s_barrier(); asm volatile("" ::: "memory"); } while (0)
template <int DK, bool GLA>
__device__ void scan2_item(const Params& p, int l, int b, int h, char* smem_) {
    constexpr int SEG = NT / DK, SLEN = 64 / SEG, KS = DK / 32, KT = DK / 16;
    constexpr int QS = DK + 8, BS = DK + 4, VS = 72;
    bf16_t* qs = (bf16_t*)smem_;
    bf16_t* ks = qs + 64 * QS;
    float* bs = (float*)(ks + 64 * QS);
    bf16_t* vt = (bf16_t*)(bs + 64 * BS);
    bf16_t* At = vt + 128 * VS;
    bf16_t* kht = At + 64 * VS;
    bf16_t* st = kht + DK * VS;
    float* segtot = (float*)(st + 128 * QS);
    float* blast = segtot + SEG * DK;
    const int tid = TIDX(), lane = tid & 63, wave = __builtin_amdgcn_readfirstlane(tid >> 6), fr = lane & 15, fq = lane >> 4;
    const int kl = tid % DK, seg = __builtin_amdgcn_readfirstlane(tid / DK);
    float lbv = 0.f, gbias = 0.f; float gu[16];
#pragma unroll
    for (int r = 0; r < 16; ++r) gu[r] = 0.f;
    if (GLA) {
#pragma unroll
        for (int r = 0; r < 16; ++r) gu[r] = p.gla_up[(size_t)(l * 16 + r) * 256 + h * 64 + kl];
        gbias = p.gla_bias[l * 256 + h * 64 + kl];
    } else if (l == 1) {
        float x0 = p.hgrn_lb[h * 128 + kl], x1 = p.hgrn_lb[512 + h * 128 + kl];
        lbv = 1.f / (1.f + expf(x0 - x1));
    }
    const float scale = GLA ? 0.125f : 0.08838834764831845f;
    const bf16_t* Zb = (const bf16_t*)(p.ws + WS_Z) + (size_t)(b * 2048) * LDZ;
    float* ssq = (float*)(smem_ + 152576);
    const int QCOL = (GLA ? ZC_Q : ZA_Q) + h * DK, KCOL = (GLA ? ZC_K : ZA_F) + h * DK, VCOL = (GLA ? ZC_V : ZA_I) + h * 128, GCOL = (GLA ? ZC_G : ZA_G) + h * 128;
    f32x4 sacc[KT];
#pragma unroll
    for (int i = 0; i < KT; ++i) sacc[i] = f32x4{0.f, 0.f, 0.f, 0.f};
    f32x4 gn4[4];
    {
        const float* gn = (GLA ? p.gla_on : p.hgrn_on) + l * 128 + (wave >> 2) * 64 + 4 * fq;
#pragma unroll
        for (int vi = 0; vi < 4; ++vi) gn4[vi] = *(const f32x4*)(gn + vi * 16);
    }
    for (int i = tid; i < 128 * QS / 2; i += NT) ((unsigned*)st)[i] = 0u;
    SCAN_SYNC();

    for (int c = 0; c < 32; ++c) {
        const bf16_t* Zc = Zb + (size_t)(c * 64) * LDZ;
        {
            bf16_t rq[SLEN], rk[SLEN];
            u32x4 rc0[GLA ? SLEN : 1], rc1[GLA ? SLEN : 1];
            {
                bf16_t rv[16];
                const int v = tid & 127, sb_ = __builtin_amdgcn_readfirstlane(tid >> 7);
#pragma unroll
                for (int i = 0; i < 16; ++i) rv[i] = Zc[(size_t)(sb_ + 4 * i) * LDZ + VCOL + v];
#pragma unroll
                for (int i = 0; i < SLEN; ++i) {
                    const bf16_t* zr = Zc + (size_t)(seg * SLEN + i) * LDZ;
                    rq[i] = zr[QCOL + kl]; rk[i] = zr[KCOL + kl];
                    if (GLA) { rc0[i] = *(const u32x4*)(zr + ZC_CODE); rc1[i] = *(const u32x4*)(zr + ZC_CODE + 8); }
                }
#pragma unroll
                for (int i = 0; i < 16; ++i) vt[v * VS + sb_ + 4 * i] = rv[i];
            }
            float run = 0.f;
#pragma unroll
            for (int i = 0; i < SLEN; ++i) {
                const int s_ = seg * SLEN + i;
                float g, kk;
                if (GLA) {
                    float x = gbias;
#pragma unroll
                    for (int r = 0; r < 4; ++r) {
                        x += bflo(rc0[i][r]) * gu[2 * r] + bfhi(rc0[i][r]) * gu[2 * r + 1];
                        x += bflo(rc1[i][r]) * gu[8 + 2 * r] + bfhi(rc1[i][r]) * gu[8 + 2 * r + 1];
                    }
                    g = (fminf(x, 0.f) - __logf(1.f + __expf(-fabsf(x)))) * (1.f / 16.f);
                    kk = bf2f(rk[i]);
                } else {
                    const float f = lbv + (1.f - lbv) * __frcp_rn(1.f + __expf(-bf2f(rk[i])));
                    g = __logf(f); kk = 1.f - f;
                }
                run += g;
                bs[s_ * BS + kl] = run;
                qs[s_ * QS + kl] = rq[i];
                ks[s_ * QS + kl] = f2bf(kk);
            }
            segtot[seg * DK + kl] = run;
        }
        SCAN_SYNC();
        {
            float pre = 0.f, tot = 0.f;
#pragma unroll
            for (int g_ = 0; g_ < SEG; ++g_) { const float v_ = segtot[g_ * DK + kl]; if (g_ < seg) pre += v_; tot += v_; }
            if (seg == 0) blast[kl] = tot;
            unsigned pk[SLEN / 2];
#pragma unroll
            for (int i = 0; i < SLEN; ++i) {
                const float bv = bs[(seg * SLEN + i) * BS + kl] + pre;
                bs[(seg * SLEN + i) * BS + kl] = bv;
                const float kh = bf2f(ks[(seg * SLEN + i) * QS + kl]) * __expf(tot - bv);
                if (i & 1) pk[i >> 1] |= ((unsigned)f2bf(kh)) << 16; else pk[i >> 1] = (unsigned)f2bf(kh);
            }
            unsigned* dst = (unsigned*)(kht + kl * VS + seg * SLEN);
#pragma unroll
            for (int i = 0; i < SLEN / 2; ++i) dst[i] = pk[i];
        }
        SCAN_SYNC();
        for (int blk = wave; blk < 10; blk += 8) {
            int bi, bj;
            if (blk < 1) { bi = 0; bj = 0; } else if (blk < 3) { bi = 1; bj = blk - 1; } else if (blk < 6) { bi = 2; bj = blk - 3; } else { bi = 3; bj = blk - 6; }
            f32x4 acc = f32x4{0.f, 0.f, 0.f, 0.f};
            const int srow = bj * 16 + fr, trow = bi * 16 + fr;
#pragma unroll
            for (int kk = 0; kk < KS; ++kk) {
                const int k0 = kk * 32 + fq * 8;
                float br[8];
                if (bi == 0) {
#pragma unroll
                    for (int j = 0; j < 8; ++j) br[j] = 0.f;
                } else {
                    const float4 r0 = *(const float4*)(bs + (bi * 16 - 1) * BS + k0), r1 = *(const float4*)(bs + (bi * 16 - 1) * BS + k0 + 4);
                    br[0] = r0.x; br[1] = r0.y; br[2] = r0.z; br[3] = r0.w; br[4] = r1.x; br[5] = r1.y; br[6] = r1.z; br[7] = r1.w;
                }
                const uint4 kq = *(const uint4*)(ks + srow * QS + k0), qq = *(const uint4*)(qs + trow * QS + k0);
                const float4 s0 = *(const float4*)(bs + srow * BS + k0), s1 = *(const float4*)(bs + srow * BS + k0 + 4);
                const float4 t0_ = *(const float4*)(bs + trow * BS + k0), t1_ = *(const float4*)(bs + trow * BS + k0 + 4);
                const float bsv[8] = {s0.x, s0.y, s0.z, s0.w, s1.x, s1.y, s1.z, s1.w}, btv[8] = {t0_.x, t0_.y, t0_.z, t0_.w, t1_.x, t1_.y, t1_.z, t1_.w};
                const unsigned kw[4] = {kq.x, kq.y, kq.z, kq.w}, qw[4] = {qq.x, qq.y, qq.z, qq.w};
                union { bf16x8 v; unsigned u[4]; } ka, qb;
#pragma unroll
                for (int j = 0; j < 4; ++j) {
                    const float e0 = __expf(fminf(br[2 * j] - bsv[2 * j], 60.f)), e1 = __expf(fminf(br[2 * j + 1] - bsv[2 * j + 1], 60.f));
                    ka.u[j] = pack2(bflo(kw[j]) * e0, bfhi(kw[j]) * e1);
                    const float f0 = __expf(btv[2 * j] - br[2 * j]), f1 = __expf(btv[2 * j + 1] - br[2 * j + 1]);
                    qb.u[j] = pack2(bflo(qw[j]) * f0, bfhi(qw[j]) * f1);
                }
                acc = __builtin_amdgcn_mfma_f32_16x16x32_bf16(ka.v, qb.v, acc, 0, 0, 0);
            }
            if (bi == bj) {
#pragma unroll
                for (int r = 0; r < 4; ++r) if (4 * fq + r > fr) acc[r] = 0.f;
            }
            uint2 o; o.x = pack2(acc[0], acc[1]); o.y = pack2(acc[2], acc[3]);
            *(uint2*)(At + trow * VS + bj * 16 + 4 * fq) = o;
        }
        {
            unsigned z_ = 0u; asm volatile("" : "+v"(z_));
            if (wave == 2) *(uint2*)(At + (0 * 16 + fr) * VS + 16 + 4 * fq) = make_uint2(z_, z_);
            if (wave == 3) *(uint2*)(At + (2 * 16 + fr) * VS + 48 + 4 * fq) = make_uint2(z_, z_);
        }
        SCAN_SYNC();
        f32x4 oacc[4]; uint2 gz[4];
        {
            const int ti = wave & 3, vh = wave >> 2, trow = ti * 16 + fr;
            bf16x8 qh[KS];
#pragma unroll
            for (int kk = 0; kk < KS; ++kk) {
                const int k0 = kk * 32 + fq * 8;
                const uint4 qq = *(const uint4*)(qs + trow * QS + k0);
                const float4 t0_ = *(const float4*)(bs + trow * BS + k0), t1_ = *(const float4*)(bs + trow * BS + k0 + 4);
                union { bf16x8 v; unsigned u[4]; } q_;
                q_.u[0] = pack2(bflo(qq.x) * __expf(t0_.x), bfhi(qq.x) * __expf(t0_.y));
                q_.u[1] = pack2(bflo(qq.y) * __expf(t0_.z), bfhi(qq.y) * __expf(t0_.w));
                q_.u[2] = pack2(bflo(qq.z) * __expf(t1_.x), bfhi(qq.z) * __expf(t1_.y));
                q_.u[3] = pack2(bflo(qq.w) * __expf(t1_.z), bfhi(qq.w) * __expf(t1_.w));
                qh[kk] = q_.v;
            }
            const bf16x8 af0 = *(const bf16x8*)(At + trow * VS + fq * 8), af1 = *(const bf16x8*)(At + trow * VS + 32 + fq * 8);
            float sq = 0.f;
#pragma unroll
            for (int vi = 0; vi < 4; ++vi) {
                const int vrow = vh * 64 + vi * 16 + fr;
                gz[vi] = *(const uint2*)(Zc + (size_t)trow * LDZ + GCOL + vh * 64 + vi * 16 + 4 * fq);
                f32x4 acc = f32x4{0.f, 0.f, 0.f, 0.f};
                acc = __builtin_amdgcn_mfma_f32_16x16x32_bf16(*(const bf16x8*)(vt + vrow * VS + fq * 8), af0, acc, 0, 0, 0);
                if (ti >= 2) acc = __builtin_amdgcn_mfma_f32_16x16x32_bf16(*(const bf16x8*)(vt + vrow * VS + 32 + fq * 8), af1, acc, 0, 0, 0);
#pragma unroll
                for (int kk = 0; kk < KS; ++kk)
                    acc = __builtin_amdgcn_mfma_f32_16x16x32_bf16(*(const bf16x8*)(st + vrow * QS + kk * 32 + fq * 8), qh[kk], acc, 0, 0, 0);
                oacc[vi] = acc * scale;
                sq += oacc[vi][0] * oacc[vi][0] + oacc[vi][1] * oacc[vi][1] + oacc[vi][2] * oacc[vi][2] + oacc[vi][3] * oacc[vi][3];
            }
            sq += shx<16>(sq); sq += shx<32>(sq);
            if (fq == 0) ssq[vh * 64 + trow] = sq;
        }
        {
            const int vrow = wave * 16 + fr;
            const bf16x8 vf0 = *(const bf16x8*)(vt + vrow * VS + fq * 8), vf1 = *(const bf16x8*)(vt + vrow * VS + 32 + fq * 8);
#pragma unroll
            for (int kt = 0; kt < KT; ++kt) {
                const float dec = __expf(blast[kt * 16 + fr]);
                sacc[kt][0] *= dec; sacc[kt][1] *= dec; sacc[kt][2] *= dec; sacc[kt][3] *= dec;
                sacc[kt] = __builtin_amdgcn_mfma_f32_16x16x32_bf16(vf0, *(const bf16x8*)(kht + (kt * 16 + fr) * VS + fq * 8), sacc[kt], 0, 0, 0);
                sacc[kt] = __builtin_amdgcn_mfma_f32_16x16x32_bf16(vf1, *(const bf16x8*)(kht + (kt * 16 + fr) * VS + 32 + fq * 8), sacc[kt], 0, 0, 0);
            }
        }
        SCAN_SYNC();
#pragma unroll
        for (int kt = 0; kt < KT; ++kt)
#pragma unroll
            for (int r = 0; r < 4; ++r) st[(wave * 16 + 4 * fq + r) * QS + kt * 16 + fr] = f2bf(sacc[kt][r]);
        {
            const int ti = wave & 3, vh = wave >> 2, trow = ti * 16 + fr;
            const float rstd = rsqrtf((ssq[trow] + ssq[64 + trow]) * (1.f / 128.f) + 1e-6f);
            bf16_t* yrow = (bf16_t*)(p.ws + WS_Y) + (size_t)(b * 2048 + c * 64 + trow) * 1536 + (GLA ? 1024 : 0) + h * 128 + vh * 64 + 4 * fq;
#pragma unroll
            for (int vi = 0; vi < 4; ++vi) {
                const f32x4 g4_ = gn4[vi]; const float4 g4 = make_float4(g4_[0], g4_[1], g4_[2], g4_[3]);
                const float z0 = bflo(gz[vi].x), z1 = bfhi(gz[vi].x), z2 = bflo(gz[vi].y), z3 = bfhi(gz[vi].y);
                uint2 o;
                o.x = pack2(oacc[vi][0] * rstd * g4.x * (z0 * sigm(z0)), oacc[vi][1] * rstd * g4.y * (z1 * sigm(z1)));
                o.y = pack2(oacc[vi][2] * rstd * g4.z * (z2 * sigm(z2)), oacc[vi][3] * rstd * g4.w * (z3 * sigm(z3)));
                *(uint2*)(yrow + vi * 16) = o;
            }
        }
    }
    SCAN_SYNC();
}

__device__ void dsaprep2_item(const Params& p, int l, int item, char* smem_) {
    bf16_t* tile = (bf16_t*)smem_;
    const int tid = TIDX(), lane = tid & 63, wave = tid >> 6;
    bf16_t* Z = (bf16_t*)(p.ws + WS_Z); bf16_t* VT = (bf16_t*)(p.ws + WS_VT);
    {
        const int tb = item * 32;
        {
            const float2 gq = *(const float2*)(p.dsa_qn + l * 128 + lane * 2), gk = *(const float2*)(p.dsa_kn + l * 128 + lane * 2);
            unsigned uu[4][8];
#pragma unroll
            for (int j = 0; j < 4; ++j)
#pragma unroll
                for (int grp = 0; grp < 8; ++grp)
                    uu[j][grp] = *(const unsigned*)(Z + (size_t)(tb + wave + 8 * j) * LDZ + (grp < 4 ? ZB_Q : ZB_K) + (grp & 3) * 128 + lane * 2);
#pragma unroll
            for (int j = 0; j < 4; ++j)
#pragma unroll
                for (int grp = 0; grp < 8; ++grp) {
                    bf16_t* ptr = Z + (size_t)(tb + wave + 8 * j) * LDZ + (grp < 4 ? ZB_Q : ZB_K) + (grp & 3) * 128 + lane * 2;
                    const float a = bflo(uu[j][grp]), b = bfhi(uu[j][grp]);
                    const float ss = wave_sum(a * a + b * b);
                    const float r = rsqrtf(ss * (1.f / 128.f) + 1e-6f) * ((grp < 4) ? 0.08838834764831845f : 1.f);
                    const float2 g = (grp < 4) ? gq : gk;
                    __hip_atomic_store((unsigned*)ptr, pack2(a * r * g.x, b * r * g.y), __ATOMIC_RELAXED, __HIP_MEMORY_SCOPE_AGENT);
                }
        }
        u32x4 uv[4];
#pragma unroll
        for (int i = 0; i < 4; ++i) { const int ch = tid + i * 512; uv[i] = *(const u32x4*)(Z + (size_t)(tb + (ch >> 6)) * LDZ + ZB_V + (ch & 63) * 8); }
#pragma unroll
        for (int i = 0; i < 4; ++i) {
            const int ch = tid + i * 512, t = ch >> 6, c8 = (ch & 63) * 8;
            unsigned* d = (unsigned*)(tile + t * 514 + c8);
            d[0] = uv[i][0]; d[1] = uv[i][1]; d[2] = uv[i][2]; d[3] = uv[i][3];
        }
        __syncthreads();
        {
            const int c = tid, b = tb >> 11, s0 = tb & 2047;
            unsigned w[16];
#pragma unroll
            for (int j = 0; j < 16; ++j) w[j] = (unsigned)tile[(2 * j) * 514 + c] | ((unsigned)tile[(2 * j + 1) * 514 + c] << 16);
            unsigned long long* dst = (unsigned long long*)(VT + ((size_t)(b * 512 + c)) * 2048 + s0);
#pragma unroll
            for (int j = 0; j < 8; ++j) __hip_atomic_store(dst + j, ((unsigned long long)w[2 * j + 1] << 32) | w[2 * j], __ATOMIC_RELAXED, __HIP_MEMORY_SCOPE_AGENT);
        }
        __syncthreads();
    }
}

__device__ void dsa_select_tile(const Params& p, int b, int tq, char* smem_) {
    constexpr int KS_ = 2052;
    unsigned* keyL = (unsigned*)smem_;
    const int tid = TIDX(), lane = tid & 63, wave = __builtin_amdgcn_readfirstlane(tid >> 6), fr = lane & 15, fq = lane >> 4;
    const bf16_t* Z = (const bf16_t*)(p.ws + WS_Z);
    unsigned long long* BM64 = (unsigned long long*)(p.ws + WS_BM);
    const int t0 = tq * 16;
    {
        const int tl = t0 + fr;
        const size_t trow = (size_t)b * 2048 + tl;
        bf16x8 qf[4][2];
#pragma unroll
        for (int h = 0; h < 4; ++h)
#pragma unroll
            for (int ks = 0; ks < 2; ++ks) qf[h][ks] = *(const bf16x8*)(Z + trow * LDZ + ZB_QI + h * 64 + ks * 32 + fq * 8);
        float w[4];
#pragma unroll
        for (int h = 0; h < 4; ++h) w[h] = bf2f(Z[trow * LDZ + ZB_WI + h]) * 0.5f;
#pragma unroll 4
        for (int kt = wave; kt <= tq; kt += 8) {
            const bf16_t* kr = Z + ((size_t)b * 2048 + kt * 16 + fr) * LDZ + ZB_KI + fq * 8;
            const bf16x8 k0 = *(const bf16x8*)kr, k1 = *(const bf16x8*)(kr + 32);
            f32x4 acc[4];
#pragma unroll
            for (int h = 0; h < 4; ++h) {
                acc[h] = __builtin_amdgcn_mfma_f32_16x16x32_bf16(k0, qf[h][0], f32x4{0.f, 0.f, 0.f, 0.f}, 0, 0, 0);
                acc[h] = __builtin_amdgcn_mfma_f32_16x16x32_bf16(k1, qf[h][1], acc[h], 0, 0, 0);
            }
            u32x4 kk;
#pragma unroll
            for (int r = 0; r < 4; ++r) {
                float sc = w[0] * fmaxf(acc[0][r] * 0.125f, 0.f) + w[1] * fmaxf(acc[1][r] * 0.125f, 0.f) + w[2] * fmaxf(acc[2][r] * 0.125f, 0.f) + w[3] * fmaxf(acc[3][r] * 0.125f, 0.f);
                if (sc == 0.f) sc = 0.f;
                const unsigned u = __float_as_uint(sc);
                const unsigned k = (u & 0x80000000u) ? ~u : (u | 0x80000000u);
                kk[r] = (kt * 16 + 4 * fq + r <= tl) ? k : 0u;
            }
            *(u32x4*)(keyL + fr * KS_ + kt * 16 + 4 * fq) = kk;
        }
    }
    __syncthreads();
    {
        const int nk = (tq + 1) * 16, jmax = (nk + 63) >> 6;
        const int qa = 2 * wave, qb = qa + 1;
        unsigned ka[32], kb[32];
#pragma unroll
        for (int j = 0; j < 32; ++j) {
            const int s = lane + 64 * j;
            ka[j] = (s < nk) ? keyL[qa * KS_ + s] : 0u;
            kb[j] = (s < nk) ? keyL[qb * KS_ + s] : 0u;
        }
        unsigned Ta = 1u, Tb = 1u; int Ca = 2047, Cb = 2047;
        if (t0 >= 256) {
            int na, nb;
            bool da, db;
            {
                int c0 = 0, c1 = 0, c2 = 0, c3 = 0;
#pragma unroll
                for (int j = 0; j < 32; ++j)
                    if (j < jmax) { c0 += (ka[j] >= 0x80000000u); c1 += (ka[j] > 0x80000000u); c2 += (kb[j] >= 0x80000000u); c3 += (kb[j] > 0x80000000u); }
                c0 = wave_total_i(c0); c1 = wave_total_i(c1); c2 = wave_total_i(c2); c3 = wave_total_i(c3);
                da = (c1 < 256 && c0 >= 256); db = (c3 < 256 && c2 >= 256);
                Ta = da ? 0x80000000u : ((c0 >= 256) ? 0x80000000u : 0u); na = da ? c0 : ((c0 >= 256) ? c0 : 0x7fffffff);
                Tb = db ? 0x80000000u : ((c2 >= 256) ? 0x80000000u : 0u); nb = db ? c2 : ((c2 >= 256) ? c2 : 0x7fffffff);
            }
            for (int bit = 30; bit >= 0; --bit) {
                if (da && db) break;
                const unsigned ca_ = Ta | (1u << bit), cb_ = Tb | (1u << bit);
                int c0 = 0, c1 = 0;
#pragma unroll
                for (int j = 0; j < 32; ++j)
                    if (j < jmax) { c0 += (ka[j] >= ca_); c1 += (kb[j] >= cb_); }
                c0 = wave_total_i(c0); c1 = wave_total_i(c1);
                if (!da && c0 >= 256) { Ta = ca_; na = c0; }
                if (!db && c1 >= 256) { Tb = cb_; nb = c1; }
                da = da || (na == 256); db = db || (nb == 256);
            }
            if (na != 256 || nb != 256) {
                int needa, needb;
                {
                    int c0 = 0, c1 = 0;
#pragma unroll
                    for (int j = 0; j < 32; ++j)
                        if (j < jmax) { c0 += (ka[j] > Ta); c1 += (kb[j] > Tb); }
                    needa = 256 - wave_total_i(c0); needb = 256 - wave_total_i(c1);
                }
                Ca = 0; Cb = 0;
                for (int bit = 10; bit >= 0; --bit) {
                    const int ca_ = Ca | (1 << bit), cb_ = Cb | (1 << bit);
                    int c0 = 0, c1 = 0;
#pragma unroll
                    for (int j = 0; j < 32; ++j)
                        if (j < jmax) { const int s = lane + 64 * j; c0 += (ka[j] == Ta && s < ca_); c1 += (kb[j] == Tb && s < cb_); }
                    c0 = wave_total_i(c0); c1 = wave_total_i(c1);
                    if (c0 < needa) Ca = ca_;
                    if (c1 < needb) Cb = cb_;
                }
            }
        }
        const size_t rowa = (size_t)b * 2048 + t0 + qa;
#pragma unroll
        for (int j = 0; j < 32; ++j) {
            const int s = lane + 64 * j;
            const unsigned long long ma = __ballot((ka[j] > Ta) || (ka[j] == Ta && s <= Ca));
            const unsigned long long mb = __ballot((kb[j] > Tb) || (kb[j] == Tb && s <= Cb));
            if (lane == 0) {
                __hip_atomic_store(&BM64[rowa * 32 + j], ma, __ATOMIC_RELAXED, __HIP_MEMORY_SCOPE_AGENT);
                __hip_atomic_store(&BM64[(rowa + 1) * 32 + j], mb, __ATOMIC_RELAXED, __HIP_MEMORY_SCOPE_AGENT);
            }
        }
    }
    __syncthreads();
}

__device__ void dsa_attn_item(const Params& p, int b, int h, int qg, char* smem_) {
    constexpr int KSTR = 136, VSTR = 40;
    bf16_t* Kl = (bf16_t*)smem_;
    bf16_t* Vl = Kl + 2 * 32 * KSTR;
    const int tid = TIDX(), lane = tid & 63, wave = __builtin_amdgcn_readfirstlane(tid >> 6), fr = lane & 15, fq = lane >> 4;
    const bf16_t* Z = (const bf16_t*)(p.ws + WS_Z); const bf16_t* VT = (const bf16_t*)(p.ws + WS_VT);
    const unsigned* BM = (const unsigned*)(p.ws + WS_BM); bf16_t* Y = (bf16_t*)(p.ws + WS_Y);
    const int kr = tid >> 4, kc = tid & 15, vd = tid >> 2, vc = tid & 3;
    const int ka_row = 8 * (fr >> 2) + (fr & 3);
    {
        const int t0 = qg * 128 + wave * 16;
        const size_t trow = (size_t)b * 2048 + t0 + fr;
        bf16x8 qf[4];
#pragma unroll
        for (int ks = 0; ks < 4; ++ks) qf[ks] = *(const bf16x8*)(Z + trow * LDZ + ZB_Q + h * 128 + ks * 32 + fq * 8);
        f32x4 o[8];
#pragma unroll
        for (int i = 0; i < 8; ++i) o[i] = f32x4{0.f, 0.f, 0.f, 0.f};
        float m = -INFINITY, lsum = 0.f;
        const unsigned* bmrow = BM + trow * 64;
        const int nsteps_blk = qg * 4 + 4, nsteps_w = (t0 + 15) / 32 + 1;
        const bf16_t* kg = Z + ((size_t)b * 2048 + kr) * LDZ + ZB_K + h * 128 + kc * 8;
        const bf16_t* vg = VT + ((size_t)(b * 4 + h) * 128 + vd) * 2048 + vc * 8;
        u32x4 rk = *(const u32x4*)kg, rv = *(const u32x4*)vg;
        *(u32x4*)(Kl + kr * KSTR + kc * 8) = rk; *(u32x4*)(Vl + vd * VSTR + vc * 8) = rv;
        __syncthreads();
        unsigned mwn = bmrow[0];
        for (int st = 0; st < nsteps_blk; ++st) {
            const bool more = (st + 1 < nsteps_blk);
            const unsigned mwc = mwn;
            mwn = bmrow[(st + 1 < nsteps_w) ? st + 1 : st];
            if (more) { rk = *(const u32x4*)(kg + (size_t)(st + 1) * 32 * LDZ); rv = *(const u32x4*)(vg + (st + 1) * 32); }
            if (st < nsteps_w) {
                const bf16_t* Kb = Kl + (st & 1) * 32 * KSTR; const bf16_t* Vb = Vl + (st & 1) * 128 * VSTR;
                f32x4 sa = f32x4{0.f, 0.f, 0.f, 0.f}, sb = f32x4{0.f, 0.f, 0.f, 0.f};
#pragma unroll
                for (int ks = 0; ks < 4; ++ks) {
                    const bf16x8 fa = *(const bf16x8*)(Kb + ka_row * KSTR + ks * 32 + fq * 8), fb = *(const bf16x8*)(Kb + (ka_row + 4) * KSTR + ks * 32 + fq * 8);
                    sa = __builtin_amdgcn_mfma_f32_16x16x32_bf16(fa, qf[ks], sa, 0, 0, 0);
                    sb = __builtin_amdgcn_mfma_f32_16x16x32_bf16(fb, qf[ks], sb, 0, 0, 0);
                }
                const unsigned mw = mwc >> (8 * fq);
                float x[8];
#pragma unroll
                for (int r = 0; r < 4; ++r) { x[r] = ((mw >> r) & 1u) ? sa[r] : -INFINITY; x[4 + r] = ((mw >> (4 + r)) & 1u) ? sb[r] : -INFINITY; }
                float mx = fmaxf(fmaxf(fmaxf(x[0], x[1]), fmaxf(x[2], x[3])), fmaxf(fmaxf(x[4], x[5]), fmaxf(x[6], x[7])));
                mx = fmaxf(mx, shx<16>(mx)); mx = fmaxf(mx, shx<32>(mx));
                const float mnew = fmaxf(m, mx);
                const float msafe = (mnew == -INFINITY) ? 0.f : mnew;
                const float alpha = __expf(m - msafe);
                float pe[8]; float ps = 0.f;
#pragma unroll
                for (int j = 0; j < 8; ++j) { pe[j] = __expf(x[j] - msafe); ps += pe[j]; }
                lsum = lsum * alpha + ps;
                m = mnew;
#pragma unroll
                for (int i = 0; i < 8; ++i) { o[i][0] *= alpha; o[i][1] *= alpha; o[i][2] *= alpha; o[i][3] *= alpha; }
                union { bf16x8 v; unsigned u[4]; } pf;
                pf.u[0] = pack2(pe[0], pe[1]); pf.u[1] = pack2(pe[2], pe[3]); pf.u[2] = pack2(pe[4], pe[5]); pf.u[3] = pack2(pe[6], pe[7]);
#pragma unroll
                for (int i = 0; i < 8; ++i) {
                    const bf16x8 vf = *(const bf16x8*)(Vb + (i * 16 + fr) * VSTR + fq * 8);
                    o[i] = __builtin_amdgcn_mfma_f32_16x16x32_bf16(vf, pf.v, o[i], 0, 0, 0);
                }
            }
            if (more) { *(u32x4*)(Kl + ((st + 1) & 1) * 32 * KSTR + kr * KSTR + kc * 8) = rk; *(u32x4*)(Vl + ((st + 1) & 1) * 128 * VSTR + vd * VSTR + vc * 8) = rv; }
            __syncthreads();
        }
        lsum += shx<16>(lsum); lsum += shx<32>(lsum);
        const float inv = 1.f / lsum;
#pragma unroll
        for (int i = 0; i < 8; ++i) {
            uint2 ov; ov.x = pack2(o[i][0] * inv, o[i][1] * inv); ov.y = pack2(o[i][2] * inv, o[i][3] * inv);
            *(uint2*)(Y + trow * 1536 + 512 + h * 128 + i * 16 + 4 * fq) = ov;
        }
    }
}

constexpr int LDS_BYTES = 155648;
__device__ void ph_mixA(const Params& p, int l, int vb0, int nvb, char* smem_) {
    for (int item = vb0; item < 64; item += nvb) {
        if (item < 32) scan2_item<128, false>(p, l, item >> 2, item & 3, smem_);
        else scan2_item<64, true>(p, l, (item - 32) >> 2, (item - 32) & 3, smem_);
    }
    unsigned* ctr = (unsigned*)(p.ws + WS_CTL) + 3584 + l * 64;
    unsigned* done = (unsigned*)(p.ws + WS_CTL) + 5300 + l * 8 * 16;
    volatile int* slot = (volatile int*)(smem_ + LDS_BYTES - 64);
    for (;;) {
        if (TIDX() == 0) *slot = (int)atomicAdd(ctr, 1u);
        __syncthreads();
        const int idx = __builtin_amdgcn_readfirstlane(*slot);
        __syncthreads();
        if (idx >= 2048) break;
        if (idx < 1536) {
            const int b = idx / 192, r = idx % 192;
            if (r < 128) dsa_select_tile(p, b, 127 - r, smem_);
            else dsaprep2_item(p, l, b * 64 + (r - 128), smem_);
            asm volatile("s_waitcnt vmcnt(0)" ::: "memory");
            __syncthreads();
            if (TIDX() == 0) __hip_atomic_fetch_add(done + b * 16, 1u, __ATOMIC_RELAXED, __HIP_MEMORY_SCOPE_AGENT);
        } else {
            const int a = idx - 1536, b = a >> 6, h = (a >> 4) & 3, qg = 15 - (a & 15);
            if (TIDX() == 0) {
                unsigned spins = 0;
                while (__hip_atomic_load(done + b * 16, __ATOMIC_RELAXED, __HIP_MEMORY_SCOPE_AGENT) < 192u) { __builtin_amdgcn_s_sleep(2); if (++spins > (1u << 18)) break; }
                __builtin_amdgcn_fence(__ATOMIC_ACQUIRE, "agent");
                asm volatile("s_waitcnt vmcnt(0)" ::: "memory");
            }
            __syncthreads();
            dsa_attn_item(p, b, h, qg, smem_);
        }
    }
}

__device__ __forceinline__ int f2sort(float f) { int i = __float_as_int(f); return i ^ ((i >> 31) & 0x7fffffff); }
__device__ __forceinline__ float sort2f(int i) { return __int_as_float(i ^ ((i >> 31) & 0x7fffffff)); }
#define INSK(K, xv) do { int _x = (xv); \
    _Pragma("unroll") for (int _j = 0; _j < 16; ++_j) { int _hi = max(K[_j], _x); _x = min(K[_j], _x); K[_j] = _hi; } } while (0)
#define INS64(K, xv) do { unsigned long long _x = (xv); \
    _Pragma("unroll") for (int _j = 0; _j < 16; ++_j) { bool _c = _x > K[_j]; unsigned long long _o = K[_j]; K[_j] = _c ? _x : _o; _x = _c ? _o : _x; } } while (0)

__device__ void ph_route(const Params& p, int vb0, int nvb, char* smem_) {
    typedef _Float16 h8 __attribute__((ext_vector_type(8)));
    const _Float16* SC = (const _Float16*)(p.ws + WS_SC);
    int* RI = (int*)(p.ws + WS_RI); float* RG = (float*)(p.ws + WS_RG);
    const int tid = TIDX(), lane = tid & 63, wave = tid >> 6;
    _Float16* tile = (_Float16*)smem_ + wave * (64 * 72);
    for (int item0 = (vb0 * 8 + wave) * 64; item0 < T_TOK * 8; item0 += nvb * 8 * 64) {
        const int item = item0 + lane;
        const int t = item >> 3, h = item & 7;
        const _Float16* s0 = SC + (size_t)t * 2048 + h * 256;
        const _Float16* wbase = SC + (size_t)item0 * 256;
        int k0[16], k1[16];
#pragma unroll
        for (int j = 0; j < 16; ++j) { k0[j] = (int)0x80000000; k1[j] = (int)0x80000000; }
#pragma unroll 1
        for (int slab = 0; slab < 4; ++slab) {
            h8 ld[8];
#pragma unroll
            for (int j = 0; j < 4; ++j) {
                const _Float16* src = wbase + (size_t)(16 * j + (lane >> 2)) * 256 + slab * 32 + (lane & 3) * 8;
                ld[j] = *(const h8*)src; ld[4 + j] = *(const h8*)(src + 128);
            }
            __builtin_amdgcn_wave_barrier();
#pragma unroll
            for (int j = 0; j < 4; ++j) {
                _Float16* dst = tile + (16 * j + (lane >> 2)) * 72 + (lane & 3) * 8;
                *(h8*)dst = ld[j]; *(h8*)(dst + 32) = ld[4 + j];
            }
            __builtin_amdgcn_fence(__ATOMIC_RELEASE, "wavefront");
            __builtin_amdgcn_wave_barrier();
            __builtin_amdgcn_fence(__ATOMIC_ACQUIRE, "wavefront");
#pragma unroll 2
            for (int ii = 0; ii < 32; ii += 8) {
                const int i = slab * 32 + ii;
                const h8 a = *(const h8*)(tile + lane * 72 + ii), b = *(const h8*)(tile + lane * 72 + 32 + ii);
#pragma unroll
                for (int e_ = 0; e_ < 8; ++e_) {
                    INSK(k0, (f2sort((float)a[e_]) & ~127) | (127 - i - e_));
                    INSK(k1, (f2sort((float)b[e_]) & ~127) | (127 - i - e_));
                }
            }
            __builtin_amdgcn_wave_barrier();
        }
        float v0[16], v1[16];
#pragma unroll
        for (int j = 0; j < 16; ++j) { k0[j] = 127 - (k0[j] & 127); k1[j] = 127 - (k1[j] & 127); v0[j] = (float)s0[k0[j]]; v1[j] = (float)s0[128 + k1[j]]; }
        unsigned long long ck[16];
#pragma unroll
        for (int j = 0; j < 16; ++j) ck[j] = 0ull;
#pragma unroll
        for (int a = 0; a < 16; ++a)
#pragma unroll
            for (int b = 0; b < 16; ++b)
                if ((a + 1) * (b + 1) <= 16) {
                    unsigned hi = (unsigned)f2sort(v0[a] + v1[b]) ^ 0x80000000u;
                    unsigned lo = ((unsigned)(255 - (a * 16 + b)) << 16) | (unsigned)(k0[a] * 128 + k1[b]);
                    INS64(ck, ((unsigned long long)hi << 32) | lo);
                }
        float e[16]; float sm = 0.f;
        const float mx = sort2f((int)((unsigned)(ck[0] >> 32) ^ 0x80000000u));
#pragma unroll
        for (int j = 0; j < 16; ++j) { e[j] = expf(sort2f((int)((unsigned)(ck[j] >> 32) ^ 0x80000000u)) - mx); sm += e[j]; }
        const float inv = 1.f / sm;
#pragma unroll
        for (int j = 0; j < 16; j += 4) {
            *(int4*)(RI + (size_t)t * 128 + h * 16 + j) = make_int4((int)(ck[j] & 0xffffu), (int)(ck[j + 1] & 0xffffu), (int)(ck[j + 2] & 0xffffu), (int)(ck[j + 3] & 0xffffu));
            *(float4*)(RG + (size_t)t * 128 + h * 16 + j) = make_float4(e[j] * inv, e[j + 1] * inv, e[j + 2] * inv, e[j + 3] * inv);
        }
    }
}

__device__ __forceinline__ void fp8x16_to_f32(const uint4 q, float (&f)[16]) {
    const unsigned w[4] = {q.x, q.y, q.z, q.w};
#pragma unroll
    for (int c = 0; c < 4; ++c) {
        auto f0 = __builtin_amdgcn_cvt_pk_f32_fp8((int)w[c], false); auto f1 = __builtin_amdgcn_cvt_pk_f32_fp8((int)w[c], true);
        f[4 * c] = f0[0]; f[4 * c + 1] = f0[1]; f[4 * c + 2] = f1[0]; f[4 * c + 3] = f1[1];
    }
}
template <int WHICH>
__device__ void ph_peer_sliced(const Params& p, int l, char* smem_) {
    const int tid = TIDX(), wave = tid >> 6;
    const bf16_t* H = (const bf16_t*)(p.ws + WS_H); const unsigned char* PU = p.ws + WS_PU; const unsigned char* PV = p.ws + WS_PV;
    const int* RI = (const int*)(p.ws + WS_RI); float* RG = (float*)(p.ws + WS_RG); float* PP = (float*)(p.ws + WS_PP);
    const float* modb = (const float*)(p.ws + WS_MOD);
    {
    unsigned* ctr = (unsigned*)(p.ws + WS_CTL) + 3712 + (l * 2 + WHICH) * 128;
    volatile int* slot = (volatile int*)(smem_ + LDS_BYTES - 64);
    const int xcc = (int)(xb_xcc_id() & 7u);
    for (int so = 0; so < 8; ++so) {
        const int x = (xcc + so) & 7;
        for (;;) {
            if (tid == 0) *slot = (int)atomicAdd(ctr + x * 16, 1u);
            __syncthreads();
            const int chunk = __builtin_amdgcn_readfirstlane(*slot);
            __syncthreads();
            if (chunk >= 256) break;
            {
                const int lane = lane_id_opaque(), eg = lane >> 3, ll = lane & 7;
                const int tb = chunk * 64 + wave * 8;
                int* lri = (int*)smem_ + wave * 2048; float* lrg = (float*)(lri + 1024);
                {
                    int ra[16]; float rg_[16];
#pragma unroll
                    for (int i = 0; i < 8; ++i) {
                        ra[2 * i] = RI[(size_t)(tb + i) * 128 + lane]; ra[2 * i + 1] = RI[(size_t)(tb + i) * 128 + 64 + lane];
                        if (WHICH == 1) { rg_[2 * i] = RG[(size_t)(tb + i) * 128 + lane]; rg_[2 * i + 1] = RG[(size_t)(tb + i) * 128 + 64 + lane]; }
                    }
#pragma unroll
                    for (int i = 0; i < 8; ++i) {
                        lri[i * 128 + lane] = ra[2 * i]; lri[i * 128 + 64 + lane] = ra[2 * i + 1];
                        if (WHICH == 1) { lrg[i * 128 + lane] = rg_[2 * i]; lrg[i * 128 + 64 + lane] = rg_[2 * i + 1]; }
                    }
                }
                __builtin_amdgcn_fence(__ATOMIC_RELEASE, "wavefront");
                __builtin_amdgcn_wave_barrier();
                __builtin_amdgcn_fence(__ATOMIC_ACQUIRE, "wavefront");
                uint4 hq0 = make_uint4(0u, 0u, 0u, 0u), hq1 = hq0;
                if (WHICH == 0) { const uint4* hp = (const uint4*)(H + (size_t)tb * 1024 + x * 128 + ll * 16); hq0 = hp[0]; hq1 = hp[1]; }
#pragma unroll 1
                for (int i = 0; i < 8; ++i) {
                    const int t = tb + i;
                    if (WHICH == 0) {
                        float hv[16];
                        hv[0] = bflo(hq0.x); hv[1] = bfhi(hq0.x); hv[2] = bflo(hq0.y); hv[3] = bfhi(hq0.y); hv[4] = bflo(hq0.z); hv[5] = bfhi(hq0.z); hv[6] = bflo(hq0.w); hv[7] = bfhi(hq0.w);
                        hv[8] = bflo(hq1.x); hv[9] = bfhi(hq1.x); hv[10] = bflo(hq1.y); hv[11] = bfhi(hq1.y); hv[12] = bflo(hq1.z); hv[13] = bfhi(hq1.z); hv[14] = bflo(hq1.w); hv[15] = bfhi(hq1.w);
                        if (i < 7) { const uint4* hp = (const uint4*)(H + (size_t)(t + 1) * 1024 + x * 128 + ll * 16); hq0 = hp[0]; hq1 = hp[1]; }
                        uint4 uq[16];
#pragma unroll
                        for (int it = 0; it < 16; ++it) {
                            const int e = lri[i * 128 + it * 8 + eg];
                            uq[it] = *(const uint4*)(PU + ((size_t)x * 16384 + e) * 128 + ll * 16);
                        }
#pragma unroll
                        for (int b2 = 0; b2 < 2; ++b2) {
                            float part[8];
#pragma unroll
                            for (int it = 0; it < 8; ++it) {
                                typedef float f32x2 __attribute__((ext_vector_type(2)));
                                const unsigned uw_[4] = {uq[b2 * 8 + it].x, uq[b2 * 8 + it].y, uq[b2 * 8 + it].z, uq[b2 * 8 + it].w};
                                f32x2 d2 = {0.f, 0.f};
#pragma unroll
                                for (int c_ = 0; c_ < 4; ++c_) {
                                    const f32x2 f0 = __builtin_amdgcn_cvt_pk_f32_fp8((int)uw_[c_], false), f1 = __builtin_amdgcn_cvt_pk_f32_fp8((int)uw_[c_], true);
                                    d2 = __builtin_elementwise_fma(f32x2{hv[4 * c_], hv[4 * c_ + 1]}, f0, d2);
                                    d2 = __builtin_elementwise_fma(f32x2{hv[4 * c_ + 2], hv[4 * c_ + 3]}, f1, d2);
                                }
                                part[it] = d2[0] + d2[1];
                            }
                            float r4[4], r2[2];
                            const bool b2_ = lane & 4, b1_ = lane & 2, b0_ = lane & 1;
#pragma unroll
                            for (int j = 0; j < 4; ++j) { const float snd = b2_ ? part[j] : part[j + 4], kp = b2_ ? part[j + 4] : part[j]; r4[j] = kp + shx<4>(snd); }
#pragma unroll
                            for (int j = 0; j < 2; ++j) { const float snd = b1_ ? r4[j] : r4[j + 2], kp = b1_ ? r4[j + 2] : r4[j]; r2[j] = kp + shx<2>(snd); }
                            const float snd = b0_ ? r2[0] : r2[1], kp = b0_ ? r2[1] : r2[0];
                            const float d = kp + shx<1>(snd);
                            PP[((size_t)x * T_TOK + t) * 128 + b2 * 64 + ll * 8 + eg] = d;
                        }
                    } else {
                        const int col = x * 128 + ll * 16 + ((lane >> 5) & 1) * 8 + ((lane >> 4) & 1) * 4 + ((lane >> 3) & 1) * 2;
                        float2* op = (float2*)(p.out + (size_t)t * 1024 + col);
                        const float2 gf = *(const float2*)(modb + (size_t)(l * 8 + (t >> 11)) * 6144 + 5120 + col), xi = *op;
                        float y[16];
#pragma unroll
                        for (int j = 0; j < 16; ++j) y[j] = 0.f;
#pragma unroll
                        for (int b2 = 0; b2 < 2; ++b2) {
                            uint4 vq[8];
#pragma unroll
                            for (int it = 0; it < 8; ++it) {
                                const int e = lri[i * 128 + b2 * 64 + it * 8 + eg];
                                vq[it] = *(const uint4*)(PV + ((size_t)x * 16384 + e) * 128 + ll * 16);
                            }
#pragma unroll
                            for (int it = 0; it < 8; ++it) {
                                const float ck = lrg[i * 128 + b2 * 64 + it * 8 + eg];
                                float f[16]; fp8x16_to_f32(vq[it], f);
#pragma unroll
                                for (int j = 0; j < 16; ++j) y[j] += ck * f[j];
                            }
                        }
                        float r8[8], r4[4], r2[2];
                        const bool b5 = lane & 32, b4 = lane & 16, b3 = lane & 8;
#pragma unroll
                        for (int j = 0; j < 8; ++j) { const float snd = b5 ? y[j] : y[j + 8], kp = b5 ? y[j + 8] : y[j]; r8[j] = kp + shx<32>(snd); }
#pragma unroll
                        for (int j = 0; j < 4; ++j) { const float snd = b4 ? r8[j] : r8[j + 4], kp = b4 ? r8[j + 4] : r8[j]; r4[j] = kp + shx<16>(snd); }
#pragma unroll
                        for (int j = 0; j < 2; ++j) { const float snd = b3 ? r4[j] : r4[j + 2], kp = b3 ? r4[j + 2] : r4[j]; r2[j] = kp + shx<8>(snd); }
                        *op = make_float2(xi.x + gf.x * r2[0], xi.y + gf.y * r2[1]);
                    }
                }
            }
        }
    }
    __syncthreads();
    }
}
__device__ void ph_peer_coef(const Params& p, int vb0, int nvb) {
    const int wave = TIDX() >> 6, lane = TIDX() & 63;
    float* RG = (float*)(p.ws + WS_RG); const float* PP = (const float*)(p.ws + WS_PP);
    for (int t0 = (vb0 * 8 + wave) * 2; t0 < T_TOK; t0 += nvb * 8 * 2) {
        float pp[2][2][8], g[2][2];
#pragma unroll
        for (int u = 0; u < 2; ++u)
#pragma unroll
            for (int half = 0; half < 2; ++half) {
                const int k = half * 64 + lane;
#pragma unroll
                for (int x = 0; x < 8; ++x) pp[u][half][x] = PP[((size_t)x * T_TOK + t0 + u) * 128 + k];
                g[u][half] = RG[(size_t)(t0 + u) * 128 + k];
            }
        asm volatile("" ::: "memory");
#pragma unroll
        for (int u = 0; u < 2; ++u)
#pragma unroll
            for (int half = 0; half < 2; ++half) {
                float d = 0.f;
#pragma unroll
                for (int x = 0; x < 8; ++x) d += pp[u][half][x];
                d *= (1.f / PU_SCALE);
                RG[(size_t)(t0 + u) * 128 + half * 64 + lane] = g[u][half] * 0.5f * d * (1.f + erff(d * 0.7071067811865476f)) * (1.f / PV_SCALE);
            }
    }
}

enum { PH_MOD = 0, PH_WPREP, PH_NORM1, PH_GEMM_IN, PH_SCAN, PH_MERGE, PH_OUT, PH_NORM2, PH_GEMM_Q, PH_GEMM_SC, PH_ROUTE, PH_G1, PH_G15, PH_G2 };

template <int PH>
__device__ __forceinline__ void run_phase(const Params& p, int l, int vb0, int nvb, char* smem) {
    const float* xin = (l == 0) ? p.x : p.out;
    if (PH == PH_MOD) ph_mod(p, vb0, nvb, smem);
    else if (PH == PH_WPREP) ph_wprep(p, l, vb0, nvb, smem);
    else if (PH == PH_NORM1) ph_norm(p, l, 0, xin, vb0, nvb);
    else if (PH == PH_GEMM_IN) {
        pg8::Gemm g{(const bf16_t*)(p.ws + WS_H), (const bf16_t*)(p.ws + WS_WIN), 1024, 1024, 1024};
        pg8::StaticOrder S; S.init(T_TOK, LDZ, nvb, vb0, 1024, 1024);
        pg8::gemm_phase(( PG8_LAS unsigned char*)smem, g, S, pg8::EpiBf16{(bf16_t*)(p.ws + WS_Z), LDZ}, TIDX());
    }
    else if (PH == PH_SCAN) ph_mixA(p, l, vb0, nvb, smem);
    else if (PH == PH_MERGE) {
        pg8::Gemm g{(const bf16_t*)(p.ws + WS_Y), (const bf16_t*)(p.ws + WS_WBR), 1536, 512, 512};
        pg8::MergeOrder S{vb0, nvb};
        pg8::gemm_phase((PG8_LAS unsigned char*)smem, g, S, pg8::EpiMerge{(bf16_t*)(p.ws + WS_H), (const bf16_t*)(p.ws + WS_Z)}, TIDX());
    }
    else if (PH == PH_OUT) {
        pg8::Gemm g{(const bf16_t*)(p.ws + WS_H), (const bf16_t*)(p.ws + WS_WOUT), 1024, 1024, 1024};
        pg8::StaticOrder S; S.init(T_TOK, 1024, nvb, vb0, 1024, 1024);
        pg8::gemm_phase((PG8_LAS unsigned char*)smem, g, S, pg8::EpiResid{xin, p.out, (const float*)(p.ws + WS_MOD) + (size_t)l * 8 * 6144}, TIDX());
    }
    else if (PH == PH_NORM2) ph_norm(p, l, 1, p.out, vb0, nvb);
    else if (PH == PH_GEMM_Q) {
        pg8::Gemm g{(const bf16_t*)(p.ws + WS_H), (const bf16_t*)(p.ws + WS_WQ), 1024, 1024, 1024};
        pg8::StaticOrder S; S.init(T_TOK, 2048, nvb, vb0, 1024, 1024);
        pg8::gemm_phase((PG8_LAS unsigned char*)smem, g, S, pg8::EpiBf16{(bf16_t*)(p.ws + WS_QP), 2048}, TIDX());
    }
    else if (PH == PH_GEMM_SC) gemm_phase((const bf16_t*)(p.ws + WS_QP), 2048, (const bf16_t*)(p.ws + WS_SK), 128, T_TOK, 2048, 128, true,
                                          EpiF16{(_Float16*)(p.ws + WS_SC), 2048}, vb0, nvb, smem, TIDX());
    else if (PH == PH_ROUTE) ph_route(p, vb0, nvb, smem);
    else if (PH == PH_G1) ph_peer_sliced<0>(p, l, smem);
    else if (PH == PH_G15) ph_peer_coef(p, vb0, nvb);
    else if (PH == PH_G2) ph_peer_sliced<1>(p, l, smem);

}

#define XB_TMO      128
#define XB_XCNT(j)  (256  + 64 * (j))
#define XB_XSUB(j)  (1280 + 64 * (j))
#define XB_XGEN(j)  (2304 + 64 * (j))
#define XB_TOP      3328
#define XB_TOPGEN   3392
#define XCD_BAR_WORDS 3456
#define XB_SPIN_CAP (1u << 18)
#define LAS __attribute__((address_space(3)))
__device__ __forceinline__ unsigned xb_ld(unsigned* p)              { return __hip_atomic_load(p, __ATOMIC_RELAXED, __HIP_MEMORY_SCOPE_AGENT); }
__device__ __forceinline__ unsigned xb_add(unsigned* p, unsigned v) { return __hip_atomic_fetch_add(p, v, __ATOMIC_RELAXED, __HIP_MEMORY_SCOPE_AGENT); }
#define XB_SPIN(cond, bar) do { unsigned _sp = 0; while (cond) { __builtin_amdgcn_s_sleep(1); \
    if ((++_sp & 255u) == 0u) { if (xb_ld(&(bar)[XB_TMO])) break; if (_sp > XB_SPIN_CAP) { atomicAdd(&(bar)[XB_TMO], 1u); break; } } } } while (0)
struct XcdBarrier { unsigned* bar; unsigned x; volatile LAS unsigned* st; int wv; };
__device__ __forceinline__ XcdBarrier xcd_barrier_post(unsigned* bar, volatile LAS unsigned* st, int wv) {
    XcdBarrier b; b.bar = bar; b.x = xb_xcc_id(); b.st = st; b.wv = wv;
    if (TIDXW(wv) == 0) (void)xb_add(&bar[XB_XCNT(b.x)], 1u);
    return b;
}
__device__ __forceinline__ void xcd_barrier_complete(unsigned* bar, unsigned x, unsigned& nloc, unsigned& nx) {
    const unsigned G = gridDim.x * gridDim.y * gridDim.z;
    unsigned sum, cnt, mine, sp = 0u;
    for (;;) {
        sum = 0u; cnt = 0u; mine = 0u;
#pragma unroll
        for (unsigned j = 0; j < 16; ++j) { const unsigned c = xb_ld(&bar[XB_XCNT(j)]); sum += c; cnt += (c > 0u) ? 1u : 0u; mine = (j == x) ? c : mine; }
        if (sum == G) break;
        __builtin_amdgcn_s_sleep(1);
        if ((++sp & 255u) == 0u) { if (xb_ld(&bar[XB_TMO])) break; if (sp > XB_SPIN_CAP) { atomicAdd(&bar[XB_TMO], 1u); break; } }
    }
    nloc = mine > 0u ? mine : 1u; nx = cnt > 0u ? cnt : 1u;
}
__device__ __forceinline__ void xcd_barrier(const XcdBarrier& b) {
    asm volatile("s_waitcnt vmcnt(0)" ::: "memory");
    __syncthreads();
    if (TIDXW(b.wv) == 0) {
        unsigned* bar = b.bar;
        __builtin_amdgcn_s_waitcnt(0);
        unsigned nloc = b.st[0], nx = b.st[1];
        if (nloc == 0u) { xcd_barrier_complete(bar, b.x, nloc, nx); b.st[0] = nloc; b.st[1] = nx; }
        const unsigned old = xb_add(&bar[XB_XSUB(b.x)], 1u);
        const unsigned gen = old / nloc;
        if (old + 1u == (gen + 1u) * nloc) {
            __builtin_amdgcn_fence(__ATOMIC_RELEASE, "agent");
            asm volatile("s_waitcnt vmcnt(0)" ::: "memory");
            const unsigned og = xb_add(&bar[XB_TOP], 1u);
            const unsigned tg = og / nx;
            if (og + 1u == (tg + 1u) * nx) xb_add(&bar[XB_TOPGEN], 1u);
            else XB_SPIN(xb_ld(&bar[XB_TOPGEN]) == tg, bar);
            __builtin_amdgcn_fence(__ATOMIC_ACQUIRE, "agent");
            xb_add(&bar[XB_XGEN(b.x)], 1u);
            asm volatile("s_waitcnt vmcnt(0)" ::: "memory");
        } else {
            XB_SPIN(xb_ld(&bar[XB_XGEN(b.x)]) == gen, bar);
            __builtin_amdgcn_fence(__ATOMIC_ACQUIRE, "agent");
            asm volatile("s_waitcnt vmcnt(0)" ::: "memory");
        }
    }
    __syncthreads();
}

__global__ void __launch_bounds__(NT) mega_kernel(Params p_in) {
#if defined(__HIP_DEVICE_COMPILE__)
    extern __shared__ __attribute__((aligned(16))) char smem[];
    volatile LAS unsigned* st = (volatile LAS unsigned*)(smem + LDS_BYTES - 16);
    int wv_ = __builtin_amdgcn_readfirstlane((int)threadIdx.x >> 6); asm volatile("" : "+s"(wv_));
    { const int t_ = TIDXW(wv_); if (t_ < 4) st[t_] = 0u; }
    __syncthreads();
    XcdBarrier bar = xcd_barrier_post((unsigned*)(p_in.ws + WS_CTL), st, wv_);
    const int vb = (int)blockIdx.x, nvb = (int)gridDim.x;
#define GB() xcd_barrier(bar)
#define RUN(PH, L) do { \
        const __attribute__((address_space(4))) Params* _kp = (const __attribute__((address_space(4))) Params*)__builtin_amdgcn_kernarg_segment_ptr(); asm volatile("" : "+s"(_kp)); Params _p = *_kp; _p.wv = wv_; \
        int _l = (L), _vb = vb, _nvb = nvb; asm volatile("" : "+s"(_l), "+s"(_vb), "+s"(_nvb)); \
        run_phase<PH>(_p, _l, _vb, _nvb, smem); } while (0)
    RUN(PH_MOD, 0);
#pragma unroll 1
    for (int l = 0; l < 2; ++l) {
        RUN(PH_WPREP, l); if (l == 0) GB();
        RUN(PH_NORM1, l); GB();
        RUN(PH_GEMM_IN, l); GB();
        RUN(PH_SCAN, l); GB();
        RUN(PH_MERGE, l); GB();
        RUN(PH_OUT, l); GB();
        RUN(PH_NORM2, l); GB();
        RUN(PH_GEMM_Q, l); GB();
        RUN(PH_GEMM_SC, l); GB();
        RUN(PH_ROUTE, l); GB();
        RUN(PH_G1, l); GB();
        RUN(PH_G15, l); GB();
        RUN(PH_G2, l);
        if (l == 0) GB();
    }
#undef RUN
#undef GB
#endif
}

extern "C" void kernel_launch(void* const* d_in, const int* in_sizes, int n_in, void* d_out, int out_size, void* d_ws, size_t ws_size,
                              hipStream_t stream) {
    if (n_in != 20 || ws_size < WS_END) { fprintf(stderr, "kernel_launch: bad inputs (n_in %d ws %zu need %zu)\n", n_in, ws_size, (size_t)WS_END); return; }
    Params p{};
    p.x = (const float*)d_in[0]; p.c = (const float*)d_in[1]; p.w_ada = (const float*)d_in[2]; p.b_ada = (const float*)d_in[3];
    p.norm_mix = (const float*)d_in[4]; p.norm_ffn = (const float*)d_in[5]; p.w_in = (const float*)d_in[6]; p.hgrn_lb = (const float*)d_in[7];
    p.hgrn_on = (const float*)d_in[8]; p.dsa_qn = (const float*)d_in[9]; p.dsa_kn = (const float*)d_in[10]; p.gla_up = (const float*)d_in[11];
    p.gla_bias = (const float*)d_in[12]; p.gla_on = (const float*)d_in[13]; p.w_branch = (const float*)d_in[14]; p.w_out = (const float*)d_in[15];
    p.peer_wq = (const float*)d_in[16]; p.peer_keys = (const float*)d_in[17]; p.peer_u = (const float*)d_in[18]; p.peer_v = (const float*)d_in[19];
    p.out = (float*)d_out; p.ws = (unsigned char*)d_ws;
    static int grid = 0;
    if (grid == 0) {
        int dev = 0, cus = 0, per_cu = 0;
        hipGetDevice(&dev);
        hipDeviceGetAttribute(&cus, hipDeviceAttributeMultiprocessorCount, dev);
        hipFuncSetAttribute((const void*)mega_kernel, hipFuncAttributeMaxDynamicSharedMemorySize, LDS_BYTES);
        hipOccupancyMaxActiveBlocksPerMultiprocessor(&per_cu, (const void*)mega_kernel, NT, LDS_BYTES);
        if (per_cu < 1) { fprintf(stderr, "kernel_launch: occupancy query says %d blocks per CU\n", per_cu); per_cu = 1; }
        (void)hipGetLastError();
        grid = cus;
    }
    hipMemsetAsync((char*)d_ws + WS_CTL, 0, 32768, stream);
    void* args[] = {&p};
    hipError_t e = hipLaunchCooperativeKernel((const void*)mega_kernel, dim3(grid), dim3(NT), args, LDS_BYTES, stream);
    if (e != hipSuccess) fprintf(stderr, "cooperative launch failed: %s (grid %d)\n", hipGetErrorString(e), grid);
}
```

```cpp
#include <hip/hip_runtime.h>
#include <stdint.h>
#include <stdio.h>

typedef unsigned short bf16_t;
typedef short bf16x8 __attribute__((ext_vector_type(8)));
typedef float f32x4 __attribute__((ext_vector_type(4)));
typedef unsigned u32x4 __attribute__((ext_vector_type(4)));

#define NT 512
constexpr int T_TOK = 16384, DM = 1024, SEQ = 2048;
constexpr int LDZ = 8704;
constexpr int ZA_Q = 0, ZA_F = 512, ZA_I = 1024, ZA_G = 1536, ZB_Q = 2048, ZB_K = 2560, ZB_V = 3072, ZC_V = 3584, ZC_G = 4096,
              ZB_QI = 4608, ZC_Q = 4864, ZC_K = 5120, ZB_KI = 5376, ZB_WI = 5440, ZC_CODE = 5444, ZM = 5632;
constexpr int IN_COLS = 8532;

constexpr size_t al256(size_t x) { return (x + 255) & ~(size_t)255; }
constexpr size_t WS_CTL = 0;
constexpr size_t WS_MOD = 65536;
constexpr size_t WS_WIN = al256(WS_MOD + (size_t)2 * 8 * 6144 * 4);
constexpr size_t WS_WBR = al256(WS_WIN + (size_t)LDZ * 1024 * 2);
constexpr size_t WS_WOUT = al256(WS_WBR + (size_t)3 * 1024 * 512 * 2);
constexpr size_t WS_WQ = al256(WS_WOUT + (size_t)1024 * 1024 * 2);
constexpr size_t WS_SK = al256(WS_WQ + (size_t)2048 * 1024 * 2);
constexpr size_t WS_PU = al256(WS_SK + (size_t)16 * 128 * 128 * 2);
constexpr size_t WS_PV = al256(WS_PU + (size_t)16384 * 1024);
constexpr size_t WS_H = al256(WS_PV + (size_t)16384 * 1024);
constexpr float PU_SCALE = 32.f, PV_SCALE = 4.f;
constexpr size_t WS_OA = al256(WS_H + (size_t)T_TOK * 1024 * 2);
constexpr size_t WS_OC = al256(WS_OA + (size_t)T_TOK * 512 * 2);
constexpr size_t WS_Y = al256(WS_OC + (size_t)T_TOK * 512 * 2);
constexpr size_t WS_Z = al256(WS_Y + (size_t)T_TOK * 1536 * 2);
constexpr size_t WS_VT = al256(WS_Z + (size_t)T_TOK * LDZ * 2);
constexpr size_t WS_BM = al256(WS_VT + (size_t)T_TOK * 512 * 2);
constexpr size_t WS_END = al256(WS_BM + (size_t)T_TOK * 64 * 4);
constexpr size_t WS_QP = WS_Z;
constexpr size_t WS_SC = al256(WS_QP + (size_t)T_TOK * 2048 * 2);
constexpr size_t WS_RI = al256(WS_SC + (size_t)T_TOK * 2048 * 4);
constexpr size_t WS_RG = al256(WS_RI + (size_t)T_TOK * 128 * 4);
constexpr size_t WS_PP = al256(WS_RG + (size_t)T_TOK * 128 * 4);
static_assert(WS_PP + (size_t)8 * T_TOK * 128 * 4 <= WS_VT, "peer partials overflow the Z region");
static_assert(WS_RG + (size_t)T_TOK * 128 * 4 <= WS_END, "peer alias overflow");

struct Params {
    const float* x; const float* c; const float* w_ada; const float* b_ada; const float* norm_mix; const float* norm_ffn;
    const float* w_in; const float* hgrn_lb; const float* hgrn_on; const float* dsa_qn; const float* dsa_kn;
    const float* gla_up; const float* gla_bias; const float* gla_on; const float* w_branch; const float* w_out;
    const float* peer_wq; const float* peer_keys; const float* peer_u; const float* peer_v;
    float* out; unsigned char* ws;
    int wv, pad;
};

__device__ __forceinline__ float bf2f(bf16_t h) { return __uint_as_float(((unsigned)h) << 16); }
__device__ __forceinline__ float bflo(unsigned u) { return __uint_as_float(u << 16); }
__device__ __forceinline__ float bfhi(unsigned u) { return __uint_as_float(u & 0xffff0000u); }
__device__ __forceinline__ bf16_t f2bf(float f) { unsigned r; asm volatile("v_cvt_pk_bf16_f32 %0, %1, %1" : "=v"(r) : "v"(f)); return (bf16_t)(r & 0xffffu); }
__device__ __forceinline__ unsigned pack2(float a, float b) { unsigned r; asm volatile("v_cvt_pk_bf16_f32 %0, %1, %2" : "=v"(r) : "v"(a), "v"(b)); return r; }
__device__ __forceinline__ int lane_id_opaque() { int l; asm volatile("v_mbcnt_lo_u32_b32 %0, -1, 0\n\tv_mbcnt_hi_u32_b32 %0, -1, %0" : "=v"(l)); return l; }
template <int M> __device__ __forceinline__ int shx_i(int v) {
    if (M < 32) return __builtin_amdgcn_ds_swizzle(v, (M << 10) | 0x1f);
    return __builtin_amdgcn_ds_bpermute((lane_id_opaque() ^ 32) << 2, v);
}
template <int M> __device__ __forceinline__ float shx(float v) { return __int_as_float(shx_i<M>(__float_as_int(v))); }
template <int M> __device__ __forceinline__ int shx(int v) { return shx_i<M>(v); }
template <int M> __device__ __forceinline__ unsigned shx(unsigned v) { return (unsigned)shx_i<M>((int)v); }
__device__ __forceinline__ int bperm(int v, int src) { return __builtin_amdgcn_ds_bpermute(src << 2, v); }
__device__ __forceinline__ float bperm(float v, int src) { return __int_as_float(__builtin_amdgcn_ds_bpermute(src << 2, __float_as_int(v))); }
__device__ __forceinline__ float wave_sum(float v) { v += shx<32>(v); v += shx<16>(v); v += shx<8>(v); v += shx<4>(v); v += shx<2>(v); v += shx<1>(v); return v; }
__device__ __forceinline__ float wave_max(float v) { v = fmaxf(v, shx<32>(v)); v = fmaxf(v, shx<16>(v)); v = fmaxf(v, shx<8>(v)); v = fmaxf(v, shx<4>(v)); v = fmaxf(v, shx<2>(v)); v = fmaxf(v, shx<1>(v)); return v; }
__device__ __forceinline__ int wave_sum_i(int v) { v += shx<32>(v); v += shx<16>(v); v += shx<8>(v); v += shx<4>(v); v += shx<2>(v); v += shx<1>(v); return v; }
__device__ __forceinline__ int wave_total_i(int v) {
    v += __builtin_amdgcn_update_dpp(0, v, 0x111, 0xf, 0xf, true);
    v += __builtin_amdgcn_update_dpp(0, v, 0x112, 0xf, 0xf, true);
    v += __builtin_amdgcn_update_dpp(0, v, 0x114, 0xf, 0xf, true);
    v += __builtin_amdgcn_update_dpp(0, v, 0x118, 0xf, 0xf, true);
    v += __builtin_amdgcn_update_dpp(0, v, 0x142, 0xa, 0xf, true);
    v += __builtin_amdgcn_update_dpp(0, v, 0x143, 0xc, 0xf, true);
    return __builtin_amdgcn_readlane(v, 63);
}
__device__ __forceinline__ float sigm(float x) { return __frcp_rn(1.f + __expf(-x)); }

__device__ __forceinline__ unsigned xb_xcc_id() { return (unsigned)__builtin_amdgcn_s_getreg((3 << 11) | 20) & 0xFu; }
__device__ __forceinline__ int TIDXW(int wv) { int t; asm volatile("v_mbcnt_lo_u32_b32 %0, -1, 0\n\tv_mbcnt_hi_u32_b32 %0, -1, %0\n\tv_lshl_or_b32 %0, %1, 6, %0" : "=v"(t) : "s"(wv)); return t; }
#define TIDX() TIDXW(p.wv)

__device__ __forceinline__ int src_col(int j) {
    if (j < 3584) return j;
    if (j < 4096) return j - 3584 + 4420;
    if (j < 4608) return j - 4096 + 4948;
    if (j < 4864) return j - 4608 + 3584;
    if (j < 5120) return j - 4864 + 3908;
    if (j < 5376) return j - 5120 + 4164;
    if (j < 5440) return j - 5376 + 3840;
    if (j < 5444) return j - 5440 + 3904;
    if (j < 5460) return j - 5444 + 4932;
    if (j < 5632) return -1;
    return j - 5632 + 5460;
}

__device__ void ph_mod(const Params& p, int vb0, int nvb, char* smem_) {
    float* sc = (float*)smem_;
    float* part = sc + 8 * 1024;
    float* mod = (float*)(p.ws + WS_MOD);
    const int tid = TIDX(), lane = tid & 63, wave = tid >> 6;
    if (vb0 >= 192) return;
    for (int i = tid; i < 8 * 1024; i += NT) { float c = p.c[i]; sc[i] = c / (1.f + __expf(-c)); }
    __syncthreads();
    for (int task = vb0; task < 192; task += nvb) {
        const int l = task / 96, n0 = (task % 96) * 64;
        const float* w = p.w_ada + (size_t)l * 1024 * 6144 + (size_t)(wave * 128) * 6144 + n0 + lane;
        float acc[8];
#pragma unroll
        for (int b = 0; b < 8; ++b) acc[b] = 0.f;
#pragma unroll 1
        for (int k0 = 0; k0 < 128; k0 += 16) {
            float wv[16];
#pragma unroll
            for (int j = 0; j < 16; ++j) wv[j] = w[(size_t)(k0 + j) * 6144];
#pragma unroll
            for (int j = 0; j < 16; ++j)
#pragma unroll
                for (int b = 0; b < 8; ++b) acc[b] += sc[b * 1024 + wave * 128 + k0 + j] * wv[j];
        }
#pragma unroll
        for (int b = 0; b < 8; ++b) part[(wave * 8 + b) * 64 + lane] = acc[b];
        __syncthreads();
        {
            const int b = tid >> 6, col = tid & 63;
            float v = p.b_ada[l * 6144 + n0 + col];
#pragma unroll
            for (int w_ = 0; w_ < 8; ++w_) v += part[(w_ * 8 + b) * 64 + col];
            mod[(size_t)(l * 8 + b) * 6144 + n0 + col] = v;
        }
        __syncthreads();
    }
}

template <bool MAP>
__device__ void tr_tile(const float* __restrict__ src, int lds_, bf16_t* __restrict__ out, int ldo, int k0, int n0, float* tile, const int tid) {
    float lv[8];
    {
        const int nn = tid & 63, scol = MAP ? src_col(n0 + nn) : (n0 + nn);
#pragma unroll
        for (int i = 0; i < 8; ++i) { const int kk = (tid >> 6) + 8 * i; lv[i] = (scol >= 0) ? src[(size_t)(k0 + kk) * lds_ + scol] : 0.f; }
#pragma unroll
        for (int i = 0; i < 8; ++i) { const int kk = (tid >> 6) + 8 * i; tile[kk * 65 + nn] = lv[i]; }
    }
    __syncthreads();
#pragma unroll
    for (int i = 0; i < 4; ++i) {
        int nn = (tid >> 5) + 16 * i, kk = (tid & 31) * 2;
        unsigned v = pack2(tile[kk * 65 + nn], tile[(kk + 1) * 65 + nn]);
        *(unsigned*)(out + (size_t)(n0 + nn) * ldo + k0 + kk) = v;
    }
    __syncthreads();
}
__device__ void conv_chunk(const float* __restrict__ src, bf16_t* __restrict__ dst, size_t base, const int tid) {
    f32x4 la[4], lb[4];
#pragma unroll
    for (int i = 0; i < 4; ++i) { const size_t e = base + (size_t)(i * NT + tid) * 8; la[i] = *(const f32x4*)(src + e); lb[i] = *(const f32x4*)(src + e + 4); }
#pragma unroll
    for (int i = 0; i < 4; ++i) {
        size_t e = base + (size_t)(i * NT + tid) * 8;
        const float4 a = make_float4(la[i][0], la[i][1], la[i][2], la[i][3]), b = make_float4(lb[i][0], lb[i][1], lb[i][2], lb[i][3]);
        uint4 o; o.x = pack2(a.x, a.y); o.y = pack2(a.z, a.w); o.z = pack2(b.x, b.y); o.w = pack2(b.z, b.w);
        *(uint4*)(dst + e) = o;
    }
}
__device__ void conv_chunk_fp8(const float* __restrict__ src, unsigned char* __restrict__ dst, size_t base, float scale, const int tid) {
    f32x4 la[4], lb[4];
#pragma unroll
    for (int i = 0; i < 4; ++i) { const size_t e = base + (size_t)(i * NT + tid) * 8; la[i] = *(const f32x4*)(src + e); lb[i] = *(const f32x4*)(src + e + 4); }
#pragma unroll
    for (int i = 0; i < 4; ++i) {
        size_t e = base + (size_t)(i * NT + tid) * 8;
        const float4 a = make_float4(la[i][0], la[i][1], la[i][2], la[i][3]), b = make_float4(lb[i][0], lb[i][1], lb[i][2], lb[i][3]);
        int lo = __builtin_amdgcn_cvt_pk_fp8_f32(a.x * scale, a.y * scale, 0, false); lo = __builtin_amdgcn_cvt_pk_fp8_f32(a.z * scale, a.w * scale, lo, true);
        int hi = __builtin_amdgcn_cvt_pk_fp8_f32(b.x * scale, b.y * scale, 0, false); hi = __builtin_amdgcn_cvt_pk_fp8_f32(b.z * scale, b.w * scale, hi, true);
        const size_t row = e >> 10, col = e & 1023;
        *(uint2*)(dst + ((col >> 7) * 16384 + row) * 128 + (col & 127)) = make_uint2((unsigned)lo, (unsigned)hi);
    }
}
__device__ void ph_wprep(const Params& p, int l, int vb0, int nvb, char* smem_) {
    float* tile = (float*)smem_;
    const int tid = TIDX();
    bf16_t* WIN = (bf16_t*)(p.ws + WS_WIN); bf16_t* WBR = (bf16_t*)(p.ws + WS_WBR); bf16_t* WOUT = (bf16_t*)(p.ws + WS_WOUT);
    bf16_t* WQ = (bf16_t*)(p.ws + WS_WQ); bf16_t* SK = (bf16_t*)(p.ws + WS_SK); unsigned char* PU = p.ws + WS_PU; unsigned char* PV = p.ws + WS_PV;
    constexpr int N_WIN = 136 * 16, N_WBR = 3 * 16 * 8, N_WOUT = 16 * 16, N_WQ = 32 * 16, N_SK = 16, N_PU = 1024, N_PV = 1024;
    constexpr int TOTAL = N_WIN + N_WBR + N_WOUT + N_WQ + N_SK + N_PU + N_PV;
    for (int task = vb0; task < TOTAL; task += nvb) {
        int r = task;
        if (r < N_WIN) { int nt = r / 16, kt = r % 16; tr_tile<true>(p.w_in + (size_t)l * 1024 * IN_COLS, IN_COLS, WIN, 1024, kt * 64, nt * 64, tile, tid); continue; }
        r -= N_WIN;
        if (r < N_WBR) { int g = r / 128, rr = r % 128, nt = rr / 8, kt = rr % 8;
            tr_tile<false>(p.w_branch + (size_t)(l * 3 + g) * 512 * 1024, 1024, WBR + (size_t)g * 1024 * 512, 512, kt * 64, nt * 64, tile, tid); continue; }
        r -= N_WBR;
        if (r < N_WOUT) { int nt = r / 16, kt = r % 16; tr_tile<false>(p.w_out + (size_t)l * 1024 * 1024, 1024, WOUT, 1024, kt * 64, nt * 64, tile, tid); continue; }
        r -= N_WOUT;
        if (r < N_WQ) { int nt = r / 16, kt = r % 16; tr_tile<false>(p.peer_wq + (size_t)l * 1024 * 2048, 2048, WQ, 1024, kt * 64, nt * 64, tile, tid); continue; }
        r -= N_WQ;
        if (r < N_SK) { conv_chunk(p.peer_keys + (size_t)l * 16 * 128 * 128, SK, (size_t)r * 16384, tid); continue; }
        r -= N_SK;
        if (r < N_PU) { conv_chunk_fp8(p.peer_u + (size_t)l * 16384 * 1024, PU, (size_t)r * 16384, PU_SCALE, tid); continue; }
        r -= N_PU;
        conv_chunk_fp8(p.peer_v + (size_t)l * 16384 * 1024, PV, (size_t)r * 16384, PV_SCALE, tid);
    }
}

__device__ void ph_norm(const Params& p, int l, int which, const float* xin, int vb0, int nvb) {
    const int wave = TIDX() >> 6, lane = TIDX() & 63;
    const float* gain = (which ? p.norm_ffn : p.norm_mix) + l * 1024;
    const float* modb = (const float*)(p.ws + WS_MOD);
    bf16_t* H = (bf16_t*)(p.ws + WS_H);
    f32x4 g[4];
#pragma unroll
    for (int i = 0; i < 4; ++i) g[i] = *(const f32x4*)(gain + (lane + 64 * i) * 4);
    for (int t = vb0 * 8 + wave; t < T_TOK; t += nvb * 8) {
        const int b = t >> 11;
        const float* mod = modb + (size_t)(l * 8 + b) * 6144 + (which ? 3072 : 0);
        const f32x4* xr = (const f32x4*)(xin + (size_t)t * 1024);
        f32x4 v[4], sc[4], sh[4]; float ss = 0.f;
#pragma unroll
        for (int i = 0; i < 4; ++i) { v[i] = xr[lane + 64 * i]; sc[i] = *(const f32x4*)(mod + 1024 + (lane + 64 * i) * 4); sh[i] = *(const f32x4*)(mod + (lane + 64 * i) * 4); }
#pragma unroll
        for (int i = 0; i < 4; ++i) ss += v[i][0] * v[i][0] + v[i][1] * v[i][1] + v[i][2] * v[i][2] + v[i][3] * v[i][3];
        ss = wave_sum(ss);
        const float rstd = rsqrtf(ss * (1.f / 1024.f) + 1e-6f);
#pragma unroll
        for (int i = 0; i < 4; ++i) {
            const int idx = (lane + 64 * i) * 4;
            const f32x4 h = v[i] * rstd * g[i] * (1.f + sc[i]) + sh[i];
            uint2 o; o.x = pack2(h[0], h[1]); o.y = pack2(h[2], h[3]);
            *(uint2*)(H + (size_t)t * 1024 + idx) = o;
        }
    }
}

constexpr int GBM = 256, GBN = 128, GBK = 64, GLS = 72;
__device__ __forceinline__ void gemm_tile(const bf16_t* __restrict__ A, int lda, const bf16_t* __restrict__ Bt, int ldb, int K,
                                          int m0, int n0, bf16_t* sA, bf16_t* sB, f32x4 (&acc)[4][4], const int tid) {
    const int lane = tid & 63, wave = tid >> 6;
    const int wm = wave >> 1, wn = wave & 1, fr = lane & 15, fq = lane >> 4;
    u32x4 ra[4], rb[2];
    const int crow = tid >> 3, ckc = (tid & 7) * 8;
    const bf16_t* Ag = A + (size_t)(m0 + crow) * lda + ckc;
    const bf16_t* Bg = Bt + (size_t)(n0 + crow) * ldb + ckc;
#pragma unroll
    for (int i = 0; i < 4; ++i) ra[i] = *(const u32x4*)(Ag + (size_t)(64 * i) * lda);
#pragma unroll
    for (int i = 0; i < 2; ++i) rb[i] = *(const u32x4*)(Bg + (size_t)(64 * i) * ldb);
    for (int k0 = 0; k0 < K; k0 += GBK) {
        __syncthreads();
#pragma unroll
        for (int i = 0; i < 4; ++i) *(u32x4*)(sA + (crow + 64 * i) * GLS + ckc) = ra[i];
#pragma unroll
        for (int i = 0; i < 2; ++i) *(u32x4*)(sB + (crow + 64 * i) * GLS + ckc) = rb[i];
        __syncthreads();
        {
            const int kn = (k0 + GBK < K) ? (k0 + GBK) : k0;
#pragma unroll
            for (int i = 0; i < 4; ++i) ra[i] = *(const u32x4*)(Ag + (size_t)(64 * i) * lda + kn);
#pragma unroll
            for (int i = 0; i < 2; ++i) rb[i] = *(const u32x4*)(Bg + (size_t)(64 * i) * ldb + kn);
        }
#pragma unroll
        for (int ks = 0; ks < 2; ++ks) {
            bf16x8 af[4], wf[4];
#pragma unroll
            for (int mf = 0; mf < 4; ++mf) af[mf] = *(const bf16x8*)(sA + (wm * 64 + mf * 16 + fr) * GLS + ks * 32 + fq * 8);
#pragma unroll
            for (int nf = 0; nf < 4; ++nf) wf[nf] = *(const bf16x8*)(sB + (wn * 64 + nf * 16 + fr) * GLS + ks * 32 + fq * 8);
#pragma unroll
            for (int nf = 0; nf < 4; ++nf)
#pragma unroll
                for (int mf = 0; mf < 4; ++mf)
                    acc[nf][mf] = __builtin_amdgcn_mfma_f32_16x16x32_bf16(wf[nf], af[mf], acc[nf][mf], 0, 0, 0);
        }
    }
}


namespace pg8 {
#define PG8_LAS __attribute__((address_space(3)))
constexpr int BM = 256, BK = 64, HALF = 128, HTB = HALF * BK * 2, STAGE_BYTES = 8 * HTB, NXCD = 8, WGM = 8;
__device__ __forceinline__ int lds_byte(int r, int c) { const int st = (r >> 4) * 2 + (c >> 5), rr = r & 15, cc = c & 31, ob = rr * 64 + cc * 2; return st * 1024 + (ob ^ (((ob >> 9) & 1) << 5)); }
__device__ __forceinline__ void stage_rc(int b, int& R, int& C) { const int st = b / 1024, sb = b % 1024, swz = sb ^ (((sb >> 9) & 1) << 5); R = (st >> 1) * 16 + swz / 64; C = (st & 1) * 32 + (swz % 64) / 2; }
__device__ __forceinline__ int perm32(int rho) { const int n = rho >> 4, i = rho & 15; return 8 * (i >> 2) + 4 * n + (i & 3); }
struct Unit { int pm, pn, aux; size_t aoff, boff; };
struct Gemm { const bf16_t* A; const bf16_t* Bt; int lda, ldb, K; };

struct StaticOrder {
    int nM, nN, nwg, G, c, lda, ldb;
    __device__ void init(int M, int N, int G_, int c_, int lda_, int ldb_) { nM = M / BM; nN = N / BM; nwg = nM * nN; G = G_; c = c_; lda = lda_; ldb = ldb_; }
    __device__ bool next(int i, Unit& u) const {
        const long L = (long)i * G + c; if (L >= nwg) return false;
        int wgid = (int)L; { const int q = nwg / NXCD, r = nwg % NXCD, xcd = wgid % NXCD, off = wgid / NXCD; wgid = (xcd < r ? xcd * (q + 1) : r * (q + 1) + (xcd - r) * q) + off; }
        const int nig = WGM * nN, gid = wgid / nig, fm = gid * WGM, gsz = (nM - fm) < WGM ? (nM - fm) : WGM;
        u.pm = fm + ((wgid % nig) % gsz); u.pn = (wgid % nig) / gsz; u.aux = 0;
        u.aoff = (size_t)u.pm * BM * lda * 2; u.boff = (size_t)u.pn * BM * ldb * 2;
        return true;
    }
};
struct MergeOrder {
    int c, G;
    __device__ bool next(int i, Unit& u) const {
        const int tile = c + (i / 3) * G; if (tile >= 256) return false;
        u.pm = tile & 63; u.pn = tile >> 6; u.aux = i % 3;
        u.aoff = ((size_t)u.pm * BM * 1536 + (size_t)u.aux * 512) * 2; u.boff = ((size_t)u.aux * 1024 + (size_t)u.pn * BM) * 512 * 2;
        return true;
    }
};

template <class Epi, class Sched>
__device__ __forceinline__ void gemm_phase(PG8_LAS unsigned char* lds, const Gemm g, const Sched& S, const Epi& E, const int tid) {
    const int wid = __builtin_amdgcn_readfirstlane(tid >> 6), lane = tid & 63, wr = wid >> 2, wc = wid & 3, fr = lane & 15, fq = lane >> 4;
    const int K = g.K, nt = K / BK;
    unsigned voffA[2], voffB[2];
#pragma unroll
    for (int i = 0; i < 2; ++i) { int R, C; stage_rc(tid * 16 + i * 8192, R, C); const int Rb = Epi::PERM ? ((R & ~31) + perm32(R & 31)) : R;
        voffA[i] = (unsigned)(R * g.lda + C) * 2u; voffB[i] = (unsigned)(Rb * g.ldb + C) * 2u; }
    const size_t kstep = (size_t)(BK * 2);
    const size_t hstepA = (size_t)HALF * g.lda * 2, hstepB = (size_t)HALF * g.ldb * 2;
    const unsigned ldsw = (unsigned)wid * 1024u;
    const int aoff = lds_byte(wr * 64 + fr, fq * 8), boff = lds_byte(wc * 32 + fr, fq * 8);
#define PG8_SA(b, h) (((b) * 2 + (h)) * HTB)
#define PG8_SB(b, h) ((4 + (b) * 2 + (h)) * HTB)
#define PG8_STAGE(bufoff, gbase, voff) do { _Pragma("unroll") for (int _i = 0; _i < 2; ++_i) \
        __builtin_amdgcn_global_load_lds((const unsigned*)((const char*)(gbase) + (voff)[_i]), (PG8_LAS unsigned*)(lds + (bufoff) + ldsw + _i * 8192), 16, 0, 0); } while (0)
#define PG8_LDA(dst, b, h) do { _Pragma("unroll") for (int m = 0; m < 4; ++m) _Pragma("unroll") for (int k = 0; k < 2; ++k) dst[m][k] = *(const PG8_LAS bf16x8*)(lds + PG8_SA(b, h) + aoff + m * 2048 + k * 1024); } while (0)
#define PG8_LDB(dst, b, h) do { _Pragma("unroll") for (int n = 0; n < 2; ++n) _Pragma("unroll") for (int k = 0; k < 2; ++k) dst[n][k] = *(const PG8_LAS bf16x8*)(lds + PG8_SB(b, h) + boff + n * 2048 + k * 1024); } while (0)
#define PG8_MMA(ai, bj, At, Bt) do { __builtin_amdgcn_s_setprio(1); _Pragma("unroll") for (int m = 0; m < 4; ++m) _Pragma("unroll") for (int n = 0; n < 2; ++n) _Pragma("unroll") for (int k = 0; k < 2; ++k) \
        acc[ai][bj][m][n] = __builtin_amdgcn_mfma_f32_16x16x32_bf16(Bt[n][k], At[m][k], acc[ai][bj][m][n], 0, 0, 0); __builtin_amdgcn_s_setprio(0); } while (0)
#define PG8_WAIT_V(n) asm volatile("s_waitcnt vmcnt(" #n ")" ::: "memory")
#define PG8_WAIT_L(n) asm volatile("s_waitcnt lgkmcnt(" #n ")" ::: "memory")
#define PG8_BAR __builtin_amdgcn_s_barrier()
#define PG8_SCHED __builtin_amdgcn_sched_barrier(0)
    Unit cur, nxt; int ui = 0;
    if (!S.next(0, cur)) return;
    f32x4 acc[2][2][4][2];
#pragma unroll
    for (int a = 0; a < 2; ++a)
#pragma unroll
        for (int b = 0; b < 2; ++b)
#pragma unroll
            for (int m = 0; m < 4; ++m)
#pragma unroll
                for (int n = 0; n < 2; ++n) acc[a][b][m][n] = f32x4{0.f, 0.f, 0.f, 0.f};
    bf16x8 At[4][2], B0[2][2], B1[2][2];
    const char* cA = (const char*)g.A + cur.aoff; const char* cB = (const char*)g.Bt + cur.boff;
    PG8_STAGE(PG8_SB(0, 0), cB, voffB); PG8_STAGE(PG8_SA(0, 0), cA, voffA); PG8_STAGE(PG8_SB(0, 1), cB + hstepB, voffB); PG8_STAGE(PG8_SA(0, 1), cA + hstepA, voffA);
    if (wr == 1) PG8_BAR;
    PG8_WAIT_V(4); PG8_BAR;
    PG8_STAGE(PG8_SB(1, 0), cB + kstep, voffB); PG8_STAGE(PG8_SA(1, 0), cA + kstep, voffA); PG8_STAGE(PG8_SB(1, 1), cB + hstepB + kstep, voffB);
    PG8_WAIT_V(6); PG8_BAR;
    for (;;) {
        const bool has_next = S.next(ui + 1, nxt);
        const char* nA = has_next ? (const char*)g.A + nxt.aoff : cA; const char* nB = has_next ? (const char*)g.Bt + nxt.boff : cB;
        for (int t = 0; t < nt; t += 2) {
            const bool last = (t == nt - 2);
            const char* a1 = cA + (size_t)(t + 1) * kstep;
            const char* a2 = last ? nA : cA + (size_t)(t + 2) * kstep; const char* b2 = last ? nB : cB + (size_t)(t + 2) * kstep;
            const char* a3 = a2 + kstep; const char* b3 = b2 + kstep;
            PG8_LDB(B0, 0, 0); PG8_SCHED; PG8_LDA(At, 0, 0); PG8_STAGE(PG8_SA(1, 1), a1 + hstepA, voffA);
            PG8_WAIT_L(8); PG8_BAR; PG8_WAIT_L(0); PG8_MMA(0, 0, At, B0); PG8_BAR; PG8_SCHED;
            PG8_LDB(B1, 0, 1); PG8_STAGE(PG8_SB(0, 0), b2, voffB);
            PG8_BAR; PG8_WAIT_L(0); PG8_MMA(0, 1, At, B1); PG8_BAR;
            PG8_LDA(At, 0, 1); PG8_STAGE(PG8_SA(0, 0), a2, voffA);
            PG8_BAR; PG8_WAIT_L(0); PG8_MMA(1, 0, At, B0); PG8_BAR; PG8_SCHED;
            PG8_STAGE(PG8_SB(0, 1), b2 + hstepB, voffB);
            PG8_WAIT_V(6); PG8_BAR; PG8_MMA(1, 1, At, B1); PG8_BAR;
            PG8_LDB(B0, 1, 0); PG8_SCHED; PG8_LDA(At, 1, 0); PG8_STAGE(PG8_SA(0, 1), a2 + hstepA, voffA);
            PG8_WAIT_L(8); PG8_BAR; PG8_WAIT_L(0); PG8_MMA(0, 0, At, B0); PG8_BAR; PG8_SCHED;
            PG8_LDB(B1, 1, 1); PG8_STAGE(PG8_SB(1, 0), b3, voffB);
            PG8_BAR; PG8_WAIT_L(0); PG8_MMA(0, 1, At, B1); PG8_BAR;
            PG8_LDA(At, 1, 1); PG8_STAGE(PG8_SA(1, 0), a3, voffA);
            PG8_BAR; PG8_WAIT_L(0); PG8_MMA(1, 0, At, B0); PG8_BAR; PG8_SCHED;
            PG8_STAGE(PG8_SB(1, 1), b3 + hstepB, voffB);
            PG8_WAIT_V(6); PG8_BAR; PG8_MMA(1, 1, At, B1); PG8_BAR;
        }
        E(acc, cur, wr, wc, fr, fq);
        if (!has_next) break;
#pragma unroll
        for (int a = 0; a < 2; ++a)
#pragma unroll
            for (int b = 0; b < 2; ++b)
#pragma unroll
                for (int m = 0; m < 4; ++m)
#pragma unroll
                    for (int n = 0; n < 2; ++n) acc[a][b][m][n] = f32x4{0.f, 0.f, 0.f, 0.f};
        cur = nxt; cA = nA; cB = nB; ++ui;
    }
    PG8_WAIT_V(0);
    if (wr == 0) PG8_BAR;
    PG8_BAR;
#undef PG8_SA
#undef PG8_SB
#undef PG8_STAGE
#undef PG8_LDA
#undef PG8_LDB
#undef PG8_MMA
#undef PG8_WAIT_V
#undef PG8_WAIT_L
#undef PG8_BAR
#undef PG8_SCHED
}

struct EpiBf16 {
    static constexpr bool PERM = true;
    bf16_t* O; int ldc;
    __device__ __forceinline__ void operator()(const f32x4 (&acc)[2][2][4][2], const Unit& u, int wr, int wc, int fr, int fq) const {
        const int row0 = u.pm * BM + wr * 64 + fr, col0 = u.pn * BM + wc * 32 + 8 * fq;
#pragma unroll
        for (int ai = 0; ai < 2; ++ai)
#pragma unroll
            for (int m = 0; m < 4; ++m) { bf16_t* rowp = O + (size_t)(row0 + ai * HALF + m * 16) * ldc + col0;
#pragma unroll
                for (int bj = 0; bj < 2; ++bj) { const f32x4 v0 = acc[ai][bj][m][0], v1 = acc[ai][bj][m][1];
                    u32x4 w; w.x = pack2(v0[0], v0[1]); w.y = pack2(v0[2], v0[3]); w.z = pack2(v1[0], v1[1]); w.w = pack2(v1[2], v1[3]);
                    *(u32x4*)(rowp + bj * HALF) = w; } }
    }
};
struct EpiResid {
    static constexpr bool PERM = false;
    const float* xin; float* out; const float* mod;
    __device__ __forceinline__ void operator()(const f32x4 (&acc)[2][2][4][2], const Unit& u, int wr, int wc, int fr, int fq) const {
        const int row0 = u.pm * BM + wr * 64 + fr, col0 = u.pn * BM + wc * 32 + 4 * fq;
        const float* gm = mod + (size_t)(row0 >> 11) * 6144 + 2048 + col0;
        f32x4 g4[2][2];
#pragma unroll
        for (int bj = 0; bj < 2; ++bj)
#pragma unroll
            for (int n = 0; n < 2; ++n) g4[bj][n] = *(const f32x4*)(gm + bj * HALF + n * 16);
#pragma unroll
        for (int ai = 0; ai < 2; ++ai) {
            f32x4 xi[4][2][2];
#pragma unroll
            for (int m = 0; m < 4; ++m)
#pragma unroll
                for (int bj = 0; bj < 2; ++bj)
#pragma unroll
                    for (int n = 0; n < 2; ++n) xi[m][bj][n] = *(const f32x4*)(xin + (size_t)(row0 + ai * HALF + m * 16) * 1024 + col0 + bj * HALF + n * 16);
            asm volatile("" ::: "memory");
#pragma unroll
            for (int m = 0; m < 4; ++m)
#pragma unroll
                for (int bj = 0; bj < 2; ++bj)
#pragma unroll
                    for (int n = 0; n < 2; ++n)
                        *(f32x4*)(out + (size_t)(row0 + ai * HALF + m * 16) * 1024 + col0 + bj * HALF + n * 16) = xi[m][bj][n] + g4[bj][n] * acc[ai][bj][m][n];
            asm volatile("" ::: "memory");
        }
    }
};
struct EpiMerge {
    static constexpr bool PERM = true;
    bf16_t* Hm; const bf16_t* Z;
    __device__ __forceinline__ void operator()(const f32x4 (&acc)[2][2][4][2], const Unit& u, int wr, int wc, int fr, int fq) const {
        const int row0 = u.pm * BM + wr * 64 + fr, col0 = u.pn * BM + wc * 32 + 8 * fq, g = u.aux;
#pragma unroll
        for (int ai = 0; ai < 2; ++ai) {
            u32x4 gz[4][2], prev[4][2];
#pragma unroll
            for (int m = 0; m < 4; ++m)
#pragma unroll
                for (int bj = 0; bj < 2; ++bj) {
                    const int row = row0 + ai * HALF + m * 16, col = col0 + bj * HALF;
                    gz[m][bj] = *(const u32x4*)(Z + (size_t)row * LDZ + ZM + g * 1024 + col);
                    prev[m][bj] = u32x4{0u, 0u, 0u, 0u};
                    if (g > 0) prev[m][bj] = *(const u32x4*)(Hm + (size_t)row * 1024 + col);
                }
            asm volatile("" ::: "memory");
#pragma unroll
            for (int m = 0; m < 4; ++m)
#pragma unroll
                for (int bj = 0; bj < 2; ++bj) {
                    const int row = row0 + ai * HALF + m * 16, col = col0 + bj * HALF;
                    const f32x4 v0 = acc[ai][bj][m][0], v1 = acc[ai][bj][m][1];
                    const u32x4 z_ = gz[m][bj], p_ = prev[m][bj];
                    u32x4 w;
                    w.x = pack2(bflo(p_.x) + sigm(bflo(z_.x)) * v0[0], bfhi(p_.x) + sigm(bfhi(z_.x)) * v0[1]);
                    w.y = pack2(bflo(p_.y) + sigm(bflo(z_.y)) * v0[2], bfhi(p_.y) + sigm(bfhi(z_.y)) * v0[3]);
                    w.z = pack2(bflo(p_.z) + sigm(bflo(z_.z)) * v1[0], bfhi(p_.z) + sigm(bfhi(z_.z)) * v1[1]);
                    w.w = pack2(bflo(p_.w) + sigm(bflo(z_.w)) * v1[2], bfhi(p_.w) + sigm(bfhi(z_.w)) * v1[3]);
                    *(u32x4*)(Hm + (size_t)row * 1024 + col) = w;
                }
            asm volatile("" ::: "memory");
        }
    }
};
}

struct EpiZ {
    bf16_t* Z; int ld;
    __device__ __forceinline__ void operator()(int m, int n, const f32x4& v) const {
        uint2 o; o.x = pack2(v[0], v[1]); o.y = pack2(v[2], v[3]);
        *(uint2*)(Z + (size_t)m * ld + n) = o;
    }
};
struct EpiF16 {
    _Float16* C; int ld;
    __device__ __forceinline__ void operator()(int m, int n, const f32x4& v) const {
        typedef _Float16 h4 __attribute__((ext_vector_type(4)));
        h4 o = {(_Float16)v[0], (_Float16)v[1], (_Float16)v[2], (_Float16)v[3]};
        *(h4*)(C + (size_t)m * ld + n) = o;
    }
};
struct EpiOut {
    const float* xin; float* out; const float* mod;
    __device__ __forceinline__ void operator()(int m, int n, const f32x4& v) const {
        int b = m >> 11;
        float4 g = *(const float4*)(mod + (size_t)b * 6144 + 2048 + n);
        float4 xi = *(const float4*)(xin + (size_t)m * 1024 + n);
        *(float4*)(out + (size_t)m * 1024 + n) = make_float4(xi.x + g.x * v[0], xi.y + g.y * v[1], xi.z + g.z * v[2], xi.w + g.w * v[3]);
    }
};

template <class Epi>
__device__ void gemm_phase(const bf16_t* A, int lda, const bf16_t* Bt, int ldb, int M, int N, int K, bool batched, Epi epi,
                           int vb0, int nvb, char* smem_, const int tid) {
    bf16_t* sA = (bf16_t*)smem_; bf16_t* sB = sA + GBM * GLS;
    const int lane = tid & 63, wave = tid >> 6, wm = wave >> 1, wn = wave & 1, fr = lane & 15, fq = lane >> 4;
    const int MT = M / GBM, NTL = N / GBN;
    for (int tile = vb0; tile < MT * NTL; tile += nvb) {
        int mt = tile % MT, nt = tile / MT;
        f32x4 acc[4][4];
#pragma unroll
        for (int a = 0; a < 4; ++a)
#pragma unroll
            for (int b = 0; b < 4; ++b) acc[a][b] = f32x4{0.f, 0.f, 0.f, 0.f};
        gemm_tile(batched ? A + nt * 128 : A, lda, Bt, ldb, K, mt * GBM, nt * GBN, sA, sB, acc, tid);
#pragma unroll
        for (int nf = 0; nf < 4; ++nf)
#pragma unroll
            for (int mf = 0; mf < 4; ++mf)
                epi(mt * GBM + wm * 64 + mf * 16 + fr, nt * GBN + wn * 64 + nf * 16 + fq * 4, acc[nf][mf]);
    }
}


#define SCAN_SYNC() do { asm volatile("s_waitcnt lgkmcnt(0)" ::: "memory"); __builtin_amdgcn_s_barrier(); asm volatile("" ::: "memory"); } while (0)
template <int DK, bool GLA>
__device__ void scan2_item(const Params& p, int l, int b, int h, char* smem_) {
    constexpr int SEG = NT / DK, SLEN = 64 / SEG, KS = DK / 32, KT = DK / 16;
    constexpr int QS = DK + 8, BS = DK + 4, VS = 72;
    bf16_t* qs = (bf16_t*)smem_;
    bf16_t* ks = qs + 64 * QS;
    float* bs = (float*)(ks + 64 * QS);
    bf16_t* vt = (bf16_t*)(bs + 64 * BS);
    bf16_t* At = vt + 128 * VS;
    bf16_t* kht = At + 64 * VS;
    bf16_t* st = kht + DK * VS;
    float* segtot = (float*)(st + 128 * QS);
    float* blast = segtot + SEG * DK;
    const int tid = TIDX(), lane = tid & 63, wave = __builtin_amdgcn_readfirstlane(tid >> 6), fr = lane & 15, fq = lane >> 4;
    const int kl = tid % DK, seg = __builtin_amdgcn_readfirstlane(tid / DK);
    float lbv = 0.f, gbias = 0.f; float gu[16];
#pragma unroll
    for (int r = 0; r < 16; ++r) gu[r] = 0.f;
    if (GLA) {
#pragma unroll
        for (int r = 0; r < 16; ++r) gu[r] = p.gla_up[(size_t)(l * 16 + r) * 256 + h * 64 + kl];
        gbias = p.gla_bias[l * 256 + h * 64 + kl];
    } else if (l == 1) {
        float x0 = p.hgrn_lb[h * 128 + kl], x1 = p.hgrn_lb[512 + h * 128 + kl];
        lbv = 1.f / (1.f + expf(x0 - x1));
    }
    const float scale = GLA ? 0.125f : 0.08838834764831845f;
    const bf16_t* Zb = (const bf16_t*)(p.ws + WS_Z) + (size_t)(b * 2048) * LDZ;
    float* ssq = (float*)(smem_ + 152576);
    const int QCOL = (GLA ? ZC_Q : ZA_Q) + h * DK, KCOL = (GLA ? ZC_K : ZA_F) + h * DK, VCOL = (GLA ? ZC_V : ZA_I) + h * 128, GCOL = (GLA ? ZC_G : ZA_G) + h * 128;
    f32x4 sacc[KT];
#pragma unroll
    for (int i = 0; i < KT; ++i) sacc[i] = f32x4{0.f, 0.f, 0.f, 0.f};
    f32x4 gn4[4];
    {
        const float* gn = (GLA ? p.gla_on : p.hgrn_on) + l * 128 + (wave >> 2) * 64 + 4 * fq;
#pragma unroll
        for (int vi = 0; vi < 4; ++vi) gn4[vi] = *(const f32x4*)(gn + vi * 16);
    }
    for (int i = tid; i < 128 * QS / 2; i += NT) ((unsigned*)st)[i] = 0u;
    SCAN_SYNC();

    for (int c = 0; c < 32; ++c) {
        const bf16_t* Zc = Zb + (size_t)(c * 64) * LDZ;
        {
            bf16_t rq[SLEN], rk[SLEN];
            u32x4 rc0[GLA ? SLEN : 1], rc1[GLA ? SLEN : 1];
            {
                bf16_t rv[16];
                const int v = tid & 127, sb_ = __builtin_amdgcn_readfirstlane(tid >> 7);
#pragma unroll
                for (int i = 0; i < 16; ++i) rv[i] = Zc[(size_t)(sb_ + 4 * i) * LDZ + VCOL + v];
#pragma unroll
                for (int i = 0; i < SLEN; ++i) {
                    const bf16_t* zr = Zc + (size_t)(seg * SLEN + i) * LDZ;
                    rq[i] = zr[QCOL + kl]; rk[i] = zr[KCOL + kl];
                    if (GLA) { rc0[i] = *(const u32x4*)(zr + ZC_CODE); rc1[i] = *(const u32x4*)(zr + ZC_CODE + 8); }
                }
#pragma unroll
                for (int i = 0; i < 16; ++i) vt[v * VS + sb_ + 4 * i] = rv[i];
            }
            float run = 0.f;
#pragma unroll
            for (int i = 0; i < SLEN; ++i) {
                const int s_ = seg * SLEN + i;
                float g, kk;
                if (GLA) {
                    float x = gbias;
#pragma unroll
                    for (int r = 0; r < 4; ++r) {
                        x += bflo(rc0[i][r]) * gu[2 * r] + bfhi(rc0[i][r]) * gu[2 * r + 1];
                        x += bflo(rc1[i][r]) * gu[8 + 2 * r] + bfhi(rc1[i][r]) * gu[8 + 2 * r + 1];
                    }
                    g = (fminf(x, 0.f) - __logf(1.f + __expf(-fabsf(x)))) * (1.f / 16.f);
                    kk = bf2f(rk[i]);
                } else {
                    const float f = lbv + (1.f - lbv) * __frcp_rn(1.f + __expf(-bf2f(rk[i])));
                    g = __logf(f); kk = 1.f - f;
                }
                run += g;
                bs[s_ * BS + kl] = run;
                qs[s_ * QS + kl] = rq[i];
                ks[s_ * QS + kl] = f2bf(kk);
            }
            segtot[seg * DK + kl] = run;
        }
        SCAN_SYNC();
        {
            float pre = 0.f, tot = 0.f;
#pragma unroll
            for (int g_ = 0; g_ < SEG; ++g_) { const float v_ = segtot[g_ * DK + kl]; if (g_ < seg) pre += v_; tot += v_; }
            if (seg == 0) blast[kl] = tot;
            unsigned pk[SLEN / 2];
#pragma unroll
            for (int i = 0; i < SLEN; ++i) {
                const float bv = bs[(seg * SLEN + i) * BS + kl] + pre;
                bs[(seg * SLEN + i) * BS + kl] = bv;
                const float kh = bf2f(ks[(seg * SLEN + i) * QS + kl]) * __expf(tot - bv);
                if (i & 1) pk[i >> 1] |= ((unsigned)f2bf(kh)) << 16; else pk[i >> 1] = (unsigned)f2bf(kh);
            }
            unsigned* dst = (unsigned*)(kht + kl * VS + seg * SLEN);
#pragma unroll
            for (int i = 0; i < SLEN / 2; ++i) dst[i] = pk[i];
        }
        SCAN_SYNC();
        for (int blk = wave; blk < 10; blk += 8) {
            int bi, bj;
            if (blk < 1) { bi = 0; bj = 0; } else if (blk < 3) { bi = 1; bj = blk - 1; } else if (blk < 6) { bi = 2; bj = blk - 3; } else { bi = 3; bj = blk - 6; }
            f32x4 acc = f32x4{0.f, 0.f, 0.f, 0.f};
            const int srow = bj * 16 + fr, trow = bi * 16 + fr;
#pragma unroll
            for (int kk = 0; kk < KS; ++kk) {
                const int k0 = kk * 32 + fq * 8;
                float br[8];
                if (bi == 0) {
#pragma unroll
                    for (int j = 0; j < 8; ++j) br[j] = 0.f;
                } else {
                    const float4 r0 = *(const float4*)(bs + (bi * 16 - 1) * BS + k0), r1 = *(const float4*)(bs + (bi * 16 - 1) * BS + k0 + 4);
                    br[0] = r0.x; br[1] = r0.y; br[2] = r0.z; br[3] = r0.w; br[4] = r1.x; br[5] = r1.y; br[6] = r1.z; br[7] = r1.w;
                }
                const uint4 kq = *(const uint4*)(ks + srow * QS + k0), qq = *(const uint4*)(qs + trow * QS + k0);
                const float4 s0 = *(const float4*)(bs + srow * BS + k0), s1 = *(const float4*)(bs + srow * BS + k0 + 4);
                const float4 t0_ = *(const float4*)(bs + trow * BS + k0), t1_ = *(const float4*)(bs + trow * BS + k0 + 4);
                const float bsv[8] = {s0.x, s0.y, s0.z, s0.w, s1.x, s1.y, s1.z, s1.w}, btv[8] = {t0_.x, t0_.y, t0_.z, t0_.w, t1_.x, t1_.y, t1_.z, t1_.w};
                const unsigned kw[4] = {kq.x, kq.y, kq.z, kq.w}, qw[4] = {qq.x, qq.y, qq.z, qq.w};
                union { bf16x8 v; unsigned u[4]; } ka, qb;
#pragma unroll
                for (int j = 0; j < 4; ++j) {
                    const float e0 = __expf(fminf(br[2 * j] - bsv[2 * j], 60.f)), e1 = __expf(fminf(br[2 * j + 1] - bsv[2 * j + 1], 60.f));
                    ka.u[j] = pack2(bflo(kw[j]) * e0, bfhi(kw[j]) * e1);
                    const float f0 = __expf(btv[2 * j] - br[2 * j]), f1 = __expf(btv[2 * j + 1] - br[2 * j + 1]);
                    qb.u[j] = pack2(bflo(qw[j]) * f0, bfhi(qw[j]) * f1);
                }
                acc = __builtin_amdgcn_mfma_f32_16x16x32_bf16(ka.v, qb.v, acc, 0, 0, 0);
            }
            if (bi == bj) {
#pragma unroll
                for (int r = 0; r < 4; ++r) if (4 * fq + r > fr) acc[r] = 0.f;
            }
            uint2 o; o.x = pack2(acc[0], acc[1]); o.y = pack2(acc[2], acc[3]);
            *(uint2*)(At + trow * VS + bj * 16 + 4 * fq) = o;
        }
        {
            unsigned z_ = 0u; asm volatile("" : "+v"(z_));
            if (wave == 2) *(uint2*)(At + (0 * 16 + fr) * VS + 16 + 4 * fq) = make_uint2(z_, z_);
            if (wave == 3) *(uint2*)(At + (2 * 16 + fr) * VS + 48 + 4 * fq) = make_uint2(z_, z_);
        }
        SCAN_SYNC();
        f32x4 oacc[4]; uint2 gz[4];
        {
            const int ti = wave & 3, vh = wave >> 2, trow = ti * 16 + fr;
            bf16x8 qh[KS];
#pragma unroll
            for (int kk = 0; kk < KS; ++kk) {
                const int k0 = kk * 32 + fq * 8;
                const uint4 qq = *(const uint4*)(qs + trow * QS + k0);
                const float4 t0_ = *(const float4*)(bs + trow * BS + k0), t1_ = *(const float4*)(bs + trow * BS + k0 + 4);
                union { bf16x8 v; unsigned u[4]; } q_;
                q_.u[0] = pack2(bflo(qq.x) * __expf(t0_.x), bfhi(qq.x) * __expf(t0_.y));
                q_.u[1] = pack2(bflo(qq.y) * __expf(t0_.z), bfhi(qq.y) * __expf(t0_.w));
                q_.u[2] = pack2(bflo(qq.z) * __expf(t1_.x), bfhi(qq.z) * __expf(t1_.y));
                q_.u[3] = pack2(bflo(qq.w) * __expf(t1_.z), bfhi(qq.w) * __expf(t1_.w));
                qh[kk] = q_.v;
            }
            const bf16x8 af0 = *(const bf16x8*)(At + trow * VS + fq * 8), af1 = *(const bf16x8*)(At + trow * VS + 32 + fq * 8);
            float sq = 0.f;
#pragma unroll
            for (int vi = 0; vi < 4; ++vi) {
                const int vrow = vh * 64 + vi * 16 + fr;
                gz[vi] = *(const uint2*)(Zc + (size_t)trow * LDZ + GCOL + vh * 64 + vi * 16 + 4 * fq);
                f32x4 acc = f32x4{0.f, 0.f, 0.f, 0.f};
                acc = __builtin_amdgcn_mfma_f32_16x16x32_bf16(*(const bf16x8*)(vt + vrow * VS + fq * 8), af0, acc, 0, 0, 0);
                if (ti >= 2) acc = __builtin_amdgcn_mfma_f32_16x16x32_bf16(*(const bf16x8*)(vt + vrow * VS + 32 + fq * 8), af1, acc, 0, 0, 0);
#pragma unroll
                for (int kk = 0; kk < KS; ++kk)
                    acc = __builtin_amdgcn_mfma_f32_16x16x32_bf16(*(const bf16x8*)(st + vrow * QS + kk * 32 + fq * 8), qh[kk], acc, 0, 0, 0);
                oacc[vi] = acc * scale;
                sq += oacc[vi][0] * oacc[vi][0] + oacc[vi][1] * oacc[vi][1] + oacc[vi][2] * oacc[vi][2] + oacc[vi][3] * oacc[vi][3];
            }
            sq += shx<16>(sq); sq += shx<32>(sq);
            if (fq == 0) ssq[vh * 64 + trow] = sq;
        }
        {
            const int vrow = wave * 16 + fr;
            const bf16x8 vf0 = *(const bf16x8*)(vt + vrow * VS + fq * 8), vf1 = *(const bf16x8*)(vt + vrow * VS + 32 + fq * 8);
#pragma unroll
            for (int kt = 0; kt < KT; ++kt) {
                const float dec = __expf(blast[kt * 16 + fr]);
                sacc[kt][0] *= dec; sacc[kt][1] *= dec; sacc[kt][2] *= dec; sacc[kt][3] *= dec;
                sacc[kt] = __builtin_amdgcn_mfma_f32_16x16x32_bf16(vf0, *(const bf16x8*)(kht + (kt * 16 + fr) * VS + fq * 8), sacc[kt], 0, 0, 0);
                sacc[kt] = __builtin_amdgcn_mfma_f32_16x16x32_bf16(vf1, *(const bf16x8*)(kht + (kt * 16 + fr) * VS + 32 + fq * 8), sacc[kt], 0, 0, 0);
            }
        }
        SCAN_SYNC();
#pragma unroll
        for (int kt = 0; kt < KT; ++kt)
#pragma unroll
            for (int r = 0; r < 4; ++r) st[(wave * 16 + 4 * fq + r) * QS + kt * 16 + fr] = f2bf(sacc[kt][r]);
        {
            const int ti = wave & 3, vh = wave >> 2, trow = ti * 16 + fr;
            const float rstd = rsqrtf((ssq[trow] + ssq[64 + trow]) * (1.f / 128.f) + 1e-6f);
            bf16_t* yrow = (bf16_t*)(p.ws + WS_Y) + (size_t)(b * 2048 + c * 64 + trow) * 1536 + (GLA ? 1024 : 0) + h * 128 + vh * 64 + 4 * fq;
#pragma unroll
            for (int vi = 0; vi < 4; ++vi) {
                const f32x4 g4_ = gn4[vi]; const float4 g4 = make_float4(g4_[0], g4_[1], g4_[2], g4_[3]);
                const float z0 = bflo(gz[vi].x), z1 = bfhi(gz[vi].x), z2 = bflo(gz[vi].y), z3 = bfhi(gz[vi].y);
                uint2 o;
                o.x = pack2(oacc[vi][0] * rstd * g4.x * (z0 * sigm(z0)), oacc[vi][1] * rstd * g4.y * (z1 * sigm(z1)));
                o.y = pack2(oacc[vi][2] * rstd * g4.z * (z2 * sigm(z2)), oacc[vi][3] * rstd * g4.w * (z3 * sigm(z3)));
                *(uint2*)(yrow + vi * 16) = o;
            }
        }
    }
    SCAN_SYNC();
}

__device__ void dsaprep2_item(const Params& p, int l, int item, char* smem_) {
    bf16_t* tile = (bf16_t*)smem_;
    const int tid = TIDX(), lane = tid & 63, wave = tid >> 6;
    bf16_t* Z = (bf16_t*)(p.ws + WS_Z); bf16_t* VT = (bf16_t*)(p.ws + WS_VT);
    {
        const int tb = item * 32;
        {
            const float2 gq = *(const float2*)(p.dsa_qn + l * 128 + lane * 2), gk = *(const float2*)(p.dsa_kn + l * 128 + lane * 2);
            unsigned uu[4][8];
#pragma unroll
            for (int j = 0; j < 4; ++j)
#pragma unroll
                for (int grp = 0; grp < 8; ++grp)
                    uu[j][grp] = *(const unsigned*)(Z + (size_t)(tb + wave + 8 * j) * LDZ + (grp < 4 ? ZB_Q : ZB_K) + (grp & 3) * 128 + lane * 2);
#pragma unroll
            for (int j = 0; j < 4; ++j)
#pragma unroll
                for (int grp = 0; grp < 8; ++grp) {
                    bf16_t* ptr = Z + (size_t)(tb + wave + 8 * j) * LDZ + (grp < 4 ? ZB_Q : ZB_K) + (grp & 3) * 128 + lane * 2;
                    const float a = bflo(uu[j][grp]), b = bfhi(uu[j][grp]);
                    const float ss = wave_sum(a * a + b * b);
                    const float r = rsqrtf(ss * (1.f / 128.f) + 1e-6f) * ((grp < 4) ? 0.08838834764831845f : 1.f);
                    const float2 g = (grp < 4) ? gq : gk;
                    __hip_atomic_store((unsigned*)ptr, pack2(a * r * g.x, b * r * g.y), __ATOMIC_RELAXED, __HIP_MEMORY_SCOPE_AGENT);
                }
        }
        u32x4 uv[4];
#pragma unroll
        for (int i = 0; i < 4; ++i) { const int ch = tid + i * 512; uv[i] = *(const u32x4*)(Z + (size_t)(tb + (ch >> 6)) * LDZ + ZB_V + (ch & 63) * 8); }
#pragma unroll
        for (int i = 0; i < 4; ++i) {
            const int ch = tid + i * 512, t = ch >> 6, c8 = (ch & 63) * 8;
            unsigned* d = (unsigned*)(tile + t * 514 + c8);
            d[0] = uv[i][0]; d[1] = uv[i][1]; d[2] = uv[i][2]; d[3] = uv[i][3];
        }
        __syncthreads();
        {
            const int c = tid, b = tb >> 11, s0 = tb & 2047;
            unsigned w[16];
#pragma unroll
            for (int j = 0; j < 16; ++j) w[j] = (unsigned)tile[(2 * j) * 514 + c] | ((unsigned)tile[(2 * j + 1) * 514 + c] << 16);
            unsigned long long* dst = (unsigned long long*)(VT + ((size_t)(b * 512 + c)) * 2048 + s0);
#pragma unroll
            for (int j = 0; j < 8; ++j) __hip_atomic_store(dst + j, ((unsigned long long)w[2 * j + 1] << 32) | w[2 * j], __ATOMIC_RELAXED, __HIP_MEMORY_SCOPE_AGENT);
        }
        __syncthreads();
    }
}

__device__ void dsa_select_tile(const Params& p, int b, int tq, char* smem_) {
    constexpr int KS_ = 2052;
    unsigned* keyL = (unsigned*)smem_;
    const int tid = TIDX(), lane = tid & 63, wave = __builtin_amdgcn_readfirstlane(tid >> 6), fr = lane & 15, fq = lane >> 4;
    const bf16_t* Z = (const bf16_t*)(p.ws + WS_Z);
    unsigned long long* BM64 = (unsigned long long*)(p.ws + WS_BM);
    const int t0 = tq * 16;
    {
        const int tl = t0 + fr;
        const size_t trow = (size_t)b * 2048 + tl;
        bf16x8 qf[4][2];
#pragma unroll
        for (int h = 0; h < 4; ++h)
#pragma unroll
            for (int ks = 0; ks < 2; ++ks) qf[h][ks] = *(const bf16x8*)(Z + trow * LDZ + ZB_QI + h * 64 + ks * 32 + fq * 8);
        float w[4];
#pragma unroll
        for (int h = 0; h < 4; ++h) w[h] = bf2f(Z[trow * LDZ + ZB_WI + h]) * 0.5f;
#pragma unroll 4
        for (int kt = wave; kt <= tq; kt += 8) {
            const bf16_t* kr = Z + ((size_t)b * 2048 + kt * 16 + fr) * LDZ + ZB_KI + fq * 8;
            const bf16x8 k0 = *(const bf16x8*)kr, k1 = *(const bf16x8*)(kr + 32);
            f32x4 acc[4];
#pragma unroll
            for (int h = 0; h < 4; ++h) {
                acc[h] = __builtin_amdgcn_mfma_f32_16x16x32_bf16(k0, qf[h][0], f32x4{0.f, 0.f, 0.f, 0.f}, 0, 0, 0);
                acc[h] = __builtin_amdgcn_mfma_f32_16x16x32_bf16(k1, qf[h][1], acc[h], 0, 0, 0);
            }
            u32x4 kk;
#pragma unroll
            for (int r = 0; r < 4; ++r) {
                float sc = w[0] * fmaxf(acc[0][r] * 0.125f, 0.f) + w[1] * fmaxf(acc[1][r] * 0.125f, 0.f) + w[2] * fmaxf(acc[2][r] * 0.125f, 0.f) + w[3] * fmaxf(acc[3][r] * 0.125f, 0.f);
                if (sc == 0.f) sc = 0.f;
                const unsigned u = __float_as_uint(sc);
                const unsigned k = (u & 0x80000000u) ? ~u : (u | 0x80000000u);
                kk[r] = (kt * 16 + 4 * fq + r <= tl) ? k : 0u;
            }
            *(u32x4*)(keyL + fr * KS_ + kt * 16 + 4 * fq) = kk;
        }
    }
    __syncthreads();
    {
        const int nk = (tq + 1) * 16, jmax = (nk + 63) >> 6;
        const int qa = 2 * wave, qb = qa + 1;
        unsigned ka[32], kb[32];
#pragma unroll
        for (int j = 0; j < 32; ++j) {
            const int s = lane + 64 * j;
            ka[j] = (s < nk) ? keyL[qa * KS_ + s] : 0u;
            kb[j] = (s < nk) ? keyL[qb * KS_ + s] : 0u;
        }
        unsigned Ta = 1u, Tb = 1u; int Ca = 2047, Cb = 2047;
        if (t0 >= 256) {
            int na, nb;
            bool da, db;
            {
                int c0 = 0, c1 = 0, c2 = 0, c3 = 0;
#pragma unroll
                for (int j = 0; j < 32; ++j)
                    if (j < jmax) { c0 += (ka[j] >= 0x80000000u); c1 += (ka[j] > 0x80000000u); c2 += (kb[j] >= 0x80000000u); c3 += (kb[j] > 0x80000000u); }
                c0 = wave_total_i(c0); c1 = wave_total_i(c1); c2 = wave_total_i(c2); c3 = wave_total_i(c3);
                da = (c1 < 256 && c0 >= 256); db = (c3 < 256 && c2 >= 256);
                Ta = da ? 0x80000000u : ((c0 >= 256) ? 0x80000000u : 0u); na = da ? c0 : ((c0 >= 256) ? c0 : 0x7fffffff);
                Tb = db ? 0x80000000u : ((c2 >= 256) ? 0x80000000u : 0u); nb = db ? c2 : ((c2 >= 256) ? c2 : 0x7fffffff);
            }
            for (int bit = 30; bit >= 0; --bit) {
                if (da && db) break;
                const unsigned ca_ = Ta | (1u << bit), cb_ = Tb | (1u << bit);
                int c0 = 0, c1 = 0;
#pragma unroll
                for (int j = 0; j < 32; ++j)
                    if (j < jmax) { c0 += (ka[j] >= ca_); c1 += (kb[j] >= cb_); }
                c0 = wave_total_i(c0); c1 = wave_total_i(c1);
                if (!da && c0 >= 256) { Ta = ca_; na = c0; }
                if (!db && c1 >= 256) { Tb = cb_; nb = c1; }
                da = da || (na == 256); db = db || (nb == 256);
            }
            if (na != 256 || nb != 256) {
                int needa, needb;
                {
                    int c0 = 0, c1 = 0;
#pragma unroll
                    for (int j = 0; j < 32; ++j)
                        if (j < jmax) { c0 += (ka[j] > Ta); c1 += (kb[j] > Tb); }
                    needa = 256 - wave_total_i(c0); needb = 256 - wave_total_i(c1);
                }
                Ca = 0; Cb = 0;
                for (int bit = 10; bit >= 0; --bit) {
                    const int ca_ = Ca | (1 << bit), cb_ = Cb | (1 << bit);
                    int c0 = 0, c1 = 0;
#pragma unroll
                    for (int j = 0; j < 32; ++j)
                        if (j < jmax) { const int s = lane + 64 * j; c0 += (ka[j] == Ta && s < ca_); c1 += (kb[j] == Tb && s < cb_); }
                    c0 = wave_total_i(c0); c1 = wave_total_i(c1);
                    if (c0 < needa) Ca = ca_;
                    if (c1 < needb) Cb = cb_;
                }
            }
        }
        const size_t rowa = (size_t)b * 2048 + t0 + qa;
#pragma unroll
        for (int j = 0; j < 32; ++j) {
            const int s = lane + 64 * j;
            const unsigned long long ma = __ballot((ka[j] > Ta) || (ka[j] == Ta && s <= Ca));
            const unsigned long long mb = __ballot((kb[j] > Tb) || (kb[j] == Tb && s <= Cb));
            if (lane == 0) {
                __hip_atomic_store(&BM64[rowa * 32 + j], ma, __ATOMIC_RELAXED, __HIP_MEMORY_SCOPE_AGENT);
                __hip_atomic_store(&BM64[(rowa + 1) * 32 + j], mb, __ATOMIC_RELAXED, __HIP_MEMORY_SCOPE_AGENT);
            }
        }
    }
    __syncthreads();
}

__device__ void dsa_attn_item(const Params& p, int b, int h, int qg, char* smem_) {
    constexpr int KSTR = 136, VSTR = 40;
    bf16_t* Kl = (bf16_t*)smem_;
    bf16_t* Vl = Kl + 2 * 32 * KSTR;
    const int tid = TIDX(), lane = tid & 63, wave = __builtin_amdgcn_readfirstlane(tid >> 6), fr = lane & 15, fq = lane >> 4;
    const bf16_t* Z = (const bf16_t*)(p.ws + WS_Z); const bf16_t* VT = (const bf16_t*)(p.ws + WS_VT);
    const unsigned* BM = (const unsigned*)(p.ws + WS_BM); bf16_t* Y = (bf16_t*)(p.ws + WS_Y);
    const int kr = tid >> 4, kc = tid & 15, vd = tid >> 2, vc = tid & 3;
    const int ka_row = 8 * (fr >> 2) + (fr & 3);
    {
        const int t0 = qg * 128 + wave * 16;
        const size_t trow = (size_t)b * 2048 + t0 + fr;
        bf16x8 qf[4];
#pragma unroll
        for (int ks = 0; ks < 4; ++ks) qf[ks] = *(const bf16x8*)(Z + trow * LDZ + ZB_Q + h * 128 + ks * 32 + fq * 8);
        f32x4 o[8];
#pragma unroll
        for (int i = 0; i < 8; ++i) o[i] = f32x4{0.f, 0.f, 0.f, 0.f};
        float m = -INFINITY, lsum = 0.f;
        const unsigned* bmrow = BM + trow * 64;
        const int nsteps_blk = qg * 4 + 4, nsteps_w = (t0 + 15) / 32 + 1;
        const bf16_t* kg = Z + ((size_t)b * 2048 + kr) * LDZ + ZB_K + h * 128 + kc * 8;
        const bf16_t* vg = VT + ((size_t)(b * 4 + h) * 128 + vd) * 2048 + vc * 8;
        u32x4 rk = *(const u32x4*)kg, rv = *(const u32x4*)vg;
        *(u32x4*)(Kl + kr * KSTR + kc * 8) = rk; *(u32x4*)(Vl + vd * VSTR + vc * 8) = rv;
        __syncthreads();
        unsigned mwn = bmrow[0];
        for (int st = 0; st < nsteps_blk; ++st) {
            const bool more = (st + 1 < nsteps_blk);
            const unsigned mwc = mwn;
            mwn = bmrow[(st + 1 < nsteps_w) ? st + 1 : st];
            if (more) { rk = *(const u32x4*)(kg + (size_t)(st + 1) * 32 * LDZ); rv = *(const u32x4*)(vg + (st + 1) * 32); }
            if (st < nsteps_w) {
                const bf16_t* Kb = Kl + (st & 1) * 32 * KSTR; const bf16_t* Vb = Vl + (st & 1) * 128 * VSTR;
                f32x4 sa = f32x4{0.f, 0.f, 0.f, 0.f}, sb = f32x4{0.f, 0.f, 0.f, 0.f};
#pragma unroll
                for (int ks = 0; ks < 4; ++ks) {
                    const bf16x8 fa = *(const bf16x8*)(Kb + ka_row * KSTR + ks * 32 + fq * 8), fb = *(const bf16x8*)(Kb + (ka_row + 4) * KSTR + ks * 32 + fq * 8);
                    sa = __builtin_amdgcn_mfma_f32_16x16x32_bf16(fa, qf[ks], sa, 0, 0, 0);
                    sb = __builtin_amdgcn_mfma_f32_16x16x32_bf16(fb, qf[ks], sb, 0, 0, 0);
                }
                const unsigned mw = mwc >> (8 * fq);
                float x[8];
#pragma unroll
                for (int r = 0; r < 4; ++r) { x[r] = ((mw >> r) & 1u) ? sa[r] : -INFINITY; x[4 + r] = ((mw >> (4 + r)) & 1u) ? sb[r] : -INFINITY; }
                float mx = fmaxf(fmaxf(fmaxf(x[0], x[1]), fmaxf(x[2], x[3])), fmaxf(fmaxf(x[4], x[5]), fmaxf(x[6], x[7])));
                mx = fmaxf(mx, shx<16>(mx)); mx = fmaxf(mx, shx<32>(mx));
                const float mnew = fmaxf(m, mx);
                const float msafe = (mnew == -INFINITY) ? 0.f : mnew;
                const float alpha = __expf(m - msafe);
                float pe[8]; float ps = 0.f;
#pragma unroll
                for (int j = 0; j < 8; ++j) { pe[j] = __expf(x[j] - msafe); ps += pe[j]; }
                lsum = lsum * alpha + ps;
                m = mnew;
#pragma unroll
                for (int i = 0; i < 8; ++i) { o[i][0] *= alpha; o[i][1] *= alpha; o[i][2] *= alpha; o[i][3] *= alpha; }
                union { bf16x8 v; unsigned u[4]; } pf;
                pf.u[0] = pack2(pe[0], pe[1]); pf.u[1] = pack2(pe[2], pe[3]); pf.u[2] = pack2(pe[4], pe[5]); pf.u[3] = pack2(pe[6], pe[7]);
#pragma unroll
                for (int i = 0; i < 8; ++i) {
                    const bf16x8 vf = *(const bf16x8*)(Vb + (i * 16 + fr) * VSTR + fq * 8);
                    o[i] = __builtin_amdgcn_mfma_f32_16x16x32_bf16(vf, pf.v, o[i], 0, 0, 0);
                }
            }
            if (more) { *(u32x4*)(Kl + ((st + 1) & 1) * 32 * KSTR + kr * KSTR + kc * 8) = rk; *(u32x4*)(Vl + ((st + 1) & 1) * 128 * VSTR + vd * VSTR + vc * 8) = rv; }
            __syncthreads();
        }
        lsum += shx<16>(lsum); lsum += shx<32>(lsum);
        const float inv = 1.f / lsum;
#pragma unroll
        for (int i = 0; i < 8; ++i) {
            uint2 ov; ov.x = pack2(o[i][0] * inv, o[i][1] * inv); ov.y = pack2(o[i][2] * inv, o[i][3] * inv);
            *(uint2*)(Y + trow * 1536 + 512 + h * 128 + i * 16 + 4 * fq) = ov;
        }
    }
}

constexpr int LDS_BYTES = 155648;
__device__ void ph_mixA(const Params& p, int l, int vb0, int nvb, char* smem_) {
    for (int item = vb0; item < 64; item += nvb) {
        if (item < 32) scan2_item<128, false>(p, l, item >> 2, item & 3, smem_);
        else scan2_item<64, true>(p, l, (item - 32) >> 2, (item - 32) & 3, smem_);
    }
    unsigned* ctr = (unsigned*)(p.ws + WS_CTL) + 3584 + l * 64;
    unsigned* done = (unsigned*)(p.ws + WS_CTL) + 5300 + l * 8 * 16;
    volatile int* slot = (volatile int*)(smem_ + LDS_BYTES - 64);
    for (;;) {
        if (TIDX() == 0) *slot = (int)atomicAdd(ctr, 1u);
        __syncthreads();
        const int idx = __builtin_amdgcn_readfirstlane(*slot);
        __syncthreads();
        if (idx >= 2048) break;
        if (idx < 1536) {
            const int b = idx / 192, r = idx % 192;
            if (r < 128) dsa_select_tile(p, b, 127 - r, smem_);
            else dsaprep2_item(p, l, b * 64 + (r - 128), smem_);
            asm volatile("s_waitcnt vmcnt(0)" ::: "memory");
            __syncthreads();
            if (TIDX() == 0) __hip_atomic_fetch_add(done + b * 16, 1u, __ATOMIC_RELAXED, __HIP_MEMORY_SCOPE_AGENT);
        } else {
            const int a = idx - 1536, b = a >> 6, h = (a >> 4) & 3, qg = 15 - (a & 15);
            if (TIDX() == 0) {
                unsigned spins = 0;
                while (__hip_atomic_load(done + b * 16, __ATOMIC_RELAXED, __HIP_MEMORY_SCOPE_AGENT) < 192u) { __builtin_amdgcn_s_sleep(2); if (++spins > (1u << 18)) break; }
                __builtin_amdgcn_fence(__ATOMIC_ACQUIRE, "agent");
                asm volatile("s_waitcnt vmcnt(0)" ::: "memory");
            }
            __syncthreads();
            dsa_attn_item(p, b, h, qg, smem_);
        }
    }
}

__device__ __forceinline__ int f2sort(float f) { int i = __float_as_int(f); return i ^ ((i >> 31) & 0x7fffffff); }
__device__ __forceinline__ float sort2f(int i) { return __int_as_float(i ^ ((i >> 31) & 0x7fffffff)); }
#define INSK(K, xv) do { int _x = (xv); \
    _Pragma("unroll") for (int _j = 0; _j < 16; ++_j) { int _hi = max(K[_j], _x); _x = min(K[_j], _x); K[_j] = _hi; } } while (0)
#define INS64(K, xv) do { unsigned long long _x = (xv); \
    _Pragma("unroll") for (int _j = 0; _j < 16; ++_j) { bool _c = _x > K[_j]; unsigned long long _o = K[_j]; K[_j] = _c ? _x : _o; _x = _c ? _o : _x; } } while (0)

__device__ void ph_route(const Params& p, int vb0, int nvb, char* smem_) {
    typedef _Float16 h8 __attribute__((ext_vector_type(8)));
    const _Float16* SC = (const _Float16*)(p.ws + WS_SC);
    int* RI = (int*)(p.ws + WS_RI); float* RG = (float*)(p.ws + WS_RG);
    const int tid = TIDX(), lane = tid & 63, wave = tid >> 6;
    _Float16* tile = (_Float16*)smem_ + wave * (64 * 72);
    for (int item0 = (vb0 * 8 + wave) * 64; item0 < T_TOK * 8; item0 += nvb * 8 * 64) {
        const int item = item0 + lane;
        const int t = item >> 3, h = item & 7;
        const _Float16* s0 = SC + (size_t)t * 2048 + h * 256;
        const _Float16* wbase = SC + (size_t)item0 * 256;
        int k0[16], k1[16];
#pragma unroll
        for (int j = 0; j < 16; ++j) { k0[j] = (int)0x80000000; k1[j] = (int)0x80000000; }
#pragma unroll 1
        for (int slab = 0; slab < 4; ++slab) {
            h8 ld[8];
#pragma unroll
            for (int j = 0; j < 4; ++j) {
                const _Float16* src = wbase + (size_t)(16 * j + (lane >> 2)) * 256 + slab * 32 + (lane & 3) * 8;
                ld[j] = *(const h8*)src; ld[4 + j] = *(const h8*)(src + 128);
            }
            __builtin_amdgcn_wave_barrier();
#pragma unroll
            for (int j = 0; j < 4; ++j) {
                _Float16* dst = tile + (16 * j + (lane >> 2)) * 72 + (lane & 3) * 8;
                *(h8*)dst = ld[j]; *(h8*)(dst + 32) = ld[4 + j];
            }
            __builtin_amdgcn_fence(__ATOMIC_RELEASE, "wavefront");
            __builtin_amdgcn_wave_barrier();
            __builtin_amdgcn_fence(__ATOMIC_ACQUIRE, "wavefront");
#pragma unroll 2
            for (int ii = 0; ii < 32; ii += 8) {
                const int i = slab * 32 + ii;
                const h8 a = *(const h8*)(tile + lane * 72 + ii), b = *(const h8*)(tile + lane * 72 + 32 + ii);
#pragma unroll
                for (int e_ = 0; e_ < 8; ++e_) {
                    INSK(k0, (f2sort((float)a[e_]) & ~127) | (127 - i - e_));
                    INSK(k1, (f2sort((float)b[e_]) & ~127) | (127 - i - e_));
                }
            }
            __builtin_amdgcn_wave_barrier();
        }
        float v0[16], v1[16];
#pragma unroll
        for (int j = 0; j < 16; ++j) { k0[j] = 127 - (k0[j] & 127); k1[j] = 127 - (k1[j] & 127); v0[j] = (float)s0[k0[j]]; v1[j] = (float)s0[128 + k1[j]]; }
        unsigned long long ck[16];
#pragma unroll
        for (int j = 0; j < 16; ++j) ck[j] = 0ull;
#pragma unroll
        for (int a = 0; a < 16; ++a)
#pragma unroll
            for (int b = 0; b < 16; ++b)
                if ((a + 1) * (b + 1) <= 16) {
                    unsigned hi = (unsigned)f2sort(v0[a] + v1[b]) ^ 0x80000000u;
                    unsigned lo = ((unsigned)(255 - (a * 16 + b)) << 16) | (unsigned)(k0[a] * 128 + k1[b]);
                    INS64(ck, ((unsigned long long)hi << 32) | lo);
                }
        float e[16]; float sm = 0.f;
        const float mx = sort2f((int)((unsigned)(ck[0] >> 32) ^ 0x80000000u));
#pragma unroll
        for (int j = 0; j < 16; ++j) { e[j] = expf(sort2f((int)((unsigned)(ck[j] >> 32) ^ 0x80000000u)) - mx); sm += e[j]; }
        const float inv = 1.f / sm;
#pragma unroll
        for (int j = 0; j < 16; j += 4) {
            *(int4*)(RI + (size_t)t * 128 + h * 16 + j) = make_int4((int)(ck[j] & 0xffffu), (int)(ck[j + 1] & 0xffffu), (int)(ck[j + 2] & 0xffffu), (int)(ck[j + 3] & 0xffffu));
            *(float4*)(RG + (size_t)t * 128 + h * 16 + j) = make_float4(e[j] * inv, e[j + 1] * inv, e[j + 2] * inv, e[j + 3] * inv);
        }
    }
}

__device__ __forceinline__ void fp8x16_to_f32(const uint4 q, float (&f)[16]) {
    const unsigned w[4] = {q.x, q.y, q.z, q.w};
#pragma unroll
    for (int c = 0; c < 4; ++c) {
        auto f0 = __builtin_amdgcn_cvt_pk_f32_fp8((int)w[c], false); auto f1 = __builtin_amdgcn_cvt_pk_f32_fp8((int)w[c], true);
        f[4 * c] = f0[0]; f[4 * c + 1] = f0[1]; f[4 * c + 2] = f1[0]; f[4 * c + 3] = f1[1];
    }
}
typedef float f32x2_t __attribute__((ext_vector_type(2)));
__device__ __forceinline__ float g1_half(const u32x4 (&uq)[8], const float (&hv)[16], int lane) {
    float part[8];
#pragma unroll
    for (int it = 0; it < 8; ++it) {
        f32x2_t d2 = {0.f, 0.f};
#pragma unroll
        for (int c_ = 0; c_ < 4; ++c_) {
            const f32x2_t f0 = __builtin_amdgcn_cvt_pk_f32_fp8((int)uq[it][c_], false), f1 = __builtin_amdgcn_cvt_pk_f32_fp8((int)uq[it][c_], true);
            d2 = __builtin_elementwise_fma(f32x2_t{hv[4 * c_], hv[4 * c_ + 1]}, f0, d2);
            d2 = __builtin_elementwise_fma(f32x2_t{hv[4 * c_ + 2], hv[4 * c_ + 3]}, f1, d2);
        }
        part[it] = d2[0] + d2[1];
    }
    float r4[4], r2[2];
    const bool b2_ = lane & 4, b1_ = lane & 2, b0_ = lane & 1;
#pragma unroll
    for (int j = 0; j < 4; ++j) { const float snd = b2_ ? part[j] : part[j + 4], kp = b2_ ? part[j + 4] : part[j]; r4[j] = kp + shx<4>(snd); }
#pragma unroll
    for (int j = 0; j < 2; ++j) { const float snd = b1_ ? r4[j] : r4[j + 2], kp = b1_ ? r4[j + 2] : r4[j]; r2[j] = kp + shx<2>(snd); }
    const float snd = b0_ ? r2[0] : r2[1], kp = b0_ ? r2[1] : r2[0];
    return kp + shx<1>(snd);
}
__device__ __forceinline__ void peer_gather8(u32x4 (&q)[8], const unsigned char* tab, const int* idx, unsigned l16) {
#pragma unroll
    for (int it = 0; it < 8; ++it) { const unsigned e_ = (unsigned)idx[it * 8]; q[it] = *(const u32x4*)(tab + ((e_ << 7) | l16)); }
}
template <bool PRE>
__device__ __forceinline__ void g1_step(int i, int t, const bf16_t* hrow_next, const unsigned char* ub, const int* lri_eg, unsigned l16, int lane, float* pp_row,
                                        u32x4& hq0, u32x4& hq1, u32x4 (&uqA)[8], u32x4 (&uqB)[8]) {
    float hv[16];
#pragma unroll
    for (int c_ = 0; c_ < 4; ++c_) { hv[2 * c_] = bflo(hq0[c_]); hv[2 * c_ + 1] = bfhi(hq0[c_]); hv[8 + 2 * c_] = bflo(hq1[c_]); hv[8 + 2 * c_ + 1] = bfhi(hq1[c_]); }
    if (PRE) { const u32x4* hp = (const u32x4*)hrow_next; hq0 = hp[0]; hq1 = hp[1]; }
    const float d0 = g1_half(uqA, hv, lane);
    __builtin_amdgcn_sched_barrier(0);
    if (PRE) { peer_gather8(uqA, ub, lri_eg + (i + 1) * 128, l16); __builtin_amdgcn_sched_barrier(0); }
    const float d1 = g1_half(uqB, hv, lane);
    __builtin_amdgcn_sched_barrier(0);
    if (PRE) { peer_gather8(uqB, ub, lri_eg + (i + 1) * 128 + 64, l16); __builtin_amdgcn_sched_barrier(0); }
    pp_row[0] = d0; pp_row[64] = d1;
}
template <bool PRE>
__device__ __forceinline__ void g2_step(int i, float2* op, const float2 gf, const unsigned char* vb_, const int* lri_eg, const float* lrg_eg, unsigned l16, int lane,
                                        u32x4 (&vqA)[8], u32x4 (&vqB)[8]) {
    const float2 xi = *op;
    f32x2_t y[8];
#pragma unroll
    for (int j = 0; j < 8; ++j) y[j] = f32x2_t{0.f, 0.f};
#pragma unroll
    for (int it = 0; it < 8; ++it) {
        const float ck = lrg_eg[i * 128 + it * 8]; const f32x2_t ck2 = {ck, ck};
#pragma unroll
        for (int c_ = 0; c_ < 4; ++c_) {
            y[2 * c_] = __builtin_elementwise_fma(ck2, __builtin_amdgcn_cvt_pk_f32_fp8((int)vqA[it][c_], false), y[2 * c_]);
            y[2 * c_ + 1] = __builtin_elementwise_fma(ck2, __builtin_amdgcn_cvt_pk_f32_fp8((int)vqA[it][c_], true), y[2 * c_ + 1]);
        }
    }
    __builtin_amdgcn_sched_barrier(0);
    if (PRE) { peer_gather8(vqA, vb_, lri_eg + (i + 1) * 128, l16); __builtin_amdgcn_sched_barrier(0); }
#pragma unroll
    for (int it = 0; it < 8; ++it) {
        const float ck = lrg_eg[i * 128 + 64 + it * 8]; const f32x2_t ck2 = {ck, ck};
#pragma unroll
        for (int c_ = 0; c_ < 4; ++c_) {
            y[2 * c_] = __builtin_elementwise_fma(ck2, __builtin_amdgcn_cvt_pk_f32_fp8((int)vqB[it][c_], false), y[2 * c_]);
            y[2 * c_ + 1] = __builtin_elementwise_fma(ck2, __builtin_amdgcn_cvt_pk_f32_fp8((int)vqB[it][c_], true), y[2 * c_ + 1]);
        }
    }
    __builtin_amdgcn_sched_barrier(0);
    if (PRE) { peer_gather8(vqB, vb_, lri_eg + (i + 1) * 128 + 64, l16); __builtin_amdgcn_sched_barrier(0); }
    float r8[8], r4[4], r2[2];
    const bool b5 = lane & 32, b4 = lane & 16, b3 = lane & 8;
#pragma unroll
    for (int j = 0; j < 8; ++j) { const float lo = y[j >> 1][j & 1], hi = y[4 + (j >> 1)][j & 1]; const float snd = b5 ? lo : hi, kp = b5 ? hi : lo; r8[j] = kp + shx<32>(snd); }
#pragma unroll
    for (int j = 0; j < 4; ++j) { const float snd = b4 ? r8[j] : r8[j + 4], kp = b4 ? r8[j + 4] : r8[j]; r4[j] = kp + shx<16>(snd); }
#pragma unroll
    for (int j = 0; j < 2; ++j) { const float snd = b3 ? r4[j] : r4[j + 2], kp = b3 ? r4[j + 2] : r4[j]; r2[j] = kp + shx<8>(snd); }
    *op = make_float2(xi.x + gf.x * r2[0], xi.y + gf.y * r2[1]);
}
template <int WHICH>
__device__ void ph_peer_sliced(const Params& p, int l, char* smem_) {
    const int tid = TIDX(), wave = tid >> 6;
    const bf16_t* H = (const bf16_t*)(p.ws + WS_H); const unsigned char* PU = p.ws + WS_PU; const unsigned char* PV = p.ws + WS_PV;
    const int* RI = (const int*)(p.ws + WS_RI); float* RG = (float*)(p.ws + WS_RG); float* PP = (float*)(p.ws + WS_PP);
    const float* modb = (const float*)(p.ws + WS_MOD);
    {
    unsigned* ctr = (unsigned*)(p.ws + WS_CTL) + 3712 + (l * 2 + WHICH) * 128;
    volatile int* slot = (volatile int*)(smem_ + LDS_BYTES - 64);
    const int xcc = (int)(xb_xcc_id() & 7u);
    for (int so = 0; so < 8; ++so) {
        const int x = (xcc + so) & 7;
        for (;;) {
            if (tid == 0) *slot = (int)atomicAdd(ctr + x * 16, 1u);
            __syncthreads();
            const int chunk = __builtin_amdgcn_readfirstlane(*slot);
            __syncthreads();
            if (chunk >= 256) break;
            {
                const int lane = lane_id_opaque(), eg = lane >> 3, ll = lane & 7;
                const int tb = chunk * 64 + wave * 8;
                int* lri = (int*)smem_ + wave * 2048; float* lrg = (float*)(lri + 1024);
                {
                    int ra[16]; float rg_[16];
#pragma unroll
                    for (int i = 0; i < 8; ++i) {
                        ra[2 * i] = RI[(size_t)(tb + i) * 128 + lane]; ra[2 * i + 1] = RI[(size_t)(tb + i) * 128 + 64 + lane];
                        if (WHICH == 1) { rg_[2 * i] = RG[(size_t)(tb + i) * 128 + lane]; rg_[2 * i + 1] = RG[(size_t)(tb + i) * 128 + 64 + lane]; }
                    }
#pragma unroll
                    for (int i = 0; i < 8; ++i) {
                        lri[i * 128 + lane] = ra[2 * i]; lri[i * 128 + 64 + lane] = ra[2 * i + 1];
                        if (WHICH == 1) { lrg[i * 128 + lane] = rg_[2 * i]; lrg[i * 128 + 64 + lane] = rg_[2 * i + 1]; }
                    }
                }
                __builtin_amdgcn_fence(__ATOMIC_RELEASE, "wavefront");
                __builtin_amdgcn_wave_barrier();
                __builtin_amdgcn_fence(__ATOMIC_ACQUIRE, "wavefront");
                const unsigned l16 = (unsigned)ll * 16u;
                if (WHICH == 0) {
                    const unsigned char* ub = PU + (size_t)x * (16384u * 128u);
                    const bf16_t* hrow = H + (size_t)tb * 1024 + x * 128 + ll * 16;
                    float* pp_row = PP + ((size_t)x * T_TOK + tb) * 128 + ll * 8 + eg;
                    u32x4 hq0 = ((const u32x4*)hrow)[0], hq1 = ((const u32x4*)hrow)[1], uqA[8], uqB[8];
                    peer_gather8(uqA, ub, lri + eg, l16);
                    peer_gather8(uqB, ub, lri + eg + 64, l16);
#pragma unroll 1
                    for (int i = 0; i < 7; ++i) g1_step<true>(i, tb + i, hrow + (size_t)(i + 1) * 1024, ub, lri + eg, l16, lane, pp_row + (size_t)i * 128, hq0, hq1, uqA, uqB);
                    g1_step<false>(7, tb + 7, hrow, ub, lri + eg, l16, lane, pp_row + (size_t)7 * 128, hq0, hq1, uqA, uqB);
                } else {
                    const unsigned char* vb_ = PV + (size_t)x * (16384u * 128u);
                    const int col = x * 128 + ll * 16 + ((lane >> 5) & 1) * 8 + ((lane >> 4) & 1) * 4 + ((lane >> 3) & 1) * 2;
                    const float2 gf = *(const float2*)(modb + (size_t)(l * 8 + (tb >> 11)) * 6144 + 5120 + col);
                    float2* op = (float2*)(p.out + (size_t)tb * 1024 + col);
                    u32x4 vqA[8], vqB[8];
                    peer_gather8(vqA, vb_, lri + eg, l16);
                    peer_gather8(vqB, vb_, lri + eg + 64, l16);
#pragma unroll 1
                    for (int i = 0; i < 7; ++i) g2_step<true>(i, op + (size_t)i * 512, gf, vb_, lri + eg, lrg + eg, l16, lane, vqA, vqB);
                    g2_step<false>(7, op + (size_t)7 * 512, gf, vb_, lri + eg, lrg + eg, l16, lane, vqA, vqB);
                }
            }
        }
    }
    __syncthreads();
    }
}
__device__ void ph_peer_coef(const Params& p, int vb0, int nvb) {
    const int wave = TIDX() >> 6, lane = TIDX() & 63;
    float* RG = (float*)(p.ws + WS_RG); const float* PP = (const float*)(p.ws + WS_PP);
    for (int t0 = (vb0 * 8 + wave) * 2; t0 < T_TOK; t0 += nvb * 8 * 2) {
        float pp[2][2][8], g[2][2];
#pragma unroll
        for (int u = 0; u < 2; ++u)
#pragma unroll
            for (int half = 0; half < 2; ++half) {
                const int k = half * 64 + lane;
#pragma unroll
                for (int x = 0; x < 8; ++x) pp[u][half][x] = PP[((size_t)x * T_TOK + t0 + u) * 128 + k];
                g[u][half] = RG[(size_t)(t0 + u) * 128 + k];
            }
        asm volatile("" ::: "memory");
#pragma unroll
        for (int u = 0; u < 2; ++u)
#pragma unroll
            for (int half = 0; half < 2; ++half) {
                float d = 0.f;
#pragma unroll
                for (int x = 0; x < 8; ++x) d += pp[u][half][x];
                d *= (1.f / PU_SCALE);
                RG[(size_t)(t0 + u) * 128 + half * 64 + lane] = g[u][half] * 0.5f * d * (1.f + erff(d * 0.7071067811865476f)) * (1.f / PV_SCALE);
            }
    }
}

enum { PH_MOD = 0, PH_WPREP, PH_NORM1, PH_GEMM_IN, PH_SCAN, PH_MERGE, PH_OUT, PH_NORM2, PH_GEMM_Q, PH_GEMM_SC, PH_ROUTE, PH_G1, PH_G15, PH_G2 };

template <int PH>
__device__ __forceinline__ void run_phase(const Params& p, int l, int vb0, int nvb, char* smem) {
    const float* xin = (l == 0) ? p.x : p.out;
    if (PH == PH_MOD) ph_mod(p, vb0, nvb, smem);
    else if (PH == PH_WPREP) ph_wprep(p, l, vb0, nvb, smem);
    else if (PH == PH_NORM1) ph_norm(p, l, 0, xin, vb0, nvb);
    else if (PH == PH_GEMM_IN) {
        pg8::Gemm g{(const bf16_t*)(p.ws + WS_H), (const bf16_t*)(p.ws + WS_WIN), 1024, 1024, 1024};
        pg8::StaticOrder S; S.init(T_TOK, LDZ, nvb, vb0, 1024, 1024);
        pg8::gemm_phase(( PG8_LAS unsigned char*)smem, g, S, pg8::EpiBf16{(bf16_t*)(p.ws + WS_Z), LDZ}, TIDX());
    }
    else if (PH == PH_SCAN) ph_mixA(p, l, vb0, nvb, smem);
    else if (PH == PH_MERGE) {
        pg8::Gemm g{(const bf16_t*)(p.ws + WS_Y), (const bf16_t*)(p.ws + WS_WBR), 1536, 512, 512};
        pg8::MergeOrder S{vb0, nvb};
        pg8::gemm_phase((PG8_LAS unsigned char*)smem, g, S, pg8::EpiMerge{(bf16_t*)(p.ws + WS_H), (const bf16_t*)(p.ws + WS_Z)}, TIDX());
    }
    else if (PH == PH_OUT) {
        pg8::Gemm g{(const bf16_t*)(p.ws + WS_H), (const bf16_t*)(p.ws + WS_WOUT), 1024, 1024, 1024};
        pg8::StaticOrder S; S.init(T_TOK, 1024, nvb, vb0, 1024, 1024);
        pg8::gemm_phase((PG8_LAS unsigned char*)smem, g, S, pg8::EpiResid{xin, p.out, (const float*)(p.ws + WS_MOD) + (size_t)l * 8 * 6144}, TIDX());
    }
    else if (PH == PH_NORM2) ph_norm(p, l, 1, p.out, vb0, nvb);
    else if (PH == PH_GEMM_Q) {
        pg8::Gemm g{(const bf16_t*)(p.ws + WS_H), (const bf16_t*)(p.ws + WS_WQ), 1024, 1024, 1024};
        pg8::StaticOrder S; S.init(T_TOK, 2048, nvb, vb0, 1024, 1024);
        pg8::gemm_phase((PG8_LAS unsigned char*)smem, g, S, pg8::EpiBf16{(bf16_t*)(p.ws + WS_QP), 2048}, TIDX());
    }
    else if (PH == PH_GEMM_SC) gemm_phase((const bf16_t*)(p.ws + WS_QP), 2048, (const bf16_t*)(p.ws + WS_SK), 128, T_TOK, 2048, 128, true,
                                          EpiF16{(_Float16*)(p.ws + WS_SC), 2048}, vb0, nvb, smem, TIDX());
    else if (PH == PH_ROUTE) ph_route(p, vb0, nvb, smem);
    else if (PH == PH_G1) ph_peer_sliced<0>(p, l, smem);
    else if (PH == PH_G15) ph_peer_coef(p, vb0, nvb);
    else if (PH == PH_G2) ph_peer_sliced<1>(p, l, smem);

}

#define XB_TMO      128
#define XB_XCNT(j)  (256  + 64 * (j))
#define XB_XSUB(j)  (1280 + 64 * (j))
#define XB_XGEN(j)  (2304 + 64 * (j))
#define XB_TOP      3328
#define XB_TOPGEN   3392
#define XCD_BAR_WORDS 3456
#define XB_SPIN_CAP (1u << 18)
#define LAS __attribute__((address_space(3)))
__device__ __forceinline__ unsigned xb_ld(unsigned* p)              { return __hip_atomic_load(p, __ATOMIC_RELAXED, __HIP_MEMORY_SCOPE_AGENT); }
__device__ __forceinline__ unsigned xb_add(unsigned* p, unsigned v) { return __hip_atomic_fetch_add(p, v, __ATOMIC_RELAXED, __HIP_MEMORY_SCOPE_AGENT); }
#define XB_SPIN(cond, bar) do { unsigned _sp = 0; while (cond) { __builtin_amdgcn_s_sleep(1); \
    if ((++_sp & 255u) == 0u) { if (xb_ld(&(bar)[XB_TMO])) break; if (_sp > XB_SPIN_CAP) { atomicAdd(&(bar)[XB_TMO], 1u); break; } } } } while (0)
struct XcdBarrier { unsigned* bar; unsigned x; volatile LAS unsigned* st; int wv; };
__device__ __forceinline__ XcdBarrier xcd_barrier_post(unsigned* bar, volatile LAS unsigned* st, int wv) {
    XcdBarrier b; b.bar = bar; b.x = xb_xcc_id(); b.st = st; b.wv = wv;
    if (TIDXW(wv) == 0) (void)xb_add(&bar[XB_XCNT(b.x)], 1u);
    return b;
}
__device__ __forceinline__ void xcd_barrier_complete(unsigned* bar, unsigned x, unsigned& nloc, unsigned& nx) {
    const unsigned G = gridDim.x * gridDim.y * gridDim.z;
    unsigned sum, cnt, mine, sp = 0u;
    for (;;) {
        sum = 0u; cnt = 0u; mine = 0u;
#pragma unroll
        for (unsigned j = 0; j < 16; ++j) { const unsigned c = xb_ld(&bar[XB_XCNT(j)]); sum += c; cnt += (c > 0u) ? 1u : 0u; mine = (j == x) ? c : mine; }
        if (sum == G) break;
        __builtin_amdgcn_s_sleep(1);
        if ((++sp & 255u) == 0u) { if (xb_ld(&bar[XB_TMO])) break; if (sp > XB_SPIN_CAP) { atomicAdd(&bar[XB_TMO], 1u); break; } }
    }
    nloc = mine > 0u ? mine : 1u; nx = cnt > 0u ? cnt : 1u;
}
__device__ __forceinline__ void xcd_barrier(const XcdBarrier& b) {
    asm volatile("s_waitcnt vmcnt(0)" ::: "memory");
    __syncthreads();
    if (TIDXW(b.wv) == 0) {
        unsigned* bar = b.bar;
        __builtin_amdgcn_s_waitcnt(0);
        unsigned nloc = b.st[0], nx = b.st[1];
        if (nloc == 0u) { xcd_barrier_complete(bar, b.x, nloc, nx); b.st[0] = nloc; b.st[1] = nx; }
        const unsigned old = xb_add(&bar[XB_XSUB(b.x)], 1u);
        const unsigned gen = old / nloc;
        if (old + 1u == (gen + 1u) * nloc) {
            __builtin_amdgcn_fence(__ATOMIC_RELEASE, "agent");
            asm volatile("s_waitcnt vmcnt(0)" ::: "memory");
            const unsigned og = xb_add(&bar[XB_TOP], 1u);
            const unsigned tg = og / nx;
            if (og + 1u == (tg + 1u) * nx) xb_add(&bar[XB_TOPGEN], 1u);
            else XB_SPIN(xb_ld(&bar[XB_TOPGEN]) == tg, bar);
            __builtin_amdgcn_fence(__ATOMIC_ACQUIRE, "agent");
            xb_add(&bar[XB_XGEN(b.x)], 1u);
            asm volatile("s_waitcnt vmcnt(0)" ::: "memory");
        } else {
            XB_SPIN(xb_ld(&bar[XB_XGEN(b.x)]) == gen, bar);
            __builtin_amdgcn_fence(__ATOMIC_ACQUIRE, "agent");
            asm volatile("s_waitcnt vmcnt(0)" ::: "memory");
        }
    }
    __syncthreads();
}

__global__ void __launch_bounds__(NT) mega_kernel(Params p_in) {
#if defined(__HIP_DEVICE_COMPILE__)
    extern __shared__ __attribute__((aligned(16))) char smem[];
    volatile LAS unsigned* st = (volatile LAS unsigned*)(smem + LDS_BYTES - 16);
    int wv_ = __builtin_amdgcn_readfirstlane((int)threadIdx.x >> 6); asm volatile("" : "+s"(wv_));
    { const int t_ = TIDXW(wv_); if (t_ < 4) st[t_] = 0u; }
    __syncthreads();
    XcdBarrier bar = xcd_barrier_post((unsigned*)(p_in.ws + WS_CTL), st, wv_);
    const int vb = (int)blockIdx.x, nvb = (int)gridDim.x;
#define GB() xcd_barrier(bar)
#define RUN(PH, L) do { \
        const __attribute__((address_space(4))) Params* _kp = (const __attribute__((address_space(4))) Params*)__builtin_amdgcn_kernarg_segment_ptr(); asm volatile("" : "+s"(_kp)); Params _p = *_kp; _p.wv = wv_; \
        int _l = (L), _vb = vb, _nvb = nvb; asm volatile("" : "+s"(_l), "+s"(_vb), "+s"(_nvb)); \
        run_phase<PH>(_p, _l, _vb, _nvb, smem); } while (0)
    RUN(PH_MOD, 0);
#pragma unroll 1
    for (int l = 0; l < 2; ++l) {
        RUN(PH_WPREP, l); if (l == 0) GB();
        RUN(PH_NORM1, l); GB();
        RUN(PH_GEMM_IN, l); GB();
        RUN(PH_SCAN, l); GB();
        RUN(PH_MERGE, l); GB();
        RUN(PH_OUT, l); GB();
        RUN(PH_NORM2, l); GB();
        RUN(PH_GEMM_Q, l); GB();
        RUN(PH_GEMM_SC, l); GB();
        RUN(PH_ROUTE, l); GB();
        RUN(PH_G1, l); GB();
        RUN(PH_G15, l); GB();
        RUN(PH_G2, l);
        if (l == 0) GB();
    }
#undef RUN
#undef GB
#endif
}

extern "C" void kernel_launch(void* const* d_in, const int* in_sizes, int n_in, void* d_out, int out_size, void* d_ws, size_t ws_size,
                              hipStream_t stream) {
    if (n_in != 20 || ws_size < WS_END) { fprintf(stderr, "kernel_launch: bad inputs (n_in %d ws %zu need %zu)\n", n_in, ws_size, (size_t)WS_END); return; }
    Params p{};
    p.x = (const float*)d_in[0]; p.c = (const float*)d_in[1]; p.w_ada = (const float*)d_in[2]; p.b_ada = (const float*)d_in[3];
    p.norm_mix = (const float*)d_in[4]; p.norm_ffn = (const float*)d_in[5]; p.w_in = (const float*)d_in[6]; p.hgrn_lb = (const float*)d_in[7];
    p.hgrn_on = (const float*)d_in[8]; p.dsa_qn = (const float*)d_in[9]; p.dsa_kn = (const float*)d_in[10]; p.gla_up = (const float*)d_in[11];
    p.gla_bias = (const float*)d_in[12]; p.gla_on = (const float*)d_in[13]; p.w_branch = (const float*)d_in[14]; p.w_out = (const float*)d_in[15];
    p.peer_wq = (const float*)d_in[16]; p.peer_keys = (const float*)d_in[17]; p.peer_u = (const float*)d_in[18]; p.peer_v = (const float*)d_in[19];
    p.out = (float*)d_out; p.ws = (unsigned char*)d_ws;
    static int grid = 0;
    if (grid == 0) {
        int dev = 0, cus = 0, per_cu = 0;
        hipGetDevice(&dev);
        hipDeviceGetAttribute(&cus, hipDeviceAttributeMultiprocessorCount, dev);
        hipFuncSetAttribute((const void*)mega_kernel, hipFuncAttributeMaxDynamicSharedMemorySize, LDS_BYTES);
        hipOccupancyMaxActiveBlocksPerMultiprocessor(&per_cu, (const void*)mega_kernel, NT, LDS_BYTES);
        if (per_cu < 1) { fprintf(stderr, "kernel_launch: occupancy query says %d blocks per CU\n", per_cu); per_cu = 1; }
        (void)hipGetLastError();
        grid = cus;
    }
    hipMemsetAsync((char*)d_ws + WS_CTL, 0, 32768, stream);
    void* args[] = {&p};
    hipError_t e = hipLaunchCooperativeKernel((const void*)mega_kernel, dim3(grid), dim3(NT), args, LDS_BYTES, stream);
    if (e != hipSuccess) fprintf(stderr, "cooperative launch failed: %s (grid %d)\n", hipGetErrorString(e), grid);
}
```

```cpp
#include <hip/hip_runtime.h>
#include <stdint.h>
#include <stdio.h>

typedef unsigned short bf16_t;
typedef short bf16x8 __attribute__((ext_vector_type(8)));
typedef float f32x4 __attribute__((ext_vector_type(4)));
typedef unsigned u32x4 __attribute__((ext_vector_type(4)));

#define NT 512
constexpr int T_TOK = 16384, DM = 1024, SEQ = 2048;
constexpr int LDZ = 8704;
constexpr int ZA_Q = 0, ZA_F = 512, ZA_I = 1024, ZA_G = 1536, ZB_Q = 2048, ZB_K = 2560, ZB_V = 3072, ZC_V = 3584, ZC_G = 4096,
              ZB_QI = 4608, ZC_Q = 4864, ZC_K = 5120, ZB_KI = 5376, ZB_WI = 5440, ZC_CODE = 5444, ZM = 5632;
constexpr int IN_COLS = 8532;

constexpr size_t al256(size_t x) { return (x + 255) & ~(size_t)255; }
constexpr size_t WS_CTL = 0;
constexpr size_t WS_MOD = 65536;
constexpr size_t WS_WIN = al256(WS_MOD + (size_t)2 * 8 * 6144 * 4);
constexpr size_t WS_WBR = al256(WS_WIN + (size_t)LDZ * 1024 * 2);
constexpr size_t WS_WOUT = al256(WS_WBR + (size_t)3 * 1024 * 512 * 2);
constexpr size_t WS_WQ = al256(WS_WOUT + (size_t)1024 * 1024 * 2);
constexpr size_t WS_SK = al256(WS_WQ + (size_t)2048 * 1024 * 2);
constexpr size_t WS_PU = al256(WS_SK + (size_t)16 * 128 * 128 * 2);
constexpr size_t WS_PV = al256(WS_PU + (size_t)16384 * 1024);
constexpr size_t WS_H = al256(WS_PV + (size_t)16384 * 1024);
constexpr float PU_SCALE = 32.f, PV_SCALE = 4.f;
constexpr size_t WS_OA = al256(WS_H + (size_t)T_TOK * 1024 * 2);
constexpr size_t WS_OC = al256(WS_OA + (size_t)T_TOK * 512 * 2);
constexpr size_t WS_H8H = WS_OA, WS_H8L = WS_OC;
constexpr size_t WS_Y = al256(WS_OC + (size_t)T_TOK * 512 * 2);
constexpr size_t WS_Z = al256(WS_Y + (size_t)T_TOK * 1536 * 2);
constexpr size_t WS_VT = al256(WS_Z + (size_t)T_TOK * LDZ * 2);
constexpr size_t WS_BM = al256(WS_VT + (size_t)T_TOK * 512 * 2);
constexpr size_t WS_END = al256(WS_BM + (size_t)T_TOK * 64 * 4);
constexpr size_t WS_QP = WS_Z;
constexpr size_t WS_SC = al256(WS_QP + (size_t)T_TOK * 2048 * 2);
constexpr size_t WS_RI = al256(WS_SC + (size_t)T_TOK * 2048 * 4);
constexpr size_t WS_RG = al256(WS_RI + (size_t)T_TOK * 128 * 4);
constexpr size_t WS_PP = al256(WS_RG + (size_t)T_TOK * 128 * 4);
static_assert(WS_PP + (size_t)8 * T_TOK * 128 * 4 <= WS_VT, "peer partials overflow the Z region");
static_assert(WS_RG + (size_t)T_TOK * 128 * 4 <= WS_END, "peer alias overflow");

struct Params {
    const float* x; const float* c; const float* w_ada; const float* b_ada; const float* norm_mix; const float* norm_ffn;
    const float* w_in; const float* hgrn_lb; const float* hgrn_on; const float* dsa_qn; const float* dsa_kn;
    const float* gla_up; const float* gla_bias; const float* gla_on; const float* w_branch; const float* w_out;
    const float* peer_wq; const float* peer_keys; const float* peer_u; const float* peer_v;
    float* out; unsigned char* ws;
    int wv, pad;
};

__device__ __forceinline__ float bf2f(bf16_t h) { return __uint_as_float(((unsigned)h) << 16); }
__device__ __forceinline__ float bflo(unsigned u) { return __uint_as_float(u << 16); }
__device__ __forceinline__ float bfhi(unsigned u) { return __uint_as_float(u & 0xffff0000u); }
__device__ __forceinline__ bf16_t f2bf(float f) { unsigned r; asm volatile("v_cvt_pk_bf16_f32 %0, %1, %1" : "=v"(r) : "v"(f)); return (bf16_t)(r & 0xffffu); }
__device__ __forceinline__ unsigned pack2(float a, float b) { unsigned r; asm volatile("v_cvt_pk_bf16_f32 %0, %1, %2" : "=v"(r) : "v"(a), "v"(b)); return r; }
__device__ __forceinline__ int lane_id_opaque() { int l; asm volatile("v_mbcnt_lo_u32_b32 %0, -1, 0\n\tv_mbcnt_hi_u32_b32 %0, -1, %0" : "=v"(l)); return l; }
template <int M> __device__ __forceinline__ int shx_i(int v) {
    if (M < 32) return __builtin_amdgcn_ds_swizzle(v, (M << 10) | 0x1f);
    return __builtin_amdgcn_ds_bpermute((lane_id_opaque() ^ 32) << 2, v);
}
template <int M> __device__ __forceinline__ float shx(float v) { return __int_as_float(shx_i<M>(__float_as_int(v))); }
template <int M> __device__ __forceinline__ int shx(int v) { return shx_i<M>(v); }
template <int M> __device__ __forceinline__ unsigned shx(unsigned v) { return (unsigned)shx_i<M>((int)v); }
__device__ __forceinline__ int bperm(int v, int src) { return __builtin_amdgcn_ds_bpermute(src << 2, v); }
__device__ __forceinline__ float bperm(float v, int src) { return __int_as_float(__builtin_amdgcn_ds_bpermute(src << 2, __float_as_int(v))); }
__device__ __forceinline__ float wave_sum(float v) { v += shx<32>(v); v += shx<16>(v); v += shx<8>(v); v += shx<4>(v); v += shx<2>(v); v += shx<1>(v); return v; }
__device__ __forceinline__ float wave_max(float v) { v = fmaxf(v, shx<32>(v)); v = fmaxf(v, shx<16>(v)); v = fmaxf(v, shx<8>(v)); v = fmaxf(v, shx<4>(v)); v = fmaxf(v, shx<2>(v)); v = fmaxf(v, shx<1>(v)); return v; }
__device__ __forceinline__ int wave_sum_i(int v) { v += shx<32>(v); v += shx<16>(v); v += shx<8>(v); v += shx<4>(v); v += shx<2>(v); v += shx<1>(v); return v; }
__device__ __forceinline__ int wave_total_i(int v) {
    v += __builtin_amdgcn_update_dpp(0, v, 0x111, 0xf, 0xf, true);
    v += __builtin_amdgcn_update_dpp(0, v, 0x112, 0xf, 0xf, true);
    v += __builtin_amdgcn_update_dpp(0, v, 0x114, 0xf, 0xf, true);
    v += __builtin_amdgcn_update_dpp(0, v, 0x118, 0xf, 0xf, true);
    v += __builtin_amdgcn_update_dpp(0, v, 0x142, 0xa, 0xf, true);
    v += __builtin_amdgcn_update_dpp(0, v, 0x143, 0xc, 0xf, true);
    return __builtin_amdgcn_readlane(v, 63);
}
__device__ __forceinline__ float sigm(float x) { return __frcp_rn(1.f + __expf(-x)); }

__device__ __forceinline__ unsigned xb_xcc_id() { return (unsigned)__builtin_amdgcn_s_getreg((3 << 11) | 20) & 0xFu; }
__device__ __forceinline__ int TIDXW(int wv) { int t; asm volatile("v_mbcnt_lo_u32_b32 %0, -1, 0\n\tv_mbcnt_hi_u32_b32 %0, -1, %0\n\tv_lshl_or_b32 %0, %1, 6, %0" : "=v"(t) : "s"(wv)); return t; }
#define TIDX() TIDXW(p.wv)

__device__ __forceinline__ int src_col(int j) {
    if (j < 3584) return j;
    if (j < 4096) return j - 3584 + 4420;
    if (j < 4608) return j - 4096 + 4948;
    if (j < 4864) return j - 4608 + 3584;
    if (j < 5120) return j - 4864 + 3908;
    if (j < 5376) return j - 5120 + 4164;
    if (j < 5440) return j - 5376 + 3840;
    if (j < 5444) return j - 5440 + 3904;
    if (j < 5460) return j - 5444 + 4932;
    if (j < 5632) return -1;
    return j - 5632 + 5460;
}

__device__ void ph_mod(const Params& p, int vb0, int nvb, char* smem_) {
    float* sc = (float*)smem_;
    float* part = sc + 8 * 1024;
    float* mod = (float*)(p.ws + WS_MOD);
    const int tid = TIDX(), lane = tid & 63, wave = tid >> 6;
    if (vb0 >= 192) return;
    for (int i = tid; i < 8 * 1024; i += NT) { float c = p.c[i]; sc[i] = c / (1.f + __expf(-c)); }
    __syncthreads();
    for (int task = vb0; task < 192; task += nvb) {
        const int l = task / 96, n0 = (task % 96) * 64;
        const float* w = p.w_ada + (size_t)l * 1024 * 6144 + (size_t)(wave * 128) * 6144 + n0 + lane;
        float acc[8];
#pragma unroll
        for (int b = 0; b < 8; ++b) acc[b] = 0.f;
#pragma unroll 1
        for (int k0 = 0; k0 < 128; k0 += 16) {
            float wv[16];
#pragma unroll
            for (int j = 0; j < 16; ++j) wv[j] = w[(size_t)(k0 + j) * 6144];
#pragma unroll
            for (int j = 0; j < 16; ++j)
#pragma unroll
                for (int b = 0; b < 8; ++b) acc[b] += sc[b * 1024 + wave * 128 + k0 + j] * wv[j];
        }
#pragma unroll
        for (int b = 0; b < 8; ++b) part[(wave * 8 + b) * 64 + lane] = acc[b];
        __syncthreads();
        {
            const int b = tid >> 6, col = tid & 63;
            float v = p.b_ada[l * 6144 + n0 + col];
#pragma unroll
            for (int w_ = 0; w_ < 8; ++w_) v += part[(w_ * 8 + b) * 64 + col];
            mod[(size_t)(l * 8 + b) * 6144 + n0 + col] = v;
        }
        __syncthreads();
    }
}

template <bool MAP>
__device__ void tr_tile(const float* __restrict__ src, int lds_, bf16_t* __restrict__ out, int ldo, int k0, int n0, float* tile, const int tid) {
    float lv[8];
    {
        const int nn = tid & 63, scol = MAP ? src_col(n0 + nn) : (n0 + nn);
#pragma unroll
        for (int i = 0; i < 8; ++i) { const int kk = (tid >> 6) + 8 * i; lv[i] = (scol >= 0) ? src[(size_t)(k0 + kk) * lds_ + scol] : 0.f; }
#pragma unroll
        for (int i = 0; i < 8; ++i) { const int kk = (tid >> 6) + 8 * i; tile[kk * 65 + nn] = lv[i]; }
    }
    __syncthreads();
#pragma unroll
    for (int i = 0; i < 4; ++i) {
        int nn = (tid >> 5) + 16 * i, kk = (tid & 31) * 2;
        unsigned v = pack2(tile[kk * 65 + nn], tile[(kk + 1) * 65 + nn]);
        *(unsigned*)(out + (size_t)(n0 + nn) * ldo + k0 + kk) = v;
    }
    __syncthreads();
}
__device__ void conv_chunk(const float* __restrict__ src, bf16_t* __restrict__ dst, size_t base, const int tid) {
    f32x4 la[4], lb[4];
#pragma unroll
    for (int i = 0; i < 4; ++i) { const size_t e = base + (size_t)(i * NT + tid) * 8; la[i] = *(const f32x4*)(src + e); lb[i] = *(const f32x4*)(src + e + 4); }
#pragma unroll
    for (int i = 0; i < 4; ++i) {
        size_t e = base + (size_t)(i * NT + tid) * 8;
        const float4 a = make_float4(la[i][0], la[i][1], la[i][2], la[i][3]), b = make_float4(lb[i][0], lb[i][1], lb[i][2], lb[i][3]);
        uint4 o; o.x = pack2(a.x, a.y); o.y = pack2(a.z, a.w); o.z = pack2(b.x, b.y); o.w = pack2(b.z, b.w);
        *(uint4*)(dst + e) = o;
    }
}
__device__ void conv_chunk_fp8(const float* __restrict__ src, unsigned char* __restrict__ dst, size_t base, float scale, const int tid) {
    f32x4 la[4], lb[4];
#pragma unroll
    for (int i = 0; i < 4; ++i) { const size_t e = base + (size_t)(i * NT + tid) * 8; la[i] = *(const f32x4*)(src + e); lb[i] = *(const f32x4*)(src + e + 4); }
#pragma unroll
    for (int i = 0; i < 4; ++i) {
        size_t e = base + (size_t)(i * NT + tid) * 8;
        const float4 a = make_float4(la[i][0], la[i][1], la[i][2], la[i][3]), b = make_float4(lb[i][0], lb[i][1], lb[i][2], lb[i][3]);
        int lo = __builtin_amdgcn_cvt_pk_fp8_f32(a.x * scale, a.y * scale, 0, false); lo = __builtin_amdgcn_cvt_pk_fp8_f32(a.z * scale, a.w * scale, lo, true);
        int hi = __builtin_amdgcn_cvt_pk_fp8_f32(b.x * scale, b.y * scale, 0, false); hi = __builtin_amdgcn_cvt_pk_fp8_f32(b.z * scale, b.w * scale, hi, true);
        const size_t row = e >> 10, col = e & 1023;
        *(uint2*)(dst + ((col >> 7) * 16384 + row) * 128 + (col & 127)) = make_uint2((unsigned)lo, (unsigned)hi);
    }
}
__device__ void ph_wprep(const Params& p, int l, int vb0, int nvb, char* smem_) {
    float* tile = (float*)smem_;
    const int tid = TIDX();
    bf16_t* WIN = (bf16_t*)(p.ws + WS_WIN); bf16_t* WBR = (bf16_t*)(p.ws + WS_WBR); bf16_t* WOUT = (bf16_t*)(p.ws + WS_WOUT);
    bf16_t* WQ = (bf16_t*)(p.ws + WS_WQ); bf16_t* SK = (bf16_t*)(p.ws + WS_SK); unsigned char* PU = p.ws + WS_PU; unsigned char* PV = p.ws + WS_PV;
    constexpr int N_WIN = 136 * 16, N_WBR = 3 * 16 * 8, N_WOUT = 16 * 16, N_WQ = 32 * 16, N_SK = 16, N_PU = 1024, N_PV = 1024;
    constexpr int TOTAL = N_WIN + N_WBR + N_WOUT + N_WQ + N_SK + N_PU + N_PV;
    for (int task = vb0; task < TOTAL; task += nvb) {
        int r = task;
        if (r < N_WIN) { int nt = r / 16, kt = r % 16; tr_tile<true>(p.w_in + (size_t)l * 1024 * IN_COLS, IN_COLS, WIN, 1024, kt * 64, nt * 64, tile, tid); continue; }
        r -= N_WIN;
        if (r < N_WBR) { int g = r / 128, rr = r % 128, nt = rr / 8, kt = rr % 8;
            tr_tile<false>(p.w_branch + (size_t)(l * 3 + g) * 512 * 1024, 1024, WBR + (size_t)g * 1024 * 512, 512, kt * 64, nt * 64, tile, tid); continue; }
        r -= N_WBR;
        if (r < N_WOUT) { int nt = r / 16, kt = r % 16; tr_tile<false>(p.w_out + (size_t)l * 1024 * 1024, 1024, WOUT, 1024, kt * 64, nt * 64, tile, tid); continue; }
        r -= N_WOUT;
        if (r < N_WQ) { int nt = r / 16, kt = r % 16; tr_tile<false>(p.peer_wq + (size_t)l * 1024 * 2048, 2048, WQ, 1024, kt * 64, nt * 64, tile, tid); continue; }
        r -= N_WQ;
        if (r < N_SK) { conv_chunk(p.peer_keys + (size_t)l * 16 * 128 * 128, SK, (size_t)r * 16384, tid); continue; }
        r -= N_SK;
        if (r < N_PU) { conv_chunk_fp8(p.peer_u + (size_t)l * 16384 * 1024, PU, (size_t)r * 16384, PU_SCALE, tid); continue; }
        r -= N_PU;
        conv_chunk_fp8(p.peer_v + (size_t)l * 16384 * 1024, PV, (size_t)r * 16384, PV_SCALE, tid);
    }
}

__device__ void ph_norm(const Params& p, int l, int which, const float* xin, int vb0, int nvb) {
    const int wave = TIDX() >> 6, lane = TIDX() & 63;
    const float* gain = (which ? p.norm_ffn : p.norm_mix) + l * 1024;
    const float* modb = (const float*)(p.ws + WS_MOD);
    bf16_t* H = (bf16_t*)(p.ws + WS_H);
    f32x4 g[4];
#pragma unroll
    for (int i = 0; i < 4; ++i) g[i] = *(const f32x4*)(gain + (lane + 64 * i) * 4);
    for (int t = vb0 * 8 + wave; t < T_TOK; t += nvb * 8) {
        const int b = t >> 11;
        const float* mod = modb + (size_t)(l * 8 + b) * 6144 + (which ? 3072 : 0);
        const f32x4* xr = (const f32x4*)(xin + (size_t)t * 1024);
        f32x4 v[4], sc[4], sh[4]; float ss = 0.f;
#pragma unroll
        for (int i = 0; i < 4; ++i) { v[i] = xr[lane + 64 * i]; sc[i] = *(const f32x4*)(mod + 1024 + (lane + 64 * i) * 4); sh[i] = *(const f32x4*)(mod + (lane + 64 * i) * 4); }
#pragma unroll
        for (int i = 0; i < 4; ++i) ss += v[i][0] * v[i][0] + v[i][1] * v[i][1] + v[i][2] * v[i][2] + v[i][3] * v[i][3];
        ss = wave_sum(ss);
        const float rstd = rsqrtf(ss * (1.f / 1024.f) + 1e-6f);
#pragma unroll
        for (int i = 0; i < 4; ++i) {
            const int idx = (lane + 64 * i) * 4;
            const f32x4 h = v[i] * rstd * g[i] * (1.f + sc[i]) + sh[i];
            uint2 o; o.x = pack2(h[0], h[1]); o.y = pack2(h[2], h[3]);
            *(uint2*)(H + (size_t)t * 1024 + idx) = o;
            if (which) {
                int hi = __builtin_amdgcn_cvt_pk_fp8_f32(h[0], h[1], 0, false); hi = __builtin_amdgcn_cvt_pk_fp8_f32(h[2], h[3], hi, true);
                const auto d0 = __builtin_amdgcn_cvt_pk_f32_fp8(hi, false); const auto d1 = __builtin_amdgcn_cvt_pk_f32_fp8(hi, true);
                int lo = __builtin_amdgcn_cvt_pk_fp8_f32((h[0] - d0[0]) * 16.f, (h[1] - d0[1]) * 16.f, 0, false);
                lo = __builtin_amdgcn_cvt_pk_fp8_f32((h[2] - d1[0]) * 16.f, (h[3] - d1[1]) * 16.f, lo, true);
                *(int*)(p.ws + WS_H8H + (size_t)t * 1024 + idx) = hi;
                *(int*)(p.ws + WS_H8L + (size_t)t * 1024 + idx) = lo;
            }
        }
    }
}

constexpr int GBM = 256, GBN = 128, GBK = 64, GLS = 72;
__device__ __forceinline__ void gemm_tile(const bf16_t* __restrict__ A, int lda, const bf16_t* __restrict__ Bt, int ldb, int K,
                                          int m0, int n0, bf16_t* sA, bf16_t* sB, f32x4 (&acc)[4][4], const int tid) {
    const int lane = tid & 63, wave = tid >> 6;
    const int wm = wave >> 1, wn = wave & 1, fr = lane & 15, fq = lane >> 4;
    u32x4 ra[4], rb[2];
    const int crow = tid >> 3, ckc = (tid & 7) * 8;
    const bf16_t* Ag = A + (size_t)(m0 + crow) * lda + ckc;
    const bf16_t* Bg = Bt + (size_t)(n0 + crow) * ldb + ckc;
#pragma unroll
    for (int i = 0; i < 4; ++i) ra[i] = *(const u32x4*)(Ag + (size_t)(64 * i) * lda);
#pragma unroll
    for (int i = 0; i < 2; ++i) rb[i] = *(const u32x4*)(Bg + (size_t)(64 * i) * ldb);
    for (int k0 = 0; k0 < K; k0 += GBK) {
        __syncthreads();
#pragma unroll
        for (int i = 0; i < 4; ++i) *(u32x4*)(sA + (crow + 64 * i) * GLS + ckc) = ra[i];
#pragma unroll
        for (int i = 0; i < 2; ++i) *(u32x4*)(sB + (crow + 64 * i) * GLS + ckc) = rb[i];
        __syncthreads();
        {
            const int kn = (k0 + GBK < K) ? (k0 + GBK) : k0;
#pragma unroll
            for (int i = 0; i < 4; ++i) ra[i] = *(const u32x4*)(Ag + (size_t)(64 * i) * lda + kn);
#pragma unroll
            for (int i = 0; i < 2; ++i) rb[i] = *(const u32x4*)(Bg + (size_t)(64 * i) * ldb + kn);
        }
#pragma unroll
        for (int ks = 0; ks < 2; ++ks) {
            bf16x8 af[4], wf[4];
#pragma unroll
            for (int mf = 0; mf < 4; ++mf) af[mf] = *(const bf16x8*)(sA + (wm * 64 + mf * 16 + fr) * GLS + ks * 32 + fq * 8);
#pragma unroll
            for (int nf = 0; nf < 4; ++nf) wf[nf] = *(const bf16x8*)(sB + (wn * 64 + nf * 16 + fr) * GLS + ks * 32 + fq * 8);
#pragma unroll
            for (int nf = 0; nf < 4; ++nf)
#pragma unroll
                for (int mf = 0; mf < 4; ++mf)
                    acc[nf][mf] = __builtin_amdgcn_mfma_f32_16x16x32_bf16(wf[nf], af[mf], acc[nf][mf], 0, 0, 0);
        }
    }
}


namespace pg8 {
#define PG8_LAS __attribute__((address_space(3)))
constexpr int BM = 256, BK = 64, HALF = 128, HTB = HALF * BK * 2, STAGE_BYTES = 8 * HTB, NXCD = 8, WGM = 8;
__device__ __forceinline__ int lds_byte(int r, int c) { const int st = (r >> 4) * 2 + (c >> 5), rr = r & 15, cc = c & 31, ob = rr * 64 + cc * 2; return st * 1024 + (ob ^ (((ob >> 9) & 1) << 5)); }
__device__ __forceinline__ void stage_rc(int b, int& R, int& C) { const int st = b / 1024, sb = b % 1024, swz = sb ^ (((sb >> 9) & 1) << 5); R = (st >> 1) * 16 + swz / 64; C = (st & 1) * 32 + (swz % 64) / 2; }
__device__ __forceinline__ int perm32(int rho) { const int n = rho >> 4, i = rho & 15; return 8 * (i >> 2) + 4 * n + (i & 3); }
struct Unit { int pm, pn, aux; size_t aoff, boff; };
struct Gemm { const bf16_t* A; const bf16_t* Bt; int lda, ldb, K; };

struct StaticOrder {
    int nM, nN, nwg, G, c, lda, ldb;
    __device__ void init(int M, int N, int G_, int c_, int lda_, int ldb_) { nM = M / BM; nN = N / BM; nwg = nM * nN; G = G_; c = c_; lda = lda_; ldb = ldb_; }
    __device__ bool next(int i, Unit& u) const {
        const long L = (long)i * G + c; if (L >= nwg) return false;
        int wgid = (int)L; { const int q = nwg / NXCD, r = nwg % NXCD, xcd = wgid % NXCD, off = wgid / NXCD; wgid = (xcd < r ? xcd * (q + 1) : r * (q + 1) + (xcd - r) * q) + off; }
        const int nig = WGM * nN, gid = wgid / nig, fm = gid * WGM, gsz = (nM - fm) < WGM ? (nM - fm) : WGM;
        u.pm = fm + ((wgid % nig) % gsz); u.pn = (wgid % nig) / gsz; u.aux = 0;
        u.aoff = (size_t)u.pm * BM * lda * 2; u.boff = (size_t)u.pn * BM * ldb * 2;
        return true;
    }
};
struct MergeOrder {
    int c, G;
    __device__ bool next(int i, Unit& u) const {
        const int tile = c + (i / 3) * G; if (tile >= 256) return false;
        u.pm = tile & 63; u.pn = tile >> 6; u.aux = i % 3;
        u.aoff = ((size_t)u.pm * BM * 1536 + (size_t)u.aux * 512) * 2; u.boff = ((size_t)u.aux * 1024 + (size_t)u.pn * BM) * 512 * 2;
        return true;
    }
};

template <class Epi, class Sched>
__device__ __forceinline__ void gemm_phase(PG8_LAS unsigned char* lds, const Gemm g, const Sched& S, const Epi& E, const int tid) {
    const int wid = __builtin_amdgcn_readfirstlane(tid >> 6), lane = tid & 63, wr = wid >> 2, wc = wid & 3, fr = lane & 15, fq = lane >> 4;
    const int K = g.K, nt = K / BK;
    unsigned voffA[2], voffB[2];
#pragma unroll
    for (int i = 0; i < 2; ++i) { int R, C; stage_rc(tid * 16 + i * 8192, R, C); const int Rb = Epi::PERM ? ((R & ~31) + perm32(R & 31)) : R;
        voffA[i] = (unsigned)(R * g.lda + C) * 2u; voffB[i] = (unsigned)(Rb * g.ldb + C) * 2u; }
    const size_t kstep = (size_t)(BK * 2);
    const size_t hstepA = (size_t)HALF * g.lda * 2, hstepB = (size_t)HALF * g.ldb * 2;
    const unsigned ldsw = (unsigned)wid * 1024u;
    const int aoff = lds_byte(wr * 64 + fr, fq * 8), boff = lds_byte(wc * 32 + fr, fq * 8);
#define PG8_SA(b, h) (((b) * 2 + (h)) * HTB)
#define PG8_SB(b, h) ((4 + (b) * 2 + (h)) * HTB)
#define PG8_STAGE(bufoff, gbase, voff) do { _Pragma("unroll") for (int _i = 0; _i < 2; ++_i) \
        __builtin_amdgcn_global_load_lds((const unsigned*)((const char*)(gbase) + (voff)[_i]), (PG8_LAS unsigned*)(lds + (bufoff) + ldsw + _i * 8192), 16, 0, 0); } while (0)
#define PG8_LDA(dst, b, h) do { _Pragma("unroll") for (int m = 0; m < 4; ++m) _Pragma("unroll") for (int k = 0; k < 2; ++k) dst[m][k] = *(const PG8_LAS bf16x8*)(lds + PG8_SA(b, h) + aoff + m * 2048 + k * 1024); } while (0)
#define PG8_LDB(dst, b, h) do { _Pragma("unroll") for (int n = 0; n < 2; ++n) _Pragma("unroll") for (int k = 0; k < 2; ++k) dst[n][k] = *(const PG8_LAS bf16x8*)(lds + PG8_SB(b, h) + boff + n * 2048 + k * 1024); } while (0)
#define PG8_MMA(ai, bj, At, Bt) do { __builtin_amdgcn_s_setprio(1); _Pragma("unroll") for (int m = 0; m < 4; ++m) _Pragma("unroll") for (int n = 0; n < 2; ++n) _Pragma("unroll") for (int k = 0; k < 2; ++k) \
        acc[ai][bj][m][n] = __builtin_amdgcn_mfma_f32_16x16x32_bf16(Bt[n][k], At[m][k], acc[ai][bj][m][n], 0, 0, 0); __builtin_amdgcn_s_setprio(0); } while (0)
#define PG8_WAIT_V(n) asm volatile("s_waitcnt vmcnt(" #n ")" ::: "memory")
#define PG8_WAIT_L(n) asm volatile("s_waitcnt lgkmcnt(" #n ")" ::: "memory")
#define PG8_BAR __builtin_amdgcn_s_barrier()
#define PG8_SCHED __builtin_amdgcn_sched_barrier(0)
    Unit cur, nxt; int ui = 0;
    if (!S.next(0, cur)) return;
    f32x4 acc[2][2][4][2];
#pragma unroll
    for (int a = 0; a < 2; ++a)
#pragma unroll
        for (int b = 0; b < 2; ++b)
#pragma unroll
            for (int m = 0; m < 4; ++m)
#pragma unroll
                for (int n = 0; n < 2; ++n) acc[a][b][m][n] = f32x4{0.f, 0.f, 0.f, 0.f};
    bf16x8 At[4][2], B0[2][2], B1[2][2];
    const char* cA = (const char*)g.A + cur.aoff; const char* cB = (const char*)g.Bt + cur.boff;
    PG8_STAGE(PG8_SB(0, 0), cB, voffB); PG8_STAGE(PG8_SA(0, 0), cA, voffA); PG8_STAGE(PG8_SB(0, 1), cB + hstepB, voffB); PG8_STAGE(PG8_SA(0, 1), cA + hstepA, voffA);
    if (wr == 1) PG8_BAR;
    PG8_WAIT_V(4); PG8_BAR;
    PG8_STAGE(PG8_SB(1, 0), cB + kstep, voffB); PG8_STAGE(PG8_SA(1, 0), cA + kstep, voffA); PG8_STAGE(PG8_SB(1, 1), cB + hstepB + kstep, voffB);
    PG8_WAIT_V(6); PG8_BAR;
    for (;;) {
        const bool has_next = S.next(ui + 1, nxt);
        const char* nA = has_next ? (const char*)g.A + nxt.aoff : cA; const char* nB = has_next ? (const char*)g.Bt + nxt.boff : cB;
        for (int t = 0; t < nt; t += 2) {
            const bool last = (t == nt - 2);
            const char* a1 = cA + (size_t)(t + 1) * kstep;
            const char* a2 = last ? nA : cA + (size_t)(t + 2) * kstep; const char* b2 = last ? nB : cB + (size_t)(t + 2) * kstep;
            const char* a3 = a2 + kstep; const char* b3 = b2 + kstep;
            PG8_LDB(B0, 0, 0); PG8_SCHED; PG8_LDA(At, 0, 0); PG8_STAGE(PG8_SA(1, 1), a1 + hstepA, voffA);
            PG8_WAIT_L(8); PG8_BAR; PG8_WAIT_L(0); PG8_MMA(0, 0, At, B0); PG8_BAR; PG8_SCHED;
            PG8_LDB(B1, 0, 1); PG8_STAGE(PG8_SB(0, 0), b2, voffB);
            PG8_BAR; PG8_WAIT_L(0); PG8_MMA(0, 1, At, B1); PG8_BAR;
            PG8_LDA(At, 0, 1); PG8_STAGE(PG8_SA(0, 0), a2, voffA);
            PG8_BAR; PG8_WAIT_L(0); PG8_MMA(1, 0, At, B0); PG8_BAR; PG8_SCHED;
            PG8_STAGE(PG8_SB(0, 1), b2 + hstepB, voffB);
            PG8_WAIT_V(6); PG8_BAR; PG8_MMA(1, 1, At, B1); PG8_BAR;
            PG8_LDB(B0, 1, 0); PG8_SCHED; PG8_LDA(At, 1, 0); PG8_STAGE(PG8_SA(0, 1), a2 + hstepA, voffA);
            PG8_WAIT_L(8); PG8_BAR; PG8_WAIT_L(0); PG8_MMA(0, 0, At, B0); PG8_BAR; PG8_SCHED;
            PG8_LDB(B1, 1, 1); PG8_STAGE(PG8_SB(1, 0), b3, voffB);
            PG8_BAR; PG8_WAIT_L(0); PG8_MMA(0, 1, At, B1); PG8_BAR;
            PG8_LDA(At, 1, 1); PG8_STAGE(PG8_SA(1, 0), a3, voffA);
            PG8_BAR; PG8_WAIT_L(0); PG8_MMA(1, 0, At, B0); PG8_BAR; PG8_SCHED;
            PG8_STAGE(PG8_SB(1, 1), b3 + hstepB, voffB);
            PG8_WAIT_V(6); PG8_BAR; PG8_MMA(1, 1, At, B1); PG8_BAR;
        }
        E(acc, cur, wr, wc, fr, fq);
        if (!has_next) break;
#pragma unroll
        for (int a = 0; a < 2; ++a)
#pragma unroll
            for (int b = 0; b < 2; ++b)
#pragma unroll
                for (int m = 0; m < 4; ++m)
#pragma unroll
                    for (int n = 0; n < 2; ++n) acc[a][b][m][n] = f32x4{0.f, 0.f, 0.f, 0.f};
        cur = nxt; cA = nA; cB = nB; ++ui;
    }
    PG8_WAIT_V(0);
    if (wr == 0) PG8_BAR;
    PG8_BAR;
#undef PG8_SA
#undef PG8_SB
#undef PG8_STAGE
#undef PG8_LDA
#undef PG8_LDB
#undef PG8_MMA
#undef PG8_WAIT_V
#undef PG8_WAIT_L
#undef PG8_BAR
#undef PG8_SCHED
}

struct EpiBf16 {
    static constexpr bool PERM = true;
    bf16_t* O; int ldc;
    __device__ __forceinline__ void operator()(const f32x4 (&acc)[2][2][4][2], const Unit& u, int wr, int wc, int fr, int fq) const {
        const int row0 = u.pm * BM + wr * 64 + fr, col0 = u.pn * BM + wc * 32 + 8 * fq;
#pragma unroll
        for (int ai = 0; ai < 2; ++ai)
#pragma unroll
            for (int m = 0; m < 4; ++m) { bf16_t* rowp = O + (size_t)(row0 + ai * HALF + m * 16) * ldc + col0;
#pragma unroll
                for (int bj = 0; bj < 2; ++bj) { const f32x4 v0 = acc[ai][bj][m][0], v1 = acc[ai][bj][m][1];
                    u32x4 w; w.x = pack2(v0[0], v0[1]); w.y = pack2(v0[2], v0[3]); w.z = pack2(v1[0], v1[1]); w.w = pack2(v1[2], v1[3]);
                    *(u32x4*)(rowp + bj * HALF) = w; } }
    }
};
struct EpiResid {
    static constexpr bool PERM = false;
    const float* xin; float* out; const float* mod;
    __device__ __forceinline__ void operator()(const f32x4 (&acc)[2][2][4][2], const Unit& u, int wr, int wc, int fr, int fq) const {
        const int row0 = u.pm * BM + wr * 64 + fr, col0 = u.pn * BM + wc * 32 + 4 * fq;
        const float* gm = mod + (size_t)(row0 >> 11) * 6144 + 2048 + col0;
        f32x4 g4[2][2];
#pragma unroll
        for (int bj = 0; bj < 2; ++bj)
#pragma unroll
            for (int n = 0; n < 2; ++n) g4[bj][n] = *(const f32x4*)(gm + bj * HALF + n * 16);
#pragma unroll
        for (int ai = 0; ai < 2; ++ai) {
            f32x4 xi[4][2][2];
#pragma unroll
            for (int m = 0; m < 4; ++m)
#pragma unroll
                for (int bj = 0; bj < 2; ++bj)
#pragma unroll
                    for (int n = 0; n < 2; ++n) xi[m][bj][n] = *(const f32x4*)(xin + (size_t)(row0 + ai * HALF + m * 16) * 1024 + col0 + bj * HALF + n * 16);
            asm volatile("" ::: "memory");
#pragma unroll
            for (int m = 0; m < 4; ++m)
#pragma unroll
                for (int bj = 0; bj < 2; ++bj)
#pragma unroll
                    for (int n = 0; n < 2; ++n)
                        *(f32x4*)(out + (size_t)(row0 + ai * HALF + m * 16) * 1024 + col0 + bj * HALF + n * 16) = xi[m][bj][n] + g4[bj][n] * acc[ai][bj][m][n];
            asm volatile("" ::: "memory");
        }
    }
};
struct EpiMerge {
    static constexpr bool PERM = true;
    bf16_t* Hm; const bf16_t* Z;
    __device__ __forceinline__ void operator()(const f32x4 (&acc)[2][2][4][2], const Unit& u, int wr, int wc, int fr, int fq) const {
        const int row0 = u.pm * BM + wr * 64 + fr, col0 = u.pn * BM + wc * 32 + 8 * fq, g = u.aux;
#pragma unroll
        for (int ai = 0; ai < 2; ++ai) {
            u32x4 gz[4][2], prev[4][2];
#pragma unroll
            for (int m = 0; m < 4; ++m)
#pragma unroll
                for (int bj = 0; bj < 2; ++bj) {
                    const int row = row0 + ai * HALF + m * 16, col = col0 + bj * HALF;
                    gz[m][bj] = *(const u32x4*)(Z + (size_t)row * LDZ + ZM + g * 1024 + col);
                    prev[m][bj] = u32x4{0u, 0u, 0u, 0u};
                    if (g > 0) prev[m][bj] = *(const u32x4*)(Hm + (size_t)row * 1024 + col);
                }
            asm volatile("" ::: "memory");
#pragma unroll
            for (int m = 0; m < 4; ++m)
#pragma unroll
                for (int bj = 0; bj < 2; ++bj) {
                    const int row = row0 + ai * HALF + m * 16, col = col0 + bj * HALF;
                    const f32x4 v0 = acc[ai][bj][m][0], v1 = acc[ai][bj][m][1];
                    const u32x4 z_ = gz[m][bj], p_ = prev[m][bj];
                    u32x4 w;
                    w.x = pack2(bflo(p_.x) + sigm(bflo(z_.x)) * v0[0], bfhi(p_.x) + sigm(bfhi(z_.x)) * v0[1]);
                    w.y = pack2(bflo(p_.y) + sigm(bflo(z_.y)) * v0[2], bfhi(p_.y) + sigm(bfhi(z_.y)) * v0[3]);
                    w.z = pack2(bflo(p_.z) + sigm(bflo(z_.z)) * v1[0], bfhi(p_.z) + sigm(bfhi(z_.z)) * v1[1]);
                    w.w = pack2(bflo(p_.w) + sigm(bflo(z_.w)) * v1[2], bfhi(p_.w) + sigm(bfhi(z_.w)) * v1[3]);
                    *(u32x4*)(Hm + (size_t)row * 1024 + col) = w;
                }
            asm volatile("" ::: "memory");
        }
    }
};
}

struct EpiZ {
    bf16_t* Z; int ld;
    __device__ __forceinline__ void operator()(int m, int n, const f32x4& v) const {
        uint2 o; o.x = pack2(v[0], v[1]); o.y = pack2(v[2], v[3]);
        *(uint2*)(Z + (size_t)m * ld + n) = o;
    }
};
struct EpiF16 {
    _Float16* C; int ld;
    __device__ __forceinline__ void operator()(int m, int n, const f32x4& v) const {
        typedef _Float16 h4 __attribute__((ext_vector_type(4)));
        h4 o = {(_Float16)v[0], (_Float16)v[1], (_Float16)v[2], (_Float16)v[3]};
        *(h4*)(C + (size_t)m * ld + n) = o;
    }
};
struct EpiOut {
    const float* xin; float* out; const float* mod;
    __device__ __forceinline__ void operator()(int m, int n, const f32x4& v) const {
        int b = m >> 11;
        float4 g = *(const float4*)(mod + (size_t)b * 6144 + 2048 + n);
        float4 xi = *(const float4*)(xin + (size_t)m * 1024 + n);
        *(float4*)(out + (size_t)m * 1024 + n) = make_float4(xi.x + g.x * v[0], xi.y + g.y * v[1], xi.z + g.z * v[2], xi.w + g.w * v[3]);
    }
};

template <class Epi>
__device__ void gemm_phase(const bf16_t* A, int lda, const bf16_t* Bt, int ldb, int M, int N, int K, bool batched, Epi epi,
                           int vb0, int nvb, char* smem_, const int tid) {
    bf16_t* sA = (bf16_t*)smem_; bf16_t* sB = sA + GBM * GLS;
    const int lane = tid & 63, wave = tid >> 6, wm = wave >> 1, wn = wave & 1, fr = lane & 15, fq = lane >> 4;
    const int MT = M / GBM, NTL = N / GBN;
    for (int tile = vb0; tile < MT * NTL; tile += nvb) {
        int mt = tile % MT, nt = tile / MT;
        f32x4 acc[4][4];
#pragma unroll
        for (int a = 0; a < 4; ++a)
#pragma unroll
            for (int b = 0; b < 4; ++b) acc[a][b] = f32x4{0.f, 0.f, 0.f, 0.f};
        gemm_tile(batched ? A + nt * 128 : A, lda, Bt, ldb, K, mt * GBM, nt * GBN, sA, sB, acc, tid);
#pragma unroll
        for (int nf = 0; nf < 4; ++nf)
#pragma unroll
            for (int mf = 0; mf < 4; ++mf)
                epi(mt * GBM + wm * 64 + mf * 16 + fr, nt * GBN + wn * 64 + nf * 16 + fq * 4, acc[nf][mf]);
    }
}


#define SCAN_SYNC() do { asm volatile("s_waitcnt lgkmcnt(0)" ::: "memory"); __builtin_amdgcn_s_barrier(); asm volatile("" ::: "memory"); } while (0)
template <int DK, bool GLA>
__device__ void scan2_item(const Params& p, int l, int b, int h, char* smem_) {
    constexpr int SEG = NT / DK, SLEN = 64 / SEG, KS = DK / 32, KT = DK / 16;
    constexpr int QS = DK + 8, BS = DK + 4, VS = 72;
    bf16_t* qs = (bf16_t*)smem_;
    bf16_t* ks = qs + 64 * QS;
    float* bs = (float*)(ks + 64 * QS);
    bf16_t* vt = (bf16_t*)(bs + 64 * BS);
    bf16_t* At = vt + 128 * VS;
    bf16_t* kht = At + 64 * VS;
    bf16_t* st = kht + DK * VS;
    float* segtot = (float*)(st + 128 * QS);
    float* blast = segtot + SEG * DK;
    const int tid = TIDX(), lane = tid & 63, wave = __builtin_amdgcn_readfirstlane(tid >> 6), fr = lane & 15, fq = lane >> 4;
    const int kl = tid % DK, seg = __builtin_amdgcn_readfirstlane(tid / DK);
    float lbv = 0.f, gbias = 0.f; float gu[16];
#pragma unroll
    for (int r = 0; r < 16; ++r) gu[r] = 0.f;
    if (GLA) {
#pragma unroll
        for (int r = 0; r < 16; ++r) gu[r] = p.gla_up[(size_t)(l * 16 + r) * 256 + h * 64 + kl];
        gbias = p.gla_bias[l * 256 + h * 64 + kl];
    } else if (l == 1) {
        float x0 = p.hgrn_lb[h * 128 + kl], x1 = p.hgrn_lb[512 + h * 128 + kl];
        lbv = 1.f / (1.f + expf(x0 - x1));
    }
    const float scale = GLA ? 0.125f : 0.08838834764831845f;
    const bf16_t* Zb = (const bf16_t*)(p.ws + WS_Z) + (size_t)(b * 2048) * LDZ;
    float* ssq = (float*)(smem_ + 152576);
    const int QCOL = (GLA ? ZC_Q : ZA_Q) + h * DK, KCOL = (GLA ? ZC_K : ZA_F) + h * DK, VCOL = (GLA ? ZC_V : ZA_I) + h * 128, GCOL = (GLA ? ZC_G : ZA_G) + h * 128;
    f32x4 sacc[KT];
#pragma unroll
    for (int i = 0; i < KT; ++i) sacc[i] = f32x4{0.f, 0.f, 0.f, 0.f};
    f32x4 gn4[4];
    {
        const float* gn = (GLA ? p.gla_on : p.hgrn_on) + l * 128 + (wave >> 2) * 64 + 4 * fq;
#pragma unroll
        for (int vi = 0; vi < 4; ++vi) gn4[vi] = *(const f32x4*)(gn + vi * 16);
    }
    for (int i = tid; i < 128 * QS / 2; i += NT) ((unsigned*)st)[i] = 0u;
    SCAN_SYNC();

    for (int c = 0; c < 32; ++c) {
        const bf16_t* Zc = Zb + (size_t)(c * 64) * LDZ;
        {
            bf16_t rq[SLEN], rk[SLEN];
            u32x4 rc0[GLA ? SLEN : 1], rc1[GLA ? SLEN : 1];
            {
                bf16_t rv[16];
                const int v = tid & 127, sb_ = __builtin_amdgcn_readfirstlane(tid >> 7);
#pragma unroll
                for (int i = 0; i < 16; ++i) rv[i] = Zc[(size_t)(sb_ + 4 * i) * LDZ + VCOL + v];
#pragma unroll
                for (int i = 0; i < SLEN; ++i) {
                    const bf16_t* zr = Zc + (size_t)(seg * SLEN + i) * LDZ;
                    rq[i] = zr[QCOL + kl]; rk[i] = zr[KCOL + kl];
                    if (GLA) { rc0[i] = *(const u32x4*)(zr + ZC_CODE); rc1[i] = *(const u32x4*)(zr + ZC_CODE + 8); }
                }
#pragma unroll
                for (int i = 0; i < 16; ++i) vt[v * VS + sb_ + 4 * i] = rv[i];
            }
            float run = 0.f;
#pragma unroll
            for (int i = 0; i < SLEN; ++i) {
                const int s_ = seg * SLEN + i;
                float g, kk;
                if (GLA) {
                    float x = gbias;
#pragma unroll
                    for (int r = 0; r < 4; ++r) {
                        x += bflo(rc0[i][r]) * gu[2 * r] + bfhi(rc0[i][r]) * gu[2 * r + 1];
                        x += bflo(rc1[i][r]) * gu[8 + 2 * r] + bfhi(rc1[i][r]) * gu[8 + 2 * r + 1];
                    }
                    g = (fminf(x, 0.f) - __logf(1.f + __expf(-fabsf(x)))) * (1.f / 16.f);
                    kk = bf2f(rk[i]);
                } else {
                    const float f = lbv + (1.f - lbv) * __frcp_rn(1.f + __expf(-bf2f(rk[i])));
                    g = __logf(f); kk = 1.f - f;
                }
                run += g;
                bs[s_ * BS + kl] = run;
                qs[s_ * QS + kl] = rq[i];
                ks[s_ * QS + kl] = f2bf(kk);
            }
            segtot[seg * DK + kl] = run;
        }
        SCAN_SYNC();
        {
            float pre = 0.f, tot = 0.f;
#pragma unroll
            for (int g_ = 0; g_ < SEG; ++g_) { const float v_ = segtot[g_ * DK + kl]; if (g_ < seg) pre += v_; tot += v_; }
            if (seg == 0) blast[kl] = tot;
            unsigned pk[SLEN / 2];
#pragma unroll
            for (int i = 0; i < SLEN; ++i) {
                const float bv = bs[(seg * SLEN + i) * BS + kl] + pre;
                bs[(seg * SLEN + i) * BS + kl] = bv;
                const float kh = bf2f(ks[(seg * SLEN + i) * QS + kl]) * __expf(tot - bv);
                if (i & 1) pk[i >> 1] |= ((unsigned)f2bf(kh)) << 16; else pk[i >> 1] = (unsigned)f2bf(kh);
            }
            unsigned* dst = (unsigned*)(kht + kl * VS + seg * SLEN);
#pragma unroll
            for (int i = 0; i < SLEN / 2; ++i) dst[i] = pk[i];
        }
        SCAN_SYNC();
        for (int blk = wave; blk < 10; blk += 8) {
            int bi, bj;
            if (blk < 1) { bi = 0; bj = 0; } else if (blk < 3) { bi = 1; bj = blk - 1; } else if (blk < 6) { bi = 2; bj = blk - 3; } else { bi = 3; bj = blk - 6; }
            f32x4 acc = f32x4{0.f, 0.f, 0.f, 0.f};
            const int srow = bj * 16 + fr, trow = bi * 16 + fr;
#pragma unroll
            for (int kk = 0; kk < KS; ++kk) {
                const int k0 = kk * 32 + fq * 8;
                float br[8];
                if (bi == 0) {
#pragma unroll
                    for (int j = 0; j < 8; ++j) br[j] = 0.f;
                } else {
                    const float4 r0 = *(const float4*)(bs + (bi * 16 - 1) * BS + k0), r1 = *(const float4*)(bs + (bi * 16 - 1) * BS + k0 + 4);
                    br[0] = r0.x; br[1] = r0.y; br[2] = r0.z; br[3] = r0.w; br[4] = r1.x; br[5] = r1.y; br[6] = r1.z; br[7] = r1.w;
                }
                const uint4 kq = *(const uint4*)(ks + srow * QS + k0), qq = *(const uint4*)(qs + trow * QS + k0);
                const float4 s0 = *(const float4*)(bs + srow * BS + k0), s1 = *(const float4*)(bs + srow * BS + k0 + 4);
                const float4 t0_ = *(const float4*)(bs + trow * BS + k0), t1_ = *(const float4*)(bs + trow * BS + k0 + 4);
                const float bsv[8] = {s0.x, s0.y, s0.z, s0.w, s1.x, s1.y, s1.z, s1.w}, btv[8] = {t0_.x, t0_.y, t0_.z, t0_.w, t1_.x, t1_.y, t1_.z, t1_.w};
                const unsigned kw[4] = {kq.x, kq.y, kq.z, kq.w}, qw[4] = {qq.x, qq.y, qq.z, qq.w};
                union { bf16x8 v; unsigned u[4]; } ka, qb;
#pragma unroll
                for (int j = 0; j < 4; ++j) {
                    const float e0 = __expf(fminf(br[2 * j] - bsv[2 * j], 60.f)), e1 = __expf(fminf(br[2 * j + 1] - bsv[2 * j + 1], 60.f));
                    ka.u[j] = pack2(bflo(kw[j]) * e0, bfhi(kw[j]) * e1);
                    const float f0 = __expf(btv[2 * j] - br[2 * j]), f1 = __expf(btv[2 * j + 1] - br[2 * j + 1]);
                    qb.u[j] = pack2(bflo(qw[j]) * f0, bfhi(qw[j]) * f1);
                }
                acc = __builtin_amdgcn_mfma_f32_16x16x32_bf16(ka.v, qb.v, acc, 0, 0, 0);
            }
            if (bi == bj) {
#pragma unroll
                for (int r = 0; r < 4; ++r) if (4 * fq + r > fr) acc[r] = 0.f;
            }
            uint2 o; o.x = pack2(acc[0], acc[1]); o.y = pack2(acc[2], acc[3]);
            *(uint2*)(At + trow * VS + bj * 16 + 4 * fq) = o;
        }
        {
            unsigned z_ = 0u; asm volatile("" : "+v"(z_));
            if (wave == 2) *(uint2*)(At + (0 * 16 + fr) * VS + 16 + 4 * fq) = make_uint2(z_, z_);
            if (wave == 3) *(uint2*)(At + (2 * 16 + fr) * VS + 48 + 4 * fq) = make_uint2(z_, z_);
        }
        SCAN_SYNC();
        f32x4 oacc[4]; uint2 gz[4];
        {
            const int ti = wave & 3, vh = wave >> 2, trow = ti * 16 + fr;
            bf16x8 qh[KS];
#pragma unroll
            for (int kk = 0; kk < KS; ++kk) {
                const int k0 = kk * 32 + fq * 8;
                const uint4 qq = *(const uint4*)(qs + trow * QS + k0);
                const float4 t0_ = *(const float4*)(bs + trow * BS + k0), t1_ = *(const float4*)(bs + trow * BS + k0 + 4);
                union { bf16x8 v; unsigned u[4]; } q_;
                q_.u[0] = pack2(bflo(qq.x) * __expf(t0_.x), bfhi(qq.x) * __expf(t0_.y));
                q_.u[1] = pack2(bflo(qq.y) * __expf(t0_.z), bfhi(qq.y) * __expf(t0_.w));
                q_.u[2] = pack2(bflo(qq.z) * __expf(t1_.x), bfhi(qq.z) * __expf(t1_.y));
                q_.u[3] = pack2(bflo(qq.w) * __expf(t1_.z), bfhi(qq.w) * __expf(t1_.w));
                qh[kk] = q_.v;
            }
            const bf16x8 af0 = *(const bf16x8*)(At + trow * VS + fq * 8), af1 = *(const bf16x8*)(At + trow * VS + 32 + fq * 8);
            float sq = 0.f;
#pragma unroll
            for (int vi = 0; vi < 4; ++vi) {
                const int vrow = vh * 64 + vi * 16 + fr;
                gz[vi] = *(const uint2*)(Zc + (size_t)trow * LDZ + GCOL + vh * 64 + vi * 16 + 4 * fq);
                f32x4 acc = f32x4{0.f, 0.f, 0.f, 0.f};
                acc = __builtin_amdgcn_mfma_f32_16x16x32_bf16(*(const bf16x8*)(vt + vrow * VS + fq * 8), af0, acc, 0, 0, 0);
                if (ti >= 2) acc = __builtin_amdgcn_mfma_f32_16x16x32_bf16(*(const bf16x8*)(vt + vrow * VS + 32 + fq * 8), af1, acc, 0, 0, 0);
#pragma unroll
                for (int kk = 0; kk < KS; ++kk)
                    acc = __builtin_amdgcn_mfma_f32_16x16x32_bf16(*(const bf16x8*)(st + vrow * QS + kk * 32 + fq * 8), qh[kk], acc, 0, 0, 0);
                oacc[vi] = acc * scale;
                sq += oacc[vi][0] * oacc[vi][0] + oacc[vi][1] * oacc[vi][1] + oacc[vi][2] * oacc[vi][2] + oacc[vi][3] * oacc[vi][3];
            }
            sq += shx<16>(sq); sq += shx<32>(sq);
            if (fq == 0) ssq[vh * 64 + trow] = sq;
        }
        {
            const int vrow = wave * 16 + fr;
            const bf16x8 vf0 = *(const bf16x8*)(vt + vrow * VS + fq * 8), vf1 = *(const bf16x8*)(vt + vrow * VS + 32 + fq * 8);
#pragma unroll
            for (int kt = 0; kt < KT; ++kt) {
                const float dec = __expf(blast[kt * 16 + fr]);
                sacc[kt][0] *= dec; sacc[kt][1] *= dec; sacc[kt][2] *= dec; sacc[kt][3] *= dec;
                sacc[kt] = __builtin_amdgcn_mfma_f32_16x16x32_bf16(vf0, *(const bf16x8*)(kht + (kt * 16 + fr) * VS + fq * 8), sacc[kt], 0, 0, 0);
                sacc[kt] = __builtin_amdgcn_mfma_f32_16x16x32_bf16(vf1, *(const bf16x8*)(kht + (kt * 16 + fr) * VS + 32 + fq * 8), sacc[kt], 0, 0, 0);
            }
        }
        SCAN_SYNC();
#pragma unroll
        for (int kt = 0; kt < KT; ++kt)
#pragma unroll
            for (int r = 0; r < 4; ++r) st[(wave * 16 + 4 * fq + r) * QS + kt * 16 + fr] = f2bf(sacc[kt][r]);
        {
            const int ti = wave & 3, vh = wave >> 2, trow = ti * 16 + fr;
            const float rstd = rsqrtf((ssq[trow] + ssq[64 + trow]) * (1.f / 128.f) + 1e-6f);
            bf16_t* yrow = (bf16_t*)(p.ws + WS_Y) + (size_t)(b * 2048 + c * 64 + trow) * 1536 + (GLA ? 1024 : 0) + h * 128 + vh * 64 + 4 * fq;
#pragma unroll
            for (int vi = 0; vi < 4; ++vi) {
                const f32x4 g4_ = gn4[vi]; const float4 g4 = make_float4(g4_[0], g4_[1], g4_[2], g4_[3]);
                const float z0 = bflo(gz[vi].x), z1 = bfhi(gz[vi].x), z2 = bflo(gz[vi].y), z3 = bfhi(gz[vi].y);
                uint2 o;
                o.x = pack2(oacc[vi][0] * rstd * g4.x * (z0 * sigm(z0)), oacc[vi][1] * rstd * g4.y * (z1 * sigm(z1)));
                o.y = pack2(oacc[vi][2] * rstd * g4.z * (z2 * sigm(z2)), oacc[vi][3] * rstd * g4.w * (z3 * sigm(z3)));
                *(uint2*)(yrow + vi * 16) = o;
            }
        }
    }
    SCAN_SYNC();
}

__device__ void dsaprep2_item(const Params& p, int l, int item, char* smem_) {
    bf16_t* tile = (bf16_t*)smem_;
    const int tid = TIDX(), lane = tid & 63, wave = tid >> 6;
    bf16_t* Z = (bf16_t*)(p.ws + WS_Z); bf16_t* VT = (bf16_t*)(p.ws + WS_VT);
    {
        const int tb = item * 32;
        {
            const float2 gq = *(const float2*)(p.dsa_qn + l * 128 + lane * 2), gk = *(const float2*)(p.dsa_kn + l * 128 + lane * 2);
            unsigned uu[4][8];
#pragma unroll
            for (int j = 0; j < 4; ++j)
#pragma unroll
                for (int grp = 0; grp < 8; ++grp)
                    uu[j][grp] = *(const unsigned*)(Z + (size_t)(tb + wave + 8 * j) * LDZ + (grp < 4 ? ZB_Q : ZB_K) + (grp & 3) * 128 + lane * 2);
#pragma unroll
            for (int j = 0; j < 4; ++j)
#pragma unroll
                for (int grp = 0; grp < 8; ++grp) {
                    bf16_t* ptr = Z + (size_t)(tb + wave + 8 * j) * LDZ + (grp < 4 ? ZB_Q : ZB_K) + (grp & 3) * 128 + lane * 2;
                    const float a = bflo(uu[j][grp]), b = bfhi(uu[j][grp]);
                    const float ss = wave_sum(a * a + b * b);
                    const float r = rsqrtf(ss * (1.f / 128.f) + 1e-6f) * ((grp < 4) ? 0.08838834764831845f : 1.f);
                    const float2 g = (grp < 4) ? gq : gk;
                    __hip_atomic_store((unsigned*)ptr, pack2(a * r * g.x, b * r * g.y), __ATOMIC_RELAXED, __HIP_MEMORY_SCOPE_AGENT);
                }
        }
        u32x4 uv[4];
#pragma unroll
        for (int i = 0; i < 4; ++i) { const int ch = tid + i * 512; uv[i] = *(const u32x4*)(Z + (size_t)(tb + (ch >> 6)) * LDZ + ZB_V + (ch & 63) * 8); }
#pragma unroll
        for (int i = 0; i < 4; ++i) {
            const int ch = tid + i * 512, t = ch >> 6, c8 = (ch & 63) * 8;
            unsigned* d = (unsigned*)(tile + t * 514 + c8);
            d[0] = uv[i][0]; d[1] = uv[i][1]; d[2] = uv[i][2]; d[3] = uv[i][3];
        }
        __syncthreads();
        {
            const int c = tid, b = tb >> 11, s0 = tb & 2047;
            unsigned w[16];
#pragma unroll
            for (int j = 0; j < 16; ++j) w[j] = (unsigned)tile[(2 * j) * 514 + c] | ((unsigned)tile[(2 * j + 1) * 514 + c] << 16);
            unsigned long long* dst = (unsigned long long*)(VT + ((size_t)(b * 512 + c)) * 2048 + s0);
#pragma unroll
            for (int j = 0; j < 8; ++j) __hip_atomic_store(dst + j, ((unsigned long long)w[2 * j + 1] << 32) | w[2 * j], __ATOMIC_RELAXED, __HIP_MEMORY_SCOPE_AGENT);
        }
        __syncthreads();
    }
}

__device__ void dsa_select_tile(const Params& p, int b, int tq, char* smem_) {
    constexpr int KS_ = 2052;
    unsigned* keyL = (unsigned*)smem_;
    const int tid = TIDX(), lane = tid & 63, wave = __builtin_amdgcn_readfirstlane(tid >> 6), fr = lane & 15, fq = lane >> 4;
    const bf16_t* Z = (const bf16_t*)(p.ws + WS_Z);
    unsigned long long* BM64 = (unsigned long long*)(p.ws + WS_BM);
    const int t0 = tq * 16;
    {
        const int tl = t0 + fr;
        const size_t trow = (size_t)b * 2048 + tl;
        bf16x8 qf[4][2];
#pragma unroll
        for (int h = 0; h < 4; ++h)
#pragma unroll
            for (int ks = 0; ks < 2; ++ks) qf[h][ks] = *(const bf16x8*)(Z + trow * LDZ + ZB_QI + h * 64 + ks * 32 + fq * 8);
        float w[4];
#pragma unroll
        for (int h = 0; h < 4; ++h) w[h] = bf2f(Z[trow * LDZ + ZB_WI + h]) * 0.5f;
#pragma unroll 4
        for (int kt = wave; kt <= tq; kt += 8) {
            const bf16_t* kr = Z + ((size_t)b * 2048 + kt * 16 + fr) * LDZ + ZB_KI + fq * 8;
            const bf16x8 k0 = *(const bf16x8*)kr, k1 = *(const bf16x8*)(kr + 32);
            f32x4 acc[4];
#pragma unroll
            for (int h = 0; h < 4; ++h) {
                acc[h] = __builtin_amdgcn_mfma_f32_16x16x32_bf16(k0, qf[h][0], f32x4{0.f, 0.f, 0.f, 0.f}, 0, 0, 0);
                acc[h] = __builtin_amdgcn_mfma_f32_16x16x32_bf16(k1, qf[h][1], acc[h], 0, 0, 0);
            }
            u32x4 kk;
#pragma unroll
            for (int r = 0; r < 4; ++r) {
                float sc = w[0] * fmaxf(acc[0][r] * 0.125f, 0.f) + w[1] * fmaxf(acc[1][r] * 0.125f, 0.f) + w[2] * fmaxf(acc[2][r] * 0.125f, 0.f) + w[3] * fmaxf(acc[3][r] * 0.125f, 0.f);
                if (sc == 0.f) sc = 0.f;
                const unsigned u = __float_as_uint(sc);
                const unsigned k = (u & 0x80000000u) ? ~u : (u | 0x80000000u);
                kk[r] = (kt * 16 + 4 * fq + r <= tl) ? k : 0u;
            }
            *(u32x4*)(keyL + fr * KS_ + kt * 16 + 4 * fq) = kk;
        }
    }
    __syncthreads();
    {
        const int nk = (tq + 1) * 16, jmax = (nk + 63) >> 6;
        const int qa = 2 * wave, qb = qa + 1;
        unsigned ka[32], kb[32];
#pragma unroll
        for (int j = 0; j < 32; ++j) {
            const int s = lane + 64 * j;
            ka[j] = (s < nk) ? keyL[qa * KS_ + s] : 0u;
            kb[j] = (s < nk) ? keyL[qb * KS_ + s] : 0u;
        }
        unsigned Ta = 1u, Tb = 1u; int Ca = 2047, Cb = 2047;
        if (t0 >= 256) {
            int na, nb;
            bool da, db;
            {
                int c0 = 0, c1 = 0, c2 = 0, c3 = 0;
#pragma unroll
                for (int j = 0; j < 32; ++j)
                    if (j < jmax) { c0 += (ka[j] >= 0x80000000u); c1 += (ka[j] > 0x80000000u); c2 += (kb[j] >= 0x80000000u); c3 += (kb[j] > 0x80000000u); }
                c0 = wave_total_i(c0); c1 = wave_total_i(c1); c2 = wave_total_i(c2); c3 = wave_total_i(c3);
                da = (c1 < 256 && c0 >= 256); db = (c3 < 256 && c2 >= 256);
                Ta = da ? 0x80000000u : ((c0 >= 256) ? 0x80000000u : 0u); na = da ? c0 : ((c0 >= 256) ? c0 : 0x7fffffff);
                Tb = db ? 0x80000000u : ((c2 >= 256) ? 0x80000000u : 0u); nb = db ? c2 : ((c2 >= 256) ? c2 : 0x7fffffff);
            }
            for (int bit = 30; bit >= 0; --bit) {
                if (da && db) break;
                const unsigned ca_ = Ta | (1u << bit), cb_ = Tb | (1u << bit);
                int c0 = 0, c1 = 0;
#pragma unroll
                for (int j = 0; j < 32; ++j)
                    if (j < jmax) { c0 += (ka[j] >= ca_); c1 += (kb[j] >= cb_); }
                c0 = wave_total_i(c0); c1 = wave_total_i(c1);
                if (!da && c0 >= 256) { Ta = ca_; na = c0; }
                if (!db && c1 >= 256) { Tb = cb_; nb = c1; }
                da = da || (na == 256); db = db || (nb == 256);
            }
            if (na != 256 || nb != 256) {
                int needa, needb;
                {
                    int c0 = 0, c1 = 0;
#pragma unroll
                    for (int j = 0; j < 32; ++j)
                        if (j < jmax) { c0 += (ka[j] > Ta); c1 += (kb[j] > Tb); }
                    needa = 256 - wave_total_i(c0); needb = 256 - wave_total_i(c1);
                }
                Ca = 0; Cb = 0;
                for (int bit = 10; bit >= 0; --bit) {
                    const int ca_ = Ca | (1 << bit), cb_ = Cb | (1 << bit);
                    int c0 = 0, c1 = 0;
#pragma unroll
                    for (int j = 0; j < 32; ++j)
                        if (j < jmax) { const int s = lane + 64 * j; c0 += (ka[j] == Ta && s < ca_); c1 += (kb[j] == Tb && s < cb_); }
                    c0 = wave_total_i(c0); c1 = wave_total_i(c1);
                    if (c0 < needa) Ca = ca_;
                    if (c1 < needb) Cb = cb_;
                }
            }
        }
        const size_t rowa = (size_t)b * 2048 + t0 + qa;
#pragma unroll
        for (int j = 0; j < 32; ++j) {
            const int s = lane + 64 * j;
            const unsigned long long ma = __ballot((ka[j] > Ta) || (ka[j] == Ta && s <= Ca));
            const unsigned long long mb = __ballot((kb[j] > Tb) || (kb[j] == Tb && s <= Cb));
            if (lane == 0) {
                __hip_atomic_store(&BM64[rowa * 32 + j], ma, __ATOMIC_RELAXED, __HIP_MEMORY_SCOPE_AGENT);
                __hip_atomic_store(&BM64[(rowa + 1) * 32 + j], mb, __ATOMIC_RELAXED, __HIP_MEMORY_SCOPE_AGENT);
            }
        }
    }
    __syncthreads();
}

__device__ void dsa_attn_item(const Params& p, int b, int h, int qg, char* smem_) {
    constexpr int KSTR = 136, VSTR = 40;
    bf16_t* Kl = (bf16_t*)smem_;
    bf16_t* Vl = Kl + 2 * 32 * KSTR;
    const int tid = TIDX(), lane = tid & 63, wave = __builtin_amdgcn_readfirstlane(tid >> 6), fr = lane & 15, fq = lane >> 4;
    const bf16_t* Z = (const bf16_t*)(p.ws + WS_Z); const bf16_t* VT = (const bf16_t*)(p.ws + WS_VT);
    const unsigned* BM = (const unsigned*)(p.ws + WS_BM); bf16_t* Y = (bf16_t*)(p.ws + WS_Y);
    const int kr = tid >> 4, kc = tid & 15, vd = tid >> 2, vc = tid & 3;
    const int ka_row = 8 * (fr >> 2) + (fr & 3);
    {
        const int t0 = qg * 128 + wave * 16;
        const size_t trow = (size_t)b * 2048 + t0 + fr;
        bf16x8 qf[4];
#pragma unroll
        for (int ks = 0; ks < 4; ++ks) qf[ks] = *(const bf16x8*)(Z + trow * LDZ + ZB_Q + h * 128 + ks * 32 + fq * 8);
        f32x4 o[8];
#pragma unroll
        for (int i = 0; i < 8; ++i) o[i] = f32x4{0.f, 0.f, 0.f, 0.f};
        float m = -INFINITY, lsum = 0.f;
        const unsigned* bmrow = BM + trow * 64;
        const int nsteps_blk = qg * 4 + 4, nsteps_w = (t0 + 15) / 32 + 1;
        const bf16_t* kg = Z + ((size_t)b * 2048 + kr) * LDZ + ZB_K + h * 128 + kc * 8;
        const bf16_t* vg = VT + ((size_t)(b * 4 + h) * 128 + vd) * 2048 + vc * 8;
        u32x4 rk = *(const u32x4*)kg, rv = *(const u32x4*)vg;
        *(u32x4*)(Kl + kr * KSTR + kc * 8) = rk; *(u32x4*)(Vl + vd * VSTR + vc * 8) = rv;
        __syncthreads();
        unsigned mwn = bmrow[0];
        for (int st = 0; st < nsteps_blk; ++st) {
            const bool more = (st + 1 < nsteps_blk);
            const unsigned mwc = mwn;
            mwn = bmrow[(st + 1 < nsteps_w) ? st + 1 : st];
            if (more) { rk = *(const u32x4*)(kg + (size_t)(st + 1) * 32 * LDZ); rv = *(const u32x4*)(vg + (st + 1) * 32); }
            if (st < nsteps_w) {
                const bf16_t* Kb = Kl + (st & 1) * 32 * KSTR; const bf16_t* Vb = Vl + (st & 1) * 128 * VSTR;
                f32x4 sa = f32x4{0.f, 0.f, 0.f, 0.f}, sb = f32x4{0.f, 0.f, 0.f, 0.f};
#pragma unroll
                for (int ks = 0; ks < 4; ++ks) {
                    const bf16x8 fa = *(const bf16x8*)(Kb + ka_row * KSTR + ks * 32 + fq * 8), fb = *(const bf16x8*)(Kb + (ka_row + 4) * KSTR + ks * 32 + fq * 8);
                    sa = __builtin_amdgcn_mfma_f32_16x16x32_bf16(fa, qf[ks], sa, 0, 0, 0);
                    sb = __builtin_amdgcn_mfma_f32_16x16x32_bf16(fb, qf[ks], sb, 0, 0, 0);
                }
                const unsigned mw = mwc >> (8 * fq);
                float x[8];
#pragma unroll
                for (int r = 0; r < 4; ++r) { x[r] = ((mw >> r) & 1u) ? sa[r] : -INFINITY; x[4 + r] = ((mw >> (4 + r)) & 1u) ? sb[r] : -INFINITY; }
                float mx = fmaxf(fmaxf(fmaxf(x[0], x[1]), fmaxf(x[2], x[3])), fmaxf(fmaxf(x[4], x[5]), fmaxf(x[6], x[7])));
                mx = fmaxf(mx, shx<16>(mx)); mx = fmaxf(mx, shx<32>(mx));
                const float mnew = fmaxf(m, mx);
                const float msafe = (mnew == -INFINITY) ? 0.f : mnew;
                const float alpha = __expf(m - msafe);
                float pe[8]; float ps = 0.f;
#pragma unroll
                for (int j = 0; j < 8; ++j) { pe[j] = __expf(x[j] - msafe); ps += pe[j]; }
                lsum = lsum * alpha + ps;
                m = mnew;
#pragma unroll
                for (int i = 0; i < 8; ++i) { o[i][0] *= alpha; o[i][1] *= alpha; o[i][2] *= alpha; o[i][3] *= alpha; }
                union { bf16x8 v; unsigned u[4]; } pf;
                pf.u[0] = pack2(pe[0], pe[1]); pf.u[1] = pack2(pe[2], pe[3]); pf.u[2] = pack2(pe[4], pe[5]); pf.u[3] = pack2(pe[6], pe[7]);
#pragma unroll
                for (int i = 0; i < 8; ++i) {
                    const bf16x8 vf = *(const bf16x8*)(Vb + (i * 16 + fr) * VSTR + fq * 8);
                    o[i] = __builtin_amdgcn_mfma_f32_16x16x32_bf16(vf, pf.v, o[i], 0, 0, 0);
                }
            }
            if (more) { *(u32x4*)(Kl + ((st + 1) & 1) * 32 * KSTR + kr * KSTR + kc * 8) = rk; *(u32x4*)(Vl + ((st + 1) & 1) * 128 * VSTR + vd * VSTR + vc * 8) = rv; }
            __syncthreads();
        }
        lsum += shx<16>(lsum); lsum += shx<32>(lsum);
        const float inv = 1.f / lsum;
#pragma unroll
        for (int i = 0; i < 8; ++i) {
            uint2 ov; ov.x = pack2(o[i][0] * inv, o[i][1] * inv); ov.y = pack2(o[i][2] * inv, o[i][3] * inv);
            *(uint2*)(Y + trow * 1536 + 512 + h * 128 + i * 16 + 4 * fq) = ov;
        }
    }
}

constexpr int LDS_BYTES = 155648;
__device__ void ph_mixA(const Params& p, int l, int vb0, int nvb, char* smem_) {
    for (int item = vb0; item < 64; item += nvb) {
        if (item < 32) scan2_item<128, false>(p, l, item >> 2, item & 3, smem_);
        else scan2_item<64, true>(p, l, (item - 32) >> 2, (item - 32) & 3, smem_);
    }
    unsigned* ctr = (unsigned*)(p.ws + WS_CTL) + 3584 + l * 64;
    unsigned* done = (unsigned*)(p.ws + WS_CTL) + 5300 + l * 8 * 16;
    volatile int* slot = (volatile int*)(smem_ + LDS_BYTES - 64);
    for (;;) {
        if (TIDX() == 0) *slot = (int)atomicAdd(ctr, 1u);
        __syncthreads();
        const int idx = __builtin_amdgcn_readfirstlane(*slot);
        __syncthreads();
        if (idx >= 2048) break;
        if (idx < 1536) {
            const int b = idx / 192, r = idx % 192;
            if (r < 128) dsa_select_tile(p, b, 127 - r, smem_);
            else dsaprep2_item(p, l, b * 64 + (r - 128), smem_);
            asm volatile("s_waitcnt vmcnt(0)" ::: "memory");
            __syncthreads();
            if (TIDX() == 0) __hip_atomic_fetch_add(done + b * 16, 1u, __ATOMIC_RELAXED, __HIP_MEMORY_SCOPE_AGENT);
        } else {
            const int a = idx - 1536, b = a >> 6, h = (a >> 4) & 3, qg = 15 - (a & 15);
            if (TIDX() == 0) {
                unsigned spins = 0;
                while (__hip_atomic_load(done + b * 16, __ATOMIC_RELAXED, __HIP_MEMORY_SCOPE_AGENT) < 192u) { __builtin_amdgcn_s_sleep(2); if (++spins > (1u << 18)) break; }
                __builtin_amdgcn_fence(__ATOMIC_ACQUIRE, "agent");
                asm volatile("s_waitcnt vmcnt(0)" ::: "memory");
            }
            __syncthreads();
            dsa_attn_item(p, b, h, qg, smem_);
        }
    }
}

__device__ __forceinline__ int f2sort(float f) { int i = __float_as_int(f); return i ^ ((i >> 31) & 0x7fffffff); }
__device__ __forceinline__ float sort2f(int i) { return __int_as_float(i ^ ((i >> 31) & 0x7fffffff)); }
#define INSK(K, xv) do { int _x = (xv); \
    _Pragma("unroll") for (int _j = 0; _j < 16; ++_j) { int _hi = max(K[_j], _x); _x = min(K[_j], _x); K[_j] = _hi; } } while (0)
#define INS64(K, xv) do { unsigned long long _x = (xv); \
    _Pragma("unroll") for (int _j = 0; _j < 16; ++_j) { bool _c = _x > K[_j]; unsigned long long _o = K[_j]; K[_j] = _c ? _x : _o; _x = _c ? _o : _x; } } while (0)

__device__ void ph_route(const Params& p, int vb0, int nvb, char* smem_) {
    typedef _Float16 h8 __attribute__((ext_vector_type(8)));
    const _Float16* SC = (const _Float16*)(p.ws + WS_SC);
    int* RI = (int*)(p.ws + WS_RI); float* RG = (float*)(p.ws + WS_RG);
    const int tid = TIDX(), lane = tid & 63, wave = tid >> 6;
    _Float16* tile = (_Float16*)smem_ + wave * (64 * 72);
    for (int item0 = (vb0 * 8 + wave) * 64; item0 < T_TOK * 8; item0 += nvb * 8 * 64) {
        const int item = item0 + lane;
        const int t = item >> 3, h = item & 7;
        const _Float16* s0 = SC + (size_t)t * 2048 + h * 256;
        const _Float16* wbase = SC + (size_t)item0 * 256;
        int k0[16], k1[16];
#pragma unroll
        for (int j = 0; j < 16; ++j) { k0[j] = (int)0x80000000; k1[j] = (int)0x80000000; }
#pragma unroll 1
        for (int slab = 0; slab < 4; ++slab) {
            h8 ld[8];
#pragma unroll
            for (int j = 0; j < 4; ++j) {
                const _Float16* src = wbase + (size_t)(16 * j + (lane >> 2)) * 256 + slab * 32 + (lane & 3) * 8;
                ld[j] = *(const h8*)src; ld[4 + j] = *(const h8*)(src + 128);
            }
            __builtin_amdgcn_wave_barrier();
#pragma unroll
            for (int j = 0; j < 4; ++j) {
                _Float16* dst = tile + (16 * j + (lane >> 2)) * 72 + (lane & 3) * 8;
                *(h8*)dst = ld[j]; *(h8*)(dst + 32) = ld[4 + j];
            }
            __builtin_amdgcn_fence(__ATOMIC_RELEASE, "wavefront");
            __builtin_amdgcn_wave_barrier();
            __builtin_amdgcn_fence(__ATOMIC_ACQUIRE, "wavefront");
#pragma unroll 2
            for (int ii = 0; ii < 32; ii += 8) {
                const int i = slab * 32 + ii;
                const h8 a = *(const h8*)(tile + lane * 72 + ii), b = *(const h8*)(tile + lane * 72 + 32 + ii);
#pragma unroll
                for (int e_ = 0; e_ < 8; ++e_) {
                    INSK(k0, (f2sort((float)a[e_]) & ~127) | (127 - i - e_));
                    INSK(k1, (f2sort((float)b[e_]) & ~127) | (127 - i - e_));
                }
            }
            __builtin_amdgcn_wave_barrier();
        }
        float v0[16], v1[16];
#pragma unroll
        for (int j = 0; j < 16; ++j) { k0[j] = 127 - (k0[j] & 127); k1[j] = 127 - (k1[j] & 127); v0[j] = (float)s0[k0[j]]; v1[j] = (float)s0[128 + k1[j]]; }
        unsigned long long ck[16];
#pragma unroll
        for (int j = 0; j < 16; ++j) ck[j] = 0ull;
#pragma unroll
        for (int a = 0; a < 16; ++a)
#pragma unroll
            for (int b = 0; b < 16; ++b)
                if ((a + 1) * (b + 1) <= 16) {
                    unsigned hi = (unsigned)f2sort(v0[a] + v1[b]) ^ 0x80000000u;
                    unsigned lo = ((unsigned)(255 - (a * 16 + b)) << 16) | (unsigned)(k0[a] * 128 + k1[b]);
                    INS64(ck, ((unsigned long long)hi << 32) | lo);
                }
        float e[16]; float sm = 0.f;
        const float mx = sort2f((int)((unsigned)(ck[0] >> 32) ^ 0x80000000u));
#pragma unroll
        for (int j = 0; j < 16; ++j) { e[j] = expf(sort2f((int)((unsigned)(ck[j] >> 32) ^ 0x80000000u)) - mx); sm += e[j]; }
        const float inv = 1.f / sm;
#pragma unroll
        for (int j = 0; j < 16; j += 4) {
            *(int4*)(RI + (size_t)t * 128 + h * 16 + j) = make_int4((int)(ck[j] & 0xffffu), (int)(ck[j + 1] & 0xffffu), (int)(ck[j + 2] & 0xffffu), (int)(ck[j + 3] & 0xffffu));
            *(float4*)(RG + (size_t)t * 128 + h * 16 + j) = make_float4(e[j] * inv, e[j + 1] * inv, e[j + 2] * inv, e[j + 3] * inv);
        }
    }
}

__device__ __forceinline__ void fp8x16_to_f32(const uint4 q, float (&f)[16]) {
    const unsigned w[4] = {q.x, q.y, q.z, q.w};
#pragma unroll
    for (int c = 0; c < 4; ++c) {
        auto f0 = __builtin_amdgcn_cvt_pk_f32_fp8((int)w[c], false); auto f1 = __builtin_amdgcn_cvt_pk_f32_fp8((int)w[c], true);
        f[4 * c] = f0[0]; f[4 * c + 1] = f0[1]; f[4 * c + 2] = f1[0]; f[4 * c + 3] = f1[1];
    }
}
constexpr bool G1_MFMA = true;
typedef float f32x2_t __attribute__((ext_vector_type(2)));
__device__ __forceinline__ float g1_half(const u32x4 (&uq)[8], const float (&hv)[16], int lane) {
    float part[8];
#pragma unroll
    for (int it = 0; it < 8; ++it) {
        f32x2_t d2 = {0.f, 0.f};
#pragma unroll
        for (int c_ = 0; c_ < 4; ++c_) {
            const f32x2_t f0 = __builtin_amdgcn_cvt_pk_f32_fp8((int)uq[it][c_], false), f1 = __builtin_amdgcn_cvt_pk_f32_fp8((int)uq[it][c_], true);
            d2 = __builtin_elementwise_fma(f32x2_t{hv[4 * c_], hv[4 * c_ + 1]}, f0, d2);
            d2 = __builtin_elementwise_fma(f32x2_t{hv[4 * c_ + 2], hv[4 * c_ + 3]}, f1, d2);
        }
        part[it] = d2[0] + d2[1];
    }
    float r4[4], r2[2];
    const bool b2_ = lane & 4, b1_ = lane & 2, b0_ = lane & 1;
#pragma unroll
    for (int j = 0; j < 4; ++j) { const float snd = b2_ ? part[j] : part[j + 4], kp = b2_ ? part[j + 4] : part[j]; r4[j] = kp + shx<4>(snd); }
#pragma unroll
    for (int j = 0; j < 2; ++j) { const float snd = b1_ ? r4[j] : r4[j + 2], kp = b1_ ? r4[j + 2] : r4[j]; r2[j] = kp + shx<2>(snd); }
    const float snd = b0_ ? r2[0] : r2[1], kp = b0_ ? r2[1] : r2[0];
    return kp + shx<1>(snd);
}
__device__ __forceinline__ void peer_gather8(u32x4 (&q)[8], const unsigned char* tab, const int* idx, unsigned l16) {
#pragma unroll
    for (int it = 0; it < 8; ++it) { const unsigned e_ = (unsigned)idx[it * 8]; q[it] = *(const u32x4*)(tab + ((e_ << 7) | l16)); }
}
template <bool PRE>
__device__ __forceinline__ void g1_step(int i, int t, const bf16_t* hrow_next, const unsigned char* ub, const int* lri_eg, unsigned l16, int lane, float* pp_row,
                                        u32x4& hq0, u32x4& hq1, u32x4 (&uqA)[8], u32x4 (&uqB)[8]) {
    float hv[16];
#pragma unroll
    for (int c_ = 0; c_ < 4; ++c_) { hv[2 * c_] = bflo(hq0[c_]); hv[2 * c_ + 1] = bfhi(hq0[c_]); hv[8 + 2 * c_] = bflo(hq1[c_]); hv[8 + 2 * c_ + 1] = bfhi(hq1[c_]); }
    if (PRE) { const u32x4* hp = (const u32x4*)hrow_next; hq0 = hp[0]; hq1 = hp[1]; }
    const float d0 = g1_half(uqA, hv, lane);
    __builtin_amdgcn_sched_barrier(0);
    if (PRE) { peer_gather8(uqA, ub, lri_eg + (i + 1) * 128, l16); __builtin_amdgcn_sched_barrier(0); }
    const float d1 = g1_half(uqB, hv, lane);
    __builtin_amdgcn_sched_barrier(0);
    if (PRE) { peer_gather8(uqB, ub, lri_eg + (i + 1) * 128 + 64, l16); __builtin_amdgcn_sched_barrier(0); }
    pp_row[0] = d0; pp_row[64] = d1;
}
template <bool PRE>
__device__ __forceinline__ void g2_step(int i, float2* op, const float2 gf, const unsigned char* vb_, const int* lri_eg, const float* lrg_eg, unsigned l16, int lane,
                                        u32x4 (&vqA)[8], u32x4 (&vqB)[8]) {
    const float2 xi = *op;
    f32x2_t y[8];
#pragma unroll
    for (int j = 0; j < 8; ++j) y[j] = f32x2_t{0.f, 0.f};
#pragma unroll
    for (int it = 0; it < 8; ++it) {
        const float ck = lrg_eg[i * 128 + it * 8]; const f32x2_t ck2 = {ck, ck};
#pragma unroll
        for (int c_ = 0; c_ < 4; ++c_) {
            y[2 * c_] = __builtin_elementwise_fma(ck2, __builtin_amdgcn_cvt_pk_f32_fp8((int)vqA[it][c_], false), y[2 * c_]);
            y[2 * c_ + 1] = __builtin_elementwise_fma(ck2, __builtin_amdgcn_cvt_pk_f32_fp8((int)vqA[it][c_], true), y[2 * c_ + 1]);
        }
    }
    __builtin_amdgcn_sched_barrier(0);
    if (PRE) { peer_gather8(vqA, vb_, lri_eg + (i + 1) * 128, l16); __builtin_amdgcn_sched_barrier(0); }
#pragma unroll
    for (int it = 0; it < 8; ++it) {
        const float ck = lrg_eg[i * 128 + 64 + it * 8]; const f32x2_t ck2 = {ck, ck};
#pragma unroll
        for (int c_ = 0; c_ < 4; ++c_) {
            y[2 * c_] = __builtin_elementwise_fma(ck2, __builtin_amdgcn_cvt_pk_f32_fp8((int)vqB[it][c_], false), y[2 * c_]);
            y[2 * c_ + 1] = __builtin_elementwise_fma(ck2, __builtin_amdgcn_cvt_pk_f32_fp8((int)vqB[it][c_], true), y[2 * c_ + 1]);
        }
    }
    __builtin_amdgcn_sched_barrier(0);
    if (PRE) { peer_gather8(vqB, vb_, lri_eg + (i + 1) * 128 + 64, l16); __builtin_amdgcn_sched_barrier(0); }
    float r8[8], r4[4], r2[2];
    const bool b5 = lane & 32, b4 = lane & 16, b3 = lane & 8;
#pragma unroll
    for (int j = 0; j < 8; ++j) { const float lo = y[j >> 1][j & 1], hi = y[4 + (j >> 1)][j & 1]; const float snd = b5 ? lo : hi, kp = b5 ? hi : lo; r8[j] = kp + shx<32>(snd); }
#pragma unroll
    for (int j = 0; j < 4; ++j) { const float snd = b4 ? r8[j] : r8[j + 4], kp = b4 ? r8[j + 4] : r8[j]; r4[j] = kp + shx<16>(snd); }
#pragma unroll
    for (int j = 0; j < 2; ++j) { const float snd = b3 ? r4[j] : r4[j + 2], kp = b3 ? r4[j + 2] : r4[j]; r2[j] = kp + shx<8>(snd); }
    *op = make_float2(xi.x + gf.x * r2[0], xi.y + gf.y * r2[1]);
}
typedef int i32x4_t __attribute__((ext_vector_type(4)));
typedef int i32x8_t __attribute__((ext_vector_type(8)));
constexpr int G1W = 18432;
__device__ __forceinline__ void g1m_dma(const unsigned char* ub, PG8_LAS unsigned char* img, const PG8_LAS unsigned short* idx, int i, int hh, int eg, unsigned q16) {
    const u32x4 w = *(const PG8_LAS u32x4*)(idx + ((i * 8 + eg) * 16 + hh * 8));
#pragma unroll
    for (int it = 0; it < 8; ++it) {
        const unsigned e_ = (it & 1) ? (w[it >> 1] >> 16) : (w[it >> 1] & 0xffffu);
        const unsigned off = (e_ << 7) | ((it & 1) ? (q16 ^ 64u) : q16);
        __builtin_amdgcn_global_load_lds((const unsigned*)(ub + off), (PG8_LAS unsigned*)(img + it * 1024), 16, 0, 0);
    }
}
template <bool PRE, int VMW>
__device__ __forceinline__ float g1m_step(const unsigned char* ub, PG8_LAS unsigned char* img, const PG8_LAS unsigned short* idx, int inext, int hh, int eg, unsigned q16,
                                          unsigned rdoff, int lane, const u32x4 a0, const u32x4 a1) {
    asm volatile("s_waitcnt vmcnt(%0)" :: "n"(VMW) : "memory");
    i32x8_t b[4];
#pragma unroll
    for (int mb = 0; mb < 4; ++mb) {
        const unsigned ro = (unsigned)mb * 2048u + rdoff;
        const i32x4_t lo = *(const PG8_LAS i32x4_t*)(img + ro), hi = *(const PG8_LAS i32x4_t*)(img + (ro ^ 64u));
        b[mb] = __builtin_shufflevector(lo, hi, 0, 1, 2, 3, 4, 5, 6, 7);
    }
    asm volatile("s_waitcnt lgkmcnt(0)" ::: "memory");
    if (PRE) g1m_dma(ub, img, idx, inext, hh, eg, q16);
    const i32x8_t a = __builtin_shufflevector((i32x4_t)a0, (i32x4_t)a1, 0, 1, 2, 3, 4, 5, 6, 7);
    float d[4]; f32x4 acc[4];
#pragma unroll
    for (int mb = 0; mb < 4; ++mb) acc[mb] = __builtin_amdgcn_mfma_scale_f32_16x16x128_f8f6f4(a, b[mb], f32x4{0.f, 0.f, 0.f, 0.f}, 0, 0, 0, 0x7f, 0, 0x7f);
#pragma unroll
    for (int mb = 0; mb < 4; ++mb) { d[mb] = acc[mb][0] + acc[mb][1] * (1.f / 16.f); asm volatile("" : "+v"(d[mb])); }
    const int g = lane >> 4;
    return g == 0 ? d[0] : g == 1 ? d[1] : g == 2 ? d[2] : d[3];
}
__device__ __forceinline__ void g1m_chunk(const Params& p, int x, int tb, char* smem_, int lane) {
    PG8_LAS unsigned char* wl = (PG8_LAS unsigned char*)smem_ + p.wv * G1W;
    PG8_LAS unsigned short* idx = (PG8_LAS unsigned short*)(wl + 16384);
    const int* RI = (const int*)(p.ws + WS_RI);
    {
        int ra[16];
#pragma unroll
        for (int i = 0; i < 8; ++i) { ra[2 * i] = RI[(size_t)(tb + i) * 128 + lane]; ra[2 * i + 1] = RI[(size_t)(tb + i) * 128 + 64 + lane]; }
#pragma unroll
        for (int i = 0; i < 8; ++i) {
            idx[(i * 8 + (lane & 7)) * 16 + (lane >> 3)] = (unsigned short)ra[2 * i];
            idx[(i * 8 + (lane & 7)) * 16 + 8 + (lane >> 3)] = (unsigned short)ra[2 * i + 1];
        }
    }
    __builtin_amdgcn_fence(__ATOMIC_RELEASE, "wavefront");
    __builtin_amdgcn_wave_barrier();
    __builtin_amdgcn_fence(__ATOMIC_ACQUIRE, "wavefront");
    const int eg = lane >> 3, n = lane & 15, kb = lane >> 4;
    const unsigned q16 = (unsigned)(((lane & 7) ^ (eg >> 1)) * 16);
    const unsigned rdoff = (unsigned)(n * 128 + ((kb ^ (n >> 1)) * 16));
    const unsigned char* ub = p.ws + WS_PU + (size_t)x * (16384u * 128u);
    const unsigned char* h8 = p.ws + ((lane & 1) ? WS_H8L : WS_H8H) + (size_t)tb * 1024 + x * 128 + kb * 16;
    float* pp = (float*)(p.ws + WS_PP) + ((size_t)x * T_TOK + tb) * 128 + lane;
    u32x4 ha[8][2];
#pragma unroll
    for (int i = 0; i < 8; ++i) { ha[i][0] = *(const u32x4*)(h8 + (size_t)i * 1024); ha[i][1] = *(const u32x4*)(h8 + (size_t)i * 1024 + 64); }
#pragma unroll
    for (int i = 0; i < 8; ++i) { asm volatile("" : "+v"(ha[i][0])); asm volatile("" : "+v"(ha[i][1])); }
    g1m_dma(ub, wl, idx, 0, 0, eg, q16);
    g1m_dma(ub, wl + 8192, idx, 0, 1, eg, q16);
    asm volatile("s_waitcnt vmcnt(8)" ::: "memory");
#pragma unroll
    for (int i = 0; i < 7; ++i) {
        const float v0 = g1m_step<true, 9>(ub, wl, idx, i + 1, 0, eg, q16, rdoff, lane, ha[i][0], ha[i][1]);
        pp[(size_t)i * 128] = v0;
        const float v1 = g1m_step<true, 9>(ub, wl + 8192, idx, i + 1, 1, eg, q16, rdoff, lane, ha[i][0], ha[i][1]);
        pp[(size_t)i * 128 + 64] = v1;
    }
    {
        const float v0 = g1m_step<false, 9>(ub, wl, idx, 0, 0, eg, q16, rdoff, lane, ha[7][0], ha[7][1]);
        pp[(size_t)7 * 128] = v0;
        const float v1 = g1m_step<false, 0>(ub, wl + 8192, idx, 0, 1, eg, q16, rdoff, lane, ha[7][0], ha[7][1]);
        pp[(size_t)7 * 128 + 64] = v1;
    }
}
template <int WHICH>
__device__ void ph_peer_sliced(const Params& p, int l, char* smem_) {
    const int tid = TIDX(), wave = tid >> 6;
    const bf16_t* H = (const bf16_t*)(p.ws + WS_H); const unsigned char* PU = p.ws + WS_PU; const unsigned char* PV = p.ws + WS_PV;
    const int* RI = (const int*)(p.ws + WS_RI); float* RG = (float*)(p.ws + WS_RG); float* PP = (float*)(p.ws + WS_PP);
    const float* modb = (const float*)(p.ws + WS_MOD);
    {
    unsigned* ctr = (unsigned*)(p.ws + WS_CTL) + 3712 + (l * 2 + WHICH) * 128;
    volatile int* slot = (volatile int*)(smem_ + LDS_BYTES - 64);
    const int xcc = (int)(xb_xcc_id() & 7u);
    for (int so = 0; so < 8; ++so) {
        const int x = (xcc + so) & 7;
        for (;;) {
            if (tid == 0) *slot = (int)atomicAdd(ctr + x * 16, 1u);
            __syncthreads();
            const int chunk = __builtin_amdgcn_readfirstlane(*slot);
            __syncthreads();
            if (chunk >= 256) break;
            {
                const int lane = lane_id_opaque(), eg = lane >> 3, ll = lane & 7;
                const int tb = chunk * 64 + wave * 8;
                if (WHICH == 0 && G1_MFMA) { g1m_chunk(p, x, tb, smem_, lane); continue; }
                int* lri = (int*)smem_ + wave * 2048; float* lrg = (float*)(lri + 1024);
                {
                    int ra[16]; float rg_[16];
#pragma unroll
                    for (int i = 0; i < 8; ++i) {
                        ra[2 * i] = RI[(size_t)(tb + i) * 128 + lane]; ra[2 * i + 1] = RI[(size_t)(tb + i) * 128 + 64 + lane];
                        if (WHICH == 1) { rg_[2 * i] = RG[(size_t)(tb + i) * 128 + lane]; rg_[2 * i + 1] = RG[(size_t)(tb + i) * 128 + 64 + lane]; }
                    }
#pragma unroll
                    for (int i = 0; i < 8; ++i) {
                        lri[i * 128 + lane] = ra[2 * i]; lri[i * 128 + 64 + lane] = ra[2 * i + 1];
                        if (WHICH == 1) { lrg[i * 128 + lane] = rg_[2 * i]; lrg[i * 128 + 64 + lane] = rg_[2 * i + 1]; }
                    }
                }
                __builtin_amdgcn_fence(__ATOMIC_RELEASE, "wavefront");
                __builtin_amdgcn_wave_barrier();
                __builtin_amdgcn_fence(__ATOMIC_ACQUIRE, "wavefront");
                const unsigned l16 = (unsigned)ll * 16u;
                if (WHICH == 0) {
                    const unsigned char* ub = PU + (size_t)x * (16384u * 128u);
                    const bf16_t* hrow = H + (size_t)tb * 1024 + x * 128 + ll * 16;
                    float* pp_row = PP + ((size_t)x * T_TOK + tb) * 128 + ll * 8 + eg;
                    u32x4 hq0 = ((const u32x4*)hrow)[0], hq1 = ((const u32x4*)hrow)[1], uqA[8], uqB[8];
                    peer_gather8(uqA, ub, lri + eg, l16);
                    peer_gather8(uqB, ub, lri + eg + 64, l16);
#pragma unroll 1
                    for (int i = 0; i < 7; ++i) g1_step<true>(i, tb + i, hrow + (size_t)(i + 1) * 1024, ub, lri + eg, l16, lane, pp_row + (size_t)i * 128, hq0, hq1, uqA, uqB);
                    g1_step<false>(7, tb + 7, hrow, ub, lri + eg, l16, lane, pp_row + (size_t)7 * 128, hq0, hq1, uqA, uqB);
                } else {
                    const unsigned char* vb_ = PV + (size_t)x * (16384u * 128u);
                    const int col = x * 128 + ll * 16 + ((lane >> 5) & 1) * 8 + ((lane >> 4) & 1) * 4 + ((lane >> 3) & 1) * 2;
                    const float2 gf = *(const float2*)(modb + (size_t)(l * 8 + (tb >> 11)) * 6144 + 5120 + col);
                    float2* op = (float2*)(p.out + (size_t)tb * 1024 + col);
                    u32x4 vqA[8], vqB[8];
                    peer_gather8(vqA, vb_, lri + eg, l16);
                    peer_gather8(vqB, vb_, lri + eg + 64, l16);
#pragma unroll 1
                    for (int i = 0; i < 7; ++i) g2_step<true>(i, op + (size_t)i * 512, gf, vb_, lri + eg, lrg + eg, l16, lane, vqA, vqB);
                    g2_step<false>(7, op + (size_t)7 * 512, gf, vb_, lri + eg, lrg + eg, l16, lane, vqA, vqB);
                }
            }
        }
    }
    __syncthreads();
    }
}
__device__ void ph_peer_coef(const Params& p, int vb0, int nvb) {
    const int wave = TIDX() >> 6, lane = TIDX() & 63;
    float* RG = (float*)(p.ws + WS_RG); const float* PP = (const float*)(p.ws + WS_PP);
    for (int t0 = (vb0 * 8 + wave) * 2; t0 < T_TOK; t0 += nvb * 8 * 2) {
        float pp[2][2][8], g[2][2];
#pragma unroll
        for (int u = 0; u < 2; ++u)
#pragma unroll
            for (int half = 0; half < 2; ++half) {
                const int k = half * 64 + lane;
#pragma unroll
                for (int x = 0; x < 8; ++x) pp[u][half][x] = PP[((size_t)x * T_TOK + t0 + u) * 128 + k];
                g[u][half] = RG[(size_t)(t0 + u) * 128 + k];
            }
        asm volatile("" ::: "memory");
#pragma unroll
        for (int u = 0; u < 2; ++u)
#pragma unroll
            for (int half = 0; half < 2; ++half) {
                float d = 0.f;
#pragma unroll
                for (int x = 0; x < 8; ++x) d += pp[u][half][x];
                d *= (1.f / PU_SCALE);
                RG[(size_t)(t0 + u) * 128 + half * 64 + lane] = g[u][half] * 0.5f * d * (1.f + erff(d * 0.7071067811865476f)) * (1.f / PV_SCALE);
            }
    }
}

enum { PH_MOD = 0, PH_WPREP, PH_NORM1, PH_GEMM_IN, PH_SCAN, PH_MERGE, PH_OUT, PH_NORM2, PH_GEMM_Q, PH_GEMM_SC, PH_ROUTE, PH_G1, PH_G15, PH_G2 };

template <int PH>
__device__ __forceinline__ void run_phase(const Params& p, int l, int vb0, int nvb, char* smem) {
    const float* xin = (l == 0) ? p.x : p.out;
    if (PH == PH_MOD) ph_mod(p, vb0, nvb, smem);
    else if (PH == PH_WPREP) ph_wprep(p, l, vb0, nvb, smem);
    else if (PH == PH_NORM1) ph_norm(p, l, 0, xin, vb0, nvb);
    else if (PH == PH_GEMM_IN) {
        pg8::Gemm g{(const bf16_t*)(p.ws + WS_H), (const bf16_t*)(p.ws + WS_WIN), 1024, 1024, 1024};
        pg8::StaticOrder S; S.init(T_TOK, LDZ, nvb, vb0, 1024, 1024);
        pg8::gemm_phase(( PG8_LAS unsigned char*)smem, g, S, pg8::EpiBf16{(bf16_t*)(p.ws + WS_Z), LDZ}, TIDX());
    }
    else if (PH == PH_SCAN) ph_mixA(p, l, vb0, nvb, smem);
    else if (PH == PH_MERGE) {
        pg8::Gemm g{(const bf16_t*)(p.ws + WS_Y), (const bf16_t*)(p.ws + WS_WBR), 1536, 512, 512};
        pg8::MergeOrder S{vb0, nvb};
        pg8::gemm_phase((PG8_LAS unsigned char*)smem, g, S, pg8::EpiMerge{(bf16_t*)(p.ws + WS_H), (const bf16_t*)(p.ws + WS_Z)}, TIDX());
    }
    else if (PH == PH_OUT) {
        pg8::Gemm g{(const bf16_t*)(p.ws + WS_H), (const bf16_t*)(p.ws + WS_WOUT), 1024, 1024, 1024};
        pg8::StaticOrder S; S.init(T_TOK, 1024, nvb, vb0, 1024, 1024);
        pg8::gemm_phase((PG8_LAS unsigned char*)smem, g, S, pg8::EpiResid{xin, p.out, (const float*)(p.ws + WS_MOD) + (size_t)l * 8 * 6144}, TIDX());
    }
    else if (PH == PH_NORM2) ph_norm(p, l, 1, p.out, vb0, nvb);
    else if (PH == PH_GEMM_Q) {
        pg8::Gemm g{(const bf16_t*)(p.ws + WS_H), (const bf16_t*)(p.ws + WS_WQ), 1024, 1024, 1024};
        pg8::StaticOrder S; S.init(T_TOK, 2048, nvb, vb0, 1024, 1024);
        pg8::gemm_phase((PG8_LAS unsigned char*)smem, g, S, pg8::EpiBf16{(bf16_t*)(p.ws + WS_QP), 2048}, TIDX());
    }
    else if (PH == PH_GEMM_SC) gemm_phase((const bf16_t*)(p.ws + WS_QP), 2048, (const bf16_t*)(p.ws + WS_SK), 128, T_TOK, 2048, 128, true,
                                          EpiF16{(_Float16*)(p.ws + WS_SC), 2048}, vb0, nvb, smem, TIDX());
    else if (PH == PH_ROUTE) ph_route(p, vb0, nvb, smem);
    else if (PH == PH_G1) ph_peer_sliced<0>(p, l, smem);
    else if (PH == PH_G15) ph_peer_coef(p, vb0, nvb);
    else if (PH == PH_G2) ph_peer_sliced<1>(p, l, smem);

}

#define XB_TMO      128
#define XB_XCNT(j)  (256  + 64 * (j))
#define XB_XSUB(j)  (1280 + 64 * (j))
#define XB_XGEN(j)  (2304 + 64 * (j))
#define XB_TOP      3328
#define XB_TOPGEN   3392
#define XCD_BAR_WORDS 3456
#define XB_SPIN_CAP (1u << 18)
#define LAS __attribute__((address_space(3)))
__device__ __forceinline__ unsigned xb_ld(unsigned* p)              { return __hip_atomic_load(p, __ATOMIC_RELAXED, __HIP_MEMORY_SCOPE_AGENT); }
__device__ __forceinline__ unsigned xb_add(unsigned* p, unsigned v) { return __hip_atomic_fetch_add(p, v, __ATOMIC_RELAXED, __HIP_MEMORY_SCOPE_AGENT); }
#define XB_SPIN(cond, bar) do { unsigned _sp = 0; while (cond) { __builtin_amdgcn_s_sleep(1); \
    if ((++_sp & 255u) == 0u) { if (xb_ld(&(bar)[XB_TMO])) break; if (_sp > XB_SPIN_CAP) { atomicAdd(&(bar)[XB_TMO], 1u); break; } } } } while (0)
struct XcdBarrier { unsigned* bar; unsigned x; volatile LAS unsigned* st; int wv; };
__device__ __forceinline__ XcdBarrier xcd_barrier_post(unsigned* bar, volatile LAS unsigned* st, int wv) {
    XcdBarrier b; b.bar = bar; b.x = xb_xcc_id(); b.st = st; b.wv = wv;
    if (TIDXW(wv) == 0) (void)xb_add(&bar[XB_XCNT(b.x)], 1u);
    return b;
}
__device__ __forceinline__ void xcd_barrier_complete(unsigned* bar, unsigned x, unsigned& nloc, unsigned& nx) {
    const unsigned G = gridDim.x * gridDim.y * gridDim.z;
    unsigned sum, cnt, mine, sp = 0u;
    for (;;) {
        sum = 0u; cnt = 0u; mine = 0u;
#pragma unroll
        for (unsigned j = 0; j < 16; ++j) { const unsigned c = xb_ld(&bar[XB_XCNT(j)]); sum += c; cnt += (c > 0u) ? 1u : 0u; mine = (j == x) ? c : mine; }
        if (sum == G) break;
        __builtin_amdgcn_s_sleep(1);
        if ((++sp & 255u) == 0u) { if (xb_ld(&bar[XB_TMO])) break; if (sp > XB_SPIN_CAP) { atomicAdd(&bar[XB_TMO], 1u); break; } }
    }
    nloc = mine > 0u ? mine : 1u; nx = cnt > 0u ? cnt : 1u;
}
__device__ __forceinline__ void xcd_barrier(const XcdBarrier& b) {
    asm volatile("s_waitcnt vmcnt(0)" ::: "memory");
    __syncthreads();
    if (TIDXW(b.wv) == 0) {
        unsigned* bar = b.bar;
        __builtin_amdgcn_s_waitcnt(0);
        unsigned nloc = b.st[0], nx = b.st[1];
        if (nloc == 0u) { xcd_barrier_complete(bar, b.x, nloc, nx); b.st[0] = nloc; b.st[1] = nx; }
        const unsigned old = xb_add(&bar[XB_XSUB(b.x)], 1u);
        const unsigned gen = old / nloc;
        if (old + 1u == (gen + 1u) * nloc) {
            __builtin_amdgcn_fence(__ATOMIC_RELEASE, "agent");
            asm volatile("s_waitcnt vmcnt(0)" ::: "memory");
            const unsigned og = xb_add(&bar[XB_TOP], 1u);
            const unsigned tg = og / nx;
            if (og + 1u == (tg + 1u) * nx) xb_add(&bar[XB_TOPGEN], 1u);
            else XB_SPIN(xb_ld(&bar[XB_TOPGEN]) == tg, bar);
            __builtin_amdgcn_fence(__ATOMIC_ACQUIRE, "agent");
            xb_add(&bar[XB_XGEN(b.x)], 1u);
            asm volatile("s_waitcnt vmcnt(0)" ::: "memory");
        } else {
            XB_SPIN(xb_ld(&bar[XB_XGEN(b.x)]) == gen, bar);
            __builtin_amdgcn_fence(__ATOMIC_ACQUIRE, "agent");
            asm volatile("s_waitcnt vmcnt(0)" ::: "memory");
        }
    }
    __syncthreads();
}

__global__ void __launch_bounds__(NT) mega_kernel(Params p_in) {
#if defined(__HIP_DEVICE_COMPILE__)
    extern __shared__ __attribute__((aligned(16))) char smem[];
    volatile LAS unsigned* st = (volatile LAS unsigned*)(smem + LDS_BYTES - 16);
    int wv_ = __builtin_amdgcn_readfirstlane((int)threadIdx.x >> 6); asm volatile("" : "+s"(wv_));
    { const int t_ = TIDXW(wv_); if (t_ < 4) st[t_] = 0u; }
    __syncthreads();
    XcdBarrier bar = xcd_barrier_post((unsigned*)(p_in.ws + WS_CTL), st, wv_);
    const int vb = (int)blockIdx.x, nvb = (int)gridDim.x;
#define GB() xcd_barrier(bar)
#define RUN(PH, L) do { \
        const __attribute__((address_space(4))) Params* _kp = (const __attribute__((address_space(4))) Params*)__builtin_amdgcn_kernarg_segment_ptr(); asm volatile("" : "+s"(_kp)); Params _p = *_kp; _p.wv = wv_; \
        int _l = (L), _vb = vb, _nvb = nvb; asm volatile("" : "+s"(_l), "+s"(_vb), "+s"(_nvb)); \
        run_phase<PH>(_p, _l, _vb, _nvb, smem); } while (0)
    RUN(PH_MOD, 0);
#pragma unroll 1
    for (int l = 0; l < 2; ++l) {
        RUN(PH_WPREP, l); if (l == 0) GB();
        RUN(PH_NORM1, l); GB();
        RUN(PH_GEMM_IN, l); GB();
        RUN(PH_SCAN, l); GB();
        RUN(PH_MERGE, l); GB();
        RUN(PH_OUT, l); GB();
        RUN(PH_NORM2, l); GB();
        RUN(PH_GEMM_Q, l); GB();
        RUN(PH_GEMM_SC, l); GB();
        RUN(PH_ROUTE, l); GB();
        RUN(PH_G1, l); GB();
        RUN(PH_G15, l); GB();
        RUN(PH_G2, l);
        if (l == 0) GB();
    }
#undef RUN
#undef GB
#endif
}

extern "C" void kernel_launch(void* const* d_in, const int* in_sizes, int n_in, void* d_out, int out_size, void* d_ws, size_t ws_size,
                              hipStream_t stream) {
    if (n_in != 20 || ws_size < WS_END) { fprintf(stderr, "kernel_launch: bad inputs (n_in %d ws %zu need %zu)\n", n_in, ws_size, (size_t)WS_END); return; }
    Params p{};
    p.x = (const float*)d_in[0]; p.c = (const float*)d_in[1]; p.w_ada = (const float*)d_in[2]; p.b_ada = (const float*)d_in[3];
    p.norm_mix = (const float*)d_in[4]; p.norm_ffn = (const float*)d_in[5]; p.w_in = (const float*)d_in[6]; p.hgrn_lb = (const float*)d_in[7];
    p.hgrn_on = (const float*)d_in[8]; p.dsa_qn = (const float*)d_in[9]; p.dsa_kn = (const float*)d_in[10]; p.gla_up = (const float*)d_in[11];
    p.gla_bias = (const float*)d_in[12]; p.gla_on = (const float*)d_in[13]; p.w_branch = (const float*)d_in[14]; p.w_out = (const float*)d_in[15];
    p.peer_wq = (const float*)d_in[16]; p.peer_keys = (const float*)d_in[17]; p.peer_u = (const float*)d_in[18]; p.peer_v = (const float*)d_in[19];
    p.out = (float*)d_out; p.ws = (unsigned char*)d_ws;
    static int grid = 0;
    if (grid == 0) {
        int dev = 0, cus = 0, per_cu = 0;
        hipGetDevice(&dev);
        hipDeviceGetAttribute(&cus, hipDeviceAttributeMultiprocessorCount, dev);
        hipFuncSetAttribute((const void*)mega_kernel, hipFuncAttributeMaxDynamicSharedMemorySize, LDS_BYTES);
        hipOccupancyMaxActiveBlocksPerMultiprocessor(&per_cu, (const void*)mega_kernel, NT, LDS_BYTES);
        if (per_cu < 1) { fprintf(stderr, "kernel_launch: occupancy query says %d blocks per CU\n", per_cu); per_cu = 1; }
        (void)hipGetLastError();
        grid = cus;
    }
    hipMemsetAsync((char*)d_ws + WS_CTL, 0, 32768, stream);
    void* args[] = {&p};
    hipError_t e = hipLaunchCooperativeKernel((const void*)mega_kernel, dim3(grid), dim3(NT), args, LDS_BYTES, stream);
    if (e != hipSuccess) fprintf(stderr, "cooperative launch failed: %s (grid %d)\n", hipGetErrorString(e), grid);
}
```

```cpp
#include <hip/hip_runtime.h>
#include <stdint.h>
#include <stdio.h>

typedef unsigned short bf16_t;
typedef short bf16x8 __attribute__((ext_vector_type(8)));
typedef float f32x4 __attribute__((ext_vector_type(4)));
typedef unsigned u32x4 __attribute__((ext_vector_type(4)));

#define NT 512
constexpr int T_TOK = 16384, DM = 1024, SEQ = 2048;
constexpr int LDZ = 8704;
constexpr int ZA_Q = 0, ZA_F = 512, ZA_I = 1024, ZA_G = 1536, ZB_Q = 2048, ZB_K = 2560, ZB_V = 3072, ZC_V = 3584, ZC_G = 4096,
              ZB_QI = 4608, ZC_Q = 4864, ZC_K = 5120, ZB_KI = 5376, ZB_WI = 5440, ZC_CODE = 5444, ZM = 5632;
constexpr int IN_COLS = 8532;

constexpr size_t al256(size_t x) { return (x + 255) & ~(size_t)255; }
constexpr size_t WS_CTL = 0;
constexpr size_t WS_MOD = 65536;
constexpr size_t WS_WIN = al256(WS_MOD + (size_t)2 * 8 * 6144 * 4);
constexpr size_t WS_WBR = al256(WS_WIN + (size_t)LDZ * 1024 * 2);
constexpr size_t WS_WOUT = al256(WS_WBR + (size_t)3 * 1024 * 512 * 2);
constexpr size_t WS_WQ = al256(WS_WOUT + (size_t)1024 * 1024 * 2);
constexpr size_t WS_SK = al256(WS_WQ + (size_t)2048 * 1024 * 2);
constexpr size_t WS_PU = al256(WS_SK + (size_t)16 * 128 * 128 * 2);
constexpr size_t WS_PV = al256(WS_PU + (size_t)16384 * 1024);
constexpr size_t WS_H = al256(WS_PV + (size_t)16384 * 1024);
constexpr float PU_SCALE = 32.f, PV_SCALE = 4.f;
constexpr size_t WS_OA = al256(WS_H + (size_t)T_TOK * 1024 * 2);
constexpr size_t WS_OC = al256(WS_OA + (size_t)T_TOK * 512 * 2);
constexpr size_t WS_H8H = WS_OA, WS_H8L = WS_OC;
constexpr size_t WS_Y = al256(WS_OC + (size_t)T_TOK * 512 * 2);
constexpr size_t WS_Z = al256(WS_Y + (size_t)T_TOK * 1536 * 2);
constexpr size_t WS_VT = al256(WS_Z + (size_t)T_TOK * LDZ * 2);
constexpr size_t WS_BM = al256(WS_VT + (size_t)T_TOK * 512 * 2);
constexpr size_t WS_END = al256(WS_BM + (size_t)T_TOK * 64 * 4);
constexpr size_t WS_QP = WS_Z;
constexpr size_t WS_SC = al256(WS_QP + (size_t)T_TOK * 2048 * 2);
constexpr size_t WS_RI = al256(WS_SC + (size_t)T_TOK * 2048 * 4);
constexpr size_t WS_RG = al256(WS_RI + (size_t)T_TOK * 128 * 4);
constexpr size_t WS_PP = al256(WS_RG + (size_t)T_TOK * 128 * 4);
constexpr size_t WS_C8H = WS_SC;
constexpr size_t WS_C8L = WS_C8H + (size_t)T_TOK * 128;
constexpr size_t WS_CINV = WS_C8L + (size_t)T_TOK * 128;
static_assert(WS_PP + (size_t)8 * T_TOK * 128 * 4 <= WS_VT, "peer partials overflow the Z region");
static_assert(WS_RG + (size_t)T_TOK * 128 * 4 <= WS_END, "peer alias overflow");

struct Params {
    const float* x; const float* c; const float* w_ada; const float* b_ada; const float* norm_mix; const float* norm_ffn;
    const float* w_in; const float* hgrn_lb; const float* hgrn_on; const float* dsa_qn; const float* dsa_kn;
    const float* gla_up; const float* gla_bias; const float* gla_on; const float* w_branch; const float* w_out;
    const float* peer_wq; const float* peer_keys; const float* peer_u; const float* peer_v;
    float* out; unsigned char* ws;
    int wv, pad;
};

__device__ __forceinline__ float bf2f(bf16_t h) { return __uint_as_float(((unsigned)h) << 16); }
__device__ __forceinline__ float bflo(unsigned u) { return __uint_as_float(u << 16); }
__device__ __forceinline__ float bfhi(unsigned u) { return __uint_as_float(u & 0xffff0000u); }
__device__ __forceinline__ bf16_t f2bf(float f) { unsigned r; asm volatile("v_cvt_pk_bf16_f32 %0, %1, %1" : "=v"(r) : "v"(f)); return (bf16_t)(r & 0xffffu); }
__device__ __forceinline__ unsigned pack2(float a, float b) { unsigned r; asm volatile("v_cvt_pk_bf16_f32 %0, %1, %2" : "=v"(r) : "v"(a), "v"(b)); return r; }
__device__ __forceinline__ int lane_id_opaque() { int l; asm volatile("v_mbcnt_lo_u32_b32 %0, -1, 0\n\tv_mbcnt_hi_u32_b32 %0, -1, %0" : "=v"(l)); return l; }
template <int M> __device__ __forceinline__ int shx_i(int v) {
    if (M < 32) return __builtin_amdgcn_ds_swizzle(v, (M << 10) | 0x1f);
    return __builtin_amdgcn_ds_bpermute((lane_id_opaque() ^ 32) << 2, v);
}
template <int M> __device__ __forceinline__ float shx(float v) { return __int_as_float(shx_i<M>(__float_as_int(v))); }
template <int M> __device__ __forceinline__ int shx(int v) { return shx_i<M>(v); }
template <int M> __device__ __forceinline__ unsigned shx(unsigned v) { return (unsigned)shx_i<M>((int)v); }
__device__ __forceinline__ int bperm(int v, int src) { return __builtin_amdgcn_ds_bpermute(src << 2, v); }
__device__ __forceinline__ float bperm(float v, int src) { return __int_as_float(__builtin_amdgcn_ds_bpermute(src << 2, __float_as_int(v))); }
__device__ __forceinline__ float wave_sum(float v) { v += shx<32>(v); v += shx<16>(v); v += shx<8>(v); v += shx<4>(v); v += shx<2>(v); v += shx<1>(v); return v; }
__device__ __forceinline__ float wave_max(float v) { v = fmaxf(v, shx<32>(v)); v = fmaxf(v, shx<16>(v)); v = fmaxf(v, shx<8>(v)); v = fmaxf(v, shx<4>(v)); v = fmaxf(v, shx<2>(v)); v = fmaxf(v, shx<1>(v)); return v; }
__device__ __forceinline__ int wave_sum_i(int v) { v += shx<32>(v); v += shx<16>(v); v += shx<8>(v); v += shx<4>(v); v += shx<2>(v); v += shx<1>(v); return v; }
__device__ __forceinline__ int wave_total_i(int v) {
    v += __builtin_amdgcn_update_dpp(0, v, 0x111, 0xf, 0xf, true);
    v += __builtin_amdgcn_update_dpp(0, v, 0x112, 0xf, 0xf, true);
    v += __builtin_amdgcn_update_dpp(0, v, 0x114, 0xf, 0xf, true);
    v += __builtin_amdgcn_update_dpp(0, v, 0x118, 0xf, 0xf, true);
    v += __builtin_amdgcn_update_dpp(0, v, 0x142, 0xa, 0xf, true);
    v += __builtin_amdgcn_update_dpp(0, v, 0x143, 0xc, 0xf, true);
    return __builtin_amdgcn_readlane(v, 63);
}
__device__ __forceinline__ float sigm(float x) { return __frcp_rn(1.f + __expf(-x)); }

__device__ __forceinline__ unsigned xb_xcc_id() { return (unsigned)__builtin_amdgcn_s_getreg((3 << 11) | 20) & 0xFu; }
__device__ __forceinline__ int TIDXW(int wv) { int t; asm volatile("v_mbcnt_lo_u32_b32 %0, -1, 0\n\tv_mbcnt_hi_u32_b32 %0, -1, %0\n\tv_lshl_or_b32 %0, %1, 6, %0" : "=v"(t) : "s"(wv)); return t; }
#define TIDX() TIDXW(p.wv)

__device__ __forceinline__ int src_col(int j) {
    if (j < 3584) return j;
    if (j < 4096) return j - 3584 + 4420;
    if (j < 4608) return j - 4096 + 4948;
    if (j < 4864) return j - 4608 + 3584;
    if (j < 5120) return j - 4864 + 3908;
    if (j < 5376) return j - 5120 + 4164;
    if (j < 5440) return j - 5376 + 3840;
    if (j < 5444) return j - 5440 + 3904;
    if (j < 5460) return j - 5444 + 4932;
    if (j < 5632) return -1;
    return j - 5632 + 5460;
}

__device__ void ph_mod(const Params& p, int vb0, int nvb, char* smem_) {
    float* sc = (float*)smem_;
    float* part = sc + 8 * 1024;
    float* mod = (float*)(p.ws + WS_MOD);
    const int tid = TIDX(), lane = tid & 63, wave = tid >> 6;
    if (vb0 >= 192) return;
    for (int i = tid; i < 8 * 1024; i += NT) { float c = p.c[i]; sc[i] = c / (1.f + __expf(-c)); }
    __syncthreads();
    for (int task = vb0; task < 192; task += nvb) {
        const int l = task / 96, n0 = (task % 96) * 64;
        const float* w = p.w_ada + (size_t)l * 1024 * 6144 + (size_t)(wave * 128) * 6144 + n0 + lane;
        float acc[8];
#pragma unroll
        for (int b = 0; b < 8; ++b) acc[b] = 0.f;
#pragma unroll 1
        for (int k0 = 0; k0 < 128; k0 += 16) {
            float wv[16];
#pragma unroll
            for (int j = 0; j < 16; ++j) wv[j] = w[(size_t)(k0 + j) * 6144];
#pragma unroll
            for (int j = 0; j < 16; ++j)
#pragma unroll
                for (int b = 0; b < 8; ++b) acc[b] += sc[b * 1024 + wave * 128 + k0 + j] * wv[j];
        }
#pragma unroll
        for (int b = 0; b < 8; ++b) part[(wave * 8 + b) * 64 + lane] = acc[b];
        __syncthreads();
        {
            const int b = tid >> 6, col = tid & 63;
            float v = p.b_ada[l * 6144 + n0 + col];
#pragma unroll
            for (int w_ = 0; w_ < 8; ++w_) v += part[(w_ * 8 + b) * 64 + col];
            mod[(size_t)(l * 8 + b) * 6144 + n0 + col] = v;
        }
        __syncthreads();
    }
}

template <bool MAP>
__device__ void tr_tile(const float* __restrict__ src, int lds_, bf16_t* __restrict__ out, int ldo, int k0, int n0, float* tile, const int tid) {
    float lv[8];
    {
        const int nn = tid & 63, scol = MAP ? src_col(n0 + nn) : (n0 + nn);
#pragma unroll
        for (int i = 0; i < 8; ++i) { const int kk = (tid >> 6) + 8 * i; lv[i] = (scol >= 0) ? src[(size_t)(k0 + kk) * lds_ + scol] : 0.f; }
#pragma unroll
        for (int i = 0; i < 8; ++i) { const int kk = (tid >> 6) + 8 * i; tile[kk * 65 + nn] = lv[i]; }
    }
    __syncthreads();
#pragma unroll
    for (int i = 0; i < 4; ++i) {
        int nn = (tid >> 5) + 16 * i, kk = (tid & 31) * 2;
        unsigned v = pack2(tile[kk * 65 + nn], tile[(kk + 1) * 65 + nn]);
        *(unsigned*)(out + (size_t)(n0 + nn) * ldo + k0 + kk) = v;
    }
    __syncthreads();
}
__device__ void conv_chunk(const float* __restrict__ src, bf16_t* __restrict__ dst, size_t base, const int tid) {
    f32x4 la[4], lb[4];
#pragma unroll
    for (int i = 0; i < 4; ++i) { const size_t e = base + (size_t)(i * NT + tid) * 8; la[i] = *(const f32x4*)(src + e); lb[i] = *(const f32x4*)(src + e + 4); }
#pragma unroll
    for (int i = 0; i < 4; ++i) {
        size_t e = base + (size_t)(i * NT + tid) * 8;
        const float4 a = make_float4(la[i][0], la[i][1], la[i][2], la[i][3]), b = make_float4(lb[i][0], lb[i][1], lb[i][2], lb[i][3]);
        uint4 o; o.x = pack2(a.x, a.y); o.y = pack2(a.z, a.w); o.z = pack2(b.x, b.y); o.w = pack2(b.z, b.w);
        *(uint4*)(dst + e) = o;
    }
}
__device__ void conv_chunk_fp8(const float* __restrict__ src, unsigned char* __restrict__ dst, size_t base, float scale, const int tid) {
    f32x4 la[4], lb[4];
#pragma unroll
    for (int i = 0; i < 4; ++i) { const size_t e = base + (size_t)(i * NT + tid) * 8; la[i] = *(const f32x4*)(src + e); lb[i] = *(const f32x4*)(src + e + 4); }
#pragma unroll
    for (int i = 0; i < 4; ++i) {
        size_t e = base + (size_t)(i * NT + tid) * 8;
        const float4 a = make_float4(la[i][0], la[i][1], la[i][2], la[i][3]), b = make_float4(lb[i][0], lb[i][1], lb[i][2], lb[i][3]);
        int lo = __builtin_amdgcn_cvt_pk_fp8_f32(a.x * scale, a.y * scale, 0, false); lo = __builtin_amdgcn_cvt_pk_fp8_f32(a.z * scale, a.w * scale, lo, true);
        int hi = __builtin_amdgcn_cvt_pk_fp8_f32(b.x * scale, b.y * scale, 0, false); hi = __builtin_amdgcn_cvt_pk_fp8_f32(b.z * scale, b.w * scale, hi, true);
        const size_t row = e >> 10, col = e & 1023;
        *(uint2*)(dst + ((col >> 7) * 16384 + row) * 128 + (col & 127)) = make_uint2((unsigned)lo, (unsigned)hi);
    }
}
__device__ void ph_wprep(const Params& p, int l, int vb0, int nvb, char* smem_) {
    float* tile = (float*)smem_;
    const int tid = TIDX();
    bf16_t* WIN = (bf16_t*)(p.ws + WS_WIN); bf16_t* WBR = (bf16_t*)(p.ws + WS_WBR); bf16_t* WOUT = (bf16_t*)(p.ws + WS_WOUT);
    bf16_t* WQ = (bf16_t*)(p.ws + WS_WQ); bf16_t* SK = (bf16_t*)(p.ws + WS_SK); unsigned char* PU = p.ws + WS_PU; unsigned char* PV = p.ws + WS_PV;
    constexpr int N_WIN = 136 * 16, N_WBR = 3 * 16 * 8, N_WOUT = 16 * 16, N_WQ = 32 * 16, N_SK = 16, N_PU = 1024, N_PV = 1024;
    constexpr int TOTAL = N_WIN + N_WBR + N_WOUT + N_WQ + N_SK + N_PU + N_PV;
    for (int task = vb0; task < TOTAL; task += nvb) {
        int r = task;
        if (r < N_WIN) { int nt = r / 16, kt = r % 16; tr_tile<true>(p.w_in + (size_t)l * 1024 * IN_COLS, IN_COLS, WIN, 1024, kt * 64, nt * 64, tile, tid); continue; }
        r -= N_WIN;
        if (r < N_WBR) { int g = r / 128, rr = r % 128, nt = rr / 8, kt = rr % 8;
            tr_tile<false>(p.w_branch + (size_t)(l * 3 + g) * 512 * 1024, 1024, WBR + (size_t)g * 1024 * 512, 512, kt * 64, nt * 64, tile, tid); continue; }
        r -= N_WBR;
        if (r < N_WOUT) { int nt = r / 16, kt = r % 16; tr_tile<false>(p.w_out + (size_t)l * 1024 * 1024, 1024, WOUT, 1024, kt * 64, nt * 64, tile, tid); continue; }
        r -= N_WOUT;
        if (r < N_WQ) { int nt = r / 16, kt = r % 16; tr_tile<false>(p.peer_wq + (size_t)l * 1024 * 2048, 2048, WQ, 1024, kt * 64, nt * 64, tile, tid); continue; }
        r -= N_WQ;
        if (r < N_SK) { conv_chunk(p.peer_keys + (size_t)l * 16 * 128 * 128, SK, (size_t)r * 16384, tid); continue; }
        r -= N_SK;
        if (r < N_PU) { conv_chunk_fp8(p.peer_u + (size_t)l * 16384 * 1024, PU, (size_t)r * 16384, PU_SCALE, tid); continue; }
        r -= N_PU;
        conv_chunk_fp8(p.peer_v + (size_t)l * 16384 * 1024, PV, (size_t)r * 16384, PV_SCALE, tid);
    }
}

__device__ void ph_norm(const Params& p, int l, int which, const float* xin, int vb0, int nvb) {
    const int wave = TIDX() >> 6, lane = TIDX() & 63;
    const float* gain = (which ? p.norm_ffn : p.norm_mix) + l * 1024;
    const float* modb = (const float*)(p.ws + WS_MOD);
    bf16_t* H = (bf16_t*)(p.ws + WS_H);
    f32x4 g[4];
#pragma unroll
    for (int i = 0; i < 4; ++i) g[i] = *(const f32x4*)(gain + (lane + 64 * i) * 4);
    for (int t = vb0 * 8 + wave; t < T_TOK; t += nvb * 8) {
        const int b = t >> 11;
        const float* mod = modb + (size_t)(l * 8 + b) * 6144 + (which ? 3072 : 0);
        const f32x4* xr = (const f32x4*)(xin + (size_t)t * 1024);
        f32x4 v[4], sc[4], sh[4]; float ss = 0.f;
#pragma unroll
        for (int i = 0; i < 4; ++i) { v[i] = xr[lane + 64 * i]; sc[i] = *(const f32x4*)(mod + 1024 + (lane + 64 * i) * 4); sh[i] = *(const f32x4*)(mod + (lane + 64 * i) * 4); }
#pragma unroll
        for (int i = 0; i < 4; ++i) ss += v[i][0] * v[i][0] + v[i][1] * v[i][1] + v[i][2] * v[i][2] + v[i][3] * v[i][3];
        ss = wave_sum(ss);
        const float rstd = rsqrtf(ss * (1.f / 1024.f) + 1e-6f);
#pragma unroll
        for (int i = 0; i < 4; ++i) {
            const int idx = (lane + 64 * i) * 4;
            const f32x4 h = v[i] * rstd * g[i] * (1.f + sc[i]) + sh[i];
            uint2 o; o.x = pack2(h[0], h[1]); o.y = pack2(h[2], h[3]);
            *(uint2*)(H + (size_t)t * 1024 + idx) = o;
            if (which) {
                int hi = __builtin_amdgcn_cvt_pk_fp8_f32(h[0], h[1], 0, false); hi = __builtin_amdgcn_cvt_pk_fp8_f32(h[2], h[3], hi, true);
                const auto d0 = __builtin_amdgcn_cvt_pk_f32_fp8(hi, false); const auto d1 = __builtin_amdgcn_cvt_pk_f32_fp8(hi, true);
                int lo = __builtin_amdgcn_cvt_pk_fp8_f32((h[0] - d0[0]) * 16.f, (h[1] - d0[1]) * 16.f, 0, false);
                lo = __builtin_amdgcn_cvt_pk_fp8_f32((h[2] - d1[0]) * 16.f, (h[3] - d1[1]) * 16.f, lo, true);
                *(int*)(p.ws + WS_H8H + (size_t)t * 1024 + idx) = hi;
                *(int*)(p.ws + WS_H8L + (size_t)t * 1024 + idx) = lo;
            }
        }
    }
}

constexpr int GBM = 256, GBN = 128, GBK = 64, GLS = 72;
__device__ __forceinline__ void gemm_tile(const bf16_t* __restrict__ A, int lda, const bf16_t* __restrict__ Bt, int ldb, int K,
                                          int m0, int n0, bf16_t* sA, bf16_t* sB, f32x4 (&acc)[4][4], const int tid) {
    const int lane = tid & 63, wave = tid >> 6;
    const int wm = wave >> 1, wn = wave & 1, fr = lane & 15, fq = lane >> 4;
    u32x4 ra[4], rb[2];
    const int crow = tid >> 3, ckc = (tid & 7) * 8;
    const bf16_t* Ag = A + (size_t)(m0 + crow) * lda + ckc;
    const bf16_t* Bg = Bt + (size_t)(n0 + crow) * ldb + ckc;
#pragma unroll
    for (int i = 0; i < 4; ++i) ra[i] = *(const u32x4*)(Ag + (size_t)(64 * i) * lda);
#pragma unroll
    for (int i = 0; i < 2; ++i) rb[i] = *(const u32x4*)(Bg + (size_t)(64 * i) * ldb);
    for (int k0 = 0; k0 < K; k0 += GBK) {
        __syncthreads();
#pragma unroll
        for (int i = 0; i < 4; ++i) *(u32x4*)(sA + (crow + 64 * i) * GLS + ckc) = ra[i];
#pragma unroll
        for (int i = 0; i < 2; ++i) *(u32x4*)(sB + (crow + 64 * i) * GLS + ckc) = rb[i];
        __syncthreads();
        {
            const int kn = (k0 + GBK < K) ? (k0 + GBK) : k0;
#pragma unroll
            for (int i = 0; i < 4; ++i) ra[i] = *(const u32x4*)(Ag + (size_t)(64 * i) * lda + kn);
#pragma unroll
            for (int i = 0; i < 2; ++i) rb[i] = *(const u32x4*)(Bg + (size_t)(64 * i) * ldb + kn);
        }
#pragma unroll
        for (int ks = 0; ks < 2; ++ks) {
            bf16x8 af[4], wf[4];
#pragma unroll
            for (int mf = 0; mf < 4; ++mf) af[mf] = *(const bf16x8*)(sA + (wm * 64 + mf * 16 + fr) * GLS + ks * 32 + fq * 8);
#pragma unroll
            for (int nf = 0; nf < 4; ++nf) wf[nf] = *(const bf16x8*)(sB + (wn * 64 + nf * 16 + fr) * GLS + ks * 32 + fq * 8);
#pragma unroll
            for (int nf = 0; nf < 4; ++nf)
#pragma unroll
                for (int mf = 0; mf < 4; ++mf)
                    acc[nf][mf] = __builtin_amdgcn_mfma_f32_16x16x32_bf16(wf[nf], af[mf], acc[nf][mf], 0, 0, 0);
        }
    }
}


namespace pg8 {
#define PG8_LAS __attribute__((address_space(3)))
constexpr int BM = 256, BK = 64, HALF = 128, HTB = HALF * BK * 2, STAGE_BYTES = 8 * HTB, NXCD = 8, WGM = 8;
__device__ __forceinline__ int lds_byte(int r, int c) { const int st = (r >> 4) * 2 + (c >> 5), rr = r & 15, cc = c & 31, ob = rr * 64 + cc * 2; return st * 1024 + (ob ^ (((ob >> 9) & 1) << 5)); }
__device__ __forceinline__ void stage_rc(int b, int& R, int& C) { const int st = b / 1024, sb = b % 1024, swz = sb ^ (((sb >> 9) & 1) << 5); R = (st >> 1) * 16 + swz / 64; C = (st & 1) * 32 + (swz % 64) / 2; }
__device__ __forceinline__ int perm32(int rho) { const int n = rho >> 4, i = rho & 15; return 8 * (i >> 2) + 4 * n + (i & 3); }
struct Unit { int pm, pn, aux; size_t aoff, boff; };
struct Gemm { const bf16_t* A; const bf16_t* Bt; int lda, ldb, K; };

struct StaticOrder {
    int nM, nN, nwg, G, c, lda, ldb;
    __device__ void init(int M, int N, int G_, int c_, int lda_, int ldb_) { nM = M / BM; nN = N / BM; nwg = nM * nN; G = G_; c = c_; lda = lda_; ldb = ldb_; }
    __device__ bool next(int i, Unit& u) const {
        const long L = (long)i * G + c; if (L >= nwg) return false;
        int wgid = (int)L; { const int q = nwg / NXCD, r = nwg % NXCD, xcd = wgid % NXCD, off = wgid / NXCD; wgid = (xcd < r ? xcd * (q + 1) : r * (q + 1) + (xcd - r) * q) + off; }
        const int nig = WGM * nN, gid = wgid / nig, fm = gid * WGM, gsz = (nM - fm) < WGM ? (nM - fm) : WGM;
        u.pm = fm + ((wgid % nig) % gsz); u.pn = (wgid % nig) / gsz; u.aux = 0;
        u.aoff = (size_t)u.pm * BM * lda * 2; u.boff = (size_t)u.pn * BM * ldb * 2;
        return true;
    }
};
struct MergeOrder {
    int c, G;
    __device__ bool next(int i, Unit& u) const {
        const int tile = c + (i / 3) * G; if (tile >= 256) return false;
        u.pm = tile & 63; u.pn = tile >> 6; u.aux = i % 3;
        u.aoff = ((size_t)u.pm * BM * 1536 + (size_t)u.aux * 512) * 2; u.boff = ((size_t)u.aux * 1024 + (size_t)u.pn * BM) * 512 * 2;
        return true;
    }
};

template <class Epi, class Sched>
__device__ __forceinline__ void gemm_phase(PG8_LAS unsigned char* lds, const Gemm g, const Sched& S, const Epi& E, const int tid) {
    const int wid = __builtin_amdgcn_readfirstlane(tid >> 6), lane = tid & 63, wr = wid >> 2, wc = wid & 3, fr = lane & 15, fq = lane >> 4;
    const int K = g.K, nt = K / BK;
    unsigned voffA[2], voffB[2];
#pragma unroll
    for (int i = 0; i < 2; ++i) { int R, C; stage_rc(tid * 16 + i * 8192, R, C); const int Rb = Epi::PERM ? ((R & ~31) + perm32(R & 31)) : R;
        voffA[i] = (unsigned)(R * g.lda + C) * 2u; voffB[i] = (unsigned)(Rb * g.ldb + C) * 2u; }
    const size_t kstep = (size_t)(BK * 2);
    const size_t hstepA = (size_t)HALF * g.lda * 2, hstepB = (size_t)HALF * g.ldb * 2;
    const unsigned ldsw = (unsigned)wid * 1024u;
    const int aoff = lds_byte(wr * 64 + fr, fq * 8), boff = lds_byte(wc * 32 + fr, fq * 8);
#define PG8_SA(b, h) (((b) * 2 + (h)) * HTB)
#define PG8_SB(b, h) ((4 + (b) * 2 + (h)) * HTB)
#define PG8_STAGE(bufoff, gbase, voff) do { _Pragma("unroll") for (int _i = 0; _i < 2; ++_i) \
        __builtin_amdgcn_global_load_lds((const unsigned*)((const char*)(gbase) + (voff)[_i]), (PG8_LAS unsigned*)(lds + (bufoff) + ldsw + _i * 8192), 16, 0, 0); } while (0)
#define PG8_LDA(dst, b, h) do { _Pragma("unroll") for (int m = 0; m < 4; ++m) _Pragma("unroll") for (int k = 0; k < 2; ++k) dst[m][k] = *(const PG8_LAS bf16x8*)(lds + PG8_SA(b, h) + aoff + m * 2048 + k * 1024); } while (0)
#define PG8_LDB(dst, b, h) do { _Pragma("unroll") for (int n = 0; n < 2; ++n) _Pragma("unroll") for (int k = 0; k < 2; ++k) dst[n][k] = *(const PG8_LAS bf16x8*)(lds + PG8_SB(b, h) + boff + n * 2048 + k * 1024); } while (0)
#define PG8_MMA(ai, bj, At, Bt) do { __builtin_amdgcn_s_setprio(1); _Pragma("unroll") for (int m = 0; m < 4; ++m) _Pragma("unroll") for (int n = 0; n < 2; ++n) _Pragma("unroll") for (int k = 0; k < 2; ++k) \
        acc[ai][bj][m][n] = __builtin_amdgcn_mfma_f32_16x16x32_bf16(Bt[n][k], At[m][k], acc[ai][bj][m][n], 0, 0, 0); __builtin_amdgcn_s_setprio(0); } while (0)
#define PG8_WAIT_V(n) asm volatile("s_waitcnt vmcnt(" #n ")" ::: "memory")
#define PG8_WAIT_L(n) asm volatile("s_waitcnt lgkmcnt(" #n ")" ::: "memory")
#define PG8_BAR __builtin_amdgcn_s_barrier()
#define PG8_SCHED __builtin_amdgcn_sched_barrier(0)
    Unit cur, nxt; int ui = 0;
    if (!S.next(0, cur)) return;
    f32x4 acc[2][2][4][2];
#pragma unroll
    for (int a = 0; a < 2; ++a)
#pragma unroll
        for (int b = 0; b < 2; ++b)
#pragma unroll
            for (int m = 0; m < 4; ++m)
#pragma unroll
                for (int n = 0; n < 2; ++n) acc[a][b][m][n] = f32x4{0.f, 0.f, 0.f, 0.f};
    bf16x8 At[4][2], B0[2][2], B1[2][2];
    const char* cA = (const char*)g.A + cur.aoff; const char* cB = (const char*)g.Bt + cur.boff;
    PG8_STAGE(PG8_SB(0, 0), cB, voffB); PG8_STAGE(PG8_SA(0, 0), cA, voffA); PG8_STAGE(PG8_SB(0, 1), cB + hstepB, voffB); PG8_STAGE(PG8_SA(0, 1), cA + hstepA, voffA);
    if (wr == 1) PG8_BAR;
    PG8_WAIT_V(4); PG8_BAR;
    PG8_STAGE(PG8_SB(1, 0), cB + kstep, voffB); PG8_STAGE(PG8_SA(1, 0), cA + kstep, voffA); PG8_STAGE(PG8_SB(1, 1), cB + hstepB + kstep, voffB);
    PG8_WAIT_V(6); PG8_BAR;
    for (;;) {
        const bool has_next = S.next(ui + 1, nxt);
        const char* nA = has_next ? (const char*)g.A + nxt.aoff : cA; const char* nB = has_next ? (const char*)g.Bt + nxt.boff : cB;
        for (int t = 0; t < nt; t += 2) {
            const bool last = (t == nt - 2);
            const char* a1 = cA + (size_t)(t + 1) * kstep;
            const char* a2 = last ? nA : cA + (size_t)(t + 2) * kstep; const char* b2 = last ? nB : cB + (size_t)(t + 2) * kstep;
            const char* a3 = a2 + kstep; const char* b3 = b2 + kstep;
            PG8_LDB(B0, 0, 0); PG8_SCHED; PG8_LDA(At, 0, 0); PG8_STAGE(PG8_SA(1, 1), a1 + hstepA, voffA);
            PG8_WAIT_L(8); PG8_BAR; PG8_WAIT_L(0); PG8_MMA(0, 0, At, B0); PG8_BAR; PG8_SCHED;
            PG8_LDB(B1, 0, 1); PG8_STAGE(PG8_SB(0, 0), b2, voffB);
            PG8_BAR; PG8_WAIT_L(0); PG8_MMA(0, 1, At, B1); PG8_BAR;
            PG8_LDA(At, 0, 1); PG8_STAGE(PG8_SA(0, 0), a2, voffA);
            PG8_BAR; PG8_WAIT_L(0); PG8_MMA(1, 0, At, B0); PG8_BAR; PG8_SCHED;
            PG8_STAGE(PG8_SB(0, 1), b2 + hstepB, voffB);
            PG8_WAIT_V(6); PG8_BAR; PG8_MMA(1, 1, At, B1); PG8_BAR;
            PG8_LDB(B0, 1, 0); PG8_SCHED; PG8_LDA(At, 1, 0); PG8_STAGE(PG8_SA(0, 1), a2 + hstepA, voffA);
            PG8_WAIT_L(8); PG8_BAR; PG8_WAIT_L(0); PG8_MMA(0, 0, At, B0); PG8_BAR; PG8_SCHED;
            PG8_LDB(B1, 1, 1); PG8_STAGE(PG8_SB(1, 0), b3, voffB);
            PG8_BAR; PG8_WAIT_L(0); PG8_MMA(0, 1, At, B1); PG8_BAR;
            PG8_LDA(At, 1, 1); PG8_STAGE(PG8_SA(1, 0), a3, voffA);
            PG8_BAR; PG8_WAIT_L(0); PG8_MMA(1, 0, At, B0); PG8_BAR; PG8_SCHED;
            PG8_STAGE(PG8_SB(1, 1), b3 + hstepB, voffB);
            PG8_WAIT_V(6); PG8_BAR; PG8_MMA(1, 1, At, B1); PG8_BAR;
        }
        E(acc, cur, wr, wc, fr, fq);
        if (!has_next) break;
#pragma unroll
        for (int a = 0; a < 2; ++a)
#pragma unroll
            for (int b = 0; b < 2; ++b)
#pragma unroll
                for (int m = 0; m < 4; ++m)
#pragma unroll
                    for (int n = 0; n < 2; ++n) acc[a][b][m][n] = f32x4{0.f, 0.f, 0.f, 0.f};
        cur = nxt; cA = nA; cB = nB; ++ui;
    }
    PG8_WAIT_V(0);
    if (wr == 0) PG8_BAR;
    PG8_BAR;
#undef PG8_SA
#undef PG8_SB
#undef PG8_STAGE
#undef PG8_LDA
#undef PG8_LDB
#undef PG8_MMA
#undef PG8_WAIT_V
#undef PG8_WAIT_L
#undef PG8_BAR
#undef PG8_SCHED
}

struct EpiBf16 {
    static constexpr bool PERM = true;
    bf16_t* O; int ldc;
    __device__ __forceinline__ void operator()(const f32x4 (&acc)[2][2][4][2], const Unit& u, int wr, int wc, int fr, int fq) const {
        const int row0 = u.pm * BM + wr * 64 + fr, col0 = u.pn * BM + wc * 32 + 8 * fq;
#pragma unroll
        for (int ai = 0; ai < 2; ++ai)
#pragma unroll
            for (int m = 0; m < 4; ++m) { bf16_t* rowp = O + (size_t)(row0 + ai * HALF + m * 16) * ldc + col0;
#pragma unroll
                for (int bj = 0; bj < 2; ++bj) { const f32x4 v0 = acc[ai][bj][m][0], v1 = acc[ai][bj][m][1];
                    u32x4 w; w.x = pack2(v0[0], v0[1]); w.y = pack2(v0[2], v0[3]); w.z = pack2(v1[0], v1[1]); w.w = pack2(v1[2], v1[3]);
                    *(u32x4*)(rowp + bj * HALF) = w; } }
    }
};
struct EpiResid {
    static constexpr bool PERM = false;
    const float* xin; float* out; const float* mod;
    __device__ __forceinline__ void operator()(const f32x4 (&acc)[2][2][4][2], const Unit& u, int wr, int wc, int fr, int fq) const {
        const int row0 = u.pm * BM + wr * 64 + fr, col0 = u.pn * BM + wc * 32 + 4 * fq;
        const float* gm = mod + (size_t)(row0 >> 11) * 6144 + 2048 + col0;
        f32x4 g4[2][2];
#pragma unroll
        for (int bj = 0; bj < 2; ++bj)
#pragma unroll
            for (int n = 0; n < 2; ++n) g4[bj][n] = *(const f32x4*)(gm + bj * HALF + n * 16);
#pragma unroll
        for (int ai = 0; ai < 2; ++ai) {
            f32x4 xi[4][2][2];
#pragma unroll
            for (int m = 0; m < 4; ++m)
#pragma unroll
                for (int bj = 0; bj < 2; ++bj)
#pragma unroll
                    for (int n = 0; n < 2; ++n) xi[m][bj][n] = *(const f32x4*)(xin + (size_t)(row0 + ai * HALF + m * 16) * 1024 + col0 + bj * HALF + n * 16);
            asm volatile("" ::: "memory");
#pragma unroll
            for (int m = 0; m < 4; ++m)
#pragma unroll
                for (int bj = 0; bj < 2; ++bj)
#pragma unroll
                    for (int n = 0; n < 2; ++n)
                        *(f32x4*)(out + (size_t)(row0 + ai * HALF + m * 16) * 1024 + col0 + bj * HALF + n * 16) = xi[m][bj][n] + g4[bj][n] * acc[ai][bj][m][n];
            asm volatile("" ::: "memory");
        }
    }
};
struct EpiMerge {
    static constexpr bool PERM = true;
    bf16_t* Hm; const bf16_t* Z;
    __device__ __forceinline__ void operator()(const f32x4 (&acc)[2][2][4][2], const Unit& u, int wr, int wc, int fr, int fq) const {
        const int row0 = u.pm * BM + wr * 64 + fr, col0 = u.pn * BM + wc * 32 + 8 * fq, g = u.aux;
#pragma unroll
        for (int ai = 0; ai < 2; ++ai) {
            u32x4 gz[4][2], prev[4][2];
#pragma unroll
            for (int m = 0; m < 4; ++m)
#pragma unroll
                for (int bj = 0; bj < 2; ++bj) {
                    const int row = row0 + ai * HALF + m * 16, col = col0 + bj * HALF;
                    gz[m][bj] = *(const u32x4*)(Z + (size_t)row * LDZ + ZM + g * 1024 + col);
                    prev[m][bj] = u32x4{0u, 0u, 0u, 0u};
                    if (g > 0) prev[m][bj] = *(const u32x4*)(Hm + (size_t)row * 1024 + col);
                }
            asm volatile("" ::: "memory");
#pragma unroll
            for (int m = 0; m < 4; ++m)
#pragma unroll
                for (int bj = 0; bj < 2; ++bj) {
                    const int row = row0 + ai * HALF + m * 16, col = col0 + bj * HALF;
                    const f32x4 v0 = acc[ai][bj][m][0], v1 = acc[ai][bj][m][1];
                    const u32x4 z_ = gz[m][bj], p_ = prev[m][bj];
                    u32x4 w;
                    w.x = pack2(bflo(p_.x) + sigm(bflo(z_.x)) * v0[0], bfhi(p_.x) + sigm(bfhi(z_.x)) * v0[1]);
                    w.y = pack2(bflo(p_.y) + sigm(bflo(z_.y)) * v0[2], bfhi(p_.y) + sigm(bfhi(z_.y)) * v0[3]);
                    w.z = pack2(bflo(p_.z) + sigm(bflo(z_.z)) * v1[0], bfhi(p_.z) + sigm(bfhi(z_.z)) * v1[1]);
                    w.w = pack2(bflo(p_.w) + sigm(bflo(z_.w)) * v1[2], bfhi(p_.w) + sigm(bfhi(z_.w)) * v1[3]);
                    *(u32x4*)(Hm + (size_t)row * 1024 + col) = w;
                }
            asm volatile("" ::: "memory");
        }
    }
};
}

struct EpiZ {
    bf16_t* Z; int ld;
    __device__ __forceinline__ void operator()(int m, int n, const f32x4& v) const {
        uint2 o; o.x = pack2(v[0], v[1]); o.y = pack2(v[2], v[3]);
        *(uint2*)(Z + (size_t)m * ld + n) = o;
    }
};
struct EpiF16 {
    _Float16* C; int ld;
    __device__ __forceinline__ void operator()(int m, int n, const f32x4& v) const {
        typedef _Float16 h4 __attribute__((ext_vector_type(4)));
        h4 o = {(_Float16)v[0], (_Float16)v[1], (_Float16)v[2], (_Float16)v[3]};
        *(h4*)(C + (size_t)m * ld + n) = o;
    }
};
struct EpiOut {
    const float* xin; float* out; const float* mod;
    __device__ __forceinline__ void operator()(int m, int n, const f32x4& v) const {
        int b = m >> 11;
        float4 g = *(const float4*)(mod + (size_t)b * 6144 + 2048 + n);
        float4 xi = *(const float4*)(xin + (size_t)m * 1024 + n);
        *(float4*)(out + (size_t)m * 1024 + n) = make_float4(xi.x + g.x * v[0], xi.y + g.y * v[1], xi.z + g.z * v[2], xi.w + g.w * v[3]);
    }
};

template <class Epi>
__device__ void gemm_phase(const bf16_t* A, int lda, const bf16_t* Bt, int ldb, int M, int N, int K, bool batched, Epi epi,
                           int vb0, int nvb, char* smem_, const int tid) {
    bf16_t* sA = (bf16_t*)smem_; bf16_t* sB = sA + GBM * GLS;
    const int lane = tid & 63, wave = tid >> 6, wm = wave >> 1, wn = wave & 1, fr = lane & 15, fq = lane >> 4;
    const int MT = M / GBM, NTL = N / GBN;
    for (int tile = vb0; tile < MT * NTL; tile += nvb) {
        int mt = tile % MT, nt = tile / MT;
        f32x4 acc[4][4];
#pragma unroll
        for (int a = 0; a < 4; ++a)
#pragma unroll
            for (int b = 0; b < 4; ++b) acc[a][b] = f32x4{0.f, 0.f, 0.f, 0.f};
        gemm_tile(batched ? A + nt * 128 : A, lda, Bt, ldb, K, mt * GBM, nt * GBN, sA, sB, acc, tid);
#pragma unroll
        for (int nf = 0; nf < 4; ++nf)
#pragma unroll
            for (int mf = 0; mf < 4; ++mf)
                epi(mt * GBM + wm * 64 + mf * 16 + fr, nt * GBN + wn * 64 + nf * 16 + fq * 4, acc[nf][mf]);
    }
}


#define SCAN_SYNC() do { asm volatile("s_waitcnt lgkmcnt(0)" ::: "memory"); __builtin_amdgcn_s_barrier(); asm volatile("" ::: "memory"); } while (0)
template <int DK, bool GLA>
__device__ void scan2_item(const Params& p, int l, int b, int h, char* smem_) {
    constexpr int SEG = NT / DK, SLEN = 64 / SEG, KS = DK / 32, KT = DK / 16;
    constexpr int QS = DK + 8, BS = DK + 4, VS = 72;
    bf16_t* qs = (bf16_t*)smem_;
    bf16_t* ks = qs + 64 * QS;
    float* bs = (float*)(ks + 64 * QS);
    bf16_t* vt = (bf16_t*)(bs + 64 * BS);
    bf16_t* At = vt + 128 * VS;
    bf16_t* kht = At + 64 * VS;
    bf16_t* st = kht + DK * VS;
    float* segtot = (float*)(st + 128 * QS);
    float* blast = segtot + SEG * DK;
    const int tid = TIDX(), lane = tid & 63, wave = __builtin_amdgcn_readfirstlane(tid >> 6), fr = lane & 15, fq = lane >> 4;
    const int kl = tid % DK, seg = __builtin_amdgcn_readfirstlane(tid / DK);
    float lbv = 0.f, gbias = 0.f; float gu[16];
#pragma unroll
    for (int r = 0; r < 16; ++r) gu[r] = 0.f;
    if (GLA) {
#pragma unroll
        for (int r = 0; r < 16; ++r) gu[r] = p.gla_up[(size_t)(l * 16 + r) * 256 + h * 64 + kl];
        gbias = p.gla_bias[l * 256 + h * 64 + kl];
    } else if (l == 1) {
        float x0 = p.hgrn_lb[h * 128 + kl], x1 = p.hgrn_lb[512 + h * 128 + kl];
        lbv = 1.f / (1.f + expf(x0 - x1));
    }
    const float scale = GLA ? 0.125f : 0.08838834764831845f;
    const bf16_t* Zb = (const bf16_t*)(p.ws + WS_Z) + (size_t)(b * 2048) * LDZ;
    float* ssq = (float*)(smem_ + 152576);
    const int QCOL = (GLA ? ZC_Q : ZA_Q) + h * DK, KCOL = (GLA ? ZC_K : ZA_F) + h * DK, VCOL = (GLA ? ZC_V : ZA_I) + h * 128, GCOL = (GLA ? ZC_G : ZA_G) + h * 128;
    f32x4 sacc[KT];
#pragma unroll
    for (int i = 0; i < KT; ++i) sacc[i] = f32x4{0.f, 0.f, 0.f, 0.f};
    f32x4 gn4[4];
    {
        const float* gn = (GLA ? p.gla_on : p.hgrn_on) + l * 128 + (wave >> 2) * 64 + 4 * fq;
#pragma unroll
        for (int vi = 0; vi < 4; ++vi) gn4[vi] = *(const f32x4*)(gn + vi * 16);
    }
    for (int i = tid; i < 128 * QS / 2; i += NT) ((unsigned*)st)[i] = 0u;
    SCAN_SYNC();

    for (int c = 0; c < 32; ++c) {
        const bf16_t* Zc = Zb + (size_t)(c * 64) * LDZ;
        {
            bf16_t rq[SLEN], rk[SLEN];
            u32x4 rc0[GLA ? SLEN : 1], rc1[GLA ? SLEN : 1];
            {
                bf16_t rv[16];
                const int v = tid & 127, sb_ = __builtin_amdgcn_readfirstlane(tid >> 7);
#pragma unroll
                for (int i = 0; i < 16; ++i) rv[i] = Zc[(size_t)(sb_ + 4 * i) * LDZ + VCOL + v];
#pragma unroll
                for (int i = 0; i < SLEN; ++i) {
                    const bf16_t* zr = Zc + (size_t)(seg * SLEN + i) * LDZ;
                    rq[i] = zr[QCOL + kl]; rk[i] = zr[KCOL + kl];
                    if (GLA) { rc0[i] = *(const u32x4*)(zr + ZC_CODE); rc1[i] = *(const u32x4*)(zr + ZC_CODE + 8); }
                }
#pragma unroll
                for (int i = 0; i < 16; ++i) vt[v * VS + sb_ + 4 * i] = rv[i];
            }
            float run = 0.f;
#pragma unroll
            for (int i = 0; i < SLEN; ++i) {
                const int s_ = seg * SLEN + i;
                float g, kk;
                if (GLA) {
                    float x = gbias;
#pragma unroll
                    for (int r = 0; r < 4; ++r) {
                        x += bflo(rc0[i][r]) * gu[2 * r] + bfhi(rc0[i][r]) * gu[2 * r + 1];
                        x += bflo(rc1[i][r]) * gu[8 + 2 * r] + bfhi(rc1[i][r]) * gu[8 + 2 * r + 1];
                    }
                    g = (fminf(x, 0.f) - __logf(1.f + __expf(-fabsf(x)))) * (1.f / 16.f);
                    kk = bf2f(rk[i]);
                } else {
                    const float f = lbv + (1.f - lbv) * __frcp_rn(1.f + __expf(-bf2f(rk[i])));
                    g = __logf(f); kk = 1.f - f;
                }
                run += g;
                bs[s_ * BS + kl] = run;
                qs[s_ * QS + kl] = rq[i];
                ks[s_ * QS + kl] = f2bf(kk);
            }
            segtot[seg * DK + kl] = run;
        }
        SCAN_SYNC();
        {
            float pre = 0.f, tot = 0.f;
#pragma unroll
            for (int g_ = 0; g_ < SEG; ++g_) { const float v_ = segtot[g_ * DK + kl]; if (g_ < seg) pre += v_; tot += v_; }
            if (seg == 0) blast[kl] = tot;
            unsigned pk[SLEN / 2];
#pragma unroll
            for (int i = 0; i < SLEN; ++i) {
                const float bv = bs[(seg * SLEN + i) * BS + kl] + pre;
                bs[(seg * SLEN + i) * BS + kl] = bv;
                const float kh = bf2f(ks[(seg * SLEN + i) * QS + kl]) * __expf(tot - bv);
                if (i & 1) pk[i >> 1] |= ((unsigned)f2bf(kh)) << 16; else pk[i >> 1] = (unsigned)f2bf(kh);
            }
            unsigned* dst = (unsigned*)(kht + kl * VS + seg * SLEN);
#pragma unroll
            for (int i = 0; i < SLEN / 2; ++i) dst[i] = pk[i];
        }
        SCAN_SYNC();
        for (int blk = wave; blk < 10; blk += 8) {
            int bi, bj;
            if (blk < 1) { bi = 0; bj = 0; } else if (blk < 3) { bi = 1; bj = blk - 1; } else if (blk < 6) { bi = 2; bj = blk - 3; } else { bi = 3; bj = blk - 6; }
            f32x4 acc = f32x4{0.f, 0.f, 0.f, 0.f};
            const int srow = bj * 16 + fr, trow = bi * 16 + fr;
#pragma unroll
            for (int kk = 0; kk < KS; ++kk) {
                const int k0 = kk * 32 + fq * 8;
                float br[8];
                if (bi == 0) {
#pragma unroll
                    for (int j = 0; j < 8; ++j) br[j] = 0.f;
                } else {
                    const float4 r0 = *(const float4*)(bs + (bi * 16 - 1) * BS + k0), r1 = *(const float4*)(bs + (bi * 16 - 1) * BS + k0 + 4);
                    br[0] = r0.x; br[1] = r0.y; br[2] = r0.z; br[3] = r0.w; br[4] = r1.x; br[5] = r1.y; br[6] = r1.z; br[7] = r1.w;
                }
                const uint4 kq = *(const uint4*)(ks + srow * QS + k0), qq = *(const uint4*)(qs + trow * QS + k0);
                const float4 s0 = *(const float4*)(bs + srow * BS + k0), s1 = *(const float4*)(bs + srow * BS + k0 + 4);
                const float4 t0_ = *(const float4*)(bs + trow * BS + k0), t1_ = *(const float4*)(bs + trow * BS + k0 + 4);
                const float bsv[8] = {s0.x, s0.y, s0.z, s0.w, s1.x, s1.y, s1.z, s1.w}, btv[8] = {t0_.x, t0_.y, t0_.z, t0_.w, t1_.x, t1_.y, t1_.z, t1_.w};
                const unsigned kw[4] = {kq.x, kq.y, kq.z, kq.w}, qw[4] = {qq.x, qq.y, qq.z, qq.w};
                union { bf16x8 v; unsigned u[4]; } ka, qb;
#pragma unroll
                for (int j = 0; j < 4; ++j) {
                    const float e0 = __expf(fminf(br[2 * j] - bsv[2 * j], 60.f)), e1 = __expf(fminf(br[2 * j + 1] - bsv[2 * j + 1], 60.f));
                    ka.u[j] = pack2(bflo(kw[j]) * e0, bfhi(kw[j]) * e1);
                    const float f0 = __expf(btv[2 * j] - br[2 * j]), f1 = __expf(btv[2 * j + 1] - br[2 * j + 1]);
                    qb.u[j] = pack2(bflo(qw[j]) * f0, bfhi(qw[j]) * f1);
                }
                acc = __builtin_amdgcn_mfma_f32_16x16x32_bf16(ka.v, qb.v, acc, 0, 0, 0);
            }
            if (bi == bj) {
#pragma unroll
                for (int r = 0; r < 4; ++r) if (4 * fq + r > fr) acc[r] = 0.f;
            }
            uint2 o; o.x = pack2(acc[0], acc[1]); o.y = pack2(acc[2], acc[3]);
            *(uint2*)(At + trow * VS + bj * 16 + 4 * fq) = o;
        }
        {
            unsigned z_ = 0u; asm volatile("" : "+v"(z_));
            if (wave == 2) *(uint2*)(At + (0 * 16 + fr) * VS + 16 + 4 * fq) = make_uint2(z_, z_);
            if (wave == 3) *(uint2*)(At + (2 * 16 + fr) * VS + 48 + 4 * fq) = make_uint2(z_, z_);
        }
        SCAN_SYNC();
        f32x4 oacc[4]; uint2 gz[4];
        {
            const int ti = wave & 3, vh = wave >> 2, trow = ti * 16 + fr;
            bf16x8 qh[KS];
#pragma unroll
            for (int kk = 0; kk < KS; ++kk) {
                const int k0 = kk * 32 + fq * 8;
                const uint4 qq = *(const uint4*)(qs + trow * QS + k0);
                const float4 t0_ = *(const float4*)(bs + trow * BS + k0), t1_ = *(const float4*)(bs + trow * BS + k0 + 4);
                union { bf16x8 v; unsigned u[4]; } q_;
                q_.u[0] = pack2(bflo(qq.x) * __expf(t0_.x), bfhi(qq.x) * __expf(t0_.y));
                q_.u[1] = pack2(bflo(qq.y) * __expf(t0_.z), bfhi(qq.y) * __expf(t0_.w));
                q_.u[2] = pack2(bflo(qq.z) * __expf(t1_.x), bfhi(qq.z) * __expf(t1_.y));
                q_.u[3] = pack2(bflo(qq.w) * __expf(t1_.z), bfhi(qq.w) * __expf(t1_.w));
                qh[kk] = q_.v;
            }
            const bf16x8 af0 = *(const bf16x8*)(At + trow * VS + fq * 8), af1 = *(const bf16x8*)(At + trow * VS + 32 + fq * 8);
            float sq = 0.f;
#pragma unroll
            for (int vi = 0; vi < 4; ++vi) {
                const int vrow = vh * 64 + vi * 16 + fr;
                gz[vi] = *(const uint2*)(Zc + (size_t)trow * LDZ + GCOL + vh * 64 + vi * 16 + 4 * fq);
                f32x4 acc = f32x4{0.f, 0.f, 0.f, 0.f};
                acc = __builtin_amdgcn_mfma_f32_16x16x32_bf16(*(const bf16x8*)(vt + vrow * VS + fq * 8), af0, acc, 0, 0, 0);
                if (ti >= 2) acc = __builtin_amdgcn_mfma_f32_16x16x32_bf16(*(const bf16x8*)(vt + vrow * VS + 32 + fq * 8), af1, acc, 0, 0, 0);
#pragma unroll
                for (int kk = 0; kk < KS; ++kk)
                    acc = __builtin_amdgcn_mfma_f32_16x16x32_bf16(*(const bf16x8*)(st + vrow * QS + kk * 32 + fq * 8), qh[kk], acc, 0, 0, 0);
                oacc[vi] = acc * scale;
                sq += oacc[vi][0] * oacc[vi][0] + oacc[vi][1] * oacc[vi][1] + oacc[vi][2] * oacc[vi][2] + oacc[vi][3] * oacc[vi][3];
            }
            sq += shx<16>(sq); sq += shx<32>(sq);
            if (fq == 0) ssq[vh * 64 + trow] = sq;
        }
        {
            const int vrow = wave * 16 + fr;
            const bf16x8 vf0 = *(const bf16x8*)(vt + vrow * VS + fq * 8), vf1 = *(const bf16x8*)(vt + vrow * VS + 32 + fq * 8);
#pragma unroll
            for (int kt = 0; kt < KT; ++kt) {
                const float dec = __expf(blast[kt * 16 + fr]);
                sacc[kt][0] *= dec; sacc[kt][1] *= dec; sacc[kt][2] *= dec; sacc[kt][3] *= dec;
                sacc[kt] = __builtin_amdgcn_mfma_f32_16x16x32_bf16(vf0, *(const bf16x8*)(kht + (kt * 16 + fr) * VS + fq * 8), sacc[kt], 0, 0, 0);
                sacc[kt] = __builtin_amdgcn_mfma_f32_16x16x32_bf16(vf1, *(const bf16x8*)(kht + (kt * 16 + fr) * VS + 32 + fq * 8), sacc[kt], 0, 0, 0);
            }
        }
        SCAN_SYNC();
#pragma unroll
        for (int kt = 0; kt < KT; ++kt)
#pragma unroll
            for (int r = 0; r < 4; ++r) st[(wave * 16 + 4 * fq + r) * QS + kt * 16 + fr] = f2bf(sacc[kt][r]);
        {
            const int ti = wave & 3, vh = wave >> 2, trow = ti * 16 + fr;
            const float rstd = rsqrtf((ssq[trow] + ssq[64 + trow]) * (1.f / 128.f) + 1e-6f);
            bf16_t* yrow = (bf16_t*)(p.ws + WS_Y) + (size_t)(b * 2048 + c * 64 + trow) * 1536 + (GLA ? 1024 : 0) + h * 128 + vh * 64 + 4 * fq;
#pragma unroll
            for (int vi = 0; vi < 4; ++vi) {
                const f32x4 g4_ = gn4[vi]; const float4 g4 = make_float4(g4_[0], g4_[1], g4_[2], g4_[3]);
                const float z0 = bflo(gz[vi].x), z1 = bfhi(gz[vi].x), z2 = bflo(gz[vi].y), z3 = bfhi(gz[vi].y);
                uint2 o;
                o.x = pack2(oacc[vi][0] * rstd * g4.x * (z0 * sigm(z0)), oacc[vi][1] * rstd * g4.y * (z1 * sigm(z1)));
                o.y = pack2(oacc[vi][2] * rstd * g4.z * (z2 * sigm(z2)), oacc[vi][3] * rstd * g4.w * (z3 * sigm(z3)));
                *(uint2*)(yrow + vi * 16) = o;
            }
        }
    }
    SCAN_SYNC();
}

__device__ void dsaprep2_item(const Params& p, int l, int item, char* smem_) {
    bf16_t* tile = (bf16_t*)smem_;
    const int tid = TIDX(), lane = tid & 63, wave = tid >> 6;
    bf16_t* Z = (bf16_t*)(p.ws + WS_Z); bf16_t* VT = (bf16_t*)(p.ws + WS_VT);
    {
        const int tb = item * 32;
        {
            const float2 gq = *(const float2*)(p.dsa_qn + l * 128 + lane * 2), gk = *(const float2*)(p.dsa_kn + l * 128 + lane * 2);
            unsigned uu[4][8];
#pragma unroll
            for (int j = 0; j < 4; ++j)
#pragma unroll
                for (int grp = 0; grp < 8; ++grp)
                    uu[j][grp] = *(const unsigned*)(Z + (size_t)(tb + wave + 8 * j) * LDZ + (grp < 4 ? ZB_Q : ZB_K) + (grp & 3) * 128 + lane * 2);
#pragma unroll
            for (int j = 0; j < 4; ++j)
#pragma unroll
                for (int grp = 0; grp < 8; ++grp) {
                    bf16_t* ptr = Z + (size_t)(tb + wave + 8 * j) * LDZ + (grp < 4 ? ZB_Q : ZB_K) + (grp & 3) * 128 + lane * 2;
                    const float a = bflo(uu[j][grp]), b = bfhi(uu[j][grp]);
                    const float ss = wave_sum(a * a + b * b);
                    const float r = rsqrtf(ss * (1.f / 128.f) + 1e-6f) * ((grp < 4) ? 0.08838834764831845f : 1.f);
                    const float2 g = (grp < 4) ? gq : gk;
                    __hip_atomic_store((unsigned*)ptr, pack2(a * r * g.x, b * r * g.y), __ATOMIC_RELAXED, __HIP_MEMORY_SCOPE_AGENT);
                }
        }
        u32x4 uv[4];
#pragma unroll
        for (int i = 0; i < 4; ++i) { const int ch = tid + i * 512; uv[i] = *(const u32x4*)(Z + (size_t)(tb + (ch >> 6)) * LDZ + ZB_V + (ch & 63) * 8); }
#pragma unroll
        for (int i = 0; i < 4; ++i) {
            const int ch = tid + i * 512, t = ch >> 6, c8 = (ch & 63) * 8;
            unsigned* d = (unsigned*)(tile + t * 514 + c8);
            d[0] = uv[i][0]; d[1] = uv[i][1]; d[2] = uv[i][2]; d[3] = uv[i][3];
        }
        __syncthreads();
        {
            const int c = tid, b = tb >> 11, s0 = tb & 2047;
            unsigned w[16];
#pragma unroll
            for (int j = 0; j < 16; ++j) w[j] = (unsigned)tile[(2 * j) * 514 + c] | ((unsigned)tile[(2 * j + 1) * 514 + c] << 16);
            unsigned long long* dst = (unsigned long long*)(VT + ((size_t)(b * 512 + c)) * 2048 + s0);
#pragma unroll
            for (int j = 0; j < 8; ++j) __hip_atomic_store(dst + j, ((unsigned long long)w[2 * j + 1] << 32) | w[2 * j], __ATOMIC_RELAXED, __HIP_MEMORY_SCOPE_AGENT);
        }
        __syncthreads();
    }
}

__device__ void dsa_select_tile(const Params& p, int b, int tq, char* smem_) {
    constexpr int KS_ = 2052;
    unsigned* keyL = (unsigned*)smem_;
    const int tid = TIDX(), lane = tid & 63, wave = __builtin_amdgcn_readfirstlane(tid >> 6), fr = lane & 15, fq = lane >> 4;
    const bf16_t* Z = (const bf16_t*)(p.ws + WS_Z);
    unsigned long long* BM64 = (unsigned long long*)(p.ws + WS_BM);
    const int t0 = tq * 16;
    {
        const int tl = t0 + fr;
        const size_t trow = (size_t)b * 2048 + tl;
        bf16x8 qf[4][2];
#pragma unroll
        for (int h = 0; h < 4; ++h)
#pragma unroll
            for (int ks = 0; ks < 2; ++ks) qf[h][ks] = *(const bf16x8*)(Z + trow * LDZ + ZB_QI + h * 64 + ks * 32 + fq * 8);
        float w[4];
#pragma unroll
        for (int h = 0; h < 4; ++h) w[h] = bf2f(Z[trow * LDZ + ZB_WI + h]) * 0.5f;
#pragma unroll 4
        for (int kt = wave; kt <= tq; kt += 8) {
            const bf16_t* kr = Z + ((size_t)b * 2048 + kt * 16 + fr) * LDZ + ZB_KI + fq * 8;
            const bf16x8 k0 = *(const bf16x8*)kr, k1 = *(const bf16x8*)(kr + 32);
            f32x4 acc[4];
#pragma unroll
            for (int h = 0; h < 4; ++h) {
                acc[h] = __builtin_amdgcn_mfma_f32_16x16x32_bf16(k0, qf[h][0], f32x4{0.f, 0.f, 0.f, 0.f}, 0, 0, 0);
                acc[h] = __builtin_amdgcn_mfma_f32_16x16x32_bf16(k1, qf[h][1], acc[h], 0, 0, 0);
            }
            u32x4 kk;
#pragma unroll
            for (int r = 0; r < 4; ++r) {
                float sc = w[0] * fmaxf(acc[0][r] * 0.125f, 0.f) + w[1] * fmaxf(acc[1][r] * 0.125f, 0.f) + w[2] * fmaxf(acc[2][r] * 0.125f, 0.f) + w[3] * fmaxf(acc[3][r] * 0.125f, 0.f);
                if (sc == 0.f) sc = 0.f;
                const unsigned u = __float_as_uint(sc);
                const unsigned k = (u & 0x80000000u) ? ~u : (u | 0x80000000u);
                kk[r] = (kt * 16 + 4 * fq + r <= tl) ? k : 0u;
            }
            *(u32x4*)(keyL + fr * KS_ + kt * 16 + 4 * fq) = kk;
        }
    }
    __syncthreads();
    {
        const int nk = (tq + 1) * 16, jmax = (nk + 63) >> 6;
        const int qa = 2 * wave, qb = qa + 1;
        unsigned ka[32], kb[32];
#pragma unroll
        for (int j = 0; j < 32; ++j) {
            const int s = lane + 64 * j;
            ka[j] = (s < nk) ? keyL[qa * KS_ + s] : 0u;
            kb[j] = (s < nk) ? keyL[qb * KS_ + s] : 0u;
        }
        unsigned Ta = 1u, Tb = 1u; int Ca = 2047, Cb = 2047;
        if (t0 >= 256) {
            int na, nb;
            bool da, db;
            {
                int c0 = 0, c1 = 0, c2 = 0, c3 = 0;
#pragma unroll
                for (int j = 0; j < 32; ++j)
                    if (j < jmax) { c0 += (ka[j] >= 0x80000000u); c1 += (ka[j] > 0x80000000u); c2 += (kb[j] >= 0x80000000u); c3 += (kb[j] > 0x80000000u); }
                c0 = wave_total_i(c0); c1 = wave_total_i(c1); c2 = wave_total_i(c2); c3 = wave_total_i(c3);
                da = (c1 < 256 && c0 >= 256); db = (c3 < 256 && c2 >= 256);
                Ta = da ? 0x80000000u : ((c0 >= 256) ? 0x80000000u : 0u); na = da ? c0 : ((c0 >= 256) ? c0 : 0x7fffffff);
                Tb = db ? 0x80000000u : ((c2 >= 256) ? 0x80000000u : 0u); nb = db ? c2 : ((c2 >= 256) ? c2 : 0x7fffffff);
            }
            for (int bit = 30; bit >= 0; --bit) {
                if (da && db) break;
                const unsigned ca_ = Ta | (1u << bit), cb_ = Tb | (1u << bit);
                int c0 = 0, c1 = 0;
#pragma unroll
                for (int j = 0; j < 32; ++j)
                    if (j < jmax) { c0 += (ka[j] >= ca_); c1 += (kb[j] >= cb_); }
                c0 = wave_total_i(c0); c1 = wave_total_i(c1);
                if (!da && c0 >= 256) { Ta = ca_; na = c0; }
                if (!db && c1 >= 256) { Tb = cb_; nb = c1; }
                da = da || (na == 256); db = db || (nb == 256);
            }
            if (na != 256 || nb != 256) {
                int needa, needb;
                {
                    int c0 = 0, c1 = 0;
#pragma unroll
                    for (int j = 0; j < 32; ++j)
                        if (j < jmax) { c0 += (ka[j] > Ta); c1 += (kb[j] > Tb); }
                    needa = 256 - wave_total_i(c0); needb = 256 - wave_total_i(c1);
                }
                Ca = 0; Cb = 0;
                for (int bit = 10; bit >= 0; --bit) {
                    const int ca_ = Ca | (1 << bit), cb_ = Cb | (1 << bit);
                    int c0 = 0, c1 = 0;
#pragma unroll
                    for (int j = 0; j < 32; ++j)
                        if (j < jmax) { const int s = lane + 64 * j; c0 += (ka[j] == Ta && s < ca_); c1 += (kb[j] == Tb && s < cb_); }
                    c0 = wave_total_i(c0); c1 = wave_total_i(c1);
                    if (c0 < needa) Ca = ca_;
                    if (c1 < needb) Cb = cb_;
                }
            }
        }
        const size_t rowa = (size_t)b * 2048 + t0 + qa;
#pragma unroll
        for (int j = 0; j < 32; ++j) {
            const int s = lane + 64 * j;
            const unsigned long long ma = __ballot((ka[j] > Ta) || (ka[j] == Ta && s <= Ca));
            const unsigned long long mb = __ballot((kb[j] > Tb) || (kb[j] == Tb && s <= Cb));
            if (lane == 0) {
                __hip_atomic_store(&BM64[rowa * 32 + j], ma, __ATOMIC_RELAXED, __HIP_MEMORY_SCOPE_AGENT);
                __hip_atomic_store(&BM64[(rowa + 1) * 32 + j], mb, __ATOMIC_RELAXED, __HIP_MEMORY_SCOPE_AGENT);
            }
        }
    }
    __syncthreads();
}

__device__ void dsa_attn_item(const Params& p, int b, int h, int qg, char* smem_) {
    constexpr int KSTR = 136, VSTR = 40;
    bf16_t* Kl = (bf16_t*)smem_;
    bf16_t* Vl = Kl + 2 * 32 * KSTR;
    const int tid = TIDX(), lane = tid & 63, wave = __builtin_amdgcn_readfirstlane(tid >> 6), fr = lane & 15, fq = lane >> 4;
    const bf16_t* Z = (const bf16_t*)(p.ws + WS_Z); const bf16_t* VT = (const bf16_t*)(p.ws + WS_VT);
    const unsigned* BM = (const unsigned*)(p.ws + WS_BM); bf16_t* Y = (bf16_t*)(p.ws + WS_Y);
    const int kr = tid >> 4, kc = tid & 15, vd = tid >> 2, vc = tid & 3;
    const int ka_row = 8 * (fr >> 2) + (fr & 3);
    {
        const int t0 = qg * 128 + wave * 16;
        const size_t trow = (size_t)b * 2048 + t0 + fr;
        bf16x8 qf[4];
#pragma unroll
        for (int ks = 0; ks < 4; ++ks) qf[ks] = *(const bf16x8*)(Z + trow * LDZ + ZB_Q + h * 128 + ks * 32 + fq * 8);
        f32x4 o[8];
#pragma unroll
        for (int i = 0; i < 8; ++i) o[i] = f32x4{0.f, 0.f, 0.f, 0.f};
        float m = -INFINITY, lsum = 0.f;
        const unsigned* bmrow = BM + trow * 64;
        const int nsteps_blk = qg * 4 + 4, nsteps_w = (t0 + 15) / 32 + 1;
        const bf16_t* kg = Z + ((size_t)b * 2048 + kr) * LDZ + ZB_K + h * 128 + kc * 8;
        const bf16_t* vg = VT + ((size_t)(b * 4 + h) * 128 + vd) * 2048 + vc * 8;
        u32x4 rk = *(const u32x4*)kg, rv = *(const u32x4*)vg;
        *(u32x4*)(Kl + kr * KSTR + kc * 8) = rk; *(u32x4*)(Vl + vd * VSTR + vc * 8) = rv;
        __syncthreads();
        unsigned mwn = bmrow[0];
        for (int st = 0; st < nsteps_blk; ++st) {
            const bool more = (st + 1 < nsteps_blk);
            const unsigned mwc = mwn;
            mwn = bmrow[(st + 1 < nsteps_w) ? st + 1 : st];
            if (more) { rk = *(const u32x4*)(kg + (size_t)(st + 1) * 32 * LDZ); rv = *(const u32x4*)(vg + (st + 1) * 32); }
            if (st < nsteps_w) {
                const bf16_t* Kb = Kl + (st & 1) * 32 * KSTR; const bf16_t* Vb = Vl + (st & 1) * 128 * VSTR;
                f32x4 sa = f32x4{0.f, 0.f, 0.f, 0.f}, sb = f32x4{0.f, 0.f, 0.f, 0.f};
#pragma unroll
                for (int ks = 0; ks < 4; ++ks) {
                    const bf16x8 fa = *(const bf16x8*)(Kb + ka_row * KSTR + ks * 32 + fq * 8), fb = *(const bf16x8*)(Kb + (ka_row + 4) * KSTR + ks * 32 + fq * 8);
                    sa = __builtin_amdgcn_mfma_f32_16x16x32_bf16(fa, qf[ks], sa, 0, 0, 0);
                    sb = __builtin_amdgcn_mfma_f32_16x16x32_bf16(fb, qf[ks], sb, 0, 0, 0);
                }
                const unsigned mw = mwc >> (8 * fq);
                float x[8];
#pragma unroll
                for (int r = 0; r < 4; ++r) { x[r] = ((mw >> r) & 1u) ? sa[r] : -INFINITY; x[4 + r] = ((mw >> (4 + r)) & 1u) ? sb[r] : -INFINITY; }
                float mx = fmaxf(fmaxf(fmaxf(x[0], x[1]), fmaxf(x[2], x[3])), fmaxf(fmaxf(x[4], x[5]), fmaxf(x[6], x[7])));
                mx = fmaxf(mx, shx<16>(mx)); mx = fmaxf(mx, shx<32>(mx));
                const float mnew = fmaxf(m, mx);
                const float msafe = (mnew == -INFINITY) ? 0.f : mnew;
                const float alpha = __expf(m - msafe);
                float pe[8]; float ps = 0.f;
#pragma unroll
                for (int j = 0; j < 8; ++j) { pe[j] = __expf(x[j] - msafe); ps += pe[j]; }
                lsum = lsum * alpha + ps;
                m = mnew;
#pragma unroll
                for (int i = 0; i < 8; ++i) { o[i][0] *= alpha; o[i][1] *= alpha; o[i][2] *= alpha; o[i][3] *= alpha; }
                union { bf16x8 v; unsigned u[4]; } pf;
                pf.u[0] = pack2(pe[0], pe[1]); pf.u[1] = pack2(pe[2], pe[3]); pf.u[2] = pack2(pe[4], pe[5]); pf.u[3] = pack2(pe[6], pe[7]);
#pragma unroll
                for (int i = 0; i < 8; ++i) {
                    const bf16x8 vf = *(const bf16x8*)(Vb + (i * 16 + fr) * VSTR + fq * 8);
                    o[i] = __builtin_amdgcn_mfma_f32_16x16x32_bf16(vf, pf.v, o[i], 0, 0, 0);
                }
            }
            if (more) { *(u32x4*)(Kl + ((st + 1) & 1) * 32 * KSTR + kr * KSTR + kc * 8) = rk; *(u32x4*)(Vl + ((st + 1) & 1) * 128 * VSTR + vd * VSTR + vc * 8) = rv; }
            __syncthreads();
        }
        lsum += shx<16>(lsum); lsum += shx<32>(lsum);
        const float inv = 1.f / lsum;
#pragma unroll
        for (int i = 0; i < 8; ++i) {
            uint2 ov; ov.x = pack2(o[i][0] * inv, o[i][1] * inv); ov.y = pack2(o[i][2] * inv, o[i][3] * inv);
            *(uint2*)(Y + trow * 1536 + 512 + h * 128 + i * 16 + 4 * fq) = ov;
        }
    }
}

constexpr int LDS_BYTES = 155648;
__device__ void ph_mixA(const Params& p, int l, int vb0, int nvb, char* smem_) {
    for (int item = vb0; item < 64; item += nvb) {
        if (item < 32) scan2_item<128, false>(p, l, item >> 2, item & 3, smem_);
        else scan2_item<64, true>(p, l, (item - 32) >> 2, (item - 32) & 3, smem_);
    }
    unsigned* ctr = (unsigned*)(p.ws + WS_CTL) + 3584 + l * 64;
    unsigned* done = (unsigned*)(p.ws + WS_CTL) + 5300 + l * 8 * 16;
    volatile int* slot = (volatile int*)(smem_ + LDS_BYTES - 64);
    for (;;) {
        if (TIDX() == 0) *slot = (int)atomicAdd(ctr, 1u);
        __syncthreads();
        const int idx = __builtin_amdgcn_readfirstlane(*slot);
        __syncthreads();
        if (idx >= 2048) break;
        if (idx < 1536) {
            const int b = idx / 192, r = idx % 192;
            if (r < 128) dsa_select_tile(p, b, 127 - r, smem_);
            else dsaprep2_item(p, l, b * 64 + (r - 128), smem_);
            asm volatile("s_waitcnt vmcnt(0)" ::: "memory");
            __syncthreads();
            if (TIDX() == 0) __hip_atomic_fetch_add(done + b * 16, 1u, __ATOMIC_RELAXED, __HIP_MEMORY_SCOPE_AGENT);
        } else {
            const int a = idx - 1536, b = a >> 6, h = (a >> 4) & 3, qg = 15 - (a & 15);
            if (TIDX() == 0) {
                unsigned spins = 0;
                while (__hip_atomic_load(done + b * 16, __ATOMIC_RELAXED, __HIP_MEMORY_SCOPE_AGENT) < 192u) { __builtin_amdgcn_s_sleep(2); if (++spins > (1u << 18)) break; }
                __builtin_amdgcn_fence(__ATOMIC_ACQUIRE, "agent");
                asm volatile("s_waitcnt vmcnt(0)" ::: "memory");
            }
            __syncthreads();
            dsa_attn_item(p, b, h, qg, smem_);
        }
    }
}

__device__ __forceinline__ int f2sort(float f) { int i = __float_as_int(f); return i ^ ((i >> 31) & 0x7fffffff); }
__device__ __forceinline__ float sort2f(int i) { return __int_as_float(i ^ ((i >> 31) & 0x7fffffff)); }
#define INSK(K, xv) do { int _x = (xv); \
    _Pragma("unroll") for (int _j = 0; _j < 16; ++_j) { int _hi = max(K[_j], _x); _x = min(K[_j], _x); K[_j] = _hi; } } while (0)
#define INS64(K, xv) do { unsigned long long _x = (xv); \
    _Pragma("unroll") for (int _j = 0; _j < 16; ++_j) { bool _c = _x > K[_j]; unsigned long long _o = K[_j]; K[_j] = _c ? _x : _o; _x = _c ? _o : _x; } } while (0)

__device__ void ph_route(const Params& p, int vb0, int nvb, char* smem_) {
    typedef _Float16 h8 __attribute__((ext_vector_type(8)));
    const _Float16* SC = (const _Float16*)(p.ws + WS_SC);
    int* RI = (int*)(p.ws + WS_RI); float* RG = (float*)(p.ws + WS_RG);
    const int tid = TIDX(), lane = tid & 63, wave = tid >> 6;
    _Float16* tile = (_Float16*)smem_ + wave * (64 * 72);
    for (int item0 = (vb0 * 8 + wave) * 64; item0 < T_TOK * 8; item0 += nvb * 8 * 64) {
        const int item = item0 + lane;
        const int t = item >> 3, h = item & 7;
        const _Float16* s0 = SC + (size_t)t * 2048 + h * 256;
        const _Float16* wbase = SC + (size_t)item0 * 256;
        int k0[16], k1[16];
#pragma unroll
        for (int j = 0; j < 16; ++j) { k0[j] = (int)0x80000000; k1[j] = (int)0x80000000; }
#pragma unroll 1
        for (int slab = 0; slab < 4; ++slab) {
            h8 ld[8];
#pragma unroll
            for (int j = 0; j < 4; ++j) {
                const _Float16* src = wbase + (size_t)(16 * j + (lane >> 2)) * 256 + slab * 32 + (lane & 3) * 8;
                ld[j] = *(const h8*)src; ld[4 + j] = *(const h8*)(src + 128);
            }
            __builtin_amdgcn_wave_barrier();
#pragma unroll
            for (int j = 0; j < 4; ++j) {
                _Float16* dst = tile + (16 * j + (lane >> 2)) * 72 + (lane & 3) * 8;
                *(h8*)dst = ld[j]; *(h8*)(dst + 32) = ld[4 + j];
            }
            __builtin_amdgcn_fence(__ATOMIC_RELEASE, "wavefront");
            __builtin_amdgcn_wave_barrier();
            __builtin_amdgcn_fence(__ATOMIC_ACQUIRE, "wavefront");
#pragma unroll 2
            for (int ii = 0; ii < 32; ii += 8) {
                const int i = slab * 32 + ii;
                const h8 a = *(const h8*)(tile + lane * 72 + ii), b = *(const h8*)(tile + lane * 72 + 32 + ii);
#pragma unroll
                for (int e_ = 0; e_ < 8; ++e_) {
                    INSK(k0, (f2sort((float)a[e_]) & ~127) | (127 - i - e_));
                    INSK(k1, (f2sort((float)b[e_]) & ~127) | (127 - i - e_));
                }
            }
            __builtin_amdgcn_wave_barrier();
        }
        float v0[16], v1[16];
#pragma unroll
        for (int j = 0; j < 16; ++j) { k0[j] = 127 - (k0[j] & 127); k1[j] = 127 - (k1[j] & 127); v0[j] = (float)s0[k0[j]]; v1[j] = (float)s0[128 + k1[j]]; }
        unsigned long long ck[16];
#pragma unroll
        for (int j = 0; j < 16; ++j) ck[j] = 0ull;
#pragma unroll
        for (int a = 0; a < 16; ++a)
#pragma unroll
            for (int b = 0; b < 16; ++b)
                if ((a + 1) * (b + 1) <= 16) {
                    unsigned hi = (unsigned)f2sort(v0[a] + v1[b]) ^ 0x80000000u;
                    unsigned lo = ((unsigned)(255 - (a * 16 + b)) << 16) | (unsigned)(k0[a] * 128 + k1[b]);
                    INS64(ck, ((unsigned long long)hi << 32) | lo);
                }
        float e[16]; float sm = 0.f;
        const float mx = sort2f((int)((unsigned)(ck[0] >> 32) ^ 0x80000000u));
#pragma unroll
        for (int j = 0; j < 16; ++j) { e[j] = expf(sort2f((int)((unsigned)(ck[j] >> 32) ^ 0x80000000u)) - mx); sm += e[j]; }
        const float inv = 1.f / sm;
#pragma unroll
        for (int j = 0; j < 16; j += 4) {
            *(int4*)(RI + (size_t)t * 128 + h * 16 + j) = make_int4((int)(ck[j] & 0xffffu), (int)(ck[j + 1] & 0xffffu), (int)(ck[j + 2] & 0xffffu), (int)(ck[j + 3] & 0xffffu));
            *(float4*)(RG + (size_t)t * 128 + h * 16 + j) = make_float4(e[j] * inv, e[j + 1] * inv, e[j + 2] * inv, e[j + 3] * inv);
        }
    }
}

__device__ __forceinline__ void fp8x16_to_f32(const uint4 q, float (&f)[16]) {
    const unsigned w[4] = {q.x, q.y, q.z, q.w};
#pragma unroll
    for (int c = 0; c < 4; ++c) {
        auto f0 = __builtin_amdgcn_cvt_pk_f32_fp8((int)w[c], false); auto f1 = __builtin_amdgcn_cvt_pk_f32_fp8((int)w[c], true);
        f[4 * c] = f0[0]; f[4 * c + 1] = f0[1]; f[4 * c + 2] = f1[0]; f[4 * c + 3] = f1[1];
    }
}
constexpr bool G2_MFMA = true;
constexpr bool G1_MFMA = true;
typedef float f32x2_t __attribute__((ext_vector_type(2)));
__device__ __forceinline__ float g1_half(const u32x4 (&uq)[8], const float (&hv)[16], int lane) {
    float part[8];
#pragma unroll
    for (int it = 0; it < 8; ++it) {
        f32x2_t d2 = {0.f, 0.f};
#pragma unroll
        for (int c_ = 0; c_ < 4; ++c_) {
            const f32x2_t f0 = __builtin_amdgcn_cvt_pk_f32_fp8((int)uq[it][c_], false), f1 = __builtin_amdgcn_cvt_pk_f32_fp8((int)uq[it][c_], true);
            d2 = __builtin_elementwise_fma(f32x2_t{hv[4 * c_], hv[4 * c_ + 1]}, f0, d2);
            d2 = __builtin_elementwise_fma(f32x2_t{hv[4 * c_ + 2], hv[4 * c_ + 3]}, f1, d2);
        }
        part[it] = d2[0] + d2[1];
    }
    float r4[4], r2[2];
    const bool b2_ = lane & 4, b1_ = lane & 2, b0_ = lane & 1;
#pragma unroll
    for (int j = 0; j < 4; ++j) { const float snd = b2_ ? part[j] : part[j + 4], kp = b2_ ? part[j + 4] : part[j]; r4[j] = kp + shx<4>(snd); }
#pragma unroll
    for (int j = 0; j < 2; ++j) { const float snd = b1_ ? r4[j] : r4[j + 2], kp = b1_ ? r4[j + 2] : r4[j]; r2[j] = kp + shx<2>(snd); }
    const float snd = b0_ ? r2[0] : r2[1], kp = b0_ ? r2[1] : r2[0];
    return kp + shx<1>(snd);
}
__device__ __forceinline__ void peer_gather8(u32x4 (&q)[8], const unsigned char* tab, const int* idx, unsigned l16) {
#pragma unroll
    for (int it = 0; it < 8; ++it) { const unsigned e_ = (unsigned)idx[it * 8]; q[it] = *(const u32x4*)(tab + ((e_ << 7) | l16)); }
}
template <bool PRE>
__device__ __forceinline__ void g1_step(int i, int t, const bf16_t* hrow_next, const unsigned char* ub, const int* lri_eg, unsigned l16, int lane, float* pp_row,
                                        u32x4& hq0, u32x4& hq1, u32x4 (&uqA)[8], u32x4 (&uqB)[8]) {
    float hv[16];
#pragma unroll
    for (int c_ = 0; c_ < 4; ++c_) { hv[2 * c_] = bflo(hq0[c_]); hv[2 * c_ + 1] = bfhi(hq0[c_]); hv[8 + 2 * c_] = bflo(hq1[c_]); hv[8 + 2 * c_ + 1] = bfhi(hq1[c_]); }
    if (PRE) { const u32x4* hp = (const u32x4*)hrow_next; hq0 = hp[0]; hq1 = hp[1]; }
    const float d0 = g1_half(uqA, hv, lane);
    __builtin_amdgcn_sched_barrier(0);
    if (PRE) { peer_gather8(uqA, ub, lri_eg + (i + 1) * 128, l16); __builtin_amdgcn_sched_barrier(0); }
    const float d1 = g1_half(uqB, hv, lane);
    __builtin_amdgcn_sched_barrier(0);
    if (PRE) { peer_gather8(uqB, ub, lri_eg + (i + 1) * 128 + 64, l16); __builtin_amdgcn_sched_barrier(0); }
    pp_row[0] = d0; pp_row[64] = d1;
}
template <bool PRE>
__device__ __forceinline__ void g2_step(int i, float2* op, const float2 gf, const unsigned char* vb_, const int* lri_eg, const float* lrg_eg, unsigned l16, int lane,
                                        u32x4 (&vqA)[8], u32x4 (&vqB)[8]) {
    const float2 xi = *op;
    f32x2_t y[8];
#pragma unroll
    for (int j = 0; j < 8; ++j) y[j] = f32x2_t{0.f, 0.f};
#pragma unroll
    for (int it = 0; it < 8; ++it) {
        const float ck = lrg_eg[i * 128 + it * 8]; const f32x2_t ck2 = {ck, ck};
#pragma unroll
        for (int c_ = 0; c_ < 4; ++c_) {
            y[2 * c_] = __builtin_elementwise_fma(ck2, __builtin_amdgcn_cvt_pk_f32_fp8((int)vqA[it][c_], false), y[2 * c_]);
            y[2 * c_ + 1] = __builtin_elementwise_fma(ck2, __builtin_amdgcn_cvt_pk_f32_fp8((int)vqA[it][c_], true), y[2 * c_ + 1]);
        }
    }
    __builtin_amdgcn_sched_barrier(0);
    if (PRE) { peer_gather8(vqA, vb_, lri_eg + (i + 1) * 128, l16); __builtin_amdgcn_sched_barrier(0); }
#pragma unroll
    for (int it = 0; it < 8; ++it) {
        const float ck = lrg_eg[i * 128 + 64 + it * 8]; const f32x2_t ck2 = {ck, ck};
#pragma unroll
        for (int c_ = 0; c_ < 4; ++c_) {
            y[2 * c_] = __builtin_elementwise_fma(ck2, __builtin_amdgcn_cvt_pk_f32_fp8((int)vqB[it][c_], false), y[2 * c_]);
            y[2 * c_ + 1] = __builtin_elementwise_fma(ck2, __builtin_amdgcn_cvt_pk_f32_fp8((int)vqB[it][c_], true), y[2 * c_ + 1]);
        }
    }
    __builtin_amdgcn_sched_barrier(0);
    if (PRE) { peer_gather8(vqB, vb_, lri_eg + (i + 1) * 128 + 64, l16); __builtin_amdgcn_sched_barrier(0); }
    float r8[8], r4[4], r2[2];
    const bool b5 = lane & 32, b4 = lane & 16, b3 = lane & 8;
#pragma unroll
    for (int j = 0; j < 8; ++j) { const float lo = y[j >> 1][j & 1], hi = y[4 + (j >> 1)][j & 1]; const float snd = b5 ? lo : hi, kp = b5 ? hi : lo; r8[j] = kp + shx<32>(snd); }
#pragma unroll
    for (int j = 0; j < 4; ++j) { const float snd = b4 ? r8[j] : r8[j + 4], kp = b4 ? r8[j + 4] : r8[j]; r4[j] = kp + shx<16>(snd); }
#pragma unroll
    for (int j = 0; j < 2; ++j) { const float snd = b3 ? r4[j] : r4[j + 2], kp = b3 ? r4[j + 2] : r4[j]; r2[j] = kp + shx<8>(snd); }
    *op = make_float2(xi.x + gf.x * r2[0], xi.y + gf.y * r2[1]);
}
typedef int i32x4_t __attribute__((ext_vector_type(4)));
typedef int i32x8_t __attribute__((ext_vector_type(8)));
constexpr int G1W = 18432;
__device__ __forceinline__ void g1m_dma(const unsigned char* ub, PG8_LAS unsigned char* img, const PG8_LAS unsigned short* idx, int i, int hh, int eg, unsigned q16) {
    const u32x4 w = *(const PG8_LAS u32x4*)(idx + ((i * 8 + eg) * 16 + hh * 8));
#pragma unroll
    for (int it = 0; it < 8; ++it) {
        const unsigned e_ = (it & 1) ? (w[it >> 1] >> 16) : (w[it >> 1] & 0xffffu);
        const unsigned off = (e_ << 7) | ((it & 1) ? (q16 ^ 64u) : q16);
        __builtin_amdgcn_global_load_lds((const unsigned*)(ub + off), (PG8_LAS unsigned*)(img + it * 1024), 16, 0, 0);
    }
}
template <bool PRE, int VMW>
__device__ __forceinline__ float g1m_step(const unsigned char* ub, PG8_LAS unsigned char* img, const PG8_LAS unsigned short* idx, int inext, int hh, int eg, unsigned q16,
                                          unsigned rdoff, int lane, const u32x4 a0, const u32x4 a1) {
    asm volatile("s_waitcnt vmcnt(%0)" :: "n"(VMW) : "memory");
    i32x8_t b[4];
#pragma unroll
    for (int mb = 0; mb < 4; ++mb) {
        const unsigned ro = (unsigned)mb * 2048u + rdoff;
        const i32x4_t lo = *(const PG8_LAS i32x4_t*)(img + ro), hi = *(const PG8_LAS i32x4_t*)(img + (ro ^ 64u));
        b[mb] = __builtin_shufflevector(lo, hi, 0, 1, 2, 3, 4, 5, 6, 7);
    }
    asm volatile("s_waitcnt lgkmcnt(0)" ::: "memory");
    if (PRE) g1m_dma(ub, img, idx, inext, hh, eg, q16);
    const i32x8_t a = __builtin_shufflevector((i32x4_t)a0, (i32x4_t)a1, 0, 1, 2, 3, 4, 5, 6, 7);
    float d[4]; f32x4 acc[4];
#pragma unroll
    for (int mb = 0; mb < 4; ++mb) acc[mb] = __builtin_amdgcn_mfma_scale_f32_16x16x128_f8f6f4(a, b[mb], f32x4{0.f, 0.f, 0.f, 0.f}, 0, 0, 0, 0x7f, 0, 0x7f);
#pragma unroll
    for (int mb = 0; mb < 4; ++mb) { d[mb] = acc[mb][0] + acc[mb][1] * (1.f / 16.f); asm volatile("" : "+v"(d[mb])); }
    const int g = lane >> 4;
    return g == 0 ? d[0] : g == 1 ? d[1] : g == 2 ? d[2] : d[3];
}
__device__ __forceinline__ void g1m_chunk(const Params& p, int x, int tb, char* smem_, int lane) {
    PG8_LAS unsigned char* wl = (PG8_LAS unsigned char*)smem_ + p.wv * G1W;
    PG8_LAS unsigned short* idx = (PG8_LAS unsigned short*)(wl + 16384);
    const int* RI = (const int*)(p.ws + WS_RI);
    {
        int ra[16];
#pragma unroll
        for (int i = 0; i < 8; ++i) { ra[2 * i] = RI[(size_t)(tb + i) * 128 + lane]; ra[2 * i + 1] = RI[(size_t)(tb + i) * 128 + 64 + lane]; }
#pragma unroll
        for (int i = 0; i < 8; ++i) {
            idx[(i * 8 + (lane & 7)) * 16 + (lane >> 3)] = (unsigned short)ra[2 * i];
            idx[(i * 8 + (lane & 7)) * 16 + 8 + (lane >> 3)] = (unsigned short)ra[2 * i + 1];
        }
    }
    __builtin_amdgcn_fence(__ATOMIC_RELEASE, "wavefront");
    __builtin_amdgcn_wave_barrier();
    __builtin_amdgcn_fence(__ATOMIC_ACQUIRE, "wavefront");
    const int eg = lane >> 3, n = lane & 15, kb = lane >> 4;
    const unsigned q16 = (unsigned)(((lane & 7) ^ (eg >> 1)) * 16);
    const unsigned rdoff = (unsigned)(n * 128 + ((kb ^ (n >> 1)) * 16));
    const unsigned char* ub = p.ws + WS_PU + (size_t)x * (16384u * 128u);
    const unsigned char* h8 = p.ws + ((lane & 1) ? WS_H8L : WS_H8H) + (size_t)tb * 1024 + x * 128 + kb * 16;
    float* pp = (float*)(p.ws + WS_PP) + ((size_t)x * T_TOK + tb) * 128 + lane;
    u32x4 ha[8][2];
#pragma unroll
    for (int i = 0; i < 8; ++i) { ha[i][0] = *(const u32x4*)(h8 + (size_t)i * 1024); ha[i][1] = *(const u32x4*)(h8 + (size_t)i * 1024 + 64); }
#pragma unroll
    for (int i = 0; i < 8; ++i) { asm volatile("" : "+v"(ha[i][0])); asm volatile("" : "+v"(ha[i][1])); }
    g1m_dma(ub, wl, idx, 0, 0, eg, q16);
    g1m_dma(ub, wl + 8192, idx, 0, 1, eg, q16);
    asm volatile("s_waitcnt vmcnt(8)" ::: "memory");
#pragma unroll
    for (int i = 0; i < 7; ++i) {
        const float v0 = g1m_step<true, 9>(ub, wl, idx, i + 1, 0, eg, q16, rdoff, lane, ha[i][0], ha[i][1]);
        pp[(size_t)i * 128] = v0;
        const float v1 = g1m_step<true, 9>(ub, wl + 8192, idx, i + 1, 1, eg, q16, rdoff, lane, ha[i][0], ha[i][1]);
        pp[(size_t)i * 128 + 64] = v1;
    }
    {
        const float v0 = g1m_step<false, 9>(ub, wl, idx, 0, 0, eg, q16, rdoff, lane, ha[7][0], ha[7][1]);
        pp[(size_t)7 * 128] = v0;
        const float v1 = g1m_step<false, 0>(ub, wl + 8192, idx, 0, 1, eg, q16, rdoff, lane, ha[7][0], ha[7][1]);
        pp[(size_t)7 * 128 + 64] = v1;
    }
}
typedef int i32x2_t __attribute__((ext_vector_type(2)));
template <bool PRE, int VMW, int HH>
__device__ __forceinline__ void g2m_step(const unsigned char* vb_, PG8_LAS unsigned char* img, const PG8_LAS unsigned short* idx, int inext, int eg, unsigned q16,
                                         const unsigned (&tra)[8], const long a0, const long a1, f32x4 (&acc)[8]) {
    asm volatile("s_waitcnt vmcnt(%0)" :: "n"(VMW) : "memory");
    long b[2][8];
#pragma unroll
    for (int u = 0; u < 2; ++u)
#pragma unroll
        for (int j = 0; j < 8; ++j) asm volatile("ds_read_b64_tr_b8 %0, %1 offset:%2" : "=v"(b[u][j]) : "v"(tra[j]), "n"(HH * 8192 + u * 4096) : "memory");
    asm volatile("s_waitcnt lgkmcnt(0)" : "+v"(b[0][0]), "+v"(b[0][1]), "+v"(b[0][2]), "+v"(b[0][3]), "+v"(b[0][4]), "+v"(b[0][5]), "+v"(b[0][6]), "+v"(b[0][7]) :: "memory");
    asm volatile("" : "+v"(b[1][0]), "+v"(b[1][1]), "+v"(b[1][2]), "+v"(b[1][3]), "+v"(b[1][4]), "+v"(b[1][5]), "+v"(b[1][6]), "+v"(b[1][7]) :: "memory");
    if (PRE) { g1m_dma(vb_, img + HH * 8192, idx, inext, HH, eg, q16); __builtin_amdgcn_sched_barrier(0); }
#pragma unroll
    for (int j = 0; j < 8; ++j) {
        acc[j] = __builtin_amdgcn_mfma_f32_16x16x32_fp8_fp8(a0, b[0][j], acc[j], 0, 0, 0);
        acc[j] = __builtin_amdgcn_mfma_f32_16x16x32_fp8_fp8(a1, b[1][j], acc[j], 0, 0, 0);
    }
}
__device__ __forceinline__ void g2m_chunk(const Params& p, int l, int x, int tb, char* smem_, int lane) {
    PG8_LAS unsigned char* wl = (PG8_LAS unsigned char*)smem_ + p.wv * G1W;
    PG8_LAS unsigned short* idx = (PG8_LAS unsigned short*)(wl + 16384);
    const int* RI = (const int*)(p.ws + WS_RI);
    {
        int ra[16];
#pragma unroll
        for (int i = 0; i < 8; ++i) { ra[2 * i] = RI[(size_t)(tb + i) * 128 + lane]; ra[2 * i + 1] = RI[(size_t)(tb + i) * 128 + 64 + lane]; }
#pragma unroll
        for (int i = 0; i < 8; ++i) {
            idx[(i * 8 + (lane & 7)) * 16 + (lane >> 3)] = (unsigned short)ra[2 * i];
            idx[(i * 8 + (lane & 7)) * 16 + 8 + (lane >> 3)] = (unsigned short)ra[2 * i + 1];
        }
    }
    __builtin_amdgcn_fence(__ATOMIC_RELEASE, "wavefront");
    __builtin_amdgcn_wave_barrier();
    __builtin_amdgcn_fence(__ATOMIC_ACQUIRE, "wavefront");
    const int eg = lane >> 3, kb = lane >> 4, li = lane & 15, q = li >> 1;
    const unsigned q16 = (unsigned)(((lane & 7) ^ (eg >> 1)) * 16);
    const int n16 = (kb & 1) * 8 + q;
    const unsigned trbase = (unsigned)((kb * 8 + q) * 128 + ((n16 >> 1) & 7) * 16 + (li & 1) * 8);
    const unsigned char* vb_ = p.ws + WS_PV + (size_t)x * (16384u * 128u);
    float* op = p.out + (size_t)tb * 1024 + x * 128 + lane;
    const float* modr = (const float*)(p.ws + WS_MOD) + (size_t)(l * 8 + (tb >> 11)) * 6144 + 5120 + x * 128 + lane;
    float gf0 = modr[0], gf1 = modr[64];
    const unsigned char* c8 = p.ws + ((lane & 1) ? WS_C8L : WS_C8H) + (size_t)tb * 128 + kb * 32;
    u32x4 ca[8][2]; float xi[8][2], cinv[8];
#pragma unroll
    for (int i = 0; i < 8; ++i) {
        ca[i][0] = *(const u32x4*)(c8 + (size_t)i * 128); ca[i][1] = *(const u32x4*)(c8 + (size_t)i * 128 + 16);
        xi[i][0] = op[(size_t)i * 1024]; xi[i][1] = op[(size_t)i * 1024 + 64];
        cinv[i] = ((const float*)(p.ws + WS_CINV))[tb + i];
    }
#pragma unroll
    for (int i = 0; i < 8; ++i) { asm volatile("" : "+v"(ca[i][0])); asm volatile("" : "+v"(ca[i][1])); asm volatile("" : "+v"(xi[i][0]), "+v"(xi[i][1]), "+v"(cinv[i])); }
    asm volatile("" : "+v"(gf0), "+v"(gf1));
    g1m_dma(vb_, wl, idx, 0, 0, eg, q16);
    g1m_dma(vb_, wl + 8192, idx, 0, 1, eg, q16);
    asm volatile("s_waitcnt vmcnt(8)" ::: "memory");
    const int g = lane >> 4;
    unsigned tra[8];
#pragma unroll
    for (int j = 0; j < 8; ++j) tra[j] = (unsigned)(unsigned long)wl + (trbase ^ (unsigned)(j * 16));
#define G2M_TOKEN(i, PRE_, W0, W1) do { \
        f32x4 acc[8]; \
        _Pragma("unroll") for (int j = 0; j < 8; ++j) acc[j] = f32x4{0.f, 0.f, 0.f, 0.f}; \
        const long a00 = (long)(((unsigned long long)ca[i][0][1] << 32) | ca[i][0][0]), a01 = (long)(((unsigned long long)ca[i][0][3] << 32) | ca[i][0][2]); \
        const long a10 = (long)(((unsigned long long)ca[i][1][1] << 32) | ca[i][1][0]), a11 = (long)(((unsigned long long)ca[i][1][3] << 32) | ca[i][1][2]); \
        g2m_step<PRE_, W0, 0>(vb_, wl, idx, (i) + 1, eg, q16, tra, a00, a01, acc); \
        g2m_step<PRE_, W1, 1>(vb_, wl, idx, (i) + 1, eg, q16, tra, a10, a11, acc); \
        float y[8]; \
        _Pragma("unroll") for (int j = 0; j < 8; ++j) { y[j] = acc[j][0] + acc[j][1] * (1.f / 16.f); asm volatile("" : "+v"(y[j])); } \
        const float ya = g == 0 ? y[0] : g == 1 ? y[1] : g == 2 ? y[2] : y[3], yb = g == 0 ? y[4] : g == 1 ? y[5] : g == 2 ? y[6] : y[7]; \
        op[(size_t)(i) * 1024] = xi[i][0] + gf0 * (ya * cinv[i]); op[(size_t)(i) * 1024 + 64] = xi[i][1] + gf1 * (yb * cinv[i]); \
        __builtin_amdgcn_sched_barrier(0); } while (0)
    G2M_TOKEN(0, true, 10, 8);
    G2M_TOKEN(1, true, 10, 10); G2M_TOKEN(2, true, 10, 10); G2M_TOKEN(3, true, 10, 10);
    G2M_TOKEN(4, true, 10, 10); G2M_TOKEN(5, true, 10, 10); G2M_TOKEN(6, true, 10, 10);
    G2M_TOKEN(7, false, 10, 0);
#undef G2M_TOKEN
}
template <int WHICH>
__device__ void ph_peer_sliced(const Params& p, int l, char* smem_) {
    const int tid = TIDX(), wave = tid >> 6;
    const bf16_t* H = (const bf16_t*)(p.ws + WS_H); const unsigned char* PU = p.ws + WS_PU; const unsigned char* PV = p.ws + WS_PV;
    const int* RI = (const int*)(p.ws + WS_RI); float* RG = (float*)(p.ws + WS_RG); float* PP = (float*)(p.ws + WS_PP);
    const float* modb = (const float*)(p.ws + WS_MOD);
    {
    unsigned* ctr = (unsigned*)(p.ws + WS_CTL) + 3712 + (l * 2 + WHICH) * 128;
    volatile int* slot = (volatile int*)(smem_ + LDS_BYTES - 64);
    const int xcc = (int)(xb_xcc_id() & 7u);
    for (int so = 0; so < 8; ++so) {
        const int x = (xcc + so) & 7;
        for (;;) {
            if (tid == 0) *slot = (int)atomicAdd(ctr + x * 16, 1u);
            __syncthreads();
            const int chunk = __builtin_amdgcn_readfirstlane(*slot);
            __syncthreads();
            if (chunk >= 256) break;
            {
                const int lane = lane_id_opaque(), eg = lane >> 3, ll = lane & 7;
                const int tb = chunk * 64 + wave * 8;
                if (WHICH == 0 && G1_MFMA) { g1m_chunk(p, x, tb, smem_, lane); continue; }
                if (WHICH == 1 && G2_MFMA) { g2m_chunk(p, l, x, tb, smem_, lane); continue; }
                int* lri = (int*)smem_ + wave * 2048; float* lrg = (float*)(lri + 1024);
                {
                    int ra[16]; float rg_[16];
#pragma unroll
                    for (int i = 0; i < 8; ++i) {
                        ra[2 * i] = RI[(size_t)(tb + i) * 128 + lane]; ra[2 * i + 1] = RI[(size_t)(tb + i) * 128 + 64 + lane];
                        if (WHICH == 1) { rg_[2 * i] = RG[(size_t)(tb + i) * 128 + lane]; rg_[2 * i + 1] = RG[(size_t)(tb + i) * 128 + 64 + lane]; }
                    }
#pragma unroll
                    for (int i = 0; i < 8; ++i) {
                        lri[i * 128 + lane] = ra[2 * i]; lri[i * 128 + 64 + lane] = ra[2 * i + 1];
                        if (WHICH == 1) { lrg[i * 128 + lane] = rg_[2 * i]; lrg[i * 128 + 64 + lane] = rg_[2 * i + 1]; }
                    }
                }
                __builtin_amdgcn_fence(__ATOMIC_RELEASE, "wavefront");
                __builtin_amdgcn_wave_barrier();
                __builtin_amdgcn_fence(__ATOMIC_ACQUIRE, "wavefront");
                const unsigned l16 = (unsigned)ll * 16u;
                if (WHICH == 0) {
                    const unsigned char* ub = PU + (size_t)x * (16384u * 128u);
                    const bf16_t* hrow = H + (size_t)tb * 1024 + x * 128 + ll * 16;
                    float* pp_row = PP + ((size_t)x * T_TOK + tb) * 128 + ll * 8 + eg;
                    u32x4 hq0 = ((const u32x4*)hrow)[0], hq1 = ((const u32x4*)hrow)[1], uqA[8], uqB[8];
                    peer_gather8(uqA, ub, lri + eg, l16);
                    peer_gather8(uqB, ub, lri + eg + 64, l16);
#pragma unroll 1
                    for (int i = 0; i < 7; ++i) g1_step<true>(i, tb + i, hrow + (size_t)(i + 1) * 1024, ub, lri + eg, l16, lane, pp_row + (size_t)i * 128, hq0, hq1, uqA, uqB);
                    g1_step<false>(7, tb + 7, hrow, ub, lri + eg, l16, lane, pp_row + (size_t)7 * 128, hq0, hq1, uqA, uqB);
                } else {
                    const unsigned char* vb_ = PV + (size_t)x * (16384u * 128u);
                    const int col = x * 128 + ll * 16 + ((lane >> 5) & 1) * 8 + ((lane >> 4) & 1) * 4 + ((lane >> 3) & 1) * 2;
                    const float2 gf = *(const float2*)(modb + (size_t)(l * 8 + (tb >> 11)) * 6144 + 5120 + col);
                    float2* op = (float2*)(p.out + (size_t)tb * 1024 + col);
                    u32x4 vqA[8], vqB[8];
                    peer_gather8(vqA, vb_, lri + eg, l16);
                    peer_gather8(vqB, vb_, lri + eg + 64, l16);
#pragma unroll 1
                    for (int i = 0; i < 7; ++i) g2_step<true>(i, op + (size_t)i * 512, gf, vb_, lri + eg, lrg + eg, l16, lane, vqA, vqB);
                    g2_step<false>(7, op + (size_t)7 * 512, gf, vb_, lri + eg, lrg + eg, l16, lane, vqA, vqB);
                }
            }
        }
    }
    __syncthreads();
    }
}
__device__ void ph_peer_coef(const Params& p, int vb0, int nvb) {
    const int wave = TIDX() >> 6, lane = TIDX() & 63;
    float* RG = (float*)(p.ws + WS_RG); const float* PP = (const float*)(p.ws + WS_PP);
    for (int t0 = (vb0 * 8 + wave) * 2; t0 < T_TOK; t0 += nvb * 8 * 2) {
        float pp[2][2][8], g[2][2];
#pragma unroll
        for (int u = 0; u < 2; ++u)
#pragma unroll
            for (int half = 0; half < 2; ++half) {
                const int k = half * 64 + lane;
#pragma unroll
                for (int x = 0; x < 8; ++x) pp[u][half][x] = PP[((size_t)x * T_TOK + t0 + u) * 128 + k];
                g[u][half] = RG[(size_t)(t0 + u) * 128 + k];
            }
        asm volatile("" ::: "memory");
#pragma unroll
        for (int u = 0; u < 2; ++u) {
            float cf[2];
#pragma unroll
            for (int half = 0; half < 2; ++half) {
                float d = 0.f;
#pragma unroll
                for (int x = 0; x < 8; ++x) d += pp[u][half][x];
                d *= (1.f / PU_SCALE);
                cf[half] = g[u][half] * 0.5f * d * (1.f + erff(d * 0.7071067811865476f)) * (1.f / PV_SCALE);
                if (!G2_MFMA) RG[(size_t)(t0 + u) * 128 + half * 64 + lane] = cf[half];
            }
            if (G2_MFMA) {
                const float m = wave_max(fmaxf(fabsf(cf[0]), fabsf(cf[1])));
                const float sc = m > 0.f ? 240.f / m : 0.f;
                const float c0 = cf[0] * sc, c1 = cf[1] * sc;
                const int hi = __builtin_amdgcn_cvt_pk_fp8_f32(c0, c1, 0, false);
                const auto bk = __builtin_amdgcn_cvt_pk_f32_fp8(hi, false);
                const int lo = __builtin_amdgcn_cvt_pk_fp8_f32((c0 - bk[0]) * 16.f, (c1 - bk[1]) * 16.f, 0, false);
                unsigned char* c8h = p.ws + WS_C8H + (size_t)(t0 + u) * 128; unsigned char* c8l = p.ws + WS_C8L + (size_t)(t0 + u) * 128;
                const int s0 = ((lane >> 3) & 3) * 32 + (lane >> 5) * 8 + (lane & 7);
                c8h[s0] = (unsigned char)(hi & 0xff); c8h[s0 + 16] = (unsigned char)((hi >> 8) & 0xff);
                c8l[s0] = (unsigned char)(lo & 0xff); c8l[s0 + 16] = (unsigned char)((lo >> 8) & 0xff);
                if (lane == 0) ((float*)(p.ws + WS_CINV))[t0 + u] = m * (1.f / 240.f);
            }
        }
    }
}

enum { PH_MOD = 0, PH_WPREP, PH_NORM1, PH_GEMM_IN, PH_SCAN, PH_MERGE, PH_OUT, PH_NORM2, PH_GEMM_Q, PH_GEMM_SC, PH_ROUTE, PH_G1, PH_G15, PH_G2 };

template <int PH>
__device__ __forceinline__ void run_phase(const Params& p, int l, int vb0, int nvb, char* smem) {
    const float* xin = (l == 0) ? p.x : p.out;
    if (PH == PH_MOD) ph_mod(p, vb0, nvb, smem);
    else if (PH == PH_WPREP) ph_wprep(p, l, vb0, nvb, smem);
    else if (PH == PH_NORM1) ph_norm(p, l, 0, xin, vb0, nvb);
    else if (PH == PH_GEMM_IN) {
        pg8::Gemm g{(const bf16_t*)(p.ws + WS_H), (const bf16_t*)(p.ws + WS_WIN), 1024, 1024, 1024};
        pg8::StaticOrder S; S.init(T_TOK, LDZ, nvb, vb0, 1024, 1024);
        pg8::gemm_phase(( PG8_LAS unsigned char*)smem, g, S, pg8::EpiBf16{(bf16_t*)(p.ws + WS_Z), LDZ}, TIDX());
    }
    else if (PH == PH_SCAN) ph_mixA(p, l, vb0, nvb, smem);
    else if (PH == PH_MERGE) {
        pg8::Gemm g{(const bf16_t*)(p.ws + WS_Y), (const bf16_t*)(p.ws + WS_WBR), 1536, 512, 512};
        pg8::MergeOrder S{vb0, nvb};
        pg8::gemm_phase((PG8_LAS unsigned char*)smem, g, S, pg8::EpiMerge{(bf16_t*)(p.ws + WS_H), (const bf16_t*)(p.ws + WS_Z)}, TIDX());
    }
    else if (PH == PH_OUT) {
        pg8::Gemm g{(const bf16_t*)(p.ws + WS_H), (const bf16_t*)(p.ws + WS_WOUT), 1024, 1024, 1024};
        pg8::StaticOrder S; S.init(T_TOK, 1024, nvb, vb0, 1024, 1024);
        pg8::gemm_phase((PG8_LAS unsigned char*)smem, g, S, pg8::EpiResid{xin, p.out, (const float*)(p.ws + WS_MOD) + (size_t)l * 8 * 6144}, TIDX());
    }
    else if (PH == PH_NORM2) ph_norm(p, l, 1, p.out, vb0, nvb);
    else if (PH == PH_GEMM_Q) {
        pg8::Gemm g{(const bf16_t*)(p.ws + WS_H), (const bf16_t*)(p.ws + WS_WQ), 1024, 1024, 1024};
        pg8::StaticOrder S; S.init(T_TOK, 2048, nvb, vb0, 1024, 1024);
        pg8::gemm_phase((PG8_LAS unsigned char*)smem, g, S, pg8::EpiBf16{(bf16_t*)(p.ws + WS_QP), 2048}, TIDX());
    }
    else if (PH == PH_GEMM_SC) gemm_phase((const bf16_t*)(p.ws + WS_QP), 2048, (const bf16_t*)(p.ws + WS_SK), 128, T_TOK, 2048, 128, true,
                                          EpiF16{(_Float16*)(p.ws + WS_SC), 2048}, vb0, nvb, smem, TIDX());
    else if (PH == PH_ROUTE) ph_route(p, vb0, nvb, smem);
    else if (PH == PH_G1) ph_peer_sliced<0>(p, l, smem);
    else if (PH == PH_G15) ph_peer_coef(p, vb0, nvb);
    else if (PH == PH_G2) ph_peer_sliced<1>(p, l, smem);

}

#define XB_TMO      128
#define XB_XCNT(j)  (256  + 64 * (j))
#define XB_XSUB(j)  (1280 + 64 * (j))
#define XB_XGEN(j)  (2304 + 64 * (j))
#define XB_TOP      3328
#define XB_TOPGEN   3392
#define XCD_BAR_WORDS 3456
#define XB_SPIN_CAP (1u << 18)
#define LAS __attribute__((address_space(3)))
__device__ __forceinline__ unsigned xb_ld(unsigned* p)              { return __hip_atomic_load(p, __ATOMIC_RELAXED, __HIP_MEMORY_SCOPE_AGENT); }
__device__ __forceinline__ unsigned xb_add(unsigned* p, unsigned v) { return __hip_atomic_fetch_add(p, v, __ATOMIC_RELAXED, __HIP_MEMORY_SCOPE_AGENT); }
#define XB_SPIN(cond, bar) do { unsigned _sp = 0; while (cond) { __builtin_amdgcn_s_sleep(1); \
    if ((++_sp & 255u) == 0u) { if (xb_ld(&(bar)[XB_TMO])) break; if (_sp > XB_SPIN_CAP) { atomicAdd(&(bar)[XB_TMO], 1u); break; } } } } while (0)
struct XcdBarrier { unsigned* bar; unsigned x; volatile LAS unsigned* st; int wv; };
__device__ __forceinline__ XcdBarrier xcd_barrier_post(unsigned* bar, volatile LAS unsigned* st, int wv) {
    XcdBarrier b; b.bar = bar; b.x = xb_xcc_id(); b.st = st; b.wv = wv;
    if (TIDXW(wv) == 0) (void)xb_add(&bar[XB_XCNT(b.x)], 1u);
    return b;
}
__device__ __forceinline__ void xcd_barrier_complete(unsigned* bar, unsigned x, unsigned& nloc, unsigned& nx) {
    const unsigned G = gridDim.x * gridDim.y * gridDim.z;
    unsigned sum, cnt, mine, sp = 0u;
    for (;;) {
        sum = 0u; cnt = 0u; mine = 0u;
#pragma unroll
        for (unsigned j = 0; j < 16; ++j) { const unsigned c = xb_ld(&bar[XB_XCNT(j)]); sum += c; cnt += (c > 0u) ? 1u : 0u; mine = (j == x) ? c : mine; }
        if (sum == G) break;
        __builtin_amdgcn_s_sleep(1);
        if ((++sp & 255u) == 0u) { if (xb_ld(&bar[XB_TMO])) break; if (sp > XB_SPIN_CAP) { atomicAdd(&bar[XB_TMO], 1u); break; } }
    }
    nloc = mine > 0u ? mine : 1u; nx = cnt > 0u ? cnt : 1u;
}
__device__ __forceinline__ void xcd_barrier(const XcdBarrier& b) {
    asm volatile("s_waitcnt vmcnt(0)" ::: "memory");
    __syncthreads();
    if (TIDXW(b.wv) == 0) {
        unsigned* bar = b.bar;
        __builtin_amdgcn_s_waitcnt(0);
        unsigned nloc = b.st[0], nx = b.st[1];
        if (nloc == 0u) { xcd_barrier_complete(bar, b.x, nloc, nx); b.st[0] = nloc; b.st[1] = nx; }
        const unsigned old = xb_add(&bar[XB_XSUB(b.x)], 1u);
        const unsigned gen = old / nloc;
        if (old + 1u == (gen + 1u) * nloc) {
            __builtin_amdgcn_fence(__ATOMIC_RELEASE, "agent");
            asm volatile("s_waitcnt vmcnt(0)" ::: "memory");
            const unsigned og = xb_add(&bar[XB_TOP], 1u);
            const unsigned tg = og / nx;
            if (og + 1u == (tg + 1u) * nx) xb_add(&bar[XB_TOPGEN], 1u);
            else XB_SPIN(xb_ld(&bar[XB_TOPGEN]) == tg, bar);
            __builtin_amdgcn_fence(__ATOMIC_ACQUIRE, "agent");
            xb_add(&bar[XB_XGEN(b.x)], 1u);
            asm volatile("s_waitcnt vmcnt(0)" ::: "memory");
        } else {
            XB_SPIN(xb_ld(&bar[XB_XGEN(b.x)]) == gen, bar);
            __builtin_amdgcn_fence(__ATOMIC_ACQUIRE, "agent");
            asm volatile("s_waitcnt vmcnt(0)" ::: "memory");
        }
    }
    __syncthreads();
}

__global__ void __launch_bounds__(NT) mega_kernel(Params p_in) {
#if defined(__HIP_DEVICE_COMPILE__)
    extern __shared__ __attribute__((aligned(16))) char smem[];
    volatile LAS unsigned* st = (volatile LAS unsigned*)(smem + LDS_BYTES - 16);
    int wv_ = __builtin_amdgcn_readfirstlane((int)threadIdx.x >> 6); asm volatile("" : "+s"(wv_));
    { const int t_ = TIDXW(wv_); if (t_ < 4) st[t_] = 0u; }
    __syncthreads();
    XcdBarrier bar = xcd_barrier_post((unsigned*)(p_in.ws + WS_CTL), st, wv_);
    const int vb = (int)blockIdx.x, nvb = (int)gridDim.x;
#define GB() xcd_barrier(bar)
#define RUN(PH, L) do { \
        const __attribute__((address_space(4))) Params* _kp = (const __attribute__((address_space(4))) Params*)__builtin_amdgcn_kernarg_segment_ptr(); asm volatile("" : "+s"(_kp)); Params _p = *_kp; _p.wv = wv_; \
        int _l = (L), _vb = vb, _nvb = nvb; asm volatile("" : "+s"(_l), "+s"(_vb), "+s"(_nvb)); \
        run_phase<PH>(_p, _l, _vb, _nvb, smem); } while (0)
    RUN(PH_MOD, 0);
#pragma unroll 1
    for (int l = 0; l < 2; ++l) {
        RUN(PH_WPREP, l); if (l == 0) GB();
        RUN(PH_NORM1, l); GB();
        RUN(PH_GEMM_IN, l); GB();
        RUN(PH_SCAN, l); GB();
        RUN(PH_MERGE, l); GB();
        RUN(PH_OUT, l); GB();
        RUN(PH_NORM2, l); GB();
        RUN(PH_GEMM_Q, l); GB();
        RUN(PH_GEMM_SC, l); GB();
        RUN(PH_ROUTE, l); GB();
        RUN(PH_G1, l); GB();
        RUN(PH_G15, l); GB();
        RUN(PH_G2, l);
        if (l == 0) GB();
    }
#undef RUN
#undef GB
#endif
}

extern "C" void kernel_launch(void* const* d_in, const int* in_sizes, int n_in, void* d_out, int out_size, void* d_ws, size_t ws_size,
                              hipStream_t stream) {
    if (n_in != 20 || ws_size < WS_END) { fprintf(stderr, "kernel_launch: bad inputs (n_in %d ws %zu need %zu)\n", n_in, ws_size, (size_t)WS_END); return; }
    Params p{};
    p.x = (const float*)d_in[0]; p.c = (const float*)d_in[1]; p.w_ada = (const float*)d_in[2]; p.b_ada = (const float*)d_in[3];
    p.norm_mix = (const float*)d_in[4]; p.norm_ffn = (const float*)d_in[5]; p.w_in = (const float*)d_in[6]; p.hgrn_lb = (const float*)d_in[7];
    p.hgrn_on = (const float*)d_in[8]; p.dsa_qn = (const float*)d_in[9]; p.dsa_kn = (const float*)d_in[10]; p.gla_up = (const float*)d_in[11];
    p.gla_bias = (const float*)d_in[12]; p.gla_on = (const float*)d_in[13]; p.w_branch = (const float*)d_in[14]; p.w_out = (const float*)d_in[15];
    p.peer_wq = (const float*)d_in[16]; p.peer_keys = (const float*)d_in[17]; p.peer_u = (const float*)d_in[18]; p.peer_v = (const float*)d_in[19];
    p.out = (float*)d_out; p.ws = (unsigned char*)d_ws;
    static int grid = 0;
    if (grid == 0) {
        int dev = 0, cus = 0, per_cu = 0;
        hipGetDevice(&dev);
        hipDeviceGetAttribute(&cus, hipDeviceAttributeMultiprocessorCount, dev);
        hipFuncSetAttribute((const void*)mega_kernel, hipFuncAttributeMaxDynamicSharedMemorySize, LDS_BYTES);
        hipOccupancyMaxActiveBlocksPerMultiprocessor(&per_cu, (const void*)mega_kernel, NT, LDS_BYTES);
        if (per_cu < 1) { fprintf(stderr, "kernel_launch: occupancy query says %d blocks per CU\n", per_cu); per_cu = 1; }
        (void)hipGetLastError();
        grid = cus;
    }
    hipMemsetAsync((char*)d_ws + WS_CTL, 0, 32768, stream);
    void* args[] = {&p};
    hipError_t e = hipLaunchCooperativeKernel((const void*)mega_kernel, dim3(grid), dim3(NT), args, LDS_BYTES, stream);
    if (e != hipSuccess) fprintf(stderr, "cooperative launch failed: %s (grid %d)\n", hipGetErrorString(e), grid);
}
```

```cpp
#include <hip/hip_runtime.h>
#include <stdint.h>
#include <stdio.h>

typedef unsigned short bf16_t;
typedef short bf16x8 __attribute__((ext_vector_type(8)));
typedef float f32x4 __attribute__((ext_vector_type(4)));
typedef unsigned u32x4 __attribute__((ext_vector_type(4)));

#define NT 512
constexpr int T_TOK = 16384, DM = 1024, SEQ = 2048;
constexpr int LDZ = 8704;
constexpr int ZA_Q = 0, ZA_F = 512, ZA_I = 1024, ZA_G = 1536, ZB_Q = 2048, ZB_K = 2560, ZB_V = 3072, ZC_V = 3584, ZC_G = 4096,
              ZB_QI = 4608, ZC_Q = 4864, ZC_K = 5120, ZB_KI = 5376, ZB_WI = 5440, ZC_CODE = 5444, ZM = 5632;
constexpr int IN_COLS = 8532;

constexpr size_t al256(size_t x) { return (x + 255) & ~(size_t)255; }
constexpr size_t WS_CTL = 0;
constexpr size_t WS_MOD = 65536;
constexpr size_t WS_WIN = al256(WS_MOD + (size_t)2 * 8 * 6144 * 4);
constexpr size_t WS_WBR = al256(WS_WIN + (size_t)LDZ * 1024 * 2);
constexpr size_t WS_WOUT = al256(WS_WBR + (size_t)3 * 1024 * 512 * 2);
constexpr size_t WS_WQ = al256(WS_WOUT + (size_t)1024 * 1024 * 2);
constexpr size_t WS_SK = al256(WS_WQ + (size_t)2048 * 1024 * 2);
constexpr size_t WS_PU = al256(WS_SK + (size_t)16 * 128 * 128 * 2);
constexpr size_t WS_PV = al256(WS_PU + (size_t)16384 * 1024);
constexpr size_t WS_H = al256(WS_PV + (size_t)16384 * 1024);
constexpr float PU_SCALE = 32.f, PV_SCALE = 4.f;
constexpr size_t WS_OA = al256(WS_H + (size_t)T_TOK * 1024 * 2);
constexpr size_t WS_OC = al256(WS_OA + (size_t)T_TOK * 512 * 2);
constexpr size_t WS_H8H = WS_OA, WS_H8L = WS_OC;
constexpr size_t WS_Y = al256(WS_OC + (size_t)T_TOK * 512 * 2);
constexpr size_t WS_Z = al256(WS_Y + (size_t)T_TOK * 1536 * 2);
constexpr size_t WS_VT = al256(WS_Z + (size_t)T_TOK * LDZ * 2);
constexpr size_t WS_BM = al256(WS_VT + (size_t)T_TOK * 512 * 2);
constexpr size_t WS_END = al256(WS_BM + (size_t)T_TOK * 64 * 4);
constexpr size_t WS_QP = WS_Z;
constexpr size_t WS_SC = al256(WS_QP + (size_t)T_TOK * 2048 * 2);
constexpr size_t WS_RI = al256(WS_SC + (size_t)T_TOK * 2048 * 4);
constexpr size_t WS_RG = al256(WS_RI + (size_t)T_TOK * 128 * 4);
constexpr size_t WS_PP = al256(WS_RG + (size_t)T_TOK * 128 * 4);
constexpr size_t WS_C8H = WS_SC;
constexpr size_t WS_C8L = WS_C8H + (size_t)T_TOK * 128;
constexpr size_t WS_CINV = WS_C8L + (size_t)T_TOK * 128;
static_assert(WS_PP + (size_t)8 * T_TOK * 128 * 4 <= WS_VT, "peer partials overflow the Z region");
static_assert(WS_RG + (size_t)T_TOK * 128 * 4 <= WS_END, "peer alias overflow");

struct Params {
    const float* x; const float* c; const float* w_ada; const float* b_ada; const float* norm_mix; const float* norm_ffn;
    const float* w_in; const float* hgrn_lb; const float* hgrn_on; const float* dsa_qn; const float* dsa_kn;
    const float* gla_up; const float* gla_bias; const float* gla_on; const float* w_branch; const float* w_out;
    const float* peer_wq; const float* peer_keys; const float* peer_u; const float* peer_v;
    float* out; unsigned char* ws;
    int wv, pad;
};

__device__ __forceinline__ float bf2f(bf16_t h) { return __uint_as_float(((unsigned)h) << 16); }
__device__ __forceinline__ float bflo(unsigned u) { return __uint_as_float(u << 16); }
__device__ __forceinline__ float bfhi(unsigned u) { return __uint_as_float(u & 0xffff0000u); }
__device__ __forceinline__ bf16_t f2bf(float f) { unsigned r; asm volatile("v_cvt_pk_bf16_f32 %0, %1, %1" : "=v"(r) : "v"(f)); return (bf16_t)(r & 0xffffu); }
__device__ __forceinline__ unsigned pack2(float a, float b) { unsigned r; asm volatile("v_cvt_pk_bf16_f32 %0, %1, %2" : "=v"(r) : "v"(a), "v"(b)); return r; }
__device__ __forceinline__ int lane_id_opaque() { int l; asm volatile("v_mbcnt_lo_u32_b32 %0, -1, 0\n\tv_mbcnt_hi_u32_b32 %0, -1, %0" : "=v"(l)); return l; }
template <int M> __device__ __forceinline__ int shx_i(int v) {
    if (M < 32) return __builtin_amdgcn_ds_swizzle(v, (M << 10) | 0x1f);
    return __builtin_amdgcn_ds_bpermute((lane_id_opaque() ^ 32) << 2, v);
}
template <int M> __device__ __forceinline__ float shx(float v) { return __int_as_float(shx_i<M>(__float_as_int(v))); }
template <int M> __device__ __forceinline__ int shx(int v) { return shx_i<M>(v); }
template <int M> __device__ __forceinline__ unsigned shx(unsigned v) { return (unsigned)shx_i<M>((int)v); }
__device__ __forceinline__ int bperm(int v, int src) { return __builtin_amdgcn_ds_bpermute(src << 2, v); }
__device__ __forceinline__ float bperm(float v, int src) { return __int_as_float(__builtin_amdgcn_ds_bpermute(src << 2, __float_as_int(v))); }
__device__ __forceinline__ float wave_sum(float v) { v += shx<32>(v); v += shx<16>(v); v += shx<8>(v); v += shx<4>(v); v += shx<2>(v); v += shx<1>(v); return v; }
__device__ __forceinline__ float wave_max(float v) { v = fmaxf(v, shx<32>(v)); v = fmaxf(v, shx<16>(v)); v = fmaxf(v, shx<8>(v)); v = fmaxf(v, shx<4>(v)); v = fmaxf(v, shx<2>(v)); v = fmaxf(v, shx<1>(v)); return v; }
__device__ __forceinline__ int wave_sum_i(int v) { v += shx<32>(v); v += shx<16>(v); v += shx<8>(v); v += shx<4>(v); v += shx<2>(v); v += shx<1>(v); return v; }
__device__ __forceinline__ int wave_total_i(int v) {
    v += __builtin_amdgcn_update_dpp(0, v, 0x111, 0xf, 0xf, true);
    v += __builtin_amdgcn_update_dpp(0, v, 0x112, 0xf, 0xf, true);
    v += __builtin_amdgcn_update_dpp(0, v, 0x114, 0xf, 0xf, true);
    v += __builtin_amdgcn_update_dpp(0, v, 0x118, 0xf, 0xf, true);
    v += __builtin_amdgcn_update_dpp(0, v, 0x142, 0xa, 0xf, true);
    v += __builtin_amdgcn_update_dpp(0, v, 0x143, 0xc, 0xf, true);
    return __builtin_amdgcn_readlane(v, 63);
}
__device__ __forceinline__ float sigm(float x) { return __frcp_rn(1.f + __expf(-x)); }

__device__ __forceinline__ unsigned xb_xcc_id() { return (unsigned)__builtin_amdgcn_s_getreg((3 << 11) | 20) & 0xFu; }
__device__ __forceinline__ int TIDXW(int wv) { int t; asm volatile("v_mbcnt_lo_u32_b32 %0, -1, 0\n\tv_mbcnt_hi_u32_b32 %0, -1, %0\n\tv_lshl_or_b32 %0, %1, 6, %0" : "=v"(t) : "s"(wv)); return t; }
#define TIDX() TIDXW(p.wv)

__device__ __forceinline__ int src_col(int j) {
    if (j < 3584) return j;
    if (j < 4096) return j - 3584 + 4420;
    if (j < 4608) return j - 4096 + 4948;
    if (j < 4864) return j - 4608 + 3584;
    if (j < 5120) return j - 4864 + 3908;
    if (j < 5376) return j - 5120 + 4164;
    if (j < 5440) return j - 5376 + 3840;
    if (j < 5444) return j - 5440 + 3904;
    if (j < 5460) return j - 5444 + 4932;
    if (j < 5632) return -1;
    return j - 5632 + 5460;
}

__device__ void ph_mod(const Params& p, int vb0, int nvb, char* smem_) {
    float* sc = (float*)smem_;
    float* part = sc + 8 * 1024;
    float* mod = (float*)(p.ws + WS_MOD);
    const int tid = TIDX(), lane = tid & 63, wave = tid >> 6;
    if (vb0 >= 192) return;
    for (int i = tid; i < 8 * 1024; i += NT) { float c = p.c[i]; sc[i] = c / (1.f + __expf(-c)); }
    __syncthreads();
    for (int task = vb0; task < 192; task += nvb) {
        const int l = task / 96, n0 = (task % 96) * 64;
        const float* w = p.w_ada + (size_t)l * 1024 * 6144 + (size_t)(wave * 128) * 6144 + n0 + lane;
        float acc[8];
#pragma unroll
        for (int b = 0; b < 8; ++b) acc[b] = 0.f;
#pragma unroll 1
        for (int k0 = 0; k0 < 128; k0 += 16) {
            float wv[16];
#pragma unroll
            for (int j = 0; j < 16; ++j) wv[j] = w[(size_t)(k0 + j) * 6144];
#pragma unroll
            for (int j = 0; j < 16; ++j)
#pragma unroll
                for (int b = 0; b < 8; ++b) acc[b] += sc[b * 1024 + wave * 128 + k0 + j] * wv[j];
        }
#pragma unroll
        for (int b = 0; b < 8; ++b) part[(wave * 8 + b) * 64 + lane] = acc[b];
        __syncthreads();
        {
            const int b = tid >> 6, col = tid & 63;
            float v = p.b_ada[l * 6144 + n0 + col];
#pragma unroll
            for (int w_ = 0; w_ < 8; ++w_) v += part[(w_ * 8 + b) * 64 + col];
            mod[(size_t)(l * 8 + b) * 6144 + n0 + col] = v;
        }
        __syncthreads();
    }
}

template <bool MAP>
__device__ void tr_tile(const float* __restrict__ src, int lds_, bf16_t* __restrict__ out, int ldo, int k0, int n0, float* tile, const int tid) {
    float lv[8];
    {
        const int nn = tid & 63, scol = MAP ? src_col(n0 + nn) : (n0 + nn);
#pragma unroll
        for (int i = 0; i < 8; ++i) { const int kk = (tid >> 6) + 8 * i; lv[i] = (scol >= 0) ? src[(size_t)(k0 + kk) * lds_ + scol] : 0.f; }
#pragma unroll
        for (int i = 0; i < 8; ++i) { const int kk = (tid >> 6) + 8 * i; tile[kk * 65 + nn] = lv[i]; }
    }
    __syncthreads();
#pragma unroll
    for (int i = 0; i < 4; ++i) {
        int nn = (tid >> 5) + 16 * i, kk = (tid & 31) * 2;
        unsigned v = pack2(tile[kk * 65 + nn], tile[(kk + 1) * 65 + nn]);
        *(unsigned*)(out + (size_t)(n0 + nn) * ldo + k0 + kk) = v;
    }
    __syncthreads();
}
__device__ void conv_chunk(const float* __restrict__ src, bf16_t* __restrict__ dst, size_t base, const int tid) {
    f32x4 la[4], lb[4];
#pragma unroll
    for (int i = 0; i < 4; ++i) { const size_t e = base + (size_t)(i * NT + tid) * 8; la[i] = *(const f32x4*)(src + e); lb[i] = *(const f32x4*)(src + e + 4); }
#pragma unroll
    for (int i = 0; i < 4; ++i) {
        size_t e = base + (size_t)(i * NT + tid) * 8;
        const float4 a = make_float4(la[i][0], la[i][1], la[i][2], la[i][3]), b = make_float4(lb[i][0], lb[i][1], lb[i][2], lb[i][3]);
        uint4 o; o.x = pack2(a.x, a.y); o.y = pack2(a.z, a.w); o.z = pack2(b.x, b.y); o.w = pack2(b.z, b.w);
        *(uint4*)(dst + e) = o;
    }
}
__device__ void conv_chunk_fp8(const float* __restrict__ src, unsigned char* __restrict__ dst, size_t base, float scale, const int tid) {
    f32x4 la[4], lb[4];
#pragma unroll
    for (int i = 0; i < 4; ++i) { const size_t e = base + (size_t)(i * NT + tid) * 8; la[i] = *(const f32x4*)(src + e); lb[i] = *(const f32x4*)(src + e + 4); }
#pragma unroll
    for (int i = 0; i < 4; ++i) {
        size_t e = base + (size_t)(i * NT + tid) * 8;
        const float4 a = make_float4(la[i][0], la[i][1], la[i][2], la[i][3]), b = make_float4(lb[i][0], lb[i][1], lb[i][2], lb[i][3]);
        int lo = __builtin_amdgcn_cvt_pk_fp8_f32(a.x * scale, a.y * scale, 0, false); lo = __builtin_amdgcn_cvt_pk_fp8_f32(a.z * scale, a.w * scale, lo, true);
        int hi = __builtin_amdgcn_cvt_pk_fp8_f32(b.x * scale, b.y * scale, 0, false); hi = __builtin_amdgcn_cvt_pk_fp8_f32(b.z * scale, b.w * scale, hi, true);
        const size_t row = e >> 10, col = e & 1023;
        *(uint2*)(dst + ((col >> 7) * 16384 + row) * 128 + (col & 127)) = make_uint2((unsigned)lo, (unsigned)hi);
    }
}
__device__ void ph_wprep(const Params& p, int l, int vb0, int nvb, char* smem_) {
    float* tile = (float*)smem_;
    const int tid = TIDX();
    bf16_t* WIN = (bf16_t*)(p.ws + WS_WIN); bf16_t* WBR = (bf16_t*)(p.ws + WS_WBR); bf16_t* WOUT = (bf16_t*)(p.ws + WS_WOUT);
    bf16_t* WQ = (bf16_t*)(p.ws + WS_WQ); bf16_t* SK = (bf16_t*)(p.ws + WS_SK); unsigned char* PU = p.ws + WS_PU; unsigned char* PV = p.ws + WS_PV;
    constexpr int N_WIN = 136 * 16, N_WBR = 3 * 16 * 8, N_WOUT = 16 * 16, N_WQ = 32 * 16, N_SK = 16, N_PU = 1024, N_PV = 1024;
    constexpr int TOTAL = N_WIN + N_WBR + N_WOUT + N_WQ + N_SK + N_PU + N_PV;
    for (int task = vb0; task < TOTAL; task += nvb) {
        int r = task;
        if (r < N_WIN) { int nt = r / 16, kt = r % 16; tr_tile<true>(p.w_in + (size_t)l * 1024 * IN_COLS, IN_COLS, WIN, 1024, kt * 64, nt * 64, tile, tid); continue; }
        r -= N_WIN;
        if (r < N_WBR) { int g = r / 128, rr = r % 128, nt = rr / 8, kt = rr % 8;
            tr_tile<false>(p.w_branch + (size_t)(l * 3 + g) * 512 * 1024, 1024, WBR + (size_t)g * 1024 * 512, 512, kt * 64, nt * 64, tile, tid); continue; }
        r -= N_WBR;
        if (r < N_WOUT) { int nt = r / 16, kt = r % 16; tr_tile<false>(p.w_out + (size_t)l * 1024 * 1024, 1024, WOUT, 1024, kt * 64, nt * 64, tile, tid); continue; }
        r -= N_WOUT;
        if (r < N_WQ) { int nt = r / 16, kt = r % 16; tr_tile<false>(p.peer_wq + (size_t)l * 1024 * 2048, 2048, WQ, 1024, kt * 64, nt * 64, tile, tid); continue; }
        r -= N_WQ;
        if (r < N_SK) { conv_chunk(p.peer_keys + (size_t)l * 16 * 128 * 128, SK, (size_t)r * 16384, tid); continue; }
        r -= N_SK;
        if (r < N_PU) { conv_chunk_fp8(p.peer_u + (size_t)l * 16384 * 1024, PU, (size_t)r * 16384, PU_SCALE, tid); continue; }
        r -= N_PU;
        conv_chunk_fp8(p.peer_v + (size_t)l * 16384 * 1024, PV, (size_t)r * 16384, PV_SCALE, tid);
    }
}

__device__ void ph_norm(const Params& p, int l, int which, const float* xin, int vb0, int nvb) {
    const int wave = TIDX() >> 6, lane = TIDX() & 63;
    const float* gain = (which ? p.norm_ffn : p.norm_mix) + l * 1024;
    const float* modb = (const float*)(p.ws + WS_MOD);
    bf16_t* H = (bf16_t*)(p.ws + WS_H);
    f32x4 g[4];
#pragma unroll
    for (int i = 0; i < 4; ++i) g[i] = *(const f32x4*)(gain + (lane + 64 * i) * 4);
    for (int t = vb0 * 8 + wave; t < T_TOK; t += nvb * 8) {
        const int b = t >> 11;
        const float* mod = modb + (size_t)(l * 8 + b) * 6144 + (which ? 3072 : 0);
        const f32x4* xr = (const f32x4*)(xin + (size_t)t * 1024);
        f32x4 v[4], sc[4], sh[4]; float ss = 0.f;
#pragma unroll
        for (int i = 0; i < 4; ++i) { v[i] = xr[lane + 64 * i]; sc[i] = *(const f32x4*)(mod + 1024 + (lane + 64 * i) * 4); sh[i] = *(const f32x4*)(mod + (lane + 64 * i) * 4); }
#pragma unroll
        for (int i = 0; i < 4; ++i) ss += v[i][0] * v[i][0] + v[i][1] * v[i][1] + v[i][2] * v[i][2] + v[i][3] * v[i][3];
        ss = wave_sum(ss);
        const float rstd = rsqrtf(ss * (1.f / 1024.f) + 1e-6f);
#pragma unroll
        for (int i = 0; i < 4; ++i) {
            const int idx = (lane + 64 * i) * 4;
            const f32x4 h = v[i] * rstd * g[i] * (1.f + sc[i]) + sh[i];
            uint2 o; o.x = pack2(h[0], h[1]); o.y = pack2(h[2], h[3]);
            *(uint2*)(H + (size_t)t * 1024 + idx) = o;
            if (which) {
                int hi = __builtin_amdgcn_cvt_pk_fp8_f32(h[0], h[1], 0, false); hi = __builtin_amdgcn_cvt_pk_fp8_f32(h[2], h[3], hi, true);
                const auto d0 = __builtin_amdgcn_cvt_pk_f32_fp8(hi, false); const auto d1 = __builtin_amdgcn_cvt_pk_f32_fp8(hi, true);
                int lo = __builtin_amdgcn_cvt_pk_fp8_f32((h[0] - d0[0]) * 16.f, (h[1] - d0[1]) * 16.f, 0, false);
                lo = __builtin_amdgcn_cvt_pk_fp8_f32((h[2] - d1[0]) * 16.f, (h[3] - d1[1]) * 16.f, lo, true);
                *(int*)(p.ws + WS_H8H + (size_t)t * 1024 + idx) = hi;
                *(int*)(p.ws + WS_H8L + (size_t)t * 1024 + idx) = lo;
            }
        }
    }
}

constexpr int GBM = 256, GBN = 128, GBK = 64, GLS = 72;
__device__ __forceinline__ void gemm_tile(const bf16_t* __restrict__ A, int lda, const bf16_t* __restrict__ Bt, int ldb, int K,
                                          int m0, int n0, bf16_t* sA, bf16_t* sB, f32x4 (&acc)[4][4], const int tid) {
    const int lane = tid & 63, wave = tid >> 6;
    const int wm = wave >> 1, wn = wave & 1, fr = lane & 15, fq = lane >> 4;
    u32x4 ra[4], rb[2];
    const int crow = tid >> 3, ckc = (tid & 7) * 8;
    const bf16_t* Ag = A + (size_t)(m0 + crow) * lda + ckc;
    const bf16_t* Bg = Bt + (size_t)(n0 + crow) * ldb + ckc;
#pragma unroll
    for (int i = 0; i < 4; ++i) ra[i] = *(const u32x4*)(Ag + (size_t)(64 * i) * lda);
#pragma unroll
    for (int i = 0; i < 2; ++i) rb[i] = *(const u32x4*)(Bg + (size_t)(64 * i) * ldb);
    for (int k0 = 0; k0 < K; k0 += GBK) {
        __syncthreads();
#pragma unroll
        for (int i = 0; i < 4; ++i) *(u32x4*)(sA + (crow + 64 * i) * GLS + ckc) = ra[i];
#pragma unroll
        for (int i = 0; i < 2; ++i) *(u32x4*)(sB + (crow + 64 * i) * GLS + ckc) = rb[i];
        __syncthreads();
        {
            const int kn = (k0 + GBK < K) ? (k0 + GBK) : k0;
#pragma unroll
            for (int i = 0; i < 4; ++i) ra[i] = *(const u32x4*)(Ag + (size_t)(64 * i) * lda + kn);
#pragma unroll
            for (int i = 0; i < 2; ++i) rb[i] = *(const u32x4*)(Bg + (size_t)(64 * i) * ldb + kn);
        }
#pragma unroll
        for (int ks = 0; ks < 2; ++ks) {
            bf16x8 af[4], wf[4];
#pragma unroll
            for (int mf = 0; mf < 4; ++mf) af[mf] = *(const bf16x8*)(sA + (wm * 64 + mf * 16 + fr) * GLS + ks * 32 + fq * 8);
#pragma unroll
            for (int nf = 0; nf < 4; ++nf) wf[nf] = *(const bf16x8*)(sB + (wn * 64 + nf * 16 + fr) * GLS + ks * 32 + fq * 8);
#pragma unroll
            for (int nf = 0; nf < 4; ++nf)
#pragma unroll
                for (int mf = 0; mf < 4; ++mf)
                    acc[nf][mf] = __builtin_amdgcn_mfma_f32_16x16x32_bf16(wf[nf], af[mf], acc[nf][mf], 0, 0, 0);
        }
    }
}


namespace pg8 {
#define PG8_LAS __attribute__((address_space(3)))
constexpr int BM = 256, BK = 64, HALF = 128, HTB = HALF * BK * 2, STAGE_BYTES = 8 * HTB, NXCD = 8, WGM = 8;
__device__ __forceinline__ int lds_byte(int r, int c) { const int st = (r >> 4) * 2 + (c >> 5), rr = r & 15, cc = c & 31, ob = rr * 64 + cc * 2; return st * 1024 + (ob ^ (((ob >> 9) & 1) << 5)); }
__device__ __forceinline__ void stage_rc(int b, int& R, int& C) { const int st = b / 1024, sb = b % 1024, swz = sb ^ (((sb >> 9) & 1) << 5); R = (st >> 1) * 16 + swz / 64; C = (st & 1) * 32 + (swz % 64) / 2; }
__device__ __forceinline__ int perm32(int rho) { const int n = rho >> 4, i = rho & 15; return 8 * (i >> 2) + 4 * n + (i & 3); }
struct Unit { int pm, pn, aux; size_t aoff, boff; };
struct Gemm { const bf16_t* A; const bf16_t* Bt; int lda, ldb, K; };

struct StaticOrder {
    int nM, nN, nwg, G, c, lda, ldb;
    __device__ void init(int M, int N, int G_, int c_, int lda_, int ldb_) { nM = M / BM; nN = N / BM; nwg = nM * nN; G = G_; c = c_; lda = lda_; ldb = ldb_; }
    __device__ bool next(int i, Unit& u) const {
        const long L = (long)i * G + c; if (L >= nwg) return false;
        int wgid = (int)L; { const int q = nwg / NXCD, r = nwg % NXCD, xcd = wgid % NXCD, off = wgid / NXCD; wgid = (xcd < r ? xcd * (q + 1) : r * (q + 1) + (xcd - r) * q) + off; }
        const int nig = WGM * nN, gid = wgid / nig, fm = gid * WGM, gsz = (nM - fm) < WGM ? (nM - fm) : WGM;
        u.pm = fm + ((wgid % nig) % gsz); u.pn = (wgid % nig) / gsz; u.aux = 0;
        u.aoff = (size_t)u.pm * BM * lda * 2; u.boff = (size_t)u.pn * BM * ldb * 2;
        return true;
    }
};
struct MergeOrder {
    int c, G;
    __device__ bool next(int i, Unit& u) const {
        const int tile = c + (i / 3) * G; if (tile >= 256) return false;
        u.pm = tile & 63; u.pn = tile >> 6; u.aux = i % 3;
        u.aoff = ((size_t)u.pm * BM * 1536 + (size_t)u.aux * 512) * 2; u.boff = ((size_t)u.aux * 1024 + (size_t)u.pn * BM) * 512 * 2;
        return true;
    }
};

template <class Epi, class Sched>
__device__ __forceinline__ void gemm_phase(PG8_LAS unsigned char* lds, const Gemm g, const Sched& S, const Epi& E, const int tid) {
    const int wid = __builtin_amdgcn_readfirstlane(tid >> 6), lane = tid & 63, wr = wid >> 2, wc = wid & 3, fr = lane & 15, fq = lane >> 4;
    const int K = g.K, nt = K / BK;
    unsigned voffA[2], voffB[2];
#pragma unroll
    for (int i = 0; i < 2; ++i) { int R, C; stage_rc(tid * 16 + i * 8192, R, C); const int Rb = Epi::PERM ? ((R & ~31) + perm32(R & 31)) : R;
        voffA[i] = (unsigned)(R * g.lda + C) * 2u; voffB[i] = (unsigned)(Rb * g.ldb + C) * 2u; }
    const size_t kstep = (size_t)(BK * 2);
    const size_t hstepA = (size_t)HALF * g.lda * 2, hstepB = (size_t)HALF * g.ldb * 2;
    const unsigned ldsw = (unsigned)wid * 1024u;
    const int aoff = lds_byte(wr * 64 + fr, fq * 8), boff = lds_byte(wc * 32 + fr, fq * 8);
#define PG8_SA(b, h) (((b) * 2 + (h)) * HTB)
#define PG8_SB(b, h) ((4 + (b) * 2 + (h)) * HTB)
#define PG8_STAGE(bufoff, gbase, voff) do { _Pragma("unroll") for (int _i = 0; _i < 2; ++_i) \
        __builtin_amdgcn_global_load_lds((const unsigned*)((const char*)(gbase) + (voff)[_i]), (PG8_LAS unsigned*)(lds + (bufoff) + ldsw + _i * 8192), 16, 0, 0); } while (0)
#define PG8_LDA(dst, b, h) do { _Pragma("unroll") for (int m = 0; m < 4; ++m) _Pragma("unroll") for (int k = 0; k < 2; ++k) dst[m][k] = *(const PG8_LAS bf16x8*)(lds + PG8_SA(b, h) + aoff + m * 2048 + k * 1024); } while (0)
#define PG8_LDB(dst, b, h) do { _Pragma("unroll") for (int n = 0; n < 2; ++n) _Pragma("unroll") for (int k = 0; k < 2; ++k) dst[n][k] = *(const PG8_LAS bf16x8*)(lds + PG8_SB(b, h) + boff + n * 2048 + k * 1024); } while (0)
#define PG8_MMA(ai, bj, At, Bt) do { __builtin_amdgcn_s_setprio(1); _Pragma("unroll") for (int m = 0; m < 4; ++m) _Pragma("unroll") for (int n = 0; n < 2; ++n) _Pragma("unroll") for (int k = 0; k < 2; ++k) \
        acc[ai][bj][m][n] = __builtin_amdgcn_mfma_f32_16x16x32_bf16(Bt[n][k], At[m][k], acc[ai][bj][m][n], 0, 0, 0); __builtin_amdgcn_s_setprio(0); } while (0)
#define PG8_WAIT_V(n) asm volatile("s_waitcnt vmcnt(" #n ")" ::: "memory")
#define PG8_WAIT_L(n) asm volatile("s_waitcnt lgkmcnt(" #n ")" ::: "memory")
#define PG8_BAR __builtin_amdgcn_s_barrier()
#define PG8_SCHED __builtin_amdgcn_sched_barrier(0)
    Unit cur, nxt; int ui = 0;
    if (!S.next(0, cur)) return;
    f32x4 acc[2][2][4][2];
#pragma unroll
    for (int a = 0; a < 2; ++a)
#pragma unroll
        for (int b = 0; b < 2; ++b)
#pragma unroll
            for (int m = 0; m < 4; ++m)
#pragma unroll
                for (int n = 0; n < 2; ++n) acc[a][b][m][n] = f32x4{0.f, 0.f, 0.f, 0.f};
    bf16x8 At[4][2], B0[2][2], B1[2][2];
    const char* cA = (const char*)g.A + cur.aoff; const char* cB = (const char*)g.Bt + cur.boff;
    PG8_STAGE(PG8_SB(0, 0), cB, voffB); PG8_STAGE(PG8_SA(0, 0), cA, voffA); PG8_STAGE(PG8_SB(0, 1), cB + hstepB, voffB); PG8_STAGE(PG8_SA(0, 1), cA + hstepA, voffA);
    if (wr == 1) PG8_BAR;
    PG8_WAIT_V(4); PG8_BAR;
    PG8_STAGE(PG8_SB(1, 0), cB + kstep, voffB); PG8_STAGE(PG8_SA(1, 0), cA + kstep, voffA); PG8_STAGE(PG8_SB(1, 1), cB + hstepB + kstep, voffB);
    PG8_WAIT_V(6); PG8_BAR;
    for (;;) {
        const bool has_next = S.next(ui + 1, nxt);
        const char* nA = has_next ? (const char*)g.A + nxt.aoff : cA; const char* nB = has_next ? (const char*)g.Bt + nxt.boff : cB;
        for (int t = 0; t < nt; t += 2) {
            const bool last = (t == nt - 2);
            const char* a1 = cA + (size_t)(t + 1) * kstep;
            const char* a2 = last ? nA : cA + (size_t)(t + 2) * kstep; const char* b2 = last ? nB : cB + (size_t)(t + 2) * kstep;
            const char* a3 = a2 + kstep; const char* b3 = b2 + kstep;
            PG8_LDB(B0, 0, 0); PG8_SCHED; PG8_LDA(At, 0, 0); PG8_STAGE(PG8_SA(1, 1), a1 + hstepA, voffA);
            PG8_WAIT_L(8); PG8_BAR; PG8_WAIT_L(0); PG8_MMA(0, 0, At, B0); PG8_BAR; PG8_SCHED;
            PG8_LDB(B1, 0, 1); PG8_STAGE(PG8_SB(0, 0), b2, voffB);
            PG8_BAR; PG8_WAIT_L(0); PG8_MMA(0, 1, At, B1); PG8_BAR;
            PG8_LDA(At, 0, 1); PG8_STAGE(PG8_SA(0, 0), a2, voffA);
            PG8_BAR; PG8_WAIT_L(0); PG8_MMA(1, 0, At, B0); PG8_BAR; PG8_SCHED;
            PG8_STAGE(PG8_SB(0, 1), b2 + hstepB, voffB);
            PG8_WAIT_V(6); PG8_BAR; PG8_MMA(1, 1, At, B1); PG8_BAR;
            PG8_LDB(B0, 1, 0); PG8_SCHED; PG8_LDA(At, 1, 0); PG8_STAGE(PG8_SA(0, 1), a2 + hstepA, voffA);
            PG8_WAIT_L(8); PG8_BAR; PG8_WAIT_L(0); PG8_MMA(0, 0, At, B0); PG8_BAR; PG8_SCHED;
            PG8_LDB(B1, 1, 1); PG8_STAGE(PG8_SB(1, 0), b3, voffB);
            PG8_BAR; PG8_WAIT_L(0); PG8_MMA(0, 1, At, B1); PG8_BAR;
            PG8_LDA(At, 1, 1); PG8_STAGE(PG8_SA(1, 0), a3, voffA);
            PG8_BAR; PG8_WAIT_L(0); PG8_MMA(1, 0, At, B0); PG8_BAR; PG8_SCHED;
            PG8_STAGE(PG8_SB(1, 1), b3 + hstepB, voffB);
            PG8_WAIT_V(6); PG8_BAR; PG8_MMA(1, 1, At, B1); PG8_BAR;
        }
        E(acc, cur, wr, wc, fr, fq);
        if (!has_next) break;
#pragma unroll
        for (int a = 0; a < 2; ++a)
#pragma unroll
            for (int b = 0; b < 2; ++b)
#pragma unroll
                for (int m = 0; m < 4; ++m)
#pragma unroll
                    for (int n = 0; n < 2; ++n) acc[a][b][m][n] = f32x4{0.f, 0.f, 0.f, 0.f};
        cur = nxt; cA = nA; cB = nB; ++ui;
    }
    PG8_WAIT_V(0);
    if (wr == 0) PG8_BAR;
    PG8_BAR;
#undef PG8_SA
#undef PG8_SB
#undef PG8_STAGE
#undef PG8_LDA
#undef PG8_LDB
#undef PG8_MMA
#undef PG8_WAIT_V
#undef PG8_WAIT_L
#undef PG8_BAR
#undef PG8_SCHED
}

struct EpiBf16 {
    static constexpr bool PERM = true;
    bf16_t* O; int ldc;
    __device__ __forceinline__ void operator()(const f32x4 (&acc)[2][2][4][2], const Unit& u, int wr, int wc, int fr, int fq) const {
        const int row0 = u.pm * BM + wr * 64 + fr, col0 = u.pn * BM + wc * 32 + 8 * fq;
#pragma unroll
        for (int ai = 0; ai < 2; ++ai)
#pragma unroll
            for (int m = 0; m < 4; ++m) { bf16_t* rowp = O + (size_t)(row0 + ai * HALF + m * 16) * ldc + col0;
#pragma unroll
                for (int bj = 0; bj < 2; ++bj) { const f32x4 v0 = acc[ai][bj][m][0], v1 = acc[ai][bj][m][1];
                    u32x4 w; w.x = pack2(v0[0], v0[1]); w.y = pack2(v0[2], v0[3]); w.z = pack2(v1[0], v1[1]); w.w = pack2(v1[2], v1[3]);
                    *(u32x4*)(rowp + bj * HALF) = w; } }
    }
};
struct EpiResid {
    static constexpr bool PERM = false;
    const float* xin; float* out; const float* mod;
    __device__ __forceinline__ void operator()(const f32x4 (&acc)[2][2][4][2], const Unit& u, int wr, int wc, int fr, int fq) const {
        const int row0 = u.pm * BM + wr * 64 + fr, col0 = u.pn * BM + wc * 32 + 4 * fq;
        const float* gm = mod + (size_t)(row0 >> 11) * 6144 + 2048 + col0;
        f32x4 g4[2][2];
#pragma unroll
        for (int bj = 0; bj < 2; ++bj)
#pragma unroll
            for (int n = 0; n < 2; ++n) g4[bj][n] = *(const f32x4*)(gm + bj * HALF + n * 16);
#pragma unroll
        for (int ai = 0; ai < 2; ++ai) {
            f32x4 xi[4][2][2];
#pragma unroll
            for (int m = 0; m < 4; ++m)
#pragma unroll
                for (int bj = 0; bj < 2; ++bj)
#pragma unroll
                    for (int n = 0; n < 2; ++n) xi[m][bj][n] = *(const f32x4*)(xin + (size_t)(row0 + ai * HALF + m * 16) * 1024 + col0 + bj * HALF + n * 16);
            asm volatile("" ::: "memory");
#pragma unroll
            for (int m = 0; m < 4; ++m)
#pragma unroll
                for (int bj = 0; bj < 2; ++bj)
#pragma unroll
                    for (int n = 0; n < 2; ++n)
                        *(f32x4*)(out + (size_t)(row0 + ai * HALF + m * 16) * 1024 + col0 + bj * HALF + n * 16) = xi[m][bj][n] + g4[bj][n] * acc[ai][bj][m][n];
            asm volatile("" ::: "memory");
        }
    }
};
struct EpiMerge {
    static constexpr bool PERM = true;
    bf16_t* Hm; const bf16_t* Z;
    __device__ __forceinline__ void operator()(const f32x4 (&acc)[2][2][4][2], const Unit& u, int wr, int wc, int fr, int fq) const {
        const int row0 = u.pm * BM + wr * 64 + fr, col0 = u.pn * BM + wc * 32 + 8 * fq, g = u.aux;
#pragma unroll
        for (int ai = 0; ai < 2; ++ai) {
            u32x4 gz[4][2], prev[4][2];
#pragma unroll
            for (int m = 0; m < 4; ++m)
#pragma unroll
                for (int bj = 0; bj < 2; ++bj) {
                    const int row = row0 + ai * HALF + m * 16, col = col0 + bj * HALF;
                    gz[m][bj] = *(const u32x4*)(Z + (size_t)row * LDZ + ZM + g * 1024 + col);
                    prev[m][bj] = u32x4{0u, 0u, 0u, 0u};
                    if (g > 0) prev[m][bj] = *(const u32x4*)(Hm + (size_t)row * 1024 + col);
                }
            asm volatile("" ::: "memory");
#pragma unroll
            for (int m = 0; m < 4; ++m)
#pragma unroll
                for (int bj = 0; bj < 2; ++bj) {
                    const int row = row0 + ai * HALF + m * 16, col = col0 + bj * HALF;
                    const f32x4 v0 = acc[ai][bj][m][0], v1 = acc[ai][bj][m][1];
                    const u32x4 z_ = gz[m][bj], p_ = prev[m][bj];
                    u32x4 w;
                    w.x = pack2(bflo(p_.x) + sigm(bflo(z_.x)) * v0[0], bfhi(p_.x) + sigm(bfhi(z_.x)) * v0[1]);
                    w.y = pack2(bflo(p_.y) + sigm(bflo(z_.y)) * v0[2], bfhi(p_.y) + sigm(bfhi(z_.y)) * v0[3]);
                    w.z = pack2(bflo(p_.z) + sigm(bflo(z_.z)) * v1[0], bfhi(p_.z) + sigm(bfhi(z_.z)) * v1[1]);
                    w.w = pack2(bflo(p_.w) + sigm(bflo(z_.w)) * v1[2], bfhi(p_.w) + sigm(bfhi(z_.w)) * v1[3]);
                    *(u32x4*)(Hm + (size_t)row * 1024 + col) = w;
                }
            asm volatile("" ::: "memory");
        }
    }
};
}

struct EpiZ {
    bf16_t* Z; int ld;
    __device__ __forceinline__ void operator()(int m, int n, const f32x4& v) const {
        uint2 o; o.x = pack2(v[0], v[1]); o.y = pack2(v[2], v[3]);
        *(uint2*)(Z + (size_t)m * ld + n) = o;
    }
};
struct EpiF16 {
    _Float16* C; int ld;
    __device__ __forceinline__ void operator()(int m, int n, const f32x4& v) const {
        typedef _Float16 h4 __attribute__((ext_vector_type(4)));
        h4 o = {(_Float16)v[0], (_Float16)v[1], (_Float16)v[2], (_Float16)v[3]};
        *(h4*)(C + (size_t)m * ld + n) = o;
    }
};
struct EpiOut {
    const float* xin; float* out; const float* mod;
    __device__ __forceinline__ void operator()(int m, int n, const f32x4& v) const {
        int b = m >> 11;
        float4 g = *(const float4*)(mod + (size_t)b * 6144 + 2048 + n);
        float4 xi = *(const float4*)(xin + (size_t)m * 1024 + n);
        *(float4*)(out + (size_t)m * 1024 + n) = make_float4(xi.x + g.x * v[0], xi.y + g.y * v[1], xi.z + g.z * v[2], xi.w + g.w * v[3]);
    }
};

template <class Epi>
__device__ void gemm_phase(const bf16_t* A, int lda, const bf16_t* Bt, int ldb, int M, int N, int K, bool batched, Epi epi,
                           int vb0, int nvb, char* smem_, const int tid) {
    bf16_t* sA = (bf16_t*)smem_; bf16_t* sB = sA + GBM * GLS;
    const int lane = tid & 63, wave = tid >> 6, wm = wave >> 1, wn = wave & 1, fr = lane & 15, fq = lane >> 4;
    const int MT = M / GBM, NTL = N / GBN;
    for (int tile = vb0; tile < MT * NTL; tile += nvb) {
        int mt = tile % MT, nt = tile / MT;
        f32x4 acc[4][4];
#pragma unroll
        for (int a = 0; a < 4; ++a)
#pragma unroll
            for (int b = 0; b < 4; ++b) acc[a][b] = f32x4{0.f, 0.f, 0.f, 0.f};
        gemm_tile(batched ? A + nt * 128 : A, lda, Bt, ldb, K, mt * GBM, nt * GBN, sA, sB, acc, tid);
#pragma unroll
        for (int nf = 0; nf < 4; ++nf)
#pragma unroll
            for (int mf = 0; mf < 4; ++mf)
                epi(mt * GBM + wm * 64 + mf * 16 + fr, nt * GBN + wn * 64 + nf * 16 + fq * 4, acc[nf][mf]);
    }
}


#define SCAN_SYNC() do { asm volatile("s_waitcnt lgkmcnt(0)" ::: "memory"); __builtin_amdgcn_s_barrier(); asm volatile("" ::: "memory"); } while (0)
template <int DK, bool GLA>
__device__ void scan2_item(const Params& p, int l, int b, int h, char* smem_) {
    constexpr int SEG = NT / DK, SLEN = 64 / SEG, KS = DK / 32, KT = DK / 16;
    constexpr int QS = DK + 8, BS = DK + 4, VS = 72;
    bf16_t* qs = (bf16_t*)smem_;
    bf16_t* ks = qs + 64 * QS;
    float* bs = (float*)(ks + 64 * QS);
    bf16_t* vt = (bf16_t*)(bs + 64 * BS);
    bf16_t* At = vt + 128 * VS;
    bf16_t* kht = At + 64 * VS;
    bf16_t* st = kht + DK * VS;
    float* segtot = (float*)(st + 128 * QS);
    float* blast = segtot + SEG * DK;
    const int tid = TIDX(), lane = tid & 63, wave = __builtin_amdgcn_readfirstlane(tid >> 6), fr = lane & 15, fq = lane >> 4;
    const int kl = tid % DK, seg = __builtin_amdgcn_readfirstlane(tid / DK);
    float lbv = 0.f, gbias = 0.f; float gu[16];
#pragma unroll
    for (int r = 0; r < 16; ++r) gu[r] = 0.f;
    if (GLA) {
#pragma unroll
        for (int r = 0; r < 16; ++r) gu[r] = p.gla_up[(size_t)(l * 16 + r) * 256 + h * 64 + kl];
        gbias = p.gla_bias[l * 256 + h * 64 + kl];
    } else if (l == 1) {
        float x0 = p.hgrn_lb[h * 128 + kl], x1 = p.hgrn_lb[512 + h * 128 + kl];
        lbv = 1.f / (1.f + expf(x0 - x1));
    }
    const float scale = GLA ? 0.125f : 0.08838834764831845f;
    const bf16_t* Zb = (const bf16_t*)(p.ws + WS_Z) + (size_t)(b * 2048) * LDZ;
    float* ssq = (float*)(smem_ + 152576);
    const int QCOL = (GLA ? ZC_Q : ZA_Q) + h * DK, KCOL = (GLA ? ZC_K : ZA_F) + h * DK, VCOL = (GLA ? ZC_V : ZA_I) + h * 128, GCOL = (GLA ? ZC_G : ZA_G) + h * 128;
    f32x4 sacc[KT];
#pragma unroll
    for (int i = 0; i < KT; ++i) sacc[i] = f32x4{0.f, 0.f, 0.f, 0.f};
    f32x4 gn4[4];
    {
        const float* gn = (GLA ? p.gla_on : p.hgrn_on) + l * 128 + (wave >> 2) * 64 + 4 * fq;
#pragma unroll
        for (int vi = 0; vi < 4; ++vi) gn4[vi] = *(const f32x4*)(gn + vi * 16);
    }
    for (int i = tid; i < 128 * QS / 2; i += NT) ((unsigned*)st)[i] = 0u;
    SCAN_SYNC();

    for (int c = 0; c < 32; ++c) {
        const bf16_t* Zc = Zb + (size_t)(c * 64) * LDZ;
        {
            bf16_t rq[SLEN], rk[SLEN];
            u32x4 rc0[GLA ? SLEN : 1], rc1[GLA ? SLEN : 1];
            {
                bf16_t rv[16];
                const int v = tid & 127, sb_ = __builtin_amdgcn_readfirstlane(tid >> 7);
#pragma unroll
                for (int i = 0; i < 16; ++i) rv[i] = Zc[(size_t)(sb_ + 4 * i) * LDZ + VCOL + v];
#pragma unroll
                for (int i = 0; i < SLEN; ++i) {
                    const bf16_t* zr = Zc + (size_t)(seg * SLEN + i) * LDZ;
                    rq[i] = zr[QCOL + kl]; rk[i] = zr[KCOL + kl];
                    if (GLA) { rc0[i] = *(const u32x4*)(zr + ZC_CODE); rc1[i] = *(const u32x4*)(zr + ZC_CODE + 8); }
                }
#pragma unroll
                for (int i = 0; i < 16; ++i) vt[v * VS + sb_ + 4 * i] = rv[i];
            }
            float run = 0.f;
#pragma unroll
            for (int i = 0; i < SLEN; ++i) {
                const int s_ = seg * SLEN + i;
                float g, kk;
                if (GLA) {
                    float x = gbias;
#pragma unroll
                    for (int r = 0; r < 4; ++r) {
                        x += bflo(rc0[i][r]) * gu[2 * r] + bfhi(rc0[i][r]) * gu[2 * r + 1];
                        x += bflo(rc1[i][r]) * gu[8 + 2 * r] + bfhi(rc1[i][r]) * gu[8 + 2 * r + 1];
                    }
                    g = (fminf(x, 0.f) - __logf(1.f + __expf(-fabsf(x)))) * (1.f / 16.f);
                    kk = bf2f(rk[i]);
                } else {
                    const float f = lbv + (1.f - lbv) * __frcp_rn(1.f + __expf(-bf2f(rk[i])));
                    g = __logf(f); kk = 1.f - f;
                }
                run += g;
                bs[s_ * BS + kl] = run;
                qs[s_ * QS + kl] = rq[i];
                ks[s_ * QS + kl] = f2bf(kk);
            }
            segtot[seg * DK + kl] = run;
        }
        SCAN_SYNC();
        {
            float pre = 0.f, tot = 0.f;
#pragma unroll
            for (int g_ = 0; g_ < SEG; ++g_) { const float v_ = segtot[g_ * DK + kl]; if (g_ < seg) pre += v_; tot += v_; }
            if (seg == 0) blast[kl] = tot;
            unsigned pk[SLEN / 2];
#pragma unroll
            for (int i = 0; i < SLEN; ++i) {
                const float bv = bs[(seg * SLEN + i) * BS + kl] + pre;
                bs[(seg * SLEN + i) * BS + kl] = bv;
                const float kh = bf2f(ks[(seg * SLEN + i) * QS + kl]) * __expf(tot - bv);
                if (i & 1) pk[i >> 1] |= ((unsigned)f2bf(kh)) << 16; else pk[i >> 1] = (unsigned)f2bf(kh);
            }
            unsigned* dst = (unsigned*)(kht + kl * VS + seg * SLEN);
#pragma unroll
            for (int i = 0; i < SLEN / 2; ++i) dst[i] = pk[i];
        }
        SCAN_SYNC();
        for (int blk = wave; blk < 10; blk += 8) {
            int bi, bj;
            if (blk < 1) { bi = 0; bj = 0; } else if (blk < 3) { bi = 1; bj = blk - 1; } else if (blk < 6) { bi = 2; bj = blk - 3; } else { bi = 3; bj = blk - 6; }
            f32x4 acc = f32x4{0.f, 0.f, 0.f, 0.f};
            const int srow = bj * 16 + fr, trow = bi * 16 + fr;
#pragma unroll
            for (int kk = 0; kk < KS; ++kk) {
                const int k0 = kk * 32 + fq * 8;
                float br[8];
                if (bi == 0) {
#pragma unroll
                    for (int j = 0; j < 8; ++j) br[j] = 0.f;
                } else {
                    const float4 r0 = *(const float4*)(bs + (bi * 16 - 1) * BS + k0), r1 = *(const float4*)(bs + (bi * 16 - 1) * BS + k0 + 4);
                    br[0] = r0.x; br[1] = r0.y; br[2] = r0.z; br[3] = r0.w; br[4] = r1.x; br[5] = r1.y; br[6] = r1.z; br[7] = r1.w;
                }
                const uint4 kq = *(const uint4*)(ks + srow * QS + k0), qq = *(const uint4*)(qs + trow * QS + k0);
                const float4 s0 = *(const float4*)(bs + srow * BS + k0), s1 = *(const float4*)(bs + srow * BS + k0 + 4);
                const float4 t0_ = *(const float4*)(bs + trow * BS + k0), t1_ = *(const float4*)(bs + trow * BS + k0 + 4);
                const float bsv[8] = {s0.x, s0.y, s0.z, s0.w, s1.x, s1.y, s1.z, s1.w}, btv[8] = {t0_.x, t0_.y, t0_.z, t0_.w, t1_.x, t1_.y, t1_.z, t1_.w};
                const unsigned kw[4] = {kq.x, kq.y, kq.z, kq.w}, qw[4] = {qq.x, qq.y, qq.z, qq.w};
                union { bf16x8 v; unsigned u[4]; } ka, qb;
#pragma unroll
                for (int j = 0; j < 4; ++j) {
                    const float e0 = __expf(fminf(br[2 * j] - bsv[2 * j], 60.f)), e1 = __expf(fminf(br[2 * j + 1] - bsv[2 * j + 1], 60.f));
                    ka.u[j] = pack2(bflo(kw[j]) * e0, bfhi(kw[j]) * e1);
                    const float f0 = __expf(btv[2 * j] - br[2 * j]), f1 = __expf(btv[2 * j + 1] - br[2 * j + 1]);
                    qb.u[j] = pack2(bflo(qw[j]) * f0, bfhi(qw[j]) * f1);
                }
                acc = __builtin_amdgcn_mfma_f32_16x16x32_bf16(ka.v, qb.v, acc, 0, 0, 0);
            }
            if (bi == bj) {
#pragma unroll
                for (int r = 0; r < 4; ++r) if (4 * fq + r > fr) acc[r] = 0.f;
            }
            uint2 o; o.x = pack2(acc[0], acc[1]); o.y = pack2(acc[2], acc[3]);
            *(uint2*)(At + trow * VS + bj * 16 + 4 * fq) = o;
        }
        {
            unsigned z_ = 0u; asm volatile("" : "+v"(z_));
            if (wave == 2) *(uint2*)(At + (0 * 16 + fr) * VS + 16 + 4 * fq) = make_uint2(z_, z_);
            if (wave == 3) *(uint2*)(At + (2 * 16 + fr) * VS + 48 + 4 * fq) = make_uint2(z_, z_);
        }
        SCAN_SYNC();
        f32x4 oacc[4]; uint2 gz[4];
        {
            const int ti = wave & 3, vh = wave >> 2, trow = ti * 16 + fr;
            bf16x8 qh[KS];
#pragma unroll
            for (int kk = 0; kk < KS; ++kk) {
                const int k0 = kk * 32 + fq * 8;
                const uint4 qq = *(const uint4*)(qs + trow * QS + k0);
                const float4 t0_ = *(const float4*)(bs + trow * BS + k0), t1_ = *(const float4*)(bs + trow * BS + k0 + 4);
                union { bf16x8 v; unsigned u[4]; } q_;
                q_.u[0] = pack2(bflo(qq.x) * __expf(t0_.x), bfhi(qq.x) * __expf(t0_.y));
                q_.u[1] = pack2(bflo(qq.y) * __expf(t0_.z), bfhi(qq.y) * __expf(t0_.w));
                q_.u[2] = pack2(bflo(qq.z) * __expf(t1_.x), bfhi(qq.z) * __expf(t1_.y));
                q_.u[3] = pack2(bflo(qq.w) * __expf(t1_.z), bfhi(qq.w) * __expf(t1_.w));
                qh[kk] = q_.v;
            }
            const bf16x8 af0 = *(const bf16x8*)(At + trow * VS + fq * 8), af1 = *(const bf16x8*)(At + trow * VS + 32 + fq * 8);
            float sq = 0.f;
#pragma unroll
            for (int vi = 0; vi < 4; ++vi) {
                const int vrow = vh * 64 + vi * 16 + fr;
                gz[vi] = *(const uint2*)(Zc + (size_t)trow * LDZ + GCOL + vh * 64 + vi * 16 + 4 * fq);
                f32x4 acc = f32x4{0.f, 0.f, 0.f, 0.f};
                acc = __builtin_amdgcn_mfma_f32_16x16x32_bf16(*(const bf16x8*)(vt + vrow * VS + fq * 8), af0, acc, 0, 0, 0);
                if (ti >= 2) acc = __builtin_amdgcn_mfma_f32_16x16x32_bf16(*(const bf16x8*)(vt + vrow * VS + 32 + fq * 8), af1, acc, 0, 0, 0);
#pragma unroll
                for (int kk = 0; kk < KS; ++kk)
                    acc = __builtin_amdgcn_mfma_f32_16x16x32_bf16(*(const bf16x8*)(st + vrow * QS + kk * 32 + fq * 8), qh[kk], acc, 0, 0, 0);
                oacc[vi] = acc * scale;
                sq += oacc[vi][0] * oacc[vi][0] + oacc[vi][1] * oacc[vi][1] + oacc[vi][2] * oacc[vi][2] + oacc[vi][3] * oacc[vi][3];
            }
            sq += shx<16>(sq); sq += shx<32>(sq);
            if (fq == 0) ssq[vh * 64 + trow] = sq;
        }
        {
            const int vrow = wave * 16 + fr;
            const bf16x8 vf0 = *(const bf16x8*)(vt + vrow * VS + fq * 8), vf1 = *(const bf16x8*)(vt + vrow * VS + 32 + fq * 8);
#pragma unroll
            for (int kt = 0; kt < KT; ++kt) {
                const float dec = __expf(blast[kt * 16 + fr]);
                sacc[kt][0] *= dec; sacc[kt][1] *= dec; sacc[kt][2] *= dec; sacc[kt][3] *= dec;
                sacc[kt] = __builtin_amdgcn_mfma_f32_16x16x32_bf16(vf0, *(const bf16x8*)(kht + (kt * 16 + fr) * VS + fq * 8), sacc[kt], 0, 0, 0);
                sacc[kt] = __builtin_amdgcn_mfma_f32_16x16x32_bf16(vf1, *(const bf16x8*)(kht + (kt * 16 + fr) * VS + 32 + fq * 8), sacc[kt], 0, 0, 0);
            }
        }
        SCAN_SYNC();
#pragma unroll
        for (int kt = 0; kt < KT; ++kt)
#pragma unroll
            for (int r = 0; r < 4; ++r) st[(wave * 16 + 4 * fq + r) * QS + kt * 16 + fr] = f2bf(sacc[kt][r]);
        {
            const int ti = wave & 3, vh = wave >> 2, trow = ti * 16 + fr;
            const float rstd = rsqrtf((ssq[trow] + ssq[64 + trow]) * (1.f / 128.f) + 1e-6f);
            bf16_t* yrow = (bf16_t*)(p.ws + WS_Y) + (size_t)(b * 2048 + c * 64 + trow) * 1536 + (GLA ? 1024 : 0) + h * 128 + vh * 64 + 4 * fq;
#pragma unroll
            for (int vi = 0; vi < 4; ++vi) {
                const f32x4 g4_ = gn4[vi]; const float4 g4 = make_float4(g4_[0], g4_[1], g4_[2], g4_[3]);
                const float z0 = bflo(gz[vi].x), z1 = bfhi(gz[vi].x), z2 = bflo(gz[vi].y), z3 = bfhi(gz[vi].y);
                uint2 o;
                o.x = pack2(oacc[vi][0] * rstd * g4.x * (z0 * sigm(z0)), oacc[vi][1] * rstd * g4.y * (z1 * sigm(z1)));
                o.y = pack2(oacc[vi][2] * rstd * g4.z * (z2 * sigm(z2)), oacc[vi][3] * rstd * g4.w * (z3 * sigm(z3)));
                *(uint2*)(yrow + vi * 16) = o;
            }
        }
    }
    SCAN_SYNC();
}

__device__ void dsaprep2_item(const Params& p, int l, int item, char* smem_) {
    bf16_t* tile = (bf16_t*)smem_;
    const int tid = TIDX(), lane = tid & 63, wave = tid >> 6;
    bf16_t* Z = (bf16_t*)(p.ws + WS_Z); bf16_t* VT = (bf16_t*)(p.ws + WS_VT);
    {
        const int tb = item * 32;
        {
            const float2 gq = *(const float2*)(p.dsa_qn + l * 128 + lane * 2), gk = *(const float2*)(p.dsa_kn + l * 128 + lane * 2);
            unsigned uu[4][8];
#pragma unroll
            for (int j = 0; j < 4; ++j)
#pragma unroll
                for (int grp = 0; grp < 8; ++grp)
                    uu[j][grp] = *(const unsigned*)(Z + (size_t)(tb + wave + 8 * j) * LDZ + (grp < 4 ? ZB_Q : ZB_K) + (grp & 3) * 128 + lane * 2);
#pragma unroll
            for (int j = 0; j < 4; ++j)
#pragma unroll
                for (int grp = 0; grp < 8; ++grp) {
                    bf16_t* ptr = Z + (size_t)(tb + wave + 8 * j) * LDZ + (grp < 4 ? ZB_Q : ZB_K) + (grp & 3) * 128 + lane * 2;
                    const float a = bflo(uu[j][grp]), b = bfhi(uu[j][grp]);
                    const float ss = wave_sum(a * a + b * b);
                    const float r = rsqrtf(ss * (1.f / 128.f) + 1e-6f) * ((grp < 4) ? 0.08838834764831845f : 1.f);
                    const float2 g = (grp < 4) ? gq : gk;
                    __hip_atomic_store((unsigned*)ptr, pack2(a * r * g.x, b * r * g.y), __ATOMIC_RELAXED, __HIP_MEMORY_SCOPE_AGENT);
                }
        }
        u32x4 uv[4];
#pragma unroll
        for (int i = 0; i < 4; ++i) { const int ch = tid + i * 512; uv[i] = *(const u32x4*)(Z + (size_t)(tb + (ch >> 6)) * LDZ + ZB_V + (ch & 63) * 8); }
#pragma unroll
        for (int i = 0; i < 4; ++i) {
            const int ch = tid + i * 512, t = ch >> 6, c8 = (ch & 63) * 8;
            unsigned* d = (unsigned*)(tile + t * 514 + c8);
            d[0] = uv[i][0]; d[1] = uv[i][1]; d[2] = uv[i][2]; d[3] = uv[i][3];
        }
        __syncthreads();
        {
            const int c = tid, b = tb >> 11, s0 = tb & 2047;
            unsigned w[16];
#pragma unroll
            for (int j = 0; j < 16; ++j) w[j] = (unsigned)tile[(2 * j) * 514 + c] | ((unsigned)tile[(2 * j + 1) * 514 + c] << 16);
            unsigned long long* dst = (unsigned long long*)(VT + ((size_t)(b * 512 + c)) * 2048 + s0);
#pragma unroll
            for (int j = 0; j < 8; ++j) __hip_atomic_store(dst + j, ((unsigned long long)w[2 * j + 1] << 32) | w[2 * j], __ATOMIC_RELAXED, __HIP_MEMORY_SCOPE_AGENT);
        }
        __syncthreads();
    }
}

__device__ void dsa_select_tile(const Params& p, int b, int tq, char* smem_) {
    constexpr int KS_ = 2052;
    unsigned* keyL = (unsigned*)smem_;
    const int tid = TIDX(), lane = tid & 63, wave = __builtin_amdgcn_readfirstlane(tid >> 6), fr = lane & 15, fq = lane >> 4;
    const bf16_t* Z = (const bf16_t*)(p.ws + WS_Z);
    unsigned long long* BM64 = (unsigned long long*)(p.ws + WS_BM);
    const int t0 = tq * 16;
    {
        const int tl = t0 + fr;
        const size_t trow = (size_t)b * 2048 + tl;
        bf16x8 qf[4][2];
#pragma unroll
        for (int h = 0; h < 4; ++h)
#pragma unroll
            for (int ks = 0; ks < 2; ++ks) qf[h][ks] = *(const bf16x8*)(Z + trow * LDZ + ZB_QI + h * 64 + ks * 32 + fq * 8);
        float w[4];
#pragma unroll
        for (int h = 0; h < 4; ++h) w[h] = bf2f(Z[trow * LDZ + ZB_WI + h]) * 0.5f;
#pragma unroll 4
        for (int kt = wave; kt <= tq; kt += 8) {
            const bf16_t* kr = Z + ((size_t)b * 2048 + kt * 16 + fr) * LDZ + ZB_KI + fq * 8;
            const bf16x8 k0 = *(const bf16x8*)kr, k1 = *(const bf16x8*)(kr + 32);
            f32x4 acc[4];
#pragma unroll
            for (int h = 0; h < 4; ++h) {
                acc[h] = __builtin_amdgcn_mfma_f32_16x16x32_bf16(k0, qf[h][0], f32x4{0.f, 0.f, 0.f, 0.f}, 0, 0, 0);
                acc[h] = __builtin_amdgcn_mfma_f32_16x16x32_bf16(k1, qf[h][1], acc[h], 0, 0, 0);
            }
            u32x4 kk;
#pragma unroll
            for (int r = 0; r < 4; ++r) {
                float sc = w[0] * fmaxf(acc[0][r] * 0.125f, 0.f) + w[1] * fmaxf(acc[1][r] * 0.125f, 0.f) + w[2] * fmaxf(acc[2][r] * 0.125f, 0.f) + w[3] * fmaxf(acc[3][r] * 0.125f, 0.f);
                if (sc == 0.f) sc = 0.f;
                const unsigned u = __float_as_uint(sc);
                const unsigned k = (u & 0x80000000u) ? ~u : (u | 0x80000000u);
                kk[r] = (kt * 16 + 4 * fq + r <= tl) ? k : 0u;
            }
            *(u32x4*)(keyL + fr * KS_ + kt * 16 + 4 * fq) = kk;
        }
    }
    __syncthreads();
    {
        const int nk = (tq + 1) * 16, jmax = (nk + 63) >> 6;
        const int qa = 2 * wave, qb = qa + 1;
        unsigned ka[32], kb[32];
#pragma unroll
        for (int j = 0; j < 32; ++j) {
            const int s = lane + 64 * j;
            ka[j] = (s < nk) ? keyL[qa * KS_ + s] : 0u;
            kb[j] = (s < nk) ? keyL[qb * KS_ + s] : 0u;
        }
        unsigned Ta = 1u, Tb = 1u; int Ca = 2047, Cb = 2047;
        if (t0 >= 256) {
            int na, nb;
            bool da, db;
            {
                int c0 = 0, c1 = 0, c2 = 0, c3 = 0;
#pragma unroll
                for (int j = 0; j < 32; ++j)
                    if (j < jmax) { c0 += (ka[j] >= 0x80000000u); c1 += (ka[j] > 0x80000000u); c2 += (kb[j] >= 0x80000000u); c3 += (kb[j] > 0x80000000u); }
                c0 = wave_total_i(c0); c1 = wave_total_i(c1); c2 = wave_total_i(c2); c3 = wave_total_i(c3);
                da = (c1 < 256 && c0 >= 256); db = (c3 < 256 && c2 >= 256);
                Ta = da ? 0x80000000u : ((c0 >= 256) ? 0x80000000u : 0u); na = da ? c0 : ((c0 >= 256) ? c0 : 0x7fffffff);
                Tb = db ? 0x80000000u : ((c2 >= 256) ? 0x80000000u : 0u); nb = db ? c2 : ((c2 >= 256) ? c2 : 0x7fffffff);
            }
            for (int bit = 30; bit >= 0; --bit) {
                if (da && db) break;
                const unsigned ca_ = Ta | (1u << bit), cb_ = Tb | (1u << bit);
                int c0 = 0, c1 = 0;
#pragma unroll
                for (int j = 0; j < 32; ++j)
                    if (j < jmax) { c0 += (ka[j] >= ca_); c1 += (kb[j] >= cb_); }
                c0 = wave_total_i(c0); c1 = wave_total_i(c1);
                if (!da && c0 >= 256) { Ta = ca_; na = c0; }
                if (!db && c1 >= 256) { Tb = cb_; nb = c1; }
                da = da || (na == 256); db = db || (nb == 256);
            }
            if (na != 256 || nb != 256) {
                int needa, needb;
                {
                    int c0 = 0, c1 = 0;
#pragma unroll
                    for (int j = 0; j < 32; ++j)
                        if (j < jmax) { c0 += (ka[j] > Ta); c1 += (kb[j] > Tb); }
                    needa = 256 - wave_total_i(c0); needb = 256 - wave_total_i(c1);
                }
                Ca = 0; Cb = 0;
                for (int bit = 10; bit >= 0; --bit) {
                    const int ca_ = Ca | (1 << bit), cb_ = Cb | (1 << bit);
                    int c0 = 0, c1 = 0;
#pragma unroll
                    for (int j = 0; j < 32; ++j)
                        if (j < jmax) { const int s = lane + 64 * j; c0 += (ka[j] == Ta && s < ca_); c1 += (kb[j] == Tb && s < cb_); }
                    c0 = wave_total_i(c0); c1 = wave_total_i(c1);
                    if (c0 < needa) Ca = ca_;
                    if (c1 < needb) Cb = cb_;
                }
            }
        }
        const size_t rowa = (size_t)b * 2048 + t0 + qa;
#pragma unroll
        for (int j = 0; j < 32; ++j) {
            const int s = lane + 64 * j;
            const unsigned long long ma = __ballot((ka[j] > Ta) || (ka[j] == Ta && s <= Ca));
            const unsigned long long mb = __ballot((kb[j] > Tb) || (kb[j] == Tb && s <= Cb));
            if (lane == 0) {
                __hip_atomic_store(&BM64[rowa * 32 + j], ma, __ATOMIC_RELAXED, __HIP_MEMORY_SCOPE_AGENT);
                __hip_atomic_store(&BM64[(rowa + 1) * 32 + j], mb, __ATOMIC_RELAXED, __HIP_MEMORY_SCOPE_AGENT);
            }
        }
    }
    __syncthreads();
}

__device__ void dsa_attn_item(const Params& p, int b, int h, int qg, char* smem_) {
    constexpr int KSTR = 136, VSTR = 40;
    bf16_t* Kl = (bf16_t*)smem_;
    bf16_t* Vl = Kl + 2 * 32 * KSTR;
    const int tid = TIDX(), lane = tid & 63, wave = __builtin_amdgcn_readfirstlane(tid >> 6), fr = lane & 15, fq = lane >> 4;
    const bf16_t* Z = (const bf16_t*)(p.ws + WS_Z); const bf16_t* VT = (const bf16_t*)(p.ws + WS_VT);
    const unsigned* BM = (const unsigned*)(p.ws + WS_BM); bf16_t* Y = (bf16_t*)(p.ws + WS_Y);
    const int kr = tid >> 4, kc = tid & 15, vd = tid >> 2, vc = tid & 3;
    const int ka_row = 8 * (fr >> 2) + (fr & 3);
    {
        const int t0 = qg * 128 + wave * 16;
        const size_t trow = (size_t)b * 2048 + t0 + fr;
        bf16x8 qf[4];
#pragma unroll
        for (int ks = 0; ks < 4; ++ks) qf[ks] = *(const bf16x8*)(Z + trow * LDZ + ZB_Q + h * 128 + ks * 32 + fq * 8);
        f32x4 o[8];
#pragma unroll
        for (int i = 0; i < 8; ++i) o[i] = f32x4{0.f, 0.f, 0.f, 0.f};
        float m = -INFINITY, lsum = 0.f;
        const unsigned* bmrow = BM + trow * 64;
        const int nsteps_blk = qg * 4 + 4, nsteps_w = (t0 + 15) / 32 + 1;
        const bf16_t* kg = Z + ((size_t)b * 2048 + kr) * LDZ + ZB_K + h * 128 + kc * 8;
        const bf16_t* vg = VT + ((size_t)(b * 4 + h) * 128 + vd) * 2048 + vc * 8;
        u32x4 rk = *(const u32x4*)kg, rv = *(const u32x4*)vg;
        *(u32x4*)(Kl + kr * KSTR + kc * 8) = rk; *(u32x4*)(Vl + vd * VSTR + vc * 8) = rv;
        __syncthreads();
        unsigned mwn = bmrow[0];
        for (int st = 0; st < nsteps_blk; ++st) {
            const bool more = (st + 1 < nsteps_blk);
            const unsigned mwc = mwn;
            mwn = bmrow[(st + 1 < nsteps_w) ? st + 1 : st];
            if (more) { rk = *(const u32x4*)(kg + (size_t)(st + 1) * 32 * LDZ); rv = *(const u32x4*)(vg + (st + 1) * 32); }
            if (st < nsteps_w) {
                const bf16_t* Kb = Kl + (st & 1) * 32 * KSTR; const bf16_t* Vb = Vl + (st & 1) * 128 * VSTR;
                f32x4 sa = f32x4{0.f, 0.f, 0.f, 0.f}, sb = f32x4{0.f, 0.f, 0.f, 0.f};
#pragma unroll
                for (int ks = 0; ks < 4; ++ks) {
                    const bf16x8 fa = *(const bf16x8*)(Kb + ka_row * KSTR + ks * 32 + fq * 8), fb = *(const bf16x8*)(Kb + (ka_row + 4) * KSTR + ks * 32 + fq * 8);
                    sa = __builtin_amdgcn_mfma_f32_16x16x32_bf16(fa, qf[ks], sa, 0, 0, 0);
                    sb = __builtin_amdgcn_mfma_f32_16x16x32_bf16(fb, qf[ks], sb, 0, 0, 0);
                }
                const unsigned mw = mwc >> (8 * fq);
                float x[8];
#pragma unroll
                for (int r = 0; r < 4; ++r) { x[r] = ((mw >> r) & 1u) ? sa[r] : -INFINITY; x[4 + r] = ((mw >> (4 + r)) & 1u) ? sb[r] : -INFINITY; }
                float mx = fmaxf(fmaxf(fmaxf(x[0], x[1]), fmaxf(x[2], x[3])), fmaxf(fmaxf(x[4], x[5]), fmaxf(x[6], x[7])));
                mx = fmaxf(mx, shx<16>(mx)); mx = fmaxf(mx, shx<32>(mx));
                const float mnew = fmaxf(m, mx);
                const float msafe = (mnew == -INFINITY) ? 0.f : mnew;
                const float alpha = __expf(m - msafe);
                float pe[8]; float ps = 0.f;
#pragma unroll
                for (int j = 0; j < 8; ++j) { pe[j] = __expf(x[j] - msafe); ps += pe[j]; }
                lsum = lsum * alpha + ps;
                m = mnew;
#pragma unroll
                for (int i = 0; i < 8; ++i) { o[i][0] *= alpha; o[i][1] *= alpha; o[i][2] *= alpha; o[i][3] *= alpha; }
                union { bf16x8 v; unsigned u[4]; } pf;
                pf.u[0] = pack2(pe[0], pe[1]); pf.u[1] = pack2(pe[2], pe[3]); pf.u[2] = pack2(pe[4], pe[5]); pf.u[3] = pack2(pe[6], pe[7]);
#pragma unroll
                for (int i = 0; i < 8; ++i) {
                    const bf16x8 vf = *(const bf16x8*)(Vb + (i * 16 + fr) * VSTR + fq * 8);
                    o[i] = __builtin_amdgcn_mfma_f32_16x16x32_bf16(vf, pf.v, o[i], 0, 0, 0);
                }
            }
            if (more) { *(u32x4*)(Kl + ((st + 1) & 1) * 32 * KSTR + kr * KSTR + kc * 8) = rk; *(u32x4*)(Vl + ((st + 1) & 1) * 128 * VSTR + vd * VSTR + vc * 8) = rv; }
            __syncthreads();
        }
        lsum += shx<16>(lsum); lsum += shx<32>(lsum);
        const float inv = 1.f / lsum;
#pragma unroll
        for (int i = 0; i < 8; ++i) {
            uint2 ov; ov.x = pack2(o[i][0] * inv, o[i][1] * inv); ov.y = pack2(o[i][2] * inv, o[i][3] * inv);
            *(uint2*)(Y + trow * 1536 + 512 + h * 128 + i * 16 + 4 * fq) = ov;
        }
    }
}

constexpr int LDS_BYTES = 155648;
__device__ void ph_mixA(const Params& p, int l, int vb0, int nvb, char* smem_) {
    for (int item = vb0; item < 64; item += nvb) {
        if (item < 32) scan2_item<128, false>(p, l, item >> 2, item & 3, smem_);
        else scan2_item<64, true>(p, l, (item - 32) >> 2, (item - 32) & 3, smem_);
    }
    unsigned* ctr = (unsigned*)(p.ws + WS_CTL) + 3584 + l * 64;
    unsigned* done = (unsigned*)(p.ws + WS_CTL) + 5300 + l * 8 * 16;
    volatile int* slot = (volatile int*)(smem_ + LDS_BYTES - 64);
    for (;;) {
        if (TIDX() == 0) *slot = (int)atomicAdd(ctr, 1u);
        __syncthreads();
        const int idx = __builtin_amdgcn_readfirstlane(*slot);
        __syncthreads();
        if (idx >= 2048) break;
        if (idx < 1536) {
            const int b = idx / 192, r = idx % 192;
            if (r < 128) dsa_select_tile(p, b, 127 - r, smem_);
            else dsaprep2_item(p, l, b * 64 + (r - 128), smem_);
            asm volatile("s_waitcnt vmcnt(0)" ::: "memory");
            __syncthreads();
            if (TIDX() == 0) __hip_atomic_fetch_add(done + b * 16, 1u, __ATOMIC_RELAXED, __HIP_MEMORY_SCOPE_AGENT);
        } else {
            const int a = idx - 1536, b = a >> 6, h = (a >> 4) & 3, qg = 15 - (a & 15);
            if (TIDX() == 0) {
                unsigned spins = 0;
                while (__hip_atomic_load(done + b * 16, __ATOMIC_RELAXED, __HIP_MEMORY_SCOPE_AGENT) < 192u) { __builtin_amdgcn_s_sleep(2); if (++spins > (1u << 18)) break; }
                __builtin_amdgcn_fence(__ATOMIC_ACQUIRE, "agent");
                asm volatile("s_waitcnt vmcnt(0)" ::: "memory");
            }
            __syncthreads();
            dsa_attn_item(p, b, h, qg, smem_);
        }
    }
}

__device__ __forceinline__ int f2sort(float f) { int i = __float_as_int(f); return i ^ ((i >> 31) & 0x7fffffff); }
__device__ __forceinline__ float sort2f(int i) { return __int_as_float(i ^ ((i >> 31) & 0x7fffffff)); }
#define INSK(K, xv) do { int _x = (xv); \
    _Pragma("unroll") for (int _j = 0; _j < 16; ++_j) { int _hi = max(K[_j], _x); _x = min(K[_j], _x); K[_j] = _hi; } } while (0)
#define INS64(K, xv) do { unsigned long long _x = (xv); \
    _Pragma("unroll") for (int _j = 0; _j < 16; ++_j) { bool _c = _x > K[_j]; unsigned long long _o = K[_j]; K[_j] = _c ? _x : _o; _x = _c ? _o : _x; } } while (0)

#define CE32(x, y) do { const int _h = max(x, y); y = min(x, y); x = _h; } while (0)
#define CE64(x, y) do { const bool _c = (y) > (x); const unsigned long long _t = x; x = _c ? y : x; y = _c ? _t : y; } while (0)
#define SORT16_I(K) do { CE32(K[0], K[1]); CE32(K[2], K[3]); CE32(K[4], K[5]); CE32(K[6], K[7]); CE32(K[8], K[9]); CE32(K[10], K[11]); CE32(K[12], K[13]); CE32(K[14], K[15]); CE32(K[0], K[2]); CE32(K[1], K[3]); CE32(K[4], K[6]); CE32(K[5], K[7]); CE32(K[8], K[10]); CE32(K[9], K[11]); CE32(K[12], K[14]); CE32(K[13], K[15]); CE32(K[1], K[2]); CE32(K[5], K[6]); CE32(K[9], K[10]); CE32(K[13], K[14]); CE32(K[0], K[4]); CE32(K[1], K[5]); CE32(K[2], K[6]); CE32(K[3], K[7]); CE32(K[8], K[12]); CE32(K[9], K[13]); CE32(K[10], K[14]); CE32(K[11], K[15]); CE32(K[2], K[4]); CE32(K[3], K[5]); CE32(K[10], K[12]); CE32(K[11], K[13]); CE32(K[1], K[2]); CE32(K[3], K[4]); CE32(K[5], K[6]); CE32(K[9], K[10]); CE32(K[11], K[12]); CE32(K[13], K[14]); CE32(K[0], K[8]); CE32(K[1], K[9]); CE32(K[2], K[10]); CE32(K[3], K[11]); CE32(K[4], K[12]); CE32(K[5], K[13]); CE32(K[6], K[14]); CE32(K[7], K[15]); CE32(K[4], K[8]); CE32(K[5], K[9]); CE32(K[6], K[10]); CE32(K[7], K[11]); CE32(K[2], K[4]); CE32(K[3], K[5]); CE32(K[6], K[8]); CE32(K[7], K[9]); CE32(K[10], K[12]); CE32(K[11], K[13]); CE32(K[1], K[2]); CE32(K[3], K[4]); CE32(K[5], K[6]); CE32(K[7], K[8]); CE32(K[9], K[10]); CE32(K[11], K[12]); CE32(K[13], K[14]); } while (0)
#define BITONIC16_I(K) do { CE32(K[0], K[8]); CE32(K[1], K[9]); CE32(K[2], K[10]); CE32(K[3], K[11]); CE32(K[4], K[12]); CE32(K[5], K[13]); CE32(K[6], K[14]); CE32(K[7], K[15]); CE32(K[0], K[4]); CE32(K[1], K[5]); CE32(K[2], K[6]); CE32(K[3], K[7]); CE32(K[8], K[12]); CE32(K[9], K[13]); CE32(K[10], K[14]); CE32(K[11], K[15]); CE32(K[0], K[2]); CE32(K[1], K[3]); CE32(K[4], K[6]); CE32(K[5], K[7]); CE32(K[8], K[10]); CE32(K[9], K[11]); CE32(K[12], K[14]); CE32(K[13], K[15]); CE32(K[0], K[1]); CE32(K[2], K[3]); CE32(K[4], K[5]); CE32(K[6], K[7]); CE32(K[8], K[9]); CE32(K[10], K[11]); CE32(K[12], K[13]); CE32(K[14], K[15]); } while (0)
#define SORT16_L(K) do { CE64(K[0], K[1]); CE64(K[2], K[3]); CE64(K[4], K[5]); CE64(K[6], K[7]); CE64(K[8], K[9]); CE64(K[10], K[11]); CE64(K[12], K[13]); CE64(K[14], K[15]); CE64(K[0], K[2]); CE64(K[1], K[3]); CE64(K[4], K[6]); CE64(K[5], K[7]); CE64(K[8], K[10]); CE64(K[9], K[11]); CE64(K[12], K[14]); CE64(K[13], K[15]); CE64(K[1], K[2]); CE64(K[5], K[6]); CE64(K[9], K[10]); CE64(K[13], K[14]); CE64(K[0], K[4]); CE64(K[1], K[5]); CE64(K[2], K[6]); CE64(K[3], K[7]); CE64(K[8], K[12]); CE64(K[9], K[13]); CE64(K[10], K[14]); CE64(K[11], K[15]); CE64(K[2], K[4]); CE64(K[3], K[5]); CE64(K[10], K[12]); CE64(K[11], K[13]); CE64(K[1], K[2]); CE64(K[3], K[4]); CE64(K[5], K[6]); CE64(K[9], K[10]); CE64(K[11], K[12]); CE64(K[13], K[14]); CE64(K[0], K[8]); CE64(K[1], K[9]); CE64(K[2], K[10]); CE64(K[3], K[11]); CE64(K[4], K[12]); CE64(K[5], K[13]); CE64(K[6], K[14]); CE64(K[7], K[15]); CE64(K[4], K[8]); CE64(K[5], K[9]); CE64(K[6], K[10]); CE64(K[7], K[11]); CE64(K[2], K[4]); CE64(K[3], K[5]); CE64(K[6], K[8]); CE64(K[7], K[9]); CE64(K[10], K[12]); CE64(K[11], K[13]); CE64(K[1], K[2]); CE64(K[3], K[4]); CE64(K[5], K[6]); CE64(K[7], K[8]); CE64(K[9], K[10]); CE64(K[11], K[12]); CE64(K[13], K[14]); } while (0)
#define BITONIC16_L(K) do { CE64(K[0], K[8]); CE64(K[1], K[9]); CE64(K[2], K[10]); CE64(K[3], K[11]); CE64(K[4], K[12]); CE64(K[5], K[13]); CE64(K[6], K[14]); CE64(K[7], K[15]); CE64(K[0], K[4]); CE64(K[1], K[5]); CE64(K[2], K[6]); CE64(K[3], K[7]); CE64(K[8], K[12]); CE64(K[9], K[13]); CE64(K[10], K[14]); CE64(K[11], K[15]); CE64(K[0], K[2]); CE64(K[1], K[3]); CE64(K[4], K[6]); CE64(K[5], K[7]); CE64(K[8], K[10]); CE64(K[9], K[11]); CE64(K[12], K[14]); CE64(K[13], K[15]); CE64(K[0], K[1]); CE64(K[2], K[3]); CE64(K[4], K[5]); CE64(K[6], K[7]); CE64(K[8], K[9]); CE64(K[10], K[11]); CE64(K[12], K[13]); CE64(K[14], K[15]); } while (0)
#define TOP16_I(R, G) do { _Pragma("unroll") for (int _j = 0; _j < 16; ++_j) R[_j] = max(R[_j], G[15 - _j]); BITONIC16_I(R); } while (0)
#define TOP16_L(R, G) do { _Pragma("unroll") for (int _j = 0; _j < 16; ++_j) R[_j] = (G[15 - _j] > R[_j]) ? G[15 - _j] : R[_j]; BITONIC16_L(R); } while (0)
__device__ void ph_route(const Params& p, int vb0, int nvb, char* smem_) {
    typedef _Float16 h8 __attribute__((ext_vector_type(8)));
    const _Float16* SC = (const _Float16*)(p.ws + WS_SC);
    int* RI = (int*)(p.ws + WS_RI); float* RG = (float*)(p.ws + WS_RG);
    const int tid = TIDX(), lane = tid & 63, wave = tid >> 6;
    _Float16* tile = (_Float16*)smem_ + wave * (64 * 72);
    for (int item0 = (vb0 * 8 + wave) * 64; item0 < T_TOK * 8; item0 += nvb * 8 * 64) {
        const int item = item0 + lane;
        const int t = item >> 3, h = item & 7;
        const _Float16* s0 = SC + (size_t)t * 2048 + h * 256;
        const _Float16* wbase = SC + (size_t)item0 * 256;
        int k0[16], k1[16];
#pragma unroll
        for (int j = 0; j < 16; ++j) { k0[j] = (int)0x80000000; k1[j] = (int)0x80000000; }
#pragma unroll 1
        for (int slab = 0; slab < 4; ++slab) {
            h8 ld[8];
#pragma unroll
            for (int j = 0; j < 4; ++j) {
                const _Float16* src = wbase + (size_t)(16 * j + (lane >> 2)) * 256 + slab * 32 + (lane & 3) * 8;
                ld[j] = *(const h8*)src; ld[4 + j] = *(const h8*)(src + 128);
            }
            __builtin_amdgcn_wave_barrier();
#pragma unroll
            for (int j = 0; j < 4; ++j) {
                _Float16* dst = tile + (16 * j + (lane >> 2)) * 72 + (lane & 3) * 8;
                *(h8*)dst = ld[j]; *(h8*)(dst + 32) = ld[4 + j];
            }
            __builtin_amdgcn_fence(__ATOMIC_RELEASE, "wavefront");
            __builtin_amdgcn_wave_barrier();
            __builtin_amdgcn_fence(__ATOMIC_ACQUIRE, "wavefront");
#pragma unroll
            for (int ii = 0; ii < 32; ii += 16) {
                const int i = slab * 32 + ii;
                const h8 a0 = *(const h8*)(tile + lane * 72 + ii), a1 = *(const h8*)(tile + lane * 72 + ii + 8);
                const h8 b0 = *(const h8*)(tile + lane * 72 + 32 + ii), b1 = *(const h8*)(tile + lane * 72 + 32 + ii + 8);
                int ga[16], gb[16];
#pragma unroll
                for (int e_ = 0; e_ < 8; ++e_) {
                    ga[e_] = (f2sort((float)a0[e_]) & ~127) | (127 - i - e_); ga[8 + e_] = (f2sort((float)a1[e_]) & ~127) | (127 - i - 8 - e_);
                    gb[e_] = (f2sort((float)b0[e_]) & ~127) | (127 - i - e_); gb[8 + e_] = (f2sort((float)b1[e_]) & ~127) | (127 - i - 8 - e_);
                }
                SORT16_I(ga); TOP16_I(k0, ga);
                SORT16_I(gb); TOP16_I(k1, gb);
            }
            __builtin_amdgcn_wave_barrier();
        }
        float v0[16], v1[16];
#pragma unroll
        for (int j = 0; j < 16; ++j) { k0[j] = 127 - (k0[j] & 127); k1[j] = 127 - (k1[j] & 127); v0[j] = (float)s0[k0[j]]; v1[j] = (float)s0[128 + k1[j]]; }
#define CAND(a, b) ((((unsigned long long)((unsigned)f2sort(v0[a] + v1[b]) ^ 0x80000000u)) << 32) | (((unsigned)(255 - ((a) * 16 + (b))) << 16) | (unsigned)(k0[a] * 128 + k1[b])))
        unsigned long long ck[16], m1[16], m2[16];
#pragma unroll
        for (int j = 0; j < 16; ++j) ck[j] = CAND(0, j);
#pragma unroll
        for (int j = 0; j < 8; ++j) { m1[j] = CAND(1, j); m1[8 + j] = CAND(15 - j, 0); }
        BITONIC16_L(m1);
        m2[0] = CAND(2, 0); m2[1] = CAND(2, 1); m2[2] = CAND(2, 2); m2[3] = CAND(2, 3); m2[4] = CAND(2, 4);
        m2[5] = CAND(3, 0); m2[6] = CAND(3, 1); m2[7] = CAND(3, 2); m2[8] = CAND(3, 3);
        m2[9] = CAND(4, 0); m2[10] = CAND(4, 1); m2[11] = CAND(4, 2);
        m2[12] = CAND(5, 0); m2[13] = CAND(5, 1); m2[14] = CAND(6, 0); m2[15] = CAND(6, 1);
        SORT16_L(m2);
        TOP16_L(ck, m1);
        TOP16_L(ck, m2);
        INS64(ck, CAND(7, 0)); INS64(ck, CAND(7, 1));
#undef CAND
        float e[16]; float sm = 0.f;
        const float mx = sort2f((int)((unsigned)(ck[0] >> 32) ^ 0x80000000u));
#pragma unroll
        for (int j = 0; j < 16; ++j) { e[j] = expf(sort2f((int)((unsigned)(ck[j] >> 32) ^ 0x80000000u)) - mx); sm += e[j]; }
        const float inv = 1.f / sm;
#pragma unroll
        for (int j = 0; j < 16; j += 4) {
            *(int4*)(RI + (size_t)t * 128 + h * 16 + j) = make_int4((int)(ck[j] & 0xffffu), (int)(ck[j + 1] & 0xffffu), (int)(ck[j + 2] & 0xffffu), (int)(ck[j + 3] & 0xffffu));
            *(float4*)(RG + (size_t)t * 128 + h * 16 + j) = make_float4(e[j] * inv, e[j + 1] * inv, e[j + 2] * inv, e[j + 3] * inv);
        }
    }
}

__device__ __forceinline__ void fp8x16_to_f32(const uint4 q, float (&f)[16]) {
    const unsigned w[4] = {q.x, q.y, q.z, q.w};
#pragma unroll
    for (int c = 0; c < 4; ++c) {
        auto f0 = __builtin_amdgcn_cvt_pk_f32_fp8((int)w[c], false); auto f1 = __builtin_amdgcn_cvt_pk_f32_fp8((int)w[c], true);
        f[4 * c] = f0[0]; f[4 * c + 1] = f0[1]; f[4 * c + 2] = f1[0]; f[4 * c + 3] = f1[1];
    }
}
constexpr bool G2_MFMA = true;
constexpr bool G1_MFMA = true;
typedef float f32x2_t __attribute__((ext_vector_type(2)));
__device__ __forceinline__ float g1_half(const u32x4 (&uq)[8], const float (&hv)[16], int lane) {
    float part[8];
#pragma unroll
    for (int it = 0; it < 8; ++it) {
        f32x2_t d2 = {0.f, 0.f};
#pragma unroll
        for (int c_ = 0; c_ < 4; ++c_) {
            const f32x2_t f0 = __builtin_amdgcn_cvt_pk_f32_fp8((int)uq[it][c_], false), f1 = __builtin_amdgcn_cvt_pk_f32_fp8((int)uq[it][c_], true);
            d2 = __builtin_elementwise_fma(f32x2_t{hv[4 * c_], hv[4 * c_ + 1]}, f0, d2);
            d2 = __builtin_elementwise_fma(f32x2_t{hv[4 * c_ + 2], hv[4 * c_ + 3]}, f1, d2);
        }
        part[it] = d2[0] + d2[1];
    }
    float r4[4], r2[2];
    const bool b2_ = lane & 4, b1_ = lane & 2, b0_ = lane & 1;
#pragma unroll
    for (int j = 0; j < 4; ++j) { const float snd = b2_ ? part[j] : part[j + 4], kp = b2_ ? part[j + 4] : part[j]; r4[j] = kp + shx<4>(snd); }
#pragma unroll
    for (int j = 0; j < 2; ++j) { const float snd = b1_ ? r4[j] : r4[j + 2], kp = b1_ ? r4[j + 2] : r4[j]; r2[j] = kp + shx<2>(snd); }
    const float snd = b0_ ? r2[0] : r2[1], kp = b0_ ? r2[1] : r2[0];
    return kp + shx<1>(snd);
}
__device__ __forceinline__ void peer_gather8(u32x4 (&q)[8], const unsigned char* tab, const int* idx, unsigned l16) {
#pragma unroll
    for (int it = 0; it < 8; ++it) { const unsigned e_ = (unsigned)idx[it * 8]; q[it] = *(const u32x4*)(tab + ((e_ << 7) | l16)); }
}
template <bool PRE>
__device__ __forceinline__ void g1_step(int i, int t, const bf16_t* hrow_next, const unsigned char* ub, const int* lri_eg, unsigned l16, int lane, float* pp_row,
                                        u32x4& hq0, u32x4& hq1, u32x4 (&uqA)[8], u32x4 (&uqB)[8]) {
    float hv[16];
#pragma unroll
    for (int c_ = 0; c_ < 4; ++c_) { hv[2 * c_] = bflo(hq0[c_]); hv[2 * c_ + 1] = bfhi(hq0[c_]); hv[8 + 2 * c_] = bflo(hq1[c_]); hv[8 + 2 * c_ + 1] = bfhi(hq1[c_]); }
    if (PRE) { const u32x4* hp = (const u32x4*)hrow_next; hq0 = hp[0]; hq1 = hp[1]; }
    const float d0 = g1_half(uqA, hv, lane);
    __builtin_amdgcn_sched_barrier(0);
    if (PRE) { peer_gather8(uqA, ub, lri_eg + (i + 1) * 128, l16); __builtin_amdgcn_sched_barrier(0); }
    const float d1 = g1_half(uqB, hv, lane);
    __builtin_amdgcn_sched_barrier(0);
    if (PRE) { peer_gather8(uqB, ub, lri_eg + (i + 1) * 128 + 64, l16); __builtin_amdgcn_sched_barrier(0); }
    pp_row[0] = d0; pp_row[64] = d1;
}
template <bool PRE>
__device__ __forceinline__ void g2_step(int i, float2* op, const float2 gf, const unsigned char* vb_, const int* lri_eg, const float* lrg_eg, unsigned l16, int lane,
                                        u32x4 (&vqA)[8], u32x4 (&vqB)[8]) {
    const float2 xi = *op;
    f32x2_t y[8];
#pragma unroll
    for (int j = 0; j < 8; ++j) y[j] = f32x2_t{0.f, 0.f};
#pragma unroll
    for (int it = 0; it < 8; ++it) {
        const float ck = lrg_eg[i * 128 + it * 8]; const f32x2_t ck2 = {ck, ck};
#pragma unroll
        for (int c_ = 0; c_ < 4; ++c_) {
            y[2 * c_] = __builtin_elementwise_fma(ck2, __builtin_amdgcn_cvt_pk_f32_fp8((int)vqA[it][c_], false), y[2 * c_]);
            y[2 * c_ + 1] = __builtin_elementwise_fma(ck2, __builtin_amdgcn_cvt_pk_f32_fp8((int)vqA[it][c_], true), y[2 * c_ + 1]);
        }
    }
    __builtin_amdgcn_sched_barrier(0);
    if (PRE) { peer_gather8(vqA, vb_, lri_eg + (i + 1) * 128, l16); __builtin_amdgcn_sched_barrier(0); }
#pragma unroll
    for (int it = 0; it < 8; ++it) {
        const float ck = lrg_eg[i * 128 + 64 + it * 8]; const f32x2_t ck2 = {ck, ck};
#pragma unroll
        for (int c_ = 0; c_ < 4; ++c_) {
            y[2 * c_] = __builtin_elementwise_fma(ck2, __builtin_amdgcn_cvt_pk_f32_fp8((int)vqB[it][c_], false), y[2 * c_]);
            y[2 * c_ + 1] = __builtin_elementwise_fma(ck2, __builtin_amdgcn_cvt_pk_f32_fp8((int)vqB[it][c_], true), y[2 * c_ + 1]);
        }
    }
    __builtin_amdgcn_sched_barrier(0);
    if (PRE) { peer_gather8(vqB, vb_, lri_eg + (i + 1) * 128 + 64, l16); __builtin_amdgcn_sched_barrier(0); }
    float r8[8], r4[4], r2[2];
    const bool b5 = lane & 32, b4 = lane & 16, b3 = lane & 8;
#pragma unroll
    for (int j = 0; j < 8; ++j) { const float lo = y[j >> 1][j & 1], hi = y[4 + (j >> 1)][j & 1]; const float snd = b5 ? lo : hi, kp = b5 ? hi : lo; r8[j] = kp + shx<32>(snd); }
#pragma unroll
    for (int j = 0; j < 4; ++j) { const float snd = b4 ? r8[j] : r8[j + 4], kp = b4 ? r8[j + 4] : r8[j]; r4[j] = kp + shx<16>(snd); }
#pragma unroll
    for (int j = 0; j < 2; ++j) { const float snd = b3 ? r4[j] : r4[j + 2], kp = b3 ? r4[j + 2] : r4[j]; r2[j] = kp + shx<8>(snd); }
    *op = make_float2(xi.x + gf.x * r2[0], xi.y + gf.y * r2[1]);
}
typedef int i32x4_t __attribute__((ext_vector_type(4)));
typedef int i32x8_t __attribute__((ext_vector_type(8)));
constexpr int G1W = 18432;
__device__ __forceinline__ void g1m_dma(const unsigned char* ub, PG8_LAS unsigned char* img, const PG8_LAS unsigned short* idx, int i, int hh, int eg, unsigned q16) {
    const u32x4 w = *(const PG8_LAS u32x4*)(idx + ((i * 8 + eg) * 16 + hh * 8));
#pragma unroll
    for (int it = 0; it < 8; ++it) {
        const unsigned e_ = (it & 1) ? (w[it >> 1] >> 16) : (w[it >> 1] & 0xffffu);
        const unsigned off = (e_ << 7) | ((it & 1) ? (q16 ^ 64u) : q16);
        __builtin_amdgcn_global_load_lds((const unsigned*)(ub + off), (PG8_LAS unsigned*)(img + it * 1024), 16, 0, 0);
    }
}
template <bool PRE, int VMW>
__device__ __forceinline__ float g1m_step(const unsigned char* ub, PG8_LAS unsigned char* img, const PG8_LAS unsigned short* idx, int inext, int hh, int eg, unsigned q16,
                                          unsigned rdoff, int lane, const u32x4 a0, const u32x4 a1) {
    asm volatile("s_waitcnt vmcnt(%0)" :: "n"(VMW) : "memory");
    i32x8_t b[4];
#pragma unroll
    for (int mb = 0; mb < 4; ++mb) {
        const unsigned ro = (unsigned)mb * 2048u + rdoff;
        const i32x4_t lo = *(const PG8_LAS i32x4_t*)(img + ro), hi = *(const PG8_LAS i32x4_t*)(img + (ro ^ 64u));
        b[mb] = __builtin_shufflevector(lo, hi, 0, 1, 2, 3, 4, 5, 6, 7);
    }
    asm volatile("s_waitcnt lgkmcnt(0)" ::: "memory");
    if (PRE) g1m_dma(ub, img, idx, inext, hh, eg, q16);
    const i32x8_t a = __builtin_shufflevector((i32x4_t)a0, (i32x4_t)a1, 0, 1, 2, 3, 4, 5, 6, 7);
    float d[4]; f32x4 acc[4];
#pragma unroll
    for (int mb = 0; mb < 4; ++mb) acc[mb] = __builtin_amdgcn_mfma_scale_f32_16x16x128_f8f6f4(a, b[mb], f32x4{0.f, 0.f, 0.f, 0.f}, 0, 0, 0, 0x7f, 0, 0x7f);
#pragma unroll
    for (int mb = 0; mb < 4; ++mb) { d[mb] = acc[mb][0] + acc[mb][1] * (1.f / 16.f); asm volatile("" : "+v"(d[mb])); }
    const int g = lane >> 4;
    return g == 0 ? d[0] : g == 1 ? d[1] : g == 2 ? d[2] : d[3];
}
__device__ __forceinline__ void g1m_chunk(const Params& p, int x, int tb, char* smem_, int lane) {
    PG8_LAS unsigned char* wl = (PG8_LAS unsigned char*)smem_ + p.wv * G1W;
    PG8_LAS unsigned short* idx = (PG8_LAS unsigned short*)(wl + 16384);
    const int* RI = (const int*)(p.ws + WS_RI);
    {
        int ra[16];
#pragma unroll
        for (int i = 0; i < 8; ++i) { ra[2 * i] = RI[(size_t)(tb + i) * 128 + lane]; ra[2 * i + 1] = RI[(size_t)(tb + i) * 128 + 64 + lane]; }
#pragma unroll
        for (int i = 0; i < 8; ++i) {
            idx[(i * 8 + (lane & 7)) * 16 + (lane >> 3)] = (unsigned short)ra[2 * i];
            idx[(i * 8 + (lane & 7)) * 16 + 8 + (lane >> 3)] = (unsigned short)ra[2 * i + 1];
        }
    }
    __builtin_amdgcn_fence(__ATOMIC_RELEASE, "wavefront");
    __builtin_amdgcn_wave_barrier();
    __builtin_amdgcn_fence(__ATOMIC_ACQUIRE, "wavefront");
    const int eg = lane >> 3, n = lane & 15, kb = lane >> 4;
    const unsigned q16 = (unsigned)(((lane & 7) ^ (eg >> 1)) * 16);
    const unsigned rdoff = (unsigned)(n * 128 + ((kb ^ (n >> 1)) * 16));
    const unsigned char* ub = p.ws + WS_PU + (size_t)x * (16384u * 128u);
    const unsigned char* h8 = p.ws + ((lane & 1) ? WS_H8L : WS_H8H) + (size_t)tb * 1024 + x * 128 + kb * 16;
    float* pp = (float*)(p.ws + WS_PP) + ((size_t)x * T_TOK + tb) * 128 + lane;
    u32x4 ha[8][2];
#pragma unroll
    for (int i = 0; i < 8; ++i) { ha[i][0] = *(const u32x4*)(h8 + (size_t)i * 1024); ha[i][1] = *(const u32x4*)(h8 + (size_t)i * 1024 + 64); }
#pragma unroll
    for (int i = 0; i < 8; ++i) { asm volatile("" : "+v"(ha[i][0])); asm volatile("" : "+v"(ha[i][1])); }
    g1m_dma(ub, wl, idx, 0, 0, eg, q16);
    g1m_dma(ub, wl + 8192, idx, 0, 1, eg, q16);
    asm volatile("s_waitcnt vmcnt(8)" ::: "memory");
#pragma unroll
    for (int i = 0; i < 7; ++i) {
        const float v0 = g1m_step<true, 9>(ub, wl, idx, i + 1, 0, eg, q16, rdoff, lane, ha[i][0], ha[i][1]);
        pp[(size_t)i * 128] = v0;
        const float v1 = g1m_step<true, 9>(ub, wl + 8192, idx, i + 1, 1, eg, q16, rdoff, lane, ha[i][0], ha[i][1]);
        pp[(size_t)i * 128 + 64] = v1;
    }
    {
        const float v0 = g1m_step<false, 9>(ub, wl, idx, 0, 0, eg, q16, rdoff, lane, ha[7][0], ha[7][1]);
        pp[(size_t)7 * 128] = v0;
        const float v1 = g1m_step<false, 0>(ub, wl + 8192, idx, 0, 1, eg, q16, rdoff, lane, ha[7][0], ha[7][1]);
        pp[(size_t)7 * 128 + 64] = v1;
    }
}
typedef int i32x2_t __attribute__((ext_vector_type(2)));
template <bool PRE, int VMW, int HH>
__device__ __forceinline__ void g2m_step(const unsigned char* vb_, PG8_LAS unsigned char* img, const PG8_LAS unsigned short* idx, int inext, int eg, unsigned q16,
                                         const unsigned (&tra)[8], const long a0, const long a1, f32x4 (&acc)[8]) {
    asm volatile("s_waitcnt vmcnt(%0)" :: "n"(VMW) : "memory");
    long b[2][8];
#pragma unroll
    for (int u = 0; u < 2; ++u)
#pragma unroll
        for (int j = 0; j < 8; ++j) asm volatile("ds_read_b64_tr_b8 %0, %1 offset:%2" : "=v"(b[u][j]) : "v"(tra[j]), "n"(HH * 8192 + u * 4096) : "memory");
    asm volatile("s_waitcnt lgkmcnt(0)" : "+v"(b[0][0]), "+v"(b[0][1]), "+v"(b[0][2]), "+v"(b[0][3]), "+v"(b[0][4]), "+v"(b[0][5]), "+v"(b[0][6]), "+v"(b[0][7]) :: "memory");
    asm volatile("" : "+v"(b[1][0]), "+v"(b[1][1]), "+v"(b[1][2]), "+v"(b[1][3]), "+v"(b[1][4]), "+v"(b[1][5]), "+v"(b[1][6]), "+v"(b[1][7]) :: "memory");
    if (PRE) { g1m_dma(vb_, img + HH * 8192, idx, inext, HH, eg, q16); __builtin_amdgcn_sched_barrier(0); }
#pragma unroll
    for (int j = 0; j < 8; ++j) {
        acc[j] = __builtin_amdgcn_mfma_f32_16x16x32_fp8_fp8(a0, b[0][j], acc[j], 0, 0, 0);
        acc[j] = __builtin_amdgcn_mfma_f32_16x16x32_fp8_fp8(a1, b[1][j], acc[j], 0, 0, 0);
    }
}
__device__ __forceinline__ void g2m_chunk(const Params& p, int l, int x, int tb, char* smem_, int lane) {
    PG8_LAS unsigned char* wl = (PG8_LAS unsigned char*)smem_ + p.wv * G1W;
    PG8_LAS unsigned short* idx = (PG8_LAS unsigned short*)(wl + 16384);
    const int* RI = (const int*)(p.ws + WS_RI);
    {
        int ra[16];
#pragma unroll
        for (int i = 0; i < 8; ++i) { ra[2 * i] = RI[(size_t)(tb + i) * 128 + lane]; ra[2 * i + 1] = RI[(size_t)(tb + i) * 128 + 64 + lane]; }
#pragma unroll
        for (int i = 0; i < 8; ++i) {
            idx[(i * 8 + (lane & 7)) * 16 + (lane >> 3)] = (unsigned short)ra[2 * i];
            idx[(i * 8 + (lane & 7)) * 16 + 8 + (lane >> 3)] = (unsigned short)ra[2 * i + 1];
        }
    }
    __builtin_amdgcn_fence(__ATOMIC_RELEASE, "wavefront");
    __builtin_amdgcn_wave_barrier();
    __builtin_amdgcn_fence(__ATOMIC_ACQUIRE, "wavefront");
    const int eg = lane >> 3, kb = lane >> 4, li = lane & 15, q = li >> 1;
    const unsigned q16 = (unsigned)(((lane & 7) ^ (eg >> 1)) * 16);
    const int n16 = (kb & 1) * 8 + q;
    const unsigned trbase = (unsigned)((kb * 8 + q) * 128 + ((n16 >> 1) & 7) * 16 + (li & 1) * 8);
    const unsigned char* vb_ = p.ws + WS_PV + (size_t)x * (16384u * 128u);
    float* op = p.out + (size_t)tb * 1024 + x * 128 + lane;
    const float* modr = (const float*)(p.ws + WS_MOD) + (size_t)(l * 8 + (tb >> 11)) * 6144 + 5120 + x * 128 + lane;
    float gf0 = modr[0], gf1 = modr[64];
    const unsigned char* c8 = p.ws + ((lane & 1) ? WS_C8L : WS_C8H) + (size_t)tb * 128 + kb * 32;
    u32x4 ca[8][2]; float xi[8][2], cinv[8];
#pragma unroll
    for (int i = 0; i < 8; ++i) {
        ca[i][0] = *(const u32x4*)(c8 + (size_t)i * 128); ca[i][1] = *(const u32x4*)(c8 + (size_t)i * 128 + 16);
        xi[i][0] = op[(size_t)i * 1024]; xi[i][1] = op[(size_t)i * 1024 + 64];
        cinv[i] = ((const float*)(p.ws + WS_CINV))[tb + i];
    }
#pragma unroll
    for (int i = 0; i < 8; ++i) { asm volatile("" : "+v"(ca[i][0])); asm volatile("" : "+v"(ca[i][1])); asm volatile("" : "+v"(xi[i][0]), "+v"(xi[i][1]), "+v"(cinv[i])); }
    asm volatile("" : "+v"(gf0), "+v"(gf1));
    g1m_dma(vb_, wl, idx, 0, 0, eg, q16);
    g1m_dma(vb_, wl + 8192, idx, 0, 1, eg, q16);
    asm volatile("s_waitcnt vmcnt(8)" ::: "memory");
    const int g = lane >> 4;
    unsigned tra[8];
#pragma unroll
    for (int j = 0; j < 8; ++j) tra[j] = (unsigned)(unsigned long)wl + (trbase ^ (unsigned)(j * 16));
#define G2M_TOKEN(i, PRE_, W0, W1) do { \
        f32x4 acc[8]; \
        _Pragma("unroll") for (int j = 0; j < 8; ++j) acc[j] = f32x4{0.f, 0.f, 0.f, 0.f}; \
        const long a00 = (long)(((unsigned long long)ca[i][0][1] << 32) | ca[i][0][0]), a01 = (long)(((unsigned long long)ca[i][0][3] << 32) | ca[i][0][2]); \
        const long a10 = (long)(((unsigned long long)ca[i][1][1] << 32) | ca[i][1][0]), a11 = (long)(((unsigned long long)ca[i][1][3] << 32) | ca[i][1][2]); \
        g2m_step<PRE_, W0, 0>(vb_, wl, idx, (i) + 1, eg, q16, tra, a00, a01, acc); \
        g2m_step<PRE_, W1, 1>(vb_, wl, idx, (i) + 1, eg, q16, tra, a10, a11, acc); \
        float y[8]; \
        _Pragma("unroll") for (int j = 0; j < 8; ++j) { y[j] = acc[j][0] + acc[j][1] * (1.f / 16.f); asm volatile("" : "+v"(y[j])); } \
        const float ya = g == 0 ? y[0] : g == 1 ? y[1] : g == 2 ? y[2] : y[3], yb = g == 0 ? y[4] : g == 1 ? y[5] : g == 2 ? y[6] : y[7]; \
        op[(size_t)(i) * 1024] = xi[i][0] + gf0 * (ya * cinv[i]); op[(size_t)(i) * 1024 + 64] = xi[i][1] + gf1 * (yb * cinv[i]); \
        __builtin_amdgcn_sched_barrier(0); } while (0)
    G2M_TOKEN(0, true, 10, 8);
    G2M_TOKEN(1, true, 10, 10); G2M_TOKEN(2, true, 10, 10); G2M_TOKEN(3, true, 10, 10);
    G2M_TOKEN(4, true, 10, 10); G2M_TOKEN(5, true, 10, 10); G2M_TOKEN(6, true, 10, 10);
    G2M_TOKEN(7, false, 10, 0);
#undef G2M_TOKEN
}
template <int WHICH>
__device__ void ph_peer_sliced(const Params& p, int l, char* smem_) {
    const int tid = TIDX(), wave = tid >> 6;
    const bf16_t* H = (const bf16_t*)(p.ws + WS_H); const unsigned char* PU = p.ws + WS_PU; const unsigned char* PV = p.ws + WS_PV;
    const int* RI = (const int*)(p.ws + WS_RI); float* RG = (float*)(p.ws + WS_RG); float* PP = (float*)(p.ws + WS_PP);
    const float* modb = (const float*)(p.ws + WS_MOD);
    {
    unsigned* ctr = (unsigned*)(p.ws + WS_CTL) + 3712 + (l * 2 + WHICH) * 128;
    volatile int* slot = (volatile int*)(smem_ + LDS_BYTES - 64);
    const int xcc = (int)(xb_xcc_id() & 7u);
    for (int so = 0; so < 8; ++so) {
        const int x = (xcc + so) & 7;
        for (;;) {
            if (tid == 0) *slot = (int)atomicAdd(ctr + x * 16, 1u);
            __syncthreads();
            const int chunk = __builtin_amdgcn_readfirstlane(*slot);
            __syncthreads();
            if (chunk >= 256) break;
            {
                const int lane = lane_id_opaque(), eg = lane >> 3, ll = lane & 7;
                const int tb = chunk * 64 + wave * 8;
                if (WHICH == 0 && G1_MFMA) { g1m_chunk(p, x, tb, smem_, lane); continue; }
                if (WHICH == 1 && G2_MFMA) { g2m_chunk(p, l, x, tb, smem_, lane); continue; }
                int* lri = (int*)smem_ + wave * 2048; float* lrg = (float*)(lri + 1024);
                {
                    int ra[16]; float rg_[16];
#pragma unroll
                    for (int i = 0; i < 8; ++i) {
                        ra[2 * i] = RI[(size_t)(tb + i) * 128 + lane]; ra[2 * i + 1] = RI[(size_t)(tb + i) * 128 + 64 + lane];
                        if (WHICH == 1) { rg_[2 * i] = RG[(size_t)(tb + i) * 128 + lane]; rg_[2 * i + 1] = RG[(size_t)(tb + i) * 128 + 64 + lane]; }
                    }
#pragma unroll
                    for (int i = 0; i < 8; ++i) {
                        lri[i * 128 + lane] = ra[2 * i]; lri[i * 128 + 64 + lane] = ra[2 * i + 1];
                        if (WHICH == 1) { lrg[i * 128 + lane] = rg_[2 * i]; lrg[i * 128 + 64 + lane] = rg_[2 * i + 1]; }
                    }
                }
                __builtin_amdgcn_fence(__ATOMIC_RELEASE, "wavefront");
                __builtin_amdgcn_wave_barrier();
                __builtin_amdgcn_fence(__ATOMIC_ACQUIRE, "wavefront");
                const unsigned l16 = (unsigned)ll * 16u;
                if (WHICH == 0) {
                    const unsigned char* ub = PU + (size_t)x * (16384u * 128u);
                    const bf16_t* hrow = H + (size_t)tb * 1024 + x * 128 + ll * 16;
                    float* pp_row = PP + ((size_t)x * T_TOK + tb) * 128 + ll * 8 + eg;
                    u32x4 hq0 = ((const u32x4*)hrow)[0], hq1 = ((const u32x4*)hrow)[1], uqA[8], uqB[8];
                    peer_gather8(uqA, ub, lri + eg, l16);
                    peer_gather8(uqB, ub, lri + eg + 64, l16);
#pragma unroll 1
                    for (int i = 0; i < 7; ++i) g1_step<true>(i, tb + i, hrow + (size_t)(i + 1) * 1024, ub, lri + eg, l16, lane, pp_row + (size_t)i * 128, hq0, hq1, uqA, uqB);
                    g1_step<false>(7, tb + 7, hrow, ub, lri + eg, l16, lane, pp_row + (size_t)7 * 128, hq0, hq1, uqA, uqB);
                } else {
                    const unsigned char* vb_ = PV + (size_t)x * (16384u * 128u);
                    const int col = x * 128 + ll * 16 + ((lane >> 5) & 1) * 8 + ((lane >> 4) & 1) * 4 + ((lane >> 3) & 1) * 2;
                    const float2 gf = *(const float2*)(modb + (size_t)(l * 8 + (tb >> 11)) * 6144 + 5120 + col);
                    float2* op = (float2*)(p.out + (size_t)tb * 1024 + col);
                    u32x4 vqA[8], vqB[8];
                    peer_gather8(vqA, vb_, lri + eg, l16);
                    peer_gather8(vqB, vb_, lri + eg + 64, l16);
#pragma unroll 1
                    for (int i = 0; i < 7; ++i) g2_step<true>(i, op + (size_t)i * 512, gf, vb_, lri + eg, lrg + eg, l16, lane, vqA, vqB);
                    g2_step<false>(7, op + (size_t)7 * 512, gf, vb_, lri + eg, lrg + eg, l16, lane, vqA, vqB);
                }
            }
        }
    }
    __syncthreads();
    }
}
__device__ void ph_peer_coef(const Params& p, int vb0, int nvb) {
    const int wave = TIDX() >> 6, lane = TIDX() & 63;
    float* RG = (float*)(p.ws + WS_RG); const float* PP = (const float*)(p.ws + WS_PP);
    for (int t0 = (vb0 * 8 + wave) * 2; t0 < T_TOK; t0 += nvb * 8 * 2) {
        float pp[2][2][8], g[2][2];
#pragma unroll
        for (int u = 0; u < 2; ++u)
#pragma unroll
            for (int half = 0; half < 2; ++half) {
                const int k = half * 64 + lane;
#pragma unroll
                for (int x = 0; x < 8; ++x) pp[u][half][x] = PP[((size_t)x * T_TOK + t0 + u) * 128 + k];
                g[u][half] = RG[(size_t)(t0 + u) * 128 + k];
            }
        asm volatile("" ::: "memory");
#pragma unroll
        for (int u = 0; u < 2; ++u) {
            float cf[2];
#pragma unroll
            for (int half = 0; half < 2; ++half) {
                float d = 0.f;
#pragma unroll
                for (int x = 0; x < 8; ++x) d += pp[u][half][x];
                d *= (1.f / PU_SCALE);
                cf[half] = g[u][half] * 0.5f * d * (1.f + erff(d * 0.7071067811865476f)) * (1.f / PV_SCALE);
                if (!G2_MFMA) RG[(size_t)(t0 + u) * 128 + half * 64 + lane] = cf[half];
            }
            if (G2_MFMA) {
                const float m = wave_max(fmaxf(fabsf(cf[0]), fabsf(cf[1])));
                const float sc = m > 0.f ? 240.f / m : 0.f;
                const float c0 = cf[0] * sc, c1 = cf[1] * sc;
                const int hi = __builtin_amdgcn_cvt_pk_fp8_f32(c0, c1, 0, false);
                const auto bk = __builtin_amdgcn_cvt_pk_f32_fp8(hi, false);
                const int lo = __builtin_amdgcn_cvt_pk_fp8_f32((c0 - bk[0]) * 16.f, (c1 - bk[1]) * 16.f, 0, false);
                unsigned char* c8h = p.ws + WS_C8H + (size_t)(t0 + u) * 128; unsigned char* c8l = p.ws + WS_C8L + (size_t)(t0 + u) * 128;
                const int s0 = ((lane >> 3) & 3) * 32 + (lane >> 5) * 8 + (lane & 7);
                c8h[s0] = (unsigned char)(hi & 0xff); c8h[s0 + 16] = (unsigned char)((hi >> 8) & 0xff);
                c8l[s0] = (unsigned char)(lo & 0xff); c8l[s0 + 16] = (unsigned char)((lo >> 8) & 0xff);
                if (lane == 0) ((float*)(p.ws + WS_CINV))[t0 + u] = m * (1.f / 240.f);
            }
        }
    }
}

enum { PH_MOD = 0, PH_WPREP, PH_NORM1, PH_GEMM_IN, PH_SCAN, PH_MERGE, PH_OUT, PH_NORM2, PH_GEMM_Q, PH_GEMM_SC, PH_ROUTE, PH_G1, PH_G15, PH_G2 };

template <int PH>
__device__ __forceinline__ void run_phase(const Params& p, int l, int vb0, int nvb, char* smem) {
    const float* xin = (l == 0) ? p.x : p.out;
    if (PH == PH_MOD) ph_mod(p, vb0, nvb, smem);
    else if (PH == PH_WPREP) ph_wprep(p, l, vb0, nvb, smem);
    else if (PH == PH_NORM1) ph_norm(p, l, 0, xin, vb0, nvb);
    else if (PH == PH_GEMM_IN) {
        pg8::Gemm g{(const bf16_t*)(p.ws + WS_H), (const bf16_t*)(p.ws + WS_WIN), 1024, 1024, 1024};
        pg8::StaticOrder S; S.init(T_TOK, LDZ, nvb, vb0, 1024, 1024);
        pg8::gemm_phase(( PG8_LAS unsigned char*)smem, g, S, pg8::EpiBf16{(bf16_t*)(p.ws + WS_Z), LDZ}, TIDX());
    }
    else if (PH == PH_SCAN) ph_mixA(p, l, vb0, nvb, smem);
    else if (PH == PH_MERGE) {
        pg8::Gemm g{(const bf16_t*)(p.ws + WS_Y), (const bf16_t*)(p.ws + WS_WBR), 1536, 512, 512};
        pg8::MergeOrder S{vb0, nvb};
        pg8::gemm_phase((PG8_LAS unsigned char*)smem, g, S, pg8::EpiMerge{(bf16_t*)(p.ws + WS_H), (const bf16_t*)(p.ws + WS_Z)}, TIDX());
    }
    else if (PH == PH_OUT) {
        pg8::Gemm g{(const bf16_t*)(p.ws + WS_H), (const bf16_t*)(p.ws + WS_WOUT), 1024, 1024, 1024};
        pg8::StaticOrder S; S.init(T_TOK, 1024, nvb, vb0, 1024, 1024);
        pg8::gemm_phase((PG8_LAS unsigned char*)smem, g, S, pg8::EpiResid{xin, p.out, (const float*)(p.ws + WS_MOD) + (size_t)l * 8 * 6144}, TIDX());
    }
    else if (PH == PH_NORM2) ph_norm(p, l, 1, p.out, vb0, nvb);
    else if (PH == PH_GEMM_Q) {
        pg8::Gemm g{(const bf16_t*)(p.ws + WS_H), (const bf16_t*)(p.ws + WS_WQ), 1024, 1024, 1024};
        pg8::StaticOrder S; S.init(T_TOK, 2048, nvb, vb0, 1024, 1024);
        pg8::gemm_phase((PG8_LAS unsigned char*)smem, g, S, pg8::EpiBf16{(bf16_t*)(p.ws + WS_QP), 2048}, TIDX());
    }
    else if (PH == PH_GEMM_SC) gemm_phase((const bf16_t*)(p.ws + WS_QP), 2048, (const bf16_t*)(p.ws + WS_SK), 128, T_TOK, 2048, 128, true,
                                          EpiF16{(_Float16*)(p.ws + WS_SC), 2048}, vb0, nvb, smem, TIDX());
    else if (PH == PH_ROUTE) ph_route(p, vb0, nvb, smem);
    else if (PH == PH_G1) ph_peer_sliced<0>(p, l, smem);
    else if (PH == PH_G15) ph_peer_coef(p, vb0, nvb);
    else if (PH == PH_G2) ph_peer_sliced<1>(p, l, smem);

}

#define XB_TMO      128
#define XB_XCNT(j)  (256  + 64 * (j))
#define XB_XSUB(j)  (1280 + 64 * (j))
#define XB_XGEN(j)  (2304 + 64 * (j))
#define XB_TOP      3328
#define XB_TOPGEN   3392
#define XCD_BAR_WORDS 3456
#define XB_SPIN_CAP (1u << 18)
#define LAS __attribute__((address_space(3)))
__device__ __forceinline__ unsigned xb_ld(unsigned* p)              { return __hip_atomic_load(p, __ATOMIC_RELAXED, __HIP_MEMORY_SCOPE_AGENT); }
__device__ __forceinline__ unsigned xb_add(unsigned* p, unsigned v) { return __hip_atomic_fetch_add(p, v, __ATOMIC_RELAXED, __HIP_MEMORY_SCOPE_AGENT); }
#define XB_SPIN(cond, bar) do { unsigned _sp = 0; while (cond) { __builtin_amdgcn_s_sleep(1); \
    if ((++_sp & 255u) == 0u) { if (xb_ld(&(bar)[XB_TMO])) break; if (_sp > XB_SPIN_CAP) { atomicAdd(&(bar)[XB_TMO], 1u); break; } } } } while (0)
struct XcdBarrier { unsigned* bar; unsigned x; volatile LAS unsigned* st; int wv; };
__device__ __forceinline__ XcdBarrier xcd_barrier_post(unsigned* bar, volatile LAS unsigned* st, int wv) {
    XcdBarrier b; b.bar = bar; b.x = xb_xcc_id(); b.st = st; b.wv = wv;
    if (TIDXW(wv) == 0) (void)xb_add(&bar[XB_XCNT(b.x)], 1u);
    return b;
}
__device__ __forceinline__ void xcd_barrier_complete(unsigned* bar, unsigned x, unsigned& nloc, unsigned& nx) {
    const unsigned G = gridDim.x * gridDim.y * gridDim.z;
    unsigned sum, cnt, mine, sp = 0u;
    for (;;) {
        sum = 0u; cnt = 0u; mine = 0u;
#pragma unroll
        for (unsigned j = 0; j < 16; ++j) { const unsigned c = xb_ld(&bar[XB_XCNT(j)]); sum += c; cnt += (c > 0u) ? 1u : 0u; mine = (j == x) ? c : mine; }
        if (sum == G) break;
        __builtin_amdgcn_s_sleep(1);
        if ((++sp & 255u) == 0u) { if (xb_ld(&bar[XB_TMO])) break; if (sp > XB_SPIN_CAP) { atomicAdd(&bar[XB_TMO], 1u); break; } }
    }
    nloc = mine > 0u ? mine : 1u; nx = cnt > 0u ? cnt : 1u;
}
__device__ __forceinline__ void xcd_barrier(const XcdBarrier& b) {
    asm volatile("s_waitcnt vmcnt(0)" ::: "memory");
    __syncthreads();
    if (TIDXW(b.wv) == 0) {
        unsigned* bar = b.bar;
        __builtin_amdgcn_s_waitcnt(0);
        unsigned nloc = b.st[0], nx = b.st[1];
        if (nloc == 0u) { xcd_barrier_complete(bar, b.x, nloc, nx); b.st[0] = nloc; b.st[1] = nx; }
        const unsigned old = xb_add(&bar[XB_XSUB(b.x)], 1u);
        const unsigned gen = old / nloc;
        if (old + 1u == (gen + 1u) * nloc) {
            __builtin_amdgcn_fence(__ATOMIC_RELEASE, "agent");
            asm volatile("s_waitcnt vmcnt(0)" ::: "memory");
            const unsigned og = xb_add(&bar[XB_TOP], 1u);
            const unsigned tg = og / nx;
            if (og + 1u == (tg + 1u) * nx) xb_add(&bar[XB_TOPGEN], 1u);
            else XB_SPIN(xb_ld(&bar[XB_TOPGEN]) == tg, bar);
            __builtin_amdgcn_fence(__ATOMIC_ACQUIRE, "agent");
            xb_add(&bar[XB_XGEN(b.x)], 1u);
            asm volatile("s_waitcnt vmcnt(0)" ::: "memory");
        } else {
            XB_SPIN(xb_ld(&bar[XB_XGEN(b.x)]) == gen, bar);
            __builtin_amdgcn_fence(__ATOMIC_ACQUIRE, "agent");
            asm volatile("s_waitcnt vmcnt(0)" ::: "memory");
        }
    }
    __syncthreads();
}

__global__ void __launch_bounds__(NT) mega_kernel(Params p_in) {
#if defined(__HIP_DEVICE_COMPILE__)
    extern __shared__ __attribute__((aligned(16))) char smem[];
    volatile LAS unsigned* st = (volatile LAS unsigned*)(smem + LDS_BYTES - 16);
    int wv_ = __builtin_amdgcn_readfirstlane((int)threadIdx.x >> 6); asm volatile("" : "+s"(wv_));
    { const int t_ = TIDXW(wv_); if (t_ < 4) st[t_] = 0u; }
    __syncthreads();
    XcdBarrier bar = xcd_barrier_post((unsigned*)(p_in.ws + WS_CTL), st, wv_);
    const int vb = (int)blockIdx.x, nvb = (int)gridDim.x;
#define GB() xcd_barrier(bar)
#define RUN(PH, L) do { \
        const __attribute__((address_space(4))) Params* _kp = (const __attribute__((address_space(4))) Params*)__builtin_amdgcn_kernarg_segment_ptr(); asm volatile("" : "+s"(_kp)); Params _p = *_kp; _p.wv = wv_; \
        int _l = (L), _vb = vb, _nvb = nvb; asm volatile("" : "+s"(_l), "+s"(_vb), "+s"(_nvb)); \
        run_phase<PH>(_p, _l, _vb, _nvb, smem); } while (0)
    RUN(PH_MOD, 0);
#pragma unroll 1
    for (int l = 0; l < 2; ++l) {
        RUN(PH_WPREP, l); if (l == 0) GB();
        RUN(PH_NORM1, l); GB();
        RUN(PH_GEMM_IN, l); GB();
        RUN(PH_SCAN, l); GB();
        RUN(PH_MERGE, l); GB();
        RUN(PH_OUT, l); GB();
        RUN(PH_NORM2, l); GB();
        RUN(PH_GEMM_Q, l); GB();
        RUN(PH_GEMM_SC, l); GB();
        RUN(PH_ROUTE, l); GB();
        RUN(PH_G1, l); GB();
        RUN(PH_G15, l); GB();
        RUN(PH_G2, l);
        if (l == 0) GB();
    }
#undef RUN
#undef GB
#endif
}

extern "C" void kernel_launch(void* const* d_in, const int* in_sizes, int n_in, void* d_out, int out_size, void* d_ws, size_t ws_size,
                              hipStream_t stream) {
    if (n_in != 20 || ws_size < WS_END) { fprintf(stderr, "kernel_launch: bad inputs (n_in %d ws %zu need %zu)\n", n_in, ws_size, (size_t)WS_END); return; }
    Params p{};
    p.x = (const float*)d_in[0]; p.c = (const float*)d_in[1]; p.w_ada = (const float*)d_in[2]; p.b_ada = (const float*)d_in[3];
    p.norm_mix = (const float*)d_in[4]; p.norm_ffn = (const float*)d_in[5]; p.w_in = (const float*)d_in[6]; p.hgrn_lb = (const float*)d_in[7];
    p.hgrn_on = (const float*)d_in[8]; p.dsa_qn = (const float*)d_in[9]; p.dsa_kn = (const float*)d_in[10]; p.gla_up = (const float*)d_in[11];
    p.gla_bias = (const float*)d_in[12]; p.gla_on = (const float*)d_in[13]; p.w_branch = (const float*)d_in[14]; p.w_out = (const float*)d_in[15];
    p.peer_wq = (const float*)d_in[16]; p.peer_keys = (const float*)d_in[17]; p.peer_u = (const float*)d_in[18]; p.peer_v = (const float*)d_in[19];
    p.out = (float*)d_out; p.ws = (unsigned char*)d_ws;
    static int grid = 0;
    if (grid == 0) {
        int dev = 0, cus = 0, per_cu = 0;
        hipGetDevice(&dev);
        hipDeviceGetAttribute(&cus, hipDeviceAttributeMultiprocessorCount, dev);
        hipFuncSetAttribute((const void*)mega_kernel, hipFuncAttributeMaxDynamicSharedMemorySize, LDS_BYTES);
        hipOccupancyMaxActiveBlocksPerMultiprocessor(&per_cu, (const void*)mega_kernel, NT, LDS_BYTES);
        if (per_cu < 1) { fprintf(stderr, "kernel_launch: occupancy query says %d blocks per CU\n", per_cu); per_cu = 1; }
        (void)hipGetLastError();
        grid = cus;
    }
    hipMemsetAsync((char*)d_ws + WS_CTL, 0, 32768, stream);
    void* args[] = {&p};
    hipError_t e = hipLaunchCooperativeKernel((const void*)mega_kernel, dim3(grid), dim3(NT), args, LDS_BYTES, stream);
    if (e != hipSuccess) fprintf(stderr, "cooperative launch failed: %s (grid %d)\n", hipGetErrorString(e), grid);
}
```

```cpp
#include <hip/hip_runtime.h>
#include <stdint.h>
#include <stdio.h>

typedef unsigned short bf16_t;
typedef short bf16x8 __attribute__((ext_vector_type(8)));
typedef float f32x4 __attribute__((ext_vector_type(4)));
typedef unsigned u32x4 __attribute__((ext_vector_type(4)));

#define NT 512
constexpr int T_TOK = 16384, DM = 1024, SEQ = 2048;
constexpr int LDZ = 8704;
constexpr int ZA_Q = 0, ZA_F = 512, ZA_I = 1024, ZA_G = 1536, ZB_Q = 2048, ZB_K = 2560, ZB_V = 3072, ZC_V = 3584, ZC_G = 4096,
              ZB_QI = 4608, ZC_Q = 4864, ZC_K = 5120, ZB_KI = 5376, ZB_WI = 5440, ZC_CODE = 5444, ZM = 5632;
constexpr int IN_COLS = 8532;

constexpr size_t al256(size_t x) { return (x + 255) & ~(size_t)255; }
constexpr size_t WS_CTL = 0;
constexpr size_t WS_MOD = 65536;
constexpr size_t WS_WIN = al256(WS_MOD + (size_t)2 * 8 * 6144 * 4);
constexpr size_t WS_WBR = al256(WS_WIN + (size_t)LDZ * 1024 * 2);
constexpr size_t WS_WOUT = al256(WS_WBR + (size_t)3 * 1024 * 512 * 2);
constexpr size_t WS_WQ = al256(WS_WOUT + (size_t)1024 * 1024 * 2);
constexpr size_t WS_SK = al256(WS_WQ + (size_t)2048 * 1024 * 2);
constexpr size_t WS_PU = al256(WS_SK + (size_t)16 * 128 * 128 * 2);
constexpr size_t WS_PV = al256(WS_PU + (size_t)16384 * 1024);
constexpr size_t WS_H = al256(WS_PV + (size_t)16384 * 1024);
constexpr float PU_SCALE = 32.f, PV_SCALE = 4.f;
constexpr size_t WS_OA = al256(WS_H + (size_t)T_TOK * 1024 * 2);
constexpr size_t WS_OC = al256(WS_OA + (size_t)T_TOK * 512 * 2);
constexpr size_t WS_H8H = WS_OA, WS_H8L = WS_OC;
constexpr size_t WS_Y = al256(WS_OC + (size_t)T_TOK * 512 * 2);
constexpr size_t WS_Z = al256(WS_Y + (size_t)T_TOK * 1536 * 2);
constexpr size_t WS_VT = al256(WS_Z + (size_t)T_TOK * LDZ * 2);
constexpr size_t WS_BM = al256(WS_VT + (size_t)T_TOK * 512 * 2);
constexpr size_t WS_END = al256(WS_BM + (size_t)T_TOK * 64 * 4);
constexpr size_t WS_QP = WS_Z;
constexpr size_t WS_SC = al256(WS_QP + (size_t)T_TOK * 2048 * 2);
constexpr size_t WS_RI = al256(WS_SC + (size_t)T_TOK * 2048 * 4);
constexpr size_t WS_RG = al256(WS_RI + (size_t)T_TOK * 128 * 4);
constexpr size_t WS_PP = al256(WS_RG + (size_t)T_TOK * 128 * 4);
constexpr size_t WS_C8H = WS_SC;
constexpr size_t WS_C8L = WS_C8H + (size_t)T_TOK * 128;
constexpr size_t WS_CINV = WS_C8L + (size_t)T_TOK * 128;
static_assert(WS_PP + (size_t)8 * T_TOK * 128 * 4 <= WS_VT, "peer partials overflow the Z region");
static_assert(WS_RG + (size_t)T_TOK * 128 * 4 <= WS_END, "peer alias overflow");

struct Params {
    const float* x; const float* c; const float* w_ada; const float* b_ada; const float* norm_mix; const float* norm_ffn;
    const float* w_in; const float* hgrn_lb; const float* hgrn_on; const float* dsa_qn; const float* dsa_kn;
    const float* gla_up; const float* gla_bias; const float* gla_on; const float* w_branch; const float* w_out;
    const float* peer_wq; const float* peer_keys; const float* peer_u; const float* peer_v;
    float* out; unsigned char* ws;
    int wv, pad;
};

__device__ __forceinline__ float bf2f(bf16_t h) { return __uint_as_float(((unsigned)h) << 16); }
__device__ __forceinline__ float bflo(unsigned u) { return __uint_as_float(u << 16); }
__device__ __forceinline__ float bfhi(unsigned u) { return __uint_as_float(u & 0xffff0000u); }
__device__ __forceinline__ bf16_t f2bf(float f) { unsigned r; asm volatile("v_cvt_pk_bf16_f32 %0, %1, %1" : "=v"(r) : "v"(f)); return (bf16_t)(r & 0xffffu); }
__device__ __forceinline__ unsigned pack2(float a, float b) { unsigned r; asm volatile("v_cvt_pk_bf16_f32 %0, %1, %2" : "=v"(r) : "v"(a), "v"(b)); return r; }
__device__ __forceinline__ int lane_id_opaque() { int l; asm volatile("v_mbcnt_lo_u32_b32 %0, -1, 0\n\tv_mbcnt_hi_u32_b32 %0, -1, %0" : "=v"(l)); return l; }
template <int M> __device__ __forceinline__ int shx_i(int v) {
    if (M < 32) return __builtin_amdgcn_ds_swizzle(v, (M << 10) | 0x1f);
    return __builtin_amdgcn_ds_bpermute((lane_id_opaque() ^ 32) << 2, v);
}
template <int M> __device__ __forceinline__ float shx(float v) { return __int_as_float(shx_i<M>(__float_as_int(v))); }
template <int M> __device__ __forceinline__ int shx(int v) { return shx_i<M>(v); }
template <int M> __device__ __forceinline__ unsigned shx(unsigned v) { return (unsigned)shx_i<M>((int)v); }
__device__ __forceinline__ int bperm(int v, int src) { return __builtin_amdgcn_ds_bpermute(src << 2, v); }
__device__ __forceinline__ float bperm(float v, int src) { return __int_as_float(__builtin_amdgcn_ds_bpermute(src << 2, __float_as_int(v))); }
__device__ __forceinline__ float wave_sum(float v) { v += shx<32>(v); v += shx<16>(v); v += shx<8>(v); v += shx<4>(v); v += shx<2>(v); v += shx<1>(v); return v; }
__device__ __forceinline__ float wave_max(float v) { v = fmaxf(v, shx<32>(v)); v = fmaxf(v, shx<16>(v)); v = fmaxf(v, shx<8>(v)); v = fmaxf(v, shx<4>(v)); v = fmaxf(v, shx<2>(v)); v = fmaxf(v, shx<1>(v)); return v; }
__device__ __forceinline__ int wave_sum_i(int v) { v += shx<32>(v); v += shx<16>(v); v += shx<8>(v); v += shx<4>(v); v += shx<2>(v); v += shx<1>(v); return v; }
__device__ __forceinline__ int wave_total_i(int v) {
    v += __builtin_amdgcn_update_dpp(0, v, 0x111, 0xf, 0xf, true);
    v += __builtin_amdgcn_update_dpp(0, v, 0x112, 0xf, 0xf, true);
    v += __builtin_amdgcn_update_dpp(0, v, 0x114, 0xf, 0xf, true);
    v += __builtin_amdgcn_update_dpp(0, v, 0x118, 0xf, 0xf, true);
    v += __builtin_amdgcn_update_dpp(0, v, 0x142, 0xa, 0xf, true);
    v += __builtin_amdgcn_update_dpp(0, v, 0x143, 0xc, 0xf, true);
    return __builtin_amdgcn_readlane(v, 63);
}
__device__ __forceinline__ float sigm(float x) { return __frcp_rn(1.f + __expf(-x)); }

__device__ __forceinline__ unsigned xb_xcc_id() { return (unsigned)__builtin_amdgcn_s_getreg((3 << 11) | 20) & 0xFu; }
__device__ __forceinline__ int TIDXW(int wv) { int t; asm volatile("v_mbcnt_lo_u32_b32 %0, -1, 0\n\tv_mbcnt_hi_u32_b32 %0, -1, %0\n\tv_lshl_or_b32 %0, %1, 6, %0" : "=v"(t) : "s"(wv)); return t; }
#define TIDX() TIDXW(p.wv)

__device__ __forceinline__ int src_col(int j) {
    if (j < 3584) return j;
    if (j < 4096) return j - 3584 + 4420;
    if (j < 4608) return j - 4096 + 4948;
    if (j < 4864) return j - 4608 + 3584;
    if (j < 5120) return j - 4864 + 3908;
    if (j < 5376) return j - 5120 + 4164;
    if (j < 5440) return j - 5376 + 3840;
    if (j < 5444) return j - 5440 + 3904;
    if (j < 5460) return j - 5444 + 4932;
    if (j < 5632) return -1;
    return j - 5632 + 5460;
}

__device__ void ph_mod(const Params& p, int vb0, int nvb, char* smem_) {
    float* sc = (float*)smem_;
    float* part = sc + 8 * 1024;
    float* mod = (float*)(p.ws + WS_MOD);
    const int tid = TIDX(), lane = tid & 63, wave = tid >> 6;
    if (vb0 >= 192) return;
    for (int i = tid; i < 8 * 1024; i += NT) { float c = p.c[i]; sc[i] = c / (1.f + __expf(-c)); }
    __syncthreads();
    for (int task = vb0; task < 192; task += nvb) {
        const int l = task / 96, n0 = (task % 96) * 64;
        const float* w = p.w_ada + (size_t)l * 1024 * 6144 + (size_t)(wave * 128) * 6144 + n0 + lane;
        float acc[8];
#pragma unroll
        for (int b = 0; b < 8; ++b) acc[b] = 0.f;
#pragma unroll 1
        for (int k0 = 0; k0 < 128; k0 += 16) {
            float wv[16];
#pragma unroll
            for (int j = 0; j < 16; ++j) wv[j] = w[(size_t)(k0 + j) * 6144];
#pragma unroll
            for (int j = 0; j < 16; ++j)
#pragma unroll
                for (int b = 0; b < 8; ++b) acc[b] += sc[b * 1024 + wave * 128 + k0 + j] * wv[j];
        }
#pragma unroll
        for (int b = 0; b < 8; ++b) part[(wave * 8 + b) * 64 + lane] = acc[b];
        __syncthreads();
        {
            const int b = tid >> 6, col = tid & 63;
            float v = p.b_ada[l * 6144 + n0 + col];
#pragma unroll
            for (int w_ = 0; w_ < 8; ++w_) v += part[(w_ * 8 + b) * 64 + col];
            mod[(size_t)(l * 8 + b) * 6144 + n0 + col] = v;
        }
        __syncthreads();
    }
}

template <bool MAP>
__device__ void tr_tile(const float* __restrict__ src, int lds_, bf16_t* __restrict__ out, int ldo, int k0, int n0, float* tile, const int tid) {
    float lv[8];
    {
        const int nn = tid & 63, scol = MAP ? src_col(n0 + nn) : (n0 + nn);
#pragma unroll
        for (int i = 0; i < 8; ++i) { const int kk = (tid >> 6) + 8 * i; lv[i] = (scol >= 0) ? src[(size_t)(k0 + kk) * lds_ + scol] : 0.f; }
#pragma unroll
        for (int i = 0; i < 8; ++i) { const int kk = (tid >> 6) + 8 * i; tile[kk * 65 + nn] = lv[i]; }
    }
    __syncthreads();
#pragma unroll
    for (int i = 0; i < 4; ++i) {
        int nn = (tid >> 5) + 16 * i, kk = (tid & 31) * 2;
        unsigned v = pack2(tile[kk * 65 + nn], tile[(kk + 1) * 65 + nn]);
        *(unsigned*)(out + (size_t)(n0 + nn) * ldo + k0 + kk) = v;
    }
    __syncthreads();
}
__device__ void conv_chunk(const float* __restrict__ src, bf16_t* __restrict__ dst, size_t base, const int tid) {
    f32x4 la[4], lb[4];
#pragma unroll
    for (int i = 0; i < 4; ++i) { const size_t e = base + (size_t)(i * NT + tid) * 8; la[i] = *(const f32x4*)(src + e); lb[i] = *(const f32x4*)(src + e + 4); }
#pragma unroll
    for (int i = 0; i < 4; ++i) {
        size_t e = base + (size_t)(i * NT + tid) * 8;
        const float4 a = make_float4(la[i][0], la[i][1], la[i][2], la[i][3]), b = make_float4(lb[i][0], lb[i][1], lb[i][2], lb[i][3]);
        uint4 o; o.x = pack2(a.x, a.y); o.y = pack2(a.z, a.w); o.z = pack2(b.x, b.y); o.w = pack2(b.z, b.w);
        *(uint4*)(dst + e) = o;
    }
}
__device__ void conv_chunk_fp8(const float* __restrict__ src, unsigned char* __restrict__ dst, size_t base, float scale, const int tid) {
    f32x4 la[4], lb[4];
#pragma unroll
    for (int i = 0; i < 4; ++i) { const size_t e = base + (size_t)(i * NT + tid) * 8; la[i] = *(const f32x4*)(src + e); lb[i] = *(const f32x4*)(src + e + 4); }
#pragma unroll
    for (int i = 0; i < 4; ++i) {
        size_t e = base + (size_t)(i * NT + tid) * 8;
        const float4 a = make_float4(la[i][0], la[i][1], la[i][2], la[i][3]), b = make_float4(lb[i][0], lb[i][1], lb[i][2], lb[i][3]);
        int lo = __builtin_amdgcn_cvt_pk_fp8_f32(a.x * scale, a.y * scale, 0, false); lo = __builtin_amdgcn_cvt_pk_fp8_f32(a.z * scale, a.w * scale, lo, true);
        int hi = __builtin_amdgcn_cvt_pk_fp8_f32(b.x * scale, b.y * scale, 0, false); hi = __builtin_amdgcn_cvt_pk_fp8_f32(b.z * scale, b.w * scale, hi, true);
        const size_t row = e >> 10, col = e & 1023;
        *(uint2*)(dst + ((col >> 7) * 16384 + row) * 128 + (col & 127)) = make_uint2((unsigned)lo, (unsigned)hi);
    }
}
__device__ void ph_wprep(const Params& p, int l, int vb0, int nvb, char* smem_) {
    float* tile = (float*)smem_;
    const int tid = TIDX();
    bf16_t* WIN = (bf16_t*)(p.ws + WS_WIN); bf16_t* WBR = (bf16_t*)(p.ws + WS_WBR); bf16_t* WOUT = (bf16_t*)(p.ws + WS_WOUT);
    bf16_t* WQ = (bf16_t*)(p.ws + WS_WQ); bf16_t* SK = (bf16_t*)(p.ws + WS_SK); unsigned char* PU = p.ws + WS_PU; unsigned char* PV = p.ws + WS_PV;
    constexpr int N_WIN = 136 * 16, N_WBR = 3 * 16 * 8, N_WOUT = 16 * 16, N_WQ = 32 * 16, N_SK = 16, N_PU = 1024, N_PV = 1024;
    constexpr int TOTAL = N_WIN + N_WBR + N_WOUT + N_WQ + N_SK + N_PU + N_PV;
    for (int task = vb0; task < TOTAL; task += nvb) {
        int r = task;
        if (r < N_WIN) { int nt = r / 16, kt = r % 16; tr_tile<true>(p.w_in + (size_t)l * 1024 * IN_COLS, IN_COLS, WIN, 1024, kt * 64, nt * 64, tile, tid); continue; }
        r -= N_WIN;
        if (r < N_WBR) { int g = r / 128, rr = r % 128, nt = rr / 8, kt = rr % 8;
            tr_tile<false>(p.w_branch + (size_t)(l * 3 + g) * 512 * 1024, 1024, WBR + (size_t)g * 1024 * 512, 512, kt * 64, nt * 64, tile, tid); continue; }
        r -= N_WBR;
        if (r < N_WOUT) { int nt = r / 16, kt = r % 16; tr_tile<false>(p.w_out + (size_t)l * 1024 * 1024, 1024, WOUT, 1024, kt * 64, nt * 64, tile, tid); continue; }
        r -= N_WOUT;
        if (r < N_WQ) { int nt = r / 16, kt = r % 16; tr_tile<false>(p.peer_wq + (size_t)l * 1024 * 2048, 2048, WQ, 1024, kt * 64, nt * 64, tile, tid); continue; }
        r -= N_WQ;
        if (r < N_SK) { conv_chunk(p.peer_keys + (size_t)l * 16 * 128 * 128, SK, (size_t)r * 16384, tid); continue; }
        r -= N_SK;
        if (r < N_PU) { conv_chunk_fp8(p.peer_u + (size_t)l * 16384 * 1024, PU, (size_t)r * 16384, PU_SCALE, tid); continue; }
        r -= N_PU;
        conv_chunk_fp8(p.peer_v + (size_t)l * 16384 * 1024, PV, (size_t)r * 16384, PV_SCALE, tid);
    }
}

__device__ void ph_norm(const Params& p, int l, int which, const float* xin, int vb0, int nvb) {
    const int wave = TIDX() >> 6, lane = TIDX() & 63;
    const float* gain = (which ? p.norm_ffn : p.norm_mix) + l * 1024;
    const float* modb = (const float*)(p.ws + WS_MOD);
    bf16_t* H = (bf16_t*)(p.ws + WS_H);
    f32x4 g[4];
#pragma unroll
    for (int i = 0; i < 4; ++i) g[i] = *(const f32x4*)(gain + (lane + 64 * i) * 4);
    for (int t = vb0 * 8 + wave; t < T_TOK; t += nvb * 8) {
        const int b = t >> 11;
        const float* mod = modb + (size_t)(l * 8 + b) * 6144 + (which ? 3072 : 0);
        const f32x4* xr = (const f32x4*)(xin + (size_t)t * 1024);
        f32x4 v[4], sc[4], sh[4]; float ss = 0.f;
#pragma unroll
        for (int i = 0; i < 4; ++i) { v[i] = xr[lane + 64 * i]; sc[i] = *(const f32x4*)(mod + 1024 + (lane + 64 * i) * 4); sh[i] = *(const f32x4*)(mod + (lane + 64 * i) * 4); }
#pragma unroll
        for (int i = 0; i < 4; ++i) ss += v[i][0] * v[i][0] + v[i][1] * v[i][1] + v[i][2] * v[i][2] + v[i][3] * v[i][3];
        ss = wave_sum(ss);
        const float rstd = rsqrtf(ss * (1.f / 1024.f) + 1e-6f);
#pragma unroll
        for (int i = 0; i < 4; ++i) {
            const int idx = (lane + 64 * i) * 4;
            const f32x4 h = v[i] * rstd * g[i] * (1.f + sc[i]) + sh[i];
            uint2 o; o.x = pack2(h[0], h[1]); o.y = pack2(h[2], h[3]);
            *(uint2*)(H + (size_t)t * 1024 + idx) = o;
            if (which) {
                int hi = __builtin_amdgcn_cvt_pk_fp8_f32(h[0], h[1], 0, false); hi = __builtin_amdgcn_cvt_pk_fp8_f32(h[2], h[3], hi, true);
                const auto d0 = __builtin_amdgcn_cvt_pk_f32_fp8(hi, false); const auto d1 = __builtin_amdgcn_cvt_pk_f32_fp8(hi, true);
                int lo = __builtin_amdgcn_cvt_pk_fp8_f32((h[0] - d0[0]) * 16.f, (h[1] - d0[1]) * 16.f, 0, false);
                lo = __builtin_amdgcn_cvt_pk_fp8_f32((h[2] - d1[0]) * 16.f, (h[3] - d1[1]) * 16.f, lo, true);
                *(int*)(p.ws + WS_H8H + (size_t)t * 1024 + idx) = hi;
                *(int*)(p.ws + WS_H8L + (size_t)t * 1024 + idx) = lo;
            }
        }
    }
}

constexpr int GBM = 256, GBN = 128, GBK = 64, GLS = 72;
__device__ __forceinline__ void gemm_tile(const bf16_t* __restrict__ A, int lda, const bf16_t* __restrict__ Bt, int ldb, int K,
                                          int m0, int n0, bf16_t* sA, bf16_t* sB, f32x4 (&acc)[4][4], const int tid) {
    const int lane = tid & 63, wave = tid >> 6;
    const int wm = wave >> 1, wn = wave & 1, fr = lane & 15, fq = lane >> 4;
    u32x4 ra[4], rb[2];
    const int crow = tid >> 3, ckc = (tid & 7) * 8;
    const bf16_t* Ag = A + (size_t)(m0 + crow) * lda + ckc;
    const bf16_t* Bg = Bt + (size_t)(n0 + crow) * ldb + ckc;
#pragma unroll
    for (int i = 0; i < 4; ++i) ra[i] = *(const u32x4*)(Ag + (size_t)(64 * i) * lda);
#pragma unroll
    for (int i = 0; i < 2; ++i) rb[i] = *(const u32x4*)(Bg + (size_t)(64 * i) * ldb);
    for (int k0 = 0; k0 < K; k0 += GBK) {
        __syncthreads();
#pragma unroll
        for (int i = 0; i < 4; ++i) *(u32x4*)(sA + (crow + 64 * i) * GLS + ckc) = ra[i];
#pragma unroll
        for (int i = 0; i < 2; ++i) *(u32x4*)(sB + (crow + 64 * i) * GLS + ckc) = rb[i];
        __syncthreads();
        {
            const int kn = (k0 + GBK < K) ? (k0 + GBK) : k0;
#pragma unroll
            for (int i = 0; i < 4; ++i) ra[i] = *(const u32x4*)(Ag + (size_t)(64 * i) * lda + kn);
#pragma unroll
            for (int i = 0; i < 2; ++i) rb[i] = *(const u32x4*)(Bg + (size_t)(64 * i) * ldb + kn);
        }
#pragma unroll
        for (int ks = 0; ks < 2; ++ks) {
            bf16x8 af[4], wf[4];
#pragma unroll
            for (int mf = 0; mf < 4; ++mf) af[mf] = *(const bf16x8*)(sA + (wm * 64 + mf * 16 + fr) * GLS + ks * 32 + fq * 8);
#pragma unroll
            for (int nf = 0; nf < 4; ++nf) wf[nf] = *(const bf16x8*)(sB + (wn * 64 + nf * 16 + fr) * GLS + ks * 32 + fq * 8);
#pragma unroll
            for (int nf = 0; nf < 4; ++nf)
#pragma unroll
                for (int mf = 0; mf < 4; ++mf)
                    acc[nf][mf] = __builtin_amdgcn_mfma_f32_16x16x32_bf16(wf[nf], af[mf], acc[nf][mf], 0, 0, 0);
        }
    }
}


namespace pg8 {
#define PG8_LAS __attribute__((address_space(3)))
constexpr int BM = 256, BK = 64, HALF = 128, HTB = HALF * BK * 2, STAGE_BYTES = 8 * HTB, NXCD = 8, WGM = 8;
__device__ __forceinline__ int lds_byte(int r, int c) { const int st = (r >> 4) * 2 + (c >> 5), rr = r & 15, cc = c & 31, ob = rr * 64 + cc * 2; return st * 1024 + (ob ^ (((ob >> 9) & 1) << 5)); }
__device__ __forceinline__ void stage_rc(int b, int& R, int& C) { const int st = b / 1024, sb = b % 1024, swz = sb ^ (((sb >> 9) & 1) << 5); R = (st >> 1) * 16 + swz / 64; C = (st & 1) * 32 + (swz % 64) / 2; }
__device__ __forceinline__ int perm32(int rho) { const int n = rho >> 4, i = rho & 15; return 8 * (i >> 2) + 4 * n + (i & 3); }
struct Unit { int pm, pn, aux; size_t aoff, boff; };
struct Gemm { const bf16_t* A; const bf16_t* Bt; int lda, ldb, K; };

struct StaticOrder {
    int nM, nN, nwg, G, c, lda, ldb;
    __device__ void init(int M, int N, int G_, int c_, int lda_, int ldb_) { nM = M / BM; nN = N / BM; nwg = nM * nN; G = G_; c = c_; lda = lda_; ldb = ldb_; }
    __device__ bool next(int i, Unit& u) const {
        const long L = (long)i * G + c; if (L >= nwg) return false;
        int wgid = (int)L; { const int q = nwg / NXCD, r = nwg % NXCD, xcd = wgid % NXCD, off = wgid / NXCD; wgid = (xcd < r ? xcd * (q + 1) : r * (q + 1) + (xcd - r) * q) + off; }
        const int nig = WGM * nN, gid = wgid / nig, fm = gid * WGM, gsz = (nM - fm) < WGM ? (nM - fm) : WGM;
        u.pm = fm + ((wgid % nig) % gsz); u.pn = (wgid % nig) / gsz; u.aux = 0;
        u.aoff = (size_t)u.pm * BM * lda * 2; u.boff = (size_t)u.pn * BM * ldb * 2;
        return true;
    }
};
struct MergeOrder {
    int c, G;
    __device__ bool next(int i, Unit& u) const {
        const int tile = c + (i / 3) * G; if (tile >= 256) return false;
        u.pm = tile & 63; u.pn = tile >> 6; u.aux = i % 3;
        u.aoff = ((size_t)u.pm * BM * 1536 + (size_t)u.aux * 512) * 2; u.boff = ((size_t)u.aux * 1024 + (size_t)u.pn * BM) * 512 * 2;
        return true;
    }
};

template <class Epi, class Sched>
__device__ __forceinline__ void gemm_phase(PG8_LAS unsigned char* lds, const Gemm g, const Sched& S, const Epi& E, const int tid) {
    const int wid = __builtin_amdgcn_readfirstlane(tid >> 6), lane = tid & 63, wr = wid >> 2, wc = wid & 3, fr = lane & 15, fq = lane >> 4;
    const int K = g.K, nt = K / BK;
    unsigned voffA[2], voffB[2];
#pragma unroll
    for (int i = 0; i < 2; ++i) { int R, C; stage_rc(tid * 16 + i * 8192, R, C); const int Rb = Epi::PERM ? ((R & ~31) + perm32(R & 31)) : R;
        voffA[i] = (unsigned)(R * g.lda + C) * 2u; voffB[i] = (unsigned)(Rb * g.ldb + C) * 2u; }
    const size_t kstep = (size_t)(BK * 2);
    const size_t hstepA = (size_t)HALF * g.lda * 2, hstepB = (size_t)HALF * g.ldb * 2;
    const unsigned ldsw = (unsigned)wid * 1024u;
    const int aoff = lds_byte(wr * 64 + fr, fq * 8), boff = lds_byte(wc * 32 + fr, fq * 8);
#define PG8_SA(b, h) (((b) * 2 + (h)) * HTB)
#define PG8_SB(b, h) ((4 + (b) * 2 + (h)) * HTB)
#define PG8_STAGE(bufoff, gbase, voff) do { _Pragma("unroll") for (int _i = 0; _i < 2; ++_i) \
        __builtin_amdgcn_global_load_lds((const unsigned*)((const char*)(gbase) + (voff)[_i]), (PG8_LAS unsigned*)(lds + (bufoff) + ldsw + _i * 8192), 16, 0, 0); } while (0)
#define PG8_LDA(dst, b, h) do { _Pragma("unroll") for (int m = 0; m < 4; ++m) _Pragma("unroll") for (int k = 0; k < 2; ++k) dst[m][k] = *(const PG8_LAS bf16x8*)(lds + PG8_SA(b, h) + aoff + m * 2048 + k * 1024); } while (0)
#define PG8_LDB(dst, b, h) do { _Pragma("unroll") for (int n = 0; n < 2; ++n) _Pragma("unroll") for (int k = 0; k < 2; ++k) dst[n][k] = *(const PG8_LAS bf16x8*)(lds + PG8_SB(b, h) + boff + n * 2048 + k * 1024); } while (0)
#define PG8_MMA(ai, bj, At, Bt) do { __builtin_amdgcn_s_setprio(1); _Pragma("unroll") for (int m = 0; m < 4; ++m) _Pragma("unroll") for (int n = 0; n < 2; ++n) _Pragma("unroll") for (int k = 0; k < 2; ++k) \
        acc[ai][bj][m][n] = __builtin_amdgcn_mfma_f32_16x16x32_bf16(Bt[n][k], At[m][k], acc[ai][bj][m][n], 0, 0, 0); __builtin_amdgcn_s_setprio(0); } while (0)
#define PG8_WAIT_V(n) asm volatile("s_waitcnt vmcnt(" #n ")" ::: "memory")
#define PG8_WAIT_L(n) asm volatile("s_waitcnt lgkmcnt(" #n ")" ::: "memory")
#define PG8_BAR __builtin_amdgcn_s_barrier()
#define PG8_SCHED __builtin_amdgcn_sched_barrier(0)
    Unit cur, nxt; int ui = 0;
    if (!S.next(0, cur)) return;
    f32x4 acc[2][2][4][2];
#pragma unroll
    for (int a = 0; a < 2; ++a)
#pragma unroll
        for (int b = 0; b < 2; ++b)
#pragma unroll
            for (int m = 0; m < 4; ++m)
#pragma unroll
                for (int n = 0; n < 2; ++n) acc[a][b][m][n] = f32x4{0.f, 0.f, 0.f, 0.f};
    bf16x8 At[4][2], B0[2][2], B1[2][2];
    const char* cA = (const char*)g.A + cur.aoff; const char* cB = (const char*)g.Bt + cur.boff;
    PG8_STAGE(PG8_SB(0, 0), cB, voffB); PG8_STAGE(PG8_SA(0, 0), cA, voffA); PG8_STAGE(PG8_SB(0, 1), cB + hstepB, voffB); PG8_STAGE(PG8_SA(0, 1), cA + hstepA, voffA);
    if (wr == 1) PG8_BAR;
    PG8_WAIT_V(4); PG8_BAR;
    PG8_STAGE(PG8_SB(1, 0), cB + kstep, voffB); PG8_STAGE(PG8_SA(1, 0), cA + kstep, voffA); PG8_STAGE(PG8_SB(1, 1), cB + hstepB + kstep, voffB);
    PG8_WAIT_V(6); PG8_BAR;
    for (;;) {
        const bool has_next = S.next(ui + 1, nxt);
        const char* nA = has_next ? (const char*)g.A + nxt.aoff : cA; const char* nB = has_next ? (const char*)g.Bt + nxt.boff : cB;
        for (int t = 0; t < nt; t += 2) {
            const bool last = (t == nt - 2);
            const char* a1 = cA + (size_t)(t + 1) * kstep;
            const char* a2 = last ? nA : cA + (size_t)(t + 2) * kstep; const char* b2 = last ? nB : cB + (size_t)(t + 2) * kstep;
            const char* a3 = a2 + kstep; const char* b3 = b2 + kstep;
            PG8_LDB(B0, 0, 0); PG8_SCHED; PG8_LDA(At, 0, 0); PG8_STAGE(PG8_SA(1, 1), a1 + hstepA, voffA);
            PG8_WAIT_L(8); PG8_BAR; PG8_WAIT_L(0); PG8_MMA(0, 0, At, B0); PG8_BAR; PG8_SCHED;
            PG8_LDB(B1, 0, 1); PG8_STAGE(PG8_SB(0, 0), b2, voffB);
            PG8_BAR; PG8_WAIT_L(0); PG8_MMA(0, 1, At, B1); PG8_BAR;
            PG8_LDA(At, 0, 1); PG8_STAGE(PG8_SA(0, 0), a2, voffA);
            PG8_BAR; PG8_WAIT_L(0); PG8_MMA(1, 0, At, B0); PG8_BAR; PG8_SCHED;
            PG8_STAGE(PG8_SB(0, 1), b2 + hstepB, voffB);
            PG8_WAIT_V(6); PG8_BAR; PG8_MMA(1, 1, At, B1); PG8_BAR;
            PG8_LDB(B0, 1, 0); PG8_SCHED; PG8_LDA(At, 1, 0); PG8_STAGE(PG8_SA(0, 1), a2 + hstepA, voffA);
            PG8_WAIT_L(8); PG8_BAR; PG8_WAIT_L(0); PG8_MMA(0, 0, At, B0); PG8_BAR; PG8_SCHED;
            PG8_LDB(B1, 1, 1); PG8_STAGE(PG8_SB(1, 0), b3, voffB);
            PG8_BAR; PG8_WAIT_L(0); PG8_MMA(0, 1, At, B1); PG8_BAR;
            PG8_LDA(At, 1, 1); PG8_STAGE(PG8_SA(1, 0), a3, voffA);
            PG8_BAR; PG8_WAIT_L(0); PG8_MMA(1, 0, At, B0); PG8_BAR; PG8_SCHED;
            PG8_STAGE(PG8_SB(1, 1), b3 + hstepB, voffB);
            PG8_WAIT_V(6); PG8_BAR; PG8_MMA(1, 1, At, B1); PG8_BAR;
        }
        E(acc, cur, wr, wc, fr, fq);
        if (!has_next) break;
#pragma unroll
        for (int a = 0; a < 2; ++a)
#pragma unroll
            for (int b = 0; b < 2; ++b)
#pragma unroll
                for (int m = 0; m < 4; ++m)
#pragma unroll
                    for (int n = 0; n < 2; ++n) acc[a][b][m][n] = f32x4{0.f, 0.f, 0.f, 0.f};
        cur = nxt; cA = nA; cB = nB; ++ui;
    }
    PG8_WAIT_V(0);
    if (wr == 0) PG8_BAR;
    PG8_BAR;
#undef PG8_SA
#undef PG8_SB
#undef PG8_STAGE
#undef PG8_LDA
#undef PG8_LDB
#undef PG8_MMA
#undef PG8_WAIT_V
#undef PG8_WAIT_L
#undef PG8_BAR
#undef PG8_SCHED
}

struct EpiBf16 {
    static constexpr bool PERM = true;
    bf16_t* O; int ldc;
    __device__ __forceinline__ void operator()(const f32x4 (&acc)[2][2][4][2], const Unit& u, int wr, int wc, int fr, int fq) const {
        const int row0 = u.pm * BM + wr * 64 + fr, col0 = u.pn * BM + wc * 32 + 8 * fq;
#pragma unroll
        for (int ai = 0; ai < 2; ++ai)
#pragma unroll
            for (int m = 0; m < 4; ++m) { bf16_t* rowp = O + (size_t)(row0 + ai * HALF + m * 16) * ldc + col0;
#pragma unroll
                for (int bj = 0; bj < 2; ++bj) { const f32x4 v0 = acc[ai][bj][m][0], v1 = acc[ai][bj][m][1];
                    u32x4 w; w.x = pack2(v0[0], v0[1]); w.y = pack2(v0[2], v0[3]); w.z = pack2(v1[0], v1[1]); w.w = pack2(v1[2], v1[3]);
                    *(u32x4*)(rowp + bj * HALF) = w; } }
    }
};
struct EpiResid {
    static constexpr bool PERM = false;
    const float* xin; float* out; const float* mod;
    __device__ __forceinline__ void operator()(const f32x4 (&acc)[2][2][4][2], const Unit& u, int wr, int wc, int fr, int fq) const {
        const int row0 = u.pm * BM + wr * 64 + fr, col0 = u.pn * BM + wc * 32 + 4 * fq;
        const float* gm = mod + (size_t)(row0 >> 11) * 6144 + 2048 + col0;
        f32x4 g4[2][2];
#pragma unroll
        for (int bj = 0; bj < 2; ++bj)
#pragma unroll
            for (int n = 0; n < 2; ++n) g4[bj][n] = *(const f32x4*)(gm + bj * HALF + n * 16);
#pragma unroll
        for (int ai = 0; ai < 2; ++ai) {
            f32x4 xi[4][2][2];
#pragma unroll
            for (int m = 0; m < 4; ++m)
#pragma unroll
                for (int bj = 0; bj < 2; ++bj)
#pragma unroll
                    for (int n = 0; n < 2; ++n) xi[m][bj][n] = *(const f32x4*)(xin + (size_t)(row0 + ai * HALF + m * 16) * 1024 + col0 + bj * HALF + n * 16);
            asm volatile("" ::: "memory");
#pragma unroll
            for (int m = 0; m < 4; ++m)
#pragma unroll
                for (int bj = 0; bj < 2; ++bj)
#pragma unroll
                    for (int n = 0; n < 2; ++n)
                        *(f32x4*)(out + (size_t)(row0 + ai * HALF + m * 16) * 1024 + col0 + bj * HALF + n * 16) = xi[m][bj][n] + g4[bj][n] * acc[ai][bj][m][n];
            asm volatile("" ::: "memory");
        }
    }
};
struct EpiMerge {
    static constexpr bool PERM = true;
    bf16_t* Hm; const bf16_t* Z;
    __device__ __forceinline__ void operator()(const f32x4 (&acc)[2][2][4][2], const Unit& u, int wr, int wc, int fr, int fq) const {
        const int row0 = u.pm * BM + wr * 64 + fr, col0 = u.pn * BM + wc * 32 + 8 * fq, g = u.aux;
#pragma unroll
        for (int ai = 0; ai < 2; ++ai) {
            u32x4 gz[4][2], prev[4][2];
#pragma unroll
            for (int m = 0; m < 4; ++m)
#pragma unroll
                for (int bj = 0; bj < 2; ++bj) {
                    const int row = row0 + ai * HALF + m * 16, col = col0 + bj * HALF;
                    gz[m][bj] = *(const u32x4*)(Z + (size_t)row * LDZ + ZM + g * 1024 + col);
                    prev[m][bj] = u32x4{0u, 0u, 0u, 0u};
                    if (g > 0) prev[m][bj] = *(const u32x4*)(Hm + (size_t)row * 1024 + col);
                }
            asm volatile("" ::: "memory");
#pragma unroll
            for (int m = 0; m < 4; ++m)
#pragma unroll
                for (int bj = 0; bj < 2; ++bj) {
                    const int row = row0 + ai * HALF + m * 16, col = col0 + bj * HALF;
                    const f32x4 v0 = acc[ai][bj][m][0], v1 = acc[ai][bj][m][1];
                    const u32x4 z_ = gz[m][bj], p_ = prev[m][bj];
                    u32x4 w;
                    w.x = pack2(bflo(p_.x) + sigm(bflo(z_.x)) * v0[0], bfhi(p_.x) + sigm(bfhi(z_.x)) * v0[1]);
                    w.y = pack2(bflo(p_.y) + sigm(bflo(z_.y)) * v0[2], bfhi(p_.y) + sigm(bfhi(z_.y)) * v0[3]);
                    w.z = pack2(bflo(p_.z) + sigm(bflo(z_.z)) * v1[0], bfhi(p_.z) + sigm(bfhi(z_.z)) * v1[1]);
                    w.w = pack2(bflo(p_.w) + sigm(bflo(z_.w)) * v1[2], bfhi(p_.w) + sigm(bfhi(z_.w)) * v1[3]);
                    *(u32x4*)(Hm + (size_t)row * 1024 + col) = w;
                }
            asm volatile("" ::: "memory");
        }
    }
};
}

struct EpiZ {
    bf16_t* Z; int ld;
    __device__ __forceinline__ void operator()(int m, int n, const f32x4& v) const {
        uint2 o; o.x = pack2(v[0], v[1]); o.y = pack2(v[2], v[3]);
        *(uint2*)(Z + (size_t)m * ld + n) = o;
    }
};
struct EpiF16 {
    _Float16* C; int ld;
    __device__ __forceinline__ void operator()(int m, int n, const f32x4& v) const {
        typedef _Float16 h4 __attribute__((ext_vector_type(4)));
        h4 o = {(_Float16)v[0], (_Float16)v[1], (_Float16)v[2], (_Float16)v[3]};
        *(h4*)(C + (size_t)m * ld + n) = o;
    }
};
struct EpiOut {
    const float* xin; float* out; const float* mod;
    __device__ __forceinline__ void operator()(int m, int n, const f32x4& v) const {
        int b = m >> 11;
        float4 g = *(const float4*)(mod + (size_t)b * 6144 + 2048 + n);
        float4 xi = *(const float4*)(xin + (size_t)m * 1024 + n);
        *(float4*)(out + (size_t)m * 1024 + n) = make_float4(xi.x + g.x * v[0], xi.y + g.y * v[1], xi.z + g.z * v[2], xi.w + g.w * v[3]);
    }
};

template <class Epi>
__device__ void gemm_phase(const bf16_t* A, int lda, const bf16_t* Bt, int ldb, int M, int N, int K, bool batched, Epi epi,
                           int vb0, int nvb, char* smem_, const int tid) {
    bf16_t* sA = (bf16_t*)smem_; bf16_t* sB = sA + GBM * GLS;
    const int lane = tid & 63, wave = tid >> 6, wm = wave >> 1, wn = wave & 1, fr = lane & 15, fq = lane >> 4;
    const int MT = M / GBM, NTL = N / GBN;
    for (int tile = vb0; tile < MT * NTL; tile += nvb) {
        int mt = tile % MT, nt = tile / MT;
        f32x4 acc[4][4];
#pragma unroll
        for (int a = 0; a < 4; ++a)
#pragma unroll
            for (int b = 0; b < 4; ++b) acc[a][b] = f32x4{0.f, 0.f, 0.f, 0.f};
        gemm_tile(batched ? A + nt * 128 : A, lda, Bt, ldb, K, mt * GBM, nt * GBN, sA, sB, acc, tid);
#pragma unroll
        for (int nf = 0; nf < 4; ++nf)
#pragma unroll
            for (int mf = 0; mf < 4; ++mf)
                epi(mt * GBM + wm * 64 + mf * 16 + fr, nt * GBN + wn * 64 + nf * 16 + fq * 4, acc[nf][mf]);
    }
}
__device__ __forceinline__ void sc_tile(const Params& p, int mt, int nt, char* smem_, const int tid) {
    bf16_t* sA = (bf16_t*)smem_; bf16_t* sB = sA + GBM * GLS;
    const int lane = tid & 63, wave = tid >> 6, wm = wave >> 1, wn = wave & 1, fr = lane & 15, fq = lane >> 4;
    f32x4 acc[4][4];
#pragma unroll
    for (int a = 0; a < 4; ++a)
#pragma unroll
        for (int b = 0; b < 4; ++b) acc[a][b] = f32x4{0.f, 0.f, 0.f, 0.f};
    gemm_tile((const bf16_t*)(p.ws + WS_QP) + nt * 128, 2048, (const bf16_t*)(p.ws + WS_SK), 128, 128, mt * GBM, nt * GBN, sA, sB, acc, tid);
    const EpiF16 epi{(_Float16*)(p.ws + WS_SC), 2048};
#pragma unroll
    for (int nf = 0; nf < 4; ++nf)
#pragma unroll
        for (int mf = 0; mf < 4; ++mf)
            epi(mt * GBM + wm * 64 + mf * 16 + fr, nt * GBN + wn * 64 + nf * 16 + fq * 4, acc[nf][mf]);
}

#define SCAN_SYNC() do { asm volatile("s_waitcnt lgkmcnt(0)" ::: "memory"); __builtin_amdgcn_s_barrier(); asm volatile("" ::: "memory"); } while (0)
template <int DK, bool GLA>
__device__ void scan2_item(const Params& p, int l, int b, int h, char* smem_) {
    constexpr int SEG = NT / DK, SLEN = 64 / SEG, KS = DK / 32, KT = DK / 16;
    constexpr int QS = DK + 8, BS = DK + 4, VS = 72;
    bf16_t* qs = (bf16_t*)smem_;
    bf16_t* ks = qs + 64 * QS;
    float* bs = (float*)(ks + 64 * QS);
    bf16_t* vt = (bf16_t*)(bs + 64 * BS);
    bf16_t* At = vt + 128 * VS;
    bf16_t* kht = At + 64 * VS;
    bf16_t* st = kht + DK * VS;
    float* segtot = (float*)(st + 128 * QS);
    float* blast = segtot + SEG * DK;
    const int tid = TIDX(), lane = tid & 63, wave = __builtin_amdgcn_readfirstlane(tid >> 6), fr = lane & 15, fq = lane >> 4;
    const int kl = tid % DK, seg = __builtin_amdgcn_readfirstlane(tid / DK);
    float lbv = 0.f, gbias = 0.f; float gu[16];
#pragma unroll
    for (int r = 0; r < 16; ++r) gu[r] = 0.f;
    if (GLA) {
#pragma unroll
        for (int r = 0; r < 16; ++r) gu[r] = p.gla_up[(size_t)(l * 16 + r) * 256 + h * 64 + kl];
        gbias = p.gla_bias[l * 256 + h * 64 + kl];
    } else if (l == 1) {
        float x0 = p.hgrn_lb[h * 128 + kl], x1 = p.hgrn_lb[512 + h * 128 + kl];
        lbv = 1.f / (1.f + expf(x0 - x1));
    }
    const float scale = GLA ? 0.125f : 0.08838834764831845f;
    const bf16_t* Zb = (const bf16_t*)(p.ws + WS_Z) + (size_t)(b * 2048) * LDZ;
    float* ssq = (float*)(smem_ + 152576);
    const int QCOL = (GLA ? ZC_Q : ZA_Q) + h * DK, KCOL = (GLA ? ZC_K : ZA_F) + h * DK, VCOL = (GLA ? ZC_V : ZA_I) + h * 128, GCOL = (GLA ? ZC_G : ZA_G) + h * 128;
    f32x4 sacc[KT];
#pragma unroll
    for (int i = 0; i < KT; ++i) sacc[i] = f32x4{0.f, 0.f, 0.f, 0.f};
    f32x4 gn4[4];
    {
        const float* gn = (GLA ? p.gla_on : p.hgrn_on) + l * 128 + (wave >> 2) * 64 + 4 * fq;
#pragma unroll
        for (int vi = 0; vi < 4; ++vi) gn4[vi] = *(const f32x4*)(gn + vi * 16);
    }
    for (int i = tid; i < 128 * QS / 2; i += NT) ((unsigned*)st)[i] = 0u;
    SCAN_SYNC();

    for (int c = 0; c < 32; ++c) {
        const bf16_t* Zc = Zb + (size_t)(c * 64) * LDZ;
        {
            bf16_t rq[SLEN], rk[SLEN];
            u32x4 rc0[GLA ? SLEN : 1], rc1[GLA ? SLEN : 1];
            {
                bf16_t rv[16];
                const int v = tid & 127, sb_ = __builtin_amdgcn_readfirstlane(tid >> 7);
#pragma unroll
                for (int i = 0; i < 16; ++i) rv[i] = Zc[(size_t)(sb_ + 4 * i) * LDZ + VCOL + v];
#pragma unroll
                for (int i = 0; i < SLEN; ++i) {
                    const bf16_t* zr = Zc + (size_t)(seg * SLEN + i) * LDZ;
                    rq[i] = zr[QCOL + kl]; rk[i] = zr[KCOL + kl];
                    if (GLA) { rc0[i] = *(const u32x4*)(zr + ZC_CODE); rc1[i] = *(const u32x4*)(zr + ZC_CODE + 8); }
                }
#pragma unroll
                for (int i = 0; i < 16; ++i) vt[v * VS + sb_ + 4 * i] = rv[i];
            }
            float run = 0.f;
#pragma unroll
            for (int i = 0; i < SLEN; ++i) {
                const int s_ = seg * SLEN + i;
                float g, kk;
                if (GLA) {
                    float x = gbias;
#pragma unroll
                    for (int r = 0; r < 4; ++r) {
                        x += bflo(rc0[i][r]) * gu[2 * r] + bfhi(rc0[i][r]) * gu[2 * r + 1];
                        x += bflo(rc1[i][r]) * gu[8 + 2 * r] + bfhi(rc1[i][r]) * gu[8 + 2 * r + 1];
                    }
                    g = (fminf(x, 0.f) - __logf(1.f + __expf(-fabsf(x)))) * (1.f / 16.f);
                    kk = bf2f(rk[i]);
                } else {
                    const float f = lbv + (1.f - lbv) * __frcp_rn(1.f + __expf(-bf2f(rk[i])));
                    g = __logf(f); kk = 1.f - f;
                }
                run += g;
                bs[s_ * BS + kl] = run;
                qs[s_ * QS + kl] = rq[i];
                ks[s_ * QS + kl] = f2bf(kk);
            }
            segtot[seg * DK + kl] = run;
        }
        SCAN_SYNC();
        {
            float pre = 0.f, tot = 0.f;
#pragma unroll
            for (int g_ = 0; g_ < SEG; ++g_) { const float v_ = segtot[g_ * DK + kl]; if (g_ < seg) pre += v_; tot += v_; }
            if (seg == 0) blast[kl] = tot;
            unsigned pk[SLEN / 2];
#pragma unroll
            for (int i = 0; i < SLEN; ++i) {
                const float bv = bs[(seg * SLEN + i) * BS + kl] + pre;
                bs[(seg * SLEN + i) * BS + kl] = bv;
                const float kh = bf2f(ks[(seg * SLEN + i) * QS + kl]) * __expf(tot - bv);
                if (i & 1) pk[i >> 1] |= ((unsigned)f2bf(kh)) << 16; else pk[i >> 1] = (unsigned)f2bf(kh);
            }
            unsigned* dst = (unsigned*)(kht + kl * VS + seg * SLEN);
#pragma unroll
            for (int i = 0; i < SLEN / 2; ++i) dst[i] = pk[i];
        }
        SCAN_SYNC();
        for (int blk = wave; blk < 10; blk += 8) {
            int bi, bj;
            if (blk < 1) { bi = 0; bj = 0; } else if (blk < 3) { bi = 1; bj = blk - 1; } else if (blk < 6) { bi = 2; bj = blk - 3; } else { bi = 3; bj = blk - 6; }
            f32x4 acc = f32x4{0.f, 0.f, 0.f, 0.f};
            const int srow = bj * 16 + fr, trow = bi * 16 + fr;
#pragma unroll
            for (int kk = 0; kk < KS; ++kk) {
                const int k0 = kk * 32 + fq * 8;
                float br[8];
                if (bi == 0) {
#pragma unroll
                    for (int j = 0; j < 8; ++j) br[j] = 0.f;
                } else {
                    const float4 r0 = *(const float4*)(bs + (bi * 16 - 1) * BS + k0), r1 = *(const float4*)(bs + (bi * 16 - 1) * BS + k0 + 4);
                    br[0] = r0.x; br[1] = r0.y; br[2] = r0.z; br[3] = r0.w; br[4] = r1.x; br[5] = r1.y; br[6] = r1.z; br[7] = r1.w;
                }
                const uint4 kq = *(const uint4*)(ks + srow * QS + k0), qq = *(const uint4*)(qs + trow * QS + k0);
                const float4 s0 = *(const float4*)(bs + srow * BS + k0), s1 = *(const float4*)(bs + srow * BS + k0 + 4);
                const float4 t0_ = *(const float4*)(bs + trow * BS + k0), t1_ = *(const float4*)(bs + trow * BS + k0 + 4);
                const float bsv[8] = {s0.x, s0.y, s0.z, s0.w, s1.x, s1.y, s1.z, s1.w}, btv[8] = {t0_.x, t0_.y, t0_.z, t0_.w, t1_.x, t1_.y, t1_.z, t1_.w};
                const unsigned kw[4] = {kq.x, kq.y, kq.z, kq.w}, qw[4] = {qq.x, qq.y, qq.z, qq.w};
                union { bf16x8 v; unsigned u[4]; } ka, qb;
#pragma unroll
                for (int j = 0; j < 4; ++j) {
                    const float e0 = __expf(fminf(br[2 * j] - bsv[2 * j], 60.f)), e1 = __expf(fminf(br[2 * j + 1] - bsv[2 * j + 1], 60.f));
                    ka.u[j] = pack2(bflo(kw[j]) * e0, bfhi(kw[j]) * e1);
                    const float f0 = __expf(btv[2 * j] - br[2 * j]), f1 = __expf(btv[2 * j + 1] - br[2 * j + 1]);
                    qb.u[j] = pack2(bflo(qw[j]) * f0, bfhi(qw[j]) * f1);
                }
                acc = __builtin_amdgcn_mfma_f32_16x16x32_bf16(ka.v, qb.v, acc, 0, 0, 0);
            }
            if (bi == bj) {
#pragma unroll
                for (int r = 0; r < 4; ++r) if (4 * fq + r > fr) acc[r] = 0.f;
            }
            uint2 o; o.x = pack2(acc[0], acc[1]); o.y = pack2(acc[2], acc[3]);
            *(uint2*)(At + trow * VS + bj * 16 + 4 * fq) = o;
        }
        {
            unsigned z_ = 0u; asm volatile("" : "+v"(z_));
            if (wave == 2) *(uint2*)(At + (0 * 16 + fr) * VS + 16 + 4 * fq) = make_uint2(z_, z_);
            if (wave == 3) *(uint2*)(At + (2 * 16 + fr) * VS + 48 + 4 * fq) = make_uint2(z_, z_);
        }
        SCAN_SYNC();
        f32x4 oacc[4]; uint2 gz[4];
        {
            const int ti = wave & 3, vh = wave >> 2, trow = ti * 16 + fr;
            bf16x8 qh[KS];
#pragma unroll
            for (int kk = 0; kk < KS; ++kk) {
                const int k0 = kk * 32 + fq * 8;
                const uint4 qq = *(const uint4*)(qs + trow * QS + k0);
                const float4 t0_ = *(const float4*)(bs + trow * BS + k0), t1_ = *(const float4*)(bs + trow * BS + k0 + 4);
                union { bf16x8 v; unsigned u[4]; } q_;
                q_.u[0] = pack2(bflo(qq.x) * __expf(t0_.x), bfhi(qq.x) * __expf(t0_.y));
                q_.u[1] = pack2(bflo(qq.y) * __expf(t0_.z), bfhi(qq.y) * __expf(t0_.w));
                q_.u[2] = pack2(bflo(qq.z) * __expf(t1_.x), bfhi(qq.z) * __expf(t1_.y));
                q_.u[3] = pack2(bflo(qq.w) * __expf(t1_.z), bfhi(qq.w) * __expf(t1_.w));
                qh[kk] = q_.v;
            }
            const bf16x8 af0 = *(const bf16x8*)(At + trow * VS + fq * 8), af1 = *(const bf16x8*)(At + trow * VS + 32 + fq * 8);
            float sq = 0.f;
#pragma unroll
            for (int vi = 0; vi < 4; ++vi) {
                const int vrow = vh * 64 + vi * 16 + fr;
                gz[vi] = *(const uint2*)(Zc + (size_t)trow * LDZ + GCOL + vh * 64 + vi * 16 + 4 * fq);
                f32x4 acc = f32x4{0.f, 0.f, 0.f, 0.f};
                acc = __builtin_amdgcn_mfma_f32_16x16x32_bf16(*(const bf16x8*)(vt + vrow * VS + fq * 8), af0, acc, 0, 0, 0);
                if (ti >= 2) acc = __builtin_amdgcn_mfma_f32_16x16x32_bf16(*(const bf16x8*)(vt + vrow * VS + 32 + fq * 8), af1, acc, 0, 0, 0);
#pragma unroll
                for (int kk = 0; kk < KS; ++kk)
                    acc = __builtin_amdgcn_mfma_f32_16x16x32_bf16(*(const bf16x8*)(st + vrow * QS + kk * 32 + fq * 8), qh[kk], acc, 0, 0, 0);
                oacc[vi] = acc * scale;
                sq += oacc[vi][0] * oacc[vi][0] + oacc[vi][1] * oacc[vi][1] + oacc[vi][2] * oacc[vi][2] + oacc[vi][3] * oacc[vi][3];
            }
            sq += shx<16>(sq); sq += shx<32>(sq);
            if (fq == 0) ssq[vh * 64 + trow] = sq;
        }
        {
            const int vrow = wave * 16 + fr;
            const bf16x8 vf0 = *(const bf16x8*)(vt + vrow * VS + fq * 8), vf1 = *(const bf16x8*)(vt + vrow * VS + 32 + fq * 8);
#pragma unroll
            for (int kt = 0; kt < KT; ++kt) {
                const float dec = __expf(blast[kt * 16 + fr]);
                sacc[kt][0] *= dec; sacc[kt][1] *= dec; sacc[kt][2] *= dec; sacc[kt][3] *= dec;
                sacc[kt] = __builtin_amdgcn_mfma_f32_16x16x32_bf16(vf0, *(const bf16x8*)(kht + (kt * 16 + fr) * VS + fq * 8), sacc[kt], 0, 0, 0);
                sacc[kt] = __builtin_amdgcn_mfma_f32_16x16x32_bf16(vf1, *(const bf16x8*)(kht + (kt * 16 + fr) * VS + 32 + fq * 8), sacc[kt], 0, 0, 0);
            }
        }
        SCAN_SYNC();
#pragma unroll
        for (int kt = 0; kt < KT; ++kt)
#pragma unroll
            for (int r = 0; r < 4; ++r) st[(wave * 16 + 4 * fq + r) * QS + kt * 16 + fr] = f2bf(sacc[kt][r]);
        {
            const int ti = wave & 3, vh = wave >> 2, trow = ti * 16 + fr;
            const float rstd = rsqrtf((ssq[trow] + ssq[64 + trow]) * (1.f / 128.f) + 1e-6f);
            bf16_t* yrow = (bf16_t*)(p.ws + WS_Y) + (size_t)(b * 2048 + c * 64 + trow) * 1536 + (GLA ? 1024 : 0) + h * 128 + vh * 64 + 4 * fq;
#pragma unroll
            for (int vi = 0; vi < 4; ++vi) {
                const f32x4 g4_ = gn4[vi]; const float4 g4 = make_float4(g4_[0], g4_[1], g4_[2], g4_[3]);
                const float z0 = bflo(gz[vi].x), z1 = bfhi(gz[vi].x), z2 = bflo(gz[vi].y), z3 = bfhi(gz[vi].y);
                uint2 o;
                o.x = pack2(oacc[vi][0] * rstd * g4.x * (z0 * sigm(z0)), oacc[vi][1] * rstd * g4.y * (z1 * sigm(z1)));
                o.y = pack2(oacc[vi][2] * rstd * g4.z * (z2 * sigm(z2)), oacc[vi][3] * rstd * g4.w * (z3 * sigm(z3)));
                *(uint2*)(yrow + vi * 16) = o;
            }
        }
    }
    SCAN_SYNC();
}

__device__ void dsaprep2_item(const Params& p, int l, int item, char* smem_) {
    bf16_t* tile = (bf16_t*)smem_;
    const int tid = TIDX(), lane = tid & 63, wave = tid >> 6;
    bf16_t* Z = (bf16_t*)(p.ws + WS_Z); bf16_t* VT = (bf16_t*)(p.ws + WS_VT);
    {
        const int tb = item * 32;
        {
            const float2 gq = *(const float2*)(p.dsa_qn + l * 128 + lane * 2), gk = *(const float2*)(p.dsa_kn + l * 128 + lane * 2);
            unsigned uu[4][8];
#pragma unroll
            for (int j = 0; j < 4; ++j)
#pragma unroll
                for (int grp = 0; grp < 8; ++grp)
                    uu[j][grp] = *(const unsigned*)(Z + (size_t)(tb + wave + 8 * j) * LDZ + (grp < 4 ? ZB_Q : ZB_K) + (grp & 3) * 128 + lane * 2);
#pragma unroll
            for (int j = 0; j < 4; ++j)
#pragma unroll
                for (int grp = 0; grp < 8; ++grp) {
                    bf16_t* ptr = Z + (size_t)(tb + wave + 8 * j) * LDZ + (grp < 4 ? ZB_Q : ZB_K) + (grp & 3) * 128 + lane * 2;
                    const float a = bflo(uu[j][grp]), b = bfhi(uu[j][grp]);
                    const float ss = wave_sum(a * a + b * b);
                    const float r = rsqrtf(ss * (1.f / 128.f) + 1e-6f) * ((grp < 4) ? 0.08838834764831845f : 1.f);
                    const float2 g = (grp < 4) ? gq : gk;
                    __hip_atomic_store((unsigned*)ptr, pack2(a * r * g.x, b * r * g.y), __ATOMIC_RELAXED, __HIP_MEMORY_SCOPE_AGENT);
                }
        }
        u32x4 uv[4];
#pragma unroll
        for (int i = 0; i < 4; ++i) { const int ch = tid + i * 512; uv[i] = *(const u32x4*)(Z + (size_t)(tb + (ch >> 6)) * LDZ + ZB_V + (ch & 63) * 8); }
#pragma unroll
        for (int i = 0; i < 4; ++i) {
            const int ch = tid + i * 512, t = ch >> 6, c8 = (ch & 63) * 8;
            unsigned* d = (unsigned*)(tile + t * 514 + c8);
            d[0] = uv[i][0]; d[1] = uv[i][1]; d[2] = uv[i][2]; d[3] = uv[i][3];
        }
        __syncthreads();
        {
            const int c = tid, b = tb >> 11, s0 = tb & 2047;
            unsigned w[16];
#pragma unroll
            for (int j = 0; j < 16; ++j) w[j] = (unsigned)tile[(2 * j) * 514 + c] | ((unsigned)tile[(2 * j + 1) * 514 + c] << 16);
            unsigned long long* dst = (unsigned long long*)(VT + ((size_t)(b * 512 + c)) * 2048 + s0);
#pragma unroll
            for (int j = 0; j < 8; ++j) __hip_atomic_store(dst + j, ((unsigned long long)w[2 * j + 1] << 32) | w[2 * j], __ATOMIC_RELAXED, __HIP_MEMORY_SCOPE_AGENT);
        }
        __syncthreads();
    }
}

__device__ void dsa_select_tile(const Params& p, int b, int tq, char* smem_) {
    constexpr int KS_ = 2052;
    unsigned* keyL = (unsigned*)smem_;
    const int tid = TIDX(), lane = tid & 63, wave = __builtin_amdgcn_readfirstlane(tid >> 6), fr = lane & 15, fq = lane >> 4;
    const bf16_t* Z = (const bf16_t*)(p.ws + WS_Z);
    unsigned long long* BM64 = (unsigned long long*)(p.ws + WS_BM);
    const int t0 = tq * 16;
    {
        const int tl = t0 + fr;
        const size_t trow = (size_t)b * 2048 + tl;
        bf16x8 qf[4][2];
#pragma unroll
        for (int h = 0; h < 4; ++h)
#pragma unroll
            for (int ks = 0; ks < 2; ++ks) qf[h][ks] = *(const bf16x8*)(Z + trow * LDZ + ZB_QI + h * 64 + ks * 32 + fq * 8);
        float w[4];
#pragma unroll
        for (int h = 0; h < 4; ++h) w[h] = bf2f(Z[trow * LDZ + ZB_WI + h]) * 0.5f;
#pragma unroll 4
        for (int kt = wave; kt <= tq; kt += 8) {
            const bf16_t* kr = Z + ((size_t)b * 2048 + kt * 16 + fr) * LDZ + ZB_KI + fq * 8;
            const bf16x8 k0 = *(const bf16x8*)kr, k1 = *(const bf16x8*)(kr + 32);
            f32x4 acc[4];
#pragma unroll
            for (int h = 0; h < 4; ++h) {
                acc[h] = __builtin_amdgcn_mfma_f32_16x16x32_bf16(k0, qf[h][0], f32x4{0.f, 0.f, 0.f, 0.f}, 0, 0, 0);
                acc[h] = __builtin_amdgcn_mfma_f32_16x16x32_bf16(k1, qf[h][1], acc[h], 0, 0, 0);
            }
            u32x4 kk;
#pragma unroll
            for (int r = 0; r < 4; ++r) {
                float sc = w[0] * fmaxf(acc[0][r] * 0.125f, 0.f) + w[1] * fmaxf(acc[1][r] * 0.125f, 0.f) + w[2] * fmaxf(acc[2][r] * 0.125f, 0.f) + w[3] * fmaxf(acc[3][r] * 0.125f, 0.f);
                if (sc == 0.f) sc = 0.f;
                const unsigned u = __float_as_uint(sc);
                const unsigned k = (u & 0x80000000u) ? ~u : (u | 0x80000000u);
                kk[r] = (kt * 16 + 4 * fq + r <= tl) ? k : 0u;
            }
            *(u32x4*)(keyL + fr * KS_ + kt * 16 + 4 * fq) = kk;
        }
    }
    __syncthreads();
    {
        const int nk = (tq + 1) * 16, jmax = (nk + 63) >> 6;
        const int qa = 2 * wave, qb = qa + 1;
        unsigned ka[32], kb[32];
#pragma unroll
        for (int j = 0; j < 32; ++j) {
            const int s = lane + 64 * j;
            ka[j] = (s < nk) ? keyL[qa * KS_ + s] : 0u;
            kb[j] = (s < nk) ? keyL[qb * KS_ + s] : 0u;
        }
        unsigned Ta = 1u, Tb = 1u; int Ca = 2047, Cb = 2047;
        if (t0 >= 256) {
            int na, nb;
            bool da, db;
            {
                int c0 = 0, c1 = 0, c2 = 0, c3 = 0;
#pragma unroll
                for (int j = 0; j < 32; ++j)
                    if (j < jmax) { c0 += (ka[j] >= 0x80000000u); c1 += (ka[j] > 0x80000000u); c2 += (kb[j] >= 0x80000000u); c3 += (kb[j] > 0x80000000u); }
                c0 = wave_total_i(c0); c1 = wave_total_i(c1); c2 = wave_total_i(c2); c3 = wave_total_i(c3);
                da = (c1 < 256 && c0 >= 256); db = (c3 < 256 && c2 >= 256);
                Ta = da ? 0x80000000u : ((c0 >= 256) ? 0x80000000u : 0u); na = da ? c0 : ((c0 >= 256) ? c0 : 0x7fffffff);
                Tb = db ? 0x80000000u : ((c2 >= 256) ? 0x80000000u : 0u); nb = db ? c2 : ((c2 >= 256) ? c2 : 0x7fffffff);
            }
            for (int bit = 30; bit >= 0; --bit) {
                if (da && db) break;
                const unsigned ca_ = Ta | (1u << bit), cb_ = Tb | (1u << bit);
                int c0 = 0, c1 = 0;
#pragma unroll
                for (int j = 0; j < 32; ++j)
                    if (j < jmax) { c0 += (ka[j] >= ca_); c1 += (kb[j] >= cb_); }
                c0 = wave_total_i(c0); c1 = wave_total_i(c1);
                if (!da && c0 >= 256) { Ta = ca_; na = c0; }
                if (!db && c1 >= 256) { Tb = cb_; nb = c1; }
                da = da || (na == 256); db = db || (nb == 256);
            }
            if (na != 256 || nb != 256) {
                int needa, needb;
                {
                    int c0 = 0, c1 = 0;
#pragma unroll
                    for (int j = 0; j < 32; ++j)
                        if (j < jmax) { c0 += (ka[j] > Ta); c1 += (kb[j] > Tb); }
                    needa = 256 - wave_total_i(c0); needb = 256 - wave_total_i(c1);
                }
                Ca = 0; Cb = 0;
                for (int bit = 10; bit >= 0; --bit) {
                    const int ca_ = Ca | (1 << bit), cb_ = Cb | (1 << bit);
                    int c0 = 0, c1 = 0;
#pragma unroll
                    for (int j = 0; j < 32; ++j)
                        if (j < jmax) { const int s = lane + 64 * j; c0 += (ka[j] == Ta && s < ca_); c1 += (kb[j] == Tb && s < cb_); }
                    c0 = wave_total_i(c0); c1 = wave_total_i(c1);
                    if (c0 < needa) Ca = ca_;
                    if (c1 < needb) Cb = cb_;
                }
            }
        }
        const size_t rowa = (size_t)b * 2048 + t0 + qa;
#pragma unroll
        for (int j = 0; j < 32; ++j) {
            const int s = lane + 64 * j;
            const unsigned long long ma = __ballot((ka[j] > Ta) || (ka[j] == Ta && s <= Ca));
            const unsigned long long mb = __ballot((kb[j] > Tb) || (kb[j] == Tb && s <= Cb));
            if (lane == 0) {
                __hip_atomic_store(&BM64[rowa * 32 + j], ma, __ATOMIC_RELAXED, __HIP_MEMORY_SCOPE_AGENT);
                __hip_atomic_store(&BM64[(rowa + 1) * 32 + j], mb, __ATOMIC_RELAXED, __HIP_MEMORY_SCOPE_AGENT);
            }
        }
    }
    __syncthreads();
}

__device__ void dsa_attn_item(const Params& p, int b, int h, int qg, char* smem_) {
    constexpr int KSTR = 136, VSTR = 40;
    bf16_t* Kl = (bf16_t*)smem_;
    bf16_t* Vl = Kl + 2 * 32 * KSTR;
    const int tid = TIDX(), lane = tid & 63, wave = __builtin_amdgcn_readfirstlane(tid >> 6), fr = lane & 15, fq = lane >> 4;
    const bf16_t* Z = (const bf16_t*)(p.ws + WS_Z); const bf16_t* VT = (const bf16_t*)(p.ws + WS_VT);
    const unsigned* BM = (const unsigned*)(p.ws + WS_BM); bf16_t* Y = (bf16_t*)(p.ws + WS_Y);
    const int kr = tid >> 4, kc = tid & 15, vd = tid >> 2, vc = tid & 3;
    const int ka_row = 8 * (fr >> 2) + (fr & 3);
    {
        const int t0 = qg * 128 + wave * 16;
        const size_t trow = (size_t)b * 2048 + t0 + fr;
        bf16x8 qf[4];
#pragma unroll
        for (int ks = 0; ks < 4; ++ks) qf[ks] = *(const bf16x8*)(Z + trow * LDZ + ZB_Q + h * 128 + ks * 32 + fq * 8);
        f32x4 o[8];
#pragma unroll
        for (int i = 0; i < 8; ++i) o[i] = f32x4{0.f, 0.f, 0.f, 0.f};
        float m = -INFINITY, lsum = 0.f;
        const unsigned* bmrow = BM + trow * 64;
        const int nsteps_blk = qg * 4 + 4, nsteps_w = (t0 + 15) / 32 + 1;
        const bf16_t* kg = Z + ((size_t)b * 2048 + kr) * LDZ + ZB_K + h * 128 + kc * 8;
        const bf16_t* vg = VT + ((size_t)(b * 4 + h) * 128 + vd) * 2048 + vc * 8;
        u32x4 rk = *(const u32x4*)kg, rv = *(const u32x4*)vg;
        *(u32x4*)(Kl + kr * KSTR + kc * 8) = rk; *(u32x4*)(Vl + vd * VSTR + vc * 8) = rv;
        __syncthreads();
        unsigned mwn = bmrow[0];
        for (int st = 0; st < nsteps_blk; ++st) {
            const bool more = (st + 1 < nsteps_blk);
            const unsigned mwc = mwn;
            mwn = bmrow[(st + 1 < nsteps_w) ? st + 1 : st];
            if (more) { rk = *(const u32x4*)(kg + (size_t)(st + 1) * 32 * LDZ); rv = *(const u32x4*)(vg + (st + 1) * 32); }
            if (st < nsteps_w) {
                const bf16_t* Kb = Kl + (st & 1) * 32 * KSTR; const bf16_t* Vb = Vl + (st & 1) * 128 * VSTR;
                f32x4 sa = f32x4{0.f, 0.f, 0.f, 0.f}, sb = f32x4{0.f, 0.f, 0.f, 0.f};
#pragma unroll
                for (int ks = 0; ks < 4; ++ks) {
                    const bf16x8 fa = *(const bf16x8*)(Kb + ka_row * KSTR + ks * 32 + fq * 8), fb = *(const bf16x8*)(Kb + (ka_row + 4) * KSTR + ks * 32 + fq * 8);
                    sa = __builtin_amdgcn_mfma_f32_16x16x32_bf16(fa, qf[ks], sa, 0, 0, 0);
                    sb = __builtin_amdgcn_mfma_f32_16x16x32_bf16(fb, qf[ks], sb, 0, 0, 0);
                }
                const unsigned mw = mwc >> (8 * fq);
                float x[8];
#pragma unroll
                for (int r = 0; r < 4; ++r) { x[r] = ((mw >> r) & 1u) ? sa[r] : -INFINITY; x[4 + r] = ((mw >> (4 + r)) & 1u) ? sb[r] : -INFINITY; }
                float mx = fmaxf(fmaxf(fmaxf(x[0], x[1]), fmaxf(x[2], x[3])), fmaxf(fmaxf(x[4], x[5]), fmaxf(x[6], x[7])));
                mx = fmaxf(mx, shx<16>(mx)); mx = fmaxf(mx, shx<32>(mx));
                const float mnew = fmaxf(m, mx);
                const float msafe = (mnew == -INFINITY) ? 0.f : mnew;
                const float alpha = __expf(m - msafe);
                float pe[8]; float ps = 0.f;
#pragma unroll
                for (int j = 0; j < 8; ++j) { pe[j] = __expf(x[j] - msafe); ps += pe[j]; }
                lsum = lsum * alpha + ps;
                m = mnew;
#pragma unroll
                for (int i = 0; i < 8; ++i) { o[i][0] *= alpha; o[i][1] *= alpha; o[i][2] *= alpha; o[i][3] *= alpha; }
                union { bf16x8 v; unsigned u[4]; } pf;
                pf.u[0] = pack2(pe[0], pe[1]); pf.u[1] = pack2(pe[2], pe[3]); pf.u[2] = pack2(pe[4], pe[5]); pf.u[3] = pack2(pe[6], pe[7]);
#pragma unroll
                for (int i = 0; i < 8; ++i) {
                    const bf16x8 vf = *(const bf16x8*)(Vb + (i * 16 + fr) * VSTR + fq * 8);
                    o[i] = __builtin_amdgcn_mfma_f32_16x16x32_bf16(vf, pf.v, o[i], 0, 0, 0);
                }
            }
            if (more) { *(u32x4*)(Kl + ((st + 1) & 1) * 32 * KSTR + kr * KSTR + kc * 8) = rk; *(u32x4*)(Vl + ((st + 1) & 1) * 128 * VSTR + vd * VSTR + vc * 8) = rv; }
            __syncthreads();
        }
        lsum += shx<16>(lsum); lsum += shx<32>(lsum);
        const float inv = 1.f / lsum;
#pragma unroll
        for (int i = 0; i < 8; ++i) {
            uint2 ov; ov.x = pack2(o[i][0] * inv, o[i][1] * inv); ov.y = pack2(o[i][2] * inv, o[i][3] * inv);
            *(uint2*)(Y + trow * 1536 + 512 + h * 128 + i * 16 + 4 * fq) = ov;
        }
    }
}

constexpr int LDS_BYTES = 155648;
__device__ void ph_mixA(const Params& p, int l, int vb0, int nvb, char* smem_) {
    for (int item = vb0; item < 64; item += nvb) {
        if (item < 32) scan2_item<128, false>(p, l, item >> 2, item & 3, smem_);
        else scan2_item<64, true>(p, l, (item - 32) >> 2, (item - 32) & 3, smem_);
    }
    unsigned* ctr = (unsigned*)(p.ws + WS_CTL) + 3584 + l * 64;
    unsigned* done = (unsigned*)(p.ws + WS_CTL) + 5300 + l * 8 * 16;
    volatile int* slot = (volatile int*)(smem_ + LDS_BYTES - 64);
    for (;;) {
        if (TIDX() == 0) *slot = (int)atomicAdd(ctr, 1u);
        __syncthreads();
        const int idx = __builtin_amdgcn_readfirstlane(*slot);
        __syncthreads();
        if (idx >= 2048) break;
        if (idx < 1536) {
            const int b = idx / 192, r = idx % 192;
            if (r < 128) dsa_select_tile(p, b, 127 - r, smem_);
            else dsaprep2_item(p, l, b * 64 + (r - 128), smem_);
            asm volatile("s_waitcnt vmcnt(0)" ::: "memory");
            __syncthreads();
            if (TIDX() == 0) __hip_atomic_fetch_add(done + b * 16, 1u, __ATOMIC_RELAXED, __HIP_MEMORY_SCOPE_AGENT);
        } else {
            const int a = idx - 1536, b = a >> 6, h = (a >> 4) & 3, qg = 15 - (a & 15);
            if (TIDX() == 0) {
                unsigned spins = 0;
                while (__hip_atomic_load(done + b * 16, __ATOMIC_RELAXED, __HIP_MEMORY_SCOPE_AGENT) < 192u) { __builtin_amdgcn_s_sleep(2); if (++spins > (1u << 18)) break; }
                __builtin_amdgcn_fence(__ATOMIC_ACQUIRE, "agent");
                asm volatile("s_waitcnt vmcnt(0)" ::: "memory");
            }
            __syncthreads();
            dsa_attn_item(p, b, h, qg, smem_);
        }
    }
}

__device__ __forceinline__ int f2sort(float f) { int i = __float_as_int(f); return i ^ ((i >> 31) & 0x7fffffff); }
__device__ __forceinline__ float sort2f(int i) { return __int_as_float(i ^ ((i >> 31) & 0x7fffffff)); }
#define INSK(K, xv) do { int _x = (xv); \
    _Pragma("unroll") for (int _j = 0; _j < 16; ++_j) { int _hi = max(K[_j], _x); _x = min(K[_j], _x); K[_j] = _hi; } } while (0)
#define INS64(K, xv) do { unsigned long long _x = (xv); \
    _Pragma("unroll") for (int _j = 0; _j < 16; ++_j) { bool _c = _x > K[_j]; unsigned long long _o = K[_j]; K[_j] = _c ? _x : _o; _x = _c ? _o : _x; } } while (0)

#define CE32(x, y) do { const int _h = max(x, y); y = min(x, y); x = _h; } while (0)
#define CE64(x, y) do { const bool _c = (y) > (x); const unsigned long long _t = x; x = _c ? y : x; y = _c ? _t : y; } while (0)
#define SORT16_I(K) do { CE32(K[0], K[1]); CE32(K[2], K[3]); CE32(K[4], K[5]); CE32(K[6], K[7]); CE32(K[8], K[9]); CE32(K[10], K[11]); CE32(K[12], K[13]); CE32(K[14], K[15]); CE32(K[0], K[2]); CE32(K[1], K[3]); CE32(K[4], K[6]); CE32(K[5], K[7]); CE32(K[8], K[10]); CE32(K[9], K[11]); CE32(K[12], K[14]); CE32(K[13], K[15]); CE32(K[1], K[2]); CE32(K[5], K[6]); CE32(K[9], K[10]); CE32(K[13], K[14]); CE32(K[0], K[4]); CE32(K[1], K[5]); CE32(K[2], K[6]); CE32(K[3], K[7]); CE32(K[8], K[12]); CE32(K[9], K[13]); CE32(K[10], K[14]); CE32(K[11], K[15]); CE32(K[2], K[4]); CE32(K[3], K[5]); CE32(K[10], K[12]); CE32(K[11], K[13]); CE32(K[1], K[2]); CE32(K[3], K[4]); CE32(K[5], K[6]); CE32(K[9], K[10]); CE32(K[11], K[12]); CE32(K[13], K[14]); CE32(K[0], K[8]); CE32(K[1], K[9]); CE32(K[2], K[10]); CE32(K[3], K[11]); CE32(K[4], K[12]); CE32(K[5], K[13]); CE32(K[6], K[14]); CE32(K[7], K[15]); CE32(K[4], K[8]); CE32(K[5], K[9]); CE32(K[6], K[10]); CE32(K[7], K[11]); CE32(K[2], K[4]); CE32(K[3], K[5]); CE32(K[6], K[8]); CE32(K[7], K[9]); CE32(K[10], K[12]); CE32(K[11], K[13]); CE32(K[1], K[2]); CE32(K[3], K[4]); CE32(K[5], K[6]); CE32(K[7], K[8]); CE32(K[9], K[10]); CE32(K[11], K[12]); CE32(K[13], K[14]); } while (0)
#define BITONIC16_I(K) do { CE32(K[0], K[8]); CE32(K[1], K[9]); CE32(K[2], K[10]); CE32(K[3], K[11]); CE32(K[4], K[12]); CE32(K[5], K[13]); CE32(K[6], K[14]); CE32(K[7], K[15]); CE32(K[0], K[4]); CE32(K[1], K[5]); CE32(K[2], K[6]); CE32(K[3], K[7]); CE32(K[8], K[12]); CE32(K[9], K[13]); CE32(K[10], K[14]); CE32(K[11], K[15]); CE32(K[0], K[2]); CE32(K[1], K[3]); CE32(K[4], K[6]); CE32(K[5], K[7]); CE32(K[8], K[10]); CE32(K[9], K[11]); CE32(K[12], K[14]); CE32(K[13], K[15]); CE32(K[0], K[1]); CE32(K[2], K[3]); CE32(K[4], K[5]); CE32(K[6], K[7]); CE32(K[8], K[9]); CE32(K[10], K[11]); CE32(K[12], K[13]); CE32(K[14], K[15]); } while (0)
#define SORT16_L(K) do { CE64(K[0], K[1]); CE64(K[2], K[3]); CE64(K[4], K[5]); CE64(K[6], K[7]); CE64(K[8], K[9]); CE64(K[10], K[11]); CE64(K[12], K[13]); CE64(K[14], K[15]); CE64(K[0], K[2]); CE64(K[1], K[3]); CE64(K[4], K[6]); CE64(K[5], K[7]); CE64(K[8], K[10]); CE64(K[9], K[11]); CE64(K[12], K[14]); CE64(K[13], K[15]); CE64(K[1], K[2]); CE64(K[5], K[6]); CE64(K[9], K[10]); CE64(K[13], K[14]); CE64(K[0], K[4]); CE64(K[1], K[5]); CE64(K[2], K[6]); CE64(K[3], K[7]); CE64(K[8], K[12]); CE64(K[9], K[13]); CE64(K[10], K[14]); CE64(K[11], K[15]); CE64(K[2], K[4]); CE64(K[3], K[5]); CE64(K[10], K[12]); CE64(K[11], K[13]); CE64(K[1], K[2]); CE64(K[3], K[4]); CE64(K[5], K[6]); CE64(K[9], K[10]); CE64(K[11], K[12]); CE64(K[13], K[14]); CE64(K[0], K[8]); CE64(K[1], K[9]); CE64(K[2], K[10]); CE64(K[3], K[11]); CE64(K[4], K[12]); CE64(K[5], K[13]); CE64(K[6], K[14]); CE64(K[7], K[15]); CE64(K[4], K[8]); CE64(K[5], K[9]); CE64(K[6], K[10]); CE64(K[7], K[11]); CE64(K[2], K[4]); CE64(K[3], K[5]); CE64(K[6], K[8]); CE64(K[7], K[9]); CE64(K[10], K[12]); CE64(K[11], K[13]); CE64(K[1], K[2]); CE64(K[3], K[4]); CE64(K[5], K[6]); CE64(K[7], K[8]); CE64(K[9], K[10]); CE64(K[11], K[12]); CE64(K[13], K[14]); } while (0)
#define BITONIC16_L(K) do { CE64(K[0], K[8]); CE64(K[1], K[9]); CE64(K[2], K[10]); CE64(K[3], K[11]); CE64(K[4], K[12]); CE64(K[5], K[13]); CE64(K[6], K[14]); CE64(K[7], K[15]); CE64(K[0], K[4]); CE64(K[1], K[5]); CE64(K[2], K[6]); CE64(K[3], K[7]); CE64(K[8], K[12]); CE64(K[9], K[13]); CE64(K[10], K[14]); CE64(K[11], K[15]); CE64(K[0], K[2]); CE64(K[1], K[3]); CE64(K[4], K[6]); CE64(K[5], K[7]); CE64(K[8], K[10]); CE64(K[9], K[11]); CE64(K[12], K[14]); CE64(K[13], K[15]); CE64(K[0], K[1]); CE64(K[2], K[3]); CE64(K[4], K[5]); CE64(K[6], K[7]); CE64(K[8], K[9]); CE64(K[10], K[11]); CE64(K[12], K[13]); CE64(K[14], K[15]); } while (0)
#define TOP16_I(R, G) do { _Pragma("unroll") for (int _j = 0; _j < 16; ++_j) R[_j] = max(R[_j], G[15 - _j]); BITONIC16_I(R); } while (0)
#define TOP16_L(R, G) do { _Pragma("unroll") for (int _j = 0; _j < 16; ++_j) R[_j] = (G[15 - _j] > R[_j]) ? G[15 - _j] : R[_j]; BITONIC16_L(R); } while (0)
__device__ void ph_route(const Params& p, int vb0, int nvb, char* smem_) {
    typedef _Float16 h8 __attribute__((ext_vector_type(8)));
    const _Float16* SC = (const _Float16*)(p.ws + WS_SC);
    int* RI = (int*)(p.ws + WS_RI); float* RG = (float*)(p.ws + WS_RG);
    const int tid = TIDX(), lane = tid & 63, wave = tid >> 6;
    _Float16* tile = (_Float16*)smem_ + wave * (64 * 72);
    for (int item0 = (vb0 * 8 + wave) * 64; item0 < T_TOK * 8; item0 += nvb * 8 * 64) {
        const int item = item0 + lane;
        const int t = item >> 3, h = item & 7;
        const _Float16* s0 = SC + (size_t)t * 2048 + h * 256;
        const _Float16* wbase = SC + (size_t)item0 * 256;
        int k0[16], k1[16];
#pragma unroll
        for (int j = 0; j < 16; ++j) { k0[j] = (int)0x80000000; k1[j] = (int)0x80000000; }
#pragma unroll 1
        for (int slab = 0; slab < 4; ++slab) {
            h8 ld[8];
#pragma unroll
            for (int j = 0; j < 4; ++j) {
                const _Float16* src = wbase + (size_t)(16 * j + (lane >> 2)) * 256 + slab * 32 + (lane & 3) * 8;
                ld[j] = *(const h8*)src; ld[4 + j] = *(const h8*)(src + 128);
            }
            __builtin_amdgcn_wave_barrier();
#pragma unroll
            for (int j = 0; j < 4; ++j) {
                _Float16* dst = tile + (16 * j + (lane >> 2)) * 72 + (lane & 3) * 8;
                *(h8*)dst = ld[j]; *(h8*)(dst + 32) = ld[4 + j];
            }
            __builtin_amdgcn_fence(__ATOMIC_RELEASE, "wavefront");
            __builtin_amdgcn_wave_barrier();
            __builtin_amdgcn_fence(__ATOMIC_ACQUIRE, "wavefront");
#pragma unroll
            for (int ii = 0; ii < 32; ii += 16) {
                const int i = slab * 32 + ii;
                const h8 a0 = *(const h8*)(tile + lane * 72 + ii), a1 = *(const h8*)(tile + lane * 72 + ii + 8);
                const h8 b0 = *(const h8*)(tile + lane * 72 + 32 + ii), b1 = *(const h8*)(tile + lane * 72 + 32 + ii + 8);
                int ga[16], gb[16];
#pragma unroll
                for (int e_ = 0; e_ < 8; ++e_) {
                    ga[e_] = (f2sort((float)a0[e_]) & ~127) | (127 - i - e_); ga[8 + e_] = (f2sort((float)a1[e_]) & ~127) | (127 - i - 8 - e_);
                    gb[e_] = (f2sort((float)b0[e_]) & ~127) | (127 - i - e_); gb[8 + e_] = (f2sort((float)b1[e_]) & ~127) | (127 - i - 8 - e_);
                }
                SORT16_I(ga); TOP16_I(k0, ga);
                SORT16_I(gb); TOP16_I(k1, gb);
            }
            __builtin_amdgcn_wave_barrier();
        }
        float v0[16], v1[16];
#pragma unroll
        for (int j = 0; j < 16; ++j) { k0[j] = 127 - (k0[j] & 127); k1[j] = 127 - (k1[j] & 127); v0[j] = (float)s0[k0[j]]; v1[j] = (float)s0[128 + k1[j]]; }
#define CAND(a, b) ((((unsigned long long)((unsigned)f2sort(v0[a] + v1[b]) ^ 0x80000000u)) << 32) | (((unsigned)(255 - ((a) * 16 + (b))) << 16) | (unsigned)(k0[a] * 128 + k1[b])))
        unsigned long long ck[16], m1[16], m2[16];
#pragma unroll
        for (int j = 0; j < 16; ++j) ck[j] = CAND(0, j);
#pragma unroll
        for (int j = 0; j < 8; ++j) { m1[j] = CAND(1, j); m1[8 + j] = CAND(15 - j, 0); }
        BITONIC16_L(m1);
        m2[0] = CAND(2, 0); m2[1] = CAND(2, 1); m2[2] = CAND(2, 2); m2[3] = CAND(2, 3); m2[4] = CAND(2, 4);
        m2[5] = CAND(3, 0); m2[6] = CAND(3, 1); m2[7] = CAND(3, 2); m2[8] = CAND(3, 3);
        m2[9] = CAND(4, 0); m2[10] = CAND(4, 1); m2[11] = CAND(4, 2);
        m2[12] = CAND(5, 0); m2[13] = CAND(5, 1); m2[14] = CAND(6, 0); m2[15] = CAND(6, 1);
        SORT16_L(m2);
        TOP16_L(ck, m1);
        TOP16_L(ck, m2);
        INS64(ck, CAND(7, 0)); INS64(ck, CAND(7, 1));
#undef CAND
        float e[16]; float sm = 0.f;
        const float mx = sort2f((int)((unsigned)(ck[0] >> 32) ^ 0x80000000u));
#pragma unroll
        for (int j = 0; j < 16; ++j) { e[j] = expf(sort2f((int)((unsigned)(ck[j] >> 32) ^ 0x80000000u)) - mx); sm += e[j]; }
        const float inv = 1.f / sm;
#pragma unroll
        for (int j = 0; j < 16; j += 4) {
            *(int4*)(RI + (size_t)t * 128 + h * 16 + j) = make_int4((int)(ck[j] & 0xffffu), (int)(ck[j + 1] & 0xffffu), (int)(ck[j + 2] & 0xffffu), (int)(ck[j + 3] & 0xffffu));
            *(float4*)(RG + (size_t)t * 128 + h * 16 + j) = make_float4(e[j] * inv, e[j + 1] * inv, e[j + 2] * inv, e[j + 3] * inv);
        }
    }
}

__device__ __forceinline__ void fp8x16_to_f32(const uint4 q, float (&f)[16]) {
    const unsigned w[4] = {q.x, q.y, q.z, q.w};
#pragma unroll
    for (int c = 0; c < 4; ++c) {
        auto f0 = __builtin_amdgcn_cvt_pk_f32_fp8((int)w[c], false); auto f1 = __builtin_amdgcn_cvt_pk_f32_fp8((int)w[c], true);
        f[4 * c] = f0[0]; f[4 * c + 1] = f0[1]; f[4 * c + 2] = f1[0]; f[4 * c + 3] = f1[1];
    }
}
constexpr bool G2_MFMA = true;
constexpr bool G1_MFMA = true;
typedef float f32x2_t __attribute__((ext_vector_type(2)));
__device__ __forceinline__ float g1_half(const u32x4 (&uq)[8], const float (&hv)[16], int lane) {
    float part[8];
#pragma unroll
    for (int it = 0; it < 8; ++it) {
        f32x2_t d2 = {0.f, 0.f};
#pragma unroll
        for (int c_ = 0; c_ < 4; ++c_) {
            const f32x2_t f0 = __builtin_amdgcn_cvt_pk_f32_fp8((int)uq[it][c_], false), f1 = __builtin_amdgcn_cvt_pk_f32_fp8((int)uq[it][c_], true);
            d2 = __builtin_elementwise_fma(f32x2_t{hv[4 * c_], hv[4 * c_ + 1]}, f0, d2);
            d2 = __builtin_elementwise_fma(f32x2_t{hv[4 * c_ + 2], hv[4 * c_ + 3]}, f1, d2);
        }
        part[it] = d2[0] + d2[1];
    }
    float r4[4], r2[2];
    const bool b2_ = lane & 4, b1_ = lane & 2, b0_ = lane & 1;
#pragma unroll
    for (int j = 0; j < 4; ++j) { const float snd = b2_ ? part[j] : part[j + 4], kp = b2_ ? part[j + 4] : part[j]; r4[j] = kp + shx<4>(snd); }
#pragma unroll
    for (int j = 0; j < 2; ++j) { const float snd = b1_ ? r4[j] : r4[j + 2], kp = b1_ ? r4[j + 2] : r4[j]; r2[j] = kp + shx<2>(snd); }
    const float snd = b0_ ? r2[0] : r2[1], kp = b0_ ? r2[1] : r2[0];
    return kp + shx<1>(snd);
}
__device__ __forceinline__ void peer_gather8(u32x4 (&q)[8], const unsigned char* tab, const int* idx, unsigned l16) {
#pragma unroll
    for (int it = 0; it < 8; ++it) { const unsigned e_ = (unsigned)idx[it * 8]; q[it] = *(const u32x4*)(tab + ((e_ << 7) | l16)); }
}
template <bool PRE>
__device__ __forceinline__ void g1_step(int i, int t, const bf16_t* hrow_next, const unsigned char* ub, const int* lri_eg, unsigned l16, int lane, float* pp_row,
                                        u32x4& hq0, u32x4& hq1, u32x4 (&uqA)[8], u32x4 (&uqB)[8]) {
    float hv[16];
#pragma unroll
    for (int c_ = 0; c_ < 4; ++c_) { hv[2 * c_] = bflo(hq0[c_]); hv[2 * c_ + 1] = bfhi(hq0[c_]); hv[8 + 2 * c_] = bflo(hq1[c_]); hv[8 + 2 * c_ + 1] = bfhi(hq1[c_]); }
    if (PRE) { const u32x4* hp = (const u32x4*)hrow_next; hq0 = hp[0]; hq1 = hp[1]; }
    const float d0 = g1_half(uqA, hv, lane);
    __builtin_amdgcn_sched_barrier(0);
    if (PRE) { peer_gather8(uqA, ub, lri_eg + (i + 1) * 128, l16); __builtin_amdgcn_sched_barrier(0); }
    const float d1 = g1_half(uqB, hv, lane);
    __builtin_amdgcn_sched_barrier(0);
    if (PRE) { peer_gather8(uqB, ub, lri_eg + (i + 1) * 128 + 64, l16); __builtin_amdgcn_sched_barrier(0); }
    pp_row[0] = d0; pp_row[64] = d1;
}
template <bool PRE>
__device__ __forceinline__ void g2_step(int i, float2* op, const float2 gf, const unsigned char* vb_, const int* lri_eg, const float* lrg_eg, unsigned l16, int lane,
                                        u32x4 (&vqA)[8], u32x4 (&vqB)[8]) {
    const float2 xi = *op;
    f32x2_t y[8];
#pragma unroll
    for (int j = 0; j < 8; ++j) y[j] = f32x2_t{0.f, 0.f};
#pragma unroll
    for (int it = 0; it < 8; ++it) {
        const float ck = lrg_eg[i * 128 + it * 8]; const f32x2_t ck2 = {ck, ck};
#pragma unroll
        for (int c_ = 0; c_ < 4; ++c_) {
            y[2 * c_] = __builtin_elementwise_fma(ck2, __builtin_amdgcn_cvt_pk_f32_fp8((int)vqA[it][c_], false), y[2 * c_]);
            y[2 * c_ + 1] = __builtin_elementwise_fma(ck2, __builtin_amdgcn_cvt_pk_f32_fp8((int)vqA[it][c_], true), y[2 * c_ + 1]);
        }
    }
    __builtin_amdgcn_sched_barrier(0);
    if (PRE) { peer_gather8(vqA, vb_, lri_eg + (i + 1) * 128, l16); __builtin_amdgcn_sched_barrier(0); }
#pragma unroll
    for (int it = 0; it < 8; ++it) {
        const float ck = lrg_eg[i * 128 + 64 + it * 8]; const f32x2_t ck2 = {ck, ck};
#pragma unroll
        for (int c_ = 0; c_ < 4; ++c_) {
            y[2 * c_] = __builtin_elementwise_fma(ck2, __builtin_amdgcn_cvt_pk_f32_fp8((int)vqB[it][c_], false), y[2 * c_]);
            y[2 * c_ + 1] = __builtin_elementwise_fma(ck2, __builtin_amdgcn_cvt_pk_f32_fp8((int)vqB[it][c_], true), y[2 * c_ + 1]);
        }
    }
    __builtin_amdgcn_sched_barrier(0);
    if (PRE) { peer_gather8(vqB, vb_, lri_eg + (i + 1) * 128 + 64, l16); __builtin_amdgcn_sched_barrier(0); }
    float r8[8], r4[4], r2[2];
    const bool b5 = lane & 32, b4 = lane & 16, b3 = lane & 8;
#pragma unroll
    for (int j = 0; j < 8; ++j) { const float lo = y[j >> 1][j & 1], hi = y[4 + (j >> 1)][j & 1]; const float snd = b5 ? lo : hi, kp = b5 ? hi : lo; r8[j] = kp + shx<32>(snd); }
#pragma unroll
    for (int j = 0; j < 4; ++j) { const float snd = b4 ? r8[j] : r8[j + 4], kp = b4 ? r8[j + 4] : r8[j]; r4[j] = kp + shx<16>(snd); }
#pragma unroll
    for (int j = 0; j < 2; ++j) { const float snd = b3 ? r4[j] : r4[j + 2], kp = b3 ? r4[j + 2] : r4[j]; r2[j] = kp + shx<8>(snd); }
    *op = make_float2(xi.x + gf.x * r2[0], xi.y + gf.y * r2[1]);
}
typedef int i32x4_t __attribute__((ext_vector_type(4)));
typedef int i32x8_t __attribute__((ext_vector_type(8)));
constexpr int G1W = 18432;
__device__ __forceinline__ void g1m_dma(const unsigned char* ub, PG8_LAS unsigned char* img, const PG8_LAS unsigned short* idx, int i, int hh, int eg, unsigned q16) {
    const u32x4 w = *(const PG8_LAS u32x4*)(idx + ((i * 8 + eg) * 16 + hh * 8));
#pragma unroll
    for (int it = 0; it < 8; ++it) {
        const unsigned e_ = (it & 1) ? (w[it >> 1] >> 16) : (w[it >> 1] & 0xffffu);
        const unsigned off = (e_ << 7) | ((it & 1) ? (q16 ^ 64u) : q16);
        __builtin_amdgcn_global_load_lds((const unsigned*)(ub + off), (PG8_LAS unsigned*)(img + it * 1024), 16, 0, 0);
    }
}
template <bool PRE, int VMW>
__device__ __forceinline__ float g1m_step(const unsigned char* ub, PG8_LAS unsigned char* img, const PG8_LAS unsigned short* idx, int inext, int hh, int eg, unsigned q16,
                                          unsigned rdoff, int lane, const u32x4 a0, const u32x4 a1) {
    asm volatile("s_waitcnt vmcnt(%0)" :: "n"(VMW) : "memory");
    i32x8_t b[4];
#pragma unroll
    for (int mb = 0; mb < 4; ++mb) {
        const unsigned ro = (unsigned)mb * 2048u + rdoff;
        const i32x4_t lo = *(const PG8_LAS i32x4_t*)(img + ro), hi = *(const PG8_LAS i32x4_t*)(img + (ro ^ 64u));
        b[mb] = __builtin_shufflevector(lo, hi, 0, 1, 2, 3, 4, 5, 6, 7);
    }
    asm volatile("s_waitcnt lgkmcnt(0)" ::: "memory");
    if (PRE) g1m_dma(ub, img, idx, inext, hh, eg, q16);
    const i32x8_t a = __builtin_shufflevector((i32x4_t)a0, (i32x4_t)a1, 0, 1, 2, 3, 4, 5, 6, 7);
    float d[4]; f32x4 acc[4];
#pragma unroll
    for (int mb = 0; mb < 4; ++mb) acc[mb] = __builtin_amdgcn_mfma_scale_f32_16x16x128_f8f6f4(a, b[mb], f32x4{0.f, 0.f, 0.f, 0.f}, 0, 0, 0, 0x7f, 0, 0x7f);
#pragma unroll
    for (int mb = 0; mb < 4; ++mb) { d[mb] = acc[mb][0] + acc[mb][1] * (1.f / 16.f); asm volatile("" : "+v"(d[mb])); }
    const int g = lane >> 4;
    return g == 0 ? d[0] : g == 1 ? d[1] : g == 2 ? d[2] : d[3];
}
__device__ __forceinline__ void g1m_chunk(const Params& p, int x, int tb, char* smem_, int lane) {
    PG8_LAS unsigned char* wl = (PG8_LAS unsigned char*)smem_ + p.wv * G1W;
    PG8_LAS unsigned short* idx = (PG8_LAS unsigned short*)(wl + 16384);
    const int* RI = (const int*)(p.ws + WS_RI);
    {
        int ra[16];
#pragma unroll
        for (int i = 0; i < 8; ++i) { ra[2 * i] = RI[(size_t)(tb + i) * 128 + lane]; ra[2 * i + 1] = RI[(size_t)(tb + i) * 128 + 64 + lane]; }
#pragma unroll
        for (int i = 0; i < 8; ++i) {
            idx[(i * 8 + (lane & 7)) * 16 + (lane >> 3)] = (unsigned short)ra[2 * i];
            idx[(i * 8 + (lane & 7)) * 16 + 8 + (lane >> 3)] = (unsigned short)ra[2 * i + 1];
        }
    }
    __builtin_amdgcn_fence(__ATOMIC_RELEASE, "wavefront");
    __builtin_amdgcn_wave_barrier();
    __builtin_amdgcn_fence(__ATOMIC_ACQUIRE, "wavefront");
    const int eg = lane >> 3, n = lane & 15, kb = lane >> 4;
    const unsigned q16 = (unsigned)(((lane & 7) ^ (eg >> 1)) * 16);
    const unsigned rdoff = (unsigned)(n * 128 + ((kb ^ (n >> 1)) * 16));
    const unsigned char* ub = p.ws + WS_PU + (size_t)x * (16384u * 128u);
    const unsigned char* h8 = p.ws + ((lane & 1) ? WS_H8L : WS_H8H) + (size_t)tb * 1024 + x * 128 + kb * 16;
    float* pp = (float*)(p.ws + WS_PP) + ((size_t)x * T_TOK + tb) * 128 + lane;
    u32x4 ha[8][2];
#pragma unroll
    for (int i = 0; i < 8; ++i) { ha[i][0] = *(const u32x4*)(h8 + (size_t)i * 1024); ha[i][1] = *(const u32x4*)(h8 + (size_t)i * 1024 + 64); }
#pragma unroll
    for (int i = 0; i < 8; ++i) { asm volatile("" : "+v"(ha[i][0])); asm volatile("" : "+v"(ha[i][1])); }
    g1m_dma(ub, wl, idx, 0, 0, eg, q16);
    g1m_dma(ub, wl + 8192, idx, 0, 1, eg, q16);
    asm volatile("s_waitcnt vmcnt(8)" ::: "memory");
#pragma unroll
    for (int i = 0; i < 7; ++i) {
        const float v0 = g1m_step<true, 9>(ub, wl, idx, i + 1, 0, eg, q16, rdoff, lane, ha[i][0], ha[i][1]);
        pp[(size_t)i * 128] = v0;
        const float v1 = g1m_step<true, 9>(ub, wl + 8192, idx, i + 1, 1, eg, q16, rdoff, lane, ha[i][0], ha[i][1]);
        pp[(size_t)i * 128 + 64] = v1;
    }
    {
        const float v0 = g1m_step<false, 9>(ub, wl, idx, 0, 0, eg, q16, rdoff, lane, ha[7][0], ha[7][1]);
        pp[(size_t)7 * 128] = v0;
        const float v1 = g1m_step<false, 0>(ub, wl + 8192, idx, 0, 1, eg, q16, rdoff, lane, ha[7][0], ha[7][1]);
        pp[(size_t)7 * 128 + 64] = v1;
    }
}
typedef int i32x2_t __attribute__((ext_vector_type(2)));
template <bool PRE, int VMW, int HH>
__device__ __forceinline__ void g2m_step(const unsigned char* vb_, PG8_LAS unsigned char* img, const PG8_LAS unsigned short* idx, int inext, int eg, unsigned q16,
                                         const unsigned (&tra)[8], const long a0, const long a1, f32x4 (&acc)[8]) {
    asm volatile("s_waitcnt vmcnt(%0)" :: "n"(VMW) : "memory");
    long b[2][8];
#pragma unroll
    for (int u = 0; u < 2; ++u)
#pragma unroll
        for (int j = 0; j < 8; ++j) asm volatile("ds_read_b64_tr_b8 %0, %1 offset:%2" : "=v"(b[u][j]) : "v"(tra[j]), "n"(HH * 8192 + u * 4096) : "memory");
    asm volatile("s_waitcnt lgkmcnt(0)" : "+v"(b[0][0]), "+v"(b[0][1]), "+v"(b[0][2]), "+v"(b[0][3]), "+v"(b[0][4]), "+v"(b[0][5]), "+v"(b[0][6]), "+v"(b[0][7]) :: "memory");
    asm volatile("" : "+v"(b[1][0]), "+v"(b[1][1]), "+v"(b[1][2]), "+v"(b[1][3]), "+v"(b[1][4]), "+v"(b[1][5]), "+v"(b[1][6]), "+v"(b[1][7]) :: "memory");
    if (PRE) { g1m_dma(vb_, img + HH * 8192, idx, inext, HH, eg, q16); __builtin_amdgcn_sched_barrier(0); }
#pragma unroll
    for (int j = 0; j < 8; ++j) {
        acc[j] = __builtin_amdgcn_mfma_f32_16x16x32_fp8_fp8(a0, b[0][j], acc[j], 0, 0, 0);
        acc[j] = __builtin_amdgcn_mfma_f32_16x16x32_fp8_fp8(a1, b[1][j], acc[j], 0, 0, 0);
    }
}
__device__ __forceinline__ void g2m_chunk(const Params& p, int l, int x, int tb, char* smem_, int lane) {
    PG8_LAS unsigned char* wl = (PG8_LAS unsigned char*)smem_ + p.wv * G1W;
    PG8_LAS unsigned short* idx = (PG8_LAS unsigned short*)(wl + 16384);
    const int* RI = (const int*)(p.ws + WS_RI);
    {
        int ra[16];
#pragma unroll
        for (int i = 0; i < 8; ++i) { ra[2 * i] = RI[(size_t)(tb + i) * 128 + lane]; ra[2 * i + 1] = RI[(size_t)(tb + i) * 128 + 64 + lane]; }
#pragma unroll
        for (int i = 0; i < 8; ++i) {
            idx[(i * 8 + (lane & 7)) * 16 + (lane >> 3)] = (unsigned short)ra[2 * i];
            idx[(i * 8 + (lane & 7)) * 16 + 8 + (lane >> 3)] = (unsigned short)ra[2 * i + 1];
        }
    }
    __builtin_amdgcn_fence(__ATOMIC_RELEASE, "wavefront");
    __builtin_amdgcn_wave_barrier();
    __builtin_amdgcn_fence(__ATOMIC_ACQUIRE, "wavefront");
    const int eg = lane >> 3, kb = lane >> 4, li = lane & 15, q = li >> 1;
    const unsigned q16 = (unsigned)(((lane & 7) ^ (eg >> 1)) * 16);
    const int n16 = (kb & 1) * 8 + q;
    const unsigned trbase = (unsigned)((kb * 8 + q) * 128 + ((n16 >> 1) & 7) * 16 + (li & 1) * 8);
    const unsigned char* vb_ = p.ws + WS_PV + (size_t)x * (16384u * 128u);
    float* op = p.out + (size_t)tb * 1024 + x * 128 + lane;
    const float* modr = (const float*)(p.ws + WS_MOD) + (size_t)(l * 8 + (tb >> 11)) * 6144 + 5120 + x * 128 + lane;
    float gf0 = modr[0], gf1 = modr[64];
    const unsigned char* c8 = p.ws + ((lane & 1) ? WS_C8L : WS_C8H) + (size_t)tb * 128 + kb * 32;
    u32x4 ca[8][2]; float xi[8][2], cinv[8];
#pragma unroll
    for (int i = 0; i < 8; ++i) {
        ca[i][0] = *(const u32x4*)(c8 + (size_t)i * 128); ca[i][1] = *(const u32x4*)(c8 + (size_t)i * 128 + 16);
        xi[i][0] = op[(size_t)i * 1024]; xi[i][1] = op[(size_t)i * 1024 + 64];
        cinv[i] = ((const float*)(p.ws + WS_CINV))[tb + i];
    }
#pragma unroll
    for (int i = 0; i < 8; ++i) { asm volatile("" : "+v"(ca[i][0])); asm volatile("" : "+v"(ca[i][1])); asm volatile("" : "+v"(xi[i][0]), "+v"(xi[i][1]), "+v"(cinv[i])); }
    asm volatile("" : "+v"(gf0), "+v"(gf1));
    g1m_dma(vb_, wl, idx, 0, 0, eg, q16);
    g1m_dma(vb_, wl + 8192, idx, 0, 1, eg, q16);
    asm volatile("s_waitcnt vmcnt(8)" ::: "memory");
    const int g = lane >> 4;
    unsigned tra[8];
#pragma unroll
    for (int j = 0; j < 8; ++j) tra[j] = (unsigned)(unsigned long)wl + (trbase ^ (unsigned)(j * 16));
#define G2M_TOKEN(i, PRE_, W0, W1) do { \
        f32x4 acc[8]; \
        _Pragma("unroll") for (int j = 0; j < 8; ++j) acc[j] = f32x4{0.f, 0.f, 0.f, 0.f}; \
        const long a00 = (long)(((unsigned long long)ca[i][0][1] << 32) | ca[i][0][0]), a01 = (long)(((unsigned long long)ca[i][0][3] << 32) | ca[i][0][2]); \
        const long a10 = (long)(((unsigned long long)ca[i][1][1] << 32) | ca[i][1][0]), a11 = (long)(((unsigned long long)ca[i][1][3] << 32) | ca[i][1][2]); \
        g2m_step<PRE_, W0, 0>(vb_, wl, idx, (i) + 1, eg, q16, tra, a00, a01, acc); \
        g2m_step<PRE_, W1, 1>(vb_, wl, idx, (i) + 1, eg, q16, tra, a10, a11, acc); \
        float y[8]; \
        _Pragma("unroll") for (int j = 0; j < 8; ++j) { y[j] = acc[j][0] + acc[j][1] * (1.f / 16.f); asm volatile("" : "+v"(y[j])); } \
        const float ya = g == 0 ? y[0] : g == 1 ? y[1] : g == 2 ? y[2] : y[3], yb = g == 0 ? y[4] : g == 1 ? y[5] : g == 2 ? y[6] : y[7]; \
        op[(size_t)(i) * 1024] = xi[i][0] + gf0 * (ya * cinv[i]); op[(size_t)(i) * 1024 + 64] = xi[i][1] + gf1 * (yb * cinv[i]); \
        __builtin_amdgcn_sched_barrier(0); } while (0)
    G2M_TOKEN(0, true, 10, 8);
    G2M_TOKEN(1, true, 10, 10); G2M_TOKEN(2, true, 10, 10); G2M_TOKEN(3, true, 10, 10);
    G2M_TOKEN(4, true, 10, 10); G2M_TOKEN(5, true, 10, 10); G2M_TOKEN(6, true, 10, 10);
    G2M_TOKEN(7, false, 10, 0);
#undef G2M_TOKEN
}
template <int WHICH>
__device__ void ph_peer_sliced(const Params& p, int l, int vb0, int nvb, char* smem_) {
    const int tid = TIDX(), wave = tid >> 6;
    const bf16_t* H = (const bf16_t*)(p.ws + WS_H); const unsigned char* PU = p.ws + WS_PU; const unsigned char* PV = p.ws + WS_PV;
    const int* RI = (const int*)(p.ws + WS_RI); float* RG = (float*)(p.ws + WS_RG); float* PP = (float*)(p.ws + WS_PP);
    const float* modb = (const float*)(p.ws + WS_MOD);
    {
    {
#pragma unroll 1
        for (int u_ = vb0; u_ < 2048; u_ += nvb) {
            const int x = u_ & 7, chunk = u_ >> 3;
            {
                const int lane = lane_id_opaque(), eg = lane >> 3, ll = lane & 7;
                const int tb = chunk * 64 + wave * 8;
                if (WHICH == 0 && G1_MFMA) { g1m_chunk(p, x, tb, smem_, lane); continue; }
                if (WHICH == 1 && G2_MFMA) { g2m_chunk(p, l, x, tb, smem_, lane); continue; }
                int* lri = (int*)smem_ + wave * 2048; float* lrg = (float*)(lri + 1024);
                {
                    int ra[16]; float rg_[16];
#pragma unroll
                    for (int i = 0; i < 8; ++i) {
                        ra[2 * i] = RI[(size_t)(tb + i) * 128 + lane]; ra[2 * i + 1] = RI[(size_t)(tb + i) * 128 + 64 + lane];
                        if (WHICH == 1) { rg_[2 * i] = RG[(size_t)(tb + i) * 128 + lane]; rg_[2 * i + 1] = RG[(size_t)(tb + i) * 128 + 64 + lane]; }
                    }
#pragma unroll
                    for (int i = 0; i < 8; ++i) {
                        lri[i * 128 + lane] = ra[2 * i]; lri[i * 128 + 64 + lane] = ra[2 * i + 1];
                        if (WHICH == 1) { lrg[i * 128 + lane] = rg_[2 * i]; lrg[i * 128 + 64 + lane] = rg_[2 * i + 1]; }
                    }
                }
                __builtin_amdgcn_fence(__ATOMIC_RELEASE, "wavefront");
                __builtin_amdgcn_wave_barrier();
                __builtin_amdgcn_fence(__ATOMIC_ACQUIRE, "wavefront");
                const unsigned l16 = (unsigned)ll * 16u;
                if (WHICH == 0) {
                    const unsigned char* ub = PU + (size_t)x * (16384u * 128u);
                    const bf16_t* hrow = H + (size_t)tb * 1024 + x * 128 + ll * 16;
                    float* pp_row = PP + ((size_t)x * T_TOK + tb) * 128 + ll * 8 + eg;
                    u32x4 hq0 = ((const u32x4*)hrow)[0], hq1 = ((const u32x4*)hrow)[1], uqA[8], uqB[8];
                    peer_gather8(uqA, ub, lri + eg, l16);
                    peer_gather8(uqB, ub, lri + eg + 64, l16);
#pragma unroll 1
                    for (int i = 0; i < 7; ++i) g1_step<true>(i, tb + i, hrow + (size_t)(i + 1) * 1024, ub, lri + eg, l16, lane, pp_row + (size_t)i * 128, hq0, hq1, uqA, uqB);
                    g1_step<false>(7, tb + 7, hrow, ub, lri + eg, l16, lane, pp_row + (size_t)7 * 128, hq0, hq1, uqA, uqB);
                } else {
                    const unsigned char* vb_ = PV + (size_t)x * (16384u * 128u);
                    const int col = x * 128 + ll * 16 + ((lane >> 5) & 1) * 8 + ((lane >> 4) & 1) * 4 + ((lane >> 3) & 1) * 2;
                    const float2 gf = *(const float2*)(modb + (size_t)(l * 8 + (tb >> 11)) * 6144 + 5120 + col);
                    float2* op = (float2*)(p.out + (size_t)tb * 1024 + col);
                    u32x4 vqA[8], vqB[8];
                    peer_gather8(vqA, vb_, lri + eg, l16);
                    peer_gather8(vqB, vb_, lri + eg + 64, l16);
#pragma unroll 1
                    for (int i = 0; i < 7; ++i) g2_step<true>(i, op + (size_t)i * 512, gf, vb_, lri + eg, lrg + eg, l16, lane, vqA, vqB);
                    g2_step<false>(7, op + (size_t)7 * 512, gf, vb_, lri + eg, lrg + eg, l16, lane, vqA, vqB);
                }
            }
        }
    }
    __syncthreads();
    }
}
__device__ void ph_peer_coef(const Params& p, int vb0, int nvb) {
    const int wave = TIDX() >> 6, lane = TIDX() & 63;
    float* RG = (float*)(p.ws + WS_RG); const float* PP = (const float*)(p.ws + WS_PP);
    for (int t0 = (vb0 * 8 + wave) * 2; t0 < T_TOK; t0 += nvb * 8 * 2) {
        float pp[2][2][8], g[2][2];
#pragma unroll
        for (int u = 0; u < 2; ++u)
#pragma unroll
            for (int half = 0; half < 2; ++half) {
                const int k = half * 64 + lane;
#pragma unroll
                for (int x = 0; x < 8; ++x) pp[u][half][x] = PP[((size_t)x * T_TOK + t0 + u) * 128 + k];
                g[u][half] = RG[(size_t)(t0 + u) * 128 + k];
            }
        asm volatile("" ::: "memory");
#pragma unroll
        for (int u = 0; u < 2; ++u) {
            float cf[2];
#pragma unroll
            for (int half = 0; half < 2; ++half) {
                float d = 0.f;
#pragma unroll
                for (int x = 0; x < 8; ++x) d += pp[u][half][x];
                d *= (1.f / PU_SCALE);
                cf[half] = g[u][half] * 0.5f * d * (1.f + erff(d * 0.7071067811865476f)) * (1.f / PV_SCALE);
                if (!G2_MFMA) RG[(size_t)(t0 + u) * 128 + half * 64 + lane] = cf[half];
            }
            if (G2_MFMA) {
                const float m = wave_max(fmaxf(fabsf(cf[0]), fabsf(cf[1])));
                const float sc = m > 0.f ? 240.f / m : 0.f;
                const float c0 = cf[0] * sc, c1 = cf[1] * sc;
                const int hi = __builtin_amdgcn_cvt_pk_fp8_f32(c0, c1, 0, false);
                const auto bk = __builtin_amdgcn_cvt_pk_f32_fp8(hi, false);
                const int lo = __builtin_amdgcn_cvt_pk_fp8_f32((c0 - bk[0]) * 16.f, (c1 - bk[1]) * 16.f, 0, false);
                unsigned char* c8h = p.ws + WS_C8H + (size_t)(t0 + u) * 128; unsigned char* c8l = p.ws + WS_C8L + (size_t)(t0 + u) * 128;
                const int s0 = ((lane >> 3) & 3) * 32 + (lane >> 5) * 8 + (lane & 7);
                c8h[s0] = (unsigned char)(hi & 0xff); c8h[s0 + 16] = (unsigned char)((hi >> 8) & 0xff);
                c8l[s0] = (unsigned char)(lo & 0xff); c8l[s0 + 16] = (unsigned char)((lo >> 8) & 0xff);
                if (lane == 0) ((float*)(p.ws + WS_CINV))[t0 + u] = m * (1.f / 240.f);
            }
        }
    }
}

enum { PH_MOD = 0, PH_WPREP, PH_NORM1, PH_GEMM_IN, PH_SCAN, PH_MERGE, PH_OUT, PH_NORM2, PH_GEMM_Q, PH_GEMM_SC, PH_ROUTE, PH_G1, PH_G15, PH_G2 };

template <int PH>
__device__ __forceinline__ void run_phase(const Params& p, int l, int vb0, int nvb, char* smem) {
    const float* xin = (l == 0) ? p.x : p.out;
    if (PH == PH_MOD) ph_mod(p, vb0, nvb, smem);
    else if (PH == PH_WPREP) ph_wprep(p, l, vb0, nvb, smem);
    else if (PH == PH_NORM1) ph_norm(p, l, 0, xin, vb0, nvb);
    else if (PH == PH_GEMM_IN) {
        pg8::Gemm g{(const bf16_t*)(p.ws + WS_H), (const bf16_t*)(p.ws + WS_WIN), 1024, 1024, 1024};
        pg8::StaticOrder S; S.init(T_TOK, LDZ, nvb, vb0, 1024, 1024);
        pg8::gemm_phase(( PG8_LAS unsigned char*)smem, g, S, pg8::EpiBf16{(bf16_t*)(p.ws + WS_Z), LDZ}, TIDX());
    }
    else if (PH == PH_SCAN) ph_mixA(p, l, vb0, nvb, smem);
    else if (PH == PH_MERGE) {
        pg8::Gemm g{(const bf16_t*)(p.ws + WS_Y), (const bf16_t*)(p.ws + WS_WBR), 1536, 512, 512};
        pg8::MergeOrder S{vb0, nvb};
        pg8::gemm_phase((PG8_LAS unsigned char*)smem, g, S, pg8::EpiMerge{(bf16_t*)(p.ws + WS_H), (const bf16_t*)(p.ws + WS_Z)}, TIDX());
    }
    else if (PH == PH_OUT) {
        pg8::Gemm g{(const bf16_t*)(p.ws + WS_H), (const bf16_t*)(p.ws + WS_WOUT), 1024, 1024, 1024};
        pg8::StaticOrder S; S.init(T_TOK, 1024, nvb, vb0, 1024, 1024);
        pg8::gemm_phase((PG8_LAS unsigned char*)smem, g, S, pg8::EpiResid{xin, p.out, (const float*)(p.ws + WS_MOD) + (size_t)l * 8 * 6144}, TIDX());
    }
    else if (PH == PH_NORM2) ph_norm(p, l, 1, p.out, vb0, nvb);
    else if (PH == PH_GEMM_Q) {
        pg8::Gemm g{(const bf16_t*)(p.ws + WS_H), (const bf16_t*)(p.ws + WS_WQ), 1024, 1024, 1024};
        pg8::StaticOrder S; S.init(T_TOK, 2048, nvb, vb0, 1024, 1024);
        pg8::gemm_phase((PG8_LAS unsigned char*)smem, g, S, pg8::EpiBf16{(bf16_t*)(p.ws + WS_QP), 2048}, TIDX());
        asm volatile("s_waitcnt vmcnt(0)" ::: "memory");
        __syncthreads();
#pragma unroll 1
        for (int i = 0; ; ++i) {
            pg8::Unit u; if (!S.next(i, u)) break;
#pragma unroll 1
            for (int hh = 0; hh < 2; ++hh) sc_tile(p, u.pm, 2 * u.pn + hh, smem, TIDX());
        }
    }
    else if (PH == PH_GEMM_SC) gemm_phase((const bf16_t*)(p.ws + WS_QP), 2048, (const bf16_t*)(p.ws + WS_SK), 128, T_TOK, 2048, 128, true,
                                          EpiF16{(_Float16*)(p.ws + WS_SC), 2048}, vb0, nvb, smem, TIDX());
    else if (PH == PH_ROUTE) ph_route(p, vb0, nvb, smem);
    else if (PH == PH_G1) ph_peer_sliced<0>(p, l, vb0, nvb, smem);
    else if (PH == PH_G15) ph_peer_coef(p, vb0, nvb);
    else if (PH == PH_G2) ph_peer_sliced<1>(p, l, vb0, nvb, smem);

}

#define XB_TMO      128
#define XB_XCNT(j)  (256  + 64 * (j))
#define XB_XSUB(j)  (1280 + 64 * (j))
#define XB_XGEN(j)  (2304 + 64 * (j))
#define XB_TOP      3328
#define XB_TOPGEN   3392
#define XCD_BAR_WORDS 3456
#define XB_SPIN_CAP (1u << 18)
#define LAS __attribute__((address_space(3)))
__device__ __forceinline__ unsigned xb_ld(unsigned* p)              { return __hip_atomic_load(p, __ATOMIC_RELAXED, __HIP_MEMORY_SCOPE_AGENT); }
__device__ __forceinline__ unsigned xb_add(unsigned* p, unsigned v) { return __hip_atomic_fetch_add(p, v, __ATOMIC_RELAXED, __HIP_MEMORY_SCOPE_AGENT); }
#define XB_SPIN(cond, bar) do { unsigned _sp = 0; while (cond) { __builtin_amdgcn_s_sleep(1); \
    if ((++_sp & 255u) == 0u) { if (xb_ld(&(bar)[XB_TMO])) break; if (_sp > XB_SPIN_CAP) { atomicAdd(&(bar)[XB_TMO], 1u); break; } } } } while (0)
struct XcdBarrier { unsigned* bar; unsigned x; volatile LAS unsigned* st; int wv; };
__device__ __forceinline__ XcdBarrier xcd_barrier_post(unsigned* bar, volatile LAS unsigned* st, int wv) {
    XcdBarrier b; b.bar = bar; b.x = xb_xcc_id(); b.st = st; b.wv = wv;
    if (TIDXW(wv) == 0) (void)xb_add(&bar[XB_XCNT(b.x)], 1u);
    return b;
}
__device__ __forceinline__ void xcd_barrier_complete(unsigned* bar, unsigned x, unsigned& nloc, unsigned& nx) {
    const unsigned G = gridDim.x * gridDim.y * gridDim.z;
    unsigned sum, cnt, mine, sp = 0u;
    for (;;) {
        sum = 0u; cnt = 0u; mine = 0u;
#pragma unroll
        for (unsigned j = 0; j < 16; ++j) { const unsigned c = xb_ld(&bar[XB_XCNT(j)]); sum += c; cnt += (c > 0u) ? 1u : 0u; mine = (j == x) ? c : mine; }
        if (sum == G) break;
        __builtin_amdgcn_s_sleep(1);
        if ((++sp & 255u) == 0u) { if (xb_ld(&bar[XB_TMO])) break; if (sp > XB_SPIN_CAP) { atomicAdd(&bar[XB_TMO], 1u); break; } }
    }
    nloc = mine > 0u ? mine : 1u; nx = cnt > 0u ? cnt : 1u;
}
__device__ __forceinline__ void xcd_barrier(const XcdBarrier& b) {
    asm volatile("s_waitcnt vmcnt(0)" ::: "memory");
    __syncthreads();
    if (TIDXW(b.wv) == 0) {
        unsigned* bar = b.bar;
        __builtin_amdgcn_s_waitcnt(0);
        unsigned nloc = b.st[0], nx = b.st[1];
        if (nloc == 0u) { xcd_barrier_complete(bar, b.x, nloc, nx); b.st[0] = nloc; b.st[1] = nx; }
        const unsigned old = xb_add(&bar[XB_XSUB(b.x)], 1u);
        const unsigned gen = old / nloc;
        if (old + 1u == (gen + 1u) * nloc) {
            __builtin_amdgcn_fence(__ATOMIC_RELEASE, "agent");
            asm volatile("s_waitcnt vmcnt(0)" ::: "memory");
            const unsigned og = xb_add(&bar[XB_TOP], 1u);
            const unsigned tg = og / nx;
            if (og + 1u == (tg + 1u) * nx) xb_add(&bar[XB_TOPGEN], 1u);
            else XB_SPIN(xb_ld(&bar[XB_TOPGEN]) == tg, bar);
            __builtin_amdgcn_fence(__ATOMIC_ACQUIRE, "agent");
            xb_add(&bar[XB_XGEN(b.x)], 1u);
            asm volatile("s_waitcnt vmcnt(0)" ::: "memory");
        } else {
            XB_SPIN(xb_ld(&bar[XB_XGEN(b.x)]) == gen, bar);
            __builtin_amdgcn_fence(__ATOMIC_ACQUIRE, "agent");
            asm volatile("s_waitcnt vmcnt(0)" ::: "memory");
        }
    }
    __syncthreads();
}

__global__ void __launch_bounds__(NT) mega_kernel(Params p_in) {
#if defined(__HIP_DEVICE_COMPILE__)
    extern __shared__ __attribute__((aligned(16))) char smem[];
    volatile LAS unsigned* st = (volatile LAS unsigned*)(smem + LDS_BYTES - 16);
    int wv_ = __builtin_amdgcn_readfirstlane((int)threadIdx.x >> 6); asm volatile("" : "+s"(wv_));
    { const int t_ = TIDXW(wv_); if (t_ < 4) st[t_] = 0u; }
    __syncthreads();
    XcdBarrier bar = xcd_barrier_post((unsigned*)(p_in.ws + WS_CTL), st, wv_);
    const int vb = (int)blockIdx.x, nvb = (int)gridDim.x;
#define GB() xcd_barrier(bar)
#define RUN(PH, L) do { \
        const __attribute__((address_space(4))) Params* _kp = (const __attribute__((address_space(4))) Params*)__builtin_amdgcn_kernarg_segment_ptr(); asm volatile("" : "+s"(_kp)); Params _p = *_kp; _p.wv = wv_; \
        int _l = (L), _vb = vb, _nvb = nvb; asm volatile("" : "+s"(_l), "+s"(_vb), "+s"(_nvb)); \
        run_phase<PH>(_p, _l, _vb, _nvb, smem); } while (0)
    RUN(PH_MOD, 0);
#pragma unroll 1
    for (int l = 0; l < 2; ++l) {
        RUN(PH_WPREP, l); if (l == 0) GB();
        RUN(PH_NORM1, l); GB();
        RUN(PH_GEMM_IN, l); GB();
        RUN(PH_SCAN, l); GB();
        RUN(PH_MERGE, l); GB();
        RUN(PH_OUT, l); GB();
        RUN(PH_NORM2, l); GB();
        RUN(PH_GEMM_Q, l); GB();
        RUN(PH_ROUTE, l); GB();
        RUN(PH_G1, l); GB();
        RUN(PH_G15, l); GB();
        RUN(PH_G2, l);
        if (l == 0) GB();
    }
#undef RUN
#undef GB
#endif
}

extern "C" void kernel_launch(void* const* d_in, const int* in_sizes, int n_in, void* d_out, int out_size, void* d_ws, size_t ws_size,
                              hipStream_t stream) {
    if (n_in != 20 || ws_size < WS_END) { fprintf(stderr, "kernel_launch: bad inputs (n_in %d ws %zu need %zu)\n", n_in, ws_size, (size_t)WS_END); return; }
    Params p{};
    p.x = (const float*)d_in[0]; p.c = (const float*)d_in[1]; p.w_ada = (const float*)d_in[2]; p.b_ada = (const float*)d_in[3];
    p.norm_mix = (const float*)d_in[4]; p.norm_ffn = (const float*)d_in[5]; p.w_in = (const float*)d_in[6]; p.hgrn_lb = (const float*)d_in[7];
    p.hgrn_on = (const float*)d_in[8]; p.dsa_qn = (const float*)d_in[9]; p.dsa_kn = (const float*)d_in[10]; p.gla_up = (const float*)d_in[11];
    p.gla_bias = (const float*)d_in[12]; p.gla_on = (const float*)d_in[13]; p.w_branch = (const float*)d_in[14]; p.w_out = (const float*)d_in[15];
    p.peer_wq = (const float*)d_in[16]; p.peer_keys = (const float*)d_in[17]; p.peer_u = (const float*)d_in[18]; p.peer_v = (const float*)d_in[19];
    p.out = (float*)d_out; p.ws = (unsigned char*)d_ws;
    static int grid = 0;
    if (grid == 0) {
        int dev = 0, cus = 0, per_cu = 0;
        hipGetDevice(&dev);
        hipDeviceGetAttribute(&cus, hipDeviceAttributeMultiprocessorCount, dev);
        hipFuncSetAttribute((const void*)mega_kernel, hipFuncAttributeMaxDynamicSharedMemorySize, LDS_BYTES);
        hipOccupancyMaxActiveBlocksPerMultiprocessor(&per_cu, (const void*)mega_kernel, NT, LDS_BYTES);
        if (per_cu < 1) { fprintf(stderr, "kernel_launch: occupancy query says %d blocks per CU\n", per_cu); per_cu = 1; }
        (void)hipGetLastError();
        grid = cus;
    }
    hipMemsetAsync((char*)d_ws + WS_CTL, 0, 32768, stream);
    void* args[] = {&p};
    hipError_t e = hipLaunchCooperativeKernel((const void*)mega_kernel, dim3(grid), dim3(NT), args, LDS_BYTES, stream);
    if (e != hipSuccess) fprintf(stderr, "cooperative launch failed: %s (grid %d)\n", hipGetErrorString(e), grid);
}
```

```cpp
#include <hip/hip_runtime.h>
#include <stdint.h>
#include <stdio.h>

typedef unsigned short bf16_t;
typedef short bf16x8 __attribute__((ext_vector_type(8)));
typedef float f32x4 __attribute__((ext_vector_type(4)));
typedef unsigned u32x4 __attribute__((ext_vector_type(4)));

#define NT 512
constexpr int T_TOK = 16384, DM = 1024, SEQ = 2048;
constexpr int LDZ = 8704;
constexpr int ZA_Q = 0, ZA_F = 512, ZA_I = 1024, ZA_G = 1536, ZB_Q = 2048, ZB_K = 2560, ZB_V = 3072, ZC_V = 3584, ZC_G = 4096,
              ZB_QI = 4608, ZC_Q = 4864, ZC_K = 5120, ZB_KI = 5376, ZB_WI = 5440, ZC_CODE = 5444, ZM = 5632;
constexpr int IN_COLS = 8532;

constexpr size_t al256(size_t x) { return (x + 255) & ~(size_t)255; }
constexpr size_t WS_CTL = 0;
constexpr size_t WS_MOD = 65536;
constexpr size_t WS_WIN = al256(WS_MOD + (size_t)2 * 8 * 6144 * 4);
constexpr size_t WS_WBR = al256(WS_WIN + (size_t)LDZ * 1024 * 2);
constexpr size_t WS_WOUT = al256(WS_WBR + (size_t)3 * 1024 * 512 * 2);
constexpr size_t WS_WQ = al256(WS_WOUT + (size_t)1024 * 1024 * 2);
constexpr size_t WS_SK = al256(WS_WQ + (size_t)2048 * 1024 * 2);
constexpr size_t WS_PU = al256(WS_SK + (size_t)16 * 128 * 128 * 2);
constexpr size_t WS_PV = al256(WS_PU + (size_t)16384 * 1024);
constexpr size_t WS_H = al256(WS_PV + (size_t)16384 * 1024);
constexpr float PU_SCALE = 32.f, PV_SCALE = 4.f;
constexpr size_t WS_OA = al256(WS_H + (size_t)T_TOK * 1024 * 2);
constexpr size_t WS_OC = al256(WS_OA + (size_t)T_TOK * 512 * 2);
constexpr size_t WS_H8H = WS_OA, WS_H8L = WS_OC;
constexpr size_t WS_Y = al256(WS_OC + (size_t)T_TOK * 512 * 2);
constexpr size_t WS_Z = al256(WS_Y + (size_t)T_TOK * 1536 * 2);
constexpr size_t WS_VT = al256(WS_Z + (size_t)T_TOK * LDZ * 2);
constexpr size_t WS_BM = al256(WS_VT + (size_t)T_TOK * 512 * 2);
constexpr size_t WS_END = al256(WS_BM + (size_t)T_TOK * 64 * 4);
constexpr size_t WS_QP = WS_Z;
constexpr size_t WS_SC = al256(WS_QP + (size_t)T_TOK * 2048 * 2);
constexpr size_t WS_RI = al256(WS_SC + (size_t)T_TOK * 2048 * 4);
constexpr size_t WS_RG = al256(WS_RI + (size_t)T_TOK * 128 * 4);
constexpr size_t WS_PP = al256(WS_RG + (size_t)T_TOK * 128 * 4);
constexpr size_t WS_C8H = WS_SC;
constexpr size_t WS_C8L = WS_C8H + (size_t)T_TOK * 128;
constexpr size_t WS_CINV = WS_C8L + (size_t)T_TOK * 128;
static_assert(WS_PP + (size_t)8 * T_TOK * 128 * 4 <= WS_VT, "peer partials overflow the Z region");
static_assert(WS_RG + (size_t)T_TOK * 128 * 4 <= WS_END, "peer alias overflow");

struct Params {
    const float* x; const float* c; const float* w_ada; const float* b_ada; const float* norm_mix; const float* norm_ffn;
    const float* w_in; const float* hgrn_lb; const float* hgrn_on; const float* dsa_qn; const float* dsa_kn;
    const float* gla_up; const float* gla_bias; const float* gla_on; const float* w_branch; const float* w_out;
    const float* peer_wq; const float* peer_keys; const float* peer_u; const float* peer_v;
    float* out; unsigned char* ws;
    int wv, pad;
};

__device__ __forceinline__ float bf2f(bf16_t h) { return __uint_as_float(((unsigned)h) << 16); }
__device__ __forceinline__ float bflo(unsigned u) { return __uint_as_float(u << 16); }
__device__ __forceinline__ float bfhi(unsigned u) { return __uint_as_float(u & 0xffff0000u); }
__device__ __forceinline__ bf16_t f2bf(float f) { unsigned r; asm volatile("v_cvt_pk_bf16_f32 %0, %1, %1" : "=v"(r) : "v"(f)); return (bf16_t)(r & 0xffffu); }
__device__ __forceinline__ unsigned pack2(float a, float b) { unsigned r; asm volatile("v_cvt_pk_bf16_f32 %0, %1, %2" : "=v"(r) : "v"(a), "v"(b)); return r; }
__device__ __forceinline__ int lane_id_opaque() { int l; asm volatile("v_mbcnt_lo_u32_b32 %0, -1, 0\n\tv_mbcnt_hi_u32_b32 %0, -1, %0" : "=v"(l)); return l; }
template <int M> __device__ __forceinline__ int shx_i(int v) {
    if (M < 32) return __builtin_amdgcn_ds_swizzle(v, (M << 10) | 0x1f);
    return __builtin_amdgcn_ds_bpermute((lane_id_opaque() ^ 32) << 2, v);
}
template <int M> __device__ __forceinline__ float shx(float v) { return __int_as_float(shx_i<M>(__float_as_int(v))); }
template <int M> __device__ __forceinline__ int shx(int v) { return shx_i<M>(v); }
template <int M> __device__ __forceinline__ unsigned shx(unsigned v) { return (unsigned)shx_i<M>((int)v); }
__device__ __forceinline__ int bperm(int v, int src) { return __builtin_amdgcn_ds_bpermute(src << 2, v); }
__device__ __forceinline__ float bperm(float v, int src) { return __int_as_float(__builtin_amdgcn_ds_bpermute(src << 2, __float_as_int(v))); }
__device__ __forceinline__ float wave_sum(float v) { v += shx<32>(v); v += shx<16>(v); v += shx<8>(v); v += shx<4>(v); v += shx<2>(v); v += shx<1>(v); return v; }
__device__ __forceinline__ float wave_max(float v) { v = fmaxf(v, shx<32>(v)); v = fmaxf(v, shx<16>(v)); v = fmaxf(v, shx<8>(v)); v = fmaxf(v, shx<4>(v)); v = fmaxf(v, shx<2>(v)); v = fmaxf(v, shx<1>(v)); return v; }
__device__ __forceinline__ int wave_sum_i(int v) { v += shx<32>(v); v += shx<16>(v); v += shx<8>(v); v += shx<4>(v); v += shx<2>(v); v += shx<1>(v); return v; }
__device__ __forceinline__ int wave_total_i(int v) {
    v += __builtin_amdgcn_update_dpp(0, v, 0x111, 0xf, 0xf, true);
    v += __builtin_amdgcn_update_dpp(0, v, 0x112, 0xf, 0xf, true);
    v += __builtin_amdgcn_update_dpp(0, v, 0x114, 0xf, 0xf, true);
    v += __builtin_amdgcn_update_dpp(0, v, 0x118, 0xf, 0xf, true);
    v += __builtin_amdgcn_update_dpp(0, v, 0x142, 0xa, 0xf, true);
    v += __builtin_amdgcn_update_dpp(0, v, 0x143, 0xc, 0xf, true);
    return __builtin_amdgcn_readlane(v, 63);
}
__device__ __forceinline__ float sigm(float x) { return __frcp_rn(1.f + __expf(-x)); }

__device__ __forceinline__ unsigned xb_xcc_id() { return (unsigned)__builtin_amdgcn_s_getreg((3 << 11) | 20) & 0xFu; }
__device__ __forceinline__ int TIDXW(int wv) { int t; asm volatile("v_mbcnt_lo_u32_b32 %0, -1, 0\n\tv_mbcnt_hi_u32_b32 %0, -1, %0\n\tv_lshl_or_b32 %0, %1, 6, %0" : "=v"(t) : "s"(wv)); return t; }
#define TIDX() TIDXW(p.wv)

__device__ __forceinline__ int src_col(int j) {
    if (j < 3584) return j;
    if (j < 4096) return j - 3584 + 4420;
    if (j < 4608) return j - 4096 + 4948;
    if (j < 4864) return j - 4608 + 3584;
    if (j < 5120) return j - 4864 + 3908;
    if (j < 5376) return j - 5120 + 4164;
    if (j < 5440) return j - 5376 + 3840;
    if (j < 5444) return j - 5440 + 3904;
    if (j < 5460) return j - 5444 + 4932;
    if (j < 5632) return -1;
    return j - 5632 + 5460;
}

__device__ void ph_mod(const Params& p, int vb0, int nvb, char* smem_) {
    float* sc = (float*)smem_;
    float* part = sc + 8 * 1024;
    float* mod = (float*)(p.ws + WS_MOD);
    const int tid = TIDX(), lane = tid & 63, wave = tid >> 6;
    if (vb0 >= 192) return;
    for (int i = tid; i < 8 * 1024; i += NT) { float c = p.c[i]; sc[i] = c / (1.f + __expf(-c)); }
    __syncthreads();
    for (int task = vb0; task < 192; task += nvb) {
        const int l = task / 96, n0 = (task % 96) * 64;
        const float* w = p.w_ada + (size_t)l * 1024 * 6144 + (size_t)(wave * 128) * 6144 + n0 + lane;
        float acc[8];
#pragma unroll
        for (int b = 0; b < 8; ++b) acc[b] = 0.f;
#pragma unroll 1
        for (int k0 = 0; k0 < 128; k0 += 16) {
            float wv[16];
#pragma unroll
            for (int j = 0; j < 16; ++j) wv[j] = w[(size_t)(k0 + j) * 6144];
#pragma unroll
            for (int j = 0; j < 16; ++j)
#pragma unroll
                for (int b = 0; b < 8; ++b) acc[b] += sc[b * 1024 + wave * 128 + k0 + j] * wv[j];
        }
#pragma unroll
        for (int b = 0; b < 8; ++b) part[(wave * 8 + b) * 64 + lane] = acc[b];
        __syncthreads();
        {
            const int b = tid >> 6, col = tid & 63;
            float v = p.b_ada[l * 6144 + n0 + col];
#pragma unroll
            for (int w_ = 0; w_ < 8; ++w_) v += part[(w_ * 8 + b) * 64 + col];
            mod[(size_t)(l * 8 + b) * 6144 + n0 + col] = v;
        }
        __syncthreads();
    }
}

template <bool MAP>
__device__ void tr_tile(const float* __restrict__ src, int lds_, bf16_t* __restrict__ out, int ldo, int k0, int n0, float* tile, const int tid) {
    float lv[8];
    {
        const int nn = tid & 63, scol = MAP ? src_col(n0 + nn) : (n0 + nn);
#pragma unroll
        for (int i = 0; i < 8; ++i) { const int kk = (tid >> 6) + 8 * i; lv[i] = (scol >= 0) ? src[(size_t)(k0 + kk) * lds_ + scol] : 0.f; }
#pragma unroll
        for (int i = 0; i < 8; ++i) { const int kk = (tid >> 6) + 8 * i; tile[kk * 65 + nn] = lv[i]; }
    }
    __syncthreads();
#pragma unroll
    for (int i = 0; i < 4; ++i) {
        int nn = (tid >> 5) + 16 * i, kk = (tid & 31) * 2;
        unsigned v = pack2(tile[kk * 65 + nn], tile[(kk + 1) * 65 + nn]);
        *(unsigned*)(out + (size_t)(n0 + nn) * ldo + k0 + kk) = v;
    }
    __syncthreads();
}
__device__ void conv_chunk(const float* __restrict__ src, bf16_t* __restrict__ dst, size_t base, const int tid) {
    f32x4 la[4], lb[4];
#pragma unroll
    for (int i = 0; i < 4; ++i) { const size_t e = base + (size_t)(i * NT + tid) * 8; la[i] = *(const f32x4*)(src + e); lb[i] = *(const f32x4*)(src + e + 4); }
#pragma unroll
    for (int i = 0; i < 4; ++i) {
        size_t e = base + (size_t)(i * NT + tid) * 8;
        const float4 a = make_float4(la[i][0], la[i][1], la[i][2], la[i][3]), b = make_float4(lb[i][0], lb[i][1], lb[i][2], lb[i][3]);
        uint4 o; o.x = pack2(a.x, a.y); o.y = pack2(a.z, a.w); o.z = pack2(b.x, b.y); o.w = pack2(b.z, b.w);
        *(uint4*)(dst + e) = o;
    }
}
__device__ void conv_chunk_fp8(const float* __restrict__ src, unsigned char* __restrict__ dst, size_t base, float scale, const int tid) {
    f32x4 la[4], lb[4];
#pragma unroll
    for (int i = 0; i < 4; ++i) { const size_t e = base + (size_t)(i * NT + tid) * 8; la[i] = *(const f32x4*)(src + e); lb[i] = *(const f32x4*)(src + e + 4); }
#pragma unroll
    for (int i = 0; i < 4; ++i) {
        size_t e = base + (size_t)(i * NT + tid) * 8;
        const float4 a = make_float4(la[i][0], la[i][1], la[i][2], la[i][3]), b = make_float4(lb[i][0], lb[i][1], lb[i][2], lb[i][3]);
        int lo = __builtin_amdgcn_cvt_pk_fp8_f32(a.x * scale, a.y * scale, 0, false); lo = __builtin_amdgcn_cvt_pk_fp8_f32(a.z * scale, a.w * scale, lo, true);
        int hi = __builtin_amdgcn_cvt_pk_fp8_f32(b.x * scale, b.y * scale, 0, false); hi = __builtin_amdgcn_cvt_pk_fp8_f32(b.z * scale, b.w * scale, hi, true);
        const size_t row = e >> 10, col = e & 1023;
        *(uint2*)(dst + ((col >> 7) * 16384 + row) * 128 + (col & 127)) = make_uint2((unsigned)lo, (unsigned)hi);
    }
}
__device__ void ph_wprep(const Params& p, int l, int vb0, int nvb, char* smem_) {
    float* tile = (float*)smem_;
    const int tid = TIDX();
    bf16_t* WIN = (bf16_t*)(p.ws + WS_WIN); bf16_t* WBR = (bf16_t*)(p.ws + WS_WBR); bf16_t* WOUT = (bf16_t*)(p.ws + WS_WOUT);
    bf16_t* WQ = (bf16_t*)(p.ws + WS_WQ); bf16_t* SK = (bf16_t*)(p.ws + WS_SK); unsigned char* PU = p.ws + WS_PU; unsigned char* PV = p.ws + WS_PV;
    constexpr int N_WIN = 136 * 16, N_WBR = 3 * 16 * 8, N_WOUT = 16 * 16, N_WQ = 32 * 16, N_SK = 16, N_PU = 1024, N_PV = 1024;
    constexpr int TOTAL = N_WIN + N_WBR + N_WOUT + N_WQ + N_SK + N_PU + N_PV;
    for (int task = vb0; task < TOTAL; task += nvb) {
        int r = task;
        if (r < N_WIN) { int nt = r / 16, kt = r % 16; tr_tile<true>(p.w_in + (size_t)l * 1024 * IN_COLS, IN_COLS, WIN, 1024, kt * 64, nt * 64, tile, tid); continue; }
        r -= N_WIN;
        if (r < N_WBR) { int g = r / 128, rr = r % 128, nt = rr / 8, kt = rr % 8;
            tr_tile<false>(p.w_branch + (size_t)(l * 3 + g) * 512 * 1024, 1024, WBR + (size_t)g * 1024 * 512, 512, kt * 64, nt * 64, tile, tid); continue; }
        r -= N_WBR;
        if (r < N_WOUT) { int nt = r / 16, kt = r % 16; tr_tile<false>(p.w_out + (size_t)l * 1024 * 1024, 1024, WOUT, 1024, kt * 64, nt * 64, tile, tid); continue; }
        r -= N_WOUT;
        if (r < N_WQ) { int nt = r / 16, kt = r % 16; tr_tile<false>(p.peer_wq + (size_t)l * 1024 * 2048, 2048, WQ, 1024, kt * 64, nt * 64, tile, tid); continue; }
        r -= N_WQ;
        if (r < N_SK) { conv_chunk(p.peer_keys + (size_t)l * 16 * 128 * 128, SK, (size_t)r * 16384, tid); continue; }
        r -= N_SK;
        if (r < N_PU) { conv_chunk_fp8(p.peer_u + (size_t)l * 16384 * 1024, PU, (size_t)r * 16384, PU_SCALE, tid); continue; }
        r -= N_PU;
        conv_chunk_fp8(p.peer_v + (size_t)l * 16384 * 1024, PV, (size_t)r * 16384, PV_SCALE, tid);
    }
}

__device__ void ph_norm(const Params& p, int l, int which, const float* xin, int vb0, int nvb) {
    const int wave = TIDX() >> 6, lane = TIDX() & 63;
    const float* gain = (which ? p.norm_ffn : p.norm_mix) + l * 1024;
    const float* modb = (const float*)(p.ws + WS_MOD);
    bf16_t* H = (bf16_t*)(p.ws + WS_H);
    f32x4 g[4];
#pragma unroll
    for (int i = 0; i < 4; ++i) g[i] = *(const f32x4*)(gain + (lane + 64 * i) * 4);
    for (int t = vb0 * 8 + wave; t < T_TOK; t += nvb * 8) {
        const int b = t >> 11;
        const float* mod = modb + (size_t)(l * 8 + b) * 6144 + (which ? 3072 : 0);
        const f32x4* xr = (const f32x4*)(xin + (size_t)t * 1024);
        f32x4 v[4], sc[4], sh[4]; float ss = 0.f;
#pragma unroll
        for (int i = 0; i < 4; ++i) { v[i] = xr[lane + 64 * i]; sc[i] = *(const f32x4*)(mod + 1024 + (lane + 64 * i) * 4); sh[i] = *(const f32x4*)(mod + (lane + 64 * i) * 4); }
#pragma unroll
        for (int i = 0; i < 4; ++i) ss += v[i][0] * v[i][0] + v[i][1] * v[i][1] + v[i][2] * v[i][2] + v[i][3] * v[i][3];
        ss = wave_sum(ss);
        const float rstd = rsqrtf(ss * (1.f / 1024.f) + 1e-6f);
#pragma unroll
        for (int i = 0; i < 4; ++i) {
            const int idx = (lane + 64 * i) * 4;
            const f32x4 h = v[i] * rstd * g[i] * (1.f + sc[i]) + sh[i];
            uint2 o; o.x = pack2(h[0], h[1]); o.y = pack2(h[2], h[3]);
            *(uint2*)(H + (size_t)t * 1024 + idx) = o;
            if (which) {
                int hi = __builtin_amdgcn_cvt_pk_fp8_f32(h[0], h[1], 0, false); hi = __builtin_amdgcn_cvt_pk_fp8_f32(h[2], h[3], hi, true);
                const auto d0 = __builtin_amdgcn_cvt_pk_f32_fp8(hi, false); const auto d1 = __builtin_amdgcn_cvt_pk_f32_fp8(hi, true);
                int lo = __builtin_amdgcn_cvt_pk_fp8_f32((h[0] - d0[0]) * 16.f, (h[1] - d0[1]) * 16.f, 0, false);
                lo = __builtin_amdgcn_cvt_pk_fp8_f32((h[2] - d1[0]) * 16.f, (h[3] - d1[1]) * 16.f, lo, true);
                *(int*)(p.ws + WS_H8H + (size_t)t * 1024 + idx) = hi;
                *(int*)(p.ws + WS_H8L + (size_t)t * 1024 + idx) = lo;
            }
        }
    }
}

constexpr int GBM = 256, GBN = 128, GBK = 64, GLS = 72;
__device__ __forceinline__ void gemm_tile(const bf16_t* __restrict__ A, int lda, const bf16_t* __restrict__ Bt, int ldb, int K,
                                          int m0, int n0, bf16_t* sA, bf16_t* sB, f32x4 (&acc)[4][4], const int tid) {
    const int lane = tid & 63, wave = tid >> 6;
    const int wm = wave >> 1, wn = wave & 1, fr = lane & 15, fq = lane >> 4;
    u32x4 ra[4], rb[2];
    const int crow = tid >> 3, ckc = (tid & 7) * 8;
    const bf16_t* Ag = A + (size_t)(m0 + crow) * lda + ckc;
    const bf16_t* Bg = Bt + (size_t)(n0 + crow) * ldb + ckc;
#pragma unroll
    for (int i = 0; i < 4; ++i) ra[i] = *(const u32x4*)(Ag + (size_t)(64 * i) * lda);
#pragma unroll
    for (int i = 0; i < 2; ++i) rb[i] = *(const u32x4*)(Bg + (size_t)(64 * i) * ldb);
    for (int k0 = 0; k0 < K; k0 += GBK) {
        __syncthreads();
#pragma unroll
        for (int i = 0; i < 4; ++i) *(u32x4*)(sA + (crow + 64 * i) * GLS + ckc) = ra[i];
#pragma unroll
        for (int i = 0; i < 2; ++i) *(u32x4*)(sB + (crow + 64 * i) * GLS + ckc) = rb[i];
        __syncthreads();
        {
            const int kn = (k0 + GBK < K) ? (k0 + GBK) : k0;
#pragma unroll
            for (int i = 0; i < 4; ++i) ra[i] = *(const u32x4*)(Ag + (size_t)(64 * i) * lda + kn);
#pragma unroll
            for (int i = 0; i < 2; ++i) rb[i] = *(const u32x4*)(Bg + (size_t)(64 * i) * ldb + kn);
        }
#pragma unroll
        for (int ks = 0; ks < 2; ++ks) {
            bf16x8 af[4], wf[4];
#pragma unroll
            for (int mf = 0; mf < 4; ++mf) af[mf] = *(const bf16x8*)(sA + (wm * 64 + mf * 16 + fr) * GLS + ks * 32 + fq * 8);
#pragma unroll
            for (int nf = 0; nf < 4; ++nf) wf[nf] = *(const bf16x8*)(sB + (wn * 64 + nf * 16 + fr) * GLS + ks * 32 + fq * 8);
#pragma unroll
            for (int nf = 0; nf < 4; ++nf)
#pragma unroll
                for (int mf = 0; mf < 4; ++mf)
                    acc[nf][mf] = __builtin_amdgcn_mfma_f32_16x16x32_bf16(wf[nf], af[mf], acc[nf][mf], 0, 0, 0);
        }
    }
}


namespace pg8 {
#define PG8_LAS __attribute__((address_space(3)))
constexpr int BM = 256, BK = 64, HALF = 128, HTB = HALF * BK * 2, STAGE_BYTES = 8 * HTB, NXCD = 8, WGM = 8;
__device__ __forceinline__ int lds_byte(int r, int c) { const int st = (r >> 4) * 2 + (c >> 5), rr = r & 15, cc = c & 31, ob = rr * 64 + cc * 2; return st * 1024 + (ob ^ (((ob >> 9) & 1) << 5)); }
__device__ __forceinline__ void stage_rc(int b, int& R, int& C) { const int st = b / 1024, sb = b % 1024, swz = sb ^ (((sb >> 9) & 1) << 5); R = (st >> 1) * 16 + swz / 64; C = (st & 1) * 32 + (swz % 64) / 2; }
__device__ __forceinline__ int perm32(int rho) { const int n = rho >> 4, i = rho & 15; return 8 * (i >> 2) + 4 * n + (i & 3); }
struct Unit { int pm, pn, aux; size_t aoff, boff; };
struct Gemm { const bf16_t* A; const bf16_t* Bt; int lda, ldb, K; };

struct StaticOrder {
    int nM, nN, nwg, G, c, lda, ldb;
    __device__ void init(int M, int N, int G_, int c_, int lda_, int ldb_) { nM = M / BM; nN = N / BM; nwg = nM * nN; G = G_; c = c_; lda = lda_; ldb = ldb_; }
    __device__ bool next(int i, Unit& u) const {
        const long L = (long)i * G + c; if (L >= nwg) return false;
        int wgid = (int)L; { const int q = nwg / NXCD, r = nwg % NXCD, xcd = wgid % NXCD, off = wgid / NXCD; wgid = (xcd < r ? xcd * (q + 1) : r * (q + 1) + (xcd - r) * q) + off; }
        const int nig = WGM * nN, gid = wgid / nig, fm = gid * WGM, gsz = (nM - fm) < WGM ? (nM - fm) : WGM;
        u.pm = fm + ((wgid % nig) % gsz); u.pn = (wgid % nig) / gsz; u.aux = 0;
        u.aoff = (size_t)u.pm * BM * lda * 2; u.boff = (size_t)u.pn * BM * ldb * 2;
        return true;
    }
};
struct MergeOrder {
    int c, G;
    __device__ bool next(int i, Unit& u) const {
        const int tile = c + (i / 3) * G; if (tile >= 256) return false;
        u.pm = tile & 63; u.pn = tile >> 6; u.aux = i % 3;
        u.aoff = ((size_t)u.pm * BM * 1536 + (size_t)u.aux * 512) * 2; u.boff = ((size_t)u.aux * 1024 + (size_t)u.pn * BM) * 512 * 2;
        return true;
    }
};

template <class Epi, class Sched>
__device__ __forceinline__ void gemm_phase(PG8_LAS unsigned char* lds, const Gemm g, const Sched& S, const Epi& E, const int tid) {
    const int wid = __builtin_amdgcn_readfirstlane(tid >> 6), lane = tid & 63, wr = wid >> 2, wc = wid & 3, fr = lane & 15, fq = lane >> 4;
    const int K = g.K, nt = K / BK;
    unsigned voffA[2], voffB[2];
#pragma unroll
    for (int i = 0; i < 2; ++i) { int R, C; stage_rc(tid * 16 + i * 8192, R, C); const int Rb = Epi::PERM ? ((R & ~31) + perm32(R & 31)) : R;
        voffA[i] = (unsigned)(R * g.lda + C) * 2u; voffB[i] = (unsigned)(Rb * g.ldb + C) * 2u; }
    const size_t kstep = (size_t)(BK * 2);
    const size_t hstepA = (size_t)HALF * g.lda * 2, hstepB = (size_t)HALF * g.ldb * 2;
    const unsigned ldsw = (unsigned)wid * 1024u;
    const int aoff = lds_byte(wr * 64 + fr, fq * 8), boff = lds_byte(wc * 32 + fr, fq * 8);
#define PG8_SA(b, h) (((b) * 2 + (h)) * HTB)
#define PG8_SB(b, h) ((4 + (b) * 2 + (h)) * HTB)
#define PG8_STAGE(bufoff, gbase, voff) do { _Pragma("unroll") for (int _i = 0; _i < 2; ++_i) \
        __builtin_amdgcn_global_load_lds((const unsigned*)((const char*)(gbase) + (voff)[_i]), (PG8_LAS unsigned*)(lds + (bufoff) + ldsw + _i * 8192), 16, 0, 0); } while (0)
#define PG8_LDA(dst, b, h) do { _Pragma("unroll") for (int m = 0; m < 4; ++m) _Pragma("unroll") for (int k = 0; k < 2; ++k) dst[m][k] = *(const PG8_LAS bf16x8*)(lds + PG8_SA(b, h) + aoff + m * 2048 + k * 1024); } while (0)
#define PG8_LDB(dst, b, h) do { _Pragma("unroll") for (int n = 0; n < 2; ++n) _Pragma("unroll") for (int k = 0; k < 2; ++k) dst[n][k] = *(const PG8_LAS bf16x8*)(lds + PG8_SB(b, h) + boff + n * 2048 + k * 1024); } while (0)
#define PG8_MMA(ai, bj, At, Bt) do { __builtin_amdgcn_s_setprio(1); _Pragma("unroll") for (int m = 0; m < 4; ++m) _Pragma("unroll") for (int n = 0; n < 2; ++n) _Pragma("unroll") for (int k = 0; k < 2; ++k) \
        acc[ai][bj][m][n] = __builtin_amdgcn_mfma_f32_16x16x32_bf16(Bt[n][k], At[m][k], acc[ai][bj][m][n], 0, 0, 0); __builtin_amdgcn_s_setprio(0); } while (0)
#define PG8_WAIT_V(n) asm volatile("s_waitcnt vmcnt(" #n ")" ::: "memory")
#define PG8_WAIT_L(n) asm volatile("s_waitcnt lgkmcnt(" #n ")" ::: "memory")
#define PG8_BAR __builtin_amdgcn_s_barrier()
#define PG8_SCHED __builtin_amdgcn_sched_barrier(0)
    Unit cur, nxt; int ui = 0;
    if (!S.next(0, cur)) return;
    f32x4 acc[2][2][4][2];
#pragma unroll
    for (int a = 0; a < 2; ++a)
#pragma unroll
        for (int b = 0; b < 2; ++b)
#pragma unroll
            for (int m = 0; m < 4; ++m)
#pragma unroll
                for (int n = 0; n < 2; ++n) acc[a][b][m][n] = f32x4{0.f, 0.f, 0.f, 0.f};
    bf16x8 At[4][2], B0[2][2], B1[2][2];
    const char* cA = (const char*)g.A + cur.aoff; const char* cB = (const char*)g.Bt + cur.boff;
    PG8_STAGE(PG8_SB(0, 0), cB, voffB); PG8_STAGE(PG8_SA(0, 0), cA, voffA); PG8_STAGE(PG8_SB(0, 1), cB + hstepB, voffB); PG8_STAGE(PG8_SA(0, 1), cA + hstepA, voffA);
    if (wr == 1) PG8_BAR;
    PG8_WAIT_V(4); PG8_BAR;
    PG8_STAGE(PG8_SB(1, 0), cB + kstep, voffB); PG8_STAGE(PG8_SA(1, 0), cA + kstep, voffA); PG8_STAGE(PG8_SB(1, 1), cB + hstepB + kstep, voffB);
    PG8_WAIT_V(6); PG8_BAR;
    for (;;) {
        const bool has_next = S.next(ui + 1, nxt);
        const char* nA = has_next ? (const char*)g.A + nxt.aoff : cA; const char* nB = has_next ? (const char*)g.Bt + nxt.boff : cB;
        for (int t = 0; t < nt; t += 2) {
            const bool last = (t == nt - 2);
            const char* a1 = cA + (size_t)(t + 1) * kstep;
            const char* a2 = last ? nA : cA + (size_t)(t + 2) * kstep; const char* b2 = last ? nB : cB + (size_t)(t + 2) * kstep;
            const char* a3 = a2 + kstep; const char* b3 = b2 + kstep;
            PG8_LDB(B0, 0, 0); PG8_SCHED; PG8_LDA(At, 0, 0); PG8_STAGE(PG8_SA(1, 1), a1 + hstepA, voffA);
            PG8_WAIT_L(8); PG8_BAR; PG8_WAIT_L(0); PG8_MMA(0, 0, At, B0); PG8_BAR; PG8_SCHED;
            PG8_LDB(B1, 0, 1); PG8_STAGE(PG8_SB(0, 0), b2, voffB);
            PG8_BAR; PG8_WAIT_L(0); PG8_MMA(0, 1, At, B1); PG8_BAR;
            PG8_LDA(At, 0, 1); PG8_STAGE(PG8_SA(0, 0), a2, voffA);
            PG8_BAR; PG8_WAIT_L(0); PG8_MMA(1, 0, At, B0); PG8_BAR; PG8_SCHED;
            PG8_STAGE(PG8_SB(0, 1), b2 + hstepB, voffB);
            PG8_WAIT_V(6); PG8_BAR; PG8_MMA(1, 1, At, B1); PG8_BAR;
            PG8_LDB(B0, 1, 0); PG8_SCHED; PG8_LDA(At, 1, 0); PG8_STAGE(PG8_SA(0, 1), a2 + hstepA, voffA);
            PG8_WAIT_L(8); PG8_BAR; PG8_WAIT_L(0); PG8_MMA(0, 0, At, B0); PG8_BAR; PG8_SCHED;
            PG8_LDB(B1, 1, 1); PG8_STAGE(PG8_SB(1, 0), b3, voffB);
            PG8_BAR; PG8_WAIT_L(0); PG8_MMA(0, 1, At, B1); PG8_BAR;
            PG8_LDA(At, 1, 1); PG8_STAGE(PG8_SA(1, 0), a3, voffA);
            PG8_BAR; PG8_WAIT_L(0); PG8_MMA(1, 0, At, B0); PG8_BAR; PG8_SCHED;
            PG8_STAGE(PG8_SB(1, 1), b3 + hstepB, voffB);
            PG8_WAIT_V(6); PG8_BAR; PG8_MMA(1, 1, At, B1); PG8_BAR;
        }
        E(acc, cur, wr, wc, fr, fq);
        if (!has_next) break;
#pragma unroll
        for (int a = 0; a < 2; ++a)
#pragma unroll
            for (int b = 0; b < 2; ++b)
#pragma unroll
                for (int m = 0; m < 4; ++m)
#pragma unroll
                    for (int n = 0; n < 2; ++n) acc[a][b][m][n] = f32x4{0.f, 0.f, 0.f, 0.f};
        cur = nxt; cA = nA; cB = nB; ++ui;
    }
    PG8_WAIT_V(0);
    if (wr == 0) PG8_BAR;
    PG8_BAR;
#undef PG8_SA
#undef PG8_SB
#undef PG8_STAGE
#undef PG8_LDA
#undef PG8_LDB
#undef PG8_MMA
#undef PG8_WAIT_V
#undef PG8_WAIT_L
#undef PG8_BAR
#undef PG8_SCHED
}

struct EpiBf16 {
    static constexpr bool PERM = true;
    bf16_t* O; int ldc;
    __device__ __forceinline__ void operator()(const f32x4 (&acc)[2][2][4][2], const Unit& u, int wr, int wc, int fr, int fq) const {
        const int row0 = u.pm * BM + wr * 64 + fr, col0 = u.pn * BM + wc * 32 + 8 * fq;
#pragma unroll
        for (int ai = 0; ai < 2; ++ai)
#pragma unroll
            for (int m = 0; m < 4; ++m) { bf16_t* rowp = O + (size_t)(row0 + ai * HALF + m * 16) * ldc + col0;
#pragma unroll
                for (int bj = 0; bj < 2; ++bj) { const f32x4 v0 = acc[ai][bj][m][0], v1 = acc[ai][bj][m][1];
                    u32x4 w; w.x = pack2(v0[0], v0[1]); w.y = pack2(v0[2], v0[3]); w.z = pack2(v1[0], v1[1]); w.w = pack2(v1[2], v1[3]);
                    *(u32x4*)(rowp + bj * HALF) = w; } }
    }
};
struct EpiResid {
    static constexpr bool PERM = false;
    const float* xin; float* out; const float* mod;
    __device__ __forceinline__ void operator()(const f32x4 (&acc)[2][2][4][2], const Unit& u, int wr, int wc, int fr, int fq) const {
        const int row0 = u.pm * BM + wr * 64 + fr, col0 = u.pn * BM + wc * 32 + 4 * fq;
        const float* gm = mod + (size_t)(row0 >> 11) * 6144 + 2048 + col0;
        f32x4 g4[2][2];
#pragma unroll
        for (int bj = 0; bj < 2; ++bj)
#pragma unroll
            for (int n = 0; n < 2; ++n) g4[bj][n] = *(const f32x4*)(gm + bj * HALF + n * 16);
#pragma unroll
        for (int ai = 0; ai < 2; ++ai) {
            f32x4 xi[4][2][2];
#pragma unroll
            for (int m = 0; m < 4; ++m)
#pragma unroll
                for (int bj = 0; bj < 2; ++bj)
#pragma unroll
                    for (int n = 0; n < 2; ++n) xi[m][bj][n] = *(const f32x4*)(xin + (size_t)(row0 + ai * HALF + m * 16) * 1024 + col0 + bj * HALF + n * 16);
            asm volatile("" ::: "memory");
#pragma unroll
            for (int m = 0; m < 4; ++m)
#pragma unroll
                for (int bj = 0; bj < 2; ++bj)
#pragma unroll
                    for (int n = 0; n < 2; ++n)
                        *(f32x4*)(out + (size_t)(row0 + ai * HALF + m * 16) * 1024 + col0 + bj * HALF + n * 16) = xi[m][bj][n] + g4[bj][n] * acc[ai][bj][m][n];
            asm volatile("" ::: "memory");
        }
    }
};
struct EpiMerge {
    static constexpr bool PERM = true;
    bf16_t* Hm; const bf16_t* Z;
    __device__ __forceinline__ void operator()(const f32x4 (&acc)[2][2][4][2], const Unit& u, int wr, int wc, int fr, int fq) const {
        const int row0 = u.pm * BM + wr * 64 + fr, col0 = u.pn * BM + wc * 32 + 8 * fq, g = u.aux;
#pragma unroll
        for (int ai = 0; ai < 2; ++ai) {
            u32x4 gz[4][2], prev[4][2];
#pragma unroll
            for (int m = 0; m < 4; ++m)
#pragma unroll
                for (int bj = 0; bj < 2; ++bj) {
                    const int row = row0 + ai * HALF + m * 16, col = col0 + bj * HALF;
                    gz[m][bj] = *(const u32x4*)(Z + (size_t)row * LDZ + ZM + g * 1024 + col);
                    prev[m][bj] = u32x4{0u, 0u, 0u, 0u};
                    if (g > 0) prev[m][bj] = *(const u32x4*)(Hm + (size_t)row * 1024 + col);
                }
            asm volatile("" ::: "memory");
#pragma unroll
            for (int m = 0; m < 4; ++m)
#pragma unroll
                for (int bj = 0; bj < 2; ++bj) {
                    const int row = row0 + ai * HALF + m * 16, col = col0 + bj * HALF;
                    const f32x4 v0 = acc[ai][bj][m][0], v1 = acc[ai][bj][m][1];
                    const u32x4 z_ = gz[m][bj], p_ = prev[m][bj];
                    u32x4 w;
                    w.x = pack2(bflo(p_.x) + sigm(bflo(z_.x)) * v0[0], bfhi(p_.x) + sigm(bfhi(z_.x)) * v0[1]);
                    w.y = pack2(bflo(p_.y) + sigm(bflo(z_.y)) * v0[2], bfhi(p_.y) + sigm(bfhi(z_.y)) * v0[3]);
                    w.z = pack2(bflo(p_.z) + sigm(bflo(z_.z)) * v1[0], bfhi(p_.z) + sigm(bfhi(z_.z)) * v1[1]);
                    w.w = pack2(bflo(p_.w) + sigm(bflo(z_.w)) * v1[2], bfhi(p_.w) + sigm(bfhi(z_.w)) * v1[3]);
                    *(u32x4*)(Hm + (size_t)row * 1024 + col) = w;
                }
            asm volatile("" ::: "memory");
        }
    }
};
}

struct EpiZ {
    bf16_t* Z; int ld;
    __device__ __forceinline__ void operator()(int m, int n, const f32x4& v) const {
        uint2 o; o.x = pack2(v[0], v[1]); o.y = pack2(v[2], v[3]);
        *(uint2*)(Z + (size_t)m * ld + n) = o;
    }
};
struct EpiF16 {
    _Float16* C; int ld;
    __device__ __forceinline__ void operator()(int m, int n, const f32x4& v) const {
        typedef _Float16 h4 __attribute__((ext_vector_type(4)));
        h4 o = {(_Float16)v[0], (_Float16)v[1], (_Float16)v[2], (_Float16)v[3]};
        *(h4*)(C + (size_t)m * ld + n) = o;
    }
};
struct EpiOut {
    const float* xin; float* out; const float* mod;
    __device__ __forceinline__ void operator()(int m, int n, const f32x4& v) const {
        int b = m >> 11;
        float4 g = *(const float4*)(mod + (size_t)b * 6144 + 2048 + n);
        float4 xi = *(const float4*)(xin + (size_t)m * 1024 + n);
        *(float4*)(out + (size_t)m * 1024 + n) = make_float4(xi.x + g.x * v[0], xi.y + g.y * v[1], xi.z + g.z * v[2], xi.w + g.w * v[3]);
    }
};

template <class Epi>
__device__ void gemm_phase(const bf16_t* A, int lda, const bf16_t* Bt, int ldb, int M, int N, int K, bool batched, Epi epi,
                           int vb0, int nvb, char* smem_, const int tid) {
    bf16_t* sA = (bf16_t*)smem_; bf16_t* sB = sA + GBM * GLS;
    const int lane = tid & 63, wave = tid >> 6, wm = wave >> 1, wn = wave & 1, fr = lane & 15, fq = lane >> 4;
    const int MT = M / GBM, NTL = N / GBN;
    for (int tile = vb0; tile < MT * NTL; tile += nvb) {
        int mt = tile % MT, nt = tile / MT;
        f32x4 acc[4][4];
#pragma unroll
        for (int a = 0; a < 4; ++a)
#pragma unroll
            for (int b = 0; b < 4; ++b) acc[a][b] = f32x4{0.f, 0.f, 0.f, 0.f};
        gemm_tile(batched ? A + nt * 128 : A, lda, Bt, ldb, K, mt * GBM, nt * GBN, sA, sB, acc, tid);
#pragma unroll
        for (int nf = 0; nf < 4; ++nf)
#pragma unroll
            for (int mf = 0; mf < 4; ++mf)
                epi(mt * GBM + wm * 64 + mf * 16 + fr, nt * GBN + wn * 64 + nf * 16 + fq * 4, acc[nf][mf]);
    }
}
__device__ __forceinline__ void sc_tile(const Params& p, int mt, int nt, char* smem_, const int tid) {
    bf16_t* sA = (bf16_t*)smem_; bf16_t* sB = sA + GBM * GLS;
    const int lane = tid & 63, wave = tid >> 6, wm = wave >> 1, wn = wave & 1, fr = lane & 15, fq = lane >> 4;
    f32x4 acc[4][4];
#pragma unroll
    for (int a = 0; a < 4; ++a)
#pragma unroll
        for (int b = 0; b < 4; ++b) acc[a][b] = f32x4{0.f, 0.f, 0.f, 0.f};
    gemm_tile((const bf16_t*)(p.ws + WS_QP) + nt * 128, 2048, (const bf16_t*)(p.ws + WS_SK), 128, 128, mt * GBM, nt * GBN, sA, sB, acc, tid);
    const EpiF16 epi{(_Float16*)(p.ws + WS_SC), 2048};
#pragma unroll
    for (int nf = 0; nf < 4; ++nf)
#pragma unroll
        for (int mf = 0; mf < 4; ++mf)
            epi(mt * GBM + wm * 64 + mf * 16 + fr, nt * GBN + wn * 64 + nf * 16 + fq * 4, acc[nf][mf]);
}

#define SCAN_SYNC() do { asm volatile("s_waitcnt lgkmcnt(0)" ::: "memory"); __builtin_amdgcn_s_barrier(); asm volatile("" ::: "memory"); } while (0)
template <int DK, bool GLA>
__device__ void scan2_item(const Params& p, int l, int b, int h, char* smem_) {
    constexpr int SEG = NT / DK, SLEN = 64 / SEG, KS = DK / 32, KT = DK / 16;
    constexpr int QS = DK + 8, BS = DK + 4, VS = 72;
    bf16_t* qs = (bf16_t*)smem_;
    bf16_t* ks = qs + 64 * QS;
    float* bs = (float*)(ks + 64 * QS);
    bf16_t* vt = (bf16_t*)(bs + 64 * BS);
    bf16_t* At = vt + 128 * VS;
    bf16_t* kht = At + 64 * VS;
    bf16_t* st = kht + DK * VS;
    float* segtot = (float*)(st + 128 * QS);
    float* blast = segtot + SEG * DK;
    const int tid = TIDX(), lane = tid & 63, wave = __builtin_amdgcn_readfirstlane(tid >> 6), fr = lane & 15, fq = lane >> 4;
    const int kl = tid % DK, seg = __builtin_amdgcn_readfirstlane(tid / DK);
    float lbv = 0.f, gbias = 0.f; float gu[16];
#pragma unroll
    for (int r = 0; r < 16; ++r) gu[r] = 0.f;
    if (GLA) {
#pragma unroll
        for (int r = 0; r < 16; ++r) gu[r] = p.gla_up[(size_t)(l * 16 + r) * 256 + h * 64 + kl];
        gbias = p.gla_bias[l * 256 + h * 64 + kl];
    } else if (l == 1) {
        float x0 = p.hgrn_lb[h * 128 + kl], x1 = p.hgrn_lb[512 + h * 128 + kl];
        lbv = 1.f / (1.f + expf(x0 - x1));
    }
    const float scale = GLA ? 0.125f : 0.08838834764831845f;
    const bf16_t* Zb = (const bf16_t*)(p.ws + WS_Z) + (size_t)(b * 2048) * LDZ;
    float* ssq = (float*)(smem_ + 152576);
    const int QCOL = (GLA ? ZC_Q : ZA_Q) + h * DK, KCOL = (GLA ? ZC_K : ZA_F) + h * DK, VCOL = (GLA ? ZC_V : ZA_I) + h * 128, GCOL = (GLA ? ZC_G : ZA_G) + h * 128;
    f32x4 sacc[KT];
#pragma unroll
    for (int i = 0; i < KT; ++i) sacc[i] = f32x4{0.f, 0.f, 0.f, 0.f};
    f32x4 gn4[4];
    {
        const float* gn = (GLA ? p.gla_on : p.hgrn_on) + l * 128 + (wave >> 2) * 64 + 4 * fq;
#pragma unroll
        for (int vi = 0; vi < 4; ++vi) gn4[vi] = *(const f32x4*)(gn + vi * 16);
    }
    for (int i = tid; i < 128 * QS / 2; i += NT) ((unsigned*)st)[i] = 0u;
    SCAN_SYNC();

    bf16_t rq[SLEN], rk[SLEN], rv[16];
    u32x4 rc0[GLA ? SLEN : 1], rc1[GLA ? SLEN : 1];
    const int v_ = tid & 127, sb_ = __builtin_amdgcn_readfirstlane(tid >> 7);
#define SCAN_FETCH(cc) do { const bf16_t* Zn_ = Zb + (size_t)((cc) * 64) * LDZ; \
        _Pragma("unroll") for (int i = 0; i < 16; ++i) rv[i] = Zn_[(size_t)(sb_ + 4 * i) * LDZ + VCOL + v_]; \
        _Pragma("unroll") for (int i = 0; i < SLEN; ++i) { const bf16_t* zr = Zn_ + (size_t)(seg * SLEN + i) * LDZ; rq[i] = zr[QCOL + kl]; rk[i] = zr[KCOL + kl]; \
            if (GLA) { rc0[i] = *(const u32x4*)(zr + ZC_CODE); rc1[i] = *(const u32x4*)(zr + ZC_CODE + 8); } } } while (0)
    SCAN_FETCH(0);
    for (int c = 0; c < 32; ++c) {
        const bf16_t* Zc = Zb + (size_t)(c * 64) * LDZ;
        {
#pragma unroll
            for (int i = 0; i < 16; ++i) vt[v_ * VS + sb_ + 4 * i] = rv[i];
            float run = 0.f;
#pragma unroll
            for (int i = 0; i < SLEN; ++i) {
                const int s_ = seg * SLEN + i;
                float g, kk;
                if (GLA) {
                    float x = gbias;
#pragma unroll
                    for (int r = 0; r < 4; ++r) {
                        x += bflo(rc0[i][r]) * gu[2 * r] + bfhi(rc0[i][r]) * gu[2 * r + 1];
                        x += bflo(rc1[i][r]) * gu[8 + 2 * r] + bfhi(rc1[i][r]) * gu[8 + 2 * r + 1];
                    }
                    g = (fminf(x, 0.f) - __logf(1.f + __expf(-fabsf(x)))) * (1.f / 16.f);
                    kk = bf2f(rk[i]);
                } else {
                    const float f = lbv + (1.f - lbv) * __frcp_rn(1.f + __expf(-bf2f(rk[i])));
                    g = __logf(f); kk = 1.f - f;
                }
                run += g;
                bs[s_ * BS + kl] = run;
                qs[s_ * QS + kl] = rq[i];
                ks[s_ * QS + kl] = f2bf(kk);
            }
            segtot[seg * DK + kl] = run;
            SCAN_FETCH(c < 31 ? c + 1 : 31);
        }
        SCAN_SYNC();
        {
            float pre = 0.f, tot = 0.f;
#pragma unroll
            for (int g_ = 0; g_ < SEG; ++g_) { const float v_ = segtot[g_ * DK + kl]; if (g_ < seg) pre += v_; tot += v_; }
            if (seg == 0) blast[kl] = tot;
            unsigned pk[SLEN / 2];
#pragma unroll
            for (int i = 0; i < SLEN; ++i) {
                const float bv = bs[(seg * SLEN + i) * BS + kl] + pre;
                bs[(seg * SLEN + i) * BS + kl] = bv;
                const float kh = bf2f(ks[(seg * SLEN + i) * QS + kl]) * __expf(tot - bv);
                if (i & 1) pk[i >> 1] |= ((unsigned)f2bf(kh)) << 16; else pk[i >> 1] = (unsigned)f2bf(kh);
            }
            unsigned* dst = (unsigned*)(kht + kl * VS + seg * SLEN);
#pragma unroll
            for (int i = 0; i < SLEN / 2; ++i) dst[i] = pk[i];
        }
        SCAN_SYNC();
        for (int blk = wave; blk < 10; blk += 8) {
            int bi, bj;
            if (blk < 1) { bi = 0; bj = 0; } else if (blk < 3) { bi = 1; bj = blk - 1; } else if (blk < 6) { bi = 2; bj = blk - 3; } else { bi = 3; bj = blk - 6; }
            f32x4 acc = f32x4{0.f, 0.f, 0.f, 0.f};
            const int srow = bj * 16 + fr, trow = bi * 16 + fr;
#pragma unroll
            for (int kk = 0; kk < KS; ++kk) {
                const int k0 = kk * 32 + fq * 8;
                float br[8];
                if (bi == 0) {
#pragma unroll
                    for (int j = 0; j < 8; ++j) br[j] = 0.f;
                } else {
                    const float4 r0 = *(const float4*)(bs + (bi * 16 - 1) * BS + k0), r1 = *(const float4*)(bs + (bi * 16 - 1) * BS + k0 + 4);
                    br[0] = r0.x; br[1] = r0.y; br[2] = r0.z; br[3] = r0.w; br[4] = r1.x; br[5] = r1.y; br[6] = r1.z; br[7] = r1.w;
                }
                const uint4 kq = *(const uint4*)(ks + srow * QS + k0), qq = *(const uint4*)(qs + trow * QS + k0);
                const float4 s0 = *(const float4*)(bs + srow * BS + k0), s1 = *(const float4*)(bs + srow * BS + k0 + 4);
                const float4 t0_ = *(const float4*)(bs + trow * BS + k0), t1_ = *(const float4*)(bs + trow * BS + k0 + 4);
                const float bsv[8] = {s0.x, s0.y, s0.z, s0.w, s1.x, s1.y, s1.z, s1.w}, btv[8] = {t0_.x, t0_.y, t0_.z, t0_.w, t1_.x, t1_.y, t1_.z, t1_.w};
                const unsigned kw[4] = {kq.x, kq.y, kq.z, kq.w}, qw[4] = {qq.x, qq.y, qq.z, qq.w};
                union { bf16x8 v; unsigned u[4]; } ka, qb;
#pragma unroll
                for (int j = 0; j < 4; ++j) {
                    const float e0 = __expf(fminf(br[2 * j] - bsv[2 * j], 60.f)), e1 = __expf(fminf(br[2 * j + 1] - bsv[2 * j + 1], 60.f));
                    ka.u[j] = pack2(bflo(kw[j]) * e0, bfhi(kw[j]) * e1);
                    const float f0 = __expf(btv[2 * j] - br[2 * j]), f1 = __expf(btv[2 * j + 1] - br[2 * j + 1]);
                    qb.u[j] = pack2(bflo(qw[j]) * f0, bfhi(qw[j]) * f1);
                }
                acc = __builtin_amdgcn_mfma_f32_16x16x32_bf16(ka.v, qb.v, acc, 0, 0, 0);
            }
            if (bi == bj) {
#pragma unroll
                for (int r = 0; r < 4; ++r) if (4 * fq + r > fr) acc[r] = 0.f;
            }
            uint2 o; o.x = pack2(acc[0], acc[1]); o.y = pack2(acc[2], acc[3]);
            *(uint2*)(At + trow * VS + bj * 16 + 4 * fq) = o;
        }
        {
            unsigned z_ = 0u; asm volatile("" : "+v"(z_));
            if (wave == 2) *(uint2*)(At + (0 * 16 + fr) * VS + 16 + 4 * fq) = make_uint2(z_, z_);
            if (wave == 3) *(uint2*)(At + (2 * 16 + fr) * VS + 48 + 4 * fq) = make_uint2(z_, z_);
        }
        SCAN_SYNC();
        f32x4 oacc[4]; uint2 gz[4];
        {
            const int ti = wave & 3, vh = wave >> 2, trow = ti * 16 + fr;
            bf16x8 qh[KS];
#pragma unroll
            for (int kk = 0; kk < KS; ++kk) {
                const int k0 = kk * 32 + fq * 8;
                const uint4 qq = *(const uint4*)(qs + trow * QS + k0);
                const float4 t0_ = *(const float4*)(bs + trow * BS + k0), t1_ = *(const float4*)(bs + trow * BS + k0 + 4);
                union { bf16x8 v; unsigned u[4]; } q_;
                q_.u[0] = pack2(bflo(qq.x) * __expf(t0_.x), bfhi(qq.x) * __expf(t0_.y));
                q_.u[1] = pack2(bflo(qq.y) * __expf(t0_.z), bfhi(qq.y) * __expf(t0_.w));
                q_.u[2] = pack2(bflo(qq.z) * __expf(t1_.x), bfhi(qq.z) * __expf(t1_.y));
                q_.u[3] = pack2(bflo(qq.w) * __expf(t1_.z), bfhi(qq.w) * __expf(t1_.w));
                qh[kk] = q_.v;
            }
            const bf16x8 af0 = *(const bf16x8*)(At + trow * VS + fq * 8), af1 = *(const bf16x8*)(At + trow * VS + 32 + fq * 8);
            float sq = 0.f;
#pragma unroll
            for (int vi = 0; vi < 4; ++vi) {
                const int vrow = vh * 64 + vi * 16 + fr;
                gz[vi] = *(const uint2*)(Zc + (size_t)trow * LDZ + GCOL + vh * 64 + vi * 16 + 4 * fq);
                f32x4 acc = f32x4{0.f, 0.f, 0.f, 0.f};
                acc = __builtin_amdgcn_mfma_f32_16x16x32_bf16(*(const bf16x8*)(vt + vrow * VS + fq * 8), af0, acc, 0, 0, 0);
                if (ti >= 2) acc = __builtin_amdgcn_mfma_f32_16x16x32_bf16(*(const bf16x8*)(vt + vrow * VS + 32 + fq * 8), af1, acc, 0, 0, 0);
#pragma unroll
                for (int kk = 0; kk < KS; ++kk)
                    acc = __builtin_amdgcn_mfma_f32_16x16x32_bf16(*(const bf16x8*)(st + vrow * QS + kk * 32 + fq * 8), qh[kk], acc, 0, 0, 0);
                oacc[vi] = acc * scale;
                sq += oacc[vi][0] * oacc[vi][0] + oacc[vi][1] * oacc[vi][1] + oacc[vi][2] * oacc[vi][2] + oacc[vi][3] * oacc[vi][3];
            }
            sq += shx<16>(sq); sq += shx<32>(sq);
            if (fq == 0) ssq[vh * 64 + trow] = sq;
        }
        {
            const int vrow = wave * 16 + fr;
            const bf16x8 vf0 = *(const bf16x8*)(vt + vrow * VS + fq * 8), vf1 = *(const bf16x8*)(vt + vrow * VS + 32 + fq * 8);
#pragma unroll
            for (int kt = 0; kt < KT; ++kt) {
                const float dec = __expf(blast[kt * 16 + fr]);
                sacc[kt][0] *= dec; sacc[kt][1] *= dec; sacc[kt][2] *= dec; sacc[kt][3] *= dec;
                sacc[kt] = __builtin_amdgcn_mfma_f32_16x16x32_bf16(vf0, *(const bf16x8*)(kht + (kt * 16 + fr) * VS + fq * 8), sacc[kt], 0, 0, 0);
                sacc[kt] = __builtin_amdgcn_mfma_f32_16x16x32_bf16(vf1, *(const bf16x8*)(kht + (kt * 16 + fr) * VS + 32 + fq * 8), sacc[kt], 0, 0, 0);
            }
        }
        SCAN_SYNC();
#pragma unroll
        for (int kt = 0; kt < KT; ++kt)
#pragma unroll
            for (int r = 0; r < 4; ++r) st[(wave * 16 + 4 * fq + r) * QS + kt * 16 + fr] = f2bf(sacc[kt][r]);
        {
            const int ti = wave & 3, vh = wave >> 2, trow = ti * 16 + fr;
            const float rstd = rsqrtf((ssq[trow] + ssq[64 + trow]) * (1.f / 128.f) + 1e-6f);
            bf16_t* yrow = (bf16_t*)(p.ws + WS_Y) + (size_t)(b * 2048 + c * 64 + trow) * 1536 + (GLA ? 1024 : 0) + h * 128 + vh * 64 + 4 * fq;
#pragma unroll
            for (int vi = 0; vi < 4; ++vi) {
                const f32x4 g4_ = gn4[vi]; const float4 g4 = make_float4(g4_[0], g4_[1], g4_[2], g4_[3]);
                const float z0 = bflo(gz[vi].x), z1 = bfhi(gz[vi].x), z2 = bflo(gz[vi].y), z3 = bfhi(gz[vi].y);
                uint2 o;
                o.x = pack2(oacc[vi][0] * rstd * g4.x * (z0 * sigm(z0)), oacc[vi][1] * rstd * g4.y * (z1 * sigm(z1)));
                o.y = pack2(oacc[vi][2] * rstd * g4.z * (z2 * sigm(z2)), oacc[vi][3] * rstd * g4.w * (z3 * sigm(z3)));
                *(uint2*)(yrow + vi * 16) = o;
            }
        }
    }
    SCAN_SYNC();
#undef SCAN_FETCH
}

__device__ void dsaprep2_item(const Params& p, int l, int item, char* smem_) {
    bf16_t* tile = (bf16_t*)smem_;
    const int tid = TIDX(), lane = tid & 63, wave = tid >> 6;
    bf16_t* Z = (bf16_t*)(p.ws + WS_Z); bf16_t* VT = (bf16_t*)(p.ws + WS_VT);
    {
        const int tb = item * 32;
        {
            const float2 gq = *(const float2*)(p.dsa_qn + l * 128 + lane * 2), gk = *(const float2*)(p.dsa_kn + l * 128 + lane * 2);
            unsigned uu[4][8];
#pragma unroll
            for (int j = 0; j < 4; ++j)
#pragma unroll
                for (int grp = 0; grp < 8; ++grp)
                    uu[j][grp] = *(const unsigned*)(Z + (size_t)(tb + wave + 8 * j) * LDZ + (grp < 4 ? ZB_Q : ZB_K) + (grp & 3) * 128 + lane * 2);
#pragma unroll
            for (int j = 0; j < 4; ++j)
#pragma unroll
                for (int grp = 0; grp < 8; ++grp) {
                    bf16_t* ptr = Z + (size_t)(tb + wave + 8 * j) * LDZ + (grp < 4 ? ZB_Q : ZB_K) + (grp & 3) * 128 + lane * 2;
                    const float a = bflo(uu[j][grp]), b = bfhi(uu[j][grp]);
                    const float ss = wave_sum(a * a + b * b);
                    const float r = rsqrtf(ss * (1.f / 128.f) + 1e-6f) * ((grp < 4) ? 0.08838834764831845f : 1.f);
                    const float2 g = (grp < 4) ? gq : gk;
                    __hip_atomic_store((unsigned*)ptr, pack2(a * r * g.x, b * r * g.y), __ATOMIC_RELAXED, __HIP_MEMORY_SCOPE_AGENT);
                }
        }
        u32x4 uv[4];
#pragma unroll
        for (int i = 0; i < 4; ++i) { const int ch = tid + i * 512; uv[i] = *(const u32x4*)(Z + (size_t)(tb + (ch >> 6)) * LDZ + ZB_V + (ch & 63) * 8); }
#pragma unroll
        for (int i = 0; i < 4; ++i) {
            const int ch = tid + i * 512, t = ch >> 6, c8 = (ch & 63) * 8;
            unsigned* d = (unsigned*)(tile + t * 514 + c8);
            d[0] = uv[i][0]; d[1] = uv[i][1]; d[2] = uv[i][2]; d[3] = uv[i][3];
        }
        __syncthreads();
        {
            const int c = tid, b = tb >> 11, s0 = tb & 2047;
            unsigned w[16];
#pragma unroll
            for (int j = 0; j < 16; ++j) w[j] = (unsigned)tile[(2 * j) * 514 + c] | ((unsigned)tile[(2 * j + 1) * 514 + c] << 16);
            unsigned long long* dst = (unsigned long long*)(VT + ((size_t)(b * 512 + c)) * 2048 + s0);
#pragma unroll
            for (int j = 0; j < 8; ++j) __hip_atomic_store(dst + j, ((unsigned long long)w[2 * j + 1] << 32) | w[2 * j], __ATOMIC_RELAXED, __HIP_MEMORY_SCOPE_AGENT);
        }
        __syncthreads();
    }
}

__device__ void dsa_select_tile(const Params& p, int b, int tq, char* smem_) {
    constexpr int KS_ = 2052;
    unsigned* keyL = (unsigned*)smem_;
    const int tid = TIDX(), lane = tid & 63, wave = __builtin_amdgcn_readfirstlane(tid >> 6), fr = lane & 15, fq = lane >> 4;
    const bf16_t* Z = (const bf16_t*)(p.ws + WS_Z);
    unsigned long long* BM64 = (unsigned long long*)(p.ws + WS_BM);
    const int t0 = tq * 16;
    {
        const int tl = t0 + fr;
        const size_t trow = (size_t)b * 2048 + tl;
        bf16x8 qf[4][2];
#pragma unroll
        for (int h = 0; h < 4; ++h)
#pragma unroll
            for (int ks = 0; ks < 2; ++ks) qf[h][ks] = *(const bf16x8*)(Z + trow * LDZ + ZB_QI + h * 64 + ks * 32 + fq * 8);
        float w[4];
#pragma unroll
        for (int h = 0; h < 4; ++h) w[h] = bf2f(Z[trow * LDZ + ZB_WI + h]) * 0.5f;
#pragma unroll 4
        for (int kt = wave; kt <= tq; kt += 8) {
            const bf16_t* kr = Z + ((size_t)b * 2048 + kt * 16 + fr) * LDZ + ZB_KI + fq * 8;
            const bf16x8 k0 = *(const bf16x8*)kr, k1 = *(const bf16x8*)(kr + 32);
            f32x4 acc[4];
#pragma unroll
            for (int h = 0; h < 4; ++h) {
                acc[h] = __builtin_amdgcn_mfma_f32_16x16x32_bf16(k0, qf[h][0], f32x4{0.f, 0.f, 0.f, 0.f}, 0, 0, 0);
                acc[h] = __builtin_amdgcn_mfma_f32_16x16x32_bf16(k1, qf[h][1], acc[h], 0, 0, 0);
            }
            u32x4 kk;
#pragma unroll
            for (int r = 0; r < 4; ++r) {
                float sc = w[0] * fmaxf(acc[0][r] * 0.125f, 0.f) + w[1] * fmaxf(acc[1][r] * 0.125f, 0.f) + w[2] * fmaxf(acc[2][r] * 0.125f, 0.f) + w[3] * fmaxf(acc[3][r] * 0.125f, 0.f);
                if (sc == 0.f) sc = 0.f;
                const unsigned u = __float_as_uint(sc);
                const unsigned k = (u & 0x80000000u) ? ~u : (u | 0x80000000u);
                kk[r] = (kt * 16 + 4 * fq + r <= tl) ? k : 0u;
            }
            *(u32x4*)(keyL + fr * KS_ + kt * 16 + 4 * fq) = kk;
        }
    }
    __syncthreads();
    {
        const int nk = (tq + 1) * 16, jmax = (nk + 63) >> 6;
        const int qa = 2 * wave, qb = qa + 1;
        unsigned ka[32], kb[32];
#pragma unroll
        for (int j = 0; j < 32; ++j) {
            const int s = lane + 64 * j;
            ka[j] = (s < nk) ? keyL[qa * KS_ + s] : 0u;
            kb[j] = (s < nk) ? keyL[qb * KS_ + s] : 0u;
        }
        unsigned Ta = 1u, Tb = 1u; int Ca = 2047, Cb = 2047;
        if (t0 >= 256) {
            int na, nb;
            bool da, db;
            {
                int c0 = 0, c1 = 0, c2 = 0, c3 = 0;
#pragma unroll
                for (int j = 0; j < 32; ++j)
                    if (j < jmax) { c0 += (ka[j] >= 0x80000000u); c1 += (ka[j] > 0x80000000u); c2 += (kb[j] >= 0x80000000u); c3 += (kb[j] > 0x80000000u); }
                c0 = wave_total_i(c0); c1 = wave_total_i(c1); c2 = wave_total_i(c2); c3 = wave_total_i(c3);
                da = (c1 < 256 && c0 >= 256); db = (c3 < 256 && c2 >= 256);
                Ta = da ? 0x80000000u : ((c0 >= 256) ? 0x80000000u : 0u); na = da ? c0 : ((c0 >= 256) ? c0 : 0x7fffffff);
                Tb = db ? 0x80000000u : ((c2 >= 256) ? 0x80000000u : 0u); nb = db ? c2 : ((c2 >= 256) ? c2 : 0x7fffffff);
            }
            for (int bit = 30; bit >= 0; --bit) {
                if (da && db) break;
                const unsigned ca_ = Ta | (1u << bit), cb_ = Tb | (1u << bit);
                int c0 = 0, c1 = 0;
#pragma unroll
                for (int j = 0; j < 32; ++j)
                    if (j < jmax) { c0 += (ka[j] >= ca_); c1 += (kb[j] >= cb_); }
                c0 = wave_total_i(c0); c1 = wave_total_i(c1);
                if (!da && c0 >= 256) { Ta = ca_; na = c0; }
                if (!db && c1 >= 256) { Tb = cb_; nb = c1; }
                da = da || (na == 256); db = db || (nb == 256);
            }
            if (na != 256 || nb != 256) {
                int needa, needb;
                {
                    int c0 = 0, c1 = 0;
#pragma unroll
                    for (int j = 0; j < 32; ++j)
                        if (j < jmax) { c0 += (ka[j] > Ta); c1 += (kb[j] > Tb); }
                    needa = 256 - wave_total_i(c0); needb = 256 - wave_total_i(c1);
                }
                Ca = 0; Cb = 0;
                for (int bit = 10; bit >= 0; --bit) {
                    const int ca_ = Ca | (1 << bit), cb_ = Cb | (1 << bit);
                    int c0 = 0, c1 = 0;
#pragma unroll
                    for (int j = 0; j < 32; ++j)
                        if (j < jmax) { const int s = lane + 64 * j; c0 += (ka[j] == Ta && s < ca_); c1 += (kb[j] == Tb && s < cb_); }
                    c0 = wave_total_i(c0); c1 = wave_total_i(c1);
                    if (c0 < needa) Ca = ca_;
                    if (c1 < needb) Cb = cb_;
                }
            }
        }
        const size_t rowa = (size_t)b * 2048 + t0 + qa;
#pragma unroll
        for (int j = 0; j < 32; ++j) {
            const int s = lane + 64 * j;
            const unsigned long long ma = __ballot((ka[j] > Ta) || (ka[j] == Ta && s <= Ca));
            const unsigned long long mb = __ballot((kb[j] > Tb) || (kb[j] == Tb && s <= Cb));
            if (lane == 0) {
                __hip_atomic_store(&BM64[rowa * 32 + j], ma, __ATOMIC_RELAXED, __HIP_MEMORY_SCOPE_AGENT);
                __hip_atomic_store(&BM64[(rowa + 1) * 32 + j], mb, __ATOMIC_RELAXED, __HIP_MEMORY_SCOPE_AGENT);
            }
        }
    }
    __syncthreads();
}

__device__ void dsa_attn_item(const Params& p, int b, int h, int qg, char* smem_) {
    constexpr int KSTR = 136, VSTR = 40;
    bf16_t* Kl = (bf16_t*)smem_;
    bf16_t* Vl = Kl + 2 * 32 * KSTR;
    const int tid = TIDX(), lane = tid & 63, wave = __builtin_amdgcn_readfirstlane(tid >> 6), fr = lane & 15, fq = lane >> 4;
    const bf16_t* Z = (const bf16_t*)(p.ws + WS_Z); const bf16_t* VT = (const bf16_t*)(p.ws + WS_VT);
    const unsigned* BM = (const unsigned*)(p.ws + WS_BM); bf16_t* Y = (bf16_t*)(p.ws + WS_Y);
    const int kr = tid >> 4, kc = tid & 15, vd = tid >> 2, vc = tid & 3;
    const int ka_row = 8 * (fr >> 2) + (fr & 3);
    {
        const int t0 = qg * 128 + wave * 16;
        const size_t trow = (size_t)b * 2048 + t0 + fr;
        bf16x8 qf[4];
#pragma unroll
        for (int ks = 0; ks < 4; ++ks) qf[ks] = *(const bf16x8*)(Z + trow * LDZ + ZB_Q + h * 128 + ks * 32 + fq * 8);
        f32x4 o[8];
#pragma unroll
        for (int i = 0; i < 8; ++i) o[i] = f32x4{0.f, 0.f, 0.f, 0.f};
        float m = -INFINITY, lsum = 0.f;
        const unsigned* bmrow = BM + trow * 64;
        const int nsteps_blk = qg * 4 + 4, nsteps_w = (t0 + 15) / 32 + 1;
        const bf16_t* kg = Z + ((size_t)b * 2048 + kr) * LDZ + ZB_K + h * 128 + kc * 8;
        const bf16_t* vg = VT + ((size_t)(b * 4 + h) * 128 + vd) * 2048 + vc * 8;
        u32x4 rk = *(const u32x4*)kg, rv = *(const u32x4*)vg;
        *(u32x4*)(Kl + kr * KSTR + kc * 8) = rk; *(u32x4*)(Vl + vd * VSTR + vc * 8) = rv;
        __syncthreads();
        unsigned mwn = bmrow[0];
        for (int st = 0; st < nsteps_blk; ++st) {
            const bool more = (st + 1 < nsteps_blk);
            const unsigned mwc = mwn;
            mwn = bmrow[(st + 1 < nsteps_w) ? st + 1 : st];
            if (more) { rk = *(const u32x4*)(kg + (size_t)(st + 1) * 32 * LDZ); rv = *(const u32x4*)(vg + (st + 1) * 32); }
            if (st < nsteps_w) {
                const bf16_t* Kb = Kl + (st & 1) * 32 * KSTR; const bf16_t* Vb = Vl + (st & 1) * 128 * VSTR;
                f32x4 sa = f32x4{0.f, 0.f, 0.f, 0.f}, sb = f32x4{0.f, 0.f, 0.f, 0.f};
#pragma unroll
                for (int ks = 0; ks < 4; ++ks) {
                    const bf16x8 fa = *(const bf16x8*)(Kb + ka_row * KSTR + ks * 32 + fq * 8), fb = *(const bf16x8*)(Kb + (ka_row + 4) * KSTR + ks * 32 + fq * 8);
                    sa = __builtin_amdgcn_mfma_f32_16x16x32_bf16(fa, qf[ks], sa, 0, 0, 0);
                    sb = __builtin_amdgcn_mfma_f32_16x16x32_bf16(fb, qf[ks], sb, 0, 0, 0);
                }
                const unsigned mw = mwc >> (8 * fq);
                float x[8];
#pragma unroll
                for (int r = 0; r < 4; ++r) { x[r] = ((mw >> r) & 1u) ? sa[r] : -INFINITY; x[4 + r] = ((mw >> (4 + r)) & 1u) ? sb[r] : -INFINITY; }
                float mx = fmaxf(fmaxf(fmaxf(x[0], x[1]), fmaxf(x[2], x[3])), fmaxf(fmaxf(x[4], x[5]), fmaxf(x[6], x[7])));
                mx = fmaxf(mx, shx<16>(mx)); mx = fmaxf(mx, shx<32>(mx));
                const float mnew = fmaxf(m, mx);
                const float msafe = (mnew == -INFINITY) ? 0.f : mnew;
                const float alpha = __expf(m - msafe);
                float pe[8]; float ps = 0.f;
#pragma unroll
                for (int j = 0; j < 8; ++j) { pe[j] = __expf(x[j] - msafe); ps += pe[j]; }
                lsum = lsum * alpha + ps;
                m = mnew;
#pragma unroll
                for (int i = 0; i < 8; ++i) { o[i][0] *= alpha; o[i][1] *= alpha; o[i][2] *= alpha; o[i][3] *= alpha; }
                union { bf16x8 v; unsigned u[4]; } pf;
                pf.u[0] = pack2(pe[0], pe[1]); pf.u[1] = pack2(pe[2], pe[3]); pf.u[2] = pack2(pe[4], pe[5]); pf.u[3] = pack2(pe[6], pe[7]);
#pragma unroll
                for (int i = 0; i < 8; ++i) {
                    const bf16x8 vf = *(const bf16x8*)(Vb + (i * 16 + fr) * VSTR + fq * 8);
                    o[i] = __builtin_amdgcn_mfma_f32_16x16x32_bf16(vf, pf.v, o[i], 0, 0, 0);
                }
            }
            if (more) { *(u32x4*)(Kl + ((st + 1) & 1) * 32 * KSTR + kr * KSTR + kc * 8) = rk; *(u32x4*)(Vl + ((st + 1) & 1) * 128 * VSTR + vd * VSTR + vc * 8) = rv; }
            __syncthreads();
        }
        lsum += shx<16>(lsum); lsum += shx<32>(lsum);
        const float inv = 1.f / lsum;
#pragma unroll
        for (int i = 0; i < 8; ++i) {
            uint2 ov; ov.x = pack2(o[i][0] * inv, o[i][1] * inv); ov.y = pack2(o[i][2] * inv, o[i][3] * inv);
            *(uint2*)(Y + trow * 1536 + 512 + h * 128 + i * 16 + 4 * fq) = ov;
        }
    }
}

constexpr int LDS_BYTES = 155648;
__device__ void ph_mixA(const Params& p, int l, int vb0, int nvb, char* smem_) {
    for (int item = vb0; item < 64; item += nvb) {
        if (item < 32) scan2_item<128, false>(p, l, item >> 2, item & 3, smem_);
        else scan2_item<64, true>(p, l, (item - 32) >> 2, (item - 32) & 3, smem_);
    }
    unsigned* ctr = (unsigned*)(p.ws + WS_CTL) + 3584 + l * 64;
    unsigned* done = (unsigned*)(p.ws + WS_CTL) + 5300 + l * 8 * 16;
    volatile int* slot = (volatile int*)(smem_ + LDS_BYTES - 64);
    for (;;) {
        if (TIDX() == 0) *slot = (int)atomicAdd(ctr, 1u);
        __syncthreads();
        const int idx = __builtin_amdgcn_readfirstlane(*slot);
        __syncthreads();
        if (idx >= 2048) break;
        if (idx < 1536) {
            const int b = idx / 192, r = idx % 192;
            if (r < 128) dsa_select_tile(p, b, 127 - r, smem_);
            else dsaprep2_item(p, l, b * 64 + (r - 128), smem_);
            asm volatile("s_waitcnt vmcnt(0)" ::: "memory");
            __syncthreads();
            if (TIDX() == 0) __hip_atomic_fetch_add(done + b * 16, 1u, __ATOMIC_RELAXED, __HIP_MEMORY_SCOPE_AGENT);
        } else {
            const int a = idx - 1536, b = a >> 6, h = (a >> 4) & 3, qg = 15 - (a & 15);
            if (TIDX() == 0) {
                unsigned spins = 0;
                while (__hip_atomic_load(done + b * 16, __ATOMIC_RELAXED, __HIP_MEMORY_SCOPE_AGENT) < 192u) { __builtin_amdgcn_s_sleep(2); if (++spins > (1u << 18)) break; }
                __builtin_amdgcn_fence(__ATOMIC_ACQUIRE, "agent");
                asm volatile("s_waitcnt vmcnt(0)" ::: "memory");
            }
            __syncthreads();
            dsa_attn_item(p, b, h, qg, smem_);
        }
    }
}

__device__ __forceinline__ int f2sort(float f) { int i = __float_as_int(f); return i ^ ((i >> 31) & 0x7fffffff); }
__device__ __forceinline__ float sort2f(int i) { return __int_as_float(i ^ ((i >> 31) & 0x7fffffff)); }
#define INSK(K, xv) do { int _x = (xv); \
    _Pragma("unroll") for (int _j = 0; _j < 16; ++_j) { int _hi = max(K[_j], _x); _x = min(K[_j], _x); K[_j] = _hi; } } while (0)
#define INS64(K, xv) do { unsigned long long _x = (xv); \
    _Pragma("unroll") for (int _j = 0; _j < 16; ++_j) { bool _c = _x > K[_j]; unsigned long long _o = K[_j]; K[_j] = _c ? _x : _o; _x = _c ? _o : _x; } } while (0)

#define CE32(x, y) do { const int _h = max(x, y); y = min(x, y); x = _h; } while (0)
#define CE64(x, y) do { const bool _c = (y) > (x); const unsigned long long _t = x; x = _c ? y : x; y = _c ? _t : y; } while (0)
#define SORT16_I(K) do { CE32(K[0], K[1]); CE32(K[2], K[3]); CE32(K[4], K[5]); CE32(K[6], K[7]); CE32(K[8], K[9]); CE32(K[10], K[11]); CE32(K[12], K[13]); CE32(K[14], K[15]); CE32(K[0], K[2]); CE32(K[1], K[3]); CE32(K[4], K[6]); CE32(K[5], K[7]); CE32(K[8], K[10]); CE32(K[9], K[11]); CE32(K[12], K[14]); CE32(K[13], K[15]); CE32(K[1], K[2]); CE32(K[5], K[6]); CE32(K[9], K[10]); CE32(K[13], K[14]); CE32(K[0], K[4]); CE32(K[1], K[5]); CE32(K[2], K[6]); CE32(K[3], K[7]); CE32(K[8], K[12]); CE32(K[9], K[13]); CE32(K[10], K[14]); CE32(K[11], K[15]); CE32(K[2], K[4]); CE32(K[3], K[5]); CE32(K[10], K[12]); CE32(K[11], K[13]); CE32(K[1], K[2]); CE32(K[3], K[4]); CE32(K[5], K[6]); CE32(K[9], K[10]); CE32(K[11], K[12]); CE32(K[13], K[14]); CE32(K[0], K[8]); CE32(K[1], K[9]); CE32(K[2], K[10]); CE32(K[3], K[11]); CE32(K[4], K[12]); CE32(K[5], K[13]); CE32(K[6], K[14]); CE32(K[7], K[15]); CE32(K[4], K[8]); CE32(K[5], K[9]); CE32(K[6], K[10]); CE32(K[7], K[11]); CE32(K[2], K[4]); CE32(K[3], K[5]); CE32(K[6], K[8]); CE32(K[7], K[9]); CE32(K[10], K[12]); CE32(K[11], K[13]); CE32(K[1], K[2]); CE32(K[3], K[4]); CE32(K[5], K[6]); CE32(K[7], K[8]); CE32(K[9], K[10]); CE32(K[11], K[12]); CE32(K[13], K[14]); } while (0)
#define BITONIC16_I(K) do { CE32(K[0], K[8]); CE32(K[1], K[9]); CE32(K[2], K[10]); CE32(K[3], K[11]); CE32(K[4], K[12]); CE32(K[5], K[13]); CE32(K[6], K[14]); CE32(K[7], K[15]); CE32(K[0], K[4]); CE32(K[1], K[5]); CE32(K[2], K[6]); CE32(K[3], K[7]); CE32(K[8], K[12]); CE32(K[9], K[13]); CE32(K[10], K[14]); CE32(K[11], K[15]); CE32(K[0], K[2]); CE32(K[1], K[3]); CE32(K[4], K[6]); CE32(K[5], K[7]); CE32(K[8], K[10]); CE32(K[9], K[11]); CE32(K[12], K[14]); CE32(K[13], K[15]); CE32(K[0], K[1]); CE32(K[2], K[3]); CE32(K[4], K[5]); CE32(K[6], K[7]); CE32(K[8], K[9]); CE32(K[10], K[11]); CE32(K[12], K[13]); CE32(K[14], K[15]); } while (0)
#define SORT16_L(K) do { CE64(K[0], K[1]); CE64(K[2], K[3]); CE64(K[4], K[5]); CE64(K[6], K[7]); CE64(K[8], K[9]); CE64(K[10], K[11]); CE64(K[12], K[13]); CE64(K[14], K[15]); CE64(K[0], K[2]); CE64(K[1], K[3]); CE64(K[4], K[6]); CE64(K[5], K[7]); CE64(K[8], K[10]); CE64(K[9], K[11]); CE64(K[12], K[14]); CE64(K[13], K[15]); CE64(K[1], K[2]); CE64(K[5], K[6]); CE64(K[9], K[10]); CE64(K[13], K[14]); CE64(K[0], K[4]); CE64(K[1], K[5]); CE64(K[2], K[6]); CE64(K[3], K[7]); CE64(K[8], K[12]); CE64(K[9], K[13]); CE64(K[10], K[14]); CE64(K[11], K[15]); CE64(K[2], K[4]); CE64(K[3], K[5]); CE64(K[10], K[12]); CE64(K[11], K[13]); CE64(K[1], K[2]); CE64(K[3], K[4]); CE64(K[5], K[6]); CE64(K[9], K[10]); CE64(K[11], K[12]); CE64(K[13], K[14]); CE64(K[0], K[8]); CE64(K[1], K[9]); CE64(K[2], K[10]); CE64(K[3], K[11]); CE64(K[4], K[12]); CE64(K[5], K[13]); CE64(K[6], K[14]); CE64(K[7], K[15]); CE64(K[4], K[8]); CE64(K[5], K[9]); CE64(K[6], K[10]); CE64(K[7], K[11]); CE64(K[2], K[4]); CE64(K[3], K[5]); CE64(K[6], K[8]); CE64(K[7], K[9]); CE64(K[10], K[12]); CE64(K[11], K[13]); CE64(K[1], K[2]); CE64(K[3], K[4]); CE64(K[5], K[6]); CE64(K[7], K[8]); CE64(K[9], K[10]); CE64(K[11], K[12]); CE64(K[13], K[14]); } while (0)
#define BITONIC16_L(K) do { CE64(K[0], K[8]); CE64(K[1], K[9]); CE64(K[2], K[10]); CE64(K[3], K[11]); CE64(K[4], K[12]); CE64(K[5], K[13]); CE64(K[6], K[14]); CE64(K[7], K[15]); CE64(K[0], K[4]); CE64(K[1], K[5]); CE64(K[2], K[6]); CE64(K[3], K[7]); CE64(K[8], K[12]); CE64(K[9], K[13]); CE64(K[10], K[14]); CE64(K[11], K[15]); CE64(K[0], K[2]); CE64(K[1], K[3]); CE64(K[4], K[6]); CE64(K[5], K[7]); CE64(K[8], K[10]); CE64(K[9], K[11]); CE64(K[12], K[14]); CE64(K[13], K[15]); CE64(K[0], K[1]); CE64(K[2], K[3]); CE64(K[4], K[5]); CE64(K[6], K[7]); CE64(K[8], K[9]); CE64(K[10], K[11]); CE64(K[12], K[13]); CE64(K[14], K[15]); } while (0)
#define TOP16_I(R, G) do { _Pragma("unroll") for (int _j = 0; _j < 16; ++_j) R[_j] = max(R[_j], G[15 - _j]); BITONIC16_I(R); } while (0)
#define TOP16_L(R, G) do { _Pragma("unroll") for (int _j = 0; _j < 16; ++_j) R[_j] = (G[15 - _j] > R[_j]) ? G[15 - _j] : R[_j]; BITONIC16_L(R); } while (0)
__device__ void ph_route(const Params& p, int vb0, int nvb, char* smem_) {
    typedef _Float16 h8 __attribute__((ext_vector_type(8)));
    const _Float16* SC = (const _Float16*)(p.ws + WS_SC);
    int* RI = (int*)(p.ws + WS_RI); float* RG = (float*)(p.ws + WS_RG);
    const int tid = TIDX(), lane = tid & 63, wave = tid >> 6;
    _Float16* tile = (_Float16*)smem_ + wave * (64 * 72);
    for (int item0 = (vb0 * 8 + wave) * 64; item0 < T_TOK * 8; item0 += nvb * 8 * 64) {
        const int item = item0 + lane;
        const int t = item >> 3, h = item & 7;
        const _Float16* s0 = SC + (size_t)t * 2048 + h * 256;
        const _Float16* wbase = SC + (size_t)item0 * 256;
        int k0[16], k1[16];
#pragma unroll
        for (int j = 0; j < 16; ++j) { k0[j] = (int)0x80000000; k1[j] = (int)0x80000000; }
#pragma unroll 1
        for (int slab = 0; slab < 4; ++slab) {
            h8 ld[8];
#pragma unroll
            for (int j = 0; j < 4; ++j) {
                const _Float16* src = wbase + (size_t)(16 * j + (lane >> 2)) * 256 + slab * 32 + (lane & 3) * 8;
                ld[j] = *(const h8*)src; ld[4 + j] = *(const h8*)(src + 128);
            }
            __builtin_amdgcn_wave_barrier();
#pragma unroll
            for (int j = 0; j < 4; ++j) {
                _Float16* dst = tile + (16 * j + (lane >> 2)) * 72 + (lane & 3) * 8;
                *(h8*)dst = ld[j]; *(h8*)(dst + 32) = ld[4 + j];
            }
            __builtin_amdgcn_fence(__ATOMIC_RELEASE, "wavefront");
            __builtin_amdgcn_wave_barrier();
            __builtin_amdgcn_fence(__ATOMIC_ACQUIRE, "wavefront");
#pragma unroll
            for (int ii = 0; ii < 32; ii += 16) {
                const int i = slab * 32 + ii;
                const h8 a0 = *(const h8*)(tile + lane * 72 + ii), a1 = *(const h8*)(tile + lane * 72 + ii + 8);
                const h8 b0 = *(const h8*)(tile + lane * 72 + 32 + ii), b1 = *(const h8*)(tile + lane * 72 + 32 + ii + 8);
                int ga[16], gb[16];
#pragma unroll
                for (int e_ = 0; e_ < 8; ++e_) {
                    ga[e_] = (f2sort((float)a0[e_]) & ~127) | (127 - i - e_); ga[8 + e_] = (f2sort((float)a1[e_]) & ~127) | (127 - i - 8 - e_);
                    gb[e_] = (f2sort((float)b0[e_]) & ~127) | (127 - i - e_); gb[8 + e_] = (f2sort((float)b1[e_]) & ~127) | (127 - i - 8 - e_);
                }
                SORT16_I(ga); TOP16_I(k0, ga);
                SORT16_I(gb); TOP16_I(k1, gb);
            }
            __builtin_amdgcn_wave_barrier();
        }
        float v0[16], v1[16];
#pragma unroll
        for (int j = 0; j < 16; ++j) { k0[j] = 127 - (k0[j] & 127); k1[j] = 127 - (k1[j] & 127); v0[j] = (float)s0[k0[j]]; v1[j] = (float)s0[128 + k1[j]]; }
#define CAND(a, b) ((((unsigned long long)((unsigned)f2sort(v0[a] + v1[b]) ^ 0x80000000u)) << 32) | (((unsigned)(255 - ((a) * 16 + (b))) << 16) | (unsigned)(k0[a] * 128 + k1[b])))
        unsigned long long ck[16], m1[16], m2[16];
#pragma unroll
        for (int j = 0; j < 16; ++j) ck[j] = CAND(0, j);
#pragma unroll
        for (int j = 0; j < 8; ++j) { m1[j] = CAND(1, j); m1[8 + j] = CAND(15 - j, 0); }
        BITONIC16_L(m1);
        m2[0] = CAND(2, 0); m2[1] = CAND(2, 1); m2[2] = CAND(2, 2); m2[3] = CAND(2, 3); m2[4] = CAND(2, 4);
        m2[5] = CAND(3, 0); m2[6] = CAND(3, 1); m2[7] = CAND(3, 2); m2[8] = CAND(3, 3);
        m2[9] = CAND(4, 0); m2[10] = CAND(4, 1); m2[11] = CAND(4, 2);
        m2[12] = CAND(5, 0); m2[13] = CAND(5, 1); m2[14] = CAND(6, 0); m2[15] = CAND(6, 1);
        SORT16_L(m2);
        TOP16_L(ck, m1);
        TOP16_L(ck, m2);
        INS64(ck, CAND(7, 0)); INS64(ck, CAND(7, 1));
#undef CAND
        float e[16]; float sm = 0.f;
        const float mx = sort2f((int)((unsigned)(ck[0] >> 32) ^ 0x80000000u));
#pragma unroll
        for (int j = 0; j < 16; ++j) { e[j] = expf(sort2f((int)((unsigned)(ck[j] >> 32) ^ 0x80000000u)) - mx); sm += e[j]; }
        const float inv = 1.f / sm;
#pragma unroll
        for (int j = 0; j < 16; j += 4) {
            *(int4*)(RI + (size_t)t * 128 + h * 16 + j) = make_int4((int)(ck[j] & 0xffffu), (int)(ck[j + 1] & 0xffffu), (int)(ck[j + 2] & 0xffffu), (int)(ck[j + 3] & 0xffffu));
            *(float4*)(RG + (size_t)t * 128 + h * 16 + j) = make_float4(e[j] * inv, e[j + 1] * inv, e[j + 2] * inv, e[j + 3] * inv);
        }
    }
}

__device__ __forceinline__ void fp8x16_to_f32(const uint4 q, float (&f)[16]) {
    const unsigned w[4] = {q.x, q.y, q.z, q.w};
#pragma unroll
    for (int c = 0; c < 4; ++c) {
        auto f0 = __builtin_amdgcn_cvt_pk_f32_fp8((int)w[c], false); auto f1 = __builtin_amdgcn_cvt_pk_f32_fp8((int)w[c], true);
        f[4 * c] = f0[0]; f[4 * c + 1] = f0[1]; f[4 * c + 2] = f1[0]; f[4 * c + 3] = f1[1];
    }
}
constexpr bool G2_MFMA = true;
constexpr bool G1_MFMA = true;
typedef float f32x2_t __attribute__((ext_vector_type(2)));
__device__ __forceinline__ float g1_half(const u32x4 (&uq)[8], const float (&hv)[16], int lane) {
    float part[8];
#pragma unroll
    for (int it = 0; it < 8; ++it) {
        f32x2_t d2 = {0.f, 0.f};
#pragma unroll
        for (int c_ = 0; c_ < 4; ++c_) {
            const f32x2_t f0 = __builtin_amdgcn_cvt_pk_f32_fp8((int)uq[it][c_], false), f1 = __builtin_amdgcn_cvt_pk_f32_fp8((int)uq[it][c_], true);
            d2 = __builtin_elementwise_fma(f32x2_t{hv[4 * c_], hv[4 * c_ + 1]}, f0, d2);
            d2 = __builtin_elementwise_fma(f32x2_t{hv[4 * c_ + 2], hv[4 * c_ + 3]}, f1, d2);
        }
        part[it] = d2[0] + d2[1];
    }
    float r4[4], r2[2];
    const bool b2_ = lane & 4, b1_ = lane & 2, b0_ = lane & 1;
#pragma unroll
    for (int j = 0; j < 4; ++j) { const float snd = b2_ ? part[j] : part[j + 4], kp = b2_ ? part[j + 4] : part[j]; r4[j] = kp + shx<4>(snd); }
#pragma unroll
    for (int j = 0; j < 2; ++j) { const float snd = b1_ ? r4[j] : r4[j + 2], kp = b1_ ? r4[j + 2] : r4[j]; r2[j] = kp + shx<2>(snd); }
    const float snd = b0_ ? r2[0] : r2[1], kp = b0_ ? r2[1] : r2[0];
    return kp + shx<1>(snd);
}
__device__ __forceinline__ void peer_gather8(u32x4 (&q)[8], const unsigned char* tab, const int* idx, unsigned l16) {
#pragma unroll
    for (int it = 0; it < 8; ++it) { const unsigned e_ = (unsigned)idx[it * 8]; q[it] = *(const u32x4*)(tab + ((e_ << 7) | l16)); }
}
template <bool PRE>
__device__ __forceinline__ void g1_step(int i, int t, const bf16_t* hrow_next, const unsigned char* ub, const int* lri_eg, unsigned l16, int lane, float* pp_row,
                                        u32x4& hq0, u32x4& hq1, u32x4 (&uqA)[8], u32x4 (&uqB)[8]) {
    float hv[16];
#pragma unroll
    for (int c_ = 0; c_ < 4; ++c_) { hv[2 * c_] = bflo(hq0[c_]); hv[2 * c_ + 1] = bfhi(hq0[c_]); hv[8 + 2 * c_] = bflo(hq1[c_]); hv[8 + 2 * c_ + 1] = bfhi(hq1[c_]); }
    if (PRE) { const u32x4* hp = (const u32x4*)hrow_next; hq0 = hp[0]; hq1 = hp[1]; }
    const float d0 = g1_half(uqA, hv, lane);
    __builtin_amdgcn_sched_barrier(0);
    if (PRE) { peer_gather8(uqA, ub, lri_eg + (i + 1) * 128, l16); __builtin_amdgcn_sched_barrier(0); }
    const float d1 = g1_half(uqB, hv, lane);
    __builtin_amdgcn_sched_barrier(0);
    if (PRE) { peer_gather8(uqB, ub, lri_eg + (i + 1) * 128 + 64, l16); __builtin_amdgcn_sched_barrier(0); }
    pp_row[0] = d0; pp_row[64] = d1;
}
template <bool PRE>
__device__ __forceinline__ void g2_step(int i, float2* op, const float2 gf, const unsigned char* vb_, const int* lri_eg, const float* lrg_eg, unsigned l16, int lane,
                                        u32x4 (&vqA)[8], u32x4 (&vqB)[8]) {
    const float2 xi = *op;
    f32x2_t y[8];
#pragma unroll
    for (int j = 0; j < 8; ++j) y[j] = f32x2_t{0.f, 0.f};
#pragma unroll
    for (int it = 0; it < 8; ++it) {
        const float ck = lrg_eg[i * 128 + it * 8]; const f32x2_t ck2 = {ck, ck};
#pragma unroll
        for (int c_ = 0; c_ < 4; ++c_) {
            y[2 * c_] = __builtin_elementwise_fma(ck2, __builtin_amdgcn_cvt_pk_f32_fp8((int)vqA[it][c_], false), y[2 * c_]);
            y[2 * c_ + 1] = __builtin_elementwise_fma(ck2, __builtin_amdgcn_cvt_pk_f32_fp8((int)vqA[it][c_], true), y[2 * c_ + 1]);
        }
    }
    __builtin_amdgcn_sched_barrier(0);
    if (PRE) { peer_gather8(vqA, vb_, lri_eg + (i + 1) * 128, l16); __builtin_amdgcn_sched_barrier(0); }
#pragma unroll
    for (int it = 0; it < 8; ++it) {
        const float ck = lrg_eg[i * 128 + 64 + it * 8]; const f32x2_t ck2 = {ck, ck};
#pragma unroll
        for (int c_ = 0; c_ < 4; ++c_) {
            y[2 * c_] = __builtin_elementwise_fma(ck2, __builtin_amdgcn_cvt_pk_f32_fp8((int)vqB[it][c_], false), y[2 * c_]);
            y[2 * c_ + 1] = __builtin_elementwise_fma(ck2, __builtin_amdgcn_cvt_pk_f32_fp8((int)vqB[it][c_], true), y[2 * c_ + 1]);
        }
    }
    __builtin_amdgcn_sched_barrier(0);
    if (PRE) { peer_gather8(vqB, vb_, lri_eg + (i + 1) * 128 + 64, l16); __builtin_amdgcn_sched_barrier(0); }
    float r8[8], r4[4], r2[2];
    const bool b5 = lane & 32, b4 = lane & 16, b3 = lane & 8;
#pragma unroll
    for (int j = 0; j < 8; ++j) { const float lo = y[j >> 1][j & 1], hi = y[4 + (j >> 1)][j & 1]; const float snd = b5 ? lo : hi, kp = b5 ? hi : lo; r8[j] = kp + shx<32>(snd); }
#pragma unroll
    for (int j = 0; j < 4; ++j) { const float snd = b4 ? r8[j] : r8[j + 4], kp = b4 ? r8[j + 4] : r8[j]; r4[j] = kp + shx<16>(snd); }
#pragma unroll
    for (int j = 0; j < 2; ++j) { const float snd = b3 ? r4[j] : r4[j + 2], kp = b3 ? r4[j + 2] : r4[j]; r2[j] = kp + shx<8>(snd); }
    *op = make_float2(xi.x + gf.x * r2[0], xi.y + gf.y * r2[1]);
}
typedef int i32x4_t __attribute__((ext_vector_type(4)));
typedef int i32x8_t __attribute__((ext_vector_type(8)));
constexpr int G1W = 18432;
__device__ __forceinline__ void g1m_dma(const unsigned char* ub, PG8_LAS unsigned char* img, const PG8_LAS unsigned short* idx, int i, int hh, int eg, unsigned q16) {
    const u32x4 w = *(const PG8_LAS u32x4*)(idx + ((i * 8 + eg) * 16 + hh * 8));
#pragma unroll
    for (int it = 0; it < 8; ++it) {
        const unsigned e_ = (it & 1) ? (w[it >> 1] >> 16) : (w[it >> 1] & 0xffffu);
        const unsigned off = (e_ << 7) | ((it & 1) ? (q16 ^ 64u) : q16);
        __builtin_amdgcn_global_load_lds((const unsigned*)(ub + off), (PG8_LAS unsigned*)(img + it * 1024), 16, 0, 0);
    }
}
template <bool PRE, int VMW>
__device__ __forceinline__ float g1m_step(const unsigned char* ub, PG8_LAS unsigned char* img, const PG8_LAS unsigned short* idx, int inext, int hh, int eg, unsigned q16,
                                          unsigned rdoff, int lane, const u32x4 a0, const u32x4 a1) {
    asm volatile("s_waitcnt vmcnt(%0)" :: "n"(VMW) : "memory");
    i32x8_t b[4];
#pragma unroll
    for (int mb = 0; mb < 4; ++mb) {
        const unsigned ro = (unsigned)mb * 2048u + rdoff;
        const i32x4_t lo = *(const PG8_LAS i32x4_t*)(img + ro), hi = *(const PG8_LAS i32x4_t*)(img + (ro ^ 64u));
        b[mb] = __builtin_shufflevector(lo, hi, 0, 1, 2, 3, 4, 5, 6, 7);
    }
    asm volatile("s_waitcnt lgkmcnt(0)" ::: "memory");
    if (PRE) g1m_dma(ub, img, idx, inext, hh, eg, q16);
    const i32x8_t a = __builtin_shufflevector((i32x4_t)a0, (i32x4_t)a1, 0, 1, 2, 3, 4, 5, 6, 7);
    float d[4]; f32x4 acc[4];
#pragma unroll
    for (int mb = 0; mb < 4; ++mb) acc[mb] = __builtin_amdgcn_mfma_scale_f32_16x16x128_f8f6f4(a, b[mb], f32x4{0.f, 0.f, 0.f, 0.f}, 0, 0, 0, 0x7f, 0, 0x7f);
#pragma unroll
    for (int mb = 0; mb < 4; ++mb) { d[mb] = acc[mb][0] + acc[mb][1] * (1.f / 16.f); asm volatile("" : "+v"(d[mb])); }
    const int g = lane >> 4;
    return g == 0 ? d[0] : g == 1 ? d[1] : g == 2 ? d[2] : d[3];
}
__device__ __forceinline__ void g1m_chunk(const Params& p, int x, int tb, char* smem_, int lane) {
    PG8_LAS unsigned char* wl = (PG8_LAS unsigned char*)smem_ + p.wv * G1W;
    PG8_LAS unsigned short* idx = (PG8_LAS unsigned short*)(wl + 16384);
    const int* RI = (const int*)(p.ws + WS_RI);
    {
        int ra[16];
#pragma unroll
        for (int i = 0; i < 8; ++i) { ra[2 * i] = RI[(size_t)(tb + i) * 128 + lane]; ra[2 * i + 1] = RI[(size_t)(tb + i) * 128 + 64 + lane]; }
#pragma unroll
        for (int i = 0; i < 8; ++i) {
            idx[(i * 8 + (lane & 7)) * 16 + (lane >> 3)] = (unsigned short)ra[2 * i];
            idx[(i * 8 + (lane & 7)) * 16 + 8 + (lane >> 3)] = (unsigned short)ra[2 * i + 1];
        }
    }
    __builtin_amdgcn_fence(__ATOMIC_RELEASE, "wavefront");
    __builtin_amdgcn_wave_barrier();
    __builtin_amdgcn_fence(__ATOMIC_ACQUIRE, "wavefront");
    const int eg = lane >> 3, n = lane & 15, kb = lane >> 4;
    const unsigned q16 = (unsigned)(((lane & 7) ^ (eg >> 1)) * 16);
    const unsigned rdoff = (unsigned)(n * 128 + ((kb ^ (n >> 1)) * 16));
    const unsigned char* ub = p.ws + WS_PU + (size_t)x * (16384u * 128u);
    const unsigned char* h8 = p.ws + ((lane & 1) ? WS_H8L : WS_H8H) + (size_t)tb * 1024 + x * 128 + kb * 16;
    float* pp = (float*)(p.ws + WS_PP) + ((size_t)x * T_TOK + tb) * 128 + lane;
    u32x4 ha[8][2];
#pragma unroll
    for (int i = 0; i < 8; ++i) { ha[i][0] = *(const u32x4*)(h8 + (size_t)i * 1024); ha[i][1] = *(const u32x4*)(h8 + (size_t)i * 1024 + 64); }
#pragma unroll
    for (int i = 0; i < 8; ++i) { asm volatile("" : "+v"(ha[i][0])); asm volatile("" : "+v"(ha[i][1])); }
    g1m_dma(ub, wl, idx, 0, 0, eg, q16);
    g1m_dma(ub, wl + 8192, idx, 0, 1, eg, q16);
    asm volatile("s_waitcnt vmcnt(8)" ::: "memory");
#pragma unroll
    for (int i = 0; i < 7; ++i) {
        const float v0 = g1m_step<true, 9>(ub, wl, idx, i + 1, 0, eg, q16, rdoff, lane, ha[i][0], ha[i][1]);
        pp[(size_t)i * 128] = v0;
        const float v1 = g1m_step<true, 9>(ub, wl + 8192, idx, i + 1, 1, eg, q16, rdoff, lane, ha[i][0], ha[i][1]);
        pp[(size_t)i * 128 + 64] = v1;
    }
    {
        const float v0 = g1m_step<false, 9>(ub, wl, idx, 0, 0, eg, q16, rdoff, lane, ha[7][0], ha[7][1]);
        pp[(size_t)7 * 128] = v0;
        const float v1 = g1m_step<false, 0>(ub, wl + 8192, idx, 0, 1, eg, q16, rdoff, lane, ha[7][0], ha[7][1]);
        pp[(size_t)7 * 128 + 64] = v1;
    }
}
typedef int i32x2_t __attribute__((ext_vector_type(2)));
template <bool PRE, int VMW, int HH>
__device__ __forceinline__ void g2m_step(const unsigned char* vb_, PG8_LAS unsigned char* img, const PG8_LAS unsigned short* idx, int inext, int eg, unsigned q16,
                                         const unsigned (&tra)[8], const long a0, const long a1, f32x4 (&acc)[8]) {
    asm volatile("s_waitcnt vmcnt(%0)" :: "n"(VMW) : "memory");
    long b[2][8];
#pragma unroll
    for (int u = 0; u < 2; ++u)
#pragma unroll
        for (int j = 0; j < 8; ++j) asm volatile("ds_read_b64_tr_b8 %0, %1 offset:%2" : "=v"(b[u][j]) : "v"(tra[j]), "n"(HH * 8192 + u * 4096) : "memory");
    asm volatile("s_waitcnt lgkmcnt(0)" : "+v"(b[0][0]), "+v"(b[0][1]), "+v"(b[0][2]), "+v"(b[0][3]), "+v"(b[0][4]), "+v"(b[0][5]), "+v"(b[0][6]), "+v"(b[0][7]) :: "memory");
    asm volatile("" : "+v"(b[1][0]), "+v"(b[1][1]), "+v"(b[1][2]), "+v"(b[1][3]), "+v"(b[1][4]), "+v"(b[1][5]), "+v"(b[1][6]), "+v"(b[1][7]) :: "memory");
    if (PRE) { g1m_dma(vb_, img + HH * 8192, idx, inext, HH, eg, q16); __builtin_amdgcn_sched_barrier(0); }
#pragma unroll
    for (int j = 0; j < 8; ++j) {
        acc[j] = __builtin_amdgcn_mfma_f32_16x16x32_fp8_fp8(a0, b[0][j], acc[j], 0, 0, 0);
        acc[j] = __builtin_amdgcn_mfma_f32_16x16x32_fp8_fp8(a1, b[1][j], acc[j], 0, 0, 0);
    }
}
__device__ __forceinline__ void g2m_chunk(const Params& p, int l, int x, int tb, char* smem_, int lane) {
    PG8_LAS unsigned char* wl = (PG8_LAS unsigned char*)smem_ + p.wv * G1W;
    PG8_LAS unsigned short* idx = (PG8_LAS unsigned short*)(wl + 16384);
    const int* RI = (const int*)(p.ws + WS_RI);
    {
        int ra[16];
#pragma unroll
        for (int i = 0; i < 8; ++i) { ra[2 * i] = RI[(size_t)(tb + i) * 128 + lane]; ra[2 * i + 1] = RI[(size_t)(tb + i) * 128 + 64 + lane]; }
#pragma unroll
        for (int i = 0; i < 8; ++i) {
            idx[(i * 8 + (lane & 7)) * 16 + (lane >> 3)] = (unsigned short)ra[2 * i];
            idx[(i * 8 + (lane & 7)) * 16 + 8 + (lane >> 3)] = (unsigned short)ra[2 * i + 1];
        }
    }
    __builtin_amdgcn_fence(__ATOMIC_RELEASE, "wavefront");
    __builtin_amdgcn_wave_barrier();
    __builtin_amdgcn_fence(__ATOMIC_ACQUIRE, "wavefront");
    const int eg = lane >> 3, kb = lane >> 4, li = lane & 15, q = li >> 1;
    const unsigned q16 = (unsigned)(((lane & 7) ^ (eg >> 1)) * 16);
    const int n16 = (kb & 1) * 8 + q;
    const unsigned trbase = (unsigned)((kb * 8 + q) * 128 + ((n16 >> 1) & 7) * 16 + (li & 1) * 8);
    const unsigned char* vb_ = p.ws + WS_PV + (size_t)x * (16384u * 128u);
    float* op = p.out + (size_t)tb * 1024 + x * 128 + lane;
    const float* modr = (const float*)(p.ws + WS_MOD) + (size_t)(l * 8 + (tb >> 11)) * 6144 + 5120 + x * 128 + lane;
    float gf0 = modr[0], gf1 = modr[64];
    const unsigned char* c8 = p.ws + ((lane & 1) ? WS_C8L : WS_C8H) + (size_t)tb * 128 + kb * 32;
    u32x4 ca[8][2]; float xi[8][2], cinv[8];
#pragma unroll
    for (int i = 0; i < 8; ++i) {
        ca[i][0] = *(const u32x4*)(c8 + (size_t)i * 128); ca[i][1] = *(const u32x4*)(c8 + (size_t)i * 128 + 16);
        xi[i][0] = op[(size_t)i * 1024]; xi[i][1] = op[(size_t)i * 1024 + 64];
        cinv[i] = ((const float*)(p.ws + WS_CINV))[tb + i];
    }
#pragma unroll
    for (int i = 0; i < 8; ++i) { asm volatile("" : "+v"(ca[i][0])); asm volatile("" : "+v"(ca[i][1])); asm volatile("" : "+v"(xi[i][0]), "+v"(xi[i][1]), "+v"(cinv[i])); }
    asm volatile("" : "+v"(gf0), "+v"(gf1));
    g1m_dma(vb_, wl, idx, 0, 0, eg, q16);
    g1m_dma(vb_, wl + 8192, idx, 0, 1, eg, q16);
    asm volatile("s_waitcnt vmcnt(8)" ::: "memory");
    const int g = lane >> 4;
    unsigned tra[8];
#pragma unroll
    for (int j = 0; j < 8; ++j) tra[j] = (unsigned)(unsigned long)wl + (trbase ^ (unsigned)(j * 16));
#define G2M_TOKEN(i, PRE_, W0, W1) do { \
        f32x4 acc[8]; \
        _Pragma("unroll") for (int j = 0; j < 8; ++j) acc[j] = f32x4{0.f, 0.f, 0.f, 0.f}; \
        const long a00 = (long)(((unsigned long long)ca[i][0][1] << 32) | ca[i][0][0]), a01 = (long)(((unsigned long long)ca[i][0][3] << 32) | ca[i][0][2]); \
        const long a10 = (long)(((unsigned long long)ca[i][1][1] << 32) | ca[i][1][0]), a11 = (long)(((unsigned long long)ca[i][1][3] << 32) | ca[i][1][2]); \
        g2m_step<PRE_, W0, 0>(vb_, wl, idx, (i) + 1, eg, q16, tra, a00, a01, acc); \
        g2m_step<PRE_, W1, 1>(vb_, wl, idx, (i) + 1, eg, q16, tra, a10, a11, acc); \
        float y[8]; \
        _Pragma("unroll") for (int j = 0; j < 8; ++j) { y[j] = acc[j][0] + acc[j][1] * (1.f / 16.f); asm volatile("" : "+v"(y[j])); } \
        const float ya = g == 0 ? y[0] : g == 1 ? y[1] : g == 2 ? y[2] : y[3], yb = g == 0 ? y[4] : g == 1 ? y[5] : g == 2 ? y[6] : y[7]; \
        op[(size_t)(i) * 1024] = xi[i][0] + gf0 * (ya * cinv[i]); op[(size_t)(i) * 1024 + 64] = xi[i][1] + gf1 * (yb * cinv[i]); \
        __builtin_amdgcn_sched_barrier(0); } while (0)
    G2M_TOKEN(0, true, 10, 8);
    G2M_TOKEN(1, true, 10, 10); G2M_TOKEN(2, true, 10, 10); G2M_TOKEN(3, true, 10, 10);
    G2M_TOKEN(4, true, 10, 10); G2M_TOKEN(5, true, 10, 10); G2M_TOKEN(6, true, 10, 10);
    G2M_TOKEN(7, false, 10, 0);
#undef G2M_TOKEN
}
template <int WHICH>
__device__ void ph_peer_sliced(const Params& p, int l, int vb0, int nvb, char* smem_) {
    const int tid = TIDX(), wave = tid >> 6;
    const bf16_t* H = (const bf16_t*)(p.ws + WS_H); const unsigned char* PU = p.ws + WS_PU; const unsigned char* PV = p.ws + WS_PV;
    const int* RI = (const int*)(p.ws + WS_RI); float* RG = (float*)(p.ws + WS_RG); float* PP = (float*)(p.ws + WS_PP);
    const float* modb = (const float*)(p.ws + WS_MOD);
    {
    {
#pragma unroll 1
        for (int u_ = vb0; u_ < 2048; u_ += nvb) {
            const int x = u_ & 7, chunk = u_ >> 3;
            {
                const int lane = lane_id_opaque(), eg = lane >> 3, ll = lane & 7;
                const int tb = chunk * 64 + wave * 8;
                if (WHICH == 0 && G1_MFMA) { g1m_chunk(p, x, tb, smem_, lane); continue; }
                if (WHICH == 1 && G2_MFMA) { g2m_chunk(p, l, x, tb, smem_, lane); continue; }
                int* lri = (int*)smem_ + wave * 2048; float* lrg = (float*)(lri + 1024);
                {
                    int ra[16]; float rg_[16];
#pragma unroll
                    for (int i = 0; i < 8; ++i) {
                        ra[2 * i] = RI[(size_t)(tb + i) * 128 + lane]; ra[2 * i + 1] = RI[(size_t)(tb + i) * 128 + 64 + lane];
                        if (WHICH == 1) { rg_[2 * i] = RG[(size_t)(tb + i) * 128 + lane]; rg_[2 * i + 1] = RG[(size_t)(tb + i) * 128 + 64 + lane]; }
                    }
#pragma unroll
                    for (int i = 0; i < 8; ++i) {
                        lri[i * 128 + lane] = ra[2 * i]; lri[i * 128 + 64 + lane] = ra[2 * i + 1];
                        if (WHICH == 1) { lrg[i * 128 + lane] = rg_[2 * i]; lrg[i * 128 + 64 + lane] = rg_[2 * i + 1]; }
                    }
                }
                __builtin_amdgcn_fence(__ATOMIC_RELEASE, "wavefront");
                __builtin_amdgcn_wave_barrier();
                __builtin_amdgcn_fence(__ATOMIC_ACQUIRE, "wavefront");
                const unsigned l16 = (unsigned)ll * 16u;
                if (WHICH == 0) {
                    const unsigned char* ub = PU + (size_t)x * (16384u * 128u);
                    const bf16_t* hrow = H + (size_t)tb * 1024 + x * 128 + ll * 16;
                    float* pp_row = PP + ((size_t)x * T_TOK + tb) * 128 + ll * 8 + eg;
                    u32x4 hq0 = ((const u32x4*)hrow)[0], hq1 = ((const u32x4*)hrow)[1], uqA[8], uqB[8];
                    peer_gather8(uqA, ub, lri + eg, l16);
                    peer_gather8(uqB, ub, lri + eg + 64, l16);
#pragma unroll 1
                    for (int i = 0; i < 7; ++i) g1_step<true>(i, tb + i, hrow + (size_t)(i + 1) * 1024, ub, lri + eg, l16, lane, pp_row + (size_t)i * 128, hq0, hq1, uqA, uqB);
                    g1_step<false>(7, tb + 7, hrow, ub, lri + eg, l16, lane, pp_row + (size_t)7 * 128, hq0, hq1, uqA, uqB);
                } else {
                    const unsigned char* vb_ = PV + (size_t)x * (16384u * 128u);
                    const int col = x * 128 + ll * 16 + ((lane >> 5) & 1) * 8 + ((lane >> 4) & 1) * 4 + ((lane >> 3) & 1) * 2;
                    const float2 gf = *(const float2*)(modb + (size_t)(l * 8 + (tb >> 11)) * 6144 + 5120 + col);
                    float2* op = (float2*)(p.out + (size_t)tb * 1024 + col);
                    u32x4 vqA[8], vqB[8];
                    peer_gather8(vqA, vb_, lri + eg, l16);
                    peer_gather8(vqB, vb_, lri + eg + 64, l16);
#pragma unroll 1
                    for (int i = 0; i < 7; ++i) g2_step<true>(i, op + (size_t)i * 512, gf, vb_, lri + eg, lrg + eg, l16, lane, vqA, vqB);
                    g2_step<false>(7, op + (size_t)7 * 512, gf, vb_, lri + eg, lrg + eg, l16, lane, vqA, vqB);
                }
            }
        }
    }
    __syncthreads();
    }
}
__device__ void ph_peer_coef(const Params& p, int vb0, int nvb) {
    const int wave = TIDX() >> 6, lane = TIDX() & 63;
    float* RG = (float*)(p.ws + WS_RG); const float* PP = (const float*)(p.ws + WS_PP);
    for (int t0 = (vb0 * 8 + wave) * 2; t0 < T_TOK; t0 += nvb * 8 * 2) {
        float pp[2][2][8], g[2][2];
#pragma unroll
        for (int u = 0; u < 2; ++u)
#pragma unroll
            for (int half = 0; half < 2; ++half) {
                const int k = half * 64 + lane;
#pragma unroll
                for (int x = 0; x < 8; ++x) pp[u][half][x] = PP[((size_t)x * T_TOK + t0 + u) * 128 + k];
                g[u][half] = RG[(size_t)(t0 + u) * 128 + k];
            }
        asm volatile("" ::: "memory");
#pragma unroll
        for (int u = 0; u < 2; ++u) {
            float cf[2];
#pragma unroll
            for (int half = 0; half < 2; ++half) {
                float d = 0.f;
#pragma unroll
                for (int x = 0; x < 8; ++x) d += pp[u][half][x];
                d *= (1.f / PU_SCALE);
                cf[half] = g[u][half] * 0.5f * d * (1.f + erff(d * 0.7071067811865476f)) * (1.f / PV_SCALE);
                if (!G2_MFMA) RG[(size_t)(t0 + u) * 128 + half * 64 + lane] = cf[half];
            }
            if (G2_MFMA) {
                const float m = wave_max(fmaxf(fabsf(cf[0]), fabsf(cf[1])));
                const float sc = m > 0.f ? 240.f / m : 0.f;
                const float c0 = cf[0] * sc, c1 = cf[1] * sc;
                const int hi = __builtin_amdgcn_cvt_pk_fp8_f32(c0, c1, 0, false);
                const auto bk = __builtin_amdgcn_cvt_pk_f32_fp8(hi, false);
                const int lo = __builtin_amdgcn_cvt_pk_fp8_f32((c0 - bk[0]) * 16.f, (c1 - bk[1]) * 16.f, 0, false);
                unsigned char* c8h = p.ws + WS_C8H + (size_t)(t0 + u) * 128; unsigned char* c8l = p.ws + WS_C8L + (size_t)(t0 + u) * 128;
                const int s0 = ((lane >> 3) & 3) * 32 + (lane >> 5) * 8 + (lane & 7);
                c8h[s0] = (unsigned char)(hi & 0xff); c8h[s0 + 16] = (unsigned char)((hi >> 8) & 0xff);
                c8l[s0] = (unsigned char)(lo & 0xff); c8l[s0 + 16] = (unsigned char)((lo >> 8) & 0xff);
                if (lane == 0) ((float*)(p.ws + WS_CINV))[t0 + u] = m * (1.f / 240.f);
            }
        }
    }
}

enum { PH_MOD = 0, PH_WPREP, PH_NORM1, PH_GEMM_IN, PH_SCAN, PH_MERGE, PH_OUT, PH_NORM2, PH_GEMM_Q, PH_GEMM_SC, PH_ROUTE, PH_G1, PH_G15, PH_G2 };

template <int PH>
__device__ __forceinline__ void run_phase(const Params& p, int l, int vb0, int nvb, char* smem) {
    const float* xin = (l == 0) ? p.x : p.out;
    if (PH == PH_MOD) ph_mod(p, vb0, nvb, smem);
    else if (PH == PH_WPREP) ph_wprep(p, l, vb0, nvb, smem);
    else if (PH == PH_NORM1) ph_norm(p, l, 0, xin, vb0, nvb);
    else if (PH == PH_GEMM_IN) {
        pg8::Gemm g{(const bf16_t*)(p.ws + WS_H), (const bf16_t*)(p.ws + WS_WIN), 1024, 1024, 1024};
        pg8::StaticOrder S; S.init(T_TOK, LDZ, nvb, vb0, 1024, 1024);
        pg8::gemm_phase(( PG8_LAS unsigned char*)smem, g, S, pg8::EpiBf16{(bf16_t*)(p.ws + WS_Z), LDZ}, TIDX());
    }
    else if (PH == PH_SCAN) ph_mixA(p, l, vb0, nvb, smem);
    else if (PH == PH_MERGE) {
        pg8::Gemm g{(const bf16_t*)(p.ws + WS_Y), (const bf16_t*)(p.ws + WS_WBR), 1536, 512, 512};
        pg8::MergeOrder S{vb0, nvb};
        pg8::gemm_phase((PG8_LAS unsigned char*)smem, g, S, pg8::EpiMerge{(bf16_t*)(p.ws + WS_H), (const bf16_t*)(p.ws + WS_Z)}, TIDX());
    }
    else if (PH == PH_OUT) {
        pg8::Gemm g{(const bf16_t*)(p.ws + WS_H), (const bf16_t*)(p.ws + WS_WOUT), 1024, 1024, 1024};
        pg8::StaticOrder S; S.init(T_TOK, 1024, nvb, vb0, 1024, 1024);
        pg8::gemm_phase((PG8_LAS unsigned char*)smem, g, S, pg8::EpiResid{xin, p.out, (const float*)(p.ws + WS_MOD) + (size_t)l * 8 * 6144}, TIDX());
    }
    else if (PH == PH_NORM2) ph_norm(p, l, 1, p.out, vb0, nvb);
    else if (PH == PH_GEMM_Q) {
        pg8::Gemm g{(const bf16_t*)(p.ws + WS_H), (const bf16_t*)(p.ws + WS_WQ), 1024, 1024, 1024};
        pg8::StaticOrder S; S.init(T_TOK, 2048, nvb, vb0, 1024, 1024);
        pg8::gemm_phase((PG8_LAS unsigned char*)smem, g, S, pg8::EpiBf16{(bf16_t*)(p.ws + WS_QP), 2048}, TIDX());
        asm volatile("s_waitcnt vmcnt(0)" ::: "memory");
        __syncthreads();
#pragma unroll 1
        for (int i = 0; ; ++i) {
            pg8::Unit u; if (!S.next(i, u)) break;
#pragma unroll 1
            for (int hh = 0; hh < 2; ++hh) sc_tile(p, u.pm, 2 * u.pn + hh, smem, TIDX());
        }
    }
    else if (PH == PH_GEMM_SC) gemm_phase((const bf16_t*)(p.ws + WS_QP), 2048, (const bf16_t*)(p.ws + WS_SK), 128, T_TOK, 2048, 128, true,
                                          EpiF16{(_Float16*)(p.ws + WS_SC), 2048}, vb0, nvb, smem, TIDX());
    else if (PH == PH_ROUTE) ph_route(p, vb0, nvb, smem);
    else if (PH == PH_G1) ph_peer_sliced<0>(p, l, vb0, nvb, smem);
    else if (PH == PH_G15) ph_peer_coef(p, vb0, nvb);
    else if (PH == PH_G2) ph_peer_sliced<1>(p, l, vb0, nvb, smem);

}

#define XB_TMO      128
#define XB_XCNT(j)  (256  + 64 * (j))
#define XB_XSUB(j)  (1280 + 64 * (j))
#define XB_XGEN(j)  (2304 + 64 * (j))
#define XB_TOP      3328
#define XB_TOPGEN   3392
#define XCD_BAR_WORDS 3456
#define XB_SPIN_CAP (1u << 18)
#define LAS __attribute__((address_space(3)))
__device__ __forceinline__ unsigned xb_ld(unsigned* p)              { return __hip_atomic_load(p, __ATOMIC_RELAXED, __HIP_MEMORY_SCOPE_AGENT); }
__device__ __forceinline__ unsigned xb_add(unsigned* p, unsigned v) { return __hip_atomic_fetch_add(p, v, __ATOMIC_RELAXED, __HIP_MEMORY_SCOPE_AGENT); }
#define XB_SPIN(cond, bar) do { unsigned _sp = 0; while (cond) { __builtin_amdgcn_s_sleep(1); \
    if ((++_sp & 255u) == 0u) { if (xb_ld(&(bar)[XB_TMO])) break; if (_sp > XB_SPIN_CAP) { atomicAdd(&(bar)[XB_TMO], 1u); break; } } } } while (0)
struct XcdBarrier { unsigned* bar; unsigned x; volatile LAS unsigned* st; int wv; };
__device__ __forceinline__ XcdBarrier xcd_barrier_post(unsigned* bar, volatile LAS unsigned* st, int wv) {
    XcdBarrier b; b.bar = bar; b.x = xb_xcc_id(); b.st = st; b.wv = wv;
    if (TIDXW(wv) == 0) (void)xb_add(&bar[XB_XCNT(b.x)], 1u);
    return b;
}
__device__ __forceinline__ void xcd_barrier_complete(unsigned* bar, unsigned x, unsigned& nloc, unsigned& nx) {
    const unsigned G = gridDim.x * gridDim.y * gridDim.z;
    unsigned sum, cnt, mine, sp = 0u;
    for (;;) {
        sum = 0u; cnt = 0u; mine = 0u;
#pragma unroll
        for (unsigned j = 0; j < 16; ++j) { const unsigned c = xb_ld(&bar[XB_XCNT(j)]); sum += c; cnt += (c > 0u) ? 1u : 0u; mine = (j == x) ? c : mine; }
        if (sum == G) break;
        __builtin_amdgcn_s_sleep(1);
        if ((++sp & 255u) == 0u) { if (xb_ld(&bar[XB_TMO])) break; if (sp > XB_SPIN_CAP) { atomicAdd(&bar[XB_TMO], 1u); break; } }
    }
    nloc = mine > 0u ? mine : 1u; nx = cnt > 0u ? cnt : 1u;
}
__device__ __forceinline__ void xcd_barrier(const XcdBarrier& b) {
    asm volatile("s_waitcnt vmcnt(0)" ::: "memory");
    __syncthreads();
    if (TIDXW(b.wv) == 0) {
        unsigned* bar = b.bar;
        __builtin_amdgcn_s_waitcnt(0);
        unsigned nloc = b.st[0], nx = b.st[1];
        if (nloc == 0u) { xcd_barrier_complete(bar, b.x, nloc, nx); b.st[0] = nloc; b.st[1] = nx; }
        const unsigned old = xb_add(&bar[XB_XSUB(b.x)], 1u);
        const unsigned gen = old / nloc;
        if (old + 1u == (gen + 1u) * nloc) {
            __builtin_amdgcn_fence(__ATOMIC_RELEASE, "agent");
            asm volatile("s_waitcnt vmcnt(0)" ::: "memory");
            const unsigned og = xb_add(&bar[XB_TOP], 1u);
            const unsigned tg = og / nx;
            if (og + 1u == (tg + 1u) * nx) xb_add(&bar[XB_TOPGEN], 1u);
            else XB_SPIN(xb_ld(&bar[XB_TOPGEN]) == tg, bar);
            __builtin_amdgcn_fence(__ATOMIC_ACQUIRE, "agent");
            xb_add(&bar[XB_XGEN(b.x)], 1u);
            asm volatile("s_waitcnt vmcnt(0)" ::: "memory");
        } else {
            XB_SPIN(xb_ld(&bar[XB_XGEN(b.x)]) == gen, bar);
            __builtin_amdgcn_fence(__ATOMIC_ACQUIRE, "agent");
            asm volatile("s_waitcnt vmcnt(0)" ::: "memory");
        }
    }
    __syncthreads();
}

__global__ void __launch_bounds__(NT) mega_kernel(Params p_in) {
#if defined(__HIP_DEVICE_COMPILE__)
    extern __shared__ __attribute__((aligned(16))) char smem[];
    volatile LAS unsigned* st = (volatile LAS unsigned*)(smem + LDS_BYTES - 16);
    int wv_ = __builtin_amdgcn_readfirstlane((int)threadIdx.x >> 6); asm volatile("" : "+s"(wv_));
    { const int t_ = TIDXW(wv_); if (t_ < 4) st[t_] = 0u; }
    __syncthreads();
    XcdBarrier bar = xcd_barrier_post((unsigned*)(p_in.ws + WS_CTL), st, wv_);
    const int vb = (int)blockIdx.x, nvb = (int)gridDim.x;
#define GB() xcd_barrier(bar)
#define RUN(PH, L) do { \
        const __attribute__((address_space(4))) Params* _kp = (const __attribute__((address_space(4))) Params*)__builtin_amdgcn_kernarg_segment_ptr(); asm volatile("" : "+s"(_kp)); Params _p = *_kp; _p.wv = wv_; \
        int _l = (L), _vb = vb, _nvb = nvb; asm volatile("" : "+s"(_l), "+s"(_vb), "+s"(_nvb)); \
        run_phase<PH>(_p, _l, _vb, _nvb, smem); } while (0)
    RUN(PH_MOD, 0);
#pragma unroll 1
    for (int l = 0; l < 2; ++l) {
        RUN(PH_WPREP, l); if (l == 0) GB();
        RUN(PH_NORM1, l); GB();
        RUN(PH_GEMM_IN, l); GB();
        RUN(PH_SCAN, l); GB();
        RUN(PH_MERGE, l); GB();
        RUN(PH_OUT, l); GB();
        RUN(PH_NORM2, l); GB();
        RUN(PH_GEMM_Q, l); GB();
        RUN(PH_ROUTE, l); GB();
        RUN(PH_G1, l); GB();
        RUN(PH_G15, l); GB();
        RUN(PH_G2, l);
        if (l == 0) GB();
    }
#undef RUN
#undef GB
#endif
}

extern "C" void kernel_launch(void* const* d_in, const int* in_sizes, int n_in, void* d_out, int out_size, void* d_ws, size_t ws_size,
                              hipStream_t stream) {
    if (n_in != 20 || ws_size < WS_END) { fprintf(stderr, "kernel_launch: bad inputs (n_in %d ws %zu need %zu)\n", n_in, ws_size, (size_t)WS_END); return; }
    Params p{};
    p.x = (const float*)d_in[0]; p.c = (const float*)d_in[1]; p.w_ada = (const float*)d_in[2]; p.b_ada = (const float*)d_in[3];
    p.norm_mix = (const float*)d_in[4]; p.norm_ffn = (const float*)d_in[5]; p.w_in = (const float*)d_in[6]; p.hgrn_lb = (const float*)d_in[7];
    p.hgrn_on = (const float*)d_in[8]; p.dsa_qn = (const float*)d_in[9]; p.dsa_kn = (const float*)d_in[10]; p.gla_up = (const float*)d_in[11];
    p.gla_bias = (const float*)d_in[12]; p.gla_on = (const float*)d_in[13]; p.w_branch = (const float*)d_in[14]; p.w_out = (const float*)d_in[15];
    p.peer_wq = (const float*)d_in[16]; p.peer_keys = (const float*)d_in[17]; p.peer_u = (const float*)d_in[18]; p.peer_v = (const float*)d_in[19];
    p.out = (float*)d_out; p.ws = (unsigned char*)d_ws;
    static int grid = 0;
    if (grid == 0) {
        int dev = 0, cus = 0, per_cu = 0;
        hipGetDevice(&dev);
        hipDeviceGetAttribute(&cus, hipDeviceAttributeMultiprocessorCount, dev);
        hipFuncSetAttribute((const void*)mega_kernel, hipFuncAttributeMaxDynamicSharedMemorySize, LDS_BYTES);
        hipOccupancyMaxActiveBlocksPerMultiprocessor(&per_cu, (const void*)mega_kernel, NT, LDS_BYTES);
        if (per_cu < 1) { fprintf(stderr, "kernel_launch: occupancy query says %d blocks per CU\n", per_cu); per_cu = 1; }
        (void)hipGetLastError();
        grid = cus;
    }
    hipMemsetAsync((char*)d_ws + WS_CTL, 0, 32768, stream);
    void* args[] = {&p};
    hipError_t e = hipLaunchCooperativeKernel((const void*)mega_kernel, dim3(grid), dim3(NT), args, LDS_BYTES, stream);
    if (e != hipSuccess) fprintf(stderr, "cooperative launch failed: %s (grid %d)\n", hipGetErrorString(e), grid);
}
```

```cpp
#include <hip/hip_runtime.h>
#include <stdint.h>
#include <stdio.h>

typedef unsigned short bf16_t;
typedef short bf16x8 __attribute__((ext_vector_type(8)));
typedef float f32x4 __attribute__((ext_vector_type(4)));
typedef unsigned u32x4 __attribute__((ext_vector_type(4)));

#define NT 512
constexpr int T_TOK = 16384, DM = 1024, SEQ = 2048;
constexpr int LDZ = 8704;
constexpr int ZA_Q = 0, ZA_F = 512, ZA_I = 1024, ZA_G = 1536, ZB_Q = 2048, ZB_K = 2560, ZB_V = 3072, ZC_V = 3584, ZC_G = 4096,
              ZB_QI = 4608, ZC_Q = 4864, ZC_K = 5120, ZB_KI = 5376, ZB_WI = 5440, ZC_CODE = 5444, ZM = 5632;
constexpr int IN_COLS = 8532;

constexpr size_t al256(size_t x) { return (x + 255) & ~(size_t)255; }
constexpr size_t WS_CTL = 0;
constexpr size_t WS_MOD = 65536;
constexpr size_t WS_WIN = al256(WS_MOD + (size_t)2 * 8 * 6144 * 4);
constexpr size_t WS_WBR = al256(WS_WIN + (size_t)LDZ * 1024 * 2);
constexpr size_t WS_WOUT = al256(WS_WBR + (size_t)3 * 1024 * 512 * 2);
constexpr size_t WS_WQ = al256(WS_WOUT + (size_t)1024 * 1024 * 2);
constexpr size_t WS_SK = al256(WS_WQ + (size_t)2048 * 1024 * 2);
constexpr size_t WS_PU = al256(WS_SK + (size_t)16 * 128 * 128 * 2);
constexpr size_t WS_PV = al256(WS_PU + (size_t)16384 * 1024);
constexpr size_t WS_H = al256(WS_PV + (size_t)16384 * 1024);
constexpr float PU_SCALE = 32.f, PV_SCALE = 4.f;
constexpr size_t WS_OA = al256(WS_H + (size_t)T_TOK * 1024 * 2);
constexpr size_t WS_OC = al256(WS_OA + (size_t)T_TOK * 512 * 2);
constexpr size_t WS_H8H = WS_OA, WS_H8L = WS_OC;
constexpr size_t WS_Y = al256(WS_OC + (size_t)T_TOK * 512 * 2);
constexpr size_t WS_Z = al256(WS_Y + (size_t)T_TOK * 1536 * 2);
constexpr size_t WS_VT = al256(WS_Z + (size_t)T_TOK * LDZ * 2);
constexpr size_t WS_BM = al256(WS_VT + (size_t)T_TOK * 512 * 2);
constexpr size_t WS_END = al256(WS_BM + (size_t)T_TOK * 64 * 4);
constexpr size_t WS_QP = WS_Z;
constexpr size_t WS_SC = al256(WS_QP + (size_t)T_TOK * 2048 * 2);
constexpr size_t WS_RI = al256(WS_SC + (size_t)T_TOK * 2048 * 4);
constexpr size_t WS_RG = al256(WS_RI + (size_t)T_TOK * 128 * 4);
constexpr size_t WS_PP = al256(WS_RG + (size_t)T_TOK * 128 * 4);
constexpr size_t WS_C8H = WS_SC;
constexpr size_t WS_C8L = WS_C8H + (size_t)T_TOK * 128;
constexpr size_t WS_CINV = WS_C8L + (size_t)T_TOK * 128;
static_assert(WS_PP + (size_t)8 * T_TOK * 128 * 4 <= WS_VT, "peer partials overflow the Z region");
static_assert(WS_RG + (size_t)T_TOK * 128 * 4 <= WS_END, "peer alias overflow");

struct Params {
    const float* x; const float* c; const float* w_ada; const float* b_ada; const float* norm_mix; const float* norm_ffn;
    const float* w_in; const float* hgrn_lb; const float* hgrn_on; const float* dsa_qn; const float* dsa_kn;
    const float* gla_up; const float* gla_bias; const float* gla_on; const float* w_branch; const float* w_out;
    const float* peer_wq; const float* peer_keys; const float* peer_u; const float* peer_v;
    float* out; unsigned char* ws;
    int wv, pad;
};

__device__ __forceinline__ float bf2f(bf16_t h) { return __uint_as_float(((unsigned)h) << 16); }
__device__ __forceinline__ float bflo(unsigned u) { return __uint_as_float(u << 16); }
__device__ __forceinline__ float bfhi(unsigned u) { return __uint_as_float(u & 0xffff0000u); }
__device__ __forceinline__ bf16_t f2bf(float f) { unsigned r; asm volatile("v_cvt_pk_bf16_f32 %0, %1, %1" : "=v"(r) : "v"(f)); return (bf16_t)(r & 0xffffu); }
__device__ __forceinline__ unsigned pack2(float a, float b) { unsigned r; asm volatile("v_cvt_pk_bf16_f32 %0, %1, %2" : "=v"(r) : "v"(a), "v"(b)); return r; }
__device__ __forceinline__ int lane_id_opaque() { int l; asm volatile("v_mbcnt_lo_u32_b32 %0, -1, 0\n\tv_mbcnt_hi_u32_b32 %0, -1, %0" : "=v"(l)); return l; }
template <int M> __device__ __forceinline__ int shx_i(int v) {
    if (M < 32) return __builtin_amdgcn_ds_swizzle(v, (M << 10) | 0x1f);
    return __builtin_amdgcn_ds_bpermute((lane_id_opaque() ^ 32) << 2, v);
}
template <int M> __device__ __forceinline__ float shx(float v) { return __int_as_float(shx_i<M>(__float_as_int(v))); }
template <int M> __device__ __forceinline__ int shx(int v) { return shx_i<M>(v); }
template <int M> __device__ __forceinline__ unsigned shx(unsigned v) { return (unsigned)shx_i<M>((int)v); }
__device__ __forceinline__ int bperm(int v, int src) { return __builtin_amdgcn_ds_bpermute(src << 2, v); }
__device__ __forceinline__ float bperm(float v, int src) { return __int_as_float(__builtin_amdgcn_ds_bpermute(src << 2, __float_as_int(v))); }
__device__ __forceinline__ float wave_sum(float v) { v += shx<32>(v); v += shx<16>(v); v += shx<8>(v); v += shx<4>(v); v += shx<2>(v); v += shx<1>(v); return v; }
__device__ __forceinline__ float wave_max(float v) { v = fmaxf(v, shx<32>(v)); v = fmaxf(v, shx<16>(v)); v = fmaxf(v, shx<8>(v)); v = fmaxf(v, shx<4>(v)); v = fmaxf(v, shx<2>(v)); v = fmaxf(v, shx<1>(v)); return v; }
__device__ __forceinline__ int wave_sum_i(int v) { v += shx<32>(v); v += shx<16>(v); v += shx<8>(v); v += shx<4>(v); v += shx<2>(v); v += shx<1>(v); return v; }
__device__ __forceinline__ int wave_total_i(int v) {
    v += __builtin_amdgcn_update_dpp(0, v, 0x111, 0xf, 0xf, true);
    v += __builtin_amdgcn_update_dpp(0, v, 0x112, 0xf, 0xf, true);
    v += __builtin_amdgcn_update_dpp(0, v, 0x114, 0xf, 0xf, true);
    v += __builtin_amdgcn_update_dpp(0, v, 0x118, 0xf, 0xf, true);
    v += __builtin_amdgcn_update_dpp(0, v, 0x142, 0xa, 0xf, true);
    v += __builtin_amdgcn_update_dpp(0, v, 0x143, 0xc, 0xf, true);
    return __builtin_amdgcn_readlane(v, 63);
}
__device__ __forceinline__ float sigm(float x) { return __frcp_rn(1.f + __expf(-x)); }

__device__ __forceinline__ unsigned xb_xcc_id() { return (unsigned)__builtin_amdgcn_s_getreg((3 << 11) | 20) & 0xFu; }
__device__ __forceinline__ int TIDXW(int wv) { int t; asm volatile("v_mbcnt_lo_u32_b32 %0, -1, 0\n\tv_mbcnt_hi_u32_b32 %0, -1, %0\n\tv_lshl_or_b32 %0, %1, 6, %0" : "=v"(t) : "s"(wv)); return t; }
#define TIDX() TIDXW(p.wv)

__device__ __forceinline__ int src_col(int j) {
    if (j < 3584) return j;
    if (j < 4096) return j - 3584 + 4420;
    if (j < 4608) return j - 4096 + 4948;
    if (j < 4864) return j - 4608 + 3584;
    if (j < 5120) return j - 4864 + 3908;
    if (j < 5376) return j - 5120 + 4164;
    if (j < 5440) return j - 5376 + 3840;
    if (j < 5444) return j - 5440 + 3904;
    if (j < 5460) return j - 5444 + 4932;
    if (j < 5632) return -1;
    return j - 5632 + 5460;
}

__device__ void ph_mod(const Params& p, int vb0, int nvb, char* smem_) {
    float* sc = (float*)smem_;
    float* part = sc + 8 * 1024;
    float* mod = (float*)(p.ws + WS_MOD);
    const int tid = TIDX(), lane = tid & 63, wave = tid >> 6;
    if (vb0 >= 192) return;
    for (int i = tid; i < 8 * 1024; i += NT) { float c = p.c[i]; sc[i] = c / (1.f + __expf(-c)); }
    __syncthreads();
    for (int task = vb0; task < 192; task += nvb) {
        const int l = task / 96, n0 = (task % 96) * 64;
        const float* w = p.w_ada + (size_t)l * 1024 * 6144 + (size_t)(wave * 128) * 6144 + n0 + lane;
        float acc[8];
#pragma unroll
        for (int b = 0; b < 8; ++b) acc[b] = 0.f;
#pragma unroll 1
        for (int k0 = 0; k0 < 128; k0 += 16) {
            float wv[16];
#pragma unroll
            for (int j = 0; j < 16; ++j) wv[j] = w[(size_t)(k0 + j) * 6144];
#pragma unroll
            for (int j = 0; j < 16; ++j)
#pragma unroll
                for (int b = 0; b < 8; ++b) acc[b] += sc[b * 1024 + wave * 128 + k0 + j] * wv[j];
        }
#pragma unroll
        for (int b = 0; b < 8; ++b) part[(wave * 8 + b) * 64 + lane] = acc[b];
        __syncthreads();
        {
            const int b = tid >> 6, col = tid & 63;
            float v = p.b_ada[l * 6144 + n0 + col];
#pragma unroll
            for (int w_ = 0; w_ < 8; ++w_) v += part[(w_ * 8 + b) * 64 + col];
            mod[(size_t)(l * 8 + b) * 6144 + n0 + col] = v;
        }
        __syncthreads();
    }
}

template <bool MAP>
__device__ void tr_tile(const float* __restrict__ src, int lds_, bf16_t* __restrict__ out, int ldo, int k0, int n0, float* tile, const int tid) {
    float lv[8];
    {
        const int nn = tid & 63, scol = MAP ? src_col(n0 + nn) : (n0 + nn);
#pragma unroll
        for (int i = 0; i < 8; ++i) { const int kk = (tid >> 6) + 8 * i; lv[i] = (scol >= 0) ? src[(size_t)(k0 + kk) * lds_ + scol] : 0.f; }
#pragma unroll
        for (int i = 0; i < 8; ++i) { const int kk = (tid >> 6) + 8 * i; tile[kk * 65 + nn] = lv[i]; }
    }
    __syncthreads();
#pragma unroll
    for (int i = 0; i < 4; ++i) {
        int nn = (tid >> 5) + 16 * i, kk = (tid & 31) * 2;
        unsigned v = pack2(tile[kk * 65 + nn], tile[(kk + 1) * 65 + nn]);
        *(unsigned*)(out + (size_t)(n0 + nn) * ldo + k0 + kk) = v;
    }
    __syncthreads();
}
__device__ void conv_chunk(const float* __restrict__ src, bf16_t* __restrict__ dst, size_t base, const int tid) {
    f32x4 la[4], lb[4];
#pragma unroll
    for (int i = 0; i < 4; ++i) { const size_t e = base + (size_t)(i * NT + tid) * 8; la[i] = *(const f32x4*)(src + e); lb[i] = *(const f32x4*)(src + e + 4); }
#pragma unroll
    for (int i = 0; i < 4; ++i) {
        size_t e = base + (size_t)(i * NT + tid) * 8;
        const float4 a = make_float4(la[i][0], la[i][1], la[i][2], la[i][3]), b = make_float4(lb[i][0], lb[i][1], lb[i][2], lb[i][3]);
        uint4 o; o.x = pack2(a.x, a.y); o.y = pack2(a.z, a.w); o.z = pack2(b.x, b.y); o.w = pack2(b.z, b.w);
        *(uint4*)(dst + e) = o;
    }
}
__device__ void conv_chunk_fp8(const float* __restrict__ src, unsigned char* __restrict__ dst, size_t base, float scale, const int tid) {
    f32x4 la[4], lb[4];
#pragma unroll
    for (int i = 0; i < 4; ++i) { const size_t e = base + (size_t)(i * NT + tid) * 8; la[i] = *(const f32x4*)(src + e); lb[i] = *(const f32x4*)(src + e + 4); }
#pragma unroll
    for (int i = 0; i < 4; ++i) {
        size_t e = base + (size_t)(i * NT + tid) * 8;
        const float4 a = make_float4(la[i][0], la[i][1], la[i][2], la[i][3]), b = make_float4(lb[i][0], lb[i][1], lb[i][2], lb[i][3]);
        int lo = __builtin_amdgcn_cvt_pk_fp8_f32(a.x * scale, a.y * scale, 0, false); lo = __builtin_amdgcn_cvt_pk_fp8_f32(a.z * scale, a.w * scale, lo, true);
        int hi = __builtin_amdgcn_cvt_pk_fp8_f32(b.x * scale, b.y * scale, 0, false); hi = __builtin_amdgcn_cvt_pk_fp8_f32(b.z * scale, b.w * scale, hi, true);
        const size_t row = e >> 10, col = e & 1023;
        *(uint2*)(dst + ((col >> 7) * 16384 + row) * 128 + (col & 127)) = make_uint2((unsigned)lo, (unsigned)hi);
    }
}
__device__ __forceinline__ bf16x8 ld8_f32_bf16(const float* src) {
    const f32x4 a = *(const f32x4*)src, b = *(const f32x4*)(src + 4);
    union { bf16x8 v; unsigned u[4]; } r; r.u[0] = pack2(a[0], a[1]); r.u[1] = pack2(a[2], a[3]); r.u[2] = pack2(b[0], b[1]); r.u[3] = pack2(b[2], b[3]);
    return r.v;
}
__device__ void wqk_task(const float* __restrict__ wq, const float* __restrict__ keys, bf16_t* __restrict__ out, int g, int kt, const int tid) {
    const int lane = tid & 63, wave = tid >> 6, fr = lane & 15, fq = lane >> 4;
    const float* kp = keys + ((size_t)g * 128 + wave * 16 + fr) * 128 + fq * 8;
    const float* wp = wq + (size_t)(kt * 64 + fr) * 2048 + g * 128 + fq * 8;
    f32x4 acc[4];
#pragma unroll
    for (int kb = 0; kb < 4; ++kb) acc[kb] = f32x4{0.f, 0.f, 0.f, 0.f};
#pragma unroll
    for (int dd = 0; dd < 4; ++dd) {
        const bf16x8 kf = ld8_f32_bf16(kp + dd * 32);
#pragma unroll
        for (int kb = 0; kb < 4; ++kb) acc[kb] = __builtin_amdgcn_mfma_f32_16x16x32_bf16(ld8_f32_bf16(wp + (size_t)(kb * 16) * 2048 + dd * 32), kf, acc[kb], 0, 0, 0);
    }
#pragma unroll
    for (int kb = 0; kb < 4; ++kb) {
        unsigned w[4];
#pragma unroll
        for (int j = 0; j < 4; ++j) { const unsigned u = __float_as_uint(acc[kb][j]); w[j] = (u + 0x7fffu + ((u >> 16) & 1u)) >> 16; }
        uint2 o; o.x = w[0] | (w[1] << 16); o.y = w[2] | (w[3] << 16);
        *(uint2*)(out + ((size_t)g * 128 + wave * 16 + fr) * 1024 + kt * 64 + kb * 16 + fq * 4) = o;
    }
}
__device__ void ph_wprep(const Params& p, int l, int vb0, int nvb, char* smem_) {
    float* tile = (float*)smem_;
    const int tid = TIDX();
    bf16_t* WIN = (bf16_t*)(p.ws + WS_WIN); bf16_t* WBR = (bf16_t*)(p.ws + WS_WBR); bf16_t* WOUT = (bf16_t*)(p.ws + WS_WOUT);
    bf16_t* WQ = (bf16_t*)(p.ws + WS_WQ); unsigned char* PU = p.ws + WS_PU; unsigned char* PV = p.ws + WS_PV;
    constexpr int N_WIN = 136 * 16, N_WBR = 3 * 16 * 8, N_WOUT = 16 * 16, N_WQ = 16 * 16, N_PU = 1024, N_PV = 1024;
    constexpr int TOTAL = N_WIN + N_WBR + N_WOUT + N_WQ + N_PU + N_PV;
    for (int task = vb0; task < TOTAL; task += nvb) {
        int r = task;
        if (r < N_WIN) { int nt = r / 16, kt = r % 16; tr_tile<true>(p.w_in + (size_t)l * 1024 * IN_COLS, IN_COLS, WIN, 1024, kt * 64, nt * 64, tile, tid); continue; }
        r -= N_WIN;
        if (r < N_WBR) { int g = r / 128, rr = r % 128, nt = rr / 8, kt = rr % 8;
            tr_tile<false>(p.w_branch + (size_t)(l * 3 + g) * 512 * 1024, 1024, WBR + (size_t)g * 1024 * 512, 512, kt * 64, nt * 64, tile, tid); continue; }
        r -= N_WBR;
        if (r < N_WOUT) { int nt = r / 16, kt = r % 16; tr_tile<false>(p.w_out + (size_t)l * 1024 * 1024, 1024, WOUT, 1024, kt * 64, nt * 64, tile, tid); continue; }
        r -= N_WOUT;
        if (r < N_WQ) { wqk_task(p.peer_wq + (size_t)l * 1024 * 2048, p.peer_keys + (size_t)l * 16 * 128 * 128, WQ, r / 16, r % 16, tid); continue; }
        r -= N_WQ;
        if (r < N_PU) { conv_chunk_fp8(p.peer_u + (size_t)l * 16384 * 1024, PU, (size_t)r * 16384, PU_SCALE, tid); continue; }
        r -= N_PU;
        conv_chunk_fp8(p.peer_v + (size_t)l * 16384 * 1024, PV, (size_t)r * 16384, PV_SCALE, tid);
    }
}

__device__ void ph_norm(const Params& p, int l, int which, const float* xin, int vb0, int nvb) {
    const int wave = TIDX() >> 6, lane = TIDX() & 63;
    const float* gain = (which ? p.norm_ffn : p.norm_mix) + l * 1024;
    const float* modb = (const float*)(p.ws + WS_MOD);
    bf16_t* H = (bf16_t*)(p.ws + WS_H);
    f32x4 g[4];
#pragma unroll
    for (int i = 0; i < 4; ++i) g[i] = *(const f32x4*)(gain + (lane + 64 * i) * 4);
    for (int t = vb0 * 8 + wave; t < T_TOK; t += nvb * 8) {
        const int b = t >> 11;
        const float* mod = modb + (size_t)(l * 8 + b) * 6144 + (which ? 3072 : 0);
        const f32x4* xr = (const f32x4*)(xin + (size_t)t * 1024);
        f32x4 v[4], sc[4], sh[4]; float ss = 0.f;
#pragma unroll
        for (int i = 0; i < 4; ++i) { v[i] = xr[lane + 64 * i]; sc[i] = *(const f32x4*)(mod + 1024 + (lane + 64 * i) * 4); sh[i] = *(const f32x4*)(mod + (lane + 64 * i) * 4); }
#pragma unroll
        for (int i = 0; i < 4; ++i) ss += v[i][0] * v[i][0] + v[i][1] * v[i][1] + v[i][2] * v[i][2] + v[i][3] * v[i][3];
        ss = wave_sum(ss);
        const float rstd = rsqrtf(ss * (1.f / 1024.f) + 1e-6f);
#pragma unroll
        for (int i = 0; i < 4; ++i) {
            const int idx = (lane + 64 * i) * 4;
            const f32x4 h = v[i] * rstd * g[i] * (1.f + sc[i]) + sh[i];
            uint2 o; o.x = pack2(h[0], h[1]); o.y = pack2(h[2], h[3]);
            *(uint2*)(H + (size_t)t * 1024 + idx) = o;
            if (which) {
                int hi = __builtin_amdgcn_cvt_pk_fp8_f32(h[0], h[1], 0, false); hi = __builtin_amdgcn_cvt_pk_fp8_f32(h[2], h[3], hi, true);
                const auto d0 = __builtin_amdgcn_cvt_pk_f32_fp8(hi, false); const auto d1 = __builtin_amdgcn_cvt_pk_f32_fp8(hi, true);
                int lo = __builtin_amdgcn_cvt_pk_fp8_f32((h[0] - d0[0]) * 16.f, (h[1] - d0[1]) * 16.f, 0, false);
                lo = __builtin_amdgcn_cvt_pk_fp8_f32((h[2] - d1[0]) * 16.f, (h[3] - d1[1]) * 16.f, lo, true);
                *(int*)(p.ws + WS_H8H + (size_t)t * 1024 + idx) = hi;
                *(int*)(p.ws + WS_H8L + (size_t)t * 1024 + idx) = lo;
            }
        }
    }
}

constexpr int GBM = 256, GBN = 128, GBK = 64, GLS = 72;
__device__ __forceinline__ void gemm_tile(const bf16_t* __restrict__ A, int lda, const bf16_t* __restrict__ Bt, int ldb, int K,
                                          int m0, int n0, bf16_t* sA, bf16_t* sB, f32x4 (&acc)[4][4], const int tid) {
    const int lane = tid & 63, wave = tid >> 6;
    const int wm = wave >> 1, wn = wave & 1, fr = lane & 15, fq = lane >> 4;
    u32x4 ra[4], rb[2];
    const int crow = tid >> 3, ckc = (tid & 7) * 8;
    const bf16_t* Ag = A + (size_t)(m0 + crow) * lda + ckc;
    const bf16_t* Bg = Bt + (size_t)(n0 + crow) * ldb + ckc;
#pragma unroll
    for (int i = 0; i < 4; ++i) ra[i] = *(const u32x4*)(Ag + (size_t)(64 * i) * lda);
#pragma unroll
    for (int i = 0; i < 2; ++i) rb[i] = *(const u32x4*)(Bg + (size_t)(64 * i) * ldb);
    for (int k0 = 0; k0 < K; k0 += GBK) {
        __syncthreads();
#pragma unroll
        for (int i = 0; i < 4; ++i) *(u32x4*)(sA + (crow + 64 * i) * GLS + ckc) = ra[i];
#pragma unroll
        for (int i = 0; i < 2; ++i) *(u32x4*)(sB + (crow + 64 * i) * GLS + ckc) = rb[i];
        __syncthreads();
        {
            const int kn = (k0 + GBK < K) ? (k0 + GBK) : k0;
#pragma unroll
            for (int i = 0; i < 4; ++i) ra[i] = *(const u32x4*)(Ag + (size_t)(64 * i) * lda + kn);
#pragma unroll
            for (int i = 0; i < 2; ++i) rb[i] = *(const u32x4*)(Bg + (size_t)(64 * i) * ldb + kn);
        }
#pragma unroll
        for (int ks = 0; ks < 2; ++ks) {
            bf16x8 af[4], wf[4];
#pragma unroll
            for (int mf = 0; mf < 4; ++mf) af[mf] = *(const bf16x8*)(sA + (wm * 64 + mf * 16 + fr) * GLS + ks * 32 + fq * 8);
#pragma unroll
            for (int nf = 0; nf < 4; ++nf) wf[nf] = *(const bf16x8*)(sB + (wn * 64 + nf * 16 + fr) * GLS + ks * 32 + fq * 8);
#pragma unroll
            for (int nf = 0; nf < 4; ++nf)
#pragma unroll
                for (int mf = 0; mf < 4; ++mf)
                    acc[nf][mf] = __builtin_amdgcn_mfma_f32_16x16x32_bf16(wf[nf], af[mf], acc[nf][mf], 0, 0, 0);
        }
    }
}


namespace pg8 {
#define PG8_LAS __attribute__((address_space(3)))
constexpr int BM = 256, BK = 64, HALF = 128, HTB = HALF * BK * 2, STAGE_BYTES = 8 * HTB, NXCD = 8, WGM = 8;
__device__ __forceinline__ int lds_byte(int r, int c) { const int st = (r >> 4) * 2 + (c >> 5), rr = r & 15, cc = c & 31, ob = rr * 64 + cc * 2; return st * 1024 + (ob ^ (((ob >> 9) & 1) << 5)); }
__device__ __forceinline__ void stage_rc(int b, int& R, int& C) { const int st = b / 1024, sb = b % 1024, swz = sb ^ (((sb >> 9) & 1) << 5); R = (st >> 1) * 16 + swz / 64; C = (st & 1) * 32 + (swz % 64) / 2; }
__device__ __forceinline__ int perm32(int rho) { const int n = rho >> 4, i = rho & 15; return 8 * (i >> 2) + 4 * n + (i & 3); }
struct Unit { int pm, pn, aux; size_t aoff, boff; };
struct Gemm { const bf16_t* A; const bf16_t* Bt; int lda, ldb, K; };

struct StaticOrder {
    int nM, nN, nwg, G, c, lda, ldb;
    __device__ void init(int M, int N, int G_, int c_, int lda_, int ldb_) { nM = M / BM; nN = N / BM; nwg = nM * nN; G = G_; c = c_; lda = lda_; ldb = ldb_; }
    __device__ bool next(int i, Unit& u) const {
        const long L = (long)i * G + c; if (L >= nwg) return false;
        int wgid = (int)L; { const int q = nwg / NXCD, r = nwg % NXCD, xcd = wgid % NXCD, off = wgid / NXCD; wgid = (xcd < r ? xcd * (q + 1) : r * (q + 1) + (xcd - r) * q) + off; }
        const int nig = WGM * nN, gid = wgid / nig, fm = gid * WGM, gsz = (nM - fm) < WGM ? (nM - fm) : WGM;
        u.pm = fm + ((wgid % nig) % gsz); u.pn = (wgid % nig) / gsz; u.aux = 0;
        u.aoff = (size_t)u.pm * BM * lda * 2; u.boff = (size_t)u.pn * BM * ldb * 2;
        return true;
    }
};
struct MergeOrder {
    int c, G;
    __device__ bool next(int i, Unit& u) const {
        const int tile = c + (i / 3) * G; if (tile >= 256) return false;
        u.pm = tile & 63; u.pn = tile >> 6; u.aux = i % 3;
        u.aoff = ((size_t)u.pm * BM * 1536 + (size_t)u.aux * 512) * 2; u.boff = ((size_t)u.aux * 1024 + (size_t)u.pn * BM) * 512 * 2;
        return true;
    }
};

template <class Epi, class Sched>
__device__ __forceinline__ void gemm_phase(PG8_LAS unsigned char* lds, const Gemm g, const Sched& S, const Epi& E, const int tid) {
    const int wid = __builtin_amdgcn_readfirstlane(tid >> 6), lane = tid & 63, wr = wid >> 2, wc = wid & 3, fr = lane & 15, fq = lane >> 4;
    const int K = g.K, nt = K / BK;
    unsigned voffA[2], voffB[2];
#pragma unroll
    for (int i = 0; i < 2; ++i) { int R, C; stage_rc(tid * 16 + i * 8192, R, C); const int Rb = Epi::PERM ? ((R & ~31) + perm32(R & 31)) : R;
        voffA[i] = (unsigned)(R * g.lda + C) * 2u; voffB[i] = (unsigned)(Rb * g.ldb + C) * 2u; }
    const size_t kstep = (size_t)(BK * 2);
    const size_t hstepA = (size_t)HALF * g.lda * 2, hstepB = (size_t)HALF * g.ldb * 2;
    const unsigned ldsw = (unsigned)wid * 1024u;
    const int aoff = lds_byte(wr * 64 + fr, fq * 8), boff = lds_byte(wc * 32 + fr, fq * 8);
#define PG8_SA(b, h) (((b) * 2 + (h)) * HTB)
#define PG8_SB(b, h) ((4 + (b) * 2 + (h)) * HTB)
#define PG8_STAGE(bufoff, gbase, voff) do { _Pragma("unroll") for (int _i = 0; _i < 2; ++_i) \
        __builtin_amdgcn_global_load_lds((const unsigned*)((const char*)(gbase) + (voff)[_i]), (PG8_LAS unsigned*)(lds + (bufoff) + ldsw + _i * 8192), 16, 0, 0); } while (0)
#define PG8_LDA(dst, b, h) do { _Pragma("unroll") for (int m = 0; m < 4; ++m) _Pragma("unroll") for (int k = 0; k < 2; ++k) dst[m][k] = *(const PG8_LAS bf16x8*)(lds + PG8_SA(b, h) + aoff + m * 2048 + k * 1024); } while (0)
#define PG8_LDB(dst, b, h) do { _Pragma("unroll") for (int n = 0; n < 2; ++n) _Pragma("unroll") for (int k = 0; k < 2; ++k) dst[n][k] = *(const PG8_LAS bf16x8*)(lds + PG8_SB(b, h) + boff + n * 2048 + k * 1024); } while (0)
#define PG8_MMA(ai, bj, At, Bt) do { __builtin_amdgcn_s_setprio(1); _Pragma("unroll") for (int m = 0; m < 4; ++m) _Pragma("unroll") for (int n = 0; n < 2; ++n) _Pragma("unroll") for (int k = 0; k < 2; ++k) \
        acc[ai][bj][m][n] = __builtin_amdgcn_mfma_f32_16x16x32_bf16(Bt[n][k], At[m][k], acc[ai][bj][m][n], 0, 0, 0); __builtin_amdgcn_s_setprio(0); } while (0)
#define PG8_WAIT_V(n) asm volatile("s_waitcnt vmcnt(" #n ")" ::: "memory")
#define PG8_WAIT_L(n) asm volatile("s_waitcnt lgkmcnt(" #n ")" ::: "memory")
#define PG8_BAR __builtin_amdgcn_s_barrier()
#define PG8_SCHED __builtin_amdgcn_sched_barrier(0)
    Unit cur, nxt; int ui = 0;
    if (!S.next(0, cur)) return;
    f32x4 acc[2][2][4][2];
#pragma unroll
    for (int a = 0; a < 2; ++a)
#pragma unroll
        for (int b = 0; b < 2; ++b)
#pragma unroll
            for (int m = 0; m < 4; ++m)
#pragma unroll
                for (int n = 0; n < 2; ++n) acc[a][b][m][n] = f32x4{0.f, 0.f, 0.f, 0.f};
    bf16x8 At[4][2], B0[2][2], B1[2][2];
    const char* cA = (const char*)g.A + cur.aoff; const char* cB = (const char*)g.Bt + cur.boff;
    PG8_STAGE(PG8_SB(0, 0), cB, voffB); PG8_STAGE(PG8_SA(0, 0), cA, voffA); PG8_STAGE(PG8_SB(0, 1), cB + hstepB, voffB); PG8_STAGE(PG8_SA(0, 1), cA + hstepA, voffA);
    if (wr == 1) PG8_BAR;
    PG8_WAIT_V(4); PG8_BAR;
    PG8_STAGE(PG8_SB(1, 0), cB + kstep, voffB); PG8_STAGE(PG8_SA(1, 0), cA + kstep, voffA); PG8_STAGE(PG8_SB(1, 1), cB + hstepB + kstep, voffB);
    PG8_WAIT_V(6); PG8_BAR;
    for (;;) {
        const bool has_next = S.next(ui + 1, nxt);
        const char* nA = has_next ? (const char*)g.A + nxt.aoff : cA; const char* nB = has_next ? (const char*)g.Bt + nxt.boff : cB;
        for (int t = 0; t < nt; t += 2) {
            const bool last = (t == nt - 2);
            const char* a1 = cA + (size_t)(t + 1) * kstep;
            const char* a2 = last ? nA : cA + (size_t)(t + 2) * kstep; const char* b2 = last ? nB : cB + (size_t)(t + 2) * kstep;
            const char* a3 = a2 + kstep; const char* b3 = b2 + kstep;
            PG8_LDB(B0, 0, 0); PG8_SCHED; PG8_LDA(At, 0, 0); PG8_STAGE(PG8_SA(1, 1), a1 + hstepA, voffA);
            PG8_WAIT_L(8); PG8_BAR; PG8_WAIT_L(0); PG8_MMA(0, 0, At, B0); PG8_BAR; PG8_SCHED;
            PG8_LDB(B1, 0, 1); PG8_STAGE(PG8_SB(0, 0), b2, voffB);
            PG8_BAR; PG8_WAIT_L(0); PG8_MMA(0, 1, At, B1); PG8_BAR;
            PG8_LDA(At, 0, 1); PG8_STAGE(PG8_SA(0, 0), a2, voffA);
            PG8_BAR; PG8_WAIT_L(0); PG8_MMA(1, 0, At, B0); PG8_BAR; PG8_SCHED;
            PG8_STAGE(PG8_SB(0, 1), b2 + hstepB, voffB);
            PG8_WAIT_V(6); PG8_BAR; PG8_MMA(1, 1, At, B1); PG8_BAR;
            PG8_LDB(B0, 1, 0); PG8_SCHED; PG8_LDA(At, 1, 0); PG8_STAGE(PG8_SA(0, 1), a2 + hstepA, voffA);
            PG8_WAIT_L(8); PG8_BAR; PG8_WAIT_L(0); PG8_MMA(0, 0, At, B0); PG8_BAR; PG8_SCHED;
            PG8_LDB(B1, 1, 1); PG8_STAGE(PG8_SB(1, 0), b3, voffB);
            PG8_BAR; PG8_WAIT_L(0); PG8_MMA(0, 1, At, B1); PG8_BAR;
            PG8_LDA(At, 1, 1); PG8_STAGE(PG8_SA(1, 0), a3, voffA);
            PG8_BAR; PG8_WAIT_L(0); PG8_MMA(1, 0, At, B0); PG8_BAR; PG8_SCHED;
            PG8_STAGE(PG8_SB(1, 1), b3 + hstepB, voffB);
            PG8_WAIT_V(6); PG8_BAR; PG8_MMA(1, 1, At, B1); PG8_BAR;
        }
        E(acc, cur, wr, wc, fr, fq);
        if (!has_next) break;
#pragma unroll
        for (int a = 0; a < 2; ++a)
#pragma unroll
            for (int b = 0; b < 2; ++b)
#pragma unroll
                for (int m = 0; m < 4; ++m)
#pragma unroll
                    for (int n = 0; n < 2; ++n) acc[a][b][m][n] = f32x4{0.f, 0.f, 0.f, 0.f};
        cur = nxt; cA = nA; cB = nB; ++ui;
    }
    PG8_WAIT_V(0);
    if (wr == 0) PG8_BAR;
    PG8_BAR;
#undef PG8_SA
#undef PG8_SB
#undef PG8_STAGE
#undef PG8_LDA
#undef PG8_LDB
#undef PG8_MMA
#undef PG8_WAIT_V
#undef PG8_WAIT_L
#undef PG8_BAR
#undef PG8_SCHED
}

struct EpiBf16 {
    static constexpr bool PERM = true;
    bf16_t* O; int ldc;
    __device__ __forceinline__ void operator()(const f32x4 (&acc)[2][2][4][2], const Unit& u, int wr, int wc, int fr, int fq) const {
        const int row0 = u.pm * BM + wr * 64 + fr, col0 = u.pn * BM + wc * 32 + 8 * fq;
#pragma unroll
        for (int ai = 0; ai < 2; ++ai)
#pragma unroll
            for (int m = 0; m < 4; ++m) { bf16_t* rowp = O + (size_t)(row0 + ai * HALF + m * 16) * ldc + col0;
#pragma unroll
                for (int bj = 0; bj < 2; ++bj) { const f32x4 v0 = acc[ai][bj][m][0], v1 = acc[ai][bj][m][1];
                    u32x4 w; w.x = pack2(v0[0], v0[1]); w.y = pack2(v0[2], v0[3]); w.z = pack2(v1[0], v1[1]); w.w = pack2(v1[2], v1[3]);
                    *(u32x4*)(rowp + bj * HALF) = w; } }
    }
};
struct EpiF16P {
    static constexpr bool PERM = true;
    _Float16* O; int ldc;
    __device__ __forceinline__ void operator()(const f32x4 (&acc)[2][2][4][2], const Unit& u, int wr, int wc, int fr, int fq) const {
        typedef _Float16 h8v __attribute__((ext_vector_type(8)));
        const int row0 = u.pm * BM + wr * 64 + fr, col0 = u.pn * BM + wc * 32 + 8 * fq;
#pragma unroll
        for (int ai = 0; ai < 2; ++ai)
#pragma unroll
            for (int m = 0; m < 4; ++m) { _Float16* rowp = O + (size_t)(row0 + ai * HALF + m * 16) * ldc + col0;
#pragma unroll
                for (int bj = 0; bj < 2; ++bj) { const f32x4 v0 = acc[ai][bj][m][0], v1 = acc[ai][bj][m][1];
                    const h8v w = {(_Float16)v0[0], (_Float16)v0[1], (_Float16)v0[2], (_Float16)v0[3], (_Float16)v1[0], (_Float16)v1[1], (_Float16)v1[2], (_Float16)v1[3]};
                    *(h8v*)(rowp + bj * HALF) = w; } }
    }
};
struct EpiResid {
    static constexpr bool PERM = false;
    const float* xin; float* out; const float* mod;
    __device__ __forceinline__ void operator()(const f32x4 (&acc)[2][2][4][2], const Unit& u, int wr, int wc, int fr, int fq) const {
        const int row0 = u.pm * BM + wr * 64 + fr, col0 = u.pn * BM + wc * 32 + 4 * fq;
        const float* gm = mod + (size_t)(row0 >> 11) * 6144 + 2048 + col0;
        f32x4 g4[2][2];
#pragma unroll
        for (int bj = 0; bj < 2; ++bj)
#pragma unroll
            for (int n = 0; n < 2; ++n) g4[bj][n] = *(const f32x4*)(gm + bj * HALF + n * 16);
#pragma unroll
        for (int ai = 0; ai < 2; ++ai) {
            f32x4 xi[4][2][2];
#pragma unroll
            for (int m = 0; m < 4; ++m)
#pragma unroll
                for (int bj = 0; bj < 2; ++bj)
#pragma unroll
                    for (int n = 0; n < 2; ++n) xi[m][bj][n] = *(const f32x4*)(xin + (size_t)(row0 + ai * HALF + m * 16) * 1024 + col0 + bj * HALF + n * 16);
            asm volatile("" ::: "memory");
#pragma unroll
            for (int m = 0; m < 4; ++m)
#pragma unroll
                for (int bj = 0; bj < 2; ++bj)
#pragma unroll
                    for (int n = 0; n < 2; ++n)
                        *(f32x4*)(out + (size_t)(row0 + ai * HALF + m * 16) * 1024 + col0 + bj * HALF + n * 16) = xi[m][bj][n] + g4[bj][n] * acc[ai][bj][m][n];
            asm volatile("" ::: "memory");
        }
    }
};
struct EpiMerge {
    static constexpr bool PERM = true;
    bf16_t* Hm; const bf16_t* Z;
    __device__ __forceinline__ void operator()(const f32x4 (&acc)[2][2][4][2], const Unit& u, int wr, int wc, int fr, int fq) const {
        const int row0 = u.pm * BM + wr * 64 + fr, col0 = u.pn * BM + wc * 32 + 8 * fq, g = u.aux;
#pragma unroll
        for (int ai = 0; ai < 2; ++ai) {
            u32x4 gz[4][2], prev[4][2];
#pragma unroll
            for (int m = 0; m < 4; ++m)
#pragma unroll
                for (int bj = 0; bj < 2; ++bj) {
                    const int row = row0 + ai * HALF + m * 16, col = col0 + bj * HALF;
                    gz[m][bj] = *(const u32x4*)(Z + (size_t)row * LDZ + ZM + g * 1024 + col);
                    prev[m][bj] = u32x4{0u, 0u, 0u, 0u};
                    if (g > 0) prev[m][bj] = *(const u32x4*)(Hm + (size_t)row * 1024 + col);
                }
            asm volatile("" ::: "memory");
#pragma unroll
            for (int m = 0; m < 4; ++m)
#pragma unroll
                for (int bj = 0; bj < 2; ++bj) {
                    const int row = row0 + ai * HALF + m * 16, col = col0 + bj * HALF;
                    const f32x4 v0 = acc[ai][bj][m][0], v1 = acc[ai][bj][m][1];
                    const u32x4 z_ = gz[m][bj], p_ = prev[m][bj];
                    u32x4 w;
                    w.x = pack2(bflo(p_.x) + sigm(bflo(z_.x)) * v0[0], bfhi(p_.x) + sigm(bfhi(z_.x)) * v0[1]);
                    w.y = pack2(bflo(p_.y) + sigm(bflo(z_.y)) * v0[2], bfhi(p_.y) + sigm(bfhi(z_.y)) * v0[3]);
                    w.z = pack2(bflo(p_.z) + sigm(bflo(z_.z)) * v1[0], bfhi(p_.z) + sigm(bfhi(z_.z)) * v1[1]);
                    w.w = pack2(bflo(p_.w) + sigm(bflo(z_.w)) * v1[2], bfhi(p_.w) + sigm(bfhi(z_.w)) * v1[3]);
                    *(u32x4*)(Hm + (size_t)row * 1024 + col) = w;
                }
            asm volatile("" ::: "memory");
        }
    }
};
}

struct EpiZ {
    bf16_t* Z; int ld;
    __device__ __forceinline__ void operator()(int m, int n, const f32x4& v) const {
        uint2 o; o.x = pack2(v[0], v[1]); o.y = pack2(v[2], v[3]);
        *(uint2*)(Z + (size_t)m * ld + n) = o;
    }
};
struct EpiF16 {
    _Float16* C; int ld;
    __device__ __forceinline__ void operator()(int m, int n, const f32x4& v) const {
        typedef _Float16 h4 __attribute__((ext_vector_type(4)));
        h4 o = {(_Float16)v[0], (_Float16)v[1], (_Float16)v[2], (_Float16)v[3]};
        *(h4*)(C + (size_t)m * ld + n) = o;
    }
};
struct EpiOut {
    const float* xin; float* out; const float* mod;
    __device__ __forceinline__ void operator()(int m, int n, const f32x4& v) const {
        int b = m >> 11;
        float4 g = *(const float4*)(mod + (size_t)b * 6144 + 2048 + n);
        float4 xi = *(const float4*)(xin + (size_t)m * 1024 + n);
        *(float4*)(out + (size_t)m * 1024 + n) = make_float4(xi.x + g.x * v[0], xi.y + g.y * v[1], xi.z + g.z * v[2], xi.w + g.w * v[3]);
    }
};

template <class Epi>
__device__ void gemm_phase(const bf16_t* A, int lda, const bf16_t* Bt, int ldb, int M, int N, int K, bool batched, Epi epi,
                           int vb0, int nvb, char* smem_, const int tid) {
    bf16_t* sA = (bf16_t*)smem_; bf16_t* sB = sA + GBM * GLS;
    const int lane = tid & 63, wave = tid >> 6, wm = wave >> 1, wn = wave & 1, fr = lane & 15, fq = lane >> 4;
    const int MT = M / GBM, NTL = N / GBN;
    for (int tile = vb0; tile < MT * NTL; tile += nvb) {
        int mt = tile % MT, nt = tile / MT;
        f32x4 acc[4][4];
#pragma unroll
        for (int a = 0; a < 4; ++a)
#pragma unroll
            for (int b = 0; b < 4; ++b) acc[a][b] = f32x4{0.f, 0.f, 0.f, 0.f};
        gemm_tile(batched ? A + nt * 128 : A, lda, Bt, ldb, K, mt * GBM, nt * GBN, sA, sB, acc, tid);
#pragma unroll
        for (int nf = 0; nf < 4; ++nf)
#pragma unroll
            for (int mf = 0; mf < 4; ++mf)
                epi(mt * GBM + wm * 64 + mf * 16 + fr, nt * GBN + wn * 64 + nf * 16 + fq * 4, acc[nf][mf]);
    }
}
__device__ __forceinline__ void sc_tile(const Params& p, int mt, int nt, char* smem_, const int tid) {
    bf16_t* sA = (bf16_t*)smem_; bf16_t* sB = sA + GBM * GLS;
    const int lane = tid & 63, wave = tid >> 6, wm = wave >> 1, wn = wave & 1, fr = lane & 15, fq = lane >> 4;
    f32x4 acc[4][4];
#pragma unroll
    for (int a = 0; a < 4; ++a)
#pragma unroll
        for (int b = 0; b < 4; ++b) acc[a][b] = f32x4{0.f, 0.f, 0.f, 0.f};
    gemm_tile((const bf16_t*)(p.ws + WS_QP) + nt * 128, 2048, (const bf16_t*)(p.ws + WS_SK), 128, 128, mt * GBM, nt * GBN, sA, sB, acc, tid);
    const EpiF16 epi{(_Float16*)(p.ws + WS_SC), 2048};
#pragma unroll
    for (int nf = 0; nf < 4; ++nf)
#pragma unroll
        for (int mf = 0; mf < 4; ++mf)
            epi(mt * GBM + wm * 64 + mf * 16 + fr, nt * GBN + wn * 64 + nf * 16 + fq * 4, acc[nf][mf]);
}

#define SCAN_SYNC() do { asm volatile("s_waitcnt lgkmcnt(0)" ::: "memory"); __builtin_amdgcn_s_barrier(); asm volatile("" ::: "memory"); } while (0)
template <int DK, bool GLA>
__device__ void scan2_item(const Params& p, int l, int b, int h, char* smem_) {
    constexpr int SEG = NT / DK, SLEN = 64 / SEG, KS = DK / 32, KT = DK / 16;
    constexpr int QS = DK + 8, BS = DK + 4, VS = 72;
    bf16_t* qs = (bf16_t*)smem_;
    bf16_t* ks = qs + 64 * QS;
    float* bs = (float*)(ks + 64 * QS);
    bf16_t* vt = (bf16_t*)(bs + 64 * BS);
    bf16_t* At = vt + 128 * VS;
    bf16_t* kht = At + 64 * VS;
    bf16_t* st = kht + DK * VS;
    float* segtot = (float*)(st + 128 * QS);
    float* blast = segtot + SEG * DK;
    const int tid = TIDX(), lane = tid & 63, wave = __builtin_amdgcn_readfirstlane(tid >> 6), fr = lane & 15, fq = lane >> 4;
    const int kl = tid % DK, seg = __builtin_amdgcn_readfirstlane(tid / DK);
    float lbv = 0.f, gbias = 0.f; float gu[16];
#pragma unroll
    for (int r = 0; r < 16; ++r) gu[r] = 0.f;
    if (GLA) {
#pragma unroll
        for (int r = 0; r < 16; ++r) gu[r] = p.gla_up[(size_t)(l * 16 + r) * 256 + h * 64 + kl];
        gbias = p.gla_bias[l * 256 + h * 64 + kl];
    } else if (l == 1) {
        float x0 = p.hgrn_lb[h * 128 + kl], x1 = p.hgrn_lb[512 + h * 128 + kl];
        lbv = 1.f / (1.f + expf(x0 - x1));
    }
    const float scale = GLA ? 0.125f : 0.08838834764831845f;
    const bf16_t* Zb = (const bf16_t*)(p.ws + WS_Z) + (size_t)(b * 2048) * LDZ;
    float* ssq = (float*)(smem_ + 152576);
    const int QCOL = (GLA ? ZC_Q : ZA_Q) + h * DK, KCOL = (GLA ? ZC_K : ZA_F) + h * DK, VCOL = (GLA ? ZC_V : ZA_I) + h * 128, GCOL = (GLA ? ZC_G : ZA_G) + h * 128;
    f32x4 sacc[KT];
#pragma unroll
    for (int i = 0; i < KT; ++i) sacc[i] = f32x4{0.f, 0.f, 0.f, 0.f};
    f32x4 gn4[4];
    {
        const float* gn = (GLA ? p.gla_on : p.hgrn_on) + l * 128 + (wave >> 2) * 64 + 4 * fq;
#pragma unroll
        for (int vi = 0; vi < 4; ++vi) gn4[vi] = *(const f32x4*)(gn + vi * 16);
    }
    for (int i = tid; i < 128 * QS / 2; i += NT) ((unsigned*)st)[i] = 0u;
    SCAN_SYNC();

    bf16_t rq[SLEN], rk[SLEN], rv[16];
    u32x4 rc0[GLA ? SLEN : 1], rc1[GLA ? SLEN : 1];
    const int v_ = tid & 127, sb_ = __builtin_amdgcn_readfirstlane(tid >> 7);
#define SCAN_FETCH(cc) do { const bf16_t* Zn_ = Zb + (size_t)((cc) * 64) * LDZ; \
        _Pragma("unroll") for (int i = 0; i < 16; ++i) rv[i] = Zn_[(size_t)(sb_ + 4 * i) * LDZ + VCOL + v_]; \
        _Pragma("unroll") for (int i = 0; i < SLEN; ++i) { const bf16_t* zr = Zn_ + (size_t)(seg * SLEN + i) * LDZ; rq[i] = zr[QCOL + kl]; rk[i] = zr[KCOL + kl]; \
            if (GLA) { rc0[i] = *(const u32x4*)(zr + ZC_CODE); rc1[i] = *(const u32x4*)(zr + ZC_CODE + 8); } } } while (0)
    SCAN_FETCH(0);
    for (int c = 0; c < 32; ++c) {
        const bf16_t* Zc = Zb + (size_t)(c * 64) * LDZ;
        {
#pragma unroll
            for (int i = 0; i < 16; ++i) vt[v_ * VS + sb_ + 4 * i] = rv[i];
            float run = 0.f;
#pragma unroll
            for (int i = 0; i < SLEN; ++i) {
                const int s_ = seg * SLEN + i;
                float g, kk;
                if (GLA) {
                    float x = gbias;
#pragma unroll
                    for (int r = 0; r < 4; ++r) {
                        x += bflo(rc0[i][r]) * gu[2 * r] + bfhi(rc0[i][r]) * gu[2 * r + 1];
                        x += bflo(rc1[i][r]) * gu[8 + 2 * r] + bfhi(rc1[i][r]) * gu[8 + 2 * r + 1];
                    }
                    g = (fminf(x, 0.f) - __logf(1.f + __expf(-fabsf(x)))) * (1.f / 16.f);
                    kk = bf2f(rk[i]);
                } else {
                    const float f = lbv + (1.f - lbv) * __frcp_rn(1.f + __expf(-bf2f(rk[i])));
                    g = __logf(f); kk = 1.f - f;
                }
                run += g;
                bs[s_ * BS + kl] = run;
                qs[s_ * QS + kl] = rq[i];
                ks[s_ * QS + kl] = f2bf(kk);
            }
            segtot[seg * DK + kl] = run;
            SCAN_FETCH(c < 31 ? c + 1 : 31);
        }
        SCAN_SYNC();
        {
            float pre = 0.f, tot = 0.f;
#pragma unroll
            for (int g_ = 0; g_ < SEG; ++g_) { const float v_ = segtot[g_ * DK + kl]; if (g_ < seg) pre += v_; tot += v_; }
            if (seg == 0) blast[kl] = tot;
            unsigned pk[SLEN / 2];
#pragma unroll
            for (int i = 0; i < SLEN; ++i) {
                const float bv = bs[(seg * SLEN + i) * BS + kl] + pre;
                bs[(seg * SLEN + i) * BS + kl] = bv;
                const float kh = bf2f(ks[(seg * SLEN + i) * QS + kl]) * __expf(tot - bv);
                if (i & 1) pk[i >> 1] |= ((unsigned)f2bf(kh)) << 16; else pk[i >> 1] = (unsigned)f2bf(kh);
            }
            unsigned* dst = (unsigned*)(kht + kl * VS + seg * SLEN);
#pragma unroll
            for (int i = 0; i < SLEN / 2; ++i) dst[i] = pk[i];
        }
        SCAN_SYNC();
        for (int blk = wave; blk < 10; blk += 8) {
            int bi, bj;
            if (blk < 1) { bi = 0; bj = 0; } else if (blk < 3) { bi = 1; bj = blk - 1; } else if (blk < 6) { bi = 2; bj = blk - 3; } else { bi = 3; bj = blk - 6; }
            f32x4 acc = f32x4{0.f, 0.f, 0.f, 0.f};
            const int srow = bj * 16 + fr, trow = bi * 16 + fr;
#pragma unroll
            for (int kk = 0; kk < KS; ++kk) {
                const int k0 = kk * 32 + fq * 8;
                float br[8];
                if (bi == 0) {
#pragma unroll
                    for (int j = 0; j < 8; ++j) br[j] = 0.f;
                } else {
                    const float4 r0 = *(const float4*)(bs + (bi * 16 - 1) * BS + k0), r1 = *(const float4*)(bs + (bi * 16 - 1) * BS + k0 + 4);
                    br[0] = r0.x; br[1] = r0.y; br[2] = r0.z; br[3] = r0.w; br[4] = r1.x; br[5] = r1.y; br[6] = r1.z; br[7] = r1.w;
                }
                const uint4 kq = *(const uint4*)(ks + srow * QS + k0), qq = *(const uint4*)(qs + trow * QS + k0);
                const float4 s0 = *(const float4*)(bs + srow * BS + k0), s1 = *(const float4*)(bs + srow * BS + k0 + 4);
                const float4 t0_ = *(const float4*)(bs + trow * BS + k0), t1_ = *(const float4*)(bs + trow * BS + k0 + 4);
                const float bsv[8] = {s0.x, s0.y, s0.z, s0.w, s1.x, s1.y, s1.z, s1.w}, btv[8] = {t0_.x, t0_.y, t0_.z, t0_.w, t1_.x, t1_.y, t1_.z, t1_.w};
                const unsigned kw[4] = {kq.x, kq.y, kq.z, kq.w}, qw[4] = {qq.x, qq.y, qq.z, qq.w};
                union { bf16x8 v; unsigned u[4]; } ka, qb;
#pragma unroll
                for (int j = 0; j < 4; ++j) {
                    const float e0 = __expf(fminf(br[2 * j] - bsv[2 * j], 60.f)), e1 = __expf(fminf(br[2 * j + 1] - bsv[2 * j + 1], 60.f));
                    ka.u[j] = pack2(bflo(kw[j]) * e0, bfhi(kw[j]) * e1);
                    const float f0 = __expf(btv[2 * j] - br[2 * j]), f1 = __expf(btv[2 * j + 1] - br[2 * j + 1]);
                    qb.u[j] = pack2(bflo(qw[j]) * f0, bfhi(qw[j]) * f1);
                }
                acc = __builtin_amdgcn_mfma_f32_16x16x32_bf16(ka.v, qb.v, acc, 0, 0, 0);
            }
            if (bi == bj) {
#pragma unroll
                for (int r = 0; r < 4; ++r) if (4 * fq + r > fr) acc[r] = 0.f;
            }
            uint2 o; o.x = pack2(acc[0], acc[1]); o.y = pack2(acc[2], acc[3]);
            *(uint2*)(At + trow * VS + bj * 16 + 4 * fq) = o;
        }
        {
            unsigned z_ = 0u; asm volatile("" : "+v"(z_));
            if (wave == 2) *(uint2*)(At + (0 * 16 + fr) * VS + 16 + 4 * fq) = make_uint2(z_, z_);
            if (wave == 3) *(uint2*)(At + (2 * 16 + fr) * VS + 48 + 4 * fq) = make_uint2(z_, z_);
        }
        SCAN_SYNC();
        f32x4 oacc[4]; uint2 gz[4];
        {
            const int ti = wave & 3, vh = wave >> 2, trow = ti * 16 + fr;
            bf16x8 qh[KS];
#pragma unroll
            for (int kk = 0; kk < KS; ++kk) {
                const int k0 = kk * 32 + fq * 8;
                const uint4 qq = *(const uint4*)(qs + trow * QS + k0);
                const float4 t0_ = *(const float4*)(bs + trow * BS + k0), t1_ = *(const float4*)(bs + trow * BS + k0 + 4);
                union { bf16x8 v; unsigned u[4]; } q_;
                q_.u[0] = pack2(bflo(qq.x) * __expf(t0_.x), bfhi(qq.x) * __expf(t0_.y));
                q_.u[1] = pack2(bflo(qq.y) * __expf(t0_.z), bfhi(qq.y) * __expf(t0_.w));
                q_.u[2] = pack2(bflo(qq.z) * __expf(t1_.x), bfhi(qq.z) * __expf(t1_.y));
                q_.u[3] = pack2(bflo(qq.w) * __expf(t1_.z), bfhi(qq.w) * __expf(t1_.w));
                qh[kk] = q_.v;
            }
            const bf16x8 af0 = *(const bf16x8*)(At + trow * VS + fq * 8), af1 = *(const bf16x8*)(At + trow * VS + 32 + fq * 8);
            float sq = 0.f;
#pragma unroll
            for (int vi = 0; vi < 4; ++vi) {
                const int vrow = vh * 64 + vi * 16 + fr;
                gz[vi] = *(const uint2*)(Zc + (size_t)trow * LDZ + GCOL + vh * 64 + vi * 16 + 4 * fq);
                f32x4 acc = f32x4{0.f, 0.f, 0.f, 0.f};
                acc = __builtin_amdgcn_mfma_f32_16x16x32_bf16(*(const bf16x8*)(vt + vrow * VS + fq * 8), af0, acc, 0, 0, 0);
                if (ti >= 2) acc = __builtin_amdgcn_mfma_f32_16x16x32_bf16(*(const bf16x8*)(vt + vrow * VS + 32 + fq * 8), af1, acc, 0, 0, 0);
#pragma unroll
                for (int kk = 0; kk < KS; ++kk)
                    acc = __builtin_amdgcn_mfma_f32_16x16x32_bf16(*(const bf16x8*)(st + vrow * QS + kk * 32 + fq * 8), qh[kk], acc, 0, 0, 0);
                oacc[vi] = acc * scale;
                sq += oacc[vi][0] * oacc[vi][0] + oacc[vi][1] * oacc[vi][1] + oacc[vi][2] * oacc[vi][2] + oacc[vi][3] * oacc[vi][3];
            }
            sq += shx<16>(sq); sq += shx<32>(sq);
            if (fq == 0) ssq[vh * 64 + trow] = sq;
        }
        {
            const int vrow = wave * 16 + fr;
            const bf16x8 vf0 = *(const bf16x8*)(vt + vrow * VS + fq * 8), vf1 = *(const bf16x8*)(vt + vrow * VS + 32 + fq * 8);
#pragma unroll
            for (int kt = 0; kt < KT; ++kt) {
                const float dec = __expf(blast[kt * 16 + fr]);
                sacc[kt][0] *= dec; sacc[kt][1] *= dec; sacc[kt][2] *= dec; sacc[kt][3] *= dec;
                sacc[kt] = __builtin_amdgcn_mfma_f32_16x16x32_bf16(vf0, *(const bf16x8*)(kht + (kt * 16 + fr) * VS + fq * 8), sacc[kt], 0, 0, 0);
                sacc[kt] = __builtin_amdgcn_mfma_f32_16x16x32_bf16(vf1, *(const bf16x8*)(kht + (kt * 16 + fr) * VS + 32 + fq * 8), sacc[kt], 0, 0, 0);
            }
        }
        SCAN_SYNC();
#pragma unroll
        for (int kt = 0; kt < KT; ++kt)
#pragma unroll
            for (int r = 0; r < 4; ++r) st[(wave * 16 + 4 * fq + r) * QS + kt * 16 + fr] = f2bf(sacc[kt][r]);
        {
            const int ti = wave & 3, vh = wave >> 2, trow = ti * 16 + fr;
            const float rstd = rsqrtf((ssq[trow] + ssq[64 + trow]) * (1.f / 128.f) + 1e-6f);
            bf16_t* yrow = (bf16_t*)(p.ws + WS_Y) + (size_t)(b * 2048 + c * 64 + trow) * 1536 + (GLA ? 1024 : 0) + h * 128 + vh * 64 + 4 * fq;
#pragma unroll
            for (int vi = 0; vi < 4; ++vi) {
                const f32x4 g4_ = gn4[vi]; const float4 g4 = make_float4(g4_[0], g4_[1], g4_[2], g4_[3]);
                const float z0 = bflo(gz[vi].x), z1 = bfhi(gz[vi].x), z2 = bflo(gz[vi].y), z3 = bfhi(gz[vi].y);
                uint2 o;
                o.x = pack2(oacc[vi][0] * rstd * g4.x * (z0 * sigm(z0)), oacc[vi][1] * rstd * g4.y * (z1 * sigm(z1)));
                o.y = pack2(oacc[vi][2] * rstd * g4.z * (z2 * sigm(z2)), oacc[vi][3] * rstd * g4.w * (z3 * sigm(z3)));
                *(uint2*)(yrow + vi * 16) = o;
            }
        }
    }
    SCAN_SYNC();
#undef SCAN_FETCH
}

__device__ void dsaprep2_item(const Params& p, int l, int item, char* smem_) {
    bf16_t* tile = (bf16_t*)smem_;
    const int tid = TIDX(), lane = tid & 63, wave = tid >> 6;
    bf16_t* Z = (bf16_t*)(p.ws + WS_Z); bf16_t* VT = (bf16_t*)(p.ws + WS_VT);
    {
        const int tb = item * 32;
        {
            const float2 gq = *(const float2*)(p.dsa_qn + l * 128 + lane * 2), gk = *(const float2*)(p.dsa_kn + l * 128 + lane * 2);
            unsigned uu[4][8];
#pragma unroll
            for (int j = 0; j < 4; ++j)
#pragma unroll
                for (int grp = 0; grp < 8; ++grp)
                    uu[j][grp] = *(const unsigned*)(Z + (size_t)(tb + wave + 8 * j) * LDZ + (grp < 4 ? ZB_Q : ZB_K) + (grp & 3) * 128 + lane * 2);
#pragma unroll
            for (int j = 0; j < 4; ++j)
#pragma unroll
                for (int grp = 0; grp < 8; ++grp) {
                    bf16_t* ptr = Z + (size_t)(tb + wave + 8 * j) * LDZ + (grp < 4 ? ZB_Q : ZB_K) + (grp & 3) * 128 + lane * 2;
                    const float a = bflo(uu[j][grp]), b = bfhi(uu[j][grp]);
                    const float ss = wave_sum(a * a + b * b);
                    const float r = rsqrtf(ss * (1.f / 128.f) + 1e-6f) * ((grp < 4) ? 0.08838834764831845f : 1.f);
                    const float2 g = (grp < 4) ? gq : gk;
                    __hip_atomic_store((unsigned*)ptr, pack2(a * r * g.x, b * r * g.y), __ATOMIC_RELAXED, __HIP_MEMORY_SCOPE_AGENT);
                }
        }
        u32x4 uv[4];
#pragma unroll
        for (int i = 0; i < 4; ++i) { const int ch = tid + i * 512; uv[i] = *(const u32x4*)(Z + (size_t)(tb + (ch >> 6)) * LDZ + ZB_V + (ch & 63) * 8); }
#pragma unroll
        for (int i = 0; i < 4; ++i) {
            const int ch = tid + i * 512, t = ch >> 6, c8 = (ch & 63) * 8;
            unsigned* d = (unsigned*)(tile + t * 514 + c8);
            d[0] = uv[i][0]; d[1] = uv[i][1]; d[2] = uv[i][2]; d[3] = uv[i][3];
        }
        __syncthreads();
        {
            const int c = tid, b = tb >> 11, s0 = tb & 2047;
            unsigned w[16];
#pragma unroll
            for (int j = 0; j < 16; ++j) w[j] = (unsigned)tile[(2 * j) * 514 + c] | ((unsigned)tile[(2 * j + 1) * 514 + c] << 16);
            unsigned long long* dst = (unsigned long long*)(VT + ((size_t)(b * 512 + c)) * 2048 + s0);
#pragma unroll
            for (int j = 0; j < 8; ++j) __hip_atomic_store(dst + j, ((unsigned long long)w[2 * j + 1] << 32) | w[2 * j], __ATOMIC_RELAXED, __HIP_MEMORY_SCOPE_AGENT);
        }
        __syncthreads();
    }
}

__device__ void dsa_select_tile(const Params& p, int b, int tq, char* smem_) {
    constexpr int KS_ = 2052;
    unsigned* keyL = (unsigned*)smem_;
    const int tid = TIDX(), lane = tid & 63, wave = __builtin_amdgcn_readfirstlane(tid >> 6), fr = lane & 15, fq = lane >> 4;
    const bf16_t* Z = (const bf16_t*)(p.ws + WS_Z);
    unsigned long long* BM64 = (unsigned long long*)(p.ws + WS_BM);
    const int t0 = tq * 16;
    {
        const int tl = t0 + fr;
        const size_t trow = (size_t)b * 2048 + tl;
        bf16x8 qf[4][2];
#pragma unroll
        for (int h = 0; h < 4; ++h)
#pragma unroll
            for (int ks = 0; ks < 2; ++ks) qf[h][ks] = *(const bf16x8*)(Z + trow * LDZ + ZB_QI + h * 64 + ks * 32 + fq * 8);
        float w[4];
#pragma unroll
        for (int h = 0; h < 4; ++h) w[h] = bf2f(Z[trow * LDZ + ZB_WI + h]) * 0.5f;
#pragma unroll 4
        for (int kt = wave; kt <= tq; kt += 8) {
            const bf16_t* kr = Z + ((size_t)b * 2048 + kt * 16 + fr) * LDZ + ZB_KI + fq * 8;
            const bf16x8 k0 = *(const bf16x8*)kr, k1 = *(const bf16x8*)(kr + 32);
            f32x4 acc[4];
#pragma unroll
            for (int h = 0; h < 4; ++h) {
                acc[h] = __builtin_amdgcn_mfma_f32_16x16x32_bf16(k0, qf[h][0], f32x4{0.f, 0.f, 0.f, 0.f}, 0, 0, 0);
                acc[h] = __builtin_amdgcn_mfma_f32_16x16x32_bf16(k1, qf[h][1], acc[h], 0, 0, 0);
            }
            u32x4 kk;
#pragma unroll
            for (int r = 0; r < 4; ++r) {
                float sc = w[0] * fmaxf(acc[0][r] * 0.125f, 0.f) + w[1] * fmaxf(acc[1][r] * 0.125f, 0.f) + w[2] * fmaxf(acc[2][r] * 0.125f, 0.f) + w[3] * fmaxf(acc[3][r] * 0.125f, 0.f);
                if (sc == 0.f) sc = 0.f;
                const unsigned u = __float_as_uint(sc);
                const unsigned k = (u & 0x80000000u) ? ~u : (u | 0x80000000u);
                kk[r] = (kt * 16 + 4 * fq + r <= tl) ? k : 0u;
            }
            *(u32x4*)(keyL + fr * KS_ + kt * 16 + 4 * fq) = kk;
        }
    }
    __syncthreads();
    {
        const int nk = (tq + 1) * 16, jmax = (nk + 63) >> 6;
        const int qa = 2 * wave, qb = qa + 1;
        unsigned ka[32], kb[32];
#pragma unroll
        for (int j = 0; j < 32; ++j) {
            const int s = lane + 64 * j;
            ka[j] = (s < nk) ? keyL[qa * KS_ + s] : 0u;
            kb[j] = (s < nk) ? keyL[qb * KS_ + s] : 0u;
        }
        unsigned Ta = 1u, Tb = 1u; int Ca = 2047, Cb = 2047;
        if (t0 >= 256) {
            int na, nb;
            bool da, db;
            {
                int c0 = 0, c1 = 0, c2 = 0, c3 = 0;
#pragma unroll
                for (int j = 0; j < 32; ++j)
                    if (j < jmax) { c0 += (ka[j] >= 0x80000000u); c1 += (ka[j] > 0x80000000u); c2 += (kb[j] >= 0x80000000u); c3 += (kb[j] > 0x80000000u); }
                c0 = wave_total_i(c0); c1 = wave_total_i(c1); c2 = wave_total_i(c2); c3 = wave_total_i(c3);
                da = (c1 < 256 && c0 >= 256); db = (c3 < 256 && c2 >= 256);
                Ta = da ? 0x80000000u : ((c0 >= 256) ? 0x80000000u : 0u); na = da ? c0 : ((c0 >= 256) ? c0 : 0x7fffffff);
                Tb = db ? 0x80000000u : ((c2 >= 256) ? 0x80000000u : 0u); nb = db ? c2 : ((c2 >= 256) ? c2 : 0x7fffffff);
            }
            for (int bit = 30; bit >= 0; --bit) {
                if (da && db) break;
                const unsigned ca_ = Ta | (1u << bit), cb_ = Tb | (1u << bit);
                int c0 = 0, c1 = 0;
#pragma unroll
                for (int j = 0; j < 32; ++j)
                    if (j < jmax) { c0 += (ka[j] >= ca_); c1 += (kb[j] >= cb_); }
                c0 = wave_total_i(c0); c1 = wave_total_i(c1);
                if (!da && c0 >= 256) { Ta = ca_; na = c0; }
                if (!db && c1 >= 256) { Tb = cb_; nb = c1; }
                da = da || (na == 256); db = db || (nb == 256);
            }
            if (na != 256 || nb != 256) {
                int needa, needb;
                {
                    int c0 = 0, c1 = 0;
#pragma unroll
                    for (int j = 0; j < 32; ++j)
                        if (j < jmax) { c0 += (ka[j] > Ta); c1 += (kb[j] > Tb); }
                    needa = 256 - wave_total_i(c0); needb = 256 - wave_total_i(c1);
                }
                Ca = 0; Cb = 0;
                for (int bit = 10; bit >= 0; --bit) {
                    const int ca_ = Ca | (1 << bit), cb_ = Cb | (1 << bit);
                    int c0 = 0, c1 = 0;
#pragma unroll
                    for (int j = 0; j < 32; ++j)
                        if (j < jmax) { const int s = lane + 64 * j; c0 += (ka[j] == Ta && s < ca_); c1 += (kb[j] == Tb && s < cb_); }
                    c0 = wave_total_i(c0); c1 = wave_total_i(c1);
                    if (c0 < needa) Ca = ca_;
                    if (c1 < needb) Cb = cb_;
                }
            }
        }
        const size_t rowa = (size_t)b * 2048 + t0 + qa;
#pragma unroll
        for (int j = 0; j < 32; ++j) {
            const int s = lane + 64 * j;
            const unsigned long long ma = __ballot((ka[j] > Ta) || (ka[j] == Ta && s <= Ca));
            const unsigned long long mb = __ballot((kb[j] > Tb) || (kb[j] == Tb && s <= Cb));
            if (lane == 0) {
                __hip_atomic_store(&BM64[rowa * 32 + j], ma, __ATOMIC_RELAXED, __HIP_MEMORY_SCOPE_AGENT);
                __hip_atomic_store(&BM64[(rowa + 1) * 32 + j], mb, __ATOMIC_RELAXED, __HIP_MEMORY_SCOPE_AGENT);
            }
        }
    }
    __syncthreads();
}

__device__ void dsa_attn_item(const Params& p, int b, int h, int qg, char* smem_) {
    constexpr int KSTR = 136, VSTR = 40;
    bf16_t* Kl = (bf16_t*)smem_;
    bf16_t* Vl = Kl + 2 * 32 * KSTR;
    const int tid = TIDX(), lane = tid & 63, wave = __builtin_amdgcn_readfirstlane(tid >> 6), fr = lane & 15, fq = lane >> 4;
    const bf16_t* Z = (const bf16_t*)(p.ws + WS_Z); const bf16_t* VT = (const bf16_t*)(p.ws + WS_VT);
    const unsigned* BM = (const unsigned*)(p.ws + WS_BM); bf16_t* Y = (bf16_t*)(p.ws + WS_Y);
    const int kr = tid >> 4, kc = tid & 15, vd = tid >> 2, vc = tid & 3;
    const int ka_row = 8 * (fr >> 2) + (fr & 3);
    {
        const int t0 = qg * 128 + wave * 16;
        const size_t trow = (size_t)b * 2048 + t0 + fr;
        bf16x8 qf[4];
#pragma unroll
        for (int ks = 0; ks < 4; ++ks) qf[ks] = *(const bf16x8*)(Z + trow * LDZ + ZB_Q + h * 128 + ks * 32 + fq * 8);
        f32x4 o[8];
#pragma unroll
        for (int i = 0; i < 8; ++i) o[i] = f32x4{0.f, 0.f, 0.f, 0.f};
        float m = -INFINITY, lsum = 0.f;
        const unsigned* bmrow = BM + trow * 64;
        const int nsteps_blk = qg * 4 + 4, nsteps_w = (t0 + 15) / 32 + 1;
        const bf16_t* kg = Z + ((size_t)b * 2048 + kr) * LDZ + ZB_K + h * 128 + kc * 8;
        const bf16_t* vg = VT + ((size_t)(b * 4 + h) * 128 + vd) * 2048 + vc * 8;
        u32x4 rk = *(const u32x4*)kg, rv = *(const u32x4*)vg;
        *(u32x4*)(Kl + kr * KSTR + kc * 8) = rk; *(u32x4*)(Vl + vd * VSTR + vc * 8) = rv;
        __syncthreads();
        unsigned mwn = bmrow[0];
        for (int st = 0; st < nsteps_blk; ++st) {
            const bool more = (st + 1 < nsteps_blk);
            const unsigned mwc = mwn;
            mwn = bmrow[(st + 1 < nsteps_w) ? st + 1 : st];
            if (more) { rk = *(const u32x4*)(kg + (size_t)(st + 1) * 32 * LDZ); rv = *(const u32x4*)(vg + (st + 1) * 32); }
            if (st < nsteps_w) {
                const bf16_t* Kb = Kl + (st & 1) * 32 * KSTR; const bf16_t* Vb = Vl + (st & 1) * 128 * VSTR;
                f32x4 sa = f32x4{0.f, 0.f, 0.f, 0.f}, sb = f32x4{0.f, 0.f, 0.f, 0.f};
#pragma unroll
                for (int ks = 0; ks < 4; ++ks) {
                    const bf16x8 fa = *(const bf16x8*)(Kb + ka_row * KSTR + ks * 32 + fq * 8), fb = *(const bf16x8*)(Kb + (ka_row + 4) * KSTR + ks * 32 + fq * 8);
                    sa = __builtin_amdgcn_mfma_f32_16x16x32_bf16(fa, qf[ks], sa, 0, 0, 0);
                    sb = __builtin_amdgcn_mfma_f32_16x16x32_bf16(fb, qf[ks], sb, 0, 0, 0);
                }
                const unsigned mw = mwc >> (8 * fq);
                float x[8];
#pragma unroll
                for (int r = 0; r < 4; ++r) { x[r] = ((mw >> r) & 1u) ? sa[r] : -INFINITY; x[4 + r] = ((mw >> (4 + r)) & 1u) ? sb[r] : -INFINITY; }
                float mx = fmaxf(fmaxf(fmaxf(x[0], x[1]), fmaxf(x[2], x[3])), fmaxf(fmaxf(x[4], x[5]), fmaxf(x[6], x[7])));
                mx = fmaxf(mx, shx<16>(mx)); mx = fmaxf(mx, shx<32>(mx));
                const float mnew = fmaxf(m, mx);
                const float msafe = (mnew == -INFINITY) ? 0.f : mnew;
                const float alpha = __expf(m - msafe);
                float pe[8]; float ps = 0.f;
#pragma unroll
                for (int j = 0; j < 8; ++j) { pe[j] = __expf(x[j] - msafe); ps += pe[j]; }
                lsum = lsum * alpha + ps;
                m = mnew;
#pragma unroll
                for (int i = 0; i < 8; ++i) { o[i][0] *= alpha; o[i][1] *= alpha; o[i][2] *= alpha; o[i][3] *= alpha; }
                union { bf16x8 v; unsigned u[4]; } pf;
                pf.u[0] = pack2(pe[0], pe[1]); pf.u[1] = pack2(pe[2], pe[3]); pf.u[2] = pack2(pe[4], pe[5]); pf.u[3] = pack2(pe[6], pe[7]);
#pragma unroll
                for (int i = 0; i < 8; ++i) {
                    const bf16x8 vf = *(const bf16x8*)(Vb + (i * 16 + fr) * VSTR + fq * 8);
                    o[i] = __builtin_amdgcn_mfma_f32_16x16x32_bf16(vf, pf.v, o[i], 0, 0, 0);
                }
            }
            if (more) { *(u32x4*)(Kl + ((st + 1) & 1) * 32 * KSTR + kr * KSTR + kc * 8) = rk; *(u32x4*)(Vl + ((st + 1) & 1) * 128 * VSTR + vd * VSTR + vc * 8) = rv; }
            __syncthreads();
        }
        lsum += shx<16>(lsum); lsum += shx<32>(lsum);
        const float inv = 1.f / lsum;
#pragma unroll
        for (int i = 0; i < 8; ++i) {
            uint2 ov; ov.x = pack2(o[i][0] * inv, o[i][1] * inv); ov.y = pack2(o[i][2] * inv, o[i][3] * inv);
            *(uint2*)(Y + trow * 1536 + 512 + h * 128 + i * 16 + 4 * fq) = ov;
        }
    }
}

constexpr int LDS_BYTES = 155648;
__device__ void ph_mixA(const Params& p, int l, int vb0, int nvb, char* smem_) {
    for (int item = vb0; item < 64; item += nvb) {
        if (item < 32) scan2_item<128, false>(p, l, item >> 2, item & 3, smem_);
        else scan2_item<64, true>(p, l, (item - 32) >> 2, (item - 32) & 3, smem_);
    }
    unsigned* ctr = (unsigned*)(p.ws + WS_CTL) + 3584 + l * 64;
    unsigned* done = (unsigned*)(p.ws + WS_CTL) + 5300 + l * 8 * 16;
    volatile int* slot = (volatile int*)(smem_ + LDS_BYTES - 64);
    for (;;) {
        if (TIDX() == 0) *slot = (int)atomicAdd(ctr, 1u);
        __syncthreads();
        const int idx = __builtin_amdgcn_readfirstlane(*slot);
        __syncthreads();
        if (idx >= 2048) break;
        if (idx < 1536) {
            const int b = idx / 192, r = idx % 192;
            if (r < 128) dsa_select_tile(p, b, 127 - r, smem_);
            else dsaprep2_item(p, l, b * 64 + (r - 128), smem_);
            asm volatile("s_waitcnt vmcnt(0)" ::: "memory");
            __syncthreads();
            if (TIDX() == 0) __hip_atomic_fetch_add(done + b * 16, 1u, __ATOMIC_RELAXED, __HIP_MEMORY_SCOPE_AGENT);
        } else {
            const int a = idx - 1536, b = a >> 6, h = (a >> 4) & 3, qg = 15 - (a & 15);
            if (TIDX() == 0) {
                unsigned spins = 0;
                while (__hip_atomic_load(done + b * 16, __ATOMIC_RELAXED, __HIP_MEMORY_SCOPE_AGENT) < 192u) { __builtin_amdgcn_s_sleep(2); if (++spins > (1u << 18)) break; }
                __builtin_amdgcn_fence(__ATOMIC_ACQUIRE, "agent");
                asm volatile("s_waitcnt vmcnt(0)" ::: "memory");
            }
            __syncthreads();
            dsa_attn_item(p, b, h, qg, smem_);
        }
    }
}

__device__ __forceinline__ int f2sort(float f) { int i = __float_as_int(f); return i ^ ((i >> 31) & 0x7fffffff); }
__device__ __forceinline__ float sort2f(int i) { return __int_as_float(i ^ ((i >> 31) & 0x7fffffff)); }
#define INSK(K, xv) do { int _x = (xv); \
    _Pragma("unroll") for (int _j = 0; _j < 16; ++_j) { int _hi = max(K[_j], _x); _x = min(K[_j], _x); K[_j] = _hi; } } while (0)
#define INS64(K, xv) do { unsigned long long _x = (xv); \
    _Pragma("unroll") for (int _j = 0; _j < 16; ++_j) { bool _c = _x > K[_j]; unsigned long long _o = K[_j]; K[_j] = _c ? _x : _o; _x = _c ? _o : _x; } } while (0)

#define CE32(x, y) do { const int _h = max(x, y); y = min(x, y); x = _h; } while (0)
#define CE64(x, y) do { const bool _c = (y) > (x); const unsigned long long _t = x; x = _c ? y : x; y = _c ? _t : y; } while (0)
#define SORT16_I(K) do { CE32(K[0], K[1]); CE32(K[2], K[3]); CE32(K[4], K[5]); CE32(K[6], K[7]); CE32(K[8], K[9]); CE32(K[10], K[11]); CE32(K[12], K[13]); CE32(K[14], K[15]); CE32(K[0], K[2]); CE32(K[1], K[3]); CE32(K[4], K[6]); CE32(K[5], K[7]); CE32(K[8], K[10]); CE32(K[9], K[11]); CE32(K[12], K[14]); CE32(K[13], K[15]); CE32(K[1], K[2]); CE32(K[5], K[6]); CE32(K[9], K[10]); CE32(K[13], K[14]); CE32(K[0], K[4]); CE32(K[1], K[5]); CE32(K[2], K[6]); CE32(K[3], K[7]); CE32(K[8], K[12]); CE32(K[9], K[13]); CE32(K[10], K[14]); CE32(K[11], K[15]); CE32(K[2], K[4]); CE32(K[3], K[5]); CE32(K[10], K[12]); CE32(K[11], K[13]); CE32(K[1], K[2]); CE32(K[3], K[4]); CE32(K[5], K[6]); CE32(K[9], K[10]); CE32(K[11], K[12]); CE32(K[13], K[14]); CE32(K[0], K[8]); CE32(K[1], K[9]); CE32(K[2], K[10]); CE32(K[3], K[11]); CE32(K[4], K[12]); CE32(K[5], K[13]); CE32(K[6], K[14]); CE32(K[7], K[15]); CE32(K[4], K[8]); CE32(K[5], K[9]); CE32(K[6], K[10]); CE32(K[7], K[11]); CE32(K[2], K[4]); CE32(K[3], K[5]); CE32(K[6], K[8]); CE32(K[7], K[9]); CE32(K[10], K[12]); CE32(K[11], K[13]); CE32(K[1], K[2]); CE32(K[3], K[4]); CE32(K[5], K[6]); CE32(K[7], K[8]); CE32(K[9], K[10]); CE32(K[11], K[12]); CE32(K[13], K[14]); } while (0)
#define BITONIC16_I(K) do { CE32(K[0], K[8]); CE32(K[1], K[9]); CE32(K[2], K[10]); CE32(K[3], K[11]); CE32(K[4], K[12]); CE32(K[5], K[13]); CE32(K[6], K[14]); CE32(K[7], K[15]); CE32(K[0], K[4]); CE32(K[1], K[5]); CE32(K[2], K[6]); CE32(K[3], K[7]); CE32(K[8], K[12]); CE32(K[9], K[13]); CE32(K[10], K[14]); CE32(K[11], K[15]); CE32(K[0], K[2]); CE32(K[1], K[3]); CE32(K[4], K[6]); CE32(K[5], K[7]); CE32(K[8], K[10]); CE32(K[9], K[11]); CE32(K[12], K[14]); CE32(K[13], K[15]); CE32(K[0], K[1]); CE32(K[2], K[3]); CE32(K[4], K[5]); CE32(K[6], K[7]); CE32(K[8], K[9]); CE32(K[10], K[11]); CE32(K[12], K[13]); CE32(K[14], K[15]); } while (0)
#define SORT16_L(K) do { CE64(K[0], K[1]); CE64(K[2], K[3]); CE64(K[4], K[5]); CE64(K[6], K[7]); CE64(K[8], K[9]); CE64(K[10], K[11]); CE64(K[12], K[13]); CE64(K[14], K[15]); CE64(K[0], K[2]); CE64(K[1], K[3]); CE64(K[4], K[6]); CE64(K[5], K[7]); CE64(K[8], K[10]); CE64(K[9], K[11]); CE64(K[12], K[14]); CE64(K[13], K[15]); CE64(K[1], K[2]); CE64(K[5], K[6]); CE64(K[9], K[10]); CE64(K[13], K[14]); CE64(K[0], K[4]); CE64(K[1], K[5]); CE64(K[2], K[6]); CE64(K[3], K[7]); CE64(K[8], K[12]); CE64(K[9], K[13]); CE64(K[10], K[14]); CE64(K[11], K[15]); CE64(K[2], K[4]); CE64(K[3], K[5]); CE64(K[10], K[12]); CE64(K[11], K[13]); CE64(K[1], K[2]); CE64(K[3], K[4]); CE64(K[5], K[6]); CE64(K[9], K[10]); CE64(K[11], K[12]); CE64(K[13], K[14]); CE64(K[0], K[8]); CE64(K[1], K[9]); CE64(K[2], K[10]); CE64(K[3], K[11]); CE64(K[4], K[12]); CE64(K[5], K[13]); CE64(K[6], K[14]); CE64(K[7], K[15]); CE64(K[4], K[8]); CE64(K[5], K[9]); CE64(K[6], K[10]); CE64(K[7], K[11]); CE64(K[2], K[4]); CE64(K[3], K[5]); CE64(K[6], K[8]); CE64(K[7], K[9]); CE64(K[10], K[12]); CE64(K[11], K[13]); CE64(K[1], K[2]); CE64(K[3], K[4]); CE64(K[5], K[6]); CE64(K[7], K[8]); CE64(K[9], K[10]); CE64(K[11], K[12]); CE64(K[13], K[14]); } while (0)
#define BITONIC16_L(K) do { CE64(K[0], K[8]); CE64(K[1], K[9]); CE64(K[2], K[10]); CE64(K[3], K[11]); CE64(K[4], K[12]); CE64(K[5], K[13]); CE64(K[6], K[14]); CE64(K[7], K[15]); CE64(K[0], K[4]); CE64(K[1], K[5]); CE64(K[2], K[6]); CE64(K[3], K[7]); CE64(K[8], K[12]); CE64(K[9], K[13]); CE64(K[10], K[14]); CE64(K[11], K[15]); CE64(K[0], K[2]); CE64(K[1], K[3]); CE64(K[4], K[6]); CE64(K[5], K[7]); CE64(K[8], K[10]); CE64(K[9], K[11]); CE64(K[12], K[14]); CE64(K[13], K[15]); CE64(K[0], K[1]); CE64(K[2], K[3]); CE64(K[4], K[5]); CE64(K[6], K[7]); CE64(K[8], K[9]); CE64(K[10], K[11]); CE64(K[12], K[13]); CE64(K[14], K[15]); } while (0)
#define TOP16_I(R, G) do { _Pragma("unroll") for (int _j = 0; _j < 16; ++_j) R[_j] = max(R[_j], G[15 - _j]); BITONIC16_I(R); } while (0)
#define TOP16_L(R, G) do { _Pragma("unroll") for (int _j = 0; _j < 16; ++_j) R[_j] = (G[15 - _j] > R[_j]) ? G[15 - _j] : R[_j]; BITONIC16_L(R); } while (0)
__device__ void ph_route(const Params& p, int vb0, int nvb, char* smem_) {
    typedef _Float16 h8 __attribute__((ext_vector_type(8)));
    const _Float16* SC = (const _Float16*)(p.ws + WS_SC);
    int* RI = (int*)(p.ws + WS_RI); float* RG = (float*)(p.ws + WS_RG);
    const int tid = TIDX(), lane = tid & 63, wave = tid >> 6;
    _Float16* tile = (_Float16*)smem_ + wave * (64 * 72);
    for (int item0 = (vb0 * 8 + wave) * 64; item0 < T_TOK * 8; item0 += nvb * 8 * 64) {
        const int item = item0 + lane;
        const int t = item >> 3, h = item & 7;
        const _Float16* s0 = SC + (size_t)t * 2048 + h * 256;
        const _Float16* wbase = SC + (size_t)item0 * 256;
        int k0[16], k1[16];
#pragma unroll
        for (int j = 0; j < 16; ++j) { k0[j] = (int)0x80000000; k1[j] = (int)0x80000000; }
#pragma unroll 1
        for (int slab = 0; slab < 4; ++slab) {
            h8 ld[8];
#pragma unroll
            for (int j = 0; j < 4; ++j) {
                const _Float16* src = wbase + (size_t)(16 * j + (lane >> 2)) * 256 + slab * 32 + (lane & 3) * 8;
                ld[j] = *(const h8*)src; ld[4 + j] = *(const h8*)(src + 128);
            }
            __builtin_amdgcn_wave_barrier();
#pragma unroll
            for (int j = 0; j < 4; ++j) {
                _Float16* dst = tile + (16 * j + (lane >> 2)) * 72 + (lane & 3) * 8;
                *(h8*)dst = ld[j]; *(h8*)(dst + 32) = ld[4 + j];
            }
            __builtin_amdgcn_fence(__ATOMIC_RELEASE, "wavefront");
            __builtin_amdgcn_wave_barrier();
            __builtin_amdgcn_fence(__ATOMIC_ACQUIRE, "wavefront");
#pragma unroll
            for (int ii = 0; ii < 32; ii += 16) {
                const int i = slab * 32 + ii;
                const h8 a0 = *(const h8*)(tile + lane * 72 + ii), a1 = *(const h8*)(tile + lane * 72 + ii + 8);
                const h8 b0 = *(const h8*)(tile + lane * 72 + 32 + ii), b1 = *(const h8*)(tile + lane * 72 + 32 + ii + 8);
                int ga[16], gb[16];
#pragma unroll
                for (int e_ = 0; e_ < 8; ++e_) {
                    ga[e_] = (f2sort((float)a0[e_]) & ~127) | (127 - i - e_); ga[8 + e_] = (f2sort((float)a1[e_]) & ~127) | (127 - i - 8 - e_);
                    gb[e_] = (f2sort((float)b0[e_]) & ~127) | (127 - i - e_); gb[8 + e_] = (f2sort((float)b1[e_]) & ~127) | (127 - i - 8 - e_);
                }
                SORT16_I(ga); TOP16_I(k0, ga);
                SORT16_I(gb); TOP16_I(k1, gb);
            }
            __builtin_amdgcn_wave_barrier();
        }
        float v0[16], v1[16];
#pragma unroll
        for (int j = 0; j < 16; ++j) { k0[j] = 127 - (k0[j] & 127); k1[j] = 127 - (k1[j] & 127); v0[j] = (float)s0[k0[j]]; v1[j] = (float)s0[128 + k1[j]]; }
#define CAND(a, b) ((((unsigned long long)((unsigned)f2sort(v0[a] + v1[b]) ^ 0x80000000u)) << 32) | (((unsigned)(255 - ((a) * 16 + (b))) << 16) | (unsigned)(k0[a] * 128 + k1[b])))
        unsigned long long ck[16], m1[16], m2[16];
#pragma unroll
        for (int j = 0; j < 16; ++j) ck[j] = CAND(0, j);
#pragma unroll
        for (int j = 0; j < 8; ++j) { m1[j] = CAND(1, j); m1[8 + j] = CAND(15 - j, 0); }
        BITONIC16_L(m1);
        m2[0] = CAND(2, 0); m2[1] = CAND(2, 1); m2[2] = CAND(2, 2); m2[3] = CAND(2, 3); m2[4] = CAND(2, 4);
        m2[5] = CAND(3, 0); m2[6] = CAND(3, 1); m2[7] = CAND(3, 2); m2[8] = CAND(3, 3);
        m2[9] = CAND(4, 0); m2[10] = CAND(4, 1); m2[11] = CAND(4, 2);
        m2[12] = CAND(5, 0); m2[13] = CAND(5, 1); m2[14] = CAND(6, 0); m2[15] = CAND(6, 1);
        SORT16_L(m2);
        TOP16_L(ck, m1);
        TOP16_L(ck, m2);
        INS64(ck, CAND(7, 0)); INS64(ck, CAND(7, 1));
#undef CAND
        float e[16]; float sm = 0.f;
        const float mx = sort2f((int)((unsigned)(ck[0] >> 32) ^ 0x80000000u));
#pragma unroll
        for (int j = 0; j < 16; ++j) { e[j] = expf(sort2f((int)((unsigned)(ck[j] >> 32) ^ 0x80000000u)) - mx); sm += e[j]; }
        const float inv = 1.f / sm;
#pragma unroll
        for (int j = 0; j < 16; j += 4) {
            *(int4*)(RI + (size_t)t * 128 + h * 16 + j) = make_int4((int)(ck[j] & 0xffffu), (int)(ck[j + 1] & 0xffffu), (int)(ck[j + 2] & 0xffffu), (int)(ck[j + 3] & 0xffffu));
            *(float4*)(RG + (size_t)t * 128 + h * 16 + j) = make_float4(e[j] * inv, e[j + 1] * inv, e[j + 2] * inv, e[j + 3] * inv);
        }
    }
}

__device__ __forceinline__ void fp8x16_to_f32(const uint4 q, float (&f)[16]) {
    const unsigned w[4] = {q.x, q.y, q.z, q.w};
#pragma unroll
    for (int c = 0; c < 4; ++c) {
        auto f0 = __builtin_amdgcn_cvt_pk_f32_fp8((int)w[c], false); auto f1 = __builtin_amdgcn_cvt_pk_f32_fp8((int)w[c], true);
        f[4 * c] = f0[0]; f[4 * c + 1] = f0[1]; f[4 * c + 2] = f1[0]; f[4 * c + 3] = f1[1];
    }
}
constexpr bool G2_MFMA = true;
constexpr bool G1_MFMA = true;
typedef float f32x2_t __attribute__((ext_vector_type(2)));
__device__ __forceinline__ float g1_half(const u32x4 (&uq)[8], const float (&hv)[16], int lane) {
    float part[8];
#pragma unroll
    for (int it = 0; it < 8; ++it) {
        f32x2_t d2 = {0.f, 0.f};
#pragma unroll
        for (int c_ = 0; c_ < 4; ++c_) {
            const f32x2_t f0 = __builtin_amdgcn_cvt_pk_f32_fp8((int)uq[it][c_], false), f1 = __builtin_amdgcn_cvt_pk_f32_fp8((int)uq[it][c_], true);
            d2 = __builtin_elementwise_fma(f32x2_t{hv[4 * c_], hv[4 * c_ + 1]}, f0, d2);
            d2 = __builtin_elementwise_fma(f32x2_t{hv[4 * c_ + 2], hv[4 * c_ + 3]}, f1, d2);
        }
        part[it] = d2[0] + d2[1];
    }
    float r4[4], r2[2];
    const bool b2_ = lane & 4, b1_ = lane & 2, b0_ = lane & 1;
#pragma unroll
    for (int j = 0; j < 4; ++j) { const float snd = b2_ ? part[j] : part[j + 4], kp = b2_ ? part[j + 4] : part[j]; r4[j] = kp + shx<4>(snd); }
#pragma unroll
    for (int j = 0; j < 2; ++j) { const float snd = b1_ ? r4[j] : r4[j + 2], kp = b1_ ? r4[j + 2] : r4[j]; r2[j] = kp + shx<2>(snd); }
    const float snd = b0_ ? r2[0] : r2[1], kp = b0_ ? r2[1] : r2[0];
    return kp + shx<1>(snd);
}
__device__ __forceinline__ void peer_gather8(u32x4 (&q)[8], const unsigned char* tab, const int* idx, unsigned l16) {
#pragma unroll
    for (int it = 0; it < 8; ++it) { const unsigned e_ = (unsigned)idx[it * 8]; q[it] = *(const u32x4*)(tab + ((e_ << 7) | l16)); }
}
template <bool PRE>
__device__ __forceinline__ void g1_step(int i, int t, const bf16_t* hrow_next, const unsigned char* ub, const int* lri_eg, unsigned l16, int lane, float* pp_row,
                                        u32x4& hq0, u32x4& hq1, u32x4 (&uqA)[8], u32x4 (&uqB)[8]) {
    float hv[16];
#pragma unroll
    for (int c_ = 0; c_ < 4; ++c_) { hv[2 * c_] = bflo(hq0[c_]); hv[2 * c_ + 1] = bfhi(hq0[c_]); hv[8 + 2 * c_] = bflo(hq1[c_]); hv[8 + 2 * c_ + 1] = bfhi(hq1[c_]); }
    if (PRE) { const u32x4* hp = (const u32x4*)hrow_next; hq0 = hp[0]; hq1 = hp[1]; }
    const float d0 = g1_half(uqA, hv, lane);
    __builtin_amdgcn_sched_barrier(0);
    if (PRE) { peer_gather8(uqA, ub, lri_eg + (i + 1) * 128, l16); __builtin_amdgcn_sched_barrier(0); }
    const float d1 = g1_half(uqB, hv, lane);
    __builtin_amdgcn_sched_barrier(0);
    if (PRE) { peer_gather8(uqB, ub, lri_eg + (i + 1) * 128 + 64, l16); __builtin_amdgcn_sched_barrier(0); }
    pp_row[0] = d0; pp_row[64] = d1;
}
template <bool PRE>
__device__ __forceinline__ void g2_step(int i, float2* op, const float2 gf, const unsigned char* vb_, const int* lri_eg, const float* lrg_eg, unsigned l16, int lane,
                                        u32x4 (&vqA)[8], u32x4 (&vqB)[8]) {
    const float2 xi = *op;
    f32x2_t y[8];
#pragma unroll
    for (int j = 0; j < 8; ++j) y[j] = f32x2_t{0.f, 0.f};
#pragma unroll
    for (int it = 0; it < 8; ++it) {
        const float ck = lrg_eg[i * 128 + it * 8]; const f32x2_t ck2 = {ck, ck};
#pragma unroll
        for (int c_ = 0; c_ < 4; ++c_) {
            y[2 * c_] = __builtin_elementwise_fma(ck2, __builtin_amdgcn_cvt_pk_f32_fp8((int)vqA[it][c_], false), y[2 * c_]);
            y[2 * c_ + 1] = __builtin_elementwise_fma(ck2, __builtin_amdgcn_cvt_pk_f32_fp8((int)vqA[it][c_], true), y[2 * c_ + 1]);
        }
    }
    __builtin_amdgcn_sched_barrier(0);
    if (PRE) { peer_gather8(vqA, vb_, lri_eg + (i + 1) * 128, l16); __builtin_amdgcn_sched_barrier(0); }
#pragma unroll
    for (int it = 0; it < 8; ++it) {
        const float ck = lrg_eg[i * 128 + 64 + it * 8]; const f32x2_t ck2 = {ck, ck};
#pragma unroll
        for (int c_ = 0; c_ < 4; ++c_) {
            y[2 * c_] = __builtin_elementwise_fma(ck2, __builtin_amdgcn_cvt_pk_f32_fp8((int)vqB[it][c_], false), y[2 * c_]);
            y[2 * c_ + 1] = __builtin_elementwise_fma(ck2, __builtin_amdgcn_cvt_pk_f32_fp8((int)vqB[it][c_], true), y[2 * c_ + 1]);
        }
    }
    __builtin_amdgcn_sched_barrier(0);
    if (PRE) { peer_gather8(vqB, vb_, lri_eg + (i + 1) * 128 + 64, l16); __builtin_amdgcn_sched_barrier(0); }
    float r8[8], r4[4], r2[2];
    const bool b5 = lane & 32, b4 = lane & 16, b3 = lane & 8;
#pragma unroll
    for (int j = 0; j < 8; ++j) { const float lo = y[j >> 1][j & 1], hi = y[4 + (j >> 1)][j & 1]; const float snd = b5 ? lo : hi, kp = b5 ? hi : lo; r8[j] = kp + shx<32>(snd); }
#pragma unroll
    for (int j = 0; j < 4; ++j) { const float snd = b4 ? r8[j] : r8[j + 4], kp = b4 ? r8[j + 4] : r8[j]; r4[j] = kp + shx<16>(snd); }
#pragma unroll
    for (int j = 0; j < 2; ++j) { const float snd = b3 ? r4[j] : r4[j + 2], kp = b3 ? r4[j + 2] : r4[j]; r2[j] = kp + shx<8>(snd); }
    *op = make_float2(xi.x + gf.x * r2[0], xi.y + gf.y * r2[1]);
}
typedef int i32x4_t __attribute__((ext_vector_type(4)));
typedef int i32x8_t __attribute__((ext_vector_type(8)));
constexpr int G1W = 18432;
__device__ __forceinline__ void g1m_dma(const unsigned char* ub, PG8_LAS unsigned char* img, const PG8_LAS unsigned short* idx, int i, int hh, int eg, unsigned q16) {
    const u32x4 w = *(const PG8_LAS u32x4*)(idx + ((i * 8 + eg) * 16 + hh * 8));
#pragma unroll
    for (int it = 0; it < 8; ++it) {
        const unsigned e_ = (it & 1) ? (w[it >> 1] >> 16) : (w[it >> 1] & 0xffffu);
        const unsigned off = (e_ << 7) | ((it & 1) ? (q16 ^ 64u) : q16);
        __builtin_amdgcn_global_load_lds((const unsigned*)(ub + off), (PG8_LAS unsigned*)(img + it * 1024), 16, 0, 0);
    }
}
template <bool PRE, int VMW>
__device__ __forceinline__ float g1m_step(const unsigned char* ub, PG8_LAS unsigned char* img, const PG8_LAS unsigned short* idx, int inext, int hh, int eg, unsigned q16,
                                          unsigned rdoff, int lane, const u32x4 a0, const u32x4 a1) {
    asm volatile("s_waitcnt vmcnt(%0)" :: "n"(VMW) : "memory");
    i32x8_t b[4];
#pragma unroll
    for (int mb = 0; mb < 4; ++mb) {
        const unsigned ro = (unsigned)mb * 2048u + rdoff;
        const i32x4_t lo = *(const PG8_LAS i32x4_t*)(img + ro), hi = *(const PG8_LAS i32x4_t*)(img + (ro ^ 64u));
        b[mb] = __builtin_shufflevector(lo, hi, 0, 1, 2, 3, 4, 5, 6, 7);
    }
    asm volatile("s_waitcnt lgkmcnt(0)" ::: "memory");
    if (PRE) g1m_dma(ub, img, idx, inext, hh, eg, q16);
    const i32x8_t a = __builtin_shufflevector((i32x4_t)a0, (i32x4_t)a1, 0, 1, 2, 3, 4, 5, 6, 7);
    float d[4]; f32x4 acc[4];
#pragma unroll
    for (int mb = 0; mb < 4; ++mb) acc[mb] = __builtin_amdgcn_mfma_scale_f32_16x16x128_f8f6f4(a, b[mb], f32x4{0.f, 0.f, 0.f, 0.f}, 0, 0, 0, 0x7f, 0, 0x7f);
#pragma unroll
    for (int mb = 0; mb < 4; ++mb) { d[mb] = acc[mb][0] + acc[mb][1] * (1.f / 16.f); asm volatile("" : "+v"(d[mb])); }
    const int g = lane >> 4;
    return g == 0 ? d[0] : g == 1 ? d[1] : g == 2 ? d[2] : d[3];
}
__device__ __forceinline__ void g1m_chunk(const Params& p, int x, int tb, char* smem_, int lane) {
    PG8_LAS unsigned char* wl = (PG8_LAS unsigned char*)smem_ + p.wv * G1W;
    PG8_LAS unsigned short* idx = (PG8_LAS unsigned short*)(wl + 16384);
    const int* RI = (const int*)(p.ws + WS_RI);
    {
        int ra[16];
#pragma unroll
        for (int i = 0; i < 8; ++i) { ra[2 * i] = RI[(size_t)(tb + i) * 128 + lane]; ra[2 * i + 1] = RI[(size_t)(tb + i) * 128 + 64 + lane]; }
#pragma unroll
        for (int i = 0; i < 8; ++i) {
            idx[(i * 8 + (lane & 7)) * 16 + (lane >> 3)] = (unsigned short)ra[2 * i];
            idx[(i * 8 + (lane & 7)) * 16 + 8 + (lane >> 3)] = (unsigned short)ra[2 * i + 1];
        }
    }
    __builtin_amdgcn_fence(__ATOMIC_RELEASE, "wavefront");
    __builtin_amdgcn_wave_barrier();
    __builtin_amdgcn_fence(__ATOMIC_ACQUIRE, "wavefront");
    const int eg = lane >> 3, n = lane & 15, kb = lane >> 4;
    const unsigned q16 = (unsigned)(((lane & 7) ^ (eg >> 1)) * 16);
    const unsigned rdoff = (unsigned)(n * 128 + ((kb ^ (n >> 1)) * 16));
    const unsigned char* ub = p.ws + WS_PU + (size_t)x * (16384u * 128u);
    const unsigned char* h8 = p.ws + ((lane & 1) ? WS_H8L : WS_H8H) + (size_t)tb * 1024 + x * 128 + kb * 16;
    float* pp = (float*)(p.ws + WS_PP) + ((size_t)x * T_TOK + tb) * 128 + lane;
    u32x4 ha[8][2];
#pragma unroll
    for (int i = 0; i < 8; ++i) { ha[i][0] = *(const u32x4*)(h8 + (size_t)i * 1024); ha[i][1] = *(const u32x4*)(h8 + (size_t)i * 1024 + 64); }
#pragma unroll
    for (int i = 0; i < 8; ++i) { asm volatile("" : "+v"(ha[i][0])); asm volatile("" : "+v"(ha[i][1])); }
    g1m_dma(ub, wl, idx, 0, 0, eg, q16);
    g1m_dma(ub, wl + 8192, idx, 0, 1, eg, q16);
    asm volatile("s_waitcnt vmcnt(8)" ::: "memory");
#pragma unroll
    for (int i = 0; i < 7; ++i) {
        const float v0 = g1m_step<true, 9>(ub, wl, idx, i + 1, 0, eg, q16, rdoff, lane, ha[i][0], ha[i][1]);
        pp[(size_t)i * 128] = v0;
        const float v1 = g1m_step<true, 9>(ub, wl + 8192, idx, i + 1, 1, eg, q16, rdoff, lane, ha[i][0], ha[i][1]);
        pp[(size_t)i * 128 + 64] = v1;
    }
    {
        const float v0 = g1m_step<false, 9>(ub, wl, idx, 0, 0, eg, q16, rdoff, lane, ha[7][0], ha[7][1]);
        pp[(size_t)7 * 128] = v0;
        const float v1 = g1m_step<false, 0>(ub, wl + 8192, idx, 0, 1, eg, q16, rdoff, lane, ha[7][0], ha[7][1]);
        pp[(size_t)7 * 128 + 64] = v1;
    }
}
typedef int i32x2_t __attribute__((ext_vector_type(2)));
template <bool PRE, int VMW, int HH>
__device__ __forceinline__ void g2m_step(const unsigned char* vb_, PG8_LAS unsigned char* img, const PG8_LAS unsigned short* idx, int inext, int eg, unsigned q16,
                                         const unsigned (&tra)[8], const long a0, const long a1, f32x4 (&acc)[8]) {
    asm volatile("s_waitcnt vmcnt(%0)" :: "n"(VMW) : "memory");
    long b[2][8];
#pragma unroll
    for (int u = 0; u < 2; ++u)
#pragma unroll
        for (int j = 0; j < 8; ++j) asm volatile("ds_read_b64_tr_b8 %0, %1 offset:%2" : "=v"(b[u][j]) : "v"(tra[j]), "n"(HH * 8192 + u * 4096) : "memory");
    asm volatile("s_waitcnt lgkmcnt(0)" : "+v"(b[0][0]), "+v"(b[0][1]), "+v"(b[0][2]), "+v"(b[0][3]), "+v"(b[0][4]), "+v"(b[0][5]), "+v"(b[0][6]), "+v"(b[0][7]) :: "memory");
    asm volatile("" : "+v"(b[1][0]), "+v"(b[1][1]), "+v"(b[1][2]), "+v"(b[1][3]), "+v"(b[1][4]), "+v"(b[1][5]), "+v"(b[1][6]), "+v"(b[1][7]) :: "memory");
    if (PRE) { g1m_dma(vb_, img + HH * 8192, idx, inext, HH, eg, q16); __builtin_amdgcn_sched_barrier(0); }
#pragma unroll
    for (int j = 0; j < 8; ++j) {
        acc[j] = __builtin_amdgcn_mfma_f32_16x16x32_fp8_fp8(a0, b[0][j], acc[j], 0, 0, 0);
        acc[j] = __builtin_amdgcn_mfma_f32_16x16x32_fp8_fp8(a1, b[1][j], acc[j], 0, 0, 0);
    }
}
__device__ __forceinline__ void g2m_chunk(const Params& p, int l, int x, int tb, char* smem_, int lane) {
    PG8_LAS unsigned char* wl = (PG8_LAS unsigned char*)smem_ + p.wv * G1W;
    PG8_LAS unsigned short* idx = (PG8_LAS unsigned short*)(wl + 16384);
    const int* RI = (const int*)(p.ws + WS_RI);
    {
        int ra[16];
#pragma unroll
        for (int i = 0; i < 8; ++i) { ra[2 * i] = RI[(size_t)(tb + i) * 128 + lane]; ra[2 * i + 1] = RI[(size_t)(tb + i) * 128 + 64 + lane]; }
#pragma unroll
        for (int i = 0; i < 8; ++i) {
            idx[(i * 8 + (lane & 7)) * 16 + (lane >> 3)] = (unsigned short)ra[2 * i];
            idx[(i * 8 + (lane & 7)) * 16 + 8 + (lane >> 3)] = (unsigned short)ra[2 * i + 1];
        }
    }
    __builtin_amdgcn_fence(__ATOMIC_RELEASE, "wavefront");
    __builtin_amdgcn_wave_barrier();
    __builtin_amdgcn_fence(__ATOMIC_ACQUIRE, "wavefront");
    const int eg = lane >> 3, kb = lane >> 4, li = lane & 15, q = li >> 1;
    const unsigned q16 = (unsigned)(((lane & 7) ^ (eg >> 1)) * 16);
    const int n16 = (kb & 1) * 8 + q;
    const unsigned trbase = (unsigned)((kb * 8 + q) * 128 + ((n16 >> 1) & 7) * 16 + (li & 1) * 8);
    const unsigned char* vb_ = p.ws + WS_PV + (size_t)x * (16384u * 128u);
    float* op = p.out + (size_t)tb * 1024 + x * 128 + lane;
    const float* modr = (const float*)(p.ws + WS_MOD) + (size_t)(l * 8 + (tb >> 11)) * 6144 + 5120 + x * 128 + lane;
    float gf0 = modr[0], gf1 = modr[64];
    const unsigned char* c8 = p.ws + ((lane & 1) ? WS_C8L : WS_C8H) + (size_t)tb * 128 + kb * 32;
    u32x4 ca[8][2]; float xi[8][2], cinv[8];
#pragma unroll
    for (int i = 0; i < 8; ++i) {
        ca[i][0] = *(const u32x4*)(c8 + (size_t)i * 128); ca[i][1] = *(const u32x4*)(c8 + (size_t)i * 128 + 16);
        xi[i][0] = op[(size_t)i * 1024]; xi[i][1] = op[(size_t)i * 1024 + 64];
        cinv[i] = ((const float*)(p.ws + WS_CINV))[tb + i];
    }
#pragma unroll
    for (int i = 0; i < 8; ++i) { asm volatile("" : "+v"(ca[i][0])); asm volatile("" : "+v"(ca[i][1])); asm volatile("" : "+v"(xi[i][0]), "+v"(xi[i][1]), "+v"(cinv[i])); }
    asm volatile("" : "+v"(gf0), "+v"(gf1));
    g1m_dma(vb_, wl, idx, 0, 0, eg, q16);
    g1m_dma(vb_, wl + 8192, idx, 0, 1, eg, q16);
    asm volatile("s_waitcnt vmcnt(8)" ::: "memory");
    const int g = lane >> 4;
    unsigned tra[8];
#pragma unroll
    for (int j = 0; j < 8; ++j) tra[j] = (unsigned)(unsigned long)wl + (trbase ^ (unsigned)(j * 16));
#define G2M_TOKEN(i, PRE_, W0, W1) do { \
        f32x4 acc[8]; \
        _Pragma("unroll") for (int j = 0; j < 8; ++j) acc[j] = f32x4{0.f, 0.f, 0.f, 0.f}; \
        const long a00 = (long)(((unsigned long long)ca[i][0][1] << 32) | ca[i][0][0]), a01 = (long)(((unsigned long long)ca[i][0][3] << 32) | ca[i][0][2]); \
        const long a10 = (long)(((unsigned long long)ca[i][1][1] << 32) | ca[i][1][0]), a11 = (long)(((unsigned long long)ca[i][1][3] << 32) | ca[i][1][2]); \
        g2m_step<PRE_, W0, 0>(vb_, wl, idx, (i) + 1, eg, q16, tra, a00, a01, acc); \
        g2m_step<PRE_, W1, 1>(vb_, wl, idx, (i) + 1, eg, q16, tra, a10, a11, acc); \
        float y[8]; \
        _Pragma("unroll") for (int j = 0; j < 8; ++j) { y[j] = acc[j][0] + acc[j][1] * (1.f / 16.f); asm volatile("" : "+v"(y[j])); } \
        const float ya = g == 0 ? y[0] : g == 1 ? y[1] : g == 2 ? y[2] : y[3], yb = g == 0 ? y[4] : g == 1 ? y[5] : g == 2 ? y[6] : y[7]; \
        op[(size_t)(i) * 1024] = xi[i][0] + gf0 * (ya * cinv[i]); op[(size_t)(i) * 1024 + 64] = xi[i][1] + gf1 * (yb * cinv[i]); \
        __builtin_amdgcn_sched_barrier(0); } while (0)
    G2M_TOKEN(0, true, 10, 8);
    G2M_TOKEN(1, true, 10, 10); G2M_TOKEN(2, true, 10, 10); G2M_TOKEN(3, true, 10, 10);
    G2M_TOKEN(4, true, 10, 10); G2M_TOKEN(5, true, 10, 10); G2M_TOKEN(6, true, 10, 10);
    G2M_TOKEN(7, false, 10, 0);
#undef G2M_TOKEN
}
template <int WHICH>
__device__ void ph_peer_sliced(const Params& p, int l, int vb0, int nvb, char* smem_) {
    const int tid = TIDX(), wave = tid >> 6;
    const bf16_t* H = (const bf16_t*)(p.ws + WS_H); const unsigned char* PU = p.ws + WS_PU; const unsigned char* PV = p.ws + WS_PV;
    const int* RI = (const int*)(p.ws + WS_RI); float* RG = (float*)(p.ws + WS_RG); float* PP = (float*)(p.ws + WS_PP);
    const float* modb = (const float*)(p.ws + WS_MOD);
    {
    {
#pragma unroll 1
        for (int u_ = vb0; u_ < 2048; u_ += nvb) {
            const int x = u_ & 7, chunk = u_ >> 3;
            {
                const int lane = lane_id_opaque(), eg = lane >> 3, ll = lane & 7;
                const int tb = chunk * 64 + wave * 8;
                if (WHICH == 0 && G1_MFMA) { g1m_chunk(p, x, tb, smem_, lane); continue; }
                if (WHICH == 1 && G2_MFMA) { g2m_chunk(p, l, x, tb, smem_, lane); continue; }
                int* lri = (int*)smem_ + wave * 2048; float* lrg = (float*)(lri + 1024);
                {
                    int ra[16]; float rg_[16];
#pragma unroll
                    for (int i = 0; i < 8; ++i) {
                        ra[2 * i] = RI[(size_t)(tb + i) * 128 + lane]; ra[2 * i + 1] = RI[(size_t)(tb + i) * 128 + 64 + lane];
                        if (WHICH == 1) { rg_[2 * i] = RG[(size_t)(tb + i) * 128 + lane]; rg_[2 * i + 1] = RG[(size_t)(tb + i) * 128 + 64 + lane]; }
                    }
#pragma unroll
                    for (int i = 0; i < 8; ++i) {
                        lri[i * 128 + lane] = ra[2 * i]; lri[i * 128 + 64 + lane] = ra[2 * i + 1];
                        if (WHICH == 1) { lrg[i * 128 + lane] = rg_[2 * i]; lrg[i * 128 + 64 + lane] = rg_[2 * i + 1]; }
                    }
                }
                __builtin_amdgcn_fence(__ATOMIC_RELEASE, "wavefront");
                __builtin_amdgcn_wave_barrier();
                __builtin_amdgcn_fence(__ATOMIC_ACQUIRE, "wavefront");
                const unsigned l16 = (unsigned)ll * 16u;
                if (WHICH == 0) {
                    const unsigned char* ub = PU + (size_t)x * (16384u * 128u);
                    const bf16_t* hrow = H + (size_t)tb * 1024 + x * 128 + ll * 16;
                    float* pp_row = PP + ((size_t)x * T_TOK + tb) * 128 + ll * 8 + eg;
                    u32x4 hq0 = ((const u32x4*)hrow)[0], hq1 = ((const u32x4*)hrow)[1], uqA[8], uqB[8];
                    peer_gather8(uqA, ub, lri + eg, l16);
                    peer_gather8(uqB, ub, lri + eg + 64, l16);
#pragma unroll 1
                    for (int i = 0; i < 7; ++i) g1_step<true>(i, tb + i, hrow + (size_t)(i + 1) * 1024, ub, lri + eg, l16, lane, pp_row + (size_t)i * 128, hq0, hq1, uqA, uqB);
                    g1_step<false>(7, tb + 7, hrow, ub, lri + eg, l16, lane, pp_row + (size_t)7 * 128, hq0, hq1, uqA, uqB);
                } else {
                    const unsigned char* vb_ = PV + (size_t)x * (16384u * 128u);
                    const int col = x * 128 + ll * 16 + ((lane >> 5) & 1) * 8 + ((lane >> 4) & 1) * 4 + ((lane >> 3) & 1) * 2;
                    const float2 gf = *(const float2*)(modb + (size_t)(l * 8 + (tb >> 11)) * 6144 + 5120 + col);
                    float2* op = (float2*)(p.out + (size_t)tb * 1024 + col);
                    u32x4 vqA[8], vqB[8];
                    peer_gather8(vqA, vb_, lri + eg, l16);
                    peer_gather8(vqB, vb_, lri + eg + 64, l16);
#pragma unroll 1
                    for (int i = 0; i < 7; ++i) g2_step<true>(i, op + (size_t)i * 512, gf, vb_, lri + eg, lrg + eg, l16, lane, vqA, vqB);
                    g2_step<false>(7, op + (size_t)7 * 512, gf, vb_, lri + eg, lrg + eg, l16, lane, vqA, vqB);
                }
            }
        }
    }
    __syncthreads();
    }
}
__device__ void ph_peer_coef(const Params& p, int vb0, int nvb) {
    const int wave = TIDX() >> 6, lane = TIDX() & 63;
    float* RG = (float*)(p.ws + WS_RG); const float* PP = (const float*)(p.ws + WS_PP);
    for (int t0 = (vb0 * 8 + wave) * 2; t0 < T_TOK; t0 += nvb * 8 * 2) {
        float pp[2][2][8], g[2][2];
#pragma unroll
        for (int u = 0; u < 2; ++u)
#pragma unroll
            for (int half = 0; half < 2; ++half) {
                const int k = half * 64 + lane;
#pragma unroll
                for (int x = 0; x < 8; ++x) pp[u][half][x] = PP[((size_t)x * T_TOK + t0 + u) * 128 + k];
                g[u][half] = RG[(size_t)(t0 + u) * 128 + k];
            }
        asm volatile("" ::: "memory");
#pragma unroll
        for (int u = 0; u < 2; ++u) {
            float cf[2];
#pragma unroll
            for (int half = 0; half < 2; ++half) {
                float d = 0.f;
#pragma unroll
                for (int x = 0; x < 8; ++x) d += pp[u][half][x];
                d *= (1.f / PU_SCALE);
                cf[half] = g[u][half] * 0.5f * d * (1.f + erff(d * 0.7071067811865476f)) * (1.f / PV_SCALE);
                if (!G2_MFMA) RG[(size_t)(t0 + u) * 128 + half * 64 + lane] = cf[half];
            }
            if (G2_MFMA) {
                const float m = wave_max(fmaxf(fabsf(cf[0]), fabsf(cf[1])));
                const float sc = m > 0.f ? 240.f / m : 0.f;
                const float c0 = cf[0] * sc, c1 = cf[1] * sc;
                const int hi = __builtin_amdgcn_cvt_pk_fp8_f32(c0, c1, 0, false);
                const auto bk = __builtin_amdgcn_cvt_pk_f32_fp8(hi, false);
                const int lo = __builtin_amdgcn_cvt_pk_fp8_f32((c0 - bk[0]) * 16.f, (c1 - bk[1]) * 16.f, 0, false);
                unsigned char* c8h = p.ws + WS_C8H + (size_t)(t0 + u) * 128; unsigned char* c8l = p.ws + WS_C8L + (size_t)(t0 + u) * 128;
                const int s0 = ((lane >> 3) & 3) * 32 + (lane >> 5) * 8 + (lane & 7);
                c8h[s0] = (unsigned char)(hi & 0xff); c8h[s0 + 16] = (unsigned char)((hi >> 8) & 0xff);
                c8l[s0] = (unsigned char)(lo & 0xff); c8l[s0 + 16] = (unsigned char)((lo >> 8) & 0xff);
                if (lane == 0) ((float*)(p.ws + WS_CINV))[t0 + u] = m * (1.f / 240.f);
            }
        }
    }
}

enum { PH_MOD = 0, PH_WPREP, PH_NORM1, PH_GEMM_IN, PH_SCAN, PH_MERGE, PH_OUT, PH_NORM2, PH_GEMM_Q, PH_GEMM_SC, PH_ROUTE, PH_G1, PH_G15, PH_G2 };

template <int PH>
__device__ __forceinline__ void run_phase(const Params& p, int l, int vb0, int nvb, char* smem) {
    const float* xin = (l == 0) ? p.x : p.out;
    if (PH == PH_MOD) ph_mod(p, vb0, nvb, smem);
    else if (PH == PH_WPREP) ph_wprep(p, l, vb0, nvb, smem);
    else if (PH == PH_NORM1) ph_norm(p, l, 0, xin, vb0, nvb);
    else if (PH == PH_GEMM_IN) {
        pg8::Gemm g{(const bf16_t*)(p.ws + WS_H), (const bf16_t*)(p.ws + WS_WIN), 1024, 1024, 1024};
        pg8::StaticOrder S; S.init(T_TOK, LDZ, nvb, vb0, 1024, 1024);
        pg8::gemm_phase(( PG8_LAS unsigned char*)smem, g, S, pg8::EpiBf16{(bf16_t*)(p.ws + WS_Z), LDZ}, TIDX());
    }
    else if (PH == PH_SCAN) ph_mixA(p, l, vb0, nvb, smem);
    else if (PH == PH_MERGE) {
        pg8::Gemm g{(const bf16_t*)(p.ws + WS_Y), (const bf16_t*)(p.ws + WS_WBR), 1536, 512, 512};
        pg8::MergeOrder S{vb0, nvb};
        pg8::gemm_phase((PG8_LAS unsigned char*)smem, g, S, pg8::EpiMerge{(bf16_t*)(p.ws + WS_H), (const bf16_t*)(p.ws + WS_Z)}, TIDX());
    }
    else if (PH == PH_OUT) {
        pg8::Gemm g{(const bf16_t*)(p.ws + WS_H), (const bf16_t*)(p.ws + WS_WOUT), 1024, 1024, 1024};
        pg8::StaticOrder S; S.init(T_TOK, 1024, nvb, vb0, 1024, 1024);
        pg8::gemm_phase((PG8_LAS unsigned char*)smem, g, S, pg8::EpiResid{xin, p.out, (const float*)(p.ws + WS_MOD) + (size_t)l * 8 * 6144}, TIDX());
    }
    else if (PH == PH_NORM2) ph_norm(p, l, 1, p.out, vb0, nvb);
    else if (PH == PH_GEMM_Q) {
        pg8::Gemm g{(const bf16_t*)(p.ws + WS_H), (const bf16_t*)(p.ws + WS_WQ), 1024, 1024, 1024};
        pg8::StaticOrder S; S.init(T_TOK, 2048, nvb, vb0, 1024, 1024);
        pg8::gemm_phase((PG8_LAS unsigned char*)smem, g, S, pg8::EpiF16P{(_Float16*)(p.ws + WS_SC), 2048}, TIDX());
    }
    else if (PH == PH_GEMM_SC) gemm_phase((const bf16_t*)(p.ws + WS_QP), 2048, (const bf16_t*)(p.ws + WS_SK), 128, T_TOK, 2048, 128, true,
                                          EpiF16{(_Float16*)(p.ws + WS_SC), 2048}, vb0, nvb, smem, TIDX());
    else if (PH == PH_ROUTE) ph_route(p, vb0, nvb, smem);
    else if (PH == PH_G1) ph_peer_sliced<0>(p, l, vb0, nvb, smem);
    else if (PH == PH_G15) ph_peer_coef(p, vb0, nvb);
    else if (PH == PH_G2) ph_peer_sliced<1>(p, l, vb0, nvb, smem);

}

#define XB_TMO      128
#define XB_XCNT(j)  (256  + 64 * (j))
#define XB_XSUB(j)  (1280 + 64 * (j))
#define XB_XGEN(j)  (2304 + 64 * (j))
#define XB_TOP      3328
#define XB_TOPGEN   3392
#define XCD_BAR_WORDS 3456
#define XB_SPIN_CAP (1u << 18)
#define LAS __attribute__((address_space(3)))
__device__ __forceinline__ unsigned xb_ld(unsigned* p)              { return __hip_atomic_load(p, __ATOMIC_RELAXED, __HIP_MEMORY_SCOPE_AGENT); }
__device__ __forceinline__ unsigned xb_add(unsigned* p, unsigned v) { return __hip_atomic_fetch_add(p, v, __ATOMIC_RELAXED, __HIP_MEMORY_SCOPE_AGENT); }
#define XB_SPIN(cond, bar) do { unsigned _sp = 0; while (cond) { __builtin_amdgcn_s_sleep(1); \
    if ((++_sp & 255u) == 0u) { if (xb_ld(&(bar)[XB_TMO])) break; if (_sp > XB_SPIN_CAP) { atomicAdd(&(bar)[XB_TMO], 1u); break; } } } } while (0)
struct XcdBarrier { unsigned* bar; unsigned x; volatile LAS unsigned* st; int wv; };
__device__ __forceinline__ XcdBarrier xcd_barrier_post(unsigned* bar, volatile LAS unsigned* st, int wv) {
    XcdBarrier b; b.bar = bar; b.x = xb_xcc_id(); b.st = st; b.wv = wv;
    if (TIDXW(wv) == 0) (void)xb_add(&bar[XB_XCNT(b.x)], 1u);
    return b;
}
__device__ __forceinline__ void xcd_barrier_complete(unsigned* bar, unsigned x, unsigned& nloc, unsigned& nx) {
    const unsigned G = gridDim.x * gridDim.y * gridDim.z;
    unsigned sum, cnt, mine, sp = 0u;
    for (;;) {
        sum = 0u; cnt = 0u; mine = 0u;
#pragma unroll
        for (unsigned j = 0; j < 16; ++j) { const unsigned c = xb_ld(&bar[XB_XCNT(j)]); sum += c; cnt += (c > 0u) ? 1u : 0u; mine = (j == x) ? c : mine; }
        if (sum == G) break;
        __builtin_amdgcn_s_sleep(1);
        if ((++sp & 255u) == 0u) { if (xb_ld(&bar[XB_TMO])) break; if (sp > XB_SPIN_CAP) { atomicAdd(&bar[XB_TMO], 1u); break; } }
    }
    nloc = mine > 0u ? mine : 1u; nx = cnt > 0u ? cnt : 1u;
}
__device__ __forceinline__ void xcd_barrier(const XcdBarrier& b) {
    asm volatile("s_waitcnt vmcnt(0)" ::: "memory");
    __syncthreads();
    if (TIDXW(b.wv) == 0) {
        unsigned* bar = b.bar;
        __builtin_amdgcn_s_waitcnt(0);
        unsigned nloc = b.st[0], nx = b.st[1];
        if (nloc == 0u) { xcd_barrier_complete(bar, b.x, nloc, nx); b.st[0] = nloc; b.st[1] = nx; }
        const unsigned old = xb_add(&bar[XB_XSUB(b.x)], 1u);
        const unsigned gen = old / nloc;
        if (old + 1u == (gen + 1u) * nloc) {
            __builtin_amdgcn_fence(__ATOMIC_RELEASE, "agent");
            asm volatile("s_waitcnt vmcnt(0)" ::: "memory");
            const unsigned og = xb_add(&bar[XB_TOP], 1u);
            const unsigned tg = og / nx;
            if (og + 1u == (tg + 1u) * nx) xb_add(&bar[XB_TOPGEN], 1u);
            else XB_SPIN(xb_ld(&bar[XB_TOPGEN]) == tg, bar);
            __builtin_amdgcn_fence(__ATOMIC_ACQUIRE, "agent");
            xb_add(&bar[XB_XGEN(b.x)], 1u);
            asm volatile("s_waitcnt vmcnt(0)" ::: "memory");
        } else {
            XB_SPIN(xb_ld(&bar[XB_XGEN(b.x)]) == gen, bar);
            __builtin_amdgcn_fence(__ATOMIC_ACQUIRE, "agent");
            asm volatile("s_waitcnt vmcnt(0)" ::: "memory");
        }
    }
    __syncthreads();
}

__global__ void __launch_bounds__(NT) mega_kernel(Params p_in) {
#if defined(__HIP_DEVICE_COMPILE__)
    extern __shared__ __attribute__((aligned(16))) char smem[];
    volatile LAS unsigned* st = (volatile LAS unsigned*)(smem + LDS_BYTES - 16);
    int wv_ = __builtin_amdgcn_readfirstlane((int)threadIdx.x >> 6); asm volatile("" : "+s"(wv_));
    { const int t_ = TIDXW(wv_); if (t_ < 4) st[t_] = 0u; }
    __syncthreads();
    XcdBarrier bar = xcd_barrier_post((unsigned*)(p_in.ws + WS_CTL), st, wv_);
    const int vb = (int)blockIdx.x, nvb = (int)gridDim.x;
#define GB() xcd_barrier(bar)
#define RUN(PH, L) do { \
        const __attribute__((address_space(4))) Params* _kp = (const __attribute__((address_space(4))) Params*)__builtin_amdgcn_kernarg_segment_ptr(); asm volatile("" : "+s"(_kp)); Params _p = *_kp; _p.wv = wv_; \
        int _l = (L), _vb = vb, _nvb = nvb; asm volatile("" : "+s"(_l), "+s"(_vb), "+s"(_nvb)); \
        run_phase<PH>(_p, _l, _vb, _nvb, smem); } while (0)
    RUN(PH_MOD, 0);
#pragma unroll 1
    for (int l = 0; l < 2; ++l) {
        RUN(PH_WPREP, l); if (l == 0) GB();
        RUN(PH_NORM1, l); GB();
        RUN(PH_GEMM_IN, l); GB();
        RUN(PH_SCAN, l); GB();
        RUN(PH_MERGE, l); GB();
        RUN(PH_OUT, l); GB();
        RUN(PH_NORM2, l); GB();
        RUN(PH_GEMM_Q, l); GB();
        RUN(PH_ROUTE, l); GB();
        RUN(PH_G1, l); GB();
        RUN(PH_G15, l); GB();
        RUN(PH_G2, l);
        if (l == 0) GB();
    }
#undef RUN
#undef GB
#endif
}

extern "C" void kernel_launch(void* const* d_in, const int* in_sizes, int n_in, void* d_out, int out_size, void* d_ws, size_t ws_size,
                              hipStream_t stream) {
    if (n_in != 20 || ws_size < WS_END) { fprintf(stderr, "kernel_launch: bad inputs (n_in %d ws %zu need %zu)\n", n_in, ws_size, (size_t)WS_END); return; }
    Params p{};
    p.x = (const float*)d_in[0]; p.c = (const float*)d_in[1]; p.w_ada = (const float*)d_in[2]; p.b_ada = (const float*)d_in[3];
    p.norm_mix = (const float*)d_in[4]; p.norm_ffn = (const float*)d_in[5]; p.w_in = (const float*)d_in[6]; p.hgrn_lb = (const float*)d_in[7];
    p.hgrn_on = (const float*)d_in[8]; p.dsa_qn = (const float*)d_in[9]; p.dsa_kn = (const float*)d_in[10]; p.gla_up = (const float*)d_in[11];
    p.gla_bias = (const float*)d_in[12]; p.gla_on = (const float*)d_in[13]; p.w_branch = (const float*)d_in[14]; p.w_out = (const float*)d_in[15];
    p.peer_wq = (const float*)d_in[16]; p.peer_keys = (const float*)d_in[17]; p.peer_u = (const float*)d_in[18]; p.peer_v = (const float*)d_in[19];
    p.out = (float*)d_out; p.ws = (unsigned char*)d_ws;
    static int grid = 0;
    if (grid == 0) {
        int dev = 0, cus = 0, per_cu = 0;
        hipGetDevice(&dev);
        hipDeviceGetAttribute(&cus, hipDeviceAttributeMultiprocessorCount, dev);
        hipFuncSetAttribute((const void*)mega_kernel, hipFuncAttributeMaxDynamicSharedMemorySize, LDS_BYTES);
        hipOccupancyMaxActiveBlocksPerMultiprocessor(&per_cu, (const void*)mega_kernel, NT, LDS_BYTES);
        if (per_cu < 1) { fprintf(stderr, "kernel_launch: occupancy query says %d blocks per CU\n", per_cu); per_cu = 1; }
        (void)hipGetLastError();
        grid = cus;
    }
    hipMemsetAsync((char*)d_ws + WS_CTL, 0, 32768, stream);
    void* args[] = {&p};
    hipError_t e = hipLaunchCooperativeKernel((const void*)mega_kernel, dim3(grid), dim3(NT), args, LDS_BYTES, stream);
    if (e != hipSuccess) fprintf(stderr, "cooperative launch failed: %s (grid %d)\n", hipGetErrorString(e), grid);
}
```

```cpp
#include <hip/hip_runtime.h>
#include <stdint.h>
#include <stdio.h>

typedef unsigned short bf16_t;
typedef short bf16x8 __attribute__((ext_vector_type(8)));
typedef float f32x4 __attribute__((ext_vector_type(4)));
typedef unsigned u32x4 __attribute__((ext_vector_type(4)));

#define NT 512
constexpr int T_TOK = 16384, DM = 1024, SEQ = 2048;
constexpr int LDZ = 8704;
constexpr int ZA_Q = 0, ZA_F = 512, ZA_I = 1024, ZA_G = 1536, ZB_Q = 2048, ZB_K = 2560, ZB_V = 3072, ZC_V = 3584, ZC_G = 4096,
              ZB_QI = 4608, ZC_Q = 4864, ZC_K = 5120, ZB_KI = 5376, ZB_WI = 5440, ZC_CODE = 5444, ZM = 5632;
constexpr int IN_COLS = 8532;

constexpr size_t al256(size_t x) { return (x + 255) & ~(size_t)255; }
constexpr size_t WS_CTL = 0;
constexpr size_t WS_MOD = 65536;
constexpr size_t WS_WIN = al256(WS_MOD + (size_t)2 * 8 * 6144 * 4);
constexpr size_t WS_WBR = al256(WS_WIN + (size_t)LDZ * 1024 * 2);
constexpr size_t WS_WOUT = al256(WS_WBR + (size_t)3 * 1024 * 512 * 2);
constexpr size_t WS_WQ = al256(WS_WOUT + (size_t)1024 * 1024 * 2);
constexpr size_t WS_SK = al256(WS_WQ + (size_t)2048 * 1024 * 2);
constexpr size_t WS_PU = al256(WS_SK + (size_t)16 * 128 * 128 * 2);
constexpr size_t WS_PV = al256(WS_PU + (size_t)16384 * 1024);
constexpr size_t WS_H = al256(WS_PV + (size_t)16384 * 1024);
constexpr float PU_SCALE = 32.f, PV_SCALE = 4.f;
constexpr size_t WS_OA = al256(WS_H + (size_t)T_TOK * 1024 * 2);
constexpr size_t WS_OC = al256(WS_OA + (size_t)T_TOK * 512 * 2);
constexpr size_t WS_H8H = WS_OA, WS_H8L = WS_OC;
constexpr size_t WS_Y = al256(WS_OC + (size_t)T_TOK * 512 * 2);
constexpr size_t WS_Z = al256(WS_Y + (size_t)T_TOK * 1536 * 2);
constexpr size_t WS_VT = al256(WS_Z + (size_t)T_TOK * LDZ * 2);
constexpr size_t WS_BM = al256(WS_VT + (size_t)T_TOK * 512 * 2);
constexpr size_t WS_END = al256(WS_BM + (size_t)T_TOK * 64 * 4);
constexpr size_t WS_QP = WS_Z;
constexpr size_t WS_SC = al256(WS_QP + (size_t)T_TOK * 2048 * 2);
constexpr size_t WS_RI = al256(WS_SC + (size_t)T_TOK * 2048 * 4);
constexpr size_t WS_RG = al256(WS_RI + (size_t)T_TOK * 128 * 4);
constexpr size_t WS_PP = al256(WS_RG + (size_t)T_TOK * 128 * 4);
constexpr size_t WS_C8H = WS_SC;
constexpr size_t WS_C8L = WS_C8H + (size_t)T_TOK * 128;
constexpr size_t WS_CINV = WS_C8L + (size_t)T_TOK * 128;
static_assert(WS_PP + (size_t)8 * T_TOK * 128 * 4 <= WS_VT, "peer partials overflow the Z region");
static_assert(WS_RG + (size_t)T_TOK * 128 * 4 <= WS_END, "peer alias overflow");

struct Params {
    const float* x; const float* c; const float* w_ada; const float* b_ada; const float* norm_mix; const float* norm_ffn;
    const float* w_in; const float* hgrn_lb; const float* hgrn_on; const float* dsa_qn; const float* dsa_kn;
    const float* gla_up; const float* gla_bias; const float* gla_on; const float* w_branch; const float* w_out;
    const float* peer_wq; const float* peer_keys; const float* peer_u; const float* peer_v;
    float* out; unsigned char* ws;
    int wv, pad;
};

__device__ __forceinline__ float bf2f(bf16_t h) { return __uint_as_float(((unsigned)h) << 16); }
__device__ __forceinline__ float bflo(unsigned u) { return __uint_as_float(u << 16); }
__device__ __forceinline__ float bfhi(unsigned u) { return __uint_as_float(u & 0xffff0000u); }
__device__ __forceinline__ bf16_t f2bf(float f) { unsigned r; asm volatile("v_cvt_pk_bf16_f32 %0, %1, %1" : "=v"(r) : "v"(f)); return (bf16_t)(r & 0xffffu); }
__device__ __forceinline__ unsigned pack2(float a, float b) { unsigned r; asm volatile("v_cvt_pk_bf16_f32 %0, %1, %2" : "=v"(r) : "v"(a), "v"(b)); return r; }
__device__ __forceinline__ int lane_id_opaque() { int l; asm volatile("v_mbcnt_lo_u32_b32 %0, -1, 0\n\tv_mbcnt_hi_u32_b32 %0, -1, %0" : "=v"(l)); return l; }
template <int M> __device__ __forceinline__ int shx_i(int v) {
    if (M < 32) return __builtin_amdgcn_ds_swizzle(v, (M << 10) | 0x1f);
    return __builtin_amdgcn_ds_bpermute((lane_id_opaque() ^ 32) << 2, v);
}
template <int M> __device__ __forceinline__ float shx(float v) { return __int_as_float(shx_i<M>(__float_as_int(v))); }
template <int M> __device__ __forceinline__ int shx(int v) { return shx_i<M>(v); }
template <int M> __device__ __forceinline__ unsigned shx(unsigned v) { return (unsigned)shx_i<M>((int)v); }
__device__ __forceinline__ int bperm(int v, int src) { return __builtin_amdgcn_ds_bpermute(src << 2, v); }
__device__ __forceinline__ float bperm(float v, int src) { return __int_as_float(__builtin_amdgcn_ds_bpermute(src << 2, __float_as_int(v))); }
__device__ __forceinline__ float wave_sum(float v) { v += shx<32>(v); v += shx<16>(v); v += shx<8>(v); v += shx<4>(v); v += shx<2>(v); v += shx<1>(v); return v; }
__device__ __forceinline__ float wave_max(float v) { v = fmaxf(v, shx<32>(v)); v = fmaxf(v, shx<16>(v)); v = fmaxf(v, shx<8>(v)); v = fmaxf(v, shx<4>(v)); v = fmaxf(v, shx<2>(v)); v = fmaxf(v, shx<1>(v)); return v; }
__device__ __forceinline__ int wave_sum_i(int v) { v += shx<32>(v); v += shx<16>(v); v += shx<8>(v); v += shx<4>(v); v += shx<2>(v); v += shx<1>(v); return v; }
__device__ __forceinline__ int wave_total_i(int v) {
    v += __builtin_amdgcn_update_dpp(0, v, 0x111, 0xf, 0xf, true);
    v += __builtin_amdgcn_update_dpp(0, v, 0x112, 0xf, 0xf, true);
    v += __builtin_amdgcn_update_dpp(0, v, 0x114, 0xf, 0xf, true);
    v += __builtin_amdgcn_update_dpp(0, v, 0x118, 0xf, 0xf, true);
    v += __builtin_amdgcn_update_dpp(0, v, 0x142, 0xa, 0xf, true);
    v += __builtin_amdgcn_update_dpp(0, v, 0x143, 0xc, 0xf, true);
    return __builtin_amdgcn_readlane(v, 63);
}
__device__ __forceinline__ float sigm(float x) { return __frcp_rn(1.f + __expf(-x)); }

__device__ __forceinline__ unsigned xb_xcc_id() { return (unsigned)__builtin_amdgcn_s_getreg((3 << 11) | 20) & 0xFu; }
__device__ __forceinline__ int TIDXW(int wv) { int t; asm volatile("v_mbcnt_lo_u32_b32 %0, -1, 0\n\tv_mbcnt_hi_u32_b32 %0, -1, %0\n\tv_lshl_or_b32 %0, %1, 6, %0" : "=v"(t) : "s"(wv)); return t; }
#define TIDX() TIDXW(p.wv)

__device__ __forceinline__ int src_col(int j) {
    if (j < 3584) return j;
    if (j < 4096) return j - 3584 + 4420;
    if (j < 4608) return j - 4096 + 4948;
    if (j < 4864) return j - 4608 + 3584;
    if (j < 5120) return j - 4864 + 3908;
    if (j < 5376) return j - 5120 + 4164;
    if (j < 5440) return j - 5376 + 3840;
    if (j < 5444) return j - 5440 + 3904;
    if (j < 5460) return j - 5444 + 4932;
    if (j < 5632) return -1;
    return j - 5632 + 5460;
}

__device__ void ph_mod(const Params& p, int vb0, int nvb, char* smem_) {
    float* sc = (float*)smem_;
    float* part = sc + 8 * 1024;
    float* mod = (float*)(p.ws + WS_MOD);
    const int tid = TIDX(), lane = tid & 63, wave = tid >> 6;
    if (vb0 >= 192) return;
    for (int i = tid; i < 8 * 1024; i += NT) { float c = p.c[i]; sc[i] = c / (1.f + __expf(-c)); }
    __syncthreads();
    for (int task = vb0; task < 192; task += nvb) {
        const int l = task / 96, n0 = (task % 96) * 64;
        const float* w = p.w_ada + (size_t)l * 1024 * 6144 + (size_t)(wave * 128) * 6144 + n0 + lane;
        float acc[8];
#pragma unroll
        for (int b = 0; b < 8; ++b) acc[b] = 0.f;
#pragma unroll 1
        for (int k0 = 0; k0 < 128; k0 += 16) {
            float wv[16];
#pragma unroll
            for (int j = 0; j < 16; ++j) wv[j] = w[(size_t)(k0 + j) * 6144];
#pragma unroll
            for (int j = 0; j < 16; ++j)
#pragma unroll
                for (int b = 0; b < 8; ++b) acc[b] += sc[b * 1024 + wave * 128 + k0 + j] * wv[j];
        }
#pragma unroll
        for (int b = 0; b < 8; ++b) part[(wave * 8 + b) * 64 + lane] = acc[b];
        __syncthreads();
        {
            const int b = tid >> 6, col = tid & 63;
            float v = p.b_ada[l * 6144 + n0 + col];
#pragma unroll
            for (int w_ = 0; w_ < 8; ++w_) v += part[(w_ * 8 + b) * 64 + col];
            mod[(size_t)(l * 8 + b) * 6144 + n0 + col] = v;
        }
        __syncthreads();
    }
}

template <bool MAP>
__device__ void tr_tile(const float* __restrict__ src, int lds_, bf16_t* __restrict__ out, int ldo, int k0, int n0, float* tile, const int tid) {
    float lv[8];
    {
        const int nn = tid & 63, scol = MAP ? src_col(n0 + nn) : (n0 + nn);
#pragma unroll
        for (int i = 0; i < 8; ++i) { const int kk = (tid >> 6) + 8 * i; lv[i] = (scol >= 0) ? src[(size_t)(k0 + kk) * lds_ + scol] : 0.f; }
#pragma unroll
        for (int i = 0; i < 8; ++i) { const int kk = (tid >> 6) + 8 * i; tile[kk * 65 + nn] = lv[i]; }
    }
    __syncthreads();
#pragma unroll
    for (int i = 0; i < 4; ++i) {
        int nn = (tid >> 5) + 16 * i, kk = (tid & 31) * 2;
        unsigned v = pack2(tile[kk * 65 + nn], tile[(kk + 1) * 65 + nn]);
        *(unsigned*)(out + (size_t)(n0 + nn) * ldo + k0 + kk) = v;
    }
    __syncthreads();
}
__device__ void conv_chunk(const float* __restrict__ src, bf16_t* __restrict__ dst, size_t base, const int tid) {
    f32x4 la[4], lb[4];
#pragma unroll
    for (int i = 0; i < 4; ++i) { const size_t e = base + (size_t)(i * NT + tid) * 8; la[i] = *(const f32x4*)(src + e); lb[i] = *(const f32x4*)(src + e + 4); }
#pragma unroll
    for (int i = 0; i < 4; ++i) {
        size_t e = base + (size_t)(i * NT + tid) * 8;
        const float4 a = make_float4(la[i][0], la[i][1], la[i][2], la[i][3]), b = make_float4(lb[i][0], lb[i][1], lb[i][2], lb[i][3]);
        uint4 o; o.x = pack2(a.x, a.y); o.y = pack2(a.z, a.w); o.z = pack2(b.x, b.y); o.w = pack2(b.z, b.w);
        *(uint4*)(dst + e) = o;
    }
}
__device__ void conv_chunk_fp8(const float* __restrict__ src, unsigned char* __restrict__ dst, size_t base, float scale, const int tid) {
    f32x4 la[4], lb[4];
#pragma unroll
    for (int i = 0; i < 4; ++i) { const size_t e = base + (size_t)(i * NT + tid) * 8; la[i] = *(const f32x4*)(src + e); lb[i] = *(const f32x4*)(src + e + 4); }
#pragma unroll
    for (int i = 0; i < 4; ++i) {
        size_t e = base + (size_t)(i * NT + tid) * 8;
        const float4 a = make_float4(la[i][0], la[i][1], la[i][2], la[i][3]), b = make_float4(lb[i][0], lb[i][1], lb[i][2], lb[i][3]);
        int lo = __builtin_amdgcn_cvt_pk_fp8_f32(a.x * scale, a.y * scale, 0, false); lo = __builtin_amdgcn_cvt_pk_fp8_f32(a.z * scale, a.w * scale, lo, true);
        int hi = __builtin_amdgcn_cvt_pk_fp8_f32(b.x * scale, b.y * scale, 0, false); hi = __builtin_amdgcn_cvt_pk_fp8_f32(b.z * scale, b.w * scale, hi, true);
        const size_t row = e >> 10, col = e & 1023;
        *(uint2*)(dst + ((col >> 7) * 16384 + row) * 128 + (col & 127)) = make_uint2((unsigned)lo, (unsigned)hi);
    }
}
__device__ __forceinline__ bf16x8 ld8_f32_bf16(const float* src) {
    const f32x4 a = *(const f32x4*)src, b = *(const f32x4*)(src + 4);
    union { bf16x8 v; unsigned u[4]; } r; r.u[0] = pack2(a[0], a[1]); r.u[1] = pack2(a[2], a[3]); r.u[2] = pack2(b[0], b[1]); r.u[3] = pack2(b[2], b[3]);
    return r.v;
}
__device__ void wqk_task(const float* __restrict__ wq, const float* __restrict__ keys, bf16_t* __restrict__ out, int g, int kt, const int tid) {
    const int lane = tid & 63, wave = tid >> 6, fr = lane & 15, fq = lane >> 4;
    const float* kp = keys + ((size_t)g * 128 + wave * 16 + fr) * 128 + fq * 8;
    const float* wp = wq + (size_t)(kt * 64 + fr) * 2048 + g * 128 + fq * 8;
    f32x4 acc[4];
#pragma unroll
    for (int kb = 0; kb < 4; ++kb) acc[kb] = f32x4{0.f, 0.f, 0.f, 0.f};
#pragma unroll
    for (int dd = 0; dd < 4; ++dd) {
        const bf16x8 kf = ld8_f32_bf16(kp + dd * 32);
#pragma unroll
        for (int kb = 0; kb < 4; ++kb) acc[kb] = __builtin_amdgcn_mfma_f32_16x16x32_bf16(ld8_f32_bf16(wp + (size_t)(kb * 16) * 2048 + dd * 32), kf, acc[kb], 0, 0, 0);
    }
#pragma unroll
    for (int kb = 0; kb < 4; ++kb) {
        unsigned w[4];
#pragma unroll
        for (int j = 0; j < 4; ++j) { const unsigned u = __float_as_uint(acc[kb][j]); w[j] = (u + 0x7fffu + ((u >> 16) & 1u)) >> 16; }
        uint2 o; o.x = w[0] | (w[1] << 16); o.y = w[2] | (w[3] << 16);
        *(uint2*)(out + ((size_t)g * 128 + wave * 16 + fr) * 1024 + kt * 64 + kb * 16 + fq * 4) = o;
    }
}
__device__ void ph_wprep(const Params& p, int l, int vb0, int nvb, char* smem_) {
    float* tile = (float*)smem_;
    const int tid = TIDX();
    bf16_t* WIN = (bf16_t*)(p.ws + WS_WIN); bf16_t* WBR = (bf16_t*)(p.ws + WS_WBR); bf16_t* WOUT = (bf16_t*)(p.ws + WS_WOUT);
    bf16_t* WQ = (bf16_t*)(p.ws + WS_WQ); unsigned char* PU = p.ws + WS_PU; unsigned char* PV = p.ws + WS_PV;
    constexpr int N_WIN = 136 * 16, N_WBR = 3 * 16 * 8, N_WOUT = 16 * 16, N_WQ = 16 * 16, N_PU = 1024, N_PV = 1024;
    constexpr int TOTAL = N_WIN + N_WBR + N_WOUT + N_WQ + N_PU + N_PV;
    for (int task = vb0; task < TOTAL; task += nvb) {
        int r = task;
        if (r < N_WIN) { int nt = r / 16, kt = r % 16; tr_tile<true>(p.w_in + (size_t)l * 1024 * IN_COLS, IN_COLS, WIN, 1024, kt * 64, nt * 64, tile, tid); continue; }
        r -= N_WIN;
        if (r < N_WBR) { int g = r / 128, rr = r % 128, nt = rr / 8, kt = rr % 8;
            tr_tile<false>(p.w_branch + (size_t)(l * 3 + g) * 512 * 1024, 1024, WBR + (size_t)g * 1024 * 512, 512, kt * 64, nt * 64, tile, tid); continue; }
        r -= N_WBR;
        if (r < N_WOUT) { int nt = r / 16, kt = r % 16; tr_tile<false>(p.w_out + (size_t)l * 1024 * 1024, 1024, WOUT, 1024, kt * 64, nt * 64, tile, tid); continue; }
        r -= N_WOUT;
        if (r < N_WQ) { wqk_task(p.peer_wq + (size_t)l * 1024 * 2048, p.peer_keys + (size_t)l * 16 * 128 * 128, WQ, r / 16, r % 16, tid); continue; }
        r -= N_WQ;
        if (r < N_PU) { conv_chunk_fp8(p.peer_u + (size_t)l * 16384 * 1024, PU, (size_t)r * 16384, PU_SCALE, tid); continue; }
        r -= N_PU;
        conv_chunk_fp8(p.peer_v + (size_t)l * 16384 * 1024, PV, (size_t)r * 16384, PV_SCALE, tid);
    }
}

__device__ void ph_norm(const Params& p, int l, int which, const float* xin, int vb0, int nvb) {
    const int wave = TIDX() >> 6, lane = TIDX() & 63;
    const float* gain = (which ? p.norm_ffn : p.norm_mix) + l * 1024;
    const float* modb = (const float*)(p.ws + WS_MOD);
    bf16_t* H = (bf16_t*)(p.ws + WS_H);
    f32x4 g[4];
#pragma unroll
    for (int i = 0; i < 4; ++i) g[i] = *(const f32x4*)(gain + (lane + 64 * i) * 4);
    for (int t = vb0 * 8 + wave; t < T_TOK; t += nvb * 8) {
        const int b = t >> 11;
        const float* mod = modb + (size_t)(l * 8 + b) * 6144 + (which ? 3072 : 0);
        const f32x4* xr = (const f32x4*)(xin + (size_t)t * 1024);
        f32x4 v[4], sc[4], sh[4]; float ss = 0.f;
#pragma unroll
        for (int i = 0; i < 4; ++i) { v[i] = xr[lane + 64 * i]; sc[i] = *(const f32x4*)(mod + 1024 + (lane + 64 * i) * 4); sh[i] = *(const f32x4*)(mod + (lane + 64 * i) * 4); }
#pragma unroll
        for (int i = 0; i < 4; ++i) ss += v[i][0] * v[i][0] + v[i][1] * v[i][1] + v[i][2] * v[i][2] + v[i][3] * v[i][3];
        ss = wave_sum(ss);
        const float rstd = rsqrtf(ss * (1.f / 1024.f) + 1e-6f);
#pragma unroll
        for (int i = 0; i < 4; ++i) {
            const int idx = (lane + 64 * i) * 4;
            const f32x4 h = v[i] * rstd * g[i] * (1.f + sc[i]) + sh[i];
            uint2 o; o.x = pack2(h[0], h[1]); o.y = pack2(h[2], h[3]);
            *(uint2*)(H + (size_t)t * 1024 + idx) = o;
            if (which) {
                int hi = __builtin_amdgcn_cvt_pk_fp8_f32(h[0], h[1], 0, false); hi = __builtin_amdgcn_cvt_pk_fp8_f32(h[2], h[3], hi, true);
                const auto d0 = __builtin_amdgcn_cvt_pk_f32_fp8(hi, false); const auto d1 = __builtin_amdgcn_cvt_pk_f32_fp8(hi, true);
                int lo = __builtin_amdgcn_cvt_pk_fp8_f32((h[0] - d0[0]) * 16.f, (h[1] - d0[1]) * 16.f, 0, false);
                lo = __builtin_amdgcn_cvt_pk_fp8_f32((h[2] - d1[0]) * 16.f, (h[3] - d1[1]) * 16.f, lo, true);
                *(int*)(p.ws + WS_H8H + (size_t)t * 1024 + idx) = hi;
                *(int*)(p.ws + WS_H8L + (size_t)t * 1024 + idx) = lo;
            }
        }
    }
}

constexpr int GBM = 256, GBN = 128, GBK = 64, GLS = 72;
__device__ __forceinline__ void gemm_tile(const bf16_t* __restrict__ A, int lda, const bf16_t* __restrict__ Bt, int ldb, int K,
                                          int m0, int n0, bf16_t* sA, bf16_t* sB, f32x4 (&acc)[4][4], const int tid) {
    const int lane = tid & 63, wave = tid >> 6;
    const int wm = wave >> 1, wn = wave & 1, fr = lane & 15, fq = lane >> 4;
    u32x4 ra[4], rb[2];
    const int crow = tid >> 3, ckc = (tid & 7) * 8;
    const bf16_t* Ag = A + (size_t)(m0 + crow) * lda + ckc;
    const bf16_t* Bg = Bt + (size_t)(n0 + crow) * ldb + ckc;
#pragma unroll
    for (int i = 0; i < 4; ++i) ra[i] = *(const u32x4*)(Ag + (size_t)(64 * i) * lda);
#pragma unroll
    for (int i = 0; i < 2; ++i) rb[i] = *(const u32x4*)(Bg + (size_t)(64 * i) * ldb);
    for (int k0 = 0; k0 < K; k0 += GBK) {
        __syncthreads();
#pragma unroll
        for (int i = 0; i < 4; ++i) *(u32x4*)(sA + (crow + 64 * i) * GLS + ckc) = ra[i];
#pragma unroll
        for (int i = 0; i < 2; ++i) *(u32x4*)(sB + (crow + 64 * i) * GLS + ckc) = rb[i];
        __syncthreads();
        {
            const int kn = (k0 + GBK < K) ? (k0 + GBK) : k0;
#pragma unroll
            for (int i = 0; i < 4; ++i) ra[i] = *(const u32x4*)(Ag + (size_t)(64 * i) * lda + kn);
#pragma unroll
            for (int i = 0; i < 2; ++i) rb[i] = *(const u32x4*)(Bg + (size_t)(64 * i) * ldb + kn);
        }
#pragma unroll
        for (int ks = 0; ks < 2; ++ks) {
            bf16x8 af[4], wf[4];
#pragma unroll
            for (int mf = 0; mf < 4; ++mf) af[mf] = *(const bf16x8*)(sA + (wm * 64 + mf * 16 + fr) * GLS + ks * 32 + fq * 8);
#pragma unroll
            for (int nf = 0; nf < 4; ++nf) wf[nf] = *(const bf16x8*)(sB + (wn * 64 + nf * 16 + fr) * GLS + ks * 32 + fq * 8);
#pragma unroll
            for (int nf = 0; nf < 4; ++nf)
#pragma unroll
                for (int mf = 0; mf < 4; ++mf)
                    acc[nf][mf] = __builtin_amdgcn_mfma_f32_16x16x32_bf16(wf[nf], af[mf], acc[nf][mf], 0, 0, 0);
        }
    }
}


namespace pg8 {
#define PG8_LAS __attribute__((address_space(3)))
constexpr int BM = 256, BK = 64, HALF = 128, HTB = HALF * BK * 2, STAGE_BYTES = 8 * HTB, NXCD = 8, WGM = 8;
__device__ __forceinline__ int lds_byte(int r, int c) { const int st = (r >> 4) * 2 + (c >> 5), rr = r & 15, cc = c & 31, ob = rr * 64 + cc * 2; return st * 1024 + (ob ^ (((ob >> 9) & 1) << 5)); }
__device__ __forceinline__ void stage_rc(int b, int& R, int& C) { const int st = b / 1024, sb = b % 1024, swz = sb ^ (((sb >> 9) & 1) << 5); R = (st >> 1) * 16 + swz / 64; C = (st & 1) * 32 + (swz % 64) / 2; }
__device__ __forceinline__ int perm32(int rho) { const int n = rho >> 4, i = rho & 15; return 8 * (i >> 2) + 4 * n + (i & 3); }
struct Unit { int pm, pn, aux; size_t aoff, boff; };
struct Gemm { const bf16_t* A; const bf16_t* Bt; int lda, ldb, K; };

struct StaticOrder {
    int nM, nN, nwg, G, c, lda, ldb;
    __device__ void init(int M, int N, int G_, int c_, int lda_, int ldb_) { nM = M / BM; nN = N / BM; nwg = nM * nN; G = G_; c = c_; lda = lda_; ldb = ldb_; }
    __device__ bool next(int i, Unit& u) const {
        const long L = (long)i * G + c; if (L >= nwg) return false;
        int wgid = (int)L; { const int q = nwg / NXCD, r = nwg % NXCD, xcd = wgid % NXCD, off = wgid / NXCD; wgid = (xcd < r ? xcd * (q + 1) : r * (q + 1) + (xcd - r) * q) + off; }
        const int nig = WGM * nN, gid = wgid / nig, fm = gid * WGM, gsz = (nM - fm) < WGM ? (nM - fm) : WGM;
        u.pm = fm + ((wgid % nig) % gsz); u.pn = (wgid % nig) / gsz; u.aux = 0;
        u.aoff = (size_t)u.pm * BM * lda * 2; u.boff = (size_t)u.pn * BM * ldb * 2;
        return true;
    }
};
struct MergeOrder {
    int c, G;
    __device__ bool next(int i, Unit& u) const {
        const int tile = c + (i / 3) * G; if (tile >= 256) return false;
        u.pm = tile & 63; u.pn = tile >> 6; u.aux = i % 3;
        u.aoff = ((size_t)u.pm * BM * 1536 + (size_t)u.aux * 512) * 2; u.boff = ((size_t)u.aux * 1024 + (size_t)u.pn * BM) * 512 * 2;
        return true;
    }
};

template <class Epi, class Sched>
__device__ __forceinline__ void gemm_phase(PG8_LAS unsigned char* lds, const Gemm g, const Sched& S, const Epi& E, const int tid) {
    const int wid = __builtin_amdgcn_readfirstlane(tid >> 6), lane = tid & 63, wr = wid >> 2, wc = wid & 3, fr = lane & 15, fq = lane >> 4;
    const int K = g.K, nt = K / BK;
    unsigned voffA[2], voffB[2];
#pragma unroll
    for (int i = 0; i < 2; ++i) { int R, C; stage_rc(tid * 16 + i * 8192, R, C); const int Rb = Epi::PERM ? ((R & ~31) + perm32(R & 31)) : R;
        voffA[i] = (unsigned)(R * g.lda + C) * 2u; voffB[i] = (unsigned)(Rb * g.ldb + C) * 2u; }
    const size_t kstep = (size_t)(BK * 2);
    const size_t hstepA = (size_t)HALF * g.lda * 2, hstepB = (size_t)HALF * g.ldb * 2;
    const unsigned ldsw = (unsigned)wid * 1024u;
    const int aoff = lds_byte(wr * 64 + fr, fq * 8), boff = lds_byte(wc * 32 + fr, fq * 8);
#define PG8_SA(b, h) (((b) * 2 + (h)) * HTB)
#define PG8_SB(b, h) ((4 + (b) * 2 + (h)) * HTB)
#define PG8_STAGE(bufoff, gbase, voff) do { _Pragma("unroll") for (int _i = 0; _i < 2; ++_i) \
        __builtin_amdgcn_global_load_lds((const unsigned*)((const char*)(gbase) + (voff)[_i]), (PG8_LAS unsigned*)(lds + (bufoff) + ldsw + _i * 8192), 16, 0, 0); } while (0)
#define PG8_LDA(dst, b, h) do { _Pragma("unroll") for (int m = 0; m < 4; ++m) _Pragma("unroll") for (int k = 0; k < 2; ++k) dst[m][k] = *(const PG8_LAS bf16x8*)(lds + PG8_SA(b, h) + aoff + m * 2048 + k * 1024); } while (0)
#define PG8_LDB(dst, b, h) do { _Pragma("unroll") for (int n = 0; n < 2; ++n) _Pragma("unroll") for (int k = 0; k < 2; ++k) dst[n][k] = *(const PG8_LAS bf16x8*)(lds + PG8_SB(b, h) + boff + n * 2048 + k * 1024); } while (0)
#define PG8_MMA(ai, bj, At, Bt) do { __builtin_amdgcn_s_setprio(1); _Pragma("unroll") for (int m = 0; m < 4; ++m) _Pragma("unroll") for (int n = 0; n < 2; ++n) _Pragma("unroll") for (int k = 0; k < 2; ++k) \
        acc[ai][bj][m][n] = __builtin_amdgcn_mfma_f32_16x16x32_bf16(Bt[n][k], At[m][k], acc[ai][bj][m][n], 0, 0, 0); __builtin_amdgcn_s_setprio(0); } while (0)
#define PG8_WAIT_V(n) asm volatile("s_waitcnt vmcnt(" #n ")" ::: "memory")
#define PG8_WAIT_L(n) asm volatile("s_waitcnt lgkmcnt(" #n ")" ::: "memory")
#define PG8_BAR __builtin_amdgcn_s_barrier()
#define PG8_SCHED __builtin_amdgcn_sched_barrier(0)
    Unit cur, nxt; int ui = 0;
    if (!S.next(0, cur)) return;
    f32x4 acc[2][2][4][2];
#pragma unroll
    for (int a = 0; a < 2; ++a)
#pragma unroll
        for (int b = 0; b < 2; ++b)
#pragma unroll
            for (int m = 0; m < 4; ++m)
#pragma unroll
                for (int n = 0; n < 2; ++n) acc[a][b][m][n] = f32x4{0.f, 0.f, 0.f, 0.f};
    bf16x8 At[4][2], B0[2][2], B1[2][2];
    const char* cA = (const char*)g.A + cur.aoff; const char* cB = (const char*)g.Bt + cur.boff;
    PG8_STAGE(PG8_SB(0, 0), cB, voffB); PG8_STAGE(PG8_SA(0, 0), cA, voffA); PG8_STAGE(PG8_SB(0, 1), cB + hstepB, voffB); PG8_STAGE(PG8_SA(0, 1), cA + hstepA, voffA);
    if (wr == 1) PG8_BAR;
    PG8_WAIT_V(4); PG8_BAR;
    PG8_STAGE(PG8_SB(1, 0), cB + kstep, voffB); PG8_STAGE(PG8_SA(1, 0), cA + kstep, voffA); PG8_STAGE(PG8_SB(1, 1), cB + hstepB + kstep, voffB);
    PG8_WAIT_V(6); PG8_BAR;
    for (;;) {
        const bool has_next = S.next(ui + 1, nxt);
        const char* nA = has_next ? (const char*)g.A + nxt.aoff : cA; const char* nB = has_next ? (const char*)g.Bt + nxt.boff : cB;
        for (int t = 0; t < nt; t += 2) {
            const bool last = (t == nt - 2);
            const char* a1 = cA + (size_t)(t + 1) * kstep;
            const char* a2 = last ? nA : cA + (size_t)(t + 2) * kstep; const char* b2 = last ? nB : cB + (size_t)(t + 2) * kstep;
            const char* a3 = a2 + kstep; const char* b3 = b2 + kstep;
            PG8_LDB(B0, 0, 0); PG8_SCHED; PG8_LDA(At, 0, 0); PG8_STAGE(PG8_SA(1, 1), a1 + hstepA, voffA);
            PG8_WAIT_L(8); PG8_BAR; PG8_WAIT_L(0); PG8_MMA(0, 0, At, B0); PG8_BAR; PG8_SCHED;
            PG8_LDB(B1, 0, 1); PG8_STAGE(PG8_SB(0, 0), b2, voffB);
            PG8_BAR; PG8_WAIT_L(0); PG8_MMA(0, 1, At, B1); PG8_BAR;
            PG8_LDA(At, 0, 1); PG8_STAGE(PG8_SA(0, 0), a2, voffA);
            PG8_BAR; PG8_WAIT_L(0); PG8_MMA(1, 0, At, B0); PG8_BAR; PG8_SCHED;
            PG8_STAGE(PG8_SB(0, 1), b2 + hstepB, voffB);
            PG8_WAIT_V(6); PG8_BAR; PG8_MMA(1, 1, At, B1); PG8_BAR;
            PG8_LDB(B0, 1, 0); PG8_SCHED; PG8_LDA(At, 1, 0); PG8_STAGE(PG8_SA(0, 1), a2 + hstepA, voffA);
            PG8_WAIT_L(8); PG8_BAR; PG8_WAIT_L(0); PG8_MMA(0, 0, At, B0); PG8_BAR; PG8_SCHED;
            PG8_LDB(B1, 1, 1); PG8_STAGE(PG8_SB(1, 0), b3, voffB);
            PG8_BAR; PG8_WAIT_L(0); PG8_MMA(0, 1, At, B1); PG8_BAR;
            PG8_LDA(At, 1, 1); PG8_STAGE(PG8_SA(1, 0), a3, voffA);
            PG8_BAR; PG8_WAIT_L(0); PG8_MMA(1, 0, At, B0); PG8_BAR; PG8_SCHED;
            PG8_STAGE(PG8_SB(1, 1), b3 + hstepB, voffB);
            PG8_WAIT_V(6); PG8_BAR; PG8_MMA(1, 1, At, B1); PG8_BAR;
        }
        E(acc, cur, wr, wc, fr, fq);
        if (!has_next) break;
#pragma unroll
        for (int a = 0; a < 2; ++a)
#pragma unroll
            for (int b = 0; b < 2; ++b)
#pragma unroll
                for (int m = 0; m < 4; ++m)
#pragma unroll
                    for (int n = 0; n < 2; ++n) acc[a][b][m][n] = f32x4{0.f, 0.f, 0.f, 0.f};
        cur = nxt; cA = nA; cB = nB; ++ui;
    }
    PG8_WAIT_V(0);
    if (wr == 0) PG8_BAR;
    PG8_BAR;
#undef PG8_SA
#undef PG8_SB
#undef PG8_STAGE
#undef PG8_LDA
#undef PG8_LDB
#undef PG8_MMA
#undef PG8_WAIT_V
#undef PG8_WAIT_L
#undef PG8_BAR
#undef PG8_SCHED
}

struct EpiBf16 {
    static constexpr bool PERM = true;
    bf16_t* O; int ldc;
    __device__ __forceinline__ void operator()(const f32x4 (&acc)[2][2][4][2], const Unit& u, int wr, int wc, int fr, int fq) const {
        const int row0 = u.pm * BM + wr * 64 + fr, col0 = u.pn * BM + wc * 32 + 8 * fq;
#pragma unroll
        for (int ai = 0; ai < 2; ++ai)
#pragma unroll
            for (int m = 0; m < 4; ++m) { bf16_t* rowp = O + (size_t)(row0 + ai * HALF + m * 16) * ldc + col0;
#pragma unroll
                for (int bj = 0; bj < 2; ++bj) { const f32x4 v0 = acc[ai][bj][m][0], v1 = acc[ai][bj][m][1];
                    u32x4 w; w.x = pack2(v0[0], v0[1]); w.y = pack2(v0[2], v0[3]); w.z = pack2(v1[0], v1[1]); w.w = pack2(v1[2], v1[3]);
                    *(u32x4*)(rowp + bj * HALF) = w; } }
    }
};
struct EpiF16P {
    static constexpr bool PERM = true;
    _Float16* O; int ldc;
    __device__ __forceinline__ void operator()(const f32x4 (&acc)[2][2][4][2], const Unit& u, int wr, int wc, int fr, int fq) const {
        typedef _Float16 h8v __attribute__((ext_vector_type(8)));
        const int row0 = u.pm * BM + wr * 64 + fr, col0 = u.pn * BM + wc * 32 + 8 * fq;
#pragma unroll
        for (int ai = 0; ai < 2; ++ai)
#pragma unroll
            for (int m = 0; m < 4; ++m) { _Float16* rowp = O + (size_t)(row0 + ai * HALF + m * 16) * ldc + col0;
#pragma unroll
                for (int bj = 0; bj < 2; ++bj) { const f32x4 v0 = acc[ai][bj][m][0], v1 = acc[ai][bj][m][1];
                    const h8v w = {(_Float16)v0[0], (_Float16)v0[1], (_Float16)v0[2], (_Float16)v0[3], (_Float16)v1[0], (_Float16)v1[1], (_Float16)v1[2], (_Float16)v1[3]};
                    *(h8v*)(rowp + bj * HALF) = w; } }
    }
};
struct EpiResid {
    static constexpr bool PERM = false;
    const float* xin; float* out; const float* mod;
    __device__ __forceinline__ void operator()(const f32x4 (&acc)[2][2][4][2], const Unit& u, int wr, int wc, int fr, int fq) const {
        const int row0 = u.pm * BM + wr * 64 + fr, col0 = u.pn * BM + wc * 32 + 4 * fq;
        const float* gm = mod + (size_t)(row0 >> 11) * 6144 + 2048 + col0;
        f32x4 g4[2][2];
#pragma unroll
        for (int bj = 0; bj < 2; ++bj)
#pragma unroll
            for (int n = 0; n < 2; ++n) g4[bj][n] = *(const f32x4*)(gm + bj * HALF + n * 16);
#pragma unroll
        for (int ai = 0; ai < 2; ++ai) {
            f32x4 xi[4][2][2];
#pragma unroll
            for (int m = 0; m < 4; ++m)
#pragma unroll
                for (int bj = 0; bj < 2; ++bj)
#pragma unroll
                    for (int n = 0; n < 2; ++n) xi[m][bj][n] = *(const f32x4*)(xin + (size_t)(row0 + ai * HALF + m * 16) * 1024 + col0 + bj * HALF + n * 16);
            asm volatile("" ::: "memory");
#pragma unroll
            for (int m = 0; m < 4; ++m)
#pragma unroll
                for (int bj = 0; bj < 2; ++bj)
#pragma unroll
                    for (int n = 0; n < 2; ++n)
                        *(f32x4*)(out + (size_t)(row0 + ai * HALF + m * 16) * 1024 + col0 + bj * HALF + n * 16) = xi[m][bj][n] + g4[bj][n] * acc[ai][bj][m][n];
            asm volatile("" ::: "memory");
        }
    }
};
struct EpiMerge {
    static constexpr bool PERM = true;
    bf16_t* Hm; const bf16_t* Z;
    __device__ __forceinline__ void operator()(const f32x4 (&acc)[2][2][4][2], const Unit& u, int wr, int wc, int fr, int fq) const {
        const int row0 = u.pm * BM + wr * 64 + fr, col0 = u.pn * BM + wc * 32 + 8 * fq, g = u.aux;
#pragma unroll
        for (int ai = 0; ai < 2; ++ai) {
            u32x4 gz[4][2], prev[4][2];
#pragma unroll
            for (int m = 0; m < 4; ++m)
#pragma unroll
                for (int bj = 0; bj < 2; ++bj) {
                    const int row = row0 + ai * HALF + m * 16, col = col0 + bj * HALF;
                    gz[m][bj] = *(const u32x4*)(Z + (size_t)row * LDZ + ZM + g * 1024 + col);
                    prev[m][bj] = u32x4{0u, 0u, 0u, 0u};
                    if (g > 0) prev[m][bj] = *(const u32x4*)(Hm + (size_t)row * 1024 + col);
                }
            asm volatile("" ::: "memory");
#pragma unroll
            for (int m = 0; m < 4; ++m)
#pragma unroll
                for (int bj = 0; bj < 2; ++bj) {
                    const int row = row0 + ai * HALF + m * 16, col = col0 + bj * HALF;
                    const f32x4 v0 = acc[ai][bj][m][0], v1 = acc[ai][bj][m][1];
                    const u32x4 z_ = gz[m][bj], p_ = prev[m][bj];
                    u32x4 w;
                    w.x = pack2(bflo(p_.x) + sigm(bflo(z_.x)) * v0[0], bfhi(p_.x) + sigm(bfhi(z_.x)) * v0[1]);
                    w.y = pack2(bflo(p_.y) + sigm(bflo(z_.y)) * v0[2], bfhi(p_.y) + sigm(bfhi(z_.y)) * v0[3]);
                    w.z = pack2(bflo(p_.z) + sigm(bflo(z_.z)) * v1[0], bfhi(p_.z) + sigm(bfhi(z_.z)) * v1[1]);
                    w.w = pack2(bflo(p_.w) + sigm(bflo(z_.w)) * v1[2], bfhi(p_.w) + sigm(bfhi(z_.w)) * v1[3]);
                    *(u32x4*)(Hm + (size_t)row * 1024 + col) = w;
                }
            asm volatile("" ::: "memory");
        }
    }
};
}

struct EpiZ {
    bf16_t* Z; int ld;
    __device__ __forceinline__ void operator()(int m, int n, const f32x4& v) const {
        uint2 o; o.x = pack2(v[0], v[1]); o.y = pack2(v[2], v[3]);
        *(uint2*)(Z + (size_t)m * ld + n) = o;
    }
};
struct EpiF16 {
    _Float16* C; int ld;
    __device__ __forceinline__ void operator()(int m, int n, const f32x4& v) const {
        typedef _Float16 h4 __attribute__((ext_vector_type(4)));
        h4 o = {(_Float16)v[0], (_Float16)v[1], (_Float16)v[2], (_Float16)v[3]};
        *(h4*)(C + (size_t)m * ld + n) = o;
    }
};
struct EpiOut {
    const float* xin; float* out; const float* mod;
    __device__ __forceinline__ void operator()(int m, int n, const f32x4& v) const {
        int b = m >> 11;
        float4 g = *(const float4*)(mod + (size_t)b * 6144 + 2048 + n);
        float4 xi = *(const float4*)(xin + (size_t)m * 1024 + n);
        *(float4*)(out + (size_t)m * 1024 + n) = make_float4(xi.x + g.x * v[0], xi.y + g.y * v[1], xi.z + g.z * v[2], xi.w + g.w * v[3]);
    }
};

template <class Epi>
__device__ void gemm_phase(const bf16_t* A, int lda, const bf16_t* Bt, int ldb, int M, int N, int K, bool batched, Epi epi,
                           int vb0, int nvb, char* smem_, const int tid) {
    bf16_t* sA = (bf16_t*)smem_; bf16_t* sB = sA + GBM * GLS;
    const int lane = tid & 63, wave = tid >> 6, wm = wave >> 1, wn = wave & 1, fr = lane & 15, fq = lane >> 4;
    const int MT = M / GBM, NTL = N / GBN;
    for (int tile = vb0; tile < MT * NTL; tile += nvb) {
        int mt = tile % MT, nt = tile / MT;
        f32x4 acc[4][4];
#pragma unroll
        for (int a = 0; a < 4; ++a)
#pragma unroll
            for (int b = 0; b < 4; ++b) acc[a][b] = f32x4{0.f, 0.f, 0.f, 0.f};
        gemm_tile(batched ? A + nt * 128 : A, lda, Bt, ldb, K, mt * GBM, nt * GBN, sA, sB, acc, tid);
#pragma unroll
        for (int nf = 0; nf < 4; ++nf)
#pragma unroll
            for (int mf = 0; mf < 4; ++mf)
                epi(mt * GBM + wm * 64 + mf * 16 + fr, nt * GBN + wn * 64 + nf * 16 + fq * 4, acc[nf][mf]);
    }
}
__device__ __forceinline__ void sc_tile(const Params& p, int mt, int nt, char* smem_, const int tid) {
    bf16_t* sA = (bf16_t*)smem_; bf16_t* sB = sA + GBM * GLS;
    const int lane = tid & 63, wave = tid >> 6, wm = wave >> 1, wn = wave & 1, fr = lane & 15, fq = lane >> 4;
    f32x4 acc[4][4];
#pragma unroll
    for (int a = 0; a < 4; ++a)
#pragma unroll
        for (int b = 0; b < 4; ++b) acc[a][b] = f32x4{0.f, 0.f, 0.f, 0.f};
    gemm_tile((const bf16_t*)(p.ws + WS_QP) + nt * 128, 2048, (const bf16_t*)(p.ws + WS_SK), 128, 128, mt * GBM, nt * GBN, sA, sB, acc, tid);
    const EpiF16 epi{(_Float16*)(p.ws + WS_SC), 2048};
#pragma unroll
    for (int nf = 0; nf < 4; ++nf)
#pragma unroll
        for (int mf = 0; mf < 4; ++mf)
            epi(mt * GBM + wm * 64 + mf * 16 + fr, nt * GBN + wn * 64 + nf * 16 + fq * 4, acc[nf][mf]);
}

#define SCAN_SYNC() do { asm volatile("s_waitcnt lgkmcnt(0)" ::: "memory"); __builtin_amdgcn_s_barrier(); asm volatile("" ::: "memory"); } while (0)
template <int DK, bool GLA>
__device__ void scan2_item(const Params& p, int l, int b, int h, char* smem_) {
    constexpr int SEG = NT / DK, SLEN = 64 / SEG, KS = DK / 32, KT = DK / 16;
    constexpr int QS = DK + 8, BS = DK + 4, VS = 72;
    bf16_t* qs = (bf16_t*)smem_;
    bf16_t* ks = qs + 64 * QS;
    float* bs = (float*)(ks + 64 * QS);
    bf16_t* vt = (bf16_t*)(bs + 64 * BS);
    bf16_t* At = vt + 128 * VS;
    bf16_t* kht = At + 64 * VS;
    bf16_t* st = kht + DK * VS;
    float* segtot = (float*)(st + 128 * QS);
    float* blast = segtot + SEG * DK;
    const int tid = TIDX(), lane = tid & 63, wave = __builtin_amdgcn_readfirstlane(tid >> 6), fr = lane & 15, fq = lane >> 4;
    const int kl = tid % DK, seg = __builtin_amdgcn_readfirstlane(tid / DK);
    float lbv = 0.f, gbias = 0.f; float gu[16];
#pragma unroll
    for (int r = 0; r < 16; ++r) gu[r] = 0.f;
    if (GLA) {
#pragma unroll
        for (int r = 0; r < 16; ++r) gu[r] = p.gla_up[(size_t)(l * 16 + r) * 256 + h * 64 + kl];
        gbias = p.gla_bias[l * 256 + h * 64 + kl];
    } else if (l == 1) {
        float x0 = p.hgrn_lb[h * 128 + kl], x1 = p.hgrn_lb[512 + h * 128 + kl];
        lbv = 1.f / (1.f + expf(x0 - x1));
    }
    const float scale = GLA ? 0.125f : 0.08838834764831845f;
    const bf16_t* Zb = (const bf16_t*)(p.ws + WS_Z) + (size_t)(b * 2048) * LDZ;
    float* ssq = (float*)(smem_ + 152576);
    const int QCOL = (GLA ? ZC_Q : ZA_Q) + h * DK, KCOL = (GLA ? ZC_K : ZA_F) + h * DK, VCOL = (GLA ? ZC_V : ZA_I) + h * 128, GCOL = (GLA ? ZC_G : ZA_G) + h * 128;
    f32x4 sacc[KT];
#pragma unroll
    for (int i = 0; i < KT; ++i) sacc[i] = f32x4{0.f, 0.f, 0.f, 0.f};
    f32x4 gn4[4];
    {
        const float* gn = (GLA ? p.gla_on : p.hgrn_on) + l * 128 + (wave >> 2) * 64 + 4 * fq;
#pragma unroll
        for (int vi = 0; vi < 4; ++vi) gn4[vi] = *(const f32x4*)(gn + vi * 16);
    }
    for (int i = tid; i < 128 * QS / 2; i += NT) ((unsigned*)st)[i] = 0u;
    SCAN_SYNC();

    bf16_t rq[SLEN], rk[SLEN], rv[16];
    u32x4 rc0[GLA ? SLEN : 1], rc1[GLA ? SLEN : 1];
    const int v_ = tid & 127, sb_ = __builtin_amdgcn_readfirstlane(tid >> 7);
#define SCAN_FETCH(cc) do { const bf16_t* Zn_ = Zb + (size_t)((cc) * 64) * LDZ; \
        _Pragma("unroll") for (int i = 0; i < 16; ++i) rv[i] = Zn_[(size_t)(sb_ + 4 * i) * LDZ + VCOL + v_]; \
        _Pragma("unroll") for (int i = 0; i < SLEN; ++i) { const bf16_t* zr = Zn_ + (size_t)(seg * SLEN + i) * LDZ; rq[i] = zr[QCOL + kl]; rk[i] = zr[KCOL + kl]; \
            if (GLA) { rc0[i] = *(const u32x4*)(zr + ZC_CODE); rc1[i] = *(const u32x4*)(zr + ZC_CODE + 8); } } } while (0)
    SCAN_FETCH(0);
    for (int c = 0; c < 32; ++c) {
        const bf16_t* Zc = Zb + (size_t)(c * 64) * LDZ;
        {
#pragma unroll
            for (int i = 0; i < 16; ++i) vt[v_ * VS + sb_ + 4 * i] = rv[i];
            float run = 0.f;
#pragma unroll
            for (int i = 0; i < SLEN; ++i) {
                const int s_ = seg * SLEN + i;
                float g, kk;
                if (GLA) {
                    float x = gbias;
#pragma unroll
                    for (int r = 0; r < 4; ++r) {
                        x += bflo(rc0[i][r]) * gu[2 * r] + bfhi(rc0[i][r]) * gu[2 * r + 1];
                        x += bflo(rc1[i][r]) * gu[8 + 2 * r] + bfhi(rc1[i][r]) * gu[8 + 2 * r + 1];
                    }
                    g = (fminf(x, 0.f) - __logf(1.f + __expf(-fabsf(x)))) * (1.f / 16.f);
                    kk = bf2f(rk[i]);
                } else {
                    const float f = lbv + (1.f - lbv) * __frcp_rn(1.f + __expf(-bf2f(rk[i])));
                    g = __logf(f); kk = 1.f - f;
                }
                run += g;
                bs[s_ * BS + kl] = run;
                qs[s_ * QS + kl] = rq[i];
                ks[s_ * QS + kl] = f2bf(kk);
            }
            segtot[seg * DK + kl] = run;
            SCAN_FETCH(c < 31 ? c + 1 : 31);
        }
        SCAN_SYNC();
        {
            float pre = 0.f, tot = 0.f;
#pragma unroll
            for (int g_ = 0; g_ < SEG; ++g_) { const float v_ = segtot[g_ * DK + kl]; if (g_ < seg) pre += v_; tot += v_; }
            if (seg == 0) blast[kl] = tot;
            unsigned pk[SLEN / 2];
#pragma unroll
            for (int i = 0; i < SLEN; ++i) {
                const float bv = bs[(seg * SLEN + i) * BS + kl] + pre;
                bs[(seg * SLEN + i) * BS + kl] = bv;
                const float kh = bf2f(ks[(seg * SLEN + i) * QS + kl]) * __expf(tot - bv);
                if (i & 1) pk[i >> 1] |= ((unsigned)f2bf(kh)) << 16; else pk[i >> 1] = (unsigned)f2bf(kh);
            }
            unsigned* dst = (unsigned*)(kht + kl * VS + seg * SLEN);
#pragma unroll
            for (int i = 0; i < SLEN / 2; ++i) dst[i] = pk[i];
        }
        SCAN_SYNC();
        for (int blk = wave; blk < 10; blk += 8) {
            int bi, bj;
            if (blk < 1) { bi = 0; bj = 0; } else if (blk < 3) { bi = 1; bj = blk - 1; } else if (blk < 6) { bi = 2; bj = blk - 3; } else { bi = 3; bj = blk - 6; }
            f32x4 acc = f32x4{0.f, 0.f, 0.f, 0.f};
            const int srow = bj * 16 + fr, trow = bi * 16 + fr;
#pragma unroll
            for (int kk = 0; kk < KS; ++kk) {
                const int k0 = kk * 32 + fq * 8;
                float br[8];
                if (bi == 0) {
#pragma unroll
                    for (int j = 0; j < 8; ++j) br[j] = 0.f;
                } else {
                    const float4 r0 = *(const float4*)(bs + (bi * 16 - 1) * BS + k0), r1 = *(const float4*)(bs + (bi * 16 - 1) * BS + k0 + 4);
                    br[0] = r0.x; br[1] = r0.y; br[2] = r0.z; br[3] = r0.w; br[4] = r1.x; br[5] = r1.y; br[6] = r1.z; br[7] = r1.w;
                }
                const uint4 kq = *(const uint4*)(ks + srow * QS + k0), qq = *(const uint4*)(qs + trow * QS + k0);
                const float4 s0 = *(const float4*)(bs + srow * BS + k0), s1 = *(const float4*)(bs + srow * BS + k0 + 4);
                const float4 t0_ = *(const float4*)(bs + trow * BS + k0), t1_ = *(const float4*)(bs + trow * BS + k0 + 4);
                const float bsv[8] = {s0.x, s0.y, s0.z, s0.w, s1.x, s1.y, s1.z, s1.w}, btv[8] = {t0_.x, t0_.y, t0_.z, t0_.w, t1_.x, t1_.y, t1_.z, t1_.w};
                const unsigned kw[4] = {kq.x, kq.y, kq.z, kq.w}, qw[4] = {qq.x, qq.y, qq.z, qq.w};
                union { bf16x8 v; unsigned u[4]; } ka, qb;
#pragma unroll
                for (int j = 0; j < 4; ++j) {
                    const float e0 = __expf(fminf(br[2 * j] - bsv[2 * j], 60.f)), e1 = __expf(fminf(br[2 * j + 1] - bsv[2 * j + 1], 60.f));
                    ka.u[j] = pack2(bflo(kw[j]) * e0, bfhi(kw[j]) * e1);
                    const float f0 = __expf(btv[2 * j] - br[2 * j]), f1 = __expf(btv[2 * j + 1] - br[2 * j + 1]);
                    qb.u[j] = pack2(bflo(qw[j]) * f0, bfhi(qw[j]) * f1);
                }
                acc = __builtin_amdgcn_mfma_f32_16x16x32_bf16(ka.v, qb.v, acc, 0, 0, 0);
            }
            if (bi == bj) {
#pragma unroll
                for (int r = 0; r < 4; ++r) if (4 * fq + r > fr) acc[r] = 0.f;
            }
            uint2 o; o.x = pack2(acc[0], acc[1]); o.y = pack2(acc[2], acc[3]);
            *(uint2*)(At + trow * VS + bj * 16 + 4 * fq) = o;
        }
        {
            unsigned z_ = 0u; asm volatile("" : "+v"(z_));
            if (wave == 2) *(uint2*)(At + (0 * 16 + fr) * VS + 16 + 4 * fq) = make_uint2(z_, z_);
            if (wave == 3) *(uint2*)(At + (2 * 16 + fr) * VS + 48 + 4 * fq) = make_uint2(z_, z_);
        }
        SCAN_SYNC();
        f32x4 oacc[4]; uint2 gz[4];
        {
            const int ti = wave & 3, vh = wave >> 2, trow = ti * 16 + fr;
            bf16x8 qh[KS];
#pragma unroll
            for (int kk = 0; kk < KS; ++kk) {
                const int k0 = kk * 32 + fq * 8;
                const uint4 qq = *(const uint4*)(qs + trow * QS + k0);
                const float4 t0_ = *(const float4*)(bs + trow * BS + k0), t1_ = *(const float4*)(bs + trow * BS + k0 + 4);
                union { bf16x8 v; unsigned u[4]; } q_;
                q_.u[0] = pack2(bflo(qq.x) * __expf(t0_.x), bfhi(qq.x) * __expf(t0_.y));
                q_.u[1] = pack2(bflo(qq.y) * __expf(t0_.z), bfhi(qq.y) * __expf(t0_.w));
                q_.u[2] = pack2(bflo(qq.z) * __expf(t1_.x), bfhi(qq.z) * __expf(t1_.y));
                q_.u[3] = pack2(bflo(qq.w) * __expf(t1_.z), bfhi(qq.w) * __expf(t1_.w));
                qh[kk] = q_.v;
            }
            const bf16x8 af0 = *(const bf16x8*)(At + trow * VS + fq * 8), af1 = *(const bf16x8*)(At + trow * VS + 32 + fq * 8);
            float sq = 0.f;
#pragma unroll
            for (int vi = 0; vi < 4; ++vi) {
                const int vrow = vh * 64 + vi * 16 + fr;
                gz[vi] = *(const uint2*)(Zc + (size_t)trow * LDZ + GCOL + vh * 64 + vi * 16 + 4 * fq);
                f32x4 acc = f32x4{0.f, 0.f, 0.f, 0.f};
                acc = __builtin_amdgcn_mfma_f32_16x16x32_bf16(*(const bf16x8*)(vt + vrow * VS + fq * 8), af0, acc, 0, 0, 0);
                if (ti >= 2) acc = __builtin_amdgcn_mfma_f32_16x16x32_bf16(*(const bf16x8*)(vt + vrow * VS + 32 + fq * 8), af1, acc, 0, 0, 0);
#pragma unroll
                for (int kk = 0; kk < KS; ++kk)
                    acc = __builtin_amdgcn_mfma_f32_16x16x32_bf16(*(const bf16x8*)(st + vrow * QS + kk * 32 + fq * 8), qh[kk], acc, 0, 0, 0);
                oacc[vi] = acc * scale;
                sq += oacc[vi][0] * oacc[vi][0] + oacc[vi][1] * oacc[vi][1] + oacc[vi][2] * oacc[vi][2] + oacc[vi][3] * oacc[vi][3];
            }
            sq += shx<16>(sq); sq += shx<32>(sq);
            if (fq == 0) ssq[vh * 64 + trow] = sq;
        }
        {
            const int vrow = wave * 16 + fr;
            const bf16x8 vf0 = *(const bf16x8*)(vt + vrow * VS + fq * 8), vf1 = *(const bf16x8*)(vt + vrow * VS + 32 + fq * 8);
#pragma unroll
            for (int kt = 0; kt < KT; ++kt) {
                const float dec = __expf(blast[kt * 16 + fr]);
                sacc[kt][0] *= dec; sacc[kt][1] *= dec; sacc[kt][2] *= dec; sacc[kt][3] *= dec;
                sacc[kt] = __builtin_amdgcn_mfma_f32_16x16x32_bf16(vf0, *(const bf16x8*)(kht + (kt * 16 + fr) * VS + fq * 8), sacc[kt], 0, 0, 0);
                sacc[kt] = __builtin_amdgcn_mfma_f32_16x16x32_bf16(vf1, *(const bf16x8*)(kht + (kt * 16 + fr) * VS + 32 + fq * 8), sacc[kt], 0, 0, 0);
            }
        }
        SCAN_SYNC();
#pragma unroll
        for (int kt = 0; kt < KT; ++kt)
#pragma unroll
            for (int r = 0; r < 4; ++r) st[(wave * 16 + 4 * fq + r) * QS + kt * 16 + fr] = f2bf(sacc[kt][r]);
        {
            const int ti = wave & 3, vh = wave >> 2, trow = ti * 16 + fr;
            const float rstd = rsqrtf((ssq[trow] + ssq[64 + trow]) * (1.f / 128.f) + 1e-6f);
            bf16_t* yrow = (bf16_t*)(p.ws + WS_Y) + (size_t)(b * 2048 + c * 64 + trow) * 1536 + (GLA ? 1024 : 0) + h * 128 + vh * 64 + 4 * fq;
#pragma unroll
            for (int vi = 0; vi < 4; ++vi) {
                const f32x4 g4_ = gn4[vi]; const float4 g4 = make_float4(g4_[0], g4_[1], g4_[2], g4_[3]);
                const float z0 = bflo(gz[vi].x), z1 = bfhi(gz[vi].x), z2 = bflo(gz[vi].y), z3 = bfhi(gz[vi].y);
                uint2 o;
                o.x = pack2(oacc[vi][0] * rstd * g4.x * (z0 * sigm(z0)), oacc[vi][1] * rstd * g4.y * (z1 * sigm(z1)));
                o.y = pack2(oacc[vi][2] * rstd * g4.z * (z2 * sigm(z2)), oacc[vi][3] * rstd * g4.w * (z3 * sigm(z3)));
                *(uint2*)(yrow + vi * 16) = o;
            }
        }
    }
    SCAN_SYNC();
#undef SCAN_FETCH
}

__device__ void dsaprep2_item(const Params& p, int l, int item, char* smem_) {
    bf16_t* tile = (bf16_t*)smem_;
    const int tid = TIDX(), lane = tid & 63, wave = tid >> 6;
    bf16_t* Z = (bf16_t*)(p.ws + WS_Z); bf16_t* VT = (bf16_t*)(p.ws + WS_VT);
    {
        const int tb = item * 32;
        {
            const float2 gq = *(const float2*)(p.dsa_qn + l * 128 + lane * 2), gk = *(const float2*)(p.dsa_kn + l * 128 + lane * 2);
            unsigned uu[4][8];
#pragma unroll
            for (int j = 0; j < 4; ++j)
#pragma unroll
                for (int grp = 0; grp < 8; ++grp)
                    uu[j][grp] = *(const unsigned*)(Z + (size_t)(tb + wave + 8 * j) * LDZ + (grp < 4 ? ZB_Q : ZB_K) + (grp & 3) * 128 + lane * 2);
#pragma unroll
            for (int j = 0; j < 4; ++j)
#pragma unroll
                for (int grp = 0; grp < 8; ++grp) {
                    bf16_t* ptr = Z + (size_t)(tb + wave + 8 * j) * LDZ + (grp < 4 ? ZB_Q : ZB_K) + (grp & 3) * 128 + lane * 2;
                    const float a = bflo(uu[j][grp]), b = bfhi(uu[j][grp]);
                    const float ss = wave_sum(a * a + b * b);
                    const float r = rsqrtf(ss * (1.f / 128.f) + 1e-6f) * ((grp < 4) ? 0.08838834764831845f : 1.f);
                    const float2 g = (grp < 4) ? gq : gk;
                    __hip_atomic_store((unsigned*)ptr, pack2(a * r * g.x, b * r * g.y), __ATOMIC_RELAXED, __HIP_MEMORY_SCOPE_AGENT);
                }
        }
        u32x4 uv[4];
#pragma unroll
        for (int i = 0; i < 4; ++i) { const int ch = tid + i * 512; uv[i] = *(const u32x4*)(Z + (size_t)(tb + (ch >> 6)) * LDZ + ZB_V + (ch & 63) * 8); }
#pragma unroll
        for (int i = 0; i < 4; ++i) {
            const int ch = tid + i * 512, t = ch >> 6, c8 = (ch & 63) * 8;
            unsigned* d = (unsigned*)(tile + t * 514 + c8);
            d[0] = uv[i][0]; d[1] = uv[i][1]; d[2] = uv[i][2]; d[3] = uv[i][3];
        }
        __syncthreads();
        {
            const int c = tid, b = tb >> 11, s0 = tb & 2047;
            unsigned w[16];
#pragma unroll
            for (int j = 0; j < 16; ++j) w[j] = (unsigned)tile[(2 * j) * 514 + c] | ((unsigned)tile[(2 * j + 1) * 514 + c] << 16);
            unsigned long long* dst = (unsigned long long*)(VT + ((size_t)(b * 512 + c)) * 2048 + s0);
#pragma unroll
            for (int j = 0; j < 8; ++j) __hip_atomic_store(dst + j, ((unsigned long long)w[2 * j + 1] << 32) | w[2 * j], __ATOMIC_RELAXED, __HIP_MEMORY_SCOPE_AGENT);
        }
        __syncthreads();
    }
}

__device__ void dsa_select_tile(const Params& p, int b, int tq, char* smem_) {
    constexpr int KS_ = 2052;
    unsigned* keyL = (unsigned*)smem_;
    const int tid = TIDX(), lane = tid & 63, wave = __builtin_amdgcn_readfirstlane(tid >> 6), fr = lane & 15, fq = lane >> 4;
    const bf16_t* Z = (const bf16_t*)(p.ws + WS_Z);
    unsigned long long* BM64 = (unsigned long long*)(p.ws + WS_BM);
    const int t0 = tq * 16;
    {
        const int tl = t0 + fr;
        const size_t trow = (size_t)b * 2048 + tl;
        bf16x8 qf[4][2];
#pragma unroll
        for (int h = 0; h < 4; ++h)
#pragma unroll
            for (int ks = 0; ks < 2; ++ks) qf[h][ks] = *(const bf16x8*)(Z + trow * LDZ + ZB_QI + h * 64 + ks * 32 + fq * 8);
        float w[4];
#pragma unroll
        for (int h = 0; h < 4; ++h) w[h] = bf2f(Z[trow * LDZ + ZB_WI + h]) * 0.5f;
#pragma unroll 4
        for (int kt = wave; kt <= tq; kt += 8) {
            const bf16_t* kr = Z + ((size_t)b * 2048 + kt * 16 + fr) * LDZ + ZB_KI + fq * 8;
            const bf16x8 k0 = *(const bf16x8*)kr, k1 = *(const bf16x8*)(kr + 32);
            f32x4 acc[4];
#pragma unroll
            for (int h = 0; h < 4; ++h) {
                acc[h] = __builtin_amdgcn_mfma_f32_16x16x32_bf16(k0, qf[h][0], f32x4{0.f, 0.f, 0.f, 0.f}, 0, 0, 0);
                acc[h] = __builtin_amdgcn_mfma_f32_16x16x32_bf16(k1, qf[h][1], acc[h], 0, 0, 0);
            }
            u32x4 kk;
#pragma unroll
            for (int r = 0; r < 4; ++r) {
                float sc = w[0] * fmaxf(acc[0][r] * 0.125f, 0.f) + w[1] * fmaxf(acc[1][r] * 0.125f, 0.f) + w[2] * fmaxf(acc[2][r] * 0.125f, 0.f) + w[3] * fmaxf(acc[3][r] * 0.125f, 0.f);
                if (sc == 0.f) sc = 0.f;
                const unsigned u = __float_as_uint(sc);
                const unsigned k = (u & 0x80000000u) ? ~u : (u | 0x80000000u);
                kk[r] = (kt * 16 + 4 * fq + r <= tl) ? k : 0u;
            }
            *(u32x4*)(keyL + fr * KS_ + kt * 16 + 4 * fq) = kk;
        }
    }
    __syncthreads();
    {
        const int nk = (tq + 1) * 16, jmax = (nk + 63) >> 6;
        const int qa = 2 * wave, qb = qa + 1;
        unsigned ka[32], kb[32];
#pragma unroll
        for (int j = 0; j < 32; ++j) {
            const int s = lane + 64 * j;
            ka[j] = (s < nk) ? keyL[qa * KS_ + s] : 0u;
            kb[j] = (s < nk) ? keyL[qb * KS_ + s] : 0u;
        }
        unsigned Ta = 1u, Tb = 1u; int Ca = 2047, Cb = 2047;
        if (t0 >= 256) {
            int na, nb;
            bool da, db;
            {
                int c0 = 0, c1 = 0, c2 = 0, c3 = 0;
#pragma unroll
                for (int j = 0; j < 32; ++j)
                    if (j < jmax) { c0 += (ka[j] >= 0x80000000u); c1 += (ka[j] > 0x80000000u); c2 += (kb[j] >= 0x80000000u); c3 += (kb[j] > 0x80000000u); }
                c0 = wave_total_i(c0); c1 = wave_total_i(c1); c2 = wave_total_i(c2); c3 = wave_total_i(c3);
                da = (c1 < 256 && c0 >= 256); db = (c3 < 256 && c2 >= 256);
                Ta = da ? 0x80000000u : ((c0 >= 256) ? 0x80000000u : 0u); na = da ? c0 : ((c0 >= 256) ? c0 : 0x7fffffff);
                Tb = db ? 0x80000000u : ((c2 >= 256) ? 0x80000000u : 0u); nb = db ? c2 : ((c2 >= 256) ? c2 : 0x7fffffff);
            }
            for (int bit = 30; bit >= 0; --bit) {
                if (da && db) break;
                const unsigned ca_ = Ta | (1u << bit), cb_ = Tb | (1u << bit);
                int c0 = 0, c1 = 0;
#pragma unroll
                for (int j = 0; j < 32; ++j)
                    if (j < jmax) { c0 += (ka[j] >= ca_); c1 += (kb[j] >= cb_); }
                c0 = wave_total_i(c0); c1 = wave_total_i(c1);
                if (!da && c0 >= 256) { Ta = ca_; na = c0; }
                if (!db && c1 >= 256) { Tb = cb_; nb = c1; }
                da = da || (na == 256); db = db || (nb == 256);
            }
            if (na != 256 || nb != 256) {
                int needa, needb;
                {
                    int c0 = 0, c1 = 0;
#pragma unroll
                    for (int j = 0; j < 32; ++j)
                        if (j < jmax) { c0 += (ka[j] > Ta); c1 += (kb[j] > Tb); }
                    needa = 256 - wave_total_i(c0); needb = 256 - wave_total_i(c1);
                }
                Ca = 0; Cb = 0;
                for (int bit = 10; bit >= 0; --bit) {
                    const int ca_ = Ca | (1 << bit), cb_ = Cb | (1 << bit);
                    int c0 = 0, c1 = 0;
#pragma unroll
                    for (int j = 0; j < 32; ++j)
                        if (j < jmax) { const int s = lane + 64 * j; c0 += (ka[j] == Ta && s < ca_); c1 += (kb[j] == Tb && s < cb_); }
                    c0 = wave_total_i(c0); c1 = wave_total_i(c1);
                    if (c0 < needa) Ca = ca_;
                    if (c1 < needb) Cb = cb_;
                }
            }
        }
        const size_t rowa = (size_t)b * 2048 + t0 + qa;
#pragma unroll
        for (int j = 0; j < 32; ++j) {
            const int s = lane + 64 * j;
            const unsigned long long ma = __ballot((ka[j] > Ta) || (ka[j] == Ta && s <= Ca));
            const unsigned long long mb = __ballot((kb[j] > Tb) || (kb[j] == Tb && s <= Cb));
            if (lane == 0) {
                __hip_atomic_store(&BM64[rowa * 32 + j], ma, __ATOMIC_RELAXED, __HIP_MEMORY_SCOPE_AGENT);
                __hip_atomic_store(&BM64[(rowa + 1) * 32 + j], mb, __ATOMIC_RELAXED, __HIP_MEMORY_SCOPE_AGENT);
            }
        }
    }
    __syncthreads();
}

__device__ void dsa_attn_item(const Params& p, int b, int h, int qg, char* smem_) {
    constexpr int KSTR = 136, VSTR = 40;
    bf16_t* Kl = (bf16_t*)smem_;
    bf16_t* Vl = Kl + 2 * 32 * KSTR;
    const int tid = TIDX(), lane = tid & 63, wave = __builtin_amdgcn_readfirstlane(tid >> 6), fr = lane & 15, fq = lane >> 4;
    const bf16_t* Z = (const bf16_t*)(p.ws + WS_Z); const bf16_t* VT = (const bf16_t*)(p.ws + WS_VT);
    const unsigned* BM = (const unsigned*)(p.ws + WS_BM); bf16_t* Y = (bf16_t*)(p.ws + WS_Y);
    const int kr = tid >> 4, kc = tid & 15, vd = tid >> 2, vc = tid & 3;
    const int ka_row = 8 * (fr >> 2) + (fr & 3);
    {
        const int t0 = qg * 128 + wave * 16;
        const size_t trow = (size_t)b * 2048 + t0 + fr;
        bf16x8 qf[4];
#pragma unroll
        for (int ks = 0; ks < 4; ++ks) qf[ks] = *(const bf16x8*)(Z + trow * LDZ + ZB_Q + h * 128 + ks * 32 + fq * 8);
        f32x4 o[8];
#pragma unroll
        for (int i = 0; i < 8; ++i) o[i] = f32x4{0.f, 0.f, 0.f, 0.f};
        float m = -INFINITY, lsum = 0.f;
        const unsigned* bmrow = BM + trow * 64;
        const int nsteps_blk = qg * 4 + 4, nsteps_w = (t0 + 15) / 32 + 1;
        const bf16_t* kg = Z + ((size_t)b * 2048 + kr) * LDZ + ZB_K + h * 128 + kc * 8;
        const bf16_t* vg = VT + ((size_t)(b * 4 + h) * 128 + vd) * 2048 + vc * 8;
        u32x4 rk = *(const u32x4*)kg, rv = *(const u32x4*)vg;
        *(u32x4*)(Kl + kr * KSTR + kc * 8) = rk; *(u32x4*)(Vl + vd * VSTR + vc * 8) = rv;
        __syncthreads();
        unsigned mwn = bmrow[0];
        for (int st = 0; st < nsteps_blk; ++st) {
            const bool more = (st + 1 < nsteps_blk);
            const unsigned mwc = mwn;
            mwn = bmrow[(st + 1 < nsteps_w) ? st + 1 : st];
            if (more) { rk = *(const u32x4*)(kg + (size_t)(st + 1) * 32 * LDZ); rv = *(const u32x4*)(vg + (st + 1) * 32); }
            if (st < nsteps_w) {
                const bf16_t* Kb = Kl + (st & 1) * 32 * KSTR; const bf16_t* Vb = Vl + (st & 1) * 128 * VSTR;
                f32x4 sa = f32x4{0.f, 0.f, 0.f, 0.f}, sb = f32x4{0.f, 0.f, 0.f, 0.f};
#pragma unroll
                for (int ks = 0; ks < 4; ++ks) {
                    const bf16x8 fa = *(const bf16x8*)(Kb + ka_row * KSTR + ks * 32 + fq * 8), fb = *(const bf16x8*)(Kb + (ka_row + 4) * KSTR + ks * 32 + fq * 8);
                    sa = __builtin_amdgcn_mfma_f32_16x16x32_bf16(fa, qf[ks], sa, 0, 0, 0);
                    sb = __builtin_amdgcn_mfma_f32_16x16x32_bf16(fb, qf[ks], sb, 0, 0, 0);
                }
                const unsigned mw = mwc >> (8 * fq);
                float x[8];
#pragma unroll
                for (int r = 0; r < 4; ++r) { x[r] = ((mw >> r) & 1u) ? sa[r] : -INFINITY; x[4 + r] = ((mw >> (4 + r)) & 1u) ? sb[r] : -INFINITY; }
                float mx = fmaxf(fmaxf(fmaxf(x[0], x[1]), fmaxf(x[2], x[3])), fmaxf(fmaxf(x[4], x[5]), fmaxf(x[6], x[7])));
                mx = fmaxf(mx, shx<16>(mx)); mx = fmaxf(mx, shx<32>(mx));
                const float mnew = fmaxf(m, mx);
                const float msafe = (mnew == -INFINITY) ? 0.f : mnew;
                const float alpha = __expf(m - msafe);
                float pe[8]; float ps = 0.f;
#pragma unroll
                for (int j = 0; j < 8; ++j) { pe[j] = __expf(x[j] - msafe); ps += pe[j]; }
                lsum = lsum * alpha + ps;
                m = mnew;
#pragma unroll
                for (int i = 0; i < 8; ++i) { o[i][0] *= alpha; o[i][1] *= alpha; o[i][2] *= alpha; o[i][3] *= alpha; }
                union { bf16x8 v; unsigned u[4]; } pf;
                pf.u[0] = pack2(pe[0], pe[1]); pf.u[1] = pack2(pe[2], pe[3]); pf.u[2] = pack2(pe[4], pe[5]); pf.u[3] = pack2(pe[6], pe[7]);
#pragma unroll
                for (int i = 0; i < 8; ++i) {
                    const bf16x8 vf = *(const bf16x8*)(Vb + (i * 16 + fr) * VSTR + fq * 8);
                    o[i] = __builtin_amdgcn_mfma_f32_16x16x32_bf16(vf, pf.v, o[i], 0, 0, 0);
                }
            }
            if (more) { *(u32x4*)(Kl + ((st + 1) & 1) * 32 * KSTR + kr * KSTR + kc * 8) = rk; *(u32x4*)(Vl + ((st + 1) & 1) * 128 * VSTR + vd * VSTR + vc * 8) = rv; }
            __syncthreads();
        }
        lsum += shx<16>(lsum); lsum += shx<32>(lsum);
        const float inv = 1.f / lsum;
#pragma unroll
        for (int i = 0; i < 8; ++i) {
            uint2 ov; ov.x = pack2(o[i][0] * inv, o[i][1] * inv); ov.y = pack2(o[i][2] * inv, o[i][3] * inv);
            *(uint2*)(Y + trow * 1536 + 512 + h * 128 + i * 16 + 4 * fq) = ov;
        }
    }
}

constexpr int LDS_BYTES = 155648;
__device__ void ph_mixA(const Params& p, int l, int vb0, int nvb, char* smem_) {
    for (int item = vb0; item < 64; item += nvb) {
        if (item < 32) scan2_item<128, false>(p, l, item >> 2, item & 3, smem_);
        else scan2_item<64, true>(p, l, (item - 32) >> 2, (item - 32) & 3, smem_);
    }
    unsigned* ctr = (unsigned*)(p.ws + WS_CTL) + 3584 + l * 64;
    unsigned* done = (unsigned*)(p.ws + WS_CTL) + 5300 + l * 8 * 16;
    volatile int* slot = (volatile int*)(smem_ + LDS_BYTES - 64);
    for (;;) {
        if (TIDX() == 0) *slot = (int)atomicAdd(ctr, 1u);
        __syncthreads();
        const int idx = __builtin_amdgcn_readfirstlane(*slot);
        __syncthreads();
        if (idx >= 2048) break;
        if (idx < 1536) {
            const int b = idx / 192, r = idx % 192;
            if (r < 128) dsa_select_tile(p, b, 127 - r, smem_);
            else dsaprep2_item(p, l, b * 64 + (r - 128), smem_);
            asm volatile("s_waitcnt vmcnt(0)" ::: "memory");
            __syncthreads();
            if (TIDX() == 0) __hip_atomic_fetch_add(done + b * 16, 1u, __ATOMIC_RELAXED, __HIP_MEMORY_SCOPE_AGENT);
        } else {
            const int a = idx - 1536, b = a >> 6, h = (a >> 4) & 3, qg = 15 - (a & 15);
            if (TIDX() == 0) {
                unsigned spins = 0;
                while (__hip_atomic_load(done + b * 16, __ATOMIC_RELAXED, __HIP_MEMORY_SCOPE_AGENT) < 192u) { __builtin_amdgcn_s_sleep(2); if (++spins > (1u << 18)) break; }
                __builtin_amdgcn_fence(__ATOMIC_ACQUIRE, "agent");
                asm volatile("s_waitcnt vmcnt(0)" ::: "memory");
            }
            __syncthreads();
            dsa_attn_item(p, b, h, qg, smem_);
        }
    }
}

__device__ __forceinline__ int f2sort(float f) { int i = __float_as_int(f); return i ^ ((i >> 31) & 0x7fffffff); }
__device__ __forceinline__ float sort2f(int i) { return __int_as_float(i ^ ((i >> 31) & 0x7fffffff)); }
#define INSK(K, xv) do { int _x = (xv); \
    _Pragma("unroll") for (int _j = 0; _j < 16; ++_j) { int _hi = max(K[_j], _x); _x = min(K[_j], _x); K[_j] = _hi; } } while (0)
#define INS64(K, xv) do { unsigned long long _x = (xv); \
    _Pragma("unroll") for (int _j = 0; _j < 16; ++_j) { bool _c = _x > K[_j]; unsigned long long _o = K[_j]; K[_j] = _c ? _x : _o; _x = _c ? _o : _x; } } while (0)

#define CE32(x, y) do { const int _h = max(x, y); y = min(x, y); x = _h; } while (0)
#define CE64(x, y) do { const bool _c = (y) > (x); const unsigned long long _t = x; x = _c ? y : x; y = _c ? _t : y; } while (0)
#define SORT16_I(K) do { CE32(K[0], K[1]); CE32(K[2], K[3]); CE32(K[4], K[5]); CE32(K[6], K[7]); CE32(K[8], K[9]); CE32(K[10], K[11]); CE32(K[12], K[13]); CE32(K[14], K[15]); CE32(K[0], K[2]); CE32(K[1], K[3]); CE32(K[4], K[6]); CE32(K[5], K[7]); CE32(K[8], K[10]); CE32(K[9], K[11]); CE32(K[12], K[14]); CE32(K[13], K[15]); CE32(K[1], K[2]); CE32(K[5], K[6]); CE32(K[9], K[10]); CE32(K[13], K[14]); CE32(K[0], K[4]); CE32(K[1], K[5]); CE32(K[2], K[6]); CE32(K[3], K[7]); CE32(K[8], K[12]); CE32(K[9], K[13]); CE32(K[10], K[14]); CE32(K[11], K[15]); CE32(K[2], K[4]); CE32(K[3], K[5]); CE32(K[10], K[12]); CE32(K[11], K[13]); CE32(K[1], K[2]); CE32(K[3], K[4]); CE32(K[5], K[6]); CE32(K[9], K[10]); CE32(K[11], K[12]); CE32(K[13], K[14]); CE32(K[0], K[8]); CE32(K[1], K[9]); CE32(K[2], K[10]); CE32(K[3], K[11]); CE32(K[4], K[12]); CE32(K[5], K[13]); CE32(K[6], K[14]); CE32(K[7], K[15]); CE32(K[4], K[8]); CE32(K[5], K[9]); CE32(K[6], K[10]); CE32(K[7], K[11]); CE32(K[2], K[4]); CE32(K[3], K[5]); CE32(K[6], K[8]); CE32(K[7], K[9]); CE32(K[10], K[12]); CE32(K[11], K[13]); CE32(K[1], K[2]); CE32(K[3], K[4]); CE32(K[5], K[6]); CE32(K[7], K[8]); CE32(K[9], K[10]); CE32(K[11], K[12]); CE32(K[13], K[14]); } while (0)
#define BITONIC16_I(K) do { CE32(K[0], K[8]); CE32(K[1], K[9]); CE32(K[2], K[10]); CE32(K[3], K[11]); CE32(K[4], K[12]); CE32(K[5], K[13]); CE32(K[6], K[14]); CE32(K[7], K[15]); CE32(K[0], K[4]); CE32(K[1], K[5]); CE32(K[2], K[6]); CE32(K[3], K[7]); CE32(K[8], K[12]); CE32(K[9], K[13]); CE32(K[10], K[14]); CE32(K[11], K[15]); CE32(K[0], K[2]); CE32(K[1], K[3]); CE32(K[4], K[6]); CE32(K[5], K[7]); CE32(K[8], K[10]); CE32(K[9], K[11]); CE32(K[12], K[14]); CE32(K[13], K[15]); CE32(K[0], K[1]); CE32(K[2], K[3]); CE32(K[4], K[5]); CE32(K[6], K[7]); CE32(K[8], K[9]); CE32(K[10], K[11]); CE32(K[12], K[13]); CE32(K[14], K[15]); } while (0)
#define SORT16_L(K) do { CE64(K[0], K[1]); CE64(K[2], K[3]); CE64(K[4], K[5]); CE64(K[6], K[7]); CE64(K[8], K[9]); CE64(K[10], K[11]); CE64(K[12], K[13]); CE64(K[14], K[15]); CE64(K[0], K[2]); CE64(K[1], K[3]); CE64(K[4], K[6]); CE64(K[5], K[7]); CE64(K[8], K[10]); CE64(K[9], K[11]); CE64(K[12], K[14]); CE64(K[13], K[15]); CE64(K[1], K[2]); CE64(K[5], K[6]); CE64(K[9], K[10]); CE64(K[13], K[14]); CE64(K[0], K[4]); CE64(K[1], K[5]); CE64(K[2], K[6]); CE64(K[3], K[7]); CE64(K[8], K[12]); CE64(K[9], K[13]); CE64(K[10], K[14]); CE64(K[11], K[15]); CE64(K[2], K[4]); CE64(K[3], K[5]); CE64(K[10], K[12]); CE64(K[11], K[13]); CE64(K[1], K[2]); CE64(K[3], K[4]); CE64(K[5], K[6]); CE64(K[9], K[10]); CE64(K[11], K[12]); CE64(K[13], K[14]); CE64(K[0], K[8]); CE64(K[1], K[9]); CE64(K[2], K[10]); CE64(K[3], K[11]); CE64(K[4], K[12]); CE64(K[5], K[13]); CE64(K[6], K[14]); CE64(K[7], K[15]); CE64(K[4], K[8]); CE64(K[5], K[9]); CE64(K[6], K[10]); CE64(K[7], K[11]); CE64(K[2], K[4]); CE64(K[3], K[5]); CE64(K[6], K[8]); CE64(K[7], K[9]); CE64(K[10], K[12]); CE64(K[11], K[13]); CE64(K[1], K[2]); CE64(K[3], K[4]); CE64(K[5], K[6]); CE64(K[7], K[8]); CE64(K[9], K[10]); CE64(K[11], K[12]); CE64(K[13], K[14]); } while (0)
#define BITONIC16_L(K) do { CE64(K[0], K[8]); CE64(K[1], K[9]); CE64(K[2], K[10]); CE64(K[3], K[11]); CE64(K[4], K[12]); CE64(K[5], K[13]); CE64(K[6], K[14]); CE64(K[7], K[15]); CE64(K[0], K[4]); CE64(K[1], K[5]); CE64(K[2], K[6]); CE64(K[3], K[7]); CE64(K[8], K[12]); CE64(K[9], K[13]); CE64(K[10], K[14]); CE64(K[11], K[15]); CE64(K[0], K[2]); CE64(K[1], K[3]); CE64(K[4], K[6]); CE64(K[5], K[7]); CE64(K[8], K[10]); CE64(K[9], K[11]); CE64(K[12], K[14]); CE64(K[13], K[15]); CE64(K[0], K[1]); CE64(K[2], K[3]); CE64(K[4], K[5]); CE64(K[6], K[7]); CE64(K[8], K[9]); CE64(K[10], K[11]); CE64(K[12], K[13]); CE64(K[14], K[15]); } while (0)
#define TOP16_I(R, G) do { _Pragma("unroll") for (int _j = 0; _j < 16; ++_j) R[_j] = max(R[_j], G[15 - _j]); BITONIC16_I(R); } while (0)
#define TOP16_L(R, G) do { _Pragma("unroll") for (int _j = 0; _j < 16; ++_j) R[_j] = (G[15 - _j] > R[_j]) ? G[15 - _j] : R[_j]; BITONIC16_L(R); } while (0)
__device__ __forceinline__ void route_wave(const Params& p, int tw0, int h, _Float16* tile  , const int lane) {
    typedef _Float16 h8 __attribute__((ext_vector_type(8)));
    const _Float16* SC = (const _Float16*)(p.ws + WS_SC);
    int* RI = (int*)(p.ws + WS_RI); float* RG = (float*)(p.ws + WS_RG);
    {
        const int t = tw0 + lane;
        const _Float16* s0 = SC + (size_t)t * 2048 + h * 256;
        const _Float16* wbase = SC + (size_t)tw0 * 2048 + h * 256;
        int k0[16], k1[16];
#pragma unroll
        for (int j = 0; j < 16; ++j) { k0[j] = (int)0x80000000; k1[j] = (int)0x80000000; }
#pragma unroll 1
        for (int slab = 0; slab < 4; ++slab) {
            h8 ld[8];
#pragma unroll
            for (int j = 0; j < 4; ++j) {
                const _Float16* src = wbase + (size_t)(16 * j + (lane >> 2)) * 2048 + slab * 32 + (lane & 3) * 8;
                ld[j] = *(const h8*)src; ld[4 + j] = *(const h8*)(src + 128);
            }
            __builtin_amdgcn_wave_barrier();
#pragma unroll
            for (int j = 0; j < 4; ++j) {
                _Float16* dst = tile + (16 * j + (lane >> 2)) * 72 + (lane & 3) * 8;
                *(h8*)dst = ld[j]; *(h8*)(dst + 32) = ld[4 + j];
            }
            __builtin_amdgcn_fence(__ATOMIC_RELEASE, "wavefront");
            __builtin_amdgcn_wave_barrier();
            __builtin_amdgcn_fence(__ATOMIC_ACQUIRE, "wavefront");
#pragma unroll
            for (int ii = 0; ii < 32; ii += 16) {
                const int i = slab * 32 + ii;
                const h8 a0 = *(const h8*)(tile + lane * 72 + ii), a1 = *(const h8*)(tile + lane * 72 + ii + 8);
                const h8 b0 = *(const h8*)(tile + lane * 72 + 32 + ii), b1 = *(const h8*)(tile + lane * 72 + 32 + ii + 8);
                int ga[16], gb[16];
#pragma unroll
                for (int e_ = 0; e_ < 8; ++e_) {
                    ga[e_] = (f2sort((float)a0[e_]) & ~127) | (127 - i - e_); ga[8 + e_] = (f2sort((float)a1[e_]) & ~127) | (127 - i - 8 - e_);
                    gb[e_] = (f2sort((float)b0[e_]) & ~127) | (127 - i - e_); gb[8 + e_] = (f2sort((float)b1[e_]) & ~127) | (127 - i - 8 - e_);
                }
                SORT16_I(ga); TOP16_I(k0, ga);
                SORT16_I(gb); TOP16_I(k1, gb);
            }
            __builtin_amdgcn_wave_barrier();
        }
        float v0[16], v1[16];
#pragma unroll
        for (int j = 0; j < 16; ++j) { k0[j] = 127 - (k0[j] & 127); k1[j] = 127 - (k1[j] & 127); v0[j] = (float)s0[k0[j]]; v1[j] = (float)s0[128 + k1[j]]; }
#define CAND(a, b) ((((unsigned long long)((unsigned)f2sort(v0[a] + v1[b]) ^ 0x80000000u)) << 32) | (((unsigned)(255 - ((a) * 16 + (b))) << 16) | (unsigned)(k0[a] * 128 + k1[b])))
        unsigned long long ck[16], m1[16], m2[16];
#pragma unroll
        for (int j = 0; j < 16; ++j) ck[j] = CAND(0, j);
#pragma unroll
        for (int j = 0; j < 8; ++j) { m1[j] = CAND(1, j); m1[8 + j] = CAND(15 - j, 0); }
        BITONIC16_L(m1);
        m2[0] = CAND(2, 0); m2[1] = CAND(2, 1); m2[2] = CAND(2, 2); m2[3] = CAND(2, 3); m2[4] = CAND(2, 4);
        m2[5] = CAND(3, 0); m2[6] = CAND(3, 1); m2[7] = CAND(3, 2); m2[8] = CAND(3, 3);
        m2[9] = CAND(4, 0); m2[10] = CAND(4, 1); m2[11] = CAND(4, 2);
        m2[12] = CAND(5, 0); m2[13] = CAND(5, 1); m2[14] = CAND(6, 0); m2[15] = CAND(6, 1);
        SORT16_L(m2);
        TOP16_L(ck, m1);
        TOP16_L(ck, m2);
        INS64(ck, CAND(7, 0)); INS64(ck, CAND(7, 1));
#undef CAND
        float e[16]; float sm = 0.f;
        const float mx = sort2f((int)((unsigned)(ck[0] >> 32) ^ 0x80000000u));
#pragma unroll
        for (int j = 0; j < 16; ++j) { e[j] = expf(sort2f((int)((unsigned)(ck[j] >> 32) ^ 0x80000000u)) - mx); sm += e[j]; }
        const float inv = 1.f / sm;
#pragma unroll
        for (int j = 0; j < 16; j += 4) {
            *(int4*)(RI + (size_t)t * 128 + h * 16 + j) = make_int4((int)(ck[j] & 0xffffu), (int)(ck[j + 1] & 0xffffu), (int)(ck[j + 2] & 0xffffu), (int)(ck[j + 3] & 0xffffu));
            *(float4*)(RG + (size_t)t * 128 + h * 16 + j) = make_float4(e[j] * inv, e[j + 1] * inv, e[j + 2] * inv, e[j + 3] * inv);
        }
    }
}

__device__ __forceinline__ void fp8x16_to_f32(const uint4 q, float (&f)[16]) {
    const unsigned w[4] = {q.x, q.y, q.z, q.w};
#pragma unroll
    for (int c = 0; c < 4; ++c) {
        auto f0 = __builtin_amdgcn_cvt_pk_f32_fp8((int)w[c], false); auto f1 = __builtin_amdgcn_cvt_pk_f32_fp8((int)w[c], true);
        f[4 * c] = f0[0]; f[4 * c + 1] = f0[1]; f[4 * c + 2] = f1[0]; f[4 * c + 3] = f1[1];
    }
}
constexpr bool G2_MFMA = true;
constexpr bool G1_MFMA = true;
typedef float f32x2_t __attribute__((ext_vector_type(2)));
__device__ __forceinline__ float g1_half(const u32x4 (&uq)[8], const float (&hv)[16], int lane) {
    float part[8];
#pragma unroll
    for (int it = 0; it < 8; ++it) {
        f32x2_t d2 = {0.f, 0.f};
#pragma unroll
        for (int c_ = 0; c_ < 4; ++c_) {
            const f32x2_t f0 = __builtin_amdgcn_cvt_pk_f32_fp8((int)uq[it][c_], false), f1 = __builtin_amdgcn_cvt_pk_f32_fp8((int)uq[it][c_], true);
            d2 = __builtin_elementwise_fma(f32x2_t{hv[4 * c_], hv[4 * c_ + 1]}, f0, d2);
            d2 = __builtin_elementwise_fma(f32x2_t{hv[4 * c_ + 2], hv[4 * c_ + 3]}, f1, d2);
        }
        part[it] = d2[0] + d2[1];
    }
    float r4[4], r2[2];
    const bool b2_ = lane & 4, b1_ = lane & 2, b0_ = lane & 1;
#pragma unroll
    for (int j = 0; j < 4; ++j) { const float snd = b2_ ? part[j] : part[j + 4], kp = b2_ ? part[j + 4] : part[j]; r4[j] = kp + shx<4>(snd); }
#pragma unroll
    for (int j = 0; j < 2; ++j) { const float snd = b1_ ? r4[j] : r4[j + 2], kp = b1_ ? r4[j + 2] : r4[j]; r2[j] = kp + shx<2>(snd); }
    const float snd = b0_ ? r2[0] : r2[1], kp = b0_ ? r2[1] : r2[0];
    return kp + shx<1>(snd);
}
__device__ __forceinline__ void peer_gather8(u32x4 (&q)[8], const unsigned char* tab, const int* idx, unsigned l16) {
#pragma unroll
    for (int it = 0; it < 8; ++it) { const unsigned e_ = (unsigned)idx[it * 8]; q[it] = *(const u32x4*)(tab + ((e_ << 7) | l16)); }
}
template <bool PRE>
__device__ __forceinline__ void g1_step(int i, int t, const bf16_t* hrow_next, const unsigned char* ub, const int* lri_eg, unsigned l16, int lane, float* pp_row,
                                        u32x4& hq0, u32x4& hq1, u32x4 (&uqA)[8], u32x4 (&uqB)[8]) {
    float hv[16];
#pragma unroll
    for (int c_ = 0; c_ < 4; ++c_) { hv[2 * c_] = bflo(hq0[c_]); hv[2 * c_ + 1] = bfhi(hq0[c_]); hv[8 + 2 * c_] = bflo(hq1[c_]); hv[8 + 2 * c_ + 1] = bfhi(hq1[c_]); }
    if (PRE) { const u32x4* hp = (const u32x4*)hrow_next; hq0 = hp[0]; hq1 = hp[1]; }
    const float d0 = g1_half(uqA, hv, lane);
    __builtin_amdgcn_sched_barrier(0);
    if (PRE) { peer_gather8(uqA, ub, lri_eg + (i + 1) * 128, l16); __builtin_amdgcn_sched_barrier(0); }
    const float d1 = g1_half(uqB, hv, lane);
    __builtin_amdgcn_sched_barrier(0);
    if (PRE) { peer_gather8(uqB, ub, lri_eg + (i + 1) * 128 + 64, l16); __builtin_amdgcn_sched_barrier(0); }
    pp_row[0] = d0; pp_row[64] = d1;
}
template <bool PRE>
__device__ __forceinline__ void g2_step(int i, float2* op, const float2 gf, const unsigned char* vb_, const int* lri_eg, const float* lrg_eg, unsigned l16, int lane,
                                        u32x4 (&vqA)[8], u32x4 (&vqB)[8]) {
    const float2 xi = *op;
    f32x2_t y[8];
#pragma unroll
    for (int j = 0; j < 8; ++j) y[j] = f32x2_t{0.f, 0.f};
#pragma unroll
    for (int it = 0; it < 8; ++it) {
        const float ck = lrg_eg[i * 128 + it * 8]; const f32x2_t ck2 = {ck, ck};
#pragma unroll
        for (int c_ = 0; c_ < 4; ++c_) {
            y[2 * c_] = __builtin_elementwise_fma(ck2, __builtin_amdgcn_cvt_pk_f32_fp8((int)vqA[it][c_], false), y[2 * c_]);
            y[2 * c_ + 1] = __builtin_elementwise_fma(ck2, __builtin_amdgcn_cvt_pk_f32_fp8((int)vqA[it][c_], true), y[2 * c_ + 1]);
        }
    }
    __builtin_amdgcn_sched_barrier(0);
    if (PRE) { peer_gather8(vqA, vb_, lri_eg + (i + 1) * 128, l16); __builtin_amdgcn_sched_barrier(0); }
#pragma unroll
    for (int it = 0; it < 8; ++it) {
        const float ck = lrg_eg[i * 128 + 64 + it * 8]; const f32x2_t ck2 = {ck, ck};
#pragma unroll
        for (int c_ = 0; c_ < 4; ++c_) {
            y[2 * c_] = __builtin_elementwise_fma(ck2, __builtin_amdgcn_cvt_pk_f32_fp8((int)vqB[it][c_], false), y[2 * c_]);
            y[2 * c_ + 1] = __builtin_elementwise_fma(ck2, __builtin_amdgcn_cvt_pk_f32_fp8((int)vqB[it][c_], true), y[2 * c_ + 1]);
        }
    }
    __builtin_amdgcn_sched_barrier(0);
    if (PRE) { peer_gather8(vqB, vb_, lri_eg + (i + 1) * 128 + 64, l16); __builtin_amdgcn_sched_barrier(0); }
    float r8[8], r4[4], r2[2];
    const bool b5 = lane & 32, b4 = lane & 16, b3 = lane & 8;
#pragma unroll
    for (int j = 0; j < 8; ++j) { const float lo = y[j >> 1][j & 1], hi = y[4 + (j >> 1)][j & 1]; const float snd = b5 ? lo : hi, kp = b5 ? hi : lo; r8[j] = kp + shx<32>(snd); }
#pragma unroll
    for (int j = 0; j < 4; ++j) { const float snd = b4 ? r8[j] : r8[j + 4], kp = b4 ? r8[j + 4] : r8[j]; r4[j] = kp + shx<16>(snd); }
#pragma unroll
    for (int j = 0; j < 2; ++j) { const float snd = b3 ? r4[j] : r4[j + 2], kp = b3 ? r4[j + 2] : r4[j]; r2[j] = kp + shx<8>(snd); }
    *op = make_float2(xi.x + gf.x * r2[0], xi.y + gf.y * r2[1]);
}
typedef int i32x4_t __attribute__((ext_vector_type(4)));
typedef int i32x8_t __attribute__((ext_vector_type(8)));
constexpr int G1W = 18432;
__device__ __forceinline__ void g1m_dma(const unsigned char* ub, PG8_LAS unsigned char* img, const PG8_LAS unsigned short* idx, int i, int hh, int eg, unsigned q16) {
    const u32x4 w = *(const PG8_LAS u32x4*)(idx + ((i * 8 + eg) * 16 + hh * 8));
#pragma unroll
    for (int it = 0; it < 8; ++it) {
        const unsigned e_ = (it & 1) ? (w[it >> 1] >> 16) : (w[it >> 1] & 0xffffu);
        const unsigned off = (e_ << 7) | ((it & 1) ? (q16 ^ 64u) : q16);
        __builtin_amdgcn_global_load_lds((const unsigned*)(ub + off), (PG8_LAS unsigned*)(img + it * 1024), 16, 0, 0);
    }
}
template <bool PRE, int VMW>
__device__ __forceinline__ float g1m_step(const unsigned char* ub, PG8_LAS unsigned char* img, const PG8_LAS unsigned short* idx, int inext, int hh, int eg, unsigned q16,
                                          unsigned rdoff, int lane, const u32x4 a0, const u32x4 a1) {
    asm volatile("s_waitcnt vmcnt(%0)" :: "n"(VMW) : "memory");
    i32x8_t b[4];
#pragma unroll
    for (int mb = 0; mb < 4; ++mb) {
        const unsigned ro = (unsigned)mb * 2048u + rdoff;
        const i32x4_t lo = *(const PG8_LAS i32x4_t*)(img + ro), hi = *(const PG8_LAS i32x4_t*)(img + (ro ^ 64u));
        b[mb] = __builtin_shufflevector(lo, hi, 0, 1, 2, 3, 4, 5, 6, 7);
    }
    asm volatile("s_waitcnt lgkmcnt(0)" ::: "memory");
    if (PRE) g1m_dma(ub, img, idx, inext, hh, eg, q16);
    const i32x8_t a = __builtin_shufflevector((i32x4_t)a0, (i32x4_t)a1, 0, 1, 2, 3, 4, 5, 6, 7);
    float d[4]; f32x4 acc[4];
#pragma unroll
    for (int mb = 0; mb < 4; ++mb) acc[mb] = __builtin_amdgcn_mfma_scale_f32_16x16x128_f8f6f4(a, b[mb], f32x4{0.f, 0.f, 0.f, 0.f}, 0, 0, 0, 0x7f, 0, 0x7f);
#pragma unroll
    for (int mb = 0; mb < 4; ++mb) { d[mb] = acc[mb][0] + acc[mb][1] * (1.f / 16.f); asm volatile("" : "+v"(d[mb])); }
    const int g = lane >> 4;
    return g == 0 ? d[0] : g == 1 ? d[1] : g == 2 ? d[2] : d[3];
}
__device__ __forceinline__ void g1m_chunk(const Params& p, int x, int tb, char* smem_, int lane) {
    PG8_LAS unsigned char* wl = (PG8_LAS unsigned char*)smem_ + p.wv * G1W;
    PG8_LAS unsigned short* idx = (PG8_LAS unsigned short*)(wl + 16384);
    const int* RI = (const int*)(p.ws + WS_RI);
    {
        int ra[16];
#pragma unroll
        for (int i = 0; i < 8; ++i) { ra[2 * i] = RI[(size_t)(tb + i) * 128 + lane]; ra[2 * i + 1] = RI[(size_t)(tb + i) * 128 + 64 + lane]; }
#pragma unroll
        for (int i = 0; i < 8; ++i) {
            idx[(i * 8 + (lane & 7)) * 16 + (lane >> 3)] = (unsigned short)ra[2 * i];
            idx[(i * 8 + (lane & 7)) * 16 + 8 + (lane >> 3)] = (unsigned short)ra[2 * i + 1];
        }
    }
    __builtin_amdgcn_fence(__ATOMIC_RELEASE, "wavefront");
    __builtin_amdgcn_wave_barrier();
    __builtin_amdgcn_fence(__ATOMIC_ACQUIRE, "wavefront");
    const int eg = lane >> 3, n = lane & 15, kb = lane >> 4;
    const unsigned q16 = (unsigned)(((lane & 7) ^ (eg >> 1)) * 16);
    const unsigned rdoff = (unsigned)(n * 128 + ((kb ^ (n >> 1)) * 16));
    const unsigned char* ub = p.ws + WS_PU + (size_t)x * (16384u * 128u);
    const unsigned char* h8 = p.ws + ((lane & 1) ? WS_H8L : WS_H8H) + (size_t)tb * 1024 + x * 128 + kb * 16;
    float* pp = (float*)(p.ws + WS_PP) + ((size_t)x * T_TOK + tb) * 128 + lane;
    u32x4 ha[8][2];
#pragma unroll
    for (int i = 0; i < 8; ++i) { ha[i][0] = *(const u32x4*)(h8 + (size_t)i * 1024); ha[i][1] = *(const u32x4*)(h8 + (size_t)i * 1024 + 64); }
#pragma unroll
    for (int i = 0; i < 8; ++i) { asm volatile("" : "+v"(ha[i][0])); asm volatile("" : "+v"(ha[i][1])); }
    g1m_dma(ub, wl, idx, 0, 0, eg, q16);
    g1m_dma(ub, wl + 8192, idx, 0, 1, eg, q16);
    asm volatile("s_waitcnt vmcnt(8)" ::: "memory");
#pragma unroll
    for (int i = 0; i < 7; ++i) {
        const float v0 = g1m_step<true, 9>(ub, wl, idx, i + 1, 0, eg, q16, rdoff, lane, ha[i][0], ha[i][1]);
        pp[(size_t)i * 128] = v0;
        const float v1 = g1m_step<true, 9>(ub, wl + 8192, idx, i + 1, 1, eg, q16, rdoff, lane, ha[i][0], ha[i][1]);
        pp[(size_t)i * 128 + 64] = v1;
    }
    {
        const float v0 = g1m_step<false, 9>(ub, wl, idx, 0, 0, eg, q16, rdoff, lane, ha[7][0], ha[7][1]);
        pp[(size_t)7 * 128] = v0;
        const float v1 = g1m_step<false, 0>(ub, wl + 8192, idx, 0, 1, eg, q16, rdoff, lane, ha[7][0], ha[7][1]);
        pp[(size_t)7 * 128 + 64] = v1;
    }
}
typedef int i32x2_t __attribute__((ext_vector_type(2)));
template <bool PRE, int VMW, int HH>
__device__ __forceinline__ void g2m_step(const unsigned char* vb_, PG8_LAS unsigned char* img, const PG8_LAS unsigned short* idx, int inext, int eg, unsigned q16,
                                         const unsigned (&tra)[8], const long a0, const long a1, f32x4 (&acc)[8]) {
    asm volatile("s_waitcnt vmcnt(%0)" :: "n"(VMW) : "memory");
    long b[2][8];
#pragma unroll
    for (int u = 0; u < 2; ++u)
#pragma unroll
        for (int j = 0; j < 8; ++j) asm volatile("ds_read_b64_tr_b8 %0, %1 offset:%2" : "=v"(b[u][j]) : "v"(tra[j]), "n"(HH * 8192 + u * 4096) : "memory");
    asm volatile("s_waitcnt lgkmcnt(0)" : "+v"(b[0][0]), "+v"(b[0][1]), "+v"(b[0][2]), "+v"(b[0][3]), "+v"(b[0][4]), "+v"(b[0][5]), "+v"(b[0][6]), "+v"(b[0][7]) :: "memory");
    asm volatile("" : "+v"(b[1][0]), "+v"(b[1][1]), "+v"(b[1][2]), "+v"(b[1][3]), "+v"(b[1][4]), "+v"(b[1][5]), "+v"(b[1][6]), "+v"(b[1][7]) :: "memory");
    if (PRE) { g1m_dma(vb_, img + HH * 8192, idx, inext, HH, eg, q16); __builtin_amdgcn_sched_barrier(0); }
#pragma unroll
    for (int j = 0; j < 8; ++j) {
        acc[j] = __builtin_amdgcn_mfma_f32_16x16x32_fp8_fp8(a0, b[0][j], acc[j], 0, 0, 0);
        acc[j] = __builtin_amdgcn_mfma_f32_16x16x32_fp8_fp8(a1, b[1][j], acc[j], 0, 0, 0);
    }
}
__device__ __forceinline__ void g2m_chunk(const Params& p, int l, int x, int tb, char* smem_, int lane) {
    PG8_LAS unsigned char* wl = (PG8_LAS unsigned char*)smem_ + p.wv * G1W;
    PG8_LAS unsigned short* idx = (PG8_LAS unsigned short*)(wl + 16384);
    const int* RI = (const int*)(p.ws + WS_RI);
    {
        int ra[16];
#pragma unroll
        for (int i = 0; i < 8; ++i) { ra[2 * i] = RI[(size_t)(tb + i) * 128 + lane]; ra[2 * i + 1] = RI[(size_t)(tb + i) * 128 + 64 + lane]; }
#pragma unroll
        for (int i = 0; i < 8; ++i) {
            idx[(i * 8 + (lane & 7)) * 16 + (lane >> 3)] = (unsigned short)ra[2 * i];
            idx[(i * 8 + (lane & 7)) * 16 + 8 + (lane >> 3)] = (unsigned short)ra[2 * i + 1];
        }
    }
    __builtin_amdgcn_fence(__ATOMIC_RELEASE, "wavefront");
    __builtin_amdgcn_wave_barrier();
    __builtin_amdgcn_fence(__ATOMIC_ACQUIRE, "wavefront");
    const int eg = lane >> 3, kb = lane >> 4, li = lane & 15, q = li >> 1;
    const unsigned q16 = (unsigned)(((lane & 7) ^ (eg >> 1)) * 16);
    const int n16 = (kb & 1) * 8 + q;
    const unsigned trbase = (unsigned)((kb * 8 + q) * 128 + ((n16 >> 1) & 7) * 16 + (li & 1) * 8);
    const unsigned char* vb_ = p.ws + WS_PV + (size_t)x * (16384u * 128u);
    float* op = p.out + (size_t)tb * 1024 + x * 128 + lane;
    const float* modr = (const float*)(p.ws + WS_MOD) + (size_t)(l * 8 + (tb >> 11)) * 6144 + 5120 + x * 128 + lane;
    float gf0 = modr[0], gf1 = modr[64];
    const unsigned char* c8 = p.ws + ((lane & 1) ? WS_C8L : WS_C8H) + (size_t)tb * 128 + kb * 32;
    u32x4 ca[8][2]; float xi[8][2], cinv[8];
#pragma unroll
    for (int i = 0; i < 8; ++i) {
        ca[i][0] = *(const u32x4*)(c8 + (size_t)i * 128); ca[i][1] = *(const u32x4*)(c8 + (size_t)i * 128 + 16);
        xi[i][0] = op[(size_t)i * 1024]; xi[i][1] = op[(size_t)i * 1024 + 64];
        cinv[i] = ((const float*)(p.ws + WS_CINV))[tb + i];
    }
#pragma unroll
    for (int i = 0; i < 8; ++i) { asm volatile("" : "+v"(ca[i][0])); asm volatile("" : "+v"(ca[i][1])); asm volatile("" : "+v"(xi[i][0]), "+v"(xi[i][1]), "+v"(cinv[i])); }
    asm volatile("" : "+v"(gf0), "+v"(gf1));
    g1m_dma(vb_, wl, idx, 0, 0, eg, q16);
    g1m_dma(vb_, wl + 8192, idx, 0, 1, eg, q16);
    asm volatile("s_waitcnt vmcnt(8)" ::: "memory");
    const int g = lane >> 4;
    unsigned tra[8];
#pragma unroll
    for (int j = 0; j < 8; ++j) tra[j] = (unsigned)(unsigned long)wl + (trbase ^ (unsigned)(j * 16));
#define G2M_TOKEN(i, PRE_, W0, W1) do { \
        f32x4 acc[8]; \
        _Pragma("unroll") for (int j = 0; j < 8; ++j) acc[j] = f32x4{0.f, 0.f, 0.f, 0.f}; \
        const long a00 = (long)(((unsigned long long)ca[i][0][1] << 32) | ca[i][0][0]), a01 = (long)(((unsigned long long)ca[i][0][3] << 32) | ca[i][0][2]); \
        const long a10 = (long)(((unsigned long long)ca[i][1][1] << 32) | ca[i][1][0]), a11 = (long)(((unsigned long long)ca[i][1][3] << 32) | ca[i][1][2]); \
        g2m_step<PRE_, W0, 0>(vb_, wl, idx, (i) + 1, eg, q16, tra, a00, a01, acc); \
        g2m_step<PRE_, W1, 1>(vb_, wl, idx, (i) + 1, eg, q16, tra, a10, a11, acc); \
        float y[8]; \
        _Pragma("unroll") for (int j = 0; j < 8; ++j) { y[j] = acc[j][0] + acc[j][1] * (1.f / 16.f); asm volatile("" : "+v"(y[j])); } \
        const float ya = g == 0 ? y[0] : g == 1 ? y[1] : g == 2 ? y[2] : y[3], yb = g == 0 ? y[4] : g == 1 ? y[5] : g == 2 ? y[6] : y[7]; \
        op[(size_t)(i) * 1024] = xi[i][0] + gf0 * (ya * cinv[i]); op[(size_t)(i) * 1024 + 64] = xi[i][1] + gf1 * (yb * cinv[i]); \
        __builtin_amdgcn_sched_barrier(0); } while (0)
    G2M_TOKEN(0, true, 10, 8);
    G2M_TOKEN(1, true, 10, 10); G2M_TOKEN(2, true, 10, 10); G2M_TOKEN(3, true, 10, 10);
    G2M_TOKEN(4, true, 10, 10); G2M_TOKEN(5, true, 10, 10); G2M_TOKEN(6, true, 10, 10);
    G2M_TOKEN(7, false, 10, 0);
#undef G2M_TOKEN
}
template <int WHICH>
__device__ void ph_peer_sliced(const Params& p, int l, int vb0, int nvb, char* smem_) {
    const int tid = TIDX(), wave = tid >> 6;
    const bf16_t* H = (const bf16_t*)(p.ws + WS_H); const unsigned char* PU = p.ws + WS_PU; const unsigned char* PV = p.ws + WS_PV;
    const int* RI = (const int*)(p.ws + WS_RI); float* RG = (float*)(p.ws + WS_RG); float* PP = (float*)(p.ws + WS_PP);
    const float* modb = (const float*)(p.ws + WS_MOD);
    {
    {
#pragma unroll 1
        for (int u_ = vb0; u_ < 2048; u_ += nvb) {
            const int x = u_ & 7, chunk = u_ >> 3;
            {
                const int lane = lane_id_opaque(), eg = lane >> 3, ll = lane & 7;
                const int tb = chunk * 64 + wave * 8;
                if (WHICH == 0 && G1_MFMA) { g1m_chunk(p, x, tb, smem_, lane); continue; }
                if (WHICH == 1 && G2_MFMA) { g2m_chunk(p, l, x, tb, smem_, lane); continue; }
                int* lri = (int*)smem_ + wave * 2048; float* lrg = (float*)(lri + 1024);
                {
                    int ra[16]; float rg_[16];
#pragma unroll
                    for (int i = 0; i < 8; ++i) {
                        ra[2 * i] = RI[(size_t)(tb + i) * 128 + lane]; ra[2 * i + 1] = RI[(size_t)(tb + i) * 128 + 64 + lane];
                        if (WHICH == 1) { rg_[2 * i] = RG[(size_t)(tb + i) * 128 + lane]; rg_[2 * i + 1] = RG[(size_t)(tb + i) * 128 + 64 + lane]; }
                    }
#pragma unroll
                    for (int i = 0; i < 8; ++i) {
                        lri[i * 128 + lane] = ra[2 * i]; lri[i * 128 + 64 + lane] = ra[2 * i + 1];
                        if (WHICH == 1) { lrg[i * 128 + lane] = rg_[2 * i]; lrg[i * 128 + 64 + lane] = rg_[2 * i + 1]; }
                    }
                }
                __builtin_amdgcn_fence(__ATOMIC_RELEASE, "wavefront");
                __builtin_amdgcn_wave_barrier();
                __builtin_amdgcn_fence(__ATOMIC_ACQUIRE, "wavefront");
                const unsigned l16 = (unsigned)ll * 16u;
                if (WHICH == 0) {
                    const unsigned char* ub = PU + (size_t)x * (16384u * 128u);
                    const bf16_t* hrow = H + (size_t)tb * 1024 + x * 128 + ll * 16;
                    float* pp_row = PP + ((size_t)x * T_TOK + tb) * 128 + ll * 8 + eg;
                    u32x4 hq0 = ((const u32x4*)hrow)[0], hq1 = ((const u32x4*)hrow)[1], uqA[8], uqB[8];
                    peer_gather8(uqA, ub, lri + eg, l16);
                    peer_gather8(uqB, ub, lri + eg + 64, l16);
#pragma unroll 1
                    for (int i = 0; i < 7; ++i) g1_step<true>(i, tb + i, hrow + (size_t)(i + 1) * 1024, ub, lri + eg, l16, lane, pp_row + (size_t)i * 128, hq0, hq1, uqA, uqB);
                    g1_step<false>(7, tb + 7, hrow, ub, lri + eg, l16, lane, pp_row + (size_t)7 * 128, hq0, hq1, uqA, uqB);
                } else {
                    const unsigned char* vb_ = PV + (size_t)x * (16384u * 128u);
                    const int col = x * 128 + ll * 16 + ((lane >> 5) & 1) * 8 + ((lane >> 4) & 1) * 4 + ((lane >> 3) & 1) * 2;
                    const float2 gf = *(const float2*)(modb + (size_t)(l * 8 + (tb >> 11)) * 6144 + 5120 + col);
                    float2* op = (float2*)(p.out + (size_t)tb * 1024 + col);
                    u32x4 vqA[8], vqB[8];
                    peer_gather8(vqA, vb_, lri + eg, l16);
                    peer_gather8(vqB, vb_, lri + eg + 64, l16);
#pragma unroll 1
                    for (int i = 0; i < 7; ++i) g2_step<true>(i, op + (size_t)i * 512, gf, vb_, lri + eg, lrg + eg, l16, lane, vqA, vqB);
                    g2_step<false>(7, op + (size_t)7 * 512, gf, vb_, lri + eg, lrg + eg, l16, lane, vqA, vqB);
                }
            }
        }
    }
    __syncthreads();
    }
}
__device__ void ph_peer_coef(const Params& p, int vb0, int nvb) {
    const int wave = TIDX() >> 6, lane = TIDX() & 63;
    float* RG = (float*)(p.ws + WS_RG); const float* PP = (const float*)(p.ws + WS_PP);
    for (int t0 = (vb0 * 8 + wave) * 2; t0 < T_TOK; t0 += nvb * 8 * 2) {
        float pp[2][2][8], g[2][2];
#pragma unroll
        for (int u = 0; u < 2; ++u)
#pragma unroll
            for (int half = 0; half < 2; ++half) {
                const int k = half * 64 + lane;
#pragma unroll
                for (int x = 0; x < 8; ++x) pp[u][half][x] = PP[((size_t)x * T_TOK + t0 + u) * 128 + k];
                g[u][half] = RG[(size_t)(t0 + u) * 128 + k];
            }
        asm volatile("" ::: "memory");
#pragma unroll
        for (int u = 0; u < 2; ++u) {
            float cf[2];
#pragma unroll
            for (int half = 0; half < 2; ++half) {
                float d = 0.f;
#pragma unroll
                for (int x = 0; x < 8; ++x) d += pp[u][half][x];
                d *= (1.f / PU_SCALE);
                cf[half] = g[u][half] * 0.5f * d * (1.f + erff(d * 0.7071067811865476f)) * (1.f / PV_SCALE);
                if (!G2_MFMA) RG[(size_t)(t0 + u) * 128 + half * 64 + lane] = cf[half];
            }
            if (G2_MFMA) {
                const float m = wave_max(fmaxf(fabsf(cf[0]), fabsf(cf[1])));
                const float sc = m > 0.f ? 240.f / m : 0.f;
                const float c0 = cf[0] * sc, c1 = cf[1] * sc;
                const int hi = __builtin_amdgcn_cvt_pk_fp8_f32(c0, c1, 0, false);
                const auto bk = __builtin_amdgcn_cvt_pk_f32_fp8(hi, false);
                const int lo = __builtin_amdgcn_cvt_pk_fp8_f32((c0 - bk[0]) * 16.f, (c1 - bk[1]) * 16.f, 0, false);
                unsigned char* c8h = p.ws + WS_C8H + (size_t)(t0 + u) * 128; unsigned char* c8l = p.ws + WS_C8L + (size_t)(t0 + u) * 128;
                const int s0 = ((lane >> 3) & 3) * 32 + (lane >> 5) * 8 + (lane & 7);
                c8h[s0] = (unsigned char)(hi & 0xff); c8h[s0 + 16] = (unsigned char)((hi >> 8) & 0xff);
                c8l[s0] = (unsigned char)(lo & 0xff); c8l[s0 + 16] = (unsigned char)((lo >> 8) & 0xff);
                if (lane == 0) ((float*)(p.ws + WS_CINV))[t0 + u] = m * (1.f / 240.f);
            }
        }
    }
}

enum { PH_MOD = 0, PH_WPREP, PH_NORM1, PH_GEMM_IN, PH_SCAN, PH_MERGE, PH_OUT, PH_NORM2, PH_GEMM_Q, PH_GEMM_SC, PH_ROUTE, PH_G1, PH_G15, PH_G2 };

template <int PH>
__device__ __forceinline__ void run_phase(const Params& p, int l, int vb0, int nvb, char* smem) {
    const float* xin = (l == 0) ? p.x : p.out;
    if (PH == PH_MOD) ph_mod(p, vb0, nvb, smem);
    else if (PH == PH_WPREP) ph_wprep(p, l, vb0, nvb, smem);
    else if (PH == PH_NORM1) ph_norm(p, l, 0, xin, vb0, nvb);
    else if (PH == PH_GEMM_IN) {
        pg8::Gemm g{(const bf16_t*)(p.ws + WS_H), (const bf16_t*)(p.ws + WS_WIN), 1024, 1024, 1024};
        pg8::StaticOrder S; S.init(T_TOK, LDZ, nvb, vb0, 1024, 1024);
        pg8::gemm_phase(( PG8_LAS unsigned char*)smem, g, S, pg8::EpiBf16{(bf16_t*)(p.ws + WS_Z), LDZ}, TIDX());
    }
    else if (PH == PH_SCAN) ph_mixA(p, l, vb0, nvb, smem);
    else if (PH == PH_MERGE) {
        pg8::Gemm g{(const bf16_t*)(p.ws + WS_Y), (const bf16_t*)(p.ws + WS_WBR), 1536, 512, 512};
        pg8::MergeOrder S{vb0, nvb};
        pg8::gemm_phase((PG8_LAS unsigned char*)smem, g, S, pg8::EpiMerge{(bf16_t*)(p.ws + WS_H), (const bf16_t*)(p.ws + WS_Z)}, TIDX());
    }
    else if (PH == PH_OUT) {
        pg8::Gemm g{(const bf16_t*)(p.ws + WS_H), (const bf16_t*)(p.ws + WS_WOUT), 1024, 1024, 1024};
        pg8::StaticOrder S; S.init(T_TOK, 1024, nvb, vb0, 1024, 1024);
        pg8::gemm_phase((PG8_LAS unsigned char*)smem, g, S, pg8::EpiResid{xin, p.out, (const float*)(p.ws + WS_MOD) + (size_t)l * 8 * 6144}, TIDX());
    }
    else if (PH == PH_NORM2) ph_norm(p, l, 1, p.out, vb0, nvb);
    else if (PH == PH_GEMM_Q) {
        pg8::Gemm g{(const bf16_t*)(p.ws + WS_H), (const bf16_t*)(p.ws + WS_WQ), 1024, 1024, 1024};
        pg8::StaticOrder S; S.init(T_TOK, 2048, nvb, vb0, 1024, 1024);
        pg8::gemm_phase((PG8_LAS unsigned char*)smem, g, S, pg8::EpiF16P{(_Float16*)(p.ws + WS_SC), 2048}, TIDX());
        asm volatile("s_waitcnt vmcnt(0)" ::: "memory");
        __syncthreads();
        {
            const int tid_ = TIDX(), lane_ = tid_ & 63, wave_ = __builtin_amdgcn_readfirstlane(tid_ >> 6);
            _Float16* tile_ = (_Float16*)smem + wave_ * (64 * 72);
#pragma unroll 1
            for (int i = (wave_ >> 2); ; i += 2) {
                pg8::Unit u; if (!S.next(i, u)) break;
                route_wave(p, u.pm * 256 + (wave_ & 3) * 64, u.pn, tile_, lane_);
            }
        }
    }
    else if (PH == PH_GEMM_SC) gemm_phase((const bf16_t*)(p.ws + WS_QP), 2048, (const bf16_t*)(p.ws + WS_SK), 128, T_TOK, 2048, 128, true,
                                          EpiF16{(_Float16*)(p.ws + WS_SC), 2048}, vb0, nvb, smem, TIDX());
    else if (PH == PH_G1) ph_peer_sliced<0>(p, l, vb0, nvb, smem);
    else if (PH == PH_G15) ph_peer_coef(p, vb0, nvb);
    else if (PH == PH_G2) ph_peer_sliced<1>(p, l, vb0, nvb, smem);

}

#define XB_TMO      128
#define XB_XCNT(j)  (256  + 64 * (j))
#define XB_XSUB(j)  (1280 + 64 * (j))
#define XB_XGEN(j)  (2304 + 64 * (j))
#define XB_TOP      3328
#define XB_TOPGEN   3392
#define XCD_BAR_WORDS 3456
#define XB_SPIN_CAP (1u << 18)
#define LAS __attribute__((address_space(3)))
__device__ __forceinline__ unsigned xb_ld(unsigned* p)              { return __hip_atomic_load(p, __ATOMIC_RELAXED, __HIP_MEMORY_SCOPE_AGENT); }
__device__ __forceinline__ unsigned xb_add(unsigned* p, unsigned v) { return __hip_atomic_fetch_add(p, v, __ATOMIC_RELAXED, __HIP_MEMORY_SCOPE_AGENT); }
#define XB_SPIN(cond, bar) do { unsigned _sp = 0; while (cond) { __builtin_amdgcn_s_sleep(1); \
    if ((++_sp & 255u) == 0u) { if (xb_ld(&(bar)[XB_TMO])) break; if (_sp > XB_SPIN_CAP) { atomicAdd(&(bar)[XB_TMO], 1u); break; } } } } while (0)
struct XcdBarrier { unsigned* bar; unsigned x; volatile LAS unsigned* st; int wv; };
__device__ __forceinline__ XcdBarrier xcd_barrier_post(unsigned* bar, volatile LAS unsigned* st, int wv) {
    XcdBarrier b; b.bar = bar; b.x = xb_xcc_id(); b.st = st; b.wv = wv;
    if (TIDXW(wv) == 0) (void)xb_add(&bar[XB_XCNT(b.x)], 1u);
    return b;
}
__device__ __forceinline__ void xcd_barrier_complete(unsigned* bar, unsigned x, unsigned& nloc, unsigned& nx) {
    const unsigned G = gridDim.x * gridDim.y * gridDim.z;
    unsigned sum, cnt, mine, sp = 0u;
    for (;;) {
        sum = 0u; cnt = 0u; mine = 0u;
#pragma unroll
        for (unsigned j = 0; j < 16; ++j) { const unsigned c = xb_ld(&bar[XB_XCNT(j)]); sum += c; cnt += (c > 0u) ? 1u : 0u; mine = (j == x) ? c : mine; }
        if (sum == G) break;
        __builtin_amdgcn_s_sleep(1);
        if ((++sp & 255u) == 0u) { if (xb_ld(&bar[XB_TMO])) break; if (sp > XB_SPIN_CAP) { atomicAdd(&bar[XB_TMO], 1u); break; } }
    }
    nloc = mine > 0u ? mine : 1u; nx = cnt > 0u ? cnt : 1u;
}
__device__ __forceinline__ void xcd_barrier(const XcdBarrier& b) {
    asm volatile("s_waitcnt vmcnt(0)" ::: "memory");
    __syncthreads();
    if (TIDXW(b.wv) == 0) {
        unsigned* bar = b.bar;
        __builtin_amdgcn_s_waitcnt(0);
        unsigned nloc = b.st[0], nx = b.st[1];
        if (nloc == 0u) { xcd_barrier_complete(bar, b.x, nloc, nx); b.st[0] = nloc; b.st[1] = nx; }
        const unsigned old = xb_add(&bar[XB_XSUB(b.x)], 1u);
        const unsigned gen = old / nloc;
        if (old + 1u == (gen + 1u) * nloc) {
            __builtin_amdgcn_fence(__ATOMIC_RELEASE, "agent");
            asm volatile("s_waitcnt vmcnt(0)" ::: "memory");
            const unsigned og = xb_add(&bar[XB_TOP], 1u);
            const unsigned tg = og / nx;
            if (og + 1u == (tg + 1u) * nx) xb_add(&bar[XB_TOPGEN], 1u);
            else XB_SPIN(xb_ld(&bar[XB_TOPGEN]) == tg, bar);
            __builtin_amdgcn_fence(__ATOMIC_ACQUIRE, "agent");
            xb_add(&bar[XB_XGEN(b.x)], 1u);
            asm volatile("s_waitcnt vmcnt(0)" ::: "memory");
        } else {
            XB_SPIN(xb_ld(&bar[XB_XGEN(b.x)]) == gen, bar);
            __builtin_amdgcn_fence(__ATOMIC_ACQUIRE, "agent");
            asm volatile("s_waitcnt vmcnt(0)" ::: "memory");
        }
    }
    __syncthreads();
}

__global__ void __launch_bounds__(NT) mega_kernel(Params p_in) {
#if defined(__HIP_DEVICE_COMPILE__)
    extern __shared__ __attribute__((aligned(16))) char smem[];
    volatile LAS unsigned* st = (volatile LAS unsigned*)(smem + LDS_BYTES - 16);
    int wv_ = __builtin_amdgcn_readfirstlane((int)threadIdx.x >> 6); asm volatile("" : "+s"(wv_));
    { const int t_ = TIDXW(wv_); if (t_ < 4) st[t_] = 0u; }
    __syncthreads();
    XcdBarrier bar = xcd_barrier_post((unsigned*)(p_in.ws + WS_CTL), st, wv_);
    const int vb = (int)blockIdx.x, nvb = (int)gridDim.x;
#define GB() xcd_barrier(bar)
#define RUN(PH, L) do { \
        const __attribute__((address_space(4))) Params* _kp = (const __attribute__((address_space(4))) Params*)__builtin_amdgcn_kernarg_segment_ptr(); asm volatile("" : "+s"(_kp)); Params _p = *_kp; _p.wv = wv_; \
        int _l = (L), _vb = vb, _nvb = nvb; asm volatile("" : "+s"(_l), "+s"(_vb), "+s"(_nvb)); \
        run_phase<PH>(_p, _l, _vb, _nvb, smem); } while (0)
    RUN(PH_MOD, 0);
#pragma unroll 1
    for (int l = 0; l < 2; ++l) {
        RUN(PH_WPREP, l); if (l == 0) GB();
        RUN(PH_NORM1, l); GB();
        RUN(PH_GEMM_IN, l); GB();
        RUN(PH_SCAN, l); GB();
        RUN(PH_MERGE, l); GB();
        RUN(PH_OUT, l); GB();
        RUN(PH_NORM2, l); GB();
        RUN(PH_GEMM_Q, l); GB();
        RUN(PH_G1, l); GB();
        RUN(PH_G15, l); GB();
        RUN(PH_G2, l);
        if (l == 0) GB();
    }
#undef RUN
#undef GB
#endif
}

extern "C" void kernel_launch(void* const* d_in, const int* in_sizes, int n_in, void* d_out, int out_size, void* d_ws, size_t ws_size,
                              hipStream_t stream) {
    if (n_in != 20 || ws_size < WS_END) { fprintf(stderr, "kernel_launch: bad inputs (n_in %d ws %zu need %zu)\n", n_in, ws_size, (size_t)WS_END); return; }
    Params p{};
    p.x = (const float*)d_in[0]; p.c = (const float*)d_in[1]; p.w_ada = (const float*)d_in[2]; p.b_ada = (const float*)d_in[3];
    p.norm_mix = (const float*)d_in[4]; p.norm_ffn = (const float*)d_in[5]; p.w_in = (const float*)d_in[6]; p.hgrn_lb = (const float*)d_in[7];
    p.hgrn_on = (const float*)d_in[8]; p.dsa_qn = (const float*)d_in[9]; p.dsa_kn = (const float*)d_in[10]; p.gla_up = (const float*)d_in[11];
    p.gla_bias = (const float*)d_in[12]; p.gla_on = (const float*)d_in[13]; p.w_branch = (const float*)d_in[14]; p.w_out = (const float*)d_in[15];
    p.peer_wq = (const float*)d_in[16]; p.peer_keys = (const float*)d_in[17]; p.peer_u = (const float*)d_in[18]; p.peer_v = (const float*)d_in[19];
    p.out = (float*)d_out; p.ws = (unsigned char*)d_ws;
    static int grid = 0;
    if (grid == 0) {
        int dev = 0, cus = 0, per_cu = 0;
        hipGetDevice(&dev);
        hipDeviceGetAttribute(&cus, hipDeviceAttributeMultiprocessorCount, dev);
        hipFuncSetAttribute((const void*)mega_kernel, hipFuncAttributeMaxDynamicSharedMemorySize, LDS_BYTES);
        hipOccupancyMaxActiveBlocksPerMultiprocessor(&per_cu, (const void*)mega_kernel, NT, LDS_BYTES);
        if (per_cu < 1) { fprintf(stderr, "kernel_launch: occupancy query says %d blocks per CU\n", per_cu); per_cu = 1; }
        (void)hipGetLastError();
        grid = cus;
    }
    hipMemsetAsync((char*)d_ws + WS_CTL, 0, 32768, stream);
    void* args[] = {&p};
    hipError_t e = hipLaunchCooperativeKernel((const void*)mega_kernel, dim3(grid), dim3(NT), args, LDS_BYTES, stream);
    if (e != hipSuccess) fprintf(stderr, "cooperative launch failed: %s (grid %d)\n", hipGetErrorString(e), grid);
}
```

```cpp
#include <hip/hip_runtime.h>
#include <stdint.h>
#include <stdio.h>

typedef unsigned short bf16_t;
typedef short bf16x8 __attribute__((ext_vector_type(8)));
typedef float f32x4 __attribute__((ext_vector_type(4)));
typedef unsigned u32x4 __attribute__((ext_vector_type(4)));

#define NT 512
constexpr int T_TOK = 16384, DM = 1024, SEQ = 2048;
constexpr int LDZ = 8704;
constexpr int ZA_Q = 0, ZA_F = 512, ZA_I = 1024, ZA_G = 1536, ZB_Q = 2048, ZB_K = 2560, ZB_V = 3072, ZC_V = 3584, ZC_G = 4096,
              ZB_QI = 4608, ZC_Q = 4864, ZC_K = 5120, ZB_KI = 5376, ZB_WI = 5440, ZC_CODE = 5444, ZM = 5632;
constexpr int IN_COLS = 8532;

constexpr size_t al256(size_t x) { return (x + 255) & ~(size_t)255; }
constexpr size_t WS_CTL = 0;
constexpr size_t WS_MOD = 65536;
constexpr size_t WS_WIN = al256(WS_MOD + (size_t)2 * 8 * 6144 * 4);
constexpr size_t WS_WBR = al256(WS_WIN + (size_t)LDZ * 1024 * 2);
constexpr size_t WS_WOUT = al256(WS_WBR + (size_t)3 * 1024 * 512 * 2);
constexpr size_t WS_WQ = al256(WS_WOUT + (size_t)1024 * 1024 * 2);
constexpr size_t WS_SK = al256(WS_WQ + (size_t)2048 * 1024 * 2);
constexpr size_t WS_PU = al256(WS_SK + (size_t)16 * 128 * 128 * 2);
constexpr size_t WS_PV = al256(WS_PU + (size_t)16384 * 1024);
constexpr size_t WS_H = al256(WS_PV + (size_t)16384 * 1024);
constexpr float PU_SCALE = 32.f, PV_SCALE = 4.f;
constexpr size_t WS_OA = al256(WS_H + (size_t)T_TOK * 1024 * 2);
constexpr size_t WS_OC = al256(WS_OA + (size_t)T_TOK * 512 * 2);
constexpr size_t WS_H8H = WS_OA, WS_H8L = WS_OC;
constexpr size_t WS_Y = al256(WS_OC + (size_t)T_TOK * 512 * 2);
constexpr size_t WS_Z = al256(WS_Y + (size_t)T_TOK * 1536 * 2);
constexpr size_t WS_VT = al256(WS_Z + (size_t)T_TOK * LDZ * 2);
constexpr size_t WS_BM = al256(WS_VT + (size_t)T_TOK * 512 * 2);
constexpr size_t WS_END = al256(WS_BM + (size_t)T_TOK * 64 * 4);
constexpr size_t WS_QP = WS_Z;
constexpr size_t WS_SC = al256(WS_QP + (size_t)T_TOK * 2048 * 2);
constexpr size_t WS_RI = al256(WS_SC + (size_t)T_TOK * 2048 * 4);
constexpr size_t WS_RG = al256(WS_RI + (size_t)T_TOK * 128 * 4);
constexpr size_t WS_PP = al256(WS_RG + (size_t)T_TOK * 128 * 4);
constexpr size_t WS_C8H = WS_SC;
constexpr size_t WS_C8L = WS_C8H + (size_t)T_TOK * 128;
constexpr size_t WS_CINV = WS_C8L + (size_t)T_TOK * 128;
static_assert(WS_PP + (size_t)8 * T_TOK * 128 * 4 <= WS_VT, "peer partials overflow the Z region");
static_assert(WS_RG + (size_t)T_TOK * 128 * 4 <= WS_END, "peer alias overflow");

struct Params {
    const float* x; const float* c; const float* w_ada; const float* b_ada; const float* norm_mix; const float* norm_ffn;
    const float* w_in; const float* hgrn_lb; const float* hgrn_on; const float* dsa_qn; const float* dsa_kn;
    const float* gla_up; const float* gla_bias; const float* gla_on; const float* w_branch; const float* w_out;
    const float* peer_wq; const float* peer_keys; const float* peer_u; const float* peer_v;
    float* out; unsigned char* ws;
    int wv, pad;
};

__device__ __forceinline__ float bf2f(bf16_t h) { return __uint_as_float(((unsigned)h) << 16); }
__device__ __forceinline__ float bflo(unsigned u) { return __uint_as_float(u << 16); }
__device__ __forceinline__ float bfhi(unsigned u) { return __uint_as_float(u & 0xffff0000u); }
__device__ __forceinline__ bf16_t f2bf(float f) { unsigned r; asm volatile("v_cvt_pk_bf16_f32 %0, %1, %1" : "=v"(r) : "v"(f)); return (bf16_t)(r & 0xffffu); }
__device__ __forceinline__ unsigned pack2(float a, float b) { unsigned r; asm volatile("v_cvt_pk_bf16_f32 %0, %1, %2" : "=v"(r) : "v"(a), "v"(b)); return r; }
__device__ __forceinline__ int lane_id_opaque() { int l; asm volatile("v_mbcnt_lo_u32_b32 %0, -1, 0\n\tv_mbcnt_hi_u32_b32 %0, -1, %0" : "=v"(l)); return l; }
template <int M> __device__ __forceinline__ int shx_i(int v) {
    if (M < 32) return __builtin_amdgcn_ds_swizzle(v, (M << 10) | 0x1f);
    return __builtin_amdgcn_ds_bpermute((lane_id_opaque() ^ 32) << 2, v);
}
template <int M> __device__ __forceinline__ float shx(float v) { return __int_as_float(shx_i<M>(__float_as_int(v))); }
template <int M> __device__ __forceinline__ int shx(int v) { return shx_i<M>(v); }
template <int M> __device__ __forceinline__ unsigned shx(unsigned v) { return (unsigned)shx_i<M>((int)v); }
__device__ __forceinline__ int bperm(int v, int src) { return __builtin_amdgcn_ds_bpermute(src << 2, v); }
__device__ __forceinline__ float bperm(float v, int src) { return __int_as_float(__builtin_amdgcn_ds_bpermute(src << 2, __float_as_int(v))); }
__device__ __forceinline__ float wave_sum(float v) { v += shx<32>(v); v += shx<16>(v); v += shx<8>(v); v += shx<4>(v); v += shx<2>(v); v += shx<1>(v); return v; }
__device__ __forceinline__ float wave_max(float v) { v = fmaxf(v, shx<32>(v)); v = fmaxf(v, shx<16>(v)); v = fmaxf(v, shx<8>(v)); v = fmaxf(v, shx<4>(v)); v = fmaxf(v, shx<2>(v)); v = fmaxf(v, shx<1>(v)); return v; }
__device__ __forceinline__ int wave_sum_i(int v) { v += shx<32>(v); v += shx<16>(v); v += shx<8>(v); v += shx<4>(v); v += shx<2>(v); v += shx<1>(v); return v; }
__device__ __forceinline__ int wave_total_i(int v) {
    v += __builtin_amdgcn_update_dpp(0, v, 0x111, 0xf, 0xf, true);
    v += __builtin_amdgcn_update_dpp(0, v, 0x112, 0xf, 0xf, true);
    v += __builtin_amdgcn_update_dpp(0, v, 0x114, 0xf, 0xf, true);
    v += __builtin_amdgcn_update_dpp(0, v, 0x118, 0xf, 0xf, true);
    v += __builtin_amdgcn_update_dpp(0, v, 0x142, 0xa, 0xf, true);
    v += __builtin_amdgcn_update_dpp(0, v, 0x143, 0xc, 0xf, true);
    return __builtin_amdgcn_readlane(v, 63);
}
__device__ __forceinline__ float fexp(float x) { return __builtin_amdgcn_exp2f(x * 1.4426950408889634f); }
__device__ __forceinline__ float flog(float x) { return __builtin_amdgcn_logf(x) * 0.6931471805599453f; }
__device__ __forceinline__ float frcp(float x) { return __builtin_amdgcn_rcpf(x); }
__device__ __forceinline__ float sigm(float x) { return frcp(1.f + fexp(-x)); }

__device__ __forceinline__ unsigned xb_xcc_id() { return (unsigned)__builtin_amdgcn_s_getreg((3 << 11) | 20) & 0xFu; }
__device__ __forceinline__ int TIDXW(int wv) { int t; asm volatile("v_mbcnt_lo_u32_b32 %0, -1, 0\n\tv_mbcnt_hi_u32_b32 %0, -1, %0\n\tv_lshl_or_b32 %0, %1, 6, %0" : "=v"(t) : "s"(wv)); return t; }
#define TIDX() TIDXW(p.wv)

__device__ __forceinline__ int src_col(int j) {
    if (j < 3584) return j;
    if (j < 4096) return j - 3584 + 4420;
    if (j < 4608) return j - 4096 + 4948;
    if (j < 4864) return j - 4608 + 3584;
    if (j < 5120) return j - 4864 + 3908;
    if (j < 5376) return j - 5120 + 4164;
    if (j < 5440) return j - 5376 + 3840;
    if (j < 5444) return j - 5440 + 3904;
    if (j < 5460) return j - 5444 + 4932;
    if (j < 5632) return -1;
    return j - 5632 + 5460;
}

__device__ void ph_mod(const Params& p, int vb0, int nvb, char* smem_) {
    float* sc = (float*)smem_;
    float* part = sc + 8 * 1024;
    float* mod = (float*)(p.ws + WS_MOD);
    const int tid = TIDX(), lane = tid & 63, wave = tid >> 6;
    if (vb0 >= 192) return;
    for (int i = tid; i < 8 * 1024; i += NT) { float c = p.c[i]; sc[i] = c / (1.f + __expf(-c)); }
    __syncthreads();
    for (int task = vb0; task < 192; task += nvb) {
        const int l = task / 96, n0 = (task % 96) * 64;
        const float* w = p.w_ada + (size_t)l * 1024 * 6144 + (size_t)(wave * 128) * 6144 + n0 + lane;
        float acc[8];
#pragma unroll
        for (int b = 0; b < 8; ++b) acc[b] = 0.f;
#pragma unroll 1
        for (int k0 = 0; k0 < 128; k0 += 16) {
            float wv[16];
#pragma unroll
            for (int j = 0; j < 16; ++j) wv[j] = w[(size_t)(k0 + j) * 6144];
#pragma unroll
            for (int j = 0; j < 16; ++j)
#pragma unroll
                for (int b = 0; b < 8; ++b) acc[b] += sc[b * 1024 + wave * 128 + k0 + j] * wv[j];
        }
#pragma unroll
        for (int b = 0; b < 8; ++b) part[(wave * 8 + b) * 64 + lane] = acc[b];
        __syncthreads();
        {
            const int b = tid >> 6, col = tid & 63;
            float v = p.b_ada[l * 6144 + n0 + col];
#pragma unroll
            for (int w_ = 0; w_ < 8; ++w_) v += part[(w_ * 8 + b) * 64 + col];
            mod[(size_t)(l * 8 + b) * 6144 + n0 + col] = v;
        }
        __syncthreads();
    }
}

template <bool MAP>
__device__ void tr_tile(const float* __restrict__ src, int lds_, bf16_t* __restrict__ out, int ldo, int k0, int n0, float* tile, const int tid) {
    float lv[8];
    {
        const int nn = tid & 63, scol = MAP ? src_col(n0 + nn) : (n0 + nn);
#pragma unroll
        for (int i = 0; i < 8; ++i) { const int kk = (tid >> 6) + 8 * i; lv[i] = (scol >= 0) ? src[(size_t)(k0 + kk) * lds_ + scol] : 0.f; }
#pragma unroll
        for (int i = 0; i < 8; ++i) { const int kk = (tid >> 6) + 8 * i; tile[kk * 65 + nn] = lv[i]; }
    }
    __syncthreads();
#pragma unroll
    for (int i = 0; i < 4; ++i) {
        int nn = (tid >> 5) + 16 * i, kk = (tid & 31) * 2;
        unsigned v = pack2(tile[kk * 65 + nn], tile[(kk + 1) * 65 + nn]);
        *(unsigned*)(out + (size_t)(n0 + nn) * ldo + k0 + kk) = v;
    }
    __syncthreads();
}
__device__ void conv_chunk(const float* __restrict__ src, bf16_t* __restrict__ dst, size_t base, const int tid) {
    f32x4 la[4], lb[4];
#pragma unroll
    for (int i = 0; i < 4; ++i) { const size_t e = base + (size_t)(i * NT + tid) * 8; la[i] = *(const f32x4*)(src + e); lb[i] = *(const f32x4*)(src + e + 4); }
#pragma unroll
    for (int i = 0; i < 4; ++i) {
        size_t e = base + (size_t)(i * NT + tid) * 8;
        const float4 a = make_float4(la[i][0], la[i][1], la[i][2], la[i][3]), b = make_float4(lb[i][0], lb[i][1], lb[i][2], lb[i][3]);
        uint4 o; o.x = pack2(a.x, a.y); o.y = pack2(a.z, a.w); o.z = pack2(b.x, b.y); o.w = pack2(b.z, b.w);
        *(uint4*)(dst + e) = o;
    }
}
__device__ void conv_chunk_fp8(const float* __restrict__ src, unsigned char* __restrict__ dst, size_t base, float scale, const int tid) {
    f32x4 la[4], lb[4];
#pragma unroll
    for (int i = 0; i < 4; ++i) { const size_t e = base + (size_t)(i * NT + tid) * 8; la[i] = *(const f32x4*)(src + e); lb[i] = *(const f32x4*)(src + e + 4); }
#pragma unroll
    for (int i = 0; i < 4; ++i) {
        size_t e = base + (size_t)(i * NT + tid) * 8;
        const float4 a = make_float4(la[i][0], la[i][1], la[i][2], la[i][3]), b = make_float4(lb[i][0], lb[i][1], lb[i][2], lb[i][3]);
        int lo = __builtin_amdgcn_cvt_pk_fp8_f32(a.x * scale, a.y * scale, 0, false); lo = __builtin_amdgcn_cvt_pk_fp8_f32(a.z * scale, a.w * scale, lo, true);
        int hi = __builtin_amdgcn_cvt_pk_fp8_f32(b.x * scale, b.y * scale, 0, false); hi = __builtin_amdgcn_cvt_pk_fp8_f32(b.z * scale, b.w * scale, hi, true);
        const size_t row = e >> 10, col = e & 1023;
        *(uint2*)(dst + ((col >> 7) * 16384 + row) * 128 + (col & 127)) = make_uint2((unsigned)lo, (unsigned)hi);
    }
}
__device__ __forceinline__ bf16x8 ld8_f32_bf16(const float* src) {
    const f32x4 a = *(const f32x4*)src, b = *(const f32x4*)(src + 4);
    union { bf16x8 v; unsigned u[4]; } r; r.u[0] = pack2(a[0], a[1]); r.u[1] = pack2(a[2], a[3]); r.u[2] = pack2(b[0], b[1]); r.u[3] = pack2(b[2], b[3]);
    return r.v;
}
__device__ void wqk_task(const float* __restrict__ wq, const float* __restrict__ keys, bf16_t* __restrict__ out, int g, int kt, const int tid) {
    const int lane = tid & 63, wave = tid >> 6, fr = lane & 15, fq = lane >> 4;
    const float* kp = keys + ((size_t)g * 128 + wave * 16 + fr) * 128 + fq * 8;
    const float* wp = wq + (size_t)(kt * 64 + fr) * 2048 + g * 128 + fq * 8;
    f32x4 acc[4];
#pragma unroll
    for (int kb = 0; kb < 4; ++kb) acc[kb] = f32x4{0.f, 0.f, 0.f, 0.f};
#pragma unroll
    for (int dd = 0; dd < 4; ++dd) {
        const bf16x8 kf = ld8_f32_bf16(kp + dd * 32);
#pragma unroll
        for (int kb = 0; kb < 4; ++kb) acc[kb] = __builtin_amdgcn_mfma_f32_16x16x32_bf16(ld8_f32_bf16(wp + (size_t)(kb * 16) * 2048 + dd * 32), kf, acc[kb], 0, 0, 0);
    }
#pragma unroll
    for (int kb = 0; kb < 4; ++kb) {
        unsigned w[4];
#pragma unroll
        for (int j = 0; j < 4; ++j) { const unsigned u = __float_as_uint(acc[kb][j]); w[j] = (u + 0x7fffu + ((u >> 16) & 1u)) >> 16; }
        uint2 o; o.x = w[0] | (w[1] << 16); o.y = w[2] | (w[3] << 16);
        *(uint2*)(out + ((size_t)g * 128 + wave * 16 + fr) * 1024 + kt * 64 + kb * 16 + fq * 4) = o;
    }
}
__device__ void ph_wprep(const Params& p, int l, int vb0, int nvb, char* smem_) {
    float* tile = (float*)smem_;
    const int tid = TIDX();
    bf16_t* WIN = (bf16_t*)(p.ws + WS_WIN); bf16_t* WBR = (bf16_t*)(p.ws + WS_WBR); bf16_t* WOUT = (bf16_t*)(p.ws + WS_WOUT);
    bf16_t* WQ = (bf16_t*)(p.ws + WS_WQ); unsigned char* PU = p.ws + WS_PU; unsigned char* PV = p.ws + WS_PV;
    constexpr int N_WIN = 136 * 16, N_WBR = 3 * 16 * 8, N_WOUT = 16 * 16, N_WQ = 16 * 16, N_PU = 1024, N_PV = 1024;
    constexpr int TOTAL = N_WIN + N_WBR + N_WOUT + N_WQ + N_PU + N_PV;
    for (int task = vb0; task < TOTAL; task += nvb) {
        int r = task;
        if (r < N_WIN) { int nt = r / 16, kt = r % 16; tr_tile<true>(p.w_in + (size_t)l * 1024 * IN_COLS, IN_COLS, WIN, 1024, kt * 64, nt * 64, tile, tid); continue; }
        r -= N_WIN;
        if (r < N_WBR) { int g = r / 128, rr = r % 128, nt = rr / 8, kt = rr % 8;
            tr_tile<false>(p.w_branch + (size_t)(l * 3 + g) * 512 * 1024, 1024, WBR + (size_t)g * 1024 * 512, 512, kt * 64, nt * 64, tile, tid); continue; }
        r -= N_WBR;
        if (r < N_WOUT) { int nt = r / 16, kt = r % 16; tr_tile<false>(p.w_out + (size_t)l * 1024 * 1024, 1024, WOUT, 1024, kt * 64, nt * 64, tile, tid); continue; }
        r -= N_WOUT;
        if (r < N_WQ) { wqk_task(p.peer_wq + (size_t)l * 1024 * 2048, p.peer_keys + (size_t)l * 16 * 128 * 128, WQ, r / 16, r % 16, tid); continue; }
        r -= N_WQ;
        if (r < N_PU) { conv_chunk_fp8(p.peer_u + (size_t)l * 16384 * 1024, PU, (size_t)r * 16384, PU_SCALE, tid); continue; }
        r -= N_PU;
        conv_chunk_fp8(p.peer_v + (size_t)l * 16384 * 1024, PV, (size_t)r * 16384, PV_SCALE, tid);
    }
}

__device__ void ph_norm(const Params& p, int l, int which, const float* xin, int vb0, int nvb) {
    const int wave = TIDX() >> 6, lane = TIDX() & 63;
    const float* gain = (which ? p.norm_ffn : p.norm_mix) + l * 1024;
    const float* modb = (const float*)(p.ws + WS_MOD);
    bf16_t* H = (bf16_t*)(p.ws + WS_H);
    f32x4 g[4];
#pragma unroll
    for (int i = 0; i < 4; ++i) g[i] = *(const f32x4*)(gain + (lane + 64 * i) * 4);
    for (int t = vb0 * 8 + wave; t < T_TOK; t += nvb * 8) {
        const int b = t >> 11;
        const float* mod = modb + (size_t)(l * 8 + b) * 6144 + (which ? 3072 : 0);
        const f32x4* xr = (const f32x4*)(xin + (size_t)t * 1024);
        f32x4 v[4], sc[4], sh[4]; float ss = 0.f;
#pragma unroll
        for (int i = 0; i < 4; ++i) { v[i] = xr[lane + 64 * i]; sc[i] = *(const f32x4*)(mod + 1024 + (lane + 64 * i) * 4); sh[i] = *(const f32x4*)(mod + (lane + 64 * i) * 4); }
#pragma unroll
        for (int i = 0; i < 4; ++i) ss += v[i][0] * v[i][0] + v[i][1] * v[i][1] + v[i][2] * v[i][2] + v[i][3] * v[i][3];
        ss = wave_sum(ss);
        const float rstd = rsqrtf(ss * (1.f / 1024.f) + 1e-6f);
#pragma unroll
        for (int i = 0; i < 4; ++i) {
            const int idx = (lane + 64 * i) * 4;
            const f32x4 h = v[i] * rstd * g[i] * (1.f + sc[i]) + sh[i];
            uint2 o; o.x = pack2(h[0], h[1]); o.y = pack2(h[2], h[3]);
            *(uint2*)(H + (size_t)t * 1024 + idx) = o;
            if (which) {
                int hi = __builtin_amdgcn_cvt_pk_fp8_f32(h[0], h[1], 0, false); hi = __builtin_amdgcn_cvt_pk_fp8_f32(h[2], h[3], hi, true);
                const auto d0 = __builtin_amdgcn_cvt_pk_f32_fp8(hi, false); const auto d1 = __builtin_amdgcn_cvt_pk_f32_fp8(hi, true);
                int lo = __builtin_amdgcn_cvt_pk_fp8_f32((h[0] - d0[0]) * 16.f, (h[1] - d0[1]) * 16.f, 0, false);
                lo = __builtin_amdgcn_cvt_pk_fp8_f32((h[2] - d1[0]) * 16.f, (h[3] - d1[1]) * 16.f, lo, true);
                *(int*)(p.ws + WS_H8H + (size_t)t * 1024 + idx) = hi;
                *(int*)(p.ws + WS_H8L + (size_t)t * 1024 + idx) = lo;
            }
        }
    }
}

constexpr int GBM = 256, GBN = 128, GBK = 64, GLS = 72;
__device__ __forceinline__ void gemm_tile(const bf16_t* __restrict__ A, int lda, const bf16_t* __restrict__ Bt, int ldb, int K,
                                          int m0, int n0, bf16_t* sA, bf16_t* sB, f32x4 (&acc)[4][4], const int tid) {
    const int lane = tid & 63, wave = tid >> 6;
    const int wm = wave >> 1, wn = wave & 1, fr = lane & 15, fq = lane >> 4;
    u32x4 ra[4], rb[2];
    const int crow = tid >> 3, ckc = (tid & 7) * 8;
    const bf16_t* Ag = A + (size_t)(m0 + crow) * lda + ckc;
    const bf16_t* Bg = Bt + (size_t)(n0 + crow) * ldb + ckc;
#pragma unroll
    for (int i = 0; i < 4; ++i) ra[i] = *(const u32x4*)(Ag + (size_t)(64 * i) * lda);
#pragma unroll
    for (int i = 0; i < 2; ++i) rb[i] = *(const u32x4*)(Bg + (size_t)(64 * i) * ldb);
    for (int k0 = 0; k0 < K; k0 += GBK) {
        __syncthreads();
#pragma unroll
        for (int i = 0; i < 4; ++i) *(u32x4*)(sA + (crow + 64 * i) * GLS + ckc) = ra[i];
#pragma unroll
        for (int i = 0; i < 2; ++i) *(u32x4*)(sB + (crow + 64 * i) * GLS + ckc) = rb[i];
        __syncthreads();
        {
            const int kn = (k0 + GBK < K) ? (k0 + GBK) : k0;
#pragma unroll
            for (int i = 0; i < 4; ++i) ra[i] = *(const u32x4*)(Ag + (size_t)(64 * i) * lda + kn);
#pragma unroll
            for (int i = 0; i < 2; ++i) rb[i] = *(const u32x4*)(Bg + (size_t)(64 * i) * ldb + kn);
        }
#pragma unroll
        for (int ks = 0; ks < 2; ++ks) {
            bf16x8 af[4], wf[4];
#pragma unroll
            for (int mf = 0; mf < 4; ++mf) af[mf] = *(const bf16x8*)(sA + (wm * 64 + mf * 16 + fr) * GLS + ks * 32 + fq * 8);
#pragma unroll
            for (int nf = 0; nf < 4; ++nf) wf[nf] = *(const bf16x8*)(sB + (wn * 64 + nf * 16 + fr) * GLS + ks * 32 + fq * 8);
#pragma unroll
            for (int nf = 0; nf < 4; ++nf)
#pragma unroll
                for (int mf = 0; mf < 4; ++mf)
                    acc[nf][mf] = __builtin_amdgcn_mfma_f32_16x16x32_bf16(wf[nf], af[mf], acc[nf][mf], 0, 0, 0);
        }
    }
}


namespace pg8 {
#define PG8_LAS __attribute__((address_space(3)))
constexpr int BM = 256, BK = 64, HALF = 128, HTB = HALF * BK * 2, STAGE_BYTES = 8 * HTB, NXCD = 8, WGM = 8;
__device__ __forceinline__ int lds_byte(int r, int c) { const int st = (r >> 4) * 2 + (c >> 5), rr = r & 15, cc = c & 31, ob = rr * 64 + cc * 2; return st * 1024 + (ob ^ (((ob >> 9) & 1) << 5)); }
__device__ __forceinline__ void stage_rc(int b, int& R, int& C) { const int st = b / 1024, sb = b % 1024, swz = sb ^ (((sb >> 9) & 1) << 5); R = (st >> 1) * 16 + swz / 64; C = (st & 1) * 32 + (swz % 64) / 2; }
__device__ __forceinline__ int perm32(int rho) { const int n = rho >> 4, i = rho & 15; return 8 * (i >> 2) + 4 * n + (i & 3); }
struct Unit { int pm, pn, aux; size_t aoff, boff; };
struct Gemm { const bf16_t* A; const bf16_t* Bt; int lda, ldb, K; };

struct StaticOrder {
    int nM, nN, nwg, G, c, lda, ldb;
    __device__ void init(int M, int N, int G_, int c_, int lda_, int ldb_) { nM = M / BM; nN = N / BM; nwg = nM * nN; G = G_; c = c_; lda = lda_; ldb = ldb_; }
    __device__ bool next(int i, Unit& u) const {
        const long L = (long)i * G + c; if (L >= nwg) return false;
        int wgid = (int)L; { const int q = nwg / NXCD, r = nwg % NXCD, xcd = wgid % NXCD, off = wgid / NXCD; wgid = (xcd < r ? xcd * (q + 1) : r * (q + 1) + (xcd - r) * q) + off; }
        const int nig = WGM * nN, gid = wgid / nig, fm = gid * WGM, gsz = (nM - fm) < WGM ? (nM - fm) : WGM;
        u.pm = fm + ((wgid % nig) % gsz); u.pn = (wgid % nig) / gsz; u.aux = 0;
        u.aoff = (size_t)u.pm * BM * lda * 2; u.boff = (size_t)u.pn * BM * ldb * 2;
        return true;
    }
};
struct MergeOrder {
    int c, G;
    __device__ bool next(int i, Unit& u) const {
        const int tile = c + (i / 3) * G; if (tile >= 256) return false;
        u.pm = tile & 63; u.pn = tile >> 6; u.aux = i % 3;
        u.aoff = ((size_t)u.pm * BM * 1536 + (size_t)u.aux * 512) * 2; u.boff = ((size_t)u.aux * 1024 + (size_t)u.pn * BM) * 512 * 2;
        return true;
    }
};

template <class Epi, class Sched>
__device__ __forceinline__ void gemm_phase(PG8_LAS unsigned char* lds, const Gemm g, const Sched& S, const Epi& E, const int tid) {
    const int wid = __builtin_amdgcn_readfirstlane(tid >> 6), lane = tid & 63, wr = wid >> 2, wc = wid & 3, fr = lane & 15, fq = lane >> 4;
    const int K = g.K, nt = K / BK;
    unsigned voffA[2], voffB[2];
#pragma unroll
    for (int i = 0; i < 2; ++i) { int R, C; stage_rc(tid * 16 + i * 8192, R, C); const int Rb = Epi::PERM ? ((R & ~31) + perm32(R & 31)) : R;
        voffA[i] = (unsigned)(R * g.lda + C) * 2u; voffB[i] = (unsigned)(Rb * g.ldb + C) * 2u; }
    const size_t kstep = (size_t)(BK * 2);
    const size_t hstepA = (size_t)HALF * g.lda * 2, hstepB = (size_t)HALF * g.ldb * 2;
    const unsigned ldsw = (unsigned)wid * 1024u;
    const int aoff = lds_byte(wr * 64 + fr, fq * 8), boff = lds_byte(wc * 32 + fr, fq * 8);
#define PG8_SA(b, h) (((b) * 2 + (h)) * HTB)
#define PG8_SB(b, h) ((4 + (b) * 2 + (h)) * HTB)
#define PG8_STAGE(bufoff, gbase, voff) do { _Pragma("unroll") for (int _i = 0; _i < 2; ++_i) \
        __builtin_amdgcn_global_load_lds((const unsigned*)((const char*)(gbase) + (voff)[_i]), (PG8_LAS unsigned*)(lds + (bufoff) + ldsw + _i * 8192), 16, 0, 0); } while (0)
#define PG8_LDA(dst, b, h) do { _Pragma("unroll") for (int m = 0; m < 4; ++m) _Pragma("unroll") for (int k = 0; k < 2; ++k) dst[m][k] = *(const PG8_LAS bf16x8*)(lds + PG8_SA(b, h) + aoff + m * 2048 + k * 1024); } while (0)
#define PG8_LDB(dst, b, h) do { _Pragma("unroll") for (int n = 0; n < 2; ++n) _Pragma("unroll") for (int k = 0; k < 2; ++k) dst[n][k] = *(const PG8_LAS bf16x8*)(lds + PG8_SB(b, h) + boff + n * 2048 + k * 1024); } while (0)
#define PG8_MMA(ai, bj, At, Bt) do { __builtin_amdgcn_s_setprio(1); _Pragma("unroll") for (int m = 0; m < 4; ++m) _Pragma("unroll") for (int n = 0; n < 2; ++n) _Pragma("unroll") for (int k = 0; k < 2; ++k) \
        acc[ai][bj][m][n] = __builtin_amdgcn_mfma_f32_16x16x32_bf16(Bt[n][k], At[m][k], acc[ai][bj][m][n], 0, 0, 0); __builtin_amdgcn_s_setprio(0); } while (0)
#define PG8_WAIT_V(n) asm volatile("s_waitcnt vmcnt(" #n ")" ::: "memory")
#define PG8_WAIT_L(n) asm volatile("s_waitcnt lgkmcnt(" #n ")" ::: "memory")
#define PG8_BAR __builtin_amdgcn_s_barrier()
#define PG8_SCHED __builtin_amdgcn_sched_barrier(0)
    Unit cur, nxt; int ui = 0;
    if (!S.next(0, cur)) return;
    f32x4 acc[2][2][4][2];
#pragma unroll
    for (int a = 0; a < 2; ++a)
#pragma unroll
        for (int b = 0; b < 2; ++b)
#pragma unroll
            for (int m = 0; m < 4; ++m)
#pragma unroll
                for (int n = 0; n < 2; ++n) acc[a][b][m][n] = f32x4{0.f, 0.f, 0.f, 0.f};
    bf16x8 At[4][2], B0[2][2], B1[2][2];
    const char* cA = (const char*)g.A + cur.aoff; const char* cB = (const char*)g.Bt + cur.boff;
    PG8_STAGE(PG8_SB(0, 0), cB, voffB); PG8_STAGE(PG8_SA(0, 0), cA, voffA); PG8_STAGE(PG8_SB(0, 1), cB + hstepB, voffB); PG8_STAGE(PG8_SA(0, 1), cA + hstepA, voffA);
    if (wr == 1) PG8_BAR;
    PG8_WAIT_V(4); PG8_BAR;
    PG8_STAGE(PG8_SB(1, 0), cB + kstep, voffB); PG8_STAGE(PG8_SA(1, 0), cA + kstep, voffA); PG8_STAGE(PG8_SB(1, 1), cB + hstepB + kstep, voffB);
    PG8_WAIT_V(6); PG8_BAR;
    for (;;) {
        const bool has_next = S.next(ui + 1, nxt);
        const char* nA = has_next ? (const char*)g.A + nxt.aoff : cA; const char* nB = has_next ? (const char*)g.Bt + nxt.boff : cB;
        for (int t = 0; t < nt; t += 2) {
            const bool last = (t == nt - 2);
            const char* a1 = cA + (size_t)(t + 1) * kstep;
            const char* a2 = last ? nA : cA + (size_t)(t + 2) * kstep; const char* b2 = last ? nB : cB + (size_t)(t + 2) * kstep;
            const char* a3 = a2 + kstep; const char* b3 = b2 + kstep;
            PG8_LDB(B0, 0, 0); PG8_SCHED; PG8_LDA(At, 0, 0); PG8_STAGE(PG8_SA(1, 1), a1 + hstepA, voffA);
            PG8_WAIT_L(8); PG8_BAR; PG8_WAIT_L(0); PG8_MMA(0, 0, At, B0); PG8_BAR; PG8_SCHED;
            PG8_LDB(B1, 0, 1); PG8_STAGE(PG8_SB(0, 0), b2, voffB);
            PG8_BAR; PG8_WAIT_L(0); PG8_MMA(0, 1, At, B1); PG8_BAR;
            PG8_LDA(At, 0, 1); PG8_STAGE(PG8_SA(0, 0), a2, voffA);
            PG8_BAR; PG8_WAIT_L(0); PG8_MMA(1, 0, At, B0); PG8_BAR; PG8_SCHED;
            PG8_STAGE(PG8_SB(0, 1), b2 + hstepB, voffB);
            PG8_WAIT_V(6); PG8_BAR; PG8_MMA(1, 1, At, B1); PG8_BAR;
            PG8_LDB(B0, 1, 0); PG8_SCHED; PG8_LDA(At, 1, 0); PG8_STAGE(PG8_SA(0, 1), a2 + hstepA, voffA);
            PG8_WAIT_L(8); PG8_BAR; PG8_WAIT_L(0); PG8_MMA(0, 0, At, B0); PG8_BAR; PG8_SCHED;
            PG8_LDB(B1, 1, 1); PG8_STAGE(PG8_SB(1, 0), b3, voffB);
            PG8_BAR; PG8_WAIT_L(0); PG8_MMA(0, 1, At, B1); PG8_BAR;
            PG8_LDA(At, 1, 1); PG8_STAGE(PG8_SA(1, 0), a3, voffA);
            PG8_BAR; PG8_WAIT_L(0); PG8_MMA(1, 0, At, B0); PG8_BAR; PG8_SCHED;
            PG8_STAGE(PG8_SB(1, 1), b3 + hstepB, voffB);
            PG8_WAIT_V(6); PG8_BAR; PG8_MMA(1, 1, At, B1); PG8_BAR;
        }
        E(acc, cur, wr, wc, fr, fq);
        if (!has_next) break;
#pragma unroll
        for (int a = 0; a < 2; ++a)
#pragma unroll
            for (int b = 0; b < 2; ++b)
#pragma unroll
                for (int m = 0; m < 4; ++m)
#pragma unroll
                    for (int n = 0; n < 2; ++n) acc[a][b][m][n] = f32x4{0.f, 0.f, 0.f, 0.f};
        cur = nxt; cA = nA; cB = nB; ++ui;
    }
    PG8_WAIT_V(0);
    if (wr == 0) PG8_BAR;
    PG8_BAR;
#undef PG8_SA
#undef PG8_SB
#undef PG8_STAGE
#undef PG8_LDA
#undef PG8_LDB
#undef PG8_MMA
#undef PG8_WAIT_V
#undef PG8_WAIT_L
#undef PG8_BAR
#undef PG8_SCHED
}

struct EpiBf16 {
    static constexpr bool PERM = true;
    bf16_t* O; int ldc;
    __device__ __forceinline__ void operator()(const f32x4 (&acc)[2][2][4][2], const Unit& u, int wr, int wc, int fr, int fq) const {
        const int row0 = u.pm * BM + wr * 64 + fr, col0 = u.pn * BM + wc * 32 + 8 * fq;
#pragma unroll
        for (int ai = 0; ai < 2; ++ai)
#pragma unroll
            for (int m = 0; m < 4; ++m) { bf16_t* rowp = O + (size_t)(row0 + ai * HALF + m * 16) * ldc + col0;
#pragma unroll
                for (int bj = 0; bj < 2; ++bj) { const f32x4 v0 = acc[ai][bj][m][0], v1 = acc[ai][bj][m][1];
                    u32x4 w; w.x = pack2(v0[0], v0[1]); w.y = pack2(v0[2], v0[3]); w.z = pack2(v1[0], v1[1]); w.w = pack2(v1[2], v1[3]);
                    *(u32x4*)(rowp + bj * HALF) = w; } }
    }
};
struct EpiF16P {
    static constexpr bool PERM = true;
    _Float16* O; int ldc;
    __device__ __forceinline__ void operator()(const f32x4 (&acc)[2][2][4][2], const Unit& u, int wr, int wc, int fr, int fq) const {
        typedef _Float16 h8v __attribute__((ext_vector_type(8)));
        const int row0 = u.pm * BM + wr * 64 + fr, col0 = u.pn * BM + wc * 32 + 8 * fq;
#pragma unroll
        for (int ai = 0; ai < 2; ++ai)
#pragma unroll
            for (int m = 0; m < 4; ++m) { _Float16* rowp = O + (size_t)(row0 + ai * HALF + m * 16) * ldc + col0;
#pragma unroll
                for (int bj = 0; bj < 2; ++bj) { const f32x4 v0 = acc[ai][bj][m][0], v1 = acc[ai][bj][m][1];
                    const h8v w = {(_Float16)v0[0], (_Float16)v0[1], (_Float16)v0[2], (_Float16)v0[3], (_Float16)v1[0], (_Float16)v1[1], (_Float16)v1[2], (_Float16)v1[3]};
                    *(h8v*)(rowp + bj * HALF) = w; } }
    }
};
struct EpiResid {
    static constexpr bool PERM = false;
    const float* xin; float* out; const float* mod;
    __device__ __forceinline__ void operator()(const f32x4 (&acc)[2][2][4][2], const Unit& u, int wr, int wc, int fr, int fq) const {
        const int row0 = u.pm * BM + wr * 64 + fr, col0 = u.pn * BM + wc * 32 + 4 * fq;
        const float* gm = mod + (size_t)(row0 >> 11) * 6144 + 2048 + col0;
        f32x4 g4[2][2];
#pragma unroll
        for (int bj = 0; bj < 2; ++bj)
#pragma unroll
            for (int n = 0; n < 2; ++n) g4[bj][n] = *(const f32x4*)(gm + bj * HALF + n * 16);
#pragma unroll
        for (int ai = 0; ai < 2; ++ai) {
            f32x4 xi[4][2][2];
#pragma unroll
            for (int m = 0; m < 4; ++m)
#pragma unroll
                for (int bj = 0; bj < 2; ++bj)
#pragma unroll
                    for (int n = 0; n < 2; ++n) xi[m][bj][n] = *(const f32x4*)(xin + (size_t)(row0 + ai * HALF + m * 16) * 1024 + col0 + bj * HALF + n * 16);
            asm volatile("" ::: "memory");
#pragma unroll
            for (int m = 0; m < 4; ++m)
#pragma unroll
                for (int bj = 0; bj < 2; ++bj)
#pragma unroll
                    for (int n = 0; n < 2; ++n)
                        *(f32x4*)(out + (size_t)(row0 + ai * HALF + m * 16) * 1024 + col0 + bj * HALF + n * 16) = xi[m][bj][n] + g4[bj][n] * acc[ai][bj][m][n];
            asm volatile("" ::: "memory");
        }
    }
};
struct EpiMerge {
    static constexpr bool PERM = true;
    bf16_t* Hm; const bf16_t* Z;
    __device__ __forceinline__ void operator()(const f32x4 (&acc)[2][2][4][2], const Unit& u, int wr, int wc, int fr, int fq) const {
        const int row0 = u.pm * BM + wr * 64 + fr, col0 = u.pn * BM + wc * 32 + 8 * fq, g = u.aux;
#pragma unroll
        for (int ai = 0; ai < 2; ++ai) {
            u32x4 gz[4][2], prev[4][2];
#pragma unroll
            for (int m = 0; m < 4; ++m)
#pragma unroll
                for (int bj = 0; bj < 2; ++bj) {
                    const int row = row0 + ai * HALF + m * 16, col = col0 + bj * HALF;
                    gz[m][bj] = *(const u32x4*)(Z + (size_t)row * LDZ + ZM + g * 1024 + col);
                    prev[m][bj] = u32x4{0u, 0u, 0u, 0u};
                    if (g > 0) prev[m][bj] = *(const u32x4*)(Hm + (size_t)row * 1024 + col);
                }
            asm volatile("" ::: "memory");
#pragma unroll
            for (int m = 0; m < 4; ++m)
#pragma unroll
                for (int bj = 0; bj < 2; ++bj) {
                    const int row = row0 + ai * HALF + m * 16, col = col0 + bj * HALF;
                    const f32x4 v0 = acc[ai][bj][m][0], v1 = acc[ai][bj][m][1];
                    const u32x4 z_ = gz[m][bj], p_ = prev[m][bj];
                    u32x4 w;
                    w.x = pack2(bflo(p_.x) + sigm(bflo(z_.x)) * v0[0], bfhi(p_.x) + sigm(bfhi(z_.x)) * v0[1]);
                    w.y = pack2(bflo(p_.y) + sigm(bflo(z_.y)) * v0[2], bfhi(p_.y) + sigm(bfhi(z_.y)) * v0[3]);
                    w.z = pack2(bflo(p_.z) + sigm(bflo(z_.z)) * v1[0], bfhi(p_.z) + sigm(bfhi(z_.z)) * v1[1]);
                    w.w = pack2(bflo(p_.w) + sigm(bflo(z_.w)) * v1[2], bfhi(p_.w) + sigm(bfhi(z_.w)) * v1[3]);
                    *(u32x4*)(Hm + (size_t)row * 1024 + col) = w;
                }
            asm volatile("" ::: "memory");
        }
    }
};
}

struct EpiZ {
    bf16_t* Z; int ld;
    __device__ __forceinline__ void operator()(int m, int n, const f32x4& v) const {
        uint2 o; o.x = pack2(v[0], v[1]); o.y = pack2(v[2], v[3]);
        *(uint2*)(Z + (size_t)m * ld + n) = o;
    }
};
struct EpiF16 {
    _Float16* C; int ld;
    __device__ __forceinline__ void operator()(int m, int n, const f32x4& v) const {
        typedef _Float16 h4 __attribute__((ext_vector_type(4)));
        h4 o = {(_Float16)v[0], (_Float16)v[1], (_Float16)v[2], (_Float16)v[3]};
        *(h4*)(C + (size_t)m * ld + n) = o;
    }
};
struct EpiOut {
    const float* xin; float* out; const float* mod;
    __device__ __forceinline__ void operator()(int m, int n, const f32x4& v) const {
        int b = m >> 11;
        float4 g = *(const float4*)(mod + (size_t)b * 6144 + 2048 + n);
        float4 xi = *(const float4*)(xin + (size_t)m * 1024 + n);
        *(float4*)(out + (size_t)m * 1024 + n) = make_float4(xi.x + g.x * v[0], xi.y + g.y * v[1], xi.z + g.z * v[2], xi.w + g.w * v[3]);
    }
};

template <class Epi>
__device__ void gemm_phase(const bf16_t* A, int lda, const bf16_t* Bt, int ldb, int M, int N, int K, bool batched, Epi epi,
                           int vb0, int nvb, char* smem_, const int tid) {
    bf16_t* sA = (bf16_t*)smem_; bf16_t* sB = sA + GBM * GLS;
    const int lane = tid & 63, wave = tid >> 6, wm = wave >> 1, wn = wave & 1, fr = lane & 15, fq = lane >> 4;
    const int MT = M / GBM, NTL = N / GBN;
    for (int tile = vb0; tile < MT * NTL; tile += nvb) {
        int mt = tile % MT, nt = tile / MT;
        f32x4 acc[4][4];
#pragma unroll
        for (int a = 0; a < 4; ++a)
#pragma unroll
            for (int b = 0; b < 4; ++b) acc[a][b] = f32x4{0.f, 0.f, 0.f, 0.f};
        gemm_tile(batched ? A + nt * 128 : A, lda, Bt, ldb, K, mt * GBM, nt * GBN, sA, sB, acc, tid);
#pragma unroll
        for (int nf = 0; nf < 4; ++nf)
#pragma unroll
            for (int mf = 0; mf < 4; ++mf)
                epi(mt * GBM + wm * 64 + mf * 16 + fr, nt * GBN + wn * 64 + nf * 16 + fq * 4, acc[nf][mf]);
    }
}
__device__ __forceinline__ void sc_tile(const Params& p, int mt, int nt, char* smem_, const int tid) {
    bf16_t* sA = (bf16_t*)smem_; bf16_t* sB = sA + GBM * GLS;
    const int lane = tid & 63, wave = tid >> 6, wm = wave >> 1, wn = wave & 1, fr = lane & 15, fq = lane >> 4;
    f32x4 acc[4][4];
#pragma unroll
    for (int a = 0; a < 4; ++a)
#pragma unroll
        for (int b = 0; b < 4; ++b) acc[a][b] = f32x4{0.f, 0.f, 0.f, 0.f};
    gemm_tile((const bf16_t*)(p.ws + WS_QP) + nt * 128, 2048, (const bf16_t*)(p.ws + WS_SK), 128, 128, mt * GBM, nt * GBN, sA, sB, acc, tid);
    const EpiF16 epi{(_Float16*)(p.ws + WS_SC), 2048};
#pragma unroll
    for (int nf = 0; nf < 4; ++nf)
#pragma unroll
        for (int mf = 0; mf < 4; ++mf)
            epi(mt * GBM + wm * 64 + mf * 16 + fr, nt * GBN + wn * 64 + nf * 16 + fq * 4, acc[nf][mf]);
}

#define SCAN_SYNC() do { asm volatile("s_waitcnt lgkmcnt(0)" ::: "memory"); __builtin_amdgcn_s_barrier(); asm volatile("" ::: "memory"); } while (0)
template <int DK, bool GLA>
__device__ void scan2_item(const Params& p, int l, int b, int h, char* smem_) {
    constexpr int SEG = NT / DK, SLEN = 64 / SEG, KS = DK / 32, KT = DK / 16;
    constexpr int QS = DK + 8, BS = DK + 4, VS = 72;
    bf16_t* qs = (bf16_t*)smem_;
    bf16_t* ks = qs + 64 * QS;
    float* bs = (float*)(ks + 64 * QS);
    bf16_t* vt = (bf16_t*)(bs + 64 * BS);
    bf16_t* At = vt + 128 * VS;
    bf16_t* kht = At + 64 * VS;
    bf16_t* st = kht + DK * VS;
    float* segtot = (float*)(st + 128 * QS);
    float* blast = segtot + SEG * DK;
    const int tid = TIDX(), lane = tid & 63, wave = __builtin_amdgcn_readfirstlane(tid >> 6), fr = lane & 15, fq = lane >> 4;
    const int kl = tid % DK, seg = __builtin_amdgcn_readfirstlane(tid / DK);
    float lbv = 0.f, gbias = 0.f; float gu[16];
#pragma unroll
    for (int r = 0; r < 16; ++r) gu[r] = 0.f;
    if (GLA) {
#pragma unroll
        for (int r = 0; r < 16; ++r) gu[r] = p.gla_up[(size_t)(l * 16 + r) * 256 + h * 64 + kl];
        gbias = p.gla_bias[l * 256 + h * 64 + kl];
    } else if (l == 1) {
        float x0 = p.hgrn_lb[h * 128 + kl], x1 = p.hgrn_lb[512 + h * 128 + kl];
        lbv = 1.f / (1.f + expf(x0 - x1));
    }
    const float scale = GLA ? 0.125f : 0.08838834764831845f;
    const bf16_t* Zb = (const bf16_t*)(p.ws + WS_Z) + (size_t)(b * 2048) * LDZ;
    float* ssq = (float*)(smem_ + 152576);
    const int QCOL = (GLA ? ZC_Q : ZA_Q) + h * DK, KCOL = (GLA ? ZC_K : ZA_F) + h * DK, VCOL = (GLA ? ZC_V : ZA_I) + h * 128, GCOL = (GLA ? ZC_G : ZA_G) + h * 128;
    f32x4 sacc[KT];
#pragma unroll
    for (int i = 0; i < KT; ++i) sacc[i] = f32x4{0.f, 0.f, 0.f, 0.f};
    f32x4 gn4[4];
    {
        const float* gn = (GLA ? p.gla_on : p.hgrn_on) + l * 128 + (wave >> 2) * 64 + 4 * fq;
#pragma unroll
        for (int vi = 0; vi < 4; ++vi) gn4[vi] = *(const f32x4*)(gn + vi * 16);
    }
    for (int i = tid; i < 128 * QS / 2; i += NT) ((unsigned*)st)[i] = 0u;
    SCAN_SYNC();

    bf16_t rq[SLEN], rk[SLEN], rv[16];
    u32x4 rc0[GLA ? SLEN : 1], rc1[GLA ? SLEN : 1];
    const int v_ = tid & 127, sb_ = __builtin_amdgcn_readfirstlane(tid >> 7);
#define SCAN_FETCH(cc) do { const bf16_t* Zn_ = Zb + (size_t)((cc) * 64) * LDZ; \
        _Pragma("unroll") for (int i = 0; i < 16; ++i) rv[i] = Zn_[(size_t)(sb_ + 4 * i) * LDZ + VCOL + v_]; \
        _Pragma("unroll") for (int i = 0; i < SLEN; ++i) { const bf16_t* zr = Zn_ + (size_t)(seg * SLEN + i) * LDZ; rq[i] = zr[QCOL + kl]; rk[i] = zr[KCOL + kl]; \
            if (GLA) { rc0[i] = *(const u32x4*)(zr + ZC_CODE); rc1[i] = *(const u32x4*)(zr + ZC_CODE + 8); } } } while (0)
    SCAN_FETCH(0);
    for (int c = 0; c < 32; ++c) {
        const bf16_t* Zc = Zb + (size_t)(c * 64) * LDZ;
        {
#pragma unroll
            for (int i = 0; i < 16; ++i) vt[v_ * VS + sb_ + 4 * i] = rv[i];
            float run = 0.f;
#pragma unroll
            for (int i = 0; i < SLEN; ++i) {
                const int s_ = seg * SLEN + i;
                float g, kk;
                if (GLA) {
                    float x = gbias;
#pragma unroll
                    for (int r = 0; r < 4; ++r) {
                        x += bflo(rc0[i][r]) * gu[2 * r] + bfhi(rc0[i][r]) * gu[2 * r + 1];
                        x += bflo(rc1[i][r]) * gu[8 + 2 * r] + bfhi(rc1[i][r]) * gu[8 + 2 * r + 1];
                    }
                    g = (fminf(x, 0.f) - flog(1.f + fexp(-fabsf(x)))) * (1.f / 16.f);
                    kk = bf2f(rk[i]);
                } else {
                    const float f = lbv + (1.f - lbv) * frcp(1.f + fexp(-bf2f(rk[i])));
                    g = flog(f); kk = 1.f - f;
                }
                run += g;
                bs[s_ * BS + kl] = run;
                qs[s_ * QS + kl] = rq[i];
                ks[s_ * QS + kl] = f2bf(kk);
            }
            segtot[seg * DK + kl] = run;
            SCAN_FETCH(c < 31 ? c + 1 : 31);
        }
        SCAN_SYNC();
        {
            float pre = 0.f, tot = 0.f;
#pragma unroll
            for (int g_ = 0; g_ < SEG; ++g_) { const float v_ = segtot[g_ * DK + kl]; if (g_ < seg) pre += v_; tot += v_; }
            if (seg == 0) blast[kl] = tot;
            unsigned pk[SLEN / 2];
#pragma unroll
            for (int i = 0; i < SLEN; ++i) {
                const float bv = bs[(seg * SLEN + i) * BS + kl] + pre;
                bs[(seg * SLEN + i) * BS + kl] = bv;
                const float kh = bf2f(ks[(seg * SLEN + i) * QS + kl]) * fexp(tot - bv);
                if (i & 1) pk[i >> 1] |= ((unsigned)f2bf(kh)) << 16; else pk[i >> 1] = (unsigned)f2bf(kh);
            }
            unsigned* dst = (unsigned*)(kht + kl * VS + seg * SLEN);
#pragma unroll
            for (int i = 0; i < SLEN / 2; ++i) dst[i] = pk[i];
        }
        SCAN_SYNC();
        for (int blk = wave; blk < 10; blk += 8) {
            int bi, bj;
            if (blk < 1) { bi = 0; bj = 0; } else if (blk < 3) { bi = 1; bj = blk - 1; } else if (blk < 6) { bi = 2; bj = blk - 3; } else { bi = 3; bj = blk - 6; }
            f32x4 acc = f32x4{0.f, 0.f, 0.f, 0.f};
            const int srow = bj * 16 + fr, trow = bi * 16 + fr;
#pragma unroll
            for (int kk = 0; kk < KS; ++kk) {
                const int k0 = kk * 32 + fq * 8;
                float br[8];
                if (bi == 0) {
#pragma unroll
                    for (int j = 0; j < 8; ++j) br[j] = 0.f;
                } else {
                    const float4 r0 = *(const float4*)(bs + (bi * 16 - 1) * BS + k0), r1 = *(const float4*)(bs + (bi * 16 - 1) * BS + k0 + 4);
                    br[0] = r0.x; br[1] = r0.y; br[2] = r0.z; br[3] = r0.w; br[4] = r1.x; br[5] = r1.y; br[6] = r1.z; br[7] = r1.w;
                }
                const uint4 kq = *(const uint4*)(ks + srow * QS + k0), qq = *(const uint4*)(qs + trow * QS + k0);
                const float4 s0 = *(const float4*)(bs + srow * BS + k0), s1 = *(const float4*)(bs + srow * BS + k0 + 4);
                const float4 t0_ = *(const float4*)(bs + trow * BS + k0), t1_ = *(const float4*)(bs + trow * BS + k0 + 4);
                const float bsv[8] = {s0.x, s0.y, s0.z, s0.w, s1.x, s1.y, s1.z, s1.w}, btv[8] = {t0_.x, t0_.y, t0_.z, t0_.w, t1_.x, t1_.y, t1_.z, t1_.w};
                const unsigned kw[4] = {kq.x, kq.y, kq.z, kq.w}, qw[4] = {qq.x, qq.y, qq.z, qq.w};
                union { bf16x8 v; unsigned u[4]; } ka, qb;
#pragma unroll
                for (int j = 0; j < 4; ++j) {
                    const float e0 = fexp(fminf(br[2 * j] - bsv[2 * j], 60.f)), e1 = fexp(fminf(br[2 * j + 1] - bsv[2 * j + 1], 60.f));
                    ka.u[j] = pack2(bflo(kw[j]) * e0, bfhi(kw[j]) * e1);
                    const float f0 = fexp(btv[2 * j] - br[2 * j]), f1 = fexp(btv[2 * j + 1] - br[2 * j + 1]);
                    qb.u[j] = pack2(bflo(qw[j]) * f0, bfhi(qw[j]) * f1);
                }
                acc = __builtin_amdgcn_mfma_f32_16x16x32_bf16(ka.v, qb.v, acc, 0, 0, 0);
            }
            if (bi == bj) {
#pragma unroll
                for (int r = 0; r < 4; ++r) if (4 * fq + r > fr) acc[r] = 0.f;
            }
            uint2 o; o.x = pack2(acc[0], acc[1]); o.y = pack2(acc[2], acc[3]);
            *(uint2*)(At + trow * VS + bj * 16 + 4 * fq) = o;
        }
        {
            unsigned z_ = 0u; asm volatile("" : "+v"(z_));
            if (wave == 2) *(uint2*)(At + (0 * 16 + fr) * VS + 16 + 4 * fq) = make_uint2(z_, z_);
            if (wave == 3) *(uint2*)(At + (2 * 16 + fr) * VS + 48 + 4 * fq) = make_uint2(z_, z_);
        }
        SCAN_SYNC();
        f32x4 oacc[4]; uint2 gz[4];
        {
            const int ti = wave & 3, vh = wave >> 2, trow = ti * 16 + fr;
            bf16x8 qh[KS];
#pragma unroll
            for (int kk = 0; kk < KS; ++kk) {
                const int k0 = kk * 32 + fq * 8;
                const uint4 qq = *(const uint4*)(qs + trow * QS + k0);
                const float4 t0_ = *(const float4*)(bs + trow * BS + k0), t1_ = *(const float4*)(bs + trow * BS + k0 + 4);
                union { bf16x8 v; unsigned u[4]; } q_;
                q_.u[0] = pack2(bflo(qq.x) * fexp(t0_.x), bfhi(qq.x) * fexp(t0_.y));
                q_.u[1] = pack2(bflo(qq.y) * fexp(t0_.z), bfhi(qq.y) * fexp(t0_.w));
                q_.u[2] = pack2(bflo(qq.z) * fexp(t1_.x), bfhi(qq.z) * fexp(t1_.y));
                q_.u[3] = pack2(bflo(qq.w) * fexp(t1_.z), bfhi(qq.w) * fexp(t1_.w));
                qh[kk] = q_.v;
            }
            const bf16x8 af0 = *(const bf16x8*)(At + trow * VS + fq * 8), af1 = *(const bf16x8*)(At + trow * VS + 32 + fq * 8);
            float sq = 0.f;
#pragma unroll
            for (int vi = 0; vi < 4; ++vi) {
                const int vrow = vh * 64 + vi * 16 + fr;
                gz[vi] = *(const uint2*)(Zc + (size_t)trow * LDZ + GCOL + vh * 64 + vi * 16 + 4 * fq);
                f32x4 acc = f32x4{0.f, 0.f, 0.f, 0.f};
                acc = __builtin_amdgcn_mfma_f32_16x16x32_bf16(*(const bf16x8*)(vt + vrow * VS + fq * 8), af0, acc, 0, 0, 0);
                if (ti >= 2) acc = __builtin_amdgcn_mfma_f32_16x16x32_bf16(*(const bf16x8*)(vt + vrow * VS + 32 + fq * 8), af1, acc, 0, 0, 0);
#pragma unroll
                for (int kk = 0; kk < KS; ++kk)
                    acc = __builtin_amdgcn_mfma_f32_16x16x32_bf16(*(const bf16x8*)(st + vrow * QS + kk * 32 + fq * 8), qh[kk], acc, 0, 0, 0);
                oacc[vi] = acc * scale;
                sq += oacc[vi][0] * oacc[vi][0] + oacc[vi][1] * oacc[vi][1] + oacc[vi][2] * oacc[vi][2] + oacc[vi][3] * oacc[vi][3];
            }
            sq += shx<16>(sq); sq += shx<32>(sq);
            if (fq == 0) ssq[vh * 64 + trow] = sq;
        }
        {
            const int vrow = wave * 16 + fr;
            const bf16x8 vf0 = *(const bf16x8*)(vt + vrow * VS + fq * 8), vf1 = *(const bf16x8*)(vt + vrow * VS + 32 + fq * 8);
#pragma unroll
            for (int kt = 0; kt < KT; ++kt) {
                const float dec = fexp(blast[kt * 16 + fr]);
                sacc[kt][0] *= dec; sacc[kt][1] *= dec; sacc[kt][2] *= dec; sacc[kt][3] *= dec;
                sacc[kt] = __builtin_amdgcn_mfma_f32_16x16x32_bf16(vf0, *(const bf16x8*)(kht + (kt * 16 + fr) * VS + fq * 8), sacc[kt], 0, 0, 0);
                sacc[kt] = __builtin_amdgcn_mfma_f32_16x16x32_bf16(vf1, *(const bf16x8*)(kht + (kt * 16 + fr) * VS + 32 + fq * 8), sacc[kt], 0, 0, 0);
            }
        }
        SCAN_SYNC();
#pragma unroll
        for (int kt = 0; kt < KT; ++kt)
#pragma unroll
            for (int r = 0; r < 4; ++r) st[(wave * 16 + 4 * fq + r) * QS + kt * 16 + fr] = f2bf(sacc[kt][r]);
        {
            const int ti = wave & 3, vh = wave >> 2, trow = ti * 16 + fr;
            const float rstd = rsqrtf((ssq[trow] + ssq[64 + trow]) * (1.f / 128.f) + 1e-6f);
            bf16_t* yrow = (bf16_t*)(p.ws + WS_Y) + (size_t)(b * 2048 + c * 64 + trow) * 1536 + (GLA ? 1024 : 0) + h * 128 + vh * 64 + 4 * fq;
#pragma unroll
            for (int vi = 0; vi < 4; ++vi) {
                const f32x4 g4_ = gn4[vi]; const float4 g4 = make_float4(g4_[0], g4_[1], g4_[2], g4_[3]);
                const float z0 = bflo(gz[vi].x), z1 = bfhi(gz[vi].x), z2 = bflo(gz[vi].y), z3 = bfhi(gz[vi].y);
                uint2 o;
                o.x = pack2(oacc[vi][0] * rstd * g4.x * (z0 * sigm(z0)), oacc[vi][1] * rstd * g4.y * (z1 * sigm(z1)));
                o.y = pack2(oacc[vi][2] * rstd * g4.z * (z2 * sigm(z2)), oacc[vi][3] * rstd * g4.w * (z3 * sigm(z3)));
                *(uint2*)(yrow + vi * 16) = o;
            }
        }
    }
    SCAN_SYNC();
#undef SCAN_FETCH
}

__device__ void dsaprep2_item(const Params& p, int l, int item, char* smem_) {
    bf16_t* tile = (bf16_t*)smem_;
    const int tid = TIDX(), lane = tid & 63, wave = tid >> 6;
    bf16_t* Z = (bf16_t*)(p.ws + WS_Z); bf16_t* VT = (bf16_t*)(p.ws + WS_VT);
    {
        const int tb = item * 32;
        {
            const float2 gq = *(const float2*)(p.dsa_qn + l * 128 + lane * 2), gk = *(const float2*)(p.dsa_kn + l * 128 + lane * 2);
            unsigned uu[4][8];
#pragma unroll
            for (int j = 0; j < 4; ++j)
#pragma unroll
                for (int grp = 0; grp < 8; ++grp)
                    uu[j][grp] = *(const unsigned*)(Z + (size_t)(tb + wave + 8 * j) * LDZ + (grp < 4 ? ZB_Q : ZB_K) + (grp & 3) * 128 + lane * 2);
#pragma unroll
            for (int j = 0; j < 4; ++j)
#pragma unroll
                for (int grp = 0; grp < 8; ++grp) {
                    bf16_t* ptr = Z + (size_t)(tb + wave + 8 * j) * LDZ + (grp < 4 ? ZB_Q : ZB_K) + (grp & 3) * 128 + lane * 2;
                    const float a = bflo(uu[j][grp]), b = bfhi(uu[j][grp]);
                    const float ss = wave_sum(a * a + b * b);
                    const float r = rsqrtf(ss * (1.f / 128.f) + 1e-6f) * ((grp < 4) ? 0.08838834764831845f : 1.f);
                    const float2 g = (grp < 4) ? gq : gk;
                    __hip_atomic_store((unsigned*)ptr, pack2(a * r * g.x, b * r * g.y), __ATOMIC_RELAXED, __HIP_MEMORY_SCOPE_AGENT);
                }
        }
        u32x4 uv[4];
#pragma unroll
        for (int i = 0; i < 4; ++i) { const int ch = tid + i * 512; uv[i] = *(const u32x4*)(Z + (size_t)(tb + (ch >> 6)) * LDZ + ZB_V + (ch & 63) * 8); }
#pragma unroll
        for (int i = 0; i < 4; ++i) {
            const int ch = tid + i * 512, t = ch >> 6, c8 = (ch & 63) * 8;
            unsigned* d = (unsigned*)(tile + t * 514 + c8);
            d[0] = uv[i][0]; d[1] = uv[i][1]; d[2] = uv[i][2]; d[3] = uv[i][3];
        }
        __syncthreads();
        {
            const int c = tid, b = tb >> 11, s0 = tb & 2047;
            unsigned w[16];
#pragma unroll
            for (int j = 0; j < 16; ++j) w[j] = (unsigned)tile[(2 * j) * 514 + c] | ((unsigned)tile[(2 * j + 1) * 514 + c] << 16);
            unsigned long long* dst = (unsigned long long*)(VT + ((size_t)(b * 512 + c)) * 2048 + s0);
#pragma unroll
            for (int j = 0; j < 8; ++j) __hip_atomic_store(dst + j, ((unsigned long long)w[2 * j + 1] << 32) | w[2 * j], __ATOMIC_RELAXED, __HIP_MEMORY_SCOPE_AGENT);
        }
        __syncthreads();
    }
}

__device__ void dsa_select_tile(const Params& p, int b, int tq, char* smem_) {
    constexpr int KS_ = 2052;
    unsigned* keyL = (unsigned*)smem_;
    const int tid = TIDX(), lane = tid & 63, wave = __builtin_amdgcn_readfirstlane(tid >> 6), fr = lane & 15, fq = lane >> 4;
    const bf16_t* Z = (const bf16_t*)(p.ws + WS_Z);
    unsigned long long* BM64 = (unsigned long long*)(p.ws + WS_BM);
    const int t0 = tq * 16;
    {
        const int tl = t0 + fr;
        const size_t trow = (size_t)b * 2048 + tl;
        bf16x8 qf[4][2];
#pragma unroll
        for (int h = 0; h < 4; ++h)
#pragma unroll
            for (int ks = 0; ks < 2; ++ks) qf[h][ks] = *(const bf16x8*)(Z + trow * LDZ + ZB_QI + h * 64 + ks * 32 + fq * 8);
        float w[4];
#pragma unroll
        for (int h = 0; h < 4; ++h) w[h] = bf2f(Z[trow * LDZ + ZB_WI + h]) * 0.5f;
#pragma unroll 4
        for (int kt = wave; kt <= tq; kt += 8) {
            const bf16_t* kr = Z + ((size_t)b * 2048 + kt * 16 + fr) * LDZ + ZB_KI + fq * 8;
            const bf16x8 k0 = *(const bf16x8*)kr, k1 = *(const bf16x8*)(kr + 32);
            f32x4 acc[4];
#pragma unroll
            for (int h = 0; h < 4; ++h) {
                acc[h] = __builtin_amdgcn_mfma_f32_16x16x32_bf16(k0, qf[h][0], f32x4{0.f, 0.f, 0.f, 0.f}, 0, 0, 0);
                acc[h] = __builtin_amdgcn_mfma_f32_16x16x32_bf16(k1, qf[h][1], acc[h], 0, 0, 0);
            }
            u32x4 kk;
#pragma unroll
            for (int r = 0; r < 4; ++r) {
                float sc = w[0] * fmaxf(acc[0][r] * 0.125f, 0.f) + w[1] * fmaxf(acc[1][r] * 0.125f, 0.f) + w[2] * fmaxf(acc[2][r] * 0.125f, 0.f) + w[3] * fmaxf(acc[3][r] * 0.125f, 0.f);
                if (sc == 0.f) sc = 0.f;
                const unsigned u = __float_as_uint(sc);
                const unsigned k = (u & 0x80000000u) ? ~u : (u | 0x80000000u);
                kk[r] = (kt * 16 + 4 * fq + r <= tl) ? k : 0u;
            }
            *(u32x4*)(keyL + fr * KS_ + kt * 16 + 4 * fq) = kk;
        }
    }
    __syncthreads();
    {
        const int nk = (tq + 1) * 16, jmax = (nk + 63) >> 6;
        const int qa = 2 * wave, qb = qa + 1;
        unsigned ka[32], kb[32];
#pragma unroll
        for (int j = 0; j < 32; ++j) {
            const int s = lane + 64 * j;
            ka[j] = (s < nk) ? keyL[qa * KS_ + s] : 0u;
            kb[j] = (s < nk) ? keyL[qb * KS_ + s] : 0u;
        }
        unsigned Ta = 1u, Tb = 1u; int Ca = 2047, Cb = 2047;
        if (t0 >= 256) {
            int na, nb;
            bool da, db;
            {
                int c0 = 0, c1 = 0, c2 = 0, c3 = 0;
#pragma unroll
                for (int j = 0; j < 32; ++j)
                    if (j < jmax) { c0 += (ka[j] >= 0x80000000u); c1 += (ka[j] > 0x80000000u); c2 += (kb[j] >= 0x80000000u); c3 += (kb[j] > 0x80000000u); }
                c0 = wave_total_i(c0); c1 = wave_total_i(c1); c2 = wave_total_i(c2); c3 = wave_total_i(c3);
                da = (c1 < 256 && c0 >= 256); db = (c3 < 256 && c2 >= 256);
                Ta = da ? 0x80000000u : ((c0 >= 256) ? 0x80000000u : 0u); na = da ? c0 : ((c0 >= 256) ? c0 : 0x7fffffff);
                Tb = db ? 0x80000000u : ((c2 >= 256) ? 0x80000000u : 0u); nb = db ? c2 : ((c2 >= 256) ? c2 : 0x7fffffff);
            }
            for (int bit = 30; bit >= 0; --bit) {
                if (da && db) break;
                const unsigned ca_ = Ta | (1u << bit), cb_ = Tb | (1u << bit);
                int c0 = 0, c1 = 0;
#pragma unroll
                for (int j = 0; j < 32; ++j)
                    if (j < jmax) { c0 += (ka[j] >= ca_); c1 += (kb[j] >= cb_); }
                c0 = wave_total_i(c0); c1 = wave_total_i(c1);
                if (!da && c0 >= 256) { Ta = ca_; na = c0; }
                if (!db && c1 >= 256) { Tb = cb_; nb = c1; }
                da = da || (na == 256); db = db || (nb == 256);
            }
            if (na != 256 || nb != 256) {
                int needa, needb;
                {
                    int c0 = 0, c1 = 0;
#pragma unroll
                    for (int j = 0; j < 32; ++j)
                        if (j < jmax) { c0 += (ka[j] > Ta); c1 += (kb[j] > Tb); }
                    needa = 256 - wave_total_i(c0); needb = 256 - wave_total_i(c1);
                }
                Ca = 0; Cb = 0;
                for (int bit = 10; bit >= 0; --bit) {
                    const int ca_ = Ca | (1 << bit), cb_ = Cb | (1 << bit);
                    int c0 = 0, c1 = 0;
#pragma unroll
                    for (int j = 0; j < 32; ++j)
                        if (j < jmax) { const int s = lane + 64 * j; c0 += (ka[j] == Ta && s < ca_); c1 += (kb[j] == Tb && s < cb_); }
                    c0 = wave_total_i(c0); c1 = wave_total_i(c1);
                    if (c0 < needa) Ca = ca_;
                    if (c1 < needb) Cb = cb_;
                }
            }
        }
        const size_t rowa = (size_t)b * 2048 + t0 + qa;
#pragma unroll
        for (int j = 0; j < 32; ++j) {
            const int s = lane + 64 * j;
            const unsigned long long ma = __ballot((ka[j] > Ta) || (ka[j] == Ta && s <= Ca));
            const unsigned long long mb = __ballot((kb[j] > Tb) || (kb[j] == Tb && s <= Cb));
            if (lane == 0) {
                __hip_atomic_store(&BM64[rowa * 32 + j], ma, __ATOMIC_RELAXED, __HIP_MEMORY_SCOPE_AGENT);
                __hip_atomic_store(&BM64[(rowa + 1) * 32 + j], mb, __ATOMIC_RELAXED, __HIP_MEMORY_SCOPE_AGENT);
            }
        }
    }
    __syncthreads();
}

__device__ void dsa_attn_item(const Params& p, int b, int h, int qg, char* smem_) {
    constexpr int KSTR = 136, VSTR = 72;
    bf16_t* Kl = (bf16_t*)smem_;
    bf16_t* Vl = Kl + 2 * 64 * KSTR;
    const int tid = TIDX(), lane = tid & 63, wave = __builtin_amdgcn_readfirstlane(tid >> 6), fr = lane & 15, fq = lane >> 4;
    const bf16_t* Z = (const bf16_t*)(p.ws + WS_Z); const bf16_t* VT = (const bf16_t*)(p.ws + WS_VT);
    const unsigned* BM = (const unsigned*)(p.ws + WS_BM); bf16_t* Y = (bf16_t*)(p.ws + WS_Y);
    const int kr = tid >> 4, kc = tid & 15, vd = tid >> 2, vc = tid & 3;
    const int ka_row = 8 * (fr >> 2) + (fr & 3);
    {
        const int t0 = qg * 128 + wave * 16;
        const size_t trow = (size_t)b * 2048 + t0 + fr;
        bf16x8 qf[4];
#pragma unroll
        for (int ks = 0; ks < 4; ++ks) qf[ks] = *(const bf16x8*)(Z + trow * LDZ + ZB_Q + h * 128 + ks * 32 + fq * 8);
        f32x4 o[8];
#pragma unroll
        for (int i = 0; i < 8; ++i) o[i] = f32x4{0.f, 0.f, 0.f, 0.f};
        float m = -INFINITY, lsum = 0.f;
        const unsigned long long* bmrow = (const unsigned long long*)(BM + trow * 64);
        const int nsteps_blk = qg * 2 + 2, nsteps_w = (t0 + 15) / 64 + 1;
        const bf16_t* kg = Z + ((size_t)b * 2048 + kr) * LDZ + ZB_K + h * 128 + kc * 8;
        const bf16_t* vg = VT + ((size_t)(b * 4 + h) * 128 + vd) * 2048 + vc * 8;
        u32x4 rk0 = *(const u32x4*)kg, rk1 = *(const u32x4*)(kg + (size_t)32 * LDZ), rv0 = *(const u32x4*)vg, rv1 = *(const u32x4*)(vg + 32);
        *(u32x4*)(Kl + kr * KSTR + kc * 8) = rk0; *(u32x4*)(Kl + (kr + 32) * KSTR + kc * 8) = rk1;
        *(u32x4*)(Vl + vd * VSTR + vc * 8) = rv0; *(u32x4*)(Vl + vd * VSTR + 32 + vc * 8) = rv1;
        __syncthreads();
        unsigned long long mwn = bmrow[0];
        for (int st = 0; st < nsteps_blk; ++st) {
            const bool more = (st + 1 < nsteps_blk);
            const unsigned long long mwc = mwn;
            mwn = bmrow[(st + 1 < nsteps_w) ? st + 1 : st];
            if (more) {
                const bf16_t* kn = kg + (size_t)(st + 1) * 64 * LDZ; const bf16_t* vn = vg + (st + 1) * 64;
                rk0 = *(const u32x4*)kn; rk1 = *(const u32x4*)(kn + (size_t)32 * LDZ); rv0 = *(const u32x4*)vn; rv1 = *(const u32x4*)(vn + 32);
            }
            if (st < nsteps_w) {
                const bf16_t* Kb = Kl + (st & 1) * 64 * KSTR; const bf16_t* Vb = Vl + (st & 1) * 128 * VSTR;
                f32x4 sc[2][2];
#pragma unroll
                for (int sub = 0; sub < 2; ++sub) {
                    sc[sub][0] = f32x4{0.f, 0.f, 0.f, 0.f}; sc[sub][1] = f32x4{0.f, 0.f, 0.f, 0.f};
#pragma unroll
                    for (int ks = 0; ks < 4; ++ks) {
                        const bf16x8 fa = *(const bf16x8*)(Kb + (sub * 32 + ka_row) * KSTR + ks * 32 + fq * 8), fb = *(const bf16x8*)(Kb + (sub * 32 + ka_row + 4) * KSTR + ks * 32 + fq * 8);
                        sc[sub][0] = __builtin_amdgcn_mfma_f32_16x16x32_bf16(fa, qf[ks], sc[sub][0], 0, 0, 0);
                        sc[sub][1] = __builtin_amdgcn_mfma_f32_16x16x32_bf16(fb, qf[ks], sc[sub][1], 0, 0, 0);
                    }
                }
                float x[16];
#pragma unroll
                for (int sub = 0; sub < 2; ++sub) {
                    const unsigned mw = (unsigned)(mwc >> (32 * sub)) >> (8 * fq);
#pragma unroll
                    for (int r = 0; r < 4; ++r) { x[sub * 8 + r] = ((mw >> r) & 1u) ? sc[sub][0][r] : -INFINITY; x[sub * 8 + 4 + r] = ((mw >> (4 + r)) & 1u) ? sc[sub][1][r] : -INFINITY; }
                }
                float mx = x[0];
#pragma unroll
                for (int j = 1; j < 16; ++j) mx = fmaxf(mx, x[j]);
                mx = fmaxf(mx, shx<16>(mx)); mx = fmaxf(mx, shx<32>(mx));
                const float mnew = fmaxf(m, mx);
                const float msafe = (mnew == -INFINITY) ? 0.f : mnew;
                const float alpha = fexp(m - msafe);
                float pe[16]; float ps = 0.f;
#pragma unroll
                for (int j = 0; j < 16; ++j) { pe[j] = fexp(x[j] - msafe); ps += pe[j]; }
                lsum = lsum * alpha + ps;
                m = mnew;
#pragma unroll
                for (int i = 0; i < 8; ++i) { o[i][0] *= alpha; o[i][1] *= alpha; o[i][2] *= alpha; o[i][3] *= alpha; }
                union { bf16x8 v; unsigned u[4]; } pf[2];
#pragma unroll
                for (int sub = 0; sub < 2; ++sub) {
                    pf[sub].u[0] = pack2(pe[sub * 8 + 0], pe[sub * 8 + 1]); pf[sub].u[1] = pack2(pe[sub * 8 + 2], pe[sub * 8 + 3]);
                    pf[sub].u[2] = pack2(pe[sub * 8 + 4], pe[sub * 8 + 5]); pf[sub].u[3] = pack2(pe[sub * 8 + 6], pe[sub * 8 + 7]);
                }
#pragma unroll
                for (int i = 0; i < 8; ++i) {
                    const bf16x8 vf0 = *(const bf16x8*)(Vb + (i * 16 + fr) * VSTR + fq * 8), vf1 = *(const bf16x8*)(Vb + (i * 16 + fr) * VSTR + 32 + fq * 8);
                    o[i] = __builtin_amdgcn_mfma_f32_16x16x32_bf16(vf0, pf[0].v, o[i], 0, 0, 0);
                    o[i] = __builtin_amdgcn_mfma_f32_16x16x32_bf16(vf1, pf[1].v, o[i], 0, 0, 0);
                }
            }
            if (more) {
                bf16_t* Kn = Kl + ((st + 1) & 1) * 64 * KSTR; bf16_t* Vn = Vl + ((st + 1) & 1) * 128 * VSTR;
                *(u32x4*)(Kn + kr * KSTR + kc * 8) = rk0; *(u32x4*)(Kn + (kr + 32) * KSTR + kc * 8) = rk1;
                *(u32x4*)(Vn + vd * VSTR + vc * 8) = rv0; *(u32x4*)(Vn + vd * VSTR + 32 + vc * 8) = rv1;
            }
            __syncthreads();
        }
        lsum += shx<16>(lsum); lsum += shx<32>(lsum);
        const float inv = 1.f / lsum;
#pragma unroll
        for (int i = 0; i < 8; ++i) {
            uint2 ov; ov.x = pack2(o[i][0] * inv, o[i][1] * inv); ov.y = pack2(o[i][2] * inv, o[i][3] * inv);
            *(uint2*)(Y + trow * 1536 + 512 + h * 128 + i * 16 + 4 * fq) = ov;
        }
    }
}

constexpr int LDS_BYTES = 155648;
__device__ void ph_mixA(const Params& p, int l, int vb0, int nvb, char* smem_) {
    for (int item = vb0; item < 64; item += nvb) {
        if (item < 32) scan2_item<128, false>(p, l, item >> 2, item & 3, smem_);
        else scan2_item<64, true>(p, l, (item - 32) >> 2, (item - 32) & 3, smem_);
    }
    unsigned* ctr = (unsigned*)(p.ws + WS_CTL) + 3584 + l * 64;
    unsigned* done = (unsigned*)(p.ws + WS_CTL) + 5300 + l * 8 * 16;
    volatile int* slot = (volatile int*)(smem_ + LDS_BYTES - 64);
    for (;;) {
        if (TIDX() == 0) *slot = (int)atomicAdd(ctr, 1u);
        __syncthreads();
        const int idx = __builtin_amdgcn_readfirstlane(*slot);
        __syncthreads();
        if (idx >= 2048) break;
        if (idx < 1536) {
            const int b = idx / 192, r = idx % 192;
            if (r < 128) dsa_select_tile(p, b, 127 - r, smem_);
            else dsaprep2_item(p, l, b * 64 + (r - 128), smem_);
            asm volatile("s_waitcnt vmcnt(0)" ::: "memory");
            __syncthreads();
            if (TIDX() == 0) __hip_atomic_fetch_add(done + b * 16, 1u, __ATOMIC_RELAXED, __HIP_MEMORY_SCOPE_AGENT);
        } else {
            const int a = idx - 1536, b = a >> 6, h = (a >> 4) & 3, qg = 15 - (a & 15);
            if (TIDX() == 0) {
                unsigned spins = 0;
                while (__hip_atomic_load(done + b * 16, __ATOMIC_RELAXED, __HIP_MEMORY_SCOPE_AGENT) < 192u) { __builtin_amdgcn_s_sleep(2); if (++spins > (1u << 18)) break; }
                __builtin_amdgcn_fence(__ATOMIC_ACQUIRE, "agent");
                asm volatile("s_waitcnt vmcnt(0)" ::: "memory");
            }
            __syncthreads();
            dsa_attn_item(p, b, h, qg, smem_);
        }
    }
}

__device__ __forceinline__ int f2sort(float f) { int i = __float_as_int(f); return i ^ ((i >> 31) & 0x7fffffff); }
__device__ __forceinline__ float sort2f(int i) { return __int_as_float(i ^ ((i >> 31) & 0x7fffffff)); }
#define INSK(K, xv) do { int _x = (xv); \
    _Pragma("unroll") for (int _j = 0; _j < 16; ++_j) { int _hi = max(K[_j], _x); _x = min(K[_j], _x); K[_j] = _hi; } } while (0)
#define INS64(K, xv) do { unsigned long long _x = (xv); \
    _Pragma("unroll") for (int _j = 0; _j < 16; ++_j) { bool _c = _x > K[_j]; unsigned long long _o = K[_j]; K[_j] = _c ? _x : _o; _x = _c ? _o : _x; } } while (0)

#define CE32(x, y) do { const int _h = max(x, y); y = min(x, y); x = _h; } while (0)
#define CE64(x, y) do { const bool _c = (y) > (x); const unsigned long long _t = x; x = _c ? y : x; y = _c ? _t : y; } while (0)
#define SORT16_I(K) do { CE32(K[0], K[1]); CE32(K[2], K[3]); CE32(K[4], K[5]); CE32(K[6], K[7]); CE32(K[8], K[9]); CE32(K[10], K[11]); CE32(K[12], K[13]); CE32(K[14], K[15]); CE32(K[0], K[2]); CE32(K[1], K[3]); CE32(K[4], K[6]); CE32(K[5], K[7]); CE32(K[8], K[10]); CE32(K[9], K[11]); CE32(K[12], K[14]); CE32(K[13], K[15]); CE32(K[1], K[2]); CE32(K[5], K[6]); CE32(K[9], K[10]); CE32(K[13], K[14]); CE32(K[0], K[4]); CE32(K[1], K[5]); CE32(K[2], K[6]); CE32(K[3], K[7]); CE32(K[8], K[12]); CE32(K[9], K[13]); CE32(K[10], K[14]); CE32(K[11], K[15]); CE32(K[2], K[4]); CE32(K[3], K[5]); CE32(K[10], K[12]); CE32(K[11], K[13]); CE32(K[1], K[2]); CE32(K[3], K[4]); CE32(K[5], K[6]); CE32(K[9], K[10]); CE32(K[11], K[12]); CE32(K[13], K[14]); CE32(K[0], K[8]); CE32(K[1], K[9]); CE32(K[2], K[10]); CE32(K[3], K[11]); CE32(K[4], K[12]); CE32(K[5], K[13]); CE32(K[6], K[14]); CE32(K[7], K[15]); CE32(K[4], K[8]); CE32(K[5], K[9]); CE32(K[6], K[10]); CE32(K[7], K[11]); CE32(K[2], K[4]); CE32(K[3], K[5]); CE32(K[6], K[8]); CE32(K[7], K[9]); CE32(K[10], K[12]); CE32(K[11], K[13]); CE32(K[1], K[2]); CE32(K[3], K[4]); CE32(K[5], K[6]); CE32(K[7], K[8]); CE32(K[9], K[10]); CE32(K[11], K[12]); CE32(K[13], K[14]); } while (0)
#define BITONIC16_I(K) do { CE32(K[0], K[8]); CE32(K[1], K[9]); CE32(K[2], K[10]); CE32(K[3], K[11]); CE32(K[4], K[12]); CE32(K[5], K[13]); CE32(K[6], K[14]); CE32(K[7], K[15]); CE32(K[0], K[4]); CE32(K[1], K[5]); CE32(K[2], K[6]); CE32(K[3], K[7]); CE32(K[8], K[12]); CE32(K[9], K[13]); CE32(K[10], K[14]); CE32(K[11], K[15]); CE32(K[0], K[2]); CE32(K[1], K[3]); CE32(K[4], K[6]); CE32(K[5], K[7]); CE32(K[8], K[10]); CE32(K[9], K[11]); CE32(K[12], K[14]); CE32(K[13], K[15]); CE32(K[0], K[1]); CE32(K[2], K[3]); CE32(K[4], K[5]); CE32(K[6], K[7]); CE32(K[8], K[9]); CE32(K[10], K[11]); CE32(K[12], K[13]); CE32(K[14], K[15]); } while (0)
#define SORT16_L(K) do { CE64(K[0], K[1]); CE64(K[2], K[3]); CE64(K[4], K[5]); CE64(K[6], K[7]); CE64(K[8], K[9]); CE64(K[10], K[11]); CE64(K[12], K[13]); CE64(K[14], K[15]); CE64(K[0], K[2]); CE64(K[1], K[3]); CE64(K[4], K[6]); CE64(K[5], K[7]); CE64(K[8], K[10]); CE64(K[9], K[11]); CE64(K[12], K[14]); CE64(K[13], K[15]); CE64(K[1], K[2]); CE64(K[5], K[6]); CE64(K[9], K[10]); CE64(K[13], K[14]); CE64(K[0], K[4]); CE64(K[1], K[5]); CE64(K[2], K[6]); CE64(K[3], K[7]); CE64(K[8], K[12]); CE64(K[9], K[13]); CE64(K[10], K[14]); CE64(K[11], K[15]); CE64(K[2], K[4]); CE64(K[3], K[5]); CE64(K[10], K[12]); CE64(K[11], K[13]); CE64(K[1], K[2]); CE64(K[3], K[4]); CE64(K[5], K[6]); CE64(K[9], K[10]); CE64(K[11], K[12]); CE64(K[13], K[14]); CE64(K[0], K[8]); CE64(K[1], K[9]); CE64(K[2], K[10]); CE64(K[3], K[11]); CE64(K[4], K[12]); CE64(K[5], K[13]); CE64(K[6], K[14]); CE64(K[7], K[15]); CE64(K[4], K[8]); CE64(K[5], K[9]); CE64(K[6], K[10]); CE64(K[7], K[11]); CE64(K[2], K[4]); CE64(K[3], K[5]); CE64(K[6], K[8]); CE64(K[7], K[9]); CE64(K[10], K[12]); CE64(K[11], K[13]); CE64(K[1], K[2]); CE64(K[3], K[4]); CE64(K[5], K[6]); CE64(K[7], K[8]); CE64(K[9], K[10]); CE64(K[11], K[12]); CE64(K[13], K[14]); } while (0)
#define BITONIC16_L(K) do { CE64(K[0], K[8]); CE64(K[1], K[9]); CE64(K[2], K[10]); CE64(K[3], K[11]); CE64(K[4], K[12]); CE64(K[5], K[13]); CE64(K[6], K[14]); CE64(K[7], K[15]); CE64(K[0], K[4]); CE64(K[1], K[5]); CE64(K[2], K[6]); CE64(K[3], K[7]); CE64(K[8], K[12]); CE64(K[9], K[13]); CE64(K[10], K[14]); CE64(K[11], K[15]); CE64(K[0], K[2]); CE64(K[1], K[3]); CE64(K[4], K[6]); CE64(K[5], K[7]); CE64(K[8], K[10]); CE64(K[9], K[11]); CE64(K[12], K[14]); CE64(K[13], K[15]); CE64(K[0], K[1]); CE64(K[2], K[3]); CE64(K[4], K[5]); CE64(K[6], K[7]); CE64(K[8], K[9]); CE64(K[10], K[11]); CE64(K[12], K[13]); CE64(K[14], K[15]); } while (0)
#define TOP16_I(R, G) do { _Pragma("unroll") for (int _j = 0; _j < 16; ++_j) R[_j] = max(R[_j], G[15 - _j]); BITONIC16_I(R); } while (0)
#define TOP16_L(R, G) do { _Pragma("unroll") for (int _j = 0; _j < 16; ++_j) R[_j] = (G[15 - _j] > R[_j]) ? G[15 - _j] : R[_j]; BITONIC16_L(R); } while (0)
__device__ __forceinline__ void route_wave(const Params& p, int tw0, int h, _Float16* tile  , const int lane) {
    typedef _Float16 h8 __attribute__((ext_vector_type(8)));
    const _Float16* SC = (const _Float16*)(p.ws + WS_SC);
    int* RI = (int*)(p.ws + WS_RI); float* RG = (float*)(p.ws + WS_RG);
    {
        const int t = tw0 + lane;
        const _Float16* s0 = SC + (size_t)t * 2048 + h * 256;
        const _Float16* wbase = SC + (size_t)tw0 * 2048 + h * 256;
        int k0[16], k1[16];
#pragma unroll
        for (int j = 0; j < 16; ++j) { k0[j] = (int)0x80000000; k1[j] = (int)0x80000000; }
#pragma unroll 1
        for (int slab = 0; slab < 4; ++slab) {
            h8 ld[8];
#pragma unroll
            for (int j = 0; j < 4; ++j) {
                const _Float16* src = wbase + (size_t)(16 * j + (lane >> 2)) * 2048 + slab * 32 + (lane & 3) * 8;
                ld[j] = *(const h8*)src; ld[4 + j] = *(const h8*)(src + 128);
            }
            __builtin_amdgcn_wave_barrier();
#pragma unroll
            for (int j = 0; j < 4; ++j) {
                _Float16* dst = tile + (16 * j + (lane >> 2)) * 72 + (lane & 3) * 8;
                *(h8*)dst = ld[j]; *(h8*)(dst + 32) = ld[4 + j];
            }
            __builtin_amdgcn_fence(__ATOMIC_RELEASE, "wavefront");
            __builtin_amdgcn_wave_barrier();
            __builtin_amdgcn_fence(__ATOMIC_ACQUIRE, "wavefront");
#pragma unroll
            for (int ii = 0; ii < 32; ii += 16) {
                const int i = slab * 32 + ii;
                const h8 a0 = *(const h8*)(tile + lane * 72 + ii), a1 = *(const h8*)(tile + lane * 72 + ii + 8);
                const h8 b0 = *(const h8*)(tile + lane * 72 + 32 + ii), b1 = *(const h8*)(tile + lane * 72 + 32 + ii + 8);
                int ga[16], gb[16];
#pragma unroll
                for (int e_ = 0; e_ < 8; ++e_) {
                    ga[e_] = (f2sort((float)a0[e_]) & ~127) | (127 - i - e_); ga[8 + e_] = (f2sort((float)a1[e_]) & ~127) | (127 - i - 8 - e_);
                    gb[e_] = (f2sort((float)b0[e_]) & ~127) | (127 - i - e_); gb[8 + e_] = (f2sort((float)b1[e_]) & ~127) | (127 - i - 8 - e_);
                }
                SORT16_I(ga); TOP16_I(k0, ga);
                SORT16_I(gb); TOP16_I(k1, gb);
            }
            __builtin_amdgcn_wave_barrier();
        }
        float v0[16], v1[16];
#pragma unroll
        for (int j = 0; j < 16; ++j) { k0[j] = 127 - (k0[j] & 127); k1[j] = 127 - (k1[j] & 127); v0[j] = (float)s0[k0[j]]; v1[j] = (float)s0[128 + k1[j]]; }
#define CAND(a, b) ((((unsigned long long)((unsigned)f2sort(v0[a] + v1[b]) ^ 0x80000000u)) << 32) | (((unsigned)(255 - ((a) * 16 + (b))) << 16) | (unsigned)(k0[a] * 128 + k1[b])))
        unsigned long long ck[16], m1[16], m2[16];
#pragma unroll
        for (int j = 0; j < 16; ++j) ck[j] = CAND(0, j);
#pragma unroll
        for (int j = 0; j < 8; ++j) { m1[j] = CAND(1, j); m1[8 + j] = CAND(15 - j, 0); }
        BITONIC16_L(m1);
        m2[0] = CAND(2, 0); m2[1] = CAND(2, 1); m2[2] = CAND(2, 2); m2[3] = CAND(2, 3); m2[4] = CAND(2, 4);
        m2[5] = CAND(3, 0); m2[6] = CAND(3, 1); m2[7] = CAND(3, 2); m2[8] = CAND(3, 3);
        m2[9] = CAND(4, 0); m2[10] = CAND(4, 1); m2[11] = CAND(4, 2);
        m2[12] = CAND(5, 0); m2[13] = CAND(5, 1); m2[14] = CAND(6, 0); m2[15] = CAND(6, 1);
        SORT16_L(m2);
        TOP16_L(ck, m1);
        TOP16_L(ck, m2);
        INS64(ck, CAND(7, 0)); INS64(ck, CAND(7, 1));
#undef CAND
        float e[16]; float sm = 0.f;
        const float mx = sort2f((int)((unsigned)(ck[0] >> 32) ^ 0x80000000u));
#pragma unroll
        for (int j = 0; j < 16; ++j) { e[j] = expf(sort2f((int)((unsigned)(ck[j] >> 32) ^ 0x80000000u)) - mx); sm += e[j]; }
        const float inv = 1.f / sm;
#pragma unroll
        for (int j = 0; j < 16; j += 4) {
            *(int4*)(RI + (size_t)t * 128 + h * 16 + j) = make_int4((int)(ck[j] & 0xffffu), (int)(ck[j + 1] & 0xffffu), (int)(ck[j + 2] & 0xffffu), (int)(ck[j + 3] & 0xffffu));
            *(float4*)(RG + (size_t)t * 128 + h * 16 + j) = make_float4(e[j] * inv, e[j + 1] * inv, e[j + 2] * inv, e[j + 3] * inv);
        }
    }
}

__device__ __forceinline__ void fp8x16_to_f32(const uint4 q, float (&f)[16]) {
    const unsigned w[4] = {q.x, q.y, q.z, q.w};
#pragma unroll
    for (int c = 0; c < 4; ++c) {
        auto f0 = __builtin_amdgcn_cvt_pk_f32_fp8((int)w[c], false); auto f1 = __builtin_amdgcn_cvt_pk_f32_fp8((int)w[c], true);
        f[4 * c] = f0[0]; f[4 * c + 1] = f0[1]; f[4 * c + 2] = f1[0]; f[4 * c + 3] = f1[1];
    }
}
constexpr bool G2_MFMA = true;
constexpr bool G1_MFMA = true;
typedef float f32x2_t __attribute__((ext_vector_type(2)));
__device__ __forceinline__ float g1_half(const u32x4 (&uq)[8], const float (&hv)[16], int lane) {
    float part[8];
#pragma unroll
    for (int it = 0; it < 8; ++it) {
        f32x2_t d2 = {0.f, 0.f};
#pragma unroll
        for (int c_ = 0; c_ < 4; ++c_) {
            const f32x2_t f0 = __builtin_amdgcn_cvt_pk_f32_fp8((int)uq[it][c_], false), f1 = __builtin_amdgcn_cvt_pk_f32_fp8((int)uq[it][c_], true);
            d2 = __builtin_elementwise_fma(f32x2_t{hv[4 * c_], hv[4 * c_ + 1]}, f0, d2);
            d2 = __builtin_elementwise_fma(f32x2_t{hv[4 * c_ + 2], hv[4 * c_ + 3]}, f1, d2);
        }
        part[it] = d2[0] + d2[1];
    }
    float r4[4], r2[2];
    const bool b2_ = lane & 4, b1_ = lane & 2, b0_ = lane & 1;
#pragma unroll
    for (int j = 0; j < 4; ++j) { const float snd = b2_ ? part[j] : part[j + 4], kp = b2_ ? part[j + 4] : part[j]; r4[j] = kp + shx<4>(snd); }
#pragma unroll
    for (int j = 0; j < 2; ++j) { const float snd = b1_ ? r4[j] : r4[j + 2], kp = b1_ ? r4[j + 2] : r4[j]; r2[j] = kp + shx<2>(snd); }
    const float snd = b0_ ? r2[0] : r2[1], kp = b0_ ? r2[1] : r2[0];
    return kp + shx<1>(snd);
}
__device__ __forceinline__ void peer_gather8(u32x4 (&q)[8], const unsigned char* tab, const int* idx, unsigned l16) {
#pragma unroll
    for (int it = 0; it < 8; ++it) { const unsigned e_ = (unsigned)idx[it * 8]; q[it] = *(const u32x4*)(tab + ((e_ << 7) | l16)); }
}
template <bool PRE>
__device__ __forceinline__ void g1_step(int i, int t, const bf16_t* hrow_next, const unsigned char* ub, const int* lri_eg, unsigned l16, int lane, float* pp_row,
                                        u32x4& hq0, u32x4& hq1, u32x4 (&uqA)[8], u32x4 (&uqB)[8]) {
    float hv[16];
#pragma unroll
    for (int c_ = 0; c_ < 4; ++c_) { hv[2 * c_] = bflo(hq0[c_]); hv[2 * c_ + 1] = bfhi(hq0[c_]); hv[8 + 2 * c_] = bflo(hq1[c_]); hv[8 + 2 * c_ + 1] = bfhi(hq1[c_]); }
    if (PRE) { const u32x4* hp = (const u32x4*)hrow_next; hq0 = hp[0]; hq1 = hp[1]; }
    const float d0 = g1_half(uqA, hv, lane);
    __builtin_amdgcn_sched_barrier(0);
    if (PRE) { peer_gather8(uqA, ub, lri_eg + (i + 1) * 128, l16); __builtin_amdgcn_sched_barrier(0); }
    const float d1 = g1_half(uqB, hv, lane);
    __builtin_amdgcn_sched_barrier(0);
    if (PRE) { peer_gather8(uqB, ub, lri_eg + (i + 1) * 128 + 64, l16); __builtin_amdgcn_sched_barrier(0); }
    pp_row[0] = d0; pp_row[64] = d1;
}
template <bool PRE>
__device__ __forceinline__ void g2_step(int i, float2* op, const float2 gf, const unsigned char* vb_, const int* lri_eg, const float* lrg_eg, unsigned l16, int lane,
                                        u32x4 (&vqA)[8], u32x4 (&vqB)[8]) {
    const float2 xi = *op;
    f32x2_t y[8];
#pragma unroll
    for (int j = 0; j < 8; ++j) y[j] = f32x2_t{0.f, 0.f};
#pragma unroll
    for (int it = 0; it < 8; ++it) {
        const float ck = lrg_eg[i * 128 + it * 8]; const f32x2_t ck2 = {ck, ck};
#pragma unroll
        for (int c_ = 0; c_ < 4; ++c_) {
            y[2 * c_] = __builtin_elementwise_fma(ck2, __builtin_amdgcn_cvt_pk_f32_fp8((int)vqA[it][c_], false), y[2 * c_]);
            y[2 * c_ + 1] = __builtin_elementwise_fma(ck2, __builtin_amdgcn_cvt_pk_f32_fp8((int)vqA[it][c_], true), y[2 * c_ + 1]);
        }
    }
    __builtin_amdgcn_sched_barrier(0);
    if (PRE) { peer_gather8(vqA, vb_, lri_eg + (i + 1) * 128, l16); __builtin_amdgcn_sched_barrier(0); }
#pragma unroll
    for (int it = 0; it < 8; ++it) {
        const float ck = lrg_eg[i * 128 + 64 + it * 8]; const f32x2_t ck2 = {ck, ck};
#pragma unroll
        for (int c_ = 0; c_ < 4; ++c_) {
            y[2 * c_] = __builtin_elementwise_fma(ck2, __builtin_amdgcn_cvt_pk_f32_fp8((int)vqB[it][c_], false), y[2 * c_]);
            y[2 * c_ + 1] = __builtin_elementwise_fma(ck2, __builtin_amdgcn_cvt_pk_f32_fp8((int)vqB[it][c_], true), y[2 * c_ + 1]);
        }
    }
    __builtin_amdgcn_sched_barrier(0);
    if (PRE) { peer_gather8(vqB, vb_, lri_eg + (i + 1) * 128 + 64, l16); __builtin_amdgcn_sched_barrier(0); }
    float r8[8], r4[4], r2[2];
    const bool b5 = lane & 32, b4 = lane & 16, b3 = lane & 8;
#pragma unroll
    for (int j = 0; j < 8; ++j) { const float lo = y[j >> 1][j & 1], hi = y[4 + (j >> 1)][j & 1]; const float snd = b5 ? lo : hi, kp = b5 ? hi : lo; r8[j] = kp + shx<32>(snd); }
#pragma unroll
    for (int j = 0; j < 4; ++j) { const float snd = b4 ? r8[j] : r8[j + 4], kp = b4 ? r8[j + 4] : r8[j]; r4[j] = kp + shx<16>(snd); }
#pragma unroll
    for (int j = 0; j < 2; ++j) { const float snd = b3 ? r4[j] : r4[j + 2], kp = b3 ? r4[j + 2] : r4[j]; r2[j] = kp + shx<8>(snd); }
    *op = make_float2(xi.x + gf.x * r2[0], xi.y + gf.y * r2[1]);
}
typedef int i32x4_t __attribute__((ext_vector_type(4)));
typedef int i32x8_t __attribute__((ext_vector_type(8)));
constexpr int G1W = 18432;
__device__ __forceinline__ void g1m_dma(const unsigned char* ub, PG8_LAS unsigned char* img, const PG8_LAS unsigned short* idx, int i, int hh, int eg, unsigned q16) {
    const u32x4 w = *(const PG8_LAS u32x4*)(idx + ((i * 8 + eg) * 16 + hh * 8));
#pragma unroll
    for (int it = 0; it < 8; ++it) {
        const unsigned e_ = (it & 1) ? (w[it >> 1] >> 16) : (w[it >> 1] & 0xffffu);
        const unsigned off = (e_ << 7) | ((it & 1) ? (q16 ^ 64u) : q16);
        __builtin_amdgcn_global_load_lds((const unsigned*)(ub + off), (PG8_LAS unsigned*)(img + it * 1024), 16, 0, 0);
    }
}
template <bool PRE, int VMW>
__device__ __forceinline__ float g1m_step(const unsigned char* ub, PG8_LAS unsigned char* img, const PG8_LAS unsigned short* idx, int inext, int hh, int eg, unsigned q16,
                                          unsigned rdoff, int lane, const u32x4 a0, const u32x4 a1) {
    asm volatile("s_waitcnt vmcnt(%0)" :: "n"(VMW) : "memory");
    i32x8_t b[4];
#pragma unroll
    for (int mb = 0; mb < 4; ++mb) {
        const unsigned ro = (unsigned)mb * 2048u + rdoff;
        const i32x4_t lo = *(const PG8_LAS i32x4_t*)(img + ro), hi = *(const PG8_LAS i32x4_t*)(img + (ro ^ 64u));
        b[mb] = __builtin_shufflevector(lo, hi, 0, 1, 2, 3, 4, 5, 6, 7);
    }
    asm volatile("s_waitcnt lgkmcnt(0)" ::: "memory");
    if (PRE) g1m_dma(ub, img, idx, inext, hh, eg, q16);
    const i32x8_t a = __builtin_shufflevector((i32x4_t)a0, (i32x4_t)a1, 0, 1, 2, 3, 4, 5, 6, 7);
    float d[4]; f32x4 acc[4];
#pragma unroll
    for (int mb = 0; mb < 4; ++mb) acc[mb] = __builtin_amdgcn_mfma_scale_f32_16x16x128_f8f6f4(a, b[mb], f32x4{0.f, 0.f, 0.f, 0.f}, 0, 0, 0, 0x7f, 0, 0x7f);
#pragma unroll
    for (int mb = 0; mb < 4; ++mb) { d[mb] = acc[mb][0] + acc[mb][1] * (1.f / 16.f); asm volatile("" : "+v"(d[mb])); }
    const int g = lane >> 4;
    return g == 0 ? d[0] : g == 1 ? d[1] : g == 2 ? d[2] : d[3];
}
__device__ __forceinline__ void g1m_chunk(const Params& p, int x, int tb, char* smem_, int lane) {
    PG8_LAS unsigned char* wl = (PG8_LAS unsigned char*)smem_ + p.wv * G1W;
    PG8_LAS unsigned short* idx = (PG8_LAS unsigned short*)(wl + 16384);
    const int* RI = (const int*)(p.ws + WS_RI);
    {
        int ra[16];
#pragma unroll
        for (int i = 0; i < 8; ++i) { ra[2 * i] = RI[(size_t)(tb + i) * 128 + lane]; ra[2 * i + 1] = RI[(size_t)(tb + i) * 128 + 64 + lane]; }
#pragma unroll
        for (int i = 0; i < 8; ++i) {
            idx[(i * 8 + (lane & 7)) * 16 + (lane >> 3)] = (unsigned short)ra[2 * i];
            idx[(i * 8 + (lane & 7)) * 16 + 8 + (lane >> 3)] = (unsigned short)ra[2 * i + 1];
        }
    }
    __builtin_amdgcn_fence(__ATOMIC_RELEASE, "wavefront");
    __builtin_amdgcn_wave_barrier();
    __builtin_amdgcn_fence(__ATOMIC_ACQUIRE, "wavefront");
    const int eg = lane >> 3, n = lane & 15, kb = lane >> 4;
    const unsigned q16 = (unsigned)(((lane & 7) ^ (eg >> 1)) * 16);
    const unsigned rdoff = (unsigned)(n * 128 + ((kb ^ (n >> 1)) * 16));
    const unsigned char* ub = p.ws + WS_PU + (size_t)x * (16384u * 128u);
    const unsigned char* h8 = p.ws + ((lane & 1) ? WS_H8L : WS_H8H) + (size_t)tb * 1024 + x * 128 + kb * 16;
    float* pp = (float*)(p.ws + WS_PP) + ((size_t)x * T_TOK + tb) * 128 + lane;
    u32x4 ha[8][2];
#pragma unroll
    for (int i = 0; i < 8; ++i) { ha[i][0] = *(const u32x4*)(h8 + (size_t)i * 1024); ha[i][1] = *(const u32x4*)(h8 + (size_t)i * 1024 + 64); }
#pragma unroll
    for (int i = 0; i < 8; ++i) { asm volatile("" : "+v"(ha[i][0])); asm volatile("" : "+v"(ha[i][1])); }
    g1m_dma(ub, wl, idx, 0, 0, eg, q16);
    g1m_dma(ub, wl + 8192, idx, 0, 1, eg, q16);
    asm volatile("s_waitcnt vmcnt(8)" ::: "memory");
#pragma unroll
    for (int i = 0; i < 7; ++i) {
        const float v0 = g1m_step<true, 9>(ub, wl, idx, i + 1, 0, eg, q16, rdoff, lane, ha[i][0], ha[i][1]);
        pp[(size_t)i * 128] = v0;
        const float v1 = g1m_step<true, 9>(ub, wl + 8192, idx, i + 1, 1, eg, q16, rdoff, lane, ha[i][0], ha[i][1]);
        pp[(size_t)i * 128 + 64] = v1;
    }
    {
        const float v0 = g1m_step<false, 9>(ub, wl, idx, 0, 0, eg, q16, rdoff, lane, ha[7][0], ha[7][1]);
        pp[(size_t)7 * 128] = v0;
        const float v1 = g1m_step<false, 0>(ub, wl + 8192, idx, 0, 1, eg, q16, rdoff, lane, ha[7][0], ha[7][1]);
        pp[(size_t)7 * 128 + 64] = v1;
    }
}
typedef int i32x2_t __attribute__((ext_vector_type(2)));
template <bool PRE, int VMW, int HH>
__device__ __forceinline__ void g2m_step(const unsigned char* vb_, PG8_LAS unsigned char* img, const PG8_LAS unsigned short* idx, int inext, int eg, unsigned q16,
                                         const unsigned (&tra)[8], const long a0, const long a1, f32x4 (&acc)[8]) {
    asm volatile("s_waitcnt vmcnt(%0)" :: "n"(VMW) : "memory");
    long b[2][8];
#pragma unroll
    for (int u = 0; u < 2; ++u)
#pragma unroll
        for (int j = 0; j < 8; ++j) asm volatile("ds_read_b64_tr_b8 %0, %1 offset:%2" : "=v"(b[u][j]) : "v"(tra[j]), "n"(HH * 8192 + u * 4096) : "memory");
    asm volatile("s_waitcnt lgkmcnt(0)" : "+v"(b[0][0]), "+v"(b[0][1]), "+v"(b[0][2]), "+v"(b[0][3]), "+v"(b[0][4]), "+v"(b[0][5]), "+v"(b[0][6]), "+v"(b[0][7]) :: "memory");
    asm volatile("" : "+v"(b[1][0]), "+v"(b[1][1]), "+v"(b[1][2]), "+v"(b[1][3]), "+v"(b[1][4]), "+v"(b[1][5]), "+v"(b[1][6]), "+v"(b[1][7]) :: "memory");
    if (PRE) { g1m_dma(vb_, img + HH * 8192, idx, inext, HH, eg, q16); __builtin_amdgcn_sched_barrier(0); }
#pragma unroll
    for (int j = 0; j < 8; ++j) {
        acc[j] = __builtin_amdgcn_mfma_f32_16x16x32_fp8_fp8(a0, b[0][j], acc[j], 0, 0, 0);
        acc[j] = __builtin_amdgcn_mfma_f32_16x16x32_fp8_fp8(a1, b[1][j], acc[j], 0, 0, 0);
    }
}
__device__ __forceinline__ void g2m_chunk(const Params& p, int l, int x, int tb, char* smem_, int lane) {
    PG8_LAS unsigned char* wl = (PG8_LAS unsigned char*)smem_ + p.wv * G1W;
    PG8_LAS unsigned short* idx = (PG8_LAS unsigned short*)(wl + 16384);
    const int* RI = (const int*)(p.ws + WS_RI);
    {
        int ra[16];
#pragma unroll
        for (int i = 0; i < 8; ++i) { ra[2 * i] = RI[(size_t)(tb + i) * 128 + lane]; ra[2 * i + 1] = RI[(size_t)(tb + i) * 128 + 64 + lane]; }
#pragma unroll
        for (int i = 0; i < 8; ++i) {
            idx[(i * 8 + (lane & 7)) * 16 + (lane >> 3)] = (unsigned short)ra[2 * i];
            idx[(i * 8 + (lane & 7)) * 16 + 8 + (lane >> 3)] = (unsigned short)ra[2 * i + 1];
        }
    }
    __builtin_amdgcn_fence(__ATOMIC_RELEASE, "wavefront");
    __builtin_amdgcn_wave_barrier();
    __builtin_amdgcn_fence(__ATOMIC_ACQUIRE, "wavefront");
    const int eg = lane >> 3, kb = lane >> 4, li = lane & 15, q = li >> 1;
    const unsigned q16 = (unsigned)(((lane & 7) ^ (eg >> 1)) * 16);
    const int n16 = (kb & 1) * 8 + q;
    const unsigned trbase = (unsigned)((kb * 8 + q) * 128 + ((n16 >> 1) & 7) * 16 + (li & 1) * 8);
    const unsigned char* vb_ = p.ws + WS_PV + (size_t)x * (16384u * 128u);
    float* op = p.out + (size_t)tb * 1024 + x * 128 + lane;
    const float* modr = (const float*)(p.ws + WS_MOD) + (size_t)(l * 8 + (tb >> 11)) * 6144 + 5120 + x * 128 + lane;
    float gf0 = modr[0], gf1 = modr[64];
    const unsigned char* c8 = p.ws + ((lane & 1) ? WS_C8L : WS_C8H) + (size_t)tb * 128 + kb * 32;
    u32x4 ca[8][2]; float xi[8][2], cinv[8];
#pragma unroll
    for (int i = 0; i < 8; ++i) {
        ca[i][0] = *(const u32x4*)(c8 + (size_t)i * 128); ca[i][1] = *(const u32x4*)(c8 + (size_t)i * 128 + 16);
        xi[i][0] = op[(size_t)i * 1024]; xi[i][1] = op[(size_t)i * 1024 + 64];
        cinv[i] = ((const float*)(p.ws + WS_CINV))[tb + i];
    }
#pragma unroll
    for (int i = 0; i < 8; ++i) { asm volatile("" : "+v"(ca[i][0])); asm volatile("" : "+v"(ca[i][1])); asm volatile("" : "+v"(xi[i][0]), "+v"(xi[i][1]), "+v"(cinv[i])); }
    asm volatile("" : "+v"(gf0), "+v"(gf1));
    g1m_dma(vb_, wl, idx, 0, 0, eg, q16);
    g1m_dma(vb_, wl + 8192, idx, 0, 1, eg, q16);
    asm volatile("s_waitcnt vmcnt(8)" ::: "memory");
    const int g = lane >> 4;
    unsigned tra[8];
#pragma unroll
    for (int j = 0; j < 8; ++j) tra[j] = (unsigned)(unsigned long)wl + (trbase ^ (unsigned)(j * 16));
#define G2M_TOKEN(i, PRE_, W0, W1) do { \
        f32x4 acc[8]; \
        _Pragma("unroll") for (int j = 0; j < 8; ++j) acc[j] = f32x4{0.f, 0.f, 0.f, 0.f}; \
        const long a00 = (long)(((unsigned long long)ca[i][0][1] << 32) | ca[i][0][0]), a01 = (long)(((unsigned long long)ca[i][0][3] << 32) | ca[i][0][2]); \
        const long a10 = (long)(((unsigned long long)ca[i][1][1] << 32) | ca[i][1][0]), a11 = (long)(((unsigned long long)ca[i][1][3] << 32) | ca[i][1][2]); \
        g2m_step<PRE_, W0, 0>(vb_, wl, idx, (i) + 1, eg, q16, tra, a00, a01, acc); \
        g2m_step<PRE_, W1, 1>(vb_, wl, idx, (i) + 1, eg, q16, tra, a10, a11, acc); \
        float y[8]; \
        _Pragma("unroll") for (int j = 0; j < 8; ++j) { y[j] = acc[j][0] + acc[j][1] * (1.f / 16.f); asm volatile("" : "+v"(y[j])); } \
        const float ya = g == 0 ? y[0] : g == 1 ? y[1] : g == 2 ? y[2] : y[3], yb = g == 0 ? y[4] : g == 1 ? y[5] : g == 2 ? y[6] : y[7]; \
        op[(size_t)(i) * 1024] = xi[i][0] + gf0 * (ya * cinv[i]); op[(size_t)(i) * 1024 + 64] = xi[i][1] + gf1 * (yb * cinv[i]); \
        __builtin_amdgcn_sched_barrier(0); } while (0)
    G2M_TOKEN(0, true, 10, 8);
    G2M_TOKEN(1, true, 10, 10); G2M_TOKEN(2, true, 10, 10); G2M_TOKEN(3, true, 10, 10);
    G2M_TOKEN(4, true, 10, 10); G2M_TOKEN(5, true, 10, 10); G2M_TOKEN(6, true, 10, 10);
    G2M_TOKEN(7, false, 10, 0);
#undef G2M_TOKEN
}
template <int WHICH>
__device__ void ph_peer_sliced(const Params& p, int l, int vb0, int nvb, char* smem_) {
    const int tid = TIDX(), wave = tid >> 6;
    const bf16_t* H = (const bf16_t*)(p.ws + WS_H); const unsigned char* PU = p.ws + WS_PU; const unsigned char* PV = p.ws + WS_PV;
    const int* RI = (const int*)(p.ws + WS_RI); float* RG = (float*)(p.ws + WS_RG); float* PP = (float*)(p.ws + WS_PP);
    const float* modb = (const float*)(p.ws + WS_MOD);
    {
    {
#pragma unroll 1
        for (int u_ = vb0; u_ < 2048; u_ += nvb) {
            const int x = u_ & 7, chunk = u_ >> 3;
            {
                const int lane = lane_id_opaque(), eg = lane >> 3, ll = lane & 7;
                const int tb = chunk * 64 + wave * 8;
                if (WHICH == 0 && G1_MFMA) { g1m_chunk(p, x, tb, smem_, lane); continue; }
                if (WHICH == 1 && G2_MFMA) { g2m_chunk(p, l, x, tb, smem_, lane); continue; }
                int* lri = (int*)smem_ + wave * 2048; float* lrg = (float*)(lri + 1024);
                {
                    int ra[16]; float rg_[16];
#pragma unroll
                    for (int i = 0; i < 8; ++i) {
                        ra[2 * i] = RI[(size_t)(tb + i) * 128 + lane]; ra[2 * i + 1] = RI[(size_t)(tb + i) * 128 + 64 + lane];
                        if (WHICH == 1) { rg_[2 * i] = RG[(size_t)(tb + i) * 128 + lane]; rg_[2 * i + 1] = RG[(size_t)(tb + i) * 128 + 64 + lane]; }
                    }
#pragma unroll
                    for (int i = 0; i < 8; ++i) {
                        lri[i * 128 + lane] = ra[2 * i]; lri[i * 128 + 64 + lane] = ra[2 * i + 1];
                        if (WHICH == 1) { lrg[i * 128 + lane] = rg_[2 * i]; lrg[i * 128 + 64 + lane] = rg_[2 * i + 1]; }
                    }
                }
                __builtin_amdgcn_fence(__ATOMIC_RELEASE, "wavefront");
                __builtin_amdgcn_wave_barrier();
                __builtin_amdgcn_fence(__ATOMIC_ACQUIRE, "wavefront");
                const unsigned l16 = (unsigned)ll * 16u;
                if (WHICH == 0) {
                    const unsigned char* ub = PU + (size_t)x * (16384u * 128u);
                    const bf16_t* hrow = H + (size_t)tb * 1024 + x * 128 + ll * 16;
                    float* pp_row = PP + ((size_t)x * T_TOK + tb) * 128 + ll * 8 + eg;
                    u32x4 hq0 = ((const u32x4*)hrow)[0], hq1 = ((const u32x4*)hrow)[1], uqA[8], uqB[8];
                    peer_gather8(uqA, ub, lri + eg, l16);
                    peer_gather8(uqB, ub, lri + eg + 64, l16);
#pragma unroll 1
                    for (int i = 0; i < 7; ++i) g1_step<true>(i, tb + i, hrow + (size_t)(i + 1) * 1024, ub, lri + eg, l16, lane, pp_row + (size_t)i * 128, hq0, hq1, uqA, uqB);
                    g1_step<false>(7, tb + 7, hrow, ub, lri + eg, l16, lane, pp_row + (size_t)7 * 128, hq0, hq1, uqA, uqB);
                } else {
                    const unsigned char* vb_ = PV + (size_t)x * (16384u * 128u);
                    const int col = x * 128 + ll * 16 + ((lane >> 5) & 1) * 8 + ((lane >> 4) & 1) * 4 + ((lane >> 3) & 1) * 2;
                    const float2 gf = *(const float2*)(modb + (size_t)(l * 8 + (tb >> 11)) * 6144 + 5120 + col);
                    float2* op = (float2*)(p.out + (size_t)tb * 1024 + col);
                    u32x4 vqA[8], vqB[8];
                    peer_gather8(vqA, vb_, lri + eg, l16);
                    peer_gather8(vqB, vb_, lri + eg + 64, l16);
#pragma unroll 1
                    for (int i = 0; i < 7; ++i) g2_step<true>(i, op + (size_t)i * 512, gf, vb_, lri + eg, lrg + eg, l16, lane, vqA, vqB);
                    g2_step<false>(7, op + (size_t)7 * 512, gf, vb_, lri + eg, lrg + eg, l16, lane, vqA, vqB);
                }
            }
        }
    }
    __syncthreads();
    }
}
__device__ void ph_peer_coef(const Params& p, int vb0, int nvb) {
    const int wave = TIDX() >> 6, lane = TIDX() & 63;
    float* RG = (float*)(p.ws + WS_RG); const float* PP = (const float*)(p.ws + WS_PP);
    for (int t0 = (vb0 * 8 + wave) * 2; t0 < T_TOK; t0 += nvb * 8 * 2) {
        float pp[2][2][8], g[2][2];
#pragma unroll
        for (int u = 0; u < 2; ++u)
#pragma unroll
            for (int half = 0; half < 2; ++half) {
                const int k = half * 64 + lane;
#pragma unroll
                for (int x = 0; x < 8; ++x) pp[u][half][x] = PP[((size_t)x * T_TOK + t0 + u) * 128 + k];
                g[u][half] = RG[(size_t)(t0 + u) * 128 + k];
            }
        asm volatile("" ::: "memory");
#pragma unroll
        for (int u = 0; u < 2; ++u) {
            float cf[2];
#pragma unroll
            for (int half = 0; half < 2; ++half) {
                float d = 0.f;
#pragma unroll
                for (int x = 0; x < 8; ++x) d += pp[u][half][x];
                d *= (1.f / PU_SCALE);
                cf[half] = g[u][half] * 0.5f * d * (1.f + erff(d * 0.7071067811865476f)) * (1.f / PV_SCALE);
                if (!G2_MFMA) RG[(size_t)(t0 + u) * 128 + half * 64 + lane] = cf[half];
            }
            if (G2_MFMA) {
                const float m = wave_max(fmaxf(fabsf(cf[0]), fabsf(cf[1])));
                const float sc = m > 0.f ? 240.f / m : 0.f;
                const float c0 = cf[0] * sc, c1 = cf[1] * sc;
                const int hi = __builtin_amdgcn_cvt_pk_fp8_f32(c0, c1, 0, false);
                const auto bk = __builtin_amdgcn_cvt_pk_f32_fp8(hi, false);
                const int lo = __builtin_amdgcn_cvt_pk_fp8_f32((c0 - bk[0]) * 16.f, (c1 - bk[1]) * 16.f, 0, false);
                unsigned char* c8h = p.ws + WS_C8H + (size_t)(t0 + u) * 128; unsigned char* c8l = p.ws + WS_C8L + (size_t)(t0 + u) * 128;
                const int s0 = ((lane >> 3) & 3) * 32 + (lane >> 5) * 8 + (lane & 7);
                c8h[s0] = (unsigned char)(hi & 0xff); c8h[s0 + 16] = (unsigned char)((hi >> 8) & 0xff);
                c8l[s0] = (unsigned char)(lo & 0xff); c8l[s0 + 16] = (unsigned char)((lo >> 8) & 0xff);
                if (lane == 0) ((float*)(p.ws + WS_CINV))[t0 + u] = m * (1.f / 240.f);
            }
        }
    }
}

enum { PH_MOD = 0, PH_WPREP, PH_NORM1, PH_GEMM_IN, PH_SCAN, PH_MERGE, PH_OUT, PH_NORM2, PH_GEMM_Q, PH_GEMM_SC, PH_ROUTE, PH_G1, PH_G15, PH_G2 };

template <int PH>
__device__ __forceinline__ void run_phase(const Params& p, int l, int vb0, int nvb, char* smem) {
    const float* xin = (l == 0) ? p.x : p.out;
    if (PH == PH_MOD) ph_mod(p, vb0, nvb, smem);
    else if (PH == PH_WPREP) ph_wprep(p, l, vb0, nvb, smem);
    else if (PH == PH_NORM1) ph_norm(p, l, 0, xin, vb0, nvb);
    else if (PH == PH_GEMM_IN) {
        pg8::Gemm g{(const bf16_t*)(p.ws + WS_H), (const bf16_t*)(p.ws + WS_WIN), 1024, 1024, 1024};
        pg8::StaticOrder S; S.init(T_TOK, LDZ, nvb, vb0, 1024, 1024);
        pg8::gemm_phase(( PG8_LAS unsigned char*)smem, g, S, pg8::EpiBf16{(bf16_t*)(p.ws + WS_Z), LDZ}, TIDX());
    }
    else if (PH == PH_SCAN) ph_mixA(p, l, vb0, nvb, smem);
    else if (PH == PH_MERGE) {
        pg8::Gemm g{(const bf16_t*)(p.ws + WS_Y), (const bf16_t*)(p.ws + WS_WBR), 1536, 512, 512};
        pg8::MergeOrder S{vb0, nvb};
        pg8::gemm_phase((PG8_LAS unsigned char*)smem, g, S, pg8::EpiMerge{(bf16_t*)(p.ws + WS_H), (const bf16_t*)(p.ws + WS_Z)}, TIDX());
    }
    else if (PH == PH_OUT) {
        pg8::Gemm g{(const bf16_t*)(p.ws + WS_H), (const bf16_t*)(p.ws + WS_WOUT), 1024, 1024, 1024};
        pg8::StaticOrder S; S.init(T_TOK, 1024, nvb, vb0, 1024, 1024);
        pg8::gemm_phase((PG8_LAS unsigned char*)smem, g, S, pg8::EpiResid{xin, p.out, (const float*)(p.ws + WS_MOD) + (size_t)l * 8 * 6144}, TIDX());
    }
    else if (PH == PH_NORM2) ph_norm(p, l, 1, p.out, vb0, nvb);
    else if (PH == PH_GEMM_Q) {
        pg8::Gemm g{(const bf16_t*)(p.ws + WS_H), (const bf16_t*)(p.ws + WS_WQ), 1024, 1024, 1024};
        pg8::StaticOrder S; S.init(T_TOK, 2048, nvb, vb0, 1024, 1024);
        pg8::gemm_phase((PG8_LAS unsigned char*)smem, g, S, pg8::EpiF16P{(_Float16*)(p.ws + WS_SC), 2048}, TIDX());
        asm volatile("s_waitcnt vmcnt(0)" ::: "memory");
        __syncthreads();
        {
            const int tid_ = TIDX(), lane_ = tid_ & 63, wave_ = __builtin_amdgcn_readfirstlane(tid_ >> 6);
            _Float16* tile_ = (_Float16*)smem + wave_ * (64 * 72);
#pragma unroll 1
            for (int i = (wave_ >> 2); ; i += 2) {
                pg8::Unit u; if (!S.next(i, u)) break;
                route_wave(p, u.pm * 256 + (wave_ & 3) * 64, u.pn, tile_, lane_);
            }
        }
    }
    else if (PH == PH_GEMM_SC) gemm_phase((const bf16_t*)(p.ws + WS_QP), 2048, (const bf16_t*)(p.ws + WS_SK), 128, T_TOK, 2048, 128, true,
                                          EpiF16{(_Float16*)(p.ws + WS_SC), 2048}, vb0, nvb, smem, TIDX());
    else if (PH == PH_G1) ph_peer_sliced<0>(p, l, vb0, nvb, smem);
    else if (PH == PH_G15) ph_peer_coef(p, vb0, nvb);
    else if (PH == PH_G2) ph_peer_sliced<1>(p, l, vb0, nvb, smem);

}

#define XB_TMO      128
#define XB_XCNT(j)  (256  + 64 * (j))
#define XB_XSUB(j)  (1280 + 64 * (j))
#define XB_XGEN(j)  (2304 + 64 * (j))
#define XB_TOP      3328
#define XB_TOPGEN   3392
#define XCD_BAR_WORDS 3456
#define XB_SPIN_CAP (1u << 18)
#define LAS __attribute__((address_space(3)))
__device__ __forceinline__ unsigned xb_ld(unsigned* p)              { return __hip_atomic_load(p, __ATOMIC_RELAXED, __HIP_MEMORY_SCOPE_AGENT); }
__device__ __forceinline__ unsigned xb_add(unsigned* p, unsigned v) { return __hip_atomic_fetch_add(p, v, __ATOMIC_RELAXED, __HIP_MEMORY_SCOPE_AGENT); }
#define XB_SPIN(cond, bar) do { unsigned _sp = 0; while (cond) { __builtin_amdgcn_s_sleep(1); \
    if ((++_sp & 255u) == 0u) { if (xb_ld(&(bar)[XB_TMO])) break; if (_sp > XB_SPIN_CAP) { atomicAdd(&(bar)[XB_TMO], 1u); break; } } } } while (0)
struct XcdBarrier { unsigned* bar; unsigned x; volatile LAS unsigned* st; int wv; };
__device__ __forceinline__ XcdBarrier xcd_barrier_post(unsigned* bar, volatile LAS unsigned* st, int wv) {
    XcdBarrier b; b.bar = bar; b.x = xb_xcc_id(); b.st = st; b.wv = wv;
    if (TIDXW(wv) == 0) (void)xb_add(&bar[XB_XCNT(b.x)], 1u);
    return b;
}
__device__ __forceinline__ void xcd_barrier_complete(unsigned* bar, unsigned x, unsigned& nloc, unsigned& nx) {
    const unsigned G = gridDim.x * gridDim.y * gridDim.z;
    unsigned sum, cnt, mine, sp = 0u;
    for (;;) {
        sum = 0u; cnt = 0u; mine = 0u;
#pragma unroll
        for (unsigned j = 0; j < 16; ++j) { const unsigned c = xb_ld(&bar[XB_XCNT(j)]); sum += c; cnt += (c > 0u) ? 1u : 0u; mine = (j == x) ? c : mine; }
        if (sum == G) break;
        __builtin_amdgcn_s_sleep(1);
        if ((++sp & 255u) == 0u) { if (xb_ld(&bar[XB_TMO])) break; if (sp > XB_SPIN_CAP) { atomicAdd(&bar[XB_TMO], 1u); break; } }
    }
    nloc = mine > 0u ? mine : 1u; nx = cnt > 0u ? cnt : 1u;
}
__device__ __forceinline__ void xcd_barrier(const XcdBarrier& b) {
    asm volatile("s_waitcnt vmcnt(0)" ::: "memory");
    __syncthreads();
    if (TIDXW(b.wv) == 0) {
        unsigned* bar = b.bar;
        __builtin_amdgcn_s_waitcnt(0);
        unsigned nloc = b.st[0], nx = b.st[1];
        if (nloc == 0u) { xcd_barrier_complete(bar, b.x, nloc, nx); b.st[0] = nloc; b.st[1] = nx; }
        const unsigned old = xb_add(&bar[XB_XSUB(b.x)], 1u);
        const unsigned gen = old / nloc;
        if (old + 1u == (gen + 1u) * nloc) {
            __builtin_amdgcn_fence(__ATOMIC_RELEASE, "agent");
            asm volatile("s_waitcnt vmcnt(0)" ::: "memory");
            const unsigned og = xb_add(&bar[XB_TOP], 1u);
            const unsigned tg = og / nx;
            if (og + 1u == (tg + 1u) * nx) xb_add(&bar[XB_TOPGEN], 1u);
            else XB_SPIN(xb_ld(&bar[XB_TOPGEN]) == tg, bar);
            __builtin_amdgcn_fence(__ATOMIC_ACQUIRE, "agent");
            xb_add(&bar[XB_XGEN(b.x)], 1u);
            asm volatile("s_waitcnt vmcnt(0)" ::: "memory");
        } else {
            XB_SPIN(xb_ld(&bar[XB_XGEN(b.x)]) == gen, bar);
            __builtin_amdgcn_fence(__ATOMIC_ACQUIRE, "agent");
            asm volatile("s_waitcnt vmcnt(0)" ::: "memory");
        }
    }
    __syncthreads();
}

__global__ void __launch_bounds__(NT) mega_kernel(Params p_in) {
#if defined(__HIP_DEVICE_COMPILE__)
    extern __shared__ __attribute__((aligned(16))) char smem[];
    volatile LAS unsigned* st = (volatile LAS unsigned*)(smem + LDS_BYTES - 16);
    int wv_ = __builtin_amdgcn_readfirstlane((int)threadIdx.x >> 6); asm volatile("" : "+s"(wv_));
    { const int t_ = TIDXW(wv_); if (t_ < 4) st[t_] = 0u; }
    __syncthreads();
    XcdBarrier bar = xcd_barrier_post((unsigned*)(p_in.ws + WS_CTL), st, wv_);
    const int vb = (int)blockIdx.x, nvb = (int)gridDim.x;
#define GB() xcd_barrier(bar)
#define RUN(PH, L) do { \
        const __attribute__((address_space(4))) Params* _kp = (const __attribute__((address_space(4))) Params*)__builtin_amdgcn_kernarg_segment_ptr(); asm volatile("" : "+s"(_kp)); Params _p = *_kp; _p.wv = wv_; \
        int _l = (L), _vb = vb, _nvb = nvb; asm volatile("" : "+s"(_l), "+s"(_vb), "+s"(_nvb)); \
        run_phase<PH>(_p, _l, _vb, _nvb, smem); } while (0)
    RUN(PH_MOD, 0);
#pragma unroll 1
    for (int l = 0; l < 2; ++l) {
        RUN(PH_WPREP, l); if (l == 0) GB();
        RUN(PH_NORM1, l); GB();
        RUN(PH_GEMM_IN, l); GB();
        RUN(PH_SCAN, l); GB();
        RUN(PH_MERGE, l); GB();
        RUN(PH_OUT, l); GB();
        RUN(PH_NORM2, l); GB();
        RUN(PH_GEMM_Q, l); GB();
        RUN(PH_G1, l); GB();
        RUN(PH_G15, l); GB();
        RUN(PH_G2, l);
        if (l == 0) GB();
    }
#undef RUN
#undef GB
#endif
}

extern "C" void kernel_launch(void* const* d_in, const int* in_sizes, int n_in, void* d_out, int out_size, void* d_ws, size_t ws_size,
                              hipStream_t stream) {
    if (n_in != 20 || ws_size < WS_END) { fprintf(stderr, "kernel_launch: bad inputs (n_in %d ws %zu need %zu)\n", n_in, ws_size, (size_t)WS_END); return; }
    Params p{};
    p.x = (const float*)d_in[0]; p.c = (const float*)d_in[1]; p.w_ada = (const float*)d_in[2]; p.b_ada = (const float*)d_in[3];
    p.norm_mix = (const float*)d_in[4]; p.norm_ffn = (const float*)d_in[5]; p.w_in = (const float*)d_in[6]; p.hgrn_lb = (const float*)d_in[7];
    p.hgrn_on = (const float*)d_in[8]; p.dsa_qn = (const float*)d_in[9]; p.dsa_kn = (const float*)d_in[10]; p.gla_up = (const float*)d_in[11];
    p.gla_bias = (const float*)d_in[12]; p.gla_on = (const float*)d_in[13]; p.w_branch = (const float*)d_in[14]; p.w_out = (const float*)d_in[15];
    p.peer_wq = (const float*)d_in[16]; p.peer_keys = (const float*)d_in[17]; p.peer_u = (const float*)d_in[18]; p.peer_v = (const float*)d_in[19];
    p.out = (float*)d_out; p.ws = (unsigned char*)d_ws;
    static int grid = 0;
    if (grid == 0) {
        int dev = 0, cus = 0, per_cu = 0;
        hipGetDevice(&dev);
        hipDeviceGetAttribute(&cus, hipDeviceAttributeMultiprocessorCount, dev);
        hipFuncSetAttribute((const void*)mega_kernel, hipFuncAttributeMaxDynamicSharedMemorySize, LDS_BYTES);
        hipOccupancyMaxActiveBlocksPerMultiprocessor(&per_cu, (const void*)mega_kernel, NT, LDS_BYTES);
        if (per_cu < 1) { fprintf(stderr, "kernel_launch: occupancy query says %d blocks per CU\n", per_cu); per_cu = 1; }
        (void)hipGetLastError();
        grid = cus;
    }
    hipMemsetAsync((char*)d_ws + WS_CTL, 0, 32768, stream);
    void* args[] = {&p};
    hipError_t e = hipLaunchCooperativeKernel((const void*)mega_kernel, dim3(grid), dim3(NT), args, LDS_BYTES, stream);
    if (e != hipSuccess) fprintf(stderr, "cooperative launch failed: %s (grid %d)\n", hipGetErrorString(e), grid);
}
```
